# Optimizing an MI355X kernel written in HIP

```python
import jax, jax.numpy as jnp
from jax import lax
import numpy as np

D_MODEL = 1024
BATCH = 4
SEQ = 8192
DEPTH = 2

CHUNK = 64
HEAD_DIM = 64
D_MIX = D_MODEL
DA = 3 * D_MIX // 8
DC = D_MIX // 4
DB = D_MIX - DA - DC
HA = DA // HEAD_DIM
HB = DB // HEAD_DIM
CONV_K = 4
LORA_W = 64
LORA_A = 64
LORA_G = 128
LORA_V = 32
RWKV_SIZES = (DB, DB, DB, LORA_W, LORA_A, LORA_G)
RWKV_COLS = sum(RWKV_SIZES)
S5_GC = 16
S5_G = DC // S5_GC
S5_P = 64
IN_SIZES = (DA, DA, DA, HA, HA, RWKV_COLS, DC)
IN_COLS = sum(IN_SIZES)
N_GROUPS = 4
EXPERTS_PER_GROUP = 8
N_EXPERTS = N_GROUPS * EXPERTS_PER_GROUP
TOP_K = 2
D_EXPERT = D_MODEL // 2
ROW_BLOCK = 128
NORM_EPS = 1e-6
HEAD_NORM_EPS = 1e-5
RWKV_GN_EPS = 64e-5
L2_EPS = 1e-12

IN_SPLITS = [int(s) for s in np.cumsum(IN_SIZES)[:-1]]
RWKV_SPLITS = [int(s) for s in np.cumsum(RWKV_SIZES)[:-1]]

kernel_name = 'hybrid_mlstm_rwkv7_s5_hmoe_adaln'


def rmsnorm(x, g):
    x32 = x.astype(jnp.float32)
    y = x32 * lax.rsqrt(jnp.mean(x32 * x32, axis=-1, keepdims=True) + NORM_EPS)
    return (y * g.astype(jnp.float32)).astype(x.dtype)


def head_layernorm(h, eps):
    mu = jnp.mean(h, axis=-1, keepdims=True)
    var = jnp.mean(jnp.square(h - mu), axis=-1, keepdims=True)
    return (h - mu) * lax.rsqrt(var + eps)


def causal_conv(x, w, b):
    k_len = w.shape[0]
    s_len = x.shape[1]
    xp = jnp.pad(x, ((0, 0), (k_len - 1, 0), (0, 0)))
    return sum(xp[:, j:j + s_len] * w[j] for j in range(k_len)) + b


def mlstm_mixer(qk_pre, v_pre, o_pre, i_pre, f_pre, conv_w, conv_b, w_q, w_k, b_i, b_f, norm_w):
    f32 = jnp.float32
    bsz, s_len, _ = v_pre.shape
    nc = s_len // CHUNK
    cx = jax.nn.silu(causal_conv(qk_pre, conv_w, conv_b)).reshape(bsz, s_len, HA, HEAD_DIM)
    q = jnp.einsum('bshd,hde->bshe', cx, w_q)
    k = jnp.einsum('bshd,hde->bshe', cx, w_k) * (HEAD_DIM ** -0.5)
    v = v_pre.reshape(bsz, s_len, HA, HEAD_DIM)

    def to_chunks(t):
        return t.astype(f32).reshape(bsz, nc, CHUNK, HA, HEAD_DIM).transpose(0, 3, 1, 2, 4)

    def gate_chunks(t):
        return t.astype(f32).reshape(bsz, nc, CHUNK, HA).transpose(0, 3, 1, 2)

    qc, kc, vc = to_chunks(q), to_chunks(k), to_chunks(v)
    ig = gate_chunks(i_pre + b_i)
    flog = jax.nn.log_sigmoid(gate_chunks(f_pre + b_f))
    bcum = jnp.cumsum(flog, axis=-1)
    gtot = bcum[..., -1]

    lw = gtot[..., None] - bcum + ig
    m_loc = jnp.max(lw, axis=-1)
    wloc = jnp.exp(lw - m_loc[..., None])
    c_loc = jnp.einsum('bhcsk,bhcsv->bhckv', kc * wloc[..., None], vc)
    n_loc = jnp.einsum('bhcs,bhcsk->bhck', wloc, kc)

    def step(carry, inp):
        c_prev, n_prev, m_prev = carry
        g_c, ml_c, cl_c, nl_c = inp
        m_new = jnp.maximum(g_c + m_prev, ml_c)
        a_old = jnp.exp(g_c + m_prev - m_new)
        a_loc = jnp.exp(ml_c - m_new)
        c_new = a_old[..., None, None] * c_prev + a_loc[..., None, None] * cl_c
        n_new = a_old[..., None] * n_prev + a_loc[..., None] * nl_c
        return (c_new, n_new, m_new), (c_prev, n_prev, m_prev)

    init = (jnp.zeros((bsz, HA, HEAD_DIM, HEAD_DIM), f32),
            jnp.zeros((bsz, HA, HEAD_DIM), f32),
            jnp.zeros((bsz, HA), f32))
    xs = tuple(jnp.moveaxis(t, 2, 0) for t in (gtot, m_loc, c_loc, n_loc))
    _, (c_st, n_st, m_st) = lax.scan(step, init, xs)
    c_st, n_st, m_st = (jnp.moveaxis(t, 0, 2) for t in (c_st, n_st, m_st))

    causal = jnp.tril(jnp.ones((CHUNK, CHUNK), dtype=bool))
    dmat = jnp.where(causal, bcum[..., :, None] - bcum[..., None, :] + ig[..., None, :], -jnp.inf)
    inter = bcum + m_st[..., None]
    m_t = jnp.maximum(inter, jnp.max(dmat, axis=-1))
    s_qk = jnp.einsum('bhctd,bhcsd->bhcts', qc, kc) * jnp.exp(dmat - m_t[..., None])
    w_inter = jnp.exp(inter - m_t)
    num = (w_inter[..., None] * jnp.einsum('bhctk,bhckv->bhctv', qc, c_st)
           + jnp.einsum('bhcts,bhcsv->bhctv', s_qk, vc))
    den = w_inter * jnp.einsum('bhctk,bhck->bhct', qc, n_st) + jnp.sum(s_qk, axis=-1)
    h = num / jnp.maximum(jnp.abs(den), jnp.exp(-m_t))[..., None]
    h = h.transpose(0, 2, 3, 1, 4).reshape(bsz, s_len, HA, HEAD_DIM)
    h = head_layernorm(h, HEAD_NORM_EPS).reshape(bsz, s_len, DA) * norm_w.astype(f32)
    return h * jax.nn.sigmoid(o_pre.astype(f32))


def rwkv7_mixer(p, mu, w0, w_up, a0, a_up, g_up, k_k, k_a, r_k, ln_w, ln_b,
                v_first=None, v0=None, v_dn=None, v_up=None):
    f32 = jnp.float32
    bsz, s_len, _ = p.shape
    prev = jnp.pad(p, ((0, 0), (1, 0), (0, 0)))[:, :s_len]
    p = p + mu * (prev - p)
    r, k, v, wd, ad, gd = jnp.split(p, RWKV_SPLITS, axis=-1)
    wlog = -jax.nn.softplus(-(w0 + jnp.tanh(wd) @ w_up).astype(f32)) - 0.5
    decay = jnp.exp(-jnp.exp(wlog))
    a = jax.nn.sigmoid((a0 + ad @ a_up).astype(f32))
    g = jax.nn.sigmoid(gd) @ g_up
    if v_first is None:
        v_first = v
    else:
        v = v + (v_first - v) * jax.nn.sigmoid(v0 + (v @ v_dn) @ v_up)

    def heads(t):
        return t.astype(f32).reshape(bsz, s_len, HB, HEAD_DIM)

    r_h, k_h, v_h, a_h, w_h = heads(r), heads(k), heads(v), heads(a), heads(decay)
    kk = k_h * k_k.astype(f32).reshape(HB, HEAD_DIM)
    kk = kk / jnp.maximum(jnp.sqrt(jnp.sum(kk * kk, axis=-1, keepdims=True)), L2_EPS)
    k_h = k_h * (1.0 + (a_h - 1.0) * k_a.astype(f32).reshape(HB, HEAD_DIM))

    def tm(t):
        return jnp.moveaxis(t, 1, 0)

    xs = (tm(r_h), tm(w_h), tm(k_h), tm(v_h), tm(-kk), tm(kk * a_h))

    def step(state, inp):
        r_t, w_t, k_t, v_t, a_t, b_t = inp
        sa = jnp.einsum('bhvk,bhk->bhv', state, a_t)
        state = (state * w_t[:, :, None, :] + sa[..., None] * b_t[:, :, None, :]
                 + v_t[..., None] * k_t[:, :, None, :])
        return state, jnp.einsum('bhvk,bhk->bhv', state, r_t)

    _, y = lax.scan(step, jnp.zeros((bsz, HB, HEAD_DIM, HEAD_DIM), f32), xs)
    y = jnp.moveaxis(y, 0, 1)
    y = head_layernorm(y, RWKV_GN_EPS).reshape(bsz, s_len, DB) * ln_w.astype(f32) + ln_b.astype(f32)
    bonus = jnp.sum(r_h * k_h * r_k.astype(f32), axis=-1, keepdims=True) * v_h
    y = (y + bonus.reshape(bsz, s_len, DB)) * g.astype(f32)
    return y, v_first


def _complex_affine_combine(e1, e2):
    a1r, a1i, b1r, b1i = e1
    a2r, a2i, b2r, b2i = e2
    return (a2r * a1r - a2i * a1i,
            a2r * a1i + a2i * a1r,
            a2r * b1r - a2i * b1i + b2r,
            a2r * b1i + a2i * b1r + b2i)


def s5_mixer(u, a_re, a_im, log_dt, b_re, b_im, c_re, c_im, d, glu_w, glu_b):
    f32 = jnp.float32
    bsz, s_len, _ = u.shape
    uf = u.astype(f32).reshape(bsz, s_len, S5_G, S5_GC)
    a_re = a_re.astype(f32)
    a_im = a_im.astype(f32)
    dt = jnp.exp(log_dt.astype(f32))[:, None]
    mag = jnp.exp(a_re * dt)
    ang = a_im * dt
    ab_re = mag * jnp.cos(ang)
    ab_im = mag * jnp.sin(ang)
    inv = 1.0 / (a_re * a_re + a_im * a_im)
    co_re = ((ab_re - 1.0) * a_re + ab_im * a_im) * inv
    co_im = (ab_im * a_re - (ab_re - 1.0) * a_im) * inv
    b_re = b_re.astype(f32)
    b_im = b_im.astype(f32)
    bb_re = co_re[..., None] * b_re - co_im[..., None] * b_im
    bb_im = co_re[..., None] * b_im + co_im[..., None] * b_re
    bu_re = jnp.einsum('gpc,bsgc->bsgp', bb_re, uf)
    bu_im = jnp.einsum('gpc,bsgc->bsgp', bb_im, uf)
    shape_a = (1, s_len, S5_G, S5_P)
    elems = (jnp.broadcast_to(ab_re, shape_a), jnp.broadcast_to(ab_im, shape_a), bu_re, bu_im)
    _, _, x_re, x_im = lax.associative_scan(_complex_affine_combine, elems, axis=1)
    y = (jnp.einsum('gcp,bsgp->bsgc', c_re.astype(f32), x_re)
         - jnp.einsum('gcp,bsgp->bsgc', c_im.astype(f32), x_im)
         + d.astype(f32).reshape(S5_G, S5_GC) * uf)
    y = jax.nn.gelu(y.reshape(bsz, s_len, DC))
    return y * jax.nn.sigmoid(y @ glu_w.astype(f32) + glu_b.astype(f32))


def hier_moe(h, w_rg, b_rg, w_re, b_re, w1, w3, w2):
    f32 = jnp.float32
    bsz, s_len, d = h.shape
    n_tok = bsz * s_len
    ht = h.reshape(n_tok, d)
    p_group = jax.nn.softmax((ht @ w_rg + b_rg).astype(f32), axis=-1)
    gp, gi = lax.top_k(p_group, 1)
    e_logits = (ht @ w_re + b_re).astype(f32).reshape(n_tok, N_GROUPS, EXPERTS_PER_GROUP)
    sel = jnp.take_along_axis(e_logits, gi[:, :, None], axis=1)[:, 0]
    ev, ei = lax.top_k(sel, TOP_K)
    wts = gp * jax.nn.softmax(ev, axis=-1)

    n_assign = n_tok * TOP_K
    eid = (gi * EXPERTS_PER_GROUP + ei).reshape(n_assign)
    tok = jnp.repeat(jnp.arange(n_tok, dtype=jnp.int32), TOP_K)
    wflat = wts.reshape(n_assign)
    order = jnp.argsort(eid)
    e_s, tok_s, w_s = eid[order], tok[order], wflat[order]
    counts = jnp.zeros((N_EXPERTS,), jnp.int32).at[eid].add(1)
    starts = jnp.cumsum(counts) - counts
    pcounts = (counts + ROW_BLOCK - 1) // ROW_BLOCK * ROW_BLOCK
    pends = jnp.cumsum(pcounts)
    pstarts = pends - pcounts
    dest = pstarts[e_s] + jnp.arange(n_assign, dtype=jnp.int32) - starts[e_s]
    n_rows = n_assign + N_EXPERTS * ROW_BLOCK
    n_blocks = n_rows // ROW_BLOCK
    row_tok = jnp.full((n_rows,), n_tok, jnp.int32).at[dest].set(tok_s)
    row_w = jnp.zeros((n_rows,), f32).at[dest].set(w_s)
    blk_e = jnp.minimum(jnp.searchsorted(pends, jnp.arange(n_blocks, dtype=jnp.int32) * ROW_BLOCK,
                                         side='right'), N_EXPERTS - 1).astype(jnp.int32)
    x_pad = jnp.concatenate([ht, jnp.zeros((1, d), ht.dtype)], axis=0)
    xr = x_pad[row_tok].reshape(n_blocks, ROW_BLOCK, d)

    def expert_block(args):
        xb, e = args
        return (jax.nn.silu(xb @ w1[e]) * (xb @ w3[e])) @ w2[e]

    yr = lax.map(expert_block, (xr, blk_e)).reshape(n_rows, d)
    out = jnp.zeros((n_tok + 1, d), yr.dtype).at[row_tok].add(yr * row_w[:, None].astype(yr.dtype))
    return out[:n_tok].reshape(bsz, s_len, d)


def setup_inputs(seed: int = 0) -> dict:
    key = jax.random.key(seed)
    ks = iter(jax.random.split(key, 64))
    f32 = jnp.float32

    def nrm(shape, scale):
        return scale * jax.random.normal(next(ks), shape, f32)

    def unif(shape, lo, hi):
        return jax.random.uniform(next(ks), shape, f32, lo, hi)

    L = DEPTH
    LV = DEPTH - 1
    return {
        'x': nrm((BATCH, SEQ, D_MODEL), 1.0),
        'c': nrm((BATCH, D_MODEL), 1.0),
        'ada_w': nrm((L, D_MODEL, 6 * D_MODEL), 0.1 * D_MODEL ** -0.5),
        'ada_b': nrm((L, 6 * D_MODEL), 0.02),
        'norm_mix': 1.0 + nrm((L, D_MODEL), 0.02),
        'norm_ffn': 1.0 + nrm((L, D_MODEL), 0.02),
        'norm_final': 1.0 + nrm((D_MODEL,), 0.02),
        'w_in': nrm((L, D_MODEL, IN_COLS), D_MODEL ** -0.5),
        'w_out': nrm((L, D_MIX, D_MODEL), D_MIX ** -0.5),
        'mlstm_conv_w': nrm((L, CONV_K, DA), CONV_K ** -0.5),
        'mlstm_conv_b': nrm((L, DA), 0.02),
        'mlstm_w_q': nrm((L, HA, HEAD_DIM, HEAD_DIM), HEAD_DIM ** -0.5),
        'mlstm_w_k': nrm((L, HA, HEAD_DIM, HEAD_DIM), HEAD_DIM ** -0.5),
        'mlstm_b_i': nrm((L, HA), 0.1),
        'mlstm_b_f': jnp.linspace(3.0, 6.0, HA, dtype=f32)[None, :] + nrm((L, HA), 0.1),
        'mlstm_norm_w': 1.0 + nrm((L, DA), 0.02),
        'rwkv_mu': unif((L, RWKV_COLS), 0.0, 1.0),
        'rwkv_w0': jnp.linspace(-6.0, 1.0, DB, dtype=f32)[None, :] + nrm((L, DB), 0.1),
        'rwkv_w_up': nrm((L, LORA_W, DB), 0.1),
        'rwkv_a0': nrm((L, DB), 0.1),
        'rwkv_a_up': nrm((L, LORA_A, DB), 0.5 * LORA_A ** -0.5),
        'rwkv_g_up': nrm((L, LORA_G, DB), LORA_G ** -0.5),
        'rwkv_k_k': 0.85 + nrm((L, DB), 0.02),
        'rwkv_k_a': 1.0 + nrm((L, DB), 0.02),
        'rwkv_r_k': nrm((L, HB, HEAD_DIM), 0.1),
        'rwkv_ln_w': 1.0 + nrm((L, DB), 0.02),
        'rwkv_ln_b': nrm((L, DB), 0.02),
        'rwkv_v0': 1.0 + nrm((LV, DB), 0.1),
        'rwkv_v_dn': nrm((LV, DB, LORA_V), DB ** -0.5),
        'rwkv_v_up': nrm((LV, LORA_V, DB), 0.1 * LORA_V ** -0.5),
        's5_a_re': -0.5 + nrm((L, S5_G, S5_P), 0.01),
        's5_a_im': jnp.pi * jnp.arange(S5_P, dtype=f32) + nrm((L, S5_G, S5_P), 0.01),
        's5_log_dt': unif((L, S5_G), float(np.log(1e-3)), float(np.log(1e-1))),
        's5_b_re': nrm((L, S5_G, S5_P, S5_GC), (2 * S5_GC) ** -0.5),
        's5_b_im': nrm((L, S5_G, S5_P, S5_GC), (2 * S5_GC) ** -0.5),
        's5_c_re': nrm((L, S5_G, S5_GC, S5_P), S5_P ** -0.5),
        's5_c_im': nrm((L, S5_G, S5_GC, S5_P), S5_P ** -0.5),
        's5_d': nrm((L, DC), 1.0),
        's5_glu_w': nrm((L, DC, DC), DC ** -0.5),
        's5_glu_b': nrm((L, DC), 0.02),
        'moe_w_rg': nrm((L, D_MODEL, N_GROUPS), D_MODEL ** -0.5),
        'moe_b_rg': nrm((L, N_GROUPS), 0.01),
        'moe_w_re': nrm((L, D_MODEL, N_EXPERTS), D_MODEL ** -0.5),
        'moe_b_re': nrm((L, N_EXPERTS), 0.01),
        'moe_w1': nrm((L, N_EXPERTS, D_MODEL, D_EXPERT), D_MODEL ** -0.5),
        'moe_w3': nrm((L, N_EXPERTS, D_MODEL, D_EXPERT), D_MODEL ** -0.5),
        'moe_w2': nrm((L, N_EXPERTS, D_EXPERT, D_MODEL), D_EXPERT ** -0.5),
    }


def reference(x, c, ada_w, ada_b, norm_mix, norm_ffn, norm_final, w_in, w_out,
              mlstm_conv_w, mlstm_conv_b, mlstm_w_q, mlstm_w_k, mlstm_b_i, mlstm_b_f, mlstm_norm_w,
              rwkv_mu, rwkv_w0, rwkv_w_up, rwkv_a0, rwkv_a_up, rwkv_g_up, rwkv_k_k, rwkv_k_a,
              rwkv_r_k, rwkv_ln_w, rwkv_ln_b, rwkv_v0, rwkv_v_dn, rwkv_v_up,
              s5_a_re, s5_a_im, s5_log_dt, s5_b_re, s5_b_im, s5_c_re, s5_c_im, s5_d,
              s5_glu_w, s5_glu_b,
              moe_w_rg, moe_b_rg, moe_w_re, moe_b_re, moe_w1, moe_w3, moe_w2):
    out_dtype = x.dtype
    cond = jax.nn.silu(c)
    v_first = None
    for l in range(DEPTH):
        mod = (cond @ ada_w[l] + ada_b[l])[:, None, :]
        sh1, sc1, gt1, sh2, sc2, gt2 = jnp.split(mod, 6, axis=-1)

        h = rmsnorm(x, norm_mix[l]) * (1.0 + sc1) + sh1
        proj = h @ w_in[l]
        a_qk, a_v, a_o, a_i, a_f, b_cols, c_u = jnp.split(proj, IN_SPLITS, axis=-1)
        y_a = mlstm_mixer(a_qk, a_v, a_o, a_i, a_f, mlstm_conv_w[l], mlstm_conv_b[l],
                          mlstm_w_q[l], mlstm_w_k[l], mlstm_b_i[l], mlstm_b_f[l], mlstm_norm_w[l])
        if l == 0:
            y_b, v_first = rwkv7_mixer(b_cols, rwkv_mu[l], rwkv_w0[l], rwkv_w_up[l], rwkv_a0[l],
                                       rwkv_a_up[l], rwkv_g_up[l], rwkv_k_k[l], rwkv_k_a[l],
                                       rwkv_r_k[l], rwkv_ln_w[l], rwkv_ln_b[l])
        else:
            y_b, _ = rwkv7_mixer(b_cols, rwkv_mu[l], rwkv_w0[l], rwkv_w_up[l], rwkv_a0[l],
                                 rwkv_a_up[l], rwkv_g_up[l], rwkv_k_k[l], rwkv_k_a[l],
                                 rwkv_r_k[l], rwkv_ln_w[l], rwkv_ln_b[l],
                                 v_first, rwkv_v0[l - 1], rwkv_v_dn[l - 1], rwkv_v_up[l - 1])
        y_c = s5_mixer(c_u, s5_a_re[l], s5_a_im[l], s5_log_dt[l], s5_b_re[l], s5_b_im[l],
                       s5_c_re[l], s5_c_im[l], s5_d[l], s5_glu_w[l], s5_glu_b[l])
        mixed = jnp.concatenate([y_a.astype(h.dtype), y_b.astype(h.dtype), y_c.astype(h.dtype)],
                                axis=-1) @ w_out[l]
        x = x + (1.0 + gt1) * mixed

        h = rmsnorm(x, norm_ffn[l]) * (1.0 + sc2) + sh2
        x = x + (1.0 + gt2) * hier_moe(h, moe_w_rg[l], moe_b_rg[l], moe_w_re[l], moe_b_re[l],
                                       moe_w1[l], moe_w3[l], moe_w2[l])
    return rmsnorm(x, norm_final).astype(out_dtype)
```

```cpp
#include <hip/hip_runtime.h>
#include <cstdio>
#include <cstdint>
#define MK_PER_PHASE 0

#ifndef MK_PER_PHASE
#define MK_PER_PHASE 0
#endif
#ifndef EN_MLSTM
#define EN_MLSTM 1
#endif
#ifndef EN_S5
#define EN_S5 1
#endif
#ifndef EN_RWKV
#define EN_RWKV 1
#endif
#ifndef EN_MOE
#define EN_MOE 1
#endif
#ifndef N_LAYERS
#define N_LAYERS 2
#endif
constexpr int NWAVES = 8, NTHR = 512;
constexpr int DM = 1024, NB = 4, SEQ = 8192, NTOK = NB * SEQ;
constexpr int DA = 384, DBR = 384, DC = 256, NH = 6, HD = 64, NCH = SEQ / 64;
constexpr int IN_COLS = 2828, NPROJ = 2816, NPROJ_PAD = 3072;
constexpr int PC_QK = 0, PC_V = 384, PC_O = 768, PC_RW = 1152, PC_S5 = 2560;
constexpr int RWC_R = 0, RWC_K = 384, RWC_V = 768, RWC_WD = 1152, RWC_AD = 1216, RWC_GD = 1280, RW_COLS = 1408;
constexpr int NEXP = 32, DEXP = 512, MOE_ROWS_MAX = 73728;
constexpr int NUNIT_M = NB * NCH * NH;
constexpr int CL_STRIDE = 4160;
constexpr float NORM_EPS = 1e-6f, HEAD_NORM_EPS = 1e-5f, RWKV_GN_EPS = 64e-5f;

constexpr size_t MiB = 1u << 20;
constexpr size_t WS_CTL = 0, CTL_ZERO_BYTES = 1 * MiB;
constexpr size_t WS_MODP = 1 * MiB;
constexpr size_t WS_MODF = 2 * MiB + 512 * 1024;
constexpr size_t WS_RTW = 3 * MiB;
constexpr size_t WS_WIN = 4 * MiB;
constexpr size_t WS_WOUT = 16 * MiB;
constexpr size_t WS_GATES = 20 * MiB;
constexpr size_t WS_W13 = 22 * MiB;
constexpr size_t WS_W2 = 86 * MiB;
constexpr size_t WS_HN = 118 * MiB;
constexpr size_t WS_CLOC = 118 * MiB;
constexpr size_t WS_MSC = 168 * MiB;
constexpr size_t WS_S5ST = 170 * MiB;
constexpr size_t WS_VF = 182 * MiB;
constexpr size_t WS_YC = 206 * MiB;
constexpr size_t WS_LIST = 206 * MiB;
constexpr size_t WS_ROWMAP = 214 * MiB;
constexpr size_t WS_TOKE = 215 * MiB;
constexpr size_t WS_TOKW = 215 * MiB + 512 * 1024;
constexpr size_t WS_PROJ = 270 * MiB;
constexpr size_t WS_RE = 446 * MiB, WS_RA = 470 * MiB, WS_RG = 494 * MiB, WS_RVG = 518 * MiB;
constexpr size_t WS_XG = 270 * MiB;
constexpr size_t WS_HMID = 414 * MiB;
constexpr size_t WS_YMOE = 270 * MiB;
constexpr size_t WS_END = 542 * MiB;
constexpr int CW_TMO = 0, CW_BAR = 4096, CW_CNT = 8192;

constexpr int RING_BYTES = 131072, MISC_OFF = RING_BYTES + 320, LDS_BYTES = 147456;

#define GAS __attribute__((address_space(1)))
#define LAS __attribute__((address_space(3)))
typedef unsigned short bf16;
typedef unsigned v4u __attribute__((ext_vector_type(4)));
typedef unsigned v2u __attribute__((ext_vector_type(2)));
typedef float f32x4 __attribute__((ext_vector_type(4)));
typedef float f32x2 __attribute__((ext_vector_type(2)));
typedef GAS unsigned gu32;
#define RLX_AGENT __ATOMIC_RELAXED, __HIP_MEMORY_SCOPE_AGENT
#define LDS_WAIT() asm volatile("s_waitcnt lgkmcnt(0)" ::: "memory")
#define VM_WAIT() asm volatile("s_waitcnt vmcnt(0)" ::: "memory")
__device__ __forceinline__ unsigned f2bf(float f) { unsigned u = __builtin_bit_cast(unsigned, f); return (u + 0x7fffu + ((u >> 16) & 1u)) >> 16; }
__device__ __forceinline__ unsigned pk2(float lo, float hi) { return f2bf(lo) | (f2bf(hi) << 16); }
__device__ __forceinline__ float bf2f(unsigned v) { return __builtin_bit_cast(float, v << 16); }
__device__ __forceinline__ float bflo(unsigned w) { return __builtin_bit_cast(float, w << 16); }
__device__ __forceinline__ float bfhi(unsigned w) { return __builtin_bit_cast(float, w & 0xffff0000u); }
__device__ __forceinline__ float sigmoidf_(float x) { return 1.f / (1.f + __expf(-x)); }
__device__ __forceinline__ float wave_sum(float v) {
#pragma unroll
    for (int o = 1; o < 64; o <<= 1) v += __shfl_xor(v, o);
    return v;
}
__device__ __forceinline__ float wave_max(float v) {
#pragma unroll
    for (int o = 1; o < 64; o <<= 1) v = fmaxf(v, __shfl_xor(v, o));
    return v;
}
namespace pg8 {
#define PG8_LAS __attribute__((address_space(3)))
typedef unsigned short bf16_t;
typedef short bf16x8 __attribute__((ext_vector_type(8)));
typedef float f32x4 __attribute__((ext_vector_type(4)));
typedef unsigned u32x4 __attribute__((ext_vector_type(4)));
constexpr int BM = 256, BK = 64, HALF = 128, HTB = HALF * BK * 2  , STAGE_BYTES = 8 * HTB, NXCD = 8, WGM = 8;

__host__ __device__ __forceinline__ int lds_byte(int r, int c) { const int st = (r >> 4) * 2 + (c >> 5), rr = r & 15, cc = c & 31, ob = rr * 64 + cc * 2; return st * 1024 + (ob ^ (((ob >> 9) & 1) << 5)); }
__host__ __device__ __forceinline__ void stage_rc(int b, int& R, int& C) { const int st = b / 1024, sb = b % 1024, swz = sb ^ (((sb >> 9) & 1) << 5); R = (st >> 1) * 16 + swz / 64; C = (st & 1) * 32 + (swz % 64) / 2; }
__host__ __device__ __forceinline__ int perm32(int rho) { const int n = rho >> 4, i = rho & 15; return 8 * (i >> 2) + 4 * n + (i & 3); }

struct Unit { int pm, pn; };
struct Gemm { const bf16_t* A; const bf16_t* Bt; int M, N, K; };

struct StaticOrder {
    int nM, nN, nwg, G, c;
    __host__ __device__ void init(int M, int N, int G_, int c_) { nM = M / BM; nN = N / BM; nwg = nM * nN; G = G_; c = c_; }
    __host__ __device__ bool next(int i, Unit& u) const {
        const long L = (long)i * G + c; if (L >= nwg) return false;
        int wgid = (int)L; { const int q = nwg / NXCD, r = nwg % NXCD, xcd = wgid % NXCD, off = wgid / NXCD; wgid = (xcd < r ? xcd * (q + 1) : r * (q + 1) + (xcd - r) * q) + off; }
        const int nig = WGM * nN, gid = wgid / nig, fm = gid * WGM, gsz = (nM - fm) < WGM ? (nM - fm) : WGM;
        u.pm = fm + ((wgid % nig) % gsz); u.pn = (wgid % nig) / gsz; return true;
    }
    __device__ __forceinline__ void a_ready(const Unit&) const {}
    __device__ __forceinline__ void done(const Unit&) const {}
};

__device__ __forceinline__ unsigned cvt_pk_bf16(float lo, float hi) { unsigned r; asm volatile("v_cvt_pk_bf16_f32 %0, %1, %2" : "=v"(r) : "v"(lo), "v"(hi)); return r; }

struct EpiProj {
    static constexpr bool PERM = true, AFTER_DRAIN = false;
    bf16_t* O; float* G;
    __device__ __forceinline__ void operator()(const f32x4 (&acc)[2][2][4][2], const Unit& u, int wr, int wc, int fr, int fq) const {
        const int row0 = u.pm * BM + wr * 64 + fr;
        if (u.pn < 11) {
            const int col0 = u.pn * BM + wc * 32 + 8 * fq;
#pragma unroll
            for (int ai = 0; ai < 2; ++ai)
#pragma unroll
                for (int m = 0; m < 4; ++m) { bf16_t* rowp = O + (size_t)(row0 + ai * HALF + m * 16) * 2816 + col0;
#pragma unroll
                    for (int bj = 0; bj < 2; ++bj) { const f32x4 v0 = acc[ai][bj][m][0], v1 = acc[ai][bj][m][1];
                        u32x4 w; w.x = cvt_pk_bf16(v0[0], v0[1]); w.y = cvt_pk_bf16(v0[2], v0[3]); w.z = cvt_pk_bf16(v1[0], v1[1]); w.w = cvt_pk_bf16(v1[2], v1[3]);
                        *(u32x4*)(rowp + bj * HALF) = w; } }
        } else if (wc == 0 && fq < 2) {
#pragma unroll
            for (int ai = 0; ai < 2; ++ai)
#pragma unroll
                for (int m = 0; m < 4; ++m) { float* rowp = G + (size_t)(row0 + ai * HALF + m * 16) * 16 + 8 * fq;
                    *(f32x4*)(rowp) = acc[ai][0][m][0]; *(f32x4*)(rowp + 4) = acc[ai][0][m][1]; }
        }
    }
};
struct EpiResid {
    static constexpr bool PERM = true, AFTER_DRAIN = false;
    const float* xin; float* out; const float* gate;
    int goff;
    __device__ __forceinline__ void operator()(const f32x4 (&acc)[2][2][4][2], const Unit& u, int wr, int wc, int fr, int fq) const {
        const int row0 = u.pm * BM + wr * 64 + fr, col0 = u.pn * BM + wc * 32 + 8 * fq;
        const float* gp = gate + (size_t)(row0 >> 13) * 6144 + goff + col0;
        f32x4 g[2][2];
#pragma unroll
        for (int bj = 0; bj < 2; ++bj)
#pragma unroll
            for (int n = 0; n < 2; ++n) g[bj][n] = *(const f32x4*)(gp + bj * HALF + 4 * n) + 1.0f;
#pragma unroll
        for (int ai = 0; ai < 2; ++ai)
#pragma unroll
            for (int m = 0; m < 4; ++m) { const size_t off = (size_t)(row0 + ai * HALF + m * 16) * 1024 + col0;
#pragma unroll
                for (int bj = 0; bj < 2; ++bj)
#pragma unroll
                    for (int n = 0; n < 2; ++n) { const f32x4 xv = *(const f32x4*)(xin + off + bj * HALF + 4 * n);
                        *(f32x4*)(out + off + bj * HALF + 4 * n) = xv + g[bj][n] * acc[ai][bj][m][n]; } }
    }
};
struct EpiSwiglu {
    static constexpr bool PERM = true, AFTER_DRAIN = false;
    bf16_t* H;
    __device__ __forceinline__ void operator()(const f32x4 (&acc)[2][2][4][2], const Unit& u, int wr, int wc, int fr, int fq) const {
        const int row0 = u.pm * BM + wr * 64 + fr, hid0 = 128 * (u.pn & 3) + 16 * wc + 4 * fq;
#pragma unroll
        for (int ai = 0; ai < 2; ++ai)
#pragma unroll
            for (int m = 0; m < 4; ++m) { bf16_t* rowp = H + (size_t)(row0 + ai * HALF + m * 16) * 512 + hid0;
#pragma unroll
                for (int bj = 0; bj < 2; ++bj) { const f32x4 g = acc[ai][bj][m][0], uu = acc[ai][bj][m][1]; float h[4];
#pragma unroll
                    for (int i = 0; i < 4; ++i) h[i] = g[i] / (1.f + __expf(-g[i])) * uu[i];
                    unsigned w0 = cvt_pk_bf16(h[0], h[1]), w1 = cvt_pk_bf16(h[2], h[3]);
                    *(unsigned long long*)(rowp + 64 * bj) = (unsigned long long)w0 | ((unsigned long long)w1 << 32); } }
    }
};
struct EpiMoeOut {
    static constexpr bool PERM = true, AFTER_DRAIN = false;
    bf16_t* Y; const int* rowmap;
    __device__ __forceinline__ void operator()(const f32x4 (&acc)[2][2][4][2], const Unit& u, int wr, int wc, int fr, int fq) const {
        const int row0 = u.pm * BM + wr * 64 + fr, col0 = (u.pn & 3) * BM + wc * 32 + 8 * fq;
#pragma unroll
        for (int ai = 0; ai < 2; ++ai)
#pragma unroll
            for (int m = 0; m < 4; ++m) { const int dst = rowmap[row0 + ai * HALF + m * 16];
                if (dst >= 0) { bf16_t* rowp = Y + (size_t)dst * 1024 + col0;
#pragma unroll
                    for (int bj = 0; bj < 2; ++bj) { const f32x4 v0 = acc[ai][bj][m][0], v1 = acc[ai][bj][m][1];
                        u32x4 w; w.x = cvt_pk_bf16(v0[0], v0[1]); w.y = cvt_pk_bf16(v0[2], v0[3]); w.z = cvt_pk_bf16(v1[0], v1[1]); w.w = cvt_pk_bf16(v1[2], v1[3]);
                        *(u32x4*)(rowp + bj * HALF) = w; } } }
    }
};
struct MoeOrder {
    PG8_LAS const int* ptab; int G, c;
    __device__ __forceinline__ bool next(int i, Unit& u) const {
        const int L = i * G + c, np = __builtin_amdgcn_readfirstlane(ptab[0]);
        if (L >= np * 4) return false;
        const int p = L >> 2; u.pm = p; u.pn = __builtin_amdgcn_readfirstlane(ptab[1 + p]) * 4 + (L & 3); return true;
    }
    __device__ __forceinline__ void a_ready(const Unit&) const {}
    __device__ __forceinline__ void done(const Unit&) const {}
};
template <class Epi, class Sched, bool ALIGN_EPI = false, bool SP2 = false>
__device__ __forceinline__ void gemm_phase(PG8_LAS unsigned char* lds, const Gemm g, const Sched& S, const Epi& E) {
    const int tid = threadIdx.x, wid = __builtin_amdgcn_readfirstlane(tid >> 6), lane = tid & 63, wr = wid >> 2, wc = wid & 3, fr = lane & 15, fq = lane >> 4;
    const int K = g.K, nt = K / BK;
    unsigned voffA[2], voffB[2];
#pragma unroll
    for (int i = 0; i < 2; ++i) { int R, C; stage_rc(tid * 16 + i * 8192, R, C); const int Rb = Epi::PERM ? ((R & ~31) + perm32(R & 31)) : R;
        voffA[i] = (unsigned)(R * K + C) * 2u; voffB[i] = (unsigned)(Rb * K + C) * 2u; }
    const size_t kstep = (size_t)(BK * 2);
    const size_t hstep = (size_t)HALF * K * 2;
    const size_t tstep = 2 * hstep;
    const unsigned ldsw = (unsigned)wid * 1024u;
    const int aoff = lds_byte(wr * 64 + fr, fq * 8), boff = lds_byte(wc * 32 + fr, fq * 8);
#define PG8_SA(b, h) (((b) * 2 + (h)) * HTB)
#define PG8_SB(b, h) ((4 + (b) * 2 + (h)) * HTB)
#define PG8_STAGE(bufoff, gbase, voff) do { _Pragma("unroll") for (int _i = 0; _i < 2; ++_i) \
        __builtin_amdgcn_global_load_lds((const unsigned*)((const char*)(gbase) + (voff)[_i]), (PG8_LAS unsigned*)(lds + (bufoff) + ldsw + _i * 8192), 16, 0, 0); } while (0)
#define PG8_LDA(dst, b, h) do { _Pragma("unroll") for (int m = 0; m < 4; ++m) _Pragma("unroll") for (int k = 0; k < 2; ++k) dst[m][k] = *(const PG8_LAS bf16x8*)(lds + PG8_SA(b, h) + aoff + m * 2048 + k * 1024); } while (0)
#define PG8_LDB(dst, b, h) do { _Pragma("unroll") for (int n = 0; n < 2; ++n) _Pragma("unroll") for (int k = 0; k < 2; ++k) dst[n][k] = *(const PG8_LAS bf16x8*)(lds + PG8_SB(b, h) + boff + n * 2048 + k * 1024); } while (0)
#define PG8_MMA(ai, bj, At, Bt) do { __builtin_amdgcn_s_setprio(1); _Pragma("unroll") for (int m = 0; m < 4; ++m) _Pragma("unroll") for (int n = 0; n < 2; ++n) _Pragma("unroll") for (int k = 0; k < 2; ++k) \
        acc[ai][bj][m][n] = __builtin_amdgcn_mfma_f32_16x16x32_bf16(Bt[n][k], At[m][k], acc[ai][bj][m][n], 0, 0, 0); __builtin_amdgcn_s_setprio(0); } while (0)
#define PG8_WAIT_V(n) asm volatile("s_waitcnt vmcnt(" #n ")" ::: "memory")
#define PG8_WAIT_L(n) asm volatile("s_waitcnt lgkmcnt(" #n ")" ::: "memory")
#define PG8_BAR __builtin_amdgcn_s_barrier()
#define PG8_SCHED __builtin_amdgcn_sched_barrier(0)
    Unit cur, nxt; int ui = 0;
    if (!S.next(0, cur)) return;
    f32x4 acc[2][2][4][2];
#pragma unroll
    for (int a = 0; a < 2; ++a)
#pragma unroll
        for (int b = 0; b < 2; ++b)
#pragma unroll
            for (int m = 0; m < 4; ++m)
#pragma unroll
                for (int n = 0; n < 2; ++n) acc[a][b][m][n] = (f32x4){0.f, 0.f, 0.f, 0.f};
    bf16x8 At[4][2], B0[2][2], B1[2][2];
    const char* cA = (const char*)g.A + (size_t)cur.pm * tstep; const char* cB = (const char*)g.Bt + (size_t)cur.pn * tstep;
    S.a_ready(cur);
    if constexpr (SP2) {
        PG8_STAGE(PG8_SB(0, 0), cB, voffB); PG8_STAGE(PG8_SB(0, 1), cB + hstep, voffB); PG8_STAGE(PG8_SA(0, 0), cA, voffA); PG8_STAGE(PG8_SA(0, 1), cA + hstep, voffA);
        if (wr == 1) PG8_BAR;
        PG8_WAIT_V(2); PG8_BAR;
        PG8_STAGE(PG8_SB(1, 0), cB + kstep, voffB); PG8_STAGE(PG8_SA(1, 0), cA + kstep, voffA); PG8_STAGE(PG8_SB(1, 1), cB + hstep + kstep, voffB);
        PG8_WAIT_V(6); PG8_BAR;
    } else {
        PG8_STAGE(PG8_SB(0, 0), cB, voffB); PG8_STAGE(PG8_SA(0, 0), cA, voffA); PG8_STAGE(PG8_SB(0, 1), cB + hstep, voffB); PG8_STAGE(PG8_SA(0, 1), cA + hstep, voffA);
        if (wr == 1) PG8_BAR;
        PG8_WAIT_V(4); PG8_BAR;
        PG8_STAGE(PG8_SB(1, 0), cB + kstep, voffB); PG8_STAGE(PG8_SA(1, 0), cA + kstep, voffA); PG8_STAGE(PG8_SB(1, 1), cB + hstep + kstep, voffB);
        PG8_WAIT_V(6); PG8_BAR;
    }
    for (;;) {
        const bool has_next = S.next(ui + 1, nxt);
        const char* nA = has_next ? (const char*)g.A + (size_t)nxt.pm * tstep : cA; const char* nB = has_next ? (const char*)g.Bt + (size_t)nxt.pn * tstep : cB;
        for (int t = 0; t < nt; t += 2) {
            const bool last = (t == nt - 2);
            const char* a1 = cA + (size_t)(t + 1) * kstep;
            const char* a2 = last ? nA : cA + (size_t)(t + 2) * kstep; const char* b2 = last ? nB : cB + (size_t)(t + 2) * kstep;
            const char* a3 = a2 + kstep; const char* b3 = b2 + kstep;
            if (last && has_next) S.a_ready(nxt);
            if constexpr (SP2) {
            PG8_LDB(B0, 0, 0); PG8_LDB(B1, 0, 1); PG8_SCHED; PG8_LDA(At, 0, 0); PG8_STAGE(PG8_SA(1, 1), a1 + hstep, voffA);
            PG8_WAIT_V(8); PG8_WAIT_L(0); PG8_BAR; PG8_MMA(0, 0, At, B0); PG8_MMA(0, 1, At, B1); PG8_BAR; PG8_SCHED;
            PG8_LDA(At, 0, 1); PG8_STAGE(PG8_SB(0, 0), b2, voffB); PG8_STAGE(PG8_SB(0, 1), b2 + hstep, voffB); PG8_STAGE(PG8_SA(0, 0), a2, voffA);
            PG8_WAIT_V(8); PG8_WAIT_L(0); PG8_BAR; PG8_MMA(1, 0, At, B0); PG8_MMA(1, 1, At, B1); PG8_BAR; PG8_SCHED;
            PG8_LDB(B0, 1, 0); PG8_LDB(B1, 1, 1); PG8_SCHED; PG8_LDA(At, 1, 0); PG8_STAGE(PG8_SA(0, 1), a2 + hstep, voffA);
            PG8_WAIT_V(8); PG8_WAIT_L(0); PG8_BAR; PG8_MMA(0, 0, At, B0); PG8_MMA(0, 1, At, B1); PG8_BAR; PG8_SCHED;
            PG8_LDA(At, 1, 1); PG8_STAGE(PG8_SB(1, 0), b3, voffB); PG8_STAGE(PG8_SB(1, 1), b3 + hstep, voffB); PG8_STAGE(PG8_SA(1, 0), a3, voffA);
            PG8_WAIT_V(8); PG8_WAIT_L(0); PG8_BAR; PG8_MMA(1, 0, At, B0); PG8_MMA(1, 1, At, B1); PG8_BAR; PG8_SCHED;
            } else {
            PG8_LDB(B0, 0, 0); PG8_SCHED; PG8_LDA(At, 0, 0); PG8_STAGE(PG8_SA(1, 1), a1 + hstep, voffA);
            PG8_WAIT_L(8); PG8_BAR; PG8_WAIT_L(0); PG8_MMA(0, 0, At, B0); PG8_BAR; PG8_SCHED;
            PG8_LDB(B1, 0, 1); PG8_STAGE(PG8_SB(0, 0), b2, voffB);
            PG8_BAR; PG8_WAIT_L(0); PG8_MMA(0, 1, At, B1); PG8_BAR;
            PG8_LDA(At, 0, 1); PG8_STAGE(PG8_SA(0, 0), a2, voffA);
            PG8_BAR; PG8_WAIT_L(0); PG8_MMA(1, 0, At, B0); PG8_BAR; PG8_SCHED;
            PG8_STAGE(PG8_SB(0, 1), b2 + hstep, voffB);
            PG8_WAIT_V(6); PG8_BAR; PG8_MMA(1, 1, At, B1); PG8_BAR;
            PG8_LDB(B0, 1, 0); PG8_SCHED; PG8_LDA(At, 1, 0); PG8_STAGE(PG8_SA(0, 1), a2 + hstep, voffA);
            PG8_WAIT_L(8); PG8_BAR; PG8_WAIT_L(0); PG8_MMA(0, 0, At, B0); PG8_BAR; PG8_SCHED;
            PG8_LDB(B1, 1, 1); PG8_STAGE(PG8_SB(1, 0), b3, voffB);
            PG8_BAR; PG8_WAIT_L(0); PG8_MMA(0, 1, At, B1); PG8_BAR;
            PG8_LDA(At, 1, 1); PG8_STAGE(PG8_SA(1, 0), a3, voffA);
            PG8_BAR; PG8_WAIT_L(0); PG8_MMA(1, 0, At, B0); PG8_BAR; PG8_SCHED;
            PG8_STAGE(PG8_SB(1, 1), b3 + hstep, voffB);
            PG8_WAIT_V(6); PG8_BAR; PG8_MMA(1, 1, At, B1); PG8_BAR;
            }
        }
        if constexpr (ALIGN_EPI) { if (wr == 0) PG8_BAR; }
        if constexpr (!Epi::AFTER_DRAIN) { E(acc, cur, wr, wc, fr, fq); S.done(cur); }
        if (!has_next) break;
#pragma unroll
        for (int a = 0; a < 2; ++a)
#pragma unroll
            for (int b = 0; b < 2; ++b)
#pragma unroll
                for (int m = 0; m < 4; ++m)
#pragma unroll
                    for (int n = 0; n < 2; ++n) acc[a][b][m][n] = (f32x4){0.f, 0.f, 0.f, 0.f};
        cur = nxt; cA = nA; cB = nB; ++ui;
        if constexpr (ALIGN_EPI) { if (wr == 1) PG8_BAR; }
    }
    PG8_WAIT_V(0);
    if constexpr (!ALIGN_EPI) { if (wr == 0) PG8_BAR; }
    PG8_BAR;
    if constexpr (Epi::AFTER_DRAIN) { E.fused(acc, cur, wr, wc, fr, fq, lds, wid, lane); S.done(cur); }
#undef PG8_SA
#undef PG8_SB
#undef PG8_STAGE
#undef PG8_LDA
#undef PG8_LDB
#undef PG8_MMA
#undef PG8_WAIT_V
#undef PG8_WAIT_L
#undef PG8_BAR
#undef PG8_SCHED
}
}
#define XB_TMO      128
#define XB_XCNT(j)  (256  + 64 * (j))
#define XB_XSUB(j)  (1280 + 64 * (j))
#define XB_XGEN(j)  (2304 + 64 * (j))
#define XB_TOP      3328
#define XB_TOPGEN   3392
#define XCD_BAR_WORDS 3456
#define XB_SPIN_CAP (1u << 18)
#define LAS __attribute__((address_space(3)))

__device__ __forceinline__ unsigned xb_ld(unsigned* p)              { return __hip_atomic_load(p, __ATOMIC_RELAXED, __HIP_MEMORY_SCOPE_AGENT); }
__device__ __forceinline__ unsigned xb_add(unsigned* p, unsigned v) { return __hip_atomic_fetch_add(p, v, __ATOMIC_RELAXED, __HIP_MEMORY_SCOPE_AGENT); }
__device__ __forceinline__ unsigned xb_xcc_id() { return (unsigned)__builtin_amdgcn_s_getreg((3 << 11) | 20) & 0xFu; }
#define XB_SPIN(cond, bar) do { unsigned _sp = 0; while (cond) { __builtin_amdgcn_s_sleep(1); \
    if ((++_sp & 255u) == 0u) { if (xb_ld(&(bar)[XB_TMO])) break; if (_sp > XB_SPIN_CAP) { atomicAdd(&(bar)[XB_TMO], 1u); break; } } } } while (0)

struct XcdBarrier {
    unsigned* bar; unsigned x;
    volatile LAS unsigned* st;
};

__device__ __forceinline__ XcdBarrier xcd_barrier_post(unsigned* bar, volatile LAS unsigned* st) {
    XcdBarrier b; b.bar = bar; b.x = xb_xcc_id(); b.st = st;
    if (threadIdx.x == 0) (void)xb_add(&bar[XB_XCNT(b.x)], 1u);
    return b;
}
__device__ __forceinline__ void xcd_barrier_complete(unsigned* bar, unsigned x, unsigned& nloc, unsigned& nx) {
    const unsigned G = gridDim.x * gridDim.y * gridDim.z;
    unsigned sum, cnt, mine, sp = 0u;
    for (;;) {
        sum = 0u; cnt = 0u; mine = 0u;
#pragma unroll
        for (unsigned j = 0; j < 16; ++j) { const unsigned c = xb_ld(&bar[XB_XCNT(j)]); sum += c; cnt += (c > 0u) ? 1u : 0u; mine = (j == x) ? c : mine; }
        if (sum == G) break;
        __builtin_amdgcn_s_sleep(1);
        if ((++sp & 255u) == 0u) { if (xb_ld(&bar[XB_TMO])) break; if (sp > XB_SPIN_CAP) { atomicAdd(&bar[XB_TMO], 1u); break; } }
    }
    nloc = mine > 0u ? mine : 1u; nx = cnt > 0u ? cnt : 1u;
}

__device__ __forceinline__ void xcd_barrier(const XcdBarrier& b) {
    asm volatile("s_waitcnt vmcnt(0)" ::: "memory");
    __syncthreads();
    if (threadIdx.x == 0) {
        unsigned* bar = b.bar;
        __builtin_amdgcn_s_waitcnt(0);
        unsigned nloc = b.st[0], nx = b.st[1];
        if (nloc == 0u) { xcd_barrier_complete(bar, b.x, nloc, nx); b.st[0] = nloc; b.st[1] = nx; }
        const unsigned old = xb_add(&bar[XB_XSUB(b.x)], 1u);
        const unsigned gen = old / nloc;
        if (old + 1u == (gen + 1u) * nloc) {
            __builtin_amdgcn_fence(__ATOMIC_RELEASE, "agent");
            asm volatile("s_waitcnt vmcnt(0)" ::: "memory");
            const unsigned og = xb_add(&bar[XB_TOP], 1u);
            const unsigned tg = og / nx;
            if (og + 1u == (tg + 1u) * nx) xb_add(&bar[XB_TOPGEN], 1u);
            else XB_SPIN(xb_ld(&bar[XB_TOPGEN]) == tg, bar);
            __builtin_amdgcn_fence(__ATOMIC_ACQUIRE, "agent");
            xb_add(&bar[XB_XGEN(b.x)], 1u);
            asm volatile("s_waitcnt vmcnt(0)" ::: "memory");
        } else {
            XB_SPIN(xb_ld(&bar[XB_XGEN(b.x)]) == gen, bar);
            __builtin_amdgcn_fence(__ATOMIC_ACQUIRE, "agent");
            asm volatile("s_waitcnt vmcnt(0)" ::: "memory");
        }
    }
    __syncthreads();
}

struct Args { const float* in[47]; float* out; unsigned char* ws; int ph_lo, ph_hi; };
typedef const __attribute__((address_space(4))) Args* KArgsP;
__device__ __forceinline__ KArgsP fresh_args() { KArgsP p = (KArgsP)__builtin_amdgcn_kernarg_segment_ptr(); asm volatile("" : "+s"(p)); return p; }
enum { I_X = 0, I_C, I_ADA_W, I_ADA_B, I_NORM_MIX, I_NORM_FFN, I_NORM_FINAL, I_W_IN, I_W_OUT, I_CONV_W, I_CONV_B, I_WQ, I_WK, I_BI, I_BF, I_MNORM_W,
       I_RMU, I_RW0, I_RWUP, I_RA0, I_RAUP, I_RGUP, I_RKK, I_RKA, I_RRK, I_RLNW, I_RLNB, I_RV0, I_RVDN, I_RVUP,
       I_S5ARE, I_S5AIM, I_S5LDT, I_S5BRE, I_S5BIM, I_S5CRE, I_S5CIM, I_S5D, I_S5GLUW, I_S5GLUB,
       I_MWRG, I_MBRG, I_MWRE, I_MBRE, I_MW1, I_MW3, I_MW2 };

struct RmWin { __device__ __forceinline__ int operator()(int n) const { return n < 1152 ? n : (n < 1164 ? 2816 + (n - 1152) : (n < 2572 ? 1152 + (n - 1164) : 2560 + (n - 2572))); } };
struct RmId  { __device__ __forceinline__ int operator()(int n) const { return n; } };
struct RmGU  { int add; __device__ __forceinline__ int operator()(int n) const { return 8 * (n >> 2) + (n & 3) + add; } };
template <class RM>
__device__ __forceinline__ void transpose_item(const float* W, int ldw, int ncols, int k0, int n0, bf16* WT, int ldt, LAS float* scr, int lane, const RM rm) {
    const int nn = n0 + (lane & 31);
#pragma unroll 8
    for (int i = 0; i < 32; ++i) { const int kk = 2 * i + (lane >> 5); scr[kk * 33 + (lane & 31)] = (nn < ncols) ? W[(size_t)(k0 + kk) * ldw + nn] : 0.f; }
    LDS_WAIT(); asm volatile("" ::: "memory");
    const int c = lane & 7;
#pragma unroll
    for (int j = 0; j < 4; ++j) { const int nl = (lane >> 3) + 8 * j; const LAS float* s = scr + (8 * c) * 33 + nl;
        v4u o; o.x = pk2(s[0 * 33], s[1 * 33]); o.y = pk2(s[2 * 33], s[3 * 33]); o.z = pk2(s[4 * 33], s[5 * 33]); o.w = pk2(s[6 * 33], s[7 * 33]);
        if (n0 + nl < ncols) *(GAS v4u*)(WT + (size_t)rm(n0 + nl) * ldt + k0 + 8 * c) = o; }
    LDS_WAIT(); asm volatile("" ::: "memory");
}
__device__ __forceinline__ void moe_convert(const float* w1, const float* w3, const float* w2, int l, bf16* W13, bf16* W2T, int worker, int nworkers, LAS float* scr, int lane) {
    for (int it = worker; it < NEXP * 768; it += nworkers) {
        const int e = it / 768, r = it % 768; const size_t eo = (size_t)(l * NEXP + e) * DM * DEXP;
        if (r < 256)      transpose_item(w1 + eo, DEXP, DEXP, 64 * (r >> 4), 32 * (r & 15), W13 + (size_t)e * 1024 * 1024, 1024, scr, lane, RmGU{0});
        else if (r < 512) transpose_item(w3 + eo, DEXP, DEXP, 64 * ((r - 256) >> 4), 32 * ((r - 256) & 15), W13 + (size_t)e * 1024 * 1024, 1024, scr, lane, RmGU{4});
        else              transpose_item(w2 + eo, DM, DM, 64 * ((r - 512) >> 5), 32 * ((r - 512) & 31), W2T + (size_t)e * 1024 * 512, 512, scr, lane, RmId{});
    }
}
__device__ __forceinline__ void phase_prologue(KArgsP a, LAS unsigned char* lds, int tid, int lane, int wave, int vcu, int G) {
    unsigned char* ws = a->ws;
    LAS float* scr = (LAS float*)(lds + wave * 16384);
    const int gw = vcu * NWAVES + wave, NGW = G * NWAVES;
    bf16* WIN = (bf16*)(ws + WS_WIN); bf16* WOUT = (bf16*)(ws + WS_WOUT);
    for (int it = gw; it < 2 * 16 * 89; it += NGW) { const int l = it / (16 * 89), r = it % (16 * 89);
        transpose_item(a->in[I_W_IN] + (size_t)l * DM * IN_COLS, IN_COLS, IN_COLS, 64 * (r / 89), 32 * (r % 89), WIN + (size_t)l * NPROJ_PAD * DM, DM, scr, lane, RmWin{}); }
    for (int it = gw; it < 2 * 16 * 32; it += NGW) { const int l = it / 512, r = it % 512;
        transpose_item(a->in[I_W_OUT] + (size_t)l * DM * DM, DM, DM, 64 * (r >> 5), 32 * (r & 31), WOUT + (size_t)l * DM * DM, DM, scr, lane, RmId{}); }
    for (int it = gw; it < 2 * 244; it += NGW) { const int l = it / 244, r = 2828 + it % 244; GAS v4u* p = (GAS v4u*)(WIN + ((size_t)l * NPROJ_PAD + r) * DM);
        p[lane] = (v4u){0u, 0u, 0u, 0u}; p[lane + 64] = (v4u){0u, 0u, 0u, 0u}; }
    { float* RTW = (float*)(ws + WS_RTW);
      for (int idx = (vcu * NTHR + tid); idx < 2 * 1024 * 48; idx += G * NTHR) { const int j = idx % 48, k = (idx / 48) % 1024, l = idx / (48 * 1024);
          RTW[idx] = j < 4 ? a->in[I_MWRG][(size_t)(l * 1024 + k) * 4 + j] : (j < 36 ? a->in[I_MWRE][(size_t)(l * 1024 + k) * 32 + (j - 4)] : 0.f); } }
    moe_convert(a->in[I_MW1], a->in[I_MW3], a->in[I_MW2], 0, (bf16*)(ws + WS_W13), (bf16*)(ws + WS_W2), gw, NGW, scr, lane);
    __syncthreads();
    if (vcu < 192) {
        const int q = vcu, l = q / 96, cb = (q >> 3) % 12, kc = q & 7;
        LAS float* cond = (LAS float*)lds;
        { const int b = tid >> 7, kk = tid & 127; const float cv = a->in[I_C][b * DM + kc * 128 + kk]; cond[tid] = cv / (1.f + __expf(-cv)); }
        __syncthreads();
        const int col = cb * 512 + tid; const float* wp = a->in[I_ADA_W] + ((size_t)l * DM + kc * 128) * 6144 + col;
        float acc0 = 0.f, acc1 = 0.f, acc2 = 0.f, acc3 = 0.f;
#pragma unroll 8
        for (int kk = 0; kk < 128; ++kk) { const float w = wp[(size_t)kk * 6144]; acc0 += cond[kk] * w; acc1 += cond[128 + kk] * w; acc2 += cond[256 + kk] * w; acc3 += cond[384 + kk] * w; }
        const float bias = (kc == 0) ? a->in[I_ADA_B][l * 6144 + col] : 0.f;
        float* MP = (float*)(ws + WS_MODP) + ((size_t)(kc * 2 + l) * 4) * 6144 + col;
        MP[0] = acc0 + bias; MP[6144] = acc1 + bias; MP[2 * 6144] = acc2 + bias; MP[3 * 6144] = acc3 + bias;
    }
}

__device__ __forceinline__ float modval(const unsigned char* ws, bool part, int l, int b, int idx) {
    if (!part) return ((const float*)(ws + WS_MODF))[(size_t)(l * 4 + b) * 6144 + idx];
    const float* mp = (const float*)(ws + WS_MODP) + (size_t)(l * 4 + b) * 6144 + idx; float s = 0.f;
#pragma unroll
    for (int kc = 0; kc < 8; ++kc) s += mp[(size_t)kc * 2 * 4 * 6144];
    return s;
}
template <int MODE, bool COMBINE>
__device__ __forceinline__ void phase_rownorm(KArgsP a, LAS unsigned char* lds, int tid, int lane, int wave, int G,
                                              const float* xsrc, float* xdst, const float* gvec, bool part, int l, int isc  , int lprev) {
    unsigned char* ws = a->ws;
    LAS float* sc = (LAS float*)lds; LAS float* sh = sc + 1024; LAS float* gt = sh + 1024;
    bf16* HN = (bf16*)(ws + WS_HN); const bf16* YM = (const bf16*)(ws + WS_YMOE); const float* TW = (const float*)(ws + WS_TOKW);
    for (int c = blockIdx.x; c < NTOK / 128; c += G) {
        const int b = c >> 6;
        __syncthreads();
        for (int j = tid; j < 1024; j += NTHR) {
            if (MODE == 0) { sc[j] = gvec[j] * (1.f + modval(ws, part, l, b, (isc + 1) * 1024 + j)); sh[j] = modval(ws, part, l, b, isc * 1024 + j); }
            else { sc[j] = gvec[j]; sh[j] = 0.f; }
            if (COMBINE) gt[j] = 1.f + modval(ws, false, lprev, b, 5 * 1024 + j);
        }
        __syncthreads();
        for (int i = 0; i < 16; ++i) {
            const int row = c * 128 + wave * 16 + i;
            const GAS f32x4* xr = (const GAS f32x4*)(xsrc + (size_t)row * DM) + lane;
            f32x4 v[4];
#pragma unroll
            for (int j = 0; j < 4; ++j) v[j] = xr[64 * j];
            if (COMBINE) {
                const float w0 = TW[2 * row], w1 = TW[2 * row + 1];
                const GAS v2u* y0 = (const GAS v2u*)(YM + (size_t)(2 * row) * DM) + lane; const GAS v2u* y1 = (const GAS v2u*)(YM + (size_t)(2 * row + 1) * DM) + lane;
#pragma unroll
                for (int j = 0; j < 4; ++j) { const v2u p0 = y0[64 * j], p1 = y1[64 * j]; const f32x4 g4 = *(const LAS f32x4*)(gt + lane * 4 + 256 * j);
                    f32x4 m; m.x = w0 * bflo(p0.x) + w1 * bflo(p1.x); m.y = w0 * bfhi(p0.x) + w1 * bfhi(p1.x); m.z = w0 * bflo(p0.y) + w1 * bflo(p1.y); m.w = w0 * bfhi(p0.y) + w1 * bfhi(p1.y);
                    v[j] = v[j] + g4 * m; }
                if (MODE == 0) { GAS f32x4* xo = (GAS f32x4*)(xdst + (size_t)row * DM) + lane;
#pragma unroll
                    for (int j = 0; j < 4; ++j) xo[64 * j] = v[j]; }
            }
            float ss = 0.f;
#pragma unroll
            for (int j = 0; j < 4; ++j) ss += (v[j].x * v[j].x + v[j].y * v[j].y) + (v[j].z * v[j].z + v[j].w * v[j].w);
            const float rstd = rsqrtf(wave_sum(ss) * (1.f / DM) + NORM_EPS);
            if (MODE == 0) {
                GAS v2u* o = (GAS v2u*)(HN + (size_t)row * DM) + lane;
#pragma unroll
                for (int j = 0; j < 4; ++j) { const f32x4 s4 = *(const LAS f32x4*)(sc + lane * 4 + 256 * j), h4 = *(const LAS f32x4*)(sh + lane * 4 + 256 * j); const f32x4 h = v[j] * rstd * s4 + h4;
                    v2u w; w.x = pk2(h.x, h.y); w.y = pk2(h.z, h.w); o[64 * j] = w; }
            } else {
                GAS f32x4* o = (GAS f32x4*)(xdst + (size_t)row * DM) + lane;
#pragma unroll
                for (int j = 0; j < 4; ++j) { const f32x4 s4 = *(const LAS f32x4*)(sc + lane * 4 + 256 * j); o[64 * j] = v[j] * rstd * s4; }
            }
        }
    }
}
__device__ __forceinline__ void mod_finalize(unsigned char* ws, int tid, int G) {
    float* MF = (float*)(ws + WS_MODF);
    for (int idx = blockIdx.x * NTHR + tid; idx < 2 * 4 * 6144; idx += G * NTHR) { const float* mp = (const float*)(ws + WS_MODP) + idx; float s = 0.f;
#pragma unroll
        for (int kc = 0; kc < 8; ++kc) s += mp[(size_t)kc * 2 * 4 * 6144];
        MF[idx] = s; }
}

typedef float f32x4m __attribute__((ext_vector_type(4)));
__device__ __forceinline__ void phase_router(KArgsP a, LAS unsigned char* lds, int tid, int lane, int wave, int G, int l) {
    unsigned char* ws = a->ws;
    LAS float* sc = (LAS float*)lds; LAS float* sh = sc + 1024; LAS float* rstd_s = sh + 1024  ; LAS float* cvec = rstd_s + 128  ; LAS float* cpart = cvec + 64  ;
    LAS float* lg = cpart + 8 * 48  ; LAS int* hist = (LAS int*)(lg + 8 * 16 * 48)  ; LAS int* basev = hist + 32; LAS int* asg_e = basev + 32  ; LAS int* asg_lp = asg_e + 256;
    bf16* HN = (bf16*)(ws + WS_HN); const float* x = a->out; const float* RTW = (const float*)(ws + WS_RTW) + (size_t)l * 1024 * 48;
    int* TOKE = (int*)(ws + WS_TOKE); float* TOKW = (float*)(ws + WS_TOKW); int* LIST = (int*)(ws + WS_LIST); unsigned* CNT = (unsigned*)(ws + WS_CTL) + CW_CNT + l * 32;
    const float* gvec = a->in[I_NORM_FFN] + l * DM;
    for (int c = blockIdx.x; c < NTOK / 128; c += G) {
        const int b = c >> 6;
        __syncthreads();
        for (int j = tid; j < 1024; j += NTHR) { sc[j] = gvec[j] * (1.f + modval(ws, false, l, b, 4 * 1024 + j)); sh[j] = modval(ws, false, l, b, 3 * 1024 + j); }
        if (tid < 32) hist[tid] = 0;
        __syncthreads();
        if (tid < 384) { const int j = tid % 48, part = tid / 48; float s = 0.f;
            for (int k = part * 128; k < part * 128 + 128; ++k) s += sh[k] * RTW[(size_t)k * 48 + j];
            cpart[part * 48 + j] = s; }
        for (int i = 0; i < 16; ++i) {
            const int row = c * 128 + wave * 16 + i;
            const GAS f32x4* xr = (const GAS f32x4*)(x + (size_t)row * DM) + lane;
            f32x4 v[4]; float ss = 0.f;
#pragma unroll
            for (int j = 0; j < 4; ++j) { v[j] = xr[64 * j]; ss += (v[j].x * v[j].x + v[j].y * v[j].y) + (v[j].z * v[j].z + v[j].w * v[j].w); }
            const float rstd = rsqrtf(wave_sum(ss) * (1.f / DM) + NORM_EPS);
            if (lane == 0) rstd_s[wave * 16 + i] = rstd;
            GAS v2u* o = (GAS v2u*)(HN + (size_t)row * DM) + lane;
#pragma unroll
            for (int j = 0; j < 4; ++j) { const f32x4 s4 = *(const LAS f32x4*)(sc + lane * 4 + 256 * j), h4 = *(const LAS f32x4*)(sh + lane * 4 + 256 * j); const f32x4 h = v[j] * rstd * s4 + h4;
                v2u w; w.x = pk2(h.x, h.y); w.y = pk2(h.z, h.w); o[64 * j] = w; }
        }
        __syncthreads();
        if (tid < 48) { float s = 0.f;
#pragma unroll
            for (int p = 0; p < 8; ++p) s += cpart[p * 48 + tid];
            s += tid < 4 ? a->in[I_MBRG][l * 4 + tid] : (tid < 36 ? a->in[I_MBRE][l * 32 + tid - 4] : 0.f); cvec[tid] = s; }
        {
            const int i16 = lane & 15, kq = lane >> 4, r0 = c * 128 + wave * 16;
            f32x4m acc0 = {0.f, 0.f, 0.f, 0.f}, acc1 = acc0, acc2 = acc0;
            const float* xrow = x + (size_t)(r0 + i16) * DM + 4 * kq;
            for (int k0 = 0; k0 < DM; k0 += 16) {
                const f32x4 xv = *(const GAS f32x4*)(xrow + k0); const f32x4 sv = *(const LAS f32x4*)(sc + k0 + 4 * kq);
                const float* wp = RTW + (size_t)(k0 + 4 * kq) * 48 + i16;
#pragma unroll
                for (int j = 0; j < 4; ++j) { const float av = xv[j] * sv[j];
                    acc0 = __builtin_amdgcn_mfma_f32_16x16x4f32(av, wp[j * 48], acc0, 0, 0, 0);
                    acc1 = __builtin_amdgcn_mfma_f32_16x16x4f32(av, wp[j * 48 + 16], acc1, 0, 0, 0);
                    acc2 = __builtin_amdgcn_mfma_f32_16x16x4f32(av, wp[j * 48 + 32], acc2, 0, 0, 0); }
            }
            __syncthreads();
            LAS float* lw = lg + wave * 16 * 48;
#pragma unroll
            for (int r = 0; r < 4; ++r) { const int rr = 4 * kq + r; const float rs = rstd_s[wave * 16 + rr];
                lw[rr * 48 + i16] = acc0[r] * rs + cvec[i16]; lw[rr * 48 + 16 + i16] = acc1[r] * rs + cvec[16 + i16]; lw[rr * 48 + 32 + i16] = acc2[r] * rs + cvec[32 + i16]; }
            LDS_WAIT(); asm volatile("" ::: "memory");
            if (lane < 16) {
                const LAS float* lr = lw + lane * 48; const int row = r0 + lane;
                float g0 = lr[0], g1 = lr[1], g2 = lr[2], g3 = lr[3]; const float gm = fmaxf(fmaxf(g0, g1), fmaxf(g2, g3));
                float p0 = __expf(g0 - gm), p1 = __expf(g1 - gm), p2 = __expf(g2 - gm), p3 = __expf(g3 - gm); const float inv = 1.f / (p0 + p1 + p2 + p3);
                p0 *= inv; p1 *= inv; p2 *= inv; p3 *= inv;
                int gi = 0; float gp = p0; if (p1 > gp) { gp = p1; gi = 1; } if (p2 > gp) { gp = p2; gi = 2; } if (p3 > gp) { gp = p3; gi = 3; }
                float ev0 = -3.4e38f, ev1 = -3.4e38f; int e0 = 0, e1 = 0;
#pragma unroll
                for (int j = 0; j < 8; ++j) { const float s = lr[4 + gi * 8 + j]; if (s > ev0) { ev1 = ev0; e1 = e0; ev0 = s; e0 = j; } else if (s > ev1) { ev1 = s; e1 = j; } }
                const float q = __expf(ev1 - ev0), w0 = gp / (1.f + q), w1 = gp * q / (1.f + q);
                e0 += gi * 8; e1 += gi * 8;
                TOKE[2 * row] = e0; TOKE[2 * row + 1] = e1; TOKW[2 * row] = w0; TOKW[2 * row + 1] = w1;
                const int a0 = 2 * (wave * 16 + lane);
                asg_e[a0] = e0; asg_e[a0 + 1] = e1; asg_lp[a0] = atomicAdd((int*)&hist[e0], 1); asg_lp[a0 + 1] = atomicAdd((int*)&hist[e1], 1);
            }
        }
        __syncthreads();
        if (tid < 32) { const int h = hist[tid]; basev[tid] = h ? (int)atomicAdd(CNT + tid, (unsigned)h) : 0; }
        __syncthreads();
        if (tid < 256) { const int e = asg_e[tid]; LIST[(size_t)e * 65536 + basev[e] + asg_lp[tid]] = (c * 128) * 2 + tid; }
    }
}
__device__ __forceinline__ void build_ptab(const unsigned* CNT, LAS int* ptab, LAS int* pst, LAS int* cnt, int tid) {
    __syncthreads();
    if (tid == 0) { int np = 0;
        for (int e = 0; e < NEXP; ++e) { const int ce = (int)__hip_atomic_load(CNT + e, RLX_AGENT); cnt[e] = ce; pst[e] = np * 256; const int pe = (ce + 255) >> 8;
            for (int p = 0; p < pe; ++p) ptab[1 + np + p] = e;
            np += pe; }
        ptab[0] = np; }
    __syncthreads();
}
__device__ __forceinline__ void phase_gather(KArgsP a, LAS unsigned char* lds, int tid, int lane, int wave, int vcu, int G, int l) {
    unsigned char* ws = a->ws;
    LAS int* ptab = (LAS int*)lds; LAS int* pst = ptab + 512; LAS int* cnt = pst + 32;
    build_ptab((const unsigned*)(ws + WS_CTL) + CW_CNT + l * 32, ptab, pst, cnt, tid);
    const bf16* HN = (const bf16*)(ws + WS_HN); bf16* XG = (bf16*)(ws + WS_XG); int* ROWMAP = (int*)(ws + WS_ROWMAP); const int* LIST = (const int*)(ws + WS_LIST);
    const int nrows = ptab[0] * 256;
    for (int row = vcu * NWAVES + wave; row < nrows; row += G * NWAVES) {
        const int e = ptab[1 + (row >> 8)], pos = row - pst[e]; const bool valid = pos < cnt[e];
        const int tok2 = valid ? LIST[(size_t)e * 65536 + pos] : -1;
        GAS v4u* d = (GAS v4u*)(XG + (size_t)row * DM) + lane;
        if (valid) { const GAS v4u* s = (const GAS v4u*)(HN + (size_t)(tok2 >> 1) * DM) + lane; const v4u p0 = s[0], p1 = s[64]; d[0] = p0; d[64] = p1; }
        else { d[0] = (v4u){0u, 0u, 0u, 0u}; d[64] = (v4u){0u, 0u, 0u, 0u}; }
        if (lane == 0) ROWMAP[row] = tok2;
    }
}

constexpr int ML_A = 0, ML_B = 4288, ML_C = ML_B + 8192, ML_D = ML_C + 4160, ML_E = ML_D + 4160, ML_S = ML_E + 4160;
__device__ __forceinline__ float logsigmoidf_(float x) { return fminf(x, 0.f) - log1pf(__expf(-fabsf(x))); }
__device__ __forceinline__ void ml_load_cx(KArgsP a, LAS float* L, int tid, int l, int b, int c, int h) {
    const bf16* PROJ = (const bf16*)(a->ws + WS_PROJ);
    LAS float* xp = L + ML_A;
    for (int idx = tid; idx < 67 * 64; idx += NTHR) { const int r = idx >> 6, ch = idx & 63, tr = c * 64 + r - 3;
        xp[idx] = tr >= 0 ? bf2f(PROJ[(size_t)(b * SEQ + tr) * NPROJ + PC_QK + h * 64 + ch]) : 0.f; }
    __syncthreads();
    const float* cw = a->in[I_CONV_W] + (size_t)l * 4 * DA + h * 64; const float* cb = a->in[I_CONV_B] + (size_t)l * DA + h * 64;
    LAS float* cx = L + ML_C;
    for (int idx = tid; idx < 64 * 64; idx += NTHR) { const int t = idx >> 6, ch = idx & 63;
        float s = cb[ch];
#pragma unroll
        for (int j = 0; j < 4; ++j) s += xp[(t + j) * 64 + ch] * cw[j * DA + ch];
        cx[t * 65 + ch] = s / (1.f + __expf(-s)); }
}
__device__ __forceinline__ void phase_m1(KArgsP a, LAS unsigned char* lds, int tid, int lane, int wave, int vcu, int G, int l) {
    unsigned char* ws = a->ws; LAS float* L = (LAS float*)lds;
    const bf16* PROJ = (const bf16*)(ws + WS_PROJ); const float* GT = (const float*)(ws + WS_GATES);
    float* CLOC = (float*)(ws + WS_CLOC); float* MLG = (float*)(ws + WS_MSC); float* MLM = MLG + 4096;
    for (int u = vcu; u < NUNIT_M; u += G) {
        const int h = u % NH, c = (u / NH) % NCH, b = u / (NH * NCH); const size_t row0 = (size_t)b * SEQ + c * 64;
        __syncthreads();
        ml_load_cx(a, L, tid, l, b, c, h);
        LAS float* wk = L + ML_B; LAS float* vs = L + ML_B + 4096; LAS float* sm = L + ML_S;
        for (int idx = tid; idx < 4096; idx += NTHR) { wk[idx] = a->in[I_WK][((size_t)(l * NH + h) * 64) * 64 + idx];
            vs[idx] = bf2f(PROJ[(row0 + (idx >> 6)) * NPROJ + PC_V + h * 64 + (idx & 63)]); }
        if (wave == 0) {
            const float ig = GT[(row0 + lane) * 16 + h] + a->in[I_BI][l * NH + h];
            const float fl = logsigmoidf_(GT[(row0 + lane) * 16 + 6 + h] + a->in[I_BF][l * NH + h]);
            float bc = fl;
#pragma unroll
            for (int o = 1; o < 64; o <<= 1) { const float t = __shfl_up(bc, o); if (lane >= o) bc += t; }
            const float gtot = __shfl(bc, 63); const float lw = gtot - bc + ig; const float ml = wave_max(lw);
            sm[128 + lane] = __expf(lw - ml);
            if (lane == 0) { MLG[u] = gtot; MLM[u] = ml; }
        }
        __syncthreads();
        {
            const int t = tid >> 3, eg = tid & 7; LAS float* cx = L + ML_C; LAS float* kT = L + ML_E;
            float acc[8] = {0.f, 0.f, 0.f, 0.f, 0.f, 0.f, 0.f, 0.f};
#pragma unroll 2
            for (int d = 0; d < 64; ++d) { const float cv = cx[t * 65 + d]; const f32x4 w0 = *(const LAS f32x4*)(wk + d * 64 + eg * 8), w1 = *(const LAS f32x4*)(wk + d * 64 + eg * 8 + 4);
                acc[0] += cv * w0.x; acc[1] += cv * w0.y; acc[2] += cv * w0.z; acc[3] += cv * w0.w; acc[4] += cv * w1.x; acc[5] += cv * w1.y; acc[6] += cv * w1.z; acc[7] += cv * w1.w; }
#pragma unroll
            for (int e = 0; e < 8; ++e) kT[(eg * 8 + e) * 65 + t] = acc[e] * 0.125f;
        }
        __syncthreads();
        {
            const int kd = tid >> 3, vg = tid & 7; LAS float* kT = L + ML_E;
            float acc[8] = {0.f, 0.f, 0.f, 0.f, 0.f, 0.f, 0.f, 0.f}, na = 0.f;
#pragma unroll 2
            for (int t = 0; t < 64; ++t) { const float kw = kT[kd * 65 + t] * sm[128 + t]; const f32x4 v0 = *(const LAS f32x4*)(vs + t * 64 + vg * 8), v1 = *(const LAS f32x4*)(vs + t * 64 + vg * 8 + 4);
                na += kw; acc[0] += kw * v0.x; acc[1] += kw * v0.y; acc[2] += kw * v0.z; acc[3] += kw * v0.w; acc[4] += kw * v1.x; acc[5] += kw * v1.y; acc[6] += kw * v1.z; acc[7] += kw * v1.w; }
            float* cl = CLOC + (size_t)u * CL_STRIDE;
            *(f32x4*)(cl + kd * 64 + vg * 8) = (f32x4){acc[0], acc[1], acc[2], acc[3]}; *(f32x4*)(cl + kd * 64 + vg * 8 + 4) = (f32x4){acc[4], acc[5], acc[6], acc[7]};
            if (vg == 0) cl[4096 + kd] = na;
        }
    }
}
__device__ __forceinline__ void phase_m2(unsigned char* ws, int tid, int wg, int nwg) {
    float* CLOC = (float*)(ws + WS_CLOC); const float* MLG = (const float*)(ws + WS_MSC); const float* MLM = MLG + 4096; float* MST = (float*)(ws + WS_MSC) + 8192;
    for (int idx = wg * NTHR + tid; idx < NB * NH * CL_STRIDE; idx += nwg * NTHR) {
        const int e = idx % CL_STRIDE, bh = idx / CL_STRIDE, b = bh / NH, h = bh % NH;
        float m = 0.f, cs = 0.f;
        for (int c0 = 0; c0 < NCH; c0 += 8) {
            float cl[8], g[8], ml[8];
#pragma unroll
            for (int j = 0; j < 8; ++j) { const int u = (b * NCH + c0 + j) * NH + h; cl[j] = CLOC[(size_t)u * CL_STRIDE + e]; g[j] = MLG[u]; ml[j] = MLM[u]; }
#pragma unroll
            for (int j = 0; j < 8; ++j) { const int u = (b * NCH + c0 + j) * NH + h;
                CLOC[(size_t)u * CL_STRIDE + e] = cs; if (e == 0) MST[u] = m;
                const float mn = fmaxf(g[j] + m, ml[j]); const float ao = __expf(g[j] + m - mn), al = __expf(ml[j] - mn);
                cs = ao * cs + al * cl[j]; m = mn; }
        }
    }
}
__device__ __forceinline__ void phase_m3(KArgsP a, LAS unsigned char* lds, int tid, int lane, int wave, int vcu, int G, int l) {
    unsigned char* ws = a->ws; LAS float* L = (LAS float*)lds;
    const bf16* PROJ = (const bf16*)(ws + WS_PROJ); const float* GT = (const float*)(ws + WS_GATES);
    const float* CLOC = (const float*)(ws + WS_CLOC); const float* MST = (const float*)(ws + WS_MSC) + 8192; bf16* YC = (bf16*)(ws + WS_YC);
    for (int u = vcu; u < NUNIT_M; u += G) {
        const int h = u % NH, c = (u / NH) % NCH, b = u / (NH * NCH); const size_t row0 = (size_t)b * SEQ + c * 64;
        __syncthreads();
        ml_load_cx(a, L, tid, l, b, c, h);
        LAS float* wq = L + ML_B; LAS float* wk = L + ML_B + 4096; LAS float* sm = L + ML_S;
        for (int idx = tid; idx < 4096; idx += NTHR) { wq[idx] = a->in[I_WQ][((size_t)(l * NH + h) * 64) * 64 + idx]; wk[idx] = a->in[I_WK][((size_t)(l * NH + h) * 64) * 64 + idx]; }
        if (wave == 0) {
            const float ig = GT[(row0 + lane) * 16 + h] + a->in[I_BI][l * NH + h];
            const float fl = logsigmoidf_(GT[(row0 + lane) * 16 + 6 + h] + a->in[I_BF][l * NH + h]);
            float bc = fl;
#pragma unroll
            for (int o = 1; o < 64; o <<= 1) { const float t = __shfl_up(bc, o); if (lane >= o) bc += t; }
            float pm = ig - bc;
#pragma unroll
            for (int o = 1; o < 64; o <<= 1) { const float t = __shfl_up(pm, o); if (lane >= o) pm = fmaxf(pm, t); }
            const float mst = MST[u]; const float inter = bc + mst, mt = fmaxf(inter, bc + pm);
            sm[lane] = ig; sm[64 + lane] = bc; sm[128 + lane] = mt; sm[192 + lane] = __expf(inter - mt); sm[256 + lane] = __expf(-mt);
        }
        __syncthreads();
        {
            const int t = tid >> 3, eg = tid & 7; LAS float* cx = L + ML_C; LAS float* qs = L + ML_D; LAS float* kT = L + ML_E;
            float aq[8] = {0.f, 0.f, 0.f, 0.f, 0.f, 0.f, 0.f, 0.f}, ak[8] = {0.f, 0.f, 0.f, 0.f, 0.f, 0.f, 0.f, 0.f};
#pragma unroll 2
            for (int d = 0; d < 64; ++d) { const float cv = cx[t * 65 + d];
                const f32x4 q0 = *(const LAS f32x4*)(wq + d * 64 + eg * 8), q1 = *(const LAS f32x4*)(wq + d * 64 + eg * 8 + 4), k0 = *(const LAS f32x4*)(wk + d * 64 + eg * 8), k1 = *(const LAS f32x4*)(wk + d * 64 + eg * 8 + 4);
                aq[0] += cv * q0.x; aq[1] += cv * q0.y; aq[2] += cv * q0.z; aq[3] += cv * q0.w; aq[4] += cv * q1.x; aq[5] += cv * q1.y; aq[6] += cv * q1.z; aq[7] += cv * q1.w;
                ak[0] += cv * k0.x; ak[1] += cv * k0.y; ak[2] += cv * k0.z; ak[3] += cv * k0.w; ak[4] += cv * k1.x; ak[5] += cv * k1.y; ak[6] += cv * k1.z; ak[7] += cv * k1.w; }
#pragma unroll
            for (int e = 0; e < 8; ++e) { qs[t * 65 + eg * 8 + e] = aq[e]; kT[(eg * 8 + e) * 65 + t] = ak[e] * 0.125f; }
        }
        __syncthreads();
        LAS float* cst = L + ML_B; LAS float* vs = L + ML_B + 4096; LAS float* Sm = L + ML_A; LAS float* nst = sm + 320;
        {
            const float* cl = CLOC + (size_t)u * CL_STRIDE;
            for (int idx = tid; idx < 4096; idx += NTHR) { cst[idx] = cl[idx]; vs[idx] = bf2f(PROJ[(row0 + (idx >> 6)) * NPROJ + PC_V + h * 64 + (idx & 63)]); }
            if (tid < 64) nst[tid] = cl[4096 + tid];
            const int t = tid >> 3, sg = tid & 7; LAS float* qs = L + ML_D; LAS float* kT = L + ML_E;
            float acc[8] = {0.f, 0.f, 0.f, 0.f, 0.f, 0.f, 0.f, 0.f};
#pragma unroll 2
            for (int e = 0; e < 64; ++e) { const float qv = qs[t * 65 + e];
#pragma unroll
                for (int j = 0; j < 8; ++j) acc[j] += qv * kT[e * 65 + sg * 8 + j]; }
            const float bt = sm[64 + t], mt = sm[128 + t];
#pragma unroll
            for (int j = 0; j < 8; ++j) { const int s = sg * 8 + j; Sm[t * 65 + s] = (s <= t) ? acc[j] * __expf(bt - sm[64 + s] + sm[s] - mt) : 0.f; }
        }
        __syncthreads();
        {
            const int t = tid >> 3, vg = tid & 7; LAS float* qs = L + ML_D;
            float acc[8] = {0.f, 0.f, 0.f, 0.f, 0.f, 0.f, 0.f, 0.f}, dq = 0.f;
#pragma unroll 2
            for (int e = 0; e < 64; ++e) { const float qv = qs[t * 65 + e]; const f32x4 c0 = *(const LAS f32x4*)(cst + e * 64 + vg * 8), c1 = *(const LAS f32x4*)(cst + e * 64 + vg * 8 + 4);
                dq += qv * nst[e];
                acc[0] += qv * c0.x; acc[1] += qv * c0.y; acc[2] += qv * c0.z; acc[3] += qv * c0.w; acc[4] += qv * c1.x; acc[5] += qv * c1.y; acc[6] += qv * c1.z; acc[7] += qv * c1.w; }
            const float wi = sm[192 + t]; dq *= wi;
#pragma unroll
            for (int j = 0; j < 8; ++j) acc[j] *= wi;
#pragma unroll 2
            for (int s = 0; s < 64; ++s) { const float sv = Sm[t * 65 + s]; const f32x4 v0 = *(const LAS f32x4*)(vs + s * 64 + vg * 8), v1 = *(const LAS f32x4*)(vs + s * 64 + vg * 8 + 4);
                dq += sv;
                acc[0] += sv * v0.x; acc[1] += sv * v0.y; acc[2] += sv * v0.z; acc[3] += sv * v0.w; acc[4] += sv * v1.x; acc[5] += sv * v1.y; acc[6] += sv * v1.z; acc[7] += sv * v1.w; }
            const float dn = 1.f / fmaxf(fabsf(dq), sm[256 + t]);
            float s1 = 0.f;
#pragma unroll
            for (int j = 0; j < 8; ++j) { acc[j] *= dn; s1 += acc[j]; }
            s1 += __shfl_xor(s1, 1); s1 += __shfl_xor(s1, 2); s1 += __shfl_xor(s1, 4);
            const float mu = s1 * (1.f / 64.f); float s2 = 0.f;
#pragma unroll
            for (int j = 0; j < 8; ++j) { acc[j] -= mu; s2 += acc[j] * acc[j]; }
            s2 += __shfl_xor(s2, 1); s2 += __shfl_xor(s2, 2); s2 += __shfl_xor(s2, 4);
            const float rs = rsqrtf(s2 * (1.f / 64.f) + HEAD_NORM_EPS);
            const float* nw = a->in[I_MNORM_W] + (size_t)l * DA + h * 64 + vg * 8;
            const v4u ov = *(const GAS v4u*)(PROJ + (row0 + t) * NPROJ + PC_O + h * 64 + vg * 8);
            const float o[8] = {bflo(ov.x), bfhi(ov.x), bflo(ov.y), bfhi(ov.y), bflo(ov.z), bfhi(ov.z), bflo(ov.w), bfhi(ov.w)};
            float r[8];
#pragma unroll
            for (int j = 0; j < 8; ++j) r[j] = acc[j] * rs * nw[j] * sigmoidf_(o[j]);
            v4u w; w.x = pk2(r[0], r[1]); w.y = pk2(r[2], r[3]); w.z = pk2(r[4], r[5]); w.w = pk2(r[6], r[7]);
            *(GAS v4u*)(YC + (row0 + t) * DM + h * 64 + vg * 8) = w;
        }
    }
}

struct S5Par { float are, aim, bre[16], bim[16]; };
__device__ __forceinline__ void s5_params(KArgsP a, int l, int g, int p, S5Par& P) {
    const float lam_re = a->in[I_S5ARE][(size_t)(l * 16 + g) * 64 + p], lam_im = a->in[I_S5AIM][(size_t)(l * 16 + g) * 64 + p];
    const float dt = expf(a->in[I_S5LDT][l * 16 + g]);
    const float mag = expf(lam_re * dt), ang = lam_im * dt;
    P.are = mag * cosf(ang); P.aim = mag * sinf(ang);
    const float inv = 1.f / (lam_re * lam_re + lam_im * lam_im);
    const float cre = ((P.are - 1.f) * lam_re + P.aim * lam_im) * inv, cim = (P.aim * lam_re - (P.are - 1.f) * lam_im) * inv;
    const float* br = a->in[I_S5BRE] + ((size_t)(l * 16 + g) * 64 + p) * 16; const float* bi = a->in[I_S5BIM] + ((size_t)(l * 16 + g) * 64 + p) * 16;
#pragma unroll
    for (int c = 0; c < 16; ++c) { P.bre[c] = cre * br[c] - cim * bi[c]; P.bim[c] = cre * bi[c] + cim * br[c]; }
}
__device__ __forceinline__ void s5_step(const S5Par& P, const LAS float* u16, float& xr, float& xi) {
    float br = 0.f, bi = 0.f;
#pragma unroll
    for (int q = 0; q < 4; ++q) { const f32x4 u = *(const LAS f32x4*)(u16 + 4 * q);
        br += P.bre[4 * q] * u.x + P.bre[4 * q + 1] * u.y + P.bre[4 * q + 2] * u.z + P.bre[4 * q + 3] * u.w;
        bi += P.bim[4 * q] * u.x + P.bim[4 * q + 1] * u.y + P.bim[4 * q + 2] * u.z + P.bim[4 * q + 3] * u.w; }
    const float nr = P.are * xr - P.aim * xi + br, ni = P.are * xi + P.aim * xr + bi; xr = nr; xi = ni;
}
__device__ __forceinline__ void s5_load_u(const unsigned char* ws, LAS float* us, int tid, size_t row0) {
    const bf16* PROJ = (const bf16*)(ws + WS_PROJ);
    for (int idx = tid; idx < 64 * 32; idx += NTHR) { const int t = idx >> 5, c8 = idx & 31;
        const v4u p = *(const GAS v4u*)(PROJ + (row0 + t) * NPROJ + PC_S5 + c8 * 8);
        LAS float* d = us + t * 256 + c8 * 8;
        *(LAS f32x4*)d = (f32x4){bflo(p.x), bfhi(p.x), bflo(p.y), bfhi(p.y)}; *(LAS f32x4*)(d + 4) = (f32x4){bflo(p.z), bfhi(p.z), bflo(p.w), bfhi(p.w)}; }
}
__device__ __forceinline__ void phase_s1(KArgsP a, LAS unsigned char* lds, int tid, int vcu, int G, int l) {
    unsigned char* ws = a->ws; LAS float* us = (LAS float*)lds; float* ST = (float*)(ws + WS_S5ST);
    const int gi = tid >> 6, p = tid & 63;
    S5Par P0, P1; s5_params(a, l, gi, p, P0); s5_params(a, l, gi + 8, p, P1);
    for (int u = vcu; u < NB * NCH; u += G) {
        const size_t row0 = (size_t)u * 64;
        __syncthreads();
        s5_load_u(ws, us, tid, row0);
        __syncthreads();
        float x0r = 0.f, x0i = 0.f, x1r = 0.f, x1i = 0.f;
        for (int t = 0; t < 64; ++t) { s5_step(P0, us + t * 256 + gi * 16, x0r, x0i); s5_step(P1, us + t * 256 + (gi + 8) * 16, x1r, x1i); }
        *(f32x2*)(ST + (((size_t)u * 16 + gi) * 64 + p) * 2) = (f32x2){x0r, x0i};
        *(f32x2*)(ST + (((size_t)u * 16 + gi + 8) * 64 + p) * 2) = (f32x2){x1r, x1i};
    }
}
__device__ __forceinline__ void phase_s2(KArgsP a, int tid, int wg, int nwg, int l) {
    float* ST = (float*)(a->ws + WS_S5ST);
    for (int idx = wg * NTHR + tid; idx < NB * 1024; idx += nwg * NTHR) {
        const int b = idx >> 10, gp = idx & 1023, g = gp >> 6, p = gp & 63;
        const float lam_re = a->in[I_S5ARE][(size_t)(l * 16 + g) * 64 + p], lam_im = a->in[I_S5AIM][(size_t)(l * 16 + g) * 64 + p];
        const float dt = expf(a->in[I_S5LDT][l * 16 + g]); const float mag = expf(lam_re * dt), ang = lam_im * dt;
        float ar = mag * cosf(ang), ai = mag * sinf(ang);
#pragma unroll
        for (int s = 0; s < 6; ++s) { const float nr = ar * ar - ai * ai, ni = 2.f * ar * ai; ar = nr; ai = ni; }
        float cr = 0.f, ci = 0.f;
        for (int c0 = 0; c0 < NCH; c0 += 8) {
            f32x2 e[8];
#pragma unroll
            for (int j = 0; j < 8; ++j) e[j] = *(const f32x2*)(ST + (((size_t)(b * NCH + c0 + j) * 16 + g) * 64 + p) * 2);
#pragma unroll
            for (int j = 0; j < 8; ++j) { *(f32x2*)(ST + (((size_t)(b * NCH + c0 + j) * 16 + g) * 64 + p) * 2) = (f32x2){cr, ci};
                const float nr = ar * cr - ai * ci + e[j].x, ni = ar * ci + ai * cr + e[j].y; cr = nr; ci = ni; }
        }
    }
}
__device__ __forceinline__ float gelu_tanh_(float x) { const float t = tanhf(0.7978845608f * (x + 0.044715f * x * x * x)); return 0.5f * x * (1.f + t); }
__device__ __forceinline__ void phase_s3(KArgsP a, LAS unsigned char* lds, int tid, int vcu, int G, int l) {
    unsigned char* ws = a->ws; LAS float* us = (LAS float*)lds; LAS float* xrr = us + 64 * 256; LAS float* xir = xrr + 8 * 1024;
    const float* ST = (const float*)(ws + WS_S5ST); bf16* YC = (bf16*)(ws + WS_YC);
    const int gi = tid >> 6, p = tid & 63;
    const int ch = tid & 255, th = tid >> 8, og = ch >> 4, oc = ch & 15;
    const float* cre = a->in[I_S5CRE] + ((size_t)(l * 16 + og) * 16 + oc) * 64; const float* cim = a->in[I_S5CIM] + ((size_t)(l * 16 + og) * 16 + oc) * 64;
    const float dv = a->in[I_S5D][l * DC + ch];
    for (int u = vcu; u < NB * NCH; u += G) {
        const size_t row0 = (size_t)u * 64;
        __syncthreads();
        s5_load_u(ws, us, tid, row0);
        S5Par P0, P1; s5_params(a, l, gi, p, P0); s5_params(a, l, gi + 8, p, P1);
        const f32x2 s0 = *(const f32x2*)(ST + (((size_t)u * 16 + gi) * 64 + p) * 2), s1 = *(const f32x2*)(ST + (((size_t)u * 16 + gi + 8) * 64 + p) * 2);
        float x0r = s0.x, x0i = s0.y, x1r = s1.x, x1i = s1.y;
        __syncthreads();
        for (int tb = 0; tb < 64; tb += 8) {
#pragma unroll 2
            for (int tt = 0; tt < 8; ++tt) { const int t = tb + tt;
                s5_step(P0, us + t * 256 + gi * 16, x0r, x0i); s5_step(P1, us + t * 256 + (gi + 8) * 16, x1r, x1i);
                xrr[tt * 1024 + gi * 64 + p] = x0r; xir[tt * 1024 + gi * 64 + p] = x0i; xrr[tt * 1024 + (gi + 8) * 64 + p] = x1r; xir[tt * 1024 + (gi + 8) * 64 + p] = x1i; }
            __syncthreads();
            {
                float y[4] = {0.f, 0.f, 0.f, 0.f};
                asm volatile("" ::: "memory");
#pragma unroll 2
                for (int p4 = 0; p4 < 16; ++p4) { const f32x4 c_r = *(const GAS f32x4*)(cre + 4 * p4), c_i = *(const GAS f32x4*)(cim + 4 * p4);
#pragma unroll
                    for (int k = 0; k < 4; ++k) { const int tt = 4 * th + k; const f32x4 vr = *(const LAS f32x4*)(xrr + tt * 1024 + og * 64 + 4 * p4), vi = *(const LAS f32x4*)(xir + tt * 1024 + og * 64 + 4 * p4);
                        y[k] += (c_r.x * vr.x + c_r.y * vr.y + c_r.z * vr.z + c_r.w * vr.w) - (c_i.x * vi.x + c_i.y * vi.y + c_i.z * vi.z + c_i.w * vi.w); } }
#pragma unroll
                for (int k = 0; k < 4; ++k) { const int t = tb + 4 * th + k; const float yy = y[k] + dv * us[t * 256 + ch]; us[t * 256 + ch] = gelu_tanh_(yy); }
            }
            __syncthreads();
        }
        {
            const float* gw = a->in[I_S5GLUW] + (size_t)l * DC * DC + ch; const float gb = a->in[I_S5GLUB][l * DC + ch];
            for (int hf = 0; hf < 2; ++hf) {
            float acc[16];
#pragma unroll
            for (int k = 0; k < 16; ++k) acc[k] = 0.f;
#pragma unroll 1
            for (int i4 = 0; i4 < 64; ++i4) { const float w0 = gw[(size_t)(4 * i4) * DC], w1 = gw[(size_t)(4 * i4 + 1) * DC], w2 = gw[(size_t)(4 * i4 + 2) * DC], w3 = gw[(size_t)(4 * i4 + 3) * DC];
#pragma unroll
                for (int k = 0; k < 16; ++k) { const f32x4 z = *(const LAS f32x4*)(us + (32 * th + 16 * hf + k) * 256 + 4 * i4); acc[k] += z.x * w0 + z.y * w1 + z.z * w2 + z.w * w3; } }
#pragma unroll
            for (int k = 0; k < 16; ++k) { const int t = 32 * th + 16 * hf + k; const float z = us[t * 256 + ch]; YC[(row0 + t) * DM + 768 + ch] = (bf16)f2bf(z * sigmoidf_(acc[k] + gb)); }
            }
        }
    }
}

__device__ __forceinline__ float rw_shift(const bf16* PROJ, const float* mu, size_t row, int col) {
    const float cur = bf2f(PROJ[row * NPROJ + PC_RW + col]); const float prv = (row % SEQ) ? bf2f(PROJ[(row - 1) * NPROJ + PC_RW + col]) : 0.f;
    return cur + mu[col] * (prv - cur);
}
__device__ __forceinline__ void phase_r1(KArgsP a, LAS unsigned char* lds, int tid, int vcu, int G, int l) {
    unsigned char* ws = a->ws; const bf16* PROJ = (const bf16*)(ws + WS_PROJ); const float* mu = a->in[I_RMU] + (size_t)l * RW_COLS;
    bf16* RE = (bf16*)(ws + WS_RE); bf16* RA = (bf16*)(ws + WS_RA); bf16* RG = (bf16*)(ws + WS_RG); bf16* RVG = (bf16*)(ws + WS_RVG);
    LAS float* th = (LAS float*)lds; LAS float* ads = th + 32 * 64; LAS float* sgs = ads + 32 * 64; LAS float* vsh = sgs + 32 * 128; LAS float* tmp = vsh + 32 * 384;
    const int cg = tid & 127, tq = tid >> 7;
    for (int u = vcu; u < NTOK / 32; u += G) {
        const size_t row0 = (size_t)u * 32;
        __syncthreads();
        for (int idx = tid; idx < 32 * 256; idx += NTHR) { const int tt = idx >> 8, col = idx & 255; const float xs = rw_shift(PROJ, mu, row0 + tt, RWC_WD + col);
            if (col < 64) th[tt * 64 + col] = tanhf(xs); else if (col < 128) ads[tt * 64 + col - 64] = xs; else sgs[tt * 128 + col - 128] = sigmoidf_(xs); }
        if (l > 0) for (int idx = tid; idx < 32 * 384; idx += NTHR) { const int tt = idx / 384, col = idx % 384; vsh[idx] = rw_shift(PROJ, mu, row0 + tt, RWC_V + col); }
        __syncthreads();
        float acc[3][8];
#pragma unroll
        for (int ci = 0; ci < 3; ++ci)
#pragma unroll
            for (int k = 0; k < 8; ++k) acc[ci][k] = 0.f;
        { const float* W = a->in[I_RWUP] + (size_t)l * 64 * DBR + cg;
#pragma unroll 2
          for (int j = 0; j < 64; ++j) { const float w0 = W[j * DBR], w1 = W[j * DBR + 128], w2 = W[j * DBR + 256];
#pragma unroll
              for (int k = 0; k < 8; ++k) { const float av = th[(tq * 8 + k) * 64 + j]; acc[0][k] += av * w0; acc[1][k] += av * w1; acc[2][k] += av * w2; } } }
#pragma unroll
        for (int ci = 0; ci < 3; ++ci) { const int c = cg + 128 * ci; const float w0 = a->in[I_RW0][l * DBR + c];
#pragma unroll
            for (int k = 0; k < 8; ++k) RE[(row0 + tq * 8 + k) * DBR + c] = (bf16)f2bf(0.60653066f * sigmoidf_(w0 + acc[ci][k])); }
#pragma unroll
        for (int ci = 0; ci < 3; ++ci)
#pragma unroll
            for (int k = 0; k < 8; ++k) acc[ci][k] = 0.f;
        { const float* W = a->in[I_RAUP] + (size_t)l * 64 * DBR + cg;
#pragma unroll 2
          for (int j = 0; j < 64; ++j) { const float w0 = W[j * DBR], w1 = W[j * DBR + 128], w2 = W[j * DBR + 256];
#pragma unroll
              for (int k = 0; k < 8; ++k) { const float av = ads[(tq * 8 + k) * 64 + j]; acc[0][k] += av * w0; acc[1][k] += av * w1; acc[2][k] += av * w2; } } }
#pragma unroll
        for (int ci = 0; ci < 3; ++ci) { const int c = cg + 128 * ci; const float a0 = a->in[I_RA0][l * DBR + c];
#pragma unroll
            for (int k = 0; k < 8; ++k) RA[(row0 + tq * 8 + k) * DBR + c] = (bf16)f2bf(sigmoidf_(a0 + acc[ci][k])); }
#pragma unroll
        for (int ci = 0; ci < 3; ++ci)
#pragma unroll
            for (int k = 0; k < 8; ++k) acc[ci][k] = 0.f;
        { const float* W = a->in[I_RGUP] + (size_t)l * 128 * DBR + cg;
#pragma unroll 2
          for (int j = 0; j < 128; ++j) { const float w0 = W[j * DBR], w1 = W[j * DBR + 128], w2 = W[j * DBR + 256];
#pragma unroll
              for (int k = 0; k < 8; ++k) { const float av = sgs[(tq * 8 + k) * 128 + j]; acc[0][k] += av * w0; acc[1][k] += av * w1; acc[2][k] += av * w2; } } }
#pragma unroll
        for (int ci = 0; ci < 3; ++ci) { const int c = cg + 128 * ci;
#pragma unroll
            for (int k = 0; k < 8; ++k) RG[(row0 + tq * 8 + k) * DBR + c] = (bf16)f2bf(acc[ci][k]); }
        if (l > 0) {
            { const int tt = tid >> 4, m2 = tid & 15; const float* W = a->in[I_RVDN] + m2; float s0 = 0.f, s1 = 0.f;
#pragma unroll 4
              for (int i = 0; i < 384; ++i) { const float v = vsh[tt * 384 + i]; s0 += v * W[i * 32]; s1 += v * W[i * 32 + 16]; }
              tmp[tt * 32 + m2] = s0; tmp[tt * 32 + m2 + 16] = s1; }
            __syncthreads();
#pragma unroll
            for (int ci = 0; ci < 3; ++ci)
#pragma unroll
                for (int k = 0; k < 8; ++k) acc[ci][k] = 0.f;
            { const float* W = a->in[I_RVUP] + cg;
#pragma unroll 2
              for (int j = 0; j < 32; ++j) { const float w0 = W[j * DBR], w1 = W[j * DBR + 128], w2 = W[j * DBR + 256];
#pragma unroll
                  for (int k = 0; k < 8; ++k) { const float av = tmp[(tq * 8 + k) * 32 + j]; acc[0][k] += av * w0; acc[1][k] += av * w1; acc[2][k] += av * w2; } } }
#pragma unroll
            for (int ci = 0; ci < 3; ++ci) { const int c = cg + 128 * ci; const float v0 = a->in[I_RV0][c];
#pragma unroll
                for (int k = 0; k < 8; ++k) RVG[(row0 + tq * 8 + k) * DBR + c] = (bf16)f2bf(sigmoidf_(v0 + acc[ci][k])); }
        }
    }
}
__device__ __forceinline__ float dpp_allsum(float x) {
    x += __builtin_bit_cast(float, __builtin_amdgcn_update_dpp(0, __builtin_bit_cast(int, x), 0x128, 0xf, 0xf, false));
    x += __builtin_bit_cast(float, __builtin_amdgcn_update_dpp(0, __builtin_bit_cast(int, x), 0x124, 0xf, 0xf, false));
    x += __builtin_bit_cast(float, __builtin_amdgcn_update_dpp(0, __builtin_bit_cast(int, x), 0x122, 0xf, 0xf, false));
    x += __builtin_bit_cast(float, __builtin_amdgcn_update_dpp(0, __builtin_bit_cast(int, x), 0x121, 0xf, 0xf, false));
    { const unsigned xi = __builtin_bit_cast(unsigned, x); auto r = __builtin_amdgcn_permlane16_swap(xi, xi, false, false); const unsigned r0 = r[0], r1 = r[1]; x = __uint_as_float(r0) + __uint_as_float(r1); }
    { const unsigned xi = __builtin_bit_cast(unsigned, x); auto r = __builtin_amdgcn_permlane32_swap(xi, xi, false, false); const unsigned r0 = r[0], r1 = r[1]; x = __uint_as_float(r0) + __uint_as_float(r1); }
    return x;
}
constexpr int R2_TC = 32, R2_BUF = 5 * R2_TC * 64 + R2_TC * 8;
struct R2Regs { v2u r0, r1, k0, k1; v2u aa, ee; unsigned vc, vp, vg, vf; };
__device__ __forceinline__ void r2_issue(const unsigned char* ws, int l, size_t row, int h, int sl, int tid, R2Regs& R) {
    const bf16* PROJ = (const bf16*)(ws + WS_PROJ);
    const int tt = tid >> 4, kq = tid & 15; const size_t r = row + tt; const bool first = (r % SEQ) == 0; const size_t rp = first ? r : r - 1;
    R.r0 = *(const GAS v2u*)(PROJ + r * NPROJ + PC_RW + RWC_R + h * 64 + kq * 4); R.r1 = *(const GAS v2u*)(PROJ + rp * NPROJ + PC_RW + RWC_R + h * 64 + kq * 4);
    R.k0 = *(const GAS v2u*)(PROJ + r * NPROJ + PC_RW + RWC_K + h * 64 + kq * 4); R.k1 = *(const GAS v2u*)(PROJ + rp * NPROJ + PC_RW + RWC_K + h * 64 + kq * 4);
    R.aa = *(const GAS v2u*)((const bf16*)(ws + WS_RA) + r * DBR + h * 64 + kq * 4); R.ee = *(const GAS v2u*)((const bf16*)(ws + WS_RE) + r * DBR + h * 64 + kq * 4);
    if (first) { R.r1 = (v2u){0u, 0u}; R.k1 = (v2u){0u, 0u}; }
    if (tid < 256) { const int t2 = tid >> 3, rr = tid & 7; const size_t q = row + t2; const bool f2 = (q % SEQ) == 0; const int vcol = h * 64 + sl * 8 + rr;
        R.vc = PROJ[q * NPROJ + PC_RW + RWC_V + vcol]; R.vp = f2 ? 0u : (unsigned)PROJ[(q - 1) * NPROJ + PC_RW + RWC_V + vcol];
        if (l > 0) { R.vg = ((const bf16*)(ws + WS_RVG))[q * DBR + vcol]; R.vf = ((const bf16*)(ws + WS_VF))[q * DBR + vcol]; } }
}
__device__ __forceinline__ void r2_prep(KArgsP a, int l, size_t row, int h, int sl, int tid, const R2Regs& R, LAS float* buf) {
    const int tt = tid >> 4, kq = tid & 15, c0 = h * 64 + kq * 4;
    const float* mu = a->in[I_RMU] + (size_t)l * RW_COLS; const float* kkw = a->in[I_RKK] + (size_t)l * DBR + c0; const float* kaw = a->in[I_RKA] + (size_t)l * DBR + c0;
    const float rc[4] = {bflo(R.r0.x), bfhi(R.r0.x), bflo(R.r0.y), bfhi(R.r0.y)}, rp[4] = {bflo(R.r1.x), bfhi(R.r1.x), bflo(R.r1.y), bfhi(R.r1.y)};
    const float kc[4] = {bflo(R.k0.x), bfhi(R.k0.x), bflo(R.k0.y), bfhi(R.k0.y)}, kp[4] = {bflo(R.k1.x), bfhi(R.k1.x), bflo(R.k1.y), bfhi(R.k1.y)};
    const float av[4] = {bflo(R.aa.x), bfhi(R.aa.x), bflo(R.aa.y), bfhi(R.aa.y)}, ev[4] = {bflo(R.ee.x), bfhi(R.ee.x), bflo(R.ee.y), bfhi(R.ee.y)};
    float rs[4], ks[4], kk[4], ss = 0.f;
#pragma unroll
    for (int j = 0; j < 4; ++j) { rs[j] = rc[j] + mu[RWC_R + c0 + j] * (rp[j] - rc[j]); ks[j] = kc[j] + mu[RWC_K + c0 + j] * (kp[j] - kc[j]); kk[j] = ks[j] * kkw[j]; ss += kk[j] * kk[j]; }
    ss += __shfl_xor(ss, 1); ss += __shfl_xor(ss, 2); ss += __shfl_xor(ss, 4); ss += __shfl_xor(ss, 8);
    const float inv = 1.f / fmaxf(sqrtf(ss), 1e-12f);
    f32x4 w4, an4, bk4, km4, rr4;
#pragma unroll
    for (int j = 0; j < 4; ++j) { const float kn = kk[j] * inv; w4[j] = __expf(-ev[j]); an4[j] = -kn; bk4[j] = kn * av[j]; km4[j] = ks[j] * (1.f + (av[j] - 1.f) * kaw[j]); rr4[j] = rs[j]; }
    const int o = tt * 64 + kq * 4;
    *(LAS f32x4*)(buf + o) = w4; *(LAS f32x4*)(buf + R2_TC * 64 + o) = an4; *(LAS f32x4*)(buf + 2 * R2_TC * 64 + o) = bk4; *(LAS f32x4*)(buf + 3 * R2_TC * 64 + o) = km4; *(LAS f32x4*)(buf + 4 * R2_TC * 64 + o) = rr4;
    if (tid < 256) { const int t2 = tid >> 3, rr = tid & 7, vcol = h * 64 + sl * 8 + rr; const float vc = bf2f(R.vc), vp = bf2f(R.vp);
        float v = vc + mu[RWC_V + vcol] * (vp - vc);
        if (l == 0) ((bf16*)(a->ws + WS_VF))[(row + t2) * DBR + vcol] = (bf16)f2bf(v);
        else { v = v + (bf2f(R.vf) - v) * bf2f(R.vg); }
        buf[5 * R2_TC * 64 + t2 * 8 + rr] = v; }
}
__device__ __forceinline__ void phase_r2(KArgsP a, LAS unsigned char* lds, int tid, int lane, int wave, int wg, int l) {
    unsigned char* ws = a->ws; LAS float* B0 = (LAS float*)lds; LAS float* B1 = B0 + R2_BUF; LAS float* ys = B1 + R2_BUF;
    bf16* YC = (bf16*)(ws + WS_YC);
    const int b = wg / 48, h = (wg % 48) >> 3, sl = wg & 7; const size_t rowb = (size_t)b * SEQ;
    R2Regs R;
    r2_issue(ws, l, rowb, h, sl, tid, R);
    r2_prep(a, l, rowb, h, sl, tid, R, B0);
    __syncthreads();
    float s = 0.f;
    for (int c = 0; c < SEQ / R2_TC; ++c) {
        LAS float* cur = (c & 1) ? B1 : B0; LAS float* nxt = (c & 1) ? B0 : B1;
        const bool more = (c + 1) < SEQ / R2_TC;
        if (more) r2_issue(ws, l, rowb + (size_t)(c + 1) * R2_TC, h, sl, tid, R);
#pragma unroll 4
        for (int t = 0; t < R2_TC; ++t) {
            const float wv = cur[t * 64 + lane], av = cur[R2_TC * 64 + t * 64 + lane], bv = cur[2 * R2_TC * 64 + t * 64 + lane], kv = cur[3 * R2_TC * 64 + t * 64 + lane], rv = cur[4 * R2_TC * 64 + t * 64 + lane];
            const float vv = cur[5 * R2_TC * 64 + t * 8 + wave];
            const float sa = dpp_allsum(s * av);
            s = s * wv + sa * bv + vv * kv;
            const float y = dpp_allsum(s * rv);
            if (lane == 0) ys[t * 8 + wave] = y;
        }
        if (more) r2_prep(a, l, rowb + (size_t)(c + 1) * R2_TC, h, sl, tid, R, nxt);
        __syncthreads();
        if (tid < 256) { const int t2 = tid >> 3, rr = tid & 7; YC[(rowb + (size_t)c * R2_TC + t2) * DM + 384 + h * 64 + sl * 8 + rr] = (bf16)f2bf(ys[t2 * 8 + rr]); }
        __syncthreads();
    }
}
__device__ __forceinline__ void phase_r3(KArgsP a, int lane, int gw, int ngw, int l) {
    unsigned char* ws = a->ws; const bf16* PROJ = (const bf16*)(ws + WS_PROJ); bf16* YC = (bf16*)(ws + WS_YC);
    const bf16* RA = (const bf16*)(ws + WS_RA); const bf16* RG = (const bf16*)(ws + WS_RG); const bf16* RVG = (const bf16*)(ws + WS_RVG); const bf16* VF = (const bf16*)(ws + WS_VF);
    const float* mu = a->in[I_RMU] + (size_t)l * RW_COLS;
    for (size_t row = gw; row < NTOK; row += ngw) {
#pragma unroll 2
        for (int h = 0; h < NH; ++h) {
            const int c = h * 64 + lane;
            const float y = bf2f(YC[row * DM + 384 + c]);
            const float m = dpp_allsum(y) * (1.f / 64.f); const float d = y - m; const float var = dpp_allsum(d * d) * (1.f / 64.f);
            const float yn = d * rsqrtf(var + RWKV_GN_EPS) * a->in[I_RLNW][l * DBR + c] + a->in[I_RLNB][l * DBR + c];
            const float rs = rw_shift(PROJ, mu, row, RWC_R + c), ks = rw_shift(PROJ, mu, row, RWC_K + c); float v = rw_shift(PROJ, mu, row, RWC_V + c);
            if (l > 0) v = v + (bf2f(VF[row * DBR + c]) - v) * bf2f(RVG[row * DBR + c]);
            const float av = bf2f(RA[row * DBR + c]);
            const float km = ks * (1.f + (av - 1.f) * a->in[I_RKA][l * DBR + c]);
            const float rk = dpp_allsum(rs * km * a->in[I_RRK][l * DBR + c]);
            YC[row * DM + 384 + c] = (bf16)f2bf((yn + rk * v) * bf2f(RG[row * DBR + c]));
        }
    }
}

constexpr int PH_PER_LAYER = 10, PH_FINAL = 1 + 2 * PH_PER_LAYER, N_PHASES = PH_FINAL + 1;
constexpr int R2_WGS = 192;
__global__ void __launch_bounds__(NTHR, 2) fwd(Args args) {
    extern __shared__ __attribute__((aligned(16))) unsigned char lds_raw[];
    LAS unsigned char* lds = (LAS unsigned char*)lds_raw;
    volatile LAS unsigned* MISC = (volatile LAS unsigned*)(lds + MISC_OFF);
    const int tid0 = threadIdx.x;
    const int G = gridDim.x;
#define PHASE_IDS int tid_ = threadIdx.x; asm volatile("" : "+v"(tid_)); const int tid = tid_, lane = tid & 63, wave = __builtin_amdgcn_readfirstlane(tid >> 6); \
    int bx_ = blockIdx.x; asm volatile("" : "+s"(bx_)); const int bx = bx_; const int vcu = (G % 8 == 0) ? (bx % 8) * (G / 8) + bx / 8 : bx; (void)lane; (void)wave; (void)vcu; (void)bx;
    unsigned char* ws0 = fresh_args()->ws;
    for (int u = tid0; u < (LDS_BYTES - RING_BYTES) / 4; u += NTHR) ((LAS unsigned*)(lds + RING_BYTES))[u] = 0u;
    __syncthreads();
    XcdBarrier bar; bar.bar = (unsigned*)(ws0 + WS_CTL) + CW_BAR; bar.x = 0; bar.st = nullptr;
    if (!MK_PER_PHASE) bar = xcd_barrier_post((unsigned*)(ws0 + WS_CTL) + CW_BAR, MISC + 8);
#if MK_PER_PHASE
    const int lo = args.ph_lo, hi = args.ph_hi;
#define IN(k) (lo <= (k) && (k) < hi)
#else
#define IN(k) true
#endif
#define SEAM(k) do { if (IN(k) && IN((k) + 1)) { XcdBarrier b2 = bar; asm volatile("" : "+s"(b2.bar)); xcd_barrier(b2); } } while (0)

    if (IN(0)) { KArgsP ap = fresh_args(); PHASE_IDS phase_prologue(ap, lds, tid, lane, wave, vcu, G); }
    SEAM(0);
#define LCONST 0
    {
        constexpr int l = LCONST; constexpr int pb = 1 + l * PH_PER_LAYER;
        if (IN(pb + 0)) { KArgsP ap = fresh_args(); PHASE_IDS unsigned char* ws = ap->ws; (void)ws;
            if (l == 0) { mod_finalize(ws, tid, G); phase_rownorm<0, false>(ap, lds, tid, lane, wave, G, ap->in[I_X], ap->out, ap->in[I_NORM_MIX], true, 0, 0, 0); }
            else {
#if EN_MOE
                phase_rownorm<0, true>(ap, lds, tid, lane, wave, G, ap->out, ap->out, ap->in[I_NORM_MIX] + l * DM, false, l, 0, l - 1);
#else
                phase_rownorm<0, false>(ap, lds, tid, lane, wave, G, ap->out, ap->out, ap->in[I_NORM_MIX] + l * DM, false, l, 0, l - 1);
#endif
            }
        }
        SEAM(pb + 0);
        if (IN(pb + 1)) { KArgsP ap = fresh_args(); PHASE_IDS unsigned char* ws = ap->ws; (void)ws;
            pg8::Gemm g{(const pg8::bf16_t*)(ws + WS_HN), (const pg8::bf16_t*)(ws + WS_WIN) + (size_t)l * NPROJ_PAD * DM, NTOK, NPROJ_PAD, DM};
            pg8::StaticOrder S; S.init(NTOK, NPROJ_PAD, G, bx);
            pg8::EpiProj E{(pg8::bf16_t*)(ws + WS_PROJ), (float*)(ws + WS_GATES)};
            pg8::gemm_phase<pg8::EpiProj, pg8::StaticOrder, true, true>(lds, g, S, E);
        }
        SEAM(pb + 1);
        if (IN(pb + 2)) { KArgsP ap = fresh_args(); PHASE_IDS unsigned char* ws = ap->ws; (void)ws;
#if EN_MLSTM
            phase_m1(ap, lds, tid, lane, wave, vcu, G, l);
            __syncthreads();
#endif
#if EN_S5
            phase_s1(ap, lds, tid, vcu, G, l);
            __syncthreads();
#endif
#if EN_RWKV
            phase_r1(ap, lds, tid, vcu, G, l);
#endif
        }
        SEAM(pb + 2);
        if (IN(pb + 3)) { KArgsP ap = fresh_args(); PHASE_IDS unsigned char* ws = ap->ws; (void)ws;
            if (vcu < R2_WGS) {
#if EN_RWKV
                phase_r2(ap, lds, tid, lane, wave, vcu, l);
#endif
            } else {
                const int wg = vcu - R2_WGS, nwg = G - R2_WGS;
#if EN_MLSTM
                phase_m2(ws, tid, wg, nwg);
#endif
#if EN_S5
                phase_s2(ap, tid, wg, nwg, l);
#endif
#if EN_MOE
                if (l == 1) moe_convert(ap->in[I_MW1], ap->in[I_MW3], ap->in[I_MW2], 1, (bf16*)(ws + WS_W13), (bf16*)(ws + WS_W2), wg * NWAVES + wave, nwg * NWAVES, (LAS float*)(lds + wave * 16384), lane);
#endif
            }
        }
        SEAM(pb + 3);
        if (IN(pb + 4)) { KArgsP ap = fresh_args(); PHASE_IDS unsigned char* ws = ap->ws; (void)ws;
#if EN_MLSTM
            phase_m3(ap, lds, tid, lane, wave, vcu, G, l);
            __syncthreads();
#else
            for (size_t i = (size_t)vcu * NTHR + tid; i < (size_t)NTOK * 384; i += (size_t)G * NTHR) ((bf16*)(ws + WS_YC))[(i / 384) * DM + (i % 384)] = 0;
#endif
#if EN_S5
            phase_s3(ap, lds, tid, vcu, G, l);
#else
            for (size_t i = (size_t)vcu * NTHR + tid; i < (size_t)NTOK * 256; i += (size_t)G * NTHR) ((bf16*)(ws + WS_YC))[(i / 256) * DM + 768 + (i % 256)] = 0;
#endif
#if EN_RWKV
            phase_r3(ap, lane, vcu * NWAVES + wave, G * NWAVES, l);
#else
            for (size_t i = (size_t)vcu * NTHR + tid; i < (size_t)NTOK * 384; i += (size_t)G * NTHR) ((bf16*)(ws + WS_YC))[(i / 384) * DM + 384 + (i % 384)] = 0;
#endif
        }
        SEAM(pb + 4);
        if (IN(pb + 5)) { KArgsP ap = fresh_args(); PHASE_IDS unsigned char* ws = ap->ws; (void)ws;
            pg8::Gemm g{(const pg8::bf16_t*)(ws + WS_YC), (const pg8::bf16_t*)(ws + WS_WOUT) + (size_t)l * DM * DM, NTOK, DM, DM};
            pg8::StaticOrder S; S.init(NTOK, DM, G, bx);
            pg8::EpiResid E{l == 0 ? ap->in[I_X] : (const float*)ap->out, ap->out, (const float*)(ws + WS_MODF) + (size_t)l * 4 * 6144, 2048};
            pg8::gemm_phase<pg8::EpiResid, pg8::StaticOrder, true, true>(lds, g, S, E);
        }
        SEAM(pb + 5);
#if EN_MOE
        if (IN(pb + 6)) { KArgsP ap = fresh_args(); PHASE_IDS phase_router(ap, lds, tid, lane, wave, G, l); }
        SEAM(pb + 6);
        if (IN(pb + 7)) { KArgsP ap = fresh_args(); PHASE_IDS phase_gather(ap, lds, tid, lane, wave, vcu, G, l); }
        SEAM(pb + 7);
        if (IN(pb + 8)) { KArgsP ap = fresh_args(); PHASE_IDS unsigned char* ws = ap->ws; (void)ws;
            LAS int* ptab = (LAS int*)(lds + RING_BYTES + 1024); LAS int* pst = ptab + 512; LAS int* cnt = pst + 32;
            build_ptab((const unsigned*)(ws + WS_CTL) + CW_CNT + l * 32, ptab, pst, cnt, tid);
            pg8::Gemm g{(const pg8::bf16_t*)(ws + WS_XG), (const pg8::bf16_t*)(ws + WS_W13), 0, 0, DM};
            pg8::MoeOrder S{ptab, G, vcu};
            pg8::EpiSwiglu E{(pg8::bf16_t*)(ws + WS_HMID)};
            pg8::gemm_phase<pg8::EpiSwiglu, pg8::MoeOrder, true, true>(lds, g, S, E);
        }
        SEAM(pb + 8);
        if (IN(pb + 9)) { KArgsP ap = fresh_args(); PHASE_IDS unsigned char* ws = ap->ws; (void)ws;
            LAS int* ptab = (LAS int*)(lds + RING_BYTES + 1024); LAS int* pst = ptab + 512; LAS int* cnt = pst + 32;
            build_ptab((const unsigned*)(ws + WS_CTL) + CW_CNT + l * 32, ptab, pst, cnt, tid);
            pg8::Gemm g{(const pg8::bf16_t*)(ws + WS_HMID), (const pg8::bf16_t*)(ws + WS_W2), 0, 0, DEXP};
            pg8::MoeOrder S{ptab, G, vcu};
            pg8::EpiMoeOut E{(pg8::bf16_t*)(ws + WS_YMOE), (const int*)(ws + WS_ROWMAP)};
            pg8::gemm_phase<pg8::EpiMoeOut, pg8::MoeOrder, true, true>(lds, g, S, E);
        }
        SEAM(pb + 9);
#else
        SEAM(pb + 6); SEAM(pb + 7); SEAM(pb + 8); SEAM(pb + 9);
#endif
    }
#undef LCONST
#if N_LAYERS > 1
#define LCONST 1
    {
        constexpr int l = LCONST; constexpr int pb = 1 + l * PH_PER_LAYER;
        if (IN(pb + 0)) { KArgsP ap = fresh_args(); PHASE_IDS unsigned char* ws = ap->ws; (void)ws;
            if (l == 0) { mod_finalize(ws, tid, G); phase_rownorm<0, false>(ap, lds, tid, lane, wave, G, ap->in[I_X], ap->out, ap->in[I_NORM_MIX], true, 0, 0, 0); }
            else {
#if EN_MOE
                phase_rownorm<0, true>(ap, lds, tid, lane, wave, G, ap->out, ap->out, ap->in[I_NORM_MIX] + l * DM, false, l, 0, l - 1);
#else
                phase_rownorm<0, false>(ap, lds, tid, lane, wave, G, ap->out, ap->out, ap->in[I_NORM_MIX] + l * DM, false, l, 0, l - 1);
#endif
            }
        }
        SEAM(pb + 0);
        if (IN(pb + 1)) { KArgsP ap = fresh_args(); PHASE_IDS unsigned char* ws = ap->ws; (void)ws;
            pg8::Gemm g{(const pg8::bf16_t*)(ws + WS_HN), (const pg8::bf16_t*)(ws + WS_WIN) + (size_t)l * NPROJ_PAD * DM, NTOK, NPROJ_PAD, DM};
            pg8::StaticOrder S; S.init(NTOK, NPROJ_PAD, G, bx);
            pg8::EpiProj E{(pg8::bf16_t*)(ws + WS_PROJ), (float*)(ws + WS_GATES)};
            pg8::gemm_phase<pg8::EpiProj, pg8::StaticOrder, true, true>(lds, g, S, E);
        }
        SEAM(pb + 1);
        if (IN(pb + 2)) { KArgsP ap = fresh_args(); PHASE_IDS unsigned char* ws = ap->ws; (void)ws;
#if EN_MLSTM
            phase_m1(ap, lds, tid, lane, wave, vcu, G, l);
            __syncthreads();
#endif
#if EN_S5
            phase_s1(ap, lds, tid, vcu, G, l);
            __syncthreads();
#endif
#if EN_RWKV
            phase_r1(ap, lds, tid, vcu, G, l);
#endif
        }
        SEAM(pb + 2);
        if (IN(pb + 3)) { KArgsP ap = fresh_args(); PHASE_IDS unsigned char* ws = ap->ws; (void)ws;
            if (vcu < R2_WGS) {
#if EN_RWKV
                phase_r2(ap, lds, tid, lane, wave, vcu, l);
#endif
            } else {
                const int wg = vcu - R2_WGS, nwg = G - R2_WGS;
#if EN_MLSTM
                phase_m2(ws, tid, wg, nwg);
#endif
#if EN_S5
                phase_s2(ap, tid, wg, nwg, l);
#endif
#if EN_MOE
                if (l == 1) moe_convert(ap->in[I_MW1], ap->in[I_MW3], ap->in[I_MW2], 1, (bf16*)(ws + WS_W13), (bf16*)(ws + WS_W2), wg * NWAVES + wave, nwg * NWAVES, (LAS float*)(lds + wave * 16384), lane);
#endif
            }
        }
        SEAM(pb + 3);
        if (IN(pb + 4)) { KArgsP ap = fresh_args(); PHASE_IDS unsigned char* ws = ap->ws; (void)ws;
#if EN_MLSTM
            phase_m3(ap, lds, tid, lane, wave, vcu, G, l);
            __syncthreads();
#else
            for (size_t i = (size_t)vcu * NTHR + tid; i < (size_t)NTOK * 384; i += (size_t)G * NTHR) ((bf16*)(ws + WS_YC))[(i / 384) * DM + (i % 384)] = 0;
#endif
#if EN_S5
            phase_s3(ap, lds, tid, vcu, G, l);
#else
            for (size_t i = (size_t)vcu * NTHR + tid; i < (size_t)NTOK * 256; i += (size_t)G * NTHR) ((bf16*)(ws + WS_YC))[(i / 256) * DM + 768 + (i % 256)] = 0;
#endif
#if EN_RWKV
            phase_r3(ap, lane, vcu * NWAVES + wave, G * NWAVES, l);
#else
            for (size_t i = (size_t)vcu * NTHR + tid; i < (size_t)NTOK * 384; i += (size_t)G * NTHR) ((bf16*)(ws + WS_YC))[(i / 384) * DM + 384 + (i % 384)] = 0;
#endif
        }
        SEAM(pb + 4);
        if (IN(pb + 5)) { KArgsP ap = fresh_args(); PHASE_IDS unsigned char* ws = ap->ws; (void)ws;
            pg8::Gemm g{(const pg8::bf16_t*)(ws + WS_YC), (const pg8::bf16_t*)(ws + WS_WOUT) + (size_t)l * DM * DM, NTOK, DM, DM};
            pg8::StaticOrder S; S.init(NTOK, DM, G, bx);
            pg8::EpiResid E{l == 0 ? ap->in[I_X] : (const float*)ap->out, ap->out, (const float*)(ws + WS_MODF) + (size_t)l * 4 * 6144, 2048};
            pg8::gemm_phase<pg8::EpiResid, pg8::StaticOrder, true, true>(lds, g, S, E);
        }
        SEAM(pb + 5);
#if EN_MOE
        if (IN(pb + 6)) { KArgsP ap = fresh_args(); PHASE_IDS phase_router(ap, lds, tid, lane, wave, G, l); }
        SEAM(pb + 6);
        if (IN(pb + 7)) { KArgsP ap = fresh_args(); PHASE_IDS phase_gather(ap, lds, tid, lane, wave, vcu, G, l); }
        SEAM(pb + 7);
        if (IN(pb + 8)) { KArgsP ap = fresh_args(); PHASE_IDS unsigned char* ws = ap->ws; (void)ws;
            LAS int* ptab = (LAS int*)(lds + RING_BYTES + 1024); LAS int* pst = ptab + 512; LAS int* cnt = pst + 32;
            build_ptab((const unsigned*)(ws + WS_CTL) + CW_CNT + l * 32, ptab, pst, cnt, tid);
            pg8::Gemm g{(const pg8::bf16_t*)(ws + WS_XG), (const pg8::bf16_t*)(ws + WS_W13), 0, 0, DM};
            pg8::MoeOrder S{ptab, G, vcu};
            pg8::EpiSwiglu E{(pg8::bf16_t*)(ws + WS_HMID)};
            pg8::gemm_phase<pg8::EpiSwiglu, pg8::MoeOrder, true, true>(lds, g, S, E);
        }
        SEAM(pb + 8);
        if (IN(pb + 9)) { KArgsP ap = fresh_args(); PHASE_IDS unsigned char* ws = ap->ws; (void)ws;
            LAS int* ptab = (LAS int*)(lds + RING_BYTES + 1024); LAS int* pst = ptab + 512; LAS int* cnt = pst + 32;
            build_ptab((const unsigned*)(ws + WS_CTL) + CW_CNT + l * 32, ptab, pst, cnt, tid);
            pg8::Gemm g{(const pg8::bf16_t*)(ws + WS_HMID), (const pg8::bf16_t*)(ws + WS_W2), 0, 0, DEXP};
            pg8::MoeOrder S{ptab, G, vcu};
            pg8::EpiMoeOut E{(pg8::bf16_t*)(ws + WS_YMOE), (const int*)(ws + WS_ROWMAP)};
            pg8::gemm_phase<pg8::EpiMoeOut, pg8::MoeOrder, true, true>(lds, g, S, E);
        }
        SEAM(pb + 9);
#else
        SEAM(pb + 6); SEAM(pb + 7); SEAM(pb + 8); SEAM(pb + 9);
#endif
    }
#undef LCONST
#endif
    if (IN(PH_FINAL)) { KArgsP ap = fresh_args(); PHASE_IDS
#if EN_MOE
        if (N_LAYERS > 0) phase_rownorm<1, true>(ap, lds, tid, lane, wave, G, ap->out, ap->out, ap->in[I_NORM_FINAL], false, 0, 0, N_LAYERS - 1);
        else phase_rownorm<1, false>(ap, lds, tid, lane, wave, G, ap->in[I_X], ap->out, ap->in[I_NORM_FINAL], false, 0, 0, 0);
#else
        phase_rownorm<1, false>(ap, lds, tid, lane, wave, G, N_LAYERS > 0 ? (const float*)ap->out : ap->in[I_X], ap->out, ap->in[I_NORM_FINAL], false, 0, 0, 0);
#endif
    }
#undef IN
#undef SEAM
}

extern "C" void kernel_launch(void* const* d_in, const int* in_sizes, int n_in, void* d_out, int out_size, void* d_ws, size_t ws_size, hipStream_t stream) {
    static int grid = 0;
    if (grid == 0) {
        if (n_in != 47 || out_size != NTOK * DM || ws_size < WS_END) { fprintf(stderr, "kernel_launch: unexpected problem (n_in %d, out %d, ws %zu < %zu)\n", n_in, out_size, ws_size, (size_t)WS_END); grid = -1; return; }
        int dev = 0, cus = 0, per_cu = 0;
        if (hipGetDevice(&dev) != hipSuccess || hipDeviceGetAttribute(&cus, hipDeviceAttributeMultiprocessorCount, dev) != hipSuccess) { grid = -1; return; }
        if (hipFuncSetAttribute((const void*)fwd, hipFuncAttributeMaxDynamicSharedMemorySize, LDS_BYTES) != hipSuccess) { fprintf(stderr, "kernel_launch: hipFuncSetAttribute failed\n"); grid = -1; return; }
        if (hipOccupancyMaxActiveBlocksPerMultiprocessor(&per_cu, (const void*)fwd, NTHR, LDS_BYTES) != hipSuccess || per_cu < 1) fprintf(stderr, "kernel_launch: occupancy query says %d\n", per_cu);
        (void)hipGetLastError();
        grid = cus;
        if (grid != 256) fprintf(stderr, "kernel_launch: %d CUs (built for 256)\n", grid);
    }
    if (grid < 0) return;
    (void)hipMemsetAsync((char*)d_ws + WS_CTL, 0, CTL_ZERO_BYTES, stream);
    Args a{};
    for (int i = 0; i < 47; ++i) a.in[i] = (const float*)d_in[i];
    a.out = (float*)d_out; a.ws = (unsigned char*)d_ws;
#if MK_PER_PHASE
    for (int p = 0; p < N_PHASES; ++p) { a.ph_lo = p; a.ph_hi = p + 1; hipLaunchKernelGGL(fwd, dim3(grid), dim3(NTHR), LDS_BYTES, stream, a); }
#else
    a.ph_lo = 0; a.ph_hi = N_PHASES; hipLaunchKernelGGL(fwd, dim3(grid), dim3(NTHR), LDS_BYTES, stream, a);
#endif
}
#ifdef DIAG_KERNELS
#define DK(name, ...) __global__ void __launch_bounds__(NTHR, 2) name(Args args) { extern __shared__ __attribute__((aligned(16))) unsigned char lds_raw[]; LAS unsigned char* lds = (LAS unsigned char*)lds_raw; \
    const int tid = threadIdx.x, lane = tid & 63, wave = __builtin_amdgcn_readfirstlane(tid >> 6); const int G = gridDim.x; const int bx = blockIdx.x; const int vcu = bx; KArgsP ap = fresh_args(); int l = ap->ph_lo; (void)lane; (void)wave; (void)vcu; (void)G; (void)l; __VA_ARGS__ }
DK(k_prologue, phase_prologue(ap, lds, tid, lane, wave, vcu, G);)
DK(k_norm0, phase_rownorm<0, false>(ap, lds, tid, lane, wave, G, ap->in[I_X], ap->out, ap->in[I_NORM_MIX], true, 0, 0, 0);)
DK(k_norm1, phase_rownorm<0, true>(ap, lds, tid, lane, wave, G, ap->out, ap->out, ap->in[I_NORM_MIX], false, l, 0, 0);)
DK(k_normf, phase_rownorm<1, true>(ap, lds, tid, lane, wave, G, ap->out, ap->out, ap->in[I_NORM_MIX], false, l, 0, 0);)
DK(k_m1, phase_m1(ap, lds, tid, lane, wave, vcu, G, l);)
DK(k_m2, phase_m2(ap->ws, tid, vcu, G);)
DK(k_m3, phase_m3(ap, lds, tid, lane, wave, vcu, G, l);)
DK(k_s1, phase_s1(ap, lds, tid, vcu, G, l);)
DK(k_s2, phase_s2(ap, tid, vcu, G, l);)
DK(k_s3, phase_s3(ap, lds, tid, vcu, G, l);)
DK(k_r1, phase_r1(ap, lds, tid, vcu, G, l);)
DK(k_r2, phase_r2(ap, lds, tid, lane, wave, vcu, l);)
DK(k_r3, phase_r3(ap, lane, vcu * NWAVES + wave, G * NWAVES, l);)
DK(k_router, phase_router(ap, lds, tid, lane, wave, G, l);)
DK(k_gather, phase_gather(ap, lds, tid, lane, wave, vcu, G, l);)
DK(k_moecv, moe_convert(ap->in[I_MW1], ap->in[I_MW3], ap->in[I_MW2], 1, (bf16*)(ap->ws + WS_W13), (bf16*)(ap->ws + WS_W2), vcu * NWAVES + wave, G * NWAVES, (LAS float*)(lds + wave * 16384), lane);)
#endif
```

```cpp
#include <hip/hip_runtime.h>
#include <cstdio>
#include <cstdint>
#define MK_PER_PHASE 0

#ifndef MK_PER_PHASE
#define MK_PER_PHASE 0
#endif
#ifndef EN_MLSTM
#define EN_MLSTM 1
#endif
#ifndef EN_S5
#define EN_S5 1
#endif
#ifndef EN_RWKV
#define EN_RWKV 1
#endif
#ifndef EN_MOE
#define EN_MOE 1
#endif
#ifndef N_LAYERS
#define N_LAYERS 2
#endif
constexpr int NWAVES = 8, NTHR = 512;
constexpr int DM = 1024, NB = 4, SEQ = 8192, NTOK = NB * SEQ;
constexpr int DA = 384, DBR = 384, DC = 256, NH = 6, HD = 64, NCH = SEQ / 64;
constexpr int IN_COLS = 2828, NPROJ = 2816, NPROJ_PAD = 3072;
constexpr int PC_QK = 0, PC_V = 384, PC_O = 768, PC_RW = 1152, PC_S5 = 2560;
constexpr int RWC_R = 0, RWC_K = 384, RWC_V = 768, RWC_WD = 1152, RWC_AD = 1216, RWC_GD = 1280, RW_COLS = 1408;
constexpr int NEXP = 32, DEXP = 512, MOE_ROWS_MAX = 73728;
constexpr int NUNIT_M = NB * NCH * NH;
constexpr int CL_STRIDE = 4160;
constexpr float NORM_EPS = 1e-6f, HEAD_NORM_EPS = 1e-5f, RWKV_GN_EPS = 64e-5f;

constexpr size_t MiB = 1u << 20;
constexpr size_t WS_CTL = 0, CTL_ZERO_BYTES = 1 * MiB;
constexpr size_t WS_MODP = 1 * MiB;
constexpr size_t WS_MODF = 2 * MiB + 512 * 1024;
constexpr size_t WS_RTW = 3 * MiB;
constexpr size_t WS_WIN = 4 * MiB;
constexpr size_t WS_WOUT = 16 * MiB;
constexpr size_t WS_GATES = 20 * MiB;
constexpr size_t WS_W13 = 22 * MiB;
constexpr size_t WS_W2 = 86 * MiB;
constexpr size_t WS_HN = 118 * MiB;
constexpr size_t WS_CLOC = 118 * MiB;
constexpr size_t WS_MSC = 168 * MiB;
constexpr size_t WS_S5ST = 170 * MiB;
constexpr size_t WS_VF = 182 * MiB;
constexpr size_t WS_YC = 206 * MiB;
constexpr size_t WS_LIST = 206 * MiB;
constexpr size_t WS_ROWMAP = 214 * MiB;
constexpr size_t WS_TOKE = 215 * MiB;
constexpr size_t WS_TOKW = 215 * MiB + 512 * 1024;
constexpr size_t WS_PROJ = 270 * MiB;
constexpr size_t WS_RE = 446 * MiB, WS_RA = 470 * MiB, WS_RG = 494 * MiB, WS_RVG = 518 * MiB;
constexpr size_t WS_XG = 270 * MiB;
constexpr size_t WS_HMID = 414 * MiB;
constexpr size_t WS_YMOE = 270 * MiB;
constexpr size_t WS_END = 542 * MiB;
constexpr int CW_TMO = 0, CW_BAR = 4096, CW_CNT = 8192;

constexpr int RING_BYTES = 131072, MISC_OFF = RING_BYTES + 320, LDS_BYTES = 147456;

#define GAS __attribute__((address_space(1)))
#define LAS __attribute__((address_space(3)))
typedef unsigned short bf16;
typedef unsigned v4u __attribute__((ext_vector_type(4)));
typedef unsigned v2u __attribute__((ext_vector_type(2)));
typedef float f32x4 __attribute__((ext_vector_type(4)));
typedef float f32x2 __attribute__((ext_vector_type(2)));
typedef GAS unsigned gu32;
#define RLX_AGENT __ATOMIC_RELAXED, __HIP_MEMORY_SCOPE_AGENT
#define LDS_WAIT() asm volatile("s_waitcnt lgkmcnt(0)" ::: "memory")
#define VM_WAIT() asm volatile("s_waitcnt vmcnt(0)" ::: "memory")
__device__ __forceinline__ unsigned f2bf(float f) { unsigned u = __builtin_bit_cast(unsigned, f); return (u + 0x7fffu + ((u >> 16) & 1u)) >> 16; }
__device__ __forceinline__ unsigned pk2(float lo, float hi) { return f2bf(lo) | (f2bf(hi) << 16); }
__device__ __forceinline__ float bf2f(unsigned v) { return __builtin_bit_cast(float, v << 16); }
__device__ __forceinline__ float bflo(unsigned w) { return __builtin_bit_cast(float, w << 16); }
__device__ __forceinline__ float bfhi(unsigned w) { return __builtin_bit_cast(float, w & 0xffff0000u); }
__device__ __forceinline__ float sigmoidf_(float x) { return 1.f / (1.f + __expf(-x)); }
__device__ __forceinline__ float wave_sum(float v) {
#pragma unroll
    for (int o = 1; o < 64; o <<= 1) v += __shfl_xor(v, o);
    return v;
}
__device__ __forceinline__ float wave_max(float v) {
#pragma unroll
    for (int o = 1; o < 64; o <<= 1) v = fmaxf(v, __shfl_xor(v, o));
    return v;
}
namespace pg8 {
#define PG8_LAS __attribute__((address_space(3)))
typedef unsigned short bf16_t;
typedef short bf16x8 __attribute__((ext_vector_type(8)));
typedef float f32x4 __attribute__((ext_vector_type(4)));
typedef unsigned u32x4 __attribute__((ext_vector_type(4)));
constexpr int BM = 256, BK = 64, HALF = 128, HTB = HALF * BK * 2  , STAGE_BYTES = 8 * HTB, NXCD = 8, WGM = 8;

__host__ __device__ __forceinline__ int lds_byte(int r, int c) { const int st = (r >> 4) * 2 + (c >> 5), rr = r & 15, cc = c & 31, ob = rr * 64 + cc * 2; return st * 1024 + (ob ^ (((ob >> 9) & 1) << 5)); }
__host__ __device__ __forceinline__ void stage_rc(int b, int& R, int& C) { const int st = b / 1024, sb = b % 1024, swz = sb ^ (((sb >> 9) & 1) << 5); R = (st >> 1) * 16 + swz / 64; C = (st & 1) * 32 + (swz % 64) / 2; }
__host__ __device__ __forceinline__ int perm32(int rho) { const int n = rho >> 4, i = rho & 15; return 8 * (i >> 2) + 4 * n + (i & 3); }

struct Unit { int pm, pn; };
struct Gemm { const bf16_t* A; const bf16_t* Bt; int M, N, K; };

struct StaticOrder {
    int nM, nN, nwg, G, c;
    __host__ __device__ void init(int M, int N, int G_, int c_) { nM = M / BM; nN = N / BM; nwg = nM * nN; G = G_; c = c_; }
    __host__ __device__ bool next(int i, Unit& u) const {
        const long L = (long)i * G + c; if (L >= nwg) return false;
        int wgid = (int)L; { const int q = nwg / NXCD, r = nwg % NXCD, xcd = wgid % NXCD, off = wgid / NXCD; wgid = (xcd < r ? xcd * (q + 1) : r * (q + 1) + (xcd - r) * q) + off; }
        const int nig = WGM * nN, gid = wgid / nig, fm = gid * WGM, gsz = (nM - fm) < WGM ? (nM - fm) : WGM;
        u.pm = fm + ((wgid % nig) % gsz); u.pn = (wgid % nig) / gsz; return true;
    }
    __device__ __forceinline__ void a_ready(const Unit&) const {}
    __device__ __forceinline__ void done(const Unit&) const {}
};

__device__ __forceinline__ unsigned cvt_pk_bf16(float lo, float hi) { unsigned r; asm volatile("v_cvt_pk_bf16_f32 %0, %1, %2" : "=v"(r) : "v"(lo), "v"(hi)); return r; }

struct EpiProj {
    static constexpr bool PERM = true, AFTER_DRAIN = false;
    bf16_t* O; float* G;
    __device__ __forceinline__ void operator()(const f32x4 (&acc)[2][2][4][2], const Unit& u, int wr, int wc, int fr, int fq) const {
        const int row0 = u.pm * BM + wr * 64 + fr;
        if (u.pn < 11) {
            const int col0 = u.pn * BM + wc * 32 + 8 * fq;
#pragma unroll
            for (int ai = 0; ai < 2; ++ai)
#pragma unroll
                for (int m = 0; m < 4; ++m) { bf16_t* rowp = O + (size_t)(row0 + ai * HALF + m * 16) * 2816 + col0;
#pragma unroll
                    for (int bj = 0; bj < 2; ++bj) { const f32x4 v0 = acc[ai][bj][m][0], v1 = acc[ai][bj][m][1];
                        u32x4 w; w.x = cvt_pk_bf16(v0[0], v0[1]); w.y = cvt_pk_bf16(v0[2], v0[3]); w.z = cvt_pk_bf16(v1[0], v1[1]); w.w = cvt_pk_bf16(v1[2], v1[3]);
                        *(u32x4*)(rowp + bj * HALF) = w; } }
        } else if (wc == 0 && fq < 2) {
#pragma unroll
            for (int ai = 0; ai < 2; ++ai)
#pragma unroll
                for (int m = 0; m < 4; ++m) { float* rowp = G + (size_t)(row0 + ai * HALF + m * 16) * 16 + 8 * fq;
                    *(f32x4*)(rowp) = acc[ai][0][m][0]; *(f32x4*)(rowp + 4) = acc[ai][0][m][1]; }
        }
    }
};
struct EpiResid {
    static constexpr bool PERM = true, AFTER_DRAIN = false;
    const float* xin; float* out; const float* gate;
    int goff;
    __device__ __forceinline__ void operator()(const f32x4 (&acc)[2][2][4][2], const Unit& u, int wr, int wc, int fr, int fq) const {
        const int row0 = u.pm * BM + wr * 64 + fr, col0 = u.pn * BM + wc * 32 + 8 * fq;
        const float* gp = gate + (size_t)(row0 >> 13) * 6144 + goff + col0;
        f32x4 g[2][2];
#pragma unroll
        for (int bj = 0; bj < 2; ++bj)
#pragma unroll
            for (int n = 0; n < 2; ++n) g[bj][n] = *(const f32x4*)(gp + bj * HALF + 4 * n) + 1.0f;
#pragma unroll
        for (int ai = 0; ai < 2; ++ai)
#pragma unroll
            for (int m = 0; m < 4; ++m) { const size_t off = (size_t)(row0 + ai * HALF + m * 16) * 1024 + col0;
#pragma unroll
                for (int bj = 0; bj < 2; ++bj)
#pragma unroll
                    for (int n = 0; n < 2; ++n) { const f32x4 xv = *(const f32x4*)(xin + off + bj * HALF + 4 * n);
                        *(f32x4*)(out + off + bj * HALF + 4 * n) = xv + g[bj][n] * acc[ai][bj][m][n]; } }
    }
};
struct EpiSwiglu {
    static constexpr bool PERM = true, AFTER_DRAIN = false;
    bf16_t* H;
    __device__ __forceinline__ void operator()(const f32x4 (&acc)[2][2][4][2], const Unit& u, int wr, int wc, int fr, int fq) const {
        const int row0 = u.pm * BM + wr * 64 + fr, hid0 = 128 * (u.pn & 3) + 16 * wc + 4 * fq;
#pragma unroll
        for (int ai = 0; ai < 2; ++ai)
#pragma unroll
            for (int m = 0; m < 4; ++m) { bf16_t* rowp = H + (size_t)(row0 + ai * HALF + m * 16) * 512 + hid0;
#pragma unroll
                for (int bj = 0; bj < 2; ++bj) { const f32x4 g = acc[ai][bj][m][0], uu = acc[ai][bj][m][1]; float h[4];
#pragma unroll
                    for (int i = 0; i < 4; ++i) h[i] = g[i] / (1.f + __expf(-g[i])) * uu[i];
                    unsigned w0 = cvt_pk_bf16(h[0], h[1]), w1 = cvt_pk_bf16(h[2], h[3]);
                    *(unsigned long long*)(rowp + 64 * bj) = (unsigned long long)w0 | ((unsigned long long)w1 << 32); } }
    }
};
struct EpiMoeOut {
    static constexpr bool PERM = true, AFTER_DRAIN = false;
    bf16_t* Y; const int* rowmap;
    __device__ __forceinline__ void operator()(const f32x4 (&acc)[2][2][4][2], const Unit& u, int wr, int wc, int fr, int fq) const {
        const int row0 = u.pm * BM + wr * 64 + fr, col0 = (u.pn & 3) * BM + wc * 32 + 8 * fq;
#pragma unroll
        for (int ai = 0; ai < 2; ++ai)
#pragma unroll
            for (int m = 0; m < 4; ++m) { const int dst = rowmap[row0 + ai * HALF + m * 16];
                if (dst >= 0) { bf16_t* rowp = Y + (size_t)dst * 1024 + col0;
#pragma unroll
                    for (int bj = 0; bj < 2; ++bj) { const f32x4 v0 = acc[ai][bj][m][0], v1 = acc[ai][bj][m][1];
                        u32x4 w; w.x = cvt_pk_bf16(v0[0], v0[1]); w.y = cvt_pk_bf16(v0[2], v0[3]); w.z = cvt_pk_bf16(v1[0], v1[1]); w.w = cvt_pk_bf16(v1[2], v1[3]);
                        *(u32x4*)(rowp + bj * HALF) = w; } } }
    }
};
struct MoeOrder {
    PG8_LAS const int* ptab; int G, c;
    __device__ __forceinline__ bool next(int i, Unit& u) const {
        const int L = i * G + c, np = __builtin_amdgcn_readfirstlane(ptab[0]);
        if (L >= np * 4) return false;
        const int p = L >> 2; u.pm = p; u.pn = __builtin_amdgcn_readfirstlane(ptab[1 + p]) * 4 + (L & 3); return true;
    }
    __device__ __forceinline__ void a_ready(const Unit&) const {}
    __device__ __forceinline__ void done(const Unit&) const {}
};
template <class Epi, class Sched, bool ALIGN_EPI = false, bool SP2 = false>
__device__ __forceinline__ void gemm_phase(PG8_LAS unsigned char* lds, const Gemm g, const Sched& S, const Epi& E) {
    const int tid = threadIdx.x, wid = __builtin_amdgcn_readfirstlane(tid >> 6), lane = tid & 63, wr = wid >> 2, wc = wid & 3, fr = lane & 15, fq = lane >> 4;
    const int K = g.K, nt = K / BK;
    unsigned voffA[2], voffB[2];
#pragma unroll
    for (int i = 0; i < 2; ++i) { int R, C; stage_rc(tid * 16 + i * 8192, R, C); const int Rb = Epi::PERM ? ((R & ~31) + perm32(R & 31)) : R;
        voffA[i] = (unsigned)(R * K + C) * 2u; voffB[i] = (unsigned)(Rb * K + C) * 2u; }
    const size_t kstep = (size_t)(BK * 2);
    const size_t hstep = (size_t)HALF * K * 2;
    const size_t tstep = 2 * hstep;
    const unsigned ldsw = (unsigned)wid * 1024u;
    const int aoff = lds_byte(wr * 64 + fr, fq * 8), boff = lds_byte(wc * 32 + fr, fq * 8);
#define PG8_SA(b, h) (((b) * 2 + (h)) * HTB)
#define PG8_SB(b, h) ((4 + (b) * 2 + (h)) * HTB)
#define PG8_STAGE(bufoff, gbase, voff) do { _Pragma("unroll") for (int _i = 0; _i < 2; ++_i) \
        __builtin_amdgcn_global_load_lds((const unsigned*)((const char*)(gbase) + (voff)[_i]), (PG8_LAS unsigned*)(lds + (bufoff) + ldsw + _i * 8192), 16, 0, 0); } while (0)
#define PG8_LDA(dst, b, h) do { _Pragma("unroll") for (int m = 0; m < 4; ++m) _Pragma("unroll") for (int k = 0; k < 2; ++k) dst[m][k] = *(const PG8_LAS bf16x8*)(lds + PG8_SA(b, h) + aoff + m * 2048 + k * 1024); } while (0)
#define PG8_LDB(dst, b, h) do { _Pragma("unroll") for (int n = 0; n < 2; ++n) _Pragma("unroll") for (int k = 0; k < 2; ++k) dst[n][k] = *(const PG8_LAS bf16x8*)(lds + PG8_SB(b, h) + boff + n * 2048 + k * 1024); } while (0)
#define PG8_MMA(ai, bj, At, Bt) do { __builtin_amdgcn_s_setprio(1); _Pragma("unroll") for (int m = 0; m < 4; ++m) _Pragma("unroll") for (int n = 0; n < 2; ++n) _Pragma("unroll") for (int k = 0; k < 2; ++k) \
        acc[ai][bj][m][n] = __builtin_amdgcn_mfma_f32_16x16x32_bf16(Bt[n][k], At[m][k], acc[ai][bj][m][n], 0, 0, 0); __builtin_amdgcn_s_setprio(0); } while (0)
#define PG8_WAIT_V(n) asm volatile("s_waitcnt vmcnt(" #n ")" ::: "memory")
#define PG8_WAIT_L(n) asm volatile("s_waitcnt lgkmcnt(" #n ")" ::: "memory")
#define PG8_BAR __builtin_amdgcn_s_barrier()
#define PG8_SCHED __builtin_amdgcn_sched_barrier(0)
    Unit cur, nxt; int ui = 0;
    if (!S.next(0, cur)) return;
    f32x4 acc[2][2][4][2];
#pragma unroll
    for (int a = 0; a < 2; ++a)
#pragma unroll
        for (int b = 0; b < 2; ++b)
#pragma unroll
            for (int m = 0; m < 4; ++m)
#pragma unroll
                for (int n = 0; n < 2; ++n) acc[a][b][m][n] = (f32x4){0.f, 0.f, 0.f, 0.f};
    bf16x8 At[4][2], B0[2][2], B1[2][2];
    const char* cA = (const char*)g.A + (size_t)cur.pm * tstep; const char* cB = (const char*)g.Bt + (size_t)cur.pn * tstep;
    S.a_ready(cur);
    if constexpr (SP2) {
        PG8_STAGE(PG8_SB(0, 0), cB, voffB); PG8_STAGE(PG8_SB(0, 1), cB + hstep, voffB); PG8_STAGE(PG8_SA(0, 0), cA, voffA); PG8_STAGE(PG8_SA(0, 1), cA + hstep, voffA);
        if (wr == 1) PG8_BAR;
        PG8_WAIT_V(2); PG8_BAR;
        PG8_STAGE(PG8_SB(1, 0), cB + kstep, voffB); PG8_STAGE(PG8_SA(1, 0), cA + kstep, voffA); PG8_STAGE(PG8_SB(1, 1), cB + hstep + kstep, voffB);
        PG8_WAIT_V(6); PG8_BAR;
    } else {
        PG8_STAGE(PG8_SB(0, 0), cB, voffB); PG8_STAGE(PG8_SA(0, 0), cA, voffA); PG8_STAGE(PG8_SB(0, 1), cB + hstep, voffB); PG8_STAGE(PG8_SA(0, 1), cA + hstep, voffA);
        if (wr == 1) PG8_BAR;
        PG8_WAIT_V(4); PG8_BAR;
        PG8_STAGE(PG8_SB(1, 0), cB + kstep, voffB); PG8_STAGE(PG8_SA(1, 0), cA + kstep, voffA); PG8_STAGE(PG8_SB(1, 1), cB + hstep + kstep, voffB);
        PG8_WAIT_V(6); PG8_BAR;
    }
    for (;;) {
        const bool has_next = S.next(ui + 1, nxt);
        const char* nA = has_next ? (const char*)g.A + (size_t)nxt.pm * tstep : cA; const char* nB = has_next ? (const char*)g.Bt + (size_t)nxt.pn * tstep : cB;
        for (int t = 0; t < nt; t += 2) {
            const bool last = (t == nt - 2);
            const char* a1 = cA + (size_t)(t + 1) * kstep;
            const char* a2 = last ? nA : cA + (size_t)(t + 2) * kstep; const char* b2 = last ? nB : cB + (size_t)(t + 2) * kstep;
            const char* a3 = a2 + kstep; const char* b3 = b2 + kstep;
            if (last && has_next) S.a_ready(nxt);
            if constexpr (SP2) {
            PG8_LDB(B0, 0, 0); PG8_LDB(B1, 0, 1); PG8_SCHED; PG8_LDA(At, 0, 0); PG8_STAGE(PG8_SA(1, 1), a1 + hstep, voffA);
            PG8_WAIT_V(8); PG8_WAIT_L(0); PG8_BAR; PG8_MMA(0, 0, At, B0); PG8_MMA(0, 1, At, B1); PG8_BAR; PG8_SCHED;
            PG8_LDA(At, 0, 1); PG8_STAGE(PG8_SB(0, 0), b2, voffB); PG8_STAGE(PG8_SB(0, 1), b2 + hstep, voffB); PG8_STAGE(PG8_SA(0, 0), a2, voffA);
            PG8_WAIT_V(8); PG8_WAIT_L(0); PG8_BAR; PG8_MMA(1, 0, At, B0); PG8_MMA(1, 1, At, B1); PG8_BAR; PG8_SCHED;
            PG8_LDB(B0, 1, 0); PG8_LDB(B1, 1, 1); PG8_SCHED; PG8_LDA(At, 1, 0); PG8_STAGE(PG8_SA(0, 1), a2 + hstep, voffA);
            PG8_WAIT_V(8); PG8_WAIT_L(0); PG8_BAR; PG8_MMA(0, 0, At, B0); PG8_MMA(0, 1, At, B1); PG8_BAR; PG8_SCHED;
            PG8_LDA(At, 1, 1); PG8_STAGE(PG8_SB(1, 0), b3, voffB); PG8_STAGE(PG8_SB(1, 1), b3 + hstep, voffB); PG8_STAGE(PG8_SA(1, 0), a3, voffA);
            PG8_WAIT_V(8); PG8_WAIT_L(0); PG8_BAR; PG8_MMA(1, 0, At, B0); PG8_MMA(1, 1, At, B1); PG8_BAR; PG8_SCHED;
            } else {
            PG8_LDB(B0, 0, 0); PG8_SCHED; PG8_LDA(At, 0, 0); PG8_STAGE(PG8_SA(1, 1), a1 + hstep, voffA);
            PG8_WAIT_L(8); PG8_BAR; PG8_WAIT_L(0); PG8_MMA(0, 0, At, B0); PG8_BAR; PG8_SCHED;
            PG8_LDB(B1, 0, 1); PG8_STAGE(PG8_SB(0, 0), b2, voffB);
            PG8_BAR; PG8_WAIT_L(0); PG8_MMA(0, 1, At, B1); PG8_BAR;
            PG8_LDA(At, 0, 1); PG8_STAGE(PG8_SA(0, 0), a2, voffA);
            PG8_BAR; PG8_WAIT_L(0); PG8_MMA(1, 0, At, B0); PG8_BAR; PG8_SCHED;
            PG8_STAGE(PG8_SB(0, 1), b2 + hstep, voffB);
            PG8_WAIT_V(6); PG8_BAR; PG8_MMA(1, 1, At, B1); PG8_BAR;
            PG8_LDB(B0, 1, 0); PG8_SCHED; PG8_LDA(At, 1, 0); PG8_STAGE(PG8_SA(0, 1), a2 + hstep, voffA);
            PG8_WAIT_L(8); PG8_BAR; PG8_WAIT_L(0); PG8_MMA(0, 0, At, B0); PG8_BAR; PG8_SCHED;
            PG8_LDB(B1, 1, 1); PG8_STAGE(PG8_SB(1, 0), b3, voffB);
            PG8_BAR; PG8_WAIT_L(0); PG8_MMA(0, 1, At, B1); PG8_BAR;
            PG8_LDA(At, 1, 1); PG8_STAGE(PG8_SA(1, 0), a3, voffA);
            PG8_BAR; PG8_WAIT_L(0); PG8_MMA(1, 0, At, B0); PG8_BAR; PG8_SCHED;
            PG8_STAGE(PG8_SB(1, 1), b3 + hstep, voffB);
            PG8_WAIT_V(6); PG8_BAR; PG8_MMA(1, 1, At, B1); PG8_BAR;
            }
        }
        if constexpr (ALIGN_EPI) { if (wr == 0) PG8_BAR; }
        if constexpr (!Epi::AFTER_DRAIN) { E(acc, cur, wr, wc, fr, fq); S.done(cur); }
        if (!has_next) break;
#pragma unroll
        for (int a = 0; a < 2; ++a)
#pragma unroll
            for (int b = 0; b < 2; ++b)
#pragma unroll
                for (int m = 0; m < 4; ++m)
#pragma unroll
                    for (int n = 0; n < 2; ++n) acc[a][b][m][n] = (f32x4){0.f, 0.f, 0.f, 0.f};
        cur = nxt; cA = nA; cB = nB; ++ui;
        if constexpr (ALIGN_EPI) { if (wr == 1) PG8_BAR; }
    }
    PG8_WAIT_V(0);
    if constexpr (!ALIGN_EPI) { if (wr == 0) PG8_BAR; }
    PG8_BAR;
    if constexpr (Epi::AFTER_DRAIN) { E.fused(acc, cur, wr, wc, fr, fq, lds, wid, lane); S.done(cur); }
#undef PG8_SA
#undef PG8_SB
#undef PG8_STAGE
#undef PG8_LDA
#undef PG8_LDB
#undef PG8_MMA
#undef PG8_WAIT_V
#undef PG8_WAIT_L
#undef PG8_BAR
#undef PG8_SCHED
}
}
#define XB_TMO      128
#define XB_XCNT(j)  (256  + 64 * (j))
#define XB_XSUB(j)  (1280 + 64 * (j))
#define XB_XGEN(j)  (2304 + 64 * (j))
#define XB_TOP      3328
#define XB_TOPGEN   3392
#define XCD_BAR_WORDS 3456
#define XB_SPIN_CAP (1u << 18)
#define LAS __attribute__((address_space(3)))

__device__ __forceinline__ unsigned xb_ld(unsigned* p)              { return __hip_atomic_load(p, __ATOMIC_RELAXED, __HIP_MEMORY_SCOPE_AGENT); }
__device__ __forceinline__ unsigned xb_add(unsigned* p, unsigned v) { return __hip_atomic_fetch_add(p, v, __ATOMIC_RELAXED, __HIP_MEMORY_SCOPE_AGENT); }
__device__ __forceinline__ unsigned xb_xcc_id() { return (unsigned)__builtin_amdgcn_s_getreg((3 << 11) | 20) & 0xFu; }
#define XB_SPIN(cond, bar) do { unsigned _sp = 0; while (cond) { __builtin_amdgcn_s_sleep(1); \
    if ((++_sp & 255u) == 0u) { if (xb_ld(&(bar)[XB_TMO])) break; if (_sp > XB_SPIN_CAP) { atomicAdd(&(bar)[XB_TMO], 1u); break; } } } } while (0)

struct XcdBarrier {
    unsigned* bar; unsigned x;
    volatile LAS unsigned* st;
};

__device__ __forceinline__ XcdBarrier xcd_barrier_post(unsigned* bar, volatile LAS unsigned* st) {
    XcdBarrier b; b.bar = bar; b.x = xb_xcc_id(); b.st = st;
    if (threadIdx.x == 0) (void)xb_add(&bar[XB_XCNT(b.x)], 1u);
    return b;
}
__device__ __forceinline__ void xcd_barrier_complete(unsigned* bar, unsigned x, unsigned& nloc, unsigned& nx) {
    const unsigned G = gridDim.x * gridDim.y * gridDim.z;
    unsigned sum, cnt, mine, sp = 0u;
    for (;;) {
        sum = 0u; cnt = 0u; mine = 0u;
#pragma unroll
        for (unsigned j = 0; j < 16; ++j) { const unsigned c = xb_ld(&bar[XB_XCNT(j)]); sum += c; cnt += (c > 0u) ? 1u : 0u; mine = (j == x) ? c : mine; }
        if (sum == G) break;
        __builtin_amdgcn_s_sleep(1);
        if ((++sp & 255u) == 0u) { if (xb_ld(&bar[XB_TMO])) break; if (sp > XB_SPIN_CAP) { atomicAdd(&bar[XB_TMO], 1u); break; } }
    }
    nloc = mine > 0u ? mine : 1u; nx = cnt > 0u ? cnt : 1u;
}

__device__ __forceinline__ void xcd_barrier(const XcdBarrier& b) {
    asm volatile("s_waitcnt vmcnt(0)" ::: "memory");
    __syncthreads();
    if (threadIdx.x == 0) {
        unsigned* bar = b.bar;
        __builtin_amdgcn_s_waitcnt(0);
        unsigned nloc = b.st[0], nx = b.st[1];
        if (nloc == 0u) { xcd_barrier_complete(bar, b.x, nloc, nx); b.st[0] = nloc; b.st[1] = nx; }
        const unsigned old = xb_add(&bar[XB_XSUB(b.x)], 1u);
        const unsigned gen = old / nloc;
        if (old + 1u == (gen + 1u) * nloc) {
            __builtin_amdgcn_fence(__ATOMIC_RELEASE, "agent");
            asm volatile("s_waitcnt vmcnt(0)" ::: "memory");
            const unsigned og = xb_add(&bar[XB_TOP], 1u);
            const unsigned tg = og / nx;
            if (og + 1u == (tg + 1u) * nx) xb_add(&bar[XB_TOPGEN], 1u);
            else XB_SPIN(xb_ld(&bar[XB_TOPGEN]) == tg, bar);
            __builtin_amdgcn_fence(__ATOMIC_ACQUIRE, "agent");
            xb_add(&bar[XB_XGEN(b.x)], 1u);
            asm volatile("s_waitcnt vmcnt(0)" ::: "memory");
        } else {
            XB_SPIN(xb_ld(&bar[XB_XGEN(b.x)]) == gen, bar);
            __builtin_amdgcn_fence(__ATOMIC_ACQUIRE, "agent");
            asm volatile("s_waitcnt vmcnt(0)" ::: "memory");
        }
    }
    __syncthreads();
}

struct Args { const float* in[47]; float* out; unsigned char* ws; int ph_lo, ph_hi; };
typedef const __attribute__((address_space(4))) Args* KArgsP;
__device__ __forceinline__ KArgsP fresh_args() { KArgsP p = (KArgsP)__builtin_amdgcn_kernarg_segment_ptr(); asm volatile("" : "+s"(p)); return p; }
enum { I_X = 0, I_C, I_ADA_W, I_ADA_B, I_NORM_MIX, I_NORM_FFN, I_NORM_FINAL, I_W_IN, I_W_OUT, I_CONV_W, I_CONV_B, I_WQ, I_WK, I_BI, I_BF, I_MNORM_W,
       I_RMU, I_RW0, I_RWUP, I_RA0, I_RAUP, I_RGUP, I_RKK, I_RKA, I_RRK, I_RLNW, I_RLNB, I_RV0, I_RVDN, I_RVUP,
       I_S5ARE, I_S5AIM, I_S5LDT, I_S5BRE, I_S5BIM, I_S5CRE, I_S5CIM, I_S5D, I_S5GLUW, I_S5GLUB,
       I_MWRG, I_MBRG, I_MWRE, I_MBRE, I_MW1, I_MW3, I_MW2 };

struct RmWin { __device__ __forceinline__ int operator()(int n) const { return n < 1152 ? n : (n < 1164 ? 2816 + (n - 1152) : (n < 2572 ? 1152 + (n - 1164) : 2560 + (n - 2572))); } };
struct RmId  { __device__ __forceinline__ int operator()(int n) const { return n; } };
struct RmGU  { int add; __device__ __forceinline__ int operator()(int n) const { return 8 * (n >> 2) + (n & 3) + add; } };
template <class RM>
__device__ __forceinline__ void transpose_item(const float* W, int ldw, int ncols, int k0, int n0, bf16* WT, int ldt, LAS float* scr, int lane, const RM rm) {
    const int nn = n0 + (lane & 31);
#pragma unroll 8
    for (int i = 0; i < 32; ++i) { const int kk = 2 * i + (lane >> 5); scr[kk * 33 + (lane & 31)] = (nn < ncols) ? W[(size_t)(k0 + kk) * ldw + nn] : 0.f; }
    LDS_WAIT(); asm volatile("" ::: "memory");
    const int c = lane & 7;
#pragma unroll
    for (int j = 0; j < 4; ++j) { const int nl = (lane >> 3) + 8 * j; const LAS float* s = scr + (8 * c) * 33 + nl;
        v4u o; o.x = pk2(s[0 * 33], s[1 * 33]); o.y = pk2(s[2 * 33], s[3 * 33]); o.z = pk2(s[4 * 33], s[5 * 33]); o.w = pk2(s[6 * 33], s[7 * 33]);
        if (n0 + nl < ncols) *(GAS v4u*)(WT + (size_t)rm(n0 + nl) * ldt + k0 + 8 * c) = o; }
    LDS_WAIT(); asm volatile("" ::: "memory");
}
__device__ __forceinline__ void moe_convert(const float* w1, const float* w3, const float* w2, int l, bf16* W13, bf16* W2T, int worker, int nworkers, LAS float* scr, int lane) {
    for (int it = worker; it < NEXP * 768; it += nworkers) {
        const int e = it / 768, r = it % 768; const size_t eo = (size_t)(l * NEXP + e) * DM * DEXP;
        if (r < 256)      transpose_item(w1 + eo, DEXP, DEXP, 64 * (r >> 4), 32 * (r & 15), W13 + (size_t)e * 1024 * 1024, 1024, scr, lane, RmGU{0});
        else if (r < 512) transpose_item(w3 + eo, DEXP, DEXP, 64 * ((r - 256) >> 4), 32 * ((r - 256) & 15), W13 + (size_t)e * 1024 * 1024, 1024, scr, lane, RmGU{4});
        else              transpose_item(w2 + eo, DM, DM, 64 * ((r - 512) >> 5), 32 * ((r - 512) & 31), W2T + (size_t)e * 1024 * 512, 512, scr, lane, RmId{});
    }
}
__device__ __forceinline__ void phase_prologue(KArgsP a, LAS unsigned char* lds, int tid, int lane, int wave, int vcu, int G) {
    unsigned char* ws = a->ws;
    LAS float* scr = (LAS float*)(lds + wave * 16384);
    const int gw = vcu * NWAVES + wave, NGW = G * NWAVES;
    bf16* WIN = (bf16*)(ws + WS_WIN); bf16* WOUT = (bf16*)(ws + WS_WOUT);
    for (int it = gw; it < 2 * 16 * 89; it += NGW) { const int l = it / (16 * 89), r = it % (16 * 89);
        transpose_item(a->in[I_W_IN] + (size_t)l * DM * IN_COLS, IN_COLS, IN_COLS, 64 * (r / 89), 32 * (r % 89), WIN + (size_t)l * NPROJ_PAD * DM, DM, scr, lane, RmWin{}); }
    for (int it = gw; it < 2 * 16 * 32; it += NGW) { const int l = it / 512, r = it % 512;
        transpose_item(a->in[I_W_OUT] + (size_t)l * DM * DM, DM, DM, 64 * (r >> 5), 32 * (r & 31), WOUT + (size_t)l * DM * DM, DM, scr, lane, RmId{}); }
    for (int it = gw; it < 2 * 244; it += NGW) { const int l = it / 244, r = 2828 + it % 244; GAS v4u* p = (GAS v4u*)(WIN + ((size_t)l * NPROJ_PAD + r) * DM);
        p[lane] = (v4u){0u, 0u, 0u, 0u}; p[lane + 64] = (v4u){0u, 0u, 0u, 0u}; }
    { float* RTW = (float*)(ws + WS_RTW);
      for (int idx = (vcu * NTHR + tid); idx < 2 * 1024 * 48; idx += G * NTHR) { const int j = idx % 48, k = (idx / 48) % 1024, l = idx / (48 * 1024);
          RTW[idx] = j < 4 ? a->in[I_MWRG][(size_t)(l * 1024 + k) * 4 + j] : (j < 36 ? a->in[I_MWRE][(size_t)(l * 1024 + k) * 32 + (j - 4)] : 0.f); } }
    moe_convert(a->in[I_MW1], a->in[I_MW3], a->in[I_MW2], 0, (bf16*)(ws + WS_W13), (bf16*)(ws + WS_W2), gw, NGW, scr, lane);
    __syncthreads();
    if (vcu < 192) {
        const int q = vcu, l = q / 96, cb = (q >> 3) % 12, kc = q & 7;
        LAS float* cond = (LAS float*)lds;
        { const int b = tid >> 7, kk = tid & 127; const float cv = a->in[I_C][b * DM + kc * 128 + kk]; cond[tid] = cv / (1.f + __expf(-cv)); }
        __syncthreads();
        const int col = cb * 512 + tid; const float* wp = a->in[I_ADA_W] + ((size_t)l * DM + kc * 128) * 6144 + col;
        float acc0 = 0.f, acc1 = 0.f, acc2 = 0.f, acc3 = 0.f;
#pragma unroll 8
        for (int kk = 0; kk < 128; ++kk) { const float w = wp[(size_t)kk * 6144]; acc0 += cond[kk] * w; acc1 += cond[128 + kk] * w; acc2 += cond[256 + kk] * w; acc3 += cond[384 + kk] * w; }
        const float bias = (kc == 0) ? a->in[I_ADA_B][l * 6144 + col] : 0.f;
        float* MP = (float*)(ws + WS_MODP) + ((size_t)(kc * 2 + l) * 4) * 6144 + col;
        MP[0] = acc0 + bias; MP[6144] = acc1 + bias; MP[2 * 6144] = acc2 + bias; MP[3 * 6144] = acc3 + bias;
    }
}

__device__ __forceinline__ float modval(const unsigned char* ws, bool part, int l, int b, int idx) {
    if (!part) return ((const float*)(ws + WS_MODF))[(size_t)(l * 4 + b) * 6144 + idx];
    const float* mp = (const float*)(ws + WS_MODP) + (size_t)(l * 4 + b) * 6144 + idx; float s = 0.f;
#pragma unroll
    for (int kc = 0; kc < 8; ++kc) s += mp[(size_t)kc * 2 * 4 * 6144];
    return s;
}
template <int MODE, bool COMBINE>
__device__ __forceinline__ void phase_rownorm(KArgsP a, LAS unsigned char* lds, int tid, int lane, int wave, int G,
                                              const float* xsrc, float* xdst, const float* gvec, bool part, int l, int isc  , int lprev) {
    unsigned char* ws = a->ws;
    LAS float* sc = (LAS float*)lds; LAS float* sh = sc + 1024; LAS float* gt = sh + 1024;
    bf16* HN = (bf16*)(ws + WS_HN); const bf16* YM = (const bf16*)(ws + WS_YMOE); const float* TW = (const float*)(ws + WS_TOKW);
    for (int c = blockIdx.x; c < NTOK / 128; c += G) {
        const int b = c >> 6;
        __syncthreads();
        for (int j = tid; j < 1024; j += NTHR) {
            if (MODE == 0) { sc[j] = gvec[j] * (1.f + modval(ws, part, l, b, (isc + 1) * 1024 + j)); sh[j] = modval(ws, part, l, b, isc * 1024 + j); }
            else { sc[j] = gvec[j]; sh[j] = 0.f; }
            if (COMBINE) gt[j] = 1.f + modval(ws, false, lprev, b, 5 * 1024 + j);
        }
        __syncthreads();
        for (int i = 0; i < 16; ++i) {
            const int row = c * 128 + wave * 16 + i;
            const GAS f32x4* xr = (const GAS f32x4*)(xsrc + (size_t)row * DM) + lane;
            f32x4 v[4];
#pragma unroll
            for (int j = 0; j < 4; ++j) v[j] = xr[64 * j];
            if (COMBINE) {
                const float w0 = TW[2 * row], w1 = TW[2 * row + 1];
                const GAS v2u* y0 = (const GAS v2u*)(YM + (size_t)(2 * row) * DM) + lane; const GAS v2u* y1 = (const GAS v2u*)(YM + (size_t)(2 * row + 1) * DM) + lane;
#pragma unroll
                for (int j = 0; j < 4; ++j) { const v2u p0 = y0[64 * j], p1 = y1[64 * j]; const f32x4 g4 = *(const LAS f32x4*)(gt + lane * 4 + 256 * j);
                    f32x4 m; m.x = w0 * bflo(p0.x) + w1 * bflo(p1.x); m.y = w0 * bfhi(p0.x) + w1 * bfhi(p1.x); m.z = w0 * bflo(p0.y) + w1 * bflo(p1.y); m.w = w0 * bfhi(p0.y) + w1 * bfhi(p1.y);
                    v[j] = v[j] + g4 * m; }
                if (MODE == 0) { GAS f32x4* xo = (GAS f32x4*)(xdst + (size_t)row * DM) + lane;
#pragma unroll
                    for (int j = 0; j < 4; ++j) xo[64 * j] = v[j]; }
            }
            float ss = 0.f;
#pragma unroll
            for (int j = 0; j < 4; ++j) ss += (v[j].x * v[j].x + v[j].y * v[j].y) + (v[j].z * v[j].z + v[j].w * v[j].w);
            const float rstd = rsqrtf(wave_sum(ss) * (1.f / DM) + NORM_EPS);
            if (MODE == 0) {
                GAS v2u* o = (GAS v2u*)(HN + (size_t)row * DM) + lane;
#pragma unroll
                for (int j = 0; j < 4; ++j) { const f32x4 s4 = *(const LAS f32x4*)(sc + lane * 4 + 256 * j), h4 = *(const LAS f32x4*)(sh + lane * 4 + 256 * j); const f32x4 h = v[j] * rstd * s4 + h4;
                    v2u w; w.x = pk2(h.x, h.y); w.y = pk2(h.z, h.w); o[64 * j] = w; }
            } else {
                GAS f32x4* o = (GAS f32x4*)(xdst + (size_t)row * DM) + lane;
#pragma unroll
                for (int j = 0; j < 4; ++j) { const f32x4 s4 = *(const LAS f32x4*)(sc + lane * 4 + 256 * j); o[64 * j] = v[j] * rstd * s4; }
            }
        }
    }
}
__device__ __forceinline__ void mod_finalize(unsigned char* ws, int tid, int G) {
    float* MF = (float*)(ws + WS_MODF);
    for (int idx = blockIdx.x * NTHR + tid; idx < 2 * 4 * 6144; idx += G * NTHR) { const float* mp = (const float*)(ws + WS_MODP) + idx; float s = 0.f;
#pragma unroll
        for (int kc = 0; kc < 8; ++kc) s += mp[(size_t)kc * 2 * 4 * 6144];
        MF[idx] = s; }
}

typedef float f32x4m __attribute__((ext_vector_type(4)));
__device__ __forceinline__ void phase_router(KArgsP a, LAS unsigned char* lds, int tid, int lane, int wave, int G, int l) {
    unsigned char* ws = a->ws;
    LAS float* sc = (LAS float*)lds; LAS float* sh = sc + 1024; LAS float* rstd_s = sh + 1024  ; LAS float* cvec = rstd_s + 128  ; LAS float* cpart = cvec + 64  ;
    LAS float* lg = cpart + 8 * 48  ; LAS int* hist = (LAS int*)(lg + 8 * 16 * 48)  ; LAS int* basev = hist + 32; LAS int* asg_e = basev + 32  ; LAS int* asg_lp = asg_e + 256;
    bf16* HN = (bf16*)(ws + WS_HN); const float* x = a->out; const float* RTW = (const float*)(ws + WS_RTW) + (size_t)l * 1024 * 48;
    int* TOKE = (int*)(ws + WS_TOKE); float* TOKW = (float*)(ws + WS_TOKW); int* LIST = (int*)(ws + WS_LIST); unsigned* CNT = (unsigned*)(ws + WS_CTL) + CW_CNT + l * 32;
    const float* gvec = a->in[I_NORM_FFN] + l * DM;
    for (int c = blockIdx.x; c < NTOK / 128; c += G) {
        const int b = c >> 6;
        __syncthreads();
        for (int j = tid; j < 1024; j += NTHR) { sc[j] = gvec[j] * (1.f + modval(ws, false, l, b, 4 * 1024 + j)); sh[j] = modval(ws, false, l, b, 3 * 1024 + j); }
        if (tid < 32) hist[tid] = 0;
        __syncthreads();
        if (tid < 384) { const int j = tid % 48, part = tid / 48; float s = 0.f;
            for (int k = part * 128; k < part * 128 + 128; ++k) s += sh[k] * RTW[(size_t)k * 48 + j];
            cpart[part * 48 + j] = s; }
        for (int i = 0; i < 16; ++i) {
            const int row = c * 128 + wave * 16 + i;
            const GAS f32x4* xr = (const GAS f32x4*)(x + (size_t)row * DM) + lane;
            f32x4 v[4]; float ss = 0.f;
#pragma unroll
            for (int j = 0; j < 4; ++j) { v[j] = xr[64 * j]; ss += (v[j].x * v[j].x + v[j].y * v[j].y) + (v[j].z * v[j].z + v[j].w * v[j].w); }
            const float rstd = rsqrtf(wave_sum(ss) * (1.f / DM) + NORM_EPS);
            if (lane == 0) rstd_s[wave * 16 + i] = rstd;
            GAS v2u* o = (GAS v2u*)(HN + (size_t)row * DM) + lane;
#pragma unroll
            for (int j = 0; j < 4; ++j) { const f32x4 s4 = *(const LAS f32x4*)(sc + lane * 4 + 256 * j), h4 = *(const LAS f32x4*)(sh + lane * 4 + 256 * j); const f32x4 h = v[j] * rstd * s4 + h4;
                v2u w; w.x = pk2(h.x, h.y); w.y = pk2(h.z, h.w); o[64 * j] = w; }
        }
        __syncthreads();
        if (tid < 48) { float s = 0.f;
#pragma unroll
            for (int p = 0; p < 8; ++p) s += cpart[p * 48 + tid];
            s += tid < 4 ? a->in[I_MBRG][l * 4 + tid] : (tid < 36 ? a->in[I_MBRE][l * 32 + tid - 4] : 0.f); cvec[tid] = s; }
        {
            const int i16 = lane & 15, kq = lane >> 4, r0 = c * 128 + wave * 16;
            f32x4m acc0 = {0.f, 0.f, 0.f, 0.f}, acc1 = acc0, acc2 = acc0;
            const float* xrow = x + (size_t)(r0 + i16) * DM + 4 * kq;
            for (int k0 = 0; k0 < DM; k0 += 16) {
                const f32x4 xv = *(const GAS f32x4*)(xrow + k0); const f32x4 sv = *(const LAS f32x4*)(sc + k0 + 4 * kq);
                const float* wp = RTW + (size_t)(k0 + 4 * kq) * 48 + i16;
#pragma unroll
                for (int j = 0; j < 4; ++j) { const float av = xv[j] * sv[j];
                    acc0 = __builtin_amdgcn_mfma_f32_16x16x4f32(av, wp[j * 48], acc0, 0, 0, 0);
                    acc1 = __builtin_amdgcn_mfma_f32_16x16x4f32(av, wp[j * 48 + 16], acc1, 0, 0, 0);
                    acc2 = __builtin_amdgcn_mfma_f32_16x16x4f32(av, wp[j * 48 + 32], acc2, 0, 0, 0); }
            }
            __syncthreads();
            LAS float* lw = lg + wave * 16 * 48;
#pragma unroll
            for (int r = 0; r < 4; ++r) { const int rr = 4 * kq + r; const float rs = rstd_s[wave * 16 + rr];
                lw[rr * 48 + i16] = acc0[r] * rs + cvec[i16]; lw[rr * 48 + 16 + i16] = acc1[r] * rs + cvec[16 + i16]; lw[rr * 48 + 32 + i16] = acc2[r] * rs + cvec[32 + i16]; }
            LDS_WAIT(); asm volatile("" ::: "memory");
            if (lane < 16) {
                const LAS float* lr = lw + lane * 48; const int row = r0 + lane;
                float g0 = lr[0], g1 = lr[1], g2 = lr[2], g3 = lr[3]; const float gm = fmaxf(fmaxf(g0, g1), fmaxf(g2, g3));
                float p0 = __expf(g0 - gm), p1 = __expf(g1 - gm), p2 = __expf(g2 - gm), p3 = __expf(g3 - gm); const float inv = 1.f / (p0 + p1 + p2 + p3);
                p0 *= inv; p1 *= inv; p2 *= inv; p3 *= inv;
                int gi = 0; float gp = p0; if (p1 > gp) { gp = p1; gi = 1; } if (p2 > gp) { gp = p2; gi = 2; } if (p3 > gp) { gp = p3; gi = 3; }
                float ev0 = -3.4e38f, ev1 = -3.4e38f; int e0 = 0, e1 = 0;
#pragma unroll
                for (int j = 0; j < 8; ++j) { const float s = lr[4 + gi * 8 + j]; if (s > ev0) { ev1 = ev0; e1 = e0; ev0 = s; e0 = j; } else if (s > ev1) { ev1 = s; e1 = j; } }
                const float q = __expf(ev1 - ev0), w0 = gp / (1.f + q), w1 = gp * q / (1.f + q);
                e0 += gi * 8; e1 += gi * 8;
                TOKE[2 * row] = e0; TOKE[2 * row + 1] = e1; TOKW[2 * row] = w0; TOKW[2 * row + 1] = w1;
                const int a0 = 2 * (wave * 16 + lane);
                asg_e[a0] = e0; asg_e[a0 + 1] = e1; asg_lp[a0] = atomicAdd((int*)&hist[e0], 1); asg_lp[a0 + 1] = atomicAdd((int*)&hist[e1], 1);
            }
        }
        __syncthreads();
        if (tid < 32) { const int h = hist[tid]; basev[tid] = h ? (int)atomicAdd(CNT + tid, (unsigned)h) : 0; }
        __syncthreads();
        if (tid < 256) { const int e = asg_e[tid]; LIST[(size_t)e * 65536 + basev[e] + asg_lp[tid]] = (c * 128) * 2 + tid; }
    }
}
__device__ __forceinline__ void build_ptab(const unsigned* CNT, LAS int* ptab, LAS int* pst, LAS int* cnt, int tid) {
    __syncthreads();
    if (tid == 0) { int np = 0;
        for (int e = 0; e < NEXP; ++e) { const int ce = (int)__hip_atomic_load(CNT + e, RLX_AGENT); cnt[e] = ce; pst[e] = np * 256; const int pe = (ce + 255) >> 8;
            for (int p = 0; p < pe; ++p) ptab[1 + np + p] = e;
            np += pe; }
        ptab[0] = np; }
    __syncthreads();
}
__device__ __forceinline__ void phase_gather(KArgsP a, LAS unsigned char* lds, int tid, int lane, int wave, int vcu, int G, int l) {
    unsigned char* ws = a->ws;
    LAS int* ptab = (LAS int*)lds; LAS int* pst = ptab + 512; LAS int* cnt = pst + 32;
    build_ptab((const unsigned*)(ws + WS_CTL) + CW_CNT + l * 32, ptab, pst, cnt, tid);
    const bf16* HN = (const bf16*)(ws + WS_HN); bf16* XG = (bf16*)(ws + WS_XG); int* ROWMAP = (int*)(ws + WS_ROWMAP); const int* LIST = (const int*)(ws + WS_LIST);
    const int nrows = ptab[0] * 256;
    for (int row = vcu * NWAVES + wave; row < nrows; row += G * NWAVES) {
        const int e = ptab[1 + (row >> 8)], pos = row - pst[e]; const bool valid = pos < cnt[e];
        const int tok2 = valid ? LIST[(size_t)e * 65536 + pos] : -1;
        GAS v4u* d = (GAS v4u*)(XG + (size_t)row * DM) + lane;
        if (valid) { const GAS v4u* s = (const GAS v4u*)(HN + (size_t)(tok2 >> 1) * DM) + lane; const v4u p0 = s[0], p1 = s[64]; d[0] = p0; d[64] = p1; }
        else { d[0] = (v4u){0u, 0u, 0u, 0u}; d[64] = (v4u){0u, 0u, 0u, 0u}; }
        if (lane == 0) ROWMAP[row] = tok2;
    }
}

constexpr int ML_A = 0, ML_B = 4288, ML_C = ML_B + 8192, ML_D = ML_C + 4160, ML_E = ML_D + 4160, ML_S = ML_E + 4160;
__device__ __forceinline__ float logsigmoidf_(float x) { return fminf(x, 0.f) - log1pf(__expf(-fabsf(x))); }
__device__ __forceinline__ void ml_load_cx(KArgsP a, LAS float* L, int tid, int l, int b, int c, int h) {
    const bf16* PROJ = (const bf16*)(a->ws + WS_PROJ);
    LAS float* xp = L + ML_A;
    for (int idx = tid; idx < 67 * 64; idx += NTHR) { const int r = idx >> 6, ch = idx & 63, tr = c * 64 + r - 3;
        xp[idx] = tr >= 0 ? bf2f(PROJ[(size_t)(b * SEQ + tr) * NPROJ + PC_QK + h * 64 + ch]) : 0.f; }
    __syncthreads();
    const float* cw = a->in[I_CONV_W] + (size_t)l * 4 * DA + h * 64; const float* cb = a->in[I_CONV_B] + (size_t)l * DA + h * 64;
    LAS float* cx = L + ML_C;
    for (int idx = tid; idx < 64 * 64; idx += NTHR) { const int t = idx >> 6, ch = idx & 63;
        float s = cb[ch];
#pragma unroll
        for (int j = 0; j < 4; ++j) s += xp[(t + j) * 64 + ch] * cw[j * DA + ch];
        cx[t * 65 + ch] = s / (1.f + __expf(-s)); }
}
__device__ __forceinline__ void phase_m1(KArgsP a, LAS unsigned char* lds, int tid, int lane, int wave, int vcu, int G, int l) {
    unsigned char* ws = a->ws; LAS float* L = (LAS float*)lds;
    const bf16* PROJ = (const bf16*)(ws + WS_PROJ); const float* GT = (const float*)(ws + WS_GATES);
    float* CLOC = (float*)(ws + WS_CLOC); float* MLG = (float*)(ws + WS_MSC); float* MLM = MLG + 4096;
    for (int u = vcu; u < NUNIT_M; u += G) {
        const int h = u % NH, c = (u / NH) % NCH, b = u / (NH * NCH); const size_t row0 = (size_t)b * SEQ + c * 64;
        __syncthreads();
        ml_load_cx(a, L, tid, l, b, c, h);
        LAS float* wk = L + ML_B; LAS float* vs = L + ML_B + 4096; LAS float* sm = L + ML_S;
        for (int idx = tid; idx < 4096; idx += NTHR) { wk[idx] = a->in[I_WK][((size_t)(l * NH + h) * 64) * 64 + idx];
            vs[idx] = bf2f(PROJ[(row0 + (idx >> 6)) * NPROJ + PC_V + h * 64 + (idx & 63)]); }
        if (wave == 0) {
            const float ig = GT[(row0 + lane) * 16 + h] + a->in[I_BI][l * NH + h];
            const float fl = logsigmoidf_(GT[(row0 + lane) * 16 + 6 + h] + a->in[I_BF][l * NH + h]);
            float bc = fl;
#pragma unroll
            for (int o = 1; o < 64; o <<= 1) { const float t = __shfl_up(bc, o); if (lane >= o) bc += t; }
            const float gtot = __shfl(bc, 63); const float lw = gtot - bc + ig; const float ml = wave_max(lw);
            sm[128 + lane] = __expf(lw - ml);
            if (lane == 0) { MLG[u] = gtot; MLM[u] = ml; }
        }
        __syncthreads();
        {
            const int t = tid >> 3, eg = tid & 7; LAS float* cx = L + ML_C; LAS float* kT = L + ML_E;
            float acc[8] = {0.f, 0.f, 0.f, 0.f, 0.f, 0.f, 0.f, 0.f};
#pragma unroll 2
            for (int d = 0; d < 64; ++d) { const float cv = cx[t * 65 + d]; const f32x4 w0 = *(const LAS f32x4*)(wk + d * 64 + eg * 8), w1 = *(const LAS f32x4*)(wk + d * 64 + eg * 8 + 4);
                acc[0] += cv * w0.x; acc[1] += cv * w0.y; acc[2] += cv * w0.z; acc[3] += cv * w0.w; acc[4] += cv * w1.x; acc[5] += cv * w1.y; acc[6] += cv * w1.z; acc[7] += cv * w1.w; }
#pragma unroll
            for (int e = 0; e < 8; ++e) kT[(eg * 8 + e) * 65 + t] = acc[e] * 0.125f;
        }
        __syncthreads();
        {
            const int kd = tid >> 3, vg = tid & 7; LAS float* kT = L + ML_E;
            float acc[8] = {0.f, 0.f, 0.f, 0.f, 0.f, 0.f, 0.f, 0.f}, na = 0.f;
#pragma unroll 2
            for (int t = 0; t < 64; ++t) { const float kw = kT[kd * 65 + t] * sm[128 + t]; const f32x4 v0 = *(const LAS f32x4*)(vs + t * 64 + vg * 8), v1 = *(const LAS f32x4*)(vs + t * 64 + vg * 8 + 4);
                na += kw; acc[0] += kw * v0.x; acc[1] += kw * v0.y; acc[2] += kw * v0.z; acc[3] += kw * v0.w; acc[4] += kw * v1.x; acc[5] += kw * v1.y; acc[6] += kw * v1.z; acc[7] += kw * v1.w; }
            float* cl = CLOC + (size_t)u * CL_STRIDE;
            *(f32x4*)(cl + kd * 64 + vg * 8) = (f32x4){acc[0], acc[1], acc[2], acc[3]}; *(f32x4*)(cl + kd * 64 + vg * 8 + 4) = (f32x4){acc[4], acc[5], acc[6], acc[7]};
            if (vg == 0) cl[4096 + kd] = na;
        }
    }
}
__device__ __forceinline__ void phase_m2(unsigned char* ws, int tid, int wg, int nwg) {
    float* CLOC = (float*)(ws + WS_CLOC); const float* MLG = (const float*)(ws + WS_MSC); const float* MLM = MLG + 4096; float* MST = (float*)(ws + WS_MSC) + 8192;
    for (int idx = wg * NTHR + tid; idx < NB * NH * CL_STRIDE; idx += nwg * NTHR) {
        const int e = idx % CL_STRIDE, bh = idx / CL_STRIDE, b = bh / NH, h = bh % NH;
        float m = 0.f, cs = 0.f;
        for (int c0 = 0; c0 < NCH; c0 += 8) {
            float cl[8], g[8], ml[8];
#pragma unroll
            for (int j = 0; j < 8; ++j) { const int u = (b * NCH + c0 + j) * NH + h; cl[j] = CLOC[(size_t)u * CL_STRIDE + e]; g[j] = MLG[u]; ml[j] = MLM[u]; }
#pragma unroll
            for (int j = 0; j < 8; ++j) { const int u = (b * NCH + c0 + j) * NH + h;
                CLOC[(size_t)u * CL_STRIDE + e] = cs; if (e == 0) MST[u] = m;
                const float mn = fmaxf(g[j] + m, ml[j]); const float ao = __expf(g[j] + m - mn), al = __expf(ml[j] - mn);
                cs = ao * cs + al * cl[j]; m = mn; }
        }
    }
}
__device__ __forceinline__ void phase_m3(KArgsP a, LAS unsigned char* lds, int tid, int lane, int wave, int vcu, int G, int l) {
    unsigned char* ws = a->ws; LAS float* L = (LAS float*)lds;
    const bf16* PROJ = (const bf16*)(ws + WS_PROJ); const float* GT = (const float*)(ws + WS_GATES);
    const float* CLOC = (const float*)(ws + WS_CLOC); const float* MST = (const float*)(ws + WS_MSC) + 8192; bf16* YC = (bf16*)(ws + WS_YC);
    for (int u = vcu; u < NUNIT_M; u += G) {
        const int h = u % NH, c = (u / NH) % NCH, b = u / (NH * NCH); const size_t row0 = (size_t)b * SEQ + c * 64;
        __syncthreads();
        ml_load_cx(a, L, tid, l, b, c, h);
        LAS float* wq = L + ML_B; LAS float* wk = L + ML_B + 4096; LAS float* sm = L + ML_S;
        for (int idx = tid; idx < 4096; idx += NTHR) { wq[idx] = a->in[I_WQ][((size_t)(l * NH + h) * 64) * 64 + idx]; wk[idx] = a->in[I_WK][((size_t)(l * NH + h) * 64) * 64 + idx]; }
        if (wave == 0) {
            const float ig = GT[(row0 + lane) * 16 + h] + a->in[I_BI][l * NH + h];
            const float fl = logsigmoidf_(GT[(row0 + lane) * 16 + 6 + h] + a->in[I_BF][l * NH + h]);
            float bc = fl;
#pragma unroll
            for (int o = 1; o < 64; o <<= 1) { const float t = __shfl_up(bc, o); if (lane >= o) bc += t; }
            float pm = ig - bc;
#pragma unroll
            for (int o = 1; o < 64; o <<= 1) { const float t = __shfl_up(pm, o); if (lane >= o) pm = fmaxf(pm, t); }
            const float mst = MST[u]; const float inter = bc + mst, mt = fmaxf(inter, bc + pm);
            sm[lane] = ig; sm[64 + lane] = bc; sm[128 + lane] = mt; sm[192 + lane] = __expf(inter - mt); sm[256 + lane] = __expf(-mt);
        }
        __syncthreads();
        {
            const int t = tid >> 3, eg = tid & 7; LAS float* cx = L + ML_C; LAS float* qs = L + ML_D; LAS float* kT = L + ML_E;
            float aq[8] = {0.f, 0.f, 0.f, 0.f, 0.f, 0.f, 0.f, 0.f}, ak[8] = {0.f, 0.f, 0.f, 0.f, 0.f, 0.f, 0.f, 0.f};
#pragma unroll 2
            for (int d = 0; d < 64; ++d) { const float cv = cx[t * 65 + d];
                const f32x4 q0 = *(const LAS f32x4*)(wq + d * 64 + eg * 8), q1 = *(const LAS f32x4*)(wq + d * 64 + eg * 8 + 4), k0 = *(const LAS f32x4*)(wk + d * 64 + eg * 8), k1 = *(const LAS f32x4*)(wk + d * 64 + eg * 8 + 4);
                aq[0] += cv * q0.x; aq[1] += cv * q0.y; aq[2] += cv * q0.z; aq[3] += cv * q0.w; aq[4] += cv * q1.x; aq[5] += cv * q1.y; aq[6] += cv * q1.z; aq[7] += cv * q1.w;
                ak[0] += cv * k0.x; ak[1] += cv * k0.y; ak[2] += cv * k0.z; ak[3] += cv * k0.w; ak[4] += cv * k1.x; ak[5] += cv * k1.y; ak[6] += cv * k1.z; ak[7] += cv * k1.w; }
#pragma unroll
            for (int e = 0; e < 8; ++e) { qs[t * 65 + eg * 8 + e] = aq[e]; kT[(eg * 8 + e) * 65 + t] = ak[e] * 0.125f; }
        }
        __syncthreads();
        LAS float* cst = L + ML_B; LAS float* vs = L + ML_B + 4096; LAS float* Sm = L + ML_A; LAS float* nst = sm + 320;
        {
            const float* cl = CLOC + (size_t)u * CL_STRIDE;
            for (int idx = tid; idx < 4096; idx += NTHR) { cst[idx] = cl[idx]; vs[idx] = bf2f(PROJ[(row0 + (idx >> 6)) * NPROJ + PC_V + h * 64 + (idx & 63)]); }
            if (tid < 64) nst[tid] = cl[4096 + tid];
            const int t = tid >> 3, sg = tid & 7; LAS float* qs = L + ML_D; LAS float* kT = L + ML_E;
            float acc[8] = {0.f, 0.f, 0.f, 0.f, 0.f, 0.f, 0.f, 0.f};
#pragma unroll 2
            for (int e = 0; e < 64; ++e) { const float qv = qs[t * 65 + e];
#pragma unroll
                for (int j = 0; j < 8; ++j) acc[j] += qv * kT[e * 65 + sg * 8 + j]; }
            const float bt = sm[64 + t], mt = sm[128 + t];
#pragma unroll
            for (int j = 0; j < 8; ++j) { const int s = sg * 8 + j; Sm[t * 65 + s] = (s <= t) ? acc[j] * __expf(bt - sm[64 + s] + sm[s] - mt) : 0.f; }
        }
        __syncthreads();
        {
            const int t = tid >> 3, vg = tid & 7; LAS float* qs = L + ML_D;
            float acc[8] = {0.f, 0.f, 0.f, 0.f, 0.f, 0.f, 0.f, 0.f}, dq = 0.f;
#pragma unroll 2
            for (int e = 0; e < 64; ++e) { const float qv = qs[t * 65 + e]; const f32x4 c0 = *(const LAS f32x4*)(cst + e * 64 + vg * 8), c1 = *(const LAS f32x4*)(cst + e * 64 + vg * 8 + 4);
                dq += qv * nst[e];
                acc[0] += qv * c0.x; acc[1] += qv * c0.y; acc[2] += qv * c0.z; acc[3] += qv * c0.w; acc[4] += qv * c1.x; acc[5] += qv * c1.y; acc[6] += qv * c1.z; acc[7] += qv * c1.w; }
            const float wi = sm[192 + t]; dq *= wi;
#pragma unroll
            for (int j = 0; j < 8; ++j) acc[j] *= wi;
#pragma unroll 2
            for (int s = 0; s < 64; ++s) { const float sv = Sm[t * 65 + s]; const f32x4 v0 = *(const LAS f32x4*)(vs + s * 64 + vg * 8), v1 = *(const LAS f32x4*)(vs + s * 64 + vg * 8 + 4);
                dq += sv;
                acc[0] += sv * v0.x; acc[1] += sv * v0.y; acc[2] += sv * v0.z; acc[3] += sv * v0.w; acc[4] += sv * v1.x; acc[5] += sv * v1.y; acc[6] += sv * v1.z; acc[7] += sv * v1.w; }
            const float dn = 1.f / fmaxf(fabsf(dq), sm[256 + t]);
            float s1 = 0.f;
#pragma unroll
            for (int j = 0; j < 8; ++j) { acc[j] *= dn; s1 += acc[j]; }
            s1 += __shfl_xor(s1, 1); s1 += __shfl_xor(s1, 2); s1 += __shfl_xor(s1, 4);
            const float mu = s1 * (1.f / 64.f); float s2 = 0.f;
#pragma unroll
            for (int j = 0; j < 8; ++j) { acc[j] -= mu; s2 += acc[j] * acc[j]; }
            s2 += __shfl_xor(s2, 1); s2 += __shfl_xor(s2, 2); s2 += __shfl_xor(s2, 4);
            const float rs = rsqrtf(s2 * (1.f / 64.f) + HEAD_NORM_EPS);
            const float* nw = a->in[I_MNORM_W] + (size_t)l * DA + h * 64 + vg * 8;
            const v4u ov = *(const GAS v4u*)(PROJ + (row0 + t) * NPROJ + PC_O + h * 64 + vg * 8);
            const float o[8] = {bflo(ov.x), bfhi(ov.x), bflo(ov.y), bfhi(ov.y), bflo(ov.z), bfhi(ov.z), bflo(ov.w), bfhi(ov.w)};
            float r[8];
#pragma unroll
            for (int j = 0; j < 8; ++j) r[j] = acc[j] * rs * nw[j] * sigmoidf_(o[j]);
            v4u w; w.x = pk2(r[0], r[1]); w.y = pk2(r[2], r[3]); w.z = pk2(r[4], r[5]); w.w = pk2(r[6], r[7]);
            *(GAS v4u*)(YC + (row0 + t) * DM + h * 64 + vg * 8) = w;
        }
    }
}

struct S5Par { float are, aim, bre[16], bim[16]; };
__device__ __forceinline__ void s5_params(KArgsP a, int l, int g, int p, S5Par& P) {
    const float lam_re = a->in[I_S5ARE][(size_t)(l * 16 + g) * 64 + p], lam_im = a->in[I_S5AIM][(size_t)(l * 16 + g) * 64 + p];
    const float dt = expf(a->in[I_S5LDT][l * 16 + g]);
    const float mag = expf(lam_re * dt), ang = lam_im * dt;
    P.are = mag * cosf(ang); P.aim = mag * sinf(ang);
    const float inv = 1.f / (lam_re * lam_re + lam_im * lam_im);
    const float cre = ((P.are - 1.f) * lam_re + P.aim * lam_im) * inv, cim = (P.aim * lam_re - (P.are - 1.f) * lam_im) * inv;
    const float* br = a->in[I_S5BRE] + ((size_t)(l * 16 + g) * 64 + p) * 16; const float* bi = a->in[I_S5BIM] + ((size_t)(l * 16 + g) * 64 + p) * 16;
#pragma unroll
    for (int c = 0; c < 16; ++c) { P.bre[c] = cre * br[c] - cim * bi[c]; P.bim[c] = cre * bi[c] + cim * br[c]; }
}
__device__ __forceinline__ void s5_step(const S5Par& P, const LAS float* u16, float& xr, float& xi) {
    float br = 0.f, bi = 0.f;
#pragma unroll
    for (int q = 0; q < 4; ++q) { const f32x4 u = *(const LAS f32x4*)(u16 + 4 * q);
        br += P.bre[4 * q] * u.x + P.bre[4 * q + 1] * u.y + P.bre[4 * q + 2] * u.z + P.bre[4 * q + 3] * u.w;
        bi += P.bim[4 * q] * u.x + P.bim[4 * q + 1] * u.y + P.bim[4 * q + 2] * u.z + P.bim[4 * q + 3] * u.w; }
    const float nr = P.are * xr - P.aim * xi + br, ni = P.are * xi + P.aim * xr + bi; xr = nr; xi = ni;
}
__device__ __forceinline__ void s5_load_u(const unsigned char* ws, LAS float* us, int tid, size_t row0) {
    const bf16* PROJ = (const bf16*)(ws + WS_PROJ);
    for (int idx = tid; idx < 64 * 32; idx += NTHR) { const int t = idx >> 5, c8 = idx & 31;
        const v4u p = *(const GAS v4u*)(PROJ + (row0 + t) * NPROJ + PC_S5 + c8 * 8);
        LAS float* d = us + t * 256 + c8 * 8;
        *(LAS f32x4*)d = (f32x4){bflo(p.x), bfhi(p.x), bflo(p.y), bfhi(p.y)}; *(LAS f32x4*)(d + 4) = (f32x4){bflo(p.z), bfhi(p.z), bflo(p.w), bfhi(p.w)}; }
}
__device__ __forceinline__ void phase_s1(KArgsP a, LAS unsigned char* lds, int tid, int vcu, int G, int l) {
    unsigned char* ws = a->ws; LAS float* us = (LAS float*)lds; float* ST = (float*)(ws + WS_S5ST);
    const int gi = tid >> 6, p = tid & 63;
    S5Par P0, P1; s5_params(a, l, gi, p, P0); s5_params(a, l, gi + 8, p, P1);
    for (int u = vcu; u < NB * NCH; u += G) {
        const size_t row0 = (size_t)u * 64;
        __syncthreads();
        s5_load_u(ws, us, tid, row0);
        __syncthreads();
        float x0r = 0.f, x0i = 0.f, x1r = 0.f, x1i = 0.f;
        for (int t = 0; t < 64; ++t) { s5_step(P0, us + t * 256 + gi * 16, x0r, x0i); s5_step(P1, us + t * 256 + (gi + 8) * 16, x1r, x1i); }
        *(f32x2*)(ST + (((size_t)u * 16 + gi) * 64 + p) * 2) = (f32x2){x0r, x0i};
        *(f32x2*)(ST + (((size_t)u * 16 + gi + 8) * 64 + p) * 2) = (f32x2){x1r, x1i};
    }
}
__device__ __forceinline__ void phase_s2(KArgsP a, int tid, int wg, int nwg, int l) {
    float* ST = (float*)(a->ws + WS_S5ST);
    for (int idx = wg * NTHR + tid; idx < NB * 1024; idx += nwg * NTHR) {
        const int b = idx >> 10, gp = idx & 1023, g = gp >> 6, p = gp & 63;
        const float lam_re = a->in[I_S5ARE][(size_t)(l * 16 + g) * 64 + p], lam_im = a->in[I_S5AIM][(size_t)(l * 16 + g) * 64 + p];
        const float dt = expf(a->in[I_S5LDT][l * 16 + g]); const float mag = expf(lam_re * dt), ang = lam_im * dt;
        float ar = mag * cosf(ang), ai = mag * sinf(ang);
#pragma unroll
        for (int s = 0; s < 6; ++s) { const float nr = ar * ar - ai * ai, ni = 2.f * ar * ai; ar = nr; ai = ni; }
        float cr = 0.f, ci = 0.f;
        for (int c0 = 0; c0 < NCH; c0 += 8) {
            f32x2 e[8];
#pragma unroll
            for (int j = 0; j < 8; ++j) e[j] = *(const f32x2*)(ST + (((size_t)(b * NCH + c0 + j) * 16 + g) * 64 + p) * 2);
#pragma unroll
            for (int j = 0; j < 8; ++j) { *(f32x2*)(ST + (((size_t)(b * NCH + c0 + j) * 16 + g) * 64 + p) * 2) = (f32x2){cr, ci};
                const float nr = ar * cr - ai * ci + e[j].x, ni = ar * ci + ai * cr + e[j].y; cr = nr; ci = ni; }
        }
    }
}
__device__ __forceinline__ float gelu_tanh_(float x) { const float t = tanhf(0.7978845608f * (x + 0.044715f * x * x * x)); return 0.5f * x * (1.f + t); }
__device__ __forceinline__ void phase_s3(KArgsP a, LAS unsigned char* lds, int tid, int vcu, int G, int l) {
    unsigned char* ws = a->ws; LAS float* us = (LAS float*)lds; LAS float* xrr = us + 64 * 256; LAS float* xir = xrr + 8 * 1024;
    const float* ST = (const float*)(ws + WS_S5ST); bf16* YC = (bf16*)(ws + WS_YC);
    const int gi = tid >> 6, p = tid & 63;
    const int ch = tid & 255, th = tid >> 8, og = ch >> 4, oc = ch & 15;
    const float* cre = a->in[I_S5CRE] + ((size_t)(l * 16 + og) * 16 + oc) * 64; const float* cim = a->in[I_S5CIM] + ((size_t)(l * 16 + og) * 16 + oc) * 64;
    const float dv = a->in[I_S5D][l * DC + ch];
    for (int u = vcu; u < NB * NCH; u += G) {
        const size_t row0 = (size_t)u * 64;
        __syncthreads();
        s5_load_u(ws, us, tid, row0);
        S5Par P0, P1; s5_params(a, l, gi, p, P0); s5_params(a, l, gi + 8, p, P1);
        const f32x2 s0 = *(const f32x2*)(ST + (((size_t)u * 16 + gi) * 64 + p) * 2), s1 = *(const f32x2*)(ST + (((size_t)u * 16 + gi + 8) * 64 + p) * 2);
        float x0r = s0.x, x0i = s0.y, x1r = s1.x, x1i = s1.y;
        __syncthreads();
        for (int tb = 0; tb < 64; tb += 8) {
#pragma unroll 2
            for (int tt = 0; tt < 8; ++tt) { const int t = tb + tt;
                s5_step(P0, us + t * 256 + gi * 16, x0r, x0i); s5_step(P1, us + t * 256 + (gi + 8) * 16, x1r, x1i);
                xrr[tt * 1024 + gi * 64 + p] = x0r; xir[tt * 1024 + gi * 64 + p] = x0i; xrr[tt * 1024 + (gi + 8) * 64 + p] = x1r; xir[tt * 1024 + (gi + 8) * 64 + p] = x1i; }
            __syncthreads();
            {
                float y[4] = {0.f, 0.f, 0.f, 0.f};
                asm volatile("" ::: "memory");
#pragma unroll 2
                for (int p4 = 0; p4 < 16; ++p4) { const f32x4 c_r = *(const GAS f32x4*)(cre + 4 * p4), c_i = *(const GAS f32x4*)(cim + 4 * p4);
#pragma unroll
                    for (int k = 0; k < 4; ++k) { const int tt = 4 * th + k; const f32x4 vr = *(const LAS f32x4*)(xrr + tt * 1024 + og * 64 + 4 * p4), vi = *(const LAS f32x4*)(xir + tt * 1024 + og * 64 + 4 * p4);
                        y[k] += (c_r.x * vr.x + c_r.y * vr.y + c_r.z * vr.z + c_r.w * vr.w) - (c_i.x * vi.x + c_i.y * vi.y + c_i.z * vi.z + c_i.w * vi.w); } }
#pragma unroll
                for (int k = 0; k < 4; ++k) { const int t = tb + 4 * th + k; const float yy = y[k] + dv * us[t * 256 + ch]; us[t * 256 + ch] = gelu_tanh_(yy); }
            }
            __syncthreads();
        }
        {
            const float* gw = a->in[I_S5GLUW] + (size_t)l * DC * DC + ch; const float gb = a->in[I_S5GLUB][l * DC + ch];
            for (int hf = 0; hf < 2; ++hf) {
            float acc[16];
#pragma unroll
            for (int k = 0; k < 16; ++k) acc[k] = 0.f;
#pragma unroll 1
            for (int i4 = 0; i4 < 64; ++i4) { const float w0 = gw[(size_t)(4 * i4) * DC], w1 = gw[(size_t)(4 * i4 + 1) * DC], w2 = gw[(size_t)(4 * i4 + 2) * DC], w3 = gw[(size_t)(4 * i4 + 3) * DC];
#pragma unroll
                for (int k = 0; k < 16; ++k) { const f32x4 z = *(const LAS f32x4*)(us + (32 * th + 16 * hf + k) * 256 + 4 * i4); acc[k] += z.x * w0 + z.y * w1 + z.z * w2 + z.w * w3; } }
#pragma unroll
            for (int k = 0; k < 16; ++k) { const int t = 32 * th + 16 * hf + k; const float z = us[t * 256 + ch]; YC[(row0 + t) * DM + 768 + ch] = (bf16)f2bf(z * sigmoidf_(acc[k] + gb)); }
            }
        }
    }
}

__device__ __forceinline__ float rw_shift(const bf16* PROJ, const float* mu, size_t row, int col) {
    const float cur = bf2f(PROJ[row * NPROJ + PC_RW + col]); const float prv = (row % SEQ) ? bf2f(PROJ[(row - 1) * NPROJ + PC_RW + col]) : 0.f;
    return cur + mu[col] * (prv - cur);
}
__device__ __forceinline__ void phase_r1(KArgsP a, LAS unsigned char* lds, int tid, int vcu, int G, int l) {
    unsigned char* ws = a->ws; const bf16* PROJ = (const bf16*)(ws + WS_PROJ); const float* mu = a->in[I_RMU] + (size_t)l * RW_COLS;
    bf16* RE = (bf16*)(ws + WS_RE); bf16* RA = (bf16*)(ws + WS_RA); bf16* RG = (bf16*)(ws + WS_RG); bf16* RVG = (bf16*)(ws + WS_RVG);
    LAS float* th = (LAS float*)lds; LAS float* ads = th + 32 * 64; LAS float* sgs = ads + 32 * 64; LAS float* vsh = sgs + 32 * 128; LAS float* tmp = vsh + 32 * 384;
    const int cg = tid & 127, tq = tid >> 7;
    for (int u = vcu; u < NTOK / 32; u += G) {
        const size_t row0 = (size_t)u * 32;
        __syncthreads();
        for (int idx = tid; idx < 32 * 256; idx += NTHR) { const int tt = idx >> 8, col = idx & 255; const float xs = rw_shift(PROJ, mu, row0 + tt, RWC_WD + col);
            if (col < 64) th[tt * 64 + col] = tanhf(xs); else if (col < 128) ads[tt * 64 + col - 64] = xs; else sgs[tt * 128 + col - 128] = sigmoidf_(xs); }
        if (l > 0) for (int idx = tid; idx < 32 * 384; idx += NTHR) { const int tt = idx / 384, col = idx % 384; vsh[idx] = rw_shift(PROJ, mu, row0 + tt, RWC_V + col); }
        __syncthreads();
        float acc[3][8];
#pragma unroll
        for (int ci = 0; ci < 3; ++ci)
#pragma unroll
            for (int k = 0; k < 8; ++k) acc[ci][k] = 0.f;
        { const float* W = a->in[I_RWUP] + (size_t)l * 64 * DBR + cg;
#pragma unroll 2
          for (int j = 0; j < 64; ++j) { const float w0 = W[j * DBR], w1 = W[j * DBR + 128], w2 = W[j * DBR + 256];
#pragma unroll
              for (int k = 0; k < 8; ++k) { const float av = th[(tq * 8 + k) * 64 + j]; acc[0][k] += av * w0; acc[1][k] += av * w1; acc[2][k] += av * w2; } } }
#pragma unroll
        for (int ci = 0; ci < 3; ++ci) { const int c = cg + 128 * ci; const float w0 = a->in[I_RW0][l * DBR + c];
#pragma unroll
            for (int k = 0; k < 8; ++k) RE[(row0 + tq * 8 + k) * DBR + c] = (bf16)f2bf(0.60653066f * sigmoidf_(w0 + acc[ci][k])); }
#pragma unroll
        for (int ci = 0; ci < 3; ++ci)
#pragma unroll
            for (int k = 0; k < 8; ++k) acc[ci][k] = 0.f;
        { const float* W = a->in[I_RAUP] + (size_t)l * 64 * DBR + cg;
#pragma unroll 2
          for (int j = 0; j < 64; ++j) { const float w0 = W[j * DBR], w1 = W[j * DBR + 128], w2 = W[j * DBR + 256];
#pragma unroll
              for (int k = 0; k < 8; ++k) { const float av = ads[(tq * 8 + k) * 64 + j]; acc[0][k] += av * w0; acc[1][k] += av * w1; acc[2][k] += av * w2; } } }
#pragma unroll
        for (int ci = 0; ci < 3; ++ci) { const int c = cg + 128 * ci; const float a0 = a->in[I_RA0][l * DBR + c];
#pragma unroll
            for (int k = 0; k < 8; ++k) RA[(row0 + tq * 8 + k) * DBR + c] = (bf16)f2bf(sigmoidf_(a0 + acc[ci][k])); }
#pragma unroll
        for (int ci = 0; ci < 3; ++ci)
#pragma unroll
            for (int k = 0; k < 8; ++k) acc[ci][k] = 0.f;
        { const float* W = a->in[I_RGUP] + (size_t)l * 128 * DBR + cg;
#pragma unroll 2
          for (int j = 0; j < 128; ++j) { const float w0 = W[j * DBR], w1 = W[j * DBR + 128], w2 = W[j * DBR + 256];
#pragma unroll
              for (int k = 0; k < 8; ++k) { const float av = sgs[(tq * 8 + k) * 128 + j]; acc[0][k] += av * w0; acc[1][k] += av * w1; acc[2][k] += av * w2; } } }
#pragma unroll
        for (int ci = 0; ci < 3; ++ci) { const int c = cg + 128 * ci;
#pragma unroll
            for (int k = 0; k < 8; ++k) RG[(row0 + tq * 8 + k) * DBR + c] = (bf16)f2bf(acc[ci][k]); }
        if (l > 0) {
            { const int tt = tid >> 4, m2 = tid & 15; const float* W = a->in[I_RVDN] + m2; float s0 = 0.f, s1 = 0.f;
#pragma unroll 4
              for (int i = 0; i < 384; ++i) { const float v = vsh[tt * 384 + i]; s0 += v * W[i * 32]; s1 += v * W[i * 32 + 16]; }
              tmp[tt * 32 + m2] = s0; tmp[tt * 32 + m2 + 16] = s1; }
            __syncthreads();
#pragma unroll
            for (int ci = 0; ci < 3; ++ci)
#pragma unroll
                for (int k = 0; k < 8; ++k) acc[ci][k] = 0.f;
            { const float* W = a->in[I_RVUP] + cg;
#pragma unroll 2
              for (int j = 0; j < 32; ++j) { const float w0 = W[j * DBR], w1 = W[j * DBR + 128], w2 = W[j * DBR + 256];
#pragma unroll
                  for (int k = 0; k < 8; ++k) { const float av = tmp[(tq * 8 + k) * 32 + j]; acc[0][k] += av * w0; acc[1][k] += av * w1; acc[2][k] += av * w2; } } }
#pragma unroll
            for (int ci = 0; ci < 3; ++ci) { const int c = cg + 128 * ci; const float v0 = a->in[I_RV0][c];
#pragma unroll
                for (int k = 0; k < 8; ++k) RVG[(row0 + tq * 8 + k) * DBR + c] = (bf16)f2bf(sigmoidf_(v0 + acc[ci][k])); }
        }
    }
}
__device__ __forceinline__ float dpp_allsum(float x) {
    x += __builtin_bit_cast(float, __builtin_amdgcn_update_dpp(0, __builtin_bit_cast(int, x), 0x128, 0xf, 0xf, false));
    x += __builtin_bit_cast(float, __builtin_amdgcn_update_dpp(0, __builtin_bit_cast(int, x), 0x124, 0xf, 0xf, false));
    x += __builtin_bit_cast(float, __builtin_amdgcn_update_dpp(0, __builtin_bit_cast(int, x), 0x122, 0xf, 0xf, false));
    x += __builtin_bit_cast(float, __builtin_amdgcn_update_dpp(0, __builtin_bit_cast(int, x), 0x121, 0xf, 0xf, false));
    { const unsigned xi = __builtin_bit_cast(unsigned, x); auto r = __builtin_amdgcn_permlane16_swap(xi, xi, false, false); const unsigned r0 = r[0], r1 = r[1]; x = __uint_as_float(r0) + __uint_as_float(r1); }
    { const unsigned xi = __builtin_bit_cast(unsigned, x); auto r = __builtin_amdgcn_permlane32_swap(xi, xi, false, false); const unsigned r0 = r[0], r1 = r[1]; x = __uint_as_float(r0) + __uint_as_float(r1); }
    return x;
}
constexpr int R2_TC = 16, R2_PAR = R2_TC * 32 * 12, R2_YP = R2_TC * 4 * 64;
struct R2Regs { v2u r0, r1, k0, k1; v2u aa, ee; unsigned vc, vp, vg, vf; };
__device__ __forceinline__ float allsum32(float x) {
    x += __builtin_bit_cast(float, __builtin_amdgcn_update_dpp(0, __builtin_bit_cast(int, x), 0x128, 0xf, 0xf, false));
    x += __builtin_bit_cast(float, __builtin_amdgcn_update_dpp(0, __builtin_bit_cast(int, x), 0x124, 0xf, 0xf, false));
    x += __builtin_bit_cast(float, __builtin_amdgcn_update_dpp(0, __builtin_bit_cast(int, x), 0x122, 0xf, 0xf, false));
    x += __builtin_bit_cast(float, __builtin_amdgcn_update_dpp(0, __builtin_bit_cast(int, x), 0x121, 0xf, 0xf, false));
    { const unsigned xi = __builtin_bit_cast(unsigned, x); auto r = __builtin_amdgcn_permlane16_swap(xi, xi, false, false); const unsigned r0 = r[0], r1 = r[1]; x = __uint_as_float(r0) + __uint_as_float(r1); }
    return x;
}
__device__ __forceinline__ void r2_issue(const unsigned char* ws, int l, size_t row, int h, int sl, int lt, R2Regs& R) {
    const bf16* PROJ = (const bf16*)(ws + WS_PROJ);
    const int tt = lt >> 4, kq = lt & 15; const size_t r = row + tt; const bool first = (r % SEQ) == 0; const size_t rp = first ? r : r - 1;
    R.r0 = *(const GAS v2u*)(PROJ + r * NPROJ + PC_RW + RWC_R + h * 64 + kq * 4); R.r1 = *(const GAS v2u*)(PROJ + rp * NPROJ + PC_RW + RWC_R + h * 64 + kq * 4);
    R.k0 = *(const GAS v2u*)(PROJ + r * NPROJ + PC_RW + RWC_K + h * 64 + kq * 4); R.k1 = *(const GAS v2u*)(PROJ + rp * NPROJ + PC_RW + RWC_K + h * 64 + kq * 4);
    R.aa = *(const GAS v2u*)((const bf16*)(ws + WS_RA) + r * DBR + h * 64 + kq * 4); R.ee = *(const GAS v2u*)((const bf16*)(ws + WS_RE) + r * DBR + h * 64 + kq * 4);
    if (first) { R.r1 = (v2u){0u, 0u}; R.k1 = (v2u){0u, 0u}; }
    if (lt < 128) { const int t2 = lt >> 3, rr = lt & 7; const size_t q = row + t2; const bool f2 = (q % SEQ) == 0; const int vcol = h * 64 + sl * 8 + rr;
        R.vc = PROJ[q * NPROJ + PC_RW + RWC_V + vcol]; R.vp = f2 ? 0u : (unsigned)PROJ[(q - 1) * NPROJ + PC_RW + RWC_V + vcol];
        if (l > 0) { R.vg = ((const bf16*)(ws + WS_RVG))[q * DBR + vcol]; R.vf = ((const bf16*)(ws + WS_VF))[q * DBR + vcol]; } }
}
__device__ __forceinline__ void r2_prep(KArgsP a, int l, size_t row, int h, int sl, int lt, const R2Regs& R, LAS float* par, LAS float* vb) {
    const int tt = lt >> 4, kq = lt & 15, c0 = h * 64 + kq * 4;
    const float* mu = a->in[I_RMU] + (size_t)l * RW_COLS; const float* kkw = a->in[I_RKK] + (size_t)l * DBR + c0; const float* kaw = a->in[I_RKA] + (size_t)l * DBR + c0;
    const float rc[4] = {bflo(R.r0.x), bfhi(R.r0.x), bflo(R.r0.y), bfhi(R.r0.y)}, rp[4] = {bflo(R.r1.x), bfhi(R.r1.x), bflo(R.r1.y), bfhi(R.r1.y)};
    const float kc[4] = {bflo(R.k0.x), bfhi(R.k0.x), bflo(R.k0.y), bfhi(R.k0.y)}, kp[4] = {bflo(R.k1.x), bfhi(R.k1.x), bflo(R.k1.y), bfhi(R.k1.y)};
    const float av[4] = {bflo(R.aa.x), bfhi(R.aa.x), bflo(R.aa.y), bfhi(R.aa.y)}, ev[4] = {bflo(R.ee.x), bfhi(R.ee.x), bflo(R.ee.y), bfhi(R.ee.y)};
    float rs[4], ks[4], kk[4], ss = 0.f;
#pragma unroll
    for (int j = 0; j < 4; ++j) { rs[j] = rc[j] + mu[RWC_R + c0 + j] * (rp[j] - rc[j]); ks[j] = kc[j] + mu[RWC_K + c0 + j] * (kp[j] - kc[j]); kk[j] = ks[j] * kkw[j]; ss += kk[j] * kk[j]; }
    ss += __shfl_xor(ss, 1); ss += __shfl_xor(ss, 2); ss += __shfl_xor(ss, 4); ss += __shfl_xor(ss, 8);
    const float inv = 1.f / fmaxf(sqrtf(ss), 1e-12f);
    float w[4], an[4], bk[4], km[4];
#pragma unroll
    for (int j = 0; j < 4; ++j) { const float kn = kk[j] * inv; w[j] = __expf(-ev[j]); an[j] = -kn; bk[j] = kn * av[j]; km[j] = ks[j] * (1.f + (av[j] - 1.f) * kaw[j]); }
    LAS float* rec = par + (tt * 32 + 2 * kq) * 12;
    *(LAS f32x4*)(rec) = (f32x4){w[0], w[1], an[0], an[1]}; *(LAS f32x4*)(rec + 4) = (f32x4){bk[0], bk[1], km[0], km[1]}; *(LAS f32x4*)(rec + 8) = (f32x4){rs[0], rs[1], 0.f, 0.f};
    *(LAS f32x4*)(rec + 12) = (f32x4){w[2], w[3], an[2], an[3]}; *(LAS f32x4*)(rec + 16) = (f32x4){bk[2], bk[3], km[2], km[3]}; *(LAS f32x4*)(rec + 20) = (f32x4){rs[2], rs[3], 0.f, 0.f};
    if (lt < 128) { const int t2 = lt >> 3, rr = lt & 7, vcol = h * 64 + sl * 8 + rr; const float vc = bf2f(R.vc), vp = bf2f(R.vp);
        float v = vc + mu[RWC_V + vcol] * (vp - vc);
        if (l == 0) ((bf16*)(a->ws + WS_VF))[(row + t2) * DBR + vcol] = (bf16)f2bf(v);
        else { v = v + (bf2f(R.vf) - v) * bf2f(R.vg); }
        vb[t2 * 8 + rr] = v; }
}
__device__ __forceinline__ void r2_yreduce(unsigned char* ws, size_t row, int h, int sl, int lt, const LAS float* yp) {
    if (lt < 128) { const int t2 = lt >> 3, rr = lt & 7; const LAS float* src = yp + (t2 * 4 + (rr >> 1)) * 64 + (rr & 1) * 32; float s = 0.f;
#pragma unroll
        for (int q = 0; q < 8; ++q) { const f32x4 v = *(const LAS f32x4*)(src + 4 * q); s += (v.x + v.y) + (v.z + v.w); }
        ((bf16*)(ws + WS_YC))[(row + t2) * DM + 384 + h * 64 + sl * 8 + rr] = (bf16)f2bf(s); }
}
__device__ __forceinline__ void r2_scan(const LAS float* par, const LAS float* vb, LAS float* yp, int lane, int wave, float& s0, float& s1) {
    const int kp = lane & 31, row = 2 * wave + (lane >> 5);
#pragma unroll 4
    for (int t = 0; t < R2_TC; ++t) {
        const LAS float* rec = par + (t * 32 + kp) * 12;
        const f32x4 p0 = *(const LAS f32x4*)rec, p1 = *(const LAS f32x4*)(rec + 4); const f32x2 p2 = *(const LAS f32x2*)(rec + 8);
        const float vv = vb[t * 8 + row];
        const float sa = allsum32(fmaf(s1, p0.w, s0 * p0.z));
        const float t0 = fmaf(s0, p0.x, vv * p1.z), t1 = fmaf(s1, p0.y, vv * p1.w);
        s0 = fmaf(sa, p1.x, t0); s1 = fmaf(sa, p1.y, t1);
        yp[(t * 4 + wave) * 64 + lane] = fmaf(s1, p2.y, s0 * p2.x);
    }
}
__device__ __forceinline__ void phase_r2(KArgsP a, LAS unsigned char* lds, int tid, int lane, int wave, int wg, int l) {
    unsigned char* ws = a->ws;
    LAS float* PAR0 = (LAS float*)lds; LAS float* PAR1 = PAR0 + R2_PAR; LAS float* V0 = PAR1 + R2_PAR; LAS float* V1 = V0 + 128; LAS float* YP0 = V1 + 128; LAS float* YP1 = YP0 + R2_YP;
    const int b = wg / 48, h = (wg % 48) >> 3, sl = wg & 7; const size_t rowb = (size_t)b * SEQ;
    const bool loader = wave >= 4; const int lt = tid - 256;
    constexpr int NC = SEQ / R2_TC;
    R2Regs RA, RB;
    if (loader) { r2_issue(ws, l, rowb, h, sl, lt, RA); r2_prep(a, l, rowb, h, sl, lt, RA, PAR0, V0); r2_issue(ws, l, rowb + R2_TC, h, sl, lt, RA); }
    __syncthreads();
    float s0 = 0.f, s1 = 0.f;
    for (int c = 0; c < NC; c += 2) {
        if (!loader) r2_scan(PAR0, V0, YP0, lane, wave, s0, s1);
        else { if (c + 2 < NC) r2_issue(ws, l, rowb + (size_t)(c + 2) * R2_TC, h, sl, lt, RB);
               r2_prep(a, l, rowb + (size_t)(c + 1) * R2_TC, h, sl, lt, RA, PAR1, V1);
               if (c > 0) r2_yreduce(ws, rowb + (size_t)(c - 1) * R2_TC, h, sl, lt, YP1); }
        __syncthreads();
        if (!loader) r2_scan(PAR1, V1, YP1, lane, wave, s0, s1);
        else { if (c + 3 < NC) r2_issue(ws, l, rowb + (size_t)(c + 3) * R2_TC, h, sl, lt, RA);
               if (c + 2 < NC) r2_prep(a, l, rowb + (size_t)(c + 2) * R2_TC, h, sl, lt, RB, PAR0, V0);
               r2_yreduce(ws, rowb + (size_t)c * R2_TC, h, sl, lt, YP0); }
        __syncthreads();
    }
    if (loader) r2_yreduce(ws, rowb + (size_t)(NC - 1) * R2_TC, h, sl, lt, YP1);
}
__device__ __forceinline__ void phase_r3(KArgsP a, int lane, int gw, int ngw, int l) {
    unsigned char* ws = a->ws; const bf16* PROJ = (const bf16*)(ws + WS_PROJ); bf16* YC = (bf16*)(ws + WS_YC);
    const bf16* RA = (const bf16*)(ws + WS_RA); const bf16* RG = (const bf16*)(ws + WS_RG); const bf16* RVG = (const bf16*)(ws + WS_RVG); const bf16* VF = (const bf16*)(ws + WS_VF);
    const float* mu = a->in[I_RMU] + (size_t)l * RW_COLS;
    for (size_t row = gw; row < NTOK; row += ngw) {
#pragma unroll 2
        for (int h = 0; h < NH; ++h) {
            const int c = h * 64 + lane;
            const float y = bf2f(YC[row * DM + 384 + c]);
            const float m = dpp_allsum(y) * (1.f / 64.f); const float d = y - m; const float var = dpp_allsum(d * d) * (1.f / 64.f);
            const float yn = d * rsqrtf(var + RWKV_GN_EPS) * a->in[I_RLNW][l * DBR + c] + a->in[I_RLNB][l * DBR + c];
            const float rs = rw_shift(PROJ, mu, row, RWC_R + c), ks = rw_shift(PROJ, mu, row, RWC_K + c); float v = rw_shift(PROJ, mu, row, RWC_V + c);
            if (l > 0) v = v + (bf2f(VF[row * DBR + c]) - v) * bf2f(RVG[row * DBR + c]);
            const float av = bf2f(RA[row * DBR + c]);
            const float km = ks * (1.f + (av - 1.f) * a->in[I_RKA][l * DBR + c]);
            const float rk = dpp_allsum(rs * km * a->in[I_RRK][l * DBR + c]);
            YC[row * DM + 384 + c] = (bf16)f2bf((yn + rk * v) * bf2f(RG[row * DBR + c]));
        }
    }
}

constexpr int PH_PER_LAYER = 10, PH_FINAL = 1 + 2 * PH_PER_LAYER, N_PHASES = PH_FINAL + 1;
constexpr int R2_WGS = 192;
__global__ void __launch_bounds__(NTHR, 2) fwd(Args args) {
    extern __shared__ __attribute__((aligned(16))) unsigned char lds_raw[];
    LAS unsigned char* lds = (LAS unsigned char*)lds_raw;
    volatile LAS unsigned* MISC = (volatile LAS unsigned*)(lds + MISC_OFF);
    const int tid0 = threadIdx.x;
    const int G = gridDim.x;
#define PHASE_IDS int tid_ = threadIdx.x; asm volatile("" : "+v"(tid_)); const int tid = tid_, lane = tid & 63, wave = __builtin_amdgcn_readfirstlane(tid >> 6); \
    int bx_ = blockIdx.x; asm volatile("" : "+s"(bx_)); const int bx = bx_; const int vcu = (G % 8 == 0) ? (bx % 8) * (G / 8) + bx / 8 : bx; (void)lane; (void)wave; (void)vcu; (void)bx;
    unsigned char* ws0 = fresh_args()->ws;
    for (int u = tid0; u < (LDS_BYTES - RING_BYTES) / 4; u += NTHR) ((LAS unsigned*)(lds + RING_BYTES))[u] = 0u;
    __syncthreads();
    XcdBarrier bar; bar.bar = (unsigned*)(ws0 + WS_CTL) + CW_BAR; bar.x = 0; bar.st = nullptr;
    if (!MK_PER_PHASE) bar = xcd_barrier_post((unsigned*)(ws0 + WS_CTL) + CW_BAR, MISC + 8);
#if MK_PER_PHASE
    const int lo = args.ph_lo, hi = args.ph_hi;
#define IN(k) (lo <= (k) && (k) < hi)
#else
#define IN(k) true
#endif
#define SEAM(k) do { if (IN(k) && IN((k) + 1)) { XcdBarrier b2 = bar; asm volatile("" : "+s"(b2.bar)); xcd_barrier(b2); } } while (0)

#ifndef DBL_SUB
#define DBL_SUB 0
#endif
#ifndef DBL_PHASE
#define DBL_PHASE (-1)
#endif
#ifndef REPN
#define REPN 2
#endif
#define REP(k) for (int rep_ = 0; rep_ < ((k) == DBL_PHASE ? REPN : 1); ++rep_)
#define REPBAR if (rep_ > 0) { XcdBarrier b2 = bar; asm volatile("" : "+s"(b2.bar)); xcd_barrier(b2); }
    REP(0) if (IN(0)) { REPBAR KArgsP ap = fresh_args(); PHASE_IDS phase_prologue(ap, lds, tid, lane, wave, vcu, G); }
    SEAM(0);
#define LCONST 0
    {
        constexpr int l = LCONST; constexpr int pb = 1 + l * PH_PER_LAYER;
        REP(pb + 0) if (IN(pb + 0)) { REPBAR KArgsP ap = fresh_args(); PHASE_IDS unsigned char* ws = ap->ws; (void)ws;
            if (l == 0) { mod_finalize(ws, tid, G); phase_rownorm<0, false>(ap, lds, tid, lane, wave, G, ap->in[I_X], ap->out, ap->in[I_NORM_MIX], true, 0, 0, 0); }
            else {
#if EN_MOE
                phase_rownorm<0, true>(ap, lds, tid, lane, wave, G, ap->out, ap->out, ap->in[I_NORM_MIX] + l * DM, false, l, 0, l - 1);
#else
                phase_rownorm<0, false>(ap, lds, tid, lane, wave, G, ap->out, ap->out, ap->in[I_NORM_MIX] + l * DM, false, l, 0, l - 1);
#endif
            }
        }
        SEAM(pb + 0);
        REP(pb + 1) if (IN(pb + 1)) { REPBAR KArgsP ap = fresh_args(); PHASE_IDS unsigned char* ws = ap->ws; (void)ws;
            pg8::Gemm g{(const pg8::bf16_t*)(ws + WS_HN), (const pg8::bf16_t*)(ws + WS_WIN) + (size_t)l * NPROJ_PAD * DM, NTOK, NPROJ_PAD, DM};
            pg8::StaticOrder S; S.init(NTOK, NPROJ_PAD, G, bx);
            pg8::EpiProj E{(pg8::bf16_t*)(ws + WS_PROJ), (float*)(ws + WS_GATES)};
            pg8::gemm_phase<pg8::EpiProj, pg8::StaticOrder, true, true>(lds, g, S, E);
        }
        SEAM(pb + 1);
        REP(pb + 2) if (IN(pb + 2)) { REPBAR KArgsP ap = fresh_args(); PHASE_IDS unsigned char* ws = ap->ws; (void)ws;
#if EN_MLSTM
            for (int q_ = 0; q_ < 1 + ((DBL_SUB == 1) && l == 0); ++q_) { phase_m1(ap, lds, tid, lane, wave, vcu, G, l); __syncthreads(); }
            __syncthreads();
#endif
#if EN_S5
            for (int q_ = 0; q_ < 1 + ((DBL_SUB == 2) && l == 0); ++q_) { phase_s1(ap, lds, tid, vcu, G, l); __syncthreads(); }
            __syncthreads();
#endif
#if EN_RWKV
            for (int q_ = 0; q_ < 1 + ((DBL_SUB == 3) && l == 0); ++q_) { phase_r1(ap, lds, tid, vcu, G, l); __syncthreads(); }
#endif
        }
        SEAM(pb + 2);
        REP(pb + 3) if (IN(pb + 3)) { REPBAR KArgsP ap = fresh_args(); PHASE_IDS unsigned char* ws = ap->ws; (void)ws;
            if (vcu < R2_WGS) {
#if EN_RWKV
                for (int q_ = 0; q_ < 1 + ((DBL_SUB == 4) && l == 0); ++q_) { phase_r2(ap, lds, tid, lane, wave, vcu, l); __syncthreads(); }
#endif
            } else {
                const int wg = vcu - R2_WGS, nwg = G - R2_WGS;
#if EN_MLSTM
                phase_m2(ws, tid, wg, nwg);
#endif
#if EN_S5
                phase_s2(ap, tid, wg, nwg, l);
#endif
#if EN_MOE
                if (l == 1) moe_convert(ap->in[I_MW1], ap->in[I_MW3], ap->in[I_MW2], 1, (bf16*)(ws + WS_W13), (bf16*)(ws + WS_W2), wg * NWAVES + wave, nwg * NWAVES, (LAS float*)(lds + wave * 16384), lane);
#endif
            }
        }
        SEAM(pb + 3);
        REP(pb + 4) if (IN(pb + 4)) { REPBAR KArgsP ap = fresh_args(); PHASE_IDS unsigned char* ws = ap->ws; (void)ws;
#if EN_MLSTM
            for (int q_ = 0; q_ < 1 + ((DBL_SUB == 5) && l == 0); ++q_) { phase_m3(ap, lds, tid, lane, wave, vcu, G, l); __syncthreads(); }
            __syncthreads();
#else
            for (size_t i = (size_t)vcu * NTHR + tid; i < (size_t)NTOK * 384; i += (size_t)G * NTHR) ((bf16*)(ws + WS_YC))[(i / 384) * DM + (i % 384)] = 0;
#endif
#if EN_S5
            for (int q_ = 0; q_ < 1 + ((DBL_SUB == 6) && l == 0); ++q_) { phase_s3(ap, lds, tid, vcu, G, l); __syncthreads(); }
#else
            for (size_t i = (size_t)vcu * NTHR + tid; i < (size_t)NTOK * 256; i += (size_t)G * NTHR) ((bf16*)(ws + WS_YC))[(i / 256) * DM + 768 + (i % 256)] = 0;
#endif
#if EN_RWKV
            phase_r3(ap, lane, vcu * NWAVES + wave, G * NWAVES, l);
#else
            for (size_t i = (size_t)vcu * NTHR + tid; i < (size_t)NTOK * 384; i += (size_t)G * NTHR) ((bf16*)(ws + WS_YC))[(i / 384) * DM + 384 + (i % 384)] = 0;
#endif
        }
        SEAM(pb + 4);
        REP(pb + 5) if (IN(pb + 5)) { REPBAR KArgsP ap = fresh_args(); PHASE_IDS unsigned char* ws = ap->ws; (void)ws;
            pg8::Gemm g{(const pg8::bf16_t*)(ws + WS_YC), (const pg8::bf16_t*)(ws + WS_WOUT) + (size_t)l * DM * DM, NTOK, DM, DM};
            pg8::StaticOrder S; S.init(NTOK, DM, G, bx);
            pg8::EpiResid E{l == 0 ? ap->in[I_X] : (const float*)ap->out, ap->out, (const float*)(ws + WS_MODF) + (size_t)l * 4 * 6144, 2048};
            pg8::gemm_phase<pg8::EpiResid, pg8::StaticOrder, true, true>(lds, g, S, E);
        }
        SEAM(pb + 5);
#if EN_MOE
        REP(pb + 6) if (IN(pb + 6)) { REPBAR KArgsP ap = fresh_args(); PHASE_IDS phase_router(ap, lds, tid, lane, wave, G, l); }
        SEAM(pb + 6);
        REP(pb + 7) if (IN(pb + 7)) { REPBAR KArgsP ap = fresh_args(); PHASE_IDS phase_gather(ap, lds, tid, lane, wave, vcu, G, l); }
        SEAM(pb + 7);
        REP(pb + 8) if (IN(pb + 8)) { REPBAR KArgsP ap = fresh_args(); PHASE_IDS unsigned char* ws = ap->ws; (void)ws;
            LAS int* ptab = (LAS int*)(lds + RING_BYTES + 1024); LAS int* pst = ptab + 512; LAS int* cnt = pst + 32;
            build_ptab((const unsigned*)(ws + WS_CTL) + CW_CNT + l * 32, ptab, pst, cnt, tid);
            pg8::Gemm g{(const pg8::bf16_t*)(ws + WS_XG), (const pg8::bf16_t*)(ws + WS_W13), 0, 0, DM};
            pg8::MoeOrder S{ptab, G, vcu};
            pg8::EpiSwiglu E{(pg8::bf16_t*)(ws + WS_HMID)};
            pg8::gemm_phase<pg8::EpiSwiglu, pg8::MoeOrder, true, true>(lds, g, S, E);
        }
        SEAM(pb + 8);
        REP(pb + 9) if (IN(pb + 9)) { REPBAR KArgsP ap = fresh_args(); PHASE_IDS unsigned char* ws = ap->ws; (void)ws;
            LAS int* ptab = (LAS int*)(lds + RING_BYTES + 1024); LAS int* pst = ptab + 512; LAS int* cnt = pst + 32;
            build_ptab((const unsigned*)(ws + WS_CTL) + CW_CNT + l * 32, ptab, pst, cnt, tid);
            pg8::Gemm g{(const pg8::bf16_t*)(ws + WS_HMID), (const pg8::bf16_t*)(ws + WS_W2), 0, 0, DEXP};
            pg8::MoeOrder S{ptab, G, vcu};
            pg8::EpiMoeOut E{(pg8::bf16_t*)(ws + WS_YMOE), (const int*)(ws + WS_ROWMAP)};
            pg8::gemm_phase<pg8::EpiMoeOut, pg8::MoeOrder, true, true>(lds, g, S, E);
        }
        SEAM(pb + 9);
#else
        SEAM(pb + 6); SEAM(pb + 7); SEAM(pb + 8); SEAM(pb + 9);
#endif
    }
#undef LCONST
#if N_LAYERS > 1
#define LCONST 1
    {
        constexpr int l = LCONST; constexpr int pb = 1 + l * PH_PER_LAYER;
        REP(pb + 0) if (IN(pb + 0)) { REPBAR KArgsP ap = fresh_args(); PHASE_IDS unsigned char* ws = ap->ws; (void)ws;
            if (l == 0) { mod_finalize(ws, tid, G); phase_rownorm<0, false>(ap, lds, tid, lane, wave, G, ap->in[I_X], ap->out, ap->in[I_NORM_MIX], true, 0, 0, 0); }
            else {
#if EN_MOE
                phase_rownorm<0, true>(ap, lds, tid, lane, wave, G, ap->out, ap->out, ap->in[I_NORM_MIX] + l * DM, false, l, 0, l - 1);
#else
                phase_rownorm<0, false>(ap, lds, tid, lane, wave, G, ap->out, ap->out, ap->in[I_NORM_MIX] + l * DM, false, l, 0, l - 1);
#endif
            }
        }
        SEAM(pb + 0);
        REP(pb + 1) if (IN(pb + 1)) { REPBAR KArgsP ap = fresh_args(); PHASE_IDS unsigned char* ws = ap->ws; (void)ws;
            pg8::Gemm g{(const pg8::bf16_t*)(ws + WS_HN), (const pg8::bf16_t*)(ws + WS_WIN) + (size_t)l * NPROJ_PAD * DM, NTOK, NPROJ_PAD, DM};
            pg8::StaticOrder S; S.init(NTOK, NPROJ_PAD, G, bx);
            pg8::EpiProj E{(pg8::bf16_t*)(ws + WS_PROJ), (float*)(ws + WS_GATES)};
            pg8::gemm_phase<pg8::EpiProj, pg8::StaticOrder, true, true>(lds, g, S, E);
        }
        SEAM(pb + 1);
        REP(pb + 2) if (IN(pb + 2)) { REPBAR KArgsP ap = fresh_args(); PHASE_IDS unsigned char* ws = ap->ws; (void)ws;
#if EN_MLSTM
            for (int q_ = 0; q_ < 1 + ((DBL_SUB == 1) && l == 0); ++q_) { phase_m1(ap, lds, tid, lane, wave, vcu, G, l); __syncthreads(); }
            __syncthreads();
#endif
#if EN_S5
            for (int q_ = 0; q_ < 1 + ((DBL_SUB == 2) && l == 0); ++q_) { phase_s1(ap, lds, tid, vcu, G, l); __syncthreads(); }
            __syncthreads();
#endif
#if EN_RWKV
            for (int q_ = 0; q_ < 1 + ((DBL_SUB == 3) && l == 0); ++q_) { phase_r1(ap, lds, tid, vcu, G, l); __syncthreads(); }
#endif
        }
        SEAM(pb + 2);
        REP(pb + 3) if (IN(pb + 3)) { REPBAR KArgsP ap = fresh_args(); PHASE_IDS unsigned char* ws = ap->ws; (void)ws;
            if (vcu < R2_WGS) {
#if EN_RWKV
                for (int q_ = 0; q_ < 1 + ((DBL_SUB == 4) && l == 0); ++q_) { phase_r2(ap, lds, tid, lane, wave, vcu, l); __syncthreads(); }
#endif
            } else {
                const int wg = vcu - R2_WGS, nwg = G - R2_WGS;
#if EN_MLSTM
                phase_m2(ws, tid, wg, nwg);
#endif
#if EN_S5
                phase_s2(ap, tid, wg, nwg, l);
#endif
#if EN_MOE
                if (l == 1) moe_convert(ap->in[I_MW1], ap->in[I_MW3], ap->in[I_MW2], 1, (bf16*)(ws + WS_W13), (bf16*)(ws + WS_W2), wg * NWAVES + wave, nwg * NWAVES, (LAS float*)(lds + wave * 16384), lane);
#endif
            }
        }
        SEAM(pb + 3);
        REP(pb + 4) if (IN(pb + 4)) { REPBAR KArgsP ap = fresh_args(); PHASE_IDS unsigned char* ws = ap->ws; (void)ws;
#if EN_MLSTM
            for (int q_ = 0; q_ < 1 + ((DBL_SUB == 5) && l == 0); ++q_) { phase_m3(ap, lds, tid, lane, wave, vcu, G, l); __syncthreads(); }
            __syncthreads();
#else
            for (size_t i = (size_t)vcu * NTHR + tid; i < (size_t)NTOK * 384; i += (size_t)G * NTHR) ((bf16*)(ws + WS_YC))[(i / 384) * DM + (i % 384)] = 0;
#endif
#if EN_S5
            for (int q_ = 0; q_ < 1 + ((DBL_SUB == 6) && l == 0); ++q_) { phase_s3(ap, lds, tid, vcu, G, l); __syncthreads(); }
#else
            for (size_t i = (size_t)vcu * NTHR + tid; i < (size_t)NTOK * 256; i += (size_t)G * NTHR) ((bf16*)(ws + WS_YC))[(i / 256) * DM + 768 + (i % 256)] = 0;
#endif
#if EN_RWKV
            phase_r3(ap, lane, vcu * NWAVES + wave, G * NWAVES, l);
#else
            for (size_t i = (size_t)vcu * NTHR + tid; i < (size_t)NTOK * 384; i += (size_t)G * NTHR) ((bf16*)(ws + WS_YC))[(i / 384) * DM + 384 + (i % 384)] = 0;
#endif
        }
        SEAM(pb + 4);
        REP(pb + 5) if (IN(pb + 5)) { REPBAR KArgsP ap = fresh_args(); PHASE_IDS unsigned char* ws = ap->ws; (void)ws;
            pg8::Gemm g{(const pg8::bf16_t*)(ws + WS_YC), (const pg8::bf16_t*)(ws + WS_WOUT) + (size_t)l * DM * DM, NTOK, DM, DM};
            pg8::StaticOrder S; S.init(NTOK, DM, G, bx);
            pg8::EpiResid E{l == 0 ? ap->in[I_X] : (const float*)ap->out, ap->out, (const float*)(ws + WS_MODF) + (size_t)l * 4 * 6144, 2048};
            pg8::gemm_phase<pg8::EpiResid, pg8::StaticOrder, true, true>(lds, g, S, E);
        }
        SEAM(pb + 5);
#if EN_MOE
        REP(pb + 6) if (IN(pb + 6)) { REPBAR KArgsP ap = fresh_args(); PHASE_IDS phase_router(ap, lds, tid, lane, wave, G, l); }
        SEAM(pb + 6);
        REP(pb + 7) if (IN(pb + 7)) { REPBAR KArgsP ap = fresh_args(); PHASE_IDS phase_gather(ap, lds, tid, lane, wave, vcu, G, l); }
        SEAM(pb + 7);
        REP(pb + 8) if (IN(pb + 8)) { REPBAR KArgsP ap = fresh_args(); PHASE_IDS unsigned char* ws = ap->ws; (void)ws;
            LAS int* ptab = (LAS int*)(lds + RING_BYTES + 1024); LAS int* pst = ptab + 512; LAS int* cnt = pst + 32;
            build_ptab((const unsigned*)(ws + WS_CTL) + CW_CNT + l * 32, ptab, pst, cnt, tid);
            pg8::Gemm g{(const pg8::bf16_t*)(ws + WS_XG), (const pg8::bf16_t*)(ws + WS_W13), 0, 0, DM};
            pg8::MoeOrder S{ptab, G, vcu};
            pg8::EpiSwiglu E{(pg8::bf16_t*)(ws + WS_HMID)};
            pg8::gemm_phase<pg8::EpiSwiglu, pg8::MoeOrder, true, true>(lds, g, S, E);
        }
        SEAM(pb + 8);
        REP(pb + 9) if (IN(pb + 9)) { REPBAR KArgsP ap = fresh_args(); PHASE_IDS unsigned char* ws = ap->ws; (void)ws;
            LAS int* ptab = (LAS int*)(lds + RING_BYTES + 1024); LAS int* pst = ptab + 512; LAS int* cnt = pst + 32;
            build_ptab((const unsigned*)(ws + WS_CTL) + CW_CNT + l * 32, ptab, pst, cnt, tid);
            pg8::Gemm g{(const pg8::bf16_t*)(ws + WS_HMID), (const pg8::bf16_t*)(ws + WS_W2), 0, 0, DEXP};
            pg8::MoeOrder S{ptab, G, vcu};
            pg8::EpiMoeOut E{(pg8::bf16_t*)(ws + WS_YMOE), (const int*)(ws + WS_ROWMAP)};
            pg8::gemm_phase<pg8::EpiMoeOut, pg8::MoeOrder, true, true>(lds, g, S, E);
        }
        SEAM(pb + 9);
#else
        SEAM(pb + 6); SEAM(pb + 7); SEAM(pb + 8); SEAM(pb + 9);
#endif
    }
#undef LCONST
#endif
    if (IN(PH_FINAL)) { KArgsP ap = fresh_args(); PHASE_IDS
#if EN_MOE
        if (N_LAYERS > 0) phase_rownorm<1, true>(ap, lds, tid, lane, wave, G, ap->out, ap->out, ap->in[I_NORM_FINAL], false, 0, 0, N_LAYERS - 1);
        else phase_rownorm<1, false>(ap, lds, tid, lane, wave, G, ap->in[I_X], ap->out, ap->in[I_NORM_FINAL], false, 0, 0, 0);
#else
        phase_rownorm<1, false>(ap, lds, tid, lane, wave, G, N_LAYERS > 0 ? (const float*)ap->out : ap->in[I_X], ap->out, ap->in[I_NORM_FINAL], false, 0, 0, 0);
#endif
    }
#undef IN
#undef SEAM
}

extern "C" void kernel_launch(void* const* d_in, const int* in_sizes, int n_in, void* d_out, int out_size, void* d_ws, size_t ws_size, hipStream_t stream) {
    static int grid = 0;
    if (grid == 0) {
        if (n_in != 47 || out_size != NTOK * DM || ws_size < WS_END) { fprintf(stderr, "kernel_launch: unexpected problem (n_in %d, out %d, ws %zu < %zu)\n", n_in, out_size, ws_size, (size_t)WS_END); grid = -1; return; }
        int dev = 0, cus = 0, per_cu = 0;
        if (hipGetDevice(&dev) != hipSuccess || hipDeviceGetAttribute(&cus, hipDeviceAttributeMultiprocessorCount, dev) != hipSuccess) { grid = -1; return; }
        if (hipFuncSetAttribute((const void*)fwd, hipFuncAttributeMaxDynamicSharedMemorySize, LDS_BYTES) != hipSuccess) { fprintf(stderr, "kernel_launch: hipFuncSetAttribute failed\n"); grid = -1; return; }
        if (hipOccupancyMaxActiveBlocksPerMultiprocessor(&per_cu, (const void*)fwd, NTHR, LDS_BYTES) != hipSuccess || per_cu < 1) fprintf(stderr, "kernel_launch: occupancy query says %d\n", per_cu);
        (void)hipGetLastError();
        grid = cus;
        if (grid != 256) fprintf(stderr, "kernel_launch: %d CUs (built for 256)\n", grid);
    }
    if (grid < 0) return;
    (void)hipMemsetAsync((char*)d_ws + WS_CTL, 0, CTL_ZERO_BYTES, stream);
    Args a{};
    for (int i = 0; i < 47; ++i) a.in[i] = (const float*)d_in[i];
    a.out = (float*)d_out; a.ws = (unsigned char*)d_ws;
#if MK_PER_PHASE
    for (int p = 0; p < N_PHASES; ++p) { a.ph_lo = p; a.ph_hi = p + 1; hipLaunchKernelGGL(fwd, dim3(grid), dim3(NTHR), LDS_BYTES, stream, a); }
#else
    a.ph_lo = 0; a.ph_hi = N_PHASES; hipLaunchKernelGGL(fwd, dim3(grid), dim3(NTHR), LDS_BYTES, stream, a);
#endif
}
#ifdef DIAG_KERNELS
#define DK(name, ...) __global__ void __launch_bounds__(NTHR, 2) name(Args args) { extern __shared__ __attribute__((aligned(16))) unsigned char lds_raw[]; LAS unsigned char* lds = (LAS unsigned char*)lds_raw; \
    const int tid = threadIdx.x, lane = tid & 63, wave = __builtin_amdgcn_readfirstlane(tid >> 6); const int G = gridDim.x; const int bx = blockIdx.x; const int vcu = bx; KArgsP ap = fresh_args(); int l = ap->ph_lo; (void)lane; (void)wave; (void)vcu; (void)G; (void)l; __VA_ARGS__ }
DK(k_prologue, phase_prologue(ap, lds, tid, lane, wave, vcu, G);)
DK(k_norm0, phase_rownorm<0, false>(ap, lds, tid, lane, wave, G, ap->in[I_X], ap->out, ap->in[I_NORM_MIX], true, 0, 0, 0);)
DK(k_norm1, phase_rownorm<0, true>(ap, lds, tid, lane, wave, G, ap->out, ap->out, ap->in[I_NORM_MIX], false, l, 0, 0);)
DK(k_normf, phase_rownorm<1, true>(ap, lds, tid, lane, wave, G, ap->out, ap->out, ap->in[I_NORM_MIX], false, l, 0, 0);)
DK(k_m1, phase_m1(ap, lds, tid, lane, wave, vcu, G, l);)
DK(k_m2, phase_m2(ap->ws, tid, vcu, G);)
DK(k_m3, phase_m3(ap, lds, tid, lane, wave, vcu, G, l);)
DK(k_s1, phase_s1(ap, lds, tid, vcu, G, l);)
DK(k_s2, phase_s2(ap, tid, vcu, G, l);)
DK(k_s3, phase_s3(ap, lds, tid, vcu, G, l);)
DK(k_r1, phase_r1(ap, lds, tid, vcu, G, l);)
DK(k_r2, phase_r2(ap, lds, tid, lane, wave, vcu, l);)
DK(k_r3, phase_r3(ap, lane, vcu * NWAVES + wave, G * NWAVES, l);)
DK(k_router, phase_router(ap, lds, tid, lane, wave, G, l);)
DK(k_gather, phase_gather(ap, lds, tid, lane, wave, vcu, G, l);)
DK(k_moecv, moe_convert(ap->in[I_MW1], ap->in[I_MW3], ap->in[I_MW2], 1, (bf16*)(ap->ws + WS_W13), (bf16*)(ap->ws + WS_W2), vcu * NWAVES + wave, G * NWAVES, (LAS float*)(lds + wave * 16384), lane);)
#endif
```

```cpp
#include <hip/hip_runtime.h>
#include <cstdio>
#include <cstdint>
#define MK_PER_PHASE 0

#ifndef MK_PER_PHASE
#define MK_PER_PHASE 0
#endif
#ifndef EN_MLSTM
#define EN_MLSTM 1
#endif
#ifndef EN_S5
#define EN_S5 1
#endif
#ifndef EN_RWKV
#define EN_RWKV 1
#endif
#ifndef EN_MOE
#define EN_MOE 1
#endif
#ifndef N_LAYERS
#define N_LAYERS 2
#endif
constexpr int NWAVES = 8, NTHR = 512;
constexpr int DM = 1024, NB = 4, SEQ = 8192, NTOK = NB * SEQ;
constexpr int DA = 384, DBR = 384, DC = 256, NH = 6, HD = 64, NCH = SEQ / 64;
constexpr int IN_COLS = 2828, NPROJ = 2816, NPROJ_PAD = 3072;
constexpr int PC_QK = 0, PC_V = 384, PC_O = 768, PC_RW = 1152, PC_S5 = 2560;
constexpr int RWC_R = 0, RWC_K = 384, RWC_V = 768, RWC_WD = 1152, RWC_AD = 1216, RWC_GD = 1280, RW_COLS = 1408;
constexpr int NEXP = 32, DEXP = 512, MOE_ROWS_MAX = 73728;
constexpr int NUNIT_M = NB * NCH * NH;
constexpr int CL_STRIDE = 4160;
constexpr float NORM_EPS = 1e-6f, HEAD_NORM_EPS = 1e-5f, RWKV_GN_EPS = 64e-5f;

constexpr size_t MiB = 1u << 20;
constexpr size_t WS_CTL = 0, CTL_ZERO_BYTES = 1 * MiB;
constexpr size_t WS_MODP = 1 * MiB;
constexpr size_t WS_MODF = 2 * MiB + 512 * 1024;
constexpr size_t WS_RTW = 3 * MiB;
constexpr size_t WS_MLW = 3 * MiB + 512 * 1024;
constexpr size_t WS_S5CM = 2 * MiB + 768 * 1024;
constexpr size_t WS_GLUT = 3 * MiB + 768 * 1024;
constexpr size_t WS_WIN = 4 * MiB;
constexpr size_t WS_WOUT = 16 * MiB;
constexpr size_t WS_GATES = 20 * MiB;
constexpr size_t WS_W13 = 22 * MiB;
constexpr size_t WS_W2 = 86 * MiB;
constexpr size_t WS_HN = 118 * MiB;
constexpr size_t WS_CLOC = 118 * MiB;
constexpr size_t WS_MSC = 168 * MiB;
constexpr size_t WS_S5ST = 170 * MiB;
constexpr size_t WS_VF = 182 * MiB;
constexpr size_t WS_YC = 206 * MiB;
constexpr size_t WS_LIST = 206 * MiB;
constexpr size_t WS_ROWMAP = 214 * MiB;
constexpr size_t WS_TOKE = 215 * MiB;
constexpr size_t WS_TOKW = 215 * MiB + 512 * 1024;
constexpr size_t WS_PROJ = 270 * MiB;
constexpr size_t WS_RE = 446 * MiB, WS_RA = 470 * MiB, WS_RG = 494 * MiB, WS_RVG = 518 * MiB;
constexpr size_t WS_XG = 270 * MiB;
constexpr size_t WS_HMID = 414 * MiB;
constexpr size_t WS_YMOE = 270 * MiB;
constexpr size_t WS_END = 542 * MiB;
constexpr int CW_TMO = 0, CW_BAR = 4096, CW_CNT = 8192;

constexpr int RING_BYTES = 131072, MISC_OFF = 135168, PTAB_OFF = MISC_OFF + 1024, LDS_BYTES = 147456;

#define GAS __attribute__((address_space(1)))
#define LAS __attribute__((address_space(3)))
typedef unsigned short bf16;
typedef unsigned v4u __attribute__((ext_vector_type(4)));
typedef unsigned v2u __attribute__((ext_vector_type(2)));
typedef float f32x4 __attribute__((ext_vector_type(4)));
typedef float f32x2 __attribute__((ext_vector_type(2)));
typedef GAS unsigned gu32;
#define RLX_AGENT __ATOMIC_RELAXED, __HIP_MEMORY_SCOPE_AGENT
#define LDS_WAIT() asm volatile("s_waitcnt lgkmcnt(0)" ::: "memory")
#define VM_WAIT() asm volatile("s_waitcnt vmcnt(0)" ::: "memory")
__device__ __forceinline__ unsigned f2bf(float f) { unsigned u = __builtin_bit_cast(unsigned, f); return (u + 0x7fffu + ((u >> 16) & 1u)) >> 16; }
__device__ __forceinline__ unsigned pk2(float lo, float hi) { return f2bf(lo) | (f2bf(hi) << 16); }
__device__ __forceinline__ float bf2f(unsigned v) { return __builtin_bit_cast(float, v << 16); }
__device__ __forceinline__ float bflo(unsigned w) { return __builtin_bit_cast(float, w << 16); }
__device__ __forceinline__ float bfhi(unsigned w) { return __builtin_bit_cast(float, w & 0xffff0000u); }
__device__ __forceinline__ float sigmoidf_(float x) { return 1.f / (1.f + __expf(-x)); }
__device__ __forceinline__ float wave_sum(float v) {
#pragma unroll
    for (int o = 1; o < 64; o <<= 1) v += __shfl_xor(v, o);
    return v;
}
__device__ __forceinline__ float wave_max(float v) {
#pragma unroll
    for (int o = 1; o < 64; o <<= 1) v = fmaxf(v, __shfl_xor(v, o));
    return v;
}
namespace pg8 {
#define PG8_LAS __attribute__((address_space(3)))
typedef unsigned short bf16_t;
typedef short bf16x8 __attribute__((ext_vector_type(8)));
typedef float f32x4 __attribute__((ext_vector_type(4)));
typedef unsigned u32x4 __attribute__((ext_vector_type(4)));
constexpr int BM = 256, BK = 64, HALF = 128, HTB = HALF * BK * 2  , STAGE_BYTES = 8 * HTB, NXCD = 8, WGM = 8;

__host__ __device__ __forceinline__ int lds_byte(int r, int c) { const int st = (r >> 4) * 2 + (c >> 5), rr = r & 15, cc = c & 31, ob = rr * 64 + cc * 2; return st * 1024 + (ob ^ (((ob >> 9) & 1) << 5)); }
__host__ __device__ __forceinline__ void stage_rc(int b, int& R, int& C) { const int st = b / 1024, sb = b % 1024, swz = sb ^ (((sb >> 9) & 1) << 5); R = (st >> 1) * 16 + swz / 64; C = (st & 1) * 32 + (swz % 64) / 2; }
__host__ __device__ __forceinline__ int perm32(int rho) { const int n = rho >> 4, i = rho & 15; return 8 * (i >> 2) + 4 * n + (i & 3); }

struct Unit { int pm, pn; };
struct Gemm { const bf16_t* A; const bf16_t* Bt; int M, N, K; };

struct StaticOrder {
    int nM, nN, nwg, G, c;
    __host__ __device__ void init(int M, int N, int G_, int c_) { nM = M / BM; nN = N / BM; nwg = nM * nN; G = G_; c = c_; }
    __host__ __device__ bool next(int i, Unit& u) const {
        const long L = (long)i * G + c; if (L >= nwg) return false;
        int wgid = (int)L; { const int q = nwg / NXCD, r = nwg % NXCD, xcd = wgid % NXCD, off = wgid / NXCD; wgid = (xcd < r ? xcd * (q + 1) : r * (q + 1) + (xcd - r) * q) + off; }
        const int nig = WGM * nN, gid = wgid / nig, fm = gid * WGM, gsz = (nM - fm) < WGM ? (nM - fm) : WGM;
        u.pm = fm + ((wgid % nig) % gsz); u.pn = (wgid % nig) / gsz; return true;
    }
    __device__ __forceinline__ void a_ready(const Unit&) const {}
    __device__ __forceinline__ void done(const Unit&) const {}
};

__device__ __forceinline__ unsigned cvt_pk_bf16(float lo, float hi) { unsigned r; asm volatile("v_cvt_pk_bf16_f32 %0, %1, %2" : "=v"(r) : "v"(lo), "v"(hi)); return r; }

struct EpiProj {
    static constexpr bool PERM = true, AFTER_DRAIN = false;
    bf16_t* O; float* G;
    __device__ __forceinline__ void operator()(const f32x4 (&acc)[2][2][4][2], const Unit& u, int wr, int wc, int fr, int fq) const {
        const int row0 = u.pm * BM + wr * 64 + fr;
        if (u.pn < 11) {
            const int col0 = u.pn * BM + wc * 32 + 8 * fq;
#pragma unroll
            for (int ai = 0; ai < 2; ++ai)
#pragma unroll
                for (int m = 0; m < 4; ++m) { bf16_t* rowp = O + (size_t)(row0 + ai * HALF + m * 16) * 2816 + col0;
#pragma unroll
                    for (int bj = 0; bj < 2; ++bj) { const f32x4 v0 = acc[ai][bj][m][0], v1 = acc[ai][bj][m][1];
                        u32x4 w; w.x = cvt_pk_bf16(v0[0], v0[1]); w.y = cvt_pk_bf16(v0[2], v0[3]); w.z = cvt_pk_bf16(v1[0], v1[1]); w.w = cvt_pk_bf16(v1[2], v1[3]);
                        *(u32x4*)(rowp + bj * HALF) = w; } }
        } else if (wc == 0 && fq < 2) {
#pragma unroll
            for (int ai = 0; ai < 2; ++ai)
#pragma unroll
                for (int m = 0; m < 4; ++m) { float* rowp = G + (size_t)(row0 + ai * HALF + m * 16) * 16 + 8 * fq;
                    *(f32x4*)(rowp) = acc[ai][0][m][0]; *(f32x4*)(rowp + 4) = acc[ai][0][m][1]; }
        }
    }
};
struct EpiResid {
    static constexpr bool PERM = true, AFTER_DRAIN = false;
    const float* xin; float* out; const float* gate;
    int goff;
    __device__ __forceinline__ void operator()(const f32x4 (&acc)[2][2][4][2], const Unit& u, int wr, int wc, int fr, int fq) const {
        const int row0 = u.pm * BM + wr * 64 + fr, col0 = u.pn * BM + wc * 32 + 8 * fq;
        const float* gp = gate + (size_t)(row0 >> 13) * 6144 + goff + col0;
        f32x4 g[2][2];
#pragma unroll
        for (int bj = 0; bj < 2; ++bj)
#pragma unroll
            for (int n = 0; n < 2; ++n) g[bj][n] = *(const f32x4*)(gp + bj * HALF + 4 * n) + 1.0f;
#pragma unroll
        for (int ai = 0; ai < 2; ++ai)
#pragma unroll
            for (int m = 0; m < 4; ++m) { const size_t off = (size_t)(row0 + ai * HALF + m * 16) * 1024 + col0;
#pragma unroll
                for (int bj = 0; bj < 2; ++bj)
#pragma unroll
                    for (int n = 0; n < 2; ++n) { const f32x4 xv = *(const f32x4*)(xin + off + bj * HALF + 4 * n);
                        *(f32x4*)(out + off + bj * HALF + 4 * n) = xv + g[bj][n] * acc[ai][bj][m][n]; } }
    }
};
struct EpiSwiglu {
    static constexpr bool PERM = true, AFTER_DRAIN = false;
    bf16_t* H;
    __device__ __forceinline__ void operator()(const f32x4 (&acc)[2][2][4][2], const Unit& u, int wr, int wc, int fr, int fq) const {
        const int row0 = u.pm * BM + wr * 64 + fr, hid0 = 128 * (u.pn & 3) + 16 * wc + 4 * fq;
#pragma unroll
        for (int ai = 0; ai < 2; ++ai)
#pragma unroll
            for (int m = 0; m < 4; ++m) { bf16_t* rowp = H + (size_t)(row0 + ai * HALF + m * 16) * 512 + hid0;
#pragma unroll
                for (int bj = 0; bj < 2; ++bj) { const f32x4 g = acc[ai][bj][m][0], uu = acc[ai][bj][m][1]; float h[4];
#pragma unroll
                    for (int i = 0; i < 4; ++i) h[i] = g[i] / (1.f + __expf(-g[i])) * uu[i];
                    unsigned w0 = cvt_pk_bf16(h[0], h[1]), w1 = cvt_pk_bf16(h[2], h[3]);
                    *(unsigned long long*)(rowp + 64 * bj) = (unsigned long long)w0 | ((unsigned long long)w1 << 32); } }
    }
};
struct EpiMoeOut {
    static constexpr bool PERM = true, AFTER_DRAIN = false;
    bf16_t* Y; const int* rowmap;
    __device__ __forceinline__ void operator()(const f32x4 (&acc)[2][2][4][2], const Unit& u, int wr, int wc, int fr, int fq) const {
        const int row0 = u.pm * BM + wr * 64 + fr, col0 = (u.pn & 3) * BM + wc * 32 + 8 * fq;
#pragma unroll
        for (int ai = 0; ai < 2; ++ai)
#pragma unroll
            for (int m = 0; m < 4; ++m) { const int dst = rowmap[row0 + ai * HALF + m * 16];
                if (dst >= 0) { bf16_t* rowp = Y + (size_t)dst * 1024 + col0;
#pragma unroll
                    for (int bj = 0; bj < 2; ++bj) { const f32x4 v0 = acc[ai][bj][m][0], v1 = acc[ai][bj][m][1];
                        u32x4 w; w.x = cvt_pk_bf16(v0[0], v0[1]); w.y = cvt_pk_bf16(v0[2], v0[3]); w.z = cvt_pk_bf16(v1[0], v1[1]); w.w = cvt_pk_bf16(v1[2], v1[3]);
                        *(u32x4*)(rowp + bj * HALF) = w; } } }
    }
};
struct MoeOrder {
    PG8_LAS const int* ptab; int G, c;
    __device__ __forceinline__ bool next(int i, Unit& u) const {
        const int L = i * G + c, np = __builtin_amdgcn_readfirstlane(ptab[0]);
        if (L >= np * 4) return false;
        const int p = L >> 2; u.pm = p; u.pn = __builtin_amdgcn_readfirstlane(ptab[1 + p]) * 4 + (L & 3); return true;
    }
    __device__ __forceinline__ void a_ready(const Unit&) const {}
    __device__ __forceinline__ void done(const Unit&) const {}
};
template <class Epi, class Sched, bool ALIGN_EPI = false, bool SP2 = false>
__device__ __forceinline__ void gemm_phase(PG8_LAS unsigned char* lds, const Gemm g, const Sched& S, const Epi& E) {
    const int tid = threadIdx.x, wid = __builtin_amdgcn_readfirstlane(tid >> 6), lane = tid & 63, wr = wid >> 2, wc = wid & 3, fr = lane & 15, fq = lane >> 4;
    const int K = g.K, nt = K / BK;
    unsigned voffA[2], voffB[2];
#pragma unroll
    for (int i = 0; i < 2; ++i) { int R, C; stage_rc(tid * 16 + i * 8192, R, C); const int Rb = Epi::PERM ? ((R & ~31) + perm32(R & 31)) : R;
        voffA[i] = (unsigned)(R * K + C) * 2u; voffB[i] = (unsigned)(Rb * K + C) * 2u; }
    const size_t kstep = (size_t)(BK * 2);
    const size_t hstep = (size_t)HALF * K * 2;
    const size_t tstep = 2 * hstep;
    const unsigned ldsw = (unsigned)wid * 1024u;
    const int aoff = lds_byte(wr * 64 + fr, fq * 8), boff = lds_byte(wc * 32 + fr, fq * 8);
#define PG8_SA(b, h) (((b) * 2 + (h)) * HTB)
#define PG8_SB(b, h) ((4 + (b) * 2 + (h)) * HTB)
#define PG8_STAGE(bufoff, gbase, voff) do { _Pragma("unroll") for (int _i = 0; _i < 2; ++_i) \
        __builtin_amdgcn_global_load_lds((const unsigned*)((const char*)(gbase) + (voff)[_i]), (PG8_LAS unsigned*)(lds + (bufoff) + ldsw + _i * 8192), 16, 0, 0); } while (0)
#define PG8_LDA(dst, b, h) do { _Pragma("unroll") for (int m = 0; m < 4; ++m) _Pragma("unroll") for (int k = 0; k < 2; ++k) dst[m][k] = *(const PG8_LAS bf16x8*)(lds + PG8_SA(b, h) + aoff + m * 2048 + k * 1024); } while (0)
#define PG8_LDB(dst, b, h) do { _Pragma("unroll") for (int n = 0; n < 2; ++n) _Pragma("unroll") for (int k = 0; k < 2; ++k) dst[n][k] = *(const PG8_LAS bf16x8*)(lds + PG8_SB(b, h) + boff + n * 2048 + k * 1024); } while (0)
#define PG8_MMA(ai, bj, At, Bt) do { __builtin_amdgcn_s_setprio(1); _Pragma("unroll") for (int m = 0; m < 4; ++m) _Pragma("unroll") for (int n = 0; n < 2; ++n) _Pragma("unroll") for (int k = 0; k < 2; ++k) \
        acc[ai][bj][m][n] = __builtin_amdgcn_mfma_f32_16x16x32_bf16(Bt[n][k], At[m][k], acc[ai][bj][m][n], 0, 0, 0); __builtin_amdgcn_s_setprio(0); } while (0)
#define PG8_WAIT_V(n) asm volatile("s_waitcnt vmcnt(" #n ")" ::: "memory")
#define PG8_WAIT_L(n) asm volatile("s_waitcnt lgkmcnt(" #n ")" ::: "memory")
#define PG8_BAR __builtin_amdgcn_s_barrier()
#define PG8_SCHED __builtin_amdgcn_sched_barrier(0)
    Unit cur, nxt; int ui = 0;
    if (!S.next(0, cur)) return;
    f32x4 acc[2][2][4][2];
#pragma unroll
    for (int a = 0; a < 2; ++a)
#pragma unroll
        for (int b = 0; b < 2; ++b)
#pragma unroll
            for (int m = 0; m < 4; ++m)
#pragma unroll
                for (int n = 0; n < 2; ++n) acc[a][b][m][n] = (f32x4){0.f, 0.f, 0.f, 0.f};
    bf16x8 At[4][2], B0[2][2], B1[2][2];
    const char* cA = (const char*)g.A + (size_t)cur.pm * tstep; const char* cB = (const char*)g.Bt + (size_t)cur.pn * tstep;
    S.a_ready(cur);
    if constexpr (SP2) {
        PG8_STAGE(PG8_SB(0, 0), cB, voffB); PG8_STAGE(PG8_SB(0, 1), cB + hstep, voffB); PG8_STAGE(PG8_SA(0, 0), cA, voffA); PG8_STAGE(PG8_SA(0, 1), cA + hstep, voffA);
        if (wr == 1) PG8_BAR;
        PG8_WAIT_V(2); PG8_BAR;
        PG8_STAGE(PG8_SB(1, 0), cB + kstep, voffB); PG8_STAGE(PG8_SA(1, 0), cA + kstep, voffA); PG8_STAGE(PG8_SB(1, 1), cB + hstep + kstep, voffB);
        PG8_WAIT_V(6); PG8_BAR;
    } else {
        PG8_STAGE(PG8_SB(0, 0), cB, voffB); PG8_STAGE(PG8_SA(0, 0), cA, voffA); PG8_STAGE(PG8_SB(0, 1), cB + hstep, voffB); PG8_STAGE(PG8_SA(0, 1), cA + hstep, voffA);
        if (wr == 1) PG8_BAR;
        PG8_WAIT_V(4); PG8_BAR;
        PG8_STAGE(PG8_SB(1, 0), cB + kstep, voffB); PG8_STAGE(PG8_SA(1, 0), cA + kstep, voffA); PG8_STAGE(PG8_SB(1, 1), cB + hstep + kstep, voffB);
        PG8_WAIT_V(6); PG8_BAR;
    }
    for (;;) {
        const bool has_next = S.next(ui + 1, nxt);
        const char* nA = has_next ? (const char*)g.A + (size_t)nxt.pm * tstep : cA; const char* nB = has_next ? (const char*)g.Bt + (size_t)nxt.pn * tstep : cB;
        for (int t = 0; t < nt; t += 2) {
            const bool last = (t == nt - 2);
            const char* a1 = cA + (size_t)(t + 1) * kstep;
            const char* a2 = last ? nA : cA + (size_t)(t + 2) * kstep; const char* b2 = last ? nB : cB + (size_t)(t + 2) * kstep;
            const char* a3 = a2 + kstep; const char* b3 = b2 + kstep;
            if (last && has_next) S.a_ready(nxt);
            if constexpr (SP2) {
            PG8_LDB(B0, 0, 0); PG8_LDB(B1, 0, 1); PG8_SCHED; PG8_LDA(At, 0, 0); PG8_STAGE(PG8_SA(1, 1), a1 + hstep, voffA);
            PG8_WAIT_V(8); PG8_WAIT_L(0); PG8_BAR; PG8_MMA(0, 0, At, B0); PG8_MMA(0, 1, At, B1); PG8_BAR; PG8_SCHED;
            PG8_LDA(At, 0, 1); PG8_STAGE(PG8_SB(0, 0), b2, voffB); PG8_STAGE(PG8_SB(0, 1), b2 + hstep, voffB); PG8_STAGE(PG8_SA(0, 0), a2, voffA);
            PG8_WAIT_V(8); PG8_WAIT_L(0); PG8_BAR; PG8_MMA(1, 0, At, B0); PG8_MMA(1, 1, At, B1); PG8_BAR; PG8_SCHED;
            PG8_LDB(B0, 1, 0); PG8_LDB(B1, 1, 1); PG8_SCHED; PG8_LDA(At, 1, 0); PG8_STAGE(PG8_SA(0, 1), a2 + hstep, voffA);
            PG8_WAIT_V(8); PG8_WAIT_L(0); PG8_BAR; PG8_MMA(0, 0, At, B0); PG8_MMA(0, 1, At, B1); PG8_BAR; PG8_SCHED;
            PG8_LDA(At, 1, 1); PG8_STAGE(PG8_SB(1, 0), b3, voffB); PG8_STAGE(PG8_SB(1, 1), b3 + hstep, voffB); PG8_STAGE(PG8_SA(1, 0), a3, voffA);
            PG8_WAIT_V(8); PG8_WAIT_L(0); PG8_BAR; PG8_MMA(1, 0, At, B0); PG8_MMA(1, 1, At, B1); PG8_BAR; PG8_SCHED;
            } else {
            PG8_LDB(B0, 0, 0); PG8_SCHED; PG8_LDA(At, 0, 0); PG8_STAGE(PG8_SA(1, 1), a1 + hstep, voffA);
            PG8_WAIT_L(8); PG8_BAR; PG8_WAIT_L(0); PG8_MMA(0, 0, At, B0); PG8_BAR; PG8_SCHED;
            PG8_LDB(B1, 0, 1); PG8_STAGE(PG8_SB(0, 0), b2, voffB);
            PG8_BAR; PG8_WAIT_L(0); PG8_MMA(0, 1, At, B1); PG8_BAR;
            PG8_LDA(At, 0, 1); PG8_STAGE(PG8_SA(0, 0), a2, voffA);
            PG8_BAR; PG8_WAIT_L(0); PG8_MMA(1, 0, At, B0); PG8_BAR; PG8_SCHED;
            PG8_STAGE(PG8_SB(0, 1), b2 + hstep, voffB);
            PG8_WAIT_V(6); PG8_BAR; PG8_MMA(1, 1, At, B1); PG8_BAR;
            PG8_LDB(B0, 1, 0); PG8_SCHED; PG8_LDA(At, 1, 0); PG8_STAGE(PG8_SA(0, 1), a2 + hstep, voffA);
            PG8_WAIT_L(8); PG8_BAR; PG8_WAIT_L(0); PG8_MMA(0, 0, At, B0); PG8_BAR; PG8_SCHED;
            PG8_LDB(B1, 1, 1); PG8_STAGE(PG8_SB(1, 0), b3, voffB);
            PG8_BAR; PG8_WAIT_L(0); PG8_MMA(0, 1, At, B1); PG8_BAR;
            PG8_LDA(At, 1, 1); PG8_STAGE(PG8_SA(1, 0), a3, voffA);
            PG8_BAR; PG8_WAIT_L(0); PG8_MMA(1, 0, At, B0); PG8_BAR; PG8_SCHED;
            PG8_STAGE(PG8_SB(1, 1), b3 + hstep, voffB);
            PG8_WAIT_V(6); PG8_BAR; PG8_MMA(1, 1, At, B1); PG8_BAR;
            }
        }
        if constexpr (ALIGN_EPI) { if (wr == 0) PG8_BAR; }
        if constexpr (!Epi::AFTER_DRAIN) { E(acc, cur, wr, wc, fr, fq); S.done(cur); }
        if (!has_next) break;
#pragma unroll
        for (int a = 0; a < 2; ++a)
#pragma unroll
            for (int b = 0; b < 2; ++b)
#pragma unroll
                for (int m = 0; m < 4; ++m)
#pragma unroll
                    for (int n = 0; n < 2; ++n) acc[a][b][m][n] = (f32x4){0.f, 0.f, 0.f, 0.f};
        cur = nxt; cA = nA; cB = nB; ++ui;
        if constexpr (ALIGN_EPI) { if (wr == 1) PG8_BAR; }
    }
    PG8_WAIT_V(0);
    if constexpr (!ALIGN_EPI) { if (wr == 0) PG8_BAR; }
    PG8_BAR;
    if constexpr (Epi::AFTER_DRAIN) { E.fused(acc, cur, wr, wc, fr, fq, lds, wid, lane); S.done(cur); }
#undef PG8_SA
#undef PG8_SB
#undef PG8_STAGE
#undef PG8_LDA
#undef PG8_LDB
#undef PG8_MMA
#undef PG8_WAIT_V
#undef PG8_WAIT_L
#undef PG8_BAR
#undef PG8_SCHED
}
}
#define XB_TMO      128
#define XB_XCNT(j)  (256  + 64 * (j))
#define XB_XSUB(j)  (1280 + 64 * (j))
#define XB_XGEN(j)  (2304 + 64 * (j))
#define XB_TOP      3328
#define XB_TOPGEN   3392
#define XCD_BAR_WORDS 3456
#define XB_SPIN_CAP (1u << 18)
#define LAS __attribute__((address_space(3)))

__device__ __forceinline__ unsigned xb_ld(unsigned* p)              { return __hip_atomic_load(p, __ATOMIC_RELAXED, __HIP_MEMORY_SCOPE_AGENT); }
__device__ __forceinline__ unsigned xb_add(unsigned* p, unsigned v) { return __hip_atomic_fetch_add(p, v, __ATOMIC_RELAXED, __HIP_MEMORY_SCOPE_AGENT); }
__device__ __forceinline__ unsigned xb_xcc_id() { return (unsigned)__builtin_amdgcn_s_getreg((3 << 11) | 20) & 0xFu; }
#define XB_SPIN(cond, bar) do { unsigned _sp = 0; while (cond) { __builtin_amdgcn_s_sleep(1); \
    if ((++_sp & 255u) == 0u) { if (xb_ld(&(bar)[XB_TMO])) break; if (_sp > XB_SPIN_CAP) { atomicAdd(&(bar)[XB_TMO], 1u); break; } } } } while (0)

struct XcdBarrier {
    unsigned* bar; unsigned x;
    volatile LAS unsigned* st;
};

__device__ __forceinline__ XcdBarrier xcd_barrier_post(unsigned* bar, volatile LAS unsigned* st) {
    XcdBarrier b; b.bar = bar; b.x = xb_xcc_id(); b.st = st;
    if (threadIdx.x == 0) (void)xb_add(&bar[XB_XCNT(b.x)], 1u);
    return b;
}
__device__ __forceinline__ void xcd_barrier_complete(unsigned* bar, unsigned x, unsigned& nloc, unsigned& nx) {
    const unsigned G = gridDim.x * gridDim.y * gridDim.z;
    unsigned sum, cnt, mine, sp = 0u;
    for (;;) {
        sum = 0u; cnt = 0u; mine = 0u;
#pragma unroll
        for (unsigned j = 0; j < 16; ++j) { const unsigned c = xb_ld(&bar[XB_XCNT(j)]); sum += c; cnt += (c > 0u) ? 1u : 0u; mine = (j == x) ? c : mine; }
        if (sum == G) break;
        __builtin_amdgcn_s_sleep(1);
        if ((++sp & 255u) == 0u) { if (xb_ld(&bar[XB_TMO])) break; if (sp > XB_SPIN_CAP) { atomicAdd(&bar[XB_TMO], 1u); break; } }
    }
    nloc = mine > 0u ? mine : 1u; nx = cnt > 0u ? cnt : 1u;
}

__device__ __forceinline__ void xcd_barrier(const XcdBarrier& b) {
    asm volatile("s_waitcnt vmcnt(0)" ::: "memory");
    __syncthreads();
    if (threadIdx.x == 0) {
        unsigned* bar = b.bar;
        __builtin_amdgcn_s_waitcnt(0);
        unsigned nloc = b.st[0], nx = b.st[1];
        if (nloc == 0u) { xcd_barrier_complete(bar, b.x, nloc, nx); b.st[0] = nloc; b.st[1] = nx; }
        const unsigned old = xb_add(&bar[XB_XSUB(b.x)], 1u);
        const unsigned gen = old / nloc;
        if (old + 1u == (gen + 1u) * nloc) {
            __builtin_amdgcn_fence(__ATOMIC_RELEASE, "agent");
            asm volatile("s_waitcnt vmcnt(0)" ::: "memory");
            const unsigned og = xb_add(&bar[XB_TOP], 1u);
            const unsigned tg = og / nx;
            if (og + 1u == (tg + 1u) * nx) xb_add(&bar[XB_TOPGEN], 1u);
            else XB_SPIN(xb_ld(&bar[XB_TOPGEN]) == tg, bar);
            __builtin_amdgcn_fence(__ATOMIC_ACQUIRE, "agent");
            xb_add(&bar[XB_XGEN(b.x)], 1u);
            asm volatile("s_waitcnt vmcnt(0)" ::: "memory");
        } else {
            XB_SPIN(xb_ld(&bar[XB_XGEN(b.x)]) == gen, bar);
            __builtin_amdgcn_fence(__ATOMIC_ACQUIRE, "agent");
            asm volatile("s_waitcnt vmcnt(0)" ::: "memory");
        }
    }
    __syncthreads();
}

struct Args { const float* in[47]; float* out; unsigned char* ws; int ph_lo, ph_hi; };
typedef const __attribute__((address_space(4))) Args* KArgsP;
__device__ __forceinline__ KArgsP fresh_args() { KArgsP p = (KArgsP)__builtin_amdgcn_kernarg_segment_ptr(); asm volatile("" : "+s"(p)); return p; }
enum { I_X = 0, I_C, I_ADA_W, I_ADA_B, I_NORM_MIX, I_NORM_FFN, I_NORM_FINAL, I_W_IN, I_W_OUT, I_CONV_W, I_CONV_B, I_WQ, I_WK, I_BI, I_BF, I_MNORM_W,
       I_RMU, I_RW0, I_RWUP, I_RA0, I_RAUP, I_RGUP, I_RKK, I_RKA, I_RRK, I_RLNW, I_RLNB, I_RV0, I_RVDN, I_RVUP,
       I_S5ARE, I_S5AIM, I_S5LDT, I_S5BRE, I_S5BIM, I_S5CRE, I_S5CIM, I_S5D, I_S5GLUW, I_S5GLUB,
       I_MWRG, I_MBRG, I_MWRE, I_MBRE, I_MW1, I_MW3, I_MW2 };

struct RmWin { __device__ __forceinline__ int operator()(int n) const { return n < 1152 ? n : (n < 1164 ? 2816 + (n - 1152) : (n < 2572 ? 1152 + (n - 1164) : 2560 + (n - 2572))); } };
struct RmId  { __device__ __forceinline__ int operator()(int n) const { return n; } };
struct RmGU  { int add; __device__ __forceinline__ int operator()(int n) const { return 8 * (n >> 2) + (n & 3) + add; } };
template <class RM>
__device__ __forceinline__ void transpose_item(const float* W, int ldw, int ncols, int k0, int n0, bf16* WT, int ldt, LAS float* scr, int lane, const RM rm) {
    const int nn = n0 + lane; const bool ok = nn < ncols; const float* src = W + (size_t)k0 * ldw + (ok ? nn : n0);
    float v[64];
#pragma unroll
    for (int kk = 0; kk < 64; ++kk) v[kk] = src[(size_t)kk * ldw];
#pragma unroll
    for (int kk = 0; kk < 64; ++kk) scr[kk * 65 + lane] = v[kk];
    LDS_WAIT(); asm volatile("" ::: "memory");
    const int c = lane & 7;
#pragma unroll
    for (int j = 0; j < 8; ++j) { const int nl = (lane >> 3) + 8 * j; const LAS float* s = scr + (8 * c) * 65 + nl;
        v4u o; o.x = pk2(s[0 * 65], s[1 * 65]); o.y = pk2(s[2 * 65], s[3 * 65]); o.z = pk2(s[4 * 65], s[5 * 65]); o.w = pk2(s[6 * 65], s[7 * 65]);
        if (n0 + nl < ncols) *(GAS v4u*)(WT + (size_t)rm(n0 + nl) * ldt + k0 + 8 * c) = o; }
    LDS_WAIT(); asm volatile("" ::: "memory");
}
__device__ __forceinline__ void moe_convert(const float* w1, const float* w3, const float* w2, int l, bf16* W13, bf16* W2T, int worker, int nworkers, LAS float* scr, int lane) {
    for (int it = worker; it < NEXP * 384; it += nworkers) {
        const int e = it / 384, r = it % 384; const size_t eo = (size_t)(l * NEXP + e) * DM * DEXP;
        if (r < 128)      transpose_item(w1 + eo, DEXP, DEXP, 64 * (r >> 3), 64 * (r & 7), W13 + (size_t)e * 1024 * 1024, 1024, scr, lane, RmGU{0});
        else if (r < 256) transpose_item(w3 + eo, DEXP, DEXP, 64 * ((r - 128) >> 3), 64 * ((r - 128) & 7), W13 + (size_t)e * 1024 * 1024, 1024, scr, lane, RmGU{4});
        else              transpose_item(w2 + eo, DM, DM, 64 * ((r - 256) >> 4), 64 * ((r - 256) & 15), W2T + (size_t)e * 1024 * 512, 512, scr, lane, RmId{});
    }
}
__device__ __forceinline__ void phase_prologue(KArgsP a, LAS unsigned char* lds, int tid, int lane, int wave, int vcu, int G) {
    unsigned char* ws = a->ws;
    LAS float* scr = (LAS float*)(lds + wave * 16640);
    const int gw = vcu * NWAVES + wave, NGW = G * NWAVES;
    bf16* WIN = (bf16*)(ws + WS_WIN); bf16* WOUT = (bf16*)(ws + WS_WOUT);
    for (int it = gw; it < 2 * 16 * 45; it += NGW) { const int l = it / (16 * 45), r = it % (16 * 45);
        transpose_item(a->in[I_W_IN] + (size_t)l * DM * IN_COLS, IN_COLS, IN_COLS, 64 * (r / 45), 64 * (r % 45), WIN + (size_t)l * NPROJ_PAD * DM, DM, scr, lane, RmWin{}); }
    for (int it = gw; it < 2 * 16 * 16; it += NGW) { const int l = it / 256, r = it % 256;
        transpose_item(a->in[I_W_OUT] + (size_t)l * DM * DM, DM, DM, 64 * (r >> 4), 64 * (r & 15), WOUT + (size_t)l * DM * DM, DM, scr, lane, RmId{}); }
    for (int it = gw; it < 2 * 244; it += NGW) { const int l = it / 244, r = 2828 + it % 244; GAS v4u* p = (GAS v4u*)(WIN + ((size_t)l * NPROJ_PAD + r) * DM);
        p[lane] = (v4u){0u, 0u, 0u, 0u}; p[lane + 64] = (v4u){0u, 0u, 0u, 0u}; }
    { float* RTW = (float*)(ws + WS_RTW);
      for (int idx = (vcu * NTHR + tid); idx < 2 * 1024 * 48; idx += G * NTHR) { const int j = idx % 48, k = (idx / 48) % 1024, l = idx / (48 * 1024);
          RTW[idx] = j < 4 ? a->in[I_MWRG][(size_t)(l * 1024 + k) * 4 + j] : (j < 36 ? a->in[I_MWRE][(size_t)(l * 1024 + k) * 32 + (j - 4)] : 0.f); } }
    { bf16* CM = (bf16*)(ws + WS_S5CM);
      for (int idx = (vcu * NTHR + tid); idx < 2 * 16 * 16 * 128; idx += G * NTHR) { const int k = idx & 127, lgc = idx >> 7;
          CM[idx] = (bf16)f2bf((k & 1) ? -a->in[I_S5CIM][(size_t)lgc * 64 + (k >> 1)] : a->in[I_S5CRE][(size_t)lgc * 64 + (k >> 1)]); } }
    for (int it = gw; it < 2 * 16; it += NGW) { const int l = it >> 4, r = it & 15;
        transpose_item(a->in[I_S5GLUW] + (size_t)l * DC * DC, DC, DC, 64 * (r >> 2), 64 * (r & 3), (bf16*)(ws + WS_GLUT) + (size_t)l * DC * DC, DC, scr, lane, RmId{}); }
    { bf16* MLW = (bf16*)(ws + WS_MLW);
      for (int idx = (vcu * NTHR + tid); idx < 2 * NH * 2 * 4096; idx += G * NTHR) { const int d = idx & 63, e = (idx >> 6) & 63, which = (idx >> 12) & 1, lh = idx >> 13;
          MLW[idx] = (bf16)f2bf(a->in[which ? I_WK : I_WQ][(size_t)lh * 4096 + d * 64 + e]); } }
    moe_convert(a->in[I_MW1], a->in[I_MW3], a->in[I_MW2], 0, (bf16*)(ws + WS_W13), (bf16*)(ws + WS_W2), gw, NGW, scr, lane);
    __syncthreads();
    if (vcu < 192) {
        const int q = vcu, l = q / 96, cb = (q >> 3) % 12, kc = q & 7;
        LAS float* cond = (LAS float*)lds;
        { const int b = tid >> 7, kk = tid & 127; const float cv = a->in[I_C][b * DM + kc * 128 + kk]; cond[tid] = cv / (1.f + __expf(-cv)); }
        __syncthreads();
        const int col = cb * 512 + tid; const float* wp = a->in[I_ADA_W] + ((size_t)l * DM + kc * 128) * 6144 + col;
        float acc0 = 0.f, acc1 = 0.f, acc2 = 0.f, acc3 = 0.f;
#pragma unroll 8
        for (int kk = 0; kk < 128; ++kk) { const float w = wp[(size_t)kk * 6144]; acc0 += cond[kk] * w; acc1 += cond[128 + kk] * w; acc2 += cond[256 + kk] * w; acc3 += cond[384 + kk] * w; }
        const float bias = (kc == 0) ? a->in[I_ADA_B][l * 6144 + col] : 0.f;
        float* MP = (float*)(ws + WS_MODP) + ((size_t)(kc * 2 + l) * 4) * 6144 + col;
        MP[0] = acc0 + bias; MP[6144] = acc1 + bias; MP[2 * 6144] = acc2 + bias; MP[3 * 6144] = acc3 + bias;
    }
}

__device__ __forceinline__ float modval(const unsigned char* ws, bool part, int l, int b, int idx) {
    if (!part) return ((const float*)(ws + WS_MODF))[(size_t)(l * 4 + b) * 6144 + idx];
    const float* mp = (const float*)(ws + WS_MODP) + (size_t)(l * 4 + b) * 6144 + idx; float s = 0.f;
#pragma unroll
    for (int kc = 0; kc < 8; ++kc) s += mp[(size_t)kc * 2 * 4 * 6144];
    return s;
}
template <int MODE, bool COMBINE>
__device__ __forceinline__ void phase_rownorm(KArgsP a, LAS unsigned char* lds, int tid, int lane, int wave, int G,
                                              const float* xsrc, float* xdst, const float* gvec, bool part, int l, int isc  , int lprev) {
    unsigned char* ws = a->ws;
    LAS float* sc = (LAS float*)lds; LAS float* sh = sc + 1024; LAS float* gt = sh + 1024;
    bf16* HN = (bf16*)(ws + WS_HN); const bf16* YM = (const bf16*)(ws + WS_YMOE); const float* TW = (const float*)(ws + WS_TOKW);
    for (int c = blockIdx.x; c < NTOK / 128; c += G) {
        const int b = c >> 6;
        __syncthreads();
        for (int j = tid; j < 1024; j += NTHR) {
            if (MODE == 0) { sc[j] = gvec[j] * (1.f + modval(ws, part, l, b, (isc + 1) * 1024 + j)); sh[j] = modval(ws, part, l, b, isc * 1024 + j); }
            else { sc[j] = gvec[j]; sh[j] = 0.f; }
            if (COMBINE) gt[j] = 1.f + modval(ws, false, lprev, b, 5 * 1024 + j);
        }
        __syncthreads();
        for (int i = 0; i < 16; ++i) {
            const int row = c * 128 + wave * 16 + i;
            const GAS f32x4* xr = (const GAS f32x4*)(xsrc + (size_t)row * DM) + lane;
            f32x4 v[4];
#pragma unroll
            for (int j = 0; j < 4; ++j) v[j] = xr[64 * j];
            if (COMBINE) {
                const float w0 = TW[2 * row], w1 = TW[2 * row + 1];
                const GAS v2u* y0 = (const GAS v2u*)(YM + (size_t)(2 * row) * DM) + lane; const GAS v2u* y1 = (const GAS v2u*)(YM + (size_t)(2 * row + 1) * DM) + lane;
#pragma unroll
                for (int j = 0; j < 4; ++j) { const v2u p0 = y0[64 * j], p1 = y1[64 * j]; const f32x4 g4 = *(const LAS f32x4*)(gt + lane * 4 + 256 * j);
                    f32x4 m; m.x = w0 * bflo(p0.x) + w1 * bflo(p1.x); m.y = w0 * bfhi(p0.x) + w1 * bfhi(p1.x); m.z = w0 * bflo(p0.y) + w1 * bflo(p1.y); m.w = w0 * bfhi(p0.y) + w1 * bfhi(p1.y);
                    v[j] = v[j] + g4 * m; }
                if (MODE == 0) { GAS f32x4* xo = (GAS f32x4*)(xdst + (size_t)row * DM) + lane;
#pragma unroll
                    for (int j = 0; j < 4; ++j) xo[64 * j] = v[j]; }
            }
            float ss = 0.f;
#pragma unroll
            for (int j = 0; j < 4; ++j) ss += (v[j].x * v[j].x + v[j].y * v[j].y) + (v[j].z * v[j].z + v[j].w * v[j].w);
            const float rstd = rsqrtf(wave_sum(ss) * (1.f / DM) + NORM_EPS);
            if (MODE == 0) {
                GAS v2u* o = (GAS v2u*)(HN + (size_t)row * DM) + lane;
#pragma unroll
                for (int j = 0; j < 4; ++j) { const f32x4 s4 = *(const LAS f32x4*)(sc + lane * 4 + 256 * j), h4 = *(const LAS f32x4*)(sh + lane * 4 + 256 * j); const f32x4 h = v[j] * rstd * s4 + h4;
                    v2u w; w.x = pk2(h.x, h.y); w.y = pk2(h.z, h.w); o[64 * j] = w; }
            } else {
                GAS f32x4* o = (GAS f32x4*)(xdst + (size_t)row * DM) + lane;
#pragma unroll
                for (int j = 0; j < 4; ++j) { const f32x4 s4 = *(const LAS f32x4*)(sc + lane * 4 + 256 * j); o[64 * j] = v[j] * rstd * s4; }
            }
        }
    }
}
__device__ __forceinline__ void mod_finalize(unsigned char* ws, int tid, int G) {
    float* MF = (float*)(ws + WS_MODF);
    for (int idx = blockIdx.x * NTHR + tid; idx < 2 * 4 * 6144; idx += G * NTHR) { const float* mp = (const float*)(ws + WS_MODP) + idx; float s = 0.f;
#pragma unroll
        for (int kc = 0; kc < 8; ++kc) s += mp[(size_t)kc * 2 * 4 * 6144];
        MF[idx] = s; }
}

typedef float f32x4m __attribute__((ext_vector_type(4)));
__device__ __forceinline__ void phase_router(KArgsP a, LAS unsigned char* lds, int tid, int lane, int wave, int G, int l) {
    unsigned char* ws = a->ws;
    LAS float* sc = (LAS float*)lds; LAS float* sh = sc + 1024; LAS float* rstd_s = sh + 1024  ; LAS float* cvec = rstd_s + 128  ; LAS float* cpart = cvec + 64  ;
    LAS float* lg = cpart + 8 * 48  ; LAS int* hist = (LAS int*)(lg + 8 * 16 * 48)  ; LAS int* basev = hist + 32; LAS int* asg_e = basev + 32  ; LAS int* asg_lp = asg_e + 256;
    bf16* HN = (bf16*)(ws + WS_HN); const float* x = a->out; const float* RTW = (const float*)(ws + WS_RTW) + (size_t)l * 1024 * 48;
    int* TOKE = (int*)(ws + WS_TOKE); float* TOKW = (float*)(ws + WS_TOKW); int* LIST = (int*)(ws + WS_LIST); unsigned* CNT = (unsigned*)(ws + WS_CTL) + CW_CNT + l * 32;
    const float* gvec = a->in[I_NORM_FFN] + l * DM;
    for (int c = blockIdx.x; c < NTOK / 128; c += G) {
        const int b = c >> 6;
        __syncthreads();
        for (int j = tid; j < 1024; j += NTHR) { sc[j] = gvec[j] * (1.f + modval(ws, false, l, b, 4 * 1024 + j)); sh[j] = modval(ws, false, l, b, 3 * 1024 + j); }
        if (tid < 32) hist[tid] = 0;
        __syncthreads();
        if (tid < 384) { const int j = tid % 48, part = tid / 48; float s = 0.f;
            for (int k = part * 128; k < part * 128 + 128; ++k) s += sh[k] * RTW[(size_t)k * 48 + j];
            cpart[part * 48 + j] = s; }
        for (int i = 0; i < 16; ++i) {
            const int row = c * 128 + wave * 16 + i;
            const GAS f32x4* xr = (const GAS f32x4*)(x + (size_t)row * DM) + lane;
            f32x4 v[4]; float ss = 0.f;
#pragma unroll
            for (int j = 0; j < 4; ++j) { v[j] = xr[64 * j]; ss += (v[j].x * v[j].x + v[j].y * v[j].y) + (v[j].z * v[j].z + v[j].w * v[j].w); }
            const float rstd = rsqrtf(wave_sum(ss) * (1.f / DM) + NORM_EPS);
            if (lane == 0) rstd_s[wave * 16 + i] = rstd;
            GAS v2u* o = (GAS v2u*)(HN + (size_t)row * DM) + lane;
#pragma unroll
            for (int j = 0; j < 4; ++j) { const f32x4 s4 = *(const LAS f32x4*)(sc + lane * 4 + 256 * j), h4 = *(const LAS f32x4*)(sh + lane * 4 + 256 * j); const f32x4 h = v[j] * rstd * s4 + h4;
                v2u w; w.x = pk2(h.x, h.y); w.y = pk2(h.z, h.w); o[64 * j] = w; }
        }
        __syncthreads();
        if (tid < 48) { float s = 0.f;
#pragma unroll
            for (int p = 0; p < 8; ++p) s += cpart[p * 48 + tid];
            s += tid < 4 ? a->in[I_MBRG][l * 4 + tid] : (tid < 36 ? a->in[I_MBRE][l * 32 + tid - 4] : 0.f); cvec[tid] = s; }
        {
            const int i16 = lane & 15, kq = lane >> 4, r0 = c * 128 + wave * 16;
            f32x4m acc0 = {0.f, 0.f, 0.f, 0.f}, acc1 = acc0, acc2 = acc0;
            const float* xrow = x + (size_t)(r0 + i16) * DM + 4 * kq;
            for (int k0 = 0; k0 < DM; k0 += 16) {
                const f32x4 xv = *(const GAS f32x4*)(xrow + k0); const f32x4 sv = *(const LAS f32x4*)(sc + k0 + 4 * kq);
                const float* wp = RTW + (size_t)(k0 + 4 * kq) * 48 + i16;
#pragma unroll
                for (int j = 0; j < 4; ++j) { const float av = xv[j] * sv[j];
                    acc0 = __builtin_amdgcn_mfma_f32_16x16x4f32(av, wp[j * 48], acc0, 0, 0, 0);
                    acc1 = __builtin_amdgcn_mfma_f32_16x16x4f32(av, wp[j * 48 + 16], acc1, 0, 0, 0);
                    acc2 = __builtin_amdgcn_mfma_f32_16x16x4f32(av, wp[j * 48 + 32], acc2, 0, 0, 0); }
            }
            __syncthreads();
            LAS float* lw = lg + wave * 16 * 48;
#pragma unroll
            for (int r = 0; r < 4; ++r) { const int rr = 4 * kq + r; const float rs = rstd_s[wave * 16 + rr];
                lw[rr * 48 + i16] = acc0[r] * rs + cvec[i16]; lw[rr * 48 + 16 + i16] = acc1[r] * rs + cvec[16 + i16]; lw[rr * 48 + 32 + i16] = acc2[r] * rs + cvec[32 + i16]; }
            LDS_WAIT(); asm volatile("" ::: "memory");
            if (lane < 16) {
                const LAS float* lr = lw + lane * 48; const int row = r0 + lane;
                float g0 = lr[0], g1 = lr[1], g2 = lr[2], g3 = lr[3]; const float gm = fmaxf(fmaxf(g0, g1), fmaxf(g2, g3));
                float p0 = __expf(g0 - gm), p1 = __expf(g1 - gm), p2 = __expf(g2 - gm), p3 = __expf(g3 - gm); const float inv = 1.f / (p0 + p1 + p2 + p3);
                p0 *= inv; p1 *= inv; p2 *= inv; p3 *= inv;
                int gi = 0; float gp = p0; if (p1 > gp) { gp = p1; gi = 1; } if (p2 > gp) { gp = p2; gi = 2; } if (p3 > gp) { gp = p3; gi = 3; }
                float ev0 = -3.4e38f, ev1 = -3.4e38f; int e0 = 0, e1 = 0;
#pragma unroll
                for (int j = 0; j < 8; ++j) { const float s = lr[4 + gi * 8 + j]; if (s > ev0) { ev1 = ev0; e1 = e0; ev0 = s; e0 = j; } else if (s > ev1) { ev1 = s; e1 = j; } }
                const float q = __expf(ev1 - ev0), w0 = gp / (1.f + q), w1 = gp * q / (1.f + q);
                e0 += gi * 8; e1 += gi * 8;
                TOKE[2 * row] = e0; TOKE[2 * row + 1] = e1; TOKW[2 * row] = w0; TOKW[2 * row + 1] = w1;
                const int a0 = 2 * (wave * 16 + lane);
                asg_e[a0] = e0; asg_e[a0 + 1] = e1; asg_lp[a0] = atomicAdd((int*)&hist[e0], 1); asg_lp[a0 + 1] = atomicAdd((int*)&hist[e1], 1);
            }
        }
        __syncthreads();
        if (tid < 32) { const int h = hist[tid]; basev[tid] = h ? (int)atomicAdd(CNT + tid, (unsigned)h) : 0; }
        __syncthreads();
        if (tid < 256) { const int e = asg_e[tid]; LIST[(size_t)e * 65536 + basev[e] + asg_lp[tid]] = (c * 128) * 2 + tid; }
    }
}
__device__ __forceinline__ void build_ptab(const unsigned* CNT, LAS int* ptab, LAS int* pst, LAS int* cnt, int tid) {
    __syncthreads();
    if (tid == 0) { int np = 0;
        for (int e = 0; e < NEXP; ++e) { const int ce = (int)__hip_atomic_load(CNT + e, RLX_AGENT); cnt[e] = ce; pst[e] = np * 256; const int pe = (ce + 255) >> 8;
            for (int p = 0; p < pe; ++p) ptab[1 + np + p] = e;
            np += pe; }
        ptab[0] = np; }
    __syncthreads();
}
__device__ __forceinline__ void phase_gather(KArgsP a, LAS unsigned char* lds, int tid, int lane, int wave, int vcu, int G, int l) {
    unsigned char* ws = a->ws;
    LAS int* ptab = (LAS int*)lds; LAS int* pst = ptab + 512; LAS int* cnt = pst + 32;
    build_ptab((const unsigned*)(ws + WS_CTL) + CW_CNT + l * 32, ptab, pst, cnt, tid);
    const bf16* HN = (const bf16*)(ws + WS_HN); bf16* XG = (bf16*)(ws + WS_XG); int* ROWMAP = (int*)(ws + WS_ROWMAP); const int* LIST = (const int*)(ws + WS_LIST);
    const int nrows = ptab[0] * 256;
    for (int row0 = (vcu * NWAVES + wave) * 4; row0 < nrows; row0 += G * NWAVES * 4) {
        int tok2[4]; v4u p0[4], p1[4];
#pragma unroll
        for (int j = 0; j < 4; ++j) { const int row = row0 + j, e = ptab[1 + (row >> 8)], pos = row - pst[e]; tok2[j] = (pos < cnt[e]) ? LIST[(size_t)e * 65536 + pos] : -1; }
#pragma unroll
        for (int j = 0; j < 4; ++j) { if (tok2[j] >= 0) { const GAS v4u* s = (const GAS v4u*)(HN + (size_t)(tok2[j] >> 1) * DM) + lane; p0[j] = s[0]; p1[j] = s[64]; } else { p0[j] = (v4u){0u, 0u, 0u, 0u}; p1[j] = p0[j]; } }
#pragma unroll
        for (int j = 0; j < 4; ++j) { GAS v4u* d = (GAS v4u*)(XG + (size_t)(row0 + j) * DM) + lane; d[0] = p0[j]; d[64] = p1[j]; if (lane == 0) ROWMAP[row0 + j] = tok2[j]; }
    }
}

typedef short bf16x8 __attribute__((ext_vector_type(8)));
constexpr int MT = 72;
constexpr int ML_XP = 0;
constexpr int ML_CX = 17152;
constexpr int ML_WQ = ML_CX + 9216, ML_WK = ML_WQ + 9216;
constexpr int ML_Q = ML_WK + 9216, ML_K = ML_Q + 9216;
constexpr int ML_S = ML_K + 9216;
constexpr int ML_VT = ML_S + 9216;
constexpr int ML_CT = ML_VT + 11520;
constexpr int ML_H = ML_CT + 11520;
constexpr int ML_SM = ML_H + 16640;
static_assert(ML_SM + 2048 <= RING_BYTES, "mLSTM LDS map");
__device__ __forceinline__ float logsigmoidf_(float x) { return fminf(x, 0.f) - log1pf(__expf(-fabsf(x))); }
__device__ __forceinline__ void mma64(const LAS bf16* A, int arow0, const LAS bf16* Bt, int brow0, int lane, f32x4& acc) {
    const LAS bf16* ap = A + (arow0 + (lane & 15)) * MT + 8 * (lane >> 4); const LAS bf16* bp = Bt + (brow0 + (lane & 15)) * MT + 8 * (lane >> 4);
    const bf16x8 a0 = *(const LAS bf16x8*)ap, a1 = *(const LAS bf16x8*)(ap + 32), b0 = *(const LAS bf16x8*)bp, b1 = *(const LAS bf16x8*)(bp + 32);
    acc = __builtin_amdgcn_mfma_f32_16x16x32_bf16(a0, b0, acc, 0, 0, 0); acc = __builtin_amdgcn_mfma_f32_16x16x32_bf16(a1, b1, acc, 0, 0, 0);
}
__device__ __forceinline__ void ml_front(KArgsP a, LAS unsigned char* lds, int tid, int l, int b, int c, int h, bool want_q) {
    const bf16* PROJ = (const bf16*)(a->ws + WS_PROJ); const size_t row0 = (size_t)b * SEQ + c * 64;
    LAS float* xp = (LAS float*)(lds + ML_XP);
    for (int idx = tid; idx < 67 * 8; idx += NTHR) { const int r = idx >> 3, c8 = idx & 7, tr = c * 64 + r - 3; LAS float* d = xp + r * 64 + c8 * 8;
        if (tr >= 0) { const v4u p = *(const GAS v4u*)(PROJ + ((size_t)b * SEQ + tr) * NPROJ + PC_QK + h * 64 + c8 * 8);
            *(LAS f32x4*)d = (f32x4){bflo(p.x), bfhi(p.x), bflo(p.y), bfhi(p.y)}; *(LAS f32x4*)(d + 4) = (f32x4){bflo(p.z), bfhi(p.z), bflo(p.w), bfhi(p.w)}; }
        else { *(LAS f32x4*)d = (f32x4){0.f, 0.f, 0.f, 0.f}; *(LAS f32x4*)(d + 4) = (f32x4){0.f, 0.f, 0.f, 0.f}; } }
    {
        const int t = tid >> 3, vg = tid & 7; LAS bf16* VT = (LAS bf16*)(lds + ML_VT);
        const v4u p = *(const GAS v4u*)(PROJ + (row0 + t) * NPROJ + PC_V + h * 64 + vg * 8);
        const unsigned w[4] = {p.x, p.y, p.z, p.w};
#pragma unroll
        for (int j = 0; j < 4; ++j) { VT[(vg * 8 + 2 * j) * MT + t] = (bf16)(w[j] & 0xffffu); VT[(vg * 8 + 2 * j + 1) * MT + t] = (bf16)(w[j] >> 16); }
        for (int idx = tid; idx < 16 * 64; idx += NTHR) VT[(64 + (idx >> 6)) * MT + (idx & 63)] = (idx < 64) ? (bf16)0x3F80 : (bf16)0;
        const bf16* WT = (const bf16*)(a->ws + WS_MLW) + (size_t)((l * NH + h) * 2) * 4096;
        const int e = tid >> 3, d8 = tid & 7;
        if (want_q) *(LAS v4u*)(lds + ML_WQ + (e * MT + d8 * 8) * 2) = *(const GAS v4u*)(WT + e * 64 + d8 * 8);
        *(LAS v4u*)(lds + ML_WK + (e * MT + d8 * 8) * 2) = *(const GAS v4u*)(WT + 4096 + e * 64 + d8 * 8);
    }
    __syncthreads();
    const float* cw = a->in[I_CONV_W] + (size_t)l * 4 * DA + h * 64; const float* cb = a->in[I_CONV_B] + (size_t)l * DA + h * 64;
    {
        const int t = tid >> 3, c8 = (tid & 7) * 8; float s[8];
#pragma unroll
        for (int j = 0; j < 8; ++j) s[j] = cb[c8 + j];
#pragma unroll
        for (int q = 0; q < 4; ++q) { const f32x4 x0 = *(const LAS f32x4*)(xp + (t + q) * 64 + c8), x1 = *(const LAS f32x4*)(xp + (t + q) * 64 + c8 + 4); const float* w = cw + q * DA + c8;
            s[0] += x0.x * w[0]; s[1] += x0.y * w[1]; s[2] += x0.z * w[2]; s[3] += x0.w * w[3]; s[4] += x1.x * w[4]; s[5] += x1.y * w[5]; s[6] += x1.z * w[6]; s[7] += x1.w * w[7]; }
#pragma unroll
        for (int j = 0; j < 8; ++j) s[j] = s[j] / (1.f + __expf(-s[j]));
        v4u o; o.x = pk2(s[0], s[1]); o.y = pk2(s[2], s[3]); o.z = pk2(s[4], s[5]); o.w = pk2(s[6], s[7]);
        *(LAS v4u*)(lds + ML_CX + (t * MT + c8) * 2) = o;
    }
}
__device__ __forceinline__ void phase_m1(KArgsP a, LAS unsigned char* lds, int tid, int lane, int wave, int vcu, int G, int l) {
    unsigned char* ws = a->ws; const float* GT = (const float*)(ws + WS_GATES);
    float* CLOC = (float*)(ws + WS_CLOC); float* MLG = (float*)(ws + WS_MSC); float* MLM = MLG + 4096;
    LAS float* sm = (LAS float*)(lds + ML_SM);
    for (int u = vcu; u < NUNIT_M; u += G) {
        const int h = u % NH, c = (u / NH) % NCH, b = u / (NH * NCH); const size_t row0 = (size_t)b * SEQ + c * 64;
        __syncthreads();
        ml_front(a, lds, tid, l, b, c, h, false);
        if (wave == 0) {
            const float ig = GT[(row0 + lane) * 16 + h] + a->in[I_BI][l * NH + h];
            const float fl = logsigmoidf_(GT[(row0 + lane) * 16 + 6 + h] + a->in[I_BF][l * NH + h]);
            float bc = fl;
#pragma unroll
            for (int o = 1; o < 64; o <<= 1) { const float t = __shfl_up(bc, o); if (lane >= o) bc += t; }
            const float gtot = __shfl(bc, 63); const float lw = gtot - bc + ig; const float ml = wave_max(lw);
            sm[lane] = __expf(lw - ml);
            if (lane == 0) { MLG[u] = gtot; MLM[u] = ml; }
        }
        __syncthreads();
        {
            const int rt = wave >> 1; LAS bf16* KT = (LAS bf16*)(lds + ML_K);
#pragma unroll
            for (int q = 0; q < 2; ++q) { const int ct = 2 * (wave & 1) + q; f32x4 acc = {0.f, 0.f, 0.f, 0.f};
                mma64((const LAS bf16*)(lds + ML_CX), 16 * rt, (const LAS bf16*)(lds + ML_WK), 16 * ct, lane, acc);
                const int t0 = 16 * rt + 4 * (lane >> 4), e = 16 * ct + (lane & 15);
                const float w0 = sm[t0] * 0.125f, w1 = sm[t0 + 1] * 0.125f, w2 = sm[t0 + 2] * 0.125f, w3 = sm[t0 + 3] * 0.125f;
                v2u o; o.x = pk2(acc[0] * w0, acc[1] * w1); o.y = pk2(acc[2] * w2, acc[3] * w3);
                *(LAS v2u*)(KT + e * MT + t0) = o; }
        }
        __syncthreads();
        {
            const int ct = wave & 3, r_lo = wave < 4 ? 0 : 3, r_hi = wave < 4 ? 3 : 5; float* cl = CLOC + (size_t)u * CL_STRIDE;
            for (int rt = r_lo; rt < r_hi; ++rt) { f32x4 acc = {0.f, 0.f, 0.f, 0.f};
                mma64((const LAS bf16*)(lds + ML_VT), 16 * rt, (const LAS bf16*)(lds + ML_K), 16 * ct, lane, acc);
                const int v0 = 16 * rt + 4 * (lane >> 4), e = 16 * ct + (lane & 15);
                if (rt < 4) {
#pragma unroll
                    for (int r = 0; r < 4; ++r) cl[(v0 + r) * 64 + e] = acc[r];
                } else if ((lane >> 4) == 0) cl[4096 + e] = acc[0]; }
        }
    }
}
__device__ __forceinline__ void phase_m2(unsigned char* ws, int tid, int wg, int nwg) {
    float* CLOC = (float*)(ws + WS_CLOC); const float* MLG = (const float*)(ws + WS_MSC); const float* MLM = MLG + 4096; float* MST = (float*)(ws + WS_MSC) + 8192;
    for (int idx = wg * NTHR + tid; idx < NB * NH * CL_STRIDE; idx += nwg * NTHR) {
        const int e = idx % CL_STRIDE, bh = idx / CL_STRIDE, b = bh / NH, h = bh % NH;
        float m = 0.f, cs = 0.f;
        for (int c0 = 0; c0 < NCH; c0 += 8) {
            float cl[8], g[8], ml[8];
#pragma unroll
            for (int j = 0; j < 8; ++j) { const int u = (b * NCH + c0 + j) * NH + h; cl[j] = CLOC[(size_t)u * CL_STRIDE + e]; g[j] = MLG[u]; ml[j] = MLM[u]; }
#pragma unroll
            for (int j = 0; j < 8; ++j) { const int u = (b * NCH + c0 + j) * NH + h;
                CLOC[(size_t)u * CL_STRIDE + e] = cs; if (e == 0) MST[u] = m;
                const float mn = fmaxf(g[j] + m, ml[j]); const float ao = __expf(g[j] + m - mn), al = __expf(ml[j] - mn);
                cs = ao * cs + al * cl[j]; m = mn; }
        }
    }
}
__device__ __forceinline__ void phase_m3(KArgsP a, LAS unsigned char* lds, int tid, int lane, int wave, int vcu, int G, int l) {
    unsigned char* ws = a->ws; const bf16* PROJ = (const bf16*)(ws + WS_PROJ); const float* GT = (const float*)(ws + WS_GATES);
    const float* CLOC = (const float*)(ws + WS_CLOC); const float* MST = (const float*)(ws + WS_MSC) + 8192; bf16* YC = (bf16*)(ws + WS_YC);
    LAS float* sm = (LAS float*)(lds + ML_SM); LAS float* hb = (LAS float*)(lds + ML_H);
    for (int u = vcu; u < NUNIT_M; u += G) {
        const int h = u % NH, c = (u / NH) % NCH, b = u / (NH * NCH); const size_t row0 = (size_t)b * SEQ + c * 64;
        __syncthreads();
        ml_front(a, lds, tid, l, b, c, h, true);
        {
            const float* cl = CLOC + (size_t)u * CL_STRIDE; LAS bf16* CT = (LAS bf16*)(lds + ML_CT);
            for (int idx = tid; idx < 65 * 16; idx += NTHR) { const int r = idx >> 4, c4 = idx & 15; const f32x4 v = *(const GAS f32x4*)(cl + r * 64 + c4 * 4);
                v2u o; o.x = pk2(v.x, v.y); o.y = pk2(v.z, v.w); *(LAS v2u*)(CT + r * MT + c4 * 4) = o; }
            for (int idx = tid; idx < 15 * 64; idx += NTHR) CT[(65 + (idx >> 6)) * MT + (idx & 63)] = 0;
        }
        if (wave == 0) {
            const float ig = GT[(row0 + lane) * 16 + h] + a->in[I_BI][l * NH + h];
            const float fl = logsigmoidf_(GT[(row0 + lane) * 16 + 6 + h] + a->in[I_BF][l * NH + h]);
            float bc = fl;
#pragma unroll
            for (int o = 1; o < 64; o <<= 1) { const float t = __shfl_up(bc, o); if (lane >= o) bc += t; }
            float pm = ig - bc;
#pragma unroll
            for (int o = 1; o < 64; o <<= 1) { const float t = __shfl_up(pm, o); if (lane >= o) pm = fmaxf(pm, t); }
            const float mst = MST[u]; const float inter = bc + mst, mt = fmaxf(inter, bc + pm);
            sm[lane] = ig - bc; sm[64 + lane] = bc - mt; sm[128 + lane] = __expf(inter - mt); sm[192 + lane] = __expf(-mt);
        }
        __syncthreads();
        {
            const int rt = wave >> 1; LAS bf16* Qs = (LAS bf16*)(lds + ML_Q); LAS bf16* Ks = (LAS bf16*)(lds + ML_K);
#pragma unroll
            for (int q = 0; q < 2; ++q) { const int ct = 2 * (wave & 1) + q; f32x4 aq = {0.f, 0.f, 0.f, 0.f}, ak = {0.f, 0.f, 0.f, 0.f};
                mma64((const LAS bf16*)(lds + ML_CX), 16 * rt, (const LAS bf16*)(lds + ML_WQ), 16 * ct, lane, aq);
                mma64((const LAS bf16*)(lds + ML_CX), 16 * rt, (const LAS bf16*)(lds + ML_WK), 16 * ct, lane, ak);
                const int t0 = 16 * rt + 4 * (lane >> 4), e = 16 * ct + (lane & 15);
#pragma unroll
                for (int r = 0; r < 4; ++r) { Qs[(t0 + r) * MT + e] = (bf16)f2bf(aq[r]); Ks[(t0 + r) * MT + e] = (bf16)f2bf(ak[r] * 0.125f); } }
        }
        __syncthreads();
        {
            const int rt = wave >> 1; LAS bf16* Ss = (LAS bf16*)(lds + ML_S);
#pragma unroll
            for (int q = 0; q < 2; ++q) { const int ct = 2 * (wave & 1) + q; f32x4 acc = {0.f, 0.f, 0.f, 0.f};
                if (ct <= rt) mma64((const LAS bf16*)(lds + ML_Q), 16 * rt, (const LAS bf16*)(lds + ML_K), 16 * ct, lane, acc);
                const int t0 = 16 * rt + 4 * (lane >> 4), s = 16 * ct + (lane & 15); const float qs = sm[s];
#pragma unroll
                for (int r = 0; r < 4; ++r) { const int t = t0 + r; Ss[t * MT + s] = (bf16)f2bf((s <= t) ? acc[r] * __expf(sm[64 + t] + qs) : 0.f); } }
        }
        __syncthreads();
        {
            const int rt = wave >> 1, nt = (wave & 1) ? 2 : 3;
            for (int q = 0; q < nt; ++q) { const int ct = (wave & 1) ? 2 + q : (q < 2 ? q : 4); f32x4 aA = {0.f, 0.f, 0.f, 0.f}, aB = {0.f, 0.f, 0.f, 0.f};
                mma64((const LAS bf16*)(lds + ML_Q), 16 * rt, (const LAS bf16*)(lds + ML_CT), 16 * ct, lane, aA);
                mma64((const LAS bf16*)(lds + ML_S), 16 * rt, (const LAS bf16*)(lds + ML_VT), 16 * ct, lane, aB);
                const int t0 = 16 * rt + 4 * (lane >> 4), v = 16 * ct + (lane & 15);
#pragma unroll
                for (int r = 0; r < 4; ++r) { const int t = t0 + r; const float x = sm[128 + t] * aA[r] + aB[r];
                    if (ct < 4) hb[t * 65 + v] = x; else if ((lane & 15) == 0) sm[256 + t] = x; } }
        }
        __syncthreads();
        {
            const int t = tid >> 3, vg = tid & 7; float acc[8];
            const float dn = 1.f / fmaxf(fabsf(sm[256 + t]), sm[192 + t]);
            float s1 = 0.f;
#pragma unroll
            for (int j = 0; j < 8; ++j) { acc[j] = hb[t * 65 + vg * 8 + j] * dn; s1 += acc[j]; }
            s1 += __shfl_xor(s1, 1); s1 += __shfl_xor(s1, 2); s1 += __shfl_xor(s1, 4);
            const float mu = s1 * (1.f / 64.f); float s2 = 0.f;
#pragma unroll
            for (int j = 0; j < 8; ++j) { acc[j] -= mu; s2 += acc[j] * acc[j]; }
            s2 += __shfl_xor(s2, 1); s2 += __shfl_xor(s2, 2); s2 += __shfl_xor(s2, 4);
            const float rs = rsqrtf(s2 * (1.f / 64.f) + HEAD_NORM_EPS);
            const float* nw = a->in[I_MNORM_W] + (size_t)l * DA + h * 64 + vg * 8;
            const v4u ov = *(const GAS v4u*)(PROJ + (row0 + t) * NPROJ + PC_O + h * 64 + vg * 8);
            const float o[8] = {bflo(ov.x), bfhi(ov.x), bflo(ov.y), bfhi(ov.y), bflo(ov.z), bfhi(ov.z), bflo(ov.w), bfhi(ov.w)};
            float r[8];
#pragma unroll
            for (int j = 0; j < 8; ++j) r[j] = acc[j] * rs * nw[j] * sigmoidf_(o[j]);
            v4u w; w.x = pk2(r[0], r[1]); w.y = pk2(r[2], r[3]); w.z = pk2(r[4], r[5]); w.w = pk2(r[6], r[7]);
            *(GAS v4u*)(YC + (row0 + t) * DM + h * 64 + vg * 8) = w;
        }
    }
}

constexpr int S5_UT = 264, S5_XT = 2056;
constexpr int S5_U = 0, S5_Z = 33792, S5_X = 67584;
static_assert(S5_X + 16 * S5_XT * 2 <= MISC_OFF, "S5 LDS map");
struct S5A { float are, aim, cre, cim; };
__device__ __forceinline__ S5A s5_a(KArgsP a, int l, int g, int p) {
    const float lam_re = a->in[I_S5ARE][(size_t)(l * 16 + g) * 64 + p], lam_im = a->in[I_S5AIM][(size_t)(l * 16 + g) * 64 + p];
    const float dt = expf(a->in[I_S5LDT][l * 16 + g]); const float mag = expf(lam_re * dt), ang = lam_im * dt;
    S5A r; r.are = mag * cosf(ang); r.aim = mag * sinf(ang);
    const float inv = 1.f / (lam_re * lam_re + lam_im * lam_im);
    r.cre = ((r.are - 1.f) * lam_re + r.aim * lam_im) * inv; r.cim = (r.aim * lam_re - (r.are - 1.f) * lam_im) * inv; return r;
}
__device__ __forceinline__ bf16x8 pack8(const float* v) { v4u o; o.x = pk2(v[0], v[1]); o.y = pk2(v[2], v[3]); o.z = pk2(v[4], v[5]); o.w = pk2(v[6], v[7]); return __builtin_bit_cast(bf16x8, o); }
__device__ __forceinline__ void s5_bfrag(KArgsP a, int l, int g, int lane, bf16x8 (&bf)[8]) {
#pragma unroll
    for (int j = 0; j < 8; ++j) { const int n = 16 * j + (lane & 15), p = n >> 1, im = n & 1, kq = lane >> 4; float v[8];
        if (kq < 2) { const S5A A = s5_a(a, l, g, p);
            const float* br = a->in[I_S5BRE] + ((size_t)(l * 16 + g) * 64 + p) * 16 + 8 * kq; const float* bi = a->in[I_S5BIM] + ((size_t)(l * 16 + g) * 64 + p) * 16 + 8 * kq;
#pragma unroll
            for (int q = 0; q < 8; ++q) v[q] = im ? (A.cre * bi[q] + A.cim * br[q]) : (A.cre * br[q] - A.cim * bi[q]);
        } else {
#pragma unroll
            for (int q = 0; q < 8; ++q) v[q] = 0.f; }
        bf[j] = pack8(v); }
}
__device__ __forceinline__ void s5_load_u(const unsigned char* ws, LAS unsigned char* lds, int tid, size_t row0) {
    const bf16* PROJ = (const bf16*)(ws + WS_PROJ);
    for (int idx = tid; idx < 64 * 32; idx += NTHR) { const int t = idx >> 5, c8 = idx & 31;
        *(LAS v4u*)(lds + S5_U + (t * S5_UT + c8 * 8) * 2) = *(const GAS v4u*)(PROJ + (row0 + t) * NPROJ + PC_S5 + c8 * 8); }
}
__device__ __forceinline__ void s5_block(LAS unsigned char* lds, int lane, int tb, int g, const bf16x8 (&bf)[8], float are, float aim, float& xr, float& xi) {
    const int kq = lane >> 4; bf16x8 uf = {0, 0, 0, 0, 0, 0, 0, 0};
    if (kq < 2) uf = *(const LAS bf16x8*)(lds + S5_U + ((16 * tb + (lane & 15)) * S5_UT + g * 16 + 8 * kq) * 2);
    LAS bf16* X = (LAS bf16*)(lds + S5_X);
#pragma unroll
    for (int j = 0; j < 8; ++j) { f32x4 acc = {0.f, 0.f, 0.f, 0.f}; acc = __builtin_amdgcn_mfma_f32_16x16x32_bf16(bf[j], uf, acc, 0, 0, 0);
        v2u o; o.x = pk2(acc[0], acc[1]); o.y = pk2(acc[2], acc[3]); *(LAS v2u*)(X + (lane & 15) * S5_XT + g * 128 + 16 * j + 4 * kq) = o; }
    LDS_WAIT(); asm volatile("" ::: "memory");
    LAS unsigned* xw = (LAS unsigned*)(lds + S5_X) + (g * 128 + 2 * lane) / 2;
#pragma unroll
    for (int t = 0; t < 16; ++t) { const unsigned w = xw[t * (S5_XT / 2)]; const float br = bflo(w), bi = bfhi(w);
        const float nr = are * xr - aim * xi + br, ni = are * xi + aim * xr + bi; xr = nr; xi = ni;
        xw[t * (S5_XT / 2)] = pk2(xr, xi); }
    LDS_WAIT(); asm volatile("" ::: "memory");
}
__device__ __forceinline__ void phase_s1(KArgsP a, LAS unsigned char* lds, int tid, int lane, int wave, int vcu, int G, int l) {
    unsigned char* ws = a->ws; float* ST = (float*)(ws + WS_S5ST);
    bf16x8 bf0[8], bf1[8]; s5_bfrag(a, l, wave, lane, bf0); s5_bfrag(a, l, wave + 8, lane, bf1);
    const S5A A0 = s5_a(a, l, wave, lane), A1 = s5_a(a, l, wave + 8, lane);
    for (int u = vcu; u < NB * NCH; u += G) {
        const size_t row0 = (size_t)u * 64;
        __syncthreads();
        s5_load_u(ws, lds, tid, row0);
        __syncthreads();
        float x0r = 0.f, x0i = 0.f, x1r = 0.f, x1i = 0.f;
        for (int tb = 0; tb < 4; ++tb) { s5_block(lds, lane, tb, wave, bf0, A0.are, A0.aim, x0r, x0i); s5_block(lds, lane, tb, wave + 8, bf1, A1.are, A1.aim, x1r, x1i); }
        *(f32x2*)(ST + (((size_t)u * 16 + wave) * 64 + lane) * 2) = (f32x2){x0r, x0i};
        *(f32x2*)(ST + (((size_t)u * 16 + wave + 8) * 64 + lane) * 2) = (f32x2){x1r, x1i};
    }
}
__device__ __forceinline__ void phase_s2(KArgsP a, int tid, int wg, int nwg, int l) {
    float* ST = (float*)(a->ws + WS_S5ST);
    for (int idx = wg * NTHR + tid; idx < NB * 1024; idx += nwg * NTHR) {
        const int b = idx >> 10, gp = idx & 1023, g = gp >> 6, p = gp & 63;
        const S5A A = s5_a(a, l, g, p); float ar = A.are, ai = A.aim;
#pragma unroll
        for (int s = 0; s < 6; ++s) { const float nr = ar * ar - ai * ai, ni = 2.f * ar * ai; ar = nr; ai = ni; }
        float cr = 0.f, ci = 0.f;
        for (int c0 = 0; c0 < NCH; c0 += 8) {
            f32x2 e[8];
#pragma unroll
            for (int j = 0; j < 8; ++j) e[j] = *(const f32x2*)(ST + (((size_t)(b * NCH + c0 + j) * 16 + g) * 64 + p) * 2);
#pragma unroll
            for (int j = 0; j < 8; ++j) { *(f32x2*)(ST + (((size_t)(b * NCH + c0 + j) * 16 + g) * 64 + p) * 2) = (f32x2){cr, ci};
                const float nr = ar * cr - ai * ci + e[j].x, ni = ar * ci + ai * cr + e[j].y; cr = nr; ci = ni; }
        }
    }
}
__device__ __forceinline__ float gelu_tanh_(float x) { const float t = tanhf(0.7978845608f * (x + 0.044715f * x * x * x)); return 0.5f * x * (1.f + t); }
__device__ __forceinline__ void s5_cproj(LAS unsigned char* lds, int lane, int tb, int g, const bf16* cmt  , const float (&dv)[4]) {
    const int kq = lane >> 4; f32x4 acc = {0.f, 0.f, 0.f, 0.f};
    bf16x8 cf[4];
#pragma unroll
    for (int s = 0; s < 4; ++s) cf[s] = __builtin_bit_cast(bf16x8, *(const GAS v4u*)(cmt + (lane & 15) * 128 + 32 * s + 8 * kq));
    const LAS bf16* xp = (const LAS bf16*)(lds + S5_X) + (lane & 15) * S5_XT + g * 128 + 8 * kq;
#pragma unroll
    for (int s = 0; s < 4; ++s) acc = __builtin_amdgcn_mfma_f32_16x16x32_bf16(cf[s], *(const LAS bf16x8*)(xp + 32 * s), acc, 0, 0, 0);
    const int t = 16 * tb + (lane & 15), c0 = g * 16 + 4 * kq;
    const v2u uw = *(const LAS v2u*)(lds + S5_U + (t * S5_UT + c0) * 2);
    const float u4[4] = {bflo(uw.x), bfhi(uw.x), bflo(uw.y), bfhi(uw.y)}; float z[4];
#pragma unroll
    for (int r = 0; r < 4; ++r) z[r] = gelu_tanh_(acc[r] + dv[r] * u4[r]);
    v2u o; o.x = pk2(z[0], z[1]); o.y = pk2(z[2], z[3]); *(LAS v2u*)(lds + S5_Z + (t * S5_UT + c0) * 2) = o;
}
__device__ __forceinline__ void phase_s3(KArgsP a, LAS unsigned char* lds, int tid, int lane, int wave, int vcu, int G, int l) {
    unsigned char* ws = a->ws; const float* ST = (const float*)(ws + WS_S5ST); bf16* YC = (bf16*)(ws + WS_YC);
    const bf16* GLUT = (const bf16*)(ws + WS_GLUT) + (size_t)l * DC * DC;
    bf16x8 bf0[8], bf1[8]; s5_bfrag(a, l, wave, lane, bf0); s5_bfrag(a, l, wave + 8, lane, bf1);
    const bf16* cm0 = (const bf16*)(ws + WS_S5CM) + (size_t)(l * 16 + wave) * 2048; const bf16* cm1 = cm0 + 8 * 2048;
    const S5A A0 = s5_a(a, l, wave, lane), A1 = s5_a(a, l, wave + 8, lane);
    float d0[4], d1[4];
#pragma unroll
    for (int r = 0; r < 4; ++r) { d0[r] = a->in[I_S5D][l * DC + wave * 16 + 4 * (lane >> 4) + r]; d1[r] = a->in[I_S5D][l * DC + (wave + 8) * 16 + 4 * (lane >> 4) + r]; }
    for (int u = vcu; u < NB * NCH; u += G) {
        const size_t row0 = (size_t)u * 64;
        __syncthreads();
        s5_load_u(ws, lds, tid, row0);
        const f32x2 s0 = *(const f32x2*)(ST + (((size_t)u * 16 + wave) * 64 + lane) * 2), s1 = *(const f32x2*)(ST + (((size_t)u * 16 + wave + 8) * 64 + lane) * 2);
        float x0r = s0.x, x0i = s0.y, x1r = s1.x, x1i = s1.y;
        __syncthreads();
        for (int tb = 0; tb < 4; ++tb) {
            s5_block(lds, lane, tb, wave, bf0, A0.are, A0.aim, x0r, x0i); s5_cproj(lds, lane, tb, wave, cm0, d0);
            s5_block(lds, lane, tb, wave + 8, bf1, A1.are, A1.aim, x1r, x1i); s5_cproj(lds, lane, tb, wave + 8, cm1, d1);
        }
        __syncthreads();
        {
            const int kq = lane >> 4;
#pragma unroll
            for (int q = 0; q < 2; ++q) { const int ct = 2 * wave + q; f32x4 acc[4];
#pragma unroll
                for (int rt = 0; rt < 4; ++rt) acc[rt] = (f32x4){0.f, 0.f, 0.f, 0.f};
                const bf16* gp = GLUT + (size_t)(16 * ct + (lane & 15)) * DC + 8 * kq;
#pragma unroll 2
                for (int s = 0; s < 8; ++s) { const bf16x8 gf = __builtin_bit_cast(bf16x8, *(const GAS v4u*)(gp + 32 * s));
#pragma unroll
                    for (int rt = 0; rt < 4; ++rt) acc[rt] = __builtin_amdgcn_mfma_f32_16x16x32_bf16(gf, *(const LAS bf16x8*)(lds + S5_Z + ((16 * rt + (lane & 15)) * S5_UT + 32 * s + 8 * kq) * 2), acc[rt], 0, 0, 0); }
                const int j0 = 16 * ct + 4 * kq; const f32x4 gb = *(const GAS f32x4*)(a->in[I_S5GLUB] + l * DC + j0);
#pragma unroll
                for (int rt = 0; rt < 4; ++rt) { const int t = 16 * rt + (lane & 15); const v2u zw = *(const LAS v2u*)(lds + S5_Z + (t * S5_UT + j0) * 2);
                    const float z0 = bflo(zw.x), z1 = bfhi(zw.x), z2 = bflo(zw.y), z3 = bfhi(zw.y);
                    v2u o; o.x = pk2(z0 * sigmoidf_(acc[rt][0] + gb.x), z1 * sigmoidf_(acc[rt][1] + gb.y)); o.y = pk2(z2 * sigmoidf_(acc[rt][2] + gb.z), z3 * sigmoidf_(acc[rt][3] + gb.w));
                    *(GAS v2u*)(YC + (row0 + t) * DM + 768 + j0) = o; } }
        }
    }
}

__device__ __forceinline__ float rw_shift(const bf16* PROJ, const float* mu, size_t row, int col) {
    const float cur = bf2f(PROJ[row * NPROJ + PC_RW + col]); const float prv = (row % SEQ) ? bf2f(PROJ[(row - 1) * NPROJ + PC_RW + col]) : 0.f;
    return cur + mu[col] * (prv - cur);
}
__device__ __forceinline__ void phase_r1(KArgsP a, LAS unsigned char* lds, int tid, int vcu, int G, int l) {
    unsigned char* ws = a->ws; const bf16* PROJ = (const bf16*)(ws + WS_PROJ); const float* mu = a->in[I_RMU] + (size_t)l * RW_COLS;
    bf16* RE = (bf16*)(ws + WS_RE); bf16* RA = (bf16*)(ws + WS_RA); bf16* RG = (bf16*)(ws + WS_RG); bf16* RVG = (bf16*)(ws + WS_RVG);
    LAS float* th = (LAS float*)lds; LAS float* ads = th + 32 * 64; LAS float* sgs = ads + 32 * 64; LAS float* vsh = sgs + 32 * 128; LAS float* tmp = vsh + 32 * 384;
    const int cg = tid & 127, tq = tid >> 7;
    for (int u = vcu; u < NTOK / 32; u += G) {
        const size_t row0 = (size_t)u * 32;
        __syncthreads();
        for (int idx = tid; idx < 32 * 256; idx += NTHR) { const int tt = idx >> 8, col = idx & 255; const float xs = rw_shift(PROJ, mu, row0 + tt, RWC_WD + col);
            if (col < 64) th[tt * 64 + col] = tanhf(xs); else if (col < 128) ads[tt * 64 + col - 64] = xs; else sgs[tt * 128 + col - 128] = sigmoidf_(xs); }
        if (l > 0) for (int idx = tid; idx < 32 * 384; idx += NTHR) { const int tt = idx / 384, col = idx % 384; vsh[idx] = rw_shift(PROJ, mu, row0 + tt, RWC_V + col); }
        __syncthreads();
        float acc[3][8];
#pragma unroll
        for (int ci = 0; ci < 3; ++ci)
#pragma unroll
            for (int k = 0; k < 8; ++k) acc[ci][k] = 0.f;
        { const float* W = a->in[I_RWUP] + (size_t)l * 64 * DBR + cg;
#pragma unroll 2
          for (int j = 0; j < 64; ++j) { const float w0 = W[j * DBR], w1 = W[j * DBR + 128], w2 = W[j * DBR + 256];
#pragma unroll
              for (int k = 0; k < 8; ++k) { const float av = th[(tq * 8 + k) * 64 + j]; acc[0][k] += av * w0; acc[1][k] += av * w1; acc[2][k] += av * w2; } } }
#pragma unroll
        for (int ci = 0; ci < 3; ++ci) { const int c = cg + 128 * ci; const float w0 = a->in[I_RW0][l * DBR + c];
#pragma unroll
            for (int k = 0; k < 8; ++k) RE[(row0 + tq * 8 + k) * DBR + c] = (bf16)f2bf(0.60653066f * sigmoidf_(w0 + acc[ci][k])); }
#pragma unroll
        for (int ci = 0; ci < 3; ++ci)
#pragma unroll
            for (int k = 0; k < 8; ++k) acc[ci][k] = 0.f;
        { const float* W = a->in[I_RAUP] + (size_t)l * 64 * DBR + cg;
#pragma unroll 2
          for (int j = 0; j < 64; ++j) { const float w0 = W[j * DBR], w1 = W[j * DBR + 128], w2 = W[j * DBR + 256];
#pragma unroll
              for (int k = 0; k < 8; ++k) { const float av = ads[(tq * 8 + k) * 64 + j]; acc[0][k] += av * w0; acc[1][k] += av * w1; acc[2][k] += av * w2; } } }
#pragma unroll
        for (int ci = 0; ci < 3; ++ci) { const int c = cg + 128 * ci; const float a0 = a->in[I_RA0][l * DBR + c];
#pragma unroll
            for (int k = 0; k < 8; ++k) RA[(row0 + tq * 8 + k) * DBR + c] = (bf16)f2bf(sigmoidf_(a0 + acc[ci][k])); }
#pragma unroll
        for (int ci = 0; ci < 3; ++ci)
#pragma unroll
            for (int k = 0; k < 8; ++k) acc[ci][k] = 0.f;
        { const float* W = a->in[I_RGUP] + (size_t)l * 128 * DBR + cg;
#pragma unroll 2
          for (int j = 0; j < 128; ++j) { const float w0 = W[j * DBR], w1 = W[j * DBR + 128], w2 = W[j * DBR + 256];
#pragma unroll
              for (int k = 0; k < 8; ++k) { const float av = sgs[(tq * 8 + k) * 128 + j]; acc[0][k] += av * w0; acc[1][k] += av * w1; acc[2][k] += av * w2; } } }
#pragma unroll
        for (int ci = 0; ci < 3; ++ci) { const int c = cg + 128 * ci;
#pragma unroll
            for (int k = 0; k < 8; ++k) RG[(row0 + tq * 8 + k) * DBR + c] = (bf16)f2bf(acc[ci][k]); }
        if (l > 0) {
            { const int tt = tid >> 4, m2 = tid & 15; const float* W = a->in[I_RVDN] + m2; float s0 = 0.f, s1 = 0.f;
#pragma unroll 4
              for (int i = 0; i < 384; ++i) { const float v = vsh[tt * 384 + i]; s0 += v * W[i * 32]; s1 += v * W[i * 32 + 16]; }
              tmp[tt * 32 + m2] = s0; tmp[tt * 32 + m2 + 16] = s1; }
            __syncthreads();
#pragma unroll
            for (int ci = 0; ci < 3; ++ci)
#pragma unroll
                for (int k = 0; k < 8; ++k) acc[ci][k] = 0.f;
            { const float* W = a->in[I_RVUP] + cg;
#pragma unroll 2
              for (int j = 0; j < 32; ++j) { const float w0 = W[j * DBR], w1 = W[j * DBR + 128], w2 = W[j * DBR + 256];
#pragma unroll
                  for (int k = 0; k < 8; ++k) { const float av = tmp[(tq * 8 + k) * 32 + j]; acc[0][k] += av * w0; acc[1][k] += av * w1; acc[2][k] += av * w2; } } }
#pragma unroll
            for (int ci = 0; ci < 3; ++ci) { const int c = cg + 128 * ci; const float v0 = a->in[I_RV0][c];
#pragma unroll
                for (int k = 0; k < 8; ++k) RVG[(row0 + tq * 8 + k) * DBR + c] = (bf16)f2bf(sigmoidf_(v0 + acc[ci][k])); }
        }
    }
}
__device__ __forceinline__ float dpp_allsum(float x) {
    x += __builtin_bit_cast(float, __builtin_amdgcn_update_dpp(0, __builtin_bit_cast(int, x), 0x128, 0xf, 0xf, false));
    x += __builtin_bit_cast(float, __builtin_amdgcn_update_dpp(0, __builtin_bit_cast(int, x), 0x124, 0xf, 0xf, false));
    x += __builtin_bit_cast(float, __builtin_amdgcn_update_dpp(0, __builtin_bit_cast(int, x), 0x122, 0xf, 0xf, false));
    x += __builtin_bit_cast(float, __builtin_amdgcn_update_dpp(0, __builtin_bit_cast(int, x), 0x121, 0xf, 0xf, false));
    { const unsigned xi = __builtin_bit_cast(unsigned, x); auto r = __builtin_amdgcn_permlane16_swap(xi, xi, false, false); const unsigned r0 = r[0], r1 = r[1]; x = __uint_as_float(r0) + __uint_as_float(r1); }
    { const unsigned xi = __builtin_bit_cast(unsigned, x); auto r = __builtin_amdgcn_permlane32_swap(xi, xi, false, false); const unsigned r0 = r[0], r1 = r[1]; x = __uint_as_float(r0) + __uint_as_float(r1); }
    return x;
}
constexpr int R2_TC = 16, R2_PAR = R2_TC * 32 * 12, R2_YP = R2_TC * 4 * 64;
struct R2Regs { v2u r0, r1, k0, k1; v2u aa, ee; unsigned vc, vp, vg, vf; };
__device__ __forceinline__ float allsum32(float x) {
    x += __builtin_bit_cast(float, __builtin_amdgcn_update_dpp(0, __builtin_bit_cast(int, x), 0x128, 0xf, 0xf, false));
    x += __builtin_bit_cast(float, __builtin_amdgcn_update_dpp(0, __builtin_bit_cast(int, x), 0x124, 0xf, 0xf, false));
    x += __builtin_bit_cast(float, __builtin_amdgcn_update_dpp(0, __builtin_bit_cast(int, x), 0x122, 0xf, 0xf, false));
    x += __builtin_bit_cast(float, __builtin_amdgcn_update_dpp(0, __builtin_bit_cast(int, x), 0x121, 0xf, 0xf, false));
    { const unsigned xi = __builtin_bit_cast(unsigned, x); auto r = __builtin_amdgcn_permlane16_swap(xi, xi, false, false); const unsigned r0 = r[0], r1 = r[1]; x = __uint_as_float(r0) + __uint_as_float(r1); }
    return x;
}
__device__ __forceinline__ void r2_issue(const unsigned char* ws, int l, size_t row, int h, int sl, int lt, R2Regs& R) {
    const bf16* PROJ = (const bf16*)(ws + WS_PROJ);
    const int tt = lt >> 4, kq = lt & 15; const size_t r = row + tt; const bool first = (r % SEQ) == 0; const size_t rp = first ? r : r - 1;
    R.r0 = *(const GAS v2u*)(PROJ + r * NPROJ + PC_RW + RWC_R + h * 64 + kq * 4); R.r1 = *(const GAS v2u*)(PROJ + rp * NPROJ + PC_RW + RWC_R + h * 64 + kq * 4);
    R.k0 = *(const GAS v2u*)(PROJ + r * NPROJ + PC_RW + RWC_K + h * 64 + kq * 4); R.k1 = *(const GAS v2u*)(PROJ + rp * NPROJ + PC_RW + RWC_K + h * 64 + kq * 4);
    R.aa = *(const GAS v2u*)((const bf16*)(ws + WS_RA) + r * DBR + h * 64 + kq * 4); R.ee = *(const GAS v2u*)((const bf16*)(ws + WS_RE) + r * DBR + h * 64 + kq * 4);
    if (first) { R.r1 = (v2u){0u, 0u}; R.k1 = (v2u){0u, 0u}; }
    if (lt < 128) { const int t2 = lt >> 3, rr = lt & 7; const size_t q = row + t2; const bool f2 = (q % SEQ) == 0; const int vcol = h * 64 + sl * 8 + rr;
        R.vc = PROJ[q * NPROJ + PC_RW + RWC_V + vcol]; R.vp = f2 ? 0u : (unsigned)PROJ[(q - 1) * NPROJ + PC_RW + RWC_V + vcol];
        if (l > 0) { R.vg = ((const bf16*)(ws + WS_RVG))[q * DBR + vcol]; R.vf = ((const bf16*)(ws + WS_VF))[q * DBR + vcol]; } }
}
__device__ __forceinline__ void r2_prep(KArgsP a, int l, size_t row, int h, int sl, int lt, const R2Regs& R, LAS float* par, LAS float* vb) {
    const int tt = lt >> 4, kq = lt & 15, c0 = h * 64 + kq * 4;
    const float* mu = a->in[I_RMU] + (size_t)l * RW_COLS; const float* kkw = a->in[I_RKK] + (size_t)l * DBR + c0; const float* kaw = a->in[I_RKA] + (size_t)l * DBR + c0;
    const float rc[4] = {bflo(R.r0.x), bfhi(R.r0.x), bflo(R.r0.y), bfhi(R.r0.y)}, rp[4] = {bflo(R.r1.x), bfhi(R.r1.x), bflo(R.r1.y), bfhi(R.r1.y)};
    const float kc[4] = {bflo(R.k0.x), bfhi(R.k0.x), bflo(R.k0.y), bfhi(R.k0.y)}, kp[4] = {bflo(R.k1.x), bfhi(R.k1.x), bflo(R.k1.y), bfhi(R.k1.y)};
    const float av[4] = {bflo(R.aa.x), bfhi(R.aa.x), bflo(R.aa.y), bfhi(R.aa.y)}, ev[4] = {bflo(R.ee.x), bfhi(R.ee.x), bflo(R.ee.y), bfhi(R.ee.y)};
    float rs[4], ks[4], kk[4], ss = 0.f;
#pragma unroll
    for (int j = 0; j < 4; ++j) { rs[j] = rc[j] + mu[RWC_R + c0 + j] * (rp[j] - rc[j]); ks[j] = kc[j] + mu[RWC_K + c0 + j] * (kp[j] - kc[j]); kk[j] = ks[j] * kkw[j]; ss += kk[j] * kk[j]; }
    ss += __shfl_xor(ss, 1); ss += __shfl_xor(ss, 2); ss += __shfl_xor(ss, 4); ss += __shfl_xor(ss, 8);
    const float inv = 1.f / fmaxf(sqrtf(ss), 1e-12f);
    float w[4], an[4], bk[4], km[4];
#pragma unroll
    for (int j = 0; j < 4; ++j) { const float kn = kk[j] * inv; w[j] = __expf(-ev[j]); an[j] = -kn; bk[j] = kn * av[j]; km[j] = ks[j] * (1.f + (av[j] - 1.f) * kaw[j]); }
    LAS float* rec = par + (tt * 32 + 2 * kq) * 12;
    *(LAS f32x4*)(rec) = (f32x4){w[0], w[1], an[0], an[1]}; *(LAS f32x4*)(rec + 4) = (f32x4){bk[0], bk[1], km[0], km[1]}; *(LAS f32x4*)(rec + 8) = (f32x4){rs[0], rs[1], 0.f, 0.f};
    *(LAS f32x4*)(rec + 12) = (f32x4){w[2], w[3], an[2], an[3]}; *(LAS f32x4*)(rec + 16) = (f32x4){bk[2], bk[3], km[2], km[3]}; *(LAS f32x4*)(rec + 20) = (f32x4){rs[2], rs[3], 0.f, 0.f};
    if (lt < 128) { const int t2 = lt >> 3, rr = lt & 7, vcol = h * 64 + sl * 8 + rr; const float vc = bf2f(R.vc), vp = bf2f(R.vp);
        float v = vc + mu[RWC_V + vcol] * (vp - vc);
        if (l == 0) ((bf16*)(a->ws + WS_VF))[(row + t2) * DBR + vcol] = (bf16)f2bf(v);
        else { v = v + (bf2f(R.vf) - v) * bf2f(R.vg); }
        vb[t2 * 8 + rr] = v; }
}
__device__ __forceinline__ void r2_yreduce(unsigned char* ws, size_t row, int h, int sl, int lt, const LAS float* yp) {
    if (lt < 128) { const int t2 = lt >> 3, rr = lt & 7; const LAS float* src = yp + (t2 * 4 + (rr >> 1)) * 64 + (rr & 1) * 32; float s = 0.f;
#pragma unroll
        for (int q = 0; q < 8; ++q) { const f32x4 v = *(const LAS f32x4*)(src + 4 * q); s += (v.x + v.y) + (v.z + v.w); }
        ((bf16*)(ws + WS_YC))[(row + t2) * DM + 384 + h * 64 + sl * 8 + rr] = (bf16)f2bf(s); }
}
__device__ __forceinline__ void r2_scan(const LAS float* par, const LAS float* vb, LAS float* yp, int lane, int wave, float& s0, float& s1) {
    const int kp = lane & 31, row = 2 * wave + (lane >> 5);
    const LAS float* rec = par + kp * 12; const LAS float* vr = vb + row; LAS float* yo = yp + wave * 64 + lane;
    f32x4 P0[3], P1[3]; f32x2 P2[3]; float VV[3];
#pragma unroll
    for (int q = 0; q < 2; ++q) { P0[q] = *(const LAS f32x4*)(rec + q * 384); P1[q] = *(const LAS f32x4*)(rec + q * 384 + 4); P2[q] = *(const LAS f32x2*)(rec + q * 384 + 8); VV[q] = vr[q * 8]; }
#pragma unroll
    for (int t = 0; t < R2_TC; ++t) {
        const int c = t % 3, n = (t + 2) % 3;
        if (t + 2 < R2_TC) { P0[n] = *(const LAS f32x4*)(rec + (t + 2) * 384); P1[n] = *(const LAS f32x4*)(rec + (t + 2) * 384 + 4); P2[n] = *(const LAS f32x2*)(rec + (t + 2) * 384 + 8); VV[n] = vr[(t + 2) * 8]; }
        const f32x4 p0 = P0[c], p1 = P1[c]; const f32x2 p2 = P2[c]; const float vv = VV[c];
        const float sa = allsum32(fmaf(s1, p0.w, s0 * p0.z));
        const float t0 = fmaf(s0, p0.x, vv * p1.z), t1 = fmaf(s1, p0.y, vv * p1.w);
        s0 = fmaf(sa, p1.x, t0); s1 = fmaf(sa, p1.y, t1);
        yo[t * 256] = fmaf(s1, p2.y, s0 * p2.x);
        __builtin_amdgcn_sched_barrier(0);
    }
}
__device__ __forceinline__ void phase_r2(KArgsP a, LAS unsigned char* lds, int tid, int lane, int wave, int wg, int l) {
    unsigned char* ws = a->ws;
    LAS float* PAR0 = (LAS float*)lds; LAS float* PAR1 = PAR0 + R2_PAR; LAS float* V0 = PAR1 + R2_PAR; LAS float* V1 = V0 + 128; LAS float* YP0 = V1 + 128; LAS float* YP1 = YP0 + R2_YP;
    const int b = wg / 48, h = (wg % 48) >> 3, sl = wg & 7; const size_t rowb = (size_t)b * SEQ;
    const bool loader = wave >= 4; const int lt = tid - 256;
    constexpr int NC = SEQ / R2_TC;
    R2Regs RA, RB;
    if (loader) { r2_issue(ws, l, rowb, h, sl, lt, RA); r2_prep(a, l, rowb, h, sl, lt, RA, PAR0, V0); r2_issue(ws, l, rowb + R2_TC, h, sl, lt, RA); }
    __syncthreads();
    float s0 = 0.f, s1 = 0.f;
    for (int c = 0; c < NC; c += 2) {
        if (!loader) r2_scan(PAR0, V0, YP0, lane, wave, s0, s1);
        else { if (c + 2 < NC) r2_issue(ws, l, rowb + (size_t)(c + 2) * R2_TC, h, sl, lt, RB);
               r2_prep(a, l, rowb + (size_t)(c + 1) * R2_TC, h, sl, lt, RA, PAR1, V1);
               if (c > 0) r2_yreduce(ws, rowb + (size_t)(c - 1) * R2_TC, h, sl, lt, YP1); }
        __syncthreads();
        if (!loader) r2_scan(PAR1, V1, YP1, lane, wave, s0, s1);
        else { if (c + 3 < NC) r2_issue(ws, l, rowb + (size_t)(c + 3) * R2_TC, h, sl, lt, RA);
               if (c + 2 < NC) r2_prep(a, l, rowb + (size_t)(c + 2) * R2_TC, h, sl, lt, RB, PAR0, V0);
               r2_yreduce(ws, rowb + (size_t)c * R2_TC, h, sl, lt, YP0); }
        __syncthreads();
    }
    if (loader) r2_yreduce(ws, rowb + (size_t)(NC - 1) * R2_TC, h, sl, lt, YP1);
}
__device__ __forceinline__ void phase_r3(KArgsP a, int lane, int gw, int ngw, int l) {
    unsigned char* ws = a->ws; const bf16* PROJ = (const bf16*)(ws + WS_PROJ); bf16* YC = (bf16*)(ws + WS_YC);
    const bf16* RA = (const bf16*)(ws + WS_RA); const bf16* RG = (const bf16*)(ws + WS_RG); const bf16* RVG = (const bf16*)(ws + WS_RVG); const bf16* VF = (const bf16*)(ws + WS_VF);
    const float* mu = a->in[I_RMU] + (size_t)l * RW_COLS;
    for (size_t row = gw; row < NTOK; row += ngw) {
#pragma unroll 2
        for (int h = 0; h < NH; ++h) {
            const int c = h * 64 + lane;
            const float y = bf2f(YC[row * DM + 384 + c]);
            const float m = dpp_allsum(y) * (1.f / 64.f); const float d = y - m; const float var = dpp_allsum(d * d) * (1.f / 64.f);
            const float yn = d * rsqrtf(var + RWKV_GN_EPS) * a->in[I_RLNW][l * DBR + c] + a->in[I_RLNB][l * DBR + c];
            const float rs = rw_shift(PROJ, mu, row, RWC_R + c), ks = rw_shift(PROJ, mu, row, RWC_K + c); float v = rw_shift(PROJ, mu, row, RWC_V + c);
            if (l > 0) v = v + (bf2f(VF[row * DBR + c]) - v) * bf2f(RVG[row * DBR + c]);
            const float av = bf2f(RA[row * DBR + c]);
            const float km = ks * (1.f + (av - 1.f) * a->in[I_RKA][l * DBR + c]);
            const float rk = dpp_allsum(rs * km * a->in[I_RRK][l * DBR + c]);
            YC[row * DM + 384 + c] = (bf16)f2bf((yn + rk * v) * bf2f(RG[row * DBR + c]));
        }
    }
}

constexpr int PH_PER_LAYER = 10, PH_FINAL = 1 + 2 * PH_PER_LAYER, N_PHASES = PH_FINAL + 1;
constexpr int R2_WGS = 192;
__global__ void __launch_bounds__(NTHR, 2) fwd(Args args) {
    extern __shared__ __attribute__((aligned(16))) unsigned char lds_raw[];
    LAS unsigned char* lds = (LAS unsigned char*)lds_raw;
    volatile LAS unsigned* MISC = (volatile LAS unsigned*)(lds + MISC_OFF);
    const int tid0 = threadIdx.x;
    const int G = gridDim.x;
#define PHASE_IDS int tid_ = threadIdx.x; asm volatile("" : "+v"(tid_)); const int tid = tid_, lane = tid & 63, wave = __builtin_amdgcn_readfirstlane(tid >> 6); \
    int bx_ = blockIdx.x; asm volatile("" : "+s"(bx_)); const int bx = bx_; const int vcu = (G % 8 == 0) ? (bx % 8) * (G / 8) + bx / 8 : bx; (void)lane; (void)wave; (void)vcu; (void)bx;
    unsigned char* ws0 = fresh_args()->ws;
    for (int u = tid0; u < (LDS_BYTES - RING_BYTES) / 4; u += NTHR) ((LAS unsigned*)(lds + RING_BYTES))[u] = 0u;
    __syncthreads();
    XcdBarrier bar; bar.bar = (unsigned*)(ws0 + WS_CTL) + CW_BAR; bar.x = 0; bar.st = nullptr;
    if (!MK_PER_PHASE) bar = xcd_barrier_post((unsigned*)(ws0 + WS_CTL) + CW_BAR, MISC + 8);
#if MK_PER_PHASE
    const int lo = args.ph_lo, hi = args.ph_hi;
#define IN(k) (lo <= (k) && (k) < hi)
#else
#define IN(k) true
#endif
#define SEAM(k) do { if (IN(k) && IN((k) + 1)) { XcdBarrier b2 = bar; asm volatile("" : "+s"(b2.bar)); xcd_barrier(b2); } } while (0)

#ifndef DBL_SUB
#define DBL_SUB 0
#endif
#ifndef DBL_PHASE
#define DBL_PHASE (-1)
#endif
#ifndef REPN
#define REPN 2
#endif
#define REP(k) for (int rep_ = 0; rep_ < ((k) == DBL_PHASE ? REPN : 1); ++rep_)
#define REPBAR if (rep_ > 0) { XcdBarrier b2 = bar; asm volatile("" : "+s"(b2.bar)); xcd_barrier(b2); }
    REP(0) if (IN(0)) { REPBAR KArgsP ap = fresh_args(); PHASE_IDS phase_prologue(ap, lds, tid, lane, wave, vcu, G); }
    SEAM(0);
#define LCONST 0
    {
        constexpr int l = LCONST; constexpr int pb = 1 + l * PH_PER_LAYER;
        REP(pb + 0) if (IN(pb + 0)) { REPBAR KArgsP ap = fresh_args(); PHASE_IDS unsigned char* ws = ap->ws; (void)ws;
            if (l == 0) { mod_finalize(ws, tid, G); phase_rownorm<0, false>(ap, lds, tid, lane, wave, G, ap->in[I_X], ap->out, ap->in[I_NORM_MIX], true, 0, 0, 0); }
            else {
#if EN_MOE
                phase_rownorm<0, true>(ap, lds, tid, lane, wave, G, ap->out, ap->out, ap->in[I_NORM_MIX] + l * DM, false, l, 0, l - 1);
#else
                phase_rownorm<0, false>(ap, lds, tid, lane, wave, G, ap->out, ap->out, ap->in[I_NORM_MIX] + l * DM, false, l, 0, l - 1);
#endif
            }
        }
        SEAM(pb + 0);
        REP(pb + 1) if (IN(pb + 1)) { REPBAR KArgsP ap = fresh_args(); PHASE_IDS unsigned char* ws = ap->ws; (void)ws;
            pg8::Gemm g{(const pg8::bf16_t*)(ws + WS_HN), (const pg8::bf16_t*)(ws + WS_WIN) + (size_t)l * NPROJ_PAD * DM, NTOK, NPROJ_PAD, DM};
            pg8::StaticOrder S; S.init(NTOK, NPROJ_PAD, G, bx);
            pg8::EpiProj E{(pg8::bf16_t*)(ws + WS_PROJ), (float*)(ws + WS_GATES)};
            pg8::gemm_phase<pg8::EpiProj, pg8::StaticOrder, true, true>(lds, g, S, E);
        }
        SEAM(pb + 1);
        REP(pb + 2) if (IN(pb + 2)) { REPBAR KArgsP ap = fresh_args(); PHASE_IDS unsigned char* ws = ap->ws; (void)ws;
#if EN_MLSTM
            for (int q_ = 0; q_ < 1 + (REPN - 1) * ((DBL_SUB == 1) && l == 0); ++q_) { phase_m1(ap, lds, tid, lane, wave, vcu, G, l); __syncthreads(); }
            __syncthreads();
#endif
#if EN_S5
            phase_s1(ap, lds, tid, lane, wave, vcu, G, l); __syncthreads();
#if DBL_SUB == 2
            if (l == 0) { phase_s1(ap, lds, tid, lane, wave, vcu, G, l); __syncthreads(); phase_s1(ap, lds, tid, lane, wave, vcu, G, l); __syncthreads(); phase_s1(ap, lds, tid, lane, wave, vcu, G, l); __syncthreads(); phase_s1(ap, lds, tid, lane, wave, vcu, G, l); __syncthreads(); }
#endif
            __syncthreads();
#endif
#if EN_RWKV
            for (int q_ = 0; q_ < 1 + (REPN - 1) * ((DBL_SUB == 3) && l == 0); ++q_) { phase_r1(ap, lds, tid, vcu, G, l); __syncthreads(); }
#endif
        }
        SEAM(pb + 2);
        REP(pb + 3) if (IN(pb + 3)) { REPBAR KArgsP ap = fresh_args(); PHASE_IDS unsigned char* ws = ap->ws; (void)ws;
            if (vcu < R2_WGS) {
#if EN_RWKV
                for (int q_ = 0; q_ < 1 + (REPN - 1) * ((DBL_SUB == 4) && l == 0); ++q_) { phase_r2(ap, lds, tid, lane, wave, vcu, l); __syncthreads(); }
#endif
            } else {
                const int wg = vcu - R2_WGS, nwg = G - R2_WGS;
#if EN_MLSTM
                phase_m2(ws, tid, wg, nwg);
#endif
#if EN_S5
                phase_s2(ap, tid, wg, nwg, l);
#endif
#if EN_MOE
                if (l == 1) moe_convert(ap->in[I_MW1], ap->in[I_MW3], ap->in[I_MW2], 1, (bf16*)(ws + WS_W13), (bf16*)(ws + WS_W2), wg * NWAVES + wave, nwg * NWAVES, (LAS float*)(lds + wave * 16640), lane);
#endif
            }
        }
        SEAM(pb + 3);
        REP(pb + 4) if (IN(pb + 4)) { REPBAR KArgsP ap = fresh_args(); PHASE_IDS unsigned char* ws = ap->ws; (void)ws;
#if EN_MLSTM
            for (int q_ = 0; q_ < 1 + (REPN - 1) * ((DBL_SUB == 5) && l == 0); ++q_) { phase_m3(ap, lds, tid, lane, wave, vcu, G, l); __syncthreads(); }
            __syncthreads();
#else
            for (size_t i = (size_t)vcu * NTHR + tid; i < (size_t)NTOK * 384; i += (size_t)G * NTHR) ((bf16*)(ws + WS_YC))[(i / 384) * DM + (i % 384)] = 0;
#endif
#if EN_S5
            for (int q_ = 0; q_ < 1 + (REPN - 1) * ((DBL_SUB == 6) && l == 0); ++q_) { phase_s3(ap, lds, tid, lane, wave, vcu, G, l); __syncthreads(); }
#else
            for (size_t i = (size_t)vcu * NTHR + tid; i < (size_t)NTOK * 256; i += (size_t)G * NTHR) ((bf16*)(ws + WS_YC))[(i / 256) * DM + 768 + (i % 256)] = 0;
#endif
#if EN_RWKV
            phase_r3(ap, lane, vcu * NWAVES + wave, G * NWAVES, l);
#else
            for (size_t i = (size_t)vcu * NTHR + tid; i < (size_t)NTOK * 384; i += (size_t)G * NTHR) ((bf16*)(ws + WS_YC))[(i / 384) * DM + 384 + (i % 384)] = 0;
#endif
        }
        SEAM(pb + 4);
        REP(pb + 5) if (IN(pb + 5)) { REPBAR KArgsP ap = fresh_args(); PHASE_IDS unsigned char* ws = ap->ws; (void)ws;
            pg8::Gemm g{(const pg8::bf16_t*)(ws + WS_YC), (const pg8::bf16_t*)(ws + WS_WOUT) + (size_t)l * DM * DM, NTOK, DM, DM};
            pg8::StaticOrder S; S.init(NTOK, DM, G, bx);
            pg8::EpiResid E{l == 0 ? ap->in[I_X] : (const float*)ap->out, ap->out, (const float*)(ws + WS_MODF) + (size_t)l * 4 * 6144, 2048};
            pg8::gemm_phase<pg8::EpiResid, pg8::StaticOrder, true, true>(lds, g, S, E);
        }
        SEAM(pb + 5);
#if EN_MOE
        REP(pb + 6) if (IN(pb + 6)) { REPBAR KArgsP ap = fresh_args(); PHASE_IDS phase_router(ap, lds, tid, lane, wave, G, l); }
        SEAM(pb + 6);
        REP(pb + 7) if (IN(pb + 7)) { REPBAR KArgsP ap = fresh_args(); PHASE_IDS phase_gather(ap, lds, tid, lane, wave, vcu, G, l); }
        SEAM(pb + 7);
        REP(pb + 8) if (IN(pb + 8)) { REPBAR KArgsP ap = fresh_args(); PHASE_IDS unsigned char* ws = ap->ws; (void)ws;
            LAS int* ptab = (LAS int*)(lds + PTAB_OFF); LAS int* pst = ptab + 512; LAS int* cnt = pst + 32;
            build_ptab((const unsigned*)(ws + WS_CTL) + CW_CNT + l * 32, ptab, pst, cnt, tid);
            pg8::Gemm g{(const pg8::bf16_t*)(ws + WS_XG), (const pg8::bf16_t*)(ws + WS_W13), 0, 0, DM};
            pg8::MoeOrder S{ptab, G, vcu};
            pg8::EpiSwiglu E{(pg8::bf16_t*)(ws + WS_HMID)};
            pg8::gemm_phase<pg8::EpiSwiglu, pg8::MoeOrder, true, true>(lds, g, S, E);
        }
        SEAM(pb + 8);
        REP(pb + 9) if (IN(pb + 9)) { REPBAR KArgsP ap = fresh_args(); PHASE_IDS unsigned char* ws = ap->ws; (void)ws;
            LAS int* ptab = (LAS int*)(lds + PTAB_OFF); LAS int* pst = ptab + 512; LAS int* cnt = pst + 32;
            build_ptab((const unsigned*)(ws + WS_CTL) + CW_CNT + l * 32, ptab, pst, cnt, tid);
            pg8::Gemm g{(const pg8::bf16_t*)(ws + WS_HMID), (const pg8::bf16_t*)(ws + WS_W2), 0, 0, DEXP};
            pg8::MoeOrder S{ptab, G, vcu};
            pg8::EpiMoeOut E{(pg8::bf16_t*)(ws + WS_YMOE), (const int*)(ws + WS_ROWMAP)};
            pg8::gemm_phase<pg8::EpiMoeOut, pg8::MoeOrder, true, true>(lds, g, S, E);
        }
        SEAM(pb + 9);
#else
        SEAM(pb + 6); SEAM(pb + 7); SEAM(pb + 8); SEAM(pb + 9);
#endif
    }
#undef LCONST
#if N_LAYERS > 1
#define LCONST 1
    {
        constexpr int l = LCONST; constexpr int pb = 1 + l * PH_PER_LAYER;
        REP(pb + 0) if (IN(pb + 0)) { REPBAR KArgsP ap = fresh_args(); PHASE_IDS unsigned char* ws = ap->ws; (void)ws;
            if (l == 0) { mod_finalize(ws, tid, G); phase_rownorm<0, false>(ap, lds, tid, lane, wave, G, ap->in[I_X], ap->out, ap->in[I_NORM_MIX], true, 0, 0, 0); }
            else {
#if EN_MOE
                phase_rownorm<0, true>(ap, lds, tid, lane, wave, G, ap->out, ap->out, ap->in[I_NORM_MIX] + l * DM, false, l, 0, l - 1);
#else
                phase_rownorm<0, false>(ap, lds, tid, lane, wave, G, ap->out, ap->out, ap->in[I_NORM_MIX] + l * DM, false, l, 0, l - 1);
#endif
            }
        }
        SEAM(pb + 0);
        REP(pb + 1) if (IN(pb + 1)) { REPBAR KArgsP ap = fresh_args(); PHASE_IDS unsigned char* ws = ap->ws; (void)ws;
            pg8::Gemm g{(const pg8::bf16_t*)(ws + WS_HN), (const pg8::bf16_t*)(ws + WS_WIN) + (size_t)l * NPROJ_PAD * DM, NTOK, NPROJ_PAD, DM};
            pg8::StaticOrder S; S.init(NTOK, NPROJ_PAD, G, bx);
            pg8::EpiProj E{(pg8::bf16_t*)(ws + WS_PROJ), (float*)(ws + WS_GATES)};
            pg8::gemm_phase<pg8::EpiProj, pg8::StaticOrder, true, true>(lds, g, S, E);
        }
        SEAM(pb + 1);
        REP(pb + 2) if (IN(pb + 2)) { REPBAR KArgsP ap = fresh_args(); PHASE_IDS unsigned char* ws = ap->ws; (void)ws;
#if EN_MLSTM
            for (int q_ = 0; q_ < 1 + (REPN - 1) * ((DBL_SUB == 1) && l == 0); ++q_) { phase_m1(ap, lds, tid, lane, wave, vcu, G, l); __syncthreads(); }
            __syncthreads();
#endif
#if EN_S5
            phase_s1(ap, lds, tid, lane, wave, vcu, G, l); __syncthreads();
#if DBL_SUB == 2
            if (l == 0) { phase_s1(ap, lds, tid, lane, wave, vcu, G, l); __syncthreads(); phase_s1(ap, lds, tid, lane, wave, vcu, G, l); __syncthreads(); phase_s1(ap, lds, tid, lane, wave, vcu, G, l); __syncthreads(); phase_s1(ap, lds, tid, lane, wave, vcu, G, l); __syncthreads(); }
#endif
            __syncthreads();
#endif
#if EN_RWKV
            for (int q_ = 0; q_ < 1 + (REPN - 1) * ((DBL_SUB == 3) && l == 0); ++q_) { phase_r1(ap, lds, tid, vcu, G, l); __syncthreads(); }
#endif
        }
        SEAM(pb + 2);
        REP(pb + 3) if (IN(pb + 3)) { REPBAR KArgsP ap = fresh_args(); PHASE_IDS unsigned char* ws = ap->ws; (void)ws;
            if (vcu < R2_WGS) {
#if EN_RWKV
                for (int q_ = 0; q_ < 1 + (REPN - 1) * ((DBL_SUB == 4) && l == 0); ++q_) { phase_r2(ap, lds, tid, lane, wave, vcu, l); __syncthreads(); }
#endif
            } else {
                const int wg = vcu - R2_WGS, nwg = G - R2_WGS;
#if EN_MLSTM
                phase_m2(ws, tid, wg, nwg);
#endif
#if EN_S5
                phase_s2(ap, tid, wg, nwg, l);
#endif
#if EN_MOE
                if (l == 1) moe_convert(ap->in[I_MW1], ap->in[I_MW3], ap->in[I_MW2], 1, (bf16*)(ws + WS_W13), (bf16*)(ws + WS_W2), wg * NWAVES + wave, nwg * NWAVES, (LAS float*)(lds + wave * 16640), lane);
#endif
            }
        }
        SEAM(pb + 3);
        REP(pb + 4) if (IN(pb + 4)) { REPBAR KArgsP ap = fresh_args(); PHASE_IDS unsigned char* ws = ap->ws; (void)ws;
#if EN_MLSTM
            for (int q_ = 0; q_ < 1 + (REPN - 1) * ((DBL_SUB == 5) && l == 0); ++q_) { phase_m3(ap, lds, tid, lane, wave, vcu, G, l); __syncthreads(); }
            __syncthreads();
#else
            for (size_t i = (size_t)vcu * NTHR + tid; i < (size_t)NTOK * 384; i += (size_t)G * NTHR) ((bf16*)(ws + WS_YC))[(i / 384) * DM + (i % 384)] = 0;
#endif
#if EN_S5
            for (int q_ = 0; q_ < 1 + (REPN - 1) * ((DBL_SUB == 6) && l == 0); ++q_) { phase_s3(ap, lds, tid, lane, wave, vcu, G, l); __syncthreads(); }
#else
            for (size_t i = (size_t)vcu * NTHR + tid; i < (size_t)NTOK * 256; i += (size_t)G * NTHR) ((bf16*)(ws + WS_YC))[(i / 256) * DM + 768 + (i % 256)] = 0;
#endif
#if EN_RWKV
            phase_r3(ap, lane, vcu * NWAVES + wave, G * NWAVES, l);
#else
            for (size_t i = (size_t)vcu * NTHR + tid; i < (size_t)NTOK * 384; i += (size_t)G * NTHR) ((bf16*)(ws + WS_YC))[(i / 384) * DM + 384 + (i % 384)] = 0;
#endif
        }
        SEAM(pb + 4);
        REP(pb + 5) if (IN(pb + 5)) { REPBAR KArgsP ap = fresh_args(); PHASE_IDS unsigned char* ws = ap->ws; (void)ws;
            pg8::Gemm g{(const pg8::bf16_t*)(ws + WS_YC), (const pg8::bf16_t*)(ws + WS_WOUT) + (size_t)l * DM * DM, NTOK, DM, DM};
            pg8::StaticOrder S; S.init(NTOK, DM, G, bx);
            pg8::EpiResid E{l == 0 ? ap->in[I_X] : (const float*)ap->out, ap->out, (const float*)(ws + WS_MODF) + (size_t)l * 4 * 6144, 2048};
            pg8::gemm_phase<pg8::EpiResid, pg8::StaticOrder, true, true>(lds, g, S, E);
        }
        SEAM(pb + 5);
#if EN_MOE
        REP(pb + 6) if (IN(pb + 6)) { REPBAR KArgsP ap = fresh_args(); PHASE_IDS phase_router(ap, lds, tid, lane, wave, G, l); }
        SEAM(pb + 6);
        REP(pb + 7) if (IN(pb + 7)) { REPBAR KArgsP ap = fresh_args(); PHASE_IDS phase_gather(ap, lds, tid, lane, wave, vcu, G, l); }
        SEAM(pb + 7);
        REP(pb + 8) if (IN(pb + 8)) { REPBAR KArgsP ap = fresh_args(); PHASE_IDS unsigned char* ws = ap->ws; (void)ws;
            LAS int* ptab = (LAS int*)(lds + PTAB_OFF); LAS int* pst = ptab + 512; LAS int* cnt = pst + 32;
            build_ptab((const unsigned*)(ws + WS_CTL) + CW_CNT + l * 32, ptab, pst, cnt, tid);
            pg8::Gemm g{(const pg8::bf16_t*)(ws + WS_XG), (const pg8::bf16_t*)(ws + WS_W13), 0, 0, DM};
            pg8::MoeOrder S{ptab, G, vcu};
            pg8::EpiSwiglu E{(pg8::bf16_t*)(ws + WS_HMID)};
            pg8::gemm_phase<pg8::EpiSwiglu, pg8::MoeOrder, true, true>(lds, g, S, E);
        }
        SEAM(pb + 8);
        REP(pb + 9) if (IN(pb + 9)) { REPBAR KArgsP ap = fresh_args(); PHASE_IDS unsigned char* ws = ap->ws; (void)ws;
            LAS int* ptab = (LAS int*)(lds + PTAB_OFF); LAS int* pst = ptab + 512; LAS int* cnt = pst + 32;
            build_ptab((const unsigned*)(ws + WS_CTL) + CW_CNT + l * 32, ptab, pst, cnt, tid);
            pg8::Gemm g{(const pg8::bf16_t*)(ws + WS_HMID), (const pg8::bf16_t*)(ws + WS_W2), 0, 0, DEXP};
            pg8::MoeOrder S{ptab, G, vcu};
            pg8::EpiMoeOut E{(pg8::bf16_t*)(ws + WS_YMOE), (const int*)(ws + WS_ROWMAP)};
            pg8::gemm_phase<pg8::EpiMoeOut, pg8::MoeOrder, true, true>(lds, g, S, E);
        }
        SEAM(pb + 9);
#else
        SEAM(pb + 6); SEAM(pb + 7); SEAM(pb + 8); SEAM(pb + 9);
#endif
    }
#undef LCONST
#endif
    if (IN(PH_FINAL)) { KArgsP ap = fresh_args(); PHASE_IDS
#if EN_MOE
        if (N_LAYERS > 0) phase_rownorm<1, true>(ap, lds, tid, lane, wave, G, ap->out, ap->out, ap->in[I_NORM_FINAL], false, 0, 0, N_LAYERS - 1);
        else phase_rownorm<1, false>(ap, lds, tid, lane, wave, G, ap->in[I_X], ap->out, ap->in[I_NORM_FINAL], false, 0, 0, 0);
#else
        phase_rownorm<1, false>(ap, lds, tid, lane, wave, G, N_LAYERS > 0 ? (const float*)ap->out : ap->in[I_X], ap->out, ap->in[I_NORM_FINAL], false, 0, 0, 0);
#endif
    }
#undef IN
#undef SEAM
}

extern "C" void kernel_launch(void* const* d_in, const int* in_sizes, int n_in, void* d_out, int out_size, void* d_ws, size_t ws_size, hipStream_t stream) {
    static int grid = 0;
    if (grid == 0) {
        if (n_in != 47 || out_size != NTOK * DM || ws_size < WS_END) { fprintf(stderr, "kernel_launch: unexpected problem (n_in %d, out %d, ws %zu < %zu)\n", n_in, out_size, ws_size, (size_t)WS_END); grid = -1; return; }
        int dev = 0, cus = 0, per_cu = 0;
        if (hipGetDevice(&dev) != hipSuccess || hipDeviceGetAttribute(&cus, hipDeviceAttributeMultiprocessorCount, dev) != hipSuccess) { grid = -1; return; }
        if (hipFuncSetAttribute((const void*)fwd, hipFuncAttributeMaxDynamicSharedMemorySize, LDS_BYTES) != hipSuccess) { fprintf(stderr, "kernel_launch: hipFuncSetAttribute failed\n"); grid = -1; return; }
        if (hipOccupancyMaxActiveBlocksPerMultiprocessor(&per_cu, (const void*)fwd, NTHR, LDS_BYTES) != hipSuccess || per_cu < 1) fprintf(stderr, "kernel_launch: occupancy query says %d\n", per_cu);
        (void)hipGetLastError();
        grid = cus;
        if (grid != 256) fprintf(stderr, "kernel_launch: %d CUs (built for 256)\n", grid);
    }
    if (grid < 0) return;
    (void)hipMemsetAsync((char*)d_ws + WS_CTL, 0, CTL_ZERO_BYTES, stream);
    Args a{};
    for (int i = 0; i < 47; ++i) a.in[i] = (const float*)d_in[i];
    a.out = (float*)d_out; a.ws = (unsigned char*)d_ws;
#if MK_PER_PHASE
    for (int p = 0; p < N_PHASES; ++p) { a.ph_lo = p; a.ph_hi = p + 1; hipLaunchKernelGGL(fwd, dim3(grid), dim3(NTHR), LDS_BYTES, stream, a); }
#else
    a.ph_lo = 0; a.ph_hi = N_PHASES; hipLaunchKernelGGL(fwd, dim3(grid), dim3(NTHR), LDS_BYTES, stream, a);
#endif
}
#ifdef DIAG_KERNELS
#define DK(name, ...) __global__ void __launch_bounds__(NTHR, 2) name(Args args) { extern __shared__ __attribute__((aligned(16))) unsigned char lds_raw[]; LAS unsigned char* lds = (LAS unsigned char*)lds_raw; \
    const int tid = threadIdx.x, lane = tid & 63, wave = __builtin_amdgcn_readfirstlane(tid >> 6); const int G = gridDim.x; const int bx = blockIdx.x; const int vcu = bx; KArgsP ap = fresh_args(); int l = ap->ph_lo; (void)lane; (void)wave; (void)vcu; (void)G; (void)l; __VA_ARGS__ }
DK(k_prologue, phase_prologue(ap, lds, tid, lane, wave, vcu, G);)
DK(k_norm0, phase_rownorm<0, false>(ap, lds, tid, lane, wave, G, ap->in[I_X], ap->out, ap->in[I_NORM_MIX], true, 0, 0, 0);)
DK(k_norm1, phase_rownorm<0, true>(ap, lds, tid, lane, wave, G, ap->out, ap->out, ap->in[I_NORM_MIX], false, l, 0, 0);)
DK(k_normf, phase_rownorm<1, true>(ap, lds, tid, lane, wave, G, ap->out, ap->out, ap->in[I_NORM_MIX], false, l, 0, 0);)
DK(k_m1, phase_m1(ap, lds, tid, lane, wave, vcu, G, l);)
DK(k_m2, phase_m2(ap->ws, tid, vcu, G);)
DK(k_m3, phase_m3(ap, lds, tid, lane, wave, vcu, G, l);)
DK(k_s1, phase_s1(ap, lds, tid, lane, wave, vcu, G, l);)
DK(k_s2, phase_s2(ap, tid, vcu, G, l);)
DK(k_s3, phase_s3(ap, lds, tid, lane, wave, vcu, G, l);)
DK(k_r1, phase_r1(ap, lds, tid, vcu, G, l);)
DK(k_r2, phase_r2(ap, lds, tid, lane, wave, vcu, l);)
DK(k_r3, phase_r3(ap, lane, vcu * NWAVES + wave, G * NWAVES, l);)
DK(k_router, phase_router(ap, lds, tid, lane, wave, G, l);)
DK(k_gather, phase_gather(ap, lds, tid, lane, wave, vcu, G, l);)
DK(k_moecv, moe_convert(ap->in[I_MW1], ap->in[I_MW3], ap->in[I_MW2], 1, (bf16*)(ap->ws + WS_W13), (bf16*)(ap->ws + WS_W2), vcu * NWAVES + wave, G * NWAVES, (LAS float*)(lds + wave * 16640), lane);)
#endif
```

```cpp
#include <hip/hip_runtime.h>
#include <cstdio>
#include <cstdint>
#define MK_PER_PHASE 0

#ifndef MK_PER_PHASE
#define MK_PER_PHASE 0
#endif
#ifndef EN_MLSTM
#define EN_MLSTM 1
#endif
#ifndef EN_S5
#define EN_S5 1
#endif
#ifndef EN_RWKV
#define EN_RWKV 1
#endif
#ifndef EN_MOE
#define EN_MOE 1
#endif
#ifndef N_LAYERS
#define N_LAYERS 2
#endif
constexpr int NWAVES = 8, NTHR = 512;
constexpr int DM = 1024, NB = 4, SEQ = 8192, NTOK = NB * SEQ;
constexpr int DA = 384, DBR = 384, DC = 256, NH = 6, HD = 64, NCH = SEQ / 64;
constexpr int IN_COLS = 2828, NPROJ = 2816, NPROJ_PAD = 3072;
constexpr int PC_QK = 0, PC_V = 384, PC_O = 768, PC_RW = 1152, PC_S5 = 2560;
constexpr int RWC_R = 0, RWC_K = 384, RWC_V = 768, RWC_WD = 1152, RWC_AD = 1216, RWC_GD = 1280, RW_COLS = 1408;
constexpr int NEXP = 32, DEXP = 512, MOE_ROWS_MAX = 73728;
constexpr int NUNIT_M = NB * NCH * NH;
constexpr int CL_STRIDE = 4160;
constexpr float NORM_EPS = 1e-6f, HEAD_NORM_EPS = 1e-5f, RWKV_GN_EPS = 64e-5f;

constexpr size_t MiB = 1u << 20;
constexpr size_t WS_CTL = 0, CTL_ZERO_BYTES = 1 * MiB;
constexpr size_t WS_MODP = 1 * MiB;
constexpr size_t WS_MODF = 2 * MiB + 512 * 1024;
constexpr size_t WS_RTW = 3 * MiB;
constexpr size_t WS_MLW = 3 * MiB + 512 * 1024;
constexpr size_t WS_S5CM = 2 * MiB + 768 * 1024;
constexpr size_t WS_GLUT = 3 * MiB + 768 * 1024;
constexpr size_t WS_WIN = 4 * MiB;
constexpr size_t WS_WOUT = 16 * MiB;
constexpr size_t WS_GATES = 20 * MiB;
constexpr size_t WS_W13 = 22 * MiB;
constexpr size_t WS_W2 = 86 * MiB;
constexpr size_t WS_HN = 118 * MiB;
constexpr size_t WS_CLOC = 118 * MiB;
constexpr size_t WS_MSC = 168 * MiB;
constexpr size_t WS_S5ST = 170 * MiB;
constexpr size_t WS_VF = 182 * MiB;
constexpr size_t WS_YC = 206 * MiB;
constexpr size_t WS_LIST = 206 * MiB;
constexpr size_t WS_ROWMAP = 214 * MiB;
constexpr size_t WS_TOKE = 215 * MiB;
constexpr size_t WS_TOKW = 215 * MiB + 512 * 1024;
constexpr size_t WS_PROJ = 270 * MiB;
constexpr size_t WS_RE = 446 * MiB, WS_RA = 470 * MiB, WS_RG = 494 * MiB, WS_RVG = 518 * MiB;
constexpr size_t WS_XG = 270 * MiB;
constexpr size_t WS_HMID = 414 * MiB;
constexpr size_t WS_YMOE = 270 * MiB;
constexpr size_t WS_R1W = 542 * MiB;
constexpr size_t WS_END = 543 * MiB;
constexpr int CW_TMO = 0, CW_BAR = 4096, CW_CNT = 8192;

constexpr int RING_BYTES = 131072, MISC_OFF = 135168, PTAB_OFF = MISC_OFF + 1024, LDS_BYTES = 147456;

#define GAS __attribute__((address_space(1)))
#define LAS __attribute__((address_space(3)))
typedef unsigned short bf16;
typedef unsigned v4u __attribute__((ext_vector_type(4)));
typedef unsigned v2u __attribute__((ext_vector_type(2)));
typedef float f32x4 __attribute__((ext_vector_type(4)));
typedef float f32x2 __attribute__((ext_vector_type(2)));
typedef GAS unsigned gu32;
#define RLX_AGENT __ATOMIC_RELAXED, __HIP_MEMORY_SCOPE_AGENT
#define LDS_WAIT() asm volatile("s_waitcnt lgkmcnt(0)" ::: "memory")
#define VM_WAIT() asm volatile("s_waitcnt vmcnt(0)" ::: "memory")
__device__ __forceinline__ unsigned f2bf(float f) { unsigned u = __builtin_bit_cast(unsigned, f); return (u + 0x7fffu + ((u >> 16) & 1u)) >> 16; }
__device__ __forceinline__ unsigned pk2(float lo, float hi) { return f2bf(lo) | (f2bf(hi) << 16); }
__device__ __forceinline__ float bf2f(unsigned v) { return __builtin_bit_cast(float, v << 16); }
__device__ __forceinline__ float bflo(unsigned w) { return __builtin_bit_cast(float, w << 16); }
__device__ __forceinline__ float bfhi(unsigned w) { return __builtin_bit_cast(float, w & 0xffff0000u); }
__device__ __forceinline__ float sigmoidf_(float x) { return 1.f / (1.f + __expf(-x)); }
__device__ __forceinline__ float wave_sum(float v) {
#pragma unroll
    for (int o = 1; o < 64; o <<= 1) v += __shfl_xor(v, o);
    return v;
}
__device__ __forceinline__ float wave_max(float v) {
#pragma unroll
    for (int o = 1; o < 64; o <<= 1) v = fmaxf(v, __shfl_xor(v, o));
    return v;
}
namespace pg8 {
#define PG8_LAS __attribute__((address_space(3)))
typedef unsigned short bf16_t;
typedef short bf16x8 __attribute__((ext_vector_type(8)));
typedef float f32x4 __attribute__((ext_vector_type(4)));
typedef unsigned u32x4 __attribute__((ext_vector_type(4)));
constexpr int BM = 256, BK = 64, HALF = 128, HTB = HALF * BK * 2  , STAGE_BYTES = 8 * HTB, NXCD = 8, WGM = 8;

__host__ __device__ __forceinline__ int lds_byte(int r, int c) { const int st = (r >> 4) * 2 + (c >> 5), rr = r & 15, cc = c & 31, ob = rr * 64 + cc * 2; return st * 1024 + (ob ^ (((ob >> 9) & 1) << 5)); }
__host__ __device__ __forceinline__ void stage_rc(int b, int& R, int& C) { const int st = b / 1024, sb = b % 1024, swz = sb ^ (((sb >> 9) & 1) << 5); R = (st >> 1) * 16 + swz / 64; C = (st & 1) * 32 + (swz % 64) / 2; }
__host__ __device__ __forceinline__ int perm32(int rho) { const int n = rho >> 4, i = rho & 15; return 8 * (i >> 2) + 4 * n + (i & 3); }

struct Unit { int pm, pn; };
struct Gemm { const bf16_t* A; const bf16_t* Bt; int M, N, K; };

struct StaticOrder {
    int nM, nN, nwg, G, c;
    __host__ __device__ void init(int M, int N, int G_, int c_) { nM = M / BM; nN = N / BM; nwg = nM * nN; G = G_; c = c_; }
    __host__ __device__ bool next(int i, Unit& u) const {
        const long L = (long)i * G + c; if (L >= nwg) return false;
        int wgid = (int)L; { const int q = nwg / NXCD, r = nwg % NXCD, xcd = wgid % NXCD, off = wgid / NXCD; wgid = (xcd < r ? xcd * (q + 1) : r * (q + 1) + (xcd - r) * q) + off; }
        const int nig = WGM * nN, gid = wgid / nig, fm = gid * WGM, gsz = (nM - fm) < WGM ? (nM - fm) : WGM;
        u.pm = fm + ((wgid % nig) % gsz); u.pn = (wgid % nig) / gsz; return true;
    }
    __device__ __forceinline__ void a_ready(const Unit&) const {}
    __device__ __forceinline__ void done(const Unit&) const {}
};

__device__ __forceinline__ unsigned cvt_pk_bf16(float lo, float hi) { unsigned r; asm volatile("v_cvt_pk_bf16_f32 %0, %1, %2" : "=v"(r) : "v"(lo), "v"(hi)); return r; }

struct EpiProj {
    static constexpr bool PERM = true, AFTER_DRAIN = false;
    bf16_t* O; float* G;
    __device__ __forceinline__ void operator()(const f32x4 (&acc)[2][2][4][2], const Unit& u, int wr, int wc, int fr, int fq) const {
        const int row0 = u.pm * BM + wr * 64 + fr;
        if (u.pn < 11) {
            const int col0 = u.pn * BM + wc * 32 + 8 * fq;
#pragma unroll
            for (int ai = 0; ai < 2; ++ai)
#pragma unroll
                for (int m = 0; m < 4; ++m) { bf16_t* rowp = O + (size_t)(row0 + ai * HALF + m * 16) * 2816 + col0;
#pragma unroll
                    for (int bj = 0; bj < 2; ++bj) { const f32x4 v0 = acc[ai][bj][m][0], v1 = acc[ai][bj][m][1];
                        u32x4 w; w.x = cvt_pk_bf16(v0[0], v0[1]); w.y = cvt_pk_bf16(v0[2], v0[3]); w.z = cvt_pk_bf16(v1[0], v1[1]); w.w = cvt_pk_bf16(v1[2], v1[3]);
                        *(u32x4*)(rowp + bj * HALF) = w; } }
        } else if (wc == 0 && fq < 2) {
#pragma unroll
            for (int ai = 0; ai < 2; ++ai)
#pragma unroll
                for (int m = 0; m < 4; ++m) { float* rowp = G + (size_t)(row0 + ai * HALF + m * 16) * 16 + 8 * fq;
                    *(f32x4*)(rowp) = acc[ai][0][m][0]; *(f32x4*)(rowp + 4) = acc[ai][0][m][1]; }
        }
    }
};
struct EpiResid {
    static constexpr bool PERM = true, AFTER_DRAIN = false;
    const float* xin; float* out; const float* gate;
    int goff;
    __device__ __forceinline__ void operator()(const f32x4 (&acc)[2][2][4][2], const Unit& u, int wr, int wc, int fr, int fq) const {
        const int row0 = u.pm * BM + wr * 64 + fr, col0 = u.pn * BM + wc * 32 + 8 * fq;
        const float* gp = gate + (size_t)(row0 >> 13) * 6144 + goff + col0;
        f32x4 g[2][2];
#pragma unroll
        for (int bj = 0; bj < 2; ++bj)
#pragma unroll
            for (int n = 0; n < 2; ++n) g[bj][n] = *(const f32x4*)(gp + bj * HALF + 4 * n) + 1.0f;
#pragma unroll
        for (int ai = 0; ai < 2; ++ai)
#pragma unroll
            for (int m = 0; m < 4; ++m) { const size_t off = (size_t)(row0 + ai * HALF + m * 16) * 1024 + col0;
#pragma unroll
                for (int bj = 0; bj < 2; ++bj)
#pragma unroll
                    for (int n = 0; n < 2; ++n) { const f32x4 xv = *(const f32x4*)(xin + off + bj * HALF + 4 * n);
                        *(f32x4*)(out + off + bj * HALF + 4 * n) = xv + g[bj][n] * acc[ai][bj][m][n]; } }
    }
};
struct EpiSwiglu {
    static constexpr bool PERM = true, AFTER_DRAIN = false;
    bf16_t* H;
    __device__ __forceinline__ void operator()(const f32x4 (&acc)[2][2][4][2], const Unit& u, int wr, int wc, int fr, int fq) const {
        const int row0 = u.pm * BM + wr * 64 + fr, hid0 = 128 * (u.pn & 3) + 16 * wc + 4 * fq;
#pragma unroll
        for (int ai = 0; ai < 2; ++ai)
#pragma unroll
            for (int m = 0; m < 4; ++m) { bf16_t* rowp = H + (size_t)(row0 + ai * HALF + m * 16) * 512 + hid0;
#pragma unroll
                for (int bj = 0; bj < 2; ++bj) { const f32x4 g = acc[ai][bj][m][0], uu = acc[ai][bj][m][1]; float h[4];
#pragma unroll
                    for (int i = 0; i < 4; ++i) h[i] = g[i] / (1.f + __expf(-g[i])) * uu[i];
                    unsigned w0 = cvt_pk_bf16(h[0], h[1]), w1 = cvt_pk_bf16(h[2], h[3]);
                    *(unsigned long long*)(rowp + 64 * bj) = (unsigned long long)w0 | ((unsigned long long)w1 << 32); } }
    }
};
struct EpiMoeOut {
    static constexpr bool PERM = true, AFTER_DRAIN = false;
    bf16_t* Y; const int* rowmap;
    __device__ __forceinline__ void operator()(const f32x4 (&acc)[2][2][4][2], const Unit& u, int wr, int wc, int fr, int fq) const {
        const int row0 = u.pm * BM + wr * 64 + fr, col0 = (u.pn & 3) * BM + wc * 32 + 8 * fq;
#pragma unroll
        for (int ai = 0; ai < 2; ++ai)
#pragma unroll
            for (int m = 0; m < 4; ++m) { const int dst = rowmap[row0 + ai * HALF + m * 16];
                if (dst >= 0) { bf16_t* rowp = Y + (size_t)dst * 1024 + col0;
#pragma unroll
                    for (int bj = 0; bj < 2; ++bj) { const f32x4 v0 = acc[ai][bj][m][0], v1 = acc[ai][bj][m][1];
                        u32x4 w; w.x = cvt_pk_bf16(v0[0], v0[1]); w.y = cvt_pk_bf16(v0[2], v0[3]); w.z = cvt_pk_bf16(v1[0], v1[1]); w.w = cvt_pk_bf16(v1[2], v1[3]);
                        *(u32x4*)(rowp + bj * HALF) = w; } } }
    }
};
struct MoeOrder {
    PG8_LAS const int* ptab; int G, c;
    __device__ __forceinline__ bool next(int i, Unit& u) const {
        const int L = i * G + c, np = __builtin_amdgcn_readfirstlane(ptab[0]);
        if (L >= np * 4) return false;
        const int p = L >> 2; u.pm = p; u.pn = __builtin_amdgcn_readfirstlane(ptab[1 + p]) * 4 + (L & 3); return true;
    }
    __device__ __forceinline__ void a_ready(const Unit&) const {}
    __device__ __forceinline__ void done(const Unit&) const {}
};
template <class Epi, class Sched, bool ALIGN_EPI = false, bool SP2 = false>
__device__ __forceinline__ void gemm_phase(PG8_LAS unsigned char* lds, const Gemm g, const Sched& S, const Epi& E) {
    const int tid = threadIdx.x, wid = __builtin_amdgcn_readfirstlane(tid >> 6), lane = tid & 63, wr = wid >> 2, wc = wid & 3, fr = lane & 15, fq = lane >> 4;
    const int K = g.K, nt = K / BK;
    unsigned voffA[2], voffB[2];
#pragma unroll
    for (int i = 0; i < 2; ++i) { int R, C; stage_rc(tid * 16 + i * 8192, R, C); const int Rb = Epi::PERM ? ((R & ~31) + perm32(R & 31)) : R;
        voffA[i] = (unsigned)(R * K + C) * 2u; voffB[i] = (unsigned)(Rb * K + C) * 2u; }
    const size_t kstep = (size_t)(BK * 2);
    const size_t hstep = (size_t)HALF * K * 2;
    const size_t tstep = 2 * hstep;
    const unsigned ldsw = (unsigned)wid * 1024u;
    const int aoff = lds_byte(wr * 64 + fr, fq * 8), boff = lds_byte(wc * 32 + fr, fq * 8);
#define PG8_SA(b, h) (((b) * 2 + (h)) * HTB)
#define PG8_SB(b, h) ((4 + (b) * 2 + (h)) * HTB)
#define PG8_STAGE(bufoff, gbase, voff) do { _Pragma("unroll") for (int _i = 0; _i < 2; ++_i) \
        __builtin_amdgcn_global_load_lds((const unsigned*)((const char*)(gbase) + (voff)[_i]), (PG8_LAS unsigned*)(lds + (bufoff) + ldsw + _i * 8192), 16, 0, 0); } while (0)
#define PG8_LDA(dst, b, h) do { _Pragma("unroll") for (int m = 0; m < 4; ++m) _Pragma("unroll") for (int k = 0; k < 2; ++k) dst[m][k] = *(const PG8_LAS bf16x8*)(lds + PG8_SA(b, h) + aoff + m * 2048 + k * 1024); } while (0)
#define PG8_LDB(dst, b, h) do { _Pragma("unroll") for (int n = 0; n < 2; ++n) _Pragma("unroll") for (int k = 0; k < 2; ++k) dst[n][k] = *(const PG8_LAS bf16x8*)(lds + PG8_SB(b, h) + boff + n * 2048 + k * 1024); } while (0)
#define PG8_MMA(ai, bj, At, Bt) do { __builtin_amdgcn_s_setprio(1); _Pragma("unroll") for (int m = 0; m < 4; ++m) _Pragma("unroll") for (int n = 0; n < 2; ++n) _Pragma("unroll") for (int k = 0; k < 2; ++k) \
        acc[ai][bj][m][n] = __builtin_amdgcn_mfma_f32_16x16x32_bf16(Bt[n][k], At[m][k], acc[ai][bj][m][n], 0, 0, 0); __builtin_amdgcn_s_setprio(0); } while (0)
#define PG8_WAIT_V(n) asm volatile("s_waitcnt vmcnt(" #n ")" ::: "memory")
#define PG8_WAIT_L(n) asm volatile("s_waitcnt lgkmcnt(" #n ")" ::: "memory")
#define PG8_BAR __builtin_amdgcn_s_barrier()
#define PG8_SCHED __builtin_amdgcn_sched_barrier(0)
    Unit cur, nxt; int ui = 0;
    if (!S.next(0, cur)) return;
    f32x4 acc[2][2][4][2];
#pragma unroll
    for (int a = 0; a < 2; ++a)
#pragma unroll
        for (int b = 0; b < 2; ++b)
#pragma unroll
            for (int m = 0; m < 4; ++m)
#pragma unroll
                for (int n = 0; n < 2; ++n) acc[a][b][m][n] = (f32x4){0.f, 0.f, 0.f, 0.f};
    bf16x8 At[4][2], B0[2][2], B1[2][2];
    const char* cA = (const char*)g.A + (size_t)cur.pm * tstep; const char* cB = (const char*)g.Bt + (size_t)cur.pn * tstep;
    S.a_ready(cur);
    if constexpr (SP2) {
        PG8_STAGE(PG8_SB(0, 0), cB, voffB); PG8_STAGE(PG8_SB(0, 1), cB + hstep, voffB); PG8_STAGE(PG8_SA(0, 0), cA, voffA); PG8_STAGE(PG8_SA(0, 1), cA + hstep, voffA);
        if (wr == 1) PG8_BAR;
        PG8_WAIT_V(2); PG8_BAR;
        PG8_STAGE(PG8_SB(1, 0), cB + kstep, voffB); PG8_STAGE(PG8_SA(1, 0), cA + kstep, voffA); PG8_STAGE(PG8_SB(1, 1), cB + hstep + kstep, voffB);
        PG8_WAIT_V(6); PG8_BAR;
    } else {
        PG8_STAGE(PG8_SB(0, 0), cB, voffB); PG8_STAGE(PG8_SA(0, 0), cA, voffA); PG8_STAGE(PG8_SB(0, 1), cB + hstep, voffB); PG8_STAGE(PG8_SA(0, 1), cA + hstep, voffA);
        if (wr == 1) PG8_BAR;
        PG8_WAIT_V(4); PG8_BAR;
        PG8_STAGE(PG8_SB(1, 0), cB + kstep, voffB); PG8_STAGE(PG8_SA(1, 0), cA + kstep, voffA); PG8_STAGE(PG8_SB(1, 1), cB + hstep + kstep, voffB);
        PG8_WAIT_V(6); PG8_BAR;
    }
    for (;;) {
        const bool has_next = S.next(ui + 1, nxt);
        const char* nA = has_next ? (const char*)g.A + (size_t)nxt.pm * tstep : cA; const char* nB = has_next ? (const char*)g.Bt + (size_t)nxt.pn * tstep : cB;
        for (int t = 0; t < nt; t += 2) {
            const bool last = (t == nt - 2);
            const char* a1 = cA + (size_t)(t + 1) * kstep;
            const char* a2 = last ? nA : cA + (size_t)(t + 2) * kstep; const char* b2 = last ? nB : cB + (size_t)(t + 2) * kstep;
            const char* a3 = a2 + kstep; const char* b3 = b2 + kstep;
            if (last && has_next) S.a_ready(nxt);
            if constexpr (SP2) {
            PG8_LDB(B0, 0, 0); PG8_LDB(B1, 0, 1); PG8_SCHED; PG8_LDA(At, 0, 0); PG8_STAGE(PG8_SA(1, 1), a1 + hstep, voffA);
            PG8_WAIT_V(8); PG8_WAIT_L(0); PG8_BAR; PG8_MMA(0, 0, At, B0); PG8_MMA(0, 1, At, B1); PG8_BAR; PG8_SCHED;
            PG8_LDA(At, 0, 1); PG8_STAGE(PG8_SB(0, 0), b2, voffB); PG8_STAGE(PG8_SB(0, 1), b2 + hstep, voffB); PG8_STAGE(PG8_SA(0, 0), a2, voffA);
            PG8_WAIT_V(8); PG8_WAIT_L(0); PG8_BAR; PG8_MMA(1, 0, At, B0); PG8_MMA(1, 1, At, B1); PG8_BAR; PG8_SCHED;
            PG8_LDB(B0, 1, 0); PG8_LDB(B1, 1, 1); PG8_SCHED; PG8_LDA(At, 1, 0); PG8_STAGE(PG8_SA(0, 1), a2 + hstep, voffA);
            PG8_WAIT_V(8); PG8_WAIT_L(0); PG8_BAR; PG8_MMA(0, 0, At, B0); PG8_MMA(0, 1, At, B1); PG8_BAR; PG8_SCHED;
            PG8_LDA(At, 1, 1); PG8_STAGE(PG8_SB(1, 0), b3, voffB); PG8_STAGE(PG8_SB(1, 1), b3 + hstep, voffB); PG8_STAGE(PG8_SA(1, 0), a3, voffA);
            PG8_WAIT_V(8); PG8_WAIT_L(0); PG8_BAR; PG8_MMA(1, 0, At, B0); PG8_MMA(1, 1, At, B1); PG8_BAR; PG8_SCHED;
            } else {
            PG8_LDB(B0, 0, 0); PG8_SCHED; PG8_LDA(At, 0, 0); PG8_STAGE(PG8_SA(1, 1), a1 + hstep, voffA);
            PG8_WAIT_L(8); PG8_BAR; PG8_WAIT_L(0); PG8_MMA(0, 0, At, B0); PG8_BAR; PG8_SCHED;
            PG8_LDB(B1, 0, 1); PG8_STAGE(PG8_SB(0, 0), b2, voffB);
            PG8_BAR; PG8_WAIT_L(0); PG8_MMA(0, 1, At, B1); PG8_BAR;
            PG8_LDA(At, 0, 1); PG8_STAGE(PG8_SA(0, 0), a2, voffA);
            PG8_BAR; PG8_WAIT_L(0); PG8_MMA(1, 0, At, B0); PG8_BAR; PG8_SCHED;
            PG8_STAGE(PG8_SB(0, 1), b2 + hstep, voffB);
            PG8_WAIT_V(6); PG8_BAR; PG8_MMA(1, 1, At, B1); PG8_BAR;
            PG8_LDB(B0, 1, 0); PG8_SCHED; PG8_LDA(At, 1, 0); PG8_STAGE(PG8_SA(0, 1), a2 + hstep, voffA);
            PG8_WAIT_L(8); PG8_BAR; PG8_WAIT_L(0); PG8_MMA(0, 0, At, B0); PG8_BAR; PG8_SCHED;
            PG8_LDB(B1, 1, 1); PG8_STAGE(PG8_SB(1, 0), b3, voffB);
            PG8_BAR; PG8_WAIT_L(0); PG8_MMA(0, 1, At, B1); PG8_BAR;
            PG8_LDA(At, 1, 1); PG8_STAGE(PG8_SA(1, 0), a3, voffA);
            PG8_BAR; PG8_WAIT_L(0); PG8_MMA(1, 0, At, B0); PG8_BAR; PG8_SCHED;
            PG8_STAGE(PG8_SB(1, 1), b3 + hstep, voffB);
            PG8_WAIT_V(6); PG8_BAR; PG8_MMA(1, 1, At, B1); PG8_BAR;
            }
        }
        if constexpr (ALIGN_EPI) { if (wr == 0) PG8_BAR; }
        if constexpr (!Epi::AFTER_DRAIN) { E(acc, cur, wr, wc, fr, fq); S.done(cur); }
        if (!has_next) break;
#pragma unroll
        for (int a = 0; a < 2; ++a)
#pragma unroll
            for (int b = 0; b < 2; ++b)
#pragma unroll
                for (int m = 0; m < 4; ++m)
#pragma unroll
                    for (int n = 0; n < 2; ++n) acc[a][b][m][n] = (f32x4){0.f, 0.f, 0.f, 0.f};
        cur = nxt; cA = nA; cB = nB; ++ui;
        if constexpr (ALIGN_EPI) { if (wr == 1) PG8_BAR; }
    }
    PG8_WAIT_V(0);
    if constexpr (!ALIGN_EPI) { if (wr == 0) PG8_BAR; }
    PG8_BAR;
    if constexpr (Epi::AFTER_DRAIN) { E.fused(acc, cur, wr, wc, fr, fq, lds, wid, lane); S.done(cur); }
#undef PG8_SA
#undef PG8_SB
#undef PG8_STAGE
#undef PG8_LDA
#undef PG8_LDB
#undef PG8_MMA
#undef PG8_WAIT_V
#undef PG8_WAIT_L
#undef PG8_BAR
#undef PG8_SCHED
}
}
#define XB_TMO      128
#define XB_XCNT(j)  (256  + 64 * (j))
#define XB_XSUB(j)  (1280 + 64 * (j))
#define XB_XGEN(j)  (2304 + 64 * (j))
#define XB_TOP      3328
#define XB_TOPGEN   3392
#define XCD_BAR_WORDS 3456
#define XB_SPIN_CAP (1u << 18)
#define LAS __attribute__((address_space(3)))

__device__ __forceinline__ unsigned xb_ld(unsigned* p)              { return __hip_atomic_load(p, __ATOMIC_RELAXED, __HIP_MEMORY_SCOPE_AGENT); }
__device__ __forceinline__ unsigned xb_add(unsigned* p, unsigned v) { return __hip_atomic_fetch_add(p, v, __ATOMIC_RELAXED, __HIP_MEMORY_SCOPE_AGENT); }
__device__ __forceinline__ unsigned xb_xcc_id() { return (unsigned)__builtin_amdgcn_s_getreg((3 << 11) | 20) & 0xFu; }
#define XB_SPIN(cond, bar) do { unsigned _sp = 0; while (cond) { __builtin_amdgcn_s_sleep(1); \
    if ((++_sp & 255u) == 0u) { if (xb_ld(&(bar)[XB_TMO])) break; if (_sp > XB_SPIN_CAP) { atomicAdd(&(bar)[XB_TMO], 1u); break; } } } } while (0)

struct XcdBarrier {
    unsigned* bar; unsigned x;
    volatile LAS unsigned* st;
};

__device__ __forceinline__ XcdBarrier xcd_barrier_post(unsigned* bar, volatile LAS unsigned* st) {
    XcdBarrier b; b.bar = bar; b.x = xb_xcc_id(); b.st = st;
    if (threadIdx.x == 0) (void)xb_add(&bar[XB_XCNT(b.x)], 1u);
    return b;
}
__device__ __forceinline__ void xcd_barrier_complete(unsigned* bar, unsigned x, unsigned& nloc, unsigned& nx) {
    const unsigned G = gridDim.x * gridDim.y * gridDim.z;
    unsigned sum, cnt, mine, sp = 0u;
    for (;;) {
        sum = 0u; cnt = 0u; mine = 0u;
#pragma unroll
        for (unsigned j = 0; j < 16; ++j) { const unsigned c = xb_ld(&bar[XB_XCNT(j)]); sum += c; cnt += (c > 0u) ? 1u : 0u; mine = (j == x) ? c : mine; }
        if (sum == G) break;
        __builtin_amdgcn_s_sleep(1);
        if ((++sp & 255u) == 0u) { if (xb_ld(&bar[XB_TMO])) break; if (sp > XB_SPIN_CAP) { atomicAdd(&bar[XB_TMO], 1u); break; } }
    }
    nloc = mine > 0u ? mine : 1u; nx = cnt > 0u ? cnt : 1u;
}

__device__ __forceinline__ void xcd_barrier(const XcdBarrier& b) {
    asm volatile("s_waitcnt vmcnt(0)" ::: "memory");
    __syncthreads();
    if (threadIdx.x == 0) {
        unsigned* bar = b.bar;
        __builtin_amdgcn_s_waitcnt(0);
        unsigned nloc = b.st[0], nx = b.st[1];
        if (nloc == 0u) { xcd_barrier_complete(bar, b.x, nloc, nx); b.st[0] = nloc; b.st[1] = nx; }
        const unsigned old = xb_add(&bar[XB_XSUB(b.x)], 1u);
        const unsigned gen = old / nloc;
        if (old + 1u == (gen + 1u) * nloc) {
            __builtin_amdgcn_fence(__ATOMIC_RELEASE, "agent");
            asm volatile("s_waitcnt vmcnt(0)" ::: "memory");
            const unsigned og = xb_add(&bar[XB_TOP], 1u);
            const unsigned tg = og / nx;
            if (og + 1u == (tg + 1u) * nx) xb_add(&bar[XB_TOPGEN], 1u);
            else XB_SPIN(xb_ld(&bar[XB_TOPGEN]) == tg, bar);
            __builtin_amdgcn_fence(__ATOMIC_ACQUIRE, "agent");
            xb_add(&bar[XB_XGEN(b.x)], 1u);
            asm volatile("s_waitcnt vmcnt(0)" ::: "memory");
        } else {
            XB_SPIN(xb_ld(&bar[XB_XGEN(b.x)]) == gen, bar);
            __builtin_amdgcn_fence(__ATOMIC_ACQUIRE, "agent");
            asm volatile("s_waitcnt vmcnt(0)" ::: "memory");
        }
    }
    __syncthreads();
}

struct Args { const float* in[47]; float* out; unsigned char* ws; int ph_lo, ph_hi; };
typedef const __attribute__((address_space(4))) Args* KArgsP;
__device__ __forceinline__ KArgsP fresh_args() { KArgsP p = (KArgsP)__builtin_amdgcn_kernarg_segment_ptr(); asm volatile("" : "+s"(p)); return p; }
enum { I_X = 0, I_C, I_ADA_W, I_ADA_B, I_NORM_MIX, I_NORM_FFN, I_NORM_FINAL, I_W_IN, I_W_OUT, I_CONV_W, I_CONV_B, I_WQ, I_WK, I_BI, I_BF, I_MNORM_W,
       I_RMU, I_RW0, I_RWUP, I_RA0, I_RAUP, I_RGUP, I_RKK, I_RKA, I_RRK, I_RLNW, I_RLNB, I_RV0, I_RVDN, I_RVUP,
       I_S5ARE, I_S5AIM, I_S5LDT, I_S5BRE, I_S5BIM, I_S5CRE, I_S5CIM, I_S5D, I_S5GLUW, I_S5GLUB,
       I_MWRG, I_MBRG, I_MWRE, I_MBRE, I_MW1, I_MW3, I_MW2 };

struct RmWin { __device__ __forceinline__ int operator()(int n) const { return n < 1152 ? n : (n < 1164 ? 2816 + (n - 1152) : (n < 2572 ? 1152 + (n - 1164) : 2560 + (n - 2572))); } };
struct RmId  { __device__ __forceinline__ int operator()(int n) const { return n; } };
struct RmGU  { int add; __device__ __forceinline__ int operator()(int n) const { return 8 * (n >> 2) + (n & 3) + add; } };
template <class RM>
__device__ __forceinline__ void transpose_item(const float* W, int ldw, int ncols, int k0, int n0, bf16* WT, int ldt, LAS float* scr, int lane, const RM rm) {
    const int nn = n0 + lane; const bool ok = nn < ncols; const float* src = W + (size_t)k0 * ldw + (ok ? nn : n0);
    float v[64];
#pragma unroll
    for (int kk = 0; kk < 64; ++kk) v[kk] = src[(size_t)kk * ldw];
#pragma unroll
    for (int kk = 0; kk < 64; ++kk) scr[kk * 65 + lane] = v[kk];
    LDS_WAIT(); asm volatile("" ::: "memory");
    const int c = lane & 7;
#pragma unroll
    for (int j = 0; j < 8; ++j) { const int nl = (lane >> 3) + 8 * j; const LAS float* s = scr + (8 * c) * 65 + nl;
        v4u o; o.x = pk2(s[0 * 65], s[1 * 65]); o.y = pk2(s[2 * 65], s[3 * 65]); o.z = pk2(s[4 * 65], s[5 * 65]); o.w = pk2(s[6 * 65], s[7 * 65]);
        if (n0 + nl < ncols) *(GAS v4u*)(WT + (size_t)rm(n0 + nl) * ldt + k0 + 8 * c) = o; }
    LDS_WAIT(); asm volatile("" ::: "memory");
}
__device__ __forceinline__ void moe_convert(const float* w1, const float* w3, const float* w2, int l, bf16* W13, bf16* W2T, int worker, int nworkers, LAS float* scr, int lane) {
    for (int it = worker; it < NEXP * 384; it += nworkers) {
        const int e = it / 384, r = it % 384; const size_t eo = (size_t)(l * NEXP + e) * DM * DEXP;
        if (r < 128)      transpose_item(w1 + eo, DEXP, DEXP, 64 * (r >> 3), 64 * (r & 7), W13 + (size_t)e * 1024 * 1024, 1024, scr, lane, RmGU{0});
        else if (r < 256) transpose_item(w3 + eo, DEXP, DEXP, 64 * ((r - 128) >> 3), 64 * ((r - 128) & 7), W13 + (size_t)e * 1024 * 1024, 1024, scr, lane, RmGU{4});
        else              transpose_item(w2 + eo, DM, DM, 64 * ((r - 256) >> 4), 64 * ((r - 256) & 15), W2T + (size_t)e * 1024 * 512, 512, scr, lane, RmId{});
    }
}
__device__ __forceinline__ void phase_prologue(KArgsP a, LAS unsigned char* lds, int tid, int lane, int wave, int vcu, int G) {
    unsigned char* ws = a->ws;
    LAS float* scr = (LAS float*)(lds + wave * 16640);
    const int gw = vcu * NWAVES + wave, NGW = G * NWAVES;
    bf16* WIN = (bf16*)(ws + WS_WIN); bf16* WOUT = (bf16*)(ws + WS_WOUT);
    for (int it = gw; it < 2 * 16 * 45; it += NGW) { const int l = it / (16 * 45), r = it % (16 * 45);
        transpose_item(a->in[I_W_IN] + (size_t)l * DM * IN_COLS, IN_COLS, IN_COLS, 64 * (r / 45), 64 * (r % 45), WIN + (size_t)l * NPROJ_PAD * DM, DM, scr, lane, RmWin{}); }
    for (int it = gw; it < 2 * 16 * 16; it += NGW) { const int l = it / 256, r = it % 256;
        transpose_item(a->in[I_W_OUT] + (size_t)l * DM * DM, DM, DM, 64 * (r >> 4), 64 * (r & 15), WOUT + (size_t)l * DM * DM, DM, scr, lane, RmId{}); }
    for (int it = gw; it < 2 * 244; it += NGW) { const int l = it / 244, r = 2828 + it % 244; GAS v4u* p = (GAS v4u*)(WIN + ((size_t)l * NPROJ_PAD + r) * DM);
        p[lane] = (v4u){0u, 0u, 0u, 0u}; p[lane + 64] = (v4u){0u, 0u, 0u, 0u}; }
    { float* RTW = (float*)(ws + WS_RTW);
      for (int idx = (vcu * NTHR + tid); idx < 2 * 1024 * 48; idx += G * NTHR) { const int j = idx % 48, k = (idx / 48) % 1024, l = idx / (48 * 1024);
          RTW[idx] = j < 4 ? a->in[I_MWRG][(size_t)(l * 1024 + k) * 4 + j] : (j < 36 ? a->in[I_MWRE][(size_t)(l * 1024 + k) * 32 + (j - 4)] : 0.f); } }
    { bf16* RW = (bf16*)(ws + WS_R1W);
      for (int idx = (vcu * NTHR + tid); idx < 2 * 98304 + 24576; idx += G * NTHR) { float v;
          if (idx < 2 * 98304) { const int l = idx / 98304, r = idx % 98304;
              if (r < 24576)      v = a->in[I_RWUP][(size_t)l * 64 * DBR + (r & 63) * DBR + (r >> 6)];
              else if (r < 49152) v = a->in[I_RAUP][(size_t)l * 64 * DBR + ((r - 24576) & 63) * DBR + ((r - 24576) >> 6)];
              else                v = a->in[I_RGUP][(size_t)l * 128 * DBR + ((r - 49152) & 127) * DBR + ((r - 49152) >> 7)];
          } else { const int r = idx - 2 * 98304;
              if (r < 12288) v = a->in[I_RVDN][(size_t)(r % 384) * 32 + (r / 384)];
              else           v = a->in[I_RVUP][(size_t)((r - 12288) & 31) * DBR + ((r - 12288) >> 5)]; }
          RW[idx] = (bf16)f2bf(v); } }
    { bf16* CM = (bf16*)(ws + WS_S5CM);
      for (int idx = (vcu * NTHR + tid); idx < 2 * 16 * 16 * 128; idx += G * NTHR) { const int k = idx & 127, lgc = idx >> 7;
          CM[idx] = (bf16)f2bf((k & 1) ? -a->in[I_S5CIM][(size_t)lgc * 64 + (k >> 1)] : a->in[I_S5CRE][(size_t)lgc * 64 + (k >> 1)]); } }
    for (int it = gw; it < 2 * 16; it += NGW) { const int l = it >> 4, r = it & 15;
        transpose_item(a->in[I_S5GLUW] + (size_t)l * DC * DC, DC, DC, 64 * (r >> 2), 64 * (r & 3), (bf16*)(ws + WS_GLUT) + (size_t)l * DC * DC, DC, scr, lane, RmId{}); }
    { bf16* MLW = (bf16*)(ws + WS_MLW);
      for (int idx = (vcu * NTHR + tid); idx < 2 * NH * 2 * 4096; idx += G * NTHR) { const int d = idx & 63, e = (idx >> 6) & 63, which = (idx >> 12) & 1, lh = idx >> 13;
          MLW[idx] = (bf16)f2bf(a->in[which ? I_WK : I_WQ][(size_t)lh * 4096 + d * 64 + e]); } }
    moe_convert(a->in[I_MW1], a->in[I_MW3], a->in[I_MW2], 0, (bf16*)(ws + WS_W13), (bf16*)(ws + WS_W2), gw, NGW, scr, lane);
    __syncthreads();
    if (vcu < 192) {
        const int q = vcu, l = q / 96, cb = (q >> 3) % 12, kc = q & 7;
        LAS float* cond = (LAS float*)lds;
        { const int b = tid >> 7, kk = tid & 127; const float cv = a->in[I_C][b * DM + kc * 128 + kk]; cond[tid] = cv / (1.f + __expf(-cv)); }
        __syncthreads();
        const int col = cb * 512 + tid; const float* wp = a->in[I_ADA_W] + ((size_t)l * DM + kc * 128) * 6144 + col;
        float acc0 = 0.f, acc1 = 0.f, acc2 = 0.f, acc3 = 0.f;
#pragma unroll 8
        for (int kk = 0; kk < 128; ++kk) { const float w = wp[(size_t)kk * 6144]; acc0 += cond[kk] * w; acc1 += cond[128 + kk] * w; acc2 += cond[256 + kk] * w; acc3 += cond[384 + kk] * w; }
        const float bias = (kc == 0) ? a->in[I_ADA_B][l * 6144 + col] : 0.f;
        float* MP = (float*)(ws + WS_MODP) + ((size_t)(kc * 2 + l) * 4) * 6144 + col;
        MP[0] = acc0 + bias; MP[6144] = acc1 + bias; MP[2 * 6144] = acc2 + bias; MP[3 * 6144] = acc3 + bias;
    }
}

__device__ __forceinline__ float modval(const unsigned char* ws, bool part, int l, int b, int idx) {
    if (!part) return ((const float*)(ws + WS_MODF))[(size_t)(l * 4 + b) * 6144 + idx];
    const float* mp = (const float*)(ws + WS_MODP) + (size_t)(l * 4 + b) * 6144 + idx; float s = 0.f;
#pragma unroll
    for (int kc = 0; kc < 8; ++kc) s += mp[(size_t)kc * 2 * 4 * 6144];
    return s;
}
template <int MODE, bool COMBINE>
__device__ __forceinline__ void phase_rownorm(KArgsP a, LAS unsigned char* lds, int tid, int lane, int wave, int G,
                                              const float* xsrc, float* xdst, const float* gvec, bool part, int l, int isc  , int lprev) {
    unsigned char* ws = a->ws;
    LAS float* sc = (LAS float*)lds; LAS float* sh = sc + 1024; LAS float* gt = sh + 1024;
    bf16* HN = (bf16*)(ws + WS_HN); const bf16* YM = (const bf16*)(ws + WS_YMOE); const float* TW = (const float*)(ws + WS_TOKW);
    for (int c = blockIdx.x; c < NTOK / 128; c += G) {
        const int b = c >> 6;
        __syncthreads();
        for (int j = tid; j < 1024; j += NTHR) {
            if (MODE == 0) { sc[j] = gvec[j] * (1.f + modval(ws, part, l, b, (isc + 1) * 1024 + j)); sh[j] = modval(ws, part, l, b, isc * 1024 + j); }
            else { sc[j] = gvec[j]; sh[j] = 0.f; }
            if (COMBINE) gt[j] = 1.f + modval(ws, false, lprev, b, 5 * 1024 + j);
        }
        __syncthreads();
        f32x4 vn[4]; v2u yn0[4], yn1[4]; float wn0 = 0.f, wn1 = 0.f;
        { const int row = c * 128 + wave * 16; const GAS f32x4* xr = (const GAS f32x4*)(xsrc + (size_t)row * DM) + lane;
#pragma unroll
          for (int j = 0; j < 4; ++j) vn[j] = xr[64 * j];
          if (COMBINE) { wn0 = TW[2 * row]; wn1 = TW[2 * row + 1]; const GAS v2u* y0 = (const GAS v2u*)(YM + (size_t)(2 * row) * DM) + lane; const GAS v2u* y1 = (const GAS v2u*)(YM + (size_t)(2 * row + 1) * DM) + lane;
#pragma unroll
              for (int j = 0; j < 4; ++j) { yn0[j] = y0[64 * j]; yn1[j] = y1[64 * j]; } } }
        for (int i = 0; i < 16; ++i) {
            const int row = c * 128 + wave * 16 + i;
            f32x4 v[4]; v2u q0[4], q1[4]; const float w0 = wn0, w1 = wn1;
#pragma unroll
            for (int j = 0; j < 4; ++j) { v[j] = vn[j]; q0[j] = yn0[j]; q1[j] = yn1[j]; }
            if (i + 1 < 16) { const int rn = row + 1; const GAS f32x4* xr = (const GAS f32x4*)(xsrc + (size_t)rn * DM) + lane;
#pragma unroll
                for (int j = 0; j < 4; ++j) vn[j] = xr[64 * j];
                if (COMBINE) { wn0 = TW[2 * rn]; wn1 = TW[2 * rn + 1]; const GAS v2u* y0 = (const GAS v2u*)(YM + (size_t)(2 * rn) * DM) + lane; const GAS v2u* y1 = (const GAS v2u*)(YM + (size_t)(2 * rn + 1) * DM) + lane;
#pragma unroll
                    for (int j = 0; j < 4; ++j) { yn0[j] = y0[64 * j]; yn1[j] = y1[64 * j]; } } }
            if (COMBINE) {
#pragma unroll
                for (int j = 0; j < 4; ++j) { const v2u p0 = q0[j], p1 = q1[j]; const f32x4 g4 = *(const LAS f32x4*)(gt + lane * 4 + 256 * j);
                    f32x4 m; m.x = w0 * bflo(p0.x) + w1 * bflo(p1.x); m.y = w0 * bfhi(p0.x) + w1 * bfhi(p1.x); m.z = w0 * bflo(p0.y) + w1 * bflo(p1.y); m.w = w0 * bfhi(p0.y) + w1 * bfhi(p1.y);
                    v[j] = v[j] + g4 * m; }
                if (MODE == 0) { GAS f32x4* xo = (GAS f32x4*)(xdst + (size_t)row * DM) + lane;
#pragma unroll
                    for (int j = 0; j < 4; ++j) xo[64 * j] = v[j]; }
            }
            float ss = 0.f;
#pragma unroll
            for (int j = 0; j < 4; ++j) ss += (v[j].x * v[j].x + v[j].y * v[j].y) + (v[j].z * v[j].z + v[j].w * v[j].w);
            const float rstd = rsqrtf(wave_sum(ss) * (1.f / DM) + NORM_EPS);
            if (MODE == 0) {
                GAS v2u* o = (GAS v2u*)(HN + (size_t)row * DM) + lane;
#pragma unroll
                for (int j = 0; j < 4; ++j) { const f32x4 s4 = *(const LAS f32x4*)(sc + lane * 4 + 256 * j), h4 = *(const LAS f32x4*)(sh + lane * 4 + 256 * j); const f32x4 h = v[j] * rstd * s4 + h4;
                    v2u w; w.x = pk2(h.x, h.y); w.y = pk2(h.z, h.w); o[64 * j] = w; }
            } else {
                GAS f32x4* o = (GAS f32x4*)(xdst + (size_t)row * DM) + lane;
#pragma unroll
                for (int j = 0; j < 4; ++j) { const f32x4 s4 = *(const LAS f32x4*)(sc + lane * 4 + 256 * j); o[64 * j] = v[j] * rstd * s4; }
            }
        }
    }
}
__device__ __forceinline__ void mod_finalize(unsigned char* ws, int tid, int G) {
    float* MF = (float*)(ws + WS_MODF);
    for (int idx = blockIdx.x * NTHR + tid; idx < 2 * 4 * 6144; idx += G * NTHR) { const float* mp = (const float*)(ws + WS_MODP) + idx; float s = 0.f;
#pragma unroll
        for (int kc = 0; kc < 8; ++kc) s += mp[(size_t)kc * 2 * 4 * 6144];
        MF[idx] = s; }
}

typedef float f32x4m __attribute__((ext_vector_type(4)));
__device__ __forceinline__ void phase_router(KArgsP a, LAS unsigned char* lds, int tid, int lane, int wave, int G, int l) {
    unsigned char* ws = a->ws;
    LAS float* sc = (LAS float*)lds; LAS float* sh = sc + 1024; LAS float* rstd_s = sh + 1024  ; LAS float* cvec = rstd_s + 128  ; LAS float* cpart = cvec + 64  ;
    LAS float* lg = cpart + 8 * 48  ; LAS int* hist = (LAS int*)(lg + 8 * 16 * 48)  ; LAS int* basev = hist + 32; LAS int* asg_e = basev + 32  ; LAS int* asg_lp = asg_e + 256;
    bf16* HN = (bf16*)(ws + WS_HN); const float* x = a->out; const float* RTW = (const float*)(ws + WS_RTW) + (size_t)l * 1024 * 48;
    int* TOKE = (int*)(ws + WS_TOKE); float* TOKW = (float*)(ws + WS_TOKW); int* LIST = (int*)(ws + WS_LIST); unsigned* CNT = (unsigned*)(ws + WS_CTL) + CW_CNT + l * 32;
    const float* gvec = a->in[I_NORM_FFN] + l * DM;
    for (int c = blockIdx.x; c < NTOK / 128; c += G) {
        const int b = c >> 6;
        __syncthreads();
        for (int j = tid; j < 1024; j += NTHR) { sc[j] = gvec[j] * (1.f + modval(ws, false, l, b, 4 * 1024 + j)); sh[j] = modval(ws, false, l, b, 3 * 1024 + j); }
        if (tid < 32) hist[tid] = 0;
        __syncthreads();
        if (tid < 384) { const int j = tid % 48, part = tid / 48; float s = 0.f;
            for (int k = part * 128; k < part * 128 + 128; ++k) s += sh[k] * RTW[(size_t)k * 48 + j];
            cpart[part * 48 + j] = s; }
        { f32x4 vn[4];
          { const GAS f32x4* xr = (const GAS f32x4*)(x + (size_t)(c * 128 + wave * 16) * DM) + lane;
#pragma unroll
            for (int j = 0; j < 4; ++j) vn[j] = xr[64 * j]; }
          for (int i = 0; i < 16; ++i) {
            const int row = c * 128 + wave * 16 + i;
            f32x4 v[4]; float ss = 0.f;
#pragma unroll
            for (int j = 0; j < 4; ++j) { v[j] = vn[j]; ss += (v[j].x * v[j].x + v[j].y * v[j].y) + (v[j].z * v[j].z + v[j].w * v[j].w); }
            if (i + 1 < 16) { const GAS f32x4* xr = (const GAS f32x4*)(x + (size_t)(row + 1) * DM) + lane;
#pragma unroll
                for (int j = 0; j < 4; ++j) vn[j] = xr[64 * j]; }
            const float rstd = rsqrtf(wave_sum(ss) * (1.f / DM) + NORM_EPS);
            if (lane == 0) rstd_s[wave * 16 + i] = rstd;
            GAS v2u* o = (GAS v2u*)(HN + (size_t)row * DM) + lane;
#pragma unroll
            for (int j = 0; j < 4; ++j) { const f32x4 s4 = *(const LAS f32x4*)(sc + lane * 4 + 256 * j), h4 = *(const LAS f32x4*)(sh + lane * 4 + 256 * j); const f32x4 h = v[j] * rstd * s4 + h4;
                v2u w; w.x = pk2(h.x, h.y); w.y = pk2(h.z, h.w); o[64 * j] = w; }
          } }
        __syncthreads();
        if (tid < 48) { float s = 0.f;
#pragma unroll
            for (int p = 0; p < 8; ++p) s += cpart[p * 48 + tid];
            s += tid < 4 ? a->in[I_MBRG][l * 4 + tid] : (tid < 36 ? a->in[I_MBRE][l * 32 + tid - 4] : 0.f); cvec[tid] = s; }
        {
            const int i16 = lane & 15, kq = lane >> 4, r0 = c * 128 + wave * 16;
            f32x4m acc0 = {0.f, 0.f, 0.f, 0.f}, acc1 = acc0, acc2 = acc0;
            const float* xrow = x + (size_t)(r0 + i16) * DM + 4 * kq;
            for (int k0 = 0; k0 < DM; k0 += 16) {
                const f32x4 xv = *(const GAS f32x4*)(xrow + k0); const f32x4 sv = *(const LAS f32x4*)(sc + k0 + 4 * kq);
                const float* wp = RTW + (size_t)(k0 + 4 * kq) * 48 + i16;
#pragma unroll
                for (int j = 0; j < 4; ++j) { const float av = xv[j] * sv[j];
                    acc0 = __builtin_amdgcn_mfma_f32_16x16x4f32(av, wp[j * 48], acc0, 0, 0, 0);
                    acc1 = __builtin_amdgcn_mfma_f32_16x16x4f32(av, wp[j * 48 + 16], acc1, 0, 0, 0);
                    acc2 = __builtin_amdgcn_mfma_f32_16x16x4f32(av, wp[j * 48 + 32], acc2, 0, 0, 0); }
            }
            __syncthreads();
            LAS float* lw = lg + wave * 16 * 48;
#pragma unroll
            for (int r = 0; r < 4; ++r) { const int rr = 4 * kq + r; const float rs = rstd_s[wave * 16 + rr];
                lw[rr * 48 + i16] = acc0[r] * rs + cvec[i16]; lw[rr * 48 + 16 + i16] = acc1[r] * rs + cvec[16 + i16]; lw[rr * 48 + 32 + i16] = acc2[r] * rs + cvec[32 + i16]; }
            LDS_WAIT(); asm volatile("" ::: "memory");
            if (lane < 16) {
                const LAS float* lr = lw + lane * 48; const int row = r0 + lane;
                float g0 = lr[0], g1 = lr[1], g2 = lr[2], g3 = lr[3]; const float gm = fmaxf(fmaxf(g0, g1), fmaxf(g2, g3));
                float p0 = __expf(g0 - gm), p1 = __expf(g1 - gm), p2 = __expf(g2 - gm), p3 = __expf(g3 - gm); const float inv = 1.f / (p0 + p1 + p2 + p3);
                p0 *= inv; p1 *= inv; p2 *= inv; p3 *= inv;
                int gi = 0; float gp = p0; if (p1 > gp) { gp = p1; gi = 1; } if (p2 > gp) { gp = p2; gi = 2; } if (p3 > gp) { gp = p3; gi = 3; }
                float ev0 = -3.4e38f, ev1 = -3.4e38f; int e0 = 0, e1 = 0;
#pragma unroll
                for (int j = 0; j < 8; ++j) { const float s = lr[4 + gi * 8 + j]; if (s > ev0) { ev1 = ev0; e1 = e0; ev0 = s; e0 = j; } else if (s > ev1) { ev1 = s; e1 = j; } }
                const float q = __expf(ev1 - ev0), w0 = gp / (1.f + q), w1 = gp * q / (1.f + q);
                e0 += gi * 8; e1 += gi * 8;
                TOKE[2 * row] = e0; TOKE[2 * row + 1] = e1; TOKW[2 * row] = w0; TOKW[2 * row + 1] = w1;
                const int a0 = 2 * (wave * 16 + lane);
                asg_e[a0] = e0; asg_e[a0 + 1] = e1; asg_lp[a0] = atomicAdd((int*)&hist[e0], 1); asg_lp[a0 + 1] = atomicAdd((int*)&hist[e1], 1);
            }
        }
        __syncthreads();
        if (tid < 32) { const int h = hist[tid]; basev[tid] = h ? (int)atomicAdd(CNT + tid, (unsigned)h) : 0; }
        __syncthreads();
        if (tid < 256) { const int e = asg_e[tid]; LIST[(size_t)e * 65536 + basev[e] + asg_lp[tid]] = (c * 128) * 2 + tid; }
    }
}
__device__ __forceinline__ void build_ptab(const unsigned* CNT, LAS int* ptab, LAS int* pst, LAS int* cnt, int tid) {
    __syncthreads();
    if (tid == 0) { int np = 0;
        for (int e = 0; e < NEXP; ++e) { const int ce = (int)__hip_atomic_load(CNT + e, RLX_AGENT); cnt[e] = ce; pst[e] = np * 256; const int pe = (ce + 255) >> 8;
            for (int p = 0; p < pe; ++p) ptab[1 + np + p] = e;
            np += pe; }
        ptab[0] = np; }
    __syncthreads();
}
__device__ __forceinline__ void phase_gather(KArgsP a, LAS unsigned char* lds, int tid, int lane, int wave, int vcu, int G, int l) {
    unsigned char* ws = a->ws;
    LAS int* ptab = (LAS int*)lds; LAS int* pst = ptab + 512; LAS int* cnt = pst + 32;
    build_ptab((const unsigned*)(ws + WS_CTL) + CW_CNT + l * 32, ptab, pst, cnt, tid);
    const bf16* HN = (const bf16*)(ws + WS_HN); bf16* XG = (bf16*)(ws + WS_XG); int* ROWMAP = (int*)(ws + WS_ROWMAP); const int* LIST = (const int*)(ws + WS_LIST);
    const int nrows = ptab[0] * 256;
    for (int row0 = (vcu * NWAVES + wave) * 8; row0 < nrows; row0 += G * NWAVES * 8) {
        int tok2[8]; v4u p0[8], p1[8];
#pragma unroll
        for (int j = 0; j < 8; ++j) { const int row = row0 + j, e = ptab[1 + (row >> 8)], pos = row - pst[e]; tok2[j] = (pos < cnt[e]) ? LIST[(size_t)e * 65536 + pos] : -1; }
#pragma unroll
        for (int j = 0; j < 8; ++j) { if (tok2[j] >= 0) { const GAS v4u* s = (const GAS v4u*)(HN + (size_t)(tok2[j] >> 1) * DM) + lane; p0[j] = s[0]; p1[j] = s[64]; } else { p0[j] = (v4u){0u, 0u, 0u, 0u}; p1[j] = p0[j]; } }
#pragma unroll
        for (int j = 0; j < 8; ++j) { GAS v4u* d = (GAS v4u*)(XG + (size_t)(row0 + j) * DM) + lane; d[0] = p0[j]; d[64] = p1[j]; if (lane == 0) ROWMAP[row0 + j] = tok2[j]; }
    }
}

typedef short bf16x8 __attribute__((ext_vector_type(8)));
constexpr int MT = 72;
constexpr int ML_XP = 0;
constexpr int ML_CX = 17152;
constexpr int ML_WQ = ML_CX + 9216, ML_WK = ML_WQ + 9216;
constexpr int ML_Q = ML_WK + 9216, ML_K = ML_Q + 9216;
constexpr int ML_S = ML_K + 9216;
constexpr int ML_VT = ML_S + 9216;
constexpr int ML_CT = ML_VT + 11520;
constexpr int ML_H = ML_CT + 11520;
constexpr int ML_SM = ML_H + 16640;
static_assert(ML_SM + 2048 <= RING_BYTES, "mLSTM LDS map");
__device__ __forceinline__ float logsigmoidf_(float x) { return fminf(x, 0.f) - log1pf(__expf(-fabsf(x))); }
__device__ __forceinline__ void mma64(const LAS bf16* A, int arow0, const LAS bf16* Bt, int brow0, int lane, f32x4& acc) {
    const LAS bf16* ap = A + (arow0 + (lane & 15)) * MT + 8 * (lane >> 4); const LAS bf16* bp = Bt + (brow0 + (lane & 15)) * MT + 8 * (lane >> 4);
    const bf16x8 a0 = *(const LAS bf16x8*)ap, a1 = *(const LAS bf16x8*)(ap + 32), b0 = *(const LAS bf16x8*)bp, b1 = *(const LAS bf16x8*)(bp + 32);
    acc = __builtin_amdgcn_mfma_f32_16x16x32_bf16(a0, b0, acc, 0, 0, 0); acc = __builtin_amdgcn_mfma_f32_16x16x32_bf16(a1, b1, acc, 0, 0, 0);
}
__device__ __forceinline__ void ml_front(KArgsP a, LAS unsigned char* lds, int tid, int l, int b, int c, int h, bool want_q) {
    const bf16* PROJ = (const bf16*)(a->ws + WS_PROJ); const size_t row0 = (size_t)b * SEQ + c * 64;
    LAS float* xp = (LAS float*)(lds + ML_XP);
    for (int idx = tid; idx < 67 * 8; idx += NTHR) { const int r = idx >> 3, c8 = idx & 7, tr = c * 64 + r - 3; LAS float* d = xp + r * 64 + c8 * 8;
        if (tr >= 0) { const v4u p = *(const GAS v4u*)(PROJ + ((size_t)b * SEQ + tr) * NPROJ + PC_QK + h * 64 + c8 * 8);
            *(LAS f32x4*)d = (f32x4){bflo(p.x), bfhi(p.x), bflo(p.y), bfhi(p.y)}; *(LAS f32x4*)(d + 4) = (f32x4){bflo(p.z), bfhi(p.z), bflo(p.w), bfhi(p.w)}; }
        else { *(LAS f32x4*)d = (f32x4){0.f, 0.f, 0.f, 0.f}; *(LAS f32x4*)(d + 4) = (f32x4){0.f, 0.f, 0.f, 0.f}; } }
    {
        const int t = tid >> 3, vg = tid & 7; LAS bf16* VT = (LAS bf16*)(lds + ML_VT);
        const v4u p = *(const GAS v4u*)(PROJ + (row0 + t) * NPROJ + PC_V + h * 64 + vg * 8);
        const unsigned w[4] = {p.x, p.y, p.z, p.w};
#pragma unroll
        for (int j = 0; j < 4; ++j) { VT[(vg * 8 + 2 * j) * MT + t] = (bf16)(w[j] & 0xffffu); VT[(vg * 8 + 2 * j + 1) * MT + t] = (bf16)(w[j] >> 16); }
        for (int idx = tid; idx < 16 * 64; idx += NTHR) VT[(64 + (idx >> 6)) * MT + (idx & 63)] = (idx < 64) ? (bf16)0x3F80 : (bf16)0;
        const bf16* WT = (const bf16*)(a->ws + WS_MLW) + (size_t)((l * NH + h) * 2) * 4096;
        const int e = tid >> 3, d8 = tid & 7;
        if (want_q) *(LAS v4u*)(lds + ML_WQ + (e * MT + d8 * 8) * 2) = *(const GAS v4u*)(WT + e * 64 + d8 * 8);
        *(LAS v4u*)(lds + ML_WK + (e * MT + d8 * 8) * 2) = *(const GAS v4u*)(WT + 4096 + e * 64 + d8 * 8);
    }
    __syncthreads();
    const float* cw = a->in[I_CONV_W] + (size_t)l * 4 * DA + h * 64; const float* cb = a->in[I_CONV_B] + (size_t)l * DA + h * 64;
    {
        const int t = tid >> 3, c8 = (tid & 7) * 8; float s[8];
#pragma unroll
        for (int j = 0; j < 8; ++j) s[j] = cb[c8 + j];
#pragma unroll
        for (int q = 0; q < 4; ++q) { const f32x4 x0 = *(const LAS f32x4*)(xp + (t + q) * 64 + c8), x1 = *(const LAS f32x4*)(xp + (t + q) * 64 + c8 + 4); const float* w = cw + q * DA + c8;
            s[0] += x0.x * w[0]; s[1] += x0.y * w[1]; s[2] += x0.z * w[2]; s[3] += x0.w * w[3]; s[4] += x1.x * w[4]; s[5] += x1.y * w[5]; s[6] += x1.z * w[6]; s[7] += x1.w * w[7]; }
#pragma unroll
        for (int j = 0; j < 8; ++j) s[j] = s[j] / (1.f + __expf(-s[j]));
        v4u o; o.x = pk2(s[0], s[1]); o.y = pk2(s[2], s[3]); o.z = pk2(s[4], s[5]); o.w = pk2(s[6], s[7]);
        *(LAS v4u*)(lds + ML_CX + (t * MT + c8) * 2) = o;
    }
}
__device__ __forceinline__ void phase_m1(KArgsP a, LAS unsigned char* lds, int tid, int lane, int wave, int vcu, int G, int l) {
    unsigned char* ws = a->ws; const float* GT = (const float*)(ws + WS_GATES);
    float* CLOC = (float*)(ws + WS_CLOC); float* MLG = (float*)(ws + WS_MSC); float* MLM = MLG + 4096;
    LAS float* sm = (LAS float*)(lds + ML_SM);
    for (int u = vcu; u < NUNIT_M; u += G) {
        const int h = u % NH, c = (u / NH) % NCH, b = u / (NH * NCH); const size_t row0 = (size_t)b * SEQ + c * 64;
        __syncthreads();
        ml_front(a, lds, tid, l, b, c, h, false);
        if (wave == 0) {
            const float ig = GT[(row0 + lane) * 16 + h] + a->in[I_BI][l * NH + h];
            const float fl = logsigmoidf_(GT[(row0 + lane) * 16 + 6 + h] + a->in[I_BF][l * NH + h]);
            float bc = fl;
#pragma unroll
            for (int o = 1; o < 64; o <<= 1) { const float t = __shfl_up(bc, o); if (lane >= o) bc += t; }
            const float gtot = __shfl(bc, 63); const float lw = gtot - bc + ig; const float ml = wave_max(lw);
            sm[lane] = __expf(lw - ml);
            if (lane == 0) { MLG[u] = gtot; MLM[u] = ml; }
        }
        __syncthreads();
        {
            const int rt = wave >> 1; LAS bf16* KT = (LAS bf16*)(lds + ML_K);
#pragma unroll
            for (int q = 0; q < 2; ++q) { const int ct = 2 * (wave & 1) + q; f32x4 acc = {0.f, 0.f, 0.f, 0.f};
                mma64((const LAS bf16*)(lds + ML_CX), 16 * rt, (const LAS bf16*)(lds + ML_WK), 16 * ct, lane, acc);
                const int t0 = 16 * rt + 4 * (lane >> 4), e = 16 * ct + (lane & 15);
                const float w0 = sm[t0] * 0.125f, w1 = sm[t0 + 1] * 0.125f, w2 = sm[t0 + 2] * 0.125f, w3 = sm[t0 + 3] * 0.125f;
                v2u o; o.x = pk2(acc[0] * w0, acc[1] * w1); o.y = pk2(acc[2] * w2, acc[3] * w3);
                *(LAS v2u*)(KT + e * MT + t0) = o; }
        }
        __syncthreads();
        {
            const int ct = wave & 3, r_lo = wave < 4 ? 0 : 3, r_hi = wave < 4 ? 3 : 5; float* cl = CLOC + (size_t)u * CL_STRIDE;
            for (int rt = r_lo; rt < r_hi; ++rt) { f32x4 acc = {0.f, 0.f, 0.f, 0.f};
                mma64((const LAS bf16*)(lds + ML_VT), 16 * rt, (const LAS bf16*)(lds + ML_K), 16 * ct, lane, acc);
                const int v0 = 16 * rt + 4 * (lane >> 4), e = 16 * ct + (lane & 15);
                if (rt < 4) {
#pragma unroll
                    for (int r = 0; r < 4; ++r) cl[(v0 + r) * 64 + e] = acc[r];
                } else if ((lane >> 4) == 0) cl[4096 + e] = acc[0]; }
        }
    }
}
__device__ __forceinline__ void phase_m2(unsigned char* ws, int tid, int wg, int nwg) {
    float* CLOC = (float*)(ws + WS_CLOC); const float* MLG = (const float*)(ws + WS_MSC); const float* MLM = MLG + 4096; float* MST = (float*)(ws + WS_MSC) + 8192;
    for (int idx = wg * NTHR + tid; idx < NB * NH * CL_STRIDE; idx += nwg * NTHR) {
        const int e = idx % CL_STRIDE, bh = idx / CL_STRIDE, b = bh / NH, h = bh % NH;
        float m = 0.f, cs = 0.f;
        for (int c0 = 0; c0 < NCH; c0 += 8) {
            float cl[8], g[8], ml[8];
#pragma unroll
            for (int j = 0; j < 8; ++j) { const int u = (b * NCH + c0 + j) * NH + h; cl[j] = CLOC[(size_t)u * CL_STRIDE + e]; g[j] = MLG[u]; ml[j] = MLM[u]; }
#pragma unroll
            for (int j = 0; j < 8; ++j) { const int u = (b * NCH + c0 + j) * NH + h;
                CLOC[(size_t)u * CL_STRIDE + e] = cs; if (e == 0) MST[u] = m;
                const float mn = fmaxf(g[j] + m, ml[j]); const float ao = __expf(g[j] + m - mn), al = __expf(ml[j] - mn);
                cs = ao * cs + al * cl[j]; m = mn; }
        }
    }
}
__device__ __forceinline__ void phase_m3(KArgsP a, LAS unsigned char* lds, int tid, int lane, int wave, int vcu, int G, int l) {
    unsigned char* ws = a->ws; const bf16* PROJ = (const bf16*)(ws + WS_PROJ); const float* GT = (const float*)(ws + WS_GATES);
    const float* CLOC = (const float*)(ws + WS_CLOC); const float* MST = (const float*)(ws + WS_MSC) + 8192; bf16* YC = (bf16*)(ws + WS_YC);
    LAS float* sm = (LAS float*)(lds + ML_SM); LAS float* hb = (LAS float*)(lds + ML_H);
    for (int u = vcu; u < NUNIT_M; u += G) {
        const int h = u % NH, c = (u / NH) % NCH, b = u / (NH * NCH); const size_t row0 = (size_t)b * SEQ + c * 64;
        __syncthreads();
        ml_front(a, lds, tid, l, b, c, h, true);
        {
            const float* cl = CLOC + (size_t)u * CL_STRIDE; LAS bf16* CT = (LAS bf16*)(lds + ML_CT);
            for (int idx = tid; idx < 65 * 16; idx += NTHR) { const int r = idx >> 4, c4 = idx & 15; const f32x4 v = *(const GAS f32x4*)(cl + r * 64 + c4 * 4);
                v2u o; o.x = pk2(v.x, v.y); o.y = pk2(v.z, v.w); *(LAS v2u*)(CT + r * MT + c4 * 4) = o; }
            for (int idx = tid; idx < 15 * 64; idx += NTHR) CT[(65 + (idx >> 6)) * MT + (idx & 63)] = 0;
        }
        if (wave == 0) {
            const float ig = GT[(row0 + lane) * 16 + h] + a->in[I_BI][l * NH + h];
            const float fl = logsigmoidf_(GT[(row0 + lane) * 16 + 6 + h] + a->in[I_BF][l * NH + h]);
            float bc = fl;
#pragma unroll
            for (int o = 1; o < 64; o <<= 1) { const float t = __shfl_up(bc, o); if (lane >= o) bc += t; }
            float pm = ig - bc;
#pragma unroll
            for (int o = 1; o < 64; o <<= 1) { const float t = __shfl_up(pm, o); if (lane >= o) pm = fmaxf(pm, t); }
            const float mst = MST[u]; const float inter = bc + mst, mt = fmaxf(inter, bc + pm);
            sm[lane] = ig - bc; sm[64 + lane] = bc - mt; sm[128 + lane] = __expf(inter - mt); sm[192 + lane] = __expf(-mt);
        }
        __syncthreads();
        {
            const int rt = wave >> 1; LAS bf16* Qs = (LAS bf16*)(lds + ML_Q); LAS bf16* Ks = (LAS bf16*)(lds + ML_K);
#pragma unroll
            for (int q = 0; q < 2; ++q) { const int ct = 2 * (wave & 1) + q; f32x4 aq = {0.f, 0.f, 0.f, 0.f}, ak = {0.f, 0.f, 0.f, 0.f};
                mma64((const LAS bf16*)(lds + ML_CX), 16 * rt, (const LAS bf16*)(lds + ML_WQ), 16 * ct, lane, aq);
                mma64((const LAS bf16*)(lds + ML_CX), 16 * rt, (const LAS bf16*)(lds + ML_WK), 16 * ct, lane, ak);
                const int t0 = 16 * rt + 4 * (lane >> 4), e = 16 * ct + (lane & 15);
#pragma unroll
                for (int r = 0; r < 4; ++r) { Qs[(t0 + r) * MT + e] = (bf16)f2bf(aq[r]); Ks[(t0 + r) * MT + e] = (bf16)f2bf(ak[r] * 0.125f); } }
        }
        __syncthreads();
        {
            const int rt = wave >> 1; LAS bf16* Ss = (LAS bf16*)(lds + ML_S);
#pragma unroll
            for (int q = 0; q < 2; ++q) { const int ct = 2 * (wave & 1) + q; f32x4 acc = {0.f, 0.f, 0.f, 0.f};
                if (ct <= rt) mma64((const LAS bf16*)(lds + ML_Q), 16 * rt, (const LAS bf16*)(lds + ML_K), 16 * ct, lane, acc);
                const int t0 = 16 * rt + 4 * (lane >> 4), s = 16 * ct + (lane & 15); const float qs = sm[s];
#pragma unroll
                for (int r = 0; r < 4; ++r) { const int t = t0 + r; Ss[t * MT + s] = (bf16)f2bf((s <= t) ? acc[r] * __expf(sm[64 + t] + qs) : 0.f); } }
        }
        __syncthreads();
        {
            const int rt = wave >> 1, nt = (wave & 1) ? 2 : 3;
            for (int q = 0; q < nt; ++q) { const int ct = (wave & 1) ? 2 + q : (q < 2 ? q : 4); f32x4 aA = {0.f, 0.f, 0.f, 0.f}, aB = {0.f, 0.f, 0.f, 0.f};
                mma64((const LAS bf16*)(lds + ML_Q), 16 * rt, (const LAS bf16*)(lds + ML_CT), 16 * ct, lane, aA);
                mma64((const LAS bf16*)(lds + ML_S), 16 * rt, (const LAS bf16*)(lds + ML_VT), 16 * ct, lane, aB);
                const int t0 = 16 * rt + 4 * (lane >> 4), v = 16 * ct + (lane & 15);
#pragma unroll
                for (int r = 0; r < 4; ++r) { const int t = t0 + r; const float x = sm[128 + t] * aA[r] + aB[r];
                    if (ct < 4) hb[t * 65 + v] = x; else if ((lane & 15) == 0) sm[256 + t] = x; } }
        }
        __syncthreads();
        {
            const int t = tid >> 3, vg = tid & 7; float acc[8];
            const float dn = 1.f / fmaxf(fabsf(sm[256 + t]), sm[192 + t]);
            float s1 = 0.f;
#pragma unroll
            for (int j = 0; j < 8; ++j) { acc[j] = hb[t * 65 + vg * 8 + j] * dn; s1 += acc[j]; }
            s1 += __shfl_xor(s1, 1); s1 += __shfl_xor(s1, 2); s1 += __shfl_xor(s1, 4);
            const float mu = s1 * (1.f / 64.f); float s2 = 0.f;
#pragma unroll
            for (int j = 0; j < 8; ++j) { acc[j] -= mu; s2 += acc[j] * acc[j]; }
            s2 += __shfl_xor(s2, 1); s2 += __shfl_xor(s2, 2); s2 += __shfl_xor(s2, 4);
            const float rs = rsqrtf(s2 * (1.f / 64.f) + HEAD_NORM_EPS);
            const float* nw = a->in[I_MNORM_W] + (size_t)l * DA + h * 64 + vg * 8;
            const v4u ov = *(const GAS v4u*)(PROJ + (row0 + t) * NPROJ + PC_O + h * 64 + vg * 8);
            const float o[8] = {bflo(ov.x), bfhi(ov.x), bflo(ov.y), bfhi(ov.y), bflo(ov.z), bfhi(ov.z), bflo(ov.w), bfhi(ov.w)};
            float r[8];
#pragma unroll
            for (int j = 0; j < 8; ++j) r[j] = acc[j] * rs * nw[j] * sigmoidf_(o[j]);
            v4u w; w.x = pk2(r[0], r[1]); w.y = pk2(r[2], r[3]); w.z = pk2(r[4], r[5]); w.w = pk2(r[6], r[7]);
            *(GAS v4u*)(YC + (row0 + t) * DM + h * 64 + vg * 8) = w;
        }
    }
}

constexpr int S5_UT = 264, S5_XT = 2056;
constexpr int S5_U = 0, S5_Z = 33792, S5_X = 67584;
static_assert(S5_X + 16 * S5_XT * 2 <= MISC_OFF, "S5 LDS map");
struct S5A { float are, aim, cre, cim; };
__device__ __forceinline__ S5A s5_a(KArgsP a, int l, int g, int p) {
    const float lam_re = a->in[I_S5ARE][(size_t)(l * 16 + g) * 64 + p], lam_im = a->in[I_S5AIM][(size_t)(l * 16 + g) * 64 + p];
    const float dt = expf(a->in[I_S5LDT][l * 16 + g]); const float mag = expf(lam_re * dt), ang = lam_im * dt;
    S5A r; r.are = mag * cosf(ang); r.aim = mag * sinf(ang);
    const float inv = 1.f / (lam_re * lam_re + lam_im * lam_im);
    r.cre = ((r.are - 1.f) * lam_re + r.aim * lam_im) * inv; r.cim = (r.aim * lam_re - (r.are - 1.f) * lam_im) * inv; return r;
}
__device__ __forceinline__ bf16x8 pack8(const float* v) { v4u o; o.x = pk2(v[0], v[1]); o.y = pk2(v[2], v[3]); o.z = pk2(v[4], v[5]); o.w = pk2(v[6], v[7]); return __builtin_bit_cast(bf16x8, o); }
__device__ __forceinline__ void s5_bfrag(KArgsP a, int l, int g, int lane, bf16x8 (&bf)[8]) {
#pragma unroll
    for (int j = 0; j < 8; ++j) { const int n = 16 * j + (lane & 15), p = n >> 1, im = n & 1, kq = lane >> 4; float v[8];
        if (kq < 2) { const S5A A = s5_a(a, l, g, p);
            const float* br = a->in[I_S5BRE] + ((size_t)(l * 16 + g) * 64 + p) * 16 + 8 * kq; const float* bi = a->in[I_S5BIM] + ((size_t)(l * 16 + g) * 64 + p) * 16 + 8 * kq;
#pragma unroll
            for (int q = 0; q < 8; ++q) v[q] = im ? (A.cre * bi[q] + A.cim * br[q]) : (A.cre * br[q] - A.cim * bi[q]);
        } else {
#pragma unroll
            for (int q = 0; q < 8; ++q) v[q] = 0.f; }
        bf[j] = pack8(v); }
}
__device__ __forceinline__ void s5_load_u(const unsigned char* ws, LAS unsigned char* lds, int tid, size_t row0) {
    const bf16* PROJ = (const bf16*)(ws + WS_PROJ);
    for (int idx = tid; idx < 64 * 32; idx += NTHR) { const int t = idx >> 5, c8 = idx & 31;
        *(LAS v4u*)(lds + S5_U + (t * S5_UT + c8 * 8) * 2) = *(const GAS v4u*)(PROJ + (row0 + t) * NPROJ + PC_S5 + c8 * 8); }
}
__device__ __forceinline__ void s5_block(LAS unsigned char* lds, int lane, int tb, int g, const bf16x8 (&bf)[8], float are, float aim, float& xr, float& xi) {
    const int kq = lane >> 4; bf16x8 uf = {0, 0, 0, 0, 0, 0, 0, 0};
    if (kq < 2) uf = *(const LAS bf16x8*)(lds + S5_U + ((16 * tb + (lane & 15)) * S5_UT + g * 16 + 8 * kq) * 2);
    LAS bf16* X = (LAS bf16*)(lds + S5_X);
#pragma unroll
    for (int j = 0; j < 8; ++j) { f32x4 acc = {0.f, 0.f, 0.f, 0.f}; acc = __builtin_amdgcn_mfma_f32_16x16x32_bf16(bf[j], uf, acc, 0, 0, 0);
        v2u o; o.x = pk2(acc[0], acc[1]); o.y = pk2(acc[2], acc[3]); *(LAS v2u*)(X + (lane & 15) * S5_XT + g * 128 + 16 * j + 4 * kq) = o; }
    LDS_WAIT(); asm volatile("" ::: "memory");
    LAS unsigned* xw = (LAS unsigned*)(lds + S5_X) + (g * 128 + 2 * lane) / 2;
#pragma unroll
    for (int t = 0; t < 16; ++t) { const unsigned w = xw[t * (S5_XT / 2)]; const float br = bflo(w), bi = bfhi(w);
        const float nr = are * xr - aim * xi + br, ni = are * xi + aim * xr + bi; xr = nr; xi = ni;
        xw[t * (S5_XT / 2)] = pk2(xr, xi); }
    LDS_WAIT(); asm volatile("" ::: "memory");
}
__device__ __forceinline__ void phase_s1(KArgsP a, LAS unsigned char* lds, int tid, int lane, int wave, int vcu, int G, int l) {
    unsigned char* ws = a->ws; float* ST = (float*)(ws + WS_S5ST);
    bf16x8 bf0[8], bf1[8]; s5_bfrag(a, l, wave, lane, bf0); s5_bfrag(a, l, wave + 8, lane, bf1);
    const S5A A0 = s5_a(a, l, wave, lane), A1 = s5_a(a, l, wave + 8, lane);
    for (int u = vcu; u < NB * NCH; u += G) {
        const size_t row0 = (size_t)u * 64;
        __syncthreads();
        s5_load_u(ws, lds, tid, row0);
        __syncthreads();
        float x0r = 0.f, x0i = 0.f, x1r = 0.f, x1i = 0.f;
        for (int tb = 0; tb < 4; ++tb) { s5_block(lds, lane, tb, wave, bf0, A0.are, A0.aim, x0r, x0i); s5_block(lds, lane, tb, wave + 8, bf1, A1.are, A1.aim, x1r, x1i); }
        *(f32x2*)(ST + (((size_t)u * 16 + wave) * 64 + lane) * 2) = (f32x2){x0r, x0i};
        *(f32x2*)(ST + (((size_t)u * 16 + wave + 8) * 64 + lane) * 2) = (f32x2){x1r, x1i};
    }
}
__device__ __forceinline__ void phase_s2(KArgsP a, int tid, int wg, int nwg, int l) {
    float* ST = (float*)(a->ws + WS_S5ST);
    for (int idx = wg * NTHR + tid; idx < NB * 1024; idx += nwg * NTHR) {
        const int b = idx >> 10, gp = idx & 1023, g = gp >> 6, p = gp & 63;
        const S5A A = s5_a(a, l, g, p); float ar = A.are, ai = A.aim;
#pragma unroll
        for (int s = 0; s < 6; ++s) { const float nr = ar * ar - ai * ai, ni = 2.f * ar * ai; ar = nr; ai = ni; }
        float cr = 0.f, ci = 0.f;
        for (int c0 = 0; c0 < NCH; c0 += 8) {
            f32x2 e[8];
#pragma unroll
            for (int j = 0; j < 8; ++j) e[j] = *(const f32x2*)(ST + (((size_t)(b * NCH + c0 + j) * 16 + g) * 64 + p) * 2);
#pragma unroll
            for (int j = 0; j < 8; ++j) { *(f32x2*)(ST + (((size_t)(b * NCH + c0 + j) * 16 + g) * 64 + p) * 2) = (f32x2){cr, ci};
                const float nr = ar * cr - ai * ci + e[j].x, ni = ar * ci + ai * cr + e[j].y; cr = nr; ci = ni; }
        }
    }
}
__device__ __forceinline__ float gelu_tanh_(float x) { const float t = tanhf(0.7978845608f * (x + 0.044715f * x * x * x)); return 0.5f * x * (1.f + t); }
__device__ __forceinline__ void s5_cproj(LAS unsigned char* lds, int lane, int tb, int g, const bf16* cmt  , const float (&dv)[4]) {
    const int kq = lane >> 4; f32x4 acc = {0.f, 0.f, 0.f, 0.f};
    bf16x8 cf[4];
#pragma unroll
    for (int s = 0; s < 4; ++s) cf[s] = __builtin_bit_cast(bf16x8, *(const GAS v4u*)(cmt + (lane & 15) * 128 + 32 * s + 8 * kq));
    const LAS bf16* xp = (const LAS bf16*)(lds + S5_X) + (lane & 15) * S5_XT + g * 128 + 8 * kq;
#pragma unroll
    for (int s = 0; s < 4; ++s) acc = __builtin_amdgcn_mfma_f32_16x16x32_bf16(cf[s], *(const LAS bf16x8*)(xp + 32 * s), acc, 0, 0, 0);
    const int t = 16 * tb + (lane & 15), c0 = g * 16 + 4 * kq;
    const v2u uw = *(const LAS v2u*)(lds + S5_U + (t * S5_UT + c0) * 2);
    const float u4[4] = {bflo(uw.x), bfhi(uw.x), bflo(uw.y), bfhi(uw.y)}; float z[4];
#pragma unroll
    for (int r = 0; r < 4; ++r) z[r] = gelu_tanh_(acc[r] + dv[r] * u4[r]);
    v2u o; o.x = pk2(z[0], z[1]); o.y = pk2(z[2], z[3]); *(LAS v2u*)(lds + S5_Z + (t * S5_UT + c0) * 2) = o;
}
__device__ __forceinline__ void phase_s3(KArgsP a, LAS unsigned char* lds, int tid, int lane, int wave, int vcu, int G, int l) {
    unsigned char* ws = a->ws; const float* ST = (const float*)(ws + WS_S5ST); bf16* YC = (bf16*)(ws + WS_YC);
    const bf16* GLUT = (const bf16*)(ws + WS_GLUT) + (size_t)l * DC * DC;
    bf16x8 bf0[8], bf1[8]; s5_bfrag(a, l, wave, lane, bf0); s5_bfrag(a, l, wave + 8, lane, bf1);
    const bf16* cm0 = (const bf16*)(ws + WS_S5CM) + (size_t)(l * 16 + wave) * 2048; const bf16* cm1 = cm0 + 8 * 2048;
    const S5A A0 = s5_a(a, l, wave, lane), A1 = s5_a(a, l, wave + 8, lane);
    float d0[4], d1[4];
#pragma unroll
    for (int r = 0; r < 4; ++r) { d0[r] = a->in[I_S5D][l * DC + wave * 16 + 4 * (lane >> 4) + r]; d1[r] = a->in[I_S5D][l * DC + (wave + 8) * 16 + 4 * (lane >> 4) + r]; }
    for (int u = vcu; u < NB * NCH; u += G) {
        const size_t row0 = (size_t)u * 64;
        __syncthreads();
        s5_load_u(ws, lds, tid, row0);
        const f32x2 s0 = *(const f32x2*)(ST + (((size_t)u * 16 + wave) * 64 + lane) * 2), s1 = *(const f32x2*)(ST + (((size_t)u * 16 + wave + 8) * 64 + lane) * 2);
        float x0r = s0.x, x0i = s0.y, x1r = s1.x, x1i = s1.y;
        __syncthreads();
        for (int tb = 0; tb < 4; ++tb) {
            s5_block(lds, lane, tb, wave, bf0, A0.are, A0.aim, x0r, x0i); s5_cproj(lds, lane, tb, wave, cm0, d0);
            s5_block(lds, lane, tb, wave + 8, bf1, A1.are, A1.aim, x1r, x1i); s5_cproj(lds, lane, tb, wave + 8, cm1, d1);
        }
        __syncthreads();
        {
            const int kq = lane >> 4;
#pragma unroll
            for (int q = 0; q < 2; ++q) { const int ct = 2 * wave + q; f32x4 acc[4];
#pragma unroll
                for (int rt = 0; rt < 4; ++rt) acc[rt] = (f32x4){0.f, 0.f, 0.f, 0.f};
                const bf16* gp = GLUT + (size_t)(16 * ct + (lane & 15)) * DC + 8 * kq;
#pragma unroll 2
                for (int s = 0; s < 8; ++s) { const bf16x8 gf = __builtin_bit_cast(bf16x8, *(const GAS v4u*)(gp + 32 * s));
#pragma unroll
                    for (int rt = 0; rt < 4; ++rt) acc[rt] = __builtin_amdgcn_mfma_f32_16x16x32_bf16(gf, *(const LAS bf16x8*)(lds + S5_Z + ((16 * rt + (lane & 15)) * S5_UT + 32 * s + 8 * kq) * 2), acc[rt], 0, 0, 0); }
                const int j0 = 16 * ct + 4 * kq; const f32x4 gb = *(const GAS f32x4*)(a->in[I_S5GLUB] + l * DC + j0);
#pragma unroll
                for (int rt = 0; rt < 4; ++rt) { const int t = 16 * rt + (lane & 15); const v2u zw = *(const LAS v2u*)(lds + S5_Z + (t * S5_UT + j0) * 2);
                    const float z0 = bflo(zw.x), z1 = bfhi(zw.x), z2 = bflo(zw.y), z3 = bfhi(zw.y);
                    v2u o; o.x = pk2(z0 * sigmoidf_(acc[rt][0] + gb.x), z1 * sigmoidf_(acc[rt][1] + gb.y)); o.y = pk2(z2 * sigmoidf_(acc[rt][2] + gb.z), z3 * sigmoidf_(acc[rt][3] + gb.w));
                    *(GAS v2u*)(YC + (row0 + t) * DM + 768 + j0) = o; } }
        }
    }
}

__device__ __forceinline__ float rw_shift(const bf16* PROJ, const float* mu, size_t row, int col) {
    const float cur = bf2f(PROJ[row * NPROJ + PC_RW + col]); const float prv = (row % SEQ) ? bf2f(PROJ[(row - 1) * NPROJ + PC_RW + col]) : 0.f;
    return cur + mu[col] * (prv - cur);
}
constexpr int R1_TH = 0, R1_AD = 9216, R1_SG = 18432, R1_VS = 35840, R1_TMP = 86016;
template <int KS, int MODE>
__device__ __forceinline__ void r1_prod(const bf16* WT, const LAS bf16* act, int astride, const float* bias, bf16* OUT, size_t row0, int lane, int wave) {
    const int kq = lane >> 4, n0 = 48 * wave; constexpr int K = 32 * KS;
    f32x4 acc[3][4];
#pragma unroll
    for (int nt = 0; nt < 3; ++nt)
#pragma unroll
        for (int ti = 0; ti < 4; ++ti) acc[nt][ti] = (f32x4){0.f, 0.f, 0.f, 0.f};
#pragma unroll
    for (int s = 0; s < KS; ++s) { bf16x8 wf[3], af[4];
#pragma unroll
        for (int nt = 0; nt < 3; ++nt) wf[nt] = __builtin_bit_cast(bf16x8, *(const GAS v4u*)(WT + (size_t)(n0 + 16 * nt + (lane & 15)) * K + 32 * s + 8 * kq));
#pragma unroll
        for (int ti = 0; ti < 4; ++ti) af[ti] = *(const LAS bf16x8*)(act + (16 * ti + (lane & 15)) * astride + 32 * s + 8 * kq);
#pragma unroll
        for (int nt = 0; nt < 3; ++nt)
#pragma unroll
            for (int ti = 0; ti < 4; ++ti) acc[nt][ti] = __builtin_amdgcn_mfma_f32_16x16x32_bf16(wf[nt], af[ti], acc[nt][ti], 0, 0, 0); }
#pragma unroll
    for (int nt = 0; nt < 3; ++nt) { const int n = n0 + 16 * nt + 4 * kq; f32x4 bv = {0.f, 0.f, 0.f, 0.f}; if (MODE != 2) bv = *(const GAS f32x4*)(bias + n);
#pragma unroll
        for (int ti = 0; ti < 4; ++ti) { float o[4];
#pragma unroll
            for (int r = 0; r < 4; ++r) { const float x = acc[nt][ti][r] + bv[r]; o[r] = MODE == 0 ? 0.60653066f * sigmoidf_(x) : (MODE == 1 ? sigmoidf_(x) : x); }
            v2u w; w.x = pk2(o[0], o[1]); w.y = pk2(o[2], o[3]);
            *(GAS v2u*)(OUT + (row0 + 16 * ti + (lane & 15)) * DBR + n) = w; } }
}
__device__ __forceinline__ void phase_r1(KArgsP a, LAS unsigned char* lds, int tid, int lane, int wave, int vcu, int G, int l) {
    unsigned char* ws = a->ws; const bf16* PROJ = (const bf16*)(ws + WS_PROJ); const float* mu = a->in[I_RMU] + (size_t)l * RW_COLS;
    const bf16* W1 = (const bf16*)(ws + WS_R1W) + (size_t)l * 98304;
    const bf16* WV = (const bf16*)(ws + WS_R1W) + 2 * 98304;
    for (int u = vcu; u < NTOK / 64; u += G) {
        const size_t row0 = (size_t)u * 64;
        __syncthreads();
        for (int idx = tid; idx < 64 * 128; idx += NTHR) { const int tt = idx >> 7, col = 2 * (idx & 127); const size_t r = row0 + tt;
            const unsigned cw = *(const GAS unsigned*)(PROJ + r * NPROJ + PC_RW + RWC_WD + col); const unsigned pw = (r % SEQ) ? *(const GAS unsigned*)(PROJ + (r - 1) * NPROJ + PC_RW + RWC_WD + col) : 0u;
            const float c0 = bflo(cw), c1 = bfhi(cw); const float x0 = c0 + mu[RWC_WD + col] * (bflo(pw) - c0), x1 = c1 + mu[RWC_WD + col + 1] * (bfhi(pw) - c1);
            if (col < 64) *(LAS unsigned*)(lds + R1_TH + (tt * 72 + col) * 2) = pk2(tanhf(x0), tanhf(x1));
            else if (col < 128) *(LAS unsigned*)(lds + R1_AD + (tt * 72 + col - 64) * 2) = pk2(x0, x1);
            else *(LAS unsigned*)(lds + R1_SG + (tt * 136 + col - 128) * 2) = pk2(sigmoidf_(x0), sigmoidf_(x1)); }
        if (l > 0) for (int idx = tid; idx < 64 * 192; idx += NTHR) { const int tt = idx / 192, col = 2 * (idx % 192); const size_t r = row0 + tt;
            const unsigned cw = *(const GAS unsigned*)(PROJ + r * NPROJ + PC_RW + RWC_V + col); const unsigned pw = (r % SEQ) ? *(const GAS unsigned*)(PROJ + (r - 1) * NPROJ + PC_RW + RWC_V + col) : 0u;
            const float c0 = bflo(cw), c1 = bfhi(cw);
            *(LAS unsigned*)(lds + R1_VS + (tt * 392 + col) * 2) = pk2(c0 + mu[RWC_V + col] * (bflo(pw) - c0), c1 + mu[RWC_V + col + 1] * (bfhi(pw) - c1)); }
        __syncthreads();
        r1_prod<2, 0>(W1, (const LAS bf16*)(lds + R1_TH), 72, a->in[I_RW0] + l * DBR, (bf16*)(ws + WS_RE), row0, lane, wave);
        r1_prod<2, 1>(W1 + 24576, (const LAS bf16*)(lds + R1_AD), 72, a->in[I_RA0] + l * DBR, (bf16*)(ws + WS_RA), row0, lane, wave);
        r1_prod<4, 2>(W1 + 49152, (const LAS bf16*)(lds + R1_SG), 136, nullptr, (bf16*)(ws + WS_RG), row0, lane, wave);
        if (l > 0) {
            { const int kq = lane >> 4, mt = wave & 1, ti = wave >> 1; f32x4 acc = {0.f, 0.f, 0.f, 0.f};
#pragma unroll 4
              for (int s = 0; s < 12; ++s) acc = __builtin_amdgcn_mfma_f32_16x16x32_bf16(__builtin_bit_cast(bf16x8, *(const GAS v4u*)(WV + (size_t)(16 * mt + (lane & 15)) * 384 + 32 * s + 8 * kq)),
                                                                                          *(const LAS bf16x8*)(lds + R1_VS + ((16 * ti + (lane & 15)) * 392 + 32 * s + 8 * kq) * 2), acc, 0, 0, 0);
              v2u w; w.x = pk2(acc[0], acc[1]); w.y = pk2(acc[2], acc[3]); *(LAS v2u*)(lds + R1_TMP + ((16 * ti + (lane & 15)) * 40 + 16 * mt + 4 * kq) * 2) = w; }
            __syncthreads();
            r1_prod<1, 1>(WV + 12288, (const LAS bf16*)(lds + R1_TMP), 40, a->in[I_RV0], (bf16*)(ws + WS_RVG), row0, lane, wave);
        }
    }
}
__device__ __forceinline__ float dpp_allsum(float x) {
    x += __builtin_bit_cast(float, __builtin_amdgcn_update_dpp(0, __builtin_bit_cast(int, x), 0x128, 0xf, 0xf, false));
    x += __builtin_bit_cast(float, __builtin_amdgcn_update_dpp(0, __builtin_bit_cast(int, x), 0x124, 0xf, 0xf, false));
    x += __builtin_bit_cast(float, __builtin_amdgcn_update_dpp(0, __builtin_bit_cast(int, x), 0x122, 0xf, 0xf, false));
    x += __builtin_bit_cast(float, __builtin_amdgcn_update_dpp(0, __builtin_bit_cast(int, x), 0x121, 0xf, 0xf, false));
    { const unsigned xi = __builtin_bit_cast(unsigned, x); auto r = __builtin_amdgcn_permlane16_swap(xi, xi, false, false); const unsigned r0 = r[0], r1 = r[1]; x = __uint_as_float(r0) + __uint_as_float(r1); }
    { const unsigned xi = __builtin_bit_cast(unsigned, x); auto r = __builtin_amdgcn_permlane32_swap(xi, xi, false, false); const unsigned r0 = r[0], r1 = r[1]; x = __uint_as_float(r0) + __uint_as_float(r1); }
    return x;
}
constexpr int R2_TC = 16, R2_PAR = R2_TC * 16 * 20, R2_YP = R2_TC * 2 * 64;
struct R2Regs { v2u r0, r1, k0, k1; v2u aa, ee; unsigned vc, vp, vg, vf; };
__device__ __forceinline__ float allsum16(float x) {
    x += __builtin_bit_cast(float, __builtin_amdgcn_update_dpp(0, __builtin_bit_cast(int, x), 0x128, 0xf, 0xf, false));
    x += __builtin_bit_cast(float, __builtin_amdgcn_update_dpp(0, __builtin_bit_cast(int, x), 0x124, 0xf, 0xf, false));
    x += __builtin_bit_cast(float, __builtin_amdgcn_update_dpp(0, __builtin_bit_cast(int, x), 0x122, 0xf, 0xf, false));
    x += __builtin_bit_cast(float, __builtin_amdgcn_update_dpp(0, __builtin_bit_cast(int, x), 0x121, 0xf, 0xf, false));
    return x;
}
__device__ __forceinline__ void r2_issue(const unsigned char* ws, int l, size_t row, int h, int sl, int lt, R2Regs& R) {
    const bf16* PROJ = (const bf16*)(ws + WS_PROJ);
    const int tt = lt >> 4, kq = lt & 15; const size_t r = row + tt; const bool first = (r % SEQ) == 0; const size_t rp = first ? r : r - 1;
    R.r0 = *(const GAS v2u*)(PROJ + r * NPROJ + PC_RW + RWC_R + h * 64 + kq * 4); R.r1 = *(const GAS v2u*)(PROJ + rp * NPROJ + PC_RW + RWC_R + h * 64 + kq * 4);
    R.k0 = *(const GAS v2u*)(PROJ + r * NPROJ + PC_RW + RWC_K + h * 64 + kq * 4); R.k1 = *(const GAS v2u*)(PROJ + rp * NPROJ + PC_RW + RWC_K + h * 64 + kq * 4);
    R.aa = *(const GAS v2u*)((const bf16*)(ws + WS_RA) + r * DBR + h * 64 + kq * 4); R.ee = *(const GAS v2u*)((const bf16*)(ws + WS_RE) + r * DBR + h * 64 + kq * 4);
    if (first) { R.r1 = (v2u){0u, 0u}; R.k1 = (v2u){0u, 0u}; }
    if (lt < 128) { const int t2 = lt >> 3, rr = lt & 7; const size_t q = row + t2; const bool f2 = (q % SEQ) == 0; const int vcol = h * 64 + sl * 8 + rr;
        R.vc = PROJ[q * NPROJ + PC_RW + RWC_V + vcol]; R.vp = f2 ? 0u : (unsigned)PROJ[(q - 1) * NPROJ + PC_RW + RWC_V + vcol];
        if (l > 0) { R.vg = ((const bf16*)(ws + WS_RVG))[q * DBR + vcol]; R.vf = ((const bf16*)(ws + WS_VF))[q * DBR + vcol]; } }
}
__device__ __forceinline__ void r2_prep(KArgsP a, int l, size_t row, int h, int sl, int lt, const R2Regs& R, LAS float* par, LAS float* vb) {
    const int tt = lt >> 4, kq = lt & 15, c0 = h * 64 + kq * 4;
    const float* mu = a->in[I_RMU] + (size_t)l * RW_COLS; const float* kkw = a->in[I_RKK] + (size_t)l * DBR + c0; const float* kaw = a->in[I_RKA] + (size_t)l * DBR + c0;
    const float rc[4] = {bflo(R.r0.x), bfhi(R.r0.x), bflo(R.r0.y), bfhi(R.r0.y)}, rp[4] = {bflo(R.r1.x), bfhi(R.r1.x), bflo(R.r1.y), bfhi(R.r1.y)};
    const float kc[4] = {bflo(R.k0.x), bfhi(R.k0.x), bflo(R.k0.y), bfhi(R.k0.y)}, kp[4] = {bflo(R.k1.x), bfhi(R.k1.x), bflo(R.k1.y), bfhi(R.k1.y)};
    const float av[4] = {bflo(R.aa.x), bfhi(R.aa.x), bflo(R.aa.y), bfhi(R.aa.y)}, ev[4] = {bflo(R.ee.x), bfhi(R.ee.x), bflo(R.ee.y), bfhi(R.ee.y)};
    float rs[4], ks[4], kk[4], ss = 0.f;
#pragma unroll
    for (int j = 0; j < 4; ++j) { rs[j] = rc[j] + mu[RWC_R + c0 + j] * (rp[j] - rc[j]); ks[j] = kc[j] + mu[RWC_K + c0 + j] * (kp[j] - kc[j]); kk[j] = ks[j] * kkw[j]; ss += kk[j] * kk[j]; }
    ss += __shfl_xor(ss, 1); ss += __shfl_xor(ss, 2); ss += __shfl_xor(ss, 4); ss += __shfl_xor(ss, 8);
    const float inv = 1.f / fmaxf(sqrtf(ss), 1e-12f);
    float w[4], an[4], bk[4], km[4];
#pragma unroll
    for (int j = 0; j < 4; ++j) { const float kn = kk[j] * inv; w[j] = __expf(-ev[j]); an[j] = -kn; bk[j] = kn * av[j]; km[j] = ks[j] * (1.f + (av[j] - 1.f) * kaw[j]); }
    LAS float* rec = par + (tt * 16 + kq) * 20;
    *(LAS f32x4*)(rec) = (f32x4){w[0], w[1], w[2], w[3]}; *(LAS f32x4*)(rec + 4) = (f32x4){an[0], an[1], an[2], an[3]}; *(LAS f32x4*)(rec + 8) = (f32x4){bk[0], bk[1], bk[2], bk[3]};
    *(LAS f32x4*)(rec + 12) = (f32x4){km[0], km[1], km[2], km[3]}; *(LAS f32x4*)(rec + 16) = (f32x4){rs[0], rs[1], rs[2], rs[3]};
    if (lt < 128) { const int t2 = lt >> 3, rr = lt & 7, vcol = h * 64 + sl * 8 + rr; const float vc = bf2f(R.vc), vp = bf2f(R.vp);
        float v = vc + mu[RWC_V + vcol] * (vp - vc);
        if (l == 0) ((bf16*)(a->ws + WS_VF))[(row + t2) * DBR + vcol] = (bf16)f2bf(v);
        else { v = v + (bf2f(R.vf) - v) * bf2f(R.vg); }
        vb[t2 * 8 + rr] = v; }
}
__device__ __forceinline__ void r2_yreduce(unsigned char* ws, size_t row, int h, int sl, int yt, const LAS float* yp) {
    const int t2 = yt >> 3, rr = yt & 7; const LAS float* src = yp + (t2 * 2 + (rr >> 2)) * 64 + (rr & 3) * 16; float s = 0.f;
#pragma unroll
    for (int q = 0; q < 4; ++q) { const f32x4 v = *(const LAS f32x4*)(src + 4 * q); s += (v.x + v.y) + (v.z + v.w); }
    ((bf16*)(ws + WS_YC))[(row + t2) * DM + 384 + h * 64 + sl * 8 + rr] = (bf16)f2bf(s);
}
__device__ __forceinline__ void r2_scan(const LAS float* par, const LAS float* vb, LAS float* yp, int lane, int wave, f32x4& s) {
    const int kq = lane & 15, row = 4 * wave + (lane >> 4);
    const LAS float* rec = par + kq * 20; const LAS float* vr = vb + row; LAS float* yo = yp + wave * 64 + lane;
    f32x4 W[3], A[3], B[3], K[3], R[3]; float VV[3];
#pragma unroll
    for (int q = 0; q < 2; ++q) { W[q] = *(const LAS f32x4*)(rec + q * 320); A[q] = *(const LAS f32x4*)(rec + q * 320 + 4); B[q] = *(const LAS f32x4*)(rec + q * 320 + 8);
        K[q] = *(const LAS f32x4*)(rec + q * 320 + 12); R[q] = *(const LAS f32x4*)(rec + q * 320 + 16); VV[q] = vr[q * 8]; }
#pragma unroll
    for (int t = 0; t < R2_TC; ++t) {
        const int c = t % 3, n = (t + 2) % 3;
        if (t + 2 < R2_TC) { W[n] = *(const LAS f32x4*)(rec + (t + 2) * 320); A[n] = *(const LAS f32x4*)(rec + (t + 2) * 320 + 4); B[n] = *(const LAS f32x4*)(rec + (t + 2) * 320 + 8);
            K[n] = *(const LAS f32x4*)(rec + (t + 2) * 320 + 12); R[n] = *(const LAS f32x4*)(rec + (t + 2) * 320 + 16); VV[n] = vr[(t + 2) * 8]; }
        const f32x4 w = W[c], a = A[c], b = B[c], k = K[c], r = R[c]; const float vv = VV[c];
        const float sa = allsum16(fmaf(s.w, a.w, fmaf(s.z, a.z, fmaf(s.y, a.y, s.x * a.x))));
        const f32x4 u = s * w + k * vv;
        s = b * sa + u;
        yo[t * 128] = fmaf(s.w, r.w, fmaf(s.z, r.z, fmaf(s.y, r.y, s.x * r.x)));
        __builtin_amdgcn_sched_barrier(0);
    }
}
__device__ __forceinline__ void phase_r2(KArgsP a, LAS unsigned char* lds, int tid, int lane, int wave, int wg, int l) {
    unsigned char* ws = a->ws;
    LAS float* PAR0 = (LAS float*)lds; LAS float* PAR1 = PAR0 + R2_PAR; LAS float* V0 = PAR1 + R2_PAR; LAS float* V1 = V0 + 128; LAS float* YP0 = V1 + 128; LAS float* YP1 = YP0 + R2_YP;
    const int b = wg / 48, h = (wg % 48) >> 3, sl = wg & 7; const size_t rowb = (size_t)b * SEQ;
    const bool scan = wave < 2, loader = wave >= 2 && wave < 6, reducer = wave >= 6; const int lt = tid - 128, yt = tid - 384;
    constexpr int NC = SEQ / R2_TC;
    R2Regs RA, RB;
    if (loader) { r2_issue(ws, l, rowb, h, sl, lt, RA); r2_prep(a, l, rowb, h, sl, lt, RA, PAR0, V0); r2_issue(ws, l, rowb + R2_TC, h, sl, lt, RA); }
    __syncthreads();
    f32x4 s = {0.f, 0.f, 0.f, 0.f};
    for (int c = 0; c < NC; c += 2) {
        if (scan) r2_scan(PAR0, V0, YP0, lane, wave, s);
        else if (loader) { if (c + 2 < NC) r2_issue(ws, l, rowb + (size_t)(c + 2) * R2_TC, h, sl, lt, RB);
                           r2_prep(a, l, rowb + (size_t)(c + 1) * R2_TC, h, sl, lt, RA, PAR1, V1); }
        else if (c > 0) r2_yreduce(ws, rowb + (size_t)(c - 1) * R2_TC, h, sl, yt, YP1);
        __syncthreads();
        if (scan) r2_scan(PAR1, V1, YP1, lane, wave, s);
        else if (loader) { if (c + 3 < NC) r2_issue(ws, l, rowb + (size_t)(c + 3) * R2_TC, h, sl, lt, RA);
                           if (c + 2 < NC) r2_prep(a, l, rowb + (size_t)(c + 2) * R2_TC, h, sl, lt, RB, PAR0, V0); }
        else r2_yreduce(ws, rowb + (size_t)c * R2_TC, h, sl, yt, YP0);
        __syncthreads();
    }
    if (reducer) r2_yreduce(ws, rowb + (size_t)(NC - 1) * R2_TC, h, sl, yt, YP1);
}
__device__ __forceinline__ void phase_r3(KArgsP a, int lane, int gw, int ngw, int l) {
    unsigned char* ws = a->ws; const bf16* PROJ = (const bf16*)(ws + WS_PROJ); bf16* YC = (bf16*)(ws + WS_YC);
    const bf16* RA = (const bf16*)(ws + WS_RA); const bf16* RG = (const bf16*)(ws + WS_RG); const bf16* RVG = (const bf16*)(ws + WS_RVG); const bf16* VF = (const bf16*)(ws + WS_VF);
    const float* mu = a->in[I_RMU] + (size_t)l * RW_COLS;
    for (size_t row = gw; row < NTOK; row += ngw) {
#pragma unroll 2
        for (int h = 0; h < NH; ++h) {
            const int c = h * 64 + lane;
            const float y = bf2f(YC[row * DM + 384 + c]);
            const float m = dpp_allsum(y) * (1.f / 64.f); const float d = y - m; const float var = dpp_allsum(d * d) * (1.f / 64.f);
            const float yn = d * rsqrtf(var + RWKV_GN_EPS) * a->in[I_RLNW][l * DBR + c] + a->in[I_RLNB][l * DBR + c];
            const float rs = rw_shift(PROJ, mu, row, RWC_R + c), ks = rw_shift(PROJ, mu, row, RWC_K + c); float v = rw_shift(PROJ, mu, row, RWC_V + c);
            if (l > 0) v = v + (bf2f(VF[row * DBR + c]) - v) * bf2f(RVG[row * DBR + c]);
            const float av = bf2f(RA[row * DBR + c]);
            const float km = ks * (1.f + (av - 1.f) * a->in[I_RKA][l * DBR + c]);
            const float rk = dpp_allsum(rs * km * a->in[I_RRK][l * DBR + c]);
            YC[row * DM + 384 + c] = (bf16)f2bf((yn + rk * v) * bf2f(RG[row * DBR + c]));
        }
    }
}

constexpr int PH_PER_LAYER = 10, PH_FINAL = 1 + 2 * PH_PER_LAYER, N_PHASES = PH_FINAL + 1;
constexpr int R2_WGS = 192;
__global__ void __launch_bounds__(NTHR, 2) fwd(Args args) {
    extern __shared__ __attribute__((aligned(16))) unsigned char lds_raw[];
    LAS unsigned char* lds = (LAS unsigned char*)lds_raw;
    volatile LAS unsigned* MISC = (volatile LAS unsigned*)(lds + MISC_OFF);
    const int tid0 = threadIdx.x;
    const int G = gridDim.x;
#define PHASE_IDS int tid_ = threadIdx.x; asm volatile("" : "+v"(tid_)); const int tid = tid_, lane = tid & 63, wave = __builtin_amdgcn_readfirstlane(tid >> 6); \
    int bx_ = blockIdx.x; asm volatile("" : "+s"(bx_)); const int bx = bx_; const int vcu = (G % 8 == 0) ? (bx % 8) * (G / 8) + bx / 8 : bx; (void)lane; (void)wave; (void)vcu; (void)bx;
    unsigned char* ws0 = fresh_args()->ws;
    for (int u = tid0; u < (LDS_BYTES - RING_BYTES) / 4; u += NTHR) ((LAS unsigned*)(lds + RING_BYTES))[u] = 0u;
    __syncthreads();
    XcdBarrier bar; bar.bar = (unsigned*)(ws0 + WS_CTL) + CW_BAR; bar.x = 0; bar.st = nullptr;
    if (!MK_PER_PHASE) bar = xcd_barrier_post((unsigned*)(ws0 + WS_CTL) + CW_BAR, MISC + 8);
#if MK_PER_PHASE
    const int lo = args.ph_lo, hi = args.ph_hi;
#define IN(k) (lo <= (k) && (k) < hi)
#else
#define IN(k) true
#endif
#define SEAM(k) do { if (IN(k) && IN((k) + 1)) { XcdBarrier b2 = bar; asm volatile("" : "+s"(b2.bar)); xcd_barrier(b2); } } while (0)

#ifndef DBL_SUB
#define DBL_SUB 0
#endif
#ifndef DBL_PHASE
#define DBL_PHASE (-1)
#endif
#ifndef REPN
#define REPN 2
#endif
#define REP(k) for (int rep_ = 0; rep_ < ((k) == DBL_PHASE ? REPN : 1); ++rep_)
#define REPBAR if (rep_ > 0) { XcdBarrier b2 = bar; asm volatile("" : "+s"(b2.bar)); xcd_barrier(b2); }
    REP(0) if (IN(0)) { REPBAR KArgsP ap = fresh_args(); PHASE_IDS phase_prologue(ap, lds, tid, lane, wave, vcu, G); }
    SEAM(0);
#define LCONST 0
    {
        constexpr int l = LCONST; constexpr int pb = 1 + l * PH_PER_LAYER;
        REP(pb + 0) if (IN(pb + 0)) { REPBAR KArgsP ap = fresh_args(); PHASE_IDS unsigned char* ws = ap->ws; (void)ws;
            if (l == 0) { mod_finalize(ws, tid, G); phase_rownorm<0, false>(ap, lds, tid, lane, wave, G, ap->in[I_X], ap->out, ap->in[I_NORM_MIX], true, 0, 0, 0); }
            else {
#if EN_MOE
                phase_rownorm<0, true>(ap, lds, tid, lane, wave, G, ap->out, ap->out, ap->in[I_NORM_MIX] + l * DM, false, l, 0, l - 1);
#else
                phase_rownorm<0, false>(ap, lds, tid, lane, wave, G, ap->out, ap->out, ap->in[I_NORM_MIX] + l * DM, false, l, 0, l - 1);
#endif
            }
        }
        SEAM(pb + 0);
        REP(pb + 1) if (IN(pb + 1)) { REPBAR KArgsP ap = fresh_args(); PHASE_IDS unsigned char* ws = ap->ws; (void)ws;
            pg8::Gemm g{(const pg8::bf16_t*)(ws + WS_HN), (const pg8::bf16_t*)(ws + WS_WIN) + (size_t)l * NPROJ_PAD * DM, NTOK, NPROJ_PAD, DM};
            pg8::StaticOrder S; S.init(NTOK, NPROJ_PAD, G, bx);
            pg8::EpiProj E{(pg8::bf16_t*)(ws + WS_PROJ), (float*)(ws + WS_GATES)};
            pg8::gemm_phase<pg8::EpiProj, pg8::StaticOrder, true, true>(lds, g, S, E);
        }
        SEAM(pb + 1);
        REP(pb + 2) if (IN(pb + 2)) { REPBAR KArgsP ap = fresh_args(); PHASE_IDS unsigned char* ws = ap->ws; (void)ws;
#if EN_MLSTM
            for (int q_ = 0; q_ < 1 + (REPN - 1) * ((DBL_SUB == 1) && l == 0); ++q_) { phase_m1(ap, lds, tid, lane, wave, vcu, G, l); __syncthreads(); }
            __syncthreads();
#endif
#if EN_S5
            phase_s1(ap, lds, tid, lane, wave, vcu, G, l); __syncthreads();
#if DBL_SUB == 2
            if (l == 0) { phase_s1(ap, lds, tid, lane, wave, vcu, G, l); __syncthreads(); phase_s1(ap, lds, tid, lane, wave, vcu, G, l); __syncthreads(); phase_s1(ap, lds, tid, lane, wave, vcu, G, l); __syncthreads(); phase_s1(ap, lds, tid, lane, wave, vcu, G, l); __syncthreads(); }
#endif
            __syncthreads();
#endif
#if EN_RWKV
            for (int q_ = 0; q_ < 1 + (REPN - 1) * ((DBL_SUB == 3) && l == 0); ++q_) { phase_r1(ap, lds, tid, lane, wave, vcu, G, l); __syncthreads(); }
#endif
        }
        SEAM(pb + 2);
        REP(pb + 3) if (IN(pb + 3)) { REPBAR KArgsP ap = fresh_args(); PHASE_IDS unsigned char* ws = ap->ws; (void)ws;
            if (vcu < R2_WGS) {
#if EN_RWKV
                for (int q_ = 0; q_ < 1 + (REPN - 1) * ((DBL_SUB == 4) && l == 0); ++q_) { phase_r2(ap, lds, tid, lane, wave, vcu, l); __syncthreads(); }
#endif
            } else {
                const int wg = vcu - R2_WGS, nwg = G - R2_WGS;
#if EN_MLSTM
                phase_m2(ws, tid, wg, nwg);
#endif
#if EN_S5
                phase_s2(ap, tid, wg, nwg, l);
#endif
#if EN_MOE
                if (l == 1) moe_convert(ap->in[I_MW1], ap->in[I_MW3], ap->in[I_MW2], 1, (bf16*)(ws + WS_W13), (bf16*)(ws + WS_W2), wg * NWAVES + wave, nwg * NWAVES, (LAS float*)(lds + wave * 16640), lane);
#endif
            }
        }
        SEAM(pb + 3);
        REP(pb + 4) if (IN(pb + 4)) { REPBAR KArgsP ap = fresh_args(); PHASE_IDS unsigned char* ws = ap->ws; (void)ws;
#if EN_MLSTM
            for (int q_ = 0; q_ < 1 + (REPN - 1) * ((DBL_SUB == 5) && l == 0); ++q_) { phase_m3(ap, lds, tid, lane, wave, vcu, G, l); __syncthreads(); }
            __syncthreads();
#else
            for (size_t i = (size_t)vcu * NTHR + tid; i < (size_t)NTOK * 384; i += (size_t)G * NTHR) ((bf16*)(ws + WS_YC))[(i / 384) * DM + (i % 384)] = 0;
#endif
#if EN_S5
            for (int q_ = 0; q_ < 1 + (REPN - 1) * ((DBL_SUB == 6) && l == 0); ++q_) { phase_s3(ap, lds, tid, lane, wave, vcu, G, l); __syncthreads(); }
#else
            for (size_t i = (size_t)vcu * NTHR + tid; i < (size_t)NTOK * 256; i += (size_t)G * NTHR) ((bf16*)(ws + WS_YC))[(i / 256) * DM + 768 + (i % 256)] = 0;
#endif
#if EN_RWKV
            phase_r3(ap, lane, vcu * NWAVES + wave, G * NWAVES, l);
#else
            for (size_t i = (size_t)vcu * NTHR + tid; i < (size_t)NTOK * 384; i += (size_t)G * NTHR) ((bf16*)(ws + WS_YC))[(i / 384) * DM + 384 + (i % 384)] = 0;
#endif
        }
        SEAM(pb + 4);
        REP(pb + 5) if (IN(pb + 5)) { REPBAR KArgsP ap = fresh_args(); PHASE_IDS unsigned char* ws = ap->ws; (void)ws;
            pg8::Gemm g{(const pg8::bf16_t*)(ws + WS_YC), (const pg8::bf16_t*)(ws + WS_WOUT) + (size_t)l * DM * DM, NTOK, DM, DM};
            pg8::StaticOrder S; S.init(NTOK, DM, G, bx);
            pg8::EpiResid E{l == 0 ? ap->in[I_X] : (const float*)ap->out, ap->out, (const float*)(ws + WS_MODF) + (size_t)l * 4 * 6144, 2048};
            pg8::gemm_phase<pg8::EpiResid, pg8::StaticOrder, true, true>(lds, g, S, E);
        }
        SEAM(pb + 5);
#if EN_MOE
        REP(pb + 6) if (IN(pb + 6)) { REPBAR KArgsP ap = fresh_args(); PHASE_IDS phase_router(ap, lds, tid, lane, wave, G, l); }
        SEAM(pb + 6);
        REP(pb + 7) if (IN(pb + 7)) { REPBAR KArgsP ap = fresh_args(); PHASE_IDS phase_gather(ap, lds, tid, lane, wave, vcu, G, l); }
        SEAM(pb + 7);
        REP(pb + 8) if (IN(pb + 8)) { REPBAR KArgsP ap = fresh_args(); PHASE_IDS unsigned char* ws = ap->ws; (void)ws;
            LAS int* ptab = (LAS int*)(lds + PTAB_OFF); LAS int* pst = ptab + 512; LAS int* cnt = pst + 32;
            build_ptab((const unsigned*)(ws + WS_CTL) + CW_CNT + l * 32, ptab, pst, cnt, tid);
            pg8::Gemm g{(const pg8::bf16_t*)(ws + WS_XG), (const pg8::bf16_t*)(ws + WS_W13), 0, 0, DM};
            pg8::MoeOrder S{ptab, G, vcu};
            pg8::EpiSwiglu E{(pg8::bf16_t*)(ws + WS_HMID)};
            pg8::gemm_phase<pg8::EpiSwiglu, pg8::MoeOrder, true, true>(lds, g, S, E);
        }
        SEAM(pb + 8);
        REP(pb + 9) if (IN(pb + 9)) { REPBAR KArgsP ap = fresh_args(); PHASE_IDS unsigned char* ws = ap->ws; (void)ws;
            LAS int* ptab = (LAS int*)(lds + PTAB_OFF); LAS int* pst = ptab + 512; LAS int* cnt = pst + 32;
            build_ptab((const unsigned*)(ws + WS_CTL) + CW_CNT + l * 32, ptab, pst, cnt, tid);
            pg8::Gemm g{(const pg8::bf16_t*)(ws + WS_HMID), (const pg8::bf16_t*)(ws + WS_W2), 0, 0, DEXP};
            pg8::MoeOrder S{ptab, G, vcu};
            pg8::EpiMoeOut E{(pg8::bf16_t*)(ws + WS_YMOE), (const int*)(ws + WS_ROWMAP)};
            pg8::gemm_phase<pg8::EpiMoeOut, pg8::MoeOrder, true, true>(lds, g, S, E);
        }
        SEAM(pb + 9);
#else
        SEAM(pb + 6); SEAM(pb + 7); SEAM(pb + 8); SEAM(pb + 9);
#endif
    }
#undef LCONST
#if N_LAYERS > 1
#define LCONST 1
    {
        constexpr int l = LCONST; constexpr int pb = 1 + l * PH_PER_LAYER;
        REP(pb + 0) if (IN(pb + 0)) { REPBAR KArgsP ap = fresh_args(); PHASE_IDS unsigned char* ws = ap->ws; (void)ws;
            if (l == 0) { mod_finalize(ws, tid, G); phase_rownorm<0, false>(ap, lds, tid, lane, wave, G, ap->in[I_X], ap->out, ap->in[I_NORM_MIX], true, 0, 0, 0); }
            else {
#if EN_MOE
                phase_rownorm<0, true>(ap, lds, tid, lane, wave, G, ap->out, ap->out, ap->in[I_NORM_MIX] + l * DM, false, l, 0, l - 1);
#else
                phase_rownorm<0, false>(ap, lds, tid, lane, wave, G, ap->out, ap->out, ap->in[I_NORM_MIX] + l * DM, false, l, 0, l - 1);
#endif
            }
        }
        SEAM(pb + 0);
        REP(pb + 1) if (IN(pb + 1)) { REPBAR KArgsP ap = fresh_args(); PHASE_IDS unsigned char* ws = ap->ws; (void)ws;
            pg8::Gemm g{(const pg8::bf16_t*)(ws + WS_HN), (const pg8::bf16_t*)(ws + WS_WIN) + (size_t)l * NPROJ_PAD * DM, NTOK, NPROJ_PAD, DM};
            pg8::StaticOrder S; S.init(NTOK, NPROJ_PAD, G, bx);
            pg8::EpiProj E{(pg8::bf16_t*)(ws + WS_PROJ), (float*)(ws + WS_GATES)};
            pg8::gemm_phase<pg8::EpiProj, pg8::StaticOrder, true, true>(lds, g, S, E);
        }
        SEAM(pb + 1);
        REP(pb + 2) if (IN(pb + 2)) { REPBAR KArgsP ap = fresh_args(); PHASE_IDS unsigned char* ws = ap->ws; (void)ws;
#if EN_MLSTM
            for (int q_ = 0; q_ < 1 + (REPN - 1) * ((DBL_SUB == 1) && l == 0); ++q_) { phase_m1(ap, lds, tid, lane, wave, vcu, G, l); __syncthreads(); }
            __syncthreads();
#endif
#if EN_S5
            phase_s1(ap, lds, tid, lane, wave, vcu, G, l); __syncthreads();
#if DBL_SUB == 2
            if (l == 0) { phase_s1(ap, lds, tid, lane, wave, vcu, G, l); __syncthreads(); phase_s1(ap, lds, tid, lane, wave, vcu, G, l); __syncthreads(); phase_s1(ap, lds, tid, lane, wave, vcu, G, l); __syncthreads(); phase_s1(ap, lds, tid, lane, wave, vcu, G, l); __syncthreads(); }
#endif
            __syncthreads();
#endif
#if EN_RWKV
            for (int q_ = 0; q_ < 1 + (REPN - 1) * ((DBL_SUB == 3) && l == 0); ++q_) { phase_r1(ap, lds, tid, lane, wave, vcu, G, l); __syncthreads(); }
#endif
        }
        SEAM(pb + 2);
        REP(pb + 3) if (IN(pb + 3)) { REPBAR KArgsP ap = fresh_args(); PHASE_IDS unsigned char* ws = ap->ws; (void)ws;
            if (vcu < R2_WGS) {
#if EN_RWKV
                for (int q_ = 0; q_ < 1 + (REPN - 1) * ((DBL_SUB == 4) && l == 0); ++q_) { phase_r2(ap, lds, tid, lane, wave, vcu, l); __syncthreads(); }
#endif
            } else {
                const int wg = vcu - R2_WGS, nwg = G - R2_WGS;
#if EN_MLSTM
                phase_m2(ws, tid, wg, nwg);
#endif
#if EN_S5
                phase_s2(ap, tid, wg, nwg, l);
#endif
#if EN_MOE
                if (l == 1) moe_convert(ap->in[I_MW1], ap->in[I_MW3], ap->in[I_MW2], 1, (bf16*)(ws + WS_W13), (bf16*)(ws + WS_W2), wg * NWAVES + wave, nwg * NWAVES, (LAS float*)(lds + wave * 16640), lane);
#endif
            }
        }
        SEAM(pb + 3);
        REP(pb + 4) if (IN(pb + 4)) { REPBAR KArgsP ap = fresh_args(); PHASE_IDS unsigned char* ws = ap->ws; (void)ws;
#if EN_MLSTM
            for (int q_ = 0; q_ < 1 + (REPN - 1) * ((DBL_SUB == 5) && l == 0); ++q_) { phase_m3(ap, lds, tid, lane, wave, vcu, G, l); __syncthreads(); }
            __syncthreads();
#else
            for (size_t i = (size_t)vcu * NTHR + tid; i < (size_t)NTOK * 384; i += (size_t)G * NTHR) ((bf16*)(ws + WS_YC))[(i / 384) * DM + (i % 384)] = 0;
#endif
#if EN_S5
            for (int q_ = 0; q_ < 1 + (REPN - 1) * ((DBL_SUB == 6) && l == 0); ++q_) { phase_s3(ap, lds, tid, lane, wave, vcu, G, l); __syncthreads(); }
#else
            for (size_t i = (size_t)vcu * NTHR + tid; i < (size_t)NTOK * 256; i += (size_t)G * NTHR) ((bf16*)(ws + WS_YC))[(i / 256) * DM + 768 + (i % 256)] = 0;
#endif
#if EN_RWKV
            phase_r3(ap, lane, vcu * NWAVES + wave, G * NWAVES, l);
#else
            for (size_t i = (size_t)vcu * NTHR + tid; i < (size_t)NTOK * 384; i += (size_t)G * NTHR) ((bf16*)(ws + WS_YC))[(i / 384) * DM + 384 + (i % 384)] = 0;
#endif
        }
        SEAM(pb + 4);
        REP(pb + 5) if (IN(pb + 5)) { REPBAR KArgsP ap = fresh_args(); PHASE_IDS unsigned char* ws = ap->ws; (void)ws;
            pg8::Gemm g{(const pg8::bf16_t*)(ws + WS_YC), (const pg8::bf16_t*)(ws + WS_WOUT) + (size_t)l * DM * DM, NTOK, DM, DM};
            pg8::StaticOrder S; S.init(NTOK, DM, G, bx);
            pg8::EpiResid E{l == 0 ? ap->in[I_X] : (const float*)ap->out, ap->out, (const float*)(ws + WS_MODF) + (size_t)l * 4 * 6144, 2048};
            pg8::gemm_phase<pg8::EpiResid, pg8::StaticOrder, true, true>(lds, g, S, E);
        }
        SEAM(pb + 5);
#if EN_MOE
        REP(pb + 6) if (IN(pb + 6)) { REPBAR KArgsP ap = fresh_args(); PHASE_IDS phase_router(ap, lds, tid, lane, wave, G, l); }
        SEAM(pb + 6);
        REP(pb + 7) if (IN(pb + 7)) { REPBAR KArgsP ap = fresh_args(); PHASE_IDS phase_gather(ap, lds, tid, lane, wave, vcu, G, l); }
        SEAM(pb + 7);
        REP(pb + 8) if (IN(pb + 8)) { REPBAR KArgsP ap = fresh_args(); PHASE_IDS unsigned char* ws = ap->ws; (void)ws;
            LAS int* ptab = (LAS int*)(lds + PTAB_OFF); LAS int* pst = ptab + 512; LAS int* cnt = pst + 32;
            build_ptab((const unsigned*)(ws + WS_CTL) + CW_CNT + l * 32, ptab, pst, cnt, tid);
            pg8::Gemm g{(const pg8::bf16_t*)(ws + WS_XG), (const pg8::bf16_t*)(ws + WS_W13), 0, 0, DM};
            pg8::MoeOrder S{ptab, G, vcu};
            pg8::EpiSwiglu E{(pg8::bf16_t*)(ws + WS_HMID)};
            pg8::gemm_phase<pg8::EpiSwiglu, pg8::MoeOrder, true, true>(lds, g, S, E);
        }
        SEAM(pb + 8);
        REP(pb + 9) if (IN(pb + 9)) { REPBAR KArgsP ap = fresh_args(); PHASE_IDS unsigned char* ws = ap->ws; (void)ws;
            LAS int* ptab = (LAS int*)(lds + PTAB_OFF); LAS int* pst = ptab + 512; LAS int* cnt = pst + 32;
            build_ptab((const unsigned*)(ws + WS_CTL) + CW_CNT + l * 32, ptab, pst, cnt, tid);
            pg8::Gemm g{(const pg8::bf16_t*)(ws + WS_HMID), (const pg8::bf16_t*)(ws + WS_W2), 0, 0, DEXP};
            pg8::MoeOrder S{ptab, G, vcu};
            pg8::EpiMoeOut E{(pg8::bf16_t*)(ws + WS_YMOE), (const int*)(ws + WS_ROWMAP)};
            pg8::gemm_phase<pg8::EpiMoeOut, pg8::MoeOrder, true, true>(lds, g, S, E);
        }
        SEAM(pb + 9);
#else
        SEAM(pb + 6); SEAM(pb + 7); SEAM(pb + 8); SEAM(pb + 9);
#endif
    }
#undef LCONST
#endif
    if (IN(PH_FINAL)) { KArgsP ap = fresh_args(); PHASE_IDS
#if EN_MOE
        if (N_LAYERS > 0) phase_rownorm<1, true>(ap, lds, tid, lane, wave, G, ap->out, ap->out, ap->in[I_NORM_FINAL], false, 0, 0, N_LAYERS - 1);
        else phase_rownorm<1, false>(ap, lds, tid, lane, wave, G, ap->in[I_X], ap->out, ap->in[I_NORM_FINAL], false, 0, 0, 0);
#else
        phase_rownorm<1, false>(ap, lds, tid, lane, wave, G, N_LAYERS > 0 ? (const float*)ap->out : ap->in[I_X], ap->out, ap->in[I_NORM_FINAL], false, 0, 0, 0);
#endif
    }
#undef IN
#undef SEAM
}

extern "C" void kernel_launch(void* const* d_in, const int* in_sizes, int n_in, void* d_out, int out_size, void* d_ws, size_t ws_size, hipStream_t stream) {
    static int grid = 0;
    if (grid == 0) {
        if (n_in != 47 || out_size != NTOK * DM || ws_size < WS_END) { fprintf(stderr, "kernel_launch: unexpected problem (n_in %d, out %d, ws %zu < %zu)\n", n_in, out_size, ws_size, (size_t)WS_END); grid = -1; return; }
        int dev = 0, cus = 0, per_cu = 0;
        if (hipGetDevice(&dev) != hipSuccess || hipDeviceGetAttribute(&cus, hipDeviceAttributeMultiprocessorCount, dev) != hipSuccess) { grid = -1; return; }
        if (hipFuncSetAttribute((const void*)fwd, hipFuncAttributeMaxDynamicSharedMemorySize, LDS_BYTES) != hipSuccess) { fprintf(stderr, "kernel_launch: hipFuncSetAttribute failed\n"); grid = -1; return; }
        if (hipOccupancyMaxActiveBlocksPerMultiprocessor(&per_cu, (const void*)fwd, NTHR, LDS_BYTES) != hipSuccess || per_cu < 1) fprintf(stderr, "kernel_launch: occupancy query says %d\n", per_cu);
        (void)hipGetLastError();
        grid = cus;
        if (grid != 256) fprintf(stderr, "kernel_launch: %d CUs (built for 256)\n", grid);
    }
    if (grid < 0) return;
    (void)hipMemsetAsync((char*)d_ws + WS_CTL, 0, CTL_ZERO_BYTES, stream);
    Args a{};
    for (int i = 0; i < 47; ++i) a.in[i] = (const float*)d_in[i];
    a.out = (float*)d_out; a.ws = (unsigned char*)d_ws;
#if MK_PER_PHASE
    for (int p = 0; p < N_PHASES; ++p) { a.ph_lo = p; a.ph_hi = p + 1; hipLaunchKernelGGL(fwd, dim3(grid), dim3(NTHR), LDS_BYTES, stream, a); }
#else
    a.ph_lo = 0; a.ph_hi = N_PHASES; hipLaunchKernelGGL(fwd, dim3(grid), dim3(NTHR), LDS_BYTES, stream, a);
#endif
}
#ifdef DIAG_KERNELS
#define DK(name, ...) __global__ void __launch_bounds__(NTHR, 2) name(Args args) { extern __shared__ __attribute__((aligned(16))) unsigned char lds_raw[]; LAS unsigned char* lds = (LAS unsigned char*)lds_raw; \
    const int tid = threadIdx.x, lane = tid & 63, wave = __builtin_amdgcn_readfirstlane(tid >> 6); const int G = gridDim.x; const int bx = blockIdx.x; const int vcu = bx; KArgsP ap = fresh_args(); int l = ap->ph_lo; (void)lane; (void)wave; (void)vcu; (void)G; (void)l; __VA_ARGS__ }
DK(k_prologue, phase_prologue(ap, lds, tid, lane, wave, vcu, G);)
DK(k_norm0, phase_rownorm<0, false>(ap, lds, tid, lane, wave, G, ap->in[I_X], ap->out, ap->in[I_NORM_MIX], true, 0, 0, 0);)
DK(k_norm1, phase_rownorm<0, true>(ap, lds, tid, lane, wave, G, ap->out, ap->out, ap->in[I_NORM_MIX], false, l, 0, 0);)
DK(k_normf, phase_rownorm<1, true>(ap, lds, tid, lane, wave, G, ap->out, ap->out, ap->in[I_NORM_MIX], false, l, 0, 0);)
DK(k_m1, phase_m1(ap, lds, tid, lane, wave, vcu, G, l);)
DK(k_m2, phase_m2(ap->ws, tid, vcu, G);)
DK(k_m3, phase_m3(ap, lds, tid, lane, wave, vcu, G, l);)
DK(k_s1, phase_s1(ap, lds, tid, lane, wave, vcu, G, l);)
DK(k_s2, phase_s2(ap, tid, vcu, G, l);)
DK(k_s3, phase_s3(ap, lds, tid, lane, wave, vcu, G, l);)
DK(k_r1, phase_r1(ap, lds, tid, lane, wave, vcu, G, l);)
DK(k_r2, phase_r2(ap, lds, tid, lane, wave, vcu, l);)
DK(k_r3, phase_r3(ap, lane, vcu * NWAVES + wave, G * NWAVES, l);)
DK(k_router, phase_router(ap, lds, tid, lane, wave, G, l);)
DK(k_gather, phase_gather(ap, lds, tid, lane, wave, vcu, G, l);)
DK(k_moecv, moe_convert(ap->in[I_MW1], ap->in[I_MW3], ap->in[I_MW2], 1, (bf16*)(ap->ws + WS_W13), (bf16*)(ap->ws + WS_W2), vcu * NWAVES + wave, G * NWAVES, (LAS float*)(lds + wave * 16640), lane);)
#endif
```

```cpp
#include <hip/hip_runtime.h>
#include <cstdio>
#include <cstdint>
#define MK_PER_PHASE 0

#ifndef MK_PER_PHASE
#define MK_PER_PHASE 0
#endif
#ifndef EN_MLSTM
#define EN_MLSTM 1
#endif
#ifndef EN_S5
#define EN_S5 1
#endif
#ifndef EN_RWKV
#define EN_RWKV 1
#endif
#ifndef EN_MOE
#define EN_MOE 1
#endif
#ifndef N_LAYERS
#define N_LAYERS 2
#endif
constexpr int NWAVES = 8, NTHR = 512;
constexpr int DM = 1024, NB = 4, SEQ = 8192, NTOK = NB * SEQ;
constexpr int DA = 384, DBR = 384, DC = 256, NH = 6, HD = 64, NCH = SEQ / 64;
constexpr int IN_COLS = 2828, NPROJ = 2816, NPROJ_PAD = 3072;
constexpr int PC_QK = 0, PC_V = 384, PC_O = 768, PC_RW = 1152, PC_S5 = 2560;
constexpr int RWC_R = 0, RWC_K = 384, RWC_V = 768, RWC_WD = 1152, RWC_AD = 1216, RWC_GD = 1280, RW_COLS = 1408;
constexpr int NEXP = 32, DEXP = 512, MOE_ROWS_MAX = 73728;
constexpr int NUNIT_M = NB * NCH * NH;
constexpr int CL_STRIDE = 4160;
constexpr float NORM_EPS = 1e-6f, HEAD_NORM_EPS = 1e-5f, RWKV_GN_EPS = 64e-5f;

constexpr size_t MiB = 1u << 20;
constexpr size_t WS_CTL = 0, CTL_ZERO_BYTES = 1 * MiB;
constexpr size_t WS_MODP = 1 * MiB;
constexpr size_t WS_MODF = 2 * MiB + 512 * 1024;
constexpr size_t WS_RTW = 3 * MiB;
constexpr size_t WS_MLW = 3 * MiB + 512 * 1024;
constexpr size_t WS_S5CM = 2 * MiB + 768 * 1024;
constexpr size_t WS_GLUT = 3 * MiB + 768 * 1024;
constexpr size_t WS_WIN = 4 * MiB;
constexpr size_t WS_WOUT = 16 * MiB;
constexpr size_t WS_GATES = 20 * MiB;
constexpr size_t WS_W13 = 22 * MiB;
constexpr size_t WS_W2 = 86 * MiB;
constexpr size_t WS_HN = 118 * MiB;
constexpr size_t WS_CLOC = 118 * MiB;
constexpr size_t WS_MSC = 168 * MiB;
constexpr size_t WS_S5ST = 170 * MiB;
constexpr size_t WS_VF = 182 * MiB;
constexpr size_t WS_YC = 206 * MiB;
constexpr size_t WS_LIST = 206 * MiB;
constexpr size_t WS_ROWMAP = 214 * MiB;
constexpr size_t WS_TOKE = 215 * MiB;
constexpr size_t WS_TOKW = 215 * MiB + 512 * 1024;
constexpr size_t WS_PROJ = 270 * MiB;
constexpr size_t WS_RE = 446 * MiB, WS_RA = 470 * MiB, WS_RG = 494 * MiB, WS_RVG = 518 * MiB;
constexpr size_t WS_XG = 270 * MiB;
constexpr size_t WS_HMID = 414 * MiB;
constexpr size_t WS_YMOE = 270 * MiB;
constexpr size_t WS_R1W = 542 * MiB;
constexpr size_t WS_OPA = 22 * MiB;
constexpr size_t WS_OPB = 543 * MiB;
constexpr size_t WS_END = 591 * MiB;
constexpr int CW_TMO = 0, CW_BAR = 4096, CW_CNT = 8192;

constexpr int RING_BYTES = 131072, MISC_OFF = 135168, PTAB_OFF = MISC_OFF + 1024, LDS_BYTES = 147456;

#define GAS __attribute__((address_space(1)))
#define LAS __attribute__((address_space(3)))
typedef unsigned short bf16;
typedef unsigned v4u __attribute__((ext_vector_type(4)));
typedef unsigned v2u __attribute__((ext_vector_type(2)));
typedef float f32x4 __attribute__((ext_vector_type(4)));
typedef float f32x2 __attribute__((ext_vector_type(2)));
typedef GAS unsigned gu32;
#define RLX_AGENT __ATOMIC_RELAXED, __HIP_MEMORY_SCOPE_AGENT
#define LDS_WAIT() asm volatile("s_waitcnt lgkmcnt(0)" ::: "memory")
#define VM_WAIT() asm volatile("s_waitcnt vmcnt(0)" ::: "memory")
__device__ __forceinline__ unsigned f2bf(float f) { unsigned u = __builtin_bit_cast(unsigned, f); return (u + 0x7fffu + ((u >> 16) & 1u)) >> 16; }
__device__ __forceinline__ unsigned pk2(float lo, float hi) { return f2bf(lo) | (f2bf(hi) << 16); }
__device__ __forceinline__ float bf2f(unsigned v) { return __builtin_bit_cast(float, v << 16); }
__device__ __forceinline__ float bflo(unsigned w) { return __builtin_bit_cast(float, w << 16); }
__device__ __forceinline__ float bfhi(unsigned w) { return __builtin_bit_cast(float, w & 0xffff0000u); }
__device__ __forceinline__ float sigmoidf_(float x) { return 1.f / (1.f + __expf(-x)); }
__device__ __forceinline__ float wave_sum(float v) {
#pragma unroll
    for (int o = 1; o < 64; o <<= 1) v += __shfl_xor(v, o);
    return v;
}
__device__ __forceinline__ float wave_max(float v) {
#pragma unroll
    for (int o = 1; o < 64; o <<= 1) v = fmaxf(v, __shfl_xor(v, o));
    return v;
}
namespace pg8 {
#define PG8_LAS __attribute__((address_space(3)))
typedef unsigned short bf16_t;
typedef short bf16x8 __attribute__((ext_vector_type(8)));
typedef float f32x4 __attribute__((ext_vector_type(4)));
typedef unsigned u32x4 __attribute__((ext_vector_type(4)));
constexpr int BM = 256, BK = 64, HALF = 128, HTB = HALF * BK * 2  , STAGE_BYTES = 8 * HTB, NXCD = 8, WGM = 8;

__host__ __device__ __forceinline__ int lds_byte(int r, int c) { const int st = (r >> 4) * 2 + (c >> 5), rr = r & 15, cc = c & 31, ob = rr * 64 + cc * 2; return st * 1024 + (ob ^ (((ob >> 9) & 1) << 5)); }
__host__ __device__ __forceinline__ void stage_rc(int b, int& R, int& C) { const int st = b / 1024, sb = b % 1024, swz = sb ^ (((sb >> 9) & 1) << 5); R = (st >> 1) * 16 + swz / 64; C = (st & 1) * 32 + (swz % 64) / 2; }
__host__ __device__ __forceinline__ int perm32(int rho) { const int n = rho >> 4, i = rho & 15; return 8 * (i >> 2) + 4 * n + (i & 3); }

struct Unit { int pm, pn; };
struct Gemm { const bf16_t* A; const bf16_t* Bt; int M, N, K; };

struct StaticOrder {
    int nM, nN, nwg, G, c;
    __host__ __device__ void init(int M, int N, int G_, int c_) { nM = M / BM; nN = N / BM; nwg = nM * nN; G = G_; c = c_; }
    __host__ __device__ bool next(int i, Unit& u) const {
        const long L = (long)i * G + c; if (L >= nwg) return false;
        int wgid = (int)L; { const int q = nwg / NXCD, r = nwg % NXCD, xcd = wgid % NXCD, off = wgid / NXCD; wgid = (xcd < r ? xcd * (q + 1) : r * (q + 1) + (xcd - r) * q) + off; }
        const int nig = WGM * nN, gid = wgid / nig, fm = gid * WGM, gsz = (nM - fm) < WGM ? (nM - fm) : WGM;
        u.pm = fm + ((wgid % nig) % gsz); u.pn = (wgid % nig) / gsz; return true;
    }
    __device__ __forceinline__ void a_ready(const Unit&) const {}
    __device__ __forceinline__ void done(const Unit&) const {}
};

__device__ __forceinline__ unsigned cvt_pk_bf16(float lo, float hi) { unsigned r; asm volatile("v_cvt_pk_bf16_f32 %0, %1, %2" : "=v"(r) : "v"(lo), "v"(hi)); return r; }

struct EpiProj {
    static constexpr bool PERM = true, AFTER_DRAIN = false;
    bf16_t* O; float* G;
    __device__ __forceinline__ void operator()(const f32x4 (&acc)[2][2][4][2], const Unit& u, int wr, int wc, int fr, int fq) const {
        const int row0 = u.pm * BM + wr * 64 + fr;
        if (u.pn < 11) {
            const int col0 = u.pn * BM + wc * 32 + 8 * fq;
#pragma unroll
            for (int ai = 0; ai < 2; ++ai)
#pragma unroll
                for (int m = 0; m < 4; ++m) { bf16_t* rowp = O + (size_t)(row0 + ai * HALF + m * 16) * 2816 + col0;
#pragma unroll
                    for (int bj = 0; bj < 2; ++bj) { const f32x4 v0 = acc[ai][bj][m][0], v1 = acc[ai][bj][m][1];
                        u32x4 w; w.x = cvt_pk_bf16(v0[0], v0[1]); w.y = cvt_pk_bf16(v0[2], v0[3]); w.z = cvt_pk_bf16(v1[0], v1[1]); w.w = cvt_pk_bf16(v1[2], v1[3]);
                        *(u32x4*)(rowp + bj * HALF) = w; } }
        } else if (wc == 0 && fq < 2) {
#pragma unroll
            for (int ai = 0; ai < 2; ++ai)
#pragma unroll
                for (int m = 0; m < 4; ++m) { float* rowp = G + (size_t)(row0 + ai * HALF + m * 16) * 16 + 8 * fq;
                    *(f32x4*)(rowp) = acc[ai][0][m][0]; *(f32x4*)(rowp + 4) = acc[ai][0][m][1]; }
        }
    }
};
struct EpiResid {
    static constexpr bool PERM = true, AFTER_DRAIN = false;
    const float* xin; float* out; const float* gate;
    int goff;
    __device__ __forceinline__ void operator()(const f32x4 (&acc)[2][2][4][2], const Unit& u, int wr, int wc, int fr, int fq) const {
        const int row0 = u.pm * BM + wr * 64 + fr, col0 = u.pn * BM + wc * 32 + 8 * fq;
        const float* gp = gate + (size_t)(row0 >> 13) * 6144 + goff + col0;
        f32x4 g[2][2];
#pragma unroll
        for (int bj = 0; bj < 2; ++bj)
#pragma unroll
            for (int n = 0; n < 2; ++n) g[bj][n] = *(const f32x4*)(gp + bj * HALF + 4 * n) + 1.0f;
#pragma unroll
        for (int ai = 0; ai < 2; ++ai)
#pragma unroll
            for (int m = 0; m < 4; ++m) { const size_t off = (size_t)(row0 + ai * HALF + m * 16) * 1024 + col0;
#pragma unroll
                for (int bj = 0; bj < 2; ++bj)
#pragma unroll
                    for (int n = 0; n < 2; ++n) { const f32x4 xv = *(const f32x4*)(xin + off + bj * HALF + 4 * n);
                        *(f32x4*)(out + off + bj * HALF + 4 * n) = xv + g[bj][n] * acc[ai][bj][m][n]; } }
    }
};
struct EpiSwiglu {
    static constexpr bool PERM = true, AFTER_DRAIN = false;
    bf16_t* H;
    __device__ __forceinline__ void operator()(const f32x4 (&acc)[2][2][4][2], const Unit& u, int wr, int wc, int fr, int fq) const {
        const int row0 = u.pm * BM + wr * 64 + fr, hid0 = 128 * (u.pn & 3) + 16 * wc + 4 * fq;
#pragma unroll
        for (int ai = 0; ai < 2; ++ai)
#pragma unroll
            for (int m = 0; m < 4; ++m) { bf16_t* rowp = H + (size_t)(row0 + ai * HALF + m * 16) * 512 + hid0;
#pragma unroll
                for (int bj = 0; bj < 2; ++bj) { const f32x4 g = acc[ai][bj][m][0], uu = acc[ai][bj][m][1]; float h[4];
#pragma unroll
                    for (int i = 0; i < 4; ++i) h[i] = g[i] / (1.f + __expf(-g[i])) * uu[i];
                    unsigned w0 = cvt_pk_bf16(h[0], h[1]), w1 = cvt_pk_bf16(h[2], h[3]);
                    *(unsigned long long*)(rowp + 64 * bj) = (unsigned long long)w0 | ((unsigned long long)w1 << 32); } }
    }
};
struct EpiMoeOut {
    static constexpr bool PERM = true, AFTER_DRAIN = false;
    bf16_t* Y; const int* rowmap;
    __device__ __forceinline__ void operator()(const f32x4 (&acc)[2][2][4][2], const Unit& u, int wr, int wc, int fr, int fq) const {
        const int row0 = u.pm * BM + wr * 64 + fr, col0 = (u.pn & 3) * BM + wc * 32 + 8 * fq;
#pragma unroll
        for (int ai = 0; ai < 2; ++ai)
#pragma unroll
            for (int m = 0; m < 4; ++m) { const int dst = rowmap[row0 + ai * HALF + m * 16];
                if (dst >= 0) { bf16_t* rowp = Y + (size_t)dst * 1024 + col0;
#pragma unroll
                    for (int bj = 0; bj < 2; ++bj) { const f32x4 v0 = acc[ai][bj][m][0], v1 = acc[ai][bj][m][1];
                        u32x4 w; w.x = cvt_pk_bf16(v0[0], v0[1]); w.y = cvt_pk_bf16(v0[2], v0[3]); w.z = cvt_pk_bf16(v1[0], v1[1]); w.w = cvt_pk_bf16(v1[2], v1[3]);
                        *(u32x4*)(rowp + bj * HALF) = w; } } }
    }
};
struct MoeOrder {
    PG8_LAS const int* ptab; int G, c;
    __device__ __forceinline__ bool next(int i, Unit& u) const {
        const int L = i * G + c, np = __builtin_amdgcn_readfirstlane(ptab[0]);
        if (L >= np * 4) return false;
        const int p = L >> 2; u.pm = p; u.pn = __builtin_amdgcn_readfirstlane(ptab[1 + p]) * 4 + (L & 3); return true;
    }
    __device__ __forceinline__ void a_ready(const Unit&) const {}
    __device__ __forceinline__ void done(const Unit&) const {}
};
template <class Epi, class Sched, bool ALIGN_EPI = false, bool SP2 = false>
__device__ __forceinline__ void gemm_phase(PG8_LAS unsigned char* lds, const Gemm g, const Sched& S, const Epi& E) {
    const int tid = threadIdx.x, wid = __builtin_amdgcn_readfirstlane(tid >> 6), lane = tid & 63, wr = wid >> 2, wc = wid & 3, fr = lane & 15, fq = lane >> 4;
    const int K = g.K, nt = K / BK;
    unsigned voffA[2], voffB[2];
#pragma unroll
    for (int i = 0; i < 2; ++i) { int R, C; stage_rc(tid * 16 + i * 8192, R, C); const int Rb = Epi::PERM ? ((R & ~31) + perm32(R & 31)) : R;
        voffA[i] = (unsigned)(R * K + C) * 2u; voffB[i] = (unsigned)(Rb * K + C) * 2u; }
    const size_t kstep = (size_t)(BK * 2);
    const size_t hstep = (size_t)HALF * K * 2;
    const size_t tstep = 2 * hstep;
    const unsigned ldsw = (unsigned)wid * 1024u;
    const int aoff = lds_byte(wr * 64 + fr, fq * 8), boff = lds_byte(wc * 32 + fr, fq * 8);
#define PG8_SA(b, h) (((b) * 2 + (h)) * HTB)
#define PG8_SB(b, h) ((4 + (b) * 2 + (h)) * HTB)
#define PG8_STAGE(bufoff, gbase, voff) do { _Pragma("unroll") for (int _i = 0; _i < 2; ++_i) \
        __builtin_amdgcn_global_load_lds((const unsigned*)((const char*)(gbase) + (voff)[_i]), (PG8_LAS unsigned*)(lds + (bufoff) + ldsw + _i * 8192), 16, 0, 0); } while (0)
#define PG8_LDA(dst, b, h) do { _Pragma("unroll") for (int m = 0; m < 4; ++m) _Pragma("unroll") for (int k = 0; k < 2; ++k) dst[m][k] = *(const PG8_LAS bf16x8*)(lds + PG8_SA(b, h) + aoff + m * 2048 + k * 1024); } while (0)
#define PG8_LDB(dst, b, h) do { _Pragma("unroll") for (int n = 0; n < 2; ++n) _Pragma("unroll") for (int k = 0; k < 2; ++k) dst[n][k] = *(const PG8_LAS bf16x8*)(lds + PG8_SB(b, h) + boff + n * 2048 + k * 1024); } while (0)
#define PG8_MMA(ai, bj, At, Bt) do { __builtin_amdgcn_s_setprio(1); _Pragma("unroll") for (int m = 0; m < 4; ++m) _Pragma("unroll") for (int n = 0; n < 2; ++n) _Pragma("unroll") for (int k = 0; k < 2; ++k) \
        acc[ai][bj][m][n] = __builtin_amdgcn_mfma_f32_16x16x32_bf16(Bt[n][k], At[m][k], acc[ai][bj][m][n], 0, 0, 0); __builtin_amdgcn_s_setprio(0); } while (0)
#define PG8_WAIT_V(n) asm volatile("s_waitcnt vmcnt(" #n ")" ::: "memory")
#define PG8_WAIT_L(n) asm volatile("s_waitcnt lgkmcnt(" #n ")" ::: "memory")
#define PG8_BAR __builtin_amdgcn_s_barrier()
#define PG8_SCHED __builtin_amdgcn_sched_barrier(0)
    Unit cur, nxt; int ui = 0;
    if (!S.next(0, cur)) return;
    f32x4 acc[2][2][4][2];
#pragma unroll
    for (int a = 0; a < 2; ++a)
#pragma unroll
        for (int b = 0; b < 2; ++b)
#pragma unroll
            for (int m = 0; m < 4; ++m)
#pragma unroll
                for (int n = 0; n < 2; ++n) acc[a][b][m][n] = (f32x4){0.f, 0.f, 0.f, 0.f};
    bf16x8 At[4][2], B0[2][2], B1[2][2];
    const char* cA = (const char*)g.A + (size_t)cur.pm * tstep; const char* cB = (const char*)g.Bt + (size_t)cur.pn * tstep;
    S.a_ready(cur);
    if constexpr (SP2) {
        PG8_STAGE(PG8_SB(0, 0), cB, voffB); PG8_STAGE(PG8_SB(0, 1), cB + hstep, voffB); PG8_STAGE(PG8_SA(0, 0), cA, voffA); PG8_STAGE(PG8_SA(0, 1), cA + hstep, voffA);
        if (wr == 1) PG8_BAR;
        PG8_WAIT_V(2); PG8_BAR;
        PG8_STAGE(PG8_SB(1, 0), cB + kstep, voffB); PG8_STAGE(PG8_SA(1, 0), cA + kstep, voffA); PG8_STAGE(PG8_SB(1, 1), cB + hstep + kstep, voffB);
        PG8_WAIT_V(6); PG8_BAR;
    } else {
        PG8_STAGE(PG8_SB(0, 0), cB, voffB); PG8_STAGE(PG8_SA(0, 0), cA, voffA); PG8_STAGE(PG8_SB(0, 1), cB + hstep, voffB); PG8_STAGE(PG8_SA(0, 1), cA + hstep, voffA);
        if (wr == 1) PG8_BAR;
        PG8_WAIT_V(4); PG8_BAR;
        PG8_STAGE(PG8_SB(1, 0), cB + kstep, voffB); PG8_STAGE(PG8_SA(1, 0), cA + kstep, voffA); PG8_STAGE(PG8_SB(1, 1), cB + hstep + kstep, voffB);
        PG8_WAIT_V(6); PG8_BAR;
    }
    for (;;) {
        const bool has_next = S.next(ui + 1, nxt);
        const char* nA = has_next ? (const char*)g.A + (size_t)nxt.pm * tstep : cA; const char* nB = has_next ? (const char*)g.Bt + (size_t)nxt.pn * tstep : cB;
        for (int t = 0; t < nt; t += 2) {
            const bool last = (t == nt - 2);
            const char* a1 = cA + (size_t)(t + 1) * kstep;
            const char* a2 = last ? nA : cA + (size_t)(t + 2) * kstep; const char* b2 = last ? nB : cB + (size_t)(t + 2) * kstep;
            const char* a3 = a2 + kstep; const char* b3 = b2 + kstep;
            if (last && has_next) S.a_ready(nxt);
            if constexpr (SP2) {
            PG8_LDB(B0, 0, 0); PG8_LDB(B1, 0, 1); PG8_SCHED; PG8_LDA(At, 0, 0); PG8_STAGE(PG8_SA(1, 1), a1 + hstep, voffA);
            PG8_WAIT_V(8); PG8_WAIT_L(0); PG8_BAR; PG8_MMA(0, 0, At, B0); PG8_MMA(0, 1, At, B1); PG8_BAR; PG8_SCHED;
            PG8_LDA(At, 0, 1); PG8_STAGE(PG8_SB(0, 0), b2, voffB); PG8_STAGE(PG8_SB(0, 1), b2 + hstep, voffB); PG8_STAGE(PG8_SA(0, 0), a2, voffA);
            PG8_WAIT_V(8); PG8_WAIT_L(0); PG8_BAR; PG8_MMA(1, 0, At, B0); PG8_MMA(1, 1, At, B1); PG8_BAR; PG8_SCHED;
            PG8_LDB(B0, 1, 0); PG8_LDB(B1, 1, 1); PG8_SCHED; PG8_LDA(At, 1, 0); PG8_STAGE(PG8_SA(0, 1), a2 + hstep, voffA);
            PG8_WAIT_V(8); PG8_WAIT_L(0); PG8_BAR; PG8_MMA(0, 0, At, B0); PG8_MMA(0, 1, At, B1); PG8_BAR; PG8_SCHED;
            PG8_LDA(At, 1, 1); PG8_STAGE(PG8_SB(1, 0), b3, voffB); PG8_STAGE(PG8_SB(1, 1), b3 + hstep, voffB); PG8_STAGE(PG8_SA(1, 0), a3, voffA);
            PG8_WAIT_V(8); PG8_WAIT_L(0); PG8_BAR; PG8_MMA(1, 0, At, B0); PG8_MMA(1, 1, At, B1); PG8_BAR; PG8_SCHED;
            } else {
            PG8_LDB(B0, 0, 0); PG8_SCHED; PG8_LDA(At, 0, 0); PG8_STAGE(PG8_SA(1, 1), a1 + hstep, voffA);
            PG8_WAIT_L(8); PG8_BAR; PG8_WAIT_L(0); PG8_MMA(0, 0, At, B0); PG8_BAR; PG8_SCHED;
            PG8_LDB(B1, 0, 1); PG8_STAGE(PG8_SB(0, 0), b2, voffB);
            PG8_BAR; PG8_WAIT_L(0); PG8_MMA(0, 1, At, B1); PG8_BAR;
            PG8_LDA(At, 0, 1); PG8_STAGE(PG8_SA(0, 0), a2, voffA);
            PG8_BAR; PG8_WAIT_L(0); PG8_MMA(1, 0, At, B0); PG8_BAR; PG8_SCHED;
            PG8_STAGE(PG8_SB(0, 1), b2 + hstep, voffB);
            PG8_WAIT_V(6); PG8_BAR; PG8_MMA(1, 1, At, B1); PG8_BAR;
            PG8_LDB(B0, 1, 0); PG8_SCHED; PG8_LDA(At, 1, 0); PG8_STAGE(PG8_SA(0, 1), a2 + hstep, voffA);
            PG8_WAIT_L(8); PG8_BAR; PG8_WAIT_L(0); PG8_MMA(0, 0, At, B0); PG8_BAR; PG8_SCHED;
            PG8_LDB(B1, 1, 1); PG8_STAGE(PG8_SB(1, 0), b3, voffB);
            PG8_BAR; PG8_WAIT_L(0); PG8_MMA(0, 1, At, B1); PG8_BAR;
            PG8_LDA(At, 1, 1); PG8_STAGE(PG8_SA(1, 0), a3, voffA);
            PG8_BAR; PG8_WAIT_L(0); PG8_MMA(1, 0, At, B0); PG8_BAR; PG8_SCHED;
            PG8_STAGE(PG8_SB(1, 1), b3 + hstep, voffB);
            PG8_WAIT_V(6); PG8_BAR; PG8_MMA(1, 1, At, B1); PG8_BAR;
            }
        }
        if constexpr (ALIGN_EPI) { if (wr == 0) PG8_BAR; }
        if constexpr (!Epi::AFTER_DRAIN) { E(acc, cur, wr, wc, fr, fq); S.done(cur); }
        if (!has_next) break;
#pragma unroll
        for (int a = 0; a < 2; ++a)
#pragma unroll
            for (int b = 0; b < 2; ++b)
#pragma unroll
                for (int m = 0; m < 4; ++m)
#pragma unroll
                    for (int n = 0; n < 2; ++n) acc[a][b][m][n] = (f32x4){0.f, 0.f, 0.f, 0.f};
        cur = nxt; cA = nA; cB = nB; ++ui;
        if constexpr (ALIGN_EPI) { if (wr == 1) PG8_BAR; }
    }
    PG8_WAIT_V(0);
    if constexpr (!ALIGN_EPI) { if (wr == 0) PG8_BAR; }
    PG8_BAR;
    if constexpr (Epi::AFTER_DRAIN) { E.fused(acc, cur, wr, wc, fr, fq, lds, wid, lane); S.done(cur); }
#undef PG8_SA
#undef PG8_SB
#undef PG8_STAGE
#undef PG8_LDA
#undef PG8_LDB
#undef PG8_MMA
#undef PG8_WAIT_V
#undef PG8_WAIT_L
#undef PG8_BAR
#undef PG8_SCHED
}
}
#define XB_TMO      128
#define XB_XCNT(j)  (256  + 64 * (j))
#define XB_XSUB(j)  (1280 + 64 * (j))
#define XB_XGEN(j)  (2304 + 64 * (j))
#define XB_TOP      3328
#define XB_TOPGEN   3392
#define XCD_BAR_WORDS 3456
#define XB_SPIN_CAP (1u << 18)
#define LAS __attribute__((address_space(3)))

__device__ __forceinline__ unsigned xb_ld(unsigned* p)              { return __hip_atomic_load(p, __ATOMIC_RELAXED, __HIP_MEMORY_SCOPE_AGENT); }
__device__ __forceinline__ unsigned xb_add(unsigned* p, unsigned v) { return __hip_atomic_fetch_add(p, v, __ATOMIC_RELAXED, __HIP_MEMORY_SCOPE_AGENT); }
__device__ __forceinline__ unsigned xb_xcc_id() { return (unsigned)__builtin_amdgcn_s_getreg((3 << 11) | 20) & 0xFu; }
#define XB_SPIN(cond, bar) do { unsigned _sp = 0; while (cond) { __builtin_amdgcn_s_sleep(1); \
    if ((++_sp & 255u) == 0u) { if (xb_ld(&(bar)[XB_TMO])) break; if (_sp > XB_SPIN_CAP) { atomicAdd(&(bar)[XB_TMO], 1u); break; } } } } while (0)

struct XcdBarrier {
    unsigned* bar; unsigned x;
    volatile LAS unsigned* st;
};

__device__ __forceinline__ XcdBarrier xcd_barrier_post(unsigned* bar, volatile LAS unsigned* st) {
    XcdBarrier b; b.bar = bar; b.x = xb_xcc_id(); b.st = st;
    if (threadIdx.x == 0) (void)xb_add(&bar[XB_XCNT(b.x)], 1u);
    return b;
}
__device__ __forceinline__ void xcd_barrier_complete(unsigned* bar, unsigned x, unsigned& nloc, unsigned& nx) {
    const unsigned G = gridDim.x * gridDim.y * gridDim.z;
    unsigned sum, cnt, mine, sp = 0u;
    for (;;) {
        sum = 0u; cnt = 0u; mine = 0u;
#pragma unroll
        for (unsigned j = 0; j < 16; ++j) { const unsigned c = xb_ld(&bar[XB_XCNT(j)]); sum += c; cnt += (c > 0u) ? 1u : 0u; mine = (j == x) ? c : mine; }
        if (sum == G) break;
        __builtin_amdgcn_s_sleep(1);
        if ((++sp & 255u) == 0u) { if (xb_ld(&bar[XB_TMO])) break; if (sp > XB_SPIN_CAP) { atomicAdd(&bar[XB_TMO], 1u); break; } }
    }
    nloc = mine > 0u ? mine : 1u; nx = cnt > 0u ? cnt : 1u;
}

__device__ __forceinline__ void xcd_barrier(const XcdBarrier& b) {
    asm volatile("s_waitcnt vmcnt(0)" ::: "memory");
    __syncthreads();
    if (threadIdx.x == 0) {
        unsigned* bar = b.bar;
        __builtin_amdgcn_s_waitcnt(0);
        unsigned nloc = b.st[0], nx = b.st[1];
        if (nloc == 0u) { xcd_barrier_complete(bar, b.x, nloc, nx); b.st[0] = nloc; b.st[1] = nx; }
        const unsigned old = xb_add(&bar[XB_XSUB(b.x)], 1u);
        const unsigned gen = old / nloc;
        if (old + 1u == (gen + 1u) * nloc) {
            __builtin_amdgcn_fence(__ATOMIC_RELEASE, "agent");
            asm volatile("s_waitcnt vmcnt(0)" ::: "memory");
            const unsigned og = xb_add(&bar[XB_TOP], 1u);
            const unsigned tg = og / nx;
            if (og + 1u == (tg + 1u) * nx) xb_add(&bar[XB_TOPGEN], 1u);
            else XB_SPIN(xb_ld(&bar[XB_TOPGEN]) == tg, bar);
            __builtin_amdgcn_fence(__ATOMIC_ACQUIRE, "agent");
            xb_add(&bar[XB_XGEN(b.x)], 1u);
            asm volatile("s_waitcnt vmcnt(0)" ::: "memory");
        } else {
            XB_SPIN(xb_ld(&bar[XB_XGEN(b.x)]) == gen, bar);
            __builtin_amdgcn_fence(__ATOMIC_ACQUIRE, "agent");
            asm volatile("s_waitcnt vmcnt(0)" ::: "memory");
        }
    }
    __syncthreads();
}

struct Args { const float* in[47]; float* out; unsigned char* ws; int ph_lo, ph_hi; };
typedef const __attribute__((address_space(4))) Args* KArgsP;
__device__ __forceinline__ KArgsP fresh_args() { KArgsP p = (KArgsP)__builtin_amdgcn_kernarg_segment_ptr(); asm volatile("" : "+s"(p)); return p; }
enum { I_X = 0, I_C, I_ADA_W, I_ADA_B, I_NORM_MIX, I_NORM_FFN, I_NORM_FINAL, I_W_IN, I_W_OUT, I_CONV_W, I_CONV_B, I_WQ, I_WK, I_BI, I_BF, I_MNORM_W,
       I_RMU, I_RW0, I_RWUP, I_RA0, I_RAUP, I_RGUP, I_RKK, I_RKA, I_RRK, I_RLNW, I_RLNB, I_RV0, I_RVDN, I_RVUP,
       I_S5ARE, I_S5AIM, I_S5LDT, I_S5BRE, I_S5BIM, I_S5CRE, I_S5CIM, I_S5D, I_S5GLUW, I_S5GLUB,
       I_MWRG, I_MBRG, I_MWRE, I_MBRE, I_MW1, I_MW3, I_MW2 };

struct RmWin { __device__ __forceinline__ int operator()(int n) const { return n < 1152 ? n : (n < 1164 ? 2816 + (n - 1152) : (n < 2572 ? 1152 + (n - 1164) : 2560 + (n - 2572))); } };
struct RmId  { __device__ __forceinline__ int operator()(int n) const { return n; } };
struct RmGU  { int add; __device__ __forceinline__ int operator()(int n) const { return 8 * (n >> 2) + (n & 3) + add; } };
template <class RM>
__device__ __forceinline__ void transpose_item(const float* W, int ldw, int ncols, int k0, int n0, bf16* WT, int ldt, LAS float* scr, int lane, const RM rm) {
    const int nn = n0 + lane; const bool ok = nn < ncols; const float* src = W + (size_t)k0 * ldw + (ok ? nn : n0);
    float v[64];
#pragma unroll
    for (int kk = 0; kk < 64; ++kk) v[kk] = src[(size_t)kk * ldw];
#pragma unroll
    for (int kk = 0; kk < 64; ++kk) scr[kk * 65 + lane] = v[kk];
    LDS_WAIT(); asm volatile("" ::: "memory");
    const int c = lane & 7;
#pragma unroll
    for (int j = 0; j < 8; ++j) { const int nl = (lane >> 3) + 8 * j; const LAS float* s = scr + (8 * c) * 65 + nl;
        v4u o; o.x = pk2(s[0 * 65], s[1 * 65]); o.y = pk2(s[2 * 65], s[3 * 65]); o.z = pk2(s[4 * 65], s[5 * 65]); o.w = pk2(s[6 * 65], s[7 * 65]);
        if (n0 + nl < ncols) *(GAS v4u*)(WT + (size_t)rm(n0 + nl) * ldt + k0 + 8 * c) = o; }
    LDS_WAIT(); asm volatile("" ::: "memory");
}
__device__ __forceinline__ void moe_convert(const float* w1, const float* w3, const float* w2, int l, bf16* W13, bf16* W2T, int worker, int nworkers, LAS float* scr, int lane) {
    for (int it = worker; it < NEXP * 384; it += nworkers) {
        const int e = it / 384, r = it % 384; const size_t eo = (size_t)(l * NEXP + e) * DM * DEXP;
        if (r < 128)      transpose_item(w1 + eo, DEXP, DEXP, 64 * (r >> 3), 64 * (r & 7), W13 + (size_t)e * 1024 * 1024, 1024, scr, lane, RmGU{0});
        else if (r < 256) transpose_item(w3 + eo, DEXP, DEXP, 64 * ((r - 128) >> 3), 64 * ((r - 128) & 7), W13 + (size_t)e * 1024 * 1024, 1024, scr, lane, RmGU{4});
        else              transpose_item(w2 + eo, DM, DM, 64 * ((r - 256) >> 4), 64 * ((r - 256) & 15), W2T + (size_t)e * 1024 * 512, 512, scr, lane, RmId{});
    }
}
__device__ __forceinline__ void phase_prologue(KArgsP a, LAS unsigned char* lds, int tid, int lane, int wave, int vcu, int G) {
    unsigned char* ws = a->ws;
    LAS float* scr = (LAS float*)(lds + wave * 16640);
    const int gw = vcu * NWAVES + wave, NGW = G * NWAVES;
    bf16* WIN = (bf16*)(ws + WS_WIN); bf16* WOUT = (bf16*)(ws + WS_WOUT);
    for (int it = gw; it < 2 * 16 * 45; it += NGW) { const int l = it / (16 * 45), r = it % (16 * 45);
        transpose_item(a->in[I_W_IN] + (size_t)l * DM * IN_COLS, IN_COLS, IN_COLS, 64 * (r / 45), 64 * (r % 45), WIN + (size_t)l * NPROJ_PAD * DM, DM, scr, lane, RmWin{}); }
    for (int it = gw; it < 2 * 16 * 16; it += NGW) { const int l = it / 256, r = it % 256;
        transpose_item(a->in[I_W_OUT] + (size_t)l * DM * DM, DM, DM, 64 * (r >> 4), 64 * (r & 15), WOUT + (size_t)l * DM * DM, DM, scr, lane, RmId{}); }
    for (int it = gw; it < 2 * 244; it += NGW) { const int l = it / 244, r = 2828 + it % 244; GAS v4u* p = (GAS v4u*)(WIN + ((size_t)l * NPROJ_PAD + r) * DM);
        p[lane] = (v4u){0u, 0u, 0u, 0u}; p[lane + 64] = (v4u){0u, 0u, 0u, 0u}; }
    { float* RTW = (float*)(ws + WS_RTW);
      for (int idx = (vcu * NTHR + tid); idx < 2 * 1024 * 48; idx += G * NTHR) { const int j = idx % 48, k = (idx / 48) % 1024, l = idx / (48 * 1024);
          RTW[idx] = j < 4 ? a->in[I_MWRG][(size_t)(l * 1024 + k) * 4 + j] : (j < 36 ? a->in[I_MWRE][(size_t)(l * 1024 + k) * 32 + (j - 4)] : 0.f); } }
    { bf16* RW = (bf16*)(ws + WS_R1W);
      for (int idx = (vcu * NTHR + tid); idx < 2 * 98304 + 24576; idx += G * NTHR) { float v;
          if (idx < 2 * 98304) { const int l = idx / 98304, r = idx % 98304;
              if (r < 24576)      v = a->in[I_RWUP][(size_t)l * 64 * DBR + (r & 63) * DBR + (r >> 6)];
              else if (r < 49152) v = a->in[I_RAUP][(size_t)l * 64 * DBR + ((r - 24576) & 63) * DBR + ((r - 24576) >> 6)];
              else                v = a->in[I_RGUP][(size_t)l * 128 * DBR + ((r - 49152) & 127) * DBR + ((r - 49152) >> 7)];
          } else { const int r = idx - 2 * 98304;
              if (r < 12288) v = a->in[I_RVDN][(size_t)(r % 384) * 32 + (r / 384)];
              else           v = a->in[I_RVUP][(size_t)((r - 12288) & 31) * DBR + ((r - 12288) >> 5)]; }
          RW[idx] = (bf16)f2bf(v); } }
    { bf16* CM = (bf16*)(ws + WS_S5CM);
      for (int idx = (vcu * NTHR + tid); idx < 2 * 16 * 16 * 128; idx += G * NTHR) { const int k = idx & 127, lgc = idx >> 7;
          CM[idx] = (bf16)f2bf((k & 1) ? -a->in[I_S5CIM][(size_t)lgc * 64 + (k >> 1)] : a->in[I_S5CRE][(size_t)lgc * 64 + (k >> 1)]); } }
    for (int it = gw; it < 2 * 16; it += NGW) { const int l = it >> 4, r = it & 15;
        transpose_item(a->in[I_S5GLUW] + (size_t)l * DC * DC, DC, DC, 64 * (r >> 2), 64 * (r & 3), (bf16*)(ws + WS_GLUT) + (size_t)l * DC * DC, DC, scr, lane, RmId{}); }
    { bf16* MLW = (bf16*)(ws + WS_MLW);
      for (int idx = (vcu * NTHR + tid); idx < 2 * NH * 2 * 4096; idx += G * NTHR) { const int d = idx & 63, e = (idx >> 6) & 63, which = (idx >> 12) & 1, lh = idx >> 13;
          MLW[idx] = (bf16)f2bf(a->in[which ? I_WK : I_WQ][(size_t)lh * 4096 + d * 64 + e]); } }
    __syncthreads();
    if (vcu < 192) {
        const int q = vcu, l = q / 96, cb = (q >> 3) % 12, kc = q & 7;
        LAS float* cond = (LAS float*)lds;
        { const int b = tid >> 7, kk = tid & 127; const float cv = a->in[I_C][b * DM + kc * 128 + kk]; cond[tid] = cv / (1.f + __expf(-cv)); }
        __syncthreads();
        const int col = cb * 512 + tid; const float* wp = a->in[I_ADA_W] + ((size_t)l * DM + kc * 128) * 6144 + col;
        float acc0 = 0.f, acc1 = 0.f, acc2 = 0.f, acc3 = 0.f;
#pragma unroll 8
        for (int kk = 0; kk < 128; ++kk) { const float w = wp[(size_t)kk * 6144]; acc0 += cond[kk] * w; acc1 += cond[128 + kk] * w; acc2 += cond[256 + kk] * w; acc3 += cond[384 + kk] * w; }
        const float bias = (kc == 0) ? a->in[I_ADA_B][l * 6144 + col] : 0.f;
        float* MP = (float*)(ws + WS_MODP) + ((size_t)(kc * 2 + l) * 4) * 6144 + col;
        MP[0] = acc0 + bias; MP[6144] = acc1 + bias; MP[2 * 6144] = acc2 + bias; MP[3 * 6144] = acc3 + bias;
    }
}

__device__ __forceinline__ float modval(const unsigned char* ws, bool part, int l, int b, int idx) {
    if (!part) return ((const float*)(ws + WS_MODF))[(size_t)(l * 4 + b) * 6144 + idx];
    const float* mp = (const float*)(ws + WS_MODP) + (size_t)(l * 4 + b) * 6144 + idx; float s = 0.f;
#pragma unroll
    for (int kc = 0; kc < 8; ++kc) s += mp[(size_t)kc * 2 * 4 * 6144];
    return s;
}
template <int MODE, bool COMBINE>
__device__ __forceinline__ void phase_rownorm(KArgsP a, LAS unsigned char* lds, int tid, int lane, int wave, int G,
                                              const float* xsrc, float* xdst, const float* gvec, bool part, int l, int isc  , int lprev) {
    unsigned char* ws = a->ws;
    LAS float* sc = (LAS float*)lds; LAS float* sh = sc + 1024; LAS float* gt = sh + 1024;
    bf16* HN = (bf16*)(ws + WS_HN); const bf16* YM = (const bf16*)(ws + WS_YMOE); const float* TW = (const float*)(ws + WS_TOKW);
    for (int c = blockIdx.x; c < NTOK / 128; c += G) {
        const int b = c >> 6;
        __syncthreads();
        for (int j = tid; j < 1024; j += NTHR) {
            if (MODE == 0) { sc[j] = gvec[j] * (1.f + modval(ws, part, l, b, (isc + 1) * 1024 + j)); sh[j] = modval(ws, part, l, b, isc * 1024 + j); }
            else { sc[j] = gvec[j]; sh[j] = 0.f; }
            if (COMBINE) gt[j] = 1.f + modval(ws, false, lprev, b, 5 * 1024 + j);
        }
        __syncthreads();
        f32x4 vn[4]; v2u yn0[4], yn1[4]; float wn0 = 0.f, wn1 = 0.f;
        { const int row = c * 128 + wave * 16; const GAS f32x4* xr = (const GAS f32x4*)(xsrc + (size_t)row * DM) + lane;
#pragma unroll
          for (int j = 0; j < 4; ++j) vn[j] = xr[64 * j];
          if (COMBINE) { wn0 = TW[2 * row]; wn1 = TW[2 * row + 1]; const GAS v2u* y0 = (const GAS v2u*)(YM + (size_t)(2 * row) * DM) + lane; const GAS v2u* y1 = (const GAS v2u*)(YM + (size_t)(2 * row + 1) * DM) + lane;
#pragma unroll
              for (int j = 0; j < 4; ++j) { yn0[j] = y0[64 * j]; yn1[j] = y1[64 * j]; } } }
        for (int i = 0; i < 16; ++i) {
            const int row = c * 128 + wave * 16 + i;
            f32x4 v[4]; v2u q0[4], q1[4]; const float w0 = wn0, w1 = wn1;
#pragma unroll
            for (int j = 0; j < 4; ++j) { v[j] = vn[j]; q0[j] = yn0[j]; q1[j] = yn1[j]; }
            if (i + 1 < 16) { const int rn = row + 1; const GAS f32x4* xr = (const GAS f32x4*)(xsrc + (size_t)rn * DM) + lane;
#pragma unroll
                for (int j = 0; j < 4; ++j) vn[j] = xr[64 * j];
                if (COMBINE) { wn0 = TW[2 * rn]; wn1 = TW[2 * rn + 1]; const GAS v2u* y0 = (const GAS v2u*)(YM + (size_t)(2 * rn) * DM) + lane; const GAS v2u* y1 = (const GAS v2u*)(YM + (size_t)(2 * rn + 1) * DM) + lane;
#pragma unroll
                    for (int j = 0; j < 4; ++j) { yn0[j] = y0[64 * j]; yn1[j] = y1[64 * j]; } } }
            if (COMBINE) {
#pragma unroll
                for (int j = 0; j < 4; ++j) { const v2u p0 = q0[j], p1 = q1[j]; const f32x4 g4 = *(const LAS f32x4*)(gt + lane * 4 + 256 * j);
                    f32x4 m; m.x = w0 * bflo(p0.x) + w1 * bflo(p1.x); m.y = w0 * bfhi(p0.x) + w1 * bfhi(p1.x); m.z = w0 * bflo(p0.y) + w1 * bflo(p1.y); m.w = w0 * bfhi(p0.y) + w1 * bfhi(p1.y);
                    v[j] = v[j] + g4 * m; }
                if (MODE == 0) { GAS f32x4* xo = (GAS f32x4*)(xdst + (size_t)row * DM) + lane;
#pragma unroll
                    for (int j = 0; j < 4; ++j) xo[64 * j] = v[j]; }
            }
            float ss = 0.f;
#pragma unroll
            for (int j = 0; j < 4; ++j) ss += (v[j].x * v[j].x + v[j].y * v[j].y) + (v[j].z * v[j].z + v[j].w * v[j].w);
            const float rstd = rsqrtf(wave_sum(ss) * (1.f / DM) + NORM_EPS);
            if (MODE == 0) {
                GAS v2u* o = (GAS v2u*)(HN + (size_t)row * DM) + lane;
#pragma unroll
                for (int j = 0; j < 4; ++j) { const f32x4 s4 = *(const LAS f32x4*)(sc + lane * 4 + 256 * j), h4 = *(const LAS f32x4*)(sh + lane * 4 + 256 * j); const f32x4 h = v[j] * rstd * s4 + h4;
                    v2u w; w.x = pk2(h.x, h.y); w.y = pk2(h.z, h.w); o[64 * j] = w; }
            } else {
                GAS f32x4* o = (GAS f32x4*)(xdst + (size_t)row * DM) + lane;
#pragma unroll
                for (int j = 0; j < 4; ++j) { const f32x4 s4 = *(const LAS f32x4*)(sc + lane * 4 + 256 * j); o[64 * j] = v[j] * rstd * s4; }
            }
        }
    }
}
__device__ __forceinline__ void mod_finalize(unsigned char* ws, int tid, int G) {
    float* MF = (float*)(ws + WS_MODF);
    for (int idx = blockIdx.x * NTHR + tid; idx < 2 * 4 * 6144; idx += G * NTHR) { const float* mp = (const float*)(ws + WS_MODP) + idx; float s = 0.f;
#pragma unroll
        for (int kc = 0; kc < 8; ++kc) s += mp[(size_t)kc * 2 * 4 * 6144];
        MF[idx] = s; }
}

typedef float f32x4m __attribute__((ext_vector_type(4)));
__device__ __forceinline__ void phase_router(KArgsP a, LAS unsigned char* lds, int tid, int lane, int wave, int G, int l) {
    unsigned char* ws = a->ws;
    LAS float* sc = (LAS float*)lds; LAS float* sh = sc + 1024; LAS float* rstd_s = sh + 1024  ; LAS float* cvec = rstd_s + 128  ; LAS float* cpart = cvec + 64  ;
    LAS float* lg = cpart + 8 * 48  ; LAS int* hist = (LAS int*)(lg + 8 * 16 * 48)  ; LAS int* basev = hist + 32; LAS int* asg_e = basev + 32  ; LAS int* asg_lp = asg_e + 256;
    bf16* HN = (bf16*)(ws + WS_HN); const float* x = a->out; const float* RTW = (const float*)(ws + WS_RTW) + (size_t)l * 1024 * 48;
    int* TOKE = (int*)(ws + WS_TOKE); float* TOKW = (float*)(ws + WS_TOKW); int* LIST = (int*)(ws + WS_LIST); unsigned* CNT = (unsigned*)(ws + WS_CTL) + CW_CNT + l * 32;
    const float* gvec = a->in[I_NORM_FFN] + l * DM;
    for (int c = blockIdx.x; c < NTOK / 128; c += G) {
        const int b = c >> 6;
        __syncthreads();
        for (int j = tid; j < 1024; j += NTHR) { sc[j] = gvec[j] * (1.f + modval(ws, false, l, b, 4 * 1024 + j)); sh[j] = modval(ws, false, l, b, 3 * 1024 + j); }
        if (tid < 32) hist[tid] = 0;
        __syncthreads();
        if (tid < 384) { const int j = tid % 48, part = tid / 48; float s = 0.f;
            for (int k = part * 128; k < part * 128 + 128; ++k) s += sh[k] * RTW[(size_t)k * 48 + j];
            cpart[part * 48 + j] = s; }
        { f32x4 vn[4];
          { const GAS f32x4* xr = (const GAS f32x4*)(x + (size_t)(c * 128 + wave * 16) * DM) + lane;
#pragma unroll
            for (int j = 0; j < 4; ++j) vn[j] = xr[64 * j]; }
          for (int i = 0; i < 16; ++i) {
            const int row = c * 128 + wave * 16 + i;
            f32x4 v[4]; float ss = 0.f;
#pragma unroll
            for (int j = 0; j < 4; ++j) { v[j] = vn[j]; ss += (v[j].x * v[j].x + v[j].y * v[j].y) + (v[j].z * v[j].z + v[j].w * v[j].w); }
            if (i + 1 < 16) { const GAS f32x4* xr = (const GAS f32x4*)(x + (size_t)(row + 1) * DM) + lane;
#pragma unroll
                for (int j = 0; j < 4; ++j) vn[j] = xr[64 * j]; }
            const float rstd = rsqrtf(wave_sum(ss) * (1.f / DM) + NORM_EPS);
            if (lane == 0) rstd_s[wave * 16 + i] = rstd;
            GAS v2u* o = (GAS v2u*)(HN + (size_t)row * DM) + lane;
#pragma unroll
            for (int j = 0; j < 4; ++j) { const f32x4 s4 = *(const LAS f32x4*)(sc + lane * 4 + 256 * j), h4 = *(const LAS f32x4*)(sh + lane * 4 + 256 * j); const f32x4 h = v[j] * rstd * s4 + h4;
                v2u w; w.x = pk2(h.x, h.y); w.y = pk2(h.z, h.w); o[64 * j] = w; }
          } }
        __syncthreads();
        if (tid < 48) { float s = 0.f;
#pragma unroll
            for (int p = 0; p < 8; ++p) s += cpart[p * 48 + tid];
            s += tid < 4 ? a->in[I_MBRG][l * 4 + tid] : (tid < 36 ? a->in[I_MBRE][l * 32 + tid - 4] : 0.f); cvec[tid] = s; }
        {
            const int i16 = lane & 15, kq = lane >> 4, r0 = c * 128 + wave * 16;
            f32x4m acc0 = {0.f, 0.f, 0.f, 0.f}, acc1 = acc0, acc2 = acc0;
            const float* xrow = x + (size_t)(r0 + i16) * DM + 4 * kq;
            for (int k0 = 0; k0 < DM; k0 += 16) {
                const f32x4 xv = *(const GAS f32x4*)(xrow + k0); const f32x4 sv = *(const LAS f32x4*)(sc + k0 + 4 * kq);
                const float* wp = RTW + (size_t)(k0 + 4 * kq) * 48 + i16;
#pragma unroll
                for (int j = 0; j < 4; ++j) { const float av = xv[j] * sv[j];
                    acc0 = __builtin_amdgcn_mfma_f32_16x16x4f32(av, wp[j * 48], acc0, 0, 0, 0);
                    acc1 = __builtin_amdgcn_mfma_f32_16x16x4f32(av, wp[j * 48 + 16], acc1, 0, 0, 0);
                    acc2 = __builtin_amdgcn_mfma_f32_16x16x4f32(av, wp[j * 48 + 32], acc2, 0, 0, 0); }
            }
            __syncthreads();
            LAS float* lw = lg + wave * 16 * 48;
#pragma unroll
            for (int r = 0; r < 4; ++r) { const int rr = 4 * kq + r; const float rs = rstd_s[wave * 16 + rr];
                lw[rr * 48 + i16] = acc0[r] * rs + cvec[i16]; lw[rr * 48 + 16 + i16] = acc1[r] * rs + cvec[16 + i16]; lw[rr * 48 + 32 + i16] = acc2[r] * rs + cvec[32 + i16]; }
            LDS_WAIT(); asm volatile("" ::: "memory");
            if (lane < 16) {
                const LAS float* lr = lw + lane * 48; const int row = r0 + lane;
                float g0 = lr[0], g1 = lr[1], g2 = lr[2], g3 = lr[3]; const float gm = fmaxf(fmaxf(g0, g1), fmaxf(g2, g3));
                float p0 = __expf(g0 - gm), p1 = __expf(g1 - gm), p2 = __expf(g2 - gm), p3 = __expf(g3 - gm); const float inv = 1.f / (p0 + p1 + p2 + p3);
                p0 *= inv; p1 *= inv; p2 *= inv; p3 *= inv;
                int gi = 0; float gp = p0; if (p1 > gp) { gp = p1; gi = 1; } if (p2 > gp) { gp = p2; gi = 2; } if (p3 > gp) { gp = p3; gi = 3; }
                float ev0 = -3.4e38f, ev1 = -3.4e38f; int e0 = 0, e1 = 0;
#pragma unroll
                for (int j = 0; j < 8; ++j) { const float s = lr[4 + gi * 8 + j]; if (s > ev0) { ev1 = ev0; e1 = e0; ev0 = s; e0 = j; } else if (s > ev1) { ev1 = s; e1 = j; } }
                const float q = __expf(ev1 - ev0), w0 = gp / (1.f + q), w1 = gp * q / (1.f + q);
                e0 += gi * 8; e1 += gi * 8;
                TOKE[2 * row] = e0; TOKE[2 * row + 1] = e1; TOKW[2 * row] = w0; TOKW[2 * row + 1] = w1;
                const int a0 = 2 * (wave * 16 + lane);
                asg_e[a0] = e0; asg_e[a0 + 1] = e1; asg_lp[a0] = atomicAdd((int*)&hist[e0], 1); asg_lp[a0 + 1] = atomicAdd((int*)&hist[e1], 1);
            }
        }
        __syncthreads();
        if (tid < 32) { const int h = hist[tid]; basev[tid] = h ? (int)atomicAdd(CNT + tid, (unsigned)h) : 0; }
        __syncthreads();
        if (tid < 256) { const int e = asg_e[tid]; LIST[(size_t)e * 65536 + basev[e] + asg_lp[tid]] = (c * 128) * 2 + tid; }
    }
}
__device__ __forceinline__ void build_ptab(const unsigned* CNT, LAS int* ptab, LAS int* pst, LAS int* cnt, int tid) {
    __syncthreads();
    if (tid == 0) { int np = 0;
        for (int e = 0; e < NEXP; ++e) { const int ce = (int)__hip_atomic_load(CNT + e, RLX_AGENT); cnt[e] = ce; pst[e] = np * 256; const int pe = (ce + 255) >> 8;
            for (int p = 0; p < pe; ++p) ptab[1 + np + p] = e;
            np += pe; }
        ptab[0] = np; }
    __syncthreads();
}
__device__ __forceinline__ void phase_gather(KArgsP a, LAS unsigned char* lds, int tid, int lane, int wave, int vcu, int G, int l) {
    unsigned char* ws = a->ws;
    LAS int* ptab = (LAS int*)lds; LAS int* pst = ptab + 512; LAS int* cnt = pst + 32;
    build_ptab((const unsigned*)(ws + WS_CTL) + CW_CNT + l * 32, ptab, pst, cnt, tid);
    const bf16* HN = (const bf16*)(ws + WS_HN); bf16* XG = (bf16*)(ws + WS_XG); int* ROWMAP = (int*)(ws + WS_ROWMAP); const int* LIST = (const int*)(ws + WS_LIST);
    const int nrows = ptab[0] * 256;
    for (int row0 = (vcu * NWAVES + wave) * 8; row0 < nrows; row0 += G * NWAVES * 8) {
        int tok2[8]; v4u p0[8], p1[8];
#pragma unroll
        for (int j = 0; j < 8; ++j) { const int row = row0 + j, e = ptab[1 + (row >> 8)], pos = row - pst[e]; tok2[j] = (pos < cnt[e]) ? LIST[(size_t)e * 65536 + pos] : -1; }
#pragma unroll
        for (int j = 0; j < 8; ++j) { if (tok2[j] >= 0) { const GAS v4u* s = (const GAS v4u*)(HN + (size_t)(tok2[j] >> 1) * DM) + lane; p0[j] = s[0]; p1[j] = s[64]; } else { p0[j] = (v4u){0u, 0u, 0u, 0u}; p1[j] = p0[j]; } }
#pragma unroll
        for (int j = 0; j < 8; ++j) { GAS v4u* d = (GAS v4u*)(XG + (size_t)(row0 + j) * DM) + lane; d[0] = p0[j]; d[64] = p1[j]; if (lane == 0) ROWMAP[row0 + j] = tok2[j]; }
    }
}

typedef short bf16x8 __attribute__((ext_vector_type(8)));
constexpr int MT = 72;
constexpr int ML_XP = 0;
constexpr int ML_CX = 17152;
constexpr int ML_WQ = ML_CX + 9216, ML_WK = ML_WQ + 9216;
constexpr int ML_Q = ML_WK + 9216, ML_K = ML_Q + 9216;
constexpr int ML_S = ML_K + 9216;
constexpr int ML_VT = ML_S + 9216;
constexpr int ML_CT = ML_VT + 11520;
constexpr int ML_H = ML_CT + 11520;
constexpr int ML_SM = ML_H + 16640;
static_assert(ML_SM + 2048 <= RING_BYTES, "mLSTM LDS map");
__device__ __forceinline__ float logsigmoidf_(float x) { return fminf(x, 0.f) - log1pf(__expf(-fabsf(x))); }
__device__ __forceinline__ void mma64(const LAS bf16* A, int arow0, const LAS bf16* Bt, int brow0, int lane, f32x4& acc) {
    const LAS bf16* ap = A + (arow0 + (lane & 15)) * MT + 8 * (lane >> 4); const LAS bf16* bp = Bt + (brow0 + (lane & 15)) * MT + 8 * (lane >> 4);
    const bf16x8 a0 = *(const LAS bf16x8*)ap, a1 = *(const LAS bf16x8*)(ap + 32), b0 = *(const LAS bf16x8*)bp, b1 = *(const LAS bf16x8*)(bp + 32);
    acc = __builtin_amdgcn_mfma_f32_16x16x32_bf16(a0, b0, acc, 0, 0, 0); acc = __builtin_amdgcn_mfma_f32_16x16x32_bf16(a1, b1, acc, 0, 0, 0);
}
__device__ __forceinline__ void ml_front(KArgsP a, LAS unsigned char* lds, int tid, int l, int b, int c, int h, bool want_q) {
    const bf16* PROJ = (const bf16*)(a->ws + WS_PROJ); const size_t row0 = (size_t)b * SEQ + c * 64;
    LAS float* xp = (LAS float*)(lds + ML_XP);
    for (int idx = tid; idx < 67 * 8; idx += NTHR) { const int r = idx >> 3, c8 = idx & 7, tr = c * 64 + r - 3; LAS float* d = xp + r * 64 + c8 * 8;
        if (tr >= 0) { const v4u p = *(const GAS v4u*)(PROJ + ((size_t)b * SEQ + tr) * NPROJ + PC_QK + h * 64 + c8 * 8);
            *(LAS f32x4*)d = (f32x4){bflo(p.x), bfhi(p.x), bflo(p.y), bfhi(p.y)}; *(LAS f32x4*)(d + 4) = (f32x4){bflo(p.z), bfhi(p.z), bflo(p.w), bfhi(p.w)}; }
        else { *(LAS f32x4*)d = (f32x4){0.f, 0.f, 0.f, 0.f}; *(LAS f32x4*)(d + 4) = (f32x4){0.f, 0.f, 0.f, 0.f}; } }
    {
        const int t = tid >> 3, vg = tid & 7; LAS bf16* VT = (LAS bf16*)(lds + ML_VT);
        const v4u p = *(const GAS v4u*)(PROJ + (row0 + t) * NPROJ + PC_V + h * 64 + vg * 8);
        const unsigned w[4] = {p.x, p.y, p.z, p.w};
#pragma unroll
        for (int j = 0; j < 4; ++j) { VT[(vg * 8 + 2 * j) * MT + t] = (bf16)(w[j] & 0xffffu); VT[(vg * 8 + 2 * j + 1) * MT + t] = (bf16)(w[j] >> 16); }
        for (int idx = tid; idx < 16 * 64; idx += NTHR) VT[(64 + (idx >> 6)) * MT + (idx & 63)] = (idx < 64) ? (bf16)0x3F80 : (bf16)0;
        const bf16* WT = (const bf16*)(a->ws + WS_MLW) + (size_t)((l * NH + h) * 2) * 4096;
        const int e = tid >> 3, d8 = tid & 7;
        if (want_q) *(LAS v4u*)(lds + ML_WQ + (e * MT + d8 * 8) * 2) = *(const GAS v4u*)(WT + e * 64 + d8 * 8);
        *(LAS v4u*)(lds + ML_WK + (e * MT + d8 * 8) * 2) = *(const GAS v4u*)(WT + 4096 + e * 64 + d8 * 8);
    }
    __syncthreads();
    const float* cw = a->in[I_CONV_W] + (size_t)l * 4 * DA + h * 64; const float* cb = a->in[I_CONV_B] + (size_t)l * DA + h * 64;
    {
        const int t = tid >> 3, c8 = (tid & 7) * 8; float s[8];
#pragma unroll
        for (int j = 0; j < 8; ++j) s[j] = cb[c8 + j];
#pragma unroll
        for (int q = 0; q < 4; ++q) { const f32x4 x0 = *(const LAS f32x4*)(xp + (t + q) * 64 + c8), x1 = *(const LAS f32x4*)(xp + (t + q) * 64 + c8 + 4); const float* w = cw + q * DA + c8;
            s[0] += x0.x * w[0]; s[1] += x0.y * w[1]; s[2] += x0.z * w[2]; s[3] += x0.w * w[3]; s[4] += x1.x * w[4]; s[5] += x1.y * w[5]; s[6] += x1.z * w[6]; s[7] += x1.w * w[7]; }
#pragma unroll
        for (int j = 0; j < 8; ++j) s[j] = s[j] / (1.f + __expf(-s[j]));
        v4u o; o.x = pk2(s[0], s[1]); o.y = pk2(s[2], s[3]); o.z = pk2(s[4], s[5]); o.w = pk2(s[6], s[7]);
        *(LAS v4u*)(lds + ML_CX + (t * MT + c8) * 2) = o;
    }
}
__device__ __forceinline__ void phase_m1(KArgsP a, LAS unsigned char* lds, int tid, int lane, int wave, int vcu, int G, int l) {
    unsigned char* ws = a->ws; const float* GT = (const float*)(ws + WS_GATES);
    float* CLOC = (float*)(ws + WS_CLOC); float* MLG = (float*)(ws + WS_MSC); float* MLM = MLG + 4096;
    LAS float* sm = (LAS float*)(lds + ML_SM);
    for (int u = vcu; u < NUNIT_M; u += G) {
        const int h = u % NH, c = (u / NH) % NCH, b = u / (NH * NCH); const size_t row0 = (size_t)b * SEQ + c * 64;
        __syncthreads();
        ml_front(a, lds, tid, l, b, c, h, false);
        if (wave == 0) {
            const float ig = GT[(row0 + lane) * 16 + h] + a->in[I_BI][l * NH + h];
            const float fl = logsigmoidf_(GT[(row0 + lane) * 16 + 6 + h] + a->in[I_BF][l * NH + h]);
            float bc = fl;
#pragma unroll
            for (int o = 1; o < 64; o <<= 1) { const float t = __shfl_up(bc, o); if (lane >= o) bc += t; }
            const float gtot = __shfl(bc, 63); const float lw = gtot - bc + ig; const float ml = wave_max(lw);
            sm[lane] = __expf(lw - ml);
            if (lane == 0) { MLG[u] = gtot; MLM[u] = ml; }
        }
        __syncthreads();
        {
            const int rt = wave >> 1; LAS bf16* KT = (LAS bf16*)(lds + ML_K);
#pragma unroll
            for (int q = 0; q < 2; ++q) { const int ct = 2 * (wave & 1) + q; f32x4 acc = {0.f, 0.f, 0.f, 0.f};
                mma64((const LAS bf16*)(lds + ML_CX), 16 * rt, (const LAS bf16*)(lds + ML_WK), 16 * ct, lane, acc);
                const int t0 = 16 * rt + 4 * (lane >> 4), e = 16 * ct + (lane & 15);
                const float w0 = sm[t0] * 0.125f, w1 = sm[t0 + 1] * 0.125f, w2 = sm[t0 + 2] * 0.125f, w3 = sm[t0 + 3] * 0.125f;
                v2u o; o.x = pk2(acc[0] * w0, acc[1] * w1); o.y = pk2(acc[2] * w2, acc[3] * w3);
                *(LAS v2u*)(KT + e * MT + t0) = o; }
        }
        __syncthreads();
        {
            const int ct = wave & 3, r_lo = wave < 4 ? 0 : 3, r_hi = wave < 4 ? 3 : 5; float* cl = CLOC + (size_t)u * CL_STRIDE;
            for (int rt = r_lo; rt < r_hi; ++rt) { f32x4 acc = {0.f, 0.f, 0.f, 0.f};
                mma64((const LAS bf16*)(lds + ML_VT), 16 * rt, (const LAS bf16*)(lds + ML_K), 16 * ct, lane, acc);
                const int v0 = 16 * rt + 4 * (lane >> 4), e = 16 * ct + (lane & 15);
                if (rt < 4) {
#pragma unroll
                    for (int r = 0; r < 4; ++r) cl[(v0 + r) * 64 + e] = acc[r];
                } else if ((lane >> 4) == 0) cl[4096 + e] = acc[0]; }
        }
    }
}
__device__ __forceinline__ void phase_m2(unsigned char* ws, int tid, int wg, int nwg) {
    float* CLOC = (float*)(ws + WS_CLOC); const float* MLG = (const float*)(ws + WS_MSC); const float* MLM = MLG + 4096; float* MST = (float*)(ws + WS_MSC) + 8192;
    for (int idx = wg * NTHR + tid; idx < NB * NH * CL_STRIDE; idx += nwg * NTHR) {
        const int e = idx % CL_STRIDE, bh = idx / CL_STRIDE, b = bh / NH, h = bh % NH;
        float m = 0.f, cs = 0.f;
        for (int c0 = 0; c0 < NCH; c0 += 8) {
            float cl[8], g[8], ml[8];
#pragma unroll
            for (int j = 0; j < 8; ++j) { const int u = (b * NCH + c0 + j) * NH + h; cl[j] = CLOC[(size_t)u * CL_STRIDE + e]; g[j] = MLG[u]; ml[j] = MLM[u]; }
#pragma unroll
            for (int j = 0; j < 8; ++j) { const int u = (b * NCH + c0 + j) * NH + h;
                CLOC[(size_t)u * CL_STRIDE + e] = cs; if (e == 0) MST[u] = m;
                const float mn = fmaxf(g[j] + m, ml[j]); const float ao = __expf(g[j] + m - mn), al = __expf(ml[j] - mn);
                cs = ao * cs + al * cl[j]; m = mn; }
        }
    }
}
__device__ __forceinline__ void phase_m3(KArgsP a, LAS unsigned char* lds, int tid, int lane, int wave, int vcu, int G, int l) {
    unsigned char* ws = a->ws; const bf16* PROJ = (const bf16*)(ws + WS_PROJ); const float* GT = (const float*)(ws + WS_GATES);
    const float* CLOC = (const float*)(ws + WS_CLOC); const float* MST = (const float*)(ws + WS_MSC) + 8192; bf16* YC = (bf16*)(ws + WS_YC);
    LAS float* sm = (LAS float*)(lds + ML_SM); LAS float* hb = (LAS float*)(lds + ML_H);
    for (int u = vcu; u < NUNIT_M; u += G) {
        const int h = u % NH, c = (u / NH) % NCH, b = u / (NH * NCH); const size_t row0 = (size_t)b * SEQ + c * 64;
        __syncthreads();
        ml_front(a, lds, tid, l, b, c, h, true);
        {
            const float* cl = CLOC + (size_t)u * CL_STRIDE; LAS bf16* CT = (LAS bf16*)(lds + ML_CT);
            for (int idx = tid; idx < 65 * 16; idx += NTHR) { const int r = idx >> 4, c4 = idx & 15; const f32x4 v = *(const GAS f32x4*)(cl + r * 64 + c4 * 4);
                v2u o; o.x = pk2(v.x, v.y); o.y = pk2(v.z, v.w); *(LAS v2u*)(CT + r * MT + c4 * 4) = o; }
            for (int idx = tid; idx < 15 * 64; idx += NTHR) CT[(65 + (idx >> 6)) * MT + (idx & 63)] = 0;
        }
        if (wave == 0) {
            const float ig = GT[(row0 + lane) * 16 + h] + a->in[I_BI][l * NH + h];
            const float fl = logsigmoidf_(GT[(row0 + lane) * 16 + 6 + h] + a->in[I_BF][l * NH + h]);
            float bc = fl;
#pragma unroll
            for (int o = 1; o < 64; o <<= 1) { const float t = __shfl_up(bc, o); if (lane >= o) bc += t; }
            float pm = ig - bc;
#pragma unroll
            for (int o = 1; o < 64; o <<= 1) { const float t = __shfl_up(pm, o); if (lane >= o) pm = fmaxf(pm, t); }
            const float mst = MST[u]; const float inter = bc + mst, mt = fmaxf(inter, bc + pm);
            sm[lane] = ig - bc; sm[64 + lane] = bc - mt; sm[128 + lane] = __expf(inter - mt); sm[192 + lane] = __expf(-mt);
        }
        __syncthreads();
        {
            const int rt = wave >> 1; LAS bf16* Qs = (LAS bf16*)(lds + ML_Q); LAS bf16* Ks = (LAS bf16*)(lds + ML_K);
#pragma unroll
            for (int q = 0; q < 2; ++q) { const int ct = 2 * (wave & 1) + q; f32x4 aq = {0.f, 0.f, 0.f, 0.f}, ak = {0.f, 0.f, 0.f, 0.f};
                mma64((const LAS bf16*)(lds + ML_CX), 16 * rt, (const LAS bf16*)(lds + ML_WQ), 16 * ct, lane, aq);
                mma64((const LAS bf16*)(lds + ML_CX), 16 * rt, (const LAS bf16*)(lds + ML_WK), 16 * ct, lane, ak);
                const int t0 = 16 * rt + 4 * (lane >> 4), e = 16 * ct + (lane & 15);
#pragma unroll
                for (int r = 0; r < 4; ++r) { Qs[(t0 + r) * MT + e] = (bf16)f2bf(aq[r]); Ks[(t0 + r) * MT + e] = (bf16)f2bf(ak[r] * 0.125f); } }
        }
        __syncthreads();
        {
            const int rt = wave >> 1; LAS bf16* Ss = (LAS bf16*)(lds + ML_S);
#pragma unroll
            for (int q = 0; q < 2; ++q) { const int ct = 2 * (wave & 1) + q; f32x4 acc = {0.f, 0.f, 0.f, 0.f};
                if (ct <= rt) mma64((const LAS bf16*)(lds + ML_Q), 16 * rt, (const LAS bf16*)(lds + ML_K), 16 * ct, lane, acc);
                const int t0 = 16 * rt + 4 * (lane >> 4), s = 16 * ct + (lane & 15); const float qs = sm[s];
#pragma unroll
                for (int r = 0; r < 4; ++r) { const int t = t0 + r; Ss[t * MT + s] = (bf16)f2bf((s <= t) ? acc[r] * __expf(sm[64 + t] + qs) : 0.f); } }
        }
        __syncthreads();
        {
            const int rt = wave >> 1, nt = (wave & 1) ? 2 : 3;
            for (int q = 0; q < nt; ++q) { const int ct = (wave & 1) ? 2 + q : (q < 2 ? q : 4); f32x4 aA = {0.f, 0.f, 0.f, 0.f}, aB = {0.f, 0.f, 0.f, 0.f};
                mma64((const LAS bf16*)(lds + ML_Q), 16 * rt, (const LAS bf16*)(lds + ML_CT), 16 * ct, lane, aA);
                mma64((const LAS bf16*)(lds + ML_S), 16 * rt, (const LAS bf16*)(lds + ML_VT), 16 * ct, lane, aB);
                const int t0 = 16 * rt + 4 * (lane >> 4), v = 16 * ct + (lane & 15);
#pragma unroll
                for (int r = 0; r < 4; ++r) { const int t = t0 + r; const float x = sm[128 + t] * aA[r] + aB[r];
                    if (ct < 4) hb[t * 65 + v] = x; else if ((lane & 15) == 0) sm[256 + t] = x; } }
        }
        __syncthreads();
        {
            const int t = tid >> 3, vg = tid & 7; float acc[8];
            const float dn = 1.f / fmaxf(fabsf(sm[256 + t]), sm[192 + t]);
            float s1 = 0.f;
#pragma unroll
            for (int j = 0; j < 8; ++j) { acc[j] = hb[t * 65 + vg * 8 + j] * dn; s1 += acc[j]; }
            s1 += __shfl_xor(s1, 1); s1 += __shfl_xor(s1, 2); s1 += __shfl_xor(s1, 4);
            const float mu = s1 * (1.f / 64.f); float s2 = 0.f;
#pragma unroll
            for (int j = 0; j < 8; ++j) { acc[j] -= mu; s2 += acc[j] * acc[j]; }
            s2 += __shfl_xor(s2, 1); s2 += __shfl_xor(s2, 2); s2 += __shfl_xor(s2, 4);
            const float rs = rsqrtf(s2 * (1.f / 64.f) + HEAD_NORM_EPS);
            const float* nw = a->in[I_MNORM_W] + (size_t)l * DA + h * 64 + vg * 8;
            const v4u ov = *(const GAS v4u*)(PROJ + (row0 + t) * NPROJ + PC_O + h * 64 + vg * 8);
            const float o[8] = {bflo(ov.x), bfhi(ov.x), bflo(ov.y), bfhi(ov.y), bflo(ov.z), bfhi(ov.z), bflo(ov.w), bfhi(ov.w)};
            float r[8];
#pragma unroll
            for (int j = 0; j < 8; ++j) r[j] = acc[j] * rs * nw[j] * sigmoidf_(o[j]);
            v4u w; w.x = pk2(r[0], r[1]); w.y = pk2(r[2], r[3]); w.z = pk2(r[4], r[5]); w.w = pk2(r[6], r[7]);
            *(GAS v4u*)(YC + (row0 + t) * DM + h * 64 + vg * 8) = w;
        }
    }
}

constexpr int S5_UT = 264, S5_XT = 2056;
constexpr int S5_U = 0, S5_Z = 33792, S5_X = 67584;
static_assert(S5_X + 16 * S5_XT * 2 <= MISC_OFF, "S5 LDS map");
struct S5A { float are, aim, cre, cim; };
__device__ __forceinline__ S5A s5_a(KArgsP a, int l, int g, int p) {
    const float lam_re = a->in[I_S5ARE][(size_t)(l * 16 + g) * 64 + p], lam_im = a->in[I_S5AIM][(size_t)(l * 16 + g) * 64 + p];
    const float dt = expf(a->in[I_S5LDT][l * 16 + g]); const float mag = expf(lam_re * dt), ang = lam_im * dt;
    S5A r; r.are = mag * cosf(ang); r.aim = mag * sinf(ang);
    const float inv = 1.f / (lam_re * lam_re + lam_im * lam_im);
    r.cre = ((r.are - 1.f) * lam_re + r.aim * lam_im) * inv; r.cim = (r.aim * lam_re - (r.are - 1.f) * lam_im) * inv; return r;
}
__device__ __forceinline__ bf16x8 pack8(const float* v) { v4u o; o.x = pk2(v[0], v[1]); o.y = pk2(v[2], v[3]); o.z = pk2(v[4], v[5]); o.w = pk2(v[6], v[7]); return __builtin_bit_cast(bf16x8, o); }
__device__ __forceinline__ void s5_bfrag(KArgsP a, int l, int g, int lane, bf16x8 (&bf)[8]) {
#pragma unroll
    for (int j = 0; j < 8; ++j) { const int n = 16 * j + (lane & 15), p = n >> 1, im = n & 1, kq = lane >> 4; float v[8];
        if (kq < 2) { const S5A A = s5_a(a, l, g, p);
            const float* br = a->in[I_S5BRE] + ((size_t)(l * 16 + g) * 64 + p) * 16 + 8 * kq; const float* bi = a->in[I_S5BIM] + ((size_t)(l * 16 + g) * 64 + p) * 16 + 8 * kq;
#pragma unroll
            for (int q = 0; q < 8; ++q) v[q] = im ? (A.cre * bi[q] + A.cim * br[q]) : (A.cre * br[q] - A.cim * bi[q]);
        } else {
#pragma unroll
            for (int q = 0; q < 8; ++q) v[q] = 0.f; }
        bf[j] = pack8(v); }
}
__device__ __forceinline__ void s5_load_u(const unsigned char* ws, LAS unsigned char* lds, int tid, size_t row0) {
    const bf16* PROJ = (const bf16*)(ws + WS_PROJ);
    for (int idx = tid; idx < 64 * 32; idx += NTHR) { const int t = idx >> 5, c8 = idx & 31;
        *(LAS v4u*)(lds + S5_U + (t * S5_UT + c8 * 8) * 2) = *(const GAS v4u*)(PROJ + (row0 + t) * NPROJ + PC_S5 + c8 * 8); }
}
__device__ __forceinline__ void s5_block(LAS unsigned char* lds, int lane, int tb, int g, const bf16x8 (&bf)[8], float are, float aim, float& xr, float& xi) {
    const int kq = lane >> 4; bf16x8 uf = {0, 0, 0, 0, 0, 0, 0, 0};
    if (kq < 2) uf = *(const LAS bf16x8*)(lds + S5_U + ((16 * tb + (lane & 15)) * S5_UT + g * 16 + 8 * kq) * 2);
    LAS bf16* X = (LAS bf16*)(lds + S5_X);
#pragma unroll
    for (int j = 0; j < 8; ++j) { f32x4 acc = {0.f, 0.f, 0.f, 0.f}; acc = __builtin_amdgcn_mfma_f32_16x16x32_bf16(bf[j], uf, acc, 0, 0, 0);
        v2u o; o.x = pk2(acc[0], acc[1]); o.y = pk2(acc[2], acc[3]); *(LAS v2u*)(X + (lane & 15) * S5_XT + g * 128 + 16 * j + 4 * kq) = o; }
    LDS_WAIT(); asm volatile("" ::: "memory");
    LAS unsigned* xw = (LAS unsigned*)(lds + S5_X) + (g * 128 + 2 * lane) / 2;
#pragma unroll
    for (int t = 0; t < 16; ++t) { const unsigned w = xw[t * (S5_XT / 2)]; const float br = bflo(w), bi = bfhi(w);
        const float nr = are * xr - aim * xi + br, ni = are * xi + aim * xr + bi; xr = nr; xi = ni;
        xw[t * (S5_XT / 2)] = pk2(xr, xi); }
    LDS_WAIT(); asm volatile("" ::: "memory");
}
__device__ __forceinline__ void phase_s1(KArgsP a, LAS unsigned char* lds, int tid, int lane, int wave, int vcu, int G, int l) {
    unsigned char* ws = a->ws; float* ST = (float*)(ws + WS_S5ST);
    bf16x8 bf0[8], bf1[8]; s5_bfrag(a, l, wave, lane, bf0); s5_bfrag(a, l, wave + 8, lane, bf1);
    const S5A A0 = s5_a(a, l, wave, lane), A1 = s5_a(a, l, wave + 8, lane);
    for (int u = vcu; u < NB * NCH; u += G) {
        const size_t row0 = (size_t)u * 64;
        __syncthreads();
        s5_load_u(ws, lds, tid, row0);
        __syncthreads();
        float x0r = 0.f, x0i = 0.f, x1r = 0.f, x1i = 0.f;
        for (int tb = 0; tb < 4; ++tb) { s5_block(lds, lane, tb, wave, bf0, A0.are, A0.aim, x0r, x0i); s5_block(lds, lane, tb, wave + 8, bf1, A1.are, A1.aim, x1r, x1i); }
        *(f32x2*)(ST + (((size_t)u * 16 + wave) * 64 + lane) * 2) = (f32x2){x0r, x0i};
        *(f32x2*)(ST + (((size_t)u * 16 + wave + 8) * 64 + lane) * 2) = (f32x2){x1r, x1i};
    }
}
__device__ __forceinline__ void phase_s2(KArgsP a, int tid, int wg, int nwg, int l) {
    float* ST = (float*)(a->ws + WS_S5ST);
    for (int idx = wg * NTHR + tid; idx < NB * 1024; idx += nwg * NTHR) {
        const int b = idx >> 10, gp = idx & 1023, g = gp >> 6, p = gp & 63;
        const S5A A = s5_a(a, l, g, p); float ar = A.are, ai = A.aim;
#pragma unroll
        for (int s = 0; s < 6; ++s) { const float nr = ar * ar - ai * ai, ni = 2.f * ar * ai; ar = nr; ai = ni; }
        float cr = 0.f, ci = 0.f;
        for (int c0 = 0; c0 < NCH; c0 += 8) {
            f32x2 e[8];
#pragma unroll
            for (int j = 0; j < 8; ++j) e[j] = *(const f32x2*)(ST + (((size_t)(b * NCH + c0 + j) * 16 + g) * 64 + p) * 2);
#pragma unroll
            for (int j = 0; j < 8; ++j) { *(f32x2*)(ST + (((size_t)(b * NCH + c0 + j) * 16 + g) * 64 + p) * 2) = (f32x2){cr, ci};
                const float nr = ar * cr - ai * ci + e[j].x, ni = ar * ci + ai * cr + e[j].y; cr = nr; ci = ni; }
        }
    }
}
__device__ __forceinline__ float gelu_tanh_(float x) { const float t = tanhf(0.7978845608f * (x + 0.044715f * x * x * x)); return 0.5f * x * (1.f + t); }
__device__ __forceinline__ void s5_cproj(LAS unsigned char* lds, int lane, int tb, int g, const bf16* cmt  , const float (&dv)[4]) {
    const int kq = lane >> 4; f32x4 acc = {0.f, 0.f, 0.f, 0.f};
    bf16x8 cf[4];
#pragma unroll
    for (int s = 0; s < 4; ++s) cf[s] = __builtin_bit_cast(bf16x8, *(const GAS v4u*)(cmt + (lane & 15) * 128 + 32 * s + 8 * kq));
    const LAS bf16* xp = (const LAS bf16*)(lds + S5_X) + (lane & 15) * S5_XT + g * 128 + 8 * kq;
#pragma unroll
    for (int s = 0; s < 4; ++s) acc = __builtin_amdgcn_mfma_f32_16x16x32_bf16(cf[s], *(const LAS bf16x8*)(xp + 32 * s), acc, 0, 0, 0);
    const int t = 16 * tb + (lane & 15), c0 = g * 16 + 4 * kq;
    const v2u uw = *(const LAS v2u*)(lds + S5_U + (t * S5_UT + c0) * 2);
    const float u4[4] = {bflo(uw.x), bfhi(uw.x), bflo(uw.y), bfhi(uw.y)}; float z[4];
#pragma unroll
    for (int r = 0; r < 4; ++r) z[r] = gelu_tanh_(acc[r] + dv[r] * u4[r]);
    v2u o; o.x = pk2(z[0], z[1]); o.y = pk2(z[2], z[3]); *(LAS v2u*)(lds + S5_Z + (t * S5_UT + c0) * 2) = o;
}
__device__ __forceinline__ void phase_s3(KArgsP a, LAS unsigned char* lds, int tid, int lane, int wave, int vcu, int G, int l) {
    unsigned char* ws = a->ws; const float* ST = (const float*)(ws + WS_S5ST); bf16* YC = (bf16*)(ws + WS_YC);
    const bf16* GLUT = (const bf16*)(ws + WS_GLUT) + (size_t)l * DC * DC;
    bf16x8 bf0[8], bf1[8]; s5_bfrag(a, l, wave, lane, bf0); s5_bfrag(a, l, wave + 8, lane, bf1);
    const bf16* cm0 = (const bf16*)(ws + WS_S5CM) + (size_t)(l * 16 + wave) * 2048; const bf16* cm1 = cm0 + 8 * 2048;
    const S5A A0 = s5_a(a, l, wave, lane), A1 = s5_a(a, l, wave + 8, lane);
    float d0[4], d1[4];
#pragma unroll
    for (int r = 0; r < 4; ++r) { d0[r] = a->in[I_S5D][l * DC + wave * 16 + 4 * (lane >> 4) + r]; d1[r] = a->in[I_S5D][l * DC + (wave + 8) * 16 + 4 * (lane >> 4) + r]; }
    for (int u = vcu; u < NB * NCH; u += G) {
        const size_t row0 = (size_t)u * 64;
        __syncthreads();
        s5_load_u(ws, lds, tid, row0);
        const f32x2 s0 = *(const f32x2*)(ST + (((size_t)u * 16 + wave) * 64 + lane) * 2), s1 = *(const f32x2*)(ST + (((size_t)u * 16 + wave + 8) * 64 + lane) * 2);
        float x0r = s0.x, x0i = s0.y, x1r = s1.x, x1i = s1.y;
        __syncthreads();
        for (int tb = 0; tb < 4; ++tb) {
            s5_block(lds, lane, tb, wave, bf0, A0.are, A0.aim, x0r, x0i); s5_cproj(lds, lane, tb, wave, cm0, d0);
            s5_block(lds, lane, tb, wave + 8, bf1, A1.are, A1.aim, x1r, x1i); s5_cproj(lds, lane, tb, wave + 8, cm1, d1);
        }
        __syncthreads();
        {
            const int kq = lane >> 4;
#pragma unroll
            for (int q = 0; q < 2; ++q) { const int ct = 2 * wave + q; f32x4 acc[4];
#pragma unroll
                for (int rt = 0; rt < 4; ++rt) acc[rt] = (f32x4){0.f, 0.f, 0.f, 0.f};
                const bf16* gp = GLUT + (size_t)(16 * ct + (lane & 15)) * DC + 8 * kq;
#pragma unroll 2
                for (int s = 0; s < 8; ++s) { const bf16x8 gf = __builtin_bit_cast(bf16x8, *(const GAS v4u*)(gp + 32 * s));
#pragma unroll
                    for (int rt = 0; rt < 4; ++rt) acc[rt] = __builtin_amdgcn_mfma_f32_16x16x32_bf16(gf, *(const LAS bf16x8*)(lds + S5_Z + ((16 * rt + (lane & 15)) * S5_UT + 32 * s + 8 * kq) * 2), acc[rt], 0, 0, 0); }
                const int j0 = 16 * ct + 4 * kq; const f32x4 gb = *(const GAS f32x4*)(a->in[I_S5GLUB] + l * DC + j0);
#pragma unroll
                for (int rt = 0; rt < 4; ++rt) { const int t = 16 * rt + (lane & 15); const v2u zw = *(const LAS v2u*)(lds + S5_Z + (t * S5_UT + j0) * 2);
                    const float z0 = bflo(zw.x), z1 = bfhi(zw.x), z2 = bflo(zw.y), z3 = bfhi(zw.y);
                    v2u o; o.x = pk2(z0 * sigmoidf_(acc[rt][0] + gb.x), z1 * sigmoidf_(acc[rt][1] + gb.y)); o.y = pk2(z2 * sigmoidf_(acc[rt][2] + gb.z), z3 * sigmoidf_(acc[rt][3] + gb.w));
                    *(GAS v2u*)(YC + (row0 + t) * DM + 768 + j0) = o; } }
        }
    }
}

__device__ __forceinline__ float rw_shift(const bf16* PROJ, const float* mu, size_t row, int col) {
    const float cur = bf2f(PROJ[row * NPROJ + PC_RW + col]); const float prv = (row % SEQ) ? bf2f(PROJ[(row - 1) * NPROJ + PC_RW + col]) : 0.f;
    return cur + mu[col] * (prv - cur);
}
constexpr int R1_TH = 0, R1_AD = 9216, R1_SG = 18432, R1_VS = 35840, R1_TMP = 86016;
template <int KS, int MODE>
__device__ __forceinline__ void r1_prod(const bf16* WT, const LAS bf16* act, int astride, const float* bias, bf16* OUT, size_t row0, int lane, int wave) {
    const int kq = lane >> 4, n0 = 48 * wave; constexpr int K = 32 * KS;
    f32x4 acc[3][4];
#pragma unroll
    for (int nt = 0; nt < 3; ++nt)
#pragma unroll
        for (int ti = 0; ti < 4; ++ti) acc[nt][ti] = (f32x4){0.f, 0.f, 0.f, 0.f};
#pragma unroll
    for (int s = 0; s < KS; ++s) { bf16x8 wf[3], af[4];
#pragma unroll
        for (int nt = 0; nt < 3; ++nt) wf[nt] = __builtin_bit_cast(bf16x8, *(const GAS v4u*)(WT + (size_t)(n0 + 16 * nt + (lane & 15)) * K + 32 * s + 8 * kq));
#pragma unroll
        for (int ti = 0; ti < 4; ++ti) af[ti] = *(const LAS bf16x8*)(act + (16 * ti + (lane & 15)) * astride + 32 * s + 8 * kq);
#pragma unroll
        for (int nt = 0; nt < 3; ++nt)
#pragma unroll
            for (int ti = 0; ti < 4; ++ti) acc[nt][ti] = __builtin_amdgcn_mfma_f32_16x16x32_bf16(wf[nt], af[ti], acc[nt][ti], 0, 0, 0); }
#pragma unroll
    for (int nt = 0; nt < 3; ++nt) { const int n = n0 + 16 * nt + 4 * kq; f32x4 bv = {0.f, 0.f, 0.f, 0.f}; if (MODE != 2) bv = *(const GAS f32x4*)(bias + n);
#pragma unroll
        for (int ti = 0; ti < 4; ++ti) { float o[4];
#pragma unroll
            for (int r = 0; r < 4; ++r) { const float x = acc[nt][ti][r] + bv[r]; o[r] = MODE == 0 ? 0.60653066f * sigmoidf_(x) : (MODE == 1 ? sigmoidf_(x) : x); }
            v2u w; w.x = pk2(o[0], o[1]); w.y = pk2(o[2], o[3]);
            *(GAS v2u*)(OUT + (row0 + 16 * ti + (lane & 15)) * DBR + n) = w; } }
}
__device__ __forceinline__ void phase_r1(KArgsP a, LAS unsigned char* lds, int tid, int lane, int wave, int vcu, int G, int l) {
    unsigned char* ws = a->ws; const bf16* PROJ = (const bf16*)(ws + WS_PROJ); const float* mu = a->in[I_RMU] + (size_t)l * RW_COLS;
    const bf16* W1 = (const bf16*)(ws + WS_R1W) + (size_t)l * 98304;
    const bf16* WV = (const bf16*)(ws + WS_R1W) + 2 * 98304;
    for (int u = vcu; u < NTOK / 64; u += G) {
        const size_t row0 = (size_t)u * 64;
        __syncthreads();
        for (int idx = tid; idx < 64 * 128; idx += NTHR) { const int tt = idx >> 7, col = 2 * (idx & 127); const size_t r = row0 + tt;
            const unsigned cw = *(const GAS unsigned*)(PROJ + r * NPROJ + PC_RW + RWC_WD + col); const unsigned pw = (r % SEQ) ? *(const GAS unsigned*)(PROJ + (r - 1) * NPROJ + PC_RW + RWC_WD + col) : 0u;
            const float c0 = bflo(cw), c1 = bfhi(cw); const float x0 = c0 + mu[RWC_WD + col] * (bflo(pw) - c0), x1 = c1 + mu[RWC_WD + col + 1] * (bfhi(pw) - c1);
            if (col < 64) *(LAS unsigned*)(lds + R1_TH + (tt * 72 + col) * 2) = pk2(tanhf(x0), tanhf(x1));
            else if (col < 128) *(LAS unsigned*)(lds + R1_AD + (tt * 72 + col - 64) * 2) = pk2(x0, x1);
            else *(LAS unsigned*)(lds + R1_SG + (tt * 136 + col - 128) * 2) = pk2(sigmoidf_(x0), sigmoidf_(x1)); }
        if (l > 0) for (int idx = tid; idx < 64 * 192; idx += NTHR) { const int tt = idx / 192, col = 2 * (idx % 192); const size_t r = row0 + tt;
            const unsigned cw = *(const GAS unsigned*)(PROJ + r * NPROJ + PC_RW + RWC_V + col); const unsigned pw = (r % SEQ) ? *(const GAS unsigned*)(PROJ + (r - 1) * NPROJ + PC_RW + RWC_V + col) : 0u;
            const float c0 = bflo(cw), c1 = bfhi(cw);
            *(LAS unsigned*)(lds + R1_VS + (tt * 392 + col) * 2) = pk2(c0 + mu[RWC_V + col] * (bflo(pw) - c0), c1 + mu[RWC_V + col + 1] * (bfhi(pw) - c1)); }
        __syncthreads();
        r1_prod<2, 0>(W1, (const LAS bf16*)(lds + R1_TH), 72, a->in[I_RW0] + l * DBR, (bf16*)(ws + WS_RE), row0, lane, wave);
        r1_prod<2, 1>(W1 + 24576, (const LAS bf16*)(lds + R1_AD), 72, a->in[I_RA0] + l * DBR, (bf16*)(ws + WS_RA), row0, lane, wave);
        r1_prod<4, 2>(W1 + 49152, (const LAS bf16*)(lds + R1_SG), 136, nullptr, (bf16*)(ws + WS_RG), row0, lane, wave);
        if (l > 0) {
            { const int kq = lane >> 4, mt = wave & 1, ti = wave >> 1; f32x4 acc = {0.f, 0.f, 0.f, 0.f};
#pragma unroll 4
              for (int s = 0; s < 12; ++s) acc = __builtin_amdgcn_mfma_f32_16x16x32_bf16(__builtin_bit_cast(bf16x8, *(const GAS v4u*)(WV + (size_t)(16 * mt + (lane & 15)) * 384 + 32 * s + 8 * kq)),
                                                                                          *(const LAS bf16x8*)(lds + R1_VS + ((16 * ti + (lane & 15)) * 392 + 32 * s + 8 * kq) * 2), acc, 0, 0, 0);
              v2u w; w.x = pk2(acc[0], acc[1]); w.y = pk2(acc[2], acc[3]); *(LAS v2u*)(lds + R1_TMP + ((16 * ti + (lane & 15)) * 40 + 16 * mt + 4 * kq) * 2) = w; }
            __syncthreads();
            r1_prod<1, 1>(WV + 12288, (const LAS bf16*)(lds + R1_TMP), 40, a->in[I_RV0], (bf16*)(ws + WS_RVG), row0, lane, wave);
        }
    }
}
__device__ __forceinline__ float dpp_allsum(float x) {
    x += __builtin_bit_cast(float, __builtin_amdgcn_update_dpp(0, __builtin_bit_cast(int, x), 0x128, 0xf, 0xf, false));
    x += __builtin_bit_cast(float, __builtin_amdgcn_update_dpp(0, __builtin_bit_cast(int, x), 0x124, 0xf, 0xf, false));
    x += __builtin_bit_cast(float, __builtin_amdgcn_update_dpp(0, __builtin_bit_cast(int, x), 0x122, 0xf, 0xf, false));
    x += __builtin_bit_cast(float, __builtin_amdgcn_update_dpp(0, __builtin_bit_cast(int, x), 0x121, 0xf, 0xf, false));
    { const unsigned xi = __builtin_bit_cast(unsigned, x); auto r = __builtin_amdgcn_permlane16_swap(xi, xi, false, false); const unsigned r0 = r[0], r1 = r[1]; x = __uint_as_float(r0) + __uint_as_float(r1); }
    { const unsigned xi = __builtin_bit_cast(unsigned, x); auto r = __builtin_amdgcn_permlane32_swap(xi, xi, false, false); const unsigned r0 = r[0], r1 = r[1]; x = __uint_as_float(r0) + __uint_as_float(r1); }
    return x;
}

constexpr int RC_EF = 0, RC_ATF = 4096, RC_QF = 8448, RC_PFT = 9472, RC_AT = 10496, RC_RT = 12800, RC_BH = 15104, RC_KH = 17408, RC_AH = 19712, RC_BTT = 22016, RC_KTT = 25088, RC_VS = 28160,
              RC_PRL = 31232, RC_QRL = 32000, RC_TQL = 32768, RC_G15 = 33536, RC_CH = 33792;
struct RCRegs { v2u r0, r1, k0, k1, aa, ee, v0, v1, vg, vf; };
__device__ __forceinline__ void rc_issue(const unsigned char* ws, int l, size_t row, int h, int tid, RCRegs& R) {
    const bf16* PROJ = (const bf16*)(ws + WS_PROJ); const int tt = tid >> 4, c0 = h * 64 + 4 * (tid & 15); const size_t r = row + tt; const bool first = (r % SEQ) == 0; const size_t rp = first ? r : r - 1;
    R.r0 = *(const GAS v2u*)(PROJ + r * NPROJ + PC_RW + RWC_R + c0); R.r1 = *(const GAS v2u*)(PROJ + rp * NPROJ + PC_RW + RWC_R + c0);
    R.k0 = *(const GAS v2u*)(PROJ + r * NPROJ + PC_RW + RWC_K + c0); R.k1 = *(const GAS v2u*)(PROJ + rp * NPROJ + PC_RW + RWC_K + c0);
    R.v0 = *(const GAS v2u*)(PROJ + r * NPROJ + PC_RW + RWC_V + c0); R.v1 = *(const GAS v2u*)(PROJ + rp * NPROJ + PC_RW + RWC_V + c0);
    R.aa = *(const GAS v2u*)((const bf16*)(ws + WS_RA) + r * DBR + c0); R.ee = *(const GAS v2u*)((const bf16*)(ws + WS_RE) + r * DBR + c0);
    if (l > 0) { R.vg = *(const GAS v2u*)((const bf16*)(ws + WS_RVG) + r * DBR + c0); R.vf = *(const GAS v2u*)((const bf16*)(ws + WS_VF) + r * DBR + c0); }
    if (first) { R.r1 = (v2u){0u, 0u}; R.k1 = (v2u){0u, 0u}; R.v1 = (v2u){0u, 0u}; }
}
__device__ __forceinline__ void unpack4(const v2u p, float (&o)[4]) { o[0] = bflo(p.x); o[1] = bfhi(p.x); o[2] = bflo(p.y); o[3] = bfhi(p.y); }
__device__ __forceinline__ v2u pack4(const float (&v)[4]) { v2u o; o.x = pk2(v[0], v[1]); o.y = pk2(v[2], v[3]); return o; }
__device__ __forceinline__ v2u pack4v(const f32x4 v) { v2u o; o.x = pk2(v[0], v[1]); o.y = pk2(v[2], v[3]); return o; }
__device__ __forceinline__ bf16x8 cat8(const v2u a, const v2u b) { v4u o; o.x = a.x; o.y = a.y; o.z = b.x; o.w = b.y; return __builtin_bit_cast(bf16x8, o); }
#define RC_BAR() asm volatile("s_waitcnt lgkmcnt(0)\n\ts_barrier" ::: "memory")

constexpr int REC_BYTES = 12288, REC_UNITS = 752;
__device__ __forceinline__ unsigned char* rc_rec(unsigned char* ws, size_t cu) { return cu < 8192 ? ws + WS_OPA + cu * REC_BYTES : ws + WS_OPB + (cu - 8192) * REC_BYTES; }
template <int OAH, int ORT, int OBT, int OKT, int OVS, int OPR, int OQR, int OTQ, int OG>
__device__ __forceinline__ int rc_unit_off(int u) {
    if (u < 128) return OAH + (u >> 3) * 144 + (u & 7) * 16;
    if (u < 256) return ORT + ((u - 128) >> 3) * 144 + (u & 7) * 16;
    if (u < 384) return OBT + ((u - 256) >> 1) * 48 + (u & 1) * 16;
    if (u < 512) return OKT + ((u - 384) >> 1) * 48 + (u & 1) * 16;
    if (u < 640) return OVS + ((u - 512) >> 1) * 48 + (u & 1) * 16;
    if (u < 672) return OPR + ((u - 640) >> 1) * 48 + (u & 1) * 16;
    if (u < 704) return OQR + ((u - 672) >> 1) * 48 + (u & 1) * 16;
    if (u < 736) return OTQ + ((u - 704) >> 1) * 48 + (u & 1) * 16;
    return OG + (u - 736) * 16;
}
__device__ __forceinline__ void rc_copy_out(unsigned char* rec, const LAS unsigned char* wb, int u) {
#pragma unroll
    for (int q = 0; q < 3; ++q) { const int uu = u + 256 * q; if (uu < REC_UNITS) *(GAS v4u*)(rec + uu * 16) = *(const LAS v4u*)(wb + rc_unit_off<RC_AH, RC_RT, RC_BTT, RC_KTT, RC_VS, RC_PRL, RC_QRL, RC_TQL, RC_G15>(uu)); }
}
constexpr int RS_RT = 0, RS_AH = 2304, RS_BTT = 4608, RS_KTT = 7680, RS_VS = 10752, RS_PRL = 13824, RS_QRL = 14592, RS_TQL = 15360, RS_G15 = 16128, RS_CH = 16384;
#define RC_BUILD(RUSE, q) do { const int bh_ = (q) >> 8, b = bh_ / NH, h = bh_ % NH, blk_ = (q) & 255, c0 = h * 64 + 4 * kq; const size_t row0 = (size_t)b * SEQ + (size_t)blk_ * 32; \
        float kkw[4], kaw[4], mur[4], muk[4], muv[4]; \
_Pragma("unroll") \
        for (int j = 0; j < 4; ++j) { kkw[j] = a->in[I_RKK][(size_t)l * DBR + c0 + j]; kaw[j] = a->in[I_RKA][(size_t)l * DBR + c0 + j]; mur[j] = mu[RWC_R + c0 + j]; muk[j] = mu[RWC_K + c0 + j]; muv[j] = mu[RWC_V + c0 + j]; } \
        float an[4], bk[4], km[4], rs[4], ev[4]; \
        {   const RCRegs& R = RUSE; \
            float rc[4], rp[4], kc[4], kp[4], av[4], vc[4], vp[4], ks[4], kk[4], vs[4]; unpack4(R.r0, rc); unpack4(R.r1, rp); unpack4(R.k0, kc); unpack4(R.k1, kp); unpack4(R.aa, av); unpack4(R.ee, ev); unpack4(R.v0, vc); unpack4(R.v1, vp); \
            float ss = 0.f; \
_Pragma("unroll") \
            for (int j = 0; j < 4; ++j) { rs[j] = rc[j] + mur[j] * (rp[j] - rc[j]); ks[j] = kc[j] + muk[j] * (kp[j] - kc[j]); kk[j] = ks[j] * kkw[j]; ss += kk[j] * kk[j]; vs[j] = vc[j] + muv[j] * (vp[j] - vc[j]); } \
            ss += __shfl_xor(ss, 1); ss += __shfl_xor(ss, 2); ss += __shfl_xor(ss, 4); ss += __shfl_xor(ss, 8); \
            const float inv = 1.f / fmaxf(sqrtf(ss), 1e-12f); \
_Pragma("unroll") \
            for (int j = 0; j < 4; ++j) { const float kn = kk[j] * inv; an[j] = -kn; bk[j] = kn * av[j]; km[j] = ks[j] * (1.f + (av[j] - 1.f) * kaw[j]); } \
            if (l == 0) *(GAS v2u*)((bf16*)(ws + WS_VF) + (row0 + tt) * DBR + c0) = pack4(vs); \
            else { float g[4], f[4]; unpack4(R.vg, g); unpack4(R.vf, f); \
_Pragma("unroll") \
                for (int j = 0; j < 4; ++j) vs[j] = vs[j] + (f[j] - vs[j]) * g[j]; } \
            *(LAS f32x4*)(cb + RC_EF + (t * 64 + 4 * kq) * 4) = (f32x4){ev[0], ev[1], ev[2], ev[3]}; \
_Pragma("unroll") \
            for (int j = 0; j < 4; ++j) *(LAS bf16*)(cb + RC_VS + ((4 * kq + j) * 24 + t) * 2) = (bf16)f2bf(vs[j]); \
        } \
        if ((q) + 2 * G < NQ) rc_issue(ws, l, (size_t)(((q) + 2 * G) >> 8) / NH * SEQ + (size_t)(((q) + 2 * G) & 255) * 32, (((q) + 2 * G) >> 8) % NH, tid, RUSE); \
        RC_BAR(); \
        {   f32x4 inc = {0.f, 0.f, 0.f, 0.f}, tot = inc; \
_Pragma("unroll") \
            for (int i = 0; i < 16; ++i) { const f32x4 ei = *(const LAS f32x4*)(cb + RC_EF + (i * 64 + 4 * kq) * 4); tot = tot + ei; if (i <= t) inc = inc + ei; } \
            float At[4], Rt[4], Bh[4], Kh[4], Bt[4], Kt[4], Gt[4]; \
_Pragma("unroll") \
            for (int j = 0; j < 4; ++j) { const float Gi = __expf(-inc[j]), Ge = __expf(ev[j] - inc[j]), Gn = __expf(inc[j]); Gt[j] = __expf(-tot[j]); \
                At[j] = an[j] * Ge; Rt[j] = rs[j] * Gi; Bh[j] = bk[j] * Gn; Kh[j] = km[j] * Gn; Bt[j] = Bh[j] * Gt[j]; Kt[j] = Kh[j] * Gt[j]; } \
            *(LAS f32x4*)(cb + RC_ATF + (t * 68 + 4 * kq) * 4) = (f32x4){At[0], At[1], At[2], At[3]}; \
            *(LAS v2u*)(cb + RC_AT + (t * 72 + 4 * kq) * 2) = pack4(At); *(LAS v2u*)(cb + RC_RT + (t * 72 + 4 * kq) * 2) = pack4(Rt); \
            *(LAS v2u*)(cb + RC_BH + (t * 72 + 4 * kq) * 2) = pack4(Bh); *(LAS v2u*)(cb + RC_KH + (t * 72 + 4 * kq) * 2) = pack4(Kh); \
_Pragma("unroll") \
            for (int j = 0; j < 4; ++j) { *(LAS bf16*)(cb + RC_BTT + ((4 * kq + j) * 24 + t) * 2) = (bf16)f2bf(Bt[j]); *(LAS bf16*)(cb + RC_KTT + ((4 * kq + j) * 24 + t) * 2) = (bf16)f2bf(Kt[j]); } \
            if (t == 0) *(LAS f32x4*)(cb + RC_G15 + 4 * kq * 4) = (f32x4){Gt[0], Gt[1], Gt[2], Gt[3]}; \
        } \
        RC_BAR(); \
        {   LAS unsigned char* wb = lds + (wave >> 2) * RC_CH; const int pi = wave & 3; \
            const LAS bf16* Ap = (const LAS bf16*)(wb + (pi < 2 ? RC_AT : RC_RT)) + li * 72 + 8 * lq; const LAS bf16* Bp = (const LAS bf16*)(wb + ((pi & 1) ? RC_KH : RC_BH)) + li * 72 + 8 * lq; \
            f32x4 acc = {0.f, 0.f, 0.f, 0.f}; \
            acc = __builtin_amdgcn_mfma_f32_16x16x32_bf16(*(const LAS bf16x8*)Ap, *(const LAS bf16x8*)Bp, acc, 0, 0, 0); \
            acc = __builtin_amdgcn_mfma_f32_16x16x32_bf16(*(const LAS bf16x8*)(Ap + 32), *(const LAS bf16x8*)(Bp + 32), acc, 0, 0, 0); \
_Pragma("unroll") \
            for (int r = 0; r < 4; ++r) { const int tr = 4 * lq + r; if (pi < 2 ? !(li < tr) : !(li <= tr)) acc[r] = 0.f; } \
            if (pi == 0) *(LAS f32x4*)(wb + RC_PFT + (li * 16 + 4 * lq) * 4) = acc; \
            else if (pi == 1) { \
_Pragma("unroll") \
                for (int r = 0; r < 4; ++r) *(LAS float*)(wb + RC_QF + ((4 * lq + r) * 16 + li) * 4) = acc[r]; } \
            else { LAS bf16* o = (LAS bf16*)(wb + (pi == 2 ? RC_PRL : RC_QRL)); \
_Pragma("unroll") \
                for (int r = 0; r < 4; ++r) o[(4 * lq + r) * 24 + li] = (bf16)f2bf(acc[r]); } \
        } \
        RC_BAR(); \
        if (wave < 4) { \
            LAS unsigned char* wb = lds + (wave >> 1) * RC_CH; const bool isq = wave & 1; \
            float X[16]; \
_Pragma("unroll") \
            for (int r = 0; r < 16; ++r) X[r] = isq ? *(const LAS float*)(wb + RC_QF + (r * 16 + li) * 4) : *(const LAS float*)(wb + RC_ATF + (r * 68 + lane) * 4); \
_Pragma("unroll") \
            for (int j = 0; j < 15; ++j) { const LAS f32x4* pc = (const LAS f32x4*)(wb + RC_PFT + j * 64); const f32x4 c0v = pc[0], c1v = pc[1], c2v = pc[2], c3v = pc[3]; \
                const float c[16] = {c0v[0], c0v[1], c0v[2], c0v[3], c1v[0], c1v[1], c1v[2], c1v[3], c2v[0], c2v[1], c2v[2], c2v[3], c3v[0], c3v[1], c3v[2], c3v[3]}; \
_Pragma("unroll") \
                for (int r = j + 1; r < 16; ++r) X[r] = fmaf(c[r], X[j], X[r]); } \
            if (!isq) { LAS bf16* o = (LAS bf16*)(wb + RC_AH); \
_Pragma("unroll") \
                for (int r = 0; r < 16; ++r) o[r * 72 + lane] = (bf16)f2bf(X[r]); } \
            else if (lane < 16) { LAS bf16* o = (LAS bf16*)(wb + RC_TQL); \
_Pragma("unroll") \
                for (int r = 0; r < 16; ++r) o[r * 24 + lane] = (bf16)f2bf(X[r]); } \
        } \
        RC_BAR(); \
        { const int cc = tid >> 8, u = tid & 255; unsigned char* rec = rc_rec(ws, (size_t)bh_ * 512 + 2 * blk_ + cc); const LAS unsigned char* wb = lds + cc * RC_CH; \
          rc_copy_out(rec, wb, u); } \
        RC_BAR(); \
    } while (0)
#define RC_SCAN(slot, row0) do { \
        if (wave < 4) { \
_Pragma("unroll") \
            for (int cc = 0; cc < 2; ++cc) { \
                LAS unsigned char* wb = slot + cc * RS_CH; const v2u z2 = {0u, 0u}; \
                const v2u Vb = *(const LAS v2u*)(wb + RS_VS + ((16 * wave + li) * 24 + 4 * lq) * 2); \
                const LAS bf16* ah = (const LAS bf16*)(wb + RS_AH) + li * 72 + 4 * lq; const LAS bf16* rt = (const LAS bf16*)(wb + RS_RT) + li * 72 + 4 * lq; \
                f32x4 aD = {0.f, 0.f, 0.f, 0.f}, aY = {0.f, 0.f, 0.f, 0.f}; \
                aD = __builtin_amdgcn_mfma_f32_16x16x32_bf16(cat8(*(const LAS v2u*)ah, *(const LAS v2u*)(ah + 16)), Sb01, aD, 0, 0, 0); \
                aD = __builtin_amdgcn_mfma_f32_16x16x32_bf16(cat8(*(const LAS v2u*)(ah + 32), *(const LAS v2u*)(ah + 48)), Sb23, aD, 0, 0, 0); \
                aD = __builtin_amdgcn_mfma_f32_16x16x32_bf16(cat8(*(const LAS v2u*)(wb + RS_TQL + (li * 24 + 4 * lq) * 2), z2), cat8(Vb, z2), aD, 0, 0, 0); \
                aY = __builtin_amdgcn_mfma_f32_16x16x32_bf16(cat8(*(const LAS v2u*)rt, *(const LAS v2u*)(rt + 16)), Sb01, aY, 0, 0, 0); \
                aY = __builtin_amdgcn_mfma_f32_16x16x32_bf16(cat8(*(const LAS v2u*)(rt + 32), *(const LAS v2u*)(rt + 48)), Sb23, aY, 0, 0, 0); \
                const bf16x8 DV = cat8(pack4v(aD), Vb); \
                aY = __builtin_amdgcn_mfma_f32_16x16x32_bf16(cat8(*(const LAS v2u*)(wb + RS_PRL + (li * 24 + 4 * lq) * 2), *(const LAS v2u*)(wb + RS_QRL + (li * 24 + 4 * lq) * 2)), DV, aY, 0, 0, 0); \
_Pragma("unroll") \
                for (int kt = 0; kt < 4; ++kt) { const f32x4 g4 = *(const LAS f32x4*)(wb + RS_G15 + (16 * kt + 4 * lq) * 4); \
                    Sacc[kt] = __builtin_amdgcn_mfma_f32_16x16x32_bf16(cat8(*(const LAS v2u*)(wb + RS_BTT + ((16 * kt + li) * 24 + 4 * lq) * 2), *(const LAS v2u*)(wb + RS_KTT + ((16 * kt + li) * 24 + 4 * lq) * 2)), DV, Sacc[kt] * g4, 0, 0, 0); } \
                Sb01 = cat8(pack4v(Sacc[0]), pack4v(Sacc[1])); Sb23 = cat8(pack4v(Sacc[2]), pack4v(Sacc[3])); \
_Pragma("unroll") \
                for (int r = 0; r < 4; ++r) YC[(row0 + cc * 16 + 4 * lq + r) * DM + 384 + h * 64 + 16 * wave + li] = (bf16)f2bf(aY[r]); \
            } \
        } \
    } while (0)

__device__ __forceinline__ void phase_r2_build(KArgsP a, LAS unsigned char* lds, int tid, int lane, int wave, int vcu, int G, int l) {
    unsigned char* ws = a->ws;
    const int tt = tid >> 4, kq = tid & 15, ch = tt >> 4, t = tt & 15;
    const int lq = lane >> 4, li = lane & 15;
    LAS unsigned char* cb = lds + ch * RC_CH;
    const float* mu = a->in[I_RMU] + (size_t)l * RW_COLS;
    constexpr int NQ = NB * NH * 256;
    RCRegs RA, RB;
    if (vcu < NQ) rc_issue(ws, l, (size_t)(vcu >> 8) / NH * SEQ + (size_t)(vcu & 255) * 32, (vcu >> 8) % NH, tid, RA);
    if (vcu + G < NQ) rc_issue(ws, l, (size_t)((vcu + G) >> 8) / NH * SEQ + (size_t)((vcu + G) & 255) * 32, ((vcu + G) >> 8) % NH, tid, RB);
    for (int q0 = vcu; q0 < NQ; q0 += 2 * G) { { const int q = q0; RC_BUILD(RA, q); } if (q0 + G < NQ) { const int q = q0 + G; RC_BUILD(RB, q); } }
}
struct RSRegs { v4u p[6]; };
__device__ __forceinline__ void rs_issue(unsigned char* ws, size_t cu0, int lt, RSRegs& R) {
#pragma unroll
    for (int j = 0; j < 6; ++j) { const int uu = lt + 256 * j; if (uu < 2 * REC_UNITS) { const int cc = uu >= REC_UNITS, u = uu - cc * REC_UNITS; R.p[j] = *(const GAS v4u*)(rc_rec(ws, cu0 + cc) + u * 16); } }
}
__device__ __forceinline__ void rs_store(LAS unsigned char* slot, int lt, const RSRegs& R) {
#pragma unroll
    for (int j = 0; j < 6; ++j) { const int uu = lt + 256 * j; if (uu < 2 * REC_UNITS) { const int cc = uu >= REC_UNITS, u = uu - cc * REC_UNITS;
        *(LAS v4u*)(slot + cc * RS_CH + rc_unit_off<RS_AH, RS_RT, RS_BTT, RS_KTT, RS_VS, RS_PRL, RS_QRL, RS_TQL, RS_G15>(u)) = R.p[j]; } }
}
__device__ __forceinline__ void phase_r2_scan(KArgsP a, LAS unsigned char* lds, int tid, int lane, int wave, int wg, int l) {
    unsigned char* ws = a->ws; bf16* YC = (bf16*)(ws + WS_YC);
    const int b = wg / NH, h = wg % NH; const size_t rowb = (size_t)b * SEQ, cub = (size_t)wg * 512;
    const int lq = lane >> 4, li = lane & 15, lt = tid - 256; const bool loader = wave >= 4;
    f32x4 Sacc[4]; bf16x8 Sb01, Sb23;
#pragma unroll
    for (int kt = 0; kt < 4; ++kt) Sacc[kt] = (f32x4){0.f, 0.f, 0.f, 0.f};
    Sb01 = (bf16x8){0, 0, 0, 0, 0, 0, 0, 0}; Sb23 = Sb01;
    constexpr int NBLK = SEQ / 32;
    LAS unsigned char* slot0 = lds; LAS unsigned char* slot1 = lds + 2 * RS_CH;
    RSRegs RA, RB;
    if (loader) { rs_issue(ws, cub, lt, RA); rs_store(slot0, lt, RA); rs_issue(ws, cub + 2, lt, RB); rs_issue(ws, cub + 4, lt, RA); }
    RC_BAR();
    for (int bb = 0; bb < NBLK; bb += 2) {
        if (!loader) { const size_t row0 = rowb + (size_t)bb * 32; LAS unsigned char* slot = slot0; RC_SCAN(slot, row0); }
        else { rs_store(slot1, lt, RB); if (bb + 3 < NBLK) rs_issue(ws, cub + 2 * (size_t)(bb + 3), lt, RB); }
        RC_BAR();
        if (!loader) { const size_t row0 = rowb + (size_t)(bb + 1) * 32; LAS unsigned char* slot = slot1; RC_SCAN(slot, row0); }
        else { if (bb + 2 < NBLK) rs_store(slot0, lt, RA); if (bb + 4 < NBLK) rs_issue(ws, cub + 2 * (size_t)(bb + 4), lt, RA); }
        RC_BAR();
    }
}
__device__ __forceinline__ void phase_r3(KArgsP a, int lane, int gw, int ngw, int l) {
    unsigned char* ws = a->ws; const bf16* PROJ = (const bf16*)(ws + WS_PROJ); bf16* YC = (bf16*)(ws + WS_YC);
    const bf16* RA = (const bf16*)(ws + WS_RA); const bf16* RG = (const bf16*)(ws + WS_RG); const bf16* RVG = (const bf16*)(ws + WS_RVG); const bf16* VF = (const bf16*)(ws + WS_VF);
    const float* mu = a->in[I_RMU] + (size_t)l * RW_COLS;
    for (size_t row = gw; row < NTOK; row += ngw) {
#pragma unroll 2
        for (int h = 0; h < NH; ++h) {
            const int c = h * 64 + lane;
            const float y = bf2f(YC[row * DM + 384 + c]);
            const float m = dpp_allsum(y) * (1.f / 64.f); const float d = y - m; const float var = dpp_allsum(d * d) * (1.f / 64.f);
            const float yn = d * rsqrtf(var + RWKV_GN_EPS) * a->in[I_RLNW][l * DBR + c] + a->in[I_RLNB][l * DBR + c];
            const float rs = rw_shift(PROJ, mu, row, RWC_R + c), ks = rw_shift(PROJ, mu, row, RWC_K + c); float v = rw_shift(PROJ, mu, row, RWC_V + c);
            if (l > 0) v = v + (bf2f(VF[row * DBR + c]) - v) * bf2f(RVG[row * DBR + c]);
            const float av = bf2f(RA[row * DBR + c]);
            const float km = ks * (1.f + (av - 1.f) * a->in[I_RKA][l * DBR + c]);
            const float rk = dpp_allsum(rs * km * a->in[I_RRK][l * DBR + c]);
            YC[row * DM + 384 + c] = (bf16)f2bf((yn + rk * v) * bf2f(RG[row * DBR + c]));
        }
    }
}

constexpr int PH_PER_LAYER = 11, PH_FINAL = 1 + 2 * PH_PER_LAYER, N_PHASES = PH_FINAL + 1;
constexpr int R2_WGS = 24;
__global__ void __launch_bounds__(NTHR, 2) fwd(Args args) {
    extern __shared__ __attribute__((aligned(16))) unsigned char lds_raw[];
    LAS unsigned char* lds = (LAS unsigned char*)lds_raw;
    volatile LAS unsigned* MISC = (volatile LAS unsigned*)(lds + MISC_OFF);
    const int tid0 = threadIdx.x;
    const int G = gridDim.x;
#define PHASE_IDS int tid_ = threadIdx.x; asm volatile("" : "+v"(tid_)); const int tid = tid_, lane = tid & 63, wave = __builtin_amdgcn_readfirstlane(tid >> 6); \
    int bx_ = blockIdx.x; asm volatile("" : "+s"(bx_)); const int bx = bx_; const int vcu = (G % 8 == 0) ? (bx % 8) * (G / 8) + bx / 8 : bx; (void)lane; (void)wave; (void)vcu; (void)bx;
    unsigned char* ws0 = fresh_args()->ws;
    for (int u = tid0; u < (LDS_BYTES - RING_BYTES) / 4; u += NTHR) ((LAS unsigned*)(lds + RING_BYTES))[u] = 0u;
    __syncthreads();
    XcdBarrier bar; bar.bar = (unsigned*)(ws0 + WS_CTL) + CW_BAR; bar.x = 0; bar.st = nullptr;
    if (!MK_PER_PHASE) bar = xcd_barrier_post((unsigned*)(ws0 + WS_CTL) + CW_BAR, MISC + 8);
#if MK_PER_PHASE
    const int lo = args.ph_lo, hi = args.ph_hi;
#define IN(k) (lo <= (k) && (k) < hi)
#else
#define IN(k) true
#endif
#define SEAM(k) do { if (IN(k) && IN((k) + 1)) { XcdBarrier b2 = bar; asm volatile("" : "+s"(b2.bar)); xcd_barrier(b2); } } while (0)

#ifndef DBL_SUB
#define DBL_SUB 0
#endif
#ifndef DBL_PHASE
#define DBL_PHASE (-1)
#endif
#ifndef REPN
#define REPN 2
#endif
#define REP(k) for (int rep_ = 0; rep_ < ((k) == DBL_PHASE ? REPN : 1); ++rep_)
#define REPBAR if (rep_ > 0) { XcdBarrier b2 = bar; asm volatile("" : "+s"(b2.bar)); xcd_barrier(b2); }
    REP(0) if (IN(0)) { REPBAR KArgsP ap = fresh_args(); PHASE_IDS phase_prologue(ap, lds, tid, lane, wave, vcu, G); }
    SEAM(0);
#define LCONST 0
    {
        constexpr int l = LCONST; constexpr int pb = 1 + l * PH_PER_LAYER;
        REP(pb + 0) if (IN(pb + 0)) { REPBAR KArgsP ap = fresh_args(); PHASE_IDS unsigned char* ws = ap->ws; (void)ws;
            if (l == 0) { mod_finalize(ws, tid, G); phase_rownorm<0, false>(ap, lds, tid, lane, wave, G, ap->in[I_X], ap->out, ap->in[I_NORM_MIX], true, 0, 0, 0); }
            else {
#if EN_MOE
                phase_rownorm<0, true>(ap, lds, tid, lane, wave, G, ap->out, ap->out, ap->in[I_NORM_MIX] + l * DM, false, l, 0, l - 1);
#else
                phase_rownorm<0, false>(ap, lds, tid, lane, wave, G, ap->out, ap->out, ap->in[I_NORM_MIX] + l * DM, false, l, 0, l - 1);
#endif
            }
        }
        SEAM(pb + 0);
        REP(pb + 1) if (IN(pb + 1)) { REPBAR KArgsP ap = fresh_args(); PHASE_IDS unsigned char* ws = ap->ws; (void)ws;
            pg8::Gemm g{(const pg8::bf16_t*)(ws + WS_HN), (const pg8::bf16_t*)(ws + WS_WIN) + (size_t)l * NPROJ_PAD * DM, NTOK, NPROJ_PAD, DM};
            pg8::StaticOrder S; S.init(NTOK, NPROJ_PAD, G, bx);
            pg8::EpiProj E{(pg8::bf16_t*)(ws + WS_PROJ), (float*)(ws + WS_GATES)};
            pg8::gemm_phase<pg8::EpiProj, pg8::StaticOrder, true, true>(lds, g, S, E);
        }
        SEAM(pb + 1);
        REP(pb + 2) if (IN(pb + 2)) { REPBAR KArgsP ap = fresh_args(); PHASE_IDS unsigned char* ws = ap->ws; (void)ws;
#if EN_MLSTM
            for (int q_ = 0; q_ < 1 + (REPN - 1) * ((DBL_SUB == 1) && l == 0); ++q_) { phase_m1(ap, lds, tid, lane, wave, vcu, G, l); __syncthreads(); }
            __syncthreads();
#endif
#if EN_S5
            phase_s1(ap, lds, tid, lane, wave, vcu, G, l); __syncthreads();
#if DBL_SUB == 2
            if (l == 0) { phase_s1(ap, lds, tid, lane, wave, vcu, G, l); __syncthreads(); phase_s1(ap, lds, tid, lane, wave, vcu, G, l); __syncthreads(); phase_s1(ap, lds, tid, lane, wave, vcu, G, l); __syncthreads(); phase_s1(ap, lds, tid, lane, wave, vcu, G, l); __syncthreads(); }
#endif
            __syncthreads();
#endif
#if EN_RWKV
            for (int q_ = 0; q_ < 1 + (REPN - 1) * ((DBL_SUB == 3) && l == 0); ++q_) { phase_r1(ap, lds, tid, lane, wave, vcu, G, l); __syncthreads(); }
#endif
        }
        SEAM(pb + 2);
        REP(pb + 3) if (IN(pb + 3)) { REPBAR KArgsP ap = fresh_args(); PHASE_IDS unsigned char* ws = ap->ws; (void)ws;
            if (vcu >= G - 64) { const int wg = vcu - (G - 64), nwg = 64;
                phase_m2(ws, tid, wg, nwg);
                phase_s2(ap, tid, wg, nwg, l);
                __syncthreads(); }
            phase_r2_build(ap, lds, tid, lane, wave, vcu, G, l);
        }
        SEAM(pb + 3);
        REP(pb + 4) if (IN(pb + 4)) { REPBAR KArgsP ap = fresh_args(); PHASE_IDS unsigned char* ws = ap->ws; (void)ws;
            if (vcu < R2_WGS) phase_r2_scan(ap, lds, tid, lane, wave, vcu, l);
            else {
                phase_m3(ap, lds, tid, lane, wave, vcu - R2_WGS, G - R2_WGS, l);
                __syncthreads();
                phase_s3(ap, lds, tid, lane, wave, vcu - R2_WGS, G - R2_WGS, l);
            }
        }
        SEAM(pb + 4);
        REP(pb + 5) if (IN(pb + 5)) { REPBAR KArgsP ap = fresh_args(); PHASE_IDS
            phase_r3(ap, lane, vcu * NWAVES + wave, G * NWAVES, l);
        }
        SEAM(pb + 5);
        REP(pb + 6) if (IN(pb + 6)) { REPBAR KArgsP ap = fresh_args(); PHASE_IDS unsigned char* ws = ap->ws; (void)ws;
            pg8::Gemm g{(const pg8::bf16_t*)(ws + WS_YC), (const pg8::bf16_t*)(ws + WS_WOUT) + (size_t)l * DM * DM, NTOK, DM, DM};
            pg8::StaticOrder S; S.init(NTOK, DM, G, bx);
            pg8::EpiResid E{l == 0 ? ap->in[I_X] : (const float*)ap->out, ap->out, (const float*)(ws + WS_MODF) + (size_t)l * 4 * 6144, 2048};
            pg8::gemm_phase<pg8::EpiResid, pg8::StaticOrder, true, true>(lds, g, S, E);
        }
        SEAM(pb + 6);
#if EN_MOE
        REP(pb + 7) if (IN(pb + 7)) { REPBAR KArgsP ap = fresh_args(); PHASE_IDS phase_router(ap, lds, tid, lane, wave, G, l); }
        SEAM(pb + 7);
        REP(pb + 8) if (IN(pb + 8)) { REPBAR KArgsP ap = fresh_args(); PHASE_IDS phase_gather(ap, lds, tid, lane, wave, vcu, G, l); __syncthreads();
            moe_convert(ap->in[I_MW1], ap->in[I_MW3], ap->in[I_MW2], l, (bf16*)(ap->ws + WS_W13), (bf16*)(ap->ws + WS_W2), vcu * NWAVES + wave, G * NWAVES, (LAS float*)(lds + wave * 16640), lane); }
        SEAM(pb + 8);
        REP(pb + 9) if (IN(pb + 9)) { REPBAR KArgsP ap = fresh_args(); PHASE_IDS unsigned char* ws = ap->ws; (void)ws;
            LAS int* ptab = (LAS int*)(lds + PTAB_OFF); LAS int* pst = ptab + 512; LAS int* cnt = pst + 32;
            build_ptab((const unsigned*)(ws + WS_CTL) + CW_CNT + l * 32, ptab, pst, cnt, tid);
            pg8::Gemm g{(const pg8::bf16_t*)(ws + WS_XG), (const pg8::bf16_t*)(ws + WS_W13), 0, 0, DM};
            pg8::MoeOrder S{ptab, G, vcu};
            pg8::EpiSwiglu E{(pg8::bf16_t*)(ws + WS_HMID)};
            pg8::gemm_phase<pg8::EpiSwiglu, pg8::MoeOrder, true, true>(lds, g, S, E);
        }
        SEAM(pb + 9);
        REP(pb + 10) if (IN(pb + 10)) { REPBAR KArgsP ap = fresh_args(); PHASE_IDS unsigned char* ws = ap->ws; (void)ws;
            LAS int* ptab = (LAS int*)(lds + PTAB_OFF); LAS int* pst = ptab + 512; LAS int* cnt = pst + 32;
            build_ptab((const unsigned*)(ws + WS_CTL) + CW_CNT + l * 32, ptab, pst, cnt, tid);
            pg8::Gemm g{(const pg8::bf16_t*)(ws + WS_HMID), (const pg8::bf16_t*)(ws + WS_W2), 0, 0, DEXP};
            pg8::MoeOrder S{ptab, G, vcu};
            pg8::EpiMoeOut E{(pg8::bf16_t*)(ws + WS_YMOE), (const int*)(ws + WS_ROWMAP)};
            pg8::gemm_phase<pg8::EpiMoeOut, pg8::MoeOrder, true, true>(lds, g, S, E);
        }
        SEAM(pb + 10);
#else
        SEAM(pb + 7); SEAM(pb + 8); SEAM(pb + 9); SEAM(pb + 10);
#endif
    }
#undef LCONST
#if N_LAYERS > 1
#define LCONST 1
    {
        constexpr int l = LCONST; constexpr int pb = 1 + l * PH_PER_LAYER;
        REP(pb + 0) if (IN(pb + 0)) { REPBAR KArgsP ap = fresh_args(); PHASE_IDS unsigned char* ws = ap->ws; (void)ws;
            if (l == 0) { mod_finalize(ws, tid, G); phase_rownorm<0, false>(ap, lds, tid, lane, wave, G, ap->in[I_X], ap->out, ap->in[I_NORM_MIX], true, 0, 0, 0); }
            else {
#if EN_MOE
                phase_rownorm<0, true>(ap, lds, tid, lane, wave, G, ap->out, ap->out, ap->in[I_NORM_MIX] + l * DM, false, l, 0, l - 1);
#else
                phase_rownorm<0, false>(ap, lds, tid, lane, wave, G, ap->out, ap->out, ap->in[I_NORM_MIX] + l * DM, false, l, 0, l - 1);
#endif
            }
        }
        SEAM(pb + 0);
        REP(pb + 1) if (IN(pb + 1)) { REPBAR KArgsP ap = fresh_args(); PHASE_IDS unsigned char* ws = ap->ws; (void)ws;
            pg8::Gemm g{(const pg8::bf16_t*)(ws + WS_HN), (const pg8::bf16_t*)(ws + WS_WIN) + (size_t)l * NPROJ_PAD * DM, NTOK, NPROJ_PAD, DM};
            pg8::StaticOrder S; S.init(NTOK, NPROJ_PAD, G, bx);
            pg8::EpiProj E{(pg8::bf16_t*)(ws + WS_PROJ), (float*)(ws + WS_GATES)};
            pg8::gemm_phase<pg8::EpiProj, pg8::StaticOrder, true, true>(lds, g, S, E);
        }
        SEAM(pb + 1);
        REP(pb + 2) if (IN(pb + 2)) { REPBAR KArgsP ap = fresh_args(); PHASE_IDS unsigned char* ws = ap->ws; (void)ws;
#if EN_MLSTM
            for (int q_ = 0; q_ < 1 + (REPN - 1) * ((DBL_SUB == 1) && l == 0); ++q_) { phase_m1(ap, lds, tid, lane, wave, vcu, G, l); __syncthreads(); }
            __syncthreads();
#endif
#if EN_S5
            phase_s1(ap, lds, tid, lane, wave, vcu, G, l); __syncthreads();
#if DBL_SUB == 2
            if (l == 0) { phase_s1(ap, lds, tid, lane, wave, vcu, G, l); __syncthreads(); phase_s1(ap, lds, tid, lane, wave, vcu, G, l); __syncthreads(); phase_s1(ap, lds, tid, lane, wave, vcu, G, l); __syncthreads(); phase_s1(ap, lds, tid, lane, wave, vcu, G, l); __syncthreads(); }
#endif
            __syncthreads();
#endif
#if EN_RWKV
            for (int q_ = 0; q_ < 1 + (REPN - 1) * ((DBL_SUB == 3) && l == 0); ++q_) { phase_r1(ap, lds, tid, lane, wave, vcu, G, l); __syncthreads(); }
#endif
        }
        SEAM(pb + 2);
        REP(pb + 3) if (IN(pb + 3)) { REPBAR KArgsP ap = fresh_args(); PHASE_IDS unsigned char* ws = ap->ws; (void)ws;
            if (vcu >= G - 64) { const int wg = vcu - (G - 64), nwg = 64;
                phase_m2(ws, tid, wg, nwg);
                phase_s2(ap, tid, wg, nwg, l);
                __syncthreads(); }
            phase_r2_build(ap, lds, tid, lane, wave, vcu, G, l);
        }
        SEAM(pb + 3);
        REP(pb + 4) if (IN(pb + 4)) { REPBAR KArgsP ap = fresh_args(); PHASE_IDS unsigned char* ws = ap->ws; (void)ws;
            if (vcu < R2_WGS) phase_r2_scan(ap, lds, tid, lane, wave, vcu, l);
            else {
                phase_m3(ap, lds, tid, lane, wave, vcu - R2_WGS, G - R2_WGS, l);
                __syncthreads();
                phase_s3(ap, lds, tid, lane, wave, vcu - R2_WGS, G - R2_WGS, l);
            }
        }
        SEAM(pb + 4);
        REP(pb + 5) if (IN(pb + 5)) { REPBAR KArgsP ap = fresh_args(); PHASE_IDS
            phase_r3(ap, lane, vcu * NWAVES + wave, G * NWAVES, l);
        }
        SEAM(pb + 5);
        REP(pb + 6) if (IN(pb + 6)) { REPBAR KArgsP ap = fresh_args(); PHASE_IDS unsigned char* ws = ap->ws; (void)ws;
            pg8::Gemm g{(const pg8::bf16_t*)(ws + WS_YC), (const pg8::bf16_t*)(ws + WS_WOUT) + (size_t)l * DM * DM, NTOK, DM, DM};
            pg8::StaticOrder S; S.init(NTOK, DM, G, bx);
            pg8::EpiResid E{l == 0 ? ap->in[I_X] : (const float*)ap->out, ap->out, (const float*)(ws + WS_MODF) + (size_t)l * 4 * 6144, 2048};
            pg8::gemm_phase<pg8::EpiResid, pg8::StaticOrder, true, true>(lds, g, S, E);
        }
        SEAM(pb + 6);
#if EN_MOE
        REP(pb + 7) if (IN(pb + 7)) { REPBAR KArgsP ap = fresh_args(); PHASE_IDS phase_router(ap, lds, tid, lane, wave, G, l); }
        SEAM(pb + 7);
        REP(pb + 8) if (IN(pb + 8)) { REPBAR KArgsP ap = fresh_args(); PHASE_IDS phase_gather(ap, lds, tid, lane, wave, vcu, G, l); __syncthreads();
            moe_convert(ap->in[I_MW1], ap->in[I_MW3], ap->in[I_MW2], l, (bf16*)(ap->ws + WS_W13), (bf16*)(ap->ws + WS_W2), vcu * NWAVES + wave, G * NWAVES, (LAS float*)(lds + wave * 16640), lane); }
        SEAM(pb + 8);
        REP(pb + 9) if (IN(pb + 9)) { REPBAR KArgsP ap = fresh_args(); PHASE_IDS unsigned char* ws = ap->ws; (void)ws;
            LAS int* ptab = (LAS int*)(lds + PTAB_OFF); LAS int* pst = ptab + 512; LAS int* cnt = pst + 32;
            build_ptab((const unsigned*)(ws + WS_CTL) + CW_CNT + l * 32, ptab, pst, cnt, tid);
            pg8::Gemm g{(const pg8::bf16_t*)(ws + WS_XG), (const pg8::bf16_t*)(ws + WS_W13), 0, 0, DM};
            pg8::MoeOrder S{ptab, G, vcu};
            pg8::EpiSwiglu E{(pg8::bf16_t*)(ws + WS_HMID)};
            pg8::gemm_phase<pg8::EpiSwiglu, pg8::MoeOrder, true, true>(lds, g, S, E);
        }
        SEAM(pb + 9);
        REP(pb + 10) if (IN(pb + 10)) { REPBAR KArgsP ap = fresh_args(); PHASE_IDS unsigned char* ws = ap->ws; (void)ws;
            LAS int* ptab = (LAS int*)(lds + PTAB_OFF); LAS int* pst = ptab + 512; LAS int* cnt = pst + 32;
            build_ptab((const unsigned*)(ws + WS_CTL) + CW_CNT + l * 32, ptab, pst, cnt, tid);
            pg8::Gemm g{(const pg8::bf16_t*)(ws + WS_HMID), (const pg8::bf16_t*)(ws + WS_W2), 0, 0, DEXP};
            pg8::MoeOrder S{ptab, G, vcu};
            pg8::EpiMoeOut E{(pg8::bf16_t*)(ws + WS_YMOE), (const int*)(ws + WS_ROWMAP)};
            pg8::gemm_phase<pg8::EpiMoeOut, pg8::MoeOrder, true, true>(lds, g, S, E);
        }
        SEAM(pb + 10);
#else
        SEAM(pb + 7); SEAM(pb + 8); SEAM(pb + 9); SEAM(pb + 10);
#endif
    }
#undef LCONST
#endif
    if (IN(PH_FINAL)) { KArgsP ap = fresh_args(); PHASE_IDS
#if EN_MOE
        if (N_LAYERS > 0) phase_rownorm<1, true>(ap, lds, tid, lane, wave, G, ap->out, ap->out, ap->in[I_NORM_FINAL], false, 0, 0, N_LAYERS - 1);
        else phase_rownorm<1, false>(ap, lds, tid, lane, wave, G, ap->in[I_X], ap->out, ap->in[I_NORM_FINAL], false, 0, 0, 0);
#else
        phase_rownorm<1, false>(ap, lds, tid, lane, wave, G, N_LAYERS > 0 ? (const float*)ap->out : ap->in[I_X], ap->out, ap->in[I_NORM_FINAL], false, 0, 0, 0);
#endif
    }
#undef IN
#undef SEAM
}

extern "C" void kernel_launch(void* const* d_in, const int* in_sizes, int n_in, void* d_out, int out_size, void* d_ws, size_t ws_size, hipStream_t stream) {
    static int grid = 0;
    if (grid == 0) {
        if (n_in != 47 || out_size != NTOK * DM || ws_size < WS_END) { fprintf(stderr, "kernel_launch: unexpected problem (n_in %d, out %d, ws %zu < %zu)\n", n_in, out_size, ws_size, (size_t)WS_END); grid = -1; return; }
        int dev = 0, cus = 0, per_cu = 0;
        if (hipGetDevice(&dev) != hipSuccess || hipDeviceGetAttribute(&cus, hipDeviceAttributeMultiprocessorCount, dev) != hipSuccess) { grid = -1; return; }
        if (hipFuncSetAttribute((const void*)fwd, hipFuncAttributeMaxDynamicSharedMemorySize, LDS_BYTES) != hipSuccess) { fprintf(stderr, "kernel_launch: hipFuncSetAttribute failed\n"); grid = -1; return; }
        if (hipOccupancyMaxActiveBlocksPerMultiprocessor(&per_cu, (const void*)fwd, NTHR, LDS_BYTES) != hipSuccess || per_cu < 1) fprintf(stderr, "kernel_launch: occupancy query says %d\n", per_cu);
        (void)hipGetLastError();
        grid = cus;
        if (grid != 256) fprintf(stderr, "kernel_launch: %d CUs (built for 256)\n", grid);
    }
    if (grid < 0) return;
    (void)hipMemsetAsync((char*)d_ws + WS_CTL, 0, CTL_ZERO_BYTES, stream);
    Args a{};
    for (int i = 0; i < 47; ++i) a.in[i] = (const float*)d_in[i];
    a.out = (float*)d_out; a.ws = (unsigned char*)d_ws;
#if MK_PER_PHASE
    for (int p = 0; p < N_PHASES; ++p) { a.ph_lo = p; a.ph_hi = p + 1; hipLaunchKernelGGL(fwd, dim3(grid), dim3(NTHR), LDS_BYTES, stream, a); }
#else
    a.ph_lo = 0; a.ph_hi = N_PHASES; hipLaunchKernelGGL(fwd, dim3(grid), dim3(NTHR), LDS_BYTES, stream, a);
#endif
}
#ifdef DIAG_KERNELS
#define DK(name, ...) __global__ void __launch_bounds__(NTHR, 2) name(Args args) { extern __shared__ __attribute__((aligned(16))) unsigned char lds_raw[]; LAS unsigned char* lds = (LAS unsigned char*)lds_raw; \
    const int tid = threadIdx.x, lane = tid & 63, wave = __builtin_amdgcn_readfirstlane(tid >> 6); const int G = gridDim.x; const int bx = blockIdx.x; const int vcu = bx; KArgsP ap = fresh_args(); int l = ap->ph_lo; (void)lane; (void)wave; (void)vcu; (void)G; (void)l; __VA_ARGS__ }
DK(k_prologue, phase_prologue(ap, lds, tid, lane, wave, vcu, G);)
DK(k_norm0, phase_rownorm<0, false>(ap, lds, tid, lane, wave, G, ap->in[I_X], ap->out, ap->in[I_NORM_MIX], true, 0, 0, 0);)
DK(k_norm1, phase_rownorm<0, true>(ap, lds, tid, lane, wave, G, ap->out, ap->out, ap->in[I_NORM_MIX], false, l, 0, 0);)
DK(k_normf, phase_rownorm<1, true>(ap, lds, tid, lane, wave, G, ap->out, ap->out, ap->in[I_NORM_MIX], false, l, 0, 0);)
DK(k_m1, phase_m1(ap, lds, tid, lane, wave, vcu, G, l);)
DK(k_m2, phase_m2(ap->ws, tid, vcu, G);)
DK(k_m3, phase_m3(ap, lds, tid, lane, wave, vcu, G, l);)
DK(k_s1, phase_s1(ap, lds, tid, lane, wave, vcu, G, l);)
DK(k_s2, phase_s2(ap, tid, vcu, G, l);)
DK(k_s3, phase_s3(ap, lds, tid, lane, wave, vcu, G, l);)
DK(k_r1, phase_r1(ap, lds, tid, lane, wave, vcu, G, l);)
DK(k_r2b, phase_r2_build(ap, lds, tid, lane, wave, vcu, G, l);)
DK(k_r2s, phase_r2_scan(ap, lds, tid, lane, wave, vcu, l);)
DK(k_r3, phase_r3(ap, lane, vcu * NWAVES + wave, G * NWAVES, l);)
DK(k_router, phase_router(ap, lds, tid, lane, wave, G, l);)
DK(k_gather, phase_gather(ap, lds, tid, lane, wave, vcu, G, l);)
DK(k_moecv, moe_convert(ap->in[I_MW1], ap->in[I_MW3], ap->in[I_MW2], 1, (bf16*)(ap->ws + WS_W13), (bf16*)(ap->ws + WS_W2), vcu * NWAVES + wave, G * NWAVES, (LAS float*)(lds + wave * 16640), lane);)
#endif
```

```cpp
#include <hip/hip_runtime.h>
#include <cstdio>
#include <cstdint>
#define MK_PER_PHASE 0

#ifndef MK_PER_PHASE
#define MK_PER_PHASE 0
#endif
#ifndef EN_MLSTM
#define EN_MLSTM 1
#endif
#ifndef EN_S5
#define EN_S5 1
#endif
#ifndef EN_RWKV
#define EN_RWKV 1
#endif
#ifndef EN_MOE
#define EN_MOE 1
#endif
#ifndef N_LAYERS
#define N_LAYERS 2
#endif
constexpr int NWAVES = 8, NTHR = 512;
constexpr int DM = 1024, NB = 4, SEQ = 8192, NTOK = NB * SEQ;
constexpr int DA = 384, DBR = 384, DC = 256, NH = 6, HD = 64, NCH = SEQ / 64;
constexpr int IN_COLS = 2828, NPROJ = 2816, NPROJ_PAD = 3072;
constexpr int PC_QK = 0, PC_V = 384, PC_O = 768, PC_RW = 1152, PC_S5 = 2560;
constexpr int RWC_R = 0, RWC_K = 384, RWC_V = 768, RWC_WD = 1152, RWC_AD = 1216, RWC_GD = 1280, RW_COLS = 1408;
constexpr int NEXP = 32, DEXP = 512, MOE_ROWS_MAX = 73728;
constexpr int NUNIT_M = NB * NCH * NH;
constexpr int CL_STRIDE = 4160;
constexpr float NORM_EPS = 1e-6f, HEAD_NORM_EPS = 1e-5f, RWKV_GN_EPS = 64e-5f;

constexpr size_t MiB = 1u << 20;
constexpr size_t WS_CTL = 0, CTL_ZERO_BYTES = 1 * MiB;
constexpr size_t WS_MODP = 1 * MiB;
constexpr size_t WS_MODF = 2 * MiB + 512 * 1024;
constexpr size_t WS_RTW = 3 * MiB;
constexpr size_t WS_MLW = 3 * MiB + 512 * 1024;
constexpr size_t WS_S5CM = 2 * MiB + 768 * 1024;
constexpr size_t WS_GLUT = 3 * MiB + 768 * 1024;
constexpr size_t WS_WIN = 4 * MiB;
constexpr size_t WS_WOUT = 16 * MiB;
constexpr size_t WS_GATES = 20 * MiB;
constexpr size_t WS_W13 = 22 * MiB;
constexpr size_t WS_W2 = 86 * MiB;
constexpr size_t WS_HN = 118 * MiB;
constexpr size_t WS_CLOC = 118 * MiB;
constexpr size_t WS_MSC = 168 * MiB;
constexpr size_t WS_S5ST = 170 * MiB;
constexpr size_t WS_VF = 182 * MiB;
constexpr size_t WS_YC = 206 * MiB;
constexpr size_t WS_LIST = 206 * MiB;
constexpr size_t WS_ROWMAP = 214 * MiB;
constexpr size_t WS_TOKE = 215 * MiB;
constexpr size_t WS_TOKW = 215 * MiB + 512 * 1024;
constexpr size_t WS_PROJ = 270 * MiB;
constexpr size_t WS_RE = 446 * MiB, WS_RA = 470 * MiB, WS_RG = 494 * MiB, WS_RVG = 518 * MiB;
constexpr size_t WS_XG = 270 * MiB;
constexpr size_t WS_HMID = 414 * MiB;
constexpr size_t WS_YMOE = 270 * MiB;
constexpr size_t WS_R1W = 542 * MiB;
constexpr size_t WS_OPA = 22 * MiB;
constexpr size_t WS_OPB = 543 * MiB;
constexpr size_t WS_END = 591 * MiB;
constexpr int CW_TMO = 0, CW_BAR = 4096, CW_CNT = 8192;

constexpr int RING_BYTES = 131072, MISC_OFF = 135168, PTAB_OFF = MISC_OFF + 1024, LDS_BYTES = 147456;

#define GAS __attribute__((address_space(1)))
#define LAS __attribute__((address_space(3)))
typedef unsigned short bf16;
typedef unsigned v4u __attribute__((ext_vector_type(4)));
typedef unsigned v2u __attribute__((ext_vector_type(2)));
typedef float f32x4 __attribute__((ext_vector_type(4)));
typedef float f32x2 __attribute__((ext_vector_type(2)));
typedef GAS unsigned gu32;
#define RLX_AGENT __ATOMIC_RELAXED, __HIP_MEMORY_SCOPE_AGENT
#define LDS_WAIT() asm volatile("s_waitcnt lgkmcnt(0)" ::: "memory")
#define VM_WAIT() asm volatile("s_waitcnt vmcnt(0)" ::: "memory")
typedef float f32x2v __attribute__((ext_vector_type(2)));
typedef __bf16 bf16x2v __attribute__((ext_vector_type(2)));
__device__ __forceinline__ unsigned pk2(float lo, float hi) { const f32x2v v = {lo, hi}; const bf16x2v b = __builtin_convertvector(v, bf16x2v); return __builtin_bit_cast(unsigned, b); }
__device__ __forceinline__ unsigned f2bf(float f) { return pk2(f, 0.f) & 0xffffu; }
__device__ __forceinline__ float bf2f(unsigned v) { return __builtin_bit_cast(float, v << 16); }
__device__ __forceinline__ float bflo(unsigned w) { return __builtin_bit_cast(float, w << 16); }
__device__ __forceinline__ float bfhi(unsigned w) { return __builtin_bit_cast(float, w & 0xffff0000u); }
__device__ __forceinline__ float sigmoidf_(float x) { return 1.f / (1.f + __expf(-x)); }
__device__ __forceinline__ float wave_sum(float v) {
#pragma unroll
    for (int o = 1; o < 64; o <<= 1) v += __shfl_xor(v, o);
    return v;
}
__device__ __forceinline__ float wave_max(float v) {
#pragma unroll
    for (int o = 1; o < 64; o <<= 1) v = fmaxf(v, __shfl_xor(v, o));
    return v;
}
namespace pg8 {
#define PG8_LAS __attribute__((address_space(3)))
typedef unsigned short bf16_t;
typedef short bf16x8 __attribute__((ext_vector_type(8)));
typedef float f32x4 __attribute__((ext_vector_type(4)));
typedef unsigned u32x4 __attribute__((ext_vector_type(4)));
constexpr int BM = 256, BK = 64, HALF = 128, HTB = HALF * BK * 2  , STAGE_BYTES = 8 * HTB, NXCD = 8, WGM = 8;

__host__ __device__ __forceinline__ int lds_byte(int r, int c) { const int st = (r >> 4) * 2 + (c >> 5), rr = r & 15, cc = c & 31, ob = rr * 64 + cc * 2; return st * 1024 + (ob ^ (((ob >> 9) & 1) << 5)); }
__host__ __device__ __forceinline__ void stage_rc(int b, int& R, int& C) { const int st = b / 1024, sb = b % 1024, swz = sb ^ (((sb >> 9) & 1) << 5); R = (st >> 1) * 16 + swz / 64; C = (st & 1) * 32 + (swz % 64) / 2; }
__host__ __device__ __forceinline__ int perm32(int rho) { const int n = rho >> 4, i = rho & 15; return 8 * (i >> 2) + 4 * n + (i & 3); }

struct Unit { int pm, pn; };
struct Gemm { const bf16_t* A; const bf16_t* Bt; int M, N, K; const int* rowmap = nullptr; };

struct StaticOrder {
    int nM, nN, nwg, G, c;
    __host__ __device__ void init(int M, int N, int G_, int c_) { nM = M / BM; nN = N / BM; nwg = nM * nN; G = G_; c = c_; }
    __host__ __device__ bool next(int i, Unit& u) const {
        const long L = (long)i * G + c; if (L >= nwg) return false;
        int wgid = (int)L; { const int q = nwg / NXCD, r = nwg % NXCD, xcd = wgid % NXCD, off = wgid / NXCD; wgid = (xcd < r ? xcd * (q + 1) : r * (q + 1) + (xcd - r) * q) + off; }
        const int nig = WGM * nN, gid = wgid / nig, fm = gid * WGM, gsz = (nM - fm) < WGM ? (nM - fm) : WGM;
        u.pm = fm + ((wgid % nig) % gsz); u.pn = (wgid % nig) / gsz; return true;
    }
    __device__ __forceinline__ void a_ready(const Unit&) const {}
    __device__ __forceinline__ void done(const Unit&) const {}
};

__device__ __forceinline__ unsigned cvt_pk_bf16(float lo, float hi) { unsigned r; asm volatile("v_cvt_pk_bf16_f32 %0, %1, %2" : "=v"(r) : "v"(lo), "v"(hi)); return r; }

struct EpiProj {
    static constexpr bool PERM = true, AFTER_DRAIN = false;
    bf16_t* O; float* G;
    __device__ __forceinline__ void operator()(const f32x4 (&acc)[2][2][4][2], const Unit& u, int wr, int wc, int fr, int fq) const {
        const int row0 = u.pm * BM + wr * 64 + fr;
        if (u.pn < 11) {
            const int col0 = u.pn * BM + wc * 32 + 8 * fq;
#pragma unroll
            for (int ai = 0; ai < 2; ++ai)
#pragma unroll
                for (int m = 0; m < 4; ++m) { bf16_t* rowp = O + (size_t)(row0 + ai * HALF + m * 16) * 2816 + col0;
#pragma unroll
                    for (int bj = 0; bj < 2; ++bj) { const f32x4 v0 = acc[ai][bj][m][0], v1 = acc[ai][bj][m][1];
                        u32x4 w; w.x = cvt_pk_bf16(v0[0], v0[1]); w.y = cvt_pk_bf16(v0[2], v0[3]); w.z = cvt_pk_bf16(v1[0], v1[1]); w.w = cvt_pk_bf16(v1[2], v1[3]);
                        *(u32x4*)(rowp + bj * HALF) = w; } }
        } else if (wc == 0 && fq < 2) {
#pragma unroll
            for (int ai = 0; ai < 2; ++ai)
#pragma unroll
                for (int m = 0; m < 4; ++m) { float* rowp = G + (size_t)(row0 + ai * HALF + m * 16) * 16 + 8 * fq;
                    *(f32x4*)(rowp) = acc[ai][0][m][0]; *(f32x4*)(rowp + 4) = acc[ai][0][m][1]; }
        }
    }
};
struct EpiResid {
    static constexpr bool PERM = true, AFTER_DRAIN = false;
    const float* xin; float* out; const float* gate;
    int goff;
    __device__ __forceinline__ void operator()(const f32x4 (&acc)[2][2][4][2], const Unit& u, int wr, int wc, int fr, int fq) const {
        const int row0 = u.pm * BM + wr * 64 + fr, col0 = u.pn * BM + wc * 32 + 8 * fq;
        const float* gp = gate + (size_t)(row0 >> 13) * 6144 + goff + col0;
        f32x4 g[2][2];
#pragma unroll
        for (int bj = 0; bj < 2; ++bj)
#pragma unroll
            for (int n = 0; n < 2; ++n) g[bj][n] = *(const f32x4*)(gp + bj * HALF + 4 * n) + 1.0f;
#pragma unroll
        for (int ai = 0; ai < 2; ++ai)
#pragma unroll
            for (int m = 0; m < 4; ++m) { const size_t off = (size_t)(row0 + ai * HALF + m * 16) * 1024 + col0;
#pragma unroll
                for (int bj = 0; bj < 2; ++bj)
#pragma unroll
                    for (int n = 0; n < 2; ++n) { const f32x4 xv = *(const f32x4*)(xin + off + bj * HALF + 4 * n);
                        *(f32x4*)(out + off + bj * HALF + 4 * n) = xv + g[bj][n] * acc[ai][bj][m][n]; } }
    }
};
struct EpiSwiglu {
    static constexpr bool PERM = true, AFTER_DRAIN = false;
    bf16_t* H;
    __device__ __forceinline__ void operator()(const f32x4 (&acc)[2][2][4][2], const Unit& u, int wr, int wc, int fr, int fq) const {
        const int row0 = u.pm * BM + wr * 64 + fr, hid0 = 128 * (u.pn & 3) + 16 * wc + 4 * fq;
#pragma unroll
        for (int ai = 0; ai < 2; ++ai)
#pragma unroll
            for (int m = 0; m < 4; ++m) { bf16_t* rowp = H + (size_t)(row0 + ai * HALF + m * 16) * 512 + hid0;
#pragma unroll
                for (int bj = 0; bj < 2; ++bj) { const f32x4 g = acc[ai][bj][m][0], uu = acc[ai][bj][m][1]; float h[4];
#pragma unroll
                    for (int i = 0; i < 4; ++i) h[i] = g[i] / (1.f + __expf(-g[i])) * uu[i];
                    unsigned w0 = cvt_pk_bf16(h[0], h[1]), w1 = cvt_pk_bf16(h[2], h[3]);
                    *(unsigned long long*)(rowp + 64 * bj) = (unsigned long long)w0 | ((unsigned long long)w1 << 32); } }
    }
};
struct EpiMoeOut {
    static constexpr bool PERM = true, AFTER_DRAIN = false;
    bf16_t* Y; const int* rowmap;
    __device__ __forceinline__ void operator()(const f32x4 (&acc)[2][2][4][2], const Unit& u, int wr, int wc, int fr, int fq) const {
        const int row0 = u.pm * BM + wr * 64 + fr, col0 = (u.pn & 3) * BM + wc * 32 + 8 * fq;
#pragma unroll
        for (int ai = 0; ai < 2; ++ai)
#pragma unroll
            for (int m = 0; m < 4; ++m) { const int dst = rowmap[row0 + ai * HALF + m * 16];
                if (dst >= 0) { bf16_t* rowp = Y + (size_t)dst * 1024 + col0;
#pragma unroll
                    for (int bj = 0; bj < 2; ++bj) { const f32x4 v0 = acc[ai][bj][m][0], v1 = acc[ai][bj][m][1];
                        u32x4 w; w.x = cvt_pk_bf16(v0[0], v0[1]); w.y = cvt_pk_bf16(v0[2], v0[3]); w.z = cvt_pk_bf16(v1[0], v1[1]); w.w = cvt_pk_bf16(v1[2], v1[3]);
                        *(u32x4*)(rowp + bj * HALF) = w; } } }
    }
};
struct MoeOrder {
    PG8_LAS const int* ptab; int G, c;
    __device__ __forceinline__ bool next(int i, Unit& u) const {
        const int L = i * G + c, np = __builtin_amdgcn_readfirstlane(ptab[0]);
        if (L >= np * 4) return false;
        const int p = L >> 2; u.pm = p; u.pn = __builtin_amdgcn_readfirstlane(ptab[1 + p]) * 4 + (L & 3); return true;
    }
    __device__ __forceinline__ void a_ready(const Unit&) const {}
    __device__ __forceinline__ void done(const Unit&) const {}
};
template <class Epi, class Sched, bool ALIGN_EPI = false, bool SP2 = false, bool GATHER = false>
__device__ __forceinline__ void gemm_phase(PG8_LAS unsigned char* lds, const Gemm g, const Sched& S, const Epi& E) {
    const int tid = threadIdx.x, wid = __builtin_amdgcn_readfirstlane(tid >> 6), lane = tid & 63, wr = wid >> 2, wc = wid & 3, fr = lane & 15, fq = lane >> 4;
    const int K = g.K, nt = K / BK;
    static_assert(!GATHER || SP2, "the gathered-A variant exists for the SP2 loop only");
    unsigned voffA[2], voffB[2];
    unsigned vAc[2] = {0u, 0u}, vAn[2] = {0u, 0u};
#pragma unroll
    for (int i = 0; i < 2; ++i) { int R, C; stage_rc(tid * 16 + i * 8192, R, C); const int Rb = Epi::PERM ? ((R & ~31) + perm32(R & 31)) : R;
        voffA[i] = (unsigned)(R * K + C) * 2u; voffB[i] = (unsigned)(Rb * K + C) * 2u; }
    const size_t kstep = (size_t)(BK * 2);
    const size_t hstep = (size_t)HALF * K * 2;
    const size_t tstep = 2 * hstep;
    const unsigned ldsw = (unsigned)wid * 1024u;
    const int aoff = lds_byte(wr * 64 + fr, fq * 8), boff = lds_byte(wc * 32 + fr, fq * 8);
#define PG8_SA(b, h) (((b) * 2 + (h)) * HTB)
#define PG8_SB(b, h) ((4 + (b) * 2 + (h)) * HTB)
#define PG8_STAGE(bufoff, gbase, voff) do { _Pragma("unroll") for (int _i = 0; _i < 2; ++_i) \
        __builtin_amdgcn_global_load_lds((const unsigned*)((const char*)(gbase) + (voff)[_i]), (PG8_LAS unsigned*)(lds + (bufoff) + ldsw + _i * 8192), 16, 0, 0); } while (0)
#define PG8_STAGEG(bufoff, base, pk) do { unsigned vg_[2]; _Pragma("unroll") for (int i_ = 0; i_ < 2; ++i_) { int R_, C_; stage_rc(tid * 16 + i_ * 8192, R_, C_); vg_[i_] = (((pk) >> (16 * i_)) & 0xffffu) * (unsigned)(2 * K) + (unsigned)(2 * C_); } PG8_STAGE(bufoff, base, vg_); } while (0)
#define PG8_STAGEA(bufoff, base, hh, nx) do { if constexpr (GATHER) { const unsigned pk_ = (nx) ? vAn[hh] : vAc[hh]; PG8_STAGEG(bufoff, base, pk_); } else PG8_STAGE(bufoff, (base) + (hh) * hstep, voffA); } while (0)
#define PG8_GOFF(dst, unit) do { _Pragma("unroll") for (int hh_ = 0; hh_ < 2; ++hh_) { unsigned pk_ = 0u; _Pragma("unroll") for (int i_ = 0; i_ < 2; ++i_) { int R_, C_; stage_rc(tid * 16 + i_ * 8192, R_, C_); \
        const int t2_ = g.rowmap[(unit).pm * BM + hh_ * HALF + R_]; pk_ |= (unsigned)(t2_ < 0 ? 0 : (t2_ >> 1)) << (16 * i_); } dst[hh_] = pk_; } } while (0)
#define PG8_LDA(dst, b, h) do { _Pragma("unroll") for (int m = 0; m < 4; ++m) _Pragma("unroll") for (int k = 0; k < 2; ++k) dst[m][k] = *(const PG8_LAS bf16x8*)(lds + PG8_SA(b, h) + aoff + m * 2048 + k * 1024); } while (0)
#define PG8_LDB(dst, b, h) do { _Pragma("unroll") for (int n = 0; n < 2; ++n) _Pragma("unroll") for (int k = 0; k < 2; ++k) dst[n][k] = *(const PG8_LAS bf16x8*)(lds + PG8_SB(b, h) + boff + n * 2048 + k * 1024); } while (0)
#define PG8_MMA(ai, bj, At, Bt) do { __builtin_amdgcn_s_setprio(1); _Pragma("unroll") for (int m = 0; m < 4; ++m) _Pragma("unroll") for (int n = 0; n < 2; ++n) _Pragma("unroll") for (int k = 0; k < 2; ++k) \
        acc[ai][bj][m][n] = __builtin_amdgcn_mfma_f32_16x16x32_bf16(Bt[n][k], At[m][k], acc[ai][bj][m][n], 0, 0, 0); __builtin_amdgcn_s_setprio(0); } while (0)
#define PG8_WAIT_V(n) asm volatile("s_waitcnt vmcnt(" #n ")" ::: "memory")
#define PG8_WAIT_L(n) asm volatile("s_waitcnt lgkmcnt(" #n ")" ::: "memory")
#define PG8_BAR __builtin_amdgcn_s_barrier()
#define PG8_SCHED __builtin_amdgcn_sched_barrier(0)
    Unit cur, nxt; int ui = 0;
    if (!S.next(0, cur)) return;
    f32x4 acc[2][2][4][2];
#pragma unroll
    for (int a = 0; a < 2; ++a)
#pragma unroll
        for (int b = 0; b < 2; ++b)
#pragma unroll
            for (int m = 0; m < 4; ++m)
#pragma unroll
                for (int n = 0; n < 2; ++n) acc[a][b][m][n] = (f32x4){0.f, 0.f, 0.f, 0.f};
    bf16x8 At[4][2], B0[2][2], B1[2][2];
    const char* cA = (const char*)g.A + (GATHER ? (size_t)0 : (size_t)cur.pm * tstep); const char* cB = (const char*)g.Bt + (size_t)cur.pn * tstep;
    if constexpr (GATHER) { PG8_GOFF(vAc, cur); }
    S.a_ready(cur);
    if constexpr (SP2) {
        PG8_STAGE(PG8_SB(0, 0), cB, voffB); PG8_STAGE(PG8_SB(0, 1), cB + hstep, voffB); PG8_STAGEA(PG8_SA(0, 0), cA, 0, false); PG8_STAGEA(PG8_SA(0, 1), cA, 1, false);
        if (wr == 1) PG8_BAR;
        PG8_WAIT_V(2); PG8_BAR;
        PG8_STAGE(PG8_SB(1, 0), cB + kstep, voffB); PG8_STAGEA(PG8_SA(1, 0), cA + kstep, 0, false); PG8_STAGE(PG8_SB(1, 1), cB + hstep + kstep, voffB);
        PG8_WAIT_V(6); PG8_BAR;
    } else {
        PG8_STAGE(PG8_SB(0, 0), cB, voffB); PG8_STAGE(PG8_SA(0, 0), cA, voffA); PG8_STAGE(PG8_SB(0, 1), cB + hstep, voffB); PG8_STAGE(PG8_SA(0, 1), cA + hstep, voffA);
        if (wr == 1) PG8_BAR;
        PG8_WAIT_V(4); PG8_BAR;
        PG8_STAGE(PG8_SB(1, 0), cB + kstep, voffB); PG8_STAGE(PG8_SA(1, 0), cA + kstep, voffA); PG8_STAGE(PG8_SB(1, 1), cB + hstep + kstep, voffB);
        PG8_WAIT_V(6); PG8_BAR;
    }
    for (;;) {
        const bool has_next = S.next(ui + 1, nxt);
        const char* nA = (has_next && !GATHER) ? (const char*)g.A + (size_t)nxt.pm * tstep : cA;
        if constexpr (GATHER) { if (has_next) { PG8_GOFF(vAn, nxt); } else { vAn[0] = vAc[0]; vAn[1] = vAc[1]; } } const char* nB = has_next ? (const char*)g.Bt + (size_t)nxt.pn * tstep : cB;
        for (int t = 0; t < nt; t += 2) {
            const bool last = (t == nt - 2);
            const char* a1 = cA + (size_t)(t + 1) * kstep;
            const char* a2 = last ? nA : cA + (size_t)(t + 2) * kstep; const char* b2 = last ? nB : cB + (size_t)(t + 2) * kstep;
            const char* a3 = a2 + kstep; const char* b3 = b2 + kstep;
            if (last && has_next) S.a_ready(nxt);
            if constexpr (SP2) {
            PG8_LDB(B0, 0, 0); PG8_LDB(B1, 0, 1); PG8_SCHED; PG8_LDA(At, 0, 0); PG8_STAGEA(PG8_SA(1, 1), a1, 1, false);
            PG8_WAIT_V(8); PG8_WAIT_L(0); PG8_BAR; PG8_MMA(0, 0, At, B0); PG8_MMA(0, 1, At, B1); PG8_BAR; PG8_SCHED;
            PG8_LDA(At, 0, 1); PG8_STAGE(PG8_SB(0, 0), b2, voffB); PG8_STAGE(PG8_SB(0, 1), b2 + hstep, voffB); PG8_STAGEA(PG8_SA(0, 0), a2, 0, last);
            PG8_WAIT_V(8); PG8_WAIT_L(0); PG8_BAR; PG8_MMA(1, 0, At, B0); PG8_MMA(1, 1, At, B1); PG8_BAR; PG8_SCHED;
            PG8_LDB(B0, 1, 0); PG8_LDB(B1, 1, 1); PG8_SCHED; PG8_LDA(At, 1, 0); PG8_STAGEA(PG8_SA(0, 1), a2, 1, last);
            PG8_WAIT_V(8); PG8_WAIT_L(0); PG8_BAR; PG8_MMA(0, 0, At, B0); PG8_MMA(0, 1, At, B1); PG8_BAR; PG8_SCHED;
            PG8_LDA(At, 1, 1); PG8_STAGE(PG8_SB(1, 0), b3, voffB); PG8_STAGE(PG8_SB(1, 1), b3 + hstep, voffB); PG8_STAGEA(PG8_SA(1, 0), a3, 0, last);
            PG8_WAIT_V(8); PG8_WAIT_L(0); PG8_BAR; PG8_MMA(1, 0, At, B0); PG8_MMA(1, 1, At, B1); PG8_BAR; PG8_SCHED;
            } else {
            PG8_LDB(B0, 0, 0); PG8_SCHED; PG8_LDA(At, 0, 0); PG8_STAGE(PG8_SA(1, 1), a1 + hstep, voffA);
            PG8_WAIT_L(8); PG8_BAR; PG8_WAIT_L(0); PG8_MMA(0, 0, At, B0); PG8_BAR; PG8_SCHED;
            PG8_LDB(B1, 0, 1); PG8_STAGE(PG8_SB(0, 0), b2, voffB);
            PG8_BAR; PG8_WAIT_L(0); PG8_MMA(0, 1, At, B1); PG8_BAR;
            PG8_LDA(At, 0, 1); PG8_STAGE(PG8_SA(0, 0), a2, voffA);
            PG8_BAR; PG8_WAIT_L(0); PG8_MMA(1, 0, At, B0); PG8_BAR; PG8_SCHED;
            PG8_STAGE(PG8_SB(0, 1), b2 + hstep, voffB);
            PG8_WAIT_V(6); PG8_BAR; PG8_MMA(1, 1, At, B1); PG8_BAR;
            PG8_LDB(B0, 1, 0); PG8_SCHED; PG8_LDA(At, 1, 0); PG8_STAGE(PG8_SA(0, 1), a2 + hstep, voffA);
            PG8_WAIT_L(8); PG8_BAR; PG8_WAIT_L(0); PG8_MMA(0, 0, At, B0); PG8_BAR; PG8_SCHED;
            PG8_LDB(B1, 1, 1); PG8_STAGE(PG8_SB(1, 0), b3, voffB);
            PG8_BAR; PG8_WAIT_L(0); PG8_MMA(0, 1, At, B1); PG8_BAR;
            PG8_LDA(At, 1, 1); PG8_STAGE(PG8_SA(1, 0), a3, voffA);
            PG8_BAR; PG8_WAIT_L(0); PG8_MMA(1, 0, At, B0); PG8_BAR; PG8_SCHED;
            PG8_STAGE(PG8_SB(1, 1), b3 + hstep, voffB);
            PG8_WAIT_V(6); PG8_BAR; PG8_MMA(1, 1, At, B1); PG8_BAR;
            }
        }
        if constexpr (ALIGN_EPI) { if (wr == 0) PG8_BAR; }
        if constexpr (!Epi::AFTER_DRAIN) { E(acc, cur, wr, wc, fr, fq); S.done(cur); }
        if (!has_next) break;
#pragma unroll
        for (int a = 0; a < 2; ++a)
#pragma unroll
            for (int b = 0; b < 2; ++b)
#pragma unroll
                for (int m = 0; m < 4; ++m)
#pragma unroll
                    for (int n = 0; n < 2; ++n) acc[a][b][m][n] = (f32x4){0.f, 0.f, 0.f, 0.f};
        cur = nxt; cA = nA; cB = nB; ++ui;
        if constexpr (GATHER) { vAc[0] = vAn[0]; vAc[1] = vAn[1]; }
        if constexpr (ALIGN_EPI) { if (wr == 1) PG8_BAR; }
    }
    PG8_WAIT_V(0);
    if constexpr (!ALIGN_EPI) { if (wr == 0) PG8_BAR; }
    PG8_BAR;
    if constexpr (Epi::AFTER_DRAIN) { E.fused(acc, cur, wr, wc, fr, fq, lds, wid, lane); S.done(cur); }
#undef PG8_SA
#undef PG8_SB
#undef PG8_STAGE
#undef PG8_STAGEA
#undef PG8_STAGEG
#undef PG8_GOFF
#undef PG8_LDA
#undef PG8_LDB
#undef PG8_MMA
#undef PG8_WAIT_V
#undef PG8_WAIT_L
#undef PG8_BAR
#undef PG8_SCHED
}
}
#define XB_TMO      128
#define XB_XCNT(j)  (256  + 64 * (j))
#define XB_XSUB(j)  (1280 + 64 * (j))
#define XB_XGEN(j)  (2304 + 64 * (j))
#define XB_TOP      3328
#define XB_TOPGEN   3392
#define XCD_BAR_WORDS 3456
#define XB_SPIN_CAP (1u << 18)
#define LAS __attribute__((address_space(3)))

__device__ __forceinline__ unsigned xb_ld(unsigned* p)              { return __hip_atomic_load(p, __ATOMIC_RELAXED, __HIP_MEMORY_SCOPE_AGENT); }
__device__ __forceinline__ unsigned xb_add(unsigned* p, unsigned v) { return __hip_atomic_fetch_add(p, v, __ATOMIC_RELAXED, __HIP_MEMORY_SCOPE_AGENT); }
__device__ __forceinline__ unsigned xb_xcc_id() { return (unsigned)__builtin_amdgcn_s_getreg((3 << 11) | 20) & 0xFu; }
#define XB_SPIN(cond, bar) do { unsigned _sp = 0; while (cond) { __builtin_amdgcn_s_sleep(1); \
    if ((++_sp & 255u) == 0u) { if (xb_ld(&(bar)[XB_TMO])) break; if (_sp > XB_SPIN_CAP) { atomicAdd(&(bar)[XB_TMO], 1u); break; } } } } while (0)

struct XcdBarrier {
    unsigned* bar; unsigned x;
    volatile LAS unsigned* st;
};

__device__ __forceinline__ XcdBarrier xcd_barrier_post(unsigned* bar, volatile LAS unsigned* st) {
    XcdBarrier b; b.bar = bar; b.x = xb_xcc_id(); b.st = st;
    if (threadIdx.x == 0) (void)xb_add(&bar[XB_XCNT(b.x)], 1u);
    return b;
}
__device__ __forceinline__ void xcd_barrier_complete(unsigned* bar, unsigned x, unsigned& nloc, unsigned& nx) {
    const unsigned G = gridDim.x * gridDim.y * gridDim.z;
    unsigned sum, cnt, mine, sp = 0u;
    for (;;) {
        sum = 0u; cnt = 0u; mine = 0u;
#pragma unroll
        for (unsigned j = 0; j < 16; ++j) { const unsigned c = xb_ld(&bar[XB_XCNT(j)]); sum += c; cnt += (c > 0u) ? 1u : 0u; mine = (j == x) ? c : mine; }
        if (sum == G) break;
        __builtin_amdgcn_s_sleep(1);
        if ((++sp & 255u) == 0u) { if (xb_ld(&bar[XB_TMO])) break; if (sp > XB_SPIN_CAP) { atomicAdd(&bar[XB_TMO], 1u); break; } }
    }
    nloc = mine > 0u ? mine : 1u; nx = cnt > 0u ? cnt : 1u;
}

__device__ __forceinline__ void xcd_barrier(const XcdBarrier& b) {
    asm volatile("s_waitcnt vmcnt(0)" ::: "memory");
    __syncthreads();
    if (threadIdx.x == 0) {
        unsigned* bar = b.bar;
        __builtin_amdgcn_s_waitcnt(0);
        unsigned nloc = b.st[0], nx = b.st[1];
        if (nloc == 0u) { xcd_barrier_complete(bar, b.x, nloc, nx); b.st[0] = nloc; b.st[1] = nx; }
        const unsigned old = xb_add(&bar[XB_XSUB(b.x)], 1u);
        const unsigned gen = old / nloc;
        if (old + 1u == (gen + 1u) * nloc) {
            __builtin_amdgcn_fence(__ATOMIC_RELEASE, "agent");
            asm volatile("s_waitcnt vmcnt(0)" ::: "memory");
            const unsigned og = xb_add(&bar[XB_TOP], 1u);
            const unsigned tg = og / nx;
            if (og + 1u == (tg + 1u) * nx) xb_add(&bar[XB_TOPGEN], 1u);
            else XB_SPIN(xb_ld(&bar[XB_TOPGEN]) == tg, bar);
            __builtin_amdgcn_fence(__ATOMIC_ACQUIRE, "agent");
            xb_add(&bar[XB_XGEN(b.x)], 1u);
            asm volatile("s_waitcnt vmcnt(0)" ::: "memory");
        } else {
            XB_SPIN(xb_ld(&bar[XB_XGEN(b.x)]) == gen, bar);
            __builtin_amdgcn_fence(__ATOMIC_ACQUIRE, "agent");
            asm volatile("s_waitcnt vmcnt(0)" ::: "memory");
        }
    }
    __syncthreads();
}

struct Args { const float* in[47]; float* out; unsigned char* ws; int ph_lo, ph_hi; };
typedef const __attribute__((address_space(4))) Args* KArgsP;
__device__ __forceinline__ KArgsP fresh_args() { KArgsP p = (KArgsP)__builtin_amdgcn_kernarg_segment_ptr(); asm volatile("" : "+s"(p)); return p; }
enum { I_X = 0, I_C, I_ADA_W, I_ADA_B, I_NORM_MIX, I_NORM_FFN, I_NORM_FINAL, I_W_IN, I_W_OUT, I_CONV_W, I_CONV_B, I_WQ, I_WK, I_BI, I_BF, I_MNORM_W,
       I_RMU, I_RW0, I_RWUP, I_RA0, I_RAUP, I_RGUP, I_RKK, I_RKA, I_RRK, I_RLNW, I_RLNB, I_RV0, I_RVDN, I_RVUP,
       I_S5ARE, I_S5AIM, I_S5LDT, I_S5BRE, I_S5BIM, I_S5CRE, I_S5CIM, I_S5D, I_S5GLUW, I_S5GLUB,
       I_MWRG, I_MBRG, I_MWRE, I_MBRE, I_MW1, I_MW3, I_MW2 };

struct RmWin { __device__ __forceinline__ int operator()(int n) const { return n < 1152 ? n : (n < 1164 ? 2816 + (n - 1152) : (n < 2572 ? 1152 + (n - 1164) : 2560 + (n - 2572))); } };
struct RmId  { __device__ __forceinline__ int operator()(int n) const { return n; } };
struct RmGU  { int add; __device__ __forceinline__ int operator()(int n) const { return 8 * (n >> 2) + (n & 3) + add; } };
template <class RM>
__device__ __forceinline__ void transpose_item(const float* W, int ldw, int ncols, int k0, int n0, bf16* WT, int ldt, LAS float* scr, int lane, const RM rm) {
    const int nn = n0 + lane; const bool ok = nn < ncols; const float* src = W + (size_t)k0 * ldw + (ok ? nn : n0);
    float v[64];
#pragma unroll
    for (int kk = 0; kk < 64; ++kk) v[kk] = src[(size_t)kk * ldw];
#pragma unroll
    for (int kk = 0; kk < 64; ++kk) scr[kk * 65 + lane] = v[kk];
    LDS_WAIT(); asm volatile("" ::: "memory");
    const int c = lane & 7;
#pragma unroll
    for (int j = 0; j < 8; ++j) { const int nl = (lane >> 3) + 8 * j; const LAS float* s = scr + (8 * c) * 65 + nl;
        v4u o; o.x = pk2(s[0 * 65], s[1 * 65]); o.y = pk2(s[2 * 65], s[3 * 65]); o.z = pk2(s[4 * 65], s[5 * 65]); o.w = pk2(s[6 * 65], s[7 * 65]);
        if (n0 + nl < ncols) *(GAS v4u*)(WT + (size_t)rm(n0 + nl) * ldt + k0 + 8 * c) = o; }
    LDS_WAIT(); asm volatile("" ::: "memory");
}
__device__ __forceinline__ void moe_convert(const float* w1, const float* w3, const float* w2, int l, bf16* W13, bf16* W2T, int worker, int nworkers, LAS float* scr, int lane) {
    for (int it = worker; it < NEXP * 384; it += nworkers) {
        const int e = it / 384, r = it % 384; const size_t eo = (size_t)(l * NEXP + e) * DM * DEXP;
        if (r < 128)      transpose_item(w1 + eo, DEXP, DEXP, 64 * (r >> 3), 64 * (r & 7), W13 + (size_t)e * 1024 * 1024, 1024, scr, lane, RmGU{0});
        else if (r < 256) transpose_item(w3 + eo, DEXP, DEXP, 64 * ((r - 128) >> 3), 64 * ((r - 128) & 7), W13 + (size_t)e * 1024 * 1024, 1024, scr, lane, RmGU{4});
        else              transpose_item(w2 + eo, DM, DM, 64 * ((r - 256) >> 4), 64 * ((r - 256) & 15), W2T + (size_t)e * 1024 * 512, 512, scr, lane, RmId{});
    }
}
__device__ __forceinline__ void phase_prologue(KArgsP a, LAS unsigned char* lds, int tid, int lane, int wave, int vcu, int G) {
    unsigned char* ws = a->ws;
    LAS float* scr = (LAS float*)(lds + wave * 16640);
    const int gw = vcu * NWAVES + wave, NGW = G * NWAVES;
    bf16* WIN = (bf16*)(ws + WS_WIN); bf16* WOUT = (bf16*)(ws + WS_WOUT);
    for (int it = gw; it < 2 * 16 * 45; it += NGW) { const int l = it / (16 * 45), r = it % (16 * 45);
        transpose_item(a->in[I_W_IN] + (size_t)l * DM * IN_COLS, IN_COLS, IN_COLS, 64 * (r / 45), 64 * (r % 45), WIN + (size_t)l * NPROJ_PAD * DM, DM, scr, lane, RmWin{}); }
    for (int it = gw; it < 2 * 16 * 16; it += NGW) { const int l = it / 256, r = it % 256;
        transpose_item(a->in[I_W_OUT] + (size_t)l * DM * DM, DM, DM, 64 * (r >> 4), 64 * (r & 15), WOUT + (size_t)l * DM * DM, DM, scr, lane, RmId{}); }
    for (int it = gw; it < 2 * 244; it += NGW) { const int l = it / 244, r = 2828 + it % 244; GAS v4u* p = (GAS v4u*)(WIN + ((size_t)l * NPROJ_PAD + r) * DM);
        p[lane] = (v4u){0u, 0u, 0u, 0u}; p[lane + 64] = (v4u){0u, 0u, 0u, 0u}; }
    { float* RTW = (float*)(ws + WS_RTW);
      for (int idx = (vcu * NTHR + tid); idx < 2 * 1024 * 48; idx += G * NTHR) { const int j = idx % 48, k = (idx / 48) % 1024, l = idx / (48 * 1024);
          RTW[idx] = j < 4 ? a->in[I_MWRG][(size_t)(l * 1024 + k) * 4 + j] : (j < 36 ? a->in[I_MWRE][(size_t)(l * 1024 + k) * 32 + (j - 4)] : 0.f); } }
    { bf16* RW = (bf16*)(ws + WS_R1W);
      for (int idx = (vcu * NTHR + tid); idx < 2 * 98304 + 24576; idx += G * NTHR) { float v;
          if (idx < 2 * 98304) { const int l = idx / 98304, r = idx % 98304;
              if (r < 24576)      v = a->in[I_RWUP][(size_t)l * 64 * DBR + (r & 63) * DBR + (r >> 6)];
              else if (r < 49152) v = a->in[I_RAUP][(size_t)l * 64 * DBR + ((r - 24576) & 63) * DBR + ((r - 24576) >> 6)];
              else                v = a->in[I_RGUP][(size_t)l * 128 * DBR + ((r - 49152) & 127) * DBR + ((r - 49152) >> 7)];
          } else { const int r = idx - 2 * 98304;
              if (r < 12288) v = a->in[I_RVDN][(size_t)(r % 384) * 32 + (r / 384)];
              else           v = a->in[I_RVUP][(size_t)((r - 12288) & 31) * DBR + ((r - 12288) >> 5)]; }
          RW[idx] = (bf16)f2bf(v); } }
    { bf16* CM = (bf16*)(ws + WS_S5CM);
      for (int idx = (vcu * NTHR + tid); idx < 2 * 16 * 16 * 128; idx += G * NTHR) { const int k = idx & 127, lgc = idx >> 7;
          CM[idx] = (bf16)f2bf((k & 1) ? -a->in[I_S5CIM][(size_t)lgc * 64 + (k >> 1)] : a->in[I_S5CRE][(size_t)lgc * 64 + (k >> 1)]); } }
    for (int it = gw; it < 2 * 16; it += NGW) { const int l = it >> 4, r = it & 15;
        transpose_item(a->in[I_S5GLUW] + (size_t)l * DC * DC, DC, DC, 64 * (r >> 2), 64 * (r & 3), (bf16*)(ws + WS_GLUT) + (size_t)l * DC * DC, DC, scr, lane, RmId{}); }
    { bf16* MLW = (bf16*)(ws + WS_MLW);
      for (int idx = (vcu * NTHR + tid); idx < 2 * NH * 2 * 4096; idx += G * NTHR) { const int d = idx & 63, e = (idx >> 6) & 63, which = (idx >> 12) & 1, lh = idx >> 13;
          MLW[idx] = (bf16)f2bf(a->in[which ? I_WK : I_WQ][(size_t)lh * 4096 + d * 64 + e]); } }
    __syncthreads();
    if (vcu < 192) {
        const int q = vcu, l = q / 96, cb = (q >> 3) % 12, kc = q & 7;
        LAS float* cond = (LAS float*)lds;
        { const int b = tid >> 7, kk = tid & 127; const float cv = a->in[I_C][b * DM + kc * 128 + kk]; cond[tid] = cv / (1.f + __expf(-cv)); }
        __syncthreads();
        const int col = cb * 512 + tid; const float* wp = a->in[I_ADA_W] + ((size_t)l * DM + kc * 128) * 6144 + col;
        float acc0 = 0.f, acc1 = 0.f, acc2 = 0.f, acc3 = 0.f;
#pragma unroll 8
        for (int kk = 0; kk < 128; ++kk) { const float w = wp[(size_t)kk * 6144]; acc0 += cond[kk] * w; acc1 += cond[128 + kk] * w; acc2 += cond[256 + kk] * w; acc3 += cond[384 + kk] * w; }
        const float bias = (kc == 0) ? a->in[I_ADA_B][l * 6144 + col] : 0.f;
        float* MP = (float*)(ws + WS_MODP) + ((size_t)(kc * 2 + l) * 4) * 6144 + col;
        MP[0] = acc0 + bias; MP[6144] = acc1 + bias; MP[2 * 6144] = acc2 + bias; MP[3 * 6144] = acc3 + bias;
    }
}

__device__ __forceinline__ float modval(const unsigned char* ws, bool part, int l, int b, int idx) {
    if (!part) return ((const float*)(ws + WS_MODF))[(size_t)(l * 4 + b) * 6144 + idx];
    const float* mp = (const float*)(ws + WS_MODP) + (size_t)(l * 4 + b) * 6144 + idx; float s = 0.f;
#pragma unroll
    for (int kc = 0; kc < 8; ++kc) s += mp[(size_t)kc * 2 * 4 * 6144];
    return s;
}
template <int MODE, bool COMBINE>
__device__ __forceinline__ void phase_rownorm(KArgsP a, LAS unsigned char* lds, int tid, int lane, int wave, int G,
                                              const float* xsrc, float* xdst, const float* gvec, bool part, int l, int isc  , int lprev) {
    unsigned char* ws = a->ws;
    LAS float* sc = (LAS float*)lds; LAS float* sh = sc + 1024; LAS float* gt = sh + 1024;
    bf16* HN = (bf16*)(ws + WS_HN); const bf16* YM = (const bf16*)(ws + WS_YMOE); const float* TW = (const float*)(ws + WS_TOKW);
    for (int c = blockIdx.x; c < NTOK / 128; c += G) {
        const int b = c >> 6;
        __syncthreads();
        for (int j = tid; j < 1024; j += NTHR) {
            if (MODE == 0) { sc[j] = gvec[j] * (1.f + modval(ws, part, l, b, (isc + 1) * 1024 + j)); sh[j] = modval(ws, part, l, b, isc * 1024 + j); }
            else { sc[j] = gvec[j]; sh[j] = 0.f; }
            if (COMBINE) gt[j] = 1.f + modval(ws, false, lprev, b, 5 * 1024 + j);
        }
        __syncthreads();
        f32x4 vn[4]; v2u yn0[4], yn1[4]; float wn0 = 0.f, wn1 = 0.f;
        { const int row = c * 128 + wave * 16; const GAS f32x4* xr = (const GAS f32x4*)(xsrc + (size_t)row * DM) + lane;
#pragma unroll
          for (int j = 0; j < 4; ++j) vn[j] = xr[64 * j];
          if (COMBINE) { wn0 = TW[2 * row]; wn1 = TW[2 * row + 1]; const GAS v2u* y0 = (const GAS v2u*)(YM + (size_t)(2 * row) * DM) + lane; const GAS v2u* y1 = (const GAS v2u*)(YM + (size_t)(2 * row + 1) * DM) + lane;
#pragma unroll
              for (int j = 0; j < 4; ++j) { yn0[j] = y0[64 * j]; yn1[j] = y1[64 * j]; } } }
        for (int i = 0; i < 16; ++i) {
            const int row = c * 128 + wave * 16 + i;
            f32x4 v[4]; v2u q0[4], q1[4]; const float w0 = wn0, w1 = wn1;
#pragma unroll
            for (int j = 0; j < 4; ++j) { v[j] = vn[j]; q0[j] = yn0[j]; q1[j] = yn1[j]; }
            if (i + 1 < 16) { const int rn = row + 1; const GAS f32x4* xr = (const GAS f32x4*)(xsrc + (size_t)rn * DM) + lane;
#pragma unroll
                for (int j = 0; j < 4; ++j) vn[j] = xr[64 * j];
                if (COMBINE) { wn0 = TW[2 * rn]; wn1 = TW[2 * rn + 1]; const GAS v2u* y0 = (const GAS v2u*)(YM + (size_t)(2 * rn) * DM) + lane; const GAS v2u* y1 = (const GAS v2u*)(YM + (size_t)(2 * rn + 1) * DM) + lane;
#pragma unroll
                    for (int j = 0; j < 4; ++j) { yn0[j] = y0[64 * j]; yn1[j] = y1[64 * j]; } } }
            if (COMBINE) {
#pragma unroll
                for (int j = 0; j < 4; ++j) { const v2u p0 = q0[j], p1 = q1[j]; const f32x4 g4 = *(const LAS f32x4*)(gt + lane * 4 + 256 * j);
                    f32x4 m; m.x = w0 * bflo(p0.x) + w1 * bflo(p1.x); m.y = w0 * bfhi(p0.x) + w1 * bfhi(p1.x); m.z = w0 * bflo(p0.y) + w1 * bflo(p1.y); m.w = w0 * bfhi(p0.y) + w1 * bfhi(p1.y);
                    v[j] = v[j] + g4 * m; }
                if (MODE == 0) { GAS f32x4* xo = (GAS f32x4*)(xdst + (size_t)row * DM) + lane;
#pragma unroll
                    for (int j = 0; j < 4; ++j) xo[64 * j] = v[j]; }
            }
            float ss = 0.f;
#pragma unroll
            for (int j = 0; j < 4; ++j) ss += (v[j].x * v[j].x + v[j].y * v[j].y) + (v[j].z * v[j].z + v[j].w * v[j].w);
            const float rstd = rsqrtf(wave_sum(ss) * (1.f / DM) + NORM_EPS);
            if (MODE == 0) {
                GAS v2u* o = (GAS v2u*)(HN + (size_t)row * DM) + lane;
#pragma unroll
                for (int j = 0; j < 4; ++j) { const f32x4 s4 = *(const LAS f32x4*)(sc + lane * 4 + 256 * j), h4 = *(const LAS f32x4*)(sh + lane * 4 + 256 * j); const f32x4 h = v[j] * rstd * s4 + h4;
                    v2u w; w.x = pk2(h.x, h.y); w.y = pk2(h.z, h.w); o[64 * j] = w; }
            } else {
                GAS f32x4* o = (GAS f32x4*)(xdst + (size_t)row * DM) + lane;
#pragma unroll
                for (int j = 0; j < 4; ++j) { const f32x4 s4 = *(const LAS f32x4*)(sc + lane * 4 + 256 * j); o[64 * j] = v[j] * rstd * s4; }
            }
        }
    }
}
__device__ __forceinline__ void mod_finalize(unsigned char* ws, int tid, int G) {
    float* MF = (float*)(ws + WS_MODF);
    for (int idx = blockIdx.x * NTHR + tid; idx < 2 * 4 * 6144; idx += G * NTHR) { const float* mp = (const float*)(ws + WS_MODP) + idx; float s = 0.f;
#pragma unroll
        for (int kc = 0; kc < 8; ++kc) s += mp[(size_t)kc * 2 * 4 * 6144];
        MF[idx] = s; }
}

typedef float f32x4m __attribute__((ext_vector_type(4)));
__device__ __forceinline__ void phase_router(KArgsP a, LAS unsigned char* lds, int tid, int lane, int wave, int G, int l) {
    unsigned char* ws = a->ws;
    LAS float* sc = (LAS float*)lds; LAS float* sh = sc + 1024; LAS float* rstd_s = sh + 1024  ; LAS float* cvec = rstd_s + 128  ; LAS float* cpart = cvec + 64  ;
    LAS float* lg = cpart + 8 * 48  ; LAS int* hist = (LAS int*)(lg + 8 * 16 * 48)  ; LAS int* basev = hist + 32; LAS int* asg_e = basev + 32  ; LAS int* asg_lp = asg_e + 256;
    bf16* HN = (bf16*)(ws + WS_HN); const float* x = a->out; const float* RTW = (const float*)(ws + WS_RTW) + (size_t)l * 1024 * 48;
    int* TOKE = (int*)(ws + WS_TOKE); float* TOKW = (float*)(ws + WS_TOKW); int* LIST = (int*)(ws + WS_LIST); unsigned* CNT = (unsigned*)(ws + WS_CTL) + CW_CNT + l * 32;
    const float* gvec = a->in[I_NORM_FFN] + l * DM;
    for (int c = blockIdx.x; c < NTOK / 128; c += G) {
        const int b = c >> 6;
        __syncthreads();
        for (int j = tid; j < 1024; j += NTHR) { sc[j] = gvec[j] * (1.f + modval(ws, false, l, b, 4 * 1024 + j)); sh[j] = modval(ws, false, l, b, 3 * 1024 + j); }
        if (tid < 32) hist[tid] = 0;
        __syncthreads();
        if (tid < 384) { const int j = tid % 48, part = tid / 48; float s = 0.f;
            for (int k = part * 128; k < part * 128 + 128; ++k) s += sh[k] * RTW[(size_t)k * 48 + j];
            cpart[part * 48 + j] = s; }
        { f32x4 vn[4];
          { const GAS f32x4* xr = (const GAS f32x4*)(x + (size_t)(c * 128 + wave * 16) * DM) + lane;
#pragma unroll
            for (int j = 0; j < 4; ++j) vn[j] = xr[64 * j]; }
          for (int i = 0; i < 16; ++i) {
            const int row = c * 128 + wave * 16 + i;
            f32x4 v[4]; float ss = 0.f;
#pragma unroll
            for (int j = 0; j < 4; ++j) { v[j] = vn[j]; ss += (v[j].x * v[j].x + v[j].y * v[j].y) + (v[j].z * v[j].z + v[j].w * v[j].w); }
            if (i + 1 < 16) { const GAS f32x4* xr = (const GAS f32x4*)(x + (size_t)(row + 1) * DM) + lane;
#pragma unroll
                for (int j = 0; j < 4; ++j) vn[j] = xr[64 * j]; }
            const float rstd = rsqrtf(wave_sum(ss) * (1.f / DM) + NORM_EPS);
            if (lane == 0) rstd_s[wave * 16 + i] = rstd;
            GAS v2u* o = (GAS v2u*)(HN + (size_t)row * DM) + lane;
#pragma unroll
            for (int j = 0; j < 4; ++j) { const f32x4 s4 = *(const LAS f32x4*)(sc + lane * 4 + 256 * j), h4 = *(const LAS f32x4*)(sh + lane * 4 + 256 * j); const f32x4 h = v[j] * rstd * s4 + h4;
                v2u w; w.x = pk2(h.x, h.y); w.y = pk2(h.z, h.w); o[64 * j] = w; }
          } }
        __syncthreads();
        if (tid < 48) { float s = 0.f;
#pragma unroll
            for (int p = 0; p < 8; ++p) s += cpart[p * 48 + tid];
            s += tid < 4 ? a->in[I_MBRG][l * 4 + tid] : (tid < 36 ? a->in[I_MBRE][l * 32 + tid - 4] : 0.f); cvec[tid] = s; }
        {
            const int i16 = lane & 15, kq = lane >> 4, r0 = c * 128 + wave * 16;
            f32x4m acc0 = {0.f, 0.f, 0.f, 0.f}, acc1 = acc0, acc2 = acc0;
            const float* xrow = x + (size_t)(r0 + i16) * DM + 4 * kq;
            for (int k0 = 0; k0 < DM; k0 += 16) {
                const f32x4 xv = *(const GAS f32x4*)(xrow + k0); const f32x4 sv = *(const LAS f32x4*)(sc + k0 + 4 * kq);
                const float* wp = RTW + (size_t)(k0 + 4 * kq) * 48 + i16;
#pragma unroll
                for (int j = 0; j < 4; ++j) { const float av = xv[j] * sv[j];
                    acc0 = __builtin_amdgcn_mfma_f32_16x16x4f32(av, wp[j * 48], acc0, 0, 0, 0);
                    acc1 = __builtin_amdgcn_mfma_f32_16x16x4f32(av, wp[j * 48 + 16], acc1, 0, 0, 0);
                    acc2 = __builtin_amdgcn_mfma_f32_16x16x4f32(av, wp[j * 48 + 32], acc2, 0, 0, 0); }
            }
            __syncthreads();
            LAS float* lw = lg + wave * 16 * 48;
#pragma unroll
            for (int r = 0; r < 4; ++r) { const int rr = 4 * kq + r; const float rs = rstd_s[wave * 16 + rr];
                lw[rr * 48 + i16] = acc0[r] * rs + cvec[i16]; lw[rr * 48 + 16 + i16] = acc1[r] * rs + cvec[16 + i16]; lw[rr * 48 + 32 + i16] = acc2[r] * rs + cvec[32 + i16]; }
            LDS_WAIT(); asm volatile("" ::: "memory");
            if (lane < 16) {
                const LAS float* lr = lw + lane * 48; const int row = r0 + lane;
                float g0 = lr[0], g1 = lr[1], g2 = lr[2], g3 = lr[3]; const float gm = fmaxf(fmaxf(g0, g1), fmaxf(g2, g3));
                float p0 = __expf(g0 - gm), p1 = __expf(g1 - gm), p2 = __expf(g2 - gm), p3 = __expf(g3 - gm); const float inv = 1.f / (p0 + p1 + p2 + p3);
                p0 *= inv; p1 *= inv; p2 *= inv; p3 *= inv;
                int gi = 0; float gp = p0; if (p1 > gp) { gp = p1; gi = 1; } if (p2 > gp) { gp = p2; gi = 2; } if (p3 > gp) { gp = p3; gi = 3; }
                float ev0 = -3.4e38f, ev1 = -3.4e38f; int e0 = 0, e1 = 0;
#pragma unroll
                for (int j = 0; j < 8; ++j) { const float s = lr[4 + gi * 8 + j]; if (s > ev0) { ev1 = ev0; e1 = e0; ev0 = s; e0 = j; } else if (s > ev1) { ev1 = s; e1 = j; } }
                const float q = __expf(ev1 - ev0), w0 = gp / (1.f + q), w1 = gp * q / (1.f + q);
                e0 += gi * 8; e1 += gi * 8;
                TOKE[2 * row] = e0; TOKE[2 * row + 1] = e1; TOKW[2 * row] = w0; TOKW[2 * row + 1] = w1;
                const int a0 = 2 * (wave * 16 + lane);
                asg_e[a0] = e0; asg_e[a0 + 1] = e1; asg_lp[a0] = atomicAdd((int*)&hist[e0], 1); asg_lp[a0 + 1] = atomicAdd((int*)&hist[e1], 1);
            }
        }
        __syncthreads();
        if (tid < 32) { const int h = hist[tid]; basev[tid] = h ? (int)atomicAdd(CNT + tid, (unsigned)h) : 0; }
        __syncthreads();
        if (tid < 256) { const int e = asg_e[tid]; LIST[(size_t)e * 65536 + basev[e] + asg_lp[tid]] = (c * 128) * 2 + tid; }
    }
}
__device__ __forceinline__ void build_ptab(const unsigned* CNT, LAS int* ptab, LAS int* pst, LAS int* cnt, int tid) {
    __syncthreads();
    if (tid == 0) { int np = 0;
        for (int e = 0; e < NEXP; ++e) { const int ce = (int)__hip_atomic_load(CNT + e, RLX_AGENT); cnt[e] = ce; pst[e] = np * 256; const int pe = (ce + 255) >> 8;
            for (int p = 0; p < pe; ++p) ptab[1 + np + p] = e;
            np += pe; }
        ptab[0] = np; }
    __syncthreads();
}
__device__ __forceinline__ void phase_gather(KArgsP a, LAS unsigned char* lds, int tid, int lane, int wave, int vcu, int G, int l) {
    unsigned char* ws = a->ws;
    LAS int* ptab = (LAS int*)lds; LAS int* pst = ptab + 512; LAS int* cnt = pst + 32;
    build_ptab((const unsigned*)(ws + WS_CTL) + CW_CNT + l * 32, ptab, pst, cnt, tid);
    const bf16* HN = (const bf16*)(ws + WS_HN); bf16* XG = (bf16*)(ws + WS_XG); int* ROWMAP = (int*)(ws + WS_ROWMAP); const int* LIST = (const int*)(ws + WS_LIST);
    const int nrows = ptab[0] * 256;
    for (int row0 = (vcu * NWAVES + wave) * 8; row0 < nrows; row0 += G * NWAVES * 8) {
        int tok2[8]; v4u p0[8], p1[8];
#pragma unroll
        for (int j = 0; j < 8; ++j) { const int row = row0 + j, e = ptab[1 + (row >> 8)], pos = row - pst[e]; tok2[j] = (pos < cnt[e]) ? LIST[(size_t)e * 65536 + pos] : -1; }
#pragma unroll
        for (int j = 0; j < 8; ++j) { if (tok2[j] >= 0) { const GAS v4u* s = (const GAS v4u*)(HN + (size_t)(tok2[j] >> 1) * DM) + lane; p0[j] = s[0]; p1[j] = s[64]; } else { p0[j] = (v4u){0u, 0u, 0u, 0u}; p1[j] = p0[j]; } }
#pragma unroll
        for (int j = 0; j < 8; ++j) { GAS v4u* d = (GAS v4u*)(XG + (size_t)(row0 + j) * DM) + lane; d[0] = p0[j]; d[64] = p1[j]; if (lane == 0) ROWMAP[row0 + j] = tok2[j]; }
    }
}

__device__ __forceinline__ void phase_rowmap(KArgsP a, LAS unsigned char* lds, int tid, int vcu, int G, int l) {
    unsigned char* ws = a->ws;
    LAS int* ptab = (LAS int*)lds; LAS int* pst = ptab + 512; LAS int* cnt = pst + 32;
    build_ptab((const unsigned*)(ws + WS_CTL) + CW_CNT + l * 32, ptab, pst, cnt, tid);
    int* ROWMAP = (int*)(ws + WS_ROWMAP); const int* LIST = (const int*)(ws + WS_LIST);
    const int nrows = ptab[0] * 256;
    for (int row = vcu * NTHR + tid; row < nrows; row += G * NTHR) { const int e = ptab[1 + (row >> 8)], pos = row - pst[e]; ROWMAP[row] = (pos < cnt[e]) ? LIST[(size_t)e * 65536 + pos] : -1; }
}

typedef short bf16x8 __attribute__((ext_vector_type(8)));
constexpr int MT = 72;
constexpr int ML_XP = 0;
constexpr int ML_CX = 17152;
constexpr int ML_WQ = ML_CX + 9216, ML_WK = ML_WQ + 9216;
constexpr int ML_Q = ML_WK + 9216, ML_K = ML_Q + 9216;
constexpr int ML_S = ML_K + 9216;
constexpr int ML_VT = ML_S + 9216;
constexpr int ML_CT = ML_VT + 11520;
constexpr int ML_H = ML_CT + 11520;
constexpr int ML_SM = ML_H + 16640;
static_assert(ML_SM + 2048 <= RING_BYTES, "mLSTM LDS map");
__device__ __forceinline__ float logsigmoidf_(float x) { return fminf(x, 0.f) - log1pf(__expf(-fabsf(x))); }
__device__ __forceinline__ void mma64(const LAS bf16* A, int arow0, const LAS bf16* Bt, int brow0, int lane, f32x4& acc) {
    const LAS bf16* ap = A + (arow0 + (lane & 15)) * MT + 8 * (lane >> 4); const LAS bf16* bp = Bt + (brow0 + (lane & 15)) * MT + 8 * (lane >> 4);
    const bf16x8 a0 = *(const LAS bf16x8*)ap, a1 = *(const LAS bf16x8*)(ap + 32), b0 = *(const LAS bf16x8*)bp, b1 = *(const LAS bf16x8*)(bp + 32);
    acc = __builtin_amdgcn_mfma_f32_16x16x32_bf16(a0, b0, acc, 0, 0, 0); acc = __builtin_amdgcn_mfma_f32_16x16x32_bf16(a1, b1, acc, 0, 0, 0);
}
__device__ __forceinline__ void ml_front(KArgsP a, LAS unsigned char* lds, int tid, int l, int b, int c, int h, bool want_q) {
    const bf16* PROJ = (const bf16*)(a->ws + WS_PROJ); const size_t row0 = (size_t)b * SEQ + c * 64;
    LAS float* xp = (LAS float*)(lds + ML_XP);
    for (int idx = tid; idx < 67 * 8; idx += NTHR) { const int r = idx >> 3, c8 = idx & 7, tr = c * 64 + r - 3; LAS float* d = xp + r * 64 + c8 * 8;
        if (tr >= 0) { const v4u p = *(const GAS v4u*)(PROJ + ((size_t)b * SEQ + tr) * NPROJ + PC_QK + h * 64 + c8 * 8);
            *(LAS f32x4*)d = (f32x4){bflo(p.x), bfhi(p.x), bflo(p.y), bfhi(p.y)}; *(LAS f32x4*)(d + 4) = (f32x4){bflo(p.z), bfhi(p.z), bflo(p.w), bfhi(p.w)}; }
        else { *(LAS f32x4*)d = (f32x4){0.f, 0.f, 0.f, 0.f}; *(LAS f32x4*)(d + 4) = (f32x4){0.f, 0.f, 0.f, 0.f}; } }
    {
        const int t = tid >> 3, vg = tid & 7; LAS bf16* VT = (LAS bf16*)(lds + ML_VT);
        const v4u p = *(const GAS v4u*)(PROJ + (row0 + t) * NPROJ + PC_V + h * 64 + vg * 8);
        const unsigned w[4] = {p.x, p.y, p.z, p.w};
#pragma unroll
        for (int j = 0; j < 4; ++j) { VT[(vg * 8 + 2 * j) * MT + t] = (bf16)(w[j] & 0xffffu); VT[(vg * 8 + 2 * j + 1) * MT + t] = (bf16)(w[j] >> 16); }
        for (int idx = tid; idx < 16 * 64; idx += NTHR) VT[(64 + (idx >> 6)) * MT + (idx & 63)] = (idx < 64) ? (bf16)0x3F80 : (bf16)0;
        const bf16* WT = (const bf16*)(a->ws + WS_MLW) + (size_t)((l * NH + h) * 2) * 4096;
        const int e = tid >> 3, d8 = tid & 7;
        if (want_q) *(LAS v4u*)(lds + ML_WQ + (e * MT + d8 * 8) * 2) = *(const GAS v4u*)(WT + e * 64 + d8 * 8);
        *(LAS v4u*)(lds + ML_WK + (e * MT + d8 * 8) * 2) = *(const GAS v4u*)(WT + 4096 + e * 64 + d8 * 8);
    }
    __syncthreads();
    const float* cw = a->in[I_CONV_W] + (size_t)l * 4 * DA + h * 64; const float* cb = a->in[I_CONV_B] + (size_t)l * DA + h * 64;
    {
        const int t = tid >> 3, c8 = (tid & 7) * 8; float s[8];
#pragma unroll
        for (int j = 0; j < 8; ++j) s[j] = cb[c8 + j];
#pragma unroll
        for (int q = 0; q < 4; ++q) { const f32x4 x0 = *(const LAS f32x4*)(xp + (t + q) * 64 + c8), x1 = *(const LAS f32x4*)(xp + (t + q) * 64 + c8 + 4); const float* w = cw + q * DA + c8;
            s[0] += x0.x * w[0]; s[1] += x0.y * w[1]; s[2] += x0.z * w[2]; s[3] += x0.w * w[3]; s[4] += x1.x * w[4]; s[5] += x1.y * w[5]; s[6] += x1.z * w[6]; s[7] += x1.w * w[7]; }
#pragma unroll
        for (int j = 0; j < 8; ++j) s[j] = s[j] / (1.f + __expf(-s[j]));
        v4u o; o.x = pk2(s[0], s[1]); o.y = pk2(s[2], s[3]); o.z = pk2(s[4], s[5]); o.w = pk2(s[6], s[7]);
        *(LAS v4u*)(lds + ML_CX + (t * MT + c8) * 2) = o;
    }
}
__device__ __forceinline__ void phase_m1(KArgsP a, LAS unsigned char* lds, int tid, int lane, int wave, int vcu, int G, int l) {
    unsigned char* ws = a->ws; const float* GT = (const float*)(ws + WS_GATES);
    float* CLOC = (float*)(ws + WS_CLOC); float* MLG = (float*)(ws + WS_MSC); float* MLM = MLG + 4096;
    LAS float* sm = (LAS float*)(lds + ML_SM);
    for (int u = vcu; u < NUNIT_M; u += G) {
        const int h = u % NH, c = (u / NH) % NCH, b = u / (NH * NCH); const size_t row0 = (size_t)b * SEQ + c * 64;
        __syncthreads();
        ml_front(a, lds, tid, l, b, c, h, false);
        if (wave == 0) {
            const float ig = GT[(row0 + lane) * 16 + h] + a->in[I_BI][l * NH + h];
            const float fl = logsigmoidf_(GT[(row0 + lane) * 16 + 6 + h] + a->in[I_BF][l * NH + h]);
            float bc = fl;
#pragma unroll
            for (int o = 1; o < 64; o <<= 1) { const float t = __shfl_up(bc, o); if (lane >= o) bc += t; }
            const float gtot = __shfl(bc, 63); const float lw = gtot - bc + ig; const float ml = wave_max(lw);
            sm[lane] = __expf(lw - ml);
            if (lane == 0) { MLG[u] = gtot; MLM[u] = ml; }
        }
        __syncthreads();
        {
            const int rt = wave >> 1; LAS bf16* KT = (LAS bf16*)(lds + ML_K);
#pragma unroll
            for (int q = 0; q < 2; ++q) { const int ct = 2 * (wave & 1) + q; f32x4 acc = {0.f, 0.f, 0.f, 0.f};
                mma64((const LAS bf16*)(lds + ML_CX), 16 * rt, (const LAS bf16*)(lds + ML_WK), 16 * ct, lane, acc);
                const int t0 = 16 * rt + 4 * (lane >> 4), e = 16 * ct + (lane & 15);
                const float w0 = sm[t0] * 0.125f, w1 = sm[t0 + 1] * 0.125f, w2 = sm[t0 + 2] * 0.125f, w3 = sm[t0 + 3] * 0.125f;
                v2u o; o.x = pk2(acc[0] * w0, acc[1] * w1); o.y = pk2(acc[2] * w2, acc[3] * w3);
                *(LAS v2u*)(KT + e * MT + t0) = o; }
        }
        __syncthreads();
        {
            const int ct = wave & 3, r_lo = wave < 4 ? 0 : 3, r_hi = wave < 4 ? 3 : 5; float* cl = CLOC + (size_t)u * CL_STRIDE;
            for (int rt = r_lo; rt < r_hi; ++rt) { f32x4 acc = {0.f, 0.f, 0.f, 0.f};
                mma64((const LAS bf16*)(lds + ML_VT), 16 * rt, (const LAS bf16*)(lds + ML_K), 16 * ct, lane, acc);
                const int v0 = 16 * rt + 4 * (lane >> 4), e = 16 * ct + (lane & 15);
                if (rt < 4) {
#pragma unroll
                    for (int r = 0; r < 4; ++r) cl[(v0 + r) * 64 + e] = acc[r];
                } else if ((lane >> 4) == 0) cl[4096 + e] = acc[0]; }
        }
    }
}
__device__ __forceinline__ void phase_m2(unsigned char* ws, int tid, int wg, int nwg) {
    float* CLOC = (float*)(ws + WS_CLOC); const float* MLG = (const float*)(ws + WS_MSC); const float* MLM = MLG + 4096; float* MST = (float*)(ws + WS_MSC) + 8192;
    for (int idx = wg * NTHR + tid; idx < NB * NH * CL_STRIDE; idx += nwg * NTHR) {
        const int e = idx % CL_STRIDE, bh = idx / CL_STRIDE, b = bh / NH, h = bh % NH;
        float m = 0.f, cs = 0.f;
        for (int c0 = 0; c0 < NCH; c0 += 8) {
            float cl[8], g[8], ml[8];
#pragma unroll
            for (int j = 0; j < 8; ++j) { const int u = (b * NCH + c0 + j) * NH + h; cl[j] = CLOC[(size_t)u * CL_STRIDE + e]; g[j] = MLG[u]; ml[j] = MLM[u]; }
#pragma unroll
            for (int j = 0; j < 8; ++j) { const int u = (b * NCH + c0 + j) * NH + h;
                CLOC[(size_t)u * CL_STRIDE + e] = cs; if (e == 0) MST[u] = m;
                const float mn = fmaxf(g[j] + m, ml[j]); const float ao = __expf(g[j] + m - mn), al = __expf(ml[j] - mn);
                cs = ao * cs + al * cl[j]; m = mn; }
        }
    }
}
__device__ __forceinline__ void phase_m3(KArgsP a, LAS unsigned char* lds, int tid, int lane, int wave, int vcu, int G, int l) {
    unsigned char* ws = a->ws; const bf16* PROJ = (const bf16*)(ws + WS_PROJ); const float* GT = (const float*)(ws + WS_GATES);
    const float* CLOC = (const float*)(ws + WS_CLOC); const float* MST = (const float*)(ws + WS_MSC) + 8192; bf16* YC = (bf16*)(ws + WS_YC);
    LAS float* sm = (LAS float*)(lds + ML_SM); LAS float* hb = (LAS float*)(lds + ML_H);
    for (int u = vcu; u < NUNIT_M; u += G) {
        const int h = u % NH, c = (u / NH) % NCH, b = u / (NH * NCH); const size_t row0 = (size_t)b * SEQ + c * 64;
        __syncthreads();
        ml_front(a, lds, tid, l, b, c, h, true);
        {
            const float* cl = CLOC + (size_t)u * CL_STRIDE; LAS bf16* CT = (LAS bf16*)(lds + ML_CT);
            for (int idx = tid; idx < 65 * 16; idx += NTHR) { const int r = idx >> 4, c4 = idx & 15; const f32x4 v = *(const GAS f32x4*)(cl + r * 64 + c4 * 4);
                v2u o; o.x = pk2(v.x, v.y); o.y = pk2(v.z, v.w); *(LAS v2u*)(CT + r * MT + c4 * 4) = o; }
            for (int idx = tid; idx < 15 * 64; idx += NTHR) CT[(65 + (idx >> 6)) * MT + (idx & 63)] = 0;
        }
        if (wave == 0) {
            const float ig = GT[(row0 + lane) * 16 + h] + a->in[I_BI][l * NH + h];
            const float fl = logsigmoidf_(GT[(row0 + lane) * 16 + 6 + h] + a->in[I_BF][l * NH + h]);
            float bc = fl;
#pragma unroll
            for (int o = 1; o < 64; o <<= 1) { const float t = __shfl_up(bc, o); if (lane >= o) bc += t; }
            float pm = ig - bc;
#pragma unroll
            for (int o = 1; o < 64; o <<= 1) { const float t = __shfl_up(pm, o); if (lane >= o) pm = fmaxf(pm, t); }
            const float mst = MST[u]; const float inter = bc + mst, mt = fmaxf(inter, bc + pm);
            sm[lane] = ig - bc; sm[64 + lane] = bc - mt; sm[128 + lane] = __expf(inter - mt); sm[192 + lane] = __expf(-mt);
        }
        __syncthreads();
        {
            const int rt = wave >> 1; LAS bf16* Qs = (LAS bf16*)(lds + ML_Q); LAS bf16* Ks = (LAS bf16*)(lds + ML_K);
#pragma unroll
            for (int q = 0; q < 2; ++q) { const int ct = 2 * (wave & 1) + q; f32x4 aq = {0.f, 0.f, 0.f, 0.f}, ak = {0.f, 0.f, 0.f, 0.f};
                mma64((const LAS bf16*)(lds + ML_CX), 16 * rt, (const LAS bf16*)(lds + ML_WQ), 16 * ct, lane, aq);
                mma64((const LAS bf16*)(lds + ML_CX), 16 * rt, (const LAS bf16*)(lds + ML_WK), 16 * ct, lane, ak);
                const int t0 = 16 * rt + 4 * (lane >> 4), e = 16 * ct + (lane & 15);
#pragma unroll
                for (int r = 0; r < 4; ++r) { Qs[(t0 + r) * MT + e] = (bf16)f2bf(aq[r]); Ks[(t0 + r) * MT + e] = (bf16)f2bf(ak[r] * 0.125f); } }
        }
        __syncthreads();
        {
            const int rt = wave >> 1; LAS bf16* Ss = (LAS bf16*)(lds + ML_S);
#pragma unroll
            for (int q = 0; q < 2; ++q) { const int ct = 2 * (wave & 1) + q; f32x4 acc = {0.f, 0.f, 0.f, 0.f};
                if (ct <= rt) mma64((const LAS bf16*)(lds + ML_Q), 16 * rt, (const LAS bf16*)(lds + ML_K), 16 * ct, lane, acc);
                const int t0 = 16 * rt + 4 * (lane >> 4), s = 16 * ct + (lane & 15); const float qs = sm[s];
#pragma unroll
                for (int r = 0; r < 4; ++r) { const int t = t0 + r; Ss[t * MT + s] = (bf16)f2bf((s <= t) ? acc[r] * __expf(sm[64 + t] + qs) : 0.f); } }
        }
        __syncthreads();
        {
            const int rt = wave >> 1, nt = (wave & 1) ? 2 : 3;
            for (int q = 0; q < nt; ++q) { const int ct = (wave & 1) ? 2 + q : (q < 2 ? q : 4); f32x4 aA = {0.f, 0.f, 0.f, 0.f}, aB = {0.f, 0.f, 0.f, 0.f};
                mma64((const LAS bf16*)(lds + ML_Q), 16 * rt, (const LAS bf16*)(lds + ML_CT), 16 * ct, lane, aA);
                mma64((const LAS bf16*)(lds + ML_S), 16 * rt, (const LAS bf16*)(lds + ML_VT), 16 * ct, lane, aB);
                const int t0 = 16 * rt + 4 * (lane >> 4), v = 16 * ct + (lane & 15);
#pragma unroll
                for (int r = 0; r < 4; ++r) { const int t = t0 + r; const float x = sm[128 + t] * aA[r] + aB[r];
                    if (ct < 4) hb[t * 65 + v] = x; else if ((lane & 15) == 0) sm[256 + t] = x; } }
        }
        __syncthreads();
        {
            const int t = tid >> 3, vg = tid & 7; float acc[8];
            const float dn = 1.f / fmaxf(fabsf(sm[256 + t]), sm[192 + t]);
            float s1 = 0.f;
#pragma unroll
            for (int j = 0; j < 8; ++j) { acc[j] = hb[t * 65 + vg * 8 + j] * dn; s1 += acc[j]; }
            s1 += __shfl_xor(s1, 1); s1 += __shfl_xor(s1, 2); s1 += __shfl_xor(s1, 4);
            const float mu = s1 * (1.f / 64.f); float s2 = 0.f;
#pragma unroll
            for (int j = 0; j < 8; ++j) { acc[j] -= mu; s2 += acc[j] * acc[j]; }
            s2 += __shfl_xor(s2, 1); s2 += __shfl_xor(s2, 2); s2 += __shfl_xor(s2, 4);
            const float rs = rsqrtf(s2 * (1.f / 64.f) + HEAD_NORM_EPS);
            const float* nw = a->in[I_MNORM_W] + (size_t)l * DA + h * 64 + vg * 8;
            const v4u ov = *(const GAS v4u*)(PROJ + (row0 + t) * NPROJ + PC_O + h * 64 + vg * 8);
            const float o[8] = {bflo(ov.x), bfhi(ov.x), bflo(ov.y), bfhi(ov.y), bflo(ov.z), bfhi(ov.z), bflo(ov.w), bfhi(ov.w)};
            float r[8];
#pragma unroll
            for (int j = 0; j < 8; ++j) r[j] = acc[j] * rs * nw[j] * sigmoidf_(o[j]);
            v4u w; w.x = pk2(r[0], r[1]); w.y = pk2(r[2], r[3]); w.z = pk2(r[4], r[5]); w.w = pk2(r[6], r[7]);
            *(GAS v4u*)(YC + (row0 + t) * DM + h * 64 + vg * 8) = w;
        }
    }
}

constexpr int S5_UT = 264, S5_XT = 2056;
constexpr int S5_U = 0, S5_Z = 33792, S5_X = 67584;
static_assert(S5_X + 16 * S5_XT * 2 <= MISC_OFF, "S5 LDS map");
struct S5A { float are, aim, cre, cim; };
__device__ __forceinline__ S5A s5_a(KArgsP a, int l, int g, int p) {
    const float lam_re = a->in[I_S5ARE][(size_t)(l * 16 + g) * 64 + p], lam_im = a->in[I_S5AIM][(size_t)(l * 16 + g) * 64 + p];
    const float dt = expf(a->in[I_S5LDT][l * 16 + g]); const float mag = expf(lam_re * dt), ang = lam_im * dt;
    S5A r; r.are = mag * cosf(ang); r.aim = mag * sinf(ang);
    const float inv = 1.f / (lam_re * lam_re + lam_im * lam_im);
    r.cre = ((r.are - 1.f) * lam_re + r.aim * lam_im) * inv; r.cim = (r.aim * lam_re - (r.are - 1.f) * lam_im) * inv; return r;
}
__device__ __forceinline__ bf16x8 pack8(const float* v) { v4u o; o.x = pk2(v[0], v[1]); o.y = pk2(v[2], v[3]); o.z = pk2(v[4], v[5]); o.w = pk2(v[6], v[7]); return __builtin_bit_cast(bf16x8, o); }
__device__ __forceinline__ void s5_bfrag(KArgsP a, int l, int g, int lane, bf16x8 (&bf)[8]) {
#pragma unroll
    for (int j = 0; j < 8; ++j) { const int n = 16 * j + (lane & 15), p = n >> 1, im = n & 1, kq = lane >> 4; float v[8];
        if (kq < 2) { const S5A A = s5_a(a, l, g, p);
            const float* br = a->in[I_S5BRE] + ((size_t)(l * 16 + g) * 64 + p) * 16 + 8 * kq; const float* bi = a->in[I_S5BIM] + ((size_t)(l * 16 + g) * 64 + p) * 16 + 8 * kq;
#pragma unroll
            for (int q = 0; q < 8; ++q) v[q] = im ? (A.cre * bi[q] + A.cim * br[q]) : (A.cre * br[q] - A.cim * bi[q]);
        } else {
#pragma unroll
            for (int q = 0; q < 8; ++q) v[q] = 0.f; }
        bf[j] = pack8(v); }
}
__device__ __forceinline__ void s5_load_u(const unsigned char* ws, LAS unsigned char* lds, int tid, size_t row0) {
    const bf16* PROJ = (const bf16*)(ws + WS_PROJ);
    for (int idx = tid; idx < 64 * 32; idx += NTHR) { const int t = idx >> 5, c8 = idx & 31;
        *(LAS v4u*)(lds + S5_U + (t * S5_UT + c8 * 8) * 2) = *(const GAS v4u*)(PROJ + (row0 + t) * NPROJ + PC_S5 + c8 * 8); }
}
__device__ __forceinline__ void s5_block(LAS unsigned char* lds, int lane, int tb, int g, const bf16x8 (&bf)[8], float are, float aim, float& xr, float& xi) {
    const int kq = lane >> 4; bf16x8 uf = {0, 0, 0, 0, 0, 0, 0, 0};
    if (kq < 2) uf = *(const LAS bf16x8*)(lds + S5_U + ((16 * tb + (lane & 15)) * S5_UT + g * 16 + 8 * kq) * 2);
    LAS bf16* X = (LAS bf16*)(lds + S5_X);
#pragma unroll
    for (int j = 0; j < 8; ++j) { f32x4 acc = {0.f, 0.f, 0.f, 0.f}; acc = __builtin_amdgcn_mfma_f32_16x16x32_bf16(bf[j], uf, acc, 0, 0, 0);
        v2u o; o.x = pk2(acc[0], acc[1]); o.y = pk2(acc[2], acc[3]); *(LAS v2u*)(X + (lane & 15) * S5_XT + g * 128 + 16 * j + 4 * kq) = o; }
    LDS_WAIT(); asm volatile("" ::: "memory");
    LAS unsigned* xw = (LAS unsigned*)(lds + S5_X) + (g * 128 + 2 * lane) / 2;
#pragma unroll
    for (int t = 0; t < 16; ++t) { const unsigned w = xw[t * (S5_XT / 2)]; const float br = bflo(w), bi = bfhi(w);
        const float nr = are * xr - aim * xi + br, ni = are * xi + aim * xr + bi; xr = nr; xi = ni;
        xw[t * (S5_XT / 2)] = pk2(xr, xi); }
    LDS_WAIT(); asm volatile("" ::: "memory");
}
__device__ __forceinline__ void phase_s1(KArgsP a, LAS unsigned char* lds, int tid, int lane, int wave, int vcu, int G, int l) {
    unsigned char* ws = a->ws; float* ST = (float*)(ws + WS_S5ST);
    bf16x8 bf0[8], bf1[8]; s5_bfrag(a, l, wave, lane, bf0); s5_bfrag(a, l, wave + 8, lane, bf1);
    const S5A A0 = s5_a(a, l, wave, lane), A1 = s5_a(a, l, wave + 8, lane);
    for (int u = vcu; u < NB * NCH; u += G) {
        const size_t row0 = (size_t)u * 64;
        __syncthreads();
        s5_load_u(ws, lds, tid, row0);
        __syncthreads();
        float x0r = 0.f, x0i = 0.f, x1r = 0.f, x1i = 0.f;
        for (int tb = 0; tb < 4; ++tb) { s5_block(lds, lane, tb, wave, bf0, A0.are, A0.aim, x0r, x0i); s5_block(lds, lane, tb, wave + 8, bf1, A1.are, A1.aim, x1r, x1i); }
        *(f32x2*)(ST + (((size_t)u * 16 + wave) * 64 + lane) * 2) = (f32x2){x0r, x0i};
        *(f32x2*)(ST + (((size_t)u * 16 + wave + 8) * 64 + lane) * 2) = (f32x2){x1r, x1i};
    }
}
__device__ __forceinline__ void phase_s2(KArgsP a, int tid, int wg, int nwg, int l) {
    float* ST = (float*)(a->ws + WS_S5ST);
    for (int idx = wg * NTHR + tid; idx < NB * 1024; idx += nwg * NTHR) {
        const int b = idx >> 10, gp = idx & 1023, g = gp >> 6, p = gp & 63;
        const S5A A = s5_a(a, l, g, p); float ar = A.are, ai = A.aim;
#pragma unroll
        for (int s = 0; s < 6; ++s) { const float nr = ar * ar - ai * ai, ni = 2.f * ar * ai; ar = nr; ai = ni; }
        float cr = 0.f, ci = 0.f;
        for (int c0 = 0; c0 < NCH; c0 += 8) {
            f32x2 e[8];
#pragma unroll
            for (int j = 0; j < 8; ++j) e[j] = *(const f32x2*)(ST + (((size_t)(b * NCH + c0 + j) * 16 + g) * 64 + p) * 2);
#pragma unroll
            for (int j = 0; j < 8; ++j) { *(f32x2*)(ST + (((size_t)(b * NCH + c0 + j) * 16 + g) * 64 + p) * 2) = (f32x2){cr, ci};
                const float nr = ar * cr - ai * ci + e[j].x, ni = ar * ci + ai * cr + e[j].y; cr = nr; ci = ni; }
        }
    }
}
__device__ __forceinline__ float gelu_tanh_(float x) { const float t = tanhf(0.7978845608f * (x + 0.044715f * x * x * x)); return 0.5f * x * (1.f + t); }
__device__ __forceinline__ void s5_cproj(LAS unsigned char* lds, int lane, int tb, int g, const bf16* cmt  , const float (&dv)[4]) {
    const int kq = lane >> 4; f32x4 acc = {0.f, 0.f, 0.f, 0.f};
    bf16x8 cf[4];
#pragma unroll
    for (int s = 0; s < 4; ++s) cf[s] = __builtin_bit_cast(bf16x8, *(const GAS v4u*)(cmt + (lane & 15) * 128 + 32 * s + 8 * kq));
    const LAS bf16* xp = (const LAS bf16*)(lds + S5_X) + (lane & 15) * S5_XT + g * 128 + 8 * kq;
#pragma unroll
    for (int s = 0; s < 4; ++s) acc = __builtin_amdgcn_mfma_f32_16x16x32_bf16(cf[s], *(const LAS bf16x8*)(xp + 32 * s), acc, 0, 0, 0);
    const int t = 16 * tb + (lane & 15), c0 = g * 16 + 4 * kq;
    const v2u uw = *(const LAS v2u*)(lds + S5_U + (t * S5_UT + c0) * 2);
    const float u4[4] = {bflo(uw.x), bfhi(uw.x), bflo(uw.y), bfhi(uw.y)}; float z[4];
#pragma unroll
    for (int r = 0; r < 4; ++r) z[r] = gelu_tanh_(acc[r] + dv[r] * u4[r]);
    v2u o; o.x = pk2(z[0], z[1]); o.y = pk2(z[2], z[3]); *(LAS v2u*)(lds + S5_Z + (t * S5_UT + c0) * 2) = o;
}
__device__ __forceinline__ void phase_s3(KArgsP a, LAS unsigned char* lds, int tid, int lane, int wave, int vcu, int G, int l) {
    unsigned char* ws = a->ws; const float* ST = (const float*)(ws + WS_S5ST); bf16* YC = (bf16*)(ws + WS_YC);
    const bf16* GLUT = (const bf16*)(ws + WS_GLUT) + (size_t)l * DC * DC;
    bf16x8 bf0[8], bf1[8]; s5_bfrag(a, l, wave, lane, bf0); s5_bfrag(a, l, wave + 8, lane, bf1);
    const bf16* cm0 = (const bf16*)(ws + WS_S5CM) + (size_t)(l * 16 + wave) * 2048; const bf16* cm1 = cm0 + 8 * 2048;
    const S5A A0 = s5_a(a, l, wave, lane), A1 = s5_a(a, l, wave + 8, lane);
    float d0[4], d1[4];
#pragma unroll
    for (int r = 0; r < 4; ++r) { d0[r] = a->in[I_S5D][l * DC + wave * 16 + 4 * (lane >> 4) + r]; d1[r] = a->in[I_S5D][l * DC + (wave + 8) * 16 + 4 * (lane >> 4) + r]; }
    for (int u = vcu; u < NB * NCH; u += G) {
        const size_t row0 = (size_t)u * 64;
        __syncthreads();
        s5_load_u(ws, lds, tid, row0);
        const f32x2 s0 = *(const f32x2*)(ST + (((size_t)u * 16 + wave) * 64 + lane) * 2), s1 = *(const f32x2*)(ST + (((size_t)u * 16 + wave + 8) * 64 + lane) * 2);
        float x0r = s0.x, x0i = s0.y, x1r = s1.x, x1i = s1.y;
        __syncthreads();
        for (int tb = 0; tb < 4; ++tb) {
            s5_block(lds, lane, tb, wave, bf0, A0.are, A0.aim, x0r, x0i); s5_cproj(lds, lane, tb, wave, cm0, d0);
            s5_block(lds, lane, tb, wave + 8, bf1, A1.are, A1.aim, x1r, x1i); s5_cproj(lds, lane, tb, wave + 8, cm1, d1);
        }
        __syncthreads();
        {
            const int kq = lane >> 4;
#pragma unroll
            for (int q = 0; q < 2; ++q) { const int ct = 2 * wave + q; f32x4 acc[4];
#pragma unroll
                for (int rt = 0; rt < 4; ++rt) acc[rt] = (f32x4){0.f, 0.f, 0.f, 0.f};
                const bf16* gp = GLUT + (size_t)(16 * ct + (lane & 15)) * DC + 8 * kq;
#pragma unroll 2
                for (int s = 0; s < 8; ++s) { const bf16x8 gf = __builtin_bit_cast(bf16x8, *(const GAS v4u*)(gp + 32 * s));
#pragma unroll
                    for (int rt = 0; rt < 4; ++rt) acc[rt] = __builtin_amdgcn_mfma_f32_16x16x32_bf16(gf, *(const LAS bf16x8*)(lds + S5_Z + ((16 * rt + (lane & 15)) * S5_UT + 32 * s + 8 * kq) * 2), acc[rt], 0, 0, 0); }
                const int j0 = 16 * ct + 4 * kq; const f32x4 gb = *(const GAS f32x4*)(a->in[I_S5GLUB] + l * DC + j0);
#pragma unroll
                for (int rt = 0; rt < 4; ++rt) { const int t = 16 * rt + (lane & 15); const v2u zw = *(const LAS v2u*)(lds + S5_Z + (t * S5_UT + j0) * 2);
                    const float z0 = bflo(zw.x), z1 = bfhi(zw.x), z2 = bflo(zw.y), z3 = bfhi(zw.y);
                    v2u o; o.x = pk2(z0 * sigmoidf_(acc[rt][0] + gb.x), z1 * sigmoidf_(acc[rt][1] + gb.y)); o.y = pk2(z2 * sigmoidf_(acc[rt][2] + gb.z), z3 * sigmoidf_(acc[rt][3] + gb.w));
                    *(GAS v2u*)(YC + (row0 + t) * DM + 768 + j0) = o; } }
        }
    }
}

__device__ __forceinline__ float rw_shift(const bf16* PROJ, const float* mu, size_t row, int col) {
    const float cur = bf2f(PROJ[row * NPROJ + PC_RW + col]); const float prv = (row % SEQ) ? bf2f(PROJ[(row - 1) * NPROJ + PC_RW + col]) : 0.f;
    return cur + mu[col] * (prv - cur);
}
constexpr int R1_TH = 0, R1_AD = 9216, R1_SG = 18432, R1_VS = 35840, R1_TMP = 86016;
template <int KS, int MODE>
__device__ __forceinline__ void r1_prod(const bf16* WT, const LAS bf16* act, int astride, const float* bias, bf16* OUT, size_t row0, int lane, int wave) {
    const int kq = lane >> 4, n0 = 48 * wave; constexpr int K = 32 * KS;
    f32x4 acc[3][4];
#pragma unroll
    for (int nt = 0; nt < 3; ++nt)
#pragma unroll
        for (int ti = 0; ti < 4; ++ti) acc[nt][ti] = (f32x4){0.f, 0.f, 0.f, 0.f};
#pragma unroll
    for (int s = 0; s < KS; ++s) { bf16x8 wf[3], af[4];
#pragma unroll
        for (int nt = 0; nt < 3; ++nt) wf[nt] = __builtin_bit_cast(bf16x8, *(const GAS v4u*)(WT + (size_t)(n0 + 16 * nt + (lane & 15)) * K + 32 * s + 8 * kq));
#pragma unroll
        for (int ti = 0; ti < 4; ++ti) af[ti] = *(const LAS bf16x8*)(act + (16 * ti + (lane & 15)) * astride + 32 * s + 8 * kq);
#pragma unroll
        for (int nt = 0; nt < 3; ++nt)
#pragma unroll
            for (int ti = 0; ti < 4; ++ti) acc[nt][ti] = __builtin_amdgcn_mfma_f32_16x16x32_bf16(wf[nt], af[ti], acc[nt][ti], 0, 0, 0); }
#pragma unroll
    for (int nt = 0; nt < 3; ++nt) { const int n = n0 + 16 * nt + 4 * kq; f32x4 bv = {0.f, 0.f, 0.f, 0.f}; if (MODE != 2) bv = *(const GAS f32x4*)(bias + n);
#pragma unroll
        for (int ti = 0; ti < 4; ++ti) { float o[4];
#pragma unroll
            for (int r = 0; r < 4; ++r) { const float x = acc[nt][ti][r] + bv[r]; o[r] = MODE == 0 ? 0.60653066f * sigmoidf_(x) : (MODE == 1 ? sigmoidf_(x) : x); }
            v2u w; w.x = pk2(o[0], o[1]); w.y = pk2(o[2], o[3]);
            *(GAS v2u*)(OUT + (row0 + 16 * ti + (lane & 15)) * DBR + n) = w; } }
}
__device__ __forceinline__ void phase_r1(KArgsP a, LAS unsigned char* lds, int tid, int lane, int wave, int vcu, int G, int l) {
    unsigned char* ws = a->ws; const bf16* PROJ = (const bf16*)(ws + WS_PROJ); const float* mu = a->in[I_RMU] + (size_t)l * RW_COLS;
    const bf16* W1 = (const bf16*)(ws + WS_R1W) + (size_t)l * 98304;
    const bf16* WV = (const bf16*)(ws + WS_R1W) + 2 * 98304;
    for (int u = vcu; u < NTOK / 64; u += G) {
        const size_t row0 = (size_t)u * 64;
        __syncthreads();
        for (int idx = tid; idx < 64 * 128; idx += NTHR) { const int tt = idx >> 7, col = 2 * (idx & 127); const size_t r = row0 + tt;
            const unsigned cw = *(const GAS unsigned*)(PROJ + r * NPROJ + PC_RW + RWC_WD + col); const unsigned pw = (r % SEQ) ? *(const GAS unsigned*)(PROJ + (r - 1) * NPROJ + PC_RW + RWC_WD + col) : 0u;
            const float c0 = bflo(cw), c1 = bfhi(cw); const float x0 = c0 + mu[RWC_WD + col] * (bflo(pw) - c0), x1 = c1 + mu[RWC_WD + col + 1] * (bfhi(pw) - c1);
            if (col < 64) *(LAS unsigned*)(lds + R1_TH + (tt * 72 + col) * 2) = pk2(tanhf(x0), tanhf(x1));
            else if (col < 128) *(LAS unsigned*)(lds + R1_AD + (tt * 72 + col - 64) * 2) = pk2(x0, x1);
            else *(LAS unsigned*)(lds + R1_SG + (tt * 136 + col - 128) * 2) = pk2(sigmoidf_(x0), sigmoidf_(x1)); }
        if (l > 0) for (int idx = tid; idx < 64 * 192; idx += NTHR) { const int tt = idx / 192, col = 2 * (idx % 192); const size_t r = row0 + tt;
            const unsigned cw = *(const GAS unsigned*)(PROJ + r * NPROJ + PC_RW + RWC_V + col); const unsigned pw = (r % SEQ) ? *(const GAS unsigned*)(PROJ + (r - 1) * NPROJ + PC_RW + RWC_V + col) : 0u;
            const float c0 = bflo(cw), c1 = bfhi(cw);
            *(LAS unsigned*)(lds + R1_VS + (tt * 392 + col) * 2) = pk2(c0 + mu[RWC_V + col] * (bflo(pw) - c0), c1 + mu[RWC_V + col + 1] * (bfhi(pw) - c1)); }
        __syncthreads();
        r1_prod<2, 0>(W1, (const LAS bf16*)(lds + R1_TH), 72, a->in[I_RW0] + l * DBR, (bf16*)(ws + WS_RE), row0, lane, wave);
        r1_prod<2, 1>(W1 + 24576, (const LAS bf16*)(lds + R1_AD), 72, a->in[I_RA0] + l * DBR, (bf16*)(ws + WS_RA), row0, lane, wave);
        r1_prod<4, 2>(W1 + 49152, (const LAS bf16*)(lds + R1_SG), 136, nullptr, (bf16*)(ws + WS_RG), row0, lane, wave);
        if (l > 0) {
            { const int kq = lane >> 4, mt = wave & 1, ti = wave >> 1; f32x4 acc = {0.f, 0.f, 0.f, 0.f};
#pragma unroll 4
              for (int s = 0; s < 12; ++s) acc = __builtin_amdgcn_mfma_f32_16x16x32_bf16(__builtin_bit_cast(bf16x8, *(const GAS v4u*)(WV + (size_t)(16 * mt + (lane & 15)) * 384 + 32 * s + 8 * kq)),
                                                                                          *(const LAS bf16x8*)(lds + R1_VS + ((16 * ti + (lane & 15)) * 392 + 32 * s + 8 * kq) * 2), acc, 0, 0, 0);
              v2u w; w.x = pk2(acc[0], acc[1]); w.y = pk2(acc[2], acc[3]); *(LAS v2u*)(lds + R1_TMP + ((16 * ti + (lane & 15)) * 40 + 16 * mt + 4 * kq) * 2) = w; }
            __syncthreads();
            r1_prod<1, 1>(WV + 12288, (const LAS bf16*)(lds + R1_TMP), 40, a->in[I_RV0], (bf16*)(ws + WS_RVG), row0, lane, wave);
        }
    }
}
__device__ __forceinline__ float dpp_allsum(float x) {
    x += __builtin_bit_cast(float, __builtin_amdgcn_update_dpp(0, __builtin_bit_cast(int, x), 0x128, 0xf, 0xf, false));
    x += __builtin_bit_cast(float, __builtin_amdgcn_update_dpp(0, __builtin_bit_cast(int, x), 0x124, 0xf, 0xf, false));
    x += __builtin_bit_cast(float, __builtin_amdgcn_update_dpp(0, __builtin_bit_cast(int, x), 0x122, 0xf, 0xf, false));
    x += __builtin_bit_cast(float, __builtin_amdgcn_update_dpp(0, __builtin_bit_cast(int, x), 0x121, 0xf, 0xf, false));
    { const unsigned xi = __builtin_bit_cast(unsigned, x); auto r = __builtin_amdgcn_permlane16_swap(xi, xi, false, false); const unsigned r0 = r[0], r1 = r[1]; x = __uint_as_float(r0) + __uint_as_float(r1); }
    { const unsigned xi = __builtin_bit_cast(unsigned, x); auto r = __builtin_amdgcn_permlane32_swap(xi, xi, false, false); const unsigned r0 = r[0], r1 = r[1]; x = __uint_as_float(r0) + __uint_as_float(r1); }
    return x;
}

constexpr int RC_EF = 0, RC_ATF = 4096, RC_QF = 8448, RC_PFT = 9472, RC_AT = 10496, RC_RT = 12800, RC_BH = 15104, RC_KH = 17408, RC_AH = 19712, RC_BTT = 22016, RC_KTT = 25088, RC_VS = 28160,
              RC_PRL = 31232, RC_QRL = 32000, RC_TQL = 32768, RC_G15 = 33536, RC_CH = 33792;
struct RCRegs { v2u r0, r1, k0, k1, aa, ee, v0, v1, vg, vf; };
__device__ __forceinline__ void rc_issue(const unsigned char* ws, int l, size_t row, int h, int tid, RCRegs& R) {
    const bf16* PROJ = (const bf16*)(ws + WS_PROJ); const int tt = tid >> 4, c0 = h * 64 + 4 * (tid & 15); const size_t r = row + tt; const bool first = (r % SEQ) == 0; const size_t rp = first ? r : r - 1;
    R.r0 = *(const GAS v2u*)(PROJ + r * NPROJ + PC_RW + RWC_R + c0); R.r1 = *(const GAS v2u*)(PROJ + rp * NPROJ + PC_RW + RWC_R + c0);
    R.k0 = *(const GAS v2u*)(PROJ + r * NPROJ + PC_RW + RWC_K + c0); R.k1 = *(const GAS v2u*)(PROJ + rp * NPROJ + PC_RW + RWC_K + c0);
    R.v0 = *(const GAS v2u*)(PROJ + r * NPROJ + PC_RW + RWC_V + c0); R.v1 = *(const GAS v2u*)(PROJ + rp * NPROJ + PC_RW + RWC_V + c0);
    R.aa = *(const GAS v2u*)((const bf16*)(ws + WS_RA) + r * DBR + c0); R.ee = *(const GAS v2u*)((const bf16*)(ws + WS_RE) + r * DBR + c0);
    if (l > 0) { R.vg = *(const GAS v2u*)((const bf16*)(ws + WS_RVG) + r * DBR + c0); R.vf = *(const GAS v2u*)((const bf16*)(ws + WS_VF) + r * DBR + c0); }
    if (first) { R.r1 = (v2u){0u, 0u}; R.k1 = (v2u){0u, 0u}; R.v1 = (v2u){0u, 0u}; }
}
__device__ __forceinline__ void unpack4(const v2u p, float (&o)[4]) { o[0] = bflo(p.x); o[1] = bfhi(p.x); o[2] = bflo(p.y); o[3] = bfhi(p.y); }
__device__ __forceinline__ v2u pack4(const float (&v)[4]) { v2u o; o.x = pk2(v[0], v[1]); o.y = pk2(v[2], v[3]); return o; }
__device__ __forceinline__ v2u pack4v(const f32x4 v) { v2u o; o.x = pk2(v[0], v[1]); o.y = pk2(v[2], v[3]); return o; }
__device__ __forceinline__ bf16x8 cat8(const v2u a, const v2u b) { v4u o; o.x = a.x; o.y = a.y; o.z = b.x; o.w = b.y; return __builtin_bit_cast(bf16x8, o); }
#define RC_BAR() asm volatile("s_waitcnt lgkmcnt(0)\n\ts_barrier" ::: "memory")

constexpr int REC_BYTES = 12288, REC_UNITS = 752;
__device__ __forceinline__ unsigned char* rc_rec(unsigned char* ws, size_t cu) { return cu < 8192 ? ws + WS_OPA + cu * REC_BYTES : ws + WS_OPB + (cu - 8192) * REC_BYTES; }
template <int OAH, int ORT, int OBT, int OKT, int OVS, int OPR, int OQR, int OTQ, int OG>
__device__ __forceinline__ int rc_unit_off(int u) {
    if (u < 128) return OAH + (u >> 3) * 144 + (u & 7) * 16;
    if (u < 256) return ORT + ((u - 128) >> 3) * 144 + (u & 7) * 16;
    if (u < 384) return OBT + ((u - 256) >> 1) * 48 + (u & 1) * 16;
    if (u < 512) return OKT + ((u - 384) >> 1) * 48 + (u & 1) * 16;
    if (u < 640) return OVS + ((u - 512) >> 1) * 48 + (u & 1) * 16;
    if (u < 672) return OPR + ((u - 640) >> 1) * 48 + (u & 1) * 16;
    if (u < 704) return OQR + ((u - 672) >> 1) * 48 + (u & 1) * 16;
    if (u < 736) return OTQ + ((u - 704) >> 1) * 48 + (u & 1) * 16;
    return OG + (u - 736) * 16;
}
__device__ __forceinline__ void rc_copy_out(unsigned char* rec, const LAS unsigned char* wb, int u) {
#pragma unroll
    for (int q = 0; q < 3; ++q) { const int uu = u + 256 * q; if (uu < REC_UNITS) *(GAS v4u*)(rec + uu * 16) = *(const LAS v4u*)(wb + rc_unit_off<RC_AH, RC_RT, RC_BTT, RC_KTT, RC_VS, RC_PRL, RC_QRL, RC_TQL, RC_G15>(uu)); }
}
constexpr int RS_RT = 0, RS_AH = 2304, RS_BTT = 4608, RS_KTT = 7680, RS_VS = 10752, RS_PRL = 13824, RS_QRL = 14592, RS_TQL = 15360, RS_G15 = 16128, RS_CH = 16384;
#define RC_BUILD(RUSE, q) do { const int bh_ = (q) >> 8, b = bh_ / NH, h = bh_ % NH, blk_ = (q) & 255, c0 = h * 64 + 4 * kq; const size_t row0 = (size_t)b * SEQ + (size_t)blk_ * 32; \
        float kkw[4], kaw[4], mur[4], muk[4], muv[4]; \
_Pragma("unroll") \
        for (int j = 0; j < 4; ++j) { kkw[j] = a->in[I_RKK][(size_t)l * DBR + c0 + j]; kaw[j] = a->in[I_RKA][(size_t)l * DBR + c0 + j]; mur[j] = mu[RWC_R + c0 + j]; muk[j] = mu[RWC_K + c0 + j]; muv[j] = mu[RWC_V + c0 + j]; } \
        float an[4], bk[4], km[4], rs[4], ev[4]; \
        {   const RCRegs& R = RUSE; \
            float rc[4], rp[4], kc[4], kp[4], av[4], vc[4], vp[4], ks[4], kk[4], vs[4]; unpack4(R.r0, rc); unpack4(R.r1, rp); unpack4(R.k0, kc); unpack4(R.k1, kp); unpack4(R.aa, av); unpack4(R.ee, ev); unpack4(R.v0, vc); unpack4(R.v1, vp); \
            float ss = 0.f; \
_Pragma("unroll") \
            for (int j = 0; j < 4; ++j) { rs[j] = rc[j] + mur[j] * (rp[j] - rc[j]); ks[j] = kc[j] + muk[j] * (kp[j] - kc[j]); kk[j] = ks[j] * kkw[j]; ss += kk[j] * kk[j]; vs[j] = vc[j] + muv[j] * (vp[j] - vc[j]); } \
            ss += __shfl_xor(ss, 1); ss += __shfl_xor(ss, 2); ss += __shfl_xor(ss, 4); ss += __shfl_xor(ss, 8); \
            const float inv = 1.f / fmaxf(sqrtf(ss), 1e-12f); \
_Pragma("unroll") \
            for (int j = 0; j < 4; ++j) { const float kn = kk[j] * inv; an[j] = -kn; bk[j] = kn * av[j]; km[j] = ks[j] * (1.f + (av[j] - 1.f) * kaw[j]); } \
            if (l == 0) *(GAS v2u*)((bf16*)(ws + WS_VF) + (row0 + tt) * DBR + c0) = pack4(vs); \
            else { float g[4], f[4]; unpack4(R.vg, g); unpack4(R.vf, f); \
_Pragma("unroll") \
                for (int j = 0; j < 4; ++j) vs[j] = vs[j] + (f[j] - vs[j]) * g[j]; } \
            *(LAS f32x4*)(cb + RC_EF + (t * 64 + 4 * kq) * 4) = (f32x4){ev[0], ev[1], ev[2], ev[3]}; \
_Pragma("unroll") \
            for (int j = 0; j < 4; ++j) *(LAS bf16*)(cb + RC_VS + ((4 * kq + j) * 24 + t) * 2) = (bf16)f2bf(vs[j]); \
        } \
        if ((q) + 2 * G < NQ) rc_issue(ws, l, (size_t)(((q) + 2 * G) >> 8) / NH * SEQ + (size_t)(((q) + 2 * G) & 255) * 32, (((q) + 2 * G) >> 8) % NH, tid, RUSE); \
        RC_BAR(); \
        {   f32x4 inc = {0.f, 0.f, 0.f, 0.f}, tot = inc; \
_Pragma("unroll") \
            for (int i = 0; i < 16; ++i) { const f32x4 ei = *(const LAS f32x4*)(cb + RC_EF + (i * 64 + 4 * kq) * 4); tot = tot + ei; if (i <= t) inc = inc + ei; } \
            float At[4], Rt[4], Bh[4], Kh[4], Bt[4], Kt[4], Gt[4]; \
_Pragma("unroll") \
            for (int j = 0; j < 4; ++j) { const float Gi = __expf(-inc[j]), Ge = __expf(ev[j] - inc[j]), Gn = __expf(inc[j]); Gt[j] = __expf(-tot[j]); \
                At[j] = an[j] * Ge; Rt[j] = rs[j] * Gi; Bh[j] = bk[j] * Gn; Kh[j] = km[j] * Gn; Bt[j] = Bh[j] * Gt[j]; Kt[j] = Kh[j] * Gt[j]; } \
            *(LAS f32x4*)(cb + RC_ATF + (t * 68 + 4 * kq) * 4) = (f32x4){At[0], At[1], At[2], At[3]}; \
            *(LAS v2u*)(cb + RC_AT + (t * 72 + 4 * kq) * 2) = pack4(At); *(LAS v2u*)(cb + RC_RT + (t * 72 + 4 * kq) * 2) = pack4(Rt); \
            *(LAS v2u*)(cb + RC_BH + (t * 72 + 4 * kq) * 2) = pack4(Bh); *(LAS v2u*)(cb + RC_KH + (t * 72 + 4 * kq) * 2) = pack4(Kh); \
_Pragma("unroll") \
            for (int j = 0; j < 4; ++j) { *(LAS bf16*)(cb + RC_BTT + ((4 * kq + j) * 24 + t) * 2) = (bf16)f2bf(Bt[j]); *(LAS bf16*)(cb + RC_KTT + ((4 * kq + j) * 24 + t) * 2) = (bf16)f2bf(Kt[j]); } \
            if (t == 0) *(LAS f32x4*)(cb + RC_G15 + 4 * kq * 4) = (f32x4){Gt[0], Gt[1], Gt[2], Gt[3]}; \
        } \
        RC_BAR(); \
        {   LAS unsigned char* wb = lds + (wave >> 2) * RC_CH; const int pi = wave & 3; \
            const LAS bf16* Ap = (const LAS bf16*)(wb + (pi < 2 ? RC_AT : RC_RT)) + li * 72 + 8 * lq; const LAS bf16* Bp = (const LAS bf16*)(wb + ((pi & 1) ? RC_KH : RC_BH)) + li * 72 + 8 * lq; \
            f32x4 acc = {0.f, 0.f, 0.f, 0.f}; \
            acc = __builtin_amdgcn_mfma_f32_16x16x32_bf16(*(const LAS bf16x8*)Ap, *(const LAS bf16x8*)Bp, acc, 0, 0, 0); \
            acc = __builtin_amdgcn_mfma_f32_16x16x32_bf16(*(const LAS bf16x8*)(Ap + 32), *(const LAS bf16x8*)(Bp + 32), acc, 0, 0, 0); \
_Pragma("unroll") \
            for (int r = 0; r < 4; ++r) { const int tr = 4 * lq + r; if (pi < 2 ? !(li < tr) : !(li <= tr)) acc[r] = 0.f; } \
            if (pi == 0) *(LAS f32x4*)(wb + RC_PFT + (li * 16 + 4 * lq) * 4) = acc; \
            else if (pi == 1) { \
_Pragma("unroll") \
                for (int r = 0; r < 4; ++r) *(LAS float*)(wb + RC_QF + ((4 * lq + r) * 16 + li) * 4) = acc[r]; } \
            else { LAS bf16* o = (LAS bf16*)(wb + (pi == 2 ? RC_PRL : RC_QRL)); \
_Pragma("unroll") \
                for (int r = 0; r < 4; ++r) o[(4 * lq + r) * 24 + li] = (bf16)f2bf(acc[r]); } \
        } \
        RC_BAR(); \
        if (wave < 4) { \
            LAS unsigned char* wb = lds + (wave >> 1) * RC_CH; const bool isq = wave & 1; \
            float X[16]; \
_Pragma("unroll") \
            for (int r = 0; r < 16; ++r) X[r] = isq ? *(const LAS float*)(wb + RC_QF + (r * 16 + li) * 4) : *(const LAS float*)(wb + RC_ATF + (r * 68 + lane) * 4); \
_Pragma("unroll") \
            for (int j = 0; j < 15; ++j) { const LAS f32x4* pc = (const LAS f32x4*)(wb + RC_PFT + j * 64); const f32x4 c0v = pc[0], c1v = pc[1], c2v = pc[2], c3v = pc[3]; \
                const float c[16] = {c0v[0], c0v[1], c0v[2], c0v[3], c1v[0], c1v[1], c1v[2], c1v[3], c2v[0], c2v[1], c2v[2], c2v[3], c3v[0], c3v[1], c3v[2], c3v[3]}; \
_Pragma("unroll") \
                for (int r = j + 1; r < 16; ++r) X[r] = fmaf(c[r], X[j], X[r]); } \
            if (!isq) { LAS bf16* o = (LAS bf16*)(wb + RC_AH); \
_Pragma("unroll") \
                for (int r = 0; r < 16; ++r) o[r * 72 + lane] = (bf16)f2bf(X[r]); } \
            else if (lane < 16) { LAS bf16* o = (LAS bf16*)(wb + RC_TQL); \
_Pragma("unroll") \
                for (int r = 0; r < 16; ++r) o[r * 24 + lane] = (bf16)f2bf(X[r]); } \
        } \
        RC_BAR(); \
        { const int cc = tid >> 8, u = tid & 255; unsigned char* rec = rc_rec(ws, (size_t)bh_ * 512 + 2 * blk_ + cc); const LAS unsigned char* wb = lds + cc * RC_CH; \
          rc_copy_out(rec, wb, u); } \
        RC_BAR(); \
    } while (0)
struct RSOps { bf16x8 a01, a23, r01, r23, tq, pq, bk[4]; v2u vb; f32x4 g[4]; };
__device__ __forceinline__ void rs_load(const LAS unsigned char* wb, int wave, int li, int lq, RSOps& O) {
    const v2u z2 = {0u, 0u};
    O.vb = *(const LAS v2u*)(wb + RS_VS + ((16 * wave + li) * 24 + 4 * lq) * 2);
    const LAS bf16* ah = (const LAS bf16*)(wb + RS_AH) + li * 72 + 4 * lq; const LAS bf16* rt = (const LAS bf16*)(wb + RS_RT) + li * 72 + 4 * lq;
    O.a01 = cat8(*(const LAS v2u*)ah, *(const LAS v2u*)(ah + 16)); O.a23 = cat8(*(const LAS v2u*)(ah + 32), *(const LAS v2u*)(ah + 48));
    O.r01 = cat8(*(const LAS v2u*)rt, *(const LAS v2u*)(rt + 16)); O.r23 = cat8(*(const LAS v2u*)(rt + 32), *(const LAS v2u*)(rt + 48));
    O.tq = cat8(*(const LAS v2u*)(wb + RS_TQL + (li * 24 + 4 * lq) * 2), z2);
    O.pq = cat8(*(const LAS v2u*)(wb + RS_PRL + (li * 24 + 4 * lq) * 2), *(const LAS v2u*)(wb + RS_QRL + (li * 24 + 4 * lq) * 2));
#pragma unroll
    for (int kt = 0; kt < 4; ++kt) { O.bk[kt] = cat8(*(const LAS v2u*)(wb + RS_BTT + ((16 * kt + li) * 24 + 4 * lq) * 2), *(const LAS v2u*)(wb + RS_KTT + ((16 * kt + li) * 24 + 4 * lq) * 2));
        O.g[kt] = *(const LAS f32x4*)(wb + RS_G15 + (16 * kt + 4 * lq) * 4); }
}
#define RC_CHUNK(O, cc, row0) do { const v2u z2_ = {0u, 0u}; \
        f32x4 aD = {0.f, 0.f, 0.f, 0.f}, aY = {0.f, 0.f, 0.f, 0.f}; \
        aD = __builtin_amdgcn_mfma_f32_16x16x32_bf16(O.a01, Sb01, aD, 0, 0, 0); \
        aD = __builtin_amdgcn_mfma_f32_16x16x32_bf16(O.a23, Sb23, aD, 0, 0, 0); \
        aD = __builtin_amdgcn_mfma_f32_16x16x32_bf16(O.tq, cat8(O.vb, z2_), aD, 0, 0, 0); \
        aY = __builtin_amdgcn_mfma_f32_16x16x32_bf16(O.r01, Sb01, aY, 0, 0, 0); \
        aY = __builtin_amdgcn_mfma_f32_16x16x32_bf16(O.r23, Sb23, aY, 0, 0, 0); \
        const bf16x8 DV = cat8(pack4v(aD), O.vb); \
_Pragma("unroll") \
        for (int kt = 0; kt < 4; ++kt) Sacc[kt] = __builtin_amdgcn_mfma_f32_16x16x32_bf16(O.bk[kt], DV, Sacc[kt] * O.g[kt], 0, 0, 0); \
        aY = __builtin_amdgcn_mfma_f32_16x16x32_bf16(O.pq, DV, aY, 0, 0, 0); \
        Sb01 = cat8(pack4v(Sacc[0]), pack4v(Sacc[1])); Sb23 = cat8(pack4v(Sacc[2]), pack4v(Sacc[3])); \
_Pragma("unroll") \
        for (int r = 0; r < 4; ++r) YC[((row0) + (cc) * 16 + 4 * lq + r) * DM + 384 + h * 64 + 16 * wave + li] = (bf16)f2bf(aY[r]); \
    } while (0)
#define RC_SCAN(slot, row0) do { { RSOps O0; rs_load(slot, wave, li, lq, O0); __builtin_amdgcn_sched_barrier(0); RC_CHUNK(O0, 0, row0); } \
        { RSOps O1; rs_load(slot + RS_CH, wave, li, lq, O1); __builtin_amdgcn_sched_barrier(0); RC_CHUNK(O1, 1, row0); } } while (0)

__device__ __forceinline__ void phase_r2_build(KArgsP a, LAS unsigned char* lds, int tid, int lane, int wave, int vcu, int G, int l) {
    unsigned char* ws = a->ws;
    const int tt = tid >> 4, kq = tid & 15, ch = tt >> 4, t = tt & 15;
    const int lq = lane >> 4, li = lane & 15;
    LAS unsigned char* cb = lds + ch * RC_CH;
    const float* mu = a->in[I_RMU] + (size_t)l * RW_COLS;
    constexpr int NQ = NB * NH * 256;
    RCRegs RA, RB;
    if (vcu < NQ) rc_issue(ws, l, (size_t)(vcu >> 8) / NH * SEQ + (size_t)(vcu & 255) * 32, (vcu >> 8) % NH, tid, RA);
    if (vcu + G < NQ) rc_issue(ws, l, (size_t)((vcu + G) >> 8) / NH * SEQ + (size_t)((vcu + G) & 255) * 32, ((vcu + G) >> 8) % NH, tid, RB);
    for (int q0 = vcu; q0 < NQ; q0 += 2 * G) { { const int q = q0; RC_BUILD(RA, q); } if (q0 + G < NQ) { const int q = q0 + G; RC_BUILD(RB, q); } }
}
struct RSRegs { v4u p[6]; };
__device__ __forceinline__ void rs_issue(unsigned char* ws, size_t cu0, int lt, RSRegs& R) {
#pragma unroll
    for (int j = 0; j < 6; ++j) { const int uu = lt + 256 * j; if (uu < 2 * REC_UNITS) { const int cc = uu >= REC_UNITS, u = uu - cc * REC_UNITS; R.p[j] = *(const GAS v4u*)(rc_rec(ws, cu0 + cc) + u * 16); } }
}
__device__ __forceinline__ void rs_store(LAS unsigned char* slot, int lt, const RSRegs& R) {
#pragma unroll
    for (int j = 0; j < 6; ++j) { const int uu = lt + 256 * j; if (uu < 2 * REC_UNITS) { const int cc = uu >= REC_UNITS, u = uu - cc * REC_UNITS;
        *(LAS v4u*)(slot + cc * RS_CH + rc_unit_off<RS_AH, RS_RT, RS_BTT, RS_KTT, RS_VS, RS_PRL, RS_QRL, RS_TQL, RS_G15>(u)) = R.p[j]; } }
}
__device__ __forceinline__ void phase_r2_scan(KArgsP a, LAS unsigned char* lds, int tid, int lane, int wave, int wg, int l) {
    unsigned char* ws = a->ws; bf16* YC = (bf16*)(ws + WS_YC);
    const int b = wg / NH, h = wg % NH; const size_t rowb = (size_t)b * SEQ, cub = (size_t)wg * 512;
    const int lq = lane >> 4, li = lane & 15, lt = tid - 256; const bool loader = wave >= 4;
    f32x4 Sacc[4]; bf16x8 Sb01, Sb23;
#pragma unroll
    for (int kt = 0; kt < 4; ++kt) Sacc[kt] = (f32x4){0.f, 0.f, 0.f, 0.f};
    Sb01 = (bf16x8){0, 0, 0, 0, 0, 0, 0, 0}; Sb23 = Sb01;
    constexpr int NBLK = SEQ / 32;
    LAS unsigned char* slot0 = lds; LAS unsigned char* slot1 = lds + 2 * RS_CH;
    RSRegs RA, RB;
    if (loader) { rs_issue(ws, cub, lt, RA); rs_store(slot0, lt, RA); rs_issue(ws, cub + 2, lt, RB); rs_issue(ws, cub + 4, lt, RA); }
    RC_BAR();
    for (int bb = 0; bb < NBLK; bb += 2) {
        if (!loader) { const size_t row0 = rowb + (size_t)bb * 32; LAS unsigned char* slot = slot0; RC_SCAN(slot, row0); }
        else { rs_store(slot1, lt, RB); if (bb + 3 < NBLK) rs_issue(ws, cub + 2 * (size_t)(bb + 3), lt, RB); }
        RC_BAR();
        if (!loader) { const size_t row0 = rowb + (size_t)(bb + 1) * 32; LAS unsigned char* slot = slot1; RC_SCAN(slot, row0); }
        else { if (bb + 2 < NBLK) rs_store(slot0, lt, RA); if (bb + 4 < NBLK) rs_issue(ws, cub + 2 * (size_t)(bb + 4), lt, RA); }
        RC_BAR();
    }
}
__device__ __forceinline__ void phase_r3(KArgsP a, int lane, int gw, int ngw, int l) {
    unsigned char* ws = a->ws; const bf16* PROJ = (const bf16*)(ws + WS_PROJ); bf16* YC = (bf16*)(ws + WS_YC);
    const bf16* RA = (const bf16*)(ws + WS_RA); const bf16* RG = (const bf16*)(ws + WS_RG); const bf16* RVG = (const bf16*)(ws + WS_RVG); const bf16* VF = (const bf16*)(ws + WS_VF);
    const float* mu = a->in[I_RMU] + (size_t)l * RW_COLS;
    for (size_t row = gw; row < NTOK; row += ngw) {
#pragma unroll 2
        for (int h = 0; h < NH; ++h) {
            const int c = h * 64 + lane;
            const float y = bf2f(YC[row * DM + 384 + c]);
            const float m = dpp_allsum(y) * (1.f / 64.f); const float d = y - m; const float var = dpp_allsum(d * d) * (1.f / 64.f);
            const float yn = d * rsqrtf(var + RWKV_GN_EPS) * a->in[I_RLNW][l * DBR + c] + a->in[I_RLNB][l * DBR + c];
            const float rs = rw_shift(PROJ, mu, row, RWC_R + c), ks = rw_shift(PROJ, mu, row, RWC_K + c); float v = rw_shift(PROJ, mu, row, RWC_V + c);
            if (l > 0) v = v + (bf2f(VF[row * DBR + c]) - v) * bf2f(RVG[row * DBR + c]);
            const float av = bf2f(RA[row * DBR + c]);
            const float km = ks * (1.f + (av - 1.f) * a->in[I_RKA][l * DBR + c]);
            const float rk = dpp_allsum(rs * km * a->in[I_RRK][l * DBR + c]);
            YC[row * DM + 384 + c] = (bf16)f2bf((yn + rk * v) * bf2f(RG[row * DBR + c]));
        }
    }
}

constexpr int PH_PER_LAYER = 11, PH_FINAL = 1 + 2 * PH_PER_LAYER, N_PHASES = PH_FINAL + 1;
constexpr int R2_WGS = 24;
__global__ void __launch_bounds__(NTHR, 2) fwd(Args args) {
    extern __shared__ __attribute__((aligned(16))) unsigned char lds_raw[];
    LAS unsigned char* lds = (LAS unsigned char*)lds_raw;
    volatile LAS unsigned* MISC = (volatile LAS unsigned*)(lds + MISC_OFF);
    const int tid0 = threadIdx.x;
    const int G = gridDim.x;
#define PHASE_IDS int tid_ = threadIdx.x; asm volatile("" : "+v"(tid_)); const int tid = tid_, lane = tid & 63, wave = __builtin_amdgcn_readfirstlane(tid >> 6); \
    int bx_ = blockIdx.x; asm volatile("" : "+s"(bx_)); const int bx = bx_; const int vcu = (G % 8 == 0) ? (bx % 8) * (G / 8) + bx / 8 : bx; (void)lane; (void)wave; (void)vcu; (void)bx;
    unsigned char* ws0 = fresh_args()->ws;
    for (int u = tid0; u < (LDS_BYTES - RING_BYTES) / 4; u += NTHR) ((LAS unsigned*)(lds + RING_BYTES))[u] = 0u;
    __syncthreads();
    XcdBarrier bar; bar.bar = (unsigned*)(ws0 + WS_CTL) + CW_BAR; bar.x = 0; bar.st = nullptr;
    if (!MK_PER_PHASE) bar = xcd_barrier_post((unsigned*)(ws0 + WS_CTL) + CW_BAR, MISC + 8);
#if MK_PER_PHASE
    const int lo = args.ph_lo, hi = args.ph_hi;
#define IN(k) (lo <= (k) && (k) < hi)
#else
#define IN(k) true
#endif
#define SEAM(k) do { if (IN(k) && IN((k) + 1)) { XcdBarrier b2 = bar; asm volatile("" : "+s"(b2.bar)); xcd_barrier(b2); } } while (0)

#ifndef DBL_SUB
#define DBL_SUB 0
#endif
#ifndef DBL_PHASE
#define DBL_PHASE (-1)
#endif
#ifndef REPN
#define REPN 2
#endif
#define REP(k) for (int rep_ = 0; rep_ < ((k) == DBL_PHASE ? REPN : 1); ++rep_)
#define REPBAR if (rep_ > 0) { XcdBarrier b2 = bar; asm volatile("" : "+s"(b2.bar)); xcd_barrier(b2); }
    REP(0) if (IN(0)) { REPBAR KArgsP ap = fresh_args(); PHASE_IDS phase_prologue(ap, lds, tid, lane, wave, vcu, G); }
    SEAM(0);
#define LCONST 0
    {
        constexpr int l = LCONST; constexpr int pb = 1 + l * PH_PER_LAYER;
        REP(pb + 0) if (IN(pb + 0)) { REPBAR KArgsP ap = fresh_args(); PHASE_IDS unsigned char* ws = ap->ws; (void)ws;
            if (l == 0) { mod_finalize(ws, tid, G); phase_rownorm<0, false>(ap, lds, tid, lane, wave, G, ap->in[I_X], ap->out, ap->in[I_NORM_MIX], true, 0, 0, 0); }
            else {
#if EN_MOE
                phase_rownorm<0, true>(ap, lds, tid, lane, wave, G, ap->out, ap->out, ap->in[I_NORM_MIX] + l * DM, false, l, 0, l - 1);
#else
                phase_rownorm<0, false>(ap, lds, tid, lane, wave, G, ap->out, ap->out, ap->in[I_NORM_MIX] + l * DM, false, l, 0, l - 1);
#endif
            }
        }
        SEAM(pb + 0);
        REP(pb + 1) if (IN(pb + 1)) { REPBAR KArgsP ap = fresh_args(); PHASE_IDS unsigned char* ws = ap->ws; (void)ws;
            pg8::Gemm g{(const pg8::bf16_t*)(ws + WS_HN), (const pg8::bf16_t*)(ws + WS_WIN) + (size_t)l * NPROJ_PAD * DM, NTOK, NPROJ_PAD, DM};
            pg8::StaticOrder S; S.init(NTOK, NPROJ_PAD, G, bx);
            pg8::EpiProj E{(pg8::bf16_t*)(ws + WS_PROJ), (float*)(ws + WS_GATES)};
            pg8::gemm_phase<pg8::EpiProj, pg8::StaticOrder, true, true>(lds, g, S, E);
        }
        SEAM(pb + 1);
        REP(pb + 2) if (IN(pb + 2)) { REPBAR KArgsP ap = fresh_args(); PHASE_IDS unsigned char* ws = ap->ws; (void)ws;
#if EN_MLSTM
            for (int q_ = 0; q_ < 1 + (REPN - 1) * ((DBL_SUB == 1) && l == 0); ++q_) { phase_m1(ap, lds, tid, lane, wave, vcu, G, l); __syncthreads(); }
            __syncthreads();
#endif
#if EN_S5
            phase_s1(ap, lds, tid, lane, wave, vcu, G, l); __syncthreads();
#if DBL_SUB == 2
            if (l == 0) { phase_s1(ap, lds, tid, lane, wave, vcu, G, l); __syncthreads(); phase_s1(ap, lds, tid, lane, wave, vcu, G, l); __syncthreads(); phase_s1(ap, lds, tid, lane, wave, vcu, G, l); __syncthreads(); phase_s1(ap, lds, tid, lane, wave, vcu, G, l); __syncthreads(); }
#endif
            __syncthreads();
#endif
#if EN_RWKV
            for (int q_ = 0; q_ < 1 + (REPN - 1) * ((DBL_SUB == 3) && l == 0); ++q_) { phase_r1(ap, lds, tid, lane, wave, vcu, G, l); __syncthreads(); }
#endif
        }
        SEAM(pb + 2);
        REP(pb + 3) if (IN(pb + 3)) { REPBAR KArgsP ap = fresh_args(); PHASE_IDS unsigned char* ws = ap->ws; (void)ws;
            if (vcu >= G - 64) { const int wg = vcu - (G - 64), nwg = 64;
                phase_m2(ws, tid, wg, nwg);
                phase_s2(ap, tid, wg, nwg, l);
                __syncthreads(); }
            phase_r2_build(ap, lds, tid, lane, wave, vcu, G, l);
        }
        SEAM(pb + 3);
        REP(pb + 4) if (IN(pb + 4)) { REPBAR KArgsP ap = fresh_args(); PHASE_IDS unsigned char* ws = ap->ws; (void)ws;
            if (bx < R2_WGS) { for (int q_ = 0; q_ < 1 + (REPN - 1) * ((DBL_SUB == 4) && l == 0); ++q_) { phase_r2_scan(ap, lds, tid, lane, wave, bx, l); __syncthreads(); } }
            else {
                for (int q_ = 0; q_ < 1 + (REPN - 1) * ((DBL_SUB == 5) && l == 0); ++q_) { phase_m3(ap, lds, tid, lane, wave, bx - R2_WGS, G - R2_WGS, l); __syncthreads(); }
                for (int q_ = 0; q_ < 1 + (REPN - 1) * ((DBL_SUB == 6) && l == 0); ++q_) { phase_s3(ap, lds, tid, lane, wave, bx - R2_WGS, G - R2_WGS, l); __syncthreads(); }
            }
        }
        SEAM(pb + 4);
        REP(pb + 5) if (IN(pb + 5)) { REPBAR KArgsP ap = fresh_args(); PHASE_IDS
            phase_r3(ap, lane, vcu * NWAVES + wave, G * NWAVES, l);
        }
        SEAM(pb + 5);
        REP(pb + 6) if (IN(pb + 6)) { REPBAR KArgsP ap = fresh_args(); PHASE_IDS unsigned char* ws = ap->ws; (void)ws;
            pg8::Gemm g{(const pg8::bf16_t*)(ws + WS_YC), (const pg8::bf16_t*)(ws + WS_WOUT) + (size_t)l * DM * DM, NTOK, DM, DM};
            pg8::StaticOrder S; S.init(NTOK, DM, G, bx);
            pg8::EpiResid E{l == 0 ? ap->in[I_X] : (const float*)ap->out, ap->out, (const float*)(ws + WS_MODF) + (size_t)l * 4 * 6144, 2048};
            pg8::gemm_phase<pg8::EpiResid, pg8::StaticOrder, true, true>(lds, g, S, E);
        }
        SEAM(pb + 6);
#if EN_MOE
        REP(pb + 7) if (IN(pb + 7)) { REPBAR KArgsP ap = fresh_args(); PHASE_IDS phase_router(ap, lds, tid, lane, wave, G, l); }
        SEAM(pb + 7);
        REP(pb + 8) if (IN(pb + 8)) { REPBAR KArgsP ap = fresh_args(); PHASE_IDS phase_rowmap(ap, lds, tid, vcu, G, l); __syncthreads();
            moe_convert(ap->in[I_MW1], ap->in[I_MW3], ap->in[I_MW2], l, (bf16*)(ap->ws + WS_W13), (bf16*)(ap->ws + WS_W2), vcu * NWAVES + wave, G * NWAVES, (LAS float*)(lds + wave * 16640), lane); }
        SEAM(pb + 8);
        REP(pb + 9) if (IN(pb + 9)) { REPBAR KArgsP ap = fresh_args(); PHASE_IDS unsigned char* ws = ap->ws; (void)ws;
            LAS int* ptab = (LAS int*)(lds + PTAB_OFF); LAS int* pst = ptab + 512; LAS int* cnt = pst + 32;
            build_ptab((const unsigned*)(ws + WS_CTL) + CW_CNT + l * 32, ptab, pst, cnt, tid);
            pg8::Gemm g{(const pg8::bf16_t*)(ws + WS_HN), (const pg8::bf16_t*)(ws + WS_W13), 0, 0, DM, (const int*)(ws + WS_ROWMAP)};
            pg8::MoeOrder S{ptab, G, vcu};
            pg8::EpiSwiglu E{(pg8::bf16_t*)(ws + WS_HMID)};
            pg8::gemm_phase<pg8::EpiSwiglu, pg8::MoeOrder, false, true, true>(lds, g, S, E);
        }
        SEAM(pb + 9);
        REP(pb + 10) if (IN(pb + 10)) { REPBAR KArgsP ap = fresh_args(); PHASE_IDS unsigned char* ws = ap->ws; (void)ws;
            LAS int* ptab = (LAS int*)(lds + PTAB_OFF); LAS int* pst = ptab + 512; LAS int* cnt = pst + 32;
            build_ptab((const unsigned*)(ws + WS_CTL) + CW_CNT + l * 32, ptab, pst, cnt, tid);
            pg8::Gemm g{(const pg8::bf16_t*)(ws + WS_HMID), (const pg8::bf16_t*)(ws + WS_W2), 0, 0, DEXP};
            pg8::MoeOrder S{ptab, G, vcu};
            pg8::EpiMoeOut E{(pg8::bf16_t*)(ws + WS_YMOE), (const int*)(ws + WS_ROWMAP)};
            pg8::gemm_phase<pg8::EpiMoeOut, pg8::MoeOrder, true, true>(lds, g, S, E);
        }
        SEAM(pb + 10);
#else
        SEAM(pb + 7); SEAM(pb + 8); SEAM(pb + 9); SEAM(pb + 10);
#endif
    }
#undef LCONST
#if N_LAYERS > 1
#define LCONST 1
    {
        constexpr int l = LCONST; constexpr int pb = 1 + l * PH_PER_LAYER;
        REP(pb + 0) if (IN(pb + 0)) { REPBAR KArgsP ap = fresh_args(); PHASE_IDS unsigned char* ws = ap->ws; (void)ws;
            if (l == 0) { mod_finalize(ws, tid, G); phase_rownorm<0, false>(ap, lds, tid, lane, wave, G, ap->in[I_X], ap->out, ap->in[I_NORM_MIX], true, 0, 0, 0); }
            else {
#if EN_MOE
                phase_rownorm<0, true>(ap, lds, tid, lane, wave, G, ap->out, ap->out, ap->in[I_NORM_MIX] + l * DM, false, l, 0, l - 1);
#else
                phase_rownorm<0, false>(ap, lds, tid, lane, wave, G, ap->out, ap->out, ap->in[I_NORM_MIX] + l * DM, false, l, 0, l - 1);
#endif
            }
        }
        SEAM(pb + 0);
        REP(pb + 1) if (IN(pb + 1)) { REPBAR KArgsP ap = fresh_args(); PHASE_IDS unsigned char* ws = ap->ws; (void)ws;
            pg8::Gemm g{(const pg8::bf16_t*)(ws + WS_HN), (const pg8::bf16_t*)(ws + WS_WIN) + (size_t)l * NPROJ_PAD * DM, NTOK, NPROJ_PAD, DM};
            pg8::StaticOrder S; S.init(NTOK, NPROJ_PAD, G, bx);
            pg8::EpiProj E{(pg8::bf16_t*)(ws + WS_PROJ), (float*)(ws + WS_GATES)};
            pg8::gemm_phase<pg8::EpiProj, pg8::StaticOrder, true, true>(lds, g, S, E);
        }
        SEAM(pb + 1);
        REP(pb + 2) if (IN(pb + 2)) { REPBAR KArgsP ap = fresh_args(); PHASE_IDS unsigned char* ws = ap->ws; (void)ws;
#if EN_MLSTM
            for (int q_ = 0; q_ < 1 + (REPN - 1) * ((DBL_SUB == 1) && l == 0); ++q_) { phase_m1(ap, lds, tid, lane, wave, vcu, G, l); __syncthreads(); }
            __syncthreads();
#endif
#if EN_S5
            phase_s1(ap, lds, tid, lane, wave, vcu, G, l); __syncthreads();
#if DBL_SUB == 2
            if (l == 0) { phase_s1(ap, lds, tid, lane, wave, vcu, G, l); __syncthreads(); phase_s1(ap, lds, tid, lane, wave, vcu, G, l); __syncthreads(); phase_s1(ap, lds, tid, lane, wave, vcu, G, l); __syncthreads(); phase_s1(ap, lds, tid, lane, wave, vcu, G, l); __syncthreads(); }
#endif
            __syncthreads();
#endif
#if EN_RWKV
            for (int q_ = 0; q_ < 1 + (REPN - 1) * ((DBL_SUB == 3) && l == 0); ++q_) { phase_r1(ap, lds, tid, lane, wave, vcu, G, l); __syncthreads(); }
#endif
        }
        SEAM(pb + 2);
        REP(pb + 3) if (IN(pb + 3)) { REPBAR KArgsP ap = fresh_args(); PHASE_IDS unsigned char* ws = ap->ws; (void)ws;
            if (vcu >= G - 64) { const int wg = vcu - (G - 64), nwg = 64;
                phase_m2(ws, tid, wg, nwg);
                phase_s2(ap, tid, wg, nwg, l);
                __syncthreads(); }
            phase_r2_build(ap, lds, tid, lane, wave, vcu, G, l);
        }
        SEAM(pb + 3);
        REP(pb + 4) if (IN(pb + 4)) { REPBAR KArgsP ap = fresh_args(); PHASE_IDS unsigned char* ws = ap->ws; (void)ws;
            if (bx < R2_WGS) { for (int q_ = 0; q_ < 1 + (REPN - 1) * ((DBL_SUB == 4) && l == 0); ++q_) { phase_r2_scan(ap, lds, tid, lane, wave, bx, l); __syncthreads(); } }
            else {
                for (int q_ = 0; q_ < 1 + (REPN - 1) * ((DBL_SUB == 5) && l == 0); ++q_) { phase_m3(ap, lds, tid, lane, wave, bx - R2_WGS, G - R2_WGS, l); __syncthreads(); }
                for (int q_ = 0; q_ < 1 + (REPN - 1) * ((DBL_SUB == 6) && l == 0); ++q_) { phase_s3(ap, lds, tid, lane, wave, bx - R2_WGS, G - R2_WGS, l); __syncthreads(); }
            }
        }
        SEAM(pb + 4);
        REP(pb + 5) if (IN(pb + 5)) { REPBAR KArgsP ap = fresh_args(); PHASE_IDS
            phase_r3(ap, lane, vcu * NWAVES + wave, G * NWAVES, l);
        }
        SEAM(pb + 5);
        REP(pb + 6) if (IN(pb + 6)) { REPBAR KArgsP ap = fresh_args(); PHASE_IDS unsigned char* ws = ap->ws; (void)ws;
            pg8::Gemm g{(const pg8::bf16_t*)(ws + WS_YC), (const pg8::bf16_t*)(ws + WS_WOUT) + (size_t)l * DM * DM, NTOK, DM, DM};
            pg8::StaticOrder S; S.init(NTOK, DM, G, bx);
            pg8::EpiResid E{l == 0 ? ap->in[I_X] : (const float*)ap->out, ap->out, (const float*)(ws + WS_MODF) + (size_t)l * 4 * 6144, 2048};
            pg8::gemm_phase<pg8::EpiResid, pg8::StaticOrder, true, true>(lds, g, S, E);
        }
        SEAM(pb + 6);
#if EN_MOE
        REP(pb + 7) if (IN(pb + 7)) { REPBAR KArgsP ap = fresh_args(); PHASE_IDS phase_router(ap, lds, tid, lane, wave, G, l); }
        SEAM(pb + 7);
        REP(pb + 8) if (IN(pb + 8)) { REPBAR KArgsP ap = fresh_args(); PHASE_IDS phase_rowmap(ap, lds, tid, vcu, G, l); __syncthreads();
            moe_convert(ap->in[I_MW1], ap->in[I_MW3], ap->in[I_MW2], l, (bf16*)(ap->ws + WS_W13), (bf16*)(ap->ws + WS_W2), vcu * NWAVES + wave, G * NWAVES, (LAS float*)(lds + wave * 16640), lane); }
        SEAM(pb + 8);
        REP(pb + 9) if (IN(pb + 9)) { REPBAR KArgsP ap = fresh_args(); PHASE_IDS unsigned char* ws = ap->ws; (void)ws;
            LAS int* ptab = (LAS int*)(lds + PTAB_OFF); LAS int* pst = ptab + 512; LAS int* cnt = pst + 32;
            build_ptab((const unsigned*)(ws + WS_CTL) + CW_CNT + l * 32, ptab, pst, cnt, tid);
            pg8::Gemm g{(const pg8::bf16_t*)(ws + WS_HN), (const pg8::bf16_t*)(ws + WS_W13), 0, 0, DM, (const int*)(ws + WS_ROWMAP)};
            pg8::MoeOrder S{ptab, G, vcu};
            pg8::EpiSwiglu E{(pg8::bf16_t*)(ws + WS_HMID)};
            pg8::gemm_phase<pg8::EpiSwiglu, pg8::MoeOrder, false, true, true>(lds, g, S, E);
        }
        SEAM(pb + 9);
        REP(pb + 10) if (IN(pb + 10)) { REPBAR KArgsP ap = fresh_args(); PHASE_IDS unsigned char* ws = ap->ws; (void)ws;
            LAS int* ptab = (LAS int*)(lds + PTAB_OFF); LAS int* pst = ptab + 512; LAS int* cnt = pst + 32;
            build_ptab((const unsigned*)(ws + WS_CTL) + CW_CNT + l * 32, ptab, pst, cnt, tid);
            pg8::Gemm g{(const pg8::bf16_t*)(ws + WS_HMID), (const pg8::bf16_t*)(ws + WS_W2), 0, 0, DEXP};
            pg8::MoeOrder S{ptab, G, vcu};
            pg8::EpiMoeOut E{(pg8::bf16_t*)(ws + WS_YMOE), (const int*)(ws + WS_ROWMAP)};
            pg8::gemm_phase<pg8::EpiMoeOut, pg8::MoeOrder, true, true>(lds, g, S, E);
        }
        SEAM(pb + 10);
#else
        SEAM(pb + 7); SEAM(pb + 8); SEAM(pb + 9); SEAM(pb + 10);
#endif
    }
#undef LCONST
#endif
    if (IN(PH_FINAL)) { KArgsP ap = fresh_args(); PHASE_IDS
#if EN_MOE
        if (N_LAYERS > 0) phase_rownorm<1, true>(ap, lds, tid, lane, wave, G, ap->out, ap->out, ap->in[I_NORM_FINAL], false, 0, 0, N_LAYERS - 1);
        else phase_rownorm<1, false>(ap, lds, tid, lane, wave, G, ap->in[I_X], ap->out, ap->in[I_NORM_FINAL], false, 0, 0, 0);
#else
        phase_rownorm<1, false>(ap, lds, tid, lane, wave, G, N_LAYERS > 0 ? (const float*)ap->out : ap->in[I_X], ap->out, ap->in[I_NORM_FINAL], false, 0, 0, 0);
#endif
    }
#undef IN
#undef SEAM
}

extern "C" void kernel_launch(void* const* d_in, const int* in_sizes, int n_in, void* d_out, int out_size, void* d_ws, size_t ws_size, hipStream_t stream) {
    static int grid = 0;
    if (grid == 0) {
        if (n_in != 47 || out_size != NTOK * DM || ws_size < WS_END) { fprintf(stderr, "kernel_launch: unexpected problem (n_in %d, out %d, ws %zu < %zu)\n", n_in, out_size, ws_size, (size_t)WS_END); grid = -1; return; }
        int dev = 0, cus = 0, per_cu = 0;
        if (hipGetDevice(&dev) != hipSuccess || hipDeviceGetAttribute(&cus, hipDeviceAttributeMultiprocessorCount, dev) != hipSuccess) { grid = -1; return; }
        if (hipFuncSetAttribute((const void*)fwd, hipFuncAttributeMaxDynamicSharedMemorySize, LDS_BYTES) != hipSuccess) { fprintf(stderr, "kernel_launch: hipFuncSetAttribute failed\n"); grid = -1; return; }
        if (hipOccupancyMaxActiveBlocksPerMultiprocessor(&per_cu, (const void*)fwd, NTHR, LDS_BYTES) != hipSuccess || per_cu < 1) fprintf(stderr, "kernel_launch: occupancy query says %d\n", per_cu);
        (void)hipGetLastError();
        grid = cus;
        if (grid != 256) fprintf(stderr, "kernel_launch: %d CUs (built for 256)\n", grid);
    }
    if (grid < 0) return;
    (void)hipMemsetAsync((char*)d_ws + WS_CTL, 0, CTL_ZERO_BYTES, stream);
    Args a{};
    for (int i = 0; i < 47; ++i) a.in[i] = (const float*)d_in[i];
    a.out = (float*)d_out; a.ws = (unsigned char*)d_ws;
#if MK_PER_PHASE
    for (int p = 0; p < N_PHASES; ++p) { a.ph_lo = p; a.ph_hi = p + 1; hipLaunchKernelGGL(fwd, dim3(grid), dim3(NTHR), LDS_BYTES, stream, a); }
#else
    a.ph_lo = 0; a.ph_hi = N_PHASES; hipLaunchKernelGGL(fwd, dim3(grid), dim3(NTHR), LDS_BYTES, stream, a);
#endif
}
#ifdef DIAG_KERNELS
#define DK(name, ...) __global__ void __launch_bounds__(NTHR, 2) name(Args args) { extern __shared__ __attribute__((aligned(16))) unsigned char lds_raw[]; LAS unsigned char* lds = (LAS unsigned char*)lds_raw; \
    const int tid = threadIdx.x, lane = tid & 63, wave = __builtin_amdgcn_readfirstlane(tid >> 6); const int G = gridDim.x; const int bx = blockIdx.x; const int vcu = bx; KArgsP ap = fresh_args(); int l = ap->ph_lo; (void)lane; (void)wave; (void)vcu; (void)G; (void)l; __VA_ARGS__ }
DK(k_prologue, phase_prologue(ap, lds, tid, lane, wave, vcu, G);)
DK(k_norm0, phase_rownorm<0, false>(ap, lds, tid, lane, wave, G, ap->in[I_X], ap->out, ap->in[I_NORM_MIX], true, 0, 0, 0);)
DK(k_norm1, phase_rownorm<0, true>(ap, lds, tid, lane, wave, G, ap->out, ap->out, ap->in[I_NORM_MIX], false, l, 0, 0);)
DK(k_normf, phase_rownorm<1, true>(ap, lds, tid, lane, wave, G, ap->out, ap->out, ap->in[I_NORM_MIX], false, l, 0, 0);)
DK(k_m1, phase_m1(ap, lds, tid, lane, wave, vcu, G, l);)
DK(k_m2, phase_m2(ap->ws, tid, vcu, G);)
DK(k_m3, phase_m3(ap, lds, tid, lane, wave, vcu, G, l);)
DK(k_s1, phase_s1(ap, lds, tid, lane, wave, vcu, G, l);)
DK(k_s2, phase_s2(ap, tid, vcu, G, l);)
DK(k_s3, phase_s3(ap, lds, tid, lane, wave, vcu, G, l);)
DK(k_r1, phase_r1(ap, lds, tid, lane, wave, vcu, G, l);)
DK(k_r2b, phase_r2_build(ap, lds, tid, lane, wave, vcu, G, l);)
DK(k_r2s, phase_r2_scan(ap, lds, tid, lane, wave, vcu, l);)
DK(k_r3, phase_r3(ap, lane, vcu * NWAVES + wave, G * NWAVES, l);)
DK(k_router, phase_router(ap, lds, tid, lane, wave, G, l);)
DK(k_gather, phase_gather(ap, lds, tid, lane, wave, vcu, G, l);)
DK(k_moecv, moe_convert(ap->in[I_MW1], ap->in[I_MW3], ap->in[I_MW2], 1, (bf16*)(ap->ws + WS_W13), (bf16*)(ap->ws + WS_W2), vcu * NWAVES + wave, G * NWAVES, (LAS float*)(lds + wave * 16640), lane);)
#endif
```

```cpp
#include <hip/hip_runtime.h>
#include <cstdio>
#include <cstdint>
#define MK_PER_PHASE 0

#ifndef MK_PER_PHASE
#define MK_PER_PHASE 0
#endif
#ifndef EN_MLSTM
#define EN_MLSTM 1
#endif
#ifndef EN_S5
#define EN_S5 1
#endif
#ifndef EN_RWKV
#define EN_RWKV 1
#endif
#ifndef EN_MOE
#define EN_MOE 1
#endif
#ifndef N_LAYERS
#define N_LAYERS 2
#endif
constexpr int NWAVES = 8, NTHR = 512;
constexpr int DM = 1024, NB = 4, SEQ = 8192, NTOK = NB * SEQ;
constexpr int DA = 384, DBR = 384, DC = 256, NH = 6, HD = 64, NCH = SEQ / 64;
constexpr int IN_COLS = 2828, NPROJ = 2816, NPROJ_PAD = 3072;
constexpr int PC_QK = 0, PC_V = 384, PC_O = 768, PC_RW = 1152, PC_S5 = 2560;
constexpr int RWC_R = 0, RWC_K = 384, RWC_V = 768, RWC_WD = 1152, RWC_AD = 1216, RWC_GD = 1280, RW_COLS = 1408;
constexpr int NEXP = 32, DEXP = 512, MOE_ROWS_MAX = 73728;
constexpr int NUNIT_M = NB * NCH * NH;
constexpr int CL_STRIDE = 4160;
constexpr float NORM_EPS = 1e-6f, HEAD_NORM_EPS = 1e-5f, RWKV_GN_EPS = 64e-5f;

constexpr size_t MiB = 1u << 20;
constexpr size_t WS_CTL = 0, CTL_ZERO_BYTES = 1 * MiB;
constexpr size_t WS_MODP = 1 * MiB;
constexpr size_t WS_MODF = 2 * MiB + 512 * 1024;
constexpr size_t WS_S5BB = 2 * MiB + 896 * 1024;
constexpr size_t WS_RTW = 3 * MiB;
constexpr size_t WS_S5AP = 3 * MiB + 384 * 1024;
constexpr size_t WS_MLW = 3 * MiB + 512 * 1024;
constexpr size_t WS_S5CM = 2 * MiB + 768 * 1024;
constexpr size_t WS_GLUT = 3 * MiB + 768 * 1024;
constexpr size_t WS_WIN = 4 * MiB;
constexpr size_t WS_WOUT = 16 * MiB;
constexpr size_t WS_GATES = 20 * MiB;
constexpr size_t WS_W13 = 22 * MiB;
constexpr size_t WS_W2 = 86 * MiB;
constexpr size_t WS_HN = 118 * MiB;
constexpr size_t WS_CLOC = 118 * MiB;
constexpr size_t WS_MSC = 168 * MiB;
constexpr size_t WS_S5ST = 170 * MiB;
constexpr size_t WS_VF = 182 * MiB;
constexpr size_t WS_YC = 206 * MiB;
constexpr size_t WS_LIST = 206 * MiB;
constexpr size_t WS_ROWMAP = 214 * MiB;
constexpr size_t WS_TOKE = 215 * MiB;
constexpr size_t WS_TOKW = 215 * MiB + 512 * 1024;
constexpr size_t WS_PROJ = 270 * MiB;
constexpr size_t WS_RE = 446 * MiB, WS_RA = 470 * MiB, WS_RG = 494 * MiB, WS_RVG = 518 * MiB;
constexpr size_t WS_XG = 270 * MiB;
constexpr size_t WS_HMID = 414 * MiB;
constexpr size_t WS_YMOE = 270 * MiB;
constexpr size_t WS_R1W = 542 * MiB;
constexpr size_t WS_OPA = 22 * MiB;
constexpr size_t WS_OPB = 543 * MiB;
constexpr size_t WS_END = 591 * MiB;
constexpr int CW_TMO = 0, CW_BAR = 4096, CW_CNT = 8192, CW_Q = 8320;

constexpr int RING_BYTES = 131072, MISC_OFF = 135168, PTAB_OFF = MISC_OFF + 1024, LDS_BYTES = 147456;

#define GAS __attribute__((address_space(1)))
#define LAS __attribute__((address_space(3)))
typedef unsigned short bf16;
typedef unsigned v4u __attribute__((ext_vector_type(4)));
typedef unsigned v2u __attribute__((ext_vector_type(2)));
typedef float f32x4 __attribute__((ext_vector_type(4)));
typedef float f32x2 __attribute__((ext_vector_type(2)));
typedef GAS unsigned gu32;
#define RLX_AGENT __ATOMIC_RELAXED, __HIP_MEMORY_SCOPE_AGENT
#define LDS_WAIT() asm volatile("s_waitcnt lgkmcnt(0)" ::: "memory")
#define VM_WAIT() asm volatile("s_waitcnt vmcnt(0)" ::: "memory")
typedef float f32x2v __attribute__((ext_vector_type(2)));
typedef __bf16 bf16x2v __attribute__((ext_vector_type(2)));
__device__ __forceinline__ unsigned pk2(float lo, float hi) { const f32x2v v = {lo, hi}; const bf16x2v b = __builtin_convertvector(v, bf16x2v); return __builtin_bit_cast(unsigned, b); }
__device__ __forceinline__ unsigned f2bf(float f) { return pk2(f, 0.f) & 0xffffu; }
__device__ __forceinline__ float bf2f(unsigned v) { return __builtin_bit_cast(float, v << 16); }
__device__ __forceinline__ float bflo(unsigned w) { return __builtin_bit_cast(float, w << 16); }
__device__ __forceinline__ float bfhi(unsigned w) { return __builtin_bit_cast(float, w & 0xffff0000u); }
__device__ __forceinline__ float sigmoidf_(float x) { return 1.f / (1.f + __expf(-x)); }
__device__ __forceinline__ float wave_sum(float v) {
#pragma unroll
    for (int o = 1; o < 64; o <<= 1) v += __shfl_xor(v, o);
    return v;
}
__device__ __forceinline__ float wave_max(float v) {
#pragma unroll
    for (int o = 1; o < 64; o <<= 1) v = fmaxf(v, __shfl_xor(v, o));
    return v;
}
namespace pg8 {
#define PG8_LAS __attribute__((address_space(3)))
typedef unsigned short bf16_t;
typedef short bf16x8 __attribute__((ext_vector_type(8)));
typedef float f32x4 __attribute__((ext_vector_type(4)));
typedef unsigned u32x4 __attribute__((ext_vector_type(4)));
constexpr int BM = 256, BK = 64, HALF = 128, HTB = HALF * BK * 2  , STAGE_BYTES = 8 * HTB, NXCD = 8, WGM = 8;

__host__ __device__ __forceinline__ int lds_byte(int r, int c) { const int st = (r >> 4) * 2 + (c >> 5), rr = r & 15, cc = c & 31, ob = rr * 64 + cc * 2; return st * 1024 + (ob ^ (((ob >> 9) & 1) << 5)); }
__host__ __device__ __forceinline__ void stage_rc(int b, int& R, int& C) { const int st = b / 1024, sb = b % 1024, swz = sb ^ (((sb >> 9) & 1) << 5); R = (st >> 1) * 16 + swz / 64; C = (st & 1) * 32 + (swz % 64) / 2; }
__host__ __device__ __forceinline__ int perm32(int rho) { const int n = rho >> 4, i = rho & 15; return 8 * (i >> 2) + 4 * n + (i & 3); }

struct Unit { int pm, pn; };
struct Gemm { const bf16_t* A; const bf16_t* Bt; int M, N, K; const int* rowmap = nullptr; };

struct StaticOrder {
    int nM, nN, nwg, G, c;
    __host__ __device__ void init(int M, int N, int G_, int c_) { nM = M / BM; nN = N / BM; nwg = nM * nN; G = G_; c = c_; }
    __host__ __device__ bool next(int i, Unit& u) const {
        const long L = (long)i * G + c; if (L >= nwg) return false;
        int wgid = (int)L; { const int q = nwg / NXCD, r = nwg % NXCD, xcd = wgid % NXCD, off = wgid / NXCD; wgid = (xcd < r ? xcd * (q + 1) : r * (q + 1) + (xcd - r) * q) + off; }
        const int nig = WGM * nN, gid = wgid / nig, fm = gid * WGM, gsz = (nM - fm) < WGM ? (nM - fm) : WGM;
        u.pm = fm + ((wgid % nig) % gsz); u.pn = (wgid % nig) / gsz; return true;
    }
    __device__ __forceinline__ void a_ready(const Unit&) const {}
    __device__ __forceinline__ void done(const Unit&) const {}
};

__device__ __forceinline__ unsigned cvt_pk_bf16(float lo, float hi) { unsigned r; asm volatile("v_cvt_pk_bf16_f32 %0, %1, %2" : "=v"(r) : "v"(lo), "v"(hi)); return r; }

struct EpiProj {
    static constexpr bool PERM = true, AFTER_DRAIN = false;
    bf16_t* O; float* G;
    __device__ __forceinline__ void operator()(const f32x4 (&acc)[2][2][4][2], const Unit& u, int wr, int wc, int fr, int fq) const {
        const int row0 = u.pm * BM + wr * 64 + fr;
        if (u.pn < 11) {
            const int col0 = u.pn * BM + wc * 32 + 8 * fq;
#pragma unroll
            for (int ai = 0; ai < 2; ++ai)
#pragma unroll
                for (int m = 0; m < 4; ++m) { bf16_t* rowp = O + (size_t)(row0 + ai * HALF + m * 16) * 2816 + col0;
#pragma unroll
                    for (int bj = 0; bj < 2; ++bj) { const f32x4 v0 = acc[ai][bj][m][0], v1 = acc[ai][bj][m][1];
                        u32x4 w; w.x = cvt_pk_bf16(v0[0], v0[1]); w.y = cvt_pk_bf16(v0[2], v0[3]); w.z = cvt_pk_bf16(v1[0], v1[1]); w.w = cvt_pk_bf16(v1[2], v1[3]);
                        *(u32x4*)(rowp + bj * HALF) = w; } }
        } else if (wc == 0 && fq < 2) {
#pragma unroll
            for (int ai = 0; ai < 2; ++ai)
#pragma unroll
                for (int m = 0; m < 4; ++m) { float* rowp = G + (size_t)(row0 + ai * HALF + m * 16) * 16 + 8 * fq;
                    *(f32x4*)(rowp) = acc[ai][0][m][0]; *(f32x4*)(rowp + 4) = acc[ai][0][m][1]; }
        }
    }
};
struct EpiResid {
    static constexpr bool PERM = true, AFTER_DRAIN = false;
    const float* xin; float* out; const float* gate;
    int goff;
    __device__ __forceinline__ void operator()(const f32x4 (&acc)[2][2][4][2], const Unit& u, int wr, int wc, int fr, int fq) const {
        const int row0 = u.pm * BM + wr * 64 + fr, col0 = u.pn * BM + wc * 32 + 8 * fq;
        const float* gp = gate + (size_t)(row0 >> 13) * 6144 + goff + col0;
        f32x4 g[2][2];
#pragma unroll
        for (int bj = 0; bj < 2; ++bj)
#pragma unroll
            for (int n = 0; n < 2; ++n) g[bj][n] = *(const f32x4*)(gp + bj * HALF + 4 * n) + 1.0f;
#pragma unroll
        for (int ai = 0; ai < 2; ++ai)
#pragma unroll
            for (int m = 0; m < 4; ++m) { const size_t off = (size_t)(row0 + ai * HALF + m * 16) * 1024 + col0;
#pragma unroll
                for (int bj = 0; bj < 2; ++bj)
#pragma unroll
                    for (int n = 0; n < 2; ++n) { const f32x4 xv = *(const f32x4*)(xin + off + bj * HALF + 4 * n);
                        *(f32x4*)(out + off + bj * HALF + 4 * n) = xv + g[bj][n] * acc[ai][bj][m][n]; } }
    }
};
struct EpiSwiglu {
    static constexpr bool PERM = true, AFTER_DRAIN = false;
    bf16_t* H;
    __device__ __forceinline__ void operator()(const f32x4 (&acc)[2][2][4][2], const Unit& u, int wr, int wc, int fr, int fq) const {
        const int row0 = u.pm * BM + wr * 64 + fr, hid0 = 128 * (u.pn & 3) + 16 * wc + 4 * fq;
#pragma unroll
        for (int ai = 0; ai < 2; ++ai)
#pragma unroll
            for (int m = 0; m < 4; ++m) { bf16_t* rowp = H + (size_t)(row0 + ai * HALF + m * 16) * 512 + hid0;
#pragma unroll
                for (int bj = 0; bj < 2; ++bj) { const f32x4 g = acc[ai][bj][m][0], uu = acc[ai][bj][m][1]; float h[4];
#pragma unroll
                    for (int i = 0; i < 4; ++i) h[i] = g[i] / (1.f + __expf(-g[i])) * uu[i];
                    unsigned w0 = cvt_pk_bf16(h[0], h[1]), w1 = cvt_pk_bf16(h[2], h[3]);
                    *(unsigned long long*)(rowp + 64 * bj) = (unsigned long long)w0 | ((unsigned long long)w1 << 32); } }
    }
};
struct EpiMoeOut {
    static constexpr bool PERM = true, AFTER_DRAIN = false;
    bf16_t* Y; const int* rowmap;
    __device__ __forceinline__ void operator()(const f32x4 (&acc)[2][2][4][2], const Unit& u, int wr, int wc, int fr, int fq) const {
        const int row0 = u.pm * BM + wr * 64 + fr, col0 = (u.pn & 3) * BM + wc * 32 + 8 * fq;
#pragma unroll
        for (int ai = 0; ai < 2; ++ai)
#pragma unroll
            for (int m = 0; m < 4; ++m) { const int dst = rowmap[row0 + ai * HALF + m * 16];
                if (dst >= 0) { bf16_t* rowp = Y + (size_t)dst * 1024 + col0;
#pragma unroll
                    for (int bj = 0; bj < 2; ++bj) { const f32x4 v0 = acc[ai][bj][m][0], v1 = acc[ai][bj][m][1];
                        u32x4 w; w.x = cvt_pk_bf16(v0[0], v0[1]); w.y = cvt_pk_bf16(v0[2], v0[3]); w.z = cvt_pk_bf16(v1[0], v1[1]); w.w = cvt_pk_bf16(v1[2], v1[3]);
                        *(u32x4*)(rowp + bj * HALF) = w; } } }
    }
};
struct MoeOrder {
    PG8_LAS const int* ptab; int G, c;
    __device__ __forceinline__ bool next(int i, Unit& u) const {
        const int L = i * G + c, np = __builtin_amdgcn_readfirstlane(ptab[0]);
        if (L >= np * 4) return false;
        const int p = L >> 2; u.pm = p; u.pn = __builtin_amdgcn_readfirstlane(ptab[1 + p]) * 4 + (L & 3); return true;
    }
    __device__ __forceinline__ void a_ready(const Unit&) const {}
    __device__ __forceinline__ void done(const Unit&) const {}
};
template <class Epi, class Sched, bool ALIGN_EPI = false, bool SP2 = false, bool GATHER = false>
__device__ __forceinline__ void gemm_phase(PG8_LAS unsigned char* lds, const Gemm g, const Sched& S, const Epi& E) {
    const int tid = threadIdx.x, wid = __builtin_amdgcn_readfirstlane(tid >> 6), lane = tid & 63, wr = wid >> 2, wc = wid & 3, fr = lane & 15, fq = lane >> 4;
    const int K = g.K, nt = K / BK;
    static_assert(!GATHER || SP2, "the gathered-A variant exists for the SP2 loop only");
    unsigned voffA[2], voffB[2];
    unsigned vAc[2] = {0u, 0u}, vAn[2] = {0u, 0u};
#pragma unroll
    for (int i = 0; i < 2; ++i) { int R, C; stage_rc(tid * 16 + i * 8192, R, C); const int Rb = Epi::PERM ? ((R & ~31) + perm32(R & 31)) : R;
        voffA[i] = (unsigned)(R * K + C) * 2u; voffB[i] = (unsigned)(Rb * K + C) * 2u; }
    const size_t kstep = (size_t)(BK * 2);
    const size_t hstep = (size_t)HALF * K * 2;
    const size_t tstep = 2 * hstep;
    const unsigned ldsw = (unsigned)wid * 1024u;
    const int aoff = lds_byte(wr * 64 + fr, fq * 8), boff = lds_byte(wc * 32 + fr, fq * 8);
#define PG8_SA(b, h) (((b) * 2 + (h)) * HTB)
#define PG8_SB(b, h) ((4 + (b) * 2 + (h)) * HTB)
#define PG8_STAGE(bufoff, gbase, voff) do { _Pragma("unroll") for (int _i = 0; _i < 2; ++_i) \
        __builtin_amdgcn_global_load_lds((const unsigned*)((const char*)(gbase) + (voff)[_i]), (PG8_LAS unsigned*)(lds + (bufoff) + ldsw + _i * 8192), 16, 0, 0); } while (0)
#define PG8_STAGEG(bufoff, base, pk) do { unsigned vg_[2]; _Pragma("unroll") for (int i_ = 0; i_ < 2; ++i_) { int R_, C_; stage_rc(tid * 16 + i_ * 8192, R_, C_); vg_[i_] = (((pk) >> (16 * i_)) & 0xffffu) * (unsigned)(2 * K) + (unsigned)(2 * C_); } PG8_STAGE(bufoff, base, vg_); } while (0)
#define PG8_STAGEA(bufoff, base, hh, nx) do { if constexpr (GATHER) { const unsigned pk_ = (nx) ? vAn[hh] : vAc[hh]; PG8_STAGEG(bufoff, base, pk_); } else PG8_STAGE(bufoff, (base) + (hh) * hstep, voffA); } while (0)
#define PG8_GOFF(dst, unit) do { _Pragma("unroll") for (int hh_ = 0; hh_ < 2; ++hh_) { unsigned pk_ = 0u; _Pragma("unroll") for (int i_ = 0; i_ < 2; ++i_) { int R_, C_; stage_rc(tid * 16 + i_ * 8192, R_, C_); \
        const int t2_ = g.rowmap[(unit).pm * BM + hh_ * HALF + R_]; pk_ |= (unsigned)(t2_ < 0 ? 0 : (t2_ >> 1)) << (16 * i_); } dst[hh_] = pk_; } } while (0)
#define PG8_LDA(dst, b, h) do { _Pragma("unroll") for (int m = 0; m < 4; ++m) _Pragma("unroll") for (int k = 0; k < 2; ++k) dst[m][k] = *(const PG8_LAS bf16x8*)(lds + PG8_SA(b, h) + aoff + m * 2048 + k * 1024); } while (0)
#define PG8_LDB(dst, b, h) do { _Pragma("unroll") for (int n = 0; n < 2; ++n) _Pragma("unroll") for (int k = 0; k < 2; ++k) dst[n][k] = *(const PG8_LAS bf16x8*)(lds + PG8_SB(b, h) + boff + n * 2048 + k * 1024); } while (0)
#define PG8_MMA(ai, bj, At, Bt) do { __builtin_amdgcn_s_setprio(1); _Pragma("unroll") for (int m = 0; m < 4; ++m) _Pragma("unroll") for (int n = 0; n < 2; ++n) _Pragma("unroll") for (int k = 0; k < 2; ++k) \
        acc[ai][bj][m][n] = __builtin_amdgcn_mfma_f32_16x16x32_bf16(Bt[n][k], At[m][k], acc[ai][bj][m][n], 0, 0, 0); __builtin_amdgcn_s_setprio(0); } while (0)
#define PG8_WAIT_V(n) asm volatile("s_waitcnt vmcnt(" #n ")" ::: "memory")
#define PG8_WAIT_L(n) asm volatile("s_waitcnt lgkmcnt(" #n ")" ::: "memory")
#define PG8_BAR __builtin_amdgcn_s_barrier()
#define PG8_SCHED __builtin_amdgcn_sched_barrier(0)
    Unit cur, nxt; int ui = 0;
    if (!S.next(0, cur)) return;
    f32x4 acc[2][2][4][2];
#pragma unroll
    for (int a = 0; a < 2; ++a)
#pragma unroll
        for (int b = 0; b < 2; ++b)
#pragma unroll
            for (int m = 0; m < 4; ++m)
#pragma unroll
                for (int n = 0; n < 2; ++n) acc[a][b][m][n] = (f32x4){0.f, 0.f, 0.f, 0.f};
    bf16x8 At[4][2], B0[2][2], B1[2][2];
    const char* cA = (const char*)g.A + (GATHER ? (size_t)0 : (size_t)cur.pm * tstep); const char* cB = (const char*)g.Bt + (size_t)cur.pn * tstep;
    if constexpr (GATHER) { PG8_GOFF(vAc, cur); }
    S.a_ready(cur);
    if constexpr (SP2) {
        PG8_STAGE(PG8_SB(0, 0), cB, voffB); PG8_STAGE(PG8_SB(0, 1), cB + hstep, voffB); PG8_STAGEA(PG8_SA(0, 0), cA, 0, false); PG8_STAGEA(PG8_SA(0, 1), cA, 1, false);
        if (wr == 1) PG8_BAR;
        PG8_WAIT_V(2); PG8_BAR;
        PG8_STAGE(PG8_SB(1, 0), cB + kstep, voffB); PG8_STAGEA(PG8_SA(1, 0), cA + kstep, 0, false); PG8_STAGE(PG8_SB(1, 1), cB + hstep + kstep, voffB);
        PG8_WAIT_V(6); PG8_BAR;
    } else {
        PG8_STAGE(PG8_SB(0, 0), cB, voffB); PG8_STAGE(PG8_SA(0, 0), cA, voffA); PG8_STAGE(PG8_SB(0, 1), cB + hstep, voffB); PG8_STAGE(PG8_SA(0, 1), cA + hstep, voffA);
        if (wr == 1) PG8_BAR;
        PG8_WAIT_V(4); PG8_BAR;
        PG8_STAGE(PG8_SB(1, 0), cB + kstep, voffB); PG8_STAGE(PG8_SA(1, 0), cA + kstep, voffA); PG8_STAGE(PG8_SB(1, 1), cB + hstep + kstep, voffB);
        PG8_WAIT_V(6); PG8_BAR;
    }
    for (;;) {
        const bool has_next = S.next(ui + 1, nxt);
        const char* nA = (has_next && !GATHER) ? (const char*)g.A + (size_t)nxt.pm * tstep : cA;
        if constexpr (GATHER) { if (has_next) { PG8_GOFF(vAn, nxt); } else { vAn[0] = vAc[0]; vAn[1] = vAc[1]; } } const char* nB = has_next ? (const char*)g.Bt + (size_t)nxt.pn * tstep : cB;
        for (int t = 0; t < nt; t += 2) {
            const bool last = (t == nt - 2);
            const char* a1 = cA + (size_t)(t + 1) * kstep;
            const char* a2 = last ? nA : cA + (size_t)(t + 2) * kstep; const char* b2 = last ? nB : cB + (size_t)(t + 2) * kstep;
            const char* a3 = a2 + kstep; const char* b3 = b2 + kstep;
            if (last && has_next) S.a_ready(nxt);
            if constexpr (SP2) {
            PG8_LDB(B0, 0, 0); PG8_LDB(B1, 0, 1); PG8_SCHED; PG8_LDA(At, 0, 0); PG8_STAGEA(PG8_SA(1, 1), a1, 1, false);
            PG8_WAIT_V(8); PG8_WAIT_L(0); PG8_BAR; PG8_MMA(0, 0, At, B0); PG8_MMA(0, 1, At, B1); PG8_BAR; PG8_SCHED;
            PG8_LDA(At, 0, 1); PG8_STAGE(PG8_SB(0, 0), b2, voffB); PG8_STAGE(PG8_SB(0, 1), b2 + hstep, voffB); PG8_STAGEA(PG8_SA(0, 0), a2, 0, last);
            PG8_WAIT_V(8); PG8_WAIT_L(0); PG8_BAR; PG8_MMA(1, 0, At, B0); PG8_MMA(1, 1, At, B1); PG8_BAR; PG8_SCHED;
            PG8_LDB(B0, 1, 0); PG8_LDB(B1, 1, 1); PG8_SCHED; PG8_LDA(At, 1, 0); PG8_STAGEA(PG8_SA(0, 1), a2, 1, last);
            PG8_WAIT_V(8); PG8_WAIT_L(0); PG8_BAR; PG8_MMA(0, 0, At, B0); PG8_MMA(0, 1, At, B1); PG8_BAR; PG8_SCHED;
            PG8_LDA(At, 1, 1); PG8_STAGE(PG8_SB(1, 0), b3, voffB); PG8_STAGE(PG8_SB(1, 1), b3 + hstep, voffB); PG8_STAGEA(PG8_SA(1, 0), a3, 0, last);
            PG8_WAIT_V(8); PG8_WAIT_L(0); PG8_BAR; PG8_MMA(1, 0, At, B0); PG8_MMA(1, 1, At, B1); PG8_BAR; PG8_SCHED;
            } else {
            PG8_LDB(B0, 0, 0); PG8_SCHED; PG8_LDA(At, 0, 0); PG8_STAGE(PG8_SA(1, 1), a1 + hstep, voffA);
            PG8_WAIT_L(8); PG8_BAR; PG8_WAIT_L(0); PG8_MMA(0, 0, At, B0); PG8_BAR; PG8_SCHED;
            PG8_LDB(B1, 0, 1); PG8_STAGE(PG8_SB(0, 0), b2, voffB);
            PG8_BAR; PG8_WAIT_L(0); PG8_MMA(0, 1, At, B1); PG8_BAR;
            PG8_LDA(At, 0, 1); PG8_STAGE(PG8_SA(0, 0), a2, voffA);
            PG8_BAR; PG8_WAIT_L(0); PG8_MMA(1, 0, At, B0); PG8_BAR; PG8_SCHED;
            PG8_STAGE(PG8_SB(0, 1), b2 + hstep, voffB);
            PG8_WAIT_V(6); PG8_BAR; PG8_MMA(1, 1, At, B1); PG8_BAR;
            PG8_LDB(B0, 1, 0); PG8_SCHED; PG8_LDA(At, 1, 0); PG8_STAGE(PG8_SA(0, 1), a2 + hstep, voffA);
            PG8_WAIT_L(8); PG8_BAR; PG8_WAIT_L(0); PG8_MMA(0, 0, At, B0); PG8_BAR; PG8_SCHED;
            PG8_LDB(B1, 1, 1); PG8_STAGE(PG8_SB(1, 0), b3, voffB);
            PG8_BAR; PG8_WAIT_L(0); PG8_MMA(0, 1, At, B1); PG8_BAR;
            PG8_LDA(At, 1, 1); PG8_STAGE(PG8_SA(1, 0), a3, voffA);
            PG8_BAR; PG8_WAIT_L(0); PG8_MMA(1, 0, At, B0); PG8_BAR; PG8_SCHED;
            PG8_STAGE(PG8_SB(1, 1), b3 + hstep, voffB);
            PG8_WAIT_V(6); PG8_BAR; PG8_MMA(1, 1, At, B1); PG8_BAR;
            }
        }
        if constexpr (ALIGN_EPI) { if (wr == 0) PG8_BAR; }
        if constexpr (!Epi::AFTER_DRAIN) { E(acc, cur, wr, wc, fr, fq); S.done(cur); }
        if (!has_next) break;
#pragma unroll
        for (int a = 0; a < 2; ++a)
#pragma unroll
            for (int b = 0; b < 2; ++b)
#pragma unroll
                for (int m = 0; m < 4; ++m)
#pragma unroll
                    for (int n = 0; n < 2; ++n) acc[a][b][m][n] = (f32x4){0.f, 0.f, 0.f, 0.f};
        cur = nxt; cA = nA; cB = nB; ++ui;
        if constexpr (GATHER) { vAc[0] = vAn[0]; vAc[1] = vAn[1]; }
        if constexpr (ALIGN_EPI) { if (wr == 1) PG8_BAR; }
    }
    PG8_WAIT_V(0);
    if constexpr (!ALIGN_EPI) { if (wr == 0) PG8_BAR; }
    PG8_BAR;
    if constexpr (Epi::AFTER_DRAIN) { E.fused(acc, cur, wr, wc, fr, fq, lds, wid, lane); S.done(cur); }
#undef PG8_SA
#undef PG8_SB
#undef PG8_STAGE
#undef PG8_STAGEA
#undef PG8_STAGEG
#undef PG8_GOFF
#undef PG8_LDA
#undef PG8_LDB
#undef PG8_MMA
#undef PG8_WAIT_V
#undef PG8_WAIT_L
#undef PG8_BAR
#undef PG8_SCHED
}
}
#define XB_TMO      128
#define XB_XCNT(j)  (256  + 64 * (j))
#define XB_XSUB(j)  (1280 + 64 * (j))
#define XB_XGEN(j)  (2304 + 64 * (j))
#define XB_TOP      3328
#define XB_TOPGEN   3392
#define XCD_BAR_WORDS 3456
#define XB_SPIN_CAP (1u << 18)
#define LAS __attribute__((address_space(3)))

__device__ __forceinline__ unsigned xb_ld(unsigned* p)              { return __hip_atomic_load(p, __ATOMIC_RELAXED, __HIP_MEMORY_SCOPE_AGENT); }
__device__ __forceinline__ unsigned xb_add(unsigned* p, unsigned v) { return __hip_atomic_fetch_add(p, v, __ATOMIC_RELAXED, __HIP_MEMORY_SCOPE_AGENT); }
__device__ __forceinline__ unsigned xb_xcc_id() { return (unsigned)__builtin_amdgcn_s_getreg((3 << 11) | 20) & 0xFu; }
#define XB_SPIN(cond, bar) do { unsigned _sp = 0; while (cond) { __builtin_amdgcn_s_sleep(1); \
    if ((++_sp & 255u) == 0u) { if (xb_ld(&(bar)[XB_TMO])) break; if (_sp > XB_SPIN_CAP) { atomicAdd(&(bar)[XB_TMO], 1u); break; } } } } while (0)

struct XcdBarrier {
    unsigned* bar; unsigned x;
    volatile LAS unsigned* st;
};

__device__ __forceinline__ XcdBarrier xcd_barrier_post(unsigned* bar, volatile LAS unsigned* st) {
    XcdBarrier b; b.bar = bar; b.x = xb_xcc_id(); b.st = st;
    if (threadIdx.x == 0) (void)xb_add(&bar[XB_XCNT(b.x)], 1u);
    return b;
}
__device__ __forceinline__ void xcd_barrier_complete(unsigned* bar, unsigned x, unsigned& nloc, unsigned& nx) {
    const unsigned G = gridDim.x * gridDim.y * gridDim.z;
    unsigned sum, cnt, mine, sp = 0u;
    for (;;) {
        sum = 0u; cnt = 0u; mine = 0u;
#pragma unroll
        for (unsigned j = 0; j < 16; ++j) { const unsigned c = xb_ld(&bar[XB_XCNT(j)]); sum += c; cnt += (c > 0u) ? 1u : 0u; mine = (j == x) ? c : mine; }
        if (sum == G) break;
        __builtin_amdgcn_s_sleep(1);
        if ((++sp & 255u) == 0u) { if (xb_ld(&bar[XB_TMO])) break; if (sp > XB_SPIN_CAP) { atomicAdd(&bar[XB_TMO], 1u); break; } }
    }
    nloc = mine > 0u ? mine : 1u; nx = cnt > 0u ? cnt : 1u;
}

__device__ __forceinline__ void xcd_barrier(const XcdBarrier& b) {
    asm volatile("s_waitcnt vmcnt(0)" ::: "memory");
    __syncthreads();
    if (threadIdx.x == 0) {
        unsigned* bar = b.bar;
        __builtin_amdgcn_s_waitcnt(0);
        unsigned nloc = b.st[0], nx = b.st[1];
        if (nloc == 0u) { xcd_barrier_complete(bar, b.x, nloc, nx); b.st[0] = nloc; b.st[1] = nx; }
        const unsigned old = xb_add(&bar[XB_XSUB(b.x)], 1u);
        const unsigned gen = old / nloc;
        if (old + 1u == (gen + 1u) * nloc) {
            __builtin_amdgcn_fence(__ATOMIC_RELEASE, "agent");
            asm volatile("s_waitcnt vmcnt(0)" ::: "memory");
            const unsigned og = xb_add(&bar[XB_TOP], 1u);
            const unsigned tg = og / nx;
            if (og + 1u == (tg + 1u) * nx) xb_add(&bar[XB_TOPGEN], 1u);
            else XB_SPIN(xb_ld(&bar[XB_TOPGEN]) == tg, bar);
            __builtin_amdgcn_fence(__ATOMIC_ACQUIRE, "agent");
            xb_add(&bar[XB_XGEN(b.x)], 1u);
            asm volatile("s_waitcnt vmcnt(0)" ::: "memory");
        } else {
            XB_SPIN(xb_ld(&bar[XB_XGEN(b.x)]) == gen, bar);
            __builtin_amdgcn_fence(__ATOMIC_ACQUIRE, "agent");
            asm volatile("s_waitcnt vmcnt(0)" ::: "memory");
        }
    }
    __syncthreads();
}

struct Args { const float* in[47]; float* out; unsigned char* ws; int ph_lo, ph_hi; };
typedef const __attribute__((address_space(4))) Args* KArgsP;
__device__ __forceinline__ KArgsP fresh_args() { KArgsP p = (KArgsP)__builtin_amdgcn_kernarg_segment_ptr(); asm volatile("" : "+s"(p)); return p; }
enum { I_X = 0, I_C, I_ADA_W, I_ADA_B, I_NORM_MIX, I_NORM_FFN, I_NORM_FINAL, I_W_IN, I_W_OUT, I_CONV_W, I_CONV_B, I_WQ, I_WK, I_BI, I_BF, I_MNORM_W,
       I_RMU, I_RW0, I_RWUP, I_RA0, I_RAUP, I_RGUP, I_RKK, I_RKA, I_RRK, I_RLNW, I_RLNB, I_RV0, I_RVDN, I_RVUP,
       I_S5ARE, I_S5AIM, I_S5LDT, I_S5BRE, I_S5BIM, I_S5CRE, I_S5CIM, I_S5D, I_S5GLUW, I_S5GLUB,
       I_MWRG, I_MBRG, I_MWRE, I_MBRE, I_MW1, I_MW3, I_MW2 };

struct RmWin { __device__ __forceinline__ int operator()(int n) const { return n < 1152 ? n : (n < 1164 ? 2816 + (n - 1152) : (n < 2572 ? 1152 + (n - 1164) : 2560 + (n - 2572))); } };
struct RmId  { __device__ __forceinline__ int operator()(int n) const { return n; } };
struct RmGU  { int add; __device__ __forceinline__ int operator()(int n) const { return 8 * (n >> 2) + (n & 3) + add; } };
template <class RM>
__device__ __forceinline__ void transpose_item(const float* W, int ldw, int ncols, int k0, int n0, bf16* WT, int ldt, LAS float* scr, int lane, const RM rm) {
    const int nn = n0 + lane; const bool ok = nn < ncols; const float* src = W + (size_t)k0 * ldw + (ok ? nn : n0);
    float v[64];
#pragma unroll
    for (int kk = 0; kk < 64; ++kk) v[kk] = src[(size_t)kk * ldw];
#pragma unroll
    for (int kk = 0; kk < 64; ++kk) scr[kk * 65 + lane] = v[kk];
    LDS_WAIT(); asm volatile("" ::: "memory");
    const int c = lane & 7;
#pragma unroll
    for (int j = 0; j < 8; ++j) { const int nl = (lane >> 3) + 8 * j; const LAS float* s = scr + (8 * c) * 65 + nl;
        v4u o; o.x = pk2(s[0 * 65], s[1 * 65]); o.y = pk2(s[2 * 65], s[3 * 65]); o.z = pk2(s[4 * 65], s[5 * 65]); o.w = pk2(s[6 * 65], s[7 * 65]);
        if (n0 + nl < ncols) *(GAS v4u*)(WT + (size_t)rm(n0 + nl) * ldt + k0 + 8 * c) = o; }
    LDS_WAIT(); asm volatile("" ::: "memory");
}
__device__ __forceinline__ void moe_convert(const float* w1, const float* w3, const float* w2, int l, bf16* W13, bf16* W2T, int worker, int nworkers, LAS float* scr, int lane) {
    for (int it = worker; it < NEXP * 384; it += nworkers) {
        const int e = it / 384, r = it % 384; const size_t eo = (size_t)(l * NEXP + e) * DM * DEXP;
        if (r < 128)      transpose_item(w1 + eo, DEXP, DEXP, 64 * (r >> 3), 64 * (r & 7), W13 + (size_t)e * 1024 * 1024, 1024, scr, lane, RmGU{0});
        else if (r < 256) transpose_item(w3 + eo, DEXP, DEXP, 64 * ((r - 128) >> 3), 64 * ((r - 128) & 7), W13 + (size_t)e * 1024 * 1024, 1024, scr, lane, RmGU{4});
        else              transpose_item(w2 + eo, DM, DM, 64 * ((r - 256) >> 4), 64 * ((r - 256) & 15), W2T + (size_t)e * 1024 * 512, 512, scr, lane, RmId{});
    }
}
__device__ __forceinline__ void phase_prologue(KArgsP a, LAS unsigned char* lds, int tid, int lane, int wave, int vcu, int G) {
    unsigned char* ws = a->ws;
    LAS float* scr = (LAS float*)(lds + wave * 16640);
    const int gw = vcu * NWAVES + wave, NGW = G * NWAVES;
    bf16* WIN = (bf16*)(ws + WS_WIN); bf16* WOUT = (bf16*)(ws + WS_WOUT);
    for (int it = gw; it < 2 * 16 * 45; it += NGW) { const int l = it / (16 * 45), r = it % (16 * 45);
        transpose_item(a->in[I_W_IN] + (size_t)l * DM * IN_COLS, IN_COLS, IN_COLS, 64 * (r / 45), 64 * (r % 45), WIN + (size_t)l * NPROJ_PAD * DM, DM, scr, lane, RmWin{}); }
    for (int it = gw; it < 2 * 16 * 16; it += NGW) { const int l = it / 256, r = it % 256;
        transpose_item(a->in[I_W_OUT] + (size_t)l * DM * DM, DM, DM, 64 * (r >> 4), 64 * (r & 15), WOUT + (size_t)l * DM * DM, DM, scr, lane, RmId{}); }
    for (int it = gw; it < 2 * 244; it += NGW) { const int l = it / 244, r = 2828 + it % 244; GAS v4u* p = (GAS v4u*)(WIN + ((size_t)l * NPROJ_PAD + r) * DM);
        p[lane] = (v4u){0u, 0u, 0u, 0u}; p[lane + 64] = (v4u){0u, 0u, 0u, 0u}; }
    { float* RTW = (float*)(ws + WS_RTW);
      for (int idx = (vcu * NTHR + tid); idx < 2 * 1024 * 48; idx += G * NTHR) { const int j = idx % 48, k = (idx / 48) % 1024, l = idx / (48 * 1024);
          RTW[idx] = j < 4 ? a->in[I_MWRG][(size_t)(l * 1024 + k) * 4 + j] : (j < 36 ? a->in[I_MWRE][(size_t)(l * 1024 + k) * 32 + (j - 4)] : 0.f); } }
    { bf16* RW = (bf16*)(ws + WS_R1W);
      for (int idx = (vcu * NTHR + tid); idx < 2 * 98304 + 24576; idx += G * NTHR) { float v;
          if (idx < 2 * 98304) { const int l = idx / 98304, r = idx % 98304;
              if (r < 24576)      v = a->in[I_RWUP][(size_t)l * 64 * DBR + (r & 63) * DBR + (r >> 6)];
              else if (r < 49152) v = a->in[I_RAUP][(size_t)l * 64 * DBR + ((r - 24576) & 63) * DBR + ((r - 24576) >> 6)];
              else                v = a->in[I_RGUP][(size_t)l * 128 * DBR + ((r - 49152) & 127) * DBR + ((r - 49152) >> 7)];
          } else { const int r = idx - 2 * 98304;
              if (r < 12288) v = a->in[I_RVDN][(size_t)(r % 384) * 32 + (r / 384)];
              else           v = a->in[I_RVUP][(size_t)((r - 12288) & 31) * DBR + ((r - 12288) >> 5)]; }
          RW[idx] = (bf16)f2bf(v); } }
    for (int idx = (vcu * NTHR + tid); idx < 2 * 16 * 64; idx += G * NTHR) { const int p = idx & 63, lg = idx >> 6;
        const float lam_re = a->in[I_S5ARE][idx], lam_im = a->in[I_S5AIM][idx]; const float dt = expf(a->in[I_S5LDT][lg]); const float mag = expf(lam_re * dt), ang = lam_im * dt;
        const float are = mag * cosf(ang), aim = mag * sinf(ang); const float inv = 1.f / (lam_re * lam_re + lam_im * lam_im);
        const float cre = ((are - 1.f) * lam_re + aim * lam_im) * inv, cim = (aim * lam_re - (are - 1.f) * lam_im) * inv;
        ((float*)(ws + WS_S5AP))[idx * 2] = are; ((float*)(ws + WS_S5AP))[idx * 2 + 1] = aim;
        const float* br = a->in[I_S5BRE] + (size_t)idx * 16; const float* bi = a->in[I_S5BIM] + (size_t)idx * 16; bf16* o = (bf16*)(ws + WS_S5BB) + ((size_t)lg * 128 + 2 * p) * 16;
        for (int c = 0; c < 16; ++c) { o[c] = (bf16)f2bf(cre * br[c] - cim * bi[c]); o[16 + c] = (bf16)f2bf(cre * bi[c] + cim * br[c]); } }
    { bf16* CM = (bf16*)(ws + WS_S5CM);
      for (int idx = (vcu * NTHR + tid); idx < 2 * 16 * 16 * 128; idx += G * NTHR) { const int k = idx & 127, lgc = idx >> 7;
          CM[idx] = (bf16)f2bf((k & 1) ? -a->in[I_S5CIM][(size_t)lgc * 64 + (k >> 1)] : a->in[I_S5CRE][(size_t)lgc * 64 + (k >> 1)]); } }
    for (int it = gw; it < 2 * 16; it += NGW) { const int l = it >> 4, r = it & 15;
        transpose_item(a->in[I_S5GLUW] + (size_t)l * DC * DC, DC, DC, 64 * (r >> 2), 64 * (r & 3), (bf16*)(ws + WS_GLUT) + (size_t)l * DC * DC, DC, scr, lane, RmId{}); }
    { bf16* MLW = (bf16*)(ws + WS_MLW);
      for (int idx = (vcu * NTHR + tid); idx < 2 * NH * 2 * 4096; idx += G * NTHR) { const int d = idx & 63, e = (idx >> 6) & 63, which = (idx >> 12) & 1, lh = idx >> 13;
          MLW[idx] = (bf16)f2bf(a->in[which ? I_WK : I_WQ][(size_t)lh * 4096 + d * 64 + e]); } }
    __syncthreads();
    if (vcu < 192) {
        const int q = vcu, l = q / 96, cb = (q >> 3) % 12, kc = q & 7;
        LAS float* cond = (LAS float*)lds;
        { const int b = tid >> 7, kk = tid & 127; const float cv = a->in[I_C][b * DM + kc * 128 + kk]; cond[tid] = cv / (1.f + __expf(-cv)); }
        __syncthreads();
        const int col = cb * 512 + tid; const float* wp = a->in[I_ADA_W] + ((size_t)l * DM + kc * 128) * 6144 + col;
        float acc0 = 0.f, acc1 = 0.f, acc2 = 0.f, acc3 = 0.f;
#pragma unroll 8
        for (int kk = 0; kk < 128; ++kk) { const float w = wp[(size_t)kk * 6144]; acc0 += cond[kk] * w; acc1 += cond[128 + kk] * w; acc2 += cond[256 + kk] * w; acc3 += cond[384 + kk] * w; }
        const float bias = (kc == 0) ? a->in[I_ADA_B][l * 6144 + col] : 0.f;
        float* MP = (float*)(ws + WS_MODP) + ((size_t)(kc * 2 + l) * 4) * 6144 + col;
        MP[0] = acc0 + bias; MP[6144] = acc1 + bias; MP[2 * 6144] = acc2 + bias; MP[3 * 6144] = acc3 + bias;
    }
}

__device__ __forceinline__ float modval(const unsigned char* ws, bool part, int l, int b, int idx) {
    if (!part) return ((const float*)(ws + WS_MODF))[(size_t)(l * 4 + b) * 6144 + idx];
    const float* mp = (const float*)(ws + WS_MODP) + (size_t)(l * 4 + b) * 6144 + idx; float s = 0.f;
#pragma unroll
    for (int kc = 0; kc < 8; ++kc) s += mp[(size_t)kc * 2 * 4 * 6144];
    return s;
}
template <int MODE, bool COMBINE>
__device__ __forceinline__ void phase_rownorm(KArgsP a, LAS unsigned char* lds, int tid, int lane, int wave, int G,
                                              const float* xsrc, float* xdst, const float* gvec, bool part, int l, int isc  , int lprev) {
    unsigned char* ws = a->ws;
    LAS float* sc = (LAS float*)lds; LAS float* sh = sc + 1024; LAS float* gt = sh + 1024;
    bf16* HN = (bf16*)(ws + WS_HN); const bf16* YM = (const bf16*)(ws + WS_YMOE); const float* TW = (const float*)(ws + WS_TOKW);
    for (int c = blockIdx.x; c < NTOK / 128; c += G) {
        const int b = c >> 6;
        __syncthreads();
        for (int j = tid; j < 1024; j += NTHR) {
            if (MODE == 0) { sc[j] = gvec[j] * (1.f + modval(ws, part, l, b, (isc + 1) * 1024 + j)); sh[j] = modval(ws, part, l, b, isc * 1024 + j); }
            else { sc[j] = gvec[j]; sh[j] = 0.f; }
            if (COMBINE) gt[j] = 1.f + modval(ws, false, lprev, b, 5 * 1024 + j);
        }
        __syncthreads();
        f32x4 vn[4]; v2u yn0[4], yn1[4]; float wn0 = 0.f, wn1 = 0.f;
        { const int row = c * 128 + wave * 16; const GAS f32x4* xr = (const GAS f32x4*)(xsrc + (size_t)row * DM) + lane;
#pragma unroll
          for (int j = 0; j < 4; ++j) vn[j] = xr[64 * j];
          if (COMBINE) { wn0 = TW[2 * row]; wn1 = TW[2 * row + 1]; const GAS v2u* y0 = (const GAS v2u*)(YM + (size_t)(2 * row) * DM) + lane; const GAS v2u* y1 = (const GAS v2u*)(YM + (size_t)(2 * row + 1) * DM) + lane;
#pragma unroll
              for (int j = 0; j < 4; ++j) { yn0[j] = y0[64 * j]; yn1[j] = y1[64 * j]; } } }
        for (int i = 0; i < 16; ++i) {
            const int row = c * 128 + wave * 16 + i;
            f32x4 v[4]; v2u q0[4], q1[4]; const float w0 = wn0, w1 = wn1;
#pragma unroll
            for (int j = 0; j < 4; ++j) { v[j] = vn[j]; q0[j] = yn0[j]; q1[j] = yn1[j]; }
            if (i + 1 < 16) { const int rn = row + 1; const GAS f32x4* xr = (const GAS f32x4*)(xsrc + (size_t)rn * DM) + lane;
#pragma unroll
                for (int j = 0; j < 4; ++j) vn[j] = xr[64 * j];
                if (COMBINE) { wn0 = TW[2 * rn]; wn1 = TW[2 * rn + 1]; const GAS v2u* y0 = (const GAS v2u*)(YM + (size_t)(2 * rn) * DM) + lane; const GAS v2u* y1 = (const GAS v2u*)(YM + (size_t)(2 * rn + 1) * DM) + lane;
#pragma unroll
                    for (int j = 0; j < 4; ++j) { yn0[j] = y0[64 * j]; yn1[j] = y1[64 * j]; } } }
            if (COMBINE) {
#pragma unroll
                for (int j = 0; j < 4; ++j) { const v2u p0 = q0[j], p1 = q1[j]; const f32x4 g4 = *(const LAS f32x4*)(gt + lane * 4 + 256 * j);
                    f32x4 m; m.x = w0 * bflo(p0.x) + w1 * bflo(p1.x); m.y = w0 * bfhi(p0.x) + w1 * bfhi(p1.x); m.z = w0 * bflo(p0.y) + w1 * bflo(p1.y); m.w = w0 * bfhi(p0.y) + w1 * bfhi(p1.y);
                    v[j] = v[j] + g4 * m; }
                if (MODE == 0) { GAS f32x4* xo = (GAS f32x4*)(xdst + (size_t)row * DM) + lane;
#pragma unroll
                    for (int j = 0; j < 4; ++j) xo[64 * j] = v[j]; }
            }
            float ss = 0.f;
#pragma unroll
            for (int j = 0; j < 4; ++j) ss += (v[j].x * v[j].x + v[j].y * v[j].y) + (v[j].z * v[j].z + v[j].w * v[j].w);
            const float rstd = rsqrtf(wave_sum(ss) * (1.f / DM) + NORM_EPS);
            if (MODE == 0) {
                GAS v2u* o = (GAS v2u*)(HN + (size_t)row * DM) + lane;
#pragma unroll
                for (int j = 0; j < 4; ++j) { const f32x4 s4 = *(const LAS f32x4*)(sc + lane * 4 + 256 * j), h4 = *(const LAS f32x4*)(sh + lane * 4 + 256 * j); const f32x4 h = v[j] * rstd * s4 + h4;
                    v2u w; w.x = pk2(h.x, h.y); w.y = pk2(h.z, h.w); o[64 * j] = w; }
            } else {
                GAS f32x4* o = (GAS f32x4*)(xdst + (size_t)row * DM) + lane;
#pragma unroll
                for (int j = 0; j < 4; ++j) { const f32x4 s4 = *(const LAS f32x4*)(sc + lane * 4 + 256 * j); o[64 * j] = v[j] * rstd * s4; }
            }
        }
    }
}
__device__ __forceinline__ void mod_finalize(unsigned char* ws, int tid, int G) {
    float* MF = (float*)(ws + WS_MODF);
    for (int idx = blockIdx.x * NTHR + tid; idx < 2 * 4 * 6144; idx += G * NTHR) { const float* mp = (const float*)(ws + WS_MODP) + idx; float s = 0.f;
#pragma unroll
        for (int kc = 0; kc < 8; ++kc) s += mp[(size_t)kc * 2 * 4 * 6144];
        MF[idx] = s; }
}

typedef float f32x4m __attribute__((ext_vector_type(4)));
__device__ __forceinline__ void phase_router(KArgsP a, LAS unsigned char* lds, int tid, int lane, int wave, int G, int l) {
    unsigned char* ws = a->ws;
    LAS float* sc = (LAS float*)lds; LAS float* sh = sc + 1024; LAS float* rstd_s = sh + 1024  ; LAS float* cvec = rstd_s + 128  ; LAS float* cpart = cvec + 64  ;
    LAS float* lg = cpart + 8 * 48  ; LAS int* hist = (LAS int*)(lg + 8 * 16 * 48)  ; LAS int* basev = hist + 32; LAS int* asg_e = basev + 32  ; LAS int* asg_lp = asg_e + 256;
    bf16* HN = (bf16*)(ws + WS_HN); const float* x = a->out; const float* RTW = (const float*)(ws + WS_RTW) + (size_t)l * 1024 * 48;
    int* TOKE = (int*)(ws + WS_TOKE); float* TOKW = (float*)(ws + WS_TOKW); int* LIST = (int*)(ws + WS_LIST); unsigned* CNT = (unsigned*)(ws + WS_CTL) + CW_CNT + l * 32;
    const float* gvec = a->in[I_NORM_FFN] + l * DM;
    for (int c = blockIdx.x; c < NTOK / 128; c += G) {
        const int b = c >> 6;
        __syncthreads();
        for (int j = tid; j < 1024; j += NTHR) { sc[j] = gvec[j] * (1.f + modval(ws, false, l, b, 4 * 1024 + j)); sh[j] = modval(ws, false, l, b, 3 * 1024 + j); }
        if (tid < 32) hist[tid] = 0;
        __syncthreads();
        if (tid < 384) { const int j = tid % 48, part = tid / 48; float s = 0.f;
            for (int k = part * 128; k < part * 128 + 128; ++k) s += sh[k] * RTW[(size_t)k * 48 + j];
            cpart[part * 48 + j] = s; }
        { f32x4 vn[4];
          { const GAS f32x4* xr = (const GAS f32x4*)(x + (size_t)(c * 128 + wave * 16) * DM) + lane;
#pragma unroll
            for (int j = 0; j < 4; ++j) vn[j] = xr[64 * j]; }
          for (int i = 0; i < 16; ++i) {
            const int row = c * 128 + wave * 16 + i;
            f32x4 v[4]; float ss = 0.f;
#pragma unroll
            for (int j = 0; j < 4; ++j) { v[j] = vn[j]; ss += (v[j].x * v[j].x + v[j].y * v[j].y) + (v[j].z * v[j].z + v[j].w * v[j].w); }
            if (i + 1 < 16) { const GAS f32x4* xr = (const GAS f32x4*)(x + (size_t)(row + 1) * DM) + lane;
#pragma unroll
                for (int j = 0; j < 4; ++j) vn[j] = xr[64 * j]; }
            const float rstd = rsqrtf(wave_sum(ss) * (1.f / DM) + NORM_EPS);
            if (lane == 0) rstd_s[wave * 16 + i] = rstd;
            GAS v2u* o = (GAS v2u*)(HN + (size_t)row * DM) + lane;
#pragma unroll
            for (int j = 0; j < 4; ++j) { const f32x4 s4 = *(const LAS f32x4*)(sc + lane * 4 + 256 * j), h4 = *(const LAS f32x4*)(sh + lane * 4 + 256 * j); const f32x4 h = v[j] * rstd * s4 + h4;
                v2u w; w.x = pk2(h.x, h.y); w.y = pk2(h.z, h.w); o[64 * j] = w; }
          } }
        __syncthreads();
        if (tid < 48) { float s = 0.f;
#pragma unroll
            for (int p = 0; p < 8; ++p) s += cpart[p * 48 + tid];
            s += tid < 4 ? a->in[I_MBRG][l * 4 + tid] : (tid < 36 ? a->in[I_MBRE][l * 32 + tid - 4] : 0.f); cvec[tid] = s; }
        {
            const int i16 = lane & 15, kq = lane >> 4, r0 = c * 128 + wave * 16;
            f32x4m acc0 = {0.f, 0.f, 0.f, 0.f}, acc1 = acc0, acc2 = acc0;
            const float* xrow = x + (size_t)(r0 + i16) * DM + 4 * kq;
            for (int k0 = 0; k0 < DM; k0 += 16) {
                const f32x4 xv = *(const GAS f32x4*)(xrow + k0); const f32x4 sv = *(const LAS f32x4*)(sc + k0 + 4 * kq);
                const float* wp = RTW + (size_t)(k0 + 4 * kq) * 48 + i16;
#pragma unroll
                for (int j = 0; j < 4; ++j) { const float av = xv[j] * sv[j];
                    acc0 = __builtin_amdgcn_mfma_f32_16x16x4f32(av, wp[j * 48], acc0, 0, 0, 0);
                    acc1 = __builtin_amdgcn_mfma_f32_16x16x4f32(av, wp[j * 48 + 16], acc1, 0, 0, 0);
                    acc2 = __builtin_amdgcn_mfma_f32_16x16x4f32(av, wp[j * 48 + 32], acc2, 0, 0, 0); }
            }
            __syncthreads();
            LAS float* lw = lg + wave * 16 * 48;
#pragma unroll
            for (int r = 0; r < 4; ++r) { const int rr = 4 * kq + r; const float rs = rstd_s[wave * 16 + rr];
                lw[rr * 48 + i16] = acc0[r] * rs + cvec[i16]; lw[rr * 48 + 16 + i16] = acc1[r] * rs + cvec[16 + i16]; lw[rr * 48 + 32 + i16] = acc2[r] * rs + cvec[32 + i16]; }
            LDS_WAIT(); asm volatile("" ::: "memory");
            if (lane < 16) {
                const LAS float* lr = lw + lane * 48; const int row = r0 + lane;
                float g0 = lr[0], g1 = lr[1], g2 = lr[2], g3 = lr[3]; const float gm = fmaxf(fmaxf(g0, g1), fmaxf(g2, g3));
                float p0 = __expf(g0 - gm), p1 = __expf(g1 - gm), p2 = __expf(g2 - gm), p3 = __expf(g3 - gm); const float inv = 1.f / (p0 + p1 + p2 + p3);
                p0 *= inv; p1 *= inv; p2 *= inv; p3 *= inv;
                int gi = 0; float gp = p0; if (p1 > gp) { gp = p1; gi = 1; } if (p2 > gp) { gp = p2; gi = 2; } if (p3 > gp) { gp = p3; gi = 3; }
                float ev0 = -3.4e38f, ev1 = -3.4e38f; int e0 = 0, e1 = 0;
#pragma unroll
                for (int j = 0; j < 8; ++j) { const float s = lr[4 + gi * 8 + j]; if (s > ev0) { ev1 = ev0; e1 = e0; ev0 = s; e0 = j; } else if (s > ev1) { ev1 = s; e1 = j; } }
                const float q = __expf(ev1 - ev0), w0 = gp / (1.f + q), w1 = gp * q / (1.f + q);
                e0 += gi * 8; e1 += gi * 8;
                TOKE[2 * row] = e0; TOKE[2 * row + 1] = e1; TOKW[2 * row] = w0; TOKW[2 * row + 1] = w1;
                const int a0 = 2 * (wave * 16 + lane);
                asg_e[a0] = e0; asg_e[a0 + 1] = e1; asg_lp[a0] = atomicAdd((int*)&hist[e0], 1); asg_lp[a0 + 1] = atomicAdd((int*)&hist[e1], 1);
            }
        }
        __syncthreads();
        if (tid < 32) { const int h = hist[tid]; basev[tid] = h ? (int)atomicAdd(CNT + tid, (unsigned)h) : 0; }
        __syncthreads();
        if (tid < 256) { const int e = asg_e[tid]; LIST[(size_t)e * 65536 + basev[e] + asg_lp[tid]] = (c * 128) * 2 + tid; }
    }
}
__device__ __forceinline__ void build_ptab(const unsigned* CNT, LAS int* ptab, LAS int* pst, LAS int* cnt, int tid) {
    __syncthreads();
    if (tid == 0) { int np = 0;
        for (int e = 0; e < NEXP; ++e) { const int ce = (int)__hip_atomic_load(CNT + e, RLX_AGENT); cnt[e] = ce; pst[e] = np * 256; const int pe = (ce + 255) >> 8;
            for (int p = 0; p < pe; ++p) ptab[1 + np + p] = e;
            np += pe; }
        ptab[0] = np; }
    __syncthreads();
}
__device__ __forceinline__ void phase_gather(KArgsP a, LAS unsigned char* lds, int tid, int lane, int wave, int vcu, int G, int l) {
    unsigned char* ws = a->ws;
    LAS int* ptab = (LAS int*)lds; LAS int* pst = ptab + 512; LAS int* cnt = pst + 32;
    build_ptab((const unsigned*)(ws + WS_CTL) + CW_CNT + l * 32, ptab, pst, cnt, tid);
    const bf16* HN = (const bf16*)(ws + WS_HN); bf16* XG = (bf16*)(ws + WS_XG); int* ROWMAP = (int*)(ws + WS_ROWMAP); const int* LIST = (const int*)(ws + WS_LIST);
    const int nrows = ptab[0] * 256;
    for (int row0 = (vcu * NWAVES + wave) * 8; row0 < nrows; row0 += G * NWAVES * 8) {
        int tok2[8]; v4u p0[8], p1[8];
#pragma unroll
        for (int j = 0; j < 8; ++j) { const int row = row0 + j, e = ptab[1 + (row >> 8)], pos = row - pst[e]; tok2[j] = (pos < cnt[e]) ? LIST[(size_t)e * 65536 + pos] : -1; }
#pragma unroll
        for (int j = 0; j < 8; ++j) { if (tok2[j] >= 0) { const GAS v4u* s = (const GAS v4u*)(HN + (size_t)(tok2[j] >> 1) * DM) + lane; p0[j] = s[0]; p1[j] = s[64]; } else { p0[j] = (v4u){0u, 0u, 0u, 0u}; p1[j] = p0[j]; } }
#pragma unroll
        for (int j = 0; j < 8; ++j) { GAS v4u* d = (GAS v4u*)(XG + (size_t)(row0 + j) * DM) + lane; d[0] = p0[j]; d[64] = p1[j]; if (lane == 0) ROWMAP[row0 + j] = tok2[j]; }
    }
}

__device__ __forceinline__ void phase_rowmap(KArgsP a, LAS unsigned char* lds, int tid, int vcu, int G, int l) {
    unsigned char* ws = a->ws;
    LAS int* ptab = (LAS int*)lds; LAS int* pst = ptab + 512; LAS int* cnt = pst + 32;
    build_ptab((const unsigned*)(ws + WS_CTL) + CW_CNT + l * 32, ptab, pst, cnt, tid);
    int* ROWMAP = (int*)(ws + WS_ROWMAP); const int* LIST = (const int*)(ws + WS_LIST);
    const int nrows = ptab[0] * 256;
    for (int row = vcu * NTHR + tid; row < nrows; row += G * NTHR) { const int e = ptab[1 + (row >> 8)], pos = row - pst[e]; ROWMAP[row] = (pos < cnt[e]) ? LIST[(size_t)e * 65536 + pos] : -1; }
}

typedef short bf16x8 __attribute__((ext_vector_type(8)));
constexpr int MT = 72;
constexpr int ML_XP = 0;
constexpr int ML_CX = 17152;
constexpr int ML_WQ = ML_CX + 9216, ML_WK = ML_WQ + 9216;
constexpr int ML_Q = ML_WK + 9216, ML_K = ML_Q + 9216;
constexpr int ML_S = ML_K + 9216;
constexpr int ML_VT = ML_S + 9216;
constexpr int ML_CT = ML_VT + 11520;
constexpr int ML_H = ML_CT + 11520;
constexpr int ML_SM = ML_H + 16640;
static_assert(ML_SM + 2048 <= RING_BYTES, "mLSTM LDS map");
__device__ __forceinline__ float logsigmoidf_(float x) { return fminf(x, 0.f) - log1pf(__expf(-fabsf(x))); }
__device__ __forceinline__ void mma64(const LAS bf16* A, int arow0, const LAS bf16* Bt, int brow0, int lane, f32x4& acc) {
    const LAS bf16* ap = A + (arow0 + (lane & 15)) * MT + 8 * (lane >> 4); const LAS bf16* bp = Bt + (brow0 + (lane & 15)) * MT + 8 * (lane >> 4);
    const bf16x8 a0 = *(const LAS bf16x8*)ap, a1 = *(const LAS bf16x8*)(ap + 32), b0 = *(const LAS bf16x8*)bp, b1 = *(const LAS bf16x8*)(bp + 32);
    acc = __builtin_amdgcn_mfma_f32_16x16x32_bf16(a0, b0, acc, 0, 0, 0); acc = __builtin_amdgcn_mfma_f32_16x16x32_bf16(a1, b1, acc, 0, 0, 0);
}
__device__ __forceinline__ void ml_front(KArgsP a, LAS unsigned char* lds, int tid, int l, int b, int c, int h, bool want_q) {
    const bf16* PROJ = (const bf16*)(a->ws + WS_PROJ); const size_t row0 = (size_t)b * SEQ + c * 64;
    LAS float* xp = (LAS float*)(lds + ML_XP);
    for (int idx = tid; idx < 67 * 8; idx += NTHR) { const int r = idx >> 3, c8 = idx & 7, tr = c * 64 + r - 3; LAS float* d = xp + r * 64 + c8 * 8;
        if (tr >= 0) { const v4u p = *(const GAS v4u*)(PROJ + ((size_t)b * SEQ + tr) * NPROJ + PC_QK + h * 64 + c8 * 8);
            *(LAS f32x4*)d = (f32x4){bflo(p.x), bfhi(p.x), bflo(p.y), bfhi(p.y)}; *(LAS f32x4*)(d + 4) = (f32x4){bflo(p.z), bfhi(p.z), bflo(p.w), bfhi(p.w)}; }
        else { *(LAS f32x4*)d = (f32x4){0.f, 0.f, 0.f, 0.f}; *(LAS f32x4*)(d + 4) = (f32x4){0.f, 0.f, 0.f, 0.f}; } }
    {
        const int t = tid >> 3, vg = tid & 7; LAS bf16* VT = (LAS bf16*)(lds + ML_VT);
        const v4u p = *(const GAS v4u*)(PROJ + (row0 + t) * NPROJ + PC_V + h * 64 + vg * 8);
        const unsigned w[4] = {p.x, p.y, p.z, p.w};
#pragma unroll
        for (int j = 0; j < 4; ++j) { VT[(vg * 8 + 2 * j) * MT + t] = (bf16)(w[j] & 0xffffu); VT[(vg * 8 + 2 * j + 1) * MT + t] = (bf16)(w[j] >> 16); }
        for (int idx = tid; idx < 16 * 64; idx += NTHR) VT[(64 + (idx >> 6)) * MT + (idx & 63)] = (idx < 64) ? (bf16)0x3F80 : (bf16)0;
        const bf16* WT = (const bf16*)(a->ws + WS_MLW) + (size_t)((l * NH + h) * 2) * 4096;
        const int e = tid >> 3, d8 = tid & 7;
        if (want_q) *(LAS v4u*)(lds + ML_WQ + (e * MT + d8 * 8) * 2) = *(const GAS v4u*)(WT + e * 64 + d8 * 8);
        *(LAS v4u*)(lds + ML_WK + (e * MT + d8 * 8) * 2) = *(const GAS v4u*)(WT + 4096 + e * 64 + d8 * 8);
    }
    __syncthreads();
    const float* cw = a->in[I_CONV_W] + (size_t)l * 4 * DA + h * 64; const float* cb = a->in[I_CONV_B] + (size_t)l * DA + h * 64;
    {
        const int t = tid >> 3, c8 = (tid & 7) * 8; float s[8];
#pragma unroll
        for (int j = 0; j < 8; ++j) s[j] = cb[c8 + j];
#pragma unroll
        for (int q = 0; q < 4; ++q) { const f32x4 x0 = *(const LAS f32x4*)(xp + (t + q) * 64 + c8), x1 = *(const LAS f32x4*)(xp + (t + q) * 64 + c8 + 4); const float* w = cw + q * DA + c8;
            s[0] += x0.x * w[0]; s[1] += x0.y * w[1]; s[2] += x0.z * w[2]; s[3] += x0.w * w[3]; s[4] += x1.x * w[4]; s[5] += x1.y * w[5]; s[6] += x1.z * w[6]; s[7] += x1.w * w[7]; }
#pragma unroll
        for (int j = 0; j < 8; ++j) s[j] = s[j] / (1.f + __expf(-s[j]));
        v4u o; o.x = pk2(s[0], s[1]); o.y = pk2(s[2], s[3]); o.z = pk2(s[4], s[5]); o.w = pk2(s[6], s[7]);
        *(LAS v4u*)(lds + ML_CX + (t * MT + c8) * 2) = o;
    }
}
__device__ __forceinline__ void phase_m1(KArgsP a, LAS unsigned char* lds, int tid, int lane, int wave, int vcu, int G, int l) {
    unsigned char* ws = a->ws; const float* GT = (const float*)(ws + WS_GATES);
    float* CLOC = (float*)(ws + WS_CLOC); float* MLG = (float*)(ws + WS_MSC); float* MLM = MLG + 4096;
    LAS float* sm = (LAS float*)(lds + ML_SM);
    for (int u = vcu; u < NUNIT_M; u += G) {
        const int h = u % NH, c = (u / NH) % NCH, b = u / (NH * NCH); const size_t row0 = (size_t)b * SEQ + c * 64;
        __syncthreads();
        ml_front(a, lds, tid, l, b, c, h, false);
        if (wave == 0) {
            const float ig = GT[(row0 + lane) * 16 + h] + a->in[I_BI][l * NH + h];
            const float fl = logsigmoidf_(GT[(row0 + lane) * 16 + 6 + h] + a->in[I_BF][l * NH + h]);
            float bc = fl;
#pragma unroll
            for (int o = 1; o < 64; o <<= 1) { const float t = __shfl_up(bc, o); if (lane >= o) bc += t; }
            const float gtot = __shfl(bc, 63); const float lw = gtot - bc + ig; const float ml = wave_max(lw);
            sm[lane] = __expf(lw - ml);
            if (lane == 0) { MLG[u] = gtot; MLM[u] = ml; }
        }
        __syncthreads();
        {
            const int rt = wave >> 1; LAS bf16* KT = (LAS bf16*)(lds + ML_K);
#pragma unroll
            for (int q = 0; q < 2; ++q) { const int ct = 2 * (wave & 1) + q; f32x4 acc = {0.f, 0.f, 0.f, 0.f};
                mma64((const LAS bf16*)(lds + ML_CX), 16 * rt, (const LAS bf16*)(lds + ML_WK), 16 * ct, lane, acc);
                const int t0 = 16 * rt + 4 * (lane >> 4), e = 16 * ct + (lane & 15);
                const float w0 = sm[t0] * 0.125f, w1 = sm[t0 + 1] * 0.125f, w2 = sm[t0 + 2] * 0.125f, w3 = sm[t0 + 3] * 0.125f;
                v2u o; o.x = pk2(acc[0] * w0, acc[1] * w1); o.y = pk2(acc[2] * w2, acc[3] * w3);
                *(LAS v2u*)(KT + e * MT + t0) = o; }
        }
        __syncthreads();
        {
            const int ct = wave & 3, r_lo = wave < 4 ? 0 : 3, r_hi = wave < 4 ? 3 : 5; float* cl = CLOC + (size_t)u * CL_STRIDE;
            for (int rt = r_lo; rt < r_hi; ++rt) { f32x4 acc = {0.f, 0.f, 0.f, 0.f};
                mma64((const LAS bf16*)(lds + ML_VT), 16 * rt, (const LAS bf16*)(lds + ML_K), 16 * ct, lane, acc);
                const int v0 = 16 * rt + 4 * (lane >> 4), e = 16 * ct + (lane & 15);
                if (rt < 4) {
#pragma unroll
                    for (int r = 0; r < 4; ++r) cl[(v0 + r) * 64 + e] = acc[r];
                } else if ((lane >> 4) == 0) cl[4096 + e] = acc[0]; }
        }
    }
}
__device__ __forceinline__ void phase_m2(unsigned char* ws, int tid, int wg, int nwg) {
    float* CLOC = (float*)(ws + WS_CLOC); const float* MLG = (const float*)(ws + WS_MSC); const float* MLM = MLG + 4096; float* MST = (float*)(ws + WS_MSC) + 8192;
    for (int idx = wg * NTHR + tid; idx < NB * NH * CL_STRIDE; idx += nwg * NTHR) {
        const int e = idx % CL_STRIDE, bh = idx / CL_STRIDE, b = bh / NH, h = bh % NH;
        float m = 0.f, cs = 0.f;
        for (int c0 = 0; c0 < NCH; c0 += 8) {
            float cl[8], g[8], ml[8];
#pragma unroll
            for (int j = 0; j < 8; ++j) { const int u = (b * NCH + c0 + j) * NH + h; cl[j] = CLOC[(size_t)u * CL_STRIDE + e]; g[j] = MLG[u]; ml[j] = MLM[u]; }
#pragma unroll
            for (int j = 0; j < 8; ++j) { const int u = (b * NCH + c0 + j) * NH + h;
                CLOC[(size_t)u * CL_STRIDE + e] = cs; if (e == 0) MST[u] = m;
                const float mn = fmaxf(g[j] + m, ml[j]); const float ao = __expf(g[j] + m - mn), al = __expf(ml[j] - mn);
                cs = ao * cs + al * cl[j]; m = mn; }
        }
    }
}
__device__ __forceinline__ void phase_m3(KArgsP a, LAS unsigned char* lds, int tid, int lane, int wave, int vcu, int G, int l) {
    unsigned char* ws = a->ws; const bf16* PROJ = (const bf16*)(ws + WS_PROJ); const float* GT = (const float*)(ws + WS_GATES);
    const float* CLOC = (const float*)(ws + WS_CLOC); const float* MST = (const float*)(ws + WS_MSC) + 8192; bf16* YC = (bf16*)(ws + WS_YC);
    LAS float* sm = (LAS float*)(lds + ML_SM); LAS float* hb = (LAS float*)(lds + ML_H);
    for (int u = vcu; u < NUNIT_M; u += G) {
        const int h = u % NH, c = (u / NH) % NCH, b = u / (NH * NCH); const size_t row0 = (size_t)b * SEQ + c * 64;
        __syncthreads();
        ml_front(a, lds, tid, l, b, c, h, true);
        {
            const float* cl = CLOC + (size_t)u * CL_STRIDE; LAS bf16* CT = (LAS bf16*)(lds + ML_CT);
            for (int idx = tid; idx < 65 * 16; idx += NTHR) { const int r = idx >> 4, c4 = idx & 15; const f32x4 v = *(const GAS f32x4*)(cl + r * 64 + c4 * 4);
                v2u o; o.x = pk2(v.x, v.y); o.y = pk2(v.z, v.w); *(LAS v2u*)(CT + r * MT + c4 * 4) = o; }
            for (int idx = tid; idx < 15 * 64; idx += NTHR) CT[(65 + (idx >> 6)) * MT + (idx & 63)] = 0;
        }
        if (wave == 0) {
            const float ig = GT[(row0 + lane) * 16 + h] + a->in[I_BI][l * NH + h];
            const float fl = logsigmoidf_(GT[(row0 + lane) * 16 + 6 + h] + a->in[I_BF][l * NH + h]);
            float bc = fl;
#pragma unroll
            for (int o = 1; o < 64; o <<= 1) { const float t = __shfl_up(bc, o); if (lane >= o) bc += t; }
            float pm = ig - bc;
#pragma unroll
            for (int o = 1; o < 64; o <<= 1) { const float t = __shfl_up(pm, o); if (lane >= o) pm = fmaxf(pm, t); }
            const float mst = MST[u]; const float inter = bc + mst, mt = fmaxf(inter, bc + pm);
            sm[lane] = ig - bc; sm[64 + lane] = bc - mt; sm[128 + lane] = __expf(inter - mt); sm[192 + lane] = __expf(-mt);
        }
        __syncthreads();
        {
            const int rt = wave >> 1; LAS bf16* Qs = (LAS bf16*)(lds + ML_Q); LAS bf16* Ks = (LAS bf16*)(lds + ML_K);
#pragma unroll
            for (int q = 0; q < 2; ++q) { const int ct = 2 * (wave & 1) + q; f32x4 aq = {0.f, 0.f, 0.f, 0.f}, ak = {0.f, 0.f, 0.f, 0.f};
                mma64((const LAS bf16*)(lds + ML_CX), 16 * rt, (const LAS bf16*)(lds + ML_WQ), 16 * ct, lane, aq);
                mma64((const LAS bf16*)(lds + ML_CX), 16 * rt, (const LAS bf16*)(lds + ML_WK), 16 * ct, lane, ak);
                const int t0 = 16 * rt + 4 * (lane >> 4), e = 16 * ct + (lane & 15);
#pragma unroll
                for (int r = 0; r < 4; ++r) { Qs[(t0 + r) * MT + e] = (bf16)f2bf(aq[r]); Ks[(t0 + r) * MT + e] = (bf16)f2bf(ak[r] * 0.125f); } }
        }
        __syncthreads();
        {
            const int rt = wave >> 1; LAS bf16* Ss = (LAS bf16*)(lds + ML_S);
#pragma unroll
            for (int q = 0; q < 2; ++q) { const int ct = 2 * (wave & 1) + q; f32x4 acc = {0.f, 0.f, 0.f, 0.f};
                if (ct <= rt) mma64((const LAS bf16*)(lds + ML_Q), 16 * rt, (const LAS bf16*)(lds + ML_K), 16 * ct, lane, acc);
                const int t0 = 16 * rt + 4 * (lane >> 4), s = 16 * ct + (lane & 15); const float qs = sm[s];
#pragma unroll
                for (int r = 0; r < 4; ++r) { const int t = t0 + r; Ss[t * MT + s] = (bf16)f2bf((s <= t) ? acc[r] * __expf(sm[64 + t] + qs) : 0.f); } }
        }
        __syncthreads();
        {
            const int rt = wave >> 1, nt = (wave & 1) ? 2 : 3;
            for (int q = 0; q < nt; ++q) { const int ct = (wave & 1) ? 2 + q : (q < 2 ? q : 4); f32x4 aA = {0.f, 0.f, 0.f, 0.f}, aB = {0.f, 0.f, 0.f, 0.f};
                mma64((const LAS bf16*)(lds + ML_Q), 16 * rt, (const LAS bf16*)(lds + ML_CT), 16 * ct, lane, aA);
                mma64((const LAS bf16*)(lds + ML_S), 16 * rt, (const LAS bf16*)(lds + ML_VT), 16 * ct, lane, aB);
                const int t0 = 16 * rt + 4 * (lane >> 4), v = 16 * ct + (lane & 15);
#pragma unroll
                for (int r = 0; r < 4; ++r) { const int t = t0 + r; const float x = sm[128 + t] * aA[r] + aB[r];
                    if (ct < 4) hb[t * 65 + v] = x; else if ((lane & 15) == 0) sm[256 + t] = x; } }
        }
        __syncthreads();
        {
            const int t = tid >> 3, vg = tid & 7; float acc[8];
            const float dn = 1.f / fmaxf(fabsf(sm[256 + t]), sm[192 + t]);
            float s1 = 0.f;
#pragma unroll
            for (int j = 0; j < 8; ++j) { acc[j] = hb[t * 65 + vg * 8 + j] * dn; s1 += acc[j]; }
            s1 += __shfl_xor(s1, 1); s1 += __shfl_xor(s1, 2); s1 += __shfl_xor(s1, 4);
            const float mu = s1 * (1.f / 64.f); float s2 = 0.f;
#pragma unroll
            for (int j = 0; j < 8; ++j) { acc[j] -= mu; s2 += acc[j] * acc[j]; }
            s2 += __shfl_xor(s2, 1); s2 += __shfl_xor(s2, 2); s2 += __shfl_xor(s2, 4);
            const float rs = rsqrtf(s2 * (1.f / 64.f) + HEAD_NORM_EPS);
            const float* nw = a->in[I_MNORM_W] + (size_t)l * DA + h * 64 + vg * 8;
            const v4u ov = *(const GAS v4u*)(PROJ + (row0 + t) * NPROJ + PC_O + h * 64 + vg * 8);
            const float o[8] = {bflo(ov.x), bfhi(ov.x), bflo(ov.y), bfhi(ov.y), bflo(ov.z), bfhi(ov.z), bflo(ov.w), bfhi(ov.w)};
            float r[8];
#pragma unroll
            for (int j = 0; j < 8; ++j) r[j] = acc[j] * rs * nw[j] * sigmoidf_(o[j]);
            v4u w; w.x = pk2(r[0], r[1]); w.y = pk2(r[2], r[3]); w.z = pk2(r[4], r[5]); w.w = pk2(r[6], r[7]);
            *(GAS v4u*)(YC + (row0 + t) * DM + h * 64 + vg * 8) = w;
        }
    }
}

constexpr int S5_UT = 264, S5_XT = 2056;
constexpr int S5_U = 0, S5_Z = 33792, S5_X = 67584;
static_assert(S5_X + 16 * S5_XT * 2 <= MISC_OFF, "S5 LDS map");
struct S5A { float are, aim, cre, cim; };
__device__ __forceinline__ S5A s5_a(KArgsP a, int l, int g, int p) {
    const float lam_re = a->in[I_S5ARE][(size_t)(l * 16 + g) * 64 + p], lam_im = a->in[I_S5AIM][(size_t)(l * 16 + g) * 64 + p];
    const float dt = expf(a->in[I_S5LDT][l * 16 + g]); const float mag = expf(lam_re * dt), ang = lam_im * dt;
    S5A r; r.are = mag * cosf(ang); r.aim = mag * sinf(ang);
    const float inv = 1.f / (lam_re * lam_re + lam_im * lam_im);
    r.cre = ((r.are - 1.f) * lam_re + r.aim * lam_im) * inv; r.cim = (r.aim * lam_re - (r.are - 1.f) * lam_im) * inv; return r;
}
__device__ __forceinline__ bf16x8 pack8(const float* v) { v4u o; o.x = pk2(v[0], v[1]); o.y = pk2(v[2], v[3]); o.z = pk2(v[4], v[5]); o.w = pk2(v[6], v[7]); return __builtin_bit_cast(bf16x8, o); }
__device__ __forceinline__ void s5_bfrag(const unsigned char* ws, int l, int g, int lane, bf16x8 (&bf)[8]) {
    const bf16* BB = (const bf16*)(ws + WS_S5BB) + (size_t)(l * 16 + g) * 128 * 16;
#pragma unroll
    for (int j = 0; j < 8; ++j) { v4u o = {0u, 0u, 0u, 0u}; if ((lane >> 4) < 2) o = *(const GAS v4u*)(BB + (16 * j + (lane & 15)) * 16 + 8 * (lane >> 4)); bf[j] = __builtin_bit_cast(bf16x8, o); }
}
__device__ __forceinline__ f32x2 s5_ap(const unsigned char* ws, int l, int g, int p) { return *(const GAS f32x2*)((const float*)(ws + WS_S5AP) + ((size_t)(l * 16 + g) * 64 + p) * 2); }
__device__ __forceinline__ void s5_load_u(const unsigned char* ws, LAS unsigned char* lds, int tid, size_t row0) {
    const bf16* PROJ = (const bf16*)(ws + WS_PROJ);
    for (int idx = tid; idx < 64 * 32; idx += NTHR) { const int t = idx >> 5, c8 = idx & 31;
        *(LAS v4u*)(lds + S5_U + (t * S5_UT + c8 * 8) * 2) = *(const GAS v4u*)(PROJ + (row0 + t) * NPROJ + PC_S5 + c8 * 8); }
}
__device__ __forceinline__ void s5_block(LAS unsigned char* lds, int lane, int tb, int g, const bf16x8 (&bf)[8], float are, float aim, float& xr, float& xi) {
    const int kq = lane >> 4; bf16x8 uf = {0, 0, 0, 0, 0, 0, 0, 0};
    if (kq < 2) uf = *(const LAS bf16x8*)(lds + S5_U + ((16 * tb + (lane & 15)) * S5_UT + g * 16 + 8 * kq) * 2);
    LAS bf16* X = (LAS bf16*)(lds + S5_X);
#pragma unroll
    for (int j = 0; j < 8; ++j) { f32x4 acc = {0.f, 0.f, 0.f, 0.f}; acc = __builtin_amdgcn_mfma_f32_16x16x32_bf16(bf[j], uf, acc, 0, 0, 0);
        v2u o; o.x = pk2(acc[0], acc[1]); o.y = pk2(acc[2], acc[3]); *(LAS v2u*)(X + (lane & 15) * S5_XT + g * 128 + 16 * j + 4 * kq) = o; }
    LDS_WAIT(); asm volatile("" ::: "memory");
    LAS unsigned* xw = (LAS unsigned*)(lds + S5_X) + (g * 128 + 2 * lane) / 2;
#pragma unroll
    for (int t = 0; t < 16; ++t) { const unsigned w = xw[t * (S5_XT / 2)]; const float br = bflo(w), bi = bfhi(w);
        const float nr = are * xr - aim * xi + br, ni = are * xi + aim * xr + bi; xr = nr; xi = ni;
        xw[t * (S5_XT / 2)] = pk2(xr, xi); }
    LDS_WAIT(); asm volatile("" ::: "memory");
}
__device__ __forceinline__ void phase_s1(KArgsP a, LAS unsigned char* lds, int tid, int lane, int wave, int vcu, int G, int l) {
    unsigned char* ws = a->ws; float* ST = (float*)(ws + WS_S5ST);
    bf16x8 bf0[8], bf1[8]; s5_bfrag(ws, l, wave, lane, bf0); s5_bfrag(ws, l, wave + 8, lane, bf1);
    struct { float are, aim; } A0, A1; { const f32x2 q0 = s5_ap(ws, l, wave, lane), q1 = s5_ap(ws, l, wave + 8, lane); A0.are = q0.x; A0.aim = q0.y; A1.are = q1.x; A1.aim = q1.y; }
    for (int u = vcu; u < NB * NCH; u += G) {
        const size_t row0 = (size_t)u * 64;
        __syncthreads();
        s5_load_u(ws, lds, tid, row0);
        __syncthreads();
        float x0r = 0.f, x0i = 0.f, x1r = 0.f, x1i = 0.f;
        for (int tb = 0; tb < 4; ++tb) { s5_block(lds, lane, tb, wave, bf0, A0.are, A0.aim, x0r, x0i); s5_block(lds, lane, tb, wave + 8, bf1, A1.are, A1.aim, x1r, x1i); }
        *(f32x2*)(ST + (((size_t)u * 16 + wave) * 64 + lane) * 2) = (f32x2){x0r, x0i};
        *(f32x2*)(ST + (((size_t)u * 16 + wave + 8) * 64 + lane) * 2) = (f32x2){x1r, x1i};
    }
}
__device__ __forceinline__ void phase_s2(KArgsP a, int tid, int wg, int nwg, int l) {
    float* ST = (float*)(a->ws + WS_S5ST);
    for (int idx = wg * NTHR + tid; idx < NB * 1024; idx += nwg * NTHR) {
        const int b = idx >> 10, gp = idx & 1023, g = gp >> 6, p = gp & 63;
        const f32x2 A = s5_ap(a->ws, l, g, p); float ar = A.x, ai = A.y;
#pragma unroll
        for (int s = 0; s < 6; ++s) { const float nr = ar * ar - ai * ai, ni = 2.f * ar * ai; ar = nr; ai = ni; }
        float cr = 0.f, ci = 0.f;
        for (int c0 = 0; c0 < NCH; c0 += 8) {
            f32x2 e[8];
#pragma unroll
            for (int j = 0; j < 8; ++j) e[j] = *(const f32x2*)(ST + (((size_t)(b * NCH + c0 + j) * 16 + g) * 64 + p) * 2);
#pragma unroll
            for (int j = 0; j < 8; ++j) { *(f32x2*)(ST + (((size_t)(b * NCH + c0 + j) * 16 + g) * 64 + p) * 2) = (f32x2){cr, ci};
                const float nr = ar * cr - ai * ci + e[j].x, ni = ar * ci + ai * cr + e[j].y; cr = nr; ci = ni; }
        }
    }
}
__device__ __forceinline__ float tanh_fast(float x) { return 1.f - 2.f / (1.f + __expf(2.f * x)); }
__device__ __forceinline__ float gelu_tanh_(float x) { const float t = tanh_fast(0.7978845608f * (x + 0.044715f * x * x * x)); return 0.5f * x * (1.f + t); }
__device__ __forceinline__ void s5_cload(const bf16* cmt  , int lane, bf16x8 (&cf)[4]) {
#pragma unroll
    for (int s = 0; s < 4; ++s) cf[s] = __builtin_bit_cast(bf16x8, *(const GAS v4u*)(cmt + (lane & 15) * 128 + 32 * s + 8 * (lane >> 4)));
}
__device__ __forceinline__ void s5_cproj(LAS unsigned char* lds, int lane, int tb, int g, const bf16x8 (&cf)[4], const float (&dv)[4]) {
    const int kq = lane >> 4; f32x4 acc = {0.f, 0.f, 0.f, 0.f};
    const LAS bf16* xp = (const LAS bf16*)(lds + S5_X) + (lane & 15) * S5_XT + g * 128 + 8 * kq;
#pragma unroll
    for (int s = 0; s < 4; ++s) acc = __builtin_amdgcn_mfma_f32_16x16x32_bf16(cf[s], *(const LAS bf16x8*)(xp + 32 * s), acc, 0, 0, 0);
    const int t = 16 * tb + (lane & 15), c0 = g * 16 + 4 * kq;
    const v2u uw = *(const LAS v2u*)(lds + S5_U + (t * S5_UT + c0) * 2);
    const float u4[4] = {bflo(uw.x), bfhi(uw.x), bflo(uw.y), bfhi(uw.y)}; float z[4];
#pragma unroll
    for (int r = 0; r < 4; ++r) z[r] = gelu_tanh_(acc[r] + dv[r] * u4[r]);
    v2u o; o.x = pk2(z[0], z[1]); o.y = pk2(z[2], z[3]); *(LAS v2u*)(lds + S5_Z + (t * S5_UT + c0) * 2) = o;
}
__device__ __forceinline__ void phase_s3(KArgsP a, LAS unsigned char* lds, int tid, int lane, int wave, int vcu, int G, int l) {
    unsigned char* ws = a->ws; const float* ST = (const float*)(ws + WS_S5ST); bf16* YC = (bf16*)(ws + WS_YC);
    const bf16* GLUT = (const bf16*)(ws + WS_GLUT) + (size_t)l * DC * DC;
    bf16x8 bf0[8], bf1[8]; s5_bfrag(ws, l, wave, lane, bf0); s5_bfrag(ws, l, wave + 8, lane, bf1);
    const bf16* cm0 = (const bf16*)(ws + WS_S5CM) + (size_t)(l * 16 + wave) * 2048; const bf16* cm1 = cm0 + 8 * 2048;
    struct { float are, aim; } A0, A1; { const f32x2 q0 = s5_ap(ws, l, wave, lane), q1 = s5_ap(ws, l, wave + 8, lane); A0.are = q0.x; A0.aim = q0.y; A1.are = q1.x; A1.aim = q1.y; }
    float d0[4], d1[4];
#pragma unroll
    for (int r = 0; r < 4; ++r) { d0[r] = a->in[I_S5D][l * DC + wave * 16 + 4 * (lane >> 4) + r]; d1[r] = a->in[I_S5D][l * DC + (wave + 8) * 16 + 4 * (lane >> 4) + r]; }
    for (int u = vcu; u < NB * NCH; u += G) {
        const size_t row0 = (size_t)u * 64;
        __syncthreads();
        s5_load_u(ws, lds, tid, row0);
        const f32x2 s0 = *(const f32x2*)(ST + (((size_t)u * 16 + wave) * 64 + lane) * 2), s1 = *(const f32x2*)(ST + (((size_t)u * 16 + wave + 8) * 64 + lane) * 2);
        float x0r = s0.x, x0i = s0.y, x1r = s1.x, x1i = s1.y;
        __syncthreads();
        for (int tb = 0; tb < 4; ++tb) {
            { bf16x8 cf[4]; s5_cload(cm0, lane, cf); s5_block(lds, lane, tb, wave, bf0, A0.are, A0.aim, x0r, x0i); s5_cproj(lds, lane, tb, wave, cf, d0); }
            { bf16x8 cf[4]; s5_cload(cm1, lane, cf); s5_block(lds, lane, tb, wave + 8, bf1, A1.are, A1.aim, x1r, x1i); s5_cproj(lds, lane, tb, wave + 8, cf, d1); }
        }
        __syncthreads();
        {
            const int kq = lane >> 4;
#pragma unroll
            for (int q = 0; q < 2; ++q) { const int ct = 2 * wave + q; f32x4 acc[4];
#pragma unroll
                for (int rt = 0; rt < 4; ++rt) acc[rt] = (f32x4){0.f, 0.f, 0.f, 0.f};
                const bf16* gp = GLUT + (size_t)(16 * ct + (lane & 15)) * DC + 8 * kq;
#pragma unroll 2
                for (int s = 0; s < 8; ++s) { const bf16x8 gf = __builtin_bit_cast(bf16x8, *(const GAS v4u*)(gp + 32 * s));
#pragma unroll
                    for (int rt = 0; rt < 4; ++rt) acc[rt] = __builtin_amdgcn_mfma_f32_16x16x32_bf16(gf, *(const LAS bf16x8*)(lds + S5_Z + ((16 * rt + (lane & 15)) * S5_UT + 32 * s + 8 * kq) * 2), acc[rt], 0, 0, 0); }
                const int j0 = 16 * ct + 4 * kq; const f32x4 gb = *(const GAS f32x4*)(a->in[I_S5GLUB] + l * DC + j0);
#pragma unroll
                for (int rt = 0; rt < 4; ++rt) { const int t = 16 * rt + (lane & 15); const v2u zw = *(const LAS v2u*)(lds + S5_Z + (t * S5_UT + j0) * 2);
                    const float z0 = bflo(zw.x), z1 = bfhi(zw.x), z2 = bflo(zw.y), z3 = bfhi(zw.y);
                    v2u o; o.x = pk2(z0 * sigmoidf_(acc[rt][0] + gb.x), z1 * sigmoidf_(acc[rt][1] + gb.y)); o.y = pk2(z2 * sigmoidf_(acc[rt][2] + gb.z), z3 * sigmoidf_(acc[rt][3] + gb.w));
                    *(GAS v2u*)(YC + (row0 + t) * DM + 768 + j0) = o; } }
        }
    }
}

__device__ __forceinline__ float rw_shift(const bf16* PROJ, const float* mu, size_t row, int col) {
    const float cur = bf2f(PROJ[row * NPROJ + PC_RW + col]); const float prv = (row % SEQ) ? bf2f(PROJ[(row - 1) * NPROJ + PC_RW + col]) : 0.f;
    return cur + mu[col] * (prv - cur);
}
constexpr int R1_TH = 0, R1_AD = 9216, R1_SG = 18432, R1_VS = 35840, R1_TMP = 86016;
template <int KS, int MODE>
__device__ __forceinline__ void r1_prod(const bf16* WT, const LAS bf16* act, int astride, const float* bias, bf16* OUT, size_t row0, int lane, int wave) {
    const int kq = lane >> 4, n0 = 48 * wave; constexpr int K = 32 * KS;
    f32x4 acc[3][4];
#pragma unroll
    for (int nt = 0; nt < 3; ++nt)
#pragma unroll
        for (int ti = 0; ti < 4; ++ti) acc[nt][ti] = (f32x4){0.f, 0.f, 0.f, 0.f};
#pragma unroll
    for (int s = 0; s < KS; ++s) { bf16x8 wf[3], af[4];
#pragma unroll
        for (int nt = 0; nt < 3; ++nt) wf[nt] = __builtin_bit_cast(bf16x8, *(const GAS v4u*)(WT + (size_t)(n0 + 16 * nt + (lane & 15)) * K + 32 * s + 8 * kq));
#pragma unroll
        for (int ti = 0; ti < 4; ++ti) af[ti] = *(const LAS bf16x8*)(act + (16 * ti + (lane & 15)) * astride + 32 * s + 8 * kq);
#pragma unroll
        for (int nt = 0; nt < 3; ++nt)
#pragma unroll
            for (int ti = 0; ti < 4; ++ti) acc[nt][ti] = __builtin_amdgcn_mfma_f32_16x16x32_bf16(wf[nt], af[ti], acc[nt][ti], 0, 0, 0); }
#pragma unroll
    for (int nt = 0; nt < 3; ++nt) { const int n = n0 + 16 * nt + 4 * kq; f32x4 bv = {0.f, 0.f, 0.f, 0.f}; if (MODE != 2) bv = *(const GAS f32x4*)(bias + n);
#pragma unroll
        for (int ti = 0; ti < 4; ++ti) { float o[4];
#pragma unroll
            for (int r = 0; r < 4; ++r) { const float x = acc[nt][ti][r] + bv[r]; o[r] = MODE == 0 ? 0.60653066f * sigmoidf_(x) : (MODE == 1 ? sigmoidf_(x) : x); }
            v2u w; w.x = pk2(o[0], o[1]); w.y = pk2(o[2], o[3]);
            *(GAS v2u*)(OUT + (row0 + 16 * ti + (lane & 15)) * DBR + n) = w; } }
}
__device__ __forceinline__ void phase_r1(KArgsP a, LAS unsigned char* lds, int tid, int lane, int wave, int vcu, int G, int l) {
    unsigned char* ws = a->ws; const bf16* PROJ = (const bf16*)(ws + WS_PROJ); const float* mu = a->in[I_RMU] + (size_t)l * RW_COLS;
    const bf16* W1 = (const bf16*)(ws + WS_R1W) + (size_t)l * 98304;
    const bf16* WV = (const bf16*)(ws + WS_R1W) + 2 * 98304;
    for (int u = vcu; u < NTOK / 64; u += G) {
        const size_t row0 = (size_t)u * 64;
        __syncthreads();
        for (int idx = tid; idx < 64 * 128; idx += NTHR) { const int tt = idx >> 7, col = 2 * (idx & 127); const size_t r = row0 + tt;
            const unsigned cw = *(const GAS unsigned*)(PROJ + r * NPROJ + PC_RW + RWC_WD + col); const unsigned pw = (r % SEQ) ? *(const GAS unsigned*)(PROJ + (r - 1) * NPROJ + PC_RW + RWC_WD + col) : 0u;
            const float c0 = bflo(cw), c1 = bfhi(cw); const float x0 = c0 + mu[RWC_WD + col] * (bflo(pw) - c0), x1 = c1 + mu[RWC_WD + col + 1] * (bfhi(pw) - c1);
            if (col < 64) *(LAS unsigned*)(lds + R1_TH + (tt * 72 + col) * 2) = pk2(tanh_fast(x0), tanh_fast(x1));
            else if (col < 128) *(LAS unsigned*)(lds + R1_AD + (tt * 72 + col - 64) * 2) = pk2(x0, x1);
            else *(LAS unsigned*)(lds + R1_SG + (tt * 136 + col - 128) * 2) = pk2(sigmoidf_(x0), sigmoidf_(x1)); }
        if (l > 0) for (int idx = tid; idx < 64 * 192; idx += NTHR) { const int tt = idx / 192, col = 2 * (idx % 192); const size_t r = row0 + tt;
            const unsigned cw = *(const GAS unsigned*)(PROJ + r * NPROJ + PC_RW + RWC_V + col); const unsigned pw = (r % SEQ) ? *(const GAS unsigned*)(PROJ + (r - 1) * NPROJ + PC_RW + RWC_V + col) : 0u;
            const float c0 = bflo(cw), c1 = bfhi(cw);
            *(LAS unsigned*)(lds + R1_VS + (tt * 392 + col) * 2) = pk2(c0 + mu[RWC_V + col] * (bflo(pw) - c0), c1 + mu[RWC_V + col + 1] * (bfhi(pw) - c1)); }
        __syncthreads();
        r1_prod<2, 0>(W1, (const LAS bf16*)(lds + R1_TH), 72, a->in[I_RW0] + l * DBR, (bf16*)(ws + WS_RE), row0, lane, wave);
        r1_prod<2, 1>(W1 + 24576, (const LAS bf16*)(lds + R1_AD), 72, a->in[I_RA0] + l * DBR, (bf16*)(ws + WS_RA), row0, lane, wave);
        r1_prod<4, 2>(W1 + 49152, (const LAS bf16*)(lds + R1_SG), 136, nullptr, (bf16*)(ws + WS_RG), row0, lane, wave);
        if (l > 0) {
            { const int kq = lane >> 4, mt = wave & 1, ti = wave >> 1; f32x4 acc = {0.f, 0.f, 0.f, 0.f};
#pragma unroll 4
              for (int s = 0; s < 12; ++s) acc = __builtin_amdgcn_mfma_f32_16x16x32_bf16(__builtin_bit_cast(bf16x8, *(const GAS v4u*)(WV + (size_t)(16 * mt + (lane & 15)) * 384 + 32 * s + 8 * kq)),
                                                                                          *(const LAS bf16x8*)(lds + R1_VS + ((16 * ti + (lane & 15)) * 392 + 32 * s + 8 * kq) * 2), acc, 0, 0, 0);
              v2u w; w.x = pk2(acc[0], acc[1]); w.y = pk2(acc[2], acc[3]); *(LAS v2u*)(lds + R1_TMP + ((16 * ti + (lane & 15)) * 40 + 16 * mt + 4 * kq) * 2) = w; }
            __syncthreads();
            r1_prod<1, 1>(WV + 12288, (const LAS bf16*)(lds + R1_TMP), 40, a->in[I_RV0], (bf16*)(ws + WS_RVG), row0, lane, wave);
        }
    }
}
__device__ __forceinline__ float dpp_allsum(float x) {
    x += __builtin_bit_cast(float, __builtin_amdgcn_update_dpp(0, __builtin_bit_cast(int, x), 0x128, 0xf, 0xf, false));
    x += __builtin_bit_cast(float, __builtin_amdgcn_update_dpp(0, __builtin_bit_cast(int, x), 0x124, 0xf, 0xf, false));
    x += __builtin_bit_cast(float, __builtin_amdgcn_update_dpp(0, __builtin_bit_cast(int, x), 0x122, 0xf, 0xf, false));
    x += __builtin_bit_cast(float, __builtin_amdgcn_update_dpp(0, __builtin_bit_cast(int, x), 0x121, 0xf, 0xf, false));
    { const unsigned xi = __builtin_bit_cast(unsigned, x); auto r = __builtin_amdgcn_permlane16_swap(xi, xi, false, false); const unsigned r0 = r[0], r1 = r[1]; x = __uint_as_float(r0) + __uint_as_float(r1); }
    { const unsigned xi = __builtin_bit_cast(unsigned, x); auto r = __builtin_amdgcn_permlane32_swap(xi, xi, false, false); const unsigned r0 = r[0], r1 = r[1]; x = __uint_as_float(r0) + __uint_as_float(r1); }
    return x;
}

constexpr int RC_EF = 0, RC_ATF = 4096, RC_QF = 8448, RC_PFT = 9472, RC_AT = 10496, RC_RT = 12800, RC_BH = 15104, RC_KH = 17408, RC_AH = 19712, RC_BTT = 22016, RC_KTT = 25088, RC_VS = 28160,
              RC_PRL = 31232, RC_QRL = 32000, RC_TQL = 32768, RC_G15 = 33536, RC_CH = 33792;
struct RCRegs { v2u r0, r1, k0, k1, aa, ee, v0, v1, vg, vf; };
__device__ __forceinline__ void rc_issue(const unsigned char* ws, int l, size_t row, int h, int tid, RCRegs& R) {
    const bf16* PROJ = (const bf16*)(ws + WS_PROJ); const int tt = tid >> 4, c0 = h * 64 + 4 * (tid & 15); const size_t r = row + tt; const bool first = (r % SEQ) == 0; const size_t rp = first ? r : r - 1;
    R.r0 = *(const GAS v2u*)(PROJ + r * NPROJ + PC_RW + RWC_R + c0); R.r1 = *(const GAS v2u*)(PROJ + rp * NPROJ + PC_RW + RWC_R + c0);
    R.k0 = *(const GAS v2u*)(PROJ + r * NPROJ + PC_RW + RWC_K + c0); R.k1 = *(const GAS v2u*)(PROJ + rp * NPROJ + PC_RW + RWC_K + c0);
    R.v0 = *(const GAS v2u*)(PROJ + r * NPROJ + PC_RW + RWC_V + c0); R.v1 = *(const GAS v2u*)(PROJ + rp * NPROJ + PC_RW + RWC_V + c0);
    R.aa = *(const GAS v2u*)((const bf16*)(ws + WS_RA) + r * DBR + c0); R.ee = *(const GAS v2u*)((const bf16*)(ws + WS_RE) + r * DBR + c0);
    if (l > 0) { R.vg = *(const GAS v2u*)((const bf16*)(ws + WS_RVG) + r * DBR + c0); R.vf = *(const GAS v2u*)((const bf16*)(ws + WS_VF) + r * DBR + c0); }
    if (first) { R.r1 = (v2u){0u, 0u}; R.k1 = (v2u){0u, 0u}; R.v1 = (v2u){0u, 0u}; }
}
__device__ __forceinline__ void unpack4(const v2u p, float (&o)[4]) { o[0] = bflo(p.x); o[1] = bfhi(p.x); o[2] = bflo(p.y); o[3] = bfhi(p.y); }
__device__ __forceinline__ v2u pack4(const float (&v)[4]) { v2u o; o.x = pk2(v[0], v[1]); o.y = pk2(v[2], v[3]); return o; }
__device__ __forceinline__ v2u pack4v(const f32x4 v) { v2u o; o.x = pk2(v[0], v[1]); o.y = pk2(v[2], v[3]); return o; }
__device__ __forceinline__ bf16x8 cat8(const v2u a, const v2u b) { v4u o; o.x = a.x; o.y = a.y; o.z = b.x; o.w = b.y; return __builtin_bit_cast(bf16x8, o); }
#define RC_BAR() asm volatile("s_waitcnt lgkmcnt(0)\n\ts_barrier" ::: "memory")

constexpr int REC_BYTES = 12288, REC_UNITS = 752;
__device__ __forceinline__ unsigned char* rc_rec(unsigned char* ws, size_t cu) { return cu < 8192 ? ws + WS_OPA + cu * REC_BYTES : ws + WS_OPB + (cu - 8192) * REC_BYTES; }
__device__ __forceinline__ v4u rc_gather_unit(const LAS unsigned char* wb, int u) {
    v2u lo, hi;
    if (u < 256) { const int base = u < 128 ? RC_AH : RC_RT, uu = u & 127, row = uu >> 3, s = (uu >> 2) & 1, lq = uu & 3; const LAS unsigned char* p = wb + base + (row * 72 + 32 * s + 4 * lq) * 2;
        lo = *(const LAS v2u*)p; hi = *(const LAS v2u*)(p + 32); }
    else if (u < 512) { const int k = (u - 256) >> 2, lq = (u - 256) & 3; lo = *(const LAS v2u*)(wb + RC_BTT + (k * 24 + 4 * lq) * 2); hi = *(const LAS v2u*)(wb + RC_KTT + (k * 24 + 4 * lq) * 2); }
    else if (u < 576) { const int t = (u - 512) >> 2, lq = (u - 512) & 3; lo = *(const LAS v2u*)(wb + RC_PRL + (t * 24 + 4 * lq) * 2); hi = *(const LAS v2u*)(wb + RC_QRL + (t * 24 + 4 * lq) * 2); }
    else if (u < 608) { const LAS unsigned char* p = wb + RC_TQL + (((u - 576) >> 1) * 24 + 8 * ((u - 576) & 1)) * 2; lo = *(const LAS v2u*)p; hi = *(const LAS v2u*)(p + 8); }
    else if (u < 736) { const LAS unsigned char* p = wb + RC_VS + (((u - 608) >> 1) * 24 + 8 * ((u - 608) & 1)) * 2; lo = *(const LAS v2u*)p; hi = *(const LAS v2u*)(p + 8); }
    else { const LAS unsigned char* p = wb + RC_G15 + (u - 736) * 16; lo = *(const LAS v2u*)p; hi = *(const LAS v2u*)(p + 8); }
    v4u o; o.x = lo.x; o.y = lo.y; o.z = hi.x; o.w = hi.y; return o;
}
__device__ __forceinline__ void rc_copy_out(unsigned char* rec, const LAS unsigned char* wb, int u) {
#pragma unroll
    for (int q = 0; q < 3; ++q) { const int uu = u + 256 * q; if (uu < REC_UNITS) *(GAS v4u*)(rec + uu * 16) = rc_gather_unit(wb, uu); }
}
constexpr int RS_AH = 0, RS_RT = 2304, RS_BK = 4608, RS_PQ = 9728, RS_TQL = 11008, RS_VS = 11776, RS_G15 = 14848, RS_CH = 15360;
__device__ __forceinline__ int rs_unit_off(int u) {
    if (u < 128) return RS_AH + (u >> 3) * 144 + (u & 7) * 16;
    if (u < 256) return RS_RT + ((u - 128) >> 3) * 144 + (u & 7) * 16;
    if (u < 512) return RS_BK + ((u - 256) >> 2) * 80 + (u & 3) * 16;
    if (u < 576) return RS_PQ + ((u - 512) >> 2) * 80 + (u & 3) * 16;
    if (u < 608) return RS_TQL + ((u - 576) >> 1) * 48 + (u & 1) * 16;
    if (u < 736) return RS_VS + ((u - 608) >> 1) * 48 + (u & 1) * 16;
    return RS_G15 + (u - 736) * 16;
}
#define RC_BUILD(RUSE, q) do { const int bh_ = (q) >> 8, b = bh_ / NH, h = bh_ % NH, blk_ = (q) & 255, c0 = h * 64 + 4 * kq; const size_t row0 = (size_t)b * SEQ + (size_t)blk_ * 32; \
        float kkw[4], kaw[4], mur[4], muk[4], muv[4]; \
_Pragma("unroll") \
        for (int j = 0; j < 4; ++j) { kkw[j] = a->in[I_RKK][(size_t)l * DBR + c0 + j]; kaw[j] = a->in[I_RKA][(size_t)l * DBR + c0 + j]; mur[j] = mu[RWC_R + c0 + j]; muk[j] = mu[RWC_K + c0 + j]; muv[j] = mu[RWC_V + c0 + j]; } \
        float an[4], bk[4], km[4], rs[4], ev[4]; \
        {   const RCRegs& R = RUSE; \
            float rc[4], rp[4], kc[4], kp[4], av[4], vc[4], vp[4], ks[4], kk[4], vs[4]; unpack4(R.r0, rc); unpack4(R.r1, rp); unpack4(R.k0, kc); unpack4(R.k1, kp); unpack4(R.aa, av); unpack4(R.ee, ev); unpack4(R.v0, vc); unpack4(R.v1, vp); \
            float ss = 0.f; \
_Pragma("unroll") \
            for (int j = 0; j < 4; ++j) { rs[j] = rc[j] + mur[j] * (rp[j] - rc[j]); ks[j] = kc[j] + muk[j] * (kp[j] - kc[j]); kk[j] = ks[j] * kkw[j]; ss += kk[j] * kk[j]; vs[j] = vc[j] + muv[j] * (vp[j] - vc[j]); } \
            ss += __shfl_xor(ss, 1); ss += __shfl_xor(ss, 2); ss += __shfl_xor(ss, 4); ss += __shfl_xor(ss, 8); \
            const float inv = 1.f / fmaxf(sqrtf(ss), 1e-12f); \
_Pragma("unroll") \
            for (int j = 0; j < 4; ++j) { const float kn = kk[j] * inv; an[j] = -kn; bk[j] = kn * av[j]; km[j] = ks[j] * (1.f + (av[j] - 1.f) * kaw[j]); } \
            if (l == 0) *(GAS v2u*)((bf16*)(ws + WS_VF) + (row0 + tt) * DBR + c0) = pack4(vs); \
            else { float g[4], f[4]; unpack4(R.vg, g); unpack4(R.vf, f); \
_Pragma("unroll") \
                for (int j = 0; j < 4; ++j) vs[j] = vs[j] + (f[j] - vs[j]) * g[j]; } \
            *(LAS f32x4*)(cb + RC_EF + (t * 64 + 4 * kq) * 4) = (f32x4){ev[0], ev[1], ev[2], ev[3]}; \
_Pragma("unroll") \
            for (int j = 0; j < 4; ++j) *(LAS bf16*)(cb + RC_VS + ((4 * kq + j) * 24 + t) * 2) = (bf16)f2bf(vs[j]); \
        } \
        if ((q) + 2 * G < NQ) rc_issue(ws, l, (size_t)(((q) + 2 * G) >> 8) / NH * SEQ + (size_t)(((q) + 2 * G) & 255) * 32, (((q) + 2 * G) >> 8) % NH, tid, RUSE); \
        RC_BAR(); \
        {   f32x4 inc = {0.f, 0.f, 0.f, 0.f}, tot = inc; \
_Pragma("unroll") \
            for (int i = 0; i < 16; ++i) { const f32x4 ei = *(const LAS f32x4*)(cb + RC_EF + (i * 64 + 4 * kq) * 4); tot = tot + ei; if (i <= t) inc = inc + ei; } \
            float At[4], Rt[4], Bh[4], Kh[4], Bt[4], Kt[4], Gt[4]; \
_Pragma("unroll") \
            for (int j = 0; j < 4; ++j) { const float Gi = __expf(-inc[j]), Ge = __expf(ev[j] - inc[j]), Gn = __expf(inc[j]); Gt[j] = __expf(-tot[j]); \
                At[j] = an[j] * Ge; Rt[j] = rs[j] * Gi; Bh[j] = bk[j] * Gn; Kh[j] = km[j] * Gn; Bt[j] = Bh[j] * Gt[j]; Kt[j] = Kh[j] * Gt[j]; } \
            *(LAS f32x4*)(cb + RC_ATF + (t * 68 + 4 * kq) * 4) = (f32x4){At[0], At[1], At[2], At[3]}; \
            *(LAS v2u*)(cb + RC_AT + (t * 72 + 4 * kq) * 2) = pack4(At); *(LAS v2u*)(cb + RC_RT + (t * 72 + 4 * kq) * 2) = pack4(Rt); \
            *(LAS v2u*)(cb + RC_BH + (t * 72 + 4 * kq) * 2) = pack4(Bh); *(LAS v2u*)(cb + RC_KH + (t * 72 + 4 * kq) * 2) = pack4(Kh); \
_Pragma("unroll") \
            for (int j = 0; j < 4; ++j) { *(LAS bf16*)(cb + RC_BTT + ((4 * kq + j) * 24 + t) * 2) = (bf16)f2bf(Bt[j]); *(LAS bf16*)(cb + RC_KTT + ((4 * kq + j) * 24 + t) * 2) = (bf16)f2bf(Kt[j]); } \
            if (t == 0) *(LAS f32x4*)(cb + RC_G15 + 4 * kq * 4) = (f32x4){Gt[0], Gt[1], Gt[2], Gt[3]}; \
        } \
        RC_BAR(); \
        {   LAS unsigned char* wb = lds + (wave >> 2) * RC_CH; const int pi = wave & 3; \
            const LAS bf16* Ap = (const LAS bf16*)(wb + (pi < 2 ? RC_AT : RC_RT)) + li * 72 + 8 * lq; const LAS bf16* Bp = (const LAS bf16*)(wb + ((pi & 1) ? RC_KH : RC_BH)) + li * 72 + 8 * lq; \
            f32x4 acc = {0.f, 0.f, 0.f, 0.f}; \
            acc = __builtin_amdgcn_mfma_f32_16x16x32_bf16(*(const LAS bf16x8*)Ap, *(const LAS bf16x8*)Bp, acc, 0, 0, 0); \
            acc = __builtin_amdgcn_mfma_f32_16x16x32_bf16(*(const LAS bf16x8*)(Ap + 32), *(const LAS bf16x8*)(Bp + 32), acc, 0, 0, 0); \
_Pragma("unroll") \
            for (int r = 0; r < 4; ++r) { const int tr = 4 * lq + r; if (pi < 2 ? !(li < tr) : !(li <= tr)) acc[r] = 0.f; } \
            if (pi == 0) *(LAS f32x4*)(wb + RC_PFT + (li * 16 + 4 * lq) * 4) = acc; \
            else if (pi == 1) { \
_Pragma("unroll") \
                for (int r = 0; r < 4; ++r) *(LAS float*)(wb + RC_QF + ((4 * lq + r) * 16 + li) * 4) = acc[r]; } \
            else { LAS bf16* o = (LAS bf16*)(wb + (pi == 2 ? RC_PRL : RC_QRL)); \
_Pragma("unroll") \
                for (int r = 0; r < 4; ++r) o[(4 * lq + r) * 24 + li] = (bf16)f2bf(acc[r]); } \
        } \
        RC_BAR(); \
        if (wave < 4) { \
            LAS unsigned char* wb = lds + (wave >> 1) * RC_CH; const bool isq = wave & 1; \
            float X[16]; \
_Pragma("unroll") \
            for (int r = 0; r < 16; ++r) X[r] = isq ? *(const LAS float*)(wb + RC_QF + (r * 16 + li) * 4) : *(const LAS float*)(wb + RC_ATF + (r * 68 + lane) * 4); \
_Pragma("unroll") \
            for (int j = 0; j < 15; ++j) { const LAS f32x4* pc = (const LAS f32x4*)(wb + RC_PFT + j * 64); const f32x4 c0v = pc[0], c1v = pc[1], c2v = pc[2], c3v = pc[3]; \
                const float c[16] = {c0v[0], c0v[1], c0v[2], c0v[3], c1v[0], c1v[1], c1v[2], c1v[3], c2v[0], c2v[1], c2v[2], c2v[3], c3v[0], c3v[1], c3v[2], c3v[3]}; \
_Pragma("unroll") \
                for (int r = j + 1; r < 16; ++r) X[r] = fmaf(c[r], X[j], X[r]); } \
            if (!isq) { LAS bf16* o = (LAS bf16*)(wb + RC_AH); \
_Pragma("unroll") \
                for (int r = 0; r < 16; ++r) o[r * 72 + lane] = (bf16)f2bf(X[r]); } \
            else if (lane < 16) { LAS bf16* o = (LAS bf16*)(wb + RC_TQL); \
_Pragma("unroll") \
                for (int r = 0; r < 16; ++r) o[r * 24 + lane] = (bf16)f2bf(X[r]); } \
        } \
        RC_BAR(); \
        { const int cc = tid >> 8, u = tid & 255; unsigned char* rec = rc_rec(ws, (size_t)bh_ * 512 + 2 * blk_ + cc); const LAS unsigned char* wb = lds + cc * RC_CH; \
          rc_copy_out(rec, wb, u); } \
        RC_BAR(); \
    } while (0)
struct RSOps { bf16x8 a01, a23, r01, r23, tq, pq, bk[4]; v2u vb; f32x4 g[4]; };
__device__ __forceinline__ void rs_load(const LAS unsigned char* wb, int wave, int li, int lq, RSOps& O) {
    O.a01 = *(const LAS bf16x8*)(wb + RS_AH + li * 144 + lq * 16); O.a23 = *(const LAS bf16x8*)(wb + RS_AH + li * 144 + 64 + lq * 16);
    O.r01 = *(const LAS bf16x8*)(wb + RS_RT + li * 144 + lq * 16); O.r23 = *(const LAS bf16x8*)(wb + RS_RT + li * 144 + 64 + lq * 16);
    O.pq = *(const LAS bf16x8*)(wb + RS_PQ + li * 80 + lq * 16);
    { const v2u t = *(const LAS v2u*)(wb + RS_TQL + li * 48 + lq * 8); v4u o; o.x = t.x; o.y = t.y; o.z = 0u; o.w = 0u; O.tq = __builtin_bit_cast(bf16x8, o); }
    O.vb = *(const LAS v2u*)(wb + RS_VS + (16 * wave + li) * 48 + lq * 8);
#pragma unroll
    for (int kt = 0; kt < 4; ++kt) { O.bk[kt] = *(const LAS bf16x8*)(wb + RS_BK + (16 * kt + li) * 80 + lq * 16); O.g[kt] = *(const LAS f32x4*)(wb + RS_G15 + (16 * kt + 4 * lq) * 4); }
}
#define RC_CHUNK(O, cc, row0) do { const v2u z2_ = {0u, 0u}; \
        f32x4 aD = {0.f, 0.f, 0.f, 0.f}, aY = {0.f, 0.f, 0.f, 0.f}; \
        aD = __builtin_amdgcn_mfma_f32_16x16x32_bf16(O.a01, Sb01, aD, 0, 0, 0); \
        aD = __builtin_amdgcn_mfma_f32_16x16x32_bf16(O.a23, Sb23, aD, 0, 0, 0); \
        aD = __builtin_amdgcn_mfma_f32_16x16x32_bf16(O.tq, cat8(O.vb, z2_), aD, 0, 0, 0); \
        aY = __builtin_amdgcn_mfma_f32_16x16x32_bf16(Sb01, O.r01, aY, 0, 0, 0); \
        aY = __builtin_amdgcn_mfma_f32_16x16x32_bf16(Sb23, O.r23, aY, 0, 0, 0); \
        const bf16x8 DV = cat8(pack4v(aD), O.vb); \
_Pragma("unroll") \
        for (int kt = 0; kt < 4; ++kt) Sacc[kt] = __builtin_amdgcn_mfma_f32_16x16x32_bf16(O.bk[kt], DV, Sacc[kt] * O.g[kt], 0, 0, 0); \
        aY = __builtin_amdgcn_mfma_f32_16x16x32_bf16(DV, O.pq, aY, 0, 0, 0); \
        Sb01 = cat8(pack4v(Sacc[0]), pack4v(Sacc[1])); Sb23 = cat8(pack4v(Sacc[2]), pack4v(Sacc[3])); \
        *(GAS v2u*)(YC + ((row0) + (cc) * 16 + li) * DM + 384 + h * 64 + 16 * wave + 4 * lq) = pack4v(aY);     \
    } while (0)
#define RC_SCAN(slot, row0) do { { RSOps O0; rs_load(slot, wave, li, lq, O0); __builtin_amdgcn_sched_barrier(0); RC_CHUNK(O0, 0, row0); } \
        { RSOps O1; rs_load(slot + RS_CH, wave, li, lq, O1); __builtin_amdgcn_sched_barrier(0); RC_CHUNK(O1, 1, row0); } } while (0)

__device__ __forceinline__ void phase_r2_build(KArgsP a, LAS unsigned char* lds, int tid, int lane, int wave, int vcu, int G, int l) {
    unsigned char* ws = a->ws;
    const int tt = tid >> 4, kq = tid & 15, ch = tt >> 4, t = tt & 15;
    const int lq = lane >> 4, li = lane & 15;
    LAS unsigned char* cb = lds + ch * RC_CH;
    const float* mu = a->in[I_RMU] + (size_t)l * RW_COLS;
    constexpr int NQ = NB * NH * 256;
    RCRegs RA, RB;
    if (vcu < NQ) rc_issue(ws, l, (size_t)(vcu >> 8) / NH * SEQ + (size_t)(vcu & 255) * 32, (vcu >> 8) % NH, tid, RA);
    if (vcu + G < NQ) rc_issue(ws, l, (size_t)((vcu + G) >> 8) / NH * SEQ + (size_t)((vcu + G) & 255) * 32, ((vcu + G) >> 8) % NH, tid, RB);
    for (int q0 = vcu; q0 < NQ; q0 += 2 * G) { { const int q = q0; RC_BUILD(RA, q); } if (q0 + G < NQ) { const int q = q0 + G; RC_BUILD(RB, q); } }
}
struct RSRegs { v4u p[6]; };
__device__ __forceinline__ void rs_issue(unsigned char* ws, size_t cu0, int lt, RSRegs& R) {
#pragma unroll
    for (int j = 0; j < 6; ++j) { const int uu = lt + 256 * j; if (uu < 2 * REC_UNITS) { const int cc = uu >= REC_UNITS, u = uu - cc * REC_UNITS; R.p[j] = *(const GAS v4u*)(rc_rec(ws, cu0 + cc) + u * 16); } }
}
__device__ __forceinline__ void rs_store(LAS unsigned char* slot, int lt, const RSRegs& R) {
#pragma unroll
    for (int j = 0; j < 6; ++j) { const int uu = lt + 256 * j; if (uu < 2 * REC_UNITS) { const int cc = uu >= REC_UNITS, u = uu - cc * REC_UNITS;
        *(LAS v4u*)(slot + cc * RS_CH + rs_unit_off(u)) = R.p[j]; } }
}
__device__ __forceinline__ void phase_r2_scan(KArgsP a, LAS unsigned char* lds, int tid, int lane, int wave, int wg, int l) {
    unsigned char* ws = a->ws; bf16* YC = (bf16*)(ws + WS_YC);
    const int b = wg / NH, h = wg % NH; const size_t rowb = (size_t)b * SEQ, cub = (size_t)wg * 512;
    const int lq = lane >> 4, li = lane & 15, lt = tid - 256; const bool loader = wave >= 4;
    f32x4 Sacc[4]; bf16x8 Sb01, Sb23;
#pragma unroll
    for (int kt = 0; kt < 4; ++kt) Sacc[kt] = (f32x4){0.f, 0.f, 0.f, 0.f};
    Sb01 = (bf16x8){0, 0, 0, 0, 0, 0, 0, 0}; Sb23 = Sb01;
    constexpr int NBLK = SEQ / 32;
    LAS unsigned char* slot0 = lds; LAS unsigned char* slot1 = lds + 2 * RS_CH;
    RSRegs RA, RB;
    if (loader) { rs_issue(ws, cub, lt, RA); rs_store(slot0, lt, RA); rs_issue(ws, cub + 2, lt, RB); rs_issue(ws, cub + 4, lt, RA); }
    RC_BAR();
    for (int bb = 0; bb < NBLK; bb += 2) {
        if (!loader) { const size_t row0 = rowb + (size_t)bb * 32; LAS unsigned char* slot = slot0; RC_SCAN(slot, row0); }
        else { rs_store(slot1, lt, RB); if (bb + 3 < NBLK) rs_issue(ws, cub + 2 * (size_t)(bb + 3), lt, RB); }
        RC_BAR();
        if (!loader) { const size_t row0 = rowb + (size_t)(bb + 1) * 32; LAS unsigned char* slot = slot1; RC_SCAN(slot, row0); }
        else { if (bb + 2 < NBLK) rs_store(slot0, lt, RA); if (bb + 4 < NBLK) rs_issue(ws, cub + 2 * (size_t)(bb + 4), lt, RA); }
        RC_BAR();
    }
}
__device__ __forceinline__ void phase_r3(KArgsP a, int lane, int gw, int ngw, int l) {
    unsigned char* ws = a->ws; const bf16* PROJ = (const bf16*)(ws + WS_PROJ); bf16* YC = (bf16*)(ws + WS_YC);
    const bf16* RA = (const bf16*)(ws + WS_RA); const bf16* RG = (const bf16*)(ws + WS_RG); const bf16* RVG = (const bf16*)(ws + WS_RVG); const bf16* VF = (const bf16*)(ws + WS_VF);
    const float* mu = a->in[I_RMU] + (size_t)l * RW_COLS;
    for (size_t row = gw; row < NTOK; row += ngw) {
#pragma unroll 2
        for (int h = 0; h < NH; ++h) {
            const int c = h * 64 + lane;
            const float y = bf2f(YC[row * DM + 384 + c]);
            const float m = dpp_allsum(y) * (1.f / 64.f); const float d = y - m; const float var = dpp_allsum(d * d) * (1.f / 64.f);
            const float yn = d * rsqrtf(var + RWKV_GN_EPS) * a->in[I_RLNW][l * DBR + c] + a->in[I_RLNB][l * DBR + c];
            const float rs = rw_shift(PROJ, mu, row, RWC_R + c), ks = rw_shift(PROJ, mu, row, RWC_K + c); float v = rw_shift(PROJ, mu, row, RWC_V + c);
            if (l > 0) v = v + (bf2f(VF[row * DBR + c]) - v) * bf2f(RVG[row * DBR + c]);
            const float av = bf2f(RA[row * DBR + c]);
            const float km = ks * (1.f + (av - 1.f) * a->in[I_RKA][l * DBR + c]);
            const float rk = dpp_allsum(rs * km * a->in[I_RRK][l * DBR + c]);
            YC[row * DM + 384 + c] = (bf16)f2bf((yn + rk * v) * bf2f(RG[row * DBR + c]));
        }
    }
}

constexpr int PH_PER_LAYER = 11, PH_FINAL = 1 + 2 * PH_PER_LAYER, N_PHASES = PH_FINAL + 1;
constexpr int R2_WGS = 24;
__global__ void __launch_bounds__(NTHR, 2) fwd(Args args) {
    extern __shared__ __attribute__((aligned(16))) unsigned char lds_raw[];
    LAS unsigned char* lds = (LAS unsigned char*)lds_raw;
    volatile LAS unsigned* MISC = (volatile LAS unsigned*)(lds + MISC_OFF);
    const int tid0 = threadIdx.x;
    const int G = gridDim.x;
#define PHASE_IDS int tid_ = threadIdx.x; asm volatile("" : "+v"(tid_)); const int tid = tid_, lane = tid & 63, wave = __builtin_amdgcn_readfirstlane(tid >> 6); \
    int bx_ = blockIdx.x; asm volatile("" : "+s"(bx_)); const int bx = bx_; const int vcu = (G % 8 == 0) ? (bx % 8) * (G / 8) + bx / 8 : bx; (void)lane; (void)wave; (void)vcu; (void)bx;
    unsigned char* ws0 = fresh_args()->ws;
    for (int u = tid0; u < (LDS_BYTES - RING_BYTES) / 4; u += NTHR) ((LAS unsigned*)(lds + RING_BYTES))[u] = 0u;
    __syncthreads();
    XcdBarrier bar; bar.bar = (unsigned*)(ws0 + WS_CTL) + CW_BAR; bar.x = 0; bar.st = nullptr;
    if (!MK_PER_PHASE) bar = xcd_barrier_post((unsigned*)(ws0 + WS_CTL) + CW_BAR, MISC + 8);
#if MK_PER_PHASE
    const int lo = args.ph_lo, hi = args.ph_hi;
#define IN(k) (lo <= (k) && (k) < hi)
#else
#define IN(k) true
#endif
#define SEAM(k) do { if (IN(k) && IN((k) + 1)) { XcdBarrier b2 = bar; asm volatile("" : "+s"(b2.bar)); xcd_barrier(b2); } } while (0)

#ifndef DBL_SUB
#define DBL_SUB 0
#endif
#ifndef DBL_PHASE
#define DBL_PHASE (-1)
#endif
#ifndef REPN
#define REPN 2
#endif
#define REP(k) for (int rep_ = 0; rep_ < ((k) == DBL_PHASE ? REPN : 1); ++rep_)
#define REPBAR if (rep_ > 0) { XcdBarrier b2 = bar; asm volatile("" : "+s"(b2.bar)); xcd_barrier(b2); }
    REP(0) if (IN(0)) { REPBAR KArgsP ap = fresh_args(); PHASE_IDS phase_prologue(ap, lds, tid, lane, wave, vcu, G); }
    SEAM(0);
#define LCONST 0
    {
        constexpr int l = LCONST; constexpr int pb = 1 + l * PH_PER_LAYER;
        REP(pb + 0) if (IN(pb + 0)) { REPBAR KArgsP ap = fresh_args(); PHASE_IDS unsigned char* ws = ap->ws; (void)ws;
            if (l == 0) { mod_finalize(ws, tid, G); phase_rownorm<0, false>(ap, lds, tid, lane, wave, G, ap->in[I_X], ap->out, ap->in[I_NORM_MIX], true, 0, 0, 0); }
            else {
#if EN_MOE
                phase_rownorm<0, true>(ap, lds, tid, lane, wave, G, ap->out, ap->out, ap->in[I_NORM_MIX] + l * DM, false, l, 0, l - 1);
#else
                phase_rownorm<0, false>(ap, lds, tid, lane, wave, G, ap->out, ap->out, ap->in[I_NORM_MIX] + l * DM, false, l, 0, l - 1);
#endif
            }
        }
        SEAM(pb + 0);
        REP(pb + 1) if (IN(pb + 1)) { REPBAR KArgsP ap = fresh_args(); PHASE_IDS unsigned char* ws = ap->ws; (void)ws;
            pg8::Gemm g{(const pg8::bf16_t*)(ws + WS_HN), (const pg8::bf16_t*)(ws + WS_WIN) + (size_t)l * NPROJ_PAD * DM, NTOK, NPROJ_PAD, DM};
            pg8::StaticOrder S; S.init(NTOK, NPROJ_PAD, G, bx);
            pg8::EpiProj E{(pg8::bf16_t*)(ws + WS_PROJ), (float*)(ws + WS_GATES)};
            pg8::gemm_phase<pg8::EpiProj, pg8::StaticOrder, true, true>(lds, g, S, E);
        }
        SEAM(pb + 1);
        REP(pb + 2) if (IN(pb + 2)) { REPBAR KArgsP ap = fresh_args(); PHASE_IDS unsigned char* ws = ap->ws; (void)ws;
#if EN_MLSTM
            for (int q_ = 0; q_ < 1 + (REPN - 1) * ((DBL_SUB == 1) && l == 0); ++q_) { phase_m1(ap, lds, tid, lane, wave, vcu, G, l); __syncthreads(); }
            __syncthreads();
#endif
#if EN_S5
            phase_s1(ap, lds, tid, lane, wave, vcu, G, l); __syncthreads();
#if DBL_SUB == 2
            if (l == 0) { phase_s1(ap, lds, tid, lane, wave, vcu, G, l); __syncthreads(); phase_s1(ap, lds, tid, lane, wave, vcu, G, l); __syncthreads(); phase_s1(ap, lds, tid, lane, wave, vcu, G, l); __syncthreads(); phase_s1(ap, lds, tid, lane, wave, vcu, G, l); __syncthreads(); }
#endif
            __syncthreads();
#endif
#if EN_RWKV
            for (int q_ = 0; q_ < 1 + (REPN - 1) * ((DBL_SUB == 3) && l == 0); ++q_) { phase_r1(ap, lds, tid, lane, wave, vcu, G, l); __syncthreads(); }
#endif
        }
        SEAM(pb + 2);
        REP(pb + 3) if (IN(pb + 3)) { REPBAR KArgsP ap = fresh_args(); PHASE_IDS unsigned char* ws = ap->ws; (void)ws;
            phase_m2(ws, tid, vcu, G);
            phase_s2(ap, tid, vcu, G, l);
            __syncthreads();
            phase_r2_build(ap, lds, tid, lane, wave, vcu, G, l);
        }
        SEAM(pb + 3);
        REP(pb + 4) if (IN(pb + 4)) { REPBAR KArgsP ap = fresh_args(); PHASE_IDS unsigned char* ws = ap->ws; (void)ws;
            if (bx < R2_WGS) { phase_r2_scan(ap, lds, tid, lane, wave, bx, l); __syncthreads(); }
            else { phase_s3(ap, lds, tid, lane, wave, bx - R2_WGS, G - R2_WGS, l); __syncthreads(); }
            {
                unsigned* qctr = (unsigned*)(ws + WS_CTL) + CW_Q + 64 * l; volatile LAS unsigned* qw = (volatile LAS unsigned*)(lds + MISC_OFF) + 16;
                for (;;) {
                    if (tid == 0) *qw = __hip_atomic_fetch_add(qctr, 1u, __ATOMIC_RELAXED, __HIP_MEMORY_SCOPE_AGENT);
                    __syncthreads();
                    const int u = (int)*qw;
                    __syncthreads();
                    if (u >= NUNIT_M) break;
                    phase_m3(ap, lds, tid, lane, wave, u, NUNIT_M, l);
                }
            }
        }
        SEAM(pb + 4);
        REP(pb + 5) if (IN(pb + 5)) { REPBAR KArgsP ap = fresh_args(); PHASE_IDS
            phase_r3(ap, lane, vcu * NWAVES + wave, G * NWAVES, l);
        }
        SEAM(pb + 5);
        REP(pb + 6) if (IN(pb + 6)) { REPBAR KArgsP ap = fresh_args(); PHASE_IDS unsigned char* ws = ap->ws; (void)ws;
            pg8::Gemm g{(const pg8::bf16_t*)(ws + WS_YC), (const pg8::bf16_t*)(ws + WS_WOUT) + (size_t)l * DM * DM, NTOK, DM, DM};
            pg8::StaticOrder S; S.init(NTOK, DM, G, bx);
            pg8::EpiResid E{l == 0 ? ap->in[I_X] : (const float*)ap->out, ap->out, (const float*)(ws + WS_MODF) + (size_t)l * 4 * 6144, 2048};
            pg8::gemm_phase<pg8::EpiResid, pg8::StaticOrder, true, true>(lds, g, S, E);
        }
        SEAM(pb + 6);
#if EN_MOE
        REP(pb + 7) if (IN(pb + 7)) { REPBAR KArgsP ap = fresh_args(); PHASE_IDS phase_router(ap, lds, tid, lane, wave, G, l); }
        SEAM(pb + 7);
        REP(pb + 8) if (IN(pb + 8)) { REPBAR KArgsP ap = fresh_args(); PHASE_IDS phase_rowmap(ap, lds, tid, vcu, G, l); __syncthreads();
            moe_convert(ap->in[I_MW1], ap->in[I_MW3], ap->in[I_MW2], l, (bf16*)(ap->ws + WS_W13), (bf16*)(ap->ws + WS_W2), vcu * NWAVES + wave, G * NWAVES, (LAS float*)(lds + wave * 16640), lane); }
        SEAM(pb + 8);
        REP(pb + 9) if (IN(pb + 9)) { REPBAR KArgsP ap = fresh_args(); PHASE_IDS unsigned char* ws = ap->ws; (void)ws;
            LAS int* ptab = (LAS int*)(lds + PTAB_OFF); LAS int* pst = ptab + 512; LAS int* cnt = pst + 32;
            build_ptab((const unsigned*)(ws + WS_CTL) + CW_CNT + l * 32, ptab, pst, cnt, tid);
            pg8::Gemm g{(const pg8::bf16_t*)(ws + WS_HN), (const pg8::bf16_t*)(ws + WS_W13), 0, 0, DM, (const int*)(ws + WS_ROWMAP)};
            pg8::MoeOrder S{ptab, G, vcu};
            pg8::EpiSwiglu E{(pg8::bf16_t*)(ws + WS_HMID)};
            pg8::gemm_phase<pg8::EpiSwiglu, pg8::MoeOrder, false, true, true>(lds, g, S, E);
        }
        SEAM(pb + 9);
        REP(pb + 10) if (IN(pb + 10)) { REPBAR KArgsP ap = fresh_args(); PHASE_IDS unsigned char* ws = ap->ws; (void)ws;
            LAS int* ptab = (LAS int*)(lds + PTAB_OFF); LAS int* pst = ptab + 512; LAS int* cnt = pst + 32;
            build_ptab((const unsigned*)(ws + WS_CTL) + CW_CNT + l * 32, ptab, pst, cnt, tid);
            pg8::Gemm g{(const pg8::bf16_t*)(ws + WS_HMID), (const pg8::bf16_t*)(ws + WS_W2), 0, 0, DEXP};
            pg8::MoeOrder S{ptab, G, vcu};
            pg8::EpiMoeOut E{(pg8::bf16_t*)(ws + WS_YMOE), (const int*)(ws + WS_ROWMAP)};
            pg8::gemm_phase<pg8::EpiMoeOut, pg8::MoeOrder, true, true>(lds, g, S, E);
        }
        SEAM(pb + 10);
#else
        SEAM(pb + 7); SEAM(pb + 8); SEAM(pb + 9); SEAM(pb + 10);
#endif
    }
#undef LCONST
#if N_LAYERS > 1
#define LCONST 1
    {
        constexpr int l = LCONST; constexpr int pb = 1 + l * PH_PER_LAYER;
        REP(pb + 0) if (IN(pb + 0)) { REPBAR KArgsP ap = fresh_args(); PHASE_IDS unsigned char* ws = ap->ws; (void)ws;
            if (l == 0) { mod_finalize(ws, tid, G); phase_rownorm<0, false>(ap, lds, tid, lane, wave, G, ap->in[I_X], ap->out, ap->in[I_NORM_MIX], true, 0, 0, 0); }
            else {
#if EN_MOE
                phase_rownorm<0, true>(ap, lds, tid, lane, wave, G, ap->out, ap->out, ap->in[I_NORM_MIX] + l * DM, false, l, 0, l - 1);
#else
                phase_rownorm<0, false>(ap, lds, tid, lane, wave, G, ap->out, ap->out, ap->in[I_NORM_MIX] + l * DM, false, l, 0, l - 1);
#endif
            }
        }
        SEAM(pb + 0);
        REP(pb + 1) if (IN(pb + 1)) { REPBAR KArgsP ap = fresh_args(); PHASE_IDS unsigned char* ws = ap->ws; (void)ws;
            pg8::Gemm g{(const pg8::bf16_t*)(ws + WS_HN), (const pg8::bf16_t*)(ws + WS_WIN) + (size_t)l * NPROJ_PAD * DM, NTOK, NPROJ_PAD, DM};
            pg8::StaticOrder S; S.init(NTOK, NPROJ_PAD, G, bx);
            pg8::EpiProj E{(pg8::bf16_t*)(ws + WS_PROJ), (float*)(ws + WS_GATES)};
            pg8::gemm_phase<pg8::EpiProj, pg8::StaticOrder, true, true>(lds, g, S, E);
        }
        SEAM(pb + 1);
        REP(pb + 2) if (IN(pb + 2)) { REPBAR KArgsP ap = fresh_args(); PHASE_IDS unsigned char* ws = ap->ws; (void)ws;
#if EN_MLSTM
            for (int q_ = 0; q_ < 1 + (REPN - 1) * ((DBL_SUB == 1) && l == 0); ++q_) { phase_m1(ap, lds, tid, lane, wave, vcu, G, l); __syncthreads(); }
            __syncthreads();
#endif
#if EN_S5
            phase_s1(ap, lds, tid, lane, wave, vcu, G, l); __syncthreads();
#if DBL_SUB == 2
            if (l == 0) { phase_s1(ap, lds, tid, lane, wave, vcu, G, l); __syncthreads(); phase_s1(ap, lds, tid, lane, wave, vcu, G, l); __syncthreads(); phase_s1(ap, lds, tid, lane, wave, vcu, G, l); __syncthreads(); phase_s1(ap, lds, tid, lane, wave, vcu, G, l); __syncthreads(); }
#endif
            __syncthreads();
#endif
#if EN_RWKV
            for (int q_ = 0; q_ < 1 + (REPN - 1) * ((DBL_SUB == 3) && l == 0); ++q_) { phase_r1(ap, lds, tid, lane, wave, vcu, G, l); __syncthreads(); }
#endif
        }
        SEAM(pb + 2);
        REP(pb + 3) if (IN(pb + 3)) { REPBAR KArgsP ap = fresh_args(); PHASE_IDS unsigned char* ws = ap->ws; (void)ws;
            phase_m2(ws, tid, vcu, G);
            phase_s2(ap, tid, vcu, G, l);
            __syncthreads();
            phase_r2_build(ap, lds, tid, lane, wave, vcu, G, l);
        }
        SEAM(pb + 3);
        REP(pb + 4) if (IN(pb + 4)) { REPBAR KArgsP ap = fresh_args(); PHASE_IDS unsigned char* ws = ap->ws; (void)ws;
            if (bx < R2_WGS) { phase_r2_scan(ap, lds, tid, lane, wave, bx, l); __syncthreads(); }
            else { phase_s3(ap, lds, tid, lane, wave, bx - R2_WGS, G - R2_WGS, l); __syncthreads(); }
            {
                unsigned* qctr = (unsigned*)(ws + WS_CTL) + CW_Q + 64 * l; volatile LAS unsigned* qw = (volatile LAS unsigned*)(lds + MISC_OFF) + 16;
                for (;;) {
                    if (tid == 0) *qw = __hip_atomic_fetch_add(qctr, 1u, __ATOMIC_RELAXED, __HIP_MEMORY_SCOPE_AGENT);
                    __syncthreads();
                    const int u = (int)*qw;
                    __syncthreads();
                    if (u >= NUNIT_M) break;
                    phase_m3(ap, lds, tid, lane, wave, u, NUNIT_M, l);
                }
            }
        }
        SEAM(pb + 4);
        REP(pb + 5) if (IN(pb + 5)) { REPBAR KArgsP ap = fresh_args(); PHASE_IDS
            phase_r3(ap, lane, vcu * NWAVES + wave, G * NWAVES, l);
        }
        SEAM(pb + 5);
        REP(pb + 6) if (IN(pb + 6)) { REPBAR KArgsP ap = fresh_args(); PHASE_IDS unsigned char* ws = ap->ws; (void)ws;
            pg8::Gemm g{(const pg8::bf16_t*)(ws + WS_YC), (const pg8::bf16_t*)(ws + WS_WOUT) + (size_t)l * DM * DM, NTOK, DM, DM};
            pg8::StaticOrder S; S.init(NTOK, DM, G, bx);
            pg8::EpiResid E{l == 0 ? ap->in[I_X] : (const float*)ap->out, ap->out, (const float*)(ws + WS_MODF) + (size_t)l * 4 * 6144, 2048};
            pg8::gemm_phase<pg8::EpiResid, pg8::StaticOrder, true, true>(lds, g, S, E);
        }
        SEAM(pb + 6);
#if EN_MOE
        REP(pb + 7) if (IN(pb + 7)) { REPBAR KArgsP ap = fresh_args(); PHASE_IDS phase_router(ap, lds, tid, lane, wave, G, l); }
        SEAM(pb + 7);
        REP(pb + 8) if (IN(pb + 8)) { REPBAR KArgsP ap = fresh_args(); PHASE_IDS phase_rowmap(ap, lds, tid, vcu, G, l); __syncthreads();
            moe_convert(ap->in[I_MW1], ap->in[I_MW3], ap->in[I_MW2], l, (bf16*)(ap->ws + WS_W13), (bf16*)(ap->ws + WS_W2), vcu * NWAVES + wave, G * NWAVES, (LAS float*)(lds + wave * 16640), lane); }
        SEAM(pb + 8);
        REP(pb + 9) if (IN(pb + 9)) { REPBAR KArgsP ap = fresh_args(); PHASE_IDS unsigned char* ws = ap->ws; (void)ws;
            LAS int* ptab = (LAS int*)(lds + PTAB_OFF); LAS int* pst = ptab + 512; LAS int* cnt = pst + 32;
            build_ptab((const unsigned*)(ws + WS_CTL) + CW_CNT + l * 32, ptab, pst, cnt, tid);
            pg8::Gemm g{(const pg8::bf16_t*)(ws + WS_HN), (const pg8::bf16_t*)(ws + WS_W13), 0, 0, DM, (const int*)(ws + WS_ROWMAP)};
            pg8::MoeOrder S{ptab, G, vcu};
            pg8::EpiSwiglu E{(pg8::bf16_t*)(ws + WS_HMID)};
            pg8::gemm_phase<pg8::EpiSwiglu, pg8::MoeOrder, false, true, true>(lds, g, S, E);
        }
        SEAM(pb + 9);
        REP(pb + 10) if (IN(pb + 10)) { REPBAR KArgsP ap = fresh_args(); PHASE_IDS unsigned char* ws = ap->ws; (void)ws;
            LAS int* ptab = (LAS int*)(lds + PTAB_OFF); LAS int* pst = ptab + 512; LAS int* cnt = pst + 32;
            build_ptab((const unsigned*)(ws + WS_CTL) + CW_CNT + l * 32, ptab, pst, cnt, tid);
            pg8::Gemm g{(const pg8::bf16_t*)(ws + WS_HMID), (const pg8::bf16_t*)(ws + WS_W2), 0, 0, DEXP};
            pg8::MoeOrder S{ptab, G, vcu};
            pg8::EpiMoeOut E{(pg8::bf16_t*)(ws + WS_YMOE), (const int*)(ws + WS_ROWMAP)};
            pg8::gemm_phase<pg8::EpiMoeOut, pg8::MoeOrder, true, true>(lds, g, S, E);
        }
        SEAM(pb + 10);
#else
        SEAM(pb + 7); SEAM(pb + 8); SEAM(pb + 9); SEAM(pb + 10);
#endif
    }
#undef LCONST
#endif
    if (IN(PH_FINAL)) { KArgsP ap = fresh_args(); PHASE_IDS
#if EN_MOE
        if (N_LAYERS > 0) phase_rownorm<1, true>(ap, lds, tid, lane, wave, G, ap->out, ap->out, ap->in[I_NORM_FINAL], false, 0, 0, N_LAYERS - 1);
        else phase_rownorm<1, false>(ap, lds, tid, lane, wave, G, ap->in[I_X], ap->out, ap->in[I_NORM_FINAL], false, 0, 0, 0);
#else
        phase_rownorm<1, false>(ap, lds, tid, lane, wave, G, N_LAYERS > 0 ? (const float*)ap->out : ap->in[I_X], ap->out, ap->in[I_NORM_FINAL], false, 0, 0, 0);
#endif
    }
#undef IN
#undef SEAM
}

extern "C" void kernel_launch(void* const* d_in, const int* in_sizes, int n_in, void* d_out, int out_size, void* d_ws, size_t ws_size, hipStream_t stream) {
    static int grid = 0;
    if (grid == 0) {
        if (n_in != 47 || out_size != NTOK * DM || ws_size < WS_END) { fprintf(stderr, "kernel_launch: unexpected problem (n_in %d, out %d, ws %zu < %zu)\n", n_in, out_size, ws_size, (size_t)WS_END); grid = -1; return; }
        int dev = 0, cus = 0, per_cu = 0;
        if (hipGetDevice(&dev) != hipSuccess || hipDeviceGetAttribute(&cus, hipDeviceAttributeMultiprocessorCount, dev) != hipSuccess) { grid = -1; return; }
        if (hipFuncSetAttribute((const void*)fwd, hipFuncAttributeMaxDynamicSharedMemorySize, LDS_BYTES) != hipSuccess) { fprintf(stderr, "kernel_launch: hipFuncSetAttribute failed\n"); grid = -1; return; }
        if (hipOccupancyMaxActiveBlocksPerMultiprocessor(&per_cu, (const void*)fwd, NTHR, LDS_BYTES) != hipSuccess || per_cu < 1) fprintf(stderr, "kernel_launch: occupancy query says %d\n", per_cu);
        (void)hipGetLastError();
        grid = cus;
        if (grid != 256) fprintf(stderr, "kernel_launch: %d CUs (built for 256)\n", grid);
    }
    if (grid < 0) return;
    (void)hipMemsetAsync((char*)d_ws + WS_CTL, 0, CTL_ZERO_BYTES, stream);
    Args a{};
    for (int i = 0; i < 47; ++i) a.in[i] = (const float*)d_in[i];
    a.out = (float*)d_out; a.ws = (unsigned char*)d_ws;
#if MK_PER_PHASE
    for (int p = 0; p < N_PHASES; ++p) { a.ph_lo = p; a.ph_hi = p + 1; hipLaunchKernelGGL(fwd, dim3(grid), dim3(NTHR), LDS_BYTES, stream, a); }
#else
    a.ph_lo = 0; a.ph_hi = N_PHASES; hipLaunchKernelGGL(fwd, dim3(grid), dim3(NTHR), LDS_BYTES, stream, a);
#endif
}
#ifdef DIAG_KERNELS
#define DK(name, ...) __global__ void __launch_bounds__(NTHR, 2) name(Args args) { extern __shared__ __attribute__((aligned(16))) unsigned char lds_raw[]; LAS unsigned char* lds = (LAS unsigned char*)lds_raw; \
    const int tid = threadIdx.x, lane = tid & 63, wave = __builtin_amdgcn_readfirstlane(tid >> 6); const int G = gridDim.x; const int bx = blockIdx.x; const int vcu = bx; KArgsP ap = fresh_args(); int l = ap->ph_lo; (void)lane; (void)wave; (void)vcu; (void)G; (void)l; __VA_ARGS__ }
DK(k_prologue, phase_prologue(ap, lds, tid, lane, wave, vcu, G);)
DK(k_norm0, phase_rownorm<0, false>(ap, lds, tid, lane, wave, G, ap->in[I_X], ap->out, ap->in[I_NORM_MIX], true, 0, 0, 0);)
DK(k_norm1, phase_rownorm<0, true>(ap, lds, tid, lane, wave, G, ap->out, ap->out, ap->in[I_NORM_MIX], false, l, 0, 0);)
DK(k_normf, phase_rownorm<1, true>(ap, lds, tid, lane, wave, G, ap->out, ap->out, ap->in[I_NORM_MIX], false, l, 0, 0);)
DK(k_m1, phase_m1(ap, lds, tid, lane, wave, vcu, G, l);)
DK(k_m2, phase_m2(ap->ws, tid, vcu, G);)
DK(k_m3, phase_m3(ap, lds, tid, lane, wave, vcu, G, l);)
DK(k_s1, phase_s1(ap, lds, tid, lane, wave, vcu, G, l);)
DK(k_s2, phase_s2(ap, tid, vcu, G, l);)
DK(k_s3, phase_s3(ap, lds, tid, lane, wave, vcu, G, l);)
DK(k_r1, phase_r1(ap, lds, tid, lane, wave, vcu, G, l);)
DK(k_r2b, phase_r2_build(ap, lds, tid, lane, wave, vcu, G, l);)
DK(k_r2s, phase_r2_scan(ap, lds, tid, lane, wave, vcu, l);)
DK(k_r3, phase_r3(ap, lane, vcu * NWAVES + wave, G * NWAVES, l);)
DK(k_router, phase_router(ap, lds, tid, lane, wave, G, l);)
DK(k_gather, phase_gather(ap, lds, tid, lane, wave, vcu, G, l);)
DK(k_moecv, moe_convert(ap->in[I_MW1], ap->in[I_MW3], ap->in[I_MW2], 1, (bf16*)(ap->ws + WS_W13), (bf16*)(ap->ws + WS_W2), vcu * NWAVES + wave, G * NWAVES, (LAS float*)(lds + wave * 16640), lane);)
#endif
```

```cpp
#include <hip/hip_runtime.h>
#include <cstdio>
#include <cstdint>
#define MK_PER_PHASE 0

#ifndef MK_PER_PHASE
#define MK_PER_PHASE 0
#endif
#ifndef EN_MLSTM
#define EN_MLSTM 1
#endif
#ifndef EN_S5
#define EN_S5 1
#endif
#ifndef EN_RWKV
#define EN_RWKV 1
#endif
#ifndef EN_MOE
#define EN_MOE 1
#endif
#ifndef N_LAYERS
#define N_LAYERS 2
#endif
constexpr int NWAVES = 8, NTHR = 512;
constexpr int DM = 1024, NB = 4, SEQ = 8192, NTOK = NB * SEQ;
constexpr int DA = 384, DBR = 384, DC = 256, NH = 6, HD = 64, NCH = SEQ / 64;
constexpr int IN_COLS = 2828, NPROJ = 2816, NPROJ_PAD = 3072;
constexpr int PC_QK = 0, PC_V = 384, PC_O = 768, PC_RW = 1152, PC_S5 = 2560;
constexpr int RWC_R = 0, RWC_K = 384, RWC_V = 768, RWC_WD = 1152, RWC_AD = 1216, RWC_GD = 1280, RW_COLS = 1408;
constexpr int NEXP = 32, DEXP = 512, MOE_ROWS_MAX = 73728;
constexpr int NUNIT_M = NB * NCH * NH;
constexpr int CL_STRIDE = 4160;
constexpr float NORM_EPS = 1e-6f, HEAD_NORM_EPS = 1e-5f, RWKV_GN_EPS = 64e-5f;

constexpr size_t MiB = 1u << 20;
constexpr size_t WS_CTL = 0, CTL_ZERO_BYTES = 1 * MiB;
constexpr size_t WS_MODP = 1 * MiB;
constexpr size_t WS_MODF = 2 * MiB + 512 * 1024;
constexpr size_t WS_S5BB = 2 * MiB + 896 * 1024;
constexpr size_t WS_RTW = 3 * MiB;
constexpr size_t WS_S5AP = 3 * MiB + 384 * 1024;
constexpr size_t WS_MLW = 3 * MiB + 512 * 1024;
constexpr size_t WS_S5CM = 2 * MiB + 768 * 1024;
constexpr size_t WS_GLUT = 3 * MiB + 768 * 1024;
constexpr size_t WS_WIN = 4 * MiB;
constexpr size_t WS_WOUT = 16 * MiB;
constexpr size_t WS_GATES = 20 * MiB;
constexpr size_t WS_W13 = 22 * MiB;
constexpr size_t WS_W2 = 86 * MiB;
constexpr size_t WS_HN = 118 * MiB;
constexpr size_t WS_CLOC = 118 * MiB;
constexpr size_t WS_MSC = 168 * MiB;
constexpr size_t WS_S5ST = 170 * MiB;
constexpr size_t WS_VF = 182 * MiB;
constexpr size_t WS_YC = 206 * MiB;
constexpr size_t WS_LIST = 206 * MiB;
constexpr size_t WS_ROWMAP = 214 * MiB;
constexpr size_t WS_TOKE = 215 * MiB;
constexpr size_t WS_TOKW = 215 * MiB + 512 * 1024;
constexpr size_t WS_PROJ = 270 * MiB;
constexpr size_t WS_RE = 446 * MiB, WS_RA = 470 * MiB, WS_RG = 494 * MiB, WS_RVG = 518 * MiB;
constexpr size_t WS_XG = 270 * MiB;
constexpr size_t WS_HMID = 414 * MiB;
constexpr size_t WS_YMOE = 270 * MiB;
constexpr size_t WS_R1W = 542 * MiB;
constexpr size_t WS_OPA = 22 * MiB;
constexpr size_t WS_OPB = 543 * MiB;
constexpr size_t WS_END = 591 * MiB;
constexpr int CW_TMO = 0, CW_BAR = 4096, CW_CNT = 8192, CW_Q = 8320;

constexpr int RING_BYTES = 131072, MISC_OFF = 135168, PTAB_OFF = MISC_OFF + 1024, LDS_BYTES = 147456;

#define GAS __attribute__((address_space(1)))
#define LAS __attribute__((address_space(3)))
typedef unsigned short bf16;
typedef unsigned v4u __attribute__((ext_vector_type(4)));
typedef unsigned v2u __attribute__((ext_vector_type(2)));
typedef float f32x4 __attribute__((ext_vector_type(4)));
typedef float f32x2 __attribute__((ext_vector_type(2)));
typedef GAS unsigned gu32;
#define RLX_AGENT __ATOMIC_RELAXED, __HIP_MEMORY_SCOPE_AGENT
#define LDS_WAIT() asm volatile("s_waitcnt lgkmcnt(0)" ::: "memory")
#define VM_WAIT() asm volatile("s_waitcnt vmcnt(0)" ::: "memory")
typedef float f32x2v __attribute__((ext_vector_type(2)));
typedef __bf16 bf16x2v __attribute__((ext_vector_type(2)));
__device__ __forceinline__ unsigned pk2(float lo, float hi) { const f32x2v v = {lo, hi}; const bf16x2v b = __builtin_convertvector(v, bf16x2v); return __builtin_bit_cast(unsigned, b); }
__device__ __forceinline__ unsigned f2bf(float f) { return pk2(f, 0.f) & 0xffffu; }
__device__ __forceinline__ float bf2f(unsigned v) { return __builtin_bit_cast(float, v << 16); }
__device__ __forceinline__ float bflo(unsigned w) { return __builtin_bit_cast(float, w << 16); }
__device__ __forceinline__ float bfhi(unsigned w) { return __builtin_bit_cast(float, w & 0xffff0000u); }
__device__ __forceinline__ float sigmoidf_(float x) { return 1.f / (1.f + __expf(-x)); }
__device__ __forceinline__ float wave_sum(float v) {
#pragma unroll
    for (int o = 1; o < 64; o <<= 1) v += __shfl_xor(v, o);
    return v;
}
__device__ __forceinline__ float wave_max(float v) {
#pragma unroll
    for (int o = 1; o < 64; o <<= 1) v = fmaxf(v, __shfl_xor(v, o));
    return v;
}
namespace pg8 {
#define PG8_LAS __attribute__((address_space(3)))
typedef unsigned short bf16_t;
typedef short bf16x8 __attribute__((ext_vector_type(8)));
typedef float f32x4 __attribute__((ext_vector_type(4)));
typedef unsigned u32x4 __attribute__((ext_vector_type(4)));
constexpr int BM = 256, BK = 64, HALF = 128, HTB = HALF * BK * 2  , STAGE_BYTES = 8 * HTB, NXCD = 8, WGM = 8;

__host__ __device__ __forceinline__ int lds_byte(int r, int c) { const int st = (r >> 4) * 2 + (c >> 5), rr = r & 15, cc = c & 31, ob = rr * 64 + cc * 2; return st * 1024 + (ob ^ (((ob >> 9) & 1) << 5)); }
__host__ __device__ __forceinline__ void stage_rc(int b, int& R, int& C) { const int st = b / 1024, sb = b % 1024, swz = sb ^ (((sb >> 9) & 1) << 5); R = (st >> 1) * 16 + swz / 64; C = (st & 1) * 32 + (swz % 64) / 2; }
__host__ __device__ __forceinline__ int perm32(int rho) { const int n = rho >> 4, i = rho & 15; return 8 * (i >> 2) + 4 * n + (i & 3); }

struct Unit { int pm, pn; };
__device__ __forceinline__ int moe_tok2(const int* list, PG8_LAS const int* ptab, int row) { const int e = ptab[1 + (row >> 8)], pos = row - ptab[512 + e]; return pos < ptab[544 + e] ? list[(size_t)e * 65536 + pos] : -1; }
struct Gemm { const bf16_t* A; const bf16_t* Bt; int M, N, K; const int* list = nullptr; PG8_LAS const int* ptab = nullptr; };

struct StaticOrder {
    int nM, nN, nwg, G, c;
    __host__ __device__ void init(int M, int N, int G_, int c_) { nM = M / BM; nN = N / BM; nwg = nM * nN; G = G_; c = c_; }
    __host__ __device__ bool next(int i, Unit& u) const {
        const long L = (long)i * G + c; if (L >= nwg) return false;
        int wgid = (int)L; { const int q = nwg / NXCD, r = nwg % NXCD, xcd = wgid % NXCD, off = wgid / NXCD; wgid = (xcd < r ? xcd * (q + 1) : r * (q + 1) + (xcd - r) * q) + off; }
        const int nig = WGM * nN, gid = wgid / nig, fm = gid * WGM, gsz = (nM - fm) < WGM ? (nM - fm) : WGM;
        u.pm = fm + ((wgid % nig) % gsz); u.pn = (wgid % nig) / gsz; return true;
    }
    __device__ __forceinline__ void a_ready(const Unit&) const {}
    __device__ __forceinline__ void done(const Unit&) const {}
};

__device__ __forceinline__ unsigned cvt_pk_bf16(float lo, float hi) { unsigned r; asm volatile("v_cvt_pk_bf16_f32 %0, %1, %2" : "=v"(r) : "v"(lo), "v"(hi)); return r; }

struct EpiProj {
    static constexpr bool PERM = true, AFTER_DRAIN = false;
    bf16_t* O; float* G;
    __device__ __forceinline__ void operator()(const f32x4 (&acc)[2][2][4][2], const Unit& u, int wr, int wc, int fr, int fq) const {
        const int row0 = u.pm * BM + wr * 64 + fr;
        if (u.pn < 11) {
            const int col0 = u.pn * BM + wc * 32 + 8 * fq;
#pragma unroll
            for (int ai = 0; ai < 2; ++ai)
#pragma unroll
                for (int m = 0; m < 4; ++m) { bf16_t* rowp = O + (size_t)(row0 + ai * HALF + m * 16) * 2816 + col0;
#pragma unroll
                    for (int bj = 0; bj < 2; ++bj) { const f32x4 v0 = acc[ai][bj][m][0], v1 = acc[ai][bj][m][1];
                        u32x4 w; w.x = cvt_pk_bf16(v0[0], v0[1]); w.y = cvt_pk_bf16(v0[2], v0[3]); w.z = cvt_pk_bf16(v1[0], v1[1]); w.w = cvt_pk_bf16(v1[2], v1[3]);
                        *(u32x4*)(rowp + bj * HALF) = w; } }
        } else if (wc == 0 && fq < 2) {
#pragma unroll
            for (int ai = 0; ai < 2; ++ai)
#pragma unroll
                for (int m = 0; m < 4; ++m) { float* rowp = G + (size_t)(row0 + ai * HALF + m * 16) * 16 + 8 * fq;
                    *(f32x4*)(rowp) = acc[ai][0][m][0]; *(f32x4*)(rowp + 4) = acc[ai][0][m][1]; }
        }
    }
};
struct EpiResid {
    static constexpr bool PERM = true, AFTER_DRAIN = false;
    const float* xin; float* out; const float* gate;
    int goff;
    __device__ __forceinline__ void operator()(const f32x4 (&acc)[2][2][4][2], const Unit& u, int wr, int wc, int fr, int fq) const {
        const int row0 = u.pm * BM + wr * 64 + fr, col0 = u.pn * BM + wc * 32 + 8 * fq;
        const float* gp = gate + (size_t)(row0 >> 13) * 6144 + goff + col0;
        f32x4 g[2][2];
#pragma unroll
        for (int bj = 0; bj < 2; ++bj)
#pragma unroll
            for (int n = 0; n < 2; ++n) g[bj][n] = *(const f32x4*)(gp + bj * HALF + 4 * n) + 1.0f;
#pragma unroll
        for (int ai = 0; ai < 2; ++ai)
#pragma unroll
            for (int m = 0; m < 4; ++m) { const size_t off = (size_t)(row0 + ai * HALF + m * 16) * 1024 + col0;
#pragma unroll
                for (int bj = 0; bj < 2; ++bj)
#pragma unroll
                    for (int n = 0; n < 2; ++n) { const f32x4 xv = *(const f32x4*)(xin + off + bj * HALF + 4 * n);
                        *(f32x4*)(out + off + bj * HALF + 4 * n) = xv + g[bj][n] * acc[ai][bj][m][n]; } }
    }
};
struct EpiSwiglu {
    static constexpr bool PERM = true, AFTER_DRAIN = false;
    bf16_t* H;
    __device__ __forceinline__ void operator()(const f32x4 (&acc)[2][2][4][2], const Unit& u, int wr, int wc, int fr, int fq) const {
        const int row0 = u.pm * BM + wr * 64 + fr, hid0 = 128 * (u.pn & 3) + 16 * wc + 4 * fq;
#pragma unroll
        for (int ai = 0; ai < 2; ++ai)
#pragma unroll
            for (int m = 0; m < 4; ++m) { bf16_t* rowp = H + (size_t)(row0 + ai * HALF + m * 16) * 512 + hid0;
#pragma unroll
                for (int bj = 0; bj < 2; ++bj) { const f32x4 g = acc[ai][bj][m][0], uu = acc[ai][bj][m][1]; float h[4];
#pragma unroll
                    for (int i = 0; i < 4; ++i) h[i] = g[i] / (1.f + __expf(-g[i])) * uu[i];
                    unsigned w0 = cvt_pk_bf16(h[0], h[1]), w1 = cvt_pk_bf16(h[2], h[3]);
                    *(unsigned long long*)(rowp + 64 * bj) = (unsigned long long)w0 | ((unsigned long long)w1 << 32); } }
    }
};
struct EpiMoeOut {
    static constexpr bool PERM = true, AFTER_DRAIN = false;
    bf16_t* Y; const int* list; PG8_LAS const int* ptab;
    __device__ __forceinline__ void operator()(const f32x4 (&acc)[2][2][4][2], const Unit& u, int wr, int wc, int fr, int fq) const {
        const int row0 = u.pm * BM + wr * 64 + fr, col0 = (u.pn & 3) * BM + wc * 32 + 8 * fq;
#pragma unroll
        for (int ai = 0; ai < 2; ++ai)
#pragma unroll
            for (int m = 0; m < 4; ++m) { const int dst = moe_tok2(list, ptab, row0 + ai * HALF + m * 16);
                if (dst >= 0) { bf16_t* rowp = Y + (size_t)dst * 1024 + col0;
#pragma unroll
                    for (int bj = 0; bj < 2; ++bj) { const f32x4 v0 = acc[ai][bj][m][0], v1 = acc[ai][bj][m][1];
                        u32x4 w; w.x = cvt_pk_bf16(v0[0], v0[1]); w.y = cvt_pk_bf16(v0[2], v0[3]); w.z = cvt_pk_bf16(v1[0], v1[1]); w.w = cvt_pk_bf16(v1[2], v1[3]);
                        *(u32x4*)(rowp + bj * HALF) = w; } } }
    }
};
struct MoeOrder {
    PG8_LAS const int* ptab; int G, c;
    __device__ __forceinline__ bool next(int i, Unit& u) const {
        const int L = i * G + c, np = __builtin_amdgcn_readfirstlane(ptab[0]);
        if (L >= np * 4) return false;
        const int p = L >> 2; u.pm = p; u.pn = __builtin_amdgcn_readfirstlane(ptab[1 + p]) * 4 + (L & 3); return true;
    }
    __device__ __forceinline__ void a_ready(const Unit&) const {}
    __device__ __forceinline__ void done(const Unit&) const {}
};
template <class Epi, class Sched, bool ALIGN_EPI = false, bool SP2 = false, bool GATHER = false>
__device__ __forceinline__ void gemm_phase(PG8_LAS unsigned char* lds, const Gemm g, const Sched& S, const Epi& E) {
    const int tid = threadIdx.x, wid = __builtin_amdgcn_readfirstlane(tid >> 6), lane = tid & 63, wr = wid >> 2, wc = wid & 3, fr = lane & 15, fq = lane >> 4;
    const int K = g.K, nt = K / BK;
    static_assert(!GATHER || SP2, "the gathered-A variant exists for the SP2 loop only");
    unsigned voffA[2], voffB[2];
    unsigned vAc[2] = {0u, 0u}, vAn[2] = {0u, 0u};
#pragma unroll
    for (int i = 0; i < 2; ++i) { int R, C; stage_rc(tid * 16 + i * 8192, R, C); const int Rb = Epi::PERM ? ((R & ~31) + perm32(R & 31)) : R;
        voffA[i] = (unsigned)(R * K + C) * 2u; voffB[i] = (unsigned)(Rb * K + C) * 2u; }
    const size_t kstep = (size_t)(BK * 2);
    const size_t hstep = (size_t)HALF * K * 2;
    const size_t tstep = 2 * hstep;
    const unsigned ldsw = (unsigned)wid * 1024u;
    const int aoff = lds_byte(wr * 64 + fr, fq * 8), boff = lds_byte(wc * 32 + fr, fq * 8);
#define PG8_SA(b, h) (((b) * 2 + (h)) * HTB)
#define PG8_SB(b, h) ((4 + (b) * 2 + (h)) * HTB)
#define PG8_STAGE(bufoff, gbase, voff) do { _Pragma("unroll") for (int _i = 0; _i < 2; ++_i) \
        __builtin_amdgcn_global_load_lds((const unsigned*)((const char*)(gbase) + (voff)[_i]), (PG8_LAS unsigned*)(lds + (bufoff) + ldsw + _i * 8192), 16, 0, 0); } while (0)
#define PG8_STAGEG(bufoff, base, pk) do { unsigned vg_[2]; _Pragma("unroll") for (int i_ = 0; i_ < 2; ++i_) { int R_, C_; stage_rc(tid * 16 + i_ * 8192, R_, C_); vg_[i_] = (((pk) >> (16 * i_)) & 0xffffu) * (unsigned)(2 * K) + (unsigned)(2 * C_); } PG8_STAGE(bufoff, base, vg_); } while (0)
#define PG8_STAGEA(bufoff, base, hh, nx) do { if constexpr (GATHER) { const unsigned pk_ = (nx) ? vAn[hh] : vAc[hh]; PG8_STAGEG(bufoff, base, pk_); } else PG8_STAGE(bufoff, (base) + (hh) * hstep, voffA); } while (0)
#define PG8_GOFF(dst, unit) do { _Pragma("unroll") for (int hh_ = 0; hh_ < 2; ++hh_) { unsigned pk_ = 0u; _Pragma("unroll") for (int i_ = 0; i_ < 2; ++i_) { int R_, C_; stage_rc(tid * 16 + i_ * 8192, R_, C_); \
        const int t2_ = moe_tok2(g.list, g.ptab, (unit).pm * BM + hh_ * HALF + R_); pk_ |= (unsigned)(t2_ < 0 ? 0 : (t2_ >> 1)) << (16 * i_); } dst[hh_] = pk_; } } while (0)
#define PG8_LDA(dst, b, h) do { _Pragma("unroll") for (int m = 0; m < 4; ++m) _Pragma("unroll") for (int k = 0; k < 2; ++k) dst[m][k] = *(const PG8_LAS bf16x8*)(lds + PG8_SA(b, h) + aoff + m * 2048 + k * 1024); } while (0)
#define PG8_LDB(dst, b, h) do { _Pragma("unroll") for (int n = 0; n < 2; ++n) _Pragma("unroll") for (int k = 0; k < 2; ++k) dst[n][k] = *(const PG8_LAS bf16x8*)(lds + PG8_SB(b, h) + boff + n * 2048 + k * 1024); } while (0)
#define PG8_MMA(ai, bj, At, Bt) do { __builtin_amdgcn_s_setprio(1); _Pragma("unroll") for (int m = 0; m < 4; ++m) _Pragma("unroll") for (int n = 0; n < 2; ++n) _Pragma("unroll") for (int k = 0; k < 2; ++k) \
        acc[ai][bj][m][n] = __builtin_amdgcn_mfma_f32_16x16x32_bf16(Bt[n][k], At[m][k], acc[ai][bj][m][n], 0, 0, 0); __builtin_amdgcn_s_setprio(0); } while (0)
#define PG8_WAIT_V(n) asm volatile("s_waitcnt vmcnt(" #n ")" ::: "memory")
#define PG8_WAIT_L(n) asm volatile("s_waitcnt lgkmcnt(" #n ")" ::: "memory")
#define PG8_BAR __builtin_amdgcn_s_barrier()
#define PG8_SCHED __builtin_amdgcn_sched_barrier(0)
    Unit cur, nxt; int ui = 0;
    if (!S.next(0, cur)) return;
    f32x4 acc[2][2][4][2];
#pragma unroll
    for (int a = 0; a < 2; ++a)
#pragma unroll
        for (int b = 0; b < 2; ++b)
#pragma unroll
            for (int m = 0; m < 4; ++m)
#pragma unroll
                for (int n = 0; n < 2; ++n) acc[a][b][m][n] = (f32x4){0.f, 0.f, 0.f, 0.f};
    bf16x8 At[4][2], B0[2][2], B1[2][2];
    const char* cA = (const char*)g.A + (GATHER ? (size_t)0 : (size_t)cur.pm * tstep); const char* cB = (const char*)g.Bt + (size_t)cur.pn * tstep;
    if constexpr (GATHER) { PG8_GOFF(vAc, cur); }
    S.a_ready(cur);
    if constexpr (SP2) {
        PG8_STAGE(PG8_SB(0, 0), cB, voffB); PG8_STAGE(PG8_SB(0, 1), cB + hstep, voffB); PG8_STAGEA(PG8_SA(0, 0), cA, 0, false); PG8_STAGEA(PG8_SA(0, 1), cA, 1, false);
        if (wr == 1) PG8_BAR;
        PG8_WAIT_V(2); PG8_BAR;
        PG8_STAGE(PG8_SB(1, 0), cB + kstep, voffB); PG8_STAGEA(PG8_SA(1, 0), cA + kstep, 0, false); PG8_STAGE(PG8_SB(1, 1), cB + hstep + kstep, voffB);
        PG8_WAIT_V(6); PG8_BAR;
    } else {
        PG8_STAGE(PG8_SB(0, 0), cB, voffB); PG8_STAGE(PG8_SA(0, 0), cA, voffA); PG8_STAGE(PG8_SB(0, 1), cB + hstep, voffB); PG8_STAGE(PG8_SA(0, 1), cA + hstep, voffA);
        if (wr == 1) PG8_BAR;
        PG8_WAIT_V(4); PG8_BAR;
        PG8_STAGE(PG8_SB(1, 0), cB + kstep, voffB); PG8_STAGE(PG8_SA(1, 0), cA + kstep, voffA); PG8_STAGE(PG8_SB(1, 1), cB + hstep + kstep, voffB);
        PG8_WAIT_V(6); PG8_BAR;
    }
    for (;;) {
        const bool has_next = S.next(ui + 1, nxt);
        const char* nA = (has_next && !GATHER) ? (const char*)g.A + (size_t)nxt.pm * tstep : cA;
        if constexpr (GATHER) { if (has_next) { PG8_GOFF(vAn, nxt); } else { vAn[0] = vAc[0]; vAn[1] = vAc[1]; } } const char* nB = has_next ? (const char*)g.Bt + (size_t)nxt.pn * tstep : cB;
        for (int t = 0; t < nt; t += 2) {
            const bool last = (t == nt - 2);
            const char* a1 = cA + (size_t)(t + 1) * kstep;
            const char* a2 = last ? nA : cA + (size_t)(t + 2) * kstep; const char* b2 = last ? nB : cB + (size_t)(t + 2) * kstep;
            const char* a3 = a2 + kstep; const char* b3 = b2 + kstep;
            if (last && has_next) S.a_ready(nxt);
            if constexpr (SP2) {
            PG8_LDB(B0, 0, 0); PG8_LDB(B1, 0, 1); PG8_SCHED; PG8_LDA(At, 0, 0); PG8_STAGEA(PG8_SA(1, 1), a1, 1, false);
            PG8_WAIT_V(8); PG8_WAIT_L(0); PG8_BAR; PG8_MMA(0, 0, At, B0); PG8_MMA(0, 1, At, B1); PG8_BAR; PG8_SCHED;
            PG8_LDA(At, 0, 1); PG8_STAGE(PG8_SB(0, 0), b2, voffB); PG8_STAGE(PG8_SB(0, 1), b2 + hstep, voffB); PG8_STAGEA(PG8_SA(0, 0), a2, 0, last);
            PG8_WAIT_V(8); PG8_WAIT_L(0); PG8_BAR; PG8_MMA(1, 0, At, B0); PG8_MMA(1, 1, At, B1); PG8_BAR; PG8_SCHED;
            PG8_LDB(B0, 1, 0); PG8_LDB(B1, 1, 1); PG8_SCHED; PG8_LDA(At, 1, 0); PG8_STAGEA(PG8_SA(0, 1), a2, 1, last);
            PG8_WAIT_V(8); PG8_WAIT_L(0); PG8_BAR; PG8_MMA(0, 0, At, B0); PG8_MMA(0, 1, At, B1); PG8_BAR; PG8_SCHED;
            PG8_LDA(At, 1, 1); PG8_STAGE(PG8_SB(1, 0), b3, voffB); PG8_STAGE(PG8_SB(1, 1), b3 + hstep, voffB); PG8_STAGEA(PG8_SA(1, 0), a3, 0, last);
            PG8_WAIT_V(8); PG8_WAIT_L(0); PG8_BAR; PG8_MMA(1, 0, At, B0); PG8_MMA(1, 1, At, B1); PG8_BAR; PG8_SCHED;
            } else {
            PG8_LDB(B0, 0, 0); PG8_SCHED; PG8_LDA(At, 0, 0); PG8_STAGE(PG8_SA(1, 1), a1 + hstep, voffA);
            PG8_WAIT_L(8); PG8_BAR; PG8_WAIT_L(0); PG8_MMA(0, 0, At, B0); PG8_BAR; PG8_SCHED;
            PG8_LDB(B1, 0, 1); PG8_STAGE(PG8_SB(0, 0), b2, voffB);
            PG8_BAR; PG8_WAIT_L(0); PG8_MMA(0, 1, At, B1); PG8_BAR;
            PG8_LDA(At, 0, 1); PG8_STAGE(PG8_SA(0, 0), a2, voffA);
            PG8_BAR; PG8_WAIT_L(0); PG8_MMA(1, 0, At, B0); PG8_BAR; PG8_SCHED;
            PG8_STAGE(PG8_SB(0, 1), b2 + hstep, voffB);
            PG8_WAIT_V(6); PG8_BAR; PG8_MMA(1, 1, At, B1); PG8_BAR;
            PG8_LDB(B0, 1, 0); PG8_SCHED; PG8_LDA(At, 1, 0); PG8_STAGE(PG8_SA(0, 1), a2 + hstep, voffA);
            PG8_WAIT_L(8); PG8_BAR; PG8_WAIT_L(0); PG8_MMA(0, 0, At, B0); PG8_BAR; PG8_SCHED;
            PG8_LDB(B1, 1, 1); PG8_STAGE(PG8_SB(1, 0), b3, voffB);
            PG8_BAR; PG8_WAIT_L(0); PG8_MMA(0, 1, At, B1); PG8_BAR;
            PG8_LDA(At, 1, 1); PG8_STAGE(PG8_SA(1, 0), a3, voffA);
            PG8_BAR; PG8_WAIT_L(0); PG8_MMA(1, 0, At, B0); PG8_BAR; PG8_SCHED;
            PG8_STAGE(PG8_SB(1, 1), b3 + hstep, voffB);
            PG8_WAIT_V(6); PG8_BAR; PG8_MMA(1, 1, At, B1); PG8_BAR;
            }
        }
        if constexpr (ALIGN_EPI) { if (wr == 0) PG8_BAR; }
        if constexpr (!Epi::AFTER_DRAIN) { E(acc, cur, wr, wc, fr, fq); S.done(cur); }
        if (!has_next) break;
#pragma unroll
        for (int a = 0; a < 2; ++a)
#pragma unroll
            for (int b = 0; b < 2; ++b)
#pragma unroll
                for (int m = 0; m < 4; ++m)
#pragma unroll
                    for (int n = 0; n < 2; ++n) acc[a][b][m][n] = (f32x4){0.f, 0.f, 0.f, 0.f};
        cur = nxt; cA = nA; cB = nB; ++ui;
        if constexpr (GATHER) { vAc[0] = vAn[0]; vAc[1] = vAn[1]; }
        if constexpr (ALIGN_EPI) { if (wr == 1) PG8_BAR; }
    }
    PG8_WAIT_V(0);
    if constexpr (!ALIGN_EPI) { if (wr == 0) PG8_BAR; }
    PG8_BAR;
    if constexpr (Epi::AFTER_DRAIN) { E.fused(acc, cur, wr, wc, fr, fq, lds, wid, lane); S.done(cur); }
#undef PG8_SA
#undef PG8_SB
#undef PG8_STAGE
#undef PG8_STAGEA
#undef PG8_STAGEG
#undef PG8_GOFF
#undef PG8_LDA
#undef PG8_LDB
#undef PG8_MMA
#undef PG8_WAIT_V
#undef PG8_WAIT_L
#undef PG8_BAR
#undef PG8_SCHED
}
}
#define XB_TMO      128
#define XB_XCNT(j)  (256  + 64 * (j))
#define XB_XSUB(j)  (1280 + 64 * (j))
#define XB_XGEN(j)  (2304 + 64 * (j))
#define XB_TOP      3328
#define XB_TOPGEN   3392
#define XCD_BAR_WORDS 3456
#define XB_SPIN_CAP (1u << 18)
#define LAS __attribute__((address_space(3)))

__device__ __forceinline__ unsigned xb_ld(unsigned* p)              { return __hip_atomic_load(p, __ATOMIC_RELAXED, __HIP_MEMORY_SCOPE_AGENT); }
__device__ __forceinline__ unsigned xb_add(unsigned* p, unsigned v) { return __hip_atomic_fetch_add(p, v, __ATOMIC_RELAXED, __HIP_MEMORY_SCOPE_AGENT); }
__device__ __forceinline__ unsigned xb_xcc_id() { return (unsigned)__builtin_amdgcn_s_getreg((3 << 11) | 20) & 0xFu; }
#define XB_SPIN(cond, bar) do { unsigned _sp = 0; while (cond) { __builtin_amdgcn_s_sleep(1); \
    if ((++_sp & 255u) == 0u) { if (xb_ld(&(bar)[XB_TMO])) break; if (_sp > XB_SPIN_CAP) { atomicAdd(&(bar)[XB_TMO], 1u); break; } } } } while (0)

struct XcdBarrier {
    unsigned* bar; unsigned x;
    volatile LAS unsigned* st;
};

__device__ __forceinline__ XcdBarrier xcd_barrier_post(unsigned* bar, volatile LAS unsigned* st) {
    XcdBarrier b; b.bar = bar; b.x = xb_xcc_id(); b.st = st;
    if (threadIdx.x == 0) (void)xb_add(&bar[XB_XCNT(b.x)], 1u);
    return b;
}
__device__ __forceinline__ void xcd_barrier_complete(unsigned* bar, unsigned x, unsigned& nloc, unsigned& nx) {
    const unsigned G = gridDim.x * gridDim.y * gridDim.z;
    unsigned sum, cnt, mine, sp = 0u;
    for (;;) {
        sum = 0u; cnt = 0u; mine = 0u;
#pragma unroll
        for (unsigned j = 0; j < 16; ++j) { const unsigned c = xb_ld(&bar[XB_XCNT(j)]); sum += c; cnt += (c > 0u) ? 1u : 0u; mine = (j == x) ? c : mine; }
        if (sum == G) break;
        __builtin_amdgcn_s_sleep(1);
        if ((++sp & 255u) == 0u) { if (xb_ld(&bar[XB_TMO])) break; if (sp > XB_SPIN_CAP) { atomicAdd(&bar[XB_TMO], 1u); break; } }
    }
    nloc = mine > 0u ? mine : 1u; nx = cnt > 0u ? cnt : 1u;
}

__device__ __forceinline__ void xcd_barrier(const XcdBarrier& b) {
    asm volatile("s_waitcnt vmcnt(0)" ::: "memory");
    __syncthreads();
    if (threadIdx.x == 0) {
        unsigned* bar = b.bar;
        __builtin_amdgcn_s_waitcnt(0);
        unsigned nloc = b.st[0], nx = b.st[1];
        if (nloc == 0u) { xcd_barrier_complete(bar, b.x, nloc, nx); b.st[0] = nloc; b.st[1] = nx; }
        const unsigned old = xb_add(&bar[XB_XSUB(b.x)], 1u);
        const unsigned gen = old / nloc;
        if (old + 1u == (gen + 1u) * nloc) {
            __builtin_amdgcn_fence(__ATOMIC_RELEASE, "agent");
            asm volatile("s_waitcnt vmcnt(0)" ::: "memory");
            const unsigned og = xb_add(&bar[XB_TOP], 1u);
            const unsigned tg = og / nx;
            if (og + 1u == (tg + 1u) * nx) xb_add(&bar[XB_TOPGEN], 1u);
            else XB_SPIN(xb_ld(&bar[XB_TOPGEN]) == tg, bar);
            __builtin_amdgcn_fence(__ATOMIC_ACQUIRE, "agent");
            xb_add(&bar[XB_XGEN(b.x)], 1u);
            asm volatile("s_waitcnt vmcnt(0)" ::: "memory");
        } else {
            XB_SPIN(xb_ld(&bar[XB_XGEN(b.x)]) == gen, bar);
            __builtin_amdgcn_fence(__ATOMIC_ACQUIRE, "agent");
            asm volatile("s_waitcnt vmcnt(0)" ::: "memory");
        }
    }
    __syncthreads();
}

struct Args { const float* in[47]; float* out; unsigned char* ws; int ph_lo, ph_hi; };
typedef const __attribute__((address_space(4))) Args* KArgsP;
__device__ __forceinline__ KArgsP fresh_args() { KArgsP p = (KArgsP)__builtin_amdgcn_kernarg_segment_ptr(); asm volatile("" : "+s"(p)); return p; }
enum { I_X = 0, I_C, I_ADA_W, I_ADA_B, I_NORM_MIX, I_NORM_FFN, I_NORM_FINAL, I_W_IN, I_W_OUT, I_CONV_W, I_CONV_B, I_WQ, I_WK, I_BI, I_BF, I_MNORM_W,
       I_RMU, I_RW0, I_RWUP, I_RA0, I_RAUP, I_RGUP, I_RKK, I_RKA, I_RRK, I_RLNW, I_RLNB, I_RV0, I_RVDN, I_RVUP,
       I_S5ARE, I_S5AIM, I_S5LDT, I_S5BRE, I_S5BIM, I_S5CRE, I_S5CIM, I_S5D, I_S5GLUW, I_S5GLUB,
       I_MWRG, I_MBRG, I_MWRE, I_MBRE, I_MW1, I_MW3, I_MW2 };

struct RmWin { __device__ __forceinline__ int operator()(int n) const { return n < 1152 ? n : (n < 1164 ? 2816 + (n - 1152) : (n < 2572 ? 1152 + (n - 1164) : 2560 + (n - 2572))); } };
struct RmId  { __device__ __forceinline__ int operator()(int n) const { return n; } };
struct RmGU  { int add; __device__ __forceinline__ int operator()(int n) const { return 8 * (n >> 2) + (n & 3) + add; } };
template <class RM>
__device__ __forceinline__ void transpose_item(const float* W, int ldw, int ncols, int k0, int n0, bf16* WT, int ldt, LAS float* scr, int lane, const RM rm) {
    const int nn = n0 + lane; const bool ok = nn < ncols; const float* src = W + (size_t)k0 * ldw + (ok ? nn : n0);
    float v[64];
#pragma unroll
    for (int kk = 0; kk < 64; ++kk) v[kk] = src[(size_t)kk * ldw];
#pragma unroll
    for (int kk = 0; kk < 64; ++kk) scr[kk * 65 + lane] = v[kk];
    LDS_WAIT(); asm volatile("" ::: "memory");
    const int c = lane & 7;
#pragma unroll
    for (int j = 0; j < 8; ++j) { const int nl = (lane >> 3) + 8 * j; const LAS float* s = scr + (8 * c) * 65 + nl;
        v4u o; o.x = pk2(s[0 * 65], s[1 * 65]); o.y = pk2(s[2 * 65], s[3 * 65]); o.z = pk2(s[4 * 65], s[5 * 65]); o.w = pk2(s[6 * 65], s[7 * 65]);
        if (n0 + nl < ncols) *(GAS v4u*)(WT + (size_t)rm(n0 + nl) * ldt + k0 + 8 * c) = o; }
    LDS_WAIT(); asm volatile("" ::: "memory");
}
__device__ __forceinline__ void moe_convert(const float* w1, const float* w3, const float* w2, int l, bf16* W13, bf16* W2T, int worker, int nworkers, LAS float* scr, int lane) {
    for (int it = worker; it < NEXP * 384; it += nworkers) {
        const int e = it / 384, r = it % 384; const size_t eo = (size_t)(l * NEXP + e) * DM * DEXP;
        if (r < 128)      transpose_item(w1 + eo, DEXP, DEXP, 64 * (r >> 3), 64 * (r & 7), W13 + (size_t)e * 1024 * 1024, 1024, scr, lane, RmGU{0});
        else if (r < 256) transpose_item(w3 + eo, DEXP, DEXP, 64 * ((r - 128) >> 3), 64 * ((r - 128) & 7), W13 + (size_t)e * 1024 * 1024, 1024, scr, lane, RmGU{4});
        else              transpose_item(w2 + eo, DM, DM, 64 * ((r - 256) >> 4), 64 * ((r - 256) & 15), W2T + (size_t)e * 1024 * 512, 512, scr, lane, RmId{});
    }
}
__device__ __forceinline__ void phase_prologue(KArgsP a, LAS unsigned char* lds, int tid, int lane, int wave, int vcu, int G) {
    unsigned char* ws = a->ws;
    LAS float* scr = (LAS float*)(lds + wave * 16640);
    const int gw = vcu * NWAVES + wave, NGW = G * NWAVES;
    bf16* WIN = (bf16*)(ws + WS_WIN); bf16* WOUT = (bf16*)(ws + WS_WOUT);
    for (int it = gw; it < 2 * 16 * 45; it += NGW) { const int l = it / (16 * 45), r = it % (16 * 45);
        transpose_item(a->in[I_W_IN] + (size_t)l * DM * IN_COLS, IN_COLS, IN_COLS, 64 * (r / 45), 64 * (r % 45), WIN + (size_t)l * NPROJ_PAD * DM, DM, scr, lane, RmWin{}); }
    for (int it = gw; it < 2 * 16 * 16; it += NGW) { const int l = it / 256, r = it % 256;
        transpose_item(a->in[I_W_OUT] + (size_t)l * DM * DM, DM, DM, 64 * (r >> 4), 64 * (r & 15), WOUT + (size_t)l * DM * DM, DM, scr, lane, RmId{}); }
    for (int it = gw; it < 2 * 244; it += NGW) { const int l = it / 244, r = 2828 + it % 244; GAS v4u* p = (GAS v4u*)(WIN + ((size_t)l * NPROJ_PAD + r) * DM);
        p[lane] = (v4u){0u, 0u, 0u, 0u}; p[lane + 64] = (v4u){0u, 0u, 0u, 0u}; }
    { float* RTW = (float*)(ws + WS_RTW);
      for (int idx = (vcu * NTHR + tid); idx < 2 * 1024 * 48; idx += G * NTHR) { const int j = idx % 48, k = (idx / 48) % 1024, l = idx / (48 * 1024);
          RTW[idx] = j < 4 ? a->in[I_MWRG][(size_t)(l * 1024 + k) * 4 + j] : (j < 36 ? a->in[I_MWRE][(size_t)(l * 1024 + k) * 32 + (j - 4)] : 0.f); } }
    { bf16* RW = (bf16*)(ws + WS_R1W);
      for (int idx = (vcu * NTHR + tid); idx < 2 * 98304 + 24576; idx += G * NTHR) { float v;
          if (idx < 2 * 98304) { const int l = idx / 98304, r = idx % 98304;
              if (r < 24576)      v = a->in[I_RWUP][(size_t)l * 64 * DBR + (r & 63) * DBR + (r >> 6)];
              else if (r < 49152) v = a->in[I_RAUP][(size_t)l * 64 * DBR + ((r - 24576) & 63) * DBR + ((r - 24576) >> 6)];
              else                v = a->in[I_RGUP][(size_t)l * 128 * DBR + ((r - 49152) & 127) * DBR + ((r - 49152) >> 7)];
          } else { const int r = idx - 2 * 98304;
              if (r < 12288) v = a->in[I_RVDN][(size_t)(r % 384) * 32 + (r / 384)];
              else           v = a->in[I_RVUP][(size_t)((r - 12288) & 31) * DBR + ((r - 12288) >> 5)]; }
          RW[idx] = (bf16)f2bf(v); } }
    for (int idx = (vcu * NTHR + tid); idx < 2 * 16 * 64; idx += G * NTHR) { const int p = idx & 63, lg = idx >> 6;
        const float lam_re = a->in[I_S5ARE][idx], lam_im = a->in[I_S5AIM][idx]; const float dt = expf(a->in[I_S5LDT][lg]); const float mag = expf(lam_re * dt), ang = lam_im * dt;
        const float are = mag * cosf(ang), aim = mag * sinf(ang); const float inv = 1.f / (lam_re * lam_re + lam_im * lam_im);
        const float cre = ((are - 1.f) * lam_re + aim * lam_im) * inv, cim = (aim * lam_re - (are - 1.f) * lam_im) * inv;
        ((float*)(ws + WS_S5AP))[idx * 2] = are; ((float*)(ws + WS_S5AP))[idx * 2 + 1] = aim;
        const float* br = a->in[I_S5BRE] + (size_t)idx * 16; const float* bi = a->in[I_S5BIM] + (size_t)idx * 16; bf16* o = (bf16*)(ws + WS_S5BB) + ((size_t)lg * 128 + 2 * p) * 16;
        for (int c = 0; c < 16; ++c) { o[c] = (bf16)f2bf(cre * br[c] - cim * bi[c]); o[16 + c] = (bf16)f2bf(cre * bi[c] + cim * br[c]); } }
    { bf16* CM = (bf16*)(ws + WS_S5CM);
      for (int idx = (vcu * NTHR + tid); idx < 2 * 16 * 16 * 128; idx += G * NTHR) { const int k = idx & 127, lgc = idx >> 7;
          CM[idx] = (bf16)f2bf((k & 1) ? -a->in[I_S5CIM][(size_t)lgc * 64 + (k >> 1)] : a->in[I_S5CRE][(size_t)lgc * 64 + (k >> 1)]); } }
    for (int it = gw; it < 2 * 16; it += NGW) { const int l = it >> 4, r = it & 15;
        transpose_item(a->in[I_S5GLUW] + (size_t)l * DC * DC, DC, DC, 64 * (r >> 2), 64 * (r & 3), (bf16*)(ws + WS_GLUT) + (size_t)l * DC * DC, DC, scr, lane, RmId{}); }
    { bf16* MLW = (bf16*)(ws + WS_MLW);
      for (int idx = (vcu * NTHR + tid); idx < 2 * NH * 2 * 4096; idx += G * NTHR) { const int d = idx & 63, e = (idx >> 6) & 63, which = (idx >> 12) & 1, lh = idx >> 13;
          MLW[idx] = (bf16)f2bf(a->in[which ? I_WK : I_WQ][(size_t)lh * 4096 + d * 64 + e]); } }
    __syncthreads();
    if (vcu < 192) {
        const int q = vcu, l = q / 96, cb = (q >> 3) % 12, kc = q & 7;
        LAS float* cond = (LAS float*)lds;
        { const int b = tid >> 7, kk = tid & 127; const float cv = a->in[I_C][b * DM + kc * 128 + kk]; cond[tid] = cv / (1.f + __expf(-cv)); }
        __syncthreads();
        const int col = cb * 512 + tid; const float* wp = a->in[I_ADA_W] + ((size_t)l * DM + kc * 128) * 6144 + col;
        float acc0 = 0.f, acc1 = 0.f, acc2 = 0.f, acc3 = 0.f;
#pragma unroll 8
        for (int kk = 0; kk < 128; ++kk) { const float w = wp[(size_t)kk * 6144]; acc0 += cond[kk] * w; acc1 += cond[128 + kk] * w; acc2 += cond[256 + kk] * w; acc3 += cond[384 + kk] * w; }
        const float bias = (kc == 0) ? a->in[I_ADA_B][l * 6144 + col] : 0.f;
        float* MP = (float*)(ws + WS_MODP) + ((size_t)(kc * 2 + l) * 4) * 6144 + col;
        MP[0] = acc0 + bias; MP[6144] = acc1 + bias; MP[2 * 6144] = acc2 + bias; MP[3 * 6144] = acc3 + bias;
    }
}

__device__ __forceinline__ float modval(const unsigned char* ws, bool part, int l, int b, int idx) {
    if (!part) return ((const float*)(ws + WS_MODF))[(size_t)(l * 4 + b) * 6144 + idx];
    const float* mp = (const float*)(ws + WS_MODP) + (size_t)(l * 4 + b) * 6144 + idx; float s = 0.f;
#pragma unroll
    for (int kc = 0; kc < 8; ++kc) s += mp[(size_t)kc * 2 * 4 * 6144];
    return s;
}
template <int MODE, bool COMBINE>
__device__ __forceinline__ void phase_rownorm(KArgsP a, LAS unsigned char* lds, int tid, int lane, int wave, int G,
                                              const float* xsrc, float* xdst, const float* gvec, bool part, int l, int isc  , int lprev) {
    unsigned char* ws = a->ws;
    LAS float* sc = (LAS float*)lds; LAS float* sh = sc + 1024; LAS float* gt = sh + 1024;
    bf16* HN = (bf16*)(ws + WS_HN); const bf16* YM = (const bf16*)(ws + WS_YMOE); const float* TW = (const float*)(ws + WS_TOKW);
    for (int c = blockIdx.x; c < NTOK / 128; c += G) {
        const int b = c >> 6;
        __syncthreads();
        for (int j = tid; j < 1024; j += NTHR) {
            if (MODE == 0) { sc[j] = gvec[j] * (1.f + modval(ws, part, l, b, (isc + 1) * 1024 + j)); sh[j] = modval(ws, part, l, b, isc * 1024 + j); }
            else { sc[j] = gvec[j]; sh[j] = 0.f; }
            if (COMBINE) gt[j] = 1.f + modval(ws, false, lprev, b, 5 * 1024 + j);
        }
        __syncthreads();
        f32x4 vn[4]; v2u yn0[4], yn1[4]; float wn0 = 0.f, wn1 = 0.f;
        { const int row = c * 128 + wave * 16; const GAS f32x4* xr = (const GAS f32x4*)(xsrc + (size_t)row * DM) + lane;
#pragma unroll
          for (int j = 0; j < 4; ++j) vn[j] = xr[64 * j];
          if (COMBINE) { wn0 = TW[2 * row]; wn1 = TW[2 * row + 1]; const GAS v2u* y0 = (const GAS v2u*)(YM + (size_t)(2 * row) * DM) + lane; const GAS v2u* y1 = (const GAS v2u*)(YM + (size_t)(2 * row + 1) * DM) + lane;
#pragma unroll
              for (int j = 0; j < 4; ++j) { yn0[j] = y0[64 * j]; yn1[j] = y1[64 * j]; } } }
        for (int i = 0; i < 16; ++i) {
            const int row = c * 128 + wave * 16 + i;
            f32x4 v[4]; v2u q0[4], q1[4]; const float w0 = wn0, w1 = wn1;
#pragma unroll
            for (int j = 0; j < 4; ++j) { v[j] = vn[j]; q0[j] = yn0[j]; q1[j] = yn1[j]; }
            if (i + 1 < 16) { const int rn = row + 1; const GAS f32x4* xr = (const GAS f32x4*)(xsrc + (size_t)rn * DM) + lane;
#pragma unroll
                for (int j = 0; j < 4; ++j) vn[j] = xr[64 * j];
                if (COMBINE) { wn0 = TW[2 * rn]; wn1 = TW[2 * rn + 1]; const GAS v2u* y0 = (const GAS v2u*)(YM + (size_t)(2 * rn) * DM) + lane; const GAS v2u* y1 = (const GAS v2u*)(YM + (size_t)(2 * rn + 1) * DM) + lane;
#pragma unroll
                    for (int j = 0; j < 4; ++j) { yn0[j] = y0[64 * j]; yn1[j] = y1[64 * j]; } } }
            if (COMBINE) {
#pragma unroll
                for (int j = 0; j < 4; ++j) { const v2u p0 = q0[j], p1 = q1[j]; const f32x4 g4 = *(const LAS f32x4*)(gt + lane * 4 + 256 * j);
                    f32x4 m; m.x = w0 * bflo(p0.x) + w1 * bflo(p1.x); m.y = w0 * bfhi(p0.x) + w1 * bfhi(p1.x); m.z = w0 * bflo(p0.y) + w1 * bflo(p1.y); m.w = w0 * bfhi(p0.y) + w1 * bfhi(p1.y);
                    v[j] = v[j] + g4 * m; }
                if (MODE == 0) { GAS f32x4* xo = (GAS f32x4*)(xdst + (size_t)row * DM) + lane;
#pragma unroll
                    for (int j = 0; j < 4; ++j) xo[64 * j] = v[j]; }
            }
            float ss = 0.f;
#pragma unroll
            for (int j = 0; j < 4; ++j) ss += (v[j].x * v[j].x + v[j].y * v[j].y) + (v[j].z * v[j].z + v[j].w * v[j].w);
            const float rstd = rsqrtf(wave_sum(ss) * (1.f / DM) + NORM_EPS);
            if (MODE == 0) {
                GAS v2u* o = (GAS v2u*)(HN + (size_t)row * DM) + lane;
#pragma unroll
                for (int j = 0; j < 4; ++j) { const f32x4 s4 = *(const LAS f32x4*)(sc + lane * 4 + 256 * j), h4 = *(const LAS f32x4*)(sh + lane * 4 + 256 * j); const f32x4 h = v[j] * rstd * s4 + h4;
                    v2u w; w.x = pk2(h.x, h.y); w.y = pk2(h.z, h.w); o[64 * j] = w; }
            } else {
                GAS f32x4* o = (GAS f32x4*)(xdst + (size_t)row * DM) + lane;
#pragma unroll
                for (int j = 0; j < 4; ++j) { const f32x4 s4 = *(const LAS f32x4*)(sc + lane * 4 + 256 * j); o[64 * j] = v[j] * rstd * s4; }
            }
        }
    }
}
__device__ __forceinline__ void mod_finalize(unsigned char* ws, int tid, int G) {
    float* MF = (float*)(ws + WS_MODF);
    for (int idx = blockIdx.x * NTHR + tid; idx < 2 * 4 * 6144; idx += G * NTHR) { const float* mp = (const float*)(ws + WS_MODP) + idx; float s = 0.f;
#pragma unroll
        for (int kc = 0; kc < 8; ++kc) s += mp[(size_t)kc * 2 * 4 * 6144];
        MF[idx] = s; }
}

typedef float f32x4m __attribute__((ext_vector_type(4)));
__device__ __forceinline__ void phase_router(KArgsP a, LAS unsigned char* lds, int tid, int lane, int wave, int G, int l) {
    unsigned char* ws = a->ws;
    LAS float* sc = (LAS float*)lds; LAS float* sh = sc + 1024; LAS float* rstd_s = sh + 1024  ; LAS float* cvec = rstd_s + 128  ; LAS float* cpart = cvec + 64  ;
    LAS float* lg = cpart + 8 * 48  ; LAS int* hist = (LAS int*)(lg + 8 * 16 * 48)  ; LAS int* basev = hist + 32; LAS int* asg_e = basev + 32  ; LAS int* asg_lp = asg_e + 256;
    bf16* HN = (bf16*)(ws + WS_HN); const float* x = a->out; const float* RTW = (const float*)(ws + WS_RTW) + (size_t)l * 1024 * 48;
    int* TOKE = (int*)(ws + WS_TOKE); float* TOKW = (float*)(ws + WS_TOKW); int* LIST = (int*)(ws + WS_LIST); unsigned* CNT = (unsigned*)(ws + WS_CTL) + CW_CNT + l * 32;
    const float* gvec = a->in[I_NORM_FFN] + l * DM;
    for (int c = blockIdx.x; c < NTOK / 128; c += G) {
        const int b = c >> 6;
        __syncthreads();
        for (int j = tid; j < 1024; j += NTHR) { sc[j] = gvec[j] * (1.f + modval(ws, false, l, b, 4 * 1024 + j)); sh[j] = modval(ws, false, l, b, 3 * 1024 + j); }
        if (tid < 32) hist[tid] = 0;
        __syncthreads();
        if (tid < 384) { const int j = tid % 48, part = tid / 48; float s = 0.f;
            for (int k = part * 128; k < part * 128 + 128; ++k) s += sh[k] * RTW[(size_t)k * 48 + j];
            cpart[part * 48 + j] = s; }
        { f32x4 vn[4];
          { const GAS f32x4* xr = (const GAS f32x4*)(x + (size_t)(c * 128 + wave * 16) * DM) + lane;
#pragma unroll
            for (int j = 0; j < 4; ++j) vn[j] = xr[64 * j]; }
          for (int i = 0; i < 16; ++i) {
            const int row = c * 128 + wave * 16 + i;
            f32x4 v[4]; float ss = 0.f;
#pragma unroll
            for (int j = 0; j < 4; ++j) { v[j] = vn[j]; ss += (v[j].x * v[j].x + v[j].y * v[j].y) + (v[j].z * v[j].z + v[j].w * v[j].w); }
            if (i + 1 < 16) { const GAS f32x4* xr = (const GAS f32x4*)(x + (size_t)(row + 1) * DM) + lane;
#pragma unroll
                for (int j = 0; j < 4; ++j) vn[j] = xr[64 * j]; }
            const float rstd = rsqrtf(wave_sum(ss) * (1.f / DM) + NORM_EPS);
            if (lane == 0) rstd_s[wave * 16 + i] = rstd;
            GAS v2u* o = (GAS v2u*)(HN + (size_t)row * DM) + lane;
#pragma unroll
            for (int j = 0; j < 4; ++j) { const f32x4 s4 = *(const LAS f32x4*)(sc + lane * 4 + 256 * j), h4 = *(const LAS f32x4*)(sh + lane * 4 + 256 * j); const f32x4 h = v[j] * rstd * s4 + h4;
                v2u w; w.x = pk2(h.x, h.y); w.y = pk2(h.z, h.w); o[64 * j] = w; }
          } }
        __syncthreads();
        if (tid < 48) { float s = 0.f;
#pragma unroll
            for (int p = 0; p < 8; ++p) s += cpart[p * 48 + tid];
            s += tid < 4 ? a->in[I_MBRG][l * 4 + tid] : (tid < 36 ? a->in[I_MBRE][l * 32 + tid - 4] : 0.f); cvec[tid] = s; }
        {
            const int i16 = lane & 15, kq = lane >> 4, r0 = c * 128 + wave * 16;
            f32x4m acc0 = {0.f, 0.f, 0.f, 0.f}, acc1 = acc0, acc2 = acc0;
            const float* xrow = x + (size_t)(r0 + i16) * DM + 4 * kq;
            for (int k0 = 0; k0 < DM; k0 += 16) {
                const f32x4 xv = *(const GAS f32x4*)(xrow + k0); const f32x4 sv = *(const LAS f32x4*)(sc + k0 + 4 * kq);
                const float* wp = RTW + (size_t)(k0 + 4 * kq) * 48 + i16;
#pragma unroll
                for (int j = 0; j < 4; ++j) { const float av = xv[j] * sv[j];
                    acc0 = __builtin_amdgcn_mfma_f32_16x16x4f32(av, wp[j * 48], acc0, 0, 0, 0);
                    acc1 = __builtin_amdgcn_mfma_f32_16x16x4f32(av, wp[j * 48 + 16], acc1, 0, 0, 0);
                    acc2 = __builtin_amdgcn_mfma_f32_16x16x4f32(av, wp[j * 48 + 32], acc2, 0, 0, 0); }
            }
            __syncthreads();
            LAS float* lw = lg + wave * 16 * 48;
#pragma unroll
            for (int r = 0; r < 4; ++r) { const int rr = 4 * kq + r; const float rs = rstd_s[wave * 16 + rr];
                lw[rr * 48 + i16] = acc0[r] * rs + cvec[i16]; lw[rr * 48 + 16 + i16] = acc1[r] * rs + cvec[16 + i16]; lw[rr * 48 + 32 + i16] = acc2[r] * rs + cvec[32 + i16]; }
            LDS_WAIT(); asm volatile("" ::: "memory");
            if (lane < 16) {
                const LAS float* lr = lw + lane * 48; const int row = r0 + lane;
                float g0 = lr[0], g1 = lr[1], g2 = lr[2], g3 = lr[3]; const float gm = fmaxf(fmaxf(g0, g1), fmaxf(g2, g3));
                float p0 = __expf(g0 - gm), p1 = __expf(g1 - gm), p2 = __expf(g2 - gm), p3 = __expf(g3 - gm); const float inv = 1.f / (p0 + p1 + p2 + p3);
                p0 *= inv; p1 *= inv; p2 *= inv; p3 *= inv;
                int gi = 0; float gp = p0; if (p1 > gp) { gp = p1; gi = 1; } if (p2 > gp) { gp = p2; gi = 2; } if (p3 > gp) { gp = p3; gi = 3; }
                float ev0 = -3.4e38f, ev1 = -3.4e38f; int e0 = 0, e1 = 0;
#pragma unroll
                for (int j = 0; j < 8; ++j) { const float s = lr[4 + gi * 8 + j]; if (s > ev0) { ev1 = ev0; e1 = e0; ev0 = s; e0 = j; } else if (s > ev1) { ev1 = s; e1 = j; } }
                const float q = __expf(ev1 - ev0), w0 = gp / (1.f + q), w1 = gp * q / (1.f + q);
                e0 += gi * 8; e1 += gi * 8;
                TOKE[2 * row] = e0; TOKE[2 * row + 1] = e1; TOKW[2 * row] = w0; TOKW[2 * row + 1] = w1;
                const int a0 = 2 * (wave * 16 + lane);
                asg_e[a0] = e0; asg_e[a0 + 1] = e1; asg_lp[a0] = atomicAdd((int*)&hist[e0], 1); asg_lp[a0 + 1] = atomicAdd((int*)&hist[e1], 1);
            }
        }
        __syncthreads();
        if (tid < 32) { const int h = hist[tid]; basev[tid] = h ? (int)atomicAdd(CNT + tid, (unsigned)h) : 0; }
        __syncthreads();
        if (tid < 256) { const int e = asg_e[tid]; LIST[(size_t)e * 65536 + basev[e] + asg_lp[tid]] = (c * 128) * 2 + tid; }
    }
}
__device__ __forceinline__ void build_ptab(const unsigned* CNT, LAS int* ptab, LAS int* pst, LAS int* cnt, int tid) {
    __syncthreads();
    if (tid == 0) { int np = 0;
        for (int e = 0; e < NEXP; ++e) { const int ce = (int)__hip_atomic_load(CNT + e, RLX_AGENT); cnt[e] = ce; pst[e] = np * 256; const int pe = (ce + 255) >> 8;
            for (int p = 0; p < pe; ++p) ptab[1 + np + p] = e;
            np += pe; }
        ptab[0] = np; }
    __syncthreads();
}
__device__ __forceinline__ void phase_gather(KArgsP a, LAS unsigned char* lds, int tid, int lane, int wave, int vcu, int G, int l) {
    unsigned char* ws = a->ws;
    LAS int* ptab = (LAS int*)lds; LAS int* pst = ptab + 512; LAS int* cnt = pst + 32;
    build_ptab((const unsigned*)(ws + WS_CTL) + CW_CNT + l * 32, ptab, pst, cnt, tid);
    const bf16* HN = (const bf16*)(ws + WS_HN); bf16* XG = (bf16*)(ws + WS_XG); int* ROWMAP = (int*)(ws + WS_ROWMAP); const int* LIST = (const int*)(ws + WS_LIST);
    const int nrows = ptab[0] * 256;
    for (int row0 = (vcu * NWAVES + wave) * 8; row0 < nrows; row0 += G * NWAVES * 8) {
        int tok2[8]; v4u p0[8], p1[8];
#pragma unroll
        for (int j = 0; j < 8; ++j) { const int row = row0 + j, e = ptab[1 + (row >> 8)], pos = row - pst[e]; tok2[j] = (pos < cnt[e]) ? LIST[(size_t)e * 65536 + pos] : -1; }
#pragma unroll
        for (int j = 0; j < 8; ++j) { if (tok2[j] >= 0) { const GAS v4u* s = (const GAS v4u*)(HN + (size_t)(tok2[j] >> 1) * DM) + lane; p0[j] = s[0]; p1[j] = s[64]; } else { p0[j] = (v4u){0u, 0u, 0u, 0u}; p1[j] = p0[j]; } }
#pragma unroll
        for (int j = 0; j < 8; ++j) { GAS v4u* d = (GAS v4u*)(XG + (size_t)(row0 + j) * DM) + lane; d[0] = p0[j]; d[64] = p1[j]; if (lane == 0) ROWMAP[row0 + j] = tok2[j]; }
    }
}

__device__ __forceinline__ void phase_rowmap(KArgsP a, LAS unsigned char* lds, int tid, int vcu, int G, int l) {
    unsigned char* ws = a->ws;
    LAS int* ptab = (LAS int*)lds; LAS int* pst = ptab + 512; LAS int* cnt = pst + 32;
    build_ptab((const unsigned*)(ws + WS_CTL) + CW_CNT + l * 32, ptab, pst, cnt, tid);
    int* ROWMAP = (int*)(ws + WS_ROWMAP); const int* LIST = (const int*)(ws + WS_LIST);
    const int nrows = ptab[0] * 256;
    for (int row = vcu * NTHR + tid; row < nrows; row += G * NTHR) { const int e = ptab[1 + (row >> 8)], pos = row - pst[e]; ROWMAP[row] = (pos < cnt[e]) ? LIST[(size_t)e * 65536 + pos] : -1; }
}

typedef short bf16x8 __attribute__((ext_vector_type(8)));
constexpr int MT = 72;
constexpr int ML_XP = 0;
constexpr int ML_CX = 17152;
constexpr int ML_WQ = ML_CX + 9216, ML_WK = ML_WQ + 9216;
constexpr int ML_Q = ML_WK + 9216, ML_K = ML_Q + 9216;
constexpr int ML_S = ML_K + 9216;
constexpr int ML_VT = ML_S + 9216;
constexpr int ML_CT = ML_VT + 11520;
constexpr int ML_H = ML_CT + 11520;
constexpr int ML_SM = ML_H + 16640;
static_assert(ML_SM + 2048 <= RING_BYTES, "mLSTM LDS map");
__device__ __forceinline__ float logsigmoidf_(float x) { return fminf(x, 0.f) - log1pf(__expf(-fabsf(x))); }
__device__ __forceinline__ void mma64(const LAS bf16* A, int arow0, const LAS bf16* Bt, int brow0, int lane, f32x4& acc) {
    const LAS bf16* ap = A + (arow0 + (lane & 15)) * MT + 8 * (lane >> 4); const LAS bf16* bp = Bt + (brow0 + (lane & 15)) * MT + 8 * (lane >> 4);
    const bf16x8 a0 = *(const LAS bf16x8*)ap, a1 = *(const LAS bf16x8*)(ap + 32), b0 = *(const LAS bf16x8*)bp, b1 = *(const LAS bf16x8*)(bp + 32);
    acc = __builtin_amdgcn_mfma_f32_16x16x32_bf16(a0, b0, acc, 0, 0, 0); acc = __builtin_amdgcn_mfma_f32_16x16x32_bf16(a1, b1, acc, 0, 0, 0);
}
__device__ __forceinline__ void ml_front(KArgsP a, LAS unsigned char* lds, int tid, int l, int b, int c, int h, bool want_q) {
    const bf16* PROJ = (const bf16*)(a->ws + WS_PROJ); const size_t row0 = (size_t)b * SEQ + c * 64;
    LAS float* xp = (LAS float*)(lds + ML_XP);
    for (int idx = tid; idx < 67 * 8; idx += NTHR) { const int r = idx >> 3, c8 = idx & 7, tr = c * 64 + r - 3; LAS float* d = xp + r * 64 + c8 * 8;
        if (tr >= 0) { const v4u p = *(const GAS v4u*)(PROJ + ((size_t)b * SEQ + tr) * NPROJ + PC_QK + h * 64 + c8 * 8);
            *(LAS f32x4*)d = (f32x4){bflo(p.x), bfhi(p.x), bflo(p.y), bfhi(p.y)}; *(LAS f32x4*)(d + 4) = (f32x4){bflo(p.z), bfhi(p.z), bflo(p.w), bfhi(p.w)}; }
        else { *(LAS f32x4*)d = (f32x4){0.f, 0.f, 0.f, 0.f}; *(LAS f32x4*)(d + 4) = (f32x4){0.f, 0.f, 0.f, 0.f}; } }
    {
        const int t = tid >> 3, vg = tid & 7; LAS bf16* VT = (LAS bf16*)(lds + ML_VT);
        const v4u p = *(const GAS v4u*)(PROJ + (row0 + t) * NPROJ + PC_V + h * 64 + vg * 8);
        const unsigned w[4] = {p.x, p.y, p.z, p.w};
#pragma unroll
        for (int j = 0; j < 4; ++j) { VT[(vg * 8 + 2 * j) * MT + t] = (bf16)(w[j] & 0xffffu); VT[(vg * 8 + 2 * j + 1) * MT + t] = (bf16)(w[j] >> 16); }
        for (int idx = tid; idx < 16 * 64; idx += NTHR) VT[(64 + (idx >> 6)) * MT + (idx & 63)] = (idx < 64) ? (bf16)0x3F80 : (bf16)0;
        const bf16* WT = (const bf16*)(a->ws + WS_MLW) + (size_t)((l * NH + h) * 2) * 4096;
        const int e = tid >> 3, d8 = tid & 7;
        if (want_q) *(LAS v4u*)(lds + ML_WQ + (e * MT + d8 * 8) * 2) = *(const GAS v4u*)(WT + e * 64 + d8 * 8);
        *(LAS v4u*)(lds + ML_WK + (e * MT + d8 * 8) * 2) = *(const GAS v4u*)(WT + 4096 + e * 64 + d8 * 8);
    }
    __syncthreads();
    const float* cw = a->in[I_CONV_W] + (size_t)l * 4 * DA + h * 64; const float* cb = a->in[I_CONV_B] + (size_t)l * DA + h * 64;
    {
        const int t = tid >> 3, c8 = (tid & 7) * 8; float s[8];
#pragma unroll
        for (int j = 0; j < 8; ++j) s[j] = cb[c8 + j];
#pragma unroll
        for (int q = 0; q < 4; ++q) { const f32x4 x0 = *(const LAS f32x4*)(xp + (t + q) * 64 + c8), x1 = *(const LAS f32x4*)(xp + (t + q) * 64 + c8 + 4); const float* w = cw + q * DA + c8;
            s[0] += x0.x * w[0]; s[1] += x0.y * w[1]; s[2] += x0.z * w[2]; s[3] += x0.w * w[3]; s[4] += x1.x * w[4]; s[5] += x1.y * w[5]; s[6] += x1.z * w[6]; s[7] += x1.w * w[7]; }
#pragma unroll
        for (int j = 0; j < 8; ++j) s[j] = s[j] / (1.f + __expf(-s[j]));
        v4u o; o.x = pk2(s[0], s[1]); o.y = pk2(s[2], s[3]); o.z = pk2(s[4], s[5]); o.w = pk2(s[6], s[7]);
        *(LAS v4u*)(lds + ML_CX + (t * MT + c8) * 2) = o;
    }
}
__device__ __forceinline__ void phase_m1(KArgsP a, LAS unsigned char* lds, int tid, int lane, int wave, int vcu, int G, int l) {
    unsigned char* ws = a->ws; const float* GT = (const float*)(ws + WS_GATES);
    float* CLOC = (float*)(ws + WS_CLOC); float* MLG = (float*)(ws + WS_MSC); float* MLM = MLG + 4096;
    LAS float* sm = (LAS float*)(lds + ML_SM);
    for (int u = vcu; u < NUNIT_M; u += G) {
        const int h = u % NH, c = (u / NH) % NCH, b = u / (NH * NCH); const size_t row0 = (size_t)b * SEQ + c * 64;
        __syncthreads();
        ml_front(a, lds, tid, l, b, c, h, false);
        if (wave == 0) {
            const float ig = GT[(row0 + lane) * 16 + h] + a->in[I_BI][l * NH + h];
            const float fl = logsigmoidf_(GT[(row0 + lane) * 16 + 6 + h] + a->in[I_BF][l * NH + h]);
            float bc = fl;
#pragma unroll
            for (int o = 1; o < 64; o <<= 1) { const float t = __shfl_up(bc, o); if (lane >= o) bc += t; }
            const float gtot = __shfl(bc, 63); const float lw = gtot - bc + ig; const float ml = wave_max(lw);
            sm[lane] = __expf(lw - ml);
            if (lane == 0) { MLG[u] = gtot; MLM[u] = ml; }
        }
        __syncthreads();
        {
            const int rt = wave >> 1; LAS bf16* KT = (LAS bf16*)(lds + ML_K);
#pragma unroll
            for (int q = 0; q < 2; ++q) { const int ct = 2 * (wave & 1) + q; f32x4 acc = {0.f, 0.f, 0.f, 0.f};
                mma64((const LAS bf16*)(lds + ML_CX), 16 * rt, (const LAS bf16*)(lds + ML_WK), 16 * ct, lane, acc);
                const int t0 = 16 * rt + 4 * (lane >> 4), e = 16 * ct + (lane & 15);
                const float w0 = sm[t0] * 0.125f, w1 = sm[t0 + 1] * 0.125f, w2 = sm[t0 + 2] * 0.125f, w3 = sm[t0 + 3] * 0.125f;
                v2u o; o.x = pk2(acc[0] * w0, acc[1] * w1); o.y = pk2(acc[2] * w2, acc[3] * w3);
                *(LAS v2u*)(KT + e * MT + t0) = o; }
        }
        __syncthreads();
        {
            const int ct = wave & 3, r_lo = wave < 4 ? 0 : 3, r_hi = wave < 4 ? 3 : 5; float* cl = CLOC + (size_t)u * CL_STRIDE;
            for (int rt = r_lo; rt < r_hi; ++rt) { f32x4 acc = {0.f, 0.f, 0.f, 0.f};
                mma64((const LAS bf16*)(lds + ML_VT), 16 * rt, (const LAS bf16*)(lds + ML_K), 16 * ct, lane, acc);
                const int v0 = 16 * rt + 4 * (lane >> 4), e = 16 * ct + (lane & 15);
                if (rt < 4) {
#pragma unroll
                    for (int r = 0; r < 4; ++r) cl[(v0 + r) * 64 + e] = acc[r];
                } else if ((lane >> 4) == 0) cl[4096 + e] = acc[0]; }
        }
    }
}
__device__ __forceinline__ void phase_m2(unsigned char* ws, int tid, int wg, int nwg) {
    float* CLOC = (float*)(ws + WS_CLOC); const float* MLG = (const float*)(ws + WS_MSC); const float* MLM = MLG + 4096; float* MST = (float*)(ws + WS_MSC) + 8192;
    for (int idx = wg * NTHR + tid; idx < NB * NH * CL_STRIDE; idx += nwg * NTHR) {
        const int e = idx % CL_STRIDE, bh = idx / CL_STRIDE, b = bh / NH, h = bh % NH;
        float m = 0.f, cs = 0.f;
        for (int c0 = 0; c0 < NCH; c0 += 8) {
            float cl[8], g[8], ml[8];
#pragma unroll
            for (int j = 0; j < 8; ++j) { const int u = (b * NCH + c0 + j) * NH + h; cl[j] = CLOC[(size_t)u * CL_STRIDE + e]; g[j] = MLG[u]; ml[j] = MLM[u]; }
#pragma unroll
            for (int j = 0; j < 8; ++j) { const int u = (b * NCH + c0 + j) * NH + h;
                CLOC[(size_t)u * CL_STRIDE + e] = cs; if (e == 0) MST[u] = m;
                const float mn = fmaxf(g[j] + m, ml[j]); const float ao = __expf(g[j] + m - mn), al = __expf(ml[j] - mn);
                cs = ao * cs + al * cl[j]; m = mn; }
        }
    }
}
__device__ __forceinline__ void phase_m3(KArgsP a, LAS unsigned char* lds, int tid, int lane, int wave, int vcu, int G, int l) {
    unsigned char* ws = a->ws; const bf16* PROJ = (const bf16*)(ws + WS_PROJ); const float* GT = (const float*)(ws + WS_GATES);
    const float* CLOC = (const float*)(ws + WS_CLOC); const float* MST = (const float*)(ws + WS_MSC) + 8192; bf16* YC = (bf16*)(ws + WS_YC);
    LAS float* sm = (LAS float*)(lds + ML_SM); LAS float* hb = (LAS float*)(lds + ML_H);
    for (int u = vcu; u < NUNIT_M; u += G) {
        const int h = u % NH, c = (u / NH) % NCH, b = u / (NH * NCH); const size_t row0 = (size_t)b * SEQ + c * 64;
        __syncthreads();
        ml_front(a, lds, tid, l, b, c, h, true);
        {
            const float* cl = CLOC + (size_t)u * CL_STRIDE; LAS bf16* CT = (LAS bf16*)(lds + ML_CT);
            for (int idx = tid; idx < 65 * 16; idx += NTHR) { const int r = idx >> 4, c4 = idx & 15; const f32x4 v = *(const GAS f32x4*)(cl + r * 64 + c4 * 4);
                v2u o; o.x = pk2(v.x, v.y); o.y = pk2(v.z, v.w); *(LAS v2u*)(CT + r * MT + c4 * 4) = o; }
            for (int idx = tid; idx < 15 * 64; idx += NTHR) CT[(65 + (idx >> 6)) * MT + (idx & 63)] = 0;
        }
        if (wave == 0) {
            const float ig = GT[(row0 + lane) * 16 + h] + a->in[I_BI][l * NH + h];
            const float fl = logsigmoidf_(GT[(row0 + lane) * 16 + 6 + h] + a->in[I_BF][l * NH + h]);
            float bc = fl;
#pragma unroll
            for (int o = 1; o < 64; o <<= 1) { const float t = __shfl_up(bc, o); if (lane >= o) bc += t; }
            float pm = ig - bc;
#pragma unroll
            for (int o = 1; o < 64; o <<= 1) { const float t = __shfl_up(pm, o); if (lane >= o) pm = fmaxf(pm, t); }
            const float mst = MST[u]; const float inter = bc + mst, mt = fmaxf(inter, bc + pm);
            sm[lane] = ig - bc; sm[64 + lane] = bc - mt; sm[128 + lane] = __expf(inter - mt); sm[192 + lane] = __expf(-mt);
        }
        __syncthreads();
        {
            const int rt = wave >> 1; LAS bf16* Qs = (LAS bf16*)(lds + ML_Q); LAS bf16* Ks = (LAS bf16*)(lds + ML_K);
#pragma unroll
            for (int q = 0; q < 2; ++q) { const int ct = 2 * (wave & 1) + q; f32x4 aq = {0.f, 0.f, 0.f, 0.f}, ak = {0.f, 0.f, 0.f, 0.f};
                mma64((const LAS bf16*)(lds + ML_CX), 16 * rt, (const LAS bf16*)(lds + ML_WQ), 16 * ct, lane, aq);
                mma64((const LAS bf16*)(lds + ML_CX), 16 * rt, (const LAS bf16*)(lds + ML_WK), 16 * ct, lane, ak);
                const int t0 = 16 * rt + 4 * (lane >> 4), e = 16 * ct + (lane & 15);
#pragma unroll
                for (int r = 0; r < 4; ++r) { Qs[(t0 + r) * MT + e] = (bf16)f2bf(aq[r]); Ks[(t0 + r) * MT + e] = (bf16)f2bf(ak[r] * 0.125f); } }
        }
        __syncthreads();
        {
            const int rt = wave >> 1; LAS bf16* Ss = (LAS bf16*)(lds + ML_S);
#pragma unroll
            for (int q = 0; q < 2; ++q) { const int ct = 2 * (wave & 1) + q; f32x4 acc = {0.f, 0.f, 0.f, 0.f};
                if (ct <= rt) mma64((const LAS bf16*)(lds + ML_Q), 16 * rt, (const LAS bf16*)(lds + ML_K), 16 * ct, lane, acc);
                const int t0 = 16 * rt + 4 * (lane >> 4), s = 16 * ct + (lane & 15); const float qs = sm[s];
#pragma unroll
                for (int r = 0; r < 4; ++r) { const int t = t0 + r; Ss[t * MT + s] = (bf16)f2bf((s <= t) ? acc[r] * __expf(sm[64 + t] + qs) : 0.f); } }
        }
        __syncthreads();
        {
            const int rt = wave >> 1, nt = (wave & 1) ? 2 : 3;
            for (int q = 0; q < nt; ++q) { const int ct = (wave & 1) ? 2 + q : (q < 2 ? q : 4); f32x4 aA = {0.f, 0.f, 0.f, 0.f}, aB = {0.f, 0.f, 0.f, 0.f};
                mma64((const LAS bf16*)(lds + ML_Q), 16 * rt, (const LAS bf16*)(lds + ML_CT), 16 * ct, lane, aA);
                mma64((const LAS bf16*)(lds + ML_S), 16 * rt, (const LAS bf16*)(lds + ML_VT), 16 * ct, lane, aB);
                const int t0 = 16 * rt + 4 * (lane >> 4), v = 16 * ct + (lane & 15);
#pragma unroll
                for (int r = 0; r < 4; ++r) { const int t = t0 + r; const float x = sm[128 + t] * aA[r] + aB[r];
                    if (ct < 4) hb[t * 65 + v] = x; else if ((lane & 15) == 0) sm[256 + t] = x; } }
        }
        __syncthreads();
        {
            const int t = tid >> 3, vg = tid & 7; float acc[8];
            const float dn = 1.f / fmaxf(fabsf(sm[256 + t]), sm[192 + t]);
            float s1 = 0.f;
#pragma unroll
            for (int j = 0; j < 8; ++j) { acc[j] = hb[t * 65 + vg * 8 + j] * dn; s1 += acc[j]; }
            s1 += __shfl_xor(s1, 1); s1 += __shfl_xor(s1, 2); s1 += __shfl_xor(s1, 4);
            const float mu = s1 * (1.f / 64.f); float s2 = 0.f;
#pragma unroll
            for (int j = 0; j < 8; ++j) { acc[j] -= mu; s2 += acc[j] * acc[j]; }
            s2 += __shfl_xor(s2, 1); s2 += __shfl_xor(s2, 2); s2 += __shfl_xor(s2, 4);
            const float rs = rsqrtf(s2 * (1.f / 64.f) + HEAD_NORM_EPS);
            const float* nw = a->in[I_MNORM_W] + (size_t)l * DA + h * 64 + vg * 8;
            const v4u ov = *(const GAS v4u*)(PROJ + (row0 + t) * NPROJ + PC_O + h * 64 + vg * 8);
            const float o[8] = {bflo(ov.x), bfhi(ov.x), bflo(ov.y), bfhi(ov.y), bflo(ov.z), bfhi(ov.z), bflo(ov.w), bfhi(ov.w)};
            float r[8];
#pragma unroll
            for (int j = 0; j < 8; ++j) r[j] = acc[j] * rs * nw[j] * sigmoidf_(o[j]);
            v4u w; w.x = pk2(r[0], r[1]); w.y = pk2(r[2], r[3]); w.z = pk2(r[4], r[5]); w.w = pk2(r[6], r[7]);
            *(GAS v4u*)(YC + (row0 + t) * DM + h * 64 + vg * 8) = w;
        }
    }
}

constexpr int S5_UT = 264, S5_XT = 2056;
constexpr int S5_U = 0, S5_Z = 33792, S5_X = 67584;
static_assert(S5_X + 16 * S5_XT * 2 <= MISC_OFF, "S5 LDS map");
struct S5A { float are, aim, cre, cim; };
__device__ __forceinline__ S5A s5_a(KArgsP a, int l, int g, int p) {
    const float lam_re = a->in[I_S5ARE][(size_t)(l * 16 + g) * 64 + p], lam_im = a->in[I_S5AIM][(size_t)(l * 16 + g) * 64 + p];
    const float dt = expf(a->in[I_S5LDT][l * 16 + g]); const float mag = expf(lam_re * dt), ang = lam_im * dt;
    S5A r; r.are = mag * cosf(ang); r.aim = mag * sinf(ang);
    const float inv = 1.f / (lam_re * lam_re + lam_im * lam_im);
    r.cre = ((r.are - 1.f) * lam_re + r.aim * lam_im) * inv; r.cim = (r.aim * lam_re - (r.are - 1.f) * lam_im) * inv; return r;
}
__device__ __forceinline__ bf16x8 pack8(const float* v) { v4u o; o.x = pk2(v[0], v[1]); o.y = pk2(v[2], v[3]); o.z = pk2(v[4], v[5]); o.w = pk2(v[6], v[7]); return __builtin_bit_cast(bf16x8, o); }
__device__ __forceinline__ void s5_bfrag(const unsigned char* ws, int l, int g, int lane, bf16x8 (&bf)[8]) {
    const bf16* BB = (const bf16*)(ws + WS_S5BB) + (size_t)(l * 16 + g) * 128 * 16;
#pragma unroll
    for (int j = 0; j < 8; ++j) { v4u o = {0u, 0u, 0u, 0u}; if ((lane >> 4) < 2) o = *(const GAS v4u*)(BB + (16 * j + (lane & 15)) * 16 + 8 * (lane >> 4)); bf[j] = __builtin_bit_cast(bf16x8, o); }
}
__device__ __forceinline__ f32x2 s5_ap(const unsigned char* ws, int l, int g, int p) { return *(const GAS f32x2*)((const float*)(ws + WS_S5AP) + ((size_t)(l * 16 + g) * 64 + p) * 2); }
__device__ __forceinline__ void s5_load_u(const unsigned char* ws, LAS unsigned char* lds, int tid, size_t row0) {
    const bf16* PROJ = (const bf16*)(ws + WS_PROJ);
    for (int idx = tid; idx < 64 * 32; idx += NTHR) { const int t = idx >> 5, c8 = idx & 31;
        *(LAS v4u*)(lds + S5_U + (t * S5_UT + c8 * 8) * 2) = *(const GAS v4u*)(PROJ + (row0 + t) * NPROJ + PC_S5 + c8 * 8); }
}
__device__ __forceinline__ void s5_block(LAS unsigned char* lds, int lane, int tb, int g, const bf16x8 (&bf)[8], float are, float aim, float& xr, float& xi) {
    const int kq = lane >> 4; bf16x8 uf = {0, 0, 0, 0, 0, 0, 0, 0};
    if (kq < 2) uf = *(const LAS bf16x8*)(lds + S5_U + ((16 * tb + (lane & 15)) * S5_UT + g * 16 + 8 * kq) * 2);
    LAS bf16* X = (LAS bf16*)(lds + S5_X);
#pragma unroll
    for (int j = 0; j < 8; ++j) { f32x4 acc = {0.f, 0.f, 0.f, 0.f}; acc = __builtin_amdgcn_mfma_f32_16x16x32_bf16(bf[j], uf, acc, 0, 0, 0);
        v2u o; o.x = pk2(acc[0], acc[1]); o.y = pk2(acc[2], acc[3]); *(LAS v2u*)(X + (lane & 15) * S5_XT + g * 128 + 16 * j + 4 * kq) = o; }
    LDS_WAIT(); asm volatile("" ::: "memory");
    LAS unsigned* xw = (LAS unsigned*)(lds + S5_X) + (g * 128 + 2 * lane) / 2;
#pragma unroll
    for (int t = 0; t < 16; ++t) { const unsigned w = xw[t * (S5_XT / 2)]; const float br = bflo(w), bi = bfhi(w);
        const float nr = are * xr - aim * xi + br, ni = are * xi + aim * xr + bi; xr = nr; xi = ni;
        xw[t * (S5_XT / 2)] = pk2(xr, xi); }
    LDS_WAIT(); asm volatile("" ::: "memory");
}
__device__ __forceinline__ void phase_s1(KArgsP a, LAS unsigned char* lds, int tid, int lane, int wave, int vcu, int G, int l) {
    unsigned char* ws = a->ws; float* ST = (float*)(ws + WS_S5ST);
    bf16x8 bf0[8], bf1[8]; s5_bfrag(ws, l, wave, lane, bf0); s5_bfrag(ws, l, wave + 8, lane, bf1);
    struct { float are, aim; } A0, A1; { const f32x2 q0 = s5_ap(ws, l, wave, lane), q1 = s5_ap(ws, l, wave + 8, lane); A0.are = q0.x; A0.aim = q0.y; A1.are = q1.x; A1.aim = q1.y; }
    for (int u = vcu; u < NB * NCH; u += G) {
        const size_t row0 = (size_t)u * 64;
        __syncthreads();
        s5_load_u(ws, lds, tid, row0);
        __syncthreads();
        float x0r = 0.f, x0i = 0.f, x1r = 0.f, x1i = 0.f;
        for (int tb = 0; tb < 4; ++tb) { s5_block(lds, lane, tb, wave, bf0, A0.are, A0.aim, x0r, x0i); s5_block(lds, lane, tb, wave + 8, bf1, A1.are, A1.aim, x1r, x1i); }
        *(f32x2*)(ST + (((size_t)u * 16 + wave) * 64 + lane) * 2) = (f32x2){x0r, x0i};
        *(f32x2*)(ST + (((size_t)u * 16 + wave + 8) * 64 + lane) * 2) = (f32x2){x1r, x1i};
    }
}
__device__ __forceinline__ void phase_s2(KArgsP a, int tid, int wg, int nwg, int l) {
    float* ST = (float*)(a->ws + WS_S5ST);
    for (int idx = wg * NTHR + tid; idx < NB * 1024; idx += nwg * NTHR) {
        const int b = idx >> 10, gp = idx & 1023, g = gp >> 6, p = gp & 63;
        const f32x2 A = s5_ap(a->ws, l, g, p); float ar = A.x, ai = A.y;
#pragma unroll
        for (int s = 0; s < 6; ++s) { const float nr = ar * ar - ai * ai, ni = 2.f * ar * ai; ar = nr; ai = ni; }
        float cr = 0.f, ci = 0.f;
        for (int c0 = 0; c0 < NCH; c0 += 8) {
            f32x2 e[8];
#pragma unroll
            for (int j = 0; j < 8; ++j) e[j] = *(const f32x2*)(ST + (((size_t)(b * NCH + c0 + j) * 16 + g) * 64 + p) * 2);
#pragma unroll
            for (int j = 0; j < 8; ++j) { *(f32x2*)(ST + (((size_t)(b * NCH + c0 + j) * 16 + g) * 64 + p) * 2) = (f32x2){cr, ci};
                const float nr = ar * cr - ai * ci + e[j].x, ni = ar * ci + ai * cr + e[j].y; cr = nr; ci = ni; }
        }
    }
}
__device__ __forceinline__ float tanh_fast(float x) { return 1.f - 2.f / (1.f + __expf(2.f * x)); }
__device__ __forceinline__ float gelu_tanh_(float x) { const float t = tanh_fast(0.7978845608f * (x + 0.044715f * x * x * x)); return 0.5f * x * (1.f + t); }
__device__ __forceinline__ void s5_cload(const bf16* cmt  , int lane, bf16x8 (&cf)[4]) {
#pragma unroll
    for (int s = 0; s < 4; ++s) cf[s] = __builtin_bit_cast(bf16x8, *(const GAS v4u*)(cmt + (lane & 15) * 128 + 32 * s + 8 * (lane >> 4)));
}
__device__ __forceinline__ void s5_cproj(LAS unsigned char* lds, int lane, int tb, int g, const bf16x8 (&cf)[4], const float (&dv)[4]) {
    const int kq = lane >> 4; f32x4 acc = {0.f, 0.f, 0.f, 0.f};
    const LAS bf16* xp = (const LAS bf16*)(lds + S5_X) + (lane & 15) * S5_XT + g * 128 + 8 * kq;
#pragma unroll
    for (int s = 0; s < 4; ++s) acc = __builtin_amdgcn_mfma_f32_16x16x32_bf16(cf[s], *(const LAS bf16x8*)(xp + 32 * s), acc, 0, 0, 0);
    const int t = 16 * tb + (lane & 15), c0 = g * 16 + 4 * kq;
    const v2u uw = *(const LAS v2u*)(lds + S5_U + (t * S5_UT + c0) * 2);
    const float u4[4] = {bflo(uw.x), bfhi(uw.x), bflo(uw.y), bfhi(uw.y)}; float z[4];
#pragma unroll
    for (int r = 0; r < 4; ++r) z[r] = gelu_tanh_(acc[r] + dv[r] * u4[r]);
    v2u o; o.x = pk2(z[0], z[1]); o.y = pk2(z[2], z[3]); *(LAS v2u*)(lds + S5_Z + (t * S5_UT + c0) * 2) = o;
}
__device__ __forceinline__ void phase_s3(KArgsP a, LAS unsigned char* lds, int tid, int lane, int wave, int vcu, int G, int l) {
    unsigned char* ws = a->ws; const float* ST = (const float*)(ws + WS_S5ST); bf16* YC = (bf16*)(ws + WS_YC);
    const bf16* GLUT = (const bf16*)(ws + WS_GLUT) + (size_t)l * DC * DC;
    bf16x8 bf0[8], bf1[8]; s5_bfrag(ws, l, wave, lane, bf0); s5_bfrag(ws, l, wave + 8, lane, bf1);
    const bf16* cm0 = (const bf16*)(ws + WS_S5CM) + (size_t)(l * 16 + wave) * 2048; const bf16* cm1 = cm0 + 8 * 2048;
    struct { float are, aim; } A0, A1; { const f32x2 q0 = s5_ap(ws, l, wave, lane), q1 = s5_ap(ws, l, wave + 8, lane); A0.are = q0.x; A0.aim = q0.y; A1.are = q1.x; A1.aim = q1.y; }
    float d0[4], d1[4];
#pragma unroll
    for (int r = 0; r < 4; ++r) { d0[r] = a->in[I_S5D][l * DC + wave * 16 + 4 * (lane >> 4) + r]; d1[r] = a->in[I_S5D][l * DC + (wave + 8) * 16 + 4 * (lane >> 4) + r]; }
    for (int u = vcu; u < NB * NCH; u += G) {
        const size_t row0 = (size_t)u * 64;
        __syncthreads();
        s5_load_u(ws, lds, tid, row0);
        const f32x2 s0 = *(const f32x2*)(ST + (((size_t)u * 16 + wave) * 64 + lane) * 2), s1 = *(const f32x2*)(ST + (((size_t)u * 16 + wave + 8) * 64 + lane) * 2);
        float x0r = s0.x, x0i = s0.y, x1r = s1.x, x1i = s1.y;
        __syncthreads();
        for (int tb = 0; tb < 4; ++tb) {
            { bf16x8 cf[4]; s5_cload(cm0, lane, cf); s5_block(lds, lane, tb, wave, bf0, A0.are, A0.aim, x0r, x0i); s5_cproj(lds, lane, tb, wave, cf, d0); }
            { bf16x8 cf[4]; s5_cload(cm1, lane, cf); s5_block(lds, lane, tb, wave + 8, bf1, A1.are, A1.aim, x1r, x1i); s5_cproj(lds, lane, tb, wave + 8, cf, d1); }
        }
        __syncthreads();
        {
            const int kq = lane >> 4;
#pragma unroll
            for (int q = 0; q < 2; ++q) { const int ct = 2 * wave + q; f32x4 acc[4];
#pragma unroll
                for (int rt = 0; rt < 4; ++rt) acc[rt] = (f32x4){0.f, 0.f, 0.f, 0.f};
                const bf16* gp = GLUT + (size_t)(16 * ct + (lane & 15)) * DC + 8 * kq;
#pragma unroll 2
                for (int s = 0; s < 8; ++s) { const bf16x8 gf = __builtin_bit_cast(bf16x8, *(const GAS v4u*)(gp + 32 * s));
#pragma unroll
                    for (int rt = 0; rt < 4; ++rt) acc[rt] = __builtin_amdgcn_mfma_f32_16x16x32_bf16(gf, *(const LAS bf16x8*)(lds + S5_Z + ((16 * rt + (lane & 15)) * S5_UT + 32 * s + 8 * kq) * 2), acc[rt], 0, 0, 0); }
                const int j0 = 16 * ct + 4 * kq; const f32x4 gb = *(const GAS f32x4*)(a->in[I_S5GLUB] + l * DC + j0);
#pragma unroll
                for (int rt = 0; rt < 4; ++rt) { const int t = 16 * rt + (lane & 15); const v2u zw = *(const LAS v2u*)(lds + S5_Z + (t * S5_UT + j0) * 2);
                    const float z0 = bflo(zw.x), z1 = bfhi(zw.x), z2 = bflo(zw.y), z3 = bfhi(zw.y);
                    v2u o; o.x = pk2(z0 * sigmoidf_(acc[rt][0] + gb.x), z1 * sigmoidf_(acc[rt][1] + gb.y)); o.y = pk2(z2 * sigmoidf_(acc[rt][2] + gb.z), z3 * sigmoidf_(acc[rt][3] + gb.w));
                    *(GAS v2u*)(YC + (row0 + t) * DM + 768 + j0) = o; } }
        }
    }
}

__device__ __forceinline__ float rw_shift(const bf16* PROJ, const float* mu, size_t row, int col) {
    const float cur = bf2f(PROJ[row * NPROJ + PC_RW + col]); const float prv = (row % SEQ) ? bf2f(PROJ[(row - 1) * NPROJ + PC_RW + col]) : 0.f;
    return cur + mu[col] * (prv - cur);
}
constexpr int R1_TH = 0, R1_AD = 9216, R1_SG = 18432, R1_VS = 35840, R1_TMP = 86016;
template <int KS, int MODE>
__device__ __forceinline__ void r1_prod(const bf16* WT, const LAS bf16* act, int astride, const float* bias, bf16* OUT, size_t row0, int lane, int wave) {
    const int kq = lane >> 4, n0 = 48 * wave; constexpr int K = 32 * KS;
    f32x4 acc[3][4];
#pragma unroll
    for (int nt = 0; nt < 3; ++nt)
#pragma unroll
        for (int ti = 0; ti < 4; ++ti) acc[nt][ti] = (f32x4){0.f, 0.f, 0.f, 0.f};
#pragma unroll
    for (int s = 0; s < KS; ++s) { bf16x8 wf[3], af[4];
#pragma unroll
        for (int nt = 0; nt < 3; ++nt) wf[nt] = __builtin_bit_cast(bf16x8, *(const GAS v4u*)(WT + (size_t)(n0 + 16 * nt + (lane & 15)) * K + 32 * s + 8 * kq));
#pragma unroll
        for (int ti = 0; ti < 4; ++ti) af[ti] = *(const LAS bf16x8*)(act + (16 * ti + (lane & 15)) * astride + 32 * s + 8 * kq);
#pragma unroll
        for (int nt = 0; nt < 3; ++nt)
#pragma unroll
            for (int ti = 0; ti < 4; ++ti) acc[nt][ti] = __builtin_amdgcn_mfma_f32_16x16x32_bf16(wf[nt], af[ti], acc[nt][ti], 0, 0, 0); }
#pragma unroll
    for (int nt = 0; nt < 3; ++nt) { const int n = n0 + 16 * nt + 4 * kq; f32x4 bv = {0.f, 0.f, 0.f, 0.f}; if (MODE != 2) bv = *(const GAS f32x4*)(bias + n);
#pragma unroll
        for (int ti = 0; ti < 4; ++ti) { float o[4];
#pragma unroll
            for (int r = 0; r < 4; ++r) { const float x = acc[nt][ti][r] + bv[r]; o[r] = MODE == 0 ? 0.60653066f * sigmoidf_(x) : (MODE == 1 ? sigmoidf_(x) : x); }
            v2u w; w.x = pk2(o[0], o[1]); w.y = pk2(o[2], o[3]);
            *(GAS v2u*)(OUT + (row0 + 16 * ti + (lane & 15)) * DBR + n) = w; } }
}
__device__ __forceinline__ void phase_r1(KArgsP a, LAS unsigned char* lds, int tid, int lane, int wave, int vcu, int G, int l) {
    unsigned char* ws = a->ws; const bf16* PROJ = (const bf16*)(ws + WS_PROJ); const float* mu = a->in[I_RMU] + (size_t)l * RW_COLS;
    const bf16* W1 = (const bf16*)(ws + WS_R1W) + (size_t)l * 98304;
    const bf16* WV = (const bf16*)(ws + WS_R1W) + 2 * 98304;
    for (int u = vcu; u < NTOK / 64; u += G) {
        const size_t row0 = (size_t)u * 64;
        __syncthreads();
        for (int idx = tid; idx < 64 * 128; idx += NTHR) { const int tt = idx >> 7, col = 2 * (idx & 127); const size_t r = row0 + tt;
            const unsigned cw = *(const GAS unsigned*)(PROJ + r * NPROJ + PC_RW + RWC_WD + col); const unsigned pw = (r % SEQ) ? *(const GAS unsigned*)(PROJ + (r - 1) * NPROJ + PC_RW + RWC_WD + col) : 0u;
            const float c0 = bflo(cw), c1 = bfhi(cw); const float x0 = c0 + mu[RWC_WD + col] * (bflo(pw) - c0), x1 = c1 + mu[RWC_WD + col + 1] * (bfhi(pw) - c1);
            if (col < 64) *(LAS unsigned*)(lds + R1_TH + (tt * 72 + col) * 2) = pk2(tanh_fast(x0), tanh_fast(x1));
            else if (col < 128) *(LAS unsigned*)(lds + R1_AD + (tt * 72 + col - 64) * 2) = pk2(x0, x1);
            else *(LAS unsigned*)(lds + R1_SG + (tt * 136 + col - 128) * 2) = pk2(sigmoidf_(x0), sigmoidf_(x1)); }
        if (l > 0) for (int idx = tid; idx < 64 * 192; idx += NTHR) { const int tt = idx / 192, col = 2 * (idx % 192); const size_t r = row0 + tt;
            const unsigned cw = *(const GAS unsigned*)(PROJ + r * NPROJ + PC_RW + RWC_V + col); const unsigned pw = (r % SEQ) ? *(const GAS unsigned*)(PROJ + (r - 1) * NPROJ + PC_RW + RWC_V + col) : 0u;
            const float c0 = bflo(cw), c1 = bfhi(cw);
            *(LAS unsigned*)(lds + R1_VS + (tt * 392 + col) * 2) = pk2(c0 + mu[RWC_V + col] * (bflo(pw) - c0), c1 + mu[RWC_V + col + 1] * (bfhi(pw) - c1)); }
        __syncthreads();
        r1_prod<2, 0>(W1, (const LAS bf16*)(lds + R1_TH), 72, a->in[I_RW0] + l * DBR, (bf16*)(ws + WS_RE), row0, lane, wave);
        r1_prod<2, 1>(W1 + 24576, (const LAS bf16*)(lds + R1_AD), 72, a->in[I_RA0] + l * DBR, (bf16*)(ws + WS_RA), row0, lane, wave);
        r1_prod<4, 2>(W1 + 49152, (const LAS bf16*)(lds + R1_SG), 136, nullptr, (bf16*)(ws + WS_RG), row0, lane, wave);
        if (l > 0) {
            { const int kq = lane >> 4, mt = wave & 1, ti = wave >> 1; f32x4 acc = {0.f, 0.f, 0.f, 0.f};
#pragma unroll 4
              for (int s = 0; s < 12; ++s) acc = __builtin_amdgcn_mfma_f32_16x16x32_bf16(__builtin_bit_cast(bf16x8, *(const GAS v4u*)(WV + (size_t)(16 * mt + (lane & 15)) * 384 + 32 * s + 8 * kq)),
                                                                                          *(const LAS bf16x8*)(lds + R1_VS + ((16 * ti + (lane & 15)) * 392 + 32 * s + 8 * kq) * 2), acc, 0, 0, 0);
              v2u w; w.x = pk2(acc[0], acc[1]); w.y = pk2(acc[2], acc[3]); *(LAS v2u*)(lds + R1_TMP + ((16 * ti + (lane & 15)) * 40 + 16 * mt + 4 * kq) * 2) = w; }
            __syncthreads();
            r1_prod<1, 1>(WV + 12288, (const LAS bf16*)(lds + R1_TMP), 40, a->in[I_RV0], (bf16*)(ws + WS_RVG), row0, lane, wave);
        }
    }
}
__device__ __forceinline__ float dpp_allsum(float x) {
    x += __builtin_bit_cast(float, __builtin_amdgcn_update_dpp(0, __builtin_bit_cast(int, x), 0x128, 0xf, 0xf, false));
    x += __builtin_bit_cast(float, __builtin_amdgcn_update_dpp(0, __builtin_bit_cast(int, x), 0x124, 0xf, 0xf, false));
    x += __builtin_bit_cast(float, __builtin_amdgcn_update_dpp(0, __builtin_bit_cast(int, x), 0x122, 0xf, 0xf, false));
    x += __builtin_bit_cast(float, __builtin_amdgcn_update_dpp(0, __builtin_bit_cast(int, x), 0x121, 0xf, 0xf, false));
    { const unsigned xi = __builtin_bit_cast(unsigned, x); auto r = __builtin_amdgcn_permlane16_swap(xi, xi, false, false); const unsigned r0 = r[0], r1 = r[1]; x = __uint_as_float(r0) + __uint_as_float(r1); }
    { const unsigned xi = __builtin_bit_cast(unsigned, x); auto r = __builtin_amdgcn_permlane32_swap(xi, xi, false, false); const unsigned r0 = r[0], r1 = r[1]; x = __uint_as_float(r0) + __uint_as_float(r1); }
    return x;
}

constexpr int RC_EF = 0, RC_ATF = 4096, RC_QF = 8448, RC_PFT = 9472, RC_AT = 10496, RC_RT = 12800, RC_BH = 15104, RC_KH = 17408, RC_AH = 19712, RC_BTT = 22016, RC_KTT = 25088, RC_VS = 28160,
              RC_PRL = 31232, RC_QRL = 32000, RC_TQL = 32768, RC_G15 = 33536, RC_CH = 33792;
struct RCRegs { v2u r0, r1, k0, k1, aa, ee, v0, v1, vg, vf; };
__device__ __forceinline__ void rc_issue(const unsigned char* ws, int l, size_t row, int h, int tid, RCRegs& R) {
    const bf16* PROJ = (const bf16*)(ws + WS_PROJ); const int tt = tid >> 4, c0 = h * 64 + 4 * (tid & 15); const size_t r = row + tt; const bool first = (r % SEQ) == 0; const size_t rp = first ? r : r - 1;
    R.r0 = *(const GAS v2u*)(PROJ + r * NPROJ + PC_RW + RWC_R + c0); R.r1 = *(const GAS v2u*)(PROJ + rp * NPROJ + PC_RW + RWC_R + c0);
    R.k0 = *(const GAS v2u*)(PROJ + r * NPROJ + PC_RW + RWC_K + c0); R.k1 = *(const GAS v2u*)(PROJ + rp * NPROJ + PC_RW + RWC_K + c0);
    R.v0 = *(const GAS v2u*)(PROJ + r * NPROJ + PC_RW + RWC_V + c0); R.v1 = *(const GAS v2u*)(PROJ + rp * NPROJ + PC_RW + RWC_V + c0);
    R.aa = *(const GAS v2u*)((const bf16*)(ws + WS_RA) + r * DBR + c0); R.ee = *(const GAS v2u*)((const bf16*)(ws + WS_RE) + r * DBR + c0);
    if (l > 0) { R.vg = *(const GAS v2u*)((const bf16*)(ws + WS_RVG) + r * DBR + c0); R.vf = *(const GAS v2u*)((const bf16*)(ws + WS_VF) + r * DBR + c0); }
    if (first) { R.r1 = (v2u){0u, 0u}; R.k1 = (v2u){0u, 0u}; R.v1 = (v2u){0u, 0u}; }
}
__device__ __forceinline__ void unpack4(const v2u p, float (&o)[4]) { o[0] = bflo(p.x); o[1] = bfhi(p.x); o[2] = bflo(p.y); o[3] = bfhi(p.y); }
__device__ __forceinline__ v2u pack4(const float (&v)[4]) { v2u o; o.x = pk2(v[0], v[1]); o.y = pk2(v[2], v[3]); return o; }
__device__ __forceinline__ v2u pack4v(const f32x4 v) { v2u o; o.x = pk2(v[0], v[1]); o.y = pk2(v[2], v[3]); return o; }
__device__ __forceinline__ bf16x8 cat8(const v2u a, const v2u b) { v4u o; o.x = a.x; o.y = a.y; o.z = b.x; o.w = b.y; return __builtin_bit_cast(bf16x8, o); }
#define RC_BAR() asm volatile("s_waitcnt lgkmcnt(0)\n\ts_barrier" ::: "memory")

constexpr int REC_BYTES = 12288, REC_UNITS = 752;
__device__ __forceinline__ unsigned char* rc_rec(unsigned char* ws, size_t cu) { return cu < 8192 ? ws + WS_OPA + cu * REC_BYTES : ws + WS_OPB + (cu - 8192) * REC_BYTES; }
__device__ __forceinline__ v4u rc_gather_unit(const LAS unsigned char* wb, int u) {
    v2u lo, hi;
    if (u < 256) { const int base = u < 128 ? RC_AH : RC_RT, uu = u & 127, row = uu >> 3, s = (uu >> 2) & 1, lq = uu & 3; const LAS unsigned char* p = wb + base + (row * 72 + 32 * s + 4 * lq) * 2;
        lo = *(const LAS v2u*)p; hi = *(const LAS v2u*)(p + 32); }
    else if (u < 512) { const int k = (u - 256) >> 2, lq = (u - 256) & 3; lo = *(const LAS v2u*)(wb + RC_BTT + (k * 24 + 4 * lq) * 2); hi = *(const LAS v2u*)(wb + RC_KTT + (k * 24 + 4 * lq) * 2); }
    else if (u < 576) { const int t = (u - 512) >> 2, lq = (u - 512) & 3; lo = *(const LAS v2u*)(wb + RC_PRL + (t * 24 + 4 * lq) * 2); hi = *(const LAS v2u*)(wb + RC_QRL + (t * 24 + 4 * lq) * 2); }
    else if (u < 608) { const LAS unsigned char* p = wb + RC_TQL + (((u - 576) >> 1) * 24 + 8 * ((u - 576) & 1)) * 2; lo = *(const LAS v2u*)p; hi = *(const LAS v2u*)(p + 8); }
    else if (u < 736) { const LAS unsigned char* p = wb + RC_VS + (((u - 608) >> 1) * 24 + 8 * ((u - 608) & 1)) * 2; lo = *(const LAS v2u*)p; hi = *(const LAS v2u*)(p + 8); }
    else { const LAS unsigned char* p = wb + RC_G15 + (u - 736) * 16; lo = *(const LAS v2u*)p; hi = *(const LAS v2u*)(p + 8); }
    v4u o; o.x = lo.x; o.y = lo.y; o.z = hi.x; o.w = hi.y; return o;
}
__device__ __forceinline__ void rc_copy_out(unsigned char* rec, const LAS unsigned char* wb, int u) {
#pragma unroll
    for (int q = 0; q < 3; ++q) { const int uu = u + 256 * q; if (uu < REC_UNITS) *(GAS v4u*)(rec + uu * 16) = rc_gather_unit(wb, uu); }
}
constexpr int RS_AH = 0, RS_RT = 2304, RS_BK = 4608, RS_PQ = 9728, RS_TQL = 11008, RS_VS = 11776, RS_G15 = 14848, RS_CH = 15360;
__device__ __forceinline__ int rs_unit_off(int u) {
    if (u < 128) return RS_AH + (u >> 3) * 144 + (u & 7) * 16;
    if (u < 256) return RS_RT + ((u - 128) >> 3) * 144 + (u & 7) * 16;
    if (u < 512) return RS_BK + ((u - 256) >> 2) * 80 + (u & 3) * 16;
    if (u < 576) return RS_PQ + ((u - 512) >> 2) * 80 + (u & 3) * 16;
    if (u < 608) return RS_TQL + ((u - 576) >> 1) * 48 + (u & 1) * 16;
    if (u < 736) return RS_VS + ((u - 608) >> 1) * 48 + (u & 1) * 16;
    return RS_G15 + (u - 736) * 16;
}
#define RC_BUILD(RUSE, q) do { const int bh_ = (q) >> 8, b = bh_ / NH, h = bh_ % NH, blk_ = (q) & 255, c0 = h * 64 + 4 * kq; const size_t row0 = (size_t)b * SEQ + (size_t)blk_ * 32; \
        float kkw[4], kaw[4], mur[4], muk[4], muv[4]; \
_Pragma("unroll") \
        for (int j = 0; j < 4; ++j) { kkw[j] = a->in[I_RKK][(size_t)l * DBR + c0 + j]; kaw[j] = a->in[I_RKA][(size_t)l * DBR + c0 + j]; mur[j] = mu[RWC_R + c0 + j]; muk[j] = mu[RWC_K + c0 + j]; muv[j] = mu[RWC_V + c0 + j]; } \
        float an[4], bk[4], km[4], rs[4], ev[4]; \
        {   const RCRegs& R = RUSE; \
            float rc[4], rp[4], kc[4], kp[4], av[4], vc[4], vp[4], ks[4], kk[4], vs[4]; unpack4(R.r0, rc); unpack4(R.r1, rp); unpack4(R.k0, kc); unpack4(R.k1, kp); unpack4(R.aa, av); unpack4(R.ee, ev); unpack4(R.v0, vc); unpack4(R.v1, vp); \
            float ss = 0.f; \
_Pragma("unroll") \
            for (int j = 0; j < 4; ++j) { rs[j] = rc[j] + mur[j] * (rp[j] - rc[j]); ks[j] = kc[j] + muk[j] * (kp[j] - kc[j]); kk[j] = ks[j] * kkw[j]; ss += kk[j] * kk[j]; vs[j] = vc[j] + muv[j] * (vp[j] - vc[j]); } \
            ss += __shfl_xor(ss, 1); ss += __shfl_xor(ss, 2); ss += __shfl_xor(ss, 4); ss += __shfl_xor(ss, 8); \
            const float inv = 1.f / fmaxf(sqrtf(ss), 1e-12f); \
_Pragma("unroll") \
            for (int j = 0; j < 4; ++j) { const float kn = kk[j] * inv; an[j] = -kn; bk[j] = kn * av[j]; km[j] = ks[j] * (1.f + (av[j] - 1.f) * kaw[j]); } \
            if (l == 0) *(GAS v2u*)((bf16*)(ws + WS_VF) + (row0 + tt) * DBR + c0) = pack4(vs); \
            else { float g[4], f[4]; unpack4(R.vg, g); unpack4(R.vf, f); \
_Pragma("unroll") \
                for (int j = 0; j < 4; ++j) vs[j] = vs[j] + (f[j] - vs[j]) * g[j]; } \
            *(LAS f32x4*)(cb + RC_EF + (t * 64 + 4 * kq) * 4) = (f32x4){ev[0], ev[1], ev[2], ev[3]}; \
_Pragma("unroll") \
            for (int j = 0; j < 4; ++j) *(LAS bf16*)(cb + RC_VS + ((4 * kq + j) * 24 + t) * 2) = (bf16)f2bf(vs[j]); \
        } \
        if ((q) + 2 * G < NQ) rc_issue(ws, l, (size_t)(((q) + 2 * G) >> 8) / NH * SEQ + (size_t)(((q) + 2 * G) & 255) * 32, (((q) + 2 * G) >> 8) % NH, tid, RUSE); \
        RC_BAR(); \
        {   f32x4 inc = {0.f, 0.f, 0.f, 0.f}, tot = inc; \
_Pragma("unroll") \
            for (int i = 0; i < 16; ++i) { const f32x4 ei = *(const LAS f32x4*)(cb + RC_EF + (i * 64 + 4 * kq) * 4); tot = tot + ei; if (i <= t) inc = inc + ei; } \
            float At[4], Rt[4], Bh[4], Kh[4], Bt[4], Kt[4], Gt[4]; \
_Pragma("unroll") \
            for (int j = 0; j < 4; ++j) { const float Gi = __expf(-inc[j]), Ge = __expf(ev[j] - inc[j]), Gn = __expf(inc[j]); Gt[j] = __expf(-tot[j]); \
                At[j] = an[j] * Ge; Rt[j] = rs[j] * Gi; Bh[j] = bk[j] * Gn; Kh[j] = km[j] * Gn; Bt[j] = Bh[j] * Gt[j]; Kt[j] = Kh[j] * Gt[j]; } \
            *(LAS f32x4*)(cb + RC_ATF + (t * 68 + 4 * kq) * 4) = (f32x4){At[0], At[1], At[2], At[3]}; \
            *(LAS v2u*)(cb + RC_AT + (t * 72 + 4 * kq) * 2) = pack4(At); *(LAS v2u*)(cb + RC_RT + (t * 72 + 4 * kq) * 2) = pack4(Rt); \
            *(LAS v2u*)(cb + RC_BH + (t * 72 + 4 * kq) * 2) = pack4(Bh); *(LAS v2u*)(cb + RC_KH + (t * 72 + 4 * kq) * 2) = pack4(Kh); \
_Pragma("unroll") \
            for (int j = 0; j < 4; ++j) { *(LAS bf16*)(cb + RC_BTT + ((4 * kq + j) * 24 + t) * 2) = (bf16)f2bf(Bt[j]); *(LAS bf16*)(cb + RC_KTT + ((4 * kq + j) * 24 + t) * 2) = (bf16)f2bf(Kt[j]); } \
            if (t == 0) *(LAS f32x4*)(cb + RC_G15 + 4 * kq * 4) = (f32x4){Gt[0], Gt[1], Gt[2], Gt[3]}; \
        } \
        RC_BAR(); \
        {   LAS unsigned char* wb = lds + (wave >> 2) * RC_CH; const int pi = wave & 3; \
            const LAS bf16* Ap = (const LAS bf16*)(wb + (pi < 2 ? RC_AT : RC_RT)) + li * 72 + 8 * lq; const LAS bf16* Bp = (const LAS bf16*)(wb + ((pi & 1) ? RC_KH : RC_BH)) + li * 72 + 8 * lq; \
            f32x4 acc = {0.f, 0.f, 0.f, 0.f}; \
            acc = __builtin_amdgcn_mfma_f32_16x16x32_bf16(*(const LAS bf16x8*)Ap, *(const LAS bf16x8*)Bp, acc, 0, 0, 0); \
            acc = __builtin_amdgcn_mfma_f32_16x16x32_bf16(*(const LAS bf16x8*)(Ap + 32), *(const LAS bf16x8*)(Bp + 32), acc, 0, 0, 0); \
_Pragma("unroll") \
            for (int r = 0; r < 4; ++r) { const int tr = 4 * lq + r; if (pi < 2 ? !(li < tr) : !(li <= tr)) acc[r] = 0.f; } \
            if (pi == 0) *(LAS f32x4*)(wb + RC_PFT + (li * 16 + 4 * lq) * 4) = acc; \
            else if (pi == 1) { \
_Pragma("unroll") \
                for (int r = 0; r < 4; ++r) *(LAS float*)(wb + RC_QF + ((4 * lq + r) * 16 + li) * 4) = acc[r]; } \
            else { LAS bf16* o = (LAS bf16*)(wb + (pi == 2 ? RC_PRL : RC_QRL)); \
_Pragma("unroll") \
                for (int r = 0; r < 4; ++r) o[(4 * lq + r) * 24 + li] = (bf16)f2bf(acc[r]); } \
        } \
        RC_BAR(); \
        if (wave < 4) { \
            LAS unsigned char* wb = lds + (wave >> 1) * RC_CH; const bool isq = wave & 1; \
            float X[16]; \
_Pragma("unroll") \
            for (int r = 0; r < 16; ++r) X[r] = isq ? *(const LAS float*)(wb + RC_QF + (r * 16 + li) * 4) : *(const LAS float*)(wb + RC_ATF + (r * 68 + lane) * 4); \
_Pragma("unroll") \
            for (int j = 0; j < 15; ++j) { const LAS f32x4* pc = (const LAS f32x4*)(wb + RC_PFT + j * 64); const f32x4 c0v = pc[0], c1v = pc[1], c2v = pc[2], c3v = pc[3]; \
                const float c[16] = {c0v[0], c0v[1], c0v[2], c0v[3], c1v[0], c1v[1], c1v[2], c1v[3], c2v[0], c2v[1], c2v[2], c2v[3], c3v[0], c3v[1], c3v[2], c3v[3]}; \
_Pragma("unroll") \
                for (int r = j + 1; r < 16; ++r) X[r] = fmaf(c[r], X[j], X[r]); } \
            if (!isq) { LAS bf16* o = (LAS bf16*)(wb + RC_AH); \
_Pragma("unroll") \
                for (int r = 0; r < 16; ++r) o[r * 72 + lane] = (bf16)f2bf(X[r]); } \
            else if (lane < 16) { LAS bf16* o = (LAS bf16*)(wb + RC_TQL); \
_Pragma("unroll") \
                for (int r = 0; r < 16; ++r) o[r * 24 + lane] = (bf16)f2bf(X[r]); } \
        } \
        RC_BAR(); \
        { const int cc = tid >> 8, u = tid & 255; unsigned char* rec = rc_rec(ws, (size_t)bh_ * 512 + 2 * blk_ + cc); const LAS unsigned char* wb = lds + cc * RC_CH; \
          rc_copy_out(rec, wb, u); } \
        RC_BAR(); \
    } while (0)
struct RSOps { bf16x8 a01, a23, r01, r23, tq, pq, bk[4]; v2u vb; f32x4 g[4]; };
__device__ __forceinline__ void rs_load(const LAS unsigned char* wb, int wave, int li, int lq, RSOps& O) {
    O.a01 = *(const LAS bf16x8*)(wb + RS_AH + li * 144 + lq * 16); O.a23 = *(const LAS bf16x8*)(wb + RS_AH + li * 144 + 64 + lq * 16);
    O.r01 = *(const LAS bf16x8*)(wb + RS_RT + li * 144 + lq * 16); O.r23 = *(const LAS bf16x8*)(wb + RS_RT + li * 144 + 64 + lq * 16);
    O.pq = *(const LAS bf16x8*)(wb + RS_PQ + li * 80 + lq * 16);
    { const v2u t = *(const LAS v2u*)(wb + RS_TQL + li * 48 + lq * 8); v4u o; o.x = t.x; o.y = t.y; o.z = 0u; o.w = 0u; O.tq = __builtin_bit_cast(bf16x8, o); }
    O.vb = *(const LAS v2u*)(wb + RS_VS + (16 * wave + li) * 48 + lq * 8);
#pragma unroll
    for (int kt = 0; kt < 4; ++kt) { O.bk[kt] = *(const LAS bf16x8*)(wb + RS_BK + (16 * kt + li) * 80 + lq * 16); O.g[kt] = *(const LAS f32x4*)(wb + RS_G15 + (16 * kt + 4 * lq) * 4); }
}
#define RC_CHUNK(O, cc, row0) do { const v2u z2_ = {0u, 0u}; \
        f32x4 aD = {0.f, 0.f, 0.f, 0.f}, aY = {0.f, 0.f, 0.f, 0.f}; \
        aD = __builtin_amdgcn_mfma_f32_16x16x32_bf16(O.a01, Sb01, aD, 0, 0, 0); \
        aD = __builtin_amdgcn_mfma_f32_16x16x32_bf16(O.a23, Sb23, aD, 0, 0, 0); \
        aD = __builtin_amdgcn_mfma_f32_16x16x32_bf16(O.tq, cat8(O.vb, z2_), aD, 0, 0, 0); \
        aY = __builtin_amdgcn_mfma_f32_16x16x32_bf16(Sb01, O.r01, aY, 0, 0, 0); \
        aY = __builtin_amdgcn_mfma_f32_16x16x32_bf16(Sb23, O.r23, aY, 0, 0, 0); \
        const bf16x8 DV = cat8(pack4v(aD), O.vb); \
_Pragma("unroll") \
        for (int kt = 0; kt < 4; ++kt) Sacc[kt] = __builtin_amdgcn_mfma_f32_16x16x32_bf16(O.bk[kt], DV, Sacc[kt] * O.g[kt], 0, 0, 0); \
        aY = __builtin_amdgcn_mfma_f32_16x16x32_bf16(DV, O.pq, aY, 0, 0, 0); \
        Sb01 = cat8(pack4v(Sacc[0]), pack4v(Sacc[1])); Sb23 = cat8(pack4v(Sacc[2]), pack4v(Sacc[3])); \
        *(GAS v2u*)(YC + ((row0) + (cc) * 16 + li) * DM + 384 + h * 64 + 16 * wave + 4 * lq) = pack4v(aY);     \
    } while (0)
#define RC_SCAN(slot, row0) do { { RSOps O0; rs_load(slot, wave, li, lq, O0); __builtin_amdgcn_sched_barrier(0); RC_CHUNK(O0, 0, row0); } \
        { RSOps O1; rs_load(slot + RS_CH, wave, li, lq, O1); __builtin_amdgcn_sched_barrier(0); RC_CHUNK(O1, 1, row0); } } while (0)

__device__ __forceinline__ void phase_r2_build(KArgsP a, LAS unsigned char* lds, int tid, int lane, int wave, int vcu, int G, int l) {
    unsigned char* ws = a->ws;
    const int tt = tid >> 4, kq = tid & 15, ch = tt >> 4, t = tt & 15;
    const int lq = lane >> 4, li = lane & 15;
    LAS unsigned char* cb = lds + ch * RC_CH;
    const float* mu = a->in[I_RMU] + (size_t)l * RW_COLS;
    constexpr int NQ = NB * NH * 256;
    RCRegs RA, RB;
    if (vcu < NQ) rc_issue(ws, l, (size_t)(vcu >> 8) / NH * SEQ + (size_t)(vcu & 255) * 32, (vcu >> 8) % NH, tid, RA);
    if (vcu + G < NQ) rc_issue(ws, l, (size_t)((vcu + G) >> 8) / NH * SEQ + (size_t)((vcu + G) & 255) * 32, ((vcu + G) >> 8) % NH, tid, RB);
    for (int q0 = vcu; q0 < NQ; q0 += 2 * G) { { const int q = q0; RC_BUILD(RA, q); } if (q0 + G < NQ) { const int q = q0 + G; RC_BUILD(RB, q); } }
}
struct RSRegs { v4u p[6]; };
__device__ __forceinline__ void rs_issue(unsigned char* ws, size_t cu0, int lt, RSRegs& R) {
#pragma unroll
    for (int j = 0; j < 6; ++j) { const int uu = lt + 256 * j; if (uu < 2 * REC_UNITS) { const int cc = uu >= REC_UNITS, u = uu - cc * REC_UNITS; R.p[j] = *(const GAS v4u*)(rc_rec(ws, cu0 + cc) + u * 16); } }
}
__device__ __forceinline__ void rs_store(LAS unsigned char* slot, int lt, const RSRegs& R) {
#pragma unroll
    for (int j = 0; j < 6; ++j) { const int uu = lt + 256 * j; if (uu < 2 * REC_UNITS) { const int cc = uu >= REC_UNITS, u = uu - cc * REC_UNITS;
        *(LAS v4u*)(slot + cc * RS_CH + rs_unit_off(u)) = R.p[j]; } }
}
__device__ __forceinline__ void phase_r2_scan(KArgsP a, LAS unsigned char* lds, int tid, int lane, int wave, int wg, int l) {
    unsigned char* ws = a->ws; bf16* YC = (bf16*)(ws + WS_YC);
    const int b = wg / NH, h = wg % NH; const size_t rowb = (size_t)b * SEQ, cub = (size_t)wg * 512;
    const int lq = lane >> 4, li = lane & 15, lt = tid - 256; const bool loader = wave >= 4;
    f32x4 Sacc[4]; bf16x8 Sb01, Sb23;
#pragma unroll
    for (int kt = 0; kt < 4; ++kt) Sacc[kt] = (f32x4){0.f, 0.f, 0.f, 0.f};
    Sb01 = (bf16x8){0, 0, 0, 0, 0, 0, 0, 0}; Sb23 = Sb01;
    constexpr int NBLK = SEQ / 32;
    LAS unsigned char* slot0 = lds; LAS unsigned char* slot1 = lds + 2 * RS_CH;
    RSRegs RA, RB;
    if (loader) { rs_issue(ws, cub, lt, RA); rs_store(slot0, lt, RA); rs_issue(ws, cub + 2, lt, RB); rs_issue(ws, cub + 4, lt, RA); }
    RC_BAR();
    for (int bb = 0; bb < NBLK; bb += 2) {
        if (!loader) { const size_t row0 = rowb + (size_t)bb * 32; LAS unsigned char* slot = slot0; RC_SCAN(slot, row0); }
        else { rs_store(slot1, lt, RB); if (bb + 3 < NBLK) rs_issue(ws, cub + 2 * (size_t)(bb + 3), lt, RB); }
        RC_BAR();
        if (!loader) { const size_t row0 = rowb + (size_t)(bb + 1) * 32; LAS unsigned char* slot = slot1; RC_SCAN(slot, row0); }
        else { if (bb + 2 < NBLK) rs_store(slot0, lt, RA); if (bb + 4 < NBLK) rs_issue(ws, cub + 2 * (size_t)(bb + 4), lt, RA); }
        RC_BAR();
    }
}
__device__ __forceinline__ void phase_r3(KArgsP a, int lane, int gw, int ngw, int l) {
    unsigned char* ws = a->ws; const bf16* PROJ = (const bf16*)(ws + WS_PROJ); bf16* YC = (bf16*)(ws + WS_YC);
    const bf16* RA = (const bf16*)(ws + WS_RA); const bf16* RG = (const bf16*)(ws + WS_RG); const bf16* RVG = (const bf16*)(ws + WS_RVG); const bf16* VF = (const bf16*)(ws + WS_VF);
    const float* mu = a->in[I_RMU] + (size_t)l * RW_COLS;
    for (size_t row = gw; row < NTOK; row += ngw) {
#pragma unroll 2
        for (int h = 0; h < NH; ++h) {
            const int c = h * 64 + lane;
            const float y = bf2f(YC[row * DM + 384 + c]);
            const float m = dpp_allsum(y) * (1.f / 64.f); const float d = y - m; const float var = dpp_allsum(d * d) * (1.f / 64.f);
            const float yn = d * rsqrtf(var + RWKV_GN_EPS) * a->in[I_RLNW][l * DBR + c] + a->in[I_RLNB][l * DBR + c];
            const float rs = rw_shift(PROJ, mu, row, RWC_R + c), ks = rw_shift(PROJ, mu, row, RWC_K + c); float v = rw_shift(PROJ, mu, row, RWC_V + c);
            if (l > 0) v = v + (bf2f(VF[row * DBR + c]) - v) * bf2f(RVG[row * DBR + c]);
            const float av = bf2f(RA[row * DBR + c]);
            const float km = ks * (1.f + (av - 1.f) * a->in[I_RKA][l * DBR + c]);
            const float rk = dpp_allsum(rs * km * a->in[I_RRK][l * DBR + c]);
            YC[row * DM + 384 + c] = (bf16)f2bf((yn + rk * v) * bf2f(RG[row * DBR + c]));
        }
    }
}

constexpr int PH_PER_LAYER = 10, PH_FINAL = 1 + 2 * PH_PER_LAYER, N_PHASES = PH_FINAL + 1;
constexpr int R2_WGS = 24;
__global__ void __launch_bounds__(NTHR, 2) fwd(Args args) {
    extern __shared__ __attribute__((aligned(16))) unsigned char lds_raw[];
    LAS unsigned char* lds = (LAS unsigned char*)lds_raw;
    volatile LAS unsigned* MISC = (volatile LAS unsigned*)(lds + MISC_OFF);
    const int tid0 = threadIdx.x;
    const int G = gridDim.x;
#define PHASE_IDS int tid_ = threadIdx.x; asm volatile("" : "+v"(tid_)); const int tid = tid_, lane = tid & 63, wave = __builtin_amdgcn_readfirstlane(tid >> 6); \
    int bx_ = blockIdx.x; asm volatile("" : "+s"(bx_)); const int bx = bx_; const int vcu = (G % 8 == 0) ? (bx % 8) * (G / 8) + bx / 8 : bx; (void)lane; (void)wave; (void)vcu; (void)bx;
    unsigned char* ws0 = fresh_args()->ws;
    for (int u = tid0; u < (LDS_BYTES - RING_BYTES) / 4; u += NTHR) ((LAS unsigned*)(lds + RING_BYTES))[u] = 0u;
    __syncthreads();
    XcdBarrier bar; bar.bar = (unsigned*)(ws0 + WS_CTL) + CW_BAR; bar.x = 0; bar.st = nullptr;
    if (!MK_PER_PHASE) bar = xcd_barrier_post((unsigned*)(ws0 + WS_CTL) + CW_BAR, MISC + 8);
#if MK_PER_PHASE
    const int lo = args.ph_lo, hi = args.ph_hi;
#define IN(k) (lo <= (k) && (k) < hi)
#else
#define IN(k) true
#endif
#define SEAM(k) do { if (IN(k) && IN((k) + 1)) { XcdBarrier b2 = bar; asm volatile("" : "+s"(b2.bar)); xcd_barrier(b2); } } while (0)

#ifndef GEMM_SP2
#define GEMM_SP2 true
#endif
#ifndef GEMM_ALIGN
#define GEMM_ALIGN true
#endif
#ifndef DBL_SUB
#define DBL_SUB 0
#endif
#ifndef DBL_PHASE
#define DBL_PHASE (-1)
#endif
#ifndef REPN
#define REPN 2
#endif
#define REP(k) for (int rep_ = 0; rep_ < ((k) == DBL_PHASE ? REPN : 1); ++rep_)
#define REPBAR if (rep_ > 0) { XcdBarrier b2 = bar; asm volatile("" : "+s"(b2.bar)); xcd_barrier(b2); }
    REP(0) if (IN(0)) { REPBAR KArgsP ap = fresh_args(); PHASE_IDS phase_prologue(ap, lds, tid, lane, wave, vcu, G); }
    SEAM(0);
#ifdef EXTRA_BAR
    for (int eb_ = 0; eb_ < EXTRA_BAR; ++eb_) { XcdBarrier b2 = bar; asm volatile("" : "+s"(b2.bar)); xcd_barrier(b2); }
#endif
#define LCONST 0
    {
        constexpr int l = LCONST; constexpr int pb = 1 + l * PH_PER_LAYER;
        REP(pb + 0) if (IN(pb + 0)) { REPBAR KArgsP ap = fresh_args(); PHASE_IDS unsigned char* ws = ap->ws; (void)ws;
            if (l == 0) { mod_finalize(ws, tid, G); phase_rownorm<0, false>(ap, lds, tid, lane, wave, G, ap->in[I_X], ap->out, ap->in[I_NORM_MIX], true, 0, 0, 0); }
            else {
#if EN_MOE
                phase_rownorm<0, true>(ap, lds, tid, lane, wave, G, ap->out, ap->out, ap->in[I_NORM_MIX] + l * DM, false, l, 0, l - 1);
#else
                phase_rownorm<0, false>(ap, lds, tid, lane, wave, G, ap->out, ap->out, ap->in[I_NORM_MIX] + l * DM, false, l, 0, l - 1);
#endif
            }
        }
        SEAM(pb + 0);
        REP(pb + 1) if (IN(pb + 1)) { REPBAR KArgsP ap = fresh_args(); PHASE_IDS unsigned char* ws = ap->ws; (void)ws;
            pg8::Gemm g{(const pg8::bf16_t*)(ws + WS_HN), (const pg8::bf16_t*)(ws + WS_WIN) + (size_t)l * NPROJ_PAD * DM, NTOK, NPROJ_PAD, DM};
            pg8::StaticOrder S; S.init(NTOK, NPROJ_PAD, G, bx);
            pg8::EpiProj E{(pg8::bf16_t*)(ws + WS_PROJ), (float*)(ws + WS_GATES)};
            pg8::gemm_phase<pg8::EpiProj, pg8::StaticOrder, GEMM_ALIGN, GEMM_SP2>(lds, g, S, E);
        }
        SEAM(pb + 1);
        REP(pb + 2) if (IN(pb + 2)) { REPBAR KArgsP ap = fresh_args(); PHASE_IDS unsigned char* ws = ap->ws; (void)ws;
#if EN_MLSTM
            for (int q_ = 0; q_ < 1 + (REPN - 1) * ((DBL_SUB == 1) && l == 0); ++q_) { phase_m1(ap, lds, tid, lane, wave, vcu, G, l); __syncthreads(); }
            __syncthreads();
#endif
#if EN_S5
            phase_s1(ap, lds, tid, lane, wave, vcu, G, l); __syncthreads();
#if DBL_SUB == 2
            if (l == 0) { phase_s1(ap, lds, tid, lane, wave, vcu, G, l); __syncthreads(); phase_s1(ap, lds, tid, lane, wave, vcu, G, l); __syncthreads(); phase_s1(ap, lds, tid, lane, wave, vcu, G, l); __syncthreads(); phase_s1(ap, lds, tid, lane, wave, vcu, G, l); __syncthreads(); }
#endif
            __syncthreads();
#endif
#if EN_RWKV
            for (int q_ = 0; q_ < 1 + (REPN - 1) * ((DBL_SUB == 3) && l == 0); ++q_) { phase_r1(ap, lds, tid, lane, wave, vcu, G, l); __syncthreads(); }
#endif
        }
        SEAM(pb + 2);
        REP(pb + 3) if (IN(pb + 3)) { REPBAR KArgsP ap = fresh_args(); PHASE_IDS unsigned char* ws = ap->ws; (void)ws;
            phase_m2(ws, tid, vcu, G);
            phase_s2(ap, tid, vcu, G, l);
            __syncthreads();
            phase_r2_build(ap, lds, tid, lane, wave, vcu, G, l);
        }
        SEAM(pb + 3);
        REP(pb + 4) if (IN(pb + 4)) { REPBAR KArgsP ap = fresh_args(); PHASE_IDS unsigned char* ws = ap->ws; (void)ws;
            if (bx < R2_WGS) { phase_r2_scan(ap, lds, tid, lane, wave, bx, l); __syncthreads(); }
            else { phase_s3(ap, lds, tid, lane, wave, bx - R2_WGS, G - R2_WGS, l); __syncthreads(); }
            {
                unsigned* qctr = (unsigned*)(ws + WS_CTL) + CW_Q + 64 * l; volatile LAS unsigned* qw = (volatile LAS unsigned*)(lds + MISC_OFF) + 16;
                for (;;) {
                    if (tid == 0) *qw = __hip_atomic_fetch_add(qctr, 1u, __ATOMIC_RELAXED, __HIP_MEMORY_SCOPE_AGENT);
                    __syncthreads();
                    const int u = (int)*qw;
                    __syncthreads();
                    if (u >= NUNIT_M) break;
                    phase_m3(ap, lds, tid, lane, wave, u, NUNIT_M, l);
                }
            }
        }
        SEAM(pb + 4);
        REP(pb + 5) if (IN(pb + 5)) { REPBAR KArgsP ap = fresh_args(); PHASE_IDS
            phase_r3(ap, lane, vcu * NWAVES + wave, G * NWAVES, l);
        }
        SEAM(pb + 5);
        REP(pb + 6) if (IN(pb + 6)) { REPBAR KArgsP ap = fresh_args(); PHASE_IDS unsigned char* ws = ap->ws; (void)ws;
            pg8::Gemm g{(const pg8::bf16_t*)(ws + WS_YC), (const pg8::bf16_t*)(ws + WS_WOUT) + (size_t)l * DM * DM, NTOK, DM, DM};
            pg8::StaticOrder S; S.init(NTOK, DM, G, bx);
            pg8::EpiResid E{l == 0 ? ap->in[I_X] : (const float*)ap->out, ap->out, (const float*)(ws + WS_MODF) + (size_t)l * 4 * 6144, 2048};
            pg8::gemm_phase<pg8::EpiResid, pg8::StaticOrder, GEMM_ALIGN, GEMM_SP2>(lds, g, S, E);
        }
        SEAM(pb + 6);
#if EN_MOE
        REP(pb + 7) if (IN(pb + 7)) { REPBAR KArgsP ap = fresh_args(); PHASE_IDS phase_router(ap, lds, tid, lane, wave, G, l); __syncthreads();
            moe_convert(ap->in[I_MW1], ap->in[I_MW3], ap->in[I_MW2], l, (bf16*)(ap->ws + WS_W13), (bf16*)(ap->ws + WS_W2), vcu * NWAVES + wave, G * NWAVES, (LAS float*)(lds + wave * 16640), lane); }
        SEAM(pb + 7);
        REP(pb + 8) if (IN(pb + 8)) { REPBAR KArgsP ap = fresh_args(); PHASE_IDS unsigned char* ws = ap->ws; (void)ws;
            LAS int* ptab = (LAS int*)(lds + PTAB_OFF); LAS int* pst = ptab + 512; LAS int* cnt = pst + 32;
            build_ptab((const unsigned*)(ws + WS_CTL) + CW_CNT + l * 32, ptab, pst, cnt, tid);
            pg8::Gemm g{(const pg8::bf16_t*)(ws + WS_HN), (const pg8::bf16_t*)(ws + WS_W13), 0, 0, DM, (const int*)(ws + WS_LIST), ptab};
            pg8::MoeOrder S{ptab, G, vcu};
            pg8::EpiSwiglu E{(pg8::bf16_t*)(ws + WS_HMID)};
            pg8::gemm_phase<pg8::EpiSwiglu, pg8::MoeOrder, false, true, true>(lds, g, S, E);
        }
        SEAM(pb + 8);
        REP(pb + 9) if (IN(pb + 9)) { REPBAR KArgsP ap = fresh_args(); PHASE_IDS unsigned char* ws = ap->ws; (void)ws;
            LAS int* ptab = (LAS int*)(lds + PTAB_OFF); LAS int* pst = ptab + 512; LAS int* cnt = pst + 32;
            build_ptab((const unsigned*)(ws + WS_CTL) + CW_CNT + l * 32, ptab, pst, cnt, tid);
            pg8::Gemm g{(const pg8::bf16_t*)(ws + WS_HMID), (const pg8::bf16_t*)(ws + WS_W2), 0, 0, DEXP};
            pg8::MoeOrder S{ptab, G, vcu};
            pg8::EpiMoeOut E{(pg8::bf16_t*)(ws + WS_YMOE), (const int*)(ws + WS_LIST), ptab};
            pg8::gemm_phase<pg8::EpiMoeOut, pg8::MoeOrder, true, true>(lds, g, S, E);
        }
        SEAM(pb + 9);
#else
        SEAM(pb + 6); SEAM(pb + 7); SEAM(pb + 8); SEAM(pb + 9);
#endif
    }
#undef LCONST
#if N_LAYERS > 1
#define LCONST 1
    {
        constexpr int l = LCONST; constexpr int pb = 1 + l * PH_PER_LAYER;
        REP(pb + 0) if (IN(pb + 0)) { REPBAR KArgsP ap = fresh_args(); PHASE_IDS unsigned char* ws = ap->ws; (void)ws;
            if (l == 0) { mod_finalize(ws, tid, G); phase_rownorm<0, false>(ap, lds, tid, lane, wave, G, ap->in[I_X], ap->out, ap->in[I_NORM_MIX], true, 0, 0, 0); }
            else {
#if EN_MOE
                phase_rownorm<0, true>(ap, lds, tid, lane, wave, G, ap->out, ap->out, ap->in[I_NORM_MIX] + l * DM, false, l, 0, l - 1);
#else
                phase_rownorm<0, false>(ap, lds, tid, lane, wave, G, ap->out, ap->out, ap->in[I_NORM_MIX] + l * DM, false, l, 0, l - 1);
#endif
            }
        }
        SEAM(pb + 0);
        REP(pb + 1) if (IN(pb + 1)) { REPBAR KArgsP ap = fresh_args(); PHASE_IDS unsigned char* ws = ap->ws; (void)ws;
            pg8::Gemm g{(const pg8::bf16_t*)(ws + WS_HN), (const pg8::bf16_t*)(ws + WS_WIN) + (size_t)l * NPROJ_PAD * DM, NTOK, NPROJ_PAD, DM};
            pg8::StaticOrder S; S.init(NTOK, NPROJ_PAD, G, bx);
            pg8::EpiProj E{(pg8::bf16_t*)(ws + WS_PROJ), (float*)(ws + WS_GATES)};
            pg8::gemm_phase<pg8::EpiProj, pg8::StaticOrder, GEMM_ALIGN, GEMM_SP2>(lds, g, S, E);
        }
        SEAM(pb + 1);
        REP(pb + 2) if (IN(pb + 2)) { REPBAR KArgsP ap = fresh_args(); PHASE_IDS unsigned char* ws = ap->ws; (void)ws;
#if EN_MLSTM
            for (int q_ = 0; q_ < 1 + (REPN - 1) * ((DBL_SUB == 1) && l == 0); ++q_) { phase_m1(ap, lds, tid, lane, wave, vcu, G, l); __syncthreads(); }
            __syncthreads();
#endif
#if EN_S5
            phase_s1(ap, lds, tid, lane, wave, vcu, G, l); __syncthreads();
#if DBL_SUB == 2
            if (l == 0) { phase_s1(ap, lds, tid, lane, wave, vcu, G, l); __syncthreads(); phase_s1(ap, lds, tid, lane, wave, vcu, G, l); __syncthreads(); phase_s1(ap, lds, tid, lane, wave, vcu, G, l); __syncthreads(); phase_s1(ap, lds, tid, lane, wave, vcu, G, l); __syncthreads(); }
#endif
            __syncthreads();
#endif
#if EN_RWKV
            for (int q_ = 0; q_ < 1 + (REPN - 1) * ((DBL_SUB == 3) && l == 0); ++q_) { phase_r1(ap, lds, tid, lane, wave, vcu, G, l); __syncthreads(); }
#endif
        }
        SEAM(pb + 2);
        REP(pb + 3) if (IN(pb + 3)) { REPBAR KArgsP ap = fresh_args(); PHASE_IDS unsigned char* ws = ap->ws; (void)ws;
            phase_m2(ws, tid, vcu, G);
            phase_s2(ap, tid, vcu, G, l);
            __syncthreads();
            phase_r2_build(ap, lds, tid, lane, wave, vcu, G, l);
        }
        SEAM(pb + 3);
        REP(pb + 4) if (IN(pb + 4)) { REPBAR KArgsP ap = fresh_args(); PHASE_IDS unsigned char* ws = ap->ws; (void)ws;
            if (bx < R2_WGS) { phase_r2_scan(ap, lds, tid, lane, wave, bx, l); __syncthreads(); }
            else { phase_s3(ap, lds, tid, lane, wave, bx - R2_WGS, G - R2_WGS, l); __syncthreads(); }
            {
                unsigned* qctr = (unsigned*)(ws + WS_CTL) + CW_Q + 64 * l; volatile LAS unsigned* qw = (volatile LAS unsigned*)(lds + MISC_OFF) + 16;
                for (;;) {
                    if (tid == 0) *qw = __hip_atomic_fetch_add(qctr, 1u, __ATOMIC_RELAXED, __HIP_MEMORY_SCOPE_AGENT);
                    __syncthreads();
                    const int u = (int)*qw;
                    __syncthreads();
                    if (u >= NUNIT_M) break;
                    phase_m3(ap, lds, tid, lane, wave, u, NUNIT_M, l);
                }
            }
        }
        SEAM(pb + 4);
        REP(pb + 5) if (IN(pb + 5)) { REPBAR KArgsP ap = fresh_args(); PHASE_IDS
            phase_r3(ap, lane, vcu * NWAVES + wave, G * NWAVES, l);
        }
        SEAM(pb + 5);
        REP(pb + 6) if (IN(pb + 6)) { REPBAR KArgsP ap = fresh_args(); PHASE_IDS unsigned char* ws = ap->ws; (void)ws;
            pg8::Gemm g{(const pg8::bf16_t*)(ws + WS_YC), (const pg8::bf16_t*)(ws + WS_WOUT) + (size_t)l * DM * DM, NTOK, DM, DM};
            pg8::StaticOrder S; S.init(NTOK, DM, G, bx);
            pg8::EpiResid E{l == 0 ? ap->in[I_X] : (const float*)ap->out, ap->out, (const float*)(ws + WS_MODF) + (size_t)l * 4 * 6144, 2048};
            pg8::gemm_phase<pg8::EpiResid, pg8::StaticOrder, GEMM_ALIGN, GEMM_SP2>(lds, g, S, E);
        }
        SEAM(pb + 6);
#if EN_MOE
        REP(pb + 7) if (IN(pb + 7)) { REPBAR KArgsP ap = fresh_args(); PHASE_IDS phase_router(ap, lds, tid, lane, wave, G, l); __syncthreads();
            moe_convert(ap->in[I_MW1], ap->in[I_MW3], ap->in[I_MW2], l, (bf16*)(ap->ws + WS_W13), (bf16*)(ap->ws + WS_W2), vcu * NWAVES + wave, G * NWAVES, (LAS float*)(lds + wave * 16640), lane); }
        SEAM(pb + 7);
        REP(pb + 8) if (IN(pb + 8)) { REPBAR KArgsP ap = fresh_args(); PHASE_IDS unsigned char* ws = ap->ws; (void)ws;
            LAS int* ptab = (LAS int*)(lds + PTAB_OFF); LAS int* pst = ptab + 512; LAS int* cnt = pst + 32;
            build_ptab((const unsigned*)(ws + WS_CTL) + CW_CNT + l * 32, ptab, pst, cnt, tid);
            pg8::Gemm g{(const pg8::bf16_t*)(ws + WS_HN), (const pg8::bf16_t*)(ws + WS_W13), 0, 0, DM, (const int*)(ws + WS_LIST), ptab};
            pg8::MoeOrder S{ptab, G, vcu};
            pg8::EpiSwiglu E{(pg8::bf16_t*)(ws + WS_HMID)};
            pg8::gemm_phase<pg8::EpiSwiglu, pg8::MoeOrder, false, true, true>(lds, g, S, E);
        }
        SEAM(pb + 8);
        REP(pb + 9) if (IN(pb + 9)) { REPBAR KArgsP ap = fresh_args(); PHASE_IDS unsigned char* ws = ap->ws; (void)ws;
            LAS int* ptab = (LAS int*)(lds + PTAB_OFF); LAS int* pst = ptab + 512; LAS int* cnt = pst + 32;
            build_ptab((const unsigned*)(ws + WS_CTL) + CW_CNT + l * 32, ptab, pst, cnt, tid);
            pg8::Gemm g{(const pg8::bf16_t*)(ws + WS_HMID), (const pg8::bf16_t*)(ws + WS_W2), 0, 0, DEXP};
            pg8::MoeOrder S{ptab, G, vcu};
            pg8::EpiMoeOut E{(pg8::bf16_t*)(ws + WS_YMOE), (const int*)(ws + WS_LIST), ptab};
            pg8::gemm_phase<pg8::EpiMoeOut, pg8::MoeOrder, true, true>(lds, g, S, E);
        }
        SEAM(pb + 9);
#else
        SEAM(pb + 6); SEAM(pb + 7); SEAM(pb + 8); SEAM(pb + 9);
#endif
    }
#undef LCONST
#endif
    if (IN(PH_FINAL)) { KArgsP ap = fresh_args(); PHASE_IDS
#if EN_MOE
        if (N_LAYERS > 0) phase_rownorm<1, true>(ap, lds, tid, lane, wave, G, ap->out, ap->out, ap->in[I_NORM_FINAL], false, 0, 0, N_LAYERS - 1);
        else phase_rownorm<1, false>(ap, lds, tid, lane, wave, G, ap->in[I_X], ap->out, ap->in[I_NORM_FINAL], false, 0, 0, 0);
#else
        phase_rownorm<1, false>(ap, lds, tid, lane, wave, G, N_LAYERS > 0 ? (const float*)ap->out : ap->in[I_X], ap->out, ap->in[I_NORM_FINAL], false, 0, 0, 0);
#endif
    }
#undef IN
#undef SEAM
}

extern "C" void kernel_launch(void* const* d_in, const int* in_sizes, int n_in, void* d_out, int out_size, void* d_ws, size_t ws_size, hipStream_t stream) {
    static int grid = 0;
    if (grid == 0) {
        if (n_in != 47 || out_size != NTOK * DM || ws_size < WS_END) { fprintf(stderr, "kernel_launch: unexpected problem (n_in %d, out %d, ws %zu < %zu)\n", n_in, out_size, ws_size, (size_t)WS_END); grid = -1; return; }
        int dev = 0, cus = 0, per_cu = 0;
        if (hipGetDevice(&dev) != hipSuccess || hipDeviceGetAttribute(&cus, hipDeviceAttributeMultiprocessorCount, dev) != hipSuccess) { grid = -1; return; }
        if (hipFuncSetAttribute((const void*)fwd, hipFuncAttributeMaxDynamicSharedMemorySize, LDS_BYTES) != hipSuccess) { fprintf(stderr, "kernel_launch: hipFuncSetAttribute failed\n"); grid = -1; return; }
        if (hipOccupancyMaxActiveBlocksPerMultiprocessor(&per_cu, (const void*)fwd, NTHR, LDS_BYTES) != hipSuccess || per_cu < 1) fprintf(stderr, "kernel_launch: occupancy query says %d\n", per_cu);
        (void)hipGetLastError();
        grid = cus;
        if (grid != 256) fprintf(stderr, "kernel_launch: %d CUs (built for 256)\n", grid);
    }
    if (grid < 0) return;
    (void)hipMemsetAsync((char*)d_ws + WS_CTL, 0, CTL_ZERO_BYTES, stream);
    Args a{};
    for (int i = 0; i < 47; ++i) a.in[i] = (const float*)d_in[i];
    a.out = (float*)d_out; a.ws = (unsigned char*)d_ws;
#if MK_PER_PHASE
    for (int p = 0; p < N_PHASES; ++p) { a.ph_lo = p; a.ph_hi = p + 1; hipLaunchKernelGGL(fwd, dim3(grid), dim3(NTHR), LDS_BYTES, stream, a); }
#else
    a.ph_lo = 0; a.ph_hi = N_PHASES; hipLaunchKernelGGL(fwd, dim3(grid), dim3(NTHR), LDS_BYTES, stream, a);
#endif
}
#ifdef DIAG_KERNELS
#define DK(name, ...) __global__ void __launch_bounds__(NTHR, 2) name(Args args) { extern __shared__ __attribute__((aligned(16))) unsigned char lds_raw[]; LAS unsigned char* lds = (LAS unsigned char*)lds_raw; \
    const int tid = threadIdx.x, lane = tid & 63, wave = __builtin_amdgcn_readfirstlane(tid >> 6); const int G = gridDim.x; const int bx = blockIdx.x; const int vcu = bx; KArgsP ap = fresh_args(); int l = ap->ph_lo; (void)lane; (void)wave; (void)vcu; (void)G; (void)l; __VA_ARGS__ }
DK(k_prologue, phase_prologue(ap, lds, tid, lane, wave, vcu, G);)
DK(k_norm0, phase_rownorm<0, false>(ap, lds, tid, lane, wave, G, ap->in[I_X], ap->out, ap->in[I_NORM_MIX], true, 0, 0, 0);)
DK(k_norm1, phase_rownorm<0, true>(ap, lds, tid, lane, wave, G, ap->out, ap->out, ap->in[I_NORM_MIX], false, l, 0, 0);)
DK(k_normf, phase_rownorm<1, true>(ap, lds, tid, lane, wave, G, ap->out, ap->out, ap->in[I_NORM_MIX], false, l, 0, 0);)
DK(k_m1, phase_m1(ap, lds, tid, lane, wave, vcu, G, l);)
DK(k_m2, phase_m2(ap->ws, tid, vcu, G);)
DK(k_m3, phase_m3(ap, lds, tid, lane, wave, vcu, G, l);)
DK(k_s1, phase_s1(ap, lds, tid, lane, wave, vcu, G, l);)
DK(k_s2, phase_s2(ap, tid, vcu, G, l);)
DK(k_s3, phase_s3(ap, lds, tid, lane, wave, vcu, G, l);)
DK(k_r1, phase_r1(ap, lds, tid, lane, wave, vcu, G, l);)
DK(k_r2b, phase_r2_build(ap, lds, tid, lane, wave, vcu, G, l);)
DK(k_r2s, phase_r2_scan(ap, lds, tid, lane, wave, vcu, l);)
DK(k_r3, phase_r3(ap, lane, vcu * NWAVES + wave, G * NWAVES, l);)
DK(k_router, phase_router(ap, lds, tid, lane, wave, G, l);)
DK(k_gather, phase_gather(ap, lds, tid, lane, wave, vcu, G, l);)
DK(k_moecv, moe_convert(ap->in[I_MW1], ap->in[I_MW3], ap->in[I_MW2], 1, (bf16*)(ap->ws + WS_W13), (bf16*)(ap->ws + WS_W2), vcu * NWAVES + wave, G * NWAVES, (LAS float*)(lds + wave * 16640), lane);)
#endif
```

```cpp
#include <hip/hip_runtime.h>
#include <cstdio>
#include <cstdint>
#define MK_PER_PHASE 0

#ifndef MK_PER_PHASE
#define MK_PER_PHASE 0
#endif
#ifndef EN_MLSTM
#define EN_MLSTM 1
#endif
#ifndef EN_S5
#define EN_S5 1
#endif
#ifndef EN_RWKV
#define EN_RWKV 1
#endif
#ifndef EN_MOE
#define EN_MOE 1
#endif
#ifndef N_LAYERS
#define N_LAYERS 2
#endif
constexpr int NWAVES = 8, NTHR = 512;
constexpr int DM = 1024, NB = 4, SEQ = 8192, NTOK = NB * SEQ;
constexpr int DA = 384, DBR = 384, DC = 256, NH = 6, HD = 64, NCH = SEQ / 64;
constexpr int IN_COLS = 2828, NPROJ = 2816, NPROJ_PAD = 3072;
constexpr int PC_QK = 0, PC_V = 384, PC_O = 768, PC_RW = 1152, PC_S5 = 2560;
constexpr int RWC_R = 0, RWC_K = 384, RWC_V = 768, RWC_WD = 1152, RWC_AD = 1216, RWC_GD = 1280, RW_COLS = 1408;
constexpr int NEXP = 32, DEXP = 512, MOE_ROWS_MAX = 73728;
constexpr int NUNIT_M = NB * NCH * NH;
constexpr int CL_STRIDE = 4160;
constexpr float NORM_EPS = 1e-6f, HEAD_NORM_EPS = 1e-5f, RWKV_GN_EPS = 64e-5f;

constexpr size_t MiB = 1u << 20;
constexpr size_t WS_CTL = 0, CTL_ZERO_BYTES = 1 * MiB;
constexpr size_t WS_MODP = 1 * MiB;
constexpr size_t WS_MODF = 2 * MiB + 512 * 1024;
constexpr size_t WS_S5BB = 2 * MiB + 896 * 1024;
constexpr size_t WS_RTW = 3 * MiB;
constexpr size_t WS_S5AP = 3 * MiB + 384 * 1024;
constexpr size_t WS_MLW = 3 * MiB + 512 * 1024;
constexpr size_t WS_S5CM = 2 * MiB + 768 * 1024;
constexpr size_t WS_GLUT = 3 * MiB + 768 * 1024;
constexpr size_t WS_WIN = 4 * MiB;
constexpr size_t WS_WOUT = 16 * MiB;
constexpr size_t WS_GATES = 20 * MiB;
constexpr size_t WS_W13 = 22 * MiB;
constexpr size_t WS_W2 = 86 * MiB;
constexpr size_t WS_HN = 118 * MiB;
constexpr size_t WS_CLOC = 118 * MiB;
constexpr size_t WS_MSC = 168 * MiB;
constexpr size_t WS_S5ST = 170 * MiB;
constexpr size_t WS_VF = 182 * MiB;
constexpr size_t WS_YC = 206 * MiB;
constexpr size_t WS_LIST = 206 * MiB;
constexpr size_t WS_ROWMAP = 214 * MiB;
constexpr size_t WS_TOKE = 215 * MiB;
constexpr size_t WS_TOKW = 215 * MiB + 512 * 1024;
constexpr size_t WS_PROJ = 270 * MiB;
constexpr size_t WS_RE = 446 * MiB, WS_RA = 470 * MiB, WS_RG = 494 * MiB, WS_RVG = 518 * MiB;
constexpr size_t WS_XG = 270 * MiB;
constexpr size_t WS_HMID = 414 * MiB;
constexpr size_t WS_YMOE = 270 * MiB;
constexpr size_t WS_R1W = 542 * MiB;
constexpr size_t WS_OPA = 22 * MiB;
constexpr size_t WS_OPB = 543 * MiB;
constexpr size_t WS_END = 591 * MiB;
constexpr int CW_TMO = 0, CW_BAR = 4096, CW_CNT = 8192, CW_Q = 8320;

constexpr int RING_BYTES = 131072, MISC_OFF = 135168, PTAB_OFF = MISC_OFF + 1024, LDS_BYTES = 147456;

#define GAS __attribute__((address_space(1)))
#define LAS __attribute__((address_space(3)))
typedef unsigned short bf16;
typedef unsigned v4u __attribute__((ext_vector_type(4)));
typedef unsigned v2u __attribute__((ext_vector_type(2)));
typedef float f32x4 __attribute__((ext_vector_type(4)));
typedef float f32x2 __attribute__((ext_vector_type(2)));
typedef GAS unsigned gu32;
#define RLX_AGENT __ATOMIC_RELAXED, __HIP_MEMORY_SCOPE_AGENT
#define LDS_WAIT() asm volatile("s_waitcnt lgkmcnt(0)" ::: "memory")
#define VM_WAIT() asm volatile("s_waitcnt vmcnt(0)" ::: "memory")
typedef float f32x2v __attribute__((ext_vector_type(2)));
typedef __bf16 bf16x2v __attribute__((ext_vector_type(2)));
__device__ __forceinline__ unsigned pk2(float lo, float hi) { const f32x2v v = {lo, hi}; const bf16x2v b = __builtin_convertvector(v, bf16x2v); return __builtin_bit_cast(unsigned, b); }
__device__ __forceinline__ unsigned f2bf(float f) { return pk2(f, 0.f) & 0xffffu; }
__device__ __forceinline__ float bf2f(unsigned v) { return __builtin_bit_cast(float, v << 16); }
__device__ __forceinline__ float bflo(unsigned w) { return __builtin_bit_cast(float, w << 16); }
__device__ __forceinline__ float bfhi(unsigned w) { return __builtin_bit_cast(float, w & 0xffff0000u); }
__device__ __forceinline__ float sigmoidf_(float x) { return 1.f / (1.f + __expf(-x)); }
__device__ __forceinline__ float wave_sum(float v) {
#pragma unroll
    for (int o = 1; o < 64; o <<= 1) v += __shfl_xor(v, o);
    return v;
}
__device__ __forceinline__ float wave_max(float v) {
#pragma unroll
    for (int o = 1; o < 64; o <<= 1) v = fmaxf(v, __shfl_xor(v, o));
    return v;
}
namespace pg8 {
#define PG8_LAS __attribute__((address_space(3)))
typedef unsigned short bf16_t;
typedef short bf16x8 __attribute__((ext_vector_type(8)));
typedef float f32x4 __attribute__((ext_vector_type(4)));
typedef unsigned u32x4 __attribute__((ext_vector_type(4)));
constexpr int BM = 256, BK = 64, HALF = 128, HTB = HALF * BK * 2  , STAGE_BYTES = 8 * HTB, NXCD = 8, WGM = 8;

__host__ __device__ __forceinline__ int lds_byte(int r, int c) { const int st = (r >> 4) * 2 + (c >> 5), rr = r & 15, cc = c & 31, ob = rr * 64 + cc * 2; return st * 1024 + (ob ^ (((ob >> 9) & 1) << 5)); }
__host__ __device__ __forceinline__ void stage_rc(int b, int& R, int& C) { const int st = b / 1024, sb = b % 1024, swz = sb ^ (((sb >> 9) & 1) << 5); R = (st >> 1) * 16 + swz / 64; C = (st & 1) * 32 + (swz % 64) / 2; }
__host__ __device__ __forceinline__ int perm32(int rho) { const int n = rho >> 4, i = rho & 15; return 8 * (i >> 2) + 4 * n + (i & 3); }

struct Unit { int pm, pn; };
__device__ __forceinline__ int moe_tok2(const int* list, PG8_LAS const int* ptab, int row) { const int e = ptab[1 + (row >> 8)], pos = row - ptab[512 + e]; return pos < ptab[544 + e] ? list[(size_t)e * 65536 + pos] : -1; }
struct Gemm { const bf16_t* A; const bf16_t* Bt; int M, N, K; const int* list = nullptr; PG8_LAS const int* ptab = nullptr; };

struct StaticOrder {
    int nM, nN, nwg, G, c;
    __host__ __device__ void init(int M, int N, int G_, int c_) { nM = M / BM; nN = N / BM; nwg = nM * nN; G = G_; c = c_; }
    __host__ __device__ bool next(int i, Unit& u) const {
        const long L = (long)i * G + c; if (L >= nwg) return false;
        int wgid = (int)L; { const int q = nwg / NXCD, r = nwg % NXCD, xcd = wgid % NXCD, off = wgid / NXCD; wgid = (xcd < r ? xcd * (q + 1) : r * (q + 1) + (xcd - r) * q) + off; }
        const int nig = WGM * nN, gid = wgid / nig, fm = gid * WGM, gsz = (nM - fm) < WGM ? (nM - fm) : WGM;
        u.pm = fm + ((wgid % nig) % gsz); u.pn = (wgid % nig) / gsz; return true;
    }
    __device__ __forceinline__ void a_ready(const Unit&) const {}
    __device__ __forceinline__ void done(const Unit&) const {}
};

__device__ __forceinline__ unsigned cvt_pk_bf16(float lo, float hi) { unsigned r; asm volatile("v_cvt_pk_bf16_f32 %0, %1, %2" : "=v"(r) : "v"(lo), "v"(hi)); return r; }

struct EpiProj {
    static constexpr bool PERM = true, AFTER_DRAIN = false;
    bf16_t* O; float* G;
    __device__ __forceinline__ void operator()(const f32x4 (&acc)[2][2][4][2], const Unit& u, int wr, int wc, int fr, int fq) const {
        const int row0 = u.pm * BM + wr * 64 + fr;
        if (u.pn < 11) {
            const int col0 = u.pn * BM + wc * 32 + 8 * fq;
#pragma unroll
            for (int ai = 0; ai < 2; ++ai)
#pragma unroll
                for (int m = 0; m < 4; ++m) { bf16_t* rowp = O + (size_t)(row0 + ai * HALF + m * 16) * 2816 + col0;
#pragma unroll
                    for (int bj = 0; bj < 2; ++bj) { const f32x4 v0 = acc[ai][bj][m][0], v1 = acc[ai][bj][m][1];
                        u32x4 w; w.x = cvt_pk_bf16(v0[0], v0[1]); w.y = cvt_pk_bf16(v0[2], v0[3]); w.z = cvt_pk_bf16(v1[0], v1[1]); w.w = cvt_pk_bf16(v1[2], v1[3]);
                        *(u32x4*)(rowp + bj * HALF) = w; } }
        } else if (wc == 0 && fq < 2) {
#pragma unroll
            for (int ai = 0; ai < 2; ++ai)
#pragma unroll
                for (int m = 0; m < 4; ++m) { float* rowp = G + (size_t)(row0 + ai * HALF + m * 16) * 16 + 8 * fq;
                    *(f32x4*)(rowp) = acc[ai][0][m][0]; *(f32x4*)(rowp + 4) = acc[ai][0][m][1]; }
        }
    }
};
struct EpiResid {
    static constexpr bool PERM = true, AFTER_DRAIN = false;
    const float* xin; float* out; const float* gate;
    int goff;
    __device__ __forceinline__ void operator()(const f32x4 (&acc)[2][2][4][2], const Unit& u, int wr, int wc, int fr, int fq) const {
        const int row0 = u.pm * BM + wr * 64 + fr, col0 = u.pn * BM + wc * 32 + 8 * fq;
        const float* gp = gate + (size_t)(row0 >> 13) * 6144 + goff + col0;
        f32x4 g[2][2];
#pragma unroll
        for (int bj = 0; bj < 2; ++bj)
#pragma unroll
            for (int n = 0; n < 2; ++n) g[bj][n] = *(const f32x4*)(gp + bj * HALF + 4 * n) + 1.0f;
#pragma unroll
        for (int ai = 0; ai < 2; ++ai)
#pragma unroll
            for (int m = 0; m < 4; ++m) { const size_t off = (size_t)(row0 + ai * HALF + m * 16) * 1024 + col0;
#pragma unroll
                for (int bj = 0; bj < 2; ++bj)
#pragma unroll
                    for (int n = 0; n < 2; ++n) { const f32x4 xv = *(const f32x4*)(xin + off + bj * HALF + 4 * n);
                        *(f32x4*)(out + off + bj * HALF + 4 * n) = xv + g[bj][n] * acc[ai][bj][m][n]; } }
    }
};
struct EpiSwiglu {
    static constexpr bool PERM = true, AFTER_DRAIN = false;
    bf16_t* H;
    __device__ __forceinline__ void operator()(const f32x4 (&acc)[2][2][4][2], const Unit& u, int wr, int wc, int fr, int fq) const {
        const int row0 = u.pm * BM + wr * 64 + fr, hid0 = 128 * (u.pn & 3) + 16 * wc + 4 * fq;
#pragma unroll
        for (int ai = 0; ai < 2; ++ai)
#pragma unroll
            for (int m = 0; m < 4; ++m) { bf16_t* rowp = H + (size_t)(row0 + ai * HALF + m * 16) * 512 + hid0;
#pragma unroll
                for (int bj = 0; bj < 2; ++bj) { const f32x4 g = acc[ai][bj][m][0], uu = acc[ai][bj][m][1]; float h[4];
#pragma unroll
                    for (int i = 0; i < 4; ++i) h[i] = g[i] / (1.f + __expf(-g[i])) * uu[i];
                    unsigned w0 = cvt_pk_bf16(h[0], h[1]), w1 = cvt_pk_bf16(h[2], h[3]);
                    *(unsigned long long*)(rowp + 64 * bj) = (unsigned long long)w0 | ((unsigned long long)w1 << 32); } }
    }
};
struct EpiMoeOut {
    static constexpr bool PERM = true, AFTER_DRAIN = false;
    bf16_t* Y; const int* list; PG8_LAS const int* ptab;
    __device__ __forceinline__ void operator()(const f32x4 (&acc)[2][2][4][2], const Unit& u, int wr, int wc, int fr, int fq) const {
        const int row0 = u.pm * BM + wr * 64 + fr, col0 = (u.pn & 3) * BM + wc * 32 + 8 * fq;
#pragma unroll
        for (int ai = 0; ai < 2; ++ai)
#pragma unroll
            for (int m = 0; m < 4; ++m) { const int dst = moe_tok2(list, ptab, row0 + ai * HALF + m * 16);
                if (dst >= 0) { bf16_t* rowp = Y + (size_t)dst * 1024 + col0;
#pragma unroll
                    for (int bj = 0; bj < 2; ++bj) { const f32x4 v0 = acc[ai][bj][m][0], v1 = acc[ai][bj][m][1];
                        u32x4 w; w.x = cvt_pk_bf16(v0[0], v0[1]); w.y = cvt_pk_bf16(v0[2], v0[3]); w.z = cvt_pk_bf16(v1[0], v1[1]); w.w = cvt_pk_bf16(v1[2], v1[3]);
                        *(u32x4*)(rowp + bj * HALF) = w; } } }
    }
};
struct MoeOrder {
    PG8_LAS const int* ptab; int G, c;
    __device__ __forceinline__ bool next(int i, Unit& u) const {
        const int L = i * G + c, np = __builtin_amdgcn_readfirstlane(ptab[0]);
        if (L >= np * 4) return false;
        const int p = L >> 2; u.pm = p; u.pn = __builtin_amdgcn_readfirstlane(ptab[1 + p]) * 4 + (L & 3); return true;
    }
    __device__ __forceinline__ void a_ready(const Unit&) const {}
    __device__ __forceinline__ void done(const Unit&) const {}
};
template <class Epi, class Sched, bool ALIGN_EPI = false, bool SP2 = false, bool GATHER = false>
__device__ __forceinline__ void gemm_phase(PG8_LAS unsigned char* lds, const Gemm g, const Sched& S, const Epi& E) {
    const int tid = threadIdx.x, wid = __builtin_amdgcn_readfirstlane(tid >> 6), lane = tid & 63, wr = wid >> 2, wc = wid & 3, fr = lane & 15, fq = lane >> 4;
    const int K = g.K, nt = K / BK;
    static_assert(!GATHER || SP2, "the gathered-A variant exists for the SP2 loop only");
    unsigned voffA[2], voffB[2];
    unsigned vAc[2] = {0u, 0u}, vAn[2] = {0u, 0u};
#pragma unroll
    for (int i = 0; i < 2; ++i) { int R, C; stage_rc(tid * 16 + i * 8192, R, C); const int Rb = Epi::PERM ? ((R & ~31) + perm32(R & 31)) : R;
        voffA[i] = (unsigned)(R * K + C) * 2u; voffB[i] = (unsigned)(Rb * K + C) * 2u; }
    const size_t kstep = (size_t)(BK * 2);
    const size_t hstep = (size_t)HALF * K * 2;
    const size_t tstep = 2 * hstep;
    const unsigned ldsw = (unsigned)wid * 1024u;
    const int aoff = lds_byte(wr * 64 + fr, fq * 8), boff = lds_byte(wc * 32 + fr, fq * 8);
#define PG8_SA(b, h) (((b) * 2 + (h)) * HTB)
#define PG8_SB(b, h) ((4 + (b) * 2 + (h)) * HTB)
#define PG8_STAGE(bufoff, gbase, voff) do { _Pragma("unroll") for (int _i = 0; _i < 2; ++_i) \
        __builtin_amdgcn_global_load_lds((const unsigned*)((const char*)(gbase) + (voff)[_i]), (PG8_LAS unsigned*)(lds + (bufoff) + ldsw + _i * 8192), 16, 0, 0); } while (0)
#define PG8_STAGEG(bufoff, base, pk) do { unsigned vg_[2]; _Pragma("unroll") for (int i_ = 0; i_ < 2; ++i_) { int R_, C_; stage_rc(tid * 16 + i_ * 8192, R_, C_); vg_[i_] = (((pk) >> (16 * i_)) & 0xffffu) * (unsigned)(2 * K) + (unsigned)(2 * C_); } PG8_STAGE(bufoff, base, vg_); } while (0)
#define PG8_STAGEA(bufoff, base, hh, nx) do { if constexpr (GATHER) { const unsigned pk_ = (nx) ? vAn[hh] : vAc[hh]; PG8_STAGEG(bufoff, base, pk_); } else PG8_STAGE(bufoff, (base) + (hh) * hstep, voffA); } while (0)
#define PG8_GOFF(dst, unit) do { _Pragma("unroll") for (int hh_ = 0; hh_ < 2; ++hh_) { unsigned pk_ = 0u; _Pragma("unroll") for (int i_ = 0; i_ < 2; ++i_) { int R_, C_; stage_rc(tid * 16 + i_ * 8192, R_, C_); \
        const int t2_ = moe_tok2(g.list, g.ptab, (unit).pm * BM + hh_ * HALF + R_); pk_ |= (unsigned)(t2_ < 0 ? 0 : (t2_ >> 1)) << (16 * i_); } dst[hh_] = pk_; } } while (0)
#define PG8_LDA(dst, b, h) do { _Pragma("unroll") for (int m = 0; m < 4; ++m) _Pragma("unroll") for (int k = 0; k < 2; ++k) dst[m][k] = *(const PG8_LAS bf16x8*)(lds + PG8_SA(b, h) + aoff + m * 2048 + k * 1024); } while (0)
#define PG8_LDB(dst, b, h) do { _Pragma("unroll") for (int n = 0; n < 2; ++n) _Pragma("unroll") for (int k = 0; k < 2; ++k) dst[n][k] = *(const PG8_LAS bf16x8*)(lds + PG8_SB(b, h) + boff + n * 2048 + k * 1024); } while (0)
#define PG8_MMA(ai, bj, At, Bt) do { __builtin_amdgcn_s_setprio(1); _Pragma("unroll") for (int m = 0; m < 4; ++m) _Pragma("unroll") for (int n = 0; n < 2; ++n) _Pragma("unroll") for (int k = 0; k < 2; ++k) \
        acc[ai][bj][m][n] = __builtin_amdgcn_mfma_f32_16x16x32_bf16(Bt[n][k], At[m][k], acc[ai][bj][m][n], 0, 0, 0); __builtin_amdgcn_s_setprio(0); } while (0)
#define PG8_WAIT_V(n) asm volatile("s_waitcnt vmcnt(" #n ")" ::: "memory")
#define PG8_WAIT_L(n) asm volatile("s_waitcnt lgkmcnt(" #n ")" ::: "memory")
#define PG8_BAR __builtin_amdgcn_s_barrier()
#define PG8_SCHED __builtin_amdgcn_sched_barrier(0)
    Unit cur, nxt; int ui = 0;
    if (!S.next(0, cur)) return;
    f32x4 acc[2][2][4][2];
#pragma unroll
    for (int a = 0; a < 2; ++a)
#pragma unroll
        for (int b = 0; b < 2; ++b)
#pragma unroll
            for (int m = 0; m < 4; ++m)
#pragma unroll
                for (int n = 0; n < 2; ++n) acc[a][b][m][n] = (f32x4){0.f, 0.f, 0.f, 0.f};
    bf16x8 At[4][2], B0[2][2], B1[2][2];
    const char* cA = (const char*)g.A + (GATHER ? (size_t)0 : (size_t)cur.pm * tstep); const char* cB = (const char*)g.Bt + (size_t)cur.pn * tstep;
    if constexpr (GATHER) { PG8_GOFF(vAc, cur); }
    S.a_ready(cur);
    if constexpr (SP2) {
        PG8_STAGE(PG8_SB(0, 0), cB, voffB); PG8_STAGE(PG8_SB(0, 1), cB + hstep, voffB); PG8_STAGEA(PG8_SA(0, 0), cA, 0, false); PG8_STAGEA(PG8_SA(0, 1), cA, 1, false);
        if (wr == 1) PG8_BAR;
        PG8_WAIT_V(2); PG8_BAR;
        PG8_STAGE(PG8_SB(1, 0), cB + kstep, voffB); PG8_STAGEA(PG8_SA(1, 0), cA + kstep, 0, false); PG8_STAGE(PG8_SB(1, 1), cB + hstep + kstep, voffB);
        PG8_WAIT_V(6); PG8_BAR;
    } else {
        PG8_STAGE(PG8_SB(0, 0), cB, voffB); PG8_STAGE(PG8_SA(0, 0), cA, voffA); PG8_STAGE(PG8_SB(0, 1), cB + hstep, voffB); PG8_STAGE(PG8_SA(0, 1), cA + hstep, voffA);
        if (wr == 1) PG8_BAR;
        PG8_WAIT_V(4); PG8_BAR;
        PG8_STAGE(PG8_SB(1, 0), cB + kstep, voffB); PG8_STAGE(PG8_SA(1, 0), cA + kstep, voffA); PG8_STAGE(PG8_SB(1, 1), cB + hstep + kstep, voffB);
        PG8_WAIT_V(6); PG8_BAR;
    }
    for (;;) {
        const bool has_next = S.next(ui + 1, nxt);
        const char* nA = (has_next && !GATHER) ? (const char*)g.A + (size_t)nxt.pm * tstep : cA;
        if constexpr (GATHER) { if (has_next) { PG8_GOFF(vAn, nxt); } else { vAn[0] = vAc[0]; vAn[1] = vAc[1]; } } const char* nB = has_next ? (const char*)g.Bt + (size_t)nxt.pn * tstep : cB;
        for (int t = 0; t < nt; t += 2) {
            const bool last = (t == nt - 2);
            const char* a1 = cA + (size_t)(t + 1) * kstep;
            const char* a2 = last ? nA : cA + (size_t)(t + 2) * kstep; const char* b2 = last ? nB : cB + (size_t)(t + 2) * kstep;
            const char* a3 = a2 + kstep; const char* b3 = b2 + kstep;
            if (last && has_next) S.a_ready(nxt);
            if constexpr (SP2) {
            PG8_LDB(B0, 0, 0); PG8_LDB(B1, 0, 1); PG8_SCHED; PG8_LDA(At, 0, 0); PG8_STAGEA(PG8_SA(1, 1), a1, 1, false);
            PG8_WAIT_V(8); PG8_WAIT_L(0); PG8_BAR; PG8_MMA(0, 0, At, B0); PG8_MMA(0, 1, At, B1); PG8_BAR; PG8_SCHED;
            PG8_LDA(At, 0, 1); PG8_STAGE(PG8_SB(0, 0), b2, voffB); PG8_STAGE(PG8_SB(0, 1), b2 + hstep, voffB); PG8_STAGEA(PG8_SA(0, 0), a2, 0, last);
            PG8_WAIT_V(8); PG8_WAIT_L(0); PG8_BAR; PG8_MMA(1, 0, At, B0); PG8_MMA(1, 1, At, B1); PG8_BAR; PG8_SCHED;
            PG8_LDB(B0, 1, 0); PG8_LDB(B1, 1, 1); PG8_SCHED; PG8_LDA(At, 1, 0); PG8_STAGEA(PG8_SA(0, 1), a2, 1, last);
            PG8_WAIT_V(8); PG8_WAIT_L(0); PG8_BAR; PG8_MMA(0, 0, At, B0); PG8_MMA(0, 1, At, B1); PG8_BAR; PG8_SCHED;
            PG8_LDA(At, 1, 1); PG8_STAGE(PG8_SB(1, 0), b3, voffB); PG8_STAGE(PG8_SB(1, 1), b3 + hstep, voffB); PG8_STAGEA(PG8_SA(1, 0), a3, 0, last);
            PG8_WAIT_V(8); PG8_WAIT_L(0); PG8_BAR; PG8_MMA(1, 0, At, B0); PG8_MMA(1, 1, At, B1); PG8_BAR; PG8_SCHED;
            } else {
            PG8_LDB(B0, 0, 0); PG8_SCHED; PG8_LDA(At, 0, 0); PG8_STAGE(PG8_SA(1, 1), a1 + hstep, voffA);
            PG8_WAIT_L(8); PG8_BAR; PG8_WAIT_L(0); PG8_MMA(0, 0, At, B0); PG8_BAR; PG8_SCHED;
            PG8_LDB(B1, 0, 1); PG8_STAGE(PG8_SB(0, 0), b2, voffB);
            PG8_BAR; PG8_WAIT_L(0); PG8_MMA(0, 1, At, B1); PG8_BAR;
            PG8_LDA(At, 0, 1); PG8_STAGE(PG8_SA(0, 0), a2, voffA);
            PG8_BAR; PG8_WAIT_L(0); PG8_MMA(1, 0, At, B0); PG8_BAR; PG8_SCHED;
            PG8_STAGE(PG8_SB(0, 1), b2 + hstep, voffB);
            PG8_WAIT_V(6); PG8_BAR; PG8_MMA(1, 1, At, B1); PG8_BAR;
            PG8_LDB(B0, 1, 0); PG8_SCHED; PG8_LDA(At, 1, 0); PG8_STAGE(PG8_SA(0, 1), a2 + hstep, voffA);
            PG8_WAIT_L(8); PG8_BAR; PG8_WAIT_L(0); PG8_MMA(0, 0, At, B0); PG8_BAR; PG8_SCHED;
            PG8_LDB(B1, 1, 1); PG8_STAGE(PG8_SB(1, 0), b3, voffB);
            PG8_BAR; PG8_WAIT_L(0); PG8_MMA(0, 1, At, B1); PG8_BAR;
            PG8_LDA(At, 1, 1); PG8_STAGE(PG8_SA(1, 0), a3, voffA);
            PG8_BAR; PG8_WAIT_L(0); PG8_MMA(1, 0, At, B0); PG8_BAR; PG8_SCHED;
            PG8_STAGE(PG8_SB(1, 1), b3 + hstep, voffB);
            PG8_WAIT_V(6); PG8_BAR; PG8_MMA(1, 1, At, B1); PG8_BAR;
            }
        }
        if constexpr (ALIGN_EPI) { if (wr == 0) PG8_BAR; }
        if constexpr (!Epi::AFTER_DRAIN) { E(acc, cur, wr, wc, fr, fq); S.done(cur); }
        if (!has_next) break;
#pragma unroll
        for (int a = 0; a < 2; ++a)
#pragma unroll
            for (int b = 0; b < 2; ++b)
#pragma unroll
                for (int m = 0; m < 4; ++m)
#pragma unroll
                    for (int n = 0; n < 2; ++n) acc[a][b][m][n] = (f32x4){0.f, 0.f, 0.f, 0.f};
        cur = nxt; cA = nA; cB = nB; ++ui;
        if constexpr (GATHER) { vAc[0] = vAn[0]; vAc[1] = vAn[1]; }
        if constexpr (ALIGN_EPI) { if (wr == 1) PG8_BAR; }
    }
    PG8_WAIT_V(0);
    if constexpr (!ALIGN_EPI) { if (wr == 0) PG8_BAR; }
    PG8_BAR;
    if constexpr (Epi::AFTER_DRAIN) { E.fused(acc, cur, wr, wc, fr, fq, lds, wid, lane); S.done(cur); }
#undef PG8_SA
#undef PG8_SB
#undef PG8_STAGE
#undef PG8_STAGEA
#undef PG8_STAGEG
#undef PG8_GOFF
#undef PG8_LDA
#undef PG8_LDB
#undef PG8_MMA
#undef PG8_WAIT_V
#undef PG8_WAIT_L
#undef PG8_BAR
#undef PG8_SCHED
}
}
#define XB_TMO      128
#define XB_XCNT(j)  (256  + 64 * (j))
#define XB_XSUB(j)  (1280 + 64 * (j))
#define XB_XGEN(j)  (2304 + 64 * (j))
#define XB_TOP      3328
#define XB_TOPGEN   3392
#define XCD_BAR_WORDS 3456
#define XB_SPIN_CAP (1u << 18)
#define LAS __attribute__((address_space(3)))

__device__ __forceinline__ unsigned xb_ld(unsigned* p)              { return __hip_atomic_load(p, __ATOMIC_RELAXED, __HIP_MEMORY_SCOPE_AGENT); }
__device__ __forceinline__ unsigned xb_add(unsigned* p, unsigned v) { return __hip_atomic_fetch_add(p, v, __ATOMIC_RELAXED, __HIP_MEMORY_SCOPE_AGENT); }
__device__ __forceinline__ unsigned xb_xcc_id() { return (unsigned)__builtin_amdgcn_s_getreg((3 << 11) | 20) & 0xFu; }
#define XB_SPIN(cond, bar) do { unsigned _sp = 0; while (cond) { __builtin_amdgcn_s_sleep(1); \
    if ((++_sp & 255u) == 0u) { if (xb_ld(&(bar)[XB_TMO])) break; if (_sp > XB_SPIN_CAP) { atomicAdd(&(bar)[XB_TMO], 1u); break; } } } } while (0)

struct XcdBarrier {
    unsigned* bar; unsigned x;
    volatile LAS unsigned* st;
};

__device__ __forceinline__ XcdBarrier xcd_barrier_post(unsigned* bar, volatile LAS unsigned* st) {
    XcdBarrier b; b.bar = bar; b.x = xb_xcc_id(); b.st = st;
    if (threadIdx.x == 0) (void)xb_add(&bar[XB_XCNT(b.x)], 1u);
    return b;
}
__device__ __forceinline__ void xcd_barrier_complete(unsigned* bar, unsigned x, unsigned& nloc, unsigned& nx) {
    const unsigned G = gridDim.x * gridDim.y * gridDim.z;
    unsigned sum, cnt, mine, sp = 0u;
    for (;;) {
        sum = 0u; cnt = 0u; mine = 0u;
#pragma unroll
        for (unsigned j = 0; j < 16; ++j) { const unsigned c = xb_ld(&bar[XB_XCNT(j)]); sum += c; cnt += (c > 0u) ? 1u : 0u; mine = (j == x) ? c : mine; }
        if (sum == G) break;
        __builtin_amdgcn_s_sleep(1);
        if ((++sp & 255u) == 0u) { if (xb_ld(&bar[XB_TMO])) break; if (sp > XB_SPIN_CAP) { atomicAdd(&bar[XB_TMO], 1u); break; } }
    }
    nloc = mine > 0u ? mine : 1u; nx = cnt > 0u ? cnt : 1u;
}

__device__ __forceinline__ void xcd_barrier(const XcdBarrier& b) {
    asm volatile("s_waitcnt vmcnt(0)" ::: "memory");
    __syncthreads();
    if (threadIdx.x == 0) {
        unsigned* bar = b.bar;
        __builtin_amdgcn_s_waitcnt(0);
        unsigned nloc = b.st[0], nx = b.st[1];
        if (nloc == 0u) { xcd_barrier_complete(bar, b.x, nloc, nx); b.st[0] = nloc; b.st[1] = nx; }
        const unsigned old = xb_add(&bar[XB_XSUB(b.x)], 1u);
        const unsigned gen = old / nloc;
        if (old + 1u == (gen + 1u) * nloc) {
            __builtin_amdgcn_fence(__ATOMIC_RELEASE, "agent");
            asm volatile("s_waitcnt vmcnt(0)" ::: "memory");
            const unsigned og = xb_add(&bar[XB_TOP], 1u);
            const unsigned tg = og / nx;
            if (og + 1u == (tg + 1u) * nx) xb_add(&bar[XB_TOPGEN], 1u);
            else XB_SPIN(xb_ld(&bar[XB_TOPGEN]) == tg, bar);
            __builtin_amdgcn_fence(__ATOMIC_ACQUIRE, "agent");
            xb_add(&bar[XB_XGEN(b.x)], 1u);
            asm volatile("s_waitcnt vmcnt(0)" ::: "memory");
        } else {
            XB_SPIN(xb_ld(&bar[XB_XGEN(b.x)]) == gen, bar);
            __builtin_amdgcn_fence(__ATOMIC_ACQUIRE, "agent");
            asm volatile("s_waitcnt vmcnt(0)" ::: "memory");
        }
    }
    __syncthreads();
}

struct Args { const float* in[47]; float* out; unsigned char* ws; int ph_lo, ph_hi; };
typedef const __attribute__((address_space(4))) Args* KArgsP;
__device__ __forceinline__ KArgsP fresh_args() { KArgsP p = (KArgsP)__builtin_amdgcn_kernarg_segment_ptr(); asm volatile("" : "+s"(p)); return p; }
enum { I_X = 0, I_C, I_ADA_W, I_ADA_B, I_NORM_MIX, I_NORM_FFN, I_NORM_FINAL, I_W_IN, I_W_OUT, I_CONV_W, I_CONV_B, I_WQ, I_WK, I_BI, I_BF, I_MNORM_W,
       I_RMU, I_RW0, I_RWUP, I_RA0, I_RAUP, I_RGUP, I_RKK, I_RKA, I_RRK, I_RLNW, I_RLNB, I_RV0, I_RVDN, I_RVUP,
       I_S5ARE, I_S5AIM, I_S5LDT, I_S5BRE, I_S5BIM, I_S5CRE, I_S5CIM, I_S5D, I_S5GLUW, I_S5GLUB,
       I_MWRG, I_MBRG, I_MWRE, I_MBRE, I_MW1, I_MW3, I_MW2 };

struct RmWin { __device__ __forceinline__ int operator()(int n) const { return n < 1152 ? n : (n < 1164 ? 2816 + (n - 1152) : (n < 2572 ? 1152 + (n - 1164) : 2560 + (n - 2572))); } };
struct RmId  { __device__ __forceinline__ int operator()(int n) const { return n; } };
struct RmGU  { int add; __device__ __forceinline__ int operator()(int n) const { return 8 * (n >> 2) + (n & 3) + add; } };
template <class RM>
__device__ __forceinline__ void transpose_item(const float* W, int ldw, int ncols, int k0, int n0, bf16* WT, int ldt, LAS float* scr, int lane, const RM rm) {
    const int nn = n0 + lane; const bool ok = nn < ncols; const float* src = W + (size_t)k0 * ldw + (ok ? nn : n0);
    float v[64];
#pragma unroll
    for (int kk = 0; kk < 64; ++kk) v[kk] = src[(size_t)kk * ldw];
#pragma unroll
    for (int kk = 0; kk < 64; ++kk) scr[kk * 65 + lane] = v[kk];
    LDS_WAIT(); asm volatile("" ::: "memory");
    const int c = lane & 7;
#pragma unroll
    for (int j = 0; j < 8; ++j) { const int nl = (lane >> 3) + 8 * j; const LAS float* s = scr + (8 * c) * 65 + nl;
        v4u o; o.x = pk2(s[0 * 65], s[1 * 65]); o.y = pk2(s[2 * 65], s[3 * 65]); o.z = pk2(s[4 * 65], s[5 * 65]); o.w = pk2(s[6 * 65], s[7 * 65]);
        if (n0 + nl < ncols) *(GAS v4u*)(WT + (size_t)rm(n0 + nl) * ldt + k0 + 8 * c) = o; }
    LDS_WAIT(); asm volatile("" ::: "memory");
}
__device__ __forceinline__ void moe_convert13(const float* w1, const float* w3, int l, bf16* W13, int worker, int nworkers, LAS float* scr, int lane) {
    for (int it = worker; it < NEXP * 256; it += nworkers) {
        const int e = it >> 8, r = it & 255; const size_t eo = (size_t)(l * NEXP + e) * DM * DEXP;
        if (r < 128) transpose_item(w1 + eo, DEXP, DEXP, 64 * (r >> 3), 64 * (r & 7), W13 + (size_t)e * 1024 * 1024, 1024, scr, lane, RmGU{0});
        else         transpose_item(w3 + eo, DEXP, DEXP, 64 * ((r - 128) >> 3), 64 * ((r - 128) & 7), W13 + (size_t)e * 1024 * 1024, 1024, scr, lane, RmGU{4});
    }
}
__device__ __forceinline__ void moe_convert2(const float* w2, int l, bf16* W2T, int worker, int nworkers, LAS float* scr, int lane) {
    for (int it = worker; it < NEXP * 128; it += nworkers) {
        const int e = it >> 7, r = it & 127; const size_t eo = (size_t)(l * NEXP + e) * DM * DEXP;
        transpose_item(w2 + eo, DM, DM, 64 * (r >> 4), 64 * (r & 15), W2T + (size_t)e * 1024 * 512, 512, scr, lane, RmId{});
    }
}
__device__ __forceinline__ void phase_prologue(KArgsP a, LAS unsigned char* lds, int tid, int lane, int wave, int vcu, int G) {
    unsigned char* ws = a->ws;
    LAS float* scr = (LAS float*)(lds + wave * 16640);
    const int gw = vcu * NWAVES + wave, NGW = G * NWAVES;
    bf16* WIN = (bf16*)(ws + WS_WIN); bf16* WOUT = (bf16*)(ws + WS_WOUT);
    for (int it = gw; it < 2 * 16 * 45; it += NGW) { const int l = it / (16 * 45), r = it % (16 * 45);
        transpose_item(a->in[I_W_IN] + (size_t)l * DM * IN_COLS, IN_COLS, IN_COLS, 64 * (r / 45), 64 * (r % 45), WIN + (size_t)l * NPROJ_PAD * DM, DM, scr, lane, RmWin{}); }
    for (int it = gw; it < 2 * 16 * 16; it += NGW) { const int l = it / 256, r = it % 256;
        transpose_item(a->in[I_W_OUT] + (size_t)l * DM * DM, DM, DM, 64 * (r >> 4), 64 * (r & 15), WOUT + (size_t)l * DM * DM, DM, scr, lane, RmId{}); }
    for (int it = gw; it < 2 * 244; it += NGW) { const int l = it / 244, r = 2828 + it % 244; GAS v4u* p = (GAS v4u*)(WIN + ((size_t)l * NPROJ_PAD + r) * DM);
        p[lane] = (v4u){0u, 0u, 0u, 0u}; p[lane + 64] = (v4u){0u, 0u, 0u, 0u}; }
    { float* RTW = (float*)(ws + WS_RTW);
      for (int idx = (vcu * NTHR + tid); idx < 2 * 1024 * 48; idx += G * NTHR) { const int j = idx % 48, k = (idx / 48) % 1024, l = idx / (48 * 1024);
          RTW[idx] = j < 4 ? a->in[I_MWRG][(size_t)(l * 1024 + k) * 4 + j] : (j < 36 ? a->in[I_MWRE][(size_t)(l * 1024 + k) * 32 + (j - 4)] : 0.f); } }
    { bf16* RW = (bf16*)(ws + WS_R1W);
      for (int idx = (vcu * NTHR + tid); idx < 2 * 98304 + 24576; idx += G * NTHR) { float v;
          if (idx < 2 * 98304) { const int l = idx / 98304, r = idx % 98304;
              if (r < 24576)      v = a->in[I_RWUP][(size_t)l * 64 * DBR + (r & 63) * DBR + (r >> 6)];
              else if (r < 49152) v = a->in[I_RAUP][(size_t)l * 64 * DBR + ((r - 24576) & 63) * DBR + ((r - 24576) >> 6)];
              else                v = a->in[I_RGUP][(size_t)l * 128 * DBR + ((r - 49152) & 127) * DBR + ((r - 49152) >> 7)];
          } else { const int r = idx - 2 * 98304;
              if (r < 12288) v = a->in[I_RVDN][(size_t)(r % 384) * 32 + (r / 384)];
              else           v = a->in[I_RVUP][(size_t)((r - 12288) & 31) * DBR + ((r - 12288) >> 5)]; }
          RW[idx] = (bf16)f2bf(v); } }
    for (int idx = (vcu * NTHR + tid); idx < 2 * 16 * 64; idx += G * NTHR) { const int p = idx & 63, lg = idx >> 6;
        const float lam_re = a->in[I_S5ARE][idx], lam_im = a->in[I_S5AIM][idx]; const float dt = expf(a->in[I_S5LDT][lg]); const float mag = expf(lam_re * dt), ang = lam_im * dt;
        const float are = mag * cosf(ang), aim = mag * sinf(ang); const float inv = 1.f / (lam_re * lam_re + lam_im * lam_im);
        const float cre = ((are - 1.f) * lam_re + aim * lam_im) * inv, cim = (aim * lam_re - (are - 1.f) * lam_im) * inv;
        ((float*)(ws + WS_S5AP))[idx * 2] = are; ((float*)(ws + WS_S5AP))[idx * 2 + 1] = aim;
        const float* br = a->in[I_S5BRE] + (size_t)idx * 16; const float* bi = a->in[I_S5BIM] + (size_t)idx * 16; bf16* o = (bf16*)(ws + WS_S5BB) + ((size_t)lg * 128 + 2 * p) * 16;
        for (int c = 0; c < 16; ++c) { o[c] = (bf16)f2bf(cre * br[c] - cim * bi[c]); o[16 + c] = (bf16)f2bf(cre * bi[c] + cim * br[c]); } }
    { bf16* CM = (bf16*)(ws + WS_S5CM);
      for (int idx = (vcu * NTHR + tid); idx < 2 * 16 * 16 * 128; idx += G * NTHR) { const int k = idx & 127, lgc = idx >> 7;
          CM[idx] = (bf16)f2bf((k & 1) ? -a->in[I_S5CIM][(size_t)lgc * 64 + (k >> 1)] : a->in[I_S5CRE][(size_t)lgc * 64 + (k >> 1)]); } }
    for (int it = gw; it < 2 * 16; it += NGW) { const int l = it >> 4, r = it & 15;
        transpose_item(a->in[I_S5GLUW] + (size_t)l * DC * DC, DC, DC, 64 * (r >> 2), 64 * (r & 3), (bf16*)(ws + WS_GLUT) + (size_t)l * DC * DC, DC, scr, lane, RmId{}); }
    { bf16* MLW = (bf16*)(ws + WS_MLW);
      for (int idx = (vcu * NTHR + tid); idx < 2 * NH * 2 * 4096; idx += G * NTHR) { const int d = idx & 63, e = (idx >> 6) & 63, which = (idx >> 12) & 1, lh = idx >> 13;
          MLW[idx] = (bf16)f2bf(a->in[which ? I_WK : I_WQ][(size_t)lh * 4096 + d * 64 + e]); } }
    __syncthreads();
    if (vcu < 192) {
        const int q = vcu, l = q / 96, cb = (q >> 3) % 12, kc = q & 7;
        LAS float* cond = (LAS float*)lds;
        { const int b = tid >> 7, kk = tid & 127; const float cv = a->in[I_C][b * DM + kc * 128 + kk]; cond[tid] = cv / (1.f + __expf(-cv)); }
        __syncthreads();
        const int col = cb * 512 + tid; const float* wp = a->in[I_ADA_W] + ((size_t)l * DM + kc * 128) * 6144 + col;
        float acc0 = 0.f, acc1 = 0.f, acc2 = 0.f, acc3 = 0.f;
#pragma unroll 8
        for (int kk = 0; kk < 128; ++kk) { const float w = wp[(size_t)kk * 6144]; acc0 += cond[kk] * w; acc1 += cond[128 + kk] * w; acc2 += cond[256 + kk] * w; acc3 += cond[384 + kk] * w; }
        const float bias = (kc == 0) ? a->in[I_ADA_B][l * 6144 + col] : 0.f;
        float* MP = (float*)(ws + WS_MODP) + ((size_t)(kc * 2 + l) * 4) * 6144 + col;
        MP[0] = acc0 + bias; MP[6144] = acc1 + bias; MP[2 * 6144] = acc2 + bias; MP[3 * 6144] = acc3 + bias;
    }
}

__device__ __forceinline__ float modval(const unsigned char* ws, bool part, int l, int b, int idx) {
    if (!part) return ((const float*)(ws + WS_MODF))[(size_t)(l * 4 + b) * 6144 + idx];
    const float* mp = (const float*)(ws + WS_MODP) + (size_t)(l * 4 + b) * 6144 + idx; float s = 0.f;
#pragma unroll
    for (int kc = 0; kc < 8; ++kc) s += mp[(size_t)kc * 2 * 4 * 6144];
    return s;
}
template <int MODE, bool COMBINE>
__device__ __forceinline__ void phase_rownorm(KArgsP a, LAS unsigned char* lds, int tid, int lane, int wave, int G,
                                              const float* xsrc, float* xdst, const float* gvec, bool part, int l, int isc  , int lprev) {
    unsigned char* ws = a->ws;
    LAS float* sc = (LAS float*)lds; LAS float* sh = sc + 1024; LAS float* gt = sh + 1024;
    bf16* HN = (bf16*)(ws + WS_HN); const bf16* YM = (const bf16*)(ws + WS_YMOE); const float* TW = (const float*)(ws + WS_TOKW);
    for (int c = blockIdx.x; c < NTOK / 128; c += G) {
        const int b = c >> 6;
        __syncthreads();
        for (int j = tid; j < 1024; j += NTHR) {
            if (MODE == 0) { sc[j] = gvec[j] * (1.f + modval(ws, part, l, b, (isc + 1) * 1024 + j)); sh[j] = modval(ws, part, l, b, isc * 1024 + j); }
            else { sc[j] = gvec[j]; sh[j] = 0.f; }
            if (COMBINE) gt[j] = 1.f + modval(ws, false, lprev, b, 5 * 1024 + j);
        }
        __syncthreads();
        f32x4 vn[4]; v2u yn0[4], yn1[4]; float wn0 = 0.f, wn1 = 0.f;
        { const int row = c * 128 + wave * 16; const GAS f32x4* xr = (const GAS f32x4*)(xsrc + (size_t)row * DM) + lane;
#pragma unroll
          for (int j = 0; j < 4; ++j) vn[j] = xr[64 * j];
          if (COMBINE) { wn0 = TW[2 * row]; wn1 = TW[2 * row + 1]; const GAS v2u* y0 = (const GAS v2u*)(YM + (size_t)(2 * row) * DM) + lane; const GAS v2u* y1 = (const GAS v2u*)(YM + (size_t)(2 * row + 1) * DM) + lane;
#pragma unroll
              for (int j = 0; j < 4; ++j) { yn0[j] = y0[64 * j]; yn1[j] = y1[64 * j]; } } }
        for (int i = 0; i < 16; ++i) {
            const int row = c * 128 + wave * 16 + i;
            f32x4 v[4]; v2u q0[4], q1[4]; const float w0 = wn0, w1 = wn1;
#pragma unroll
            for (int j = 0; j < 4; ++j) { v[j] = vn[j]; q0[j] = yn0[j]; q1[j] = yn1[j]; }
            if (i + 1 < 16) { const int rn = row + 1; const GAS f32x4* xr = (const GAS f32x4*)(xsrc + (size_t)rn * DM) + lane;
#pragma unroll
                for (int j = 0; j < 4; ++j) vn[j] = xr[64 * j];
                if (COMBINE) { wn0 = TW[2 * rn]; wn1 = TW[2 * rn + 1]; const GAS v2u* y0 = (const GAS v2u*)(YM + (size_t)(2 * rn) * DM) + lane; const GAS v2u* y1 = (const GAS v2u*)(YM + (size_t)(2 * rn + 1) * DM) + lane;
#pragma unroll
                    for (int j = 0; j < 4; ++j) { yn0[j] = y0[64 * j]; yn1[j] = y1[64 * j]; } } }
            if (COMBINE) {
#pragma unroll
                for (int j = 0; j < 4; ++j) { const v2u p0 = q0[j], p1 = q1[j]; const f32x4 g4 = *(const LAS f32x4*)(gt + lane * 4 + 256 * j);
                    f32x4 m; m.x = w0 * bflo(p0.x) + w1 * bflo(p1.x); m.y = w0 * bfhi(p0.x) + w1 * bfhi(p1.x); m.z = w0 * bflo(p0.y) + w1 * bflo(p1.y); m.w = w0 * bfhi(p0.y) + w1 * bfhi(p1.y);
                    v[j] = v[j] + g4 * m; }
                if (MODE == 0) { GAS f32x4* xo = (GAS f32x4*)(xdst + (size_t)row * DM) + lane;
#pragma unroll
                    for (int j = 0; j < 4; ++j) xo[64 * j] = v[j]; }
            }
            float ss = 0.f;
#pragma unroll
            for (int j = 0; j < 4; ++j) ss += (v[j].x * v[j].x + v[j].y * v[j].y) + (v[j].z * v[j].z + v[j].w * v[j].w);
            const float rstd = rsqrtf(wave_sum(ss) * (1.f / DM) + NORM_EPS);
            if (MODE == 0) {
                GAS v2u* o = (GAS v2u*)(HN + (size_t)row * DM) + lane;
#pragma unroll
                for (int j = 0; j < 4; ++j) { const f32x4 s4 = *(const LAS f32x4*)(sc + lane * 4 + 256 * j), h4 = *(const LAS f32x4*)(sh + lane * 4 + 256 * j); const f32x4 h = v[j] * rstd * s4 + h4;
                    v2u w; w.x = pk2(h.x, h.y); w.y = pk2(h.z, h.w); o[64 * j] = w; }
            } else {
                GAS f32x4* o = (GAS f32x4*)(xdst + (size_t)row * DM) + lane;
#pragma unroll
                for (int j = 0; j < 4; ++j) { const f32x4 s4 = *(const LAS f32x4*)(sc + lane * 4 + 256 * j); o[64 * j] = v[j] * rstd * s4; }
            }
        }
    }
}
__device__ __forceinline__ void mod_finalize(unsigned char* ws, int tid, int G) {
    float* MF = (float*)(ws + WS_MODF);
    for (int idx = blockIdx.x * NTHR + tid; idx < 2 * 4 * 6144; idx += G * NTHR) { const float* mp = (const float*)(ws + WS_MODP) + idx; float s = 0.f;
#pragma unroll
        for (int kc = 0; kc < 8; ++kc) s += mp[(size_t)kc * 2 * 4 * 6144];
        MF[idx] = s; }
}

typedef float f32x4m __attribute__((ext_vector_type(4)));
__device__ __forceinline__ void phase_router(KArgsP a, LAS unsigned char* lds, int tid, int lane, int wave, int G, int l) {
    unsigned char* ws = a->ws;
    LAS float* sc = (LAS float*)lds; LAS float* sh = sc + 1024; LAS float* rstd_s = sh + 1024  ; LAS float* cvec = rstd_s + 128  ; LAS float* cpart = cvec + 64  ;
    LAS float* lg = cpart + 8 * 48  ; LAS int* hist = (LAS int*)(lg + 8 * 16 * 48)  ; LAS int* basev = hist + 32; LAS int* asg_e = basev + 32  ; LAS int* asg_lp = asg_e + 256;
    bf16* HN = (bf16*)(ws + WS_HN); const float* x = a->out; const float* RTW = (const float*)(ws + WS_RTW) + (size_t)l * 1024 * 48;
    int* TOKE = (int*)(ws + WS_TOKE); float* TOKW = (float*)(ws + WS_TOKW); int* LIST = (int*)(ws + WS_LIST); unsigned* CNT = (unsigned*)(ws + WS_CTL) + CW_CNT + l * 32;
    const float* gvec = a->in[I_NORM_FFN] + l * DM;
    for (int c = blockIdx.x; c < NTOK / 128; c += G) {
        const int b = c >> 6;
        __syncthreads();
        for (int j = tid; j < 1024; j += NTHR) { sc[j] = gvec[j] * (1.f + modval(ws, false, l, b, 4 * 1024 + j)); sh[j] = modval(ws, false, l, b, 3 * 1024 + j); }
        if (tid < 32) hist[tid] = 0;
        __syncthreads();
        if (tid < 384) { const int j = tid % 48, part = tid / 48; float s = 0.f;
            for (int k = part * 128; k < part * 128 + 128; ++k) s += sh[k] * RTW[(size_t)k * 48 + j];
            cpart[part * 48 + j] = s; }
        { f32x4 vn[4];
          { const GAS f32x4* xr = (const GAS f32x4*)(x + (size_t)(c * 128 + wave * 16) * DM) + lane;
#pragma unroll
            for (int j = 0; j < 4; ++j) vn[j] = xr[64 * j]; }
          for (int i = 0; i < 16; ++i) {
            const int row = c * 128 + wave * 16 + i;
            f32x4 v[4]; float ss = 0.f;
#pragma unroll
            for (int j = 0; j < 4; ++j) { v[j] = vn[j]; ss += (v[j].x * v[j].x + v[j].y * v[j].y) + (v[j].z * v[j].z + v[j].w * v[j].w); }
            if (i + 1 < 16) { const GAS f32x4* xr = (const GAS f32x4*)(x + (size_t)(row + 1) * DM) + lane;
#pragma unroll
                for (int j = 0; j < 4; ++j) vn[j] = xr[64 * j]; }
            const float rstd = rsqrtf(wave_sum(ss) * (1.f / DM) + NORM_EPS);
            if (lane == 0) rstd_s[wave * 16 + i] = rstd;
            GAS v2u* o = (GAS v2u*)(HN + (size_t)row * DM) + lane;
#pragma unroll
            for (int j = 0; j < 4; ++j) { const f32x4 s4 = *(const LAS f32x4*)(sc + lane * 4 + 256 * j), h4 = *(const LAS f32x4*)(sh + lane * 4 + 256 * j); const f32x4 h = v[j] * rstd * s4 + h4;
                v2u w; w.x = pk2(h.x, h.y); w.y = pk2(h.z, h.w); o[64 * j] = w; }
          } }
        __syncthreads();
        if (tid < 48) { float s = 0.f;
#pragma unroll
            for (int p = 0; p < 8; ++p) s += cpart[p * 48 + tid];
            s += tid < 4 ? a->in[I_MBRG][l * 4 + tid] : (tid < 36 ? a->in[I_MBRE][l * 32 + tid - 4] : 0.f); cvec[tid] = s; }
        {
            const int i16 = lane & 15, kq = lane >> 4, r0 = c * 128 + wave * 16;
            f32x4m acc0 = {0.f, 0.f, 0.f, 0.f}, acc1 = acc0, acc2 = acc0;
            const float* xrow = x + (size_t)(r0 + i16) * DM + 4 * kq;
#pragma unroll 4
            for (int k0 = 0; k0 < DM; k0 += 16) {
                const f32x4 xv = *(const GAS f32x4*)(xrow + k0); const f32x4 sv = *(const LAS f32x4*)(sc + k0 + 4 * kq);
                const float* wp = RTW + (size_t)(k0 + 4 * kq) * 48 + i16;
#pragma unroll
                for (int j = 0; j < 4; ++j) { const float av = xv[j] * sv[j];
                    acc0 = __builtin_amdgcn_mfma_f32_16x16x4f32(av, wp[j * 48], acc0, 0, 0, 0);
                    acc1 = __builtin_amdgcn_mfma_f32_16x16x4f32(av, wp[j * 48 + 16], acc1, 0, 0, 0);
                    acc2 = __builtin_amdgcn_mfma_f32_16x16x4f32(av, wp[j * 48 + 32], acc2, 0, 0, 0); }
            }
            __syncthreads();
            LAS float* lw = lg + wave * 16 * 48;
#pragma unroll
            for (int r = 0; r < 4; ++r) { const int rr = 4 * kq + r; const float rs = rstd_s[wave * 16 + rr];
                lw[rr * 48 + i16] = acc0[r] * rs + cvec[i16]; lw[rr * 48 + 16 + i16] = acc1[r] * rs + cvec[16 + i16]; lw[rr * 48 + 32 + i16] = acc2[r] * rs + cvec[32 + i16]; }
            LDS_WAIT(); asm volatile("" ::: "memory");
            if (lane < 16) {
                const LAS float* lr = lw + lane * 48; const int row = r0 + lane;
                float g0 = lr[0], g1 = lr[1], g2 = lr[2], g3 = lr[3]; const float gm = fmaxf(fmaxf(g0, g1), fmaxf(g2, g3));
                float p0 = __expf(g0 - gm), p1 = __expf(g1 - gm), p2 = __expf(g2 - gm), p3 = __expf(g3 - gm); const float inv = 1.f / (p0 + p1 + p2 + p3);
                p0 *= inv; p1 *= inv; p2 *= inv; p3 *= inv;
                int gi = 0; float gp = p0; if (p1 > gp) { gp = p1; gi = 1; } if (p2 > gp) { gp = p2; gi = 2; } if (p3 > gp) { gp = p3; gi = 3; }
                float ev0 = -3.4e38f, ev1 = -3.4e38f; int e0 = 0, e1 = 0;
#pragma unroll
                for (int j = 0; j < 8; ++j) { const float s = lr[4 + gi * 8 + j]; if (s > ev0) { ev1 = ev0; e1 = e0; ev0 = s; e0 = j; } else if (s > ev1) { ev1 = s; e1 = j; } }
                const float q = __expf(ev1 - ev0), w0 = gp / (1.f + q), w1 = gp * q / (1.f + q);
                e0 += gi * 8; e1 += gi * 8;
                TOKE[2 * row] = e0; TOKE[2 * row + 1] = e1; TOKW[2 * row] = w0; TOKW[2 * row + 1] = w1;
                const int a0 = 2 * (wave * 16 + lane);
                asg_e[a0] = e0; asg_e[a0 + 1] = e1; asg_lp[a0] = atomicAdd((int*)&hist[e0], 1); asg_lp[a0 + 1] = atomicAdd((int*)&hist[e1], 1);
            }
        }
        __syncthreads();
        if (tid < 32) { const int h = hist[tid]; basev[tid] = h ? (int)atomicAdd(CNT + tid, (unsigned)h) : 0; }
        __syncthreads();
        if (tid < 256) { const int e = asg_e[tid]; LIST[(size_t)e * 65536 + basev[e] + asg_lp[tid]] = (c * 128) * 2 + tid; }
    }
}
__device__ __forceinline__ void build_ptab(const unsigned* CNT, LAS int* ptab, LAS int* pst, LAS int* cnt, int tid) {
    __syncthreads();
    if (tid == 0) { int np = 0;
        for (int e = 0; e < NEXP; ++e) { const int ce = (int)__hip_atomic_load(CNT + e, RLX_AGENT); cnt[e] = ce; pst[e] = np * 256; const int pe = (ce + 255) >> 8;
            for (int p = 0; p < pe; ++p) ptab[1 + np + p] = e;
            np += pe; }
        ptab[0] = np; }
    __syncthreads();
}
__device__ __forceinline__ void phase_gather(KArgsP a, LAS unsigned char* lds, int tid, int lane, int wave, int vcu, int G, int l) {
    unsigned char* ws = a->ws;
    LAS int* ptab = (LAS int*)lds; LAS int* pst = ptab + 512; LAS int* cnt = pst + 32;
    build_ptab((const unsigned*)(ws + WS_CTL) + CW_CNT + l * 32, ptab, pst, cnt, tid);
    const bf16* HN = (const bf16*)(ws + WS_HN); bf16* XG = (bf16*)(ws + WS_XG); int* ROWMAP = (int*)(ws + WS_ROWMAP); const int* LIST = (const int*)(ws + WS_LIST);
    const int nrows = ptab[0] * 256;
    for (int row0 = (vcu * NWAVES + wave) * 8; row0 < nrows; row0 += G * NWAVES * 8) {
        int tok2[8]; v4u p0[8], p1[8];
#pragma unroll
        for (int j = 0; j < 8; ++j) { const int row = row0 + j, e = ptab[1 + (row >> 8)], pos = row - pst[e]; tok2[j] = (pos < cnt[e]) ? LIST[(size_t)e * 65536 + pos] : -1; }
#pragma unroll
        for (int j = 0; j < 8; ++j) { if (tok2[j] >= 0) { const GAS v4u* s = (const GAS v4u*)(HN + (size_t)(tok2[j] >> 1) * DM) + lane; p0[j] = s[0]; p1[j] = s[64]; } else { p0[j] = (v4u){0u, 0u, 0u, 0u}; p1[j] = p0[j]; } }
#pragma unroll
        for (int j = 0; j < 8; ++j) { GAS v4u* d = (GAS v4u*)(XG + (size_t)(row0 + j) * DM) + lane; d[0] = p0[j]; d[64] = p1[j]; if (lane == 0) ROWMAP[row0 + j] = tok2[j]; }
    }
}

__device__ __forceinline__ void phase_rowmap(KArgsP a, LAS unsigned char* lds, int tid, int vcu, int G, int l) {
    unsigned char* ws = a->ws;
    LAS int* ptab = (LAS int*)lds; LAS int* pst = ptab + 512; LAS int* cnt = pst + 32;
    build_ptab((const unsigned*)(ws + WS_CTL) + CW_CNT + l * 32, ptab, pst, cnt, tid);
    int* ROWMAP = (int*)(ws + WS_ROWMAP); const int* LIST = (const int*)(ws + WS_LIST);
    const int nrows = ptab[0] * 256;
    for (int row = vcu * NTHR + tid; row < nrows; row += G * NTHR) { const int e = ptab[1 + (row >> 8)], pos = row - pst[e]; ROWMAP[row] = (pos < cnt[e]) ? LIST[(size_t)e * 65536 + pos] : -1; }
}

typedef short bf16x8 __attribute__((ext_vector_type(8)));
constexpr int MT = 72;
constexpr int ML_XP = 0;
constexpr int ML_CX = 17152;
constexpr int ML_WQ = ML_CX + 9216, ML_WK = ML_WQ + 9216;
constexpr int ML_Q = ML_WK + 9216, ML_K = ML_Q + 9216;
constexpr int ML_S = ML_K + 9216;
constexpr int ML_VT = ML_S + 9216;
constexpr int ML_CT = ML_VT + 11520;
constexpr int ML_H = ML_CT + 11520;
constexpr int ML_SM = ML_H + 16640;
static_assert(ML_SM + 2048 <= RING_BYTES, "mLSTM LDS map");
__device__ __forceinline__ float logsigmoidf_(float x) { return fminf(x, 0.f) - log1pf(__expf(-fabsf(x))); }
__device__ __forceinline__ void mma64(const LAS bf16* A, int arow0, const LAS bf16* Bt, int brow0, int lane, f32x4& acc) {
    const LAS bf16* ap = A + (arow0 + (lane & 15)) * MT + 8 * (lane >> 4); const LAS bf16* bp = Bt + (brow0 + (lane & 15)) * MT + 8 * (lane >> 4);
    const bf16x8 a0 = *(const LAS bf16x8*)ap, a1 = *(const LAS bf16x8*)(ap + 32), b0 = *(const LAS bf16x8*)bp, b1 = *(const LAS bf16x8*)(bp + 32);
    acc = __builtin_amdgcn_mfma_f32_16x16x32_bf16(a0, b0, acc, 0, 0, 0); acc = __builtin_amdgcn_mfma_f32_16x16x32_bf16(a1, b1, acc, 0, 0, 0);
}
__device__ __forceinline__ void ml_front(KArgsP a, LAS unsigned char* lds, int tid, int l, int b, int c, int h, bool want_q) {
    const bf16* PROJ = (const bf16*)(a->ws + WS_PROJ); const size_t row0 = (size_t)b * SEQ + c * 64;
    LAS float* xp = (LAS float*)(lds + ML_XP);
    for (int idx = tid; idx < 67 * 8; idx += NTHR) { const int r = idx >> 3, c8 = idx & 7, tr = c * 64 + r - 3; LAS float* d = xp + r * 64 + c8 * 8;
        if (tr >= 0) { const v4u p = *(const GAS v4u*)(PROJ + ((size_t)b * SEQ + tr) * NPROJ + PC_QK + h * 64 + c8 * 8);
            *(LAS f32x4*)d = (f32x4){bflo(p.x), bfhi(p.x), bflo(p.y), bfhi(p.y)}; *(LAS f32x4*)(d + 4) = (f32x4){bflo(p.z), bfhi(p.z), bflo(p.w), bfhi(p.w)}; }
        else { *(LAS f32x4*)d = (f32x4){0.f, 0.f, 0.f, 0.f}; *(LAS f32x4*)(d + 4) = (f32x4){0.f, 0.f, 0.f, 0.f}; } }
    {
        const int t = tid >> 3, vg = tid & 7; LAS bf16* VT = (LAS bf16*)(lds + ML_VT);
        const v4u p = *(const GAS v4u*)(PROJ + (row0 + t) * NPROJ + PC_V + h * 64 + vg * 8);
        const unsigned w[4] = {p.x, p.y, p.z, p.w};
#pragma unroll
        for (int j = 0; j < 4; ++j) { VT[(vg * 8 + 2 * j) * MT + t] = (bf16)(w[j] & 0xffffu); VT[(vg * 8 + 2 * j + 1) * MT + t] = (bf16)(w[j] >> 16); }
        for (int idx = tid; idx < 16 * 64; idx += NTHR) VT[(64 + (idx >> 6)) * MT + (idx & 63)] = (idx < 64) ? (bf16)0x3F80 : (bf16)0;
        const bf16* WT = (const bf16*)(a->ws + WS_MLW) + (size_t)((l * NH + h) * 2) * 4096;
        const int e = tid >> 3, d8 = tid & 7;
        if (want_q) *(LAS v4u*)(lds + ML_WQ + (e * MT + d8 * 8) * 2) = *(const GAS v4u*)(WT + e * 64 + d8 * 8);
        *(LAS v4u*)(lds + ML_WK + (e * MT + d8 * 8) * 2) = *(const GAS v4u*)(WT + 4096 + e * 64 + d8 * 8);
    }
    __syncthreads();
    const float* cw = a->in[I_CONV_W] + (size_t)l * 4 * DA + h * 64; const float* cb = a->in[I_CONV_B] + (size_t)l * DA + h * 64;
    {
        const int t = tid >> 3, c8 = (tid & 7) * 8; float s[8];
#pragma unroll
        for (int j = 0; j < 8; ++j) s[j] = cb[c8 + j];
#pragma unroll
        for (int q = 0; q < 4; ++q) { const f32x4 x0 = *(const LAS f32x4*)(xp + (t + q) * 64 + c8), x1 = *(const LAS f32x4*)(xp + (t + q) * 64 + c8 + 4); const float* w = cw + q * DA + c8;
            s[0] += x0.x * w[0]; s[1] += x0.y * w[1]; s[2] += x0.z * w[2]; s[3] += x0.w * w[3]; s[4] += x1.x * w[4]; s[5] += x1.y * w[5]; s[6] += x1.z * w[6]; s[7] += x1.w * w[7]; }
#pragma unroll
        for (int j = 0; j < 8; ++j) s[j] = s[j] / (1.f + __expf(-s[j]));
        v4u o; o.x = pk2(s[0], s[1]); o.y = pk2(s[2], s[3]); o.z = pk2(s[4], s[5]); o.w = pk2(s[6], s[7]);
        *(LAS v4u*)(lds + ML_CX + (t * MT + c8) * 2) = o;
    }
}
__device__ __forceinline__ void phase_m1(KArgsP a, LAS unsigned char* lds, int tid, int lane, int wave, int vcu, int G, int l) {
    unsigned char* ws = a->ws; const float* GT = (const float*)(ws + WS_GATES);
    float* CLOC = (float*)(ws + WS_CLOC); float* MLG = (float*)(ws + WS_MSC); float* MLM = MLG + 4096;
    LAS float* sm = (LAS float*)(lds + ML_SM);
    for (int u = vcu; u < NUNIT_M; u += G) {
        const int h = u % NH, c = (u / NH) % NCH, b = u / (NH * NCH); const size_t row0 = (size_t)b * SEQ + c * 64;
        __syncthreads();
        ml_front(a, lds, tid, l, b, c, h, false);
        if (wave == 0) {
            const float ig = GT[(row0 + lane) * 16 + h] + a->in[I_BI][l * NH + h];
            const float fl = logsigmoidf_(GT[(row0 + lane) * 16 + 6 + h] + a->in[I_BF][l * NH + h]);
            float bc = fl;
#pragma unroll
            for (int o = 1; o < 64; o <<= 1) { const float t = __shfl_up(bc, o); if (lane >= o) bc += t; }
            const float gtot = __shfl(bc, 63); const float lw = gtot - bc + ig; const float ml = wave_max(lw);
            sm[lane] = __expf(lw - ml);
            if (lane == 0) { MLG[u] = gtot; MLM[u] = ml; }
        }
        __syncthreads();
        {
            const int rt = wave >> 1; LAS bf16* KT = (LAS bf16*)(lds + ML_K);
#pragma unroll
            for (int q = 0; q < 2; ++q) { const int ct = 2 * (wave & 1) + q; f32x4 acc = {0.f, 0.f, 0.f, 0.f};
                mma64((const LAS bf16*)(lds + ML_CX), 16 * rt, (const LAS bf16*)(lds + ML_WK), 16 * ct, lane, acc);
                const int t0 = 16 * rt + 4 * (lane >> 4), e = 16 * ct + (lane & 15);
                const float w0 = sm[t0] * 0.125f, w1 = sm[t0 + 1] * 0.125f, w2 = sm[t0 + 2] * 0.125f, w3 = sm[t0 + 3] * 0.125f;
                v2u o; o.x = pk2(acc[0] * w0, acc[1] * w1); o.y = pk2(acc[2] * w2, acc[3] * w3);
                *(LAS v2u*)(KT + e * MT + t0) = o; }
        }
        __syncthreads();
        {
            const int ct = wave & 3, r_lo = wave < 4 ? 0 : 3, r_hi = wave < 4 ? 3 : 5; float* cl = CLOC + (size_t)u * CL_STRIDE;
            for (int rt = r_lo; rt < r_hi; ++rt) { f32x4 acc = {0.f, 0.f, 0.f, 0.f};
                mma64((const LAS bf16*)(lds + ML_VT), 16 * rt, (const LAS bf16*)(lds + ML_K), 16 * ct, lane, acc);
                const int v0 = 16 * rt + 4 * (lane >> 4), e = 16 * ct + (lane & 15);
                if (rt < 4) {
#pragma unroll
                    for (int r = 0; r < 4; ++r) cl[(v0 + r) * 64 + e] = acc[r];
                } else if ((lane >> 4) == 0) cl[4096 + e] = acc[0]; }
        }
    }
}
__device__ __forceinline__ void phase_m2(unsigned char* ws, int tid, int wg, int nwg) {
    float* CLOC = (float*)(ws + WS_CLOC); const float* MLG = (const float*)(ws + WS_MSC); const float* MLM = MLG + 4096; float* MST = (float*)(ws + WS_MSC) + 8192;
    for (int idx = wg * NTHR + tid; idx < NB * NH * CL_STRIDE; idx += nwg * NTHR) {
        const int e = idx % CL_STRIDE, bh = idx / CL_STRIDE, b = bh / NH, h = bh % NH;
        float m = 0.f, cs = 0.f;
        for (int c0 = 0; c0 < NCH; c0 += 8) {
            float cl[8], g[8], ml[8];
#pragma unroll
            for (int j = 0; j < 8; ++j) { const int u = (b * NCH + c0 + j) * NH + h; cl[j] = CLOC[(size_t)u * CL_STRIDE + e]; g[j] = MLG[u]; ml[j] = MLM[u]; }
#pragma unroll
            for (int j = 0; j < 8; ++j) { const int u = (b * NCH + c0 + j) * NH + h;
                CLOC[(size_t)u * CL_STRIDE + e] = cs; if (e == 0) MST[u] = m;
                const float mn = fmaxf(g[j] + m, ml[j]); const float ao = __expf(g[j] + m - mn), al = __expf(ml[j] - mn);
                cs = ao * cs + al * cl[j]; m = mn; }
        }
    }
}
__device__ __forceinline__ void phase_m3(KArgsP a, LAS unsigned char* lds, int tid, int lane, int wave, int vcu, int G, int l) {
    unsigned char* ws = a->ws; const bf16* PROJ = (const bf16*)(ws + WS_PROJ); const float* GT = (const float*)(ws + WS_GATES);
    const float* CLOC = (const float*)(ws + WS_CLOC); const float* MST = (const float*)(ws + WS_MSC) + 8192; bf16* YC = (bf16*)(ws + WS_YC);
    LAS float* sm = (LAS float*)(lds + ML_SM); LAS float* hb = (LAS float*)(lds + ML_H);
    for (int u = vcu; u < NUNIT_M; u += G) {
        const int h = u % NH, c = (u / NH) % NCH, b = u / (NH * NCH); const size_t row0 = (size_t)b * SEQ + c * 64;
        __syncthreads();
        ml_front(a, lds, tid, l, b, c, h, true);
        {
            const float* cl = CLOC + (size_t)u * CL_STRIDE; LAS bf16* CT = (LAS bf16*)(lds + ML_CT);
            for (int idx = tid; idx < 65 * 16; idx += NTHR) { const int r = idx >> 4, c4 = idx & 15; const f32x4 v = *(const GAS f32x4*)(cl + r * 64 + c4 * 4);
                v2u o; o.x = pk2(v.x, v.y); o.y = pk2(v.z, v.w); *(LAS v2u*)(CT + r * MT + c4 * 4) = o; }
            for (int idx = tid; idx < 15 * 64; idx += NTHR) CT[(65 + (idx >> 6)) * MT + (idx & 63)] = 0;
        }
        if (wave == 0) {
            const float ig = GT[(row0 + lane) * 16 + h] + a->in[I_BI][l * NH + h];
            const float fl = logsigmoidf_(GT[(row0 + lane) * 16 + 6 + h] + a->in[I_BF][l * NH + h]);
            float bc = fl;
#pragma unroll
            for (int o = 1; o < 64; o <<= 1) { const float t = __shfl_up(bc, o); if (lane >= o) bc += t; }
            float pm = ig - bc;
#pragma unroll
            for (int o = 1; o < 64; o <<= 1) { const float t = __shfl_up(pm, o); if (lane >= o) pm = fmaxf(pm, t); }
            const float mst = MST[u]; const float inter = bc + mst, mt = fmaxf(inter, bc + pm);
            sm[lane] = ig - bc; sm[64 + lane] = bc - mt; sm[128 + lane] = __expf(inter - mt); sm[192 + lane] = __expf(-mt);
        }
        __syncthreads();
        {
            const int rt = wave >> 1; LAS bf16* Qs = (LAS bf16*)(lds + ML_Q); LAS bf16* Ks = (LAS bf16*)(lds + ML_K);
#pragma unroll
            for (int q = 0; q < 2; ++q) { const int ct = 2 * (wave & 1) + q; f32x4 aq = {0.f, 0.f, 0.f, 0.f}, ak = {0.f, 0.f, 0.f, 0.f};
                mma64((const LAS bf16*)(lds + ML_CX), 16 * rt, (const LAS bf16*)(lds + ML_WQ), 16 * ct, lane, aq);
                mma64((const LAS bf16*)(lds + ML_CX), 16 * rt, (const LAS bf16*)(lds + ML_WK), 16 * ct, lane, ak);
                const int t0 = 16 * rt + 4 * (lane >> 4), e = 16 * ct + (lane & 15);
#pragma unroll
                for (int r = 0; r < 4; ++r) { Qs[(t0 + r) * MT + e] = (bf16)f2bf(aq[r]); Ks[(t0 + r) * MT + e] = (bf16)f2bf(ak[r] * 0.125f); } }
        }
        __syncthreads();
        {
            const int rt = wave >> 1; LAS bf16* Ss = (LAS bf16*)(lds + ML_S);
#pragma unroll
            for (int q = 0; q < 2; ++q) { const int ct = 2 * (wave & 1) + q; f32x4 acc = {0.f, 0.f, 0.f, 0.f};
                if (ct <= rt) mma64((const LAS bf16*)(lds + ML_Q), 16 * rt, (const LAS bf16*)(lds + ML_K), 16 * ct, lane, acc);
                const int t0 = 16 * rt + 4 * (lane >> 4), s = 16 * ct + (lane & 15); const float qs = sm[s];
#pragma unroll
                for (int r = 0; r < 4; ++r) { const int t = t0 + r; Ss[t * MT + s] = (bf16)f2bf((s <= t) ? acc[r] * __expf(sm[64 + t] + qs) : 0.f); } }
        }
        __syncthreads();
        {
            const int rt = wave >> 1, nt = (wave & 1) ? 2 : 3;
            for (int q = 0; q < nt; ++q) { const int ct = (wave & 1) ? 2 + q : (q < 2 ? q : 4); f32x4 aA = {0.f, 0.f, 0.f, 0.f}, aB = {0.f, 0.f, 0.f, 0.f};
                mma64((const LAS bf16*)(lds + ML_Q), 16 * rt, (const LAS bf16*)(lds + ML_CT), 16 * ct, lane, aA);
                mma64((const LAS bf16*)(lds + ML_S), 16 * rt, (const LAS bf16*)(lds + ML_VT), 16 * ct, lane, aB);
                const int t0 = 16 * rt + 4 * (lane >> 4), v = 16 * ct + (lane & 15);
#pragma unroll
                for (int r = 0; r < 4; ++r) { const int t = t0 + r; const float x = sm[128 + t] * aA[r] + aB[r];
                    if (ct < 4) hb[t * 65 + v] = x; else if ((lane & 15) == 0) sm[256 + t] = x; } }
        }
        __syncthreads();
        {
            const int t = tid >> 3, vg = tid & 7; float acc[8];
            const float dn = 1.f / fmaxf(fabsf(sm[256 + t]), sm[192 + t]);
            float s1 = 0.f;
#pragma unroll
            for (int j = 0; j < 8; ++j) { acc[j] = hb[t * 65 + vg * 8 + j] * dn; s1 += acc[j]; }
            s1 += __shfl_xor(s1, 1); s1 += __shfl_xor(s1, 2); s1 += __shfl_xor(s1, 4);
            const float mu = s1 * (1.f / 64.f); float s2 = 0.f;
#pragma unroll
            for (int j = 0; j < 8; ++j) { acc[j] -= mu; s2 += acc[j] * acc[j]; }
            s2 += __shfl_xor(s2, 1); s2 += __shfl_xor(s2, 2); s2 += __shfl_xor(s2, 4);
            const float rs = rsqrtf(s2 * (1.f / 64.f) + HEAD_NORM_EPS);
            const float* nw = a->in[I_MNORM_W] + (size_t)l * DA + h * 64 + vg * 8;
            const v4u ov = *(const GAS v4u*)(PROJ + (row0 + t) * NPROJ + PC_O + h * 64 + vg * 8);
            const float o[8] = {bflo(ov.x), bfhi(ov.x), bflo(ov.y), bfhi(ov.y), bflo(ov.z), bfhi(ov.z), bflo(ov.w), bfhi(ov.w)};
            float r[8];
#pragma unroll
            for (int j = 0; j < 8; ++j) r[j] = acc[j] * rs * nw[j] * sigmoidf_(o[j]);
            v4u w; w.x = pk2(r[0], r[1]); w.y = pk2(r[2], r[3]); w.z = pk2(r[4], r[5]); w.w = pk2(r[6], r[7]);
            *(GAS v4u*)(YC + (row0 + t) * DM + h * 64 + vg * 8) = w;
        }
    }
}

constexpr int S5_UT = 264, S5_XT = 2056;
constexpr int S5_U = 0, S5_Z = 33792, S5_X = 67584;
static_assert(S5_X + 16 * S5_XT * 2 <= MISC_OFF, "S5 LDS map");
struct S5A { float are, aim, cre, cim; };
__device__ __forceinline__ S5A s5_a(KArgsP a, int l, int g, int p) {
    const float lam_re = a->in[I_S5ARE][(size_t)(l * 16 + g) * 64 + p], lam_im = a->in[I_S5AIM][(size_t)(l * 16 + g) * 64 + p];
    const float dt = expf(a->in[I_S5LDT][l * 16 + g]); const float mag = expf(lam_re * dt), ang = lam_im * dt;
    S5A r; r.are = mag * cosf(ang); r.aim = mag * sinf(ang);
    const float inv = 1.f / (lam_re * lam_re + lam_im * lam_im);
    r.cre = ((r.are - 1.f) * lam_re + r.aim * lam_im) * inv; r.cim = (r.aim * lam_re - (r.are - 1.f) * lam_im) * inv; return r;
}
__device__ __forceinline__ bf16x8 pack8(const float* v) { v4u o; o.x = pk2(v[0], v[1]); o.y = pk2(v[2], v[3]); o.z = pk2(v[4], v[5]); o.w = pk2(v[6], v[7]); return __builtin_bit_cast(bf16x8, o); }
__device__ __forceinline__ void s5_bfrag(const unsigned char* ws, int l, int g, int lane, bf16x8 (&bf)[8]) {
    const bf16* BB = (const bf16*)(ws + WS_S5BB) + (size_t)(l * 16 + g) * 128 * 16;
#pragma unroll
    for (int j = 0; j < 8; ++j) { v4u o = {0u, 0u, 0u, 0u}; if ((lane >> 4) < 2) o = *(const GAS v4u*)(BB + (16 * j + (lane & 15)) * 16 + 8 * (lane >> 4)); bf[j] = __builtin_bit_cast(bf16x8, o); }
}
__device__ __forceinline__ f32x2 s5_ap(const unsigned char* ws, int l, int g, int p) { return *(const GAS f32x2*)((const float*)(ws + WS_S5AP) + ((size_t)(l * 16 + g) * 64 + p) * 2); }
__device__ __forceinline__ void s5_load_u(const unsigned char* ws, LAS unsigned char* lds, int tid, size_t row0) {
    const bf16* PROJ = (const bf16*)(ws + WS_PROJ);
    for (int idx = tid; idx < 64 * 32; idx += NTHR) { const int t = idx >> 5, c8 = idx & 31;
        *(LAS v4u*)(lds + S5_U + (t * S5_UT + c8 * 8) * 2) = *(const GAS v4u*)(PROJ + (row0 + t) * NPROJ + PC_S5 + c8 * 8); }
}
__device__ __forceinline__ void s5_block(LAS unsigned char* lds, int lane, int tb, int g, const bf16x8 (&bf)[8], float are, float aim, float& xr, float& xi) {
    const int kq = lane >> 4; bf16x8 uf = {0, 0, 0, 0, 0, 0, 0, 0};
    if (kq < 2) uf = *(const LAS bf16x8*)(lds + S5_U + ((16 * tb + (lane & 15)) * S5_UT + g * 16 + 8 * kq) * 2);
    LAS bf16* X = (LAS bf16*)(lds + S5_X);
#pragma unroll
    for (int j = 0; j < 8; ++j) { f32x4 acc = {0.f, 0.f, 0.f, 0.f}; acc = __builtin_amdgcn_mfma_f32_16x16x32_bf16(bf[j], uf, acc, 0, 0, 0);
        v2u o; o.x = pk2(acc[0], acc[1]); o.y = pk2(acc[2], acc[3]); *(LAS v2u*)(X + (lane & 15) * S5_XT + g * 128 + 16 * j + 4 * kq) = o; }
    LDS_WAIT(); asm volatile("" ::: "memory");
    LAS unsigned* xw = (LAS unsigned*)(lds + S5_X) + (g * 128 + 2 * lane) / 2;
    unsigned wv[16];
#pragma unroll
    for (int t = 0; t < 16; ++t) wv[t] = xw[t * (S5_XT / 2)];
#pragma unroll
    for (int t = 0; t < 16; ++t) { const float br = bflo(wv[t]), bi = bfhi(wv[t]);
        const float nr = are * xr - aim * xi + br, ni = are * xi + aim * xr + bi; xr = nr; xi = ni;
        wv[t] = pk2(xr, xi); }
#pragma unroll
    for (int t = 0; t < 16; ++t) xw[t * (S5_XT / 2)] = wv[t];
    LDS_WAIT(); asm volatile("" ::: "memory");
}
__device__ __forceinline__ void phase_s1(KArgsP a, LAS unsigned char* lds, int tid, int lane, int wave, int vcu, int G, int l) {
    unsigned char* ws = a->ws; float* ST = (float*)(ws + WS_S5ST);
    bf16x8 bf0[8], bf1[8]; s5_bfrag(ws, l, wave, lane, bf0); s5_bfrag(ws, l, wave + 8, lane, bf1);
    struct { float are, aim; } A0, A1; { const f32x2 q0 = s5_ap(ws, l, wave, lane), q1 = s5_ap(ws, l, wave + 8, lane); A0.are = q0.x; A0.aim = q0.y; A1.are = q1.x; A1.aim = q1.y; }
    for (int u = vcu; u < NB * NCH; u += G) {
        const size_t row0 = (size_t)u * 64;
        __syncthreads();
        s5_load_u(ws, lds, tid, row0);
        __syncthreads();
        float x0r = 0.f, x0i = 0.f, x1r = 0.f, x1i = 0.f;
        for (int tb = 0; tb < 4; ++tb) { s5_block(lds, lane, tb, wave, bf0, A0.are, A0.aim, x0r, x0i); s5_block(lds, lane, tb, wave + 8, bf1, A1.are, A1.aim, x1r, x1i); }
        *(f32x2*)(ST + (((size_t)u * 16 + wave) * 64 + lane) * 2) = (f32x2){x0r, x0i};
        *(f32x2*)(ST + (((size_t)u * 16 + wave + 8) * 64 + lane) * 2) = (f32x2){x1r, x1i};
    }
}
__device__ __forceinline__ void phase_s2(KArgsP a, int tid, int wg, int nwg, int l) {
    float* ST = (float*)(a->ws + WS_S5ST);
    for (int idx = wg * NTHR + tid; idx < NB * 1024; idx += nwg * NTHR) {
        const int b = idx >> 10, gp = idx & 1023, g = gp >> 6, p = gp & 63;
        const f32x2 A = s5_ap(a->ws, l, g, p); float ar = A.x, ai = A.y;
#pragma unroll
        for (int s = 0; s < 6; ++s) { const float nr = ar * ar - ai * ai, ni = 2.f * ar * ai; ar = nr; ai = ni; }
        float cr = 0.f, ci = 0.f;
        for (int c0 = 0; c0 < NCH; c0 += 8) {
            f32x2 e[8];
#pragma unroll
            for (int j = 0; j < 8; ++j) e[j] = *(const f32x2*)(ST + (((size_t)(b * NCH + c0 + j) * 16 + g) * 64 + p) * 2);
#pragma unroll
            for (int j = 0; j < 8; ++j) { *(f32x2*)(ST + (((size_t)(b * NCH + c0 + j) * 16 + g) * 64 + p) * 2) = (f32x2){cr, ci};
                const float nr = ar * cr - ai * ci + e[j].x, ni = ar * ci + ai * cr + e[j].y; cr = nr; ci = ni; }
        }
    }
}
__device__ __forceinline__ float tanh_fast(float x) { return 1.f - 2.f / (1.f + __expf(2.f * x)); }
__device__ __forceinline__ float gelu_tanh_(float x) { const float t = tanh_fast(0.7978845608f * (x + 0.044715f * x * x * x)); return 0.5f * x * (1.f + t); }
__device__ __forceinline__ void s5_cload(const bf16* cmt  , int lane, bf16x8 (&cf)[4]) {
#pragma unroll
    for (int s = 0; s < 4; ++s) cf[s] = __builtin_bit_cast(bf16x8, *(const GAS v4u*)(cmt + (lane & 15) * 128 + 32 * s + 8 * (lane >> 4)));
}
__device__ __forceinline__ void s5_cproj(LAS unsigned char* lds, int lane, int tb, int g, const bf16x8 (&cf)[4], const float (&dv)[4]) {
    const int kq = lane >> 4; f32x4 acc = {0.f, 0.f, 0.f, 0.f};
    const LAS bf16* xp = (const LAS bf16*)(lds + S5_X) + (lane & 15) * S5_XT + g * 128 + 8 * kq;
#pragma unroll
    for (int s = 0; s < 4; ++s) acc = __builtin_amdgcn_mfma_f32_16x16x32_bf16(cf[s], *(const LAS bf16x8*)(xp + 32 * s), acc, 0, 0, 0);
    const int t = 16 * tb + (lane & 15), c0 = g * 16 + 4 * kq;
    const v2u uw = *(const LAS v2u*)(lds + S5_U + (t * S5_UT + c0) * 2);
    const float u4[4] = {bflo(uw.x), bfhi(uw.x), bflo(uw.y), bfhi(uw.y)}; float z[4];
#pragma unroll
    for (int r = 0; r < 4; ++r) z[r] = gelu_tanh_(acc[r] + dv[r] * u4[r]);
    v2u o; o.x = pk2(z[0], z[1]); o.y = pk2(z[2], z[3]); *(LAS v2u*)(lds + S5_Z + (t * S5_UT + c0) * 2) = o;
}
__device__ __forceinline__ void phase_s3(KArgsP a, LAS unsigned char* lds, int tid, int lane, int wave, int vcu, int G, int l) {
    unsigned char* ws = a->ws; const float* ST = (const float*)(ws + WS_S5ST); bf16* YC = (bf16*)(ws + WS_YC);
    const bf16* GLUT = (const bf16*)(ws + WS_GLUT) + (size_t)l * DC * DC;
    bf16x8 bf0[8], bf1[8]; s5_bfrag(ws, l, wave, lane, bf0); s5_bfrag(ws, l, wave + 8, lane, bf1);
    const bf16* cm0 = (const bf16*)(ws + WS_S5CM) + (size_t)(l * 16 + wave) * 2048; const bf16* cm1 = cm0 + 8 * 2048;
    struct { float are, aim; } A0, A1; { const f32x2 q0 = s5_ap(ws, l, wave, lane), q1 = s5_ap(ws, l, wave + 8, lane); A0.are = q0.x; A0.aim = q0.y; A1.are = q1.x; A1.aim = q1.y; }
    float d0[4], d1[4];
#pragma unroll
    for (int r = 0; r < 4; ++r) { d0[r] = a->in[I_S5D][l * DC + wave * 16 + 4 * (lane >> 4) + r]; d1[r] = a->in[I_S5D][l * DC + (wave + 8) * 16 + 4 * (lane >> 4) + r]; }
    for (int u = vcu; u < NB * NCH; u += G) {
        const size_t row0 = (size_t)u * 64;
        __syncthreads();
        s5_load_u(ws, lds, tid, row0);
        const f32x2 s0 = *(const f32x2*)(ST + (((size_t)u * 16 + wave) * 64 + lane) * 2), s1 = *(const f32x2*)(ST + (((size_t)u * 16 + wave + 8) * 64 + lane) * 2);
        float x0r = s0.x, x0i = s0.y, x1r = s1.x, x1i = s1.y;
        __syncthreads();
        for (int tb = 0; tb < 4; ++tb) {
            { bf16x8 cf[4]; s5_cload(cm0, lane, cf); s5_block(lds, lane, tb, wave, bf0, A0.are, A0.aim, x0r, x0i); s5_cproj(lds, lane, tb, wave, cf, d0); }
            { bf16x8 cf[4]; s5_cload(cm1, lane, cf); s5_block(lds, lane, tb, wave + 8, bf1, A1.are, A1.aim, x1r, x1i); s5_cproj(lds, lane, tb, wave + 8, cf, d1); }
        }
        __syncthreads();
        {
            const int kq = lane >> 4;
#pragma unroll
            for (int q = 0; q < 2; ++q) { const int ct = 2 * wave + q; f32x4 acc[4];
#pragma unroll
                for (int rt = 0; rt < 4; ++rt) acc[rt] = (f32x4){0.f, 0.f, 0.f, 0.f};
                const bf16* gp = GLUT + (size_t)(16 * ct + (lane & 15)) * DC + 8 * kq;
#pragma unroll 2
                for (int s = 0; s < 8; ++s) { const bf16x8 gf = __builtin_bit_cast(bf16x8, *(const GAS v4u*)(gp + 32 * s));
#pragma unroll
                    for (int rt = 0; rt < 4; ++rt) acc[rt] = __builtin_amdgcn_mfma_f32_16x16x32_bf16(gf, *(const LAS bf16x8*)(lds + S5_Z + ((16 * rt + (lane & 15)) * S5_UT + 32 * s + 8 * kq) * 2), acc[rt], 0, 0, 0); }
                const int j0 = 16 * ct + 4 * kq; const f32x4 gb = *(const GAS f32x4*)(a->in[I_S5GLUB] + l * DC + j0);
#pragma unroll
                for (int rt = 0; rt < 4; ++rt) { const int t = 16 * rt + (lane & 15); const v2u zw = *(const LAS v2u*)(lds + S5_Z + (t * S5_UT + j0) * 2);
                    const float z0 = bflo(zw.x), z1 = bfhi(zw.x), z2 = bflo(zw.y), z3 = bfhi(zw.y);
                    v2u o; o.x = pk2(z0 * sigmoidf_(acc[rt][0] + gb.x), z1 * sigmoidf_(acc[rt][1] + gb.y)); o.y = pk2(z2 * sigmoidf_(acc[rt][2] + gb.z), z3 * sigmoidf_(acc[rt][3] + gb.w));
                    *(GAS v2u*)(YC + (row0 + t) * DM + 768 + j0) = o; } }
        }
    }
}

__device__ __forceinline__ float rw_shift(const bf16* PROJ, const float* mu, size_t row, int col) {
    const float cur = bf2f(PROJ[row * NPROJ + PC_RW + col]); const float prv = (row % SEQ) ? bf2f(PROJ[(row - 1) * NPROJ + PC_RW + col]) : 0.f;
    return cur + mu[col] * (prv - cur);
}
constexpr int R1_TH = 0, R1_AD = 9216, R1_SG = 18432, R1_VS = 35840, R1_TMP = 86016;
template <int KS, int MODE>
__device__ __forceinline__ void r1_prod(const bf16* WT, const LAS bf16* act, int astride, const float* bias, bf16* OUT, size_t row0, int lane, int wave) {
    const int kq = lane >> 4, n0 = 48 * wave; constexpr int K = 32 * KS;
    f32x4 acc[3][4];
#pragma unroll
    for (int nt = 0; nt < 3; ++nt)
#pragma unroll
        for (int ti = 0; ti < 4; ++ti) acc[nt][ti] = (f32x4){0.f, 0.f, 0.f, 0.f};
#pragma unroll
    for (int s = 0; s < KS; ++s) { bf16x8 wf[3], af[4];
#pragma unroll
        for (int nt = 0; nt < 3; ++nt) wf[nt] = __builtin_bit_cast(bf16x8, *(const GAS v4u*)(WT + (size_t)(n0 + 16 * nt + (lane & 15)) * K + 32 * s + 8 * kq));
#pragma unroll
        for (int ti = 0; ti < 4; ++ti) af[ti] = *(const LAS bf16x8*)(act + (16 * ti + (lane & 15)) * astride + 32 * s + 8 * kq);
#pragma unroll
        for (int nt = 0; nt < 3; ++nt)
#pragma unroll
            for (int ti = 0; ti < 4; ++ti) acc[nt][ti] = __builtin_amdgcn_mfma_f32_16x16x32_bf16(wf[nt], af[ti], acc[nt][ti], 0, 0, 0); }
#pragma unroll
    for (int nt = 0; nt < 3; ++nt) { const int n = n0 + 16 * nt + 4 * kq; f32x4 bv = {0.f, 0.f, 0.f, 0.f}; if (MODE != 2) bv = *(const GAS f32x4*)(bias + n);
#pragma unroll
        for (int ti = 0; ti < 4; ++ti) { float o[4];
#pragma unroll
            for (int r = 0; r < 4; ++r) { const float x = acc[nt][ti][r] + bv[r]; o[r] = MODE == 0 ? 0.60653066f * sigmoidf_(x) : (MODE == 1 ? sigmoidf_(x) : x); }
            v2u w; w.x = pk2(o[0], o[1]); w.y = pk2(o[2], o[3]);
            *(GAS v2u*)(OUT + (row0 + 16 * ti + (lane & 15)) * DBR + n) = w; } }
}
__device__ __forceinline__ void phase_r1(KArgsP a, LAS unsigned char* lds, int tid, int lane, int wave, int vcu, int G, int l) {
    unsigned char* ws = a->ws; const bf16* PROJ = (const bf16*)(ws + WS_PROJ); const float* mu = a->in[I_RMU] + (size_t)l * RW_COLS;
    const bf16* W1 = (const bf16*)(ws + WS_R1W) + (size_t)l * 98304;
    const bf16* WV = (const bf16*)(ws + WS_R1W) + 2 * 98304;
    for (int u = vcu; u < NTOK / 64; u += G) {
        const size_t row0 = (size_t)u * 64;
        __syncthreads();
        for (int idx = tid; idx < 64 * 128; idx += NTHR) { const int tt = idx >> 7, col = 2 * (idx & 127); const size_t r = row0 + tt;
            const unsigned cw = *(const GAS unsigned*)(PROJ + r * NPROJ + PC_RW + RWC_WD + col); const unsigned pw = (r % SEQ) ? *(const GAS unsigned*)(PROJ + (r - 1) * NPROJ + PC_RW + RWC_WD + col) : 0u;
            const float c0 = bflo(cw), c1 = bfhi(cw); const float x0 = c0 + mu[RWC_WD + col] * (bflo(pw) - c0), x1 = c1 + mu[RWC_WD + col + 1] * (bfhi(pw) - c1);
            if (col < 64) *(LAS unsigned*)(lds + R1_TH + (tt * 72 + col) * 2) = pk2(tanh_fast(x0), tanh_fast(x1));
            else if (col < 128) *(LAS unsigned*)(lds + R1_AD + (tt * 72 + col - 64) * 2) = pk2(x0, x1);
            else *(LAS unsigned*)(lds + R1_SG + (tt * 136 + col - 128) * 2) = pk2(sigmoidf_(x0), sigmoidf_(x1)); }
        if (l > 0) for (int idx = tid; idx < 64 * 192; idx += NTHR) { const int tt = idx / 192, col = 2 * (idx % 192); const size_t r = row0 + tt;
            const unsigned cw = *(const GAS unsigned*)(PROJ + r * NPROJ + PC_RW + RWC_V + col); const unsigned pw = (r % SEQ) ? *(const GAS unsigned*)(PROJ + (r - 1) * NPROJ + PC_RW + RWC_V + col) : 0u;
            const float c0 = bflo(cw), c1 = bfhi(cw);
            *(LAS unsigned*)(lds + R1_VS + (tt * 392 + col) * 2) = pk2(c0 + mu[RWC_V + col] * (bflo(pw) - c0), c1 + mu[RWC_V + col + 1] * (bfhi(pw) - c1)); }
        __syncthreads();
        r1_prod<2, 0>(W1, (const LAS bf16*)(lds + R1_TH), 72, a->in[I_RW0] + l * DBR, (bf16*)(ws + WS_RE), row0, lane, wave);
        r1_prod<2, 1>(W1 + 24576, (const LAS bf16*)(lds + R1_AD), 72, a->in[I_RA0] + l * DBR, (bf16*)(ws + WS_RA), row0, lane, wave);
        r1_prod<4, 2>(W1 + 49152, (const LAS bf16*)(lds + R1_SG), 136, nullptr, (bf16*)(ws + WS_RG), row0, lane, wave);
        if (l > 0) {
            { const int kq = lane >> 4, mt = wave & 1, ti = wave >> 1; f32x4 acc = {0.f, 0.f, 0.f, 0.f};
#pragma unroll
              for (int s = 0; s < 12; ++s) acc = __builtin_amdgcn_mfma_f32_16x16x32_bf16(__builtin_bit_cast(bf16x8, *(const GAS v4u*)(WV + (size_t)(16 * mt + (lane & 15)) * 384 + 32 * s + 8 * kq)),
                                                                                          *(const LAS bf16x8*)(lds + R1_VS + ((16 * ti + (lane & 15)) * 392 + 32 * s + 8 * kq) * 2), acc, 0, 0, 0);
              v2u w; w.x = pk2(acc[0], acc[1]); w.y = pk2(acc[2], acc[3]); *(LAS v2u*)(lds + R1_TMP + ((16 * ti + (lane & 15)) * 40 + 16 * mt + 4 * kq) * 2) = w; }
            __syncthreads();
            r1_prod<1, 1>(WV + 12288, (const LAS bf16*)(lds + R1_TMP), 40, a->in[I_RV0], (bf16*)(ws + WS_RVG), row0, lane, wave);
        }
    }
}
__device__ __forceinline__ float dpp_allsum(float x) {
    x += __builtin_bit_cast(float, __builtin_amdgcn_update_dpp(0, __builtin_bit_cast(int, x), 0x128, 0xf, 0xf, false));
    x += __builtin_bit_cast(float, __builtin_amdgcn_update_dpp(0, __builtin_bit_cast(int, x), 0x124, 0xf, 0xf, false));
    x += __builtin_bit_cast(float, __builtin_amdgcn_update_dpp(0, __builtin_bit_cast(int, x), 0x122, 0xf, 0xf, false));
    x += __builtin_bit_cast(float, __builtin_amdgcn_update_dpp(0, __builtin_bit_cast(int, x), 0x121, 0xf, 0xf, false));
    { const unsigned xi = __builtin_bit_cast(unsigned, x); auto r = __builtin_amdgcn_permlane16_swap(xi, xi, false, false); const unsigned r0 = r[0], r1 = r[1]; x = __uint_as_float(r0) + __uint_as_float(r1); }
    { const unsigned xi = __builtin_bit_cast(unsigned, x); auto r = __builtin_amdgcn_permlane32_swap(xi, xi, false, false); const unsigned r0 = r[0], r1 = r[1]; x = __uint_as_float(r0) + __uint_as_float(r1); }
    return x;
}

constexpr int RC_EF = 0, RC_ATF = 4096, RC_QF = 8448, RC_PFT = 9472, RC_AT = 10496, RC_RT = 12800, RC_BH = 15104, RC_KH = 17408, RC_AH = 19712, RC_BTT = 22016, RC_KTT = 25088, RC_VS = 28160,
              RC_PRL = 31232, RC_QRL = 32000, RC_TQL = 32768, RC_G15 = 33536, RC_CH = 33792;
struct RCRegs { v2u r0, r1, k0, k1, aa, ee, v0, v1, vg, vf; };
__device__ __forceinline__ void rc_issue(const unsigned char* ws, int l, size_t row, int h, int tid, RCRegs& R) {
    const bf16* PROJ = (const bf16*)(ws + WS_PROJ); const int tt = tid >> 4, c0 = h * 64 + 4 * (tid & 15); const size_t r = row + tt; const bool first = (r % SEQ) == 0; const size_t rp = first ? r : r - 1;
    R.r0 = *(const GAS v2u*)(PROJ + r * NPROJ + PC_RW + RWC_R + c0); R.r1 = *(const GAS v2u*)(PROJ + rp * NPROJ + PC_RW + RWC_R + c0);
    R.k0 = *(const GAS v2u*)(PROJ + r * NPROJ + PC_RW + RWC_K + c0); R.k1 = *(const GAS v2u*)(PROJ + rp * NPROJ + PC_RW + RWC_K + c0);
    R.v0 = *(const GAS v2u*)(PROJ + r * NPROJ + PC_RW + RWC_V + c0); R.v1 = *(const GAS v2u*)(PROJ + rp * NPROJ + PC_RW + RWC_V + c0);
    R.aa = *(const GAS v2u*)((const bf16*)(ws + WS_RA) + r * DBR + c0); R.ee = *(const GAS v2u*)((const bf16*)(ws + WS_RE) + r * DBR + c0);
    if (l > 0) { R.vg = *(const GAS v2u*)((const bf16*)(ws + WS_RVG) + r * DBR + c0); R.vf = *(const GAS v2u*)((const bf16*)(ws + WS_VF) + r * DBR + c0); }
    if (first) { R.r1 = (v2u){0u, 0u}; R.k1 = (v2u){0u, 0u}; R.v1 = (v2u){0u, 0u}; }
}
__device__ __forceinline__ void unpack4(const v2u p, float (&o)[4]) { o[0] = bflo(p.x); o[1] = bfhi(p.x); o[2] = bflo(p.y); o[3] = bfhi(p.y); }
__device__ __forceinline__ v2u pack4(const float (&v)[4]) { v2u o; o.x = pk2(v[0], v[1]); o.y = pk2(v[2], v[3]); return o; }
__device__ __forceinline__ v2u pack4v(const f32x4 v) { v2u o; o.x = pk2(v[0], v[1]); o.y = pk2(v[2], v[3]); return o; }
__device__ __forceinline__ bf16x8 cat8(const v2u a, const v2u b) { v4u o; o.x = a.x; o.y = a.y; o.z = b.x; o.w = b.y; return __builtin_bit_cast(bf16x8, o); }
#define RC_BAR() asm volatile("s_waitcnt lgkmcnt(0)\n\ts_barrier" ::: "memory")

constexpr int REC_BYTES = 12288, REC_UNITS = 752;
__device__ __forceinline__ unsigned char* rc_rec(unsigned char* ws, size_t cu) { return cu < 8192 ? ws + WS_OPA + cu * REC_BYTES : ws + WS_OPB + (cu - 8192) * REC_BYTES; }
__device__ __forceinline__ v4u rc_gather_unit(const LAS unsigned char* wb, int u) {
    v2u lo, hi;
    if (u < 256) { const int base = u < 128 ? RC_AH : RC_RT, uu = u & 127, row = uu >> 3, s = (uu >> 2) & 1, lq = uu & 3; const LAS unsigned char* p = wb + base + (row * 72 + 32 * s + 4 * lq) * 2;
        lo = *(const LAS v2u*)p; hi = *(const LAS v2u*)(p + 32); }
    else if (u < 512) { const int k = (u - 256) >> 2, lq = (u - 256) & 3; lo = *(const LAS v2u*)(wb + RC_BTT + (k * 24 + 4 * lq) * 2); hi = *(const LAS v2u*)(wb + RC_KTT + (k * 24 + 4 * lq) * 2); }
    else if (u < 576) { const int t = (u - 512) >> 2, lq = (u - 512) & 3; lo = *(const LAS v2u*)(wb + RC_PRL + (t * 24 + 4 * lq) * 2); hi = *(const LAS v2u*)(wb + RC_QRL + (t * 24 + 4 * lq) * 2); }
    else if (u < 608) { const LAS unsigned char* p = wb + RC_TQL + (((u - 576) >> 1) * 24 + 8 * ((u - 576) & 1)) * 2; lo = *(const LAS v2u*)p; hi = *(const LAS v2u*)(p + 8); }
    else if (u < 736) { const LAS unsigned char* p = wb + RC_VS + (((u - 608) >> 1) * 24 + 8 * ((u - 608) & 1)) * 2; lo = *(const LAS v2u*)p; hi = *(const LAS v2u*)(p + 8); }
    else { const LAS unsigned char* p = wb + RC_G15 + (u - 736) * 16; lo = *(const LAS v2u*)p; hi = *(const LAS v2u*)(p + 8); }
    v4u o; o.x = lo.x; o.y = lo.y; o.z = hi.x; o.w = hi.y; return o;
}
__device__ __forceinline__ void rc_copy_out(unsigned char* rec, const LAS unsigned char* wb, int u) {
#pragma unroll
    for (int q = 0; q < 3; ++q) { const int uu = u + 256 * q; if (uu < REC_UNITS) *(GAS v4u*)(rec + uu * 16) = rc_gather_unit(wb, uu); }
}
constexpr int RS_AH = 0, RS_RT = 2304, RS_BK = 4608, RS_PQ = 9728, RS_TQL = 11008, RS_VS = 11776, RS_G15 = 14848, RS_CH = 15360;
__device__ __forceinline__ int rs_unit_off(int u) {
    if (u < 128) return RS_AH + (u >> 3) * 144 + (u & 7) * 16;
    if (u < 256) return RS_RT + ((u - 128) >> 3) * 144 + (u & 7) * 16;
    if (u < 512) return RS_BK + ((u - 256) >> 2) * 80 + (u & 3) * 16;
    if (u < 576) return RS_PQ + ((u - 512) >> 2) * 80 + (u & 3) * 16;
    if (u < 608) return RS_TQL + ((u - 576) >> 1) * 48 + (u & 1) * 16;
    if (u < 736) return RS_VS + ((u - 608) >> 1) * 48 + (u & 1) * 16;
    return RS_G15 + (u - 736) * 16;
}
#define RC_BUILD(RUSE, q) do { const int bh_ = (q) >> 8, b = bh_ / NH, h = bh_ % NH, blk_ = (q) & 255, c0 = h * 64 + 4 * kq; const size_t row0 = (size_t)b * SEQ + (size_t)blk_ * 32; \
        float kkw[4], kaw[4], mur[4], muk[4], muv[4]; \
_Pragma("unroll") \
        for (int j = 0; j < 4; ++j) { kkw[j] = a->in[I_RKK][(size_t)l * DBR + c0 + j]; kaw[j] = a->in[I_RKA][(size_t)l * DBR + c0 + j]; mur[j] = mu[RWC_R + c0 + j]; muk[j] = mu[RWC_K + c0 + j]; muv[j] = mu[RWC_V + c0 + j]; } \
        float an[4], bk[4], km[4], rs[4], ev[4]; \
        {   const RCRegs& R = RUSE; \
            float rc[4], rp[4], kc[4], kp[4], av[4], vc[4], vp[4], ks[4], kk[4], vs[4]; unpack4(R.r0, rc); unpack4(R.r1, rp); unpack4(R.k0, kc); unpack4(R.k1, kp); unpack4(R.aa, av); unpack4(R.ee, ev); unpack4(R.v0, vc); unpack4(R.v1, vp); \
            float ss = 0.f; \
_Pragma("unroll") \
            for (int j = 0; j < 4; ++j) { rs[j] = rc[j] + mur[j] * (rp[j] - rc[j]); ks[j] = kc[j] + muk[j] * (kp[j] - kc[j]); kk[j] = ks[j] * kkw[j]; ss += kk[j] * kk[j]; vs[j] = vc[j] + muv[j] * (vp[j] - vc[j]); } \
            ss += __shfl_xor(ss, 1); ss += __shfl_xor(ss, 2); ss += __shfl_xor(ss, 4); ss += __shfl_xor(ss, 8); \
            const float inv = 1.f / fmaxf(sqrtf(ss), 1e-12f); \
_Pragma("unroll") \
            for (int j = 0; j < 4; ++j) { const float kn = kk[j] * inv; an[j] = -kn; bk[j] = kn * av[j]; km[j] = ks[j] * (1.f + (av[j] - 1.f) * kaw[j]); } \
            if (l == 0) *(GAS v2u*)((bf16*)(ws + WS_VF) + (row0 + tt) * DBR + c0) = pack4(vs); \
            else { float g[4], f[4]; unpack4(R.vg, g); unpack4(R.vf, f); \
_Pragma("unroll") \
                for (int j = 0; j < 4; ++j) vs[j] = vs[j] + (f[j] - vs[j]) * g[j]; } \
            *(LAS f32x4*)(cb + RC_EF + (t * 64 + 4 * kq) * 4) = (f32x4){ev[0], ev[1], ev[2], ev[3]}; \
_Pragma("unroll") \
            for (int j = 0; j < 4; ++j) *(LAS bf16*)(cb + RC_VS + ((4 * kq + j) * 24 + t) * 2) = (bf16)f2bf(vs[j]); \
        } \
        if ((q) + 2 * G < NQ) rc_issue(ws, l, (size_t)(((q) + 2 * G) >> 8) / NH * SEQ + (size_t)(((q) + 2 * G) & 255) * 32, (((q) + 2 * G) >> 8) % NH, tid, RUSE); \
        RC_BAR(); \
        {   f32x4 inc = {0.f, 0.f, 0.f, 0.f}, tot = inc; \
_Pragma("unroll") \
            for (int i = 0; i < 16; ++i) { const f32x4 ei = *(const LAS f32x4*)(cb + RC_EF + (i * 64 + 4 * kq) * 4); tot = tot + ei; if (i <= t) inc = inc + ei; } \
            float At[4], Rt[4], Bh[4], Kh[4], Bt[4], Kt[4], Gt[4]; \
_Pragma("unroll") \
            for (int j = 0; j < 4; ++j) { const float Gi = __expf(-inc[j]), Ge = __expf(ev[j] - inc[j]), Gn = __expf(inc[j]); Gt[j] = __expf(-tot[j]); \
                At[j] = an[j] * Ge; Rt[j] = rs[j] * Gi; Bh[j] = bk[j] * Gn; Kh[j] = km[j] * Gn; Bt[j] = Bh[j] * Gt[j]; Kt[j] = Kh[j] * Gt[j]; } \
            *(LAS f32x4*)(cb + RC_ATF + (t * 68 + 4 * kq) * 4) = (f32x4){At[0], At[1], At[2], At[3]}; \
            *(LAS v2u*)(cb + RC_AT + (t * 72 + 4 * kq) * 2) = pack4(At); *(LAS v2u*)(cb + RC_RT + (t * 72 + 4 * kq) * 2) = pack4(Rt); \
            *(LAS v2u*)(cb + RC_BH + (t * 72 + 4 * kq) * 2) = pack4(Bh); *(LAS v2u*)(cb + RC_KH + (t * 72 + 4 * kq) * 2) = pack4(Kh); \
_Pragma("unroll") \
            for (int j = 0; j < 4; ++j) { *(LAS bf16*)(cb + RC_BTT + ((4 * kq + j) * 24 + t) * 2) = (bf16)f2bf(Bt[j]); *(LAS bf16*)(cb + RC_KTT + ((4 * kq + j) * 24 + t) * 2) = (bf16)f2bf(Kt[j]); } \
            if (t == 0) *(LAS f32x4*)(cb + RC_G15 + 4 * kq * 4) = (f32x4){Gt[0], Gt[1], Gt[2], Gt[3]}; \
        } \
        RC_BAR(); \
        {   LAS unsigned char* wb = lds + (wave >> 2) * RC_CH; const int pi = wave & 3; \
            const LAS bf16* Ap = (const LAS bf16*)(wb + (pi < 2 ? RC_AT : RC_RT)) + li * 72 + 8 * lq; const LAS bf16* Bp = (const LAS bf16*)(wb + ((pi & 1) ? RC_KH : RC_BH)) + li * 72 + 8 * lq; \
            f32x4 acc = {0.f, 0.f, 0.f, 0.f}; \
            acc = __builtin_amdgcn_mfma_f32_16x16x32_bf16(*(const LAS bf16x8*)Ap, *(const LAS bf16x8*)Bp, acc, 0, 0, 0); \
            acc = __builtin_amdgcn_mfma_f32_16x16x32_bf16(*(const LAS bf16x8*)(Ap + 32), *(const LAS bf16x8*)(Bp + 32), acc, 0, 0, 0); \
_Pragma("unroll") \
            for (int r = 0; r < 4; ++r) { const int tr = 4 * lq + r; if (pi < 2 ? !(li < tr) : !(li <= tr)) acc[r] = 0.f; } \
            if (pi == 0) *(LAS f32x4*)(wb + RC_PFT + (li * 16 + 4 * lq) * 4) = acc; \
            else if (pi == 1) { \
_Pragma("unroll") \
                for (int r = 0; r < 4; ++r) *(LAS float*)(wb + RC_QF + ((4 * lq + r) * 16 + li) * 4) = acc[r]; } \
            else { LAS bf16* o = (LAS bf16*)(wb + (pi == 2 ? RC_PRL : RC_QRL)); \
_Pragma("unroll") \
                for (int r = 0; r < 4; ++r) o[(4 * lq + r) * 24 + li] = (bf16)f2bf(acc[r]); } \
        } \
        RC_BAR(); \
        if (wave < 4) { \
            LAS unsigned char* wb = lds + (wave >> 1) * RC_CH; const bool isq = wave & 1; \
            float X[16]; \
_Pragma("unroll") \
            for (int r = 0; r < 16; ++r) X[r] = isq ? *(const LAS float*)(wb + RC_QF + (r * 16 + li) * 4) : *(const LAS float*)(wb + RC_ATF + (r * 68 + lane) * 4); \
_Pragma("unroll") \
            for (int j = 0; j < 15; ++j) { const LAS f32x4* pc = (const LAS f32x4*)(wb + RC_PFT + j * 64); const f32x4 c0v = pc[0], c1v = pc[1], c2v = pc[2], c3v = pc[3]; \
                const float c[16] = {c0v[0], c0v[1], c0v[2], c0v[3], c1v[0], c1v[1], c1v[2], c1v[3], c2v[0], c2v[1], c2v[2], c2v[3], c3v[0], c3v[1], c3v[2], c3v[3]}; \
_Pragma("unroll") \
                for (int r = j + 1; r < 16; ++r) X[r] = fmaf(c[r], X[j], X[r]); } \
            if (!isq) { LAS bf16* o = (LAS bf16*)(wb + RC_AH); \
_Pragma("unroll") \
                for (int r = 0; r < 16; ++r) o[r * 72 + lane] = (bf16)f2bf(X[r]); } \
            else if (lane < 16) { LAS bf16* o = (LAS bf16*)(wb + RC_TQL); \
_Pragma("unroll") \
                for (int r = 0; r < 16; ++r) o[r * 24 + lane] = (bf16)f2bf(X[r]); } \
        } \
        RC_BAR(); \
        { const int cc = tid >> 8, u = tid & 255; unsigned char* rec = rc_rec(ws, (size_t)bh_ * 512 + 2 * blk_ + cc); const LAS unsigned char* wb = lds + cc * RC_CH; \
          rc_copy_out(rec, wb, u); } \
        RC_BAR(); \
    } while (0)
struct RSOps { bf16x8 a01, a23, r01, r23, tq, pq, bk[4]; v2u vb; f32x4 g[4]; };
__device__ __forceinline__ void rs_load(const LAS unsigned char* wb, int wave, int li, int lq, RSOps& O) {
    O.a01 = *(const LAS bf16x8*)(wb + RS_AH + li * 144 + lq * 16); O.a23 = *(const LAS bf16x8*)(wb + RS_AH + li * 144 + 64 + lq * 16);
    O.r01 = *(const LAS bf16x8*)(wb + RS_RT + li * 144 + lq * 16); O.r23 = *(const LAS bf16x8*)(wb + RS_RT + li * 144 + 64 + lq * 16);
    O.pq = *(const LAS bf16x8*)(wb + RS_PQ + li * 80 + lq * 16);
    { const v2u t = *(const LAS v2u*)(wb + RS_TQL + li * 48 + lq * 8); v4u o; o.x = t.x; o.y = t.y; o.z = 0u; o.w = 0u; O.tq = __builtin_bit_cast(bf16x8, o); }
    O.vb = *(const LAS v2u*)(wb + RS_VS + (16 * wave + li) * 48 + lq * 8);
#pragma unroll
    for (int kt = 0; kt < 4; ++kt) { O.bk[kt] = *(const LAS bf16x8*)(wb + RS_BK + (16 * kt + li) * 80 + lq * 16); O.g[kt] = *(const LAS f32x4*)(wb + RS_G15 + (16 * kt + 4 * lq) * 4); }
}
#define RC_CHUNK(O, cc, row0) do { const v2u z2_ = {0u, 0u}; \
        f32x4 aD = {0.f, 0.f, 0.f, 0.f}, aY = {0.f, 0.f, 0.f, 0.f}; \
        aD = __builtin_amdgcn_mfma_f32_16x16x32_bf16(O.a01, Sb01, aD, 0, 0, 0); \
        aD = __builtin_amdgcn_mfma_f32_16x16x32_bf16(O.a23, Sb23, aD, 0, 0, 0); \
        aD = __builtin_amdgcn_mfma_f32_16x16x32_bf16(O.tq, cat8(O.vb, z2_), aD, 0, 0, 0); \
        aY = __builtin_amdgcn_mfma_f32_16x16x32_bf16(Sb01, O.r01, aY, 0, 0, 0); \
        aY = __builtin_amdgcn_mfma_f32_16x16x32_bf16(Sb23, O.r23, aY, 0, 0, 0); \
        const bf16x8 DV = cat8(pack4v(aD), O.vb); \
_Pragma("unroll") \
        for (int kt = 0; kt < 4; ++kt) Sacc[kt] = __builtin_amdgcn_mfma_f32_16x16x32_bf16(O.bk[kt], DV, Sacc[kt] * O.g[kt], 0, 0, 0); \
        aY = __builtin_amdgcn_mfma_f32_16x16x32_bf16(DV, O.pq, aY, 0, 0, 0); \
        Sb01 = cat8(pack4v(Sacc[0]), pack4v(Sacc[1])); Sb23 = cat8(pack4v(Sacc[2]), pack4v(Sacc[3])); \
        *(GAS v2u*)(YC + ((row0) + (cc) * 16 + li) * DM + 384 + h * 64 + 16 * wave + 4 * lq) = pack4v(aY);     \
    } while (0)
#define RC_SCAN(slot, row0) do { { RSOps O0; rs_load(slot, wave, li, lq, O0); __builtin_amdgcn_sched_barrier(0); RC_CHUNK(O0, 0, row0); } \
        { RSOps O1; rs_load(slot + RS_CH, wave, li, lq, O1); __builtin_amdgcn_sched_barrier(0); RC_CHUNK(O1, 1, row0); } } while (0)

__device__ __forceinline__ void phase_r2_build(KArgsP a, LAS unsigned char* lds, int tid, int lane, int wave, int vcu, int G, int l) {
    unsigned char* ws = a->ws;
    const int tt = tid >> 4, kq = tid & 15, ch = tt >> 4, t = tt & 15;
    const int lq = lane >> 4, li = lane & 15;
    LAS unsigned char* cb = lds + ch * RC_CH;
    const float* mu = a->in[I_RMU] + (size_t)l * RW_COLS;
    constexpr int NQ = NB * NH * 256;
    RCRegs RA, RB;
    if (vcu < NQ) rc_issue(ws, l, (size_t)(vcu >> 8) / NH * SEQ + (size_t)(vcu & 255) * 32, (vcu >> 8) % NH, tid, RA);
    if (vcu + G < NQ) rc_issue(ws, l, (size_t)((vcu + G) >> 8) / NH * SEQ + (size_t)((vcu + G) & 255) * 32, ((vcu + G) >> 8) % NH, tid, RB);
    for (int q0 = vcu; q0 < NQ; q0 += 2 * G) { { const int q = q0; RC_BUILD(RA, q); } if (q0 + G < NQ) { const int q = q0 + G; RC_BUILD(RB, q); } }
}
struct RSRegs { v4u p[6]; };
__device__ __forceinline__ void rs_issue(unsigned char* ws, size_t cu0, int lt, RSRegs& R) {
#pragma unroll
    for (int j = 0; j < 6; ++j) { const int uu = lt + 256 * j; if (uu < 2 * REC_UNITS) { const int cc = uu >= REC_UNITS, u = uu - cc * REC_UNITS; R.p[j] = *(const GAS v4u*)(rc_rec(ws, cu0 + cc) + u * 16); } }
}
__device__ __forceinline__ void rs_store(LAS unsigned char* slot, int lt, const RSRegs& R) {
#pragma unroll
    for (int j = 0; j < 6; ++j) { const int uu = lt + 256 * j; if (uu < 2 * REC_UNITS) { const int cc = uu >= REC_UNITS, u = uu - cc * REC_UNITS;
        *(LAS v4u*)(slot + cc * RS_CH + rs_unit_off(u)) = R.p[j]; } }
}
__device__ __forceinline__ void phase_r2_scan(KArgsP a, LAS unsigned char* lds, int tid, int lane, int wave, int wg, int l) {
    unsigned char* ws = a->ws; bf16* YC = (bf16*)(ws + WS_YC);
    const int b = wg / NH, h = wg % NH; const size_t rowb = (size_t)b * SEQ, cub = (size_t)wg * 512;
    const int lq = lane >> 4, li = lane & 15, lt = tid - 256; const bool loader = wave >= 4;
    f32x4 Sacc[4]; bf16x8 Sb01, Sb23;
#pragma unroll
    for (int kt = 0; kt < 4; ++kt) Sacc[kt] = (f32x4){0.f, 0.f, 0.f, 0.f};
    Sb01 = (bf16x8){0, 0, 0, 0, 0, 0, 0, 0}; Sb23 = Sb01;
    constexpr int NBLK = SEQ / 32;
    LAS unsigned char* slot0 = lds; LAS unsigned char* slot1 = lds + 2 * RS_CH;
    RSRegs RA, RB;
    if (loader) { rs_issue(ws, cub, lt, RA); rs_store(slot0, lt, RA); rs_issue(ws, cub + 2, lt, RB); rs_issue(ws, cub + 4, lt, RA); }
    RC_BAR();
    for (int bb = 0; bb < NBLK; bb += 2) {
        if (!loader) { const size_t row0 = rowb + (size_t)bb * 32; LAS unsigned char* slot = slot0; RC_SCAN(slot, row0); }
        else { rs_store(slot1, lt, RB); if (bb + 3 < NBLK) rs_issue(ws, cub + 2 * (size_t)(bb + 3), lt, RB); }
        RC_BAR();
        if (!loader) { const size_t row0 = rowb + (size_t)(bb + 1) * 32; LAS unsigned char* slot = slot1; RC_SCAN(slot, row0); }
        else { if (bb + 2 < NBLK) rs_store(slot0, lt, RA); if (bb + 4 < NBLK) rs_issue(ws, cub + 2 * (size_t)(bb + 4), lt, RA); }
        RC_BAR();
    }
}
__device__ __forceinline__ void phase_r3(KArgsP a, int lane, int gw, int ngw, int l) {
    unsigned char* ws = a->ws; const bf16* PROJ = (const bf16*)(ws + WS_PROJ); bf16* YC = (bf16*)(ws + WS_YC);
    const bf16* RA = (const bf16*)(ws + WS_RA); const bf16* RG = (const bf16*)(ws + WS_RG); const bf16* RVG = (const bf16*)(ws + WS_RVG); const bf16* VF = (const bf16*)(ws + WS_VF);
    const float* mu = a->in[I_RMU] + (size_t)l * RW_COLS;
    for (size_t row = gw; row < NTOK; row += ngw) {
#pragma unroll
        for (int h = 0; h < NH; ++h) {
            const int c = h * 64 + lane;
            const float y = bf2f(YC[row * DM + 384 + c]);
            const float m = dpp_allsum(y) * (1.f / 64.f); const float d = y - m; const float var = dpp_allsum(d * d) * (1.f / 64.f);
            const float yn = d * rsqrtf(var + RWKV_GN_EPS) * a->in[I_RLNW][l * DBR + c] + a->in[I_RLNB][l * DBR + c];
            const float rs = rw_shift(PROJ, mu, row, RWC_R + c), ks = rw_shift(PROJ, mu, row, RWC_K + c); float v = rw_shift(PROJ, mu, row, RWC_V + c);
            if (l > 0) v = v + (bf2f(VF[row * DBR + c]) - v) * bf2f(RVG[row * DBR + c]);
            const float av = bf2f(RA[row * DBR + c]);
            const float km = ks * (1.f + (av - 1.f) * a->in[I_RKA][l * DBR + c]);
            const float rk = dpp_allsum(rs * km * a->in[I_RRK][l * DBR + c]);
            YC[row * DM + 384 + c] = (bf16)f2bf((yn + rk * v) * bf2f(RG[row * DBR + c]));
        }
    }
}

constexpr int PH_PER_LAYER = 10, PH_FINAL = 1 + 2 * PH_PER_LAYER, N_PHASES = PH_FINAL + 1;
constexpr int R2_WGS = 24;
__global__ void __launch_bounds__(NTHR, 2) fwd(Args args) {
    extern __shared__ __attribute__((aligned(16))) unsigned char lds_raw[];
    LAS unsigned char* lds = (LAS unsigned char*)lds_raw;
    volatile LAS unsigned* MISC = (volatile LAS unsigned*)(lds + MISC_OFF);
    const int tid0 = threadIdx.x;
    const int G = gridDim.x;
#define PHASE_IDS int tid_ = threadIdx.x; asm volatile("" : "+v"(tid_)); const int tid = tid_, lane = tid & 63, wave = __builtin_amdgcn_readfirstlane(tid >> 6); \
    int bx_ = blockIdx.x; asm volatile("" : "+s"(bx_)); const int bx = bx_; const int vcu = (G % 8 == 0) ? (bx % 8) * (G / 8) + bx / 8 : bx; (void)lane; (void)wave; (void)vcu; (void)bx;
    unsigned char* ws0 = fresh_args()->ws;
    for (int u = tid0; u < (LDS_BYTES - RING_BYTES) / 4; u += NTHR) ((LAS unsigned*)(lds + RING_BYTES))[u] = 0u;
    __syncthreads();
    XcdBarrier bar; bar.bar = (unsigned*)(ws0 + WS_CTL) + CW_BAR; bar.x = 0; bar.st = nullptr;
    if (!MK_PER_PHASE) bar = xcd_barrier_post((unsigned*)(ws0 + WS_CTL) + CW_BAR, MISC + 8);
#if MK_PER_PHASE
    const int lo = args.ph_lo, hi = args.ph_hi;
#define IN(k) (lo <= (k) && (k) < hi)
#else
#define IN(k) true
#endif
#define SEAM(k) do { if (IN(k) && IN((k) + 1)) { XcdBarrier b2 = bar; asm volatile("" : "+s"(b2.bar)); xcd_barrier(b2); } } while (0)

#ifndef GEMM_SP2
#define GEMM_SP2 true
#endif
#ifndef GEMM_ALIGN
#define GEMM_ALIGN true
#endif
#ifndef DBL_SUB
#define DBL_SUB 0
#endif
#ifndef DBL_PHASE
#define DBL_PHASE (-1)
#endif
#ifndef REPN
#define REPN 2
#endif
#define REP(k) for (int rep_ = 0; rep_ < ((k) == DBL_PHASE ? REPN : 1); ++rep_)
#define REPBAR if (rep_ > 0) { XcdBarrier b2 = bar; asm volatile("" : "+s"(b2.bar)); xcd_barrier(b2); }
    REP(0) if (IN(0)) { REPBAR KArgsP ap = fresh_args(); PHASE_IDS phase_prologue(ap, lds, tid, lane, wave, vcu, G); }
    SEAM(0);
#ifdef EXTRA_BAR
    for (int eb_ = 0; eb_ < EXTRA_BAR; ++eb_) { XcdBarrier b2 = bar; asm volatile("" : "+s"(b2.bar)); xcd_barrier(b2); }
#endif
#define LCONST 0
    {
        constexpr int l = LCONST; constexpr int pb = 1 + l * PH_PER_LAYER;
        REP(pb + 0) if (IN(pb + 0)) { REPBAR KArgsP ap = fresh_args(); PHASE_IDS unsigned char* ws = ap->ws; (void)ws;
            if (l == 0) { mod_finalize(ws, tid, G); phase_rownorm<0, false>(ap, lds, tid, lane, wave, G, ap->in[I_X], ap->out, ap->in[I_NORM_MIX], true, 0, 0, 0); }
            else {
#if EN_MOE
                phase_rownorm<0, true>(ap, lds, tid, lane, wave, G, ap->out, ap->out, ap->in[I_NORM_MIX] + l * DM, false, l, 0, l - 1);
#else
                phase_rownorm<0, false>(ap, lds, tid, lane, wave, G, ap->out, ap->out, ap->in[I_NORM_MIX] + l * DM, false, l, 0, l - 1);
#endif
            }
        }
        SEAM(pb + 0);
        REP(pb + 1) if (IN(pb + 1)) { REPBAR KArgsP ap = fresh_args(); PHASE_IDS unsigned char* ws = ap->ws; (void)ws;
            pg8::Gemm g{(const pg8::bf16_t*)(ws + WS_HN), (const pg8::bf16_t*)(ws + WS_WIN) + (size_t)l * NPROJ_PAD * DM, NTOK, NPROJ_PAD, DM};
            pg8::StaticOrder S; S.init(NTOK, NPROJ_PAD, G, bx);
            pg8::EpiProj E{(pg8::bf16_t*)(ws + WS_PROJ), (float*)(ws + WS_GATES)};
            pg8::gemm_phase<pg8::EpiProj, pg8::StaticOrder, GEMM_ALIGN, GEMM_SP2>(lds, g, S, E);
        }
        SEAM(pb + 1);
        REP(pb + 2) if (IN(pb + 2)) { REPBAR KArgsP ap = fresh_args(); PHASE_IDS unsigned char* ws = ap->ws; (void)ws;
#if EN_MLSTM
            for (int q_ = 0; q_ < 1 + (REPN - 1) * ((DBL_SUB == 1) && l == 0); ++q_) { phase_m1(ap, lds, tid, lane, wave, vcu, G, l); __syncthreads(); }
            __syncthreads();
#endif
#if EN_S5
            phase_s1(ap, lds, tid, lane, wave, vcu, G, l); __syncthreads();
#if DBL_SUB == 2
            if (l == 0) { phase_s1(ap, lds, tid, lane, wave, vcu, G, l); __syncthreads(); phase_s1(ap, lds, tid, lane, wave, vcu, G, l); __syncthreads(); phase_s1(ap, lds, tid, lane, wave, vcu, G, l); __syncthreads(); phase_s1(ap, lds, tid, lane, wave, vcu, G, l); __syncthreads(); }
#endif
            __syncthreads();
#endif
#if EN_RWKV
            for (int q_ = 0; q_ < 1 + (REPN - 1) * ((DBL_SUB == 3) && l == 0); ++q_) { phase_r1(ap, lds, tid, lane, wave, vcu, G, l); __syncthreads(); }
#endif
        }
        SEAM(pb + 2);
        REP(pb + 3) if (IN(pb + 3)) { REPBAR KArgsP ap = fresh_args(); PHASE_IDS unsigned char* ws = ap->ws; (void)ws;
            phase_m2(ws, tid, vcu, G);
            phase_s2(ap, tid, vcu, G, l);
            __syncthreads();
            phase_r2_build(ap, lds, tid, lane, wave, vcu, G, l);
        }
        SEAM(pb + 3);
        REP(pb + 4) if (IN(pb + 4)) { REPBAR KArgsP ap = fresh_args(); PHASE_IDS unsigned char* ws = ap->ws; (void)ws;
            if (bx < R2_WGS) { phase_r2_scan(ap, lds, tid, lane, wave, bx, l); __syncthreads(); }
            else { phase_s3(ap, lds, tid, lane, wave, bx - R2_WGS, G - R2_WGS, l); __syncthreads(); }
            {
                unsigned* qctr = (unsigned*)(ws + WS_CTL) + CW_Q + 64 * l; volatile LAS unsigned* qw = (volatile LAS unsigned*)(lds + MISC_OFF) + 16;
                for (;;) {
                    if (tid == 0) *qw = __hip_atomic_fetch_add(qctr, 1u, __ATOMIC_RELAXED, __HIP_MEMORY_SCOPE_AGENT);
                    __syncthreads();
                    const int u = (int)*qw;
                    __syncthreads();
                    if (u >= NUNIT_M) break;
                    phase_m3(ap, lds, tid, lane, wave, u, NUNIT_M, l);
                }
            }
        }
        SEAM(pb + 4);
        REP(pb + 5) if (IN(pb + 5)) { REPBAR KArgsP ap = fresh_args(); PHASE_IDS
            phase_r3(ap, lane, vcu * NWAVES + wave, G * NWAVES, l);
        }
        SEAM(pb + 5);
        REP(pb + 6) if (IN(pb + 6)) { REPBAR KArgsP ap = fresh_args(); PHASE_IDS unsigned char* ws = ap->ws; (void)ws;
            pg8::Gemm g{(const pg8::bf16_t*)(ws + WS_YC), (const pg8::bf16_t*)(ws + WS_WOUT) + (size_t)l * DM * DM, NTOK, DM, DM};
            pg8::StaticOrder S; S.init(NTOK, DM, G, bx);
            pg8::EpiResid E{l == 0 ? ap->in[I_X] : (const float*)ap->out, ap->out, (const float*)(ws + WS_MODF) + (size_t)l * 4 * 6144, 2048};
            pg8::gemm_phase<pg8::EpiResid, pg8::StaticOrder, GEMM_ALIGN, GEMM_SP2>(lds, g, S, E);
        }
        SEAM(pb + 6);
#if EN_MOE
        REP(pb + 7) if (IN(pb + 7)) { REPBAR KArgsP ap = fresh_args(); PHASE_IDS phase_router(ap, lds, tid, lane, wave, G, l); __syncthreads();
            moe_convert13(ap->in[I_MW1], ap->in[I_MW3], l, (bf16*)(ap->ws + WS_W13), vcu * NWAVES + wave, G * NWAVES, (LAS float*)(lds + wave * 16640), lane);
            moe_convert2(ap->in[I_MW2], l, (bf16*)(ap->ws + WS_W2), vcu * NWAVES + wave, G * NWAVES, (LAS float*)(lds + wave * 16640), lane); }
        SEAM(pb + 7);
        REP(pb + 8) if (IN(pb + 8)) { REPBAR KArgsP ap = fresh_args(); PHASE_IDS unsigned char* ws = ap->ws; (void)ws;
            LAS int* ptab = (LAS int*)(lds + PTAB_OFF); LAS int* pst = ptab + 512; LAS int* cnt = pst + 32;
            build_ptab((const unsigned*)(ws + WS_CTL) + CW_CNT + l * 32, ptab, pst, cnt, tid);
            pg8::Gemm g{(const pg8::bf16_t*)(ws + WS_HN), (const pg8::bf16_t*)(ws + WS_W13), 0, 0, DM, (const int*)(ws + WS_LIST), ptab};
            pg8::MoeOrder S{ptab, G, vcu};
            pg8::EpiSwiglu E{(pg8::bf16_t*)(ws + WS_HMID)};
            pg8::gemm_phase<pg8::EpiSwiglu, pg8::MoeOrder, false, true, true>(lds, g, S, E);
        }
        SEAM(pb + 8);
        REP(pb + 9) if (IN(pb + 9)) { REPBAR KArgsP ap = fresh_args(); PHASE_IDS unsigned char* ws = ap->ws; (void)ws;
            LAS int* ptab = (LAS int*)(lds + PTAB_OFF); LAS int* pst = ptab + 512; LAS int* cnt = pst + 32;
            build_ptab((const unsigned*)(ws + WS_CTL) + CW_CNT + l * 32, ptab, pst, cnt, tid);
            pg8::Gemm g{(const pg8::bf16_t*)(ws + WS_HMID), (const pg8::bf16_t*)(ws + WS_W2), 0, 0, DEXP};
            pg8::MoeOrder S{ptab, G, vcu};
            pg8::EpiMoeOut E{(pg8::bf16_t*)(ws + WS_YMOE), (const int*)(ws + WS_LIST), ptab};
            pg8::gemm_phase<pg8::EpiMoeOut, pg8::MoeOrder, true, true>(lds, g, S, E);
        }
        SEAM(pb + 9);
#else
        SEAM(pb + 6); SEAM(pb + 7); SEAM(pb + 8); SEAM(pb + 9);
#endif
    }
#undef LCONST
#if N_LAYERS > 1
#define LCONST 1
    {
        constexpr int l = LCONST; constexpr int pb = 1 + l * PH_PER_LAYER;
        REP(pb + 0) if (IN(pb + 0)) { REPBAR KArgsP ap = fresh_args(); PHASE_IDS unsigned char* ws = ap->ws; (void)ws;
            if (l == 0) { mod_finalize(ws, tid, G); phase_rownorm<0, false>(ap, lds, tid, lane, wave, G, ap->in[I_X], ap->out, ap->in[I_NORM_MIX], true, 0, 0, 0); }
            else {
#if EN_MOE
                phase_rownorm<0, true>(ap, lds, tid, lane, wave, G, ap->out, ap->out, ap->in[I_NORM_MIX] + l * DM, false, l, 0, l - 1);
#else
                phase_rownorm<0, false>(ap, lds, tid, lane, wave, G, ap->out, ap->out, ap->in[I_NORM_MIX] + l * DM, false, l, 0, l - 1);
#endif
            }
        }
        SEAM(pb + 0);
        REP(pb + 1) if (IN(pb + 1)) { REPBAR KArgsP ap = fresh_args(); PHASE_IDS unsigned char* ws = ap->ws; (void)ws;
            pg8::Gemm g{(const pg8::bf16_t*)(ws + WS_HN), (const pg8::bf16_t*)(ws + WS_WIN) + (size_t)l * NPROJ_PAD * DM, NTOK, NPROJ_PAD, DM};
            pg8::StaticOrder S; S.init(NTOK, NPROJ_PAD, G, bx);
            pg8::EpiProj E{(pg8::bf16_t*)(ws + WS_PROJ), (float*)(ws + WS_GATES)};
            pg8::gemm_phase<pg8::EpiProj, pg8::StaticOrder, GEMM_ALIGN, GEMM_SP2>(lds, g, S, E);
        }
        SEAM(pb + 1);
        REP(pb + 2) if (IN(pb + 2)) { REPBAR KArgsP ap = fresh_args(); PHASE_IDS unsigned char* ws = ap->ws; (void)ws;
#if EN_MLSTM
            for (int q_ = 0; q_ < 1 + (REPN - 1) * ((DBL_SUB == 1) && l == 0); ++q_) { phase_m1(ap, lds, tid, lane, wave, vcu, G, l); __syncthreads(); }
            __syncthreads();
#endif
#if EN_S5
            phase_s1(ap, lds, tid, lane, wave, vcu, G, l); __syncthreads();
#if DBL_SUB == 2
            if (l == 0) { phase_s1(ap, lds, tid, lane, wave, vcu, G, l); __syncthreads(); phase_s1(ap, lds, tid, lane, wave, vcu, G, l); __syncthreads(); phase_s1(ap, lds, tid, lane, wave, vcu, G, l); __syncthreads(); phase_s1(ap, lds, tid, lane, wave, vcu, G, l); __syncthreads(); }
#endif
            __syncthreads();
#endif
#if EN_RWKV
            for (int q_ = 0; q_ < 1 + (REPN - 1) * ((DBL_SUB == 3) && l == 0); ++q_) { phase_r1(ap, lds, tid, lane, wave, vcu, G, l); __syncthreads(); }
#endif
        }
        SEAM(pb + 2);
        REP(pb + 3) if (IN(pb + 3)) { REPBAR KArgsP ap = fresh_args(); PHASE_IDS unsigned char* ws = ap->ws; (void)ws;
            phase_m2(ws, tid, vcu, G);
            phase_s2(ap, tid, vcu, G, l);
            __syncthreads();
            phase_r2_build(ap, lds, tid, lane, wave, vcu, G, l);
        }
        SEAM(pb + 3);
        REP(pb + 4) if (IN(pb + 4)) { REPBAR KArgsP ap = fresh_args(); PHASE_IDS unsigned char* ws = ap->ws; (void)ws;
            if (bx < R2_WGS) { phase_r2_scan(ap, lds, tid, lane, wave, bx, l); __syncthreads(); }
            else { phase_s3(ap, lds, tid, lane, wave, bx - R2_WGS, G - R2_WGS, l); __syncthreads(); }
            {
                unsigned* qctr = (unsigned*)(ws + WS_CTL) + CW_Q + 64 * l; volatile LAS unsigned* qw = (volatile LAS unsigned*)(lds + MISC_OFF) + 16;
                for (;;) {
                    if (tid == 0) *qw = __hip_atomic_fetch_add(qctr, 1u, __ATOMIC_RELAXED, __HIP_MEMORY_SCOPE_AGENT);
                    __syncthreads();
                    const int u = (int)*qw;
                    __syncthreads();
                    if (u >= NUNIT_M) break;
                    phase_m3(ap, lds, tid, lane, wave, u, NUNIT_M, l);
                }
            }
        }
        SEAM(pb + 4);
        REP(pb + 5) if (IN(pb + 5)) { REPBAR KArgsP ap = fresh_args(); PHASE_IDS
            phase_r3(ap, lane, vcu * NWAVES + wave, G * NWAVES, l);
        }
        SEAM(pb + 5);
        REP(pb + 6) if (IN(pb + 6)) { REPBAR KArgsP ap = fresh_args(); PHASE_IDS unsigned char* ws = ap->ws; (void)ws;
            pg8::Gemm g{(const pg8::bf16_t*)(ws + WS_YC), (const pg8::bf16_t*)(ws + WS_WOUT) + (size_t)l * DM * DM, NTOK, DM, DM};
            pg8::StaticOrder S; S.init(NTOK, DM, G, bx);
            pg8::EpiResid E{l == 0 ? ap->in[I_X] : (const float*)ap->out, ap->out, (const float*)(ws + WS_MODF) + (size_t)l * 4 * 6144, 2048};
            pg8::gemm_phase<pg8::EpiResid, pg8::StaticOrder, GEMM_ALIGN, GEMM_SP2>(lds, g, S, E);
        }
        SEAM(pb + 6);
#if EN_MOE
        REP(pb + 7) if (IN(pb + 7)) { REPBAR KArgsP ap = fresh_args(); PHASE_IDS phase_router(ap, lds, tid, lane, wave, G, l); __syncthreads();
            moe_convert13(ap->in[I_MW1], ap->in[I_MW3], l, (bf16*)(ap->ws + WS_W13), vcu * NWAVES + wave, G * NWAVES, (LAS float*)(lds + wave * 16640), lane);
            moe_convert2(ap->in[I_MW2], l, (bf16*)(ap->ws + WS_W2), vcu * NWAVES + wave, G * NWAVES, (LAS float*)(lds + wave * 16640), lane); }
        SEAM(pb + 7);
        REP(pb + 8) if (IN(pb + 8)) { REPBAR KArgsP ap = fresh_args(); PHASE_IDS unsigned char* ws = ap->ws; (void)ws;
            LAS int* ptab = (LAS int*)(lds + PTAB_OFF); LAS int* pst = ptab + 512; LAS int* cnt = pst + 32;
            build_ptab((const unsigned*)(ws + WS_CTL) + CW_CNT + l * 32, ptab, pst, cnt, tid);
            pg8::Gemm g{(const pg8::bf16_t*)(ws + WS_HN), (const pg8::bf16_t*)(ws + WS_W13), 0, 0, DM, (const int*)(ws + WS_LIST), ptab};
            pg8::MoeOrder S{ptab, G, vcu};
            pg8::EpiSwiglu E{(pg8::bf16_t*)(ws + WS_HMID)};
            pg8::gemm_phase<pg8::EpiSwiglu, pg8::MoeOrder, false, true, true>(lds, g, S, E);
        }
        SEAM(pb + 8);
        REP(pb + 9) if (IN(pb + 9)) { REPBAR KArgsP ap = fresh_args(); PHASE_IDS unsigned char* ws = ap->ws; (void)ws;
            LAS int* ptab = (LAS int*)(lds + PTAB_OFF); LAS int* pst = ptab + 512; LAS int* cnt = pst + 32;
            build_ptab((const unsigned*)(ws + WS_CTL) + CW_CNT + l * 32, ptab, pst, cnt, tid);
            pg8::Gemm g{(const pg8::bf16_t*)(ws + WS_HMID), (const pg8::bf16_t*)(ws + WS_W2), 0, 0, DEXP};
            pg8::MoeOrder S{ptab, G, vcu};
            pg8::EpiMoeOut E{(pg8::bf16_t*)(ws + WS_YMOE), (const int*)(ws + WS_LIST), ptab};
            pg8::gemm_phase<pg8::EpiMoeOut, pg8::MoeOrder, true, true>(lds, g, S, E);
        }
        SEAM(pb + 9);
#else
        SEAM(pb + 6); SEAM(pb + 7); SEAM(pb + 8); SEAM(pb + 9);
#endif
    }
#undef LCONST
#endif
    if (IN(PH_FINAL)) { KArgsP ap = fresh_args(); PHASE_IDS
#if EN_MOE
        if (N_LAYERS > 0) phase_rownorm<1, true>(ap, lds, tid, lane, wave, G, ap->out, ap->out, ap->in[I_NORM_FINAL], false, 0, 0, N_LAYERS - 1);
        else phase_rownorm<1, false>(ap, lds, tid, lane, wave, G, ap->in[I_X], ap->out, ap->in[I_NORM_FINAL], false, 0, 0, 0);
#else
        phase_rownorm<1, false>(ap, lds, tid, lane, wave, G, N_LAYERS > 0 ? (const float*)ap->out : ap->in[I_X], ap->out, ap->in[I_NORM_FINAL], false, 0, 0, 0);
#endif
    }
#undef IN
#undef SEAM
}

extern "C" void kernel_launch(void* const* d_in, const int* in_sizes, int n_in, void* d_out, int out_size, void* d_ws, size_t ws_size, hipStream_t stream) {
    static int grid = 0;
    if (grid == 0) {
        if (n_in != 47 || out_size != NTOK * DM || ws_size < WS_END) { fprintf(stderr, "kernel_launch: unexpected problem (n_in %d, out %d, ws %zu < %zu)\n", n_in, out_size, ws_size, (size_t)WS_END); grid = -1; return; }
        int dev = 0, cus = 0, per_cu = 0;
        if (hipGetDevice(&dev) != hipSuccess || hipDeviceGetAttribute(&cus, hipDeviceAttributeMultiprocessorCount, dev) != hipSuccess) { grid = -1; return; }
        if (hipFuncSetAttribute((const void*)fwd, hipFuncAttributeMaxDynamicSharedMemorySize, LDS_BYTES) != hipSuccess) { fprintf(stderr, "kernel_launch: hipFuncSetAttribute failed\n"); grid = -1; return; }
        if (hipOccupancyMaxActiveBlocksPerMultiprocessor(&per_cu, (const void*)fwd, NTHR, LDS_BYTES) != hipSuccess || per_cu < 1) fprintf(stderr, "kernel_launch: occupancy query says %d\n", per_cu);
        (void)hipGetLastError();
        grid = cus;
        if (grid != 256) fprintf(stderr, "kernel_launch: %d CUs (built for 256)\n", grid);
    }
    if (grid < 0) return;
    (void)hipMemsetAsync((char*)d_ws + WS_CTL, 0, CTL_ZERO_BYTES, stream);
    Args a{};
    for (int i = 0; i < 47; ++i) a.in[i] = (const float*)d_in[i];
    a.out = (float*)d_out; a.ws = (unsigned char*)d_ws;
#if MK_PER_PHASE
    for (int p = 0; p < N_PHASES; ++p) { a.ph_lo = p; a.ph_hi = p + 1; hipLaunchKernelGGL(fwd, dim3(grid), dim3(NTHR), LDS_BYTES, stream, a); }
#else
    a.ph_lo = 0; a.ph_hi = N_PHASES; hipLaunchKernelGGL(fwd, dim3(grid), dim3(NTHR), LDS_BYTES, stream, a);
#endif
}
#ifdef DIAG_KERNELS
#define DK(name, ...) __global__ void __launch_bounds__(NTHR, 2) name(Args args) { extern __shared__ __attribute__((aligned(16))) unsigned char lds_raw[]; LAS unsigned char* lds = (LAS unsigned char*)lds_raw; \
    const int tid = threadIdx.x, lane = tid & 63, wave = __builtin_amdgcn_readfirstlane(tid >> 6); const int G = gridDim.x; const int bx = blockIdx.x; const int vcu = bx; KArgsP ap = fresh_args(); int l = ap->ph_lo; (void)lane; (void)wave; (void)vcu; (void)G; (void)l; __VA_ARGS__ }
DK(k_prologue, phase_prologue(ap, lds, tid, lane, wave, vcu, G);)
DK(k_norm0, phase_rownorm<0, false>(ap, lds, tid, lane, wave, G, ap->in[I_X], ap->out, ap->in[I_NORM_MIX], true, 0, 0, 0);)
DK(k_norm1, phase_rownorm<0, true>(ap, lds, tid, lane, wave, G, ap->out, ap->out, ap->in[I_NORM_MIX], false, l, 0, 0);)
DK(k_normf, phase_rownorm<1, true>(ap, lds, tid, lane, wave, G, ap->out, ap->out, ap->in[I_NORM_MIX], false, l, 0, 0);)
DK(k_m1, phase_m1(ap, lds, tid, lane, wave, vcu, G, l);)
DK(k_m2, phase_m2(ap->ws, tid, vcu, G);)
DK(k_m3, phase_m3(ap, lds, tid, lane, wave, vcu, G, l);)
DK(k_s1, phase_s1(ap, lds, tid, lane, wave, vcu, G, l);)
DK(k_s2, phase_s2(ap, tid, vcu, G, l);)
DK(k_s3, phase_s3(ap, lds, tid, lane, wave, vcu, G, l);)
DK(k_r1, phase_r1(ap, lds, tid, lane, wave, vcu, G, l);)
DK(k_r2b, phase_r2_build(ap, lds, tid, lane, wave, vcu, G, l);)
DK(k_r2s, phase_r2_scan(ap, lds, tid, lane, wave, vcu, l);)
DK(k_r3, phase_r3(ap, lane, vcu * NWAVES + wave, G * NWAVES, l);)
DK(k_router, phase_router(ap, lds, tid, lane, wave, G, l);)
DK(k_gather, phase_gather(ap, lds, tid, lane, wave, vcu, G, l);)
DK(k_moecv, moe_convert13(ap->in[I_MW1], ap->in[I_MW3], 1, (bf16*)(ap->ws + WS_W13), vcu * NWAVES + wave, G * NWAVES, (LAS float*)(lds + wave * 16640), lane);)
#endif
```

```cpp
#include <hip/hip_runtime.h>
#include <cstdio>
#include <cstdint>
#define MK_PER_PHASE 0

#ifndef MK_PER_PHASE
#define MK_PER_PHASE 0
#endif
#ifndef EN_MLSTM
#define EN_MLSTM 1
#endif
#ifndef EN_S5
#define EN_S5 1
#endif
#ifndef EN_RWKV
#define EN_RWKV 1
#endif
#ifndef EN_MOE
#define EN_MOE 1
#endif
#ifndef N_LAYERS
#define N_LAYERS 2
#endif
constexpr int NWAVES = 8, NTHR = 512;
constexpr int DM = 1024, NB = 4, SEQ = 8192, NTOK = NB * SEQ;
constexpr int DA = 384, DBR = 384, DC = 256, NH = 6, HD = 64, NCH = SEQ / 64;
constexpr int IN_COLS = 2828, NPROJ = 2816, NPROJ_PAD = 3072;
constexpr int PC_QK = 0, PC_V = 384, PC_O = 768, PC_RW = 1152, PC_S5 = 2560;
constexpr int RWC_R = 0, RWC_K = 384, RWC_V = 768, RWC_WD = 1152, RWC_AD = 1216, RWC_GD = 1280, RW_COLS = 1408;
constexpr int NEXP = 32, DEXP = 512, MOE_ROWS_MAX = 73728;
constexpr int NUNIT_M = NB * NCH * NH;
constexpr int CL_STRIDE = 4160;
constexpr float NORM_EPS = 1e-6f, HEAD_NORM_EPS = 1e-5f, RWKV_GN_EPS = 64e-5f;

constexpr size_t MiB = 1u << 20;
constexpr size_t WS_CTL = 0, CTL_ZERO_BYTES = 1 * MiB;
constexpr size_t WS_MODP = 1 * MiB;
constexpr size_t WS_MODF = 2 * MiB + 512 * 1024;
constexpr size_t WS_S5BB = 2 * MiB + 896 * 1024;
constexpr size_t WS_RTW = 3 * MiB;
constexpr size_t WS_S5AP = 3 * MiB + 384 * 1024;
constexpr size_t WS_MLW = 3 * MiB + 512 * 1024;
constexpr size_t WS_S5CM = 2 * MiB + 768 * 1024;
constexpr size_t WS_GLUT = 3 * MiB + 768 * 1024;
constexpr size_t WS_WIN = 4 * MiB;
constexpr size_t WS_WOUT = 16 * MiB;
constexpr size_t WS_GATES = 20 * MiB;
constexpr size_t WS_W13 = 22 * MiB;
constexpr size_t WS_W2 = 86 * MiB;
constexpr size_t WS_HN = 118 * MiB;
constexpr size_t WS_CLOC = 118 * MiB;
constexpr size_t WS_MSC = 168 * MiB;
constexpr size_t WS_S5ST = 170 * MiB;
constexpr size_t WS_VF = 182 * MiB;
constexpr size_t WS_YC = 206 * MiB;
constexpr size_t WS_LIST = 206 * MiB;
constexpr size_t WS_ROWMAP = 214 * MiB;
constexpr size_t WS_TOKE = 215 * MiB;
constexpr size_t WS_TOKW = 215 * MiB + 512 * 1024;
constexpr size_t WS_PROJ = 270 * MiB;
constexpr size_t WS_RE = 446 * MiB, WS_RA = 470 * MiB, WS_RG = 494 * MiB, WS_RVG = 518 * MiB;
constexpr size_t WS_XG = 270 * MiB;
constexpr size_t WS_HMID = 414 * MiB;
constexpr size_t WS_YMOE = 270 * MiB;
constexpr size_t WS_R1W = 542 * MiB;
constexpr size_t WS_OPA = 22 * MiB;
constexpr size_t WS_OPB = 543 * MiB;
constexpr size_t WS_END = 591 * MiB;
constexpr int CW_TMO = 0, CW_BAR = 4096, CW_CNT = 8192, CW_Q = 8320;

constexpr int RING_BYTES = 131072, MISC_OFF = 135168, PTAB_OFF = MISC_OFF + 1024, LDS_BYTES = 147456;

#define GAS __attribute__((address_space(1)))
#define LAS __attribute__((address_space(3)))
typedef unsigned short bf16;
typedef unsigned v4u __attribute__((ext_vector_type(4)));
typedef unsigned v2u __attribute__((ext_vector_type(2)));
typedef float f32x4 __attribute__((ext_vector_type(4)));
typedef float f32x2 __attribute__((ext_vector_type(2)));
typedef GAS unsigned gu32;
#define RLX_AGENT __ATOMIC_RELAXED, __HIP_MEMORY_SCOPE_AGENT
#define LDS_WAIT() asm volatile("s_waitcnt lgkmcnt(0)" ::: "memory")
#define VM_WAIT() asm volatile("s_waitcnt vmcnt(0)" ::: "memory")
typedef float f32x2v __attribute__((ext_vector_type(2)));
typedef __bf16 bf16x2v __attribute__((ext_vector_type(2)));
__device__ __forceinline__ unsigned pk2(float lo, float hi) { const f32x2v v = {lo, hi}; const bf16x2v b = __builtin_convertvector(v, bf16x2v); return __builtin_bit_cast(unsigned, b); }
__device__ __forceinline__ unsigned f2bf(float f) { return pk2(f, 0.f) & 0xffffu; }
__device__ __forceinline__ float bf2f(unsigned v) { return __builtin_bit_cast(float, v << 16); }
__device__ __forceinline__ float bflo(unsigned w) { return __builtin_bit_cast(float, w << 16); }
__device__ __forceinline__ float bfhi(unsigned w) { return __builtin_bit_cast(float, w & 0xffff0000u); }
__device__ __forceinline__ float sigmoidf_(float x) { return 1.f / (1.f + __expf(-x)); }
__device__ __forceinline__ float wave_sum(float v) {
#pragma unroll
    for (int o = 1; o < 64; o <<= 1) v += __shfl_xor(v, o);
    return v;
}
__device__ __forceinline__ float wave_max(float v) {
#pragma unroll
    for (int o = 1; o < 64; o <<= 1) v = fmaxf(v, __shfl_xor(v, o));
    return v;
}
namespace pg8 {
#define PG8_LAS __attribute__((address_space(3)))
typedef unsigned short bf16_t;
typedef short bf16x8 __attribute__((ext_vector_type(8)));
typedef float f32x4 __attribute__((ext_vector_type(4)));
typedef unsigned u32x4 __attribute__((ext_vector_type(4)));
constexpr int BM = 256, BK = 64, HALF = 128, HTB = HALF * BK * 2  , STAGE_BYTES = 8 * HTB, NXCD = 8, WGM = 8;

__host__ __device__ __forceinline__ int lds_byte(int r, int c) { const int st = (r >> 4) * 2 + (c >> 5), rr = r & 15, cc = c & 31, ob = rr * 64 + cc * 2; return st * 1024 + (ob ^ (((ob >> 9) & 1) << 5)); }
__host__ __device__ __forceinline__ void stage_rc(int b, int& R, int& C) { const int st = b / 1024, sb = b % 1024, swz = sb ^ (((sb >> 9) & 1) << 5); R = (st >> 1) * 16 + swz / 64; C = (st & 1) * 32 + (swz % 64) / 2; }
__host__ __device__ __forceinline__ int perm32(int rho) { const int n = rho >> 4, i = rho & 15; return 8 * (i >> 2) + 4 * n + (i & 3); }

struct Unit { int pm, pn; };
__device__ __forceinline__ int moe_tok2(const int* list, PG8_LAS const int* ptab, int row) { const int e = ptab[1 + (row >> 8)], pos = row - ptab[512 + e]; return pos < ptab[544 + e] ? list[(size_t)e * 65536 + pos] : -1; }
struct Gemm { const bf16_t* A; const bf16_t* Bt; int M, N, K; const int* list = nullptr; PG8_LAS const int* ptab = nullptr; };

struct StaticOrder {
    int nM, nN, nwg, G, c;
    __host__ __device__ void init(int M, int N, int G_, int c_) { nM = M / BM; nN = N / BM; nwg = nM * nN; G = G_; c = c_; }
    __host__ __device__ bool next(int i, Unit& u) const {
        const long L = (long)i * G + c; if (L >= nwg) return false;
        int wgid = (int)L; { const int q = nwg / NXCD, r = nwg % NXCD, xcd = wgid % NXCD, off = wgid / NXCD; wgid = (xcd < r ? xcd * (q + 1) : r * (q + 1) + (xcd - r) * q) + off; }
        const int nig = WGM * nN, gid = wgid / nig, fm = gid * WGM, gsz = (nM - fm) < WGM ? (nM - fm) : WGM;
        u.pm = fm + ((wgid % nig) % gsz); u.pn = (wgid % nig) / gsz; return true;
    }
    __device__ __forceinline__ void a_ready(const Unit&) const {}
    __device__ __forceinline__ void done(const Unit&) const {}
};

__device__ __forceinline__ unsigned cvt_pk_bf16(float lo, float hi) { unsigned r; asm volatile("v_cvt_pk_bf16_f32 %0, %1, %2" : "=v"(r) : "v"(lo), "v"(hi)); return r; }

struct EpiProj {
    static constexpr bool PERM = true, AFTER_DRAIN = false;
    bf16_t* O; float* G;
    __device__ __forceinline__ void operator()(const f32x4 (&acc)[2][2][4][2], const Unit& u, int wr, int wc, int fr, int fq) const {
        const int row0 = u.pm * BM + wr * 64 + fr;
        if (u.pn < 11) {
            const int col0 = u.pn * BM + wc * 32 + 8 * fq;
#pragma unroll
            for (int ai = 0; ai < 2; ++ai)
#pragma unroll
                for (int m = 0; m < 4; ++m) { bf16_t* rowp = O + (size_t)(row0 + ai * HALF + m * 16) * 2816 + col0;
#pragma unroll
                    for (int bj = 0; bj < 2; ++bj) { const f32x4 v0 = acc[ai][bj][m][0], v1 = acc[ai][bj][m][1];
                        u32x4 w; w.x = cvt_pk_bf16(v0[0], v0[1]); w.y = cvt_pk_bf16(v0[2], v0[3]); w.z = cvt_pk_bf16(v1[0], v1[1]); w.w = cvt_pk_bf16(v1[2], v1[3]);
                        *(u32x4*)(rowp + bj * HALF) = w; } }
        } else if (wc == 0 && fq < 2) {
#pragma unroll
            for (int ai = 0; ai < 2; ++ai)
#pragma unroll
                for (int m = 0; m < 4; ++m) { float* rowp = G + (size_t)(row0 + ai * HALF + m * 16) * 16 + 8 * fq;
                    *(f32x4*)(rowp) = acc[ai][0][m][0]; *(f32x4*)(rowp + 4) = acc[ai][0][m][1]; }
        }
    }
};
struct EpiResid {
    static constexpr bool PERM = true, AFTER_DRAIN = false;
    const float* xin; float* out; const float* gate;
    int goff;
    __device__ __forceinline__ void operator()(const f32x4 (&acc)[2][2][4][2], const Unit& u, int wr, int wc, int fr, int fq) const {
        const int row0 = u.pm * BM + wr * 64 + fr, col0 = u.pn * BM + wc * 32 + 8 * fq;
        const float* gp = gate + (size_t)(row0 >> 13) * 6144 + goff + col0;
        f32x4 g[2][2];
#pragma unroll
        for (int bj = 0; bj < 2; ++bj)
#pragma unroll
            for (int n = 0; n < 2; ++n) g[bj][n] = *(const f32x4*)(gp + bj * HALF + 4 * n) + 1.0f;
#pragma unroll
        for (int ai = 0; ai < 2; ++ai)
#pragma unroll
            for (int m = 0; m < 4; ++m) { const size_t off = (size_t)(row0 + ai * HALF + m * 16) * 1024 + col0;
#pragma unroll
                for (int bj = 0; bj < 2; ++bj)
#pragma unroll
                    for (int n = 0; n < 2; ++n) { const f32x4 xv = *(const f32x4*)(xin + off + bj * HALF + 4 * n);
                        *(f32x4*)(out + off + bj * HALF + 4 * n) = xv + g[bj][n] * acc[ai][bj][m][n]; } }
    }
};
struct EpiSwiglu {
    static constexpr bool PERM = true, AFTER_DRAIN = false;
    bf16_t* H;
    __device__ __forceinline__ void operator()(const f32x4 (&acc)[2][2][4][2], const Unit& u, int wr, int wc, int fr, int fq) const {
        const int row0 = u.pm * BM + wr * 64 + fr, hid0 = 128 * (u.pn & 3) + 16 * wc + 4 * fq;
#pragma unroll
        for (int ai = 0; ai < 2; ++ai)
#pragma unroll
            for (int m = 0; m < 4; ++m) { bf16_t* rowp = H + (size_t)(row0 + ai * HALF + m * 16) * 512 + hid0;
#pragma unroll
                for (int bj = 0; bj < 2; ++bj) { const f32x4 g = acc[ai][bj][m][0], uu = acc[ai][bj][m][1]; float h[4];
#pragma unroll
                    for (int i = 0; i < 4; ++i) h[i] = g[i] / (1.f + __expf(-g[i])) * uu[i];
                    unsigned w0 = cvt_pk_bf16(h[0], h[1]), w1 = cvt_pk_bf16(h[2], h[3]);
                    *(unsigned long long*)(rowp + 64 * bj) = (unsigned long long)w0 | ((unsigned long long)w1 << 32); } }
    }
};
struct EpiMoeOut {
    static constexpr bool PERM = true, AFTER_DRAIN = false;
    bf16_t* Y; const int* list; PG8_LAS const int* ptab;
    __device__ __forceinline__ void operator()(const f32x4 (&acc)[2][2][4][2], const Unit& u, int wr, int wc, int fr, int fq) const {
        const int row0 = u.pm * BM + wr * 64 + fr, col0 = (u.pn & 3) * BM + wc * 32 + 8 * fq;
#pragma unroll
        for (int ai = 0; ai < 2; ++ai)
#pragma unroll
            for (int m = 0; m < 4; ++m) { const int dst = moe_tok2(list, ptab, row0 + ai * HALF + m * 16);
                if (dst >= 0) { bf16_t* rowp = Y + (size_t)dst * 1024 + col0;
#pragma unroll
                    for (int bj = 0; bj < 2; ++bj) { const f32x4 v0 = acc[ai][bj][m][0], v1 = acc[ai][bj][m][1];
                        u32x4 w; w.x = cvt_pk_bf16(v0[0], v0[1]); w.y = cvt_pk_bf16(v0[2], v0[3]); w.z = cvt_pk_bf16(v1[0], v1[1]); w.w = cvt_pk_bf16(v1[2], v1[3]);
                        *(u32x4*)(rowp + bj * HALF) = w; } } }
    }
};
struct MoeOrder {
    PG8_LAS const int* ptab; int G, c;
    __device__ __forceinline__ bool next(int i, Unit& u) const {
        const int L = i * G + c, np = __builtin_amdgcn_readfirstlane(ptab[0]);
        if (L >= np * 4) return false;
        const int p = L >> 2; u.pm = p; u.pn = __builtin_amdgcn_readfirstlane(ptab[1 + p]) * 4 + (L & 3); return true;
    }
    __device__ __forceinline__ void a_ready(const Unit&) const {}
    __device__ __forceinline__ void done(const Unit&) const {}
};
template <class Epi, class Sched, bool ALIGN_EPI = false, bool SP2 = false, bool GATHER = false>
__device__ __forceinline__ void gemm_phase(PG8_LAS unsigned char* lds, const Gemm g, const Sched& S, const Epi& E) {
    const int tid = threadIdx.x, wid = __builtin_amdgcn_readfirstlane(tid >> 6), lane = tid & 63, wr = wid >> 2, wc = wid & 3, fr = lane & 15, fq = lane >> 4;
    const int K = g.K, nt = K / BK;
    static_assert(!GATHER || SP2, "the gathered-A variant exists for the SP2 loop only");
    unsigned voffA[2], voffB[2];
    unsigned vAc[2] = {0u, 0u}, vAn[2] = {0u, 0u};
#pragma unroll
    for (int i = 0; i < 2; ++i) { int R, C; stage_rc(tid * 16 + i * 8192, R, C); const int Rb = Epi::PERM ? ((R & ~31) + perm32(R & 31)) : R;
        voffA[i] = (unsigned)(R * K + C) * 2u; voffB[i] = (unsigned)(Rb * K + C) * 2u; }
    const size_t kstep = (size_t)(BK * 2);
    const size_t hstep = (size_t)HALF * K * 2;
    const size_t tstep = 2 * hstep;
    const unsigned ldsw = (unsigned)wid * 1024u;
    const int aoff = lds_byte(wr * 64 + fr, fq * 8), boff = lds_byte(wc * 32 + fr, fq * 8);
#define PG8_SA(b, h) (((b) * 2 + (h)) * HTB)
#define PG8_SB(b, h) ((4 + (b) * 2 + (h)) * HTB)
#define PG8_STAGE(bufoff, gbase, voff) do { _Pragma("unroll") for (int _i = 0; _i < 2; ++_i) \
        __builtin_amdgcn_global_load_lds((const unsigned*)((const char*)(gbase) + (voff)[_i]), (PG8_LAS unsigned*)(lds + (bufoff) + ldsw + _i * 8192), 16, 0, 0); } while (0)
#define PG8_STAGEG(bufoff, base, pk) do { unsigned vg_[2]; _Pragma("unroll") for (int i_ = 0; i_ < 2; ++i_) { int R_, C_; stage_rc(tid * 16 + i_ * 8192, R_, C_); vg_[i_] = (((pk) >> (16 * i_)) & 0xffffu) * (unsigned)(2 * K) + (unsigned)(2 * C_); } PG8_STAGE(bufoff, base, vg_); } while (0)
#define PG8_STAGEA(bufoff, base, hh, nx) do { if constexpr (GATHER) { const unsigned pk_ = (nx) ? vAn[hh] : vAc[hh]; PG8_STAGEG(bufoff, base, pk_); } else PG8_STAGE(bufoff, (base) + (hh) * hstep, voffA); } while (0)
#define PG8_GOFF(dst, unit) do { _Pragma("unroll") for (int hh_ = 0; hh_ < 2; ++hh_) { unsigned pk_ = 0u; _Pragma("unroll") for (int i_ = 0; i_ < 2; ++i_) { int R_, C_; stage_rc(tid * 16 + i_ * 8192, R_, C_); \
        const int t2_ = moe_tok2(g.list, g.ptab, (unit).pm * BM + hh_ * HALF + R_); pk_ |= (unsigned)(t2_ < 0 ? 0 : (t2_ >> 1)) << (16 * i_); } dst[hh_] = pk_; } } while (0)
#define PG8_LDA(dst, b, h) do { _Pragma("unroll") for (int m = 0; m < 4; ++m) _Pragma("unroll") for (int k = 0; k < 2; ++k) dst[m][k] = *(const PG8_LAS bf16x8*)(lds + PG8_SA(b, h) + aoff + m * 2048 + k * 1024); } while (0)
#define PG8_LDB(dst, b, h) do { _Pragma("unroll") for (int n = 0; n < 2; ++n) _Pragma("unroll") for (int k = 0; k < 2; ++k) dst[n][k] = *(const PG8_LAS bf16x8*)(lds + PG8_SB(b, h) + boff + n * 2048 + k * 1024); } while (0)
#define PG8_MMA(ai, bj, At, Bt) do { __builtin_amdgcn_s_setprio(1); _Pragma("unroll") for (int m = 0; m < 4; ++m) _Pragma("unroll") for (int n = 0; n < 2; ++n) _Pragma("unroll") for (int k = 0; k < 2; ++k) \
        acc[ai][bj][m][n] = __builtin_amdgcn_mfma_f32_16x16x32_bf16(Bt[n][k], At[m][k], acc[ai][bj][m][n], 0, 0, 0); __builtin_amdgcn_s_setprio(0); } while (0)
#define PG8_WAIT_V(n) asm volatile("s_waitcnt vmcnt(" #n ")" ::: "memory")
#define PG8_WAIT_L(n) asm volatile("s_waitcnt lgkmcnt(" #n ")" ::: "memory")
#define PG8_BAR __builtin_amdgcn_s_barrier()
#define PG8_SCHED __builtin_amdgcn_sched_barrier(0)
    Unit cur, nxt; int ui = 0;
    if (!S.next(0, cur)) return;
    f32x4 acc[2][2][4][2];
#pragma unroll
    for (int a = 0; a < 2; ++a)
#pragma unroll
        for (int b = 0; b < 2; ++b)
#pragma unroll
            for (int m = 0; m < 4; ++m)
#pragma unroll
                for (int n = 0; n < 2; ++n) acc[a][b][m][n] = (f32x4){0.f, 0.f, 0.f, 0.f};
    bf16x8 At[4][2], B0[2][2], B1[2][2];
    const char* cA = (const char*)g.A + (GATHER ? (size_t)0 : (size_t)cur.pm * tstep); const char* cB = (const char*)g.Bt + (size_t)cur.pn * tstep;
    if constexpr (GATHER) { PG8_GOFF(vAc, cur); }
    S.a_ready(cur);
    if constexpr (SP2) {
        PG8_STAGE(PG8_SB(0, 0), cB, voffB); PG8_STAGE(PG8_SB(0, 1), cB + hstep, voffB); PG8_STAGEA(PG8_SA(0, 0), cA, 0, false); PG8_STAGEA(PG8_SA(0, 1), cA, 1, false);
        if (wr == 1) PG8_BAR;
        PG8_WAIT_V(2); PG8_BAR;
        PG8_STAGE(PG8_SB(1, 0), cB + kstep, voffB); PG8_STAGEA(PG8_SA(1, 0), cA + kstep, 0, false); PG8_STAGE(PG8_SB(1, 1), cB + hstep + kstep, voffB);
        PG8_WAIT_V(6); PG8_BAR;
    } else {
        PG8_STAGE(PG8_SB(0, 0), cB, voffB); PG8_STAGE(PG8_SA(0, 0), cA, voffA); PG8_STAGE(PG8_SB(0, 1), cB + hstep, voffB); PG8_STAGE(PG8_SA(0, 1), cA + hstep, voffA);
        if (wr == 1) PG8_BAR;
        PG8_WAIT_V(4); PG8_BAR;
        PG8_STAGE(PG8_SB(1, 0), cB + kstep, voffB); PG8_STAGE(PG8_SA(1, 0), cA + kstep, voffA); PG8_STAGE(PG8_SB(1, 1), cB + hstep + kstep, voffB);
        PG8_WAIT_V(6); PG8_BAR;
    }
    for (;;) {
        const bool has_next = S.next(ui + 1, nxt);
        const char* nA = (has_next && !GATHER) ? (const char*)g.A + (size_t)nxt.pm * tstep : cA;
        if constexpr (GATHER) { if (has_next) { PG8_GOFF(vAn, nxt); } else { vAn[0] = vAc[0]; vAn[1] = vAc[1]; } } const char* nB = has_next ? (const char*)g.Bt + (size_t)nxt.pn * tstep : cB;
        for (int t = 0; t < nt; t += 2) {
            const bool last = (t == nt - 2);
            const char* a1 = cA + (size_t)(t + 1) * kstep;
            const char* a2 = last ? nA : cA + (size_t)(t + 2) * kstep; const char* b2 = last ? nB : cB + (size_t)(t + 2) * kstep;
            const char* a3 = a2 + kstep; const char* b3 = b2 + kstep;
            if (last && has_next) S.a_ready(nxt);
            if constexpr (SP2) {
            PG8_LDB(B0, 0, 0); PG8_LDB(B1, 0, 1); PG8_SCHED; PG8_LDA(At, 0, 0); PG8_STAGEA(PG8_SA(1, 1), a1, 1, false);
            PG8_WAIT_V(8); PG8_WAIT_L(0); PG8_BAR; PG8_MMA(0, 0, At, B0); PG8_MMA(0, 1, At, B1); PG8_BAR; PG8_SCHED;
            PG8_LDA(At, 0, 1); PG8_STAGE(PG8_SB(0, 0), b2, voffB); PG8_STAGE(PG8_SB(0, 1), b2 + hstep, voffB); PG8_STAGEA(PG8_SA(0, 0), a2, 0, last);
            PG8_WAIT_V(8); PG8_WAIT_L(0); PG8_BAR; PG8_MMA(1, 0, At, B0); PG8_MMA(1, 1, At, B1); PG8_BAR; PG8_SCHED;
            PG8_LDB(B0, 1, 0); PG8_LDB(B1, 1, 1); PG8_SCHED; PG8_LDA(At, 1, 0); PG8_STAGEA(PG8_SA(0, 1), a2, 1, last);
            PG8_WAIT_V(8); PG8_WAIT_L(0); PG8_BAR; PG8_MMA(0, 0, At, B0); PG8_MMA(0, 1, At, B1); PG8_BAR; PG8_SCHED;
            PG8_LDA(At, 1, 1); PG8_STAGE(PG8_SB(1, 0), b3, voffB); PG8_STAGE(PG8_SB(1, 1), b3 + hstep, voffB); PG8_STAGEA(PG8_SA(1, 0), a3, 0, last);
            PG8_WAIT_V(8); PG8_WAIT_L(0); PG8_BAR; PG8_MMA(1, 0, At, B0); PG8_MMA(1, 1, At, B1); PG8_BAR; PG8_SCHED;
            } else {
            PG8_LDB(B0, 0, 0); PG8_SCHED; PG8_LDA(At, 0, 0); PG8_STAGE(PG8_SA(1, 1), a1 + hstep, voffA);
            PG8_WAIT_L(8); PG8_BAR; PG8_WAIT_L(0); PG8_MMA(0, 0, At, B0); PG8_BAR; PG8_SCHED;
            PG8_LDB(B1, 0, 1); PG8_STAGE(PG8_SB(0, 0), b2, voffB);
            PG8_BAR; PG8_WAIT_L(0); PG8_MMA(0, 1, At, B1); PG8_BAR;
            PG8_LDA(At, 0, 1); PG8_STAGE(PG8_SA(0, 0), a2, voffA);
            PG8_BAR; PG8_WAIT_L(0); PG8_MMA(1, 0, At, B0); PG8_BAR; PG8_SCHED;
            PG8_STAGE(PG8_SB(0, 1), b2 + hstep, voffB);
            PG8_WAIT_V(6); PG8_BAR; PG8_MMA(1, 1, At, B1); PG8_BAR;
            PG8_LDB(B0, 1, 0); PG8_SCHED; PG8_LDA(At, 1, 0); PG8_STAGE(PG8_SA(0, 1), a2 + hstep, voffA);
            PG8_WAIT_L(8); PG8_BAR; PG8_WAIT_L(0); PG8_MMA(0, 0, At, B0); PG8_BAR; PG8_SCHED;
            PG8_LDB(B1, 1, 1); PG8_STAGE(PG8_SB(1, 0), b3, voffB);
            PG8_BAR; PG8_WAIT_L(0); PG8_MMA(0, 1, At, B1); PG8_BAR;
            PG8_LDA(At, 1, 1); PG8_STAGE(PG8_SA(1, 0), a3, voffA);
            PG8_BAR; PG8_WAIT_L(0); PG8_MMA(1, 0, At, B0); PG8_BAR; PG8_SCHED;
            PG8_STAGE(PG8_SB(1, 1), b3 + hstep, voffB);
            PG8_WAIT_V(6); PG8_BAR; PG8_MMA(1, 1, At, B1); PG8_BAR;
            }
        }
        if constexpr (ALIGN_EPI) { if (wr == 0) PG8_BAR; }
        if constexpr (!Epi::AFTER_DRAIN) { E(acc, cur, wr, wc, fr, fq); S.done(cur); }
        if (!has_next) break;
#pragma unroll
        for (int a = 0; a < 2; ++a)
#pragma unroll
            for (int b = 0; b < 2; ++b)
#pragma unroll
                for (int m = 0; m < 4; ++m)
#pragma unroll
                    for (int n = 0; n < 2; ++n) acc[a][b][m][n] = (f32x4){0.f, 0.f, 0.f, 0.f};
        cur = nxt; cA = nA; cB = nB; ++ui;
        if constexpr (GATHER) { vAc[0] = vAn[0]; vAc[1] = vAn[1]; }
        if constexpr (ALIGN_EPI) { if (wr == 1) PG8_BAR; }
    }
    PG8_WAIT_V(0);
    if constexpr (!ALIGN_EPI) { if (wr == 0) PG8_BAR; }
    PG8_BAR;
    if constexpr (Epi::AFTER_DRAIN) { E.fused(acc, cur, wr, wc, fr, fq, lds, wid, lane); S.done(cur); }
#undef PG8_SA
#undef PG8_SB
#undef PG8_STAGE
#undef PG8_STAGEA
#undef PG8_STAGEG
#undef PG8_GOFF
#undef PG8_LDA
#undef PG8_LDB
#undef PG8_MMA
#undef PG8_WAIT_V
#undef PG8_WAIT_L
#undef PG8_BAR
#undef PG8_SCHED
}
}
#define XB_TMO      128
#define XB_XCNT(j)  (256  + 64 * (j))
#define XB_XSUB(j)  (1280 + 64 * (j))
#define XB_XGEN(j)  (2304 + 64 * (j))
#define XB_TOP      3328
#define XB_TOPGEN   3392
#define XCD_BAR_WORDS 3456
#define XB_SPIN_CAP (1u << 18)
#define LAS __attribute__((address_space(3)))

__device__ __forceinline__ unsigned xb_ld(unsigned* p)              { return __hip_atomic_load(p, __ATOMIC_RELAXED, __HIP_MEMORY_SCOPE_AGENT); }
__device__ __forceinline__ unsigned xb_add(unsigned* p, unsigned v) { return __hip_atomic_fetch_add(p, v, __ATOMIC_RELAXED, __HIP_MEMORY_SCOPE_AGENT); }
__device__ __forceinline__ unsigned xb_xcc_id() { return (unsigned)__builtin_amdgcn_s_getreg((3 << 11) | 20) & 0xFu; }
#define XB_SPIN(cond, bar) do { unsigned _sp = 0; while (cond) { __builtin_amdgcn_s_sleep(1); \
    if ((++_sp & 255u) == 0u) { if (xb_ld(&(bar)[XB_TMO])) break; if (_sp > XB_SPIN_CAP) { atomicAdd(&(bar)[XB_TMO], 1u); break; } } } } while (0)

struct XcdBarrier {
    unsigned* bar; unsigned x;
    volatile LAS unsigned* st;
};

__device__ __forceinline__ XcdBarrier xcd_barrier_post(unsigned* bar, volatile LAS unsigned* st) {
    XcdBarrier b; b.bar = bar; b.x = xb_xcc_id(); b.st = st;
    if (threadIdx.x == 0) (void)xb_add(&bar[XB_XCNT(b.x)], 1u);
    return b;
}
__device__ __forceinline__ void xcd_barrier_complete(unsigned* bar, unsigned x, unsigned& nloc, unsigned& nx) {
    const unsigned G = gridDim.x * gridDim.y * gridDim.z;
    unsigned sum, cnt, mine, sp = 0u;
    for (;;) {
        sum = 0u; cnt = 0u; mine = 0u;
#pragma unroll
        for (unsigned j = 0; j < 16; ++j) { const unsigned c = xb_ld(&bar[XB_XCNT(j)]); sum += c; cnt += (c > 0u) ? 1u : 0u; mine = (j == x) ? c : mine; }
        if (sum == G) break;
        __builtin_amdgcn_s_sleep(1);
        if ((++sp & 255u) == 0u) { if (xb_ld(&bar[XB_TMO])) break; if (sp > XB_SPIN_CAP) { atomicAdd(&bar[XB_TMO], 1u); break; } }
    }
    nloc = mine > 0u ? mine : 1u; nx = cnt > 0u ? cnt : 1u;
}

__device__ __forceinline__ void xcd_barrier(const XcdBarrier& b) {
    asm volatile("s_waitcnt vmcnt(0)" ::: "memory");
    __syncthreads();
    if (threadIdx.x == 0) {
        unsigned* bar = b.bar;
        __builtin_amdgcn_s_waitcnt(0);
        unsigned nloc = b.st[0], nx = b.st[1];
        if (nloc == 0u) { xcd_barrier_complete(bar, b.x, nloc, nx); b.st[0] = nloc; b.st[1] = nx; }
        const unsigned old = xb_add(&bar[XB_XSUB(b.x)], 1u);
        const unsigned gen = old / nloc;
        if (old + 1u == (gen + 1u) * nloc) {
            __builtin_amdgcn_fence(__ATOMIC_RELEASE, "agent");
            asm volatile("s_waitcnt vmcnt(0)" ::: "memory");
            const unsigned og = xb_add(&bar[XB_TOP], 1u);
            const unsigned tg = og / nx;
            if (og + 1u == (tg + 1u) * nx) xb_add(&bar[XB_TOPGEN], 1u);
            else XB_SPIN(xb_ld(&bar[XB_TOPGEN]) == tg, bar);
            __builtin_amdgcn_fence(__ATOMIC_ACQUIRE, "agent");
            xb_add(&bar[XB_XGEN(b.x)], 1u);
            asm volatile("s_waitcnt vmcnt(0)" ::: "memory");
        } else {
            XB_SPIN(xb_ld(&bar[XB_XGEN(b.x)]) == gen, bar);
            __builtin_amdgcn_fence(__ATOMIC_ACQUIRE, "agent");
            asm volatile("s_waitcnt vmcnt(0)" ::: "memory");
        }
    }
    __syncthreads();
}

struct Args { const float* in[47]; float* out; unsigned char* ws; int ph_lo, ph_hi; };
typedef const __attribute__((address_space(4))) Args* KArgsP;
__device__ __forceinline__ KArgsP fresh_args() { KArgsP p = (KArgsP)__builtin_amdgcn_kernarg_segment_ptr(); asm volatile("" : "+s"(p)); return p; }
enum { I_X = 0, I_C, I_ADA_W, I_ADA_B, I_NORM_MIX, I_NORM_FFN, I_NORM_FINAL, I_W_IN, I_W_OUT, I_CONV_W, I_CONV_B, I_WQ, I_WK, I_BI, I_BF, I_MNORM_W,
       I_RMU, I_RW0, I_RWUP, I_RA0, I_RAUP, I_RGUP, I_RKK, I_RKA, I_RRK, I_RLNW, I_RLNB, I_RV0, I_RVDN, I_RVUP,
       I_S5ARE, I_S5AIM, I_S5LDT, I_S5BRE, I_S5BIM, I_S5CRE, I_S5CIM, I_S5D, I_S5GLUW, I_S5GLUB,
       I_MWRG, I_MBRG, I_MWRE, I_MBRE, I_MW1, I_MW3, I_MW2 };

struct RmWin { __device__ __forceinline__ int operator()(int n) const { return n < 1152 ? n : (n < 1164 ? 2816 + (n - 1152) : (n < 2572 ? 1152 + (n - 1164) : 2560 + (n - 2572))); } };
struct RmId  { __device__ __forceinline__ int operator()(int n) const { return n; } };
struct RmGU  { int add; __device__ __forceinline__ int operator()(int n) const { return 8 * (n >> 2) + (n & 3) + add; } };
template <class RM>
__device__ __forceinline__ void transpose_item(const float* W, int ldw, int ncols, int k0, int n0, bf16* WT, int ldt, LAS float* scr, int lane, const RM rm) {
    const int nn = n0 + lane; const bool ok = nn < ncols; const float* src = W + (size_t)k0 * ldw + (ok ? nn : n0);
    float v[64];
#pragma unroll
    for (int kk = 0; kk < 64; ++kk) v[kk] = src[(size_t)kk * ldw];
#pragma unroll
    for (int kk = 0; kk < 64; ++kk) scr[kk * 65 + lane] = v[kk];
    LDS_WAIT(); asm volatile("" ::: "memory");
    const int c = lane & 7;
#pragma unroll
    for (int j = 0; j < 8; ++j) { const int nl = (lane >> 3) + 8 * j; const LAS float* s = scr + (8 * c) * 65 + nl;
        v4u o; o.x = pk2(s[0 * 65], s[1 * 65]); o.y = pk2(s[2 * 65], s[3 * 65]); o.z = pk2(s[4 * 65], s[5 * 65]); o.w = pk2(s[6 * 65], s[7 * 65]);
        if (n0 + nl < ncols) *(GAS v4u*)(WT + (size_t)rm(n0 + nl) * ldt + k0 + 8 * c) = o; }
    LDS_WAIT(); asm volatile("" ::: "memory");
}
__device__ __forceinline__ void moe_convert13(const float* w1, const float* w3, int l, bf16* W13, int worker, int nworkers, LAS float* scr, int lane) {
    for (int it = worker; it < NEXP * 256; it += nworkers) {
        const int e = it >> 8, r = it & 255; const size_t eo = (size_t)(l * NEXP + e) * DM * DEXP;
        if (r < 128) transpose_item(w1 + eo, DEXP, DEXP, 64 * (r >> 3), 64 * (r & 7), W13 + (size_t)e * 1024 * 1024, 1024, scr, lane, RmGU{0});
        else         transpose_item(w3 + eo, DEXP, DEXP, 64 * ((r - 128) >> 3), 64 * ((r - 128) & 7), W13 + (size_t)e * 1024 * 1024, 1024, scr, lane, RmGU{4});
    }
}
__device__ __forceinline__ void moe_convert2(const float* w2, int l, bf16* W2T, int worker, int nworkers, LAS float* scr, int lane) {
    for (int it = worker; it < NEXP * 128; it += nworkers) {
        const int e = it >> 7, r = it & 127; const size_t eo = (size_t)(l * NEXP + e) * DM * DEXP;
        transpose_item(w2 + eo, DM, DM, 64 * (r >> 4), 64 * (r & 15), W2T + (size_t)e * 1024 * 512, 512, scr, lane, RmId{});
    }
}
__device__ __forceinline__ void phase_prologue(KArgsP a, LAS unsigned char* lds, int tid, int lane, int wave, int vcu, int G) {
    unsigned char* ws = a->ws;
    LAS float* scr = (LAS float*)(lds + wave * 16640);
    const int gw = vcu * NWAVES + wave, NGW = G * NWAVES;
    bf16* WIN = (bf16*)(ws + WS_WIN); bf16* WOUT = (bf16*)(ws + WS_WOUT);
    for (int it = gw; it < 2 * 16 * 45; it += NGW) { const int l = it / (16 * 45), r = it % (16 * 45);
        transpose_item(a->in[I_W_IN] + (size_t)l * DM * IN_COLS, IN_COLS, IN_COLS, 64 * (r / 45), 64 * (r % 45), WIN + (size_t)l * NPROJ_PAD * DM, DM, scr, lane, RmWin{}); }
    for (int it = gw; it < 2 * 16 * 16; it += NGW) { const int l = it / 256, r = it % 256;
        transpose_item(a->in[I_W_OUT] + (size_t)l * DM * DM, DM, DM, 64 * (r >> 4), 64 * (r & 15), WOUT + (size_t)l * DM * DM, DM, scr, lane, RmId{}); }
    for (int it = gw; it < 2 * 244; it += NGW) { const int l = it / 244, r = 2828 + it % 244; GAS v4u* p = (GAS v4u*)(WIN + ((size_t)l * NPROJ_PAD + r) * DM);
        p[lane] = (v4u){0u, 0u, 0u, 0u}; p[lane + 64] = (v4u){0u, 0u, 0u, 0u}; }
    { float* RTW = (float*)(ws + WS_RTW);
      for (int idx = (vcu * NTHR + tid); idx < 2 * 1024 * 48; idx += G * NTHR) { const int j = idx % 48, k = (idx / 48) % 1024, l = idx / (48 * 1024);
          RTW[idx] = j < 4 ? a->in[I_MWRG][(size_t)(l * 1024 + k) * 4 + j] : (j < 36 ? a->in[I_MWRE][(size_t)(l * 1024 + k) * 32 + (j - 4)] : 0.f); } }
    { bf16* RW = (bf16*)(ws + WS_R1W);
      for (int idx = (vcu * NTHR + tid); idx < 2 * 98304 + 24576; idx += G * NTHR) { float v;
          if (idx < 2 * 98304) { const int l = idx / 98304, r = idx % 98304;
              if (r < 24576)      v = a->in[I_RWUP][(size_t)l * 64 * DBR + (r & 63) * DBR + (r >> 6)];
              else if (r < 49152) v = a->in[I_RAUP][(size_t)l * 64 * DBR + ((r - 24576) & 63) * DBR + ((r - 24576) >> 6)];
              else                v = a->in[I_RGUP][(size_t)l * 128 * DBR + ((r - 49152) & 127) * DBR + ((r - 49152) >> 7)];
          } else { const int r = idx - 2 * 98304;
              if (r < 12288) v = a->in[I_RVDN][(size_t)(r % 384) * 32 + (r / 384)];
              else           v = a->in[I_RVUP][(size_t)((r - 12288) & 31) * DBR + ((r - 12288) >> 5)]; }
          RW[idx] = (bf16)f2bf(v); } }
    for (int idx = (vcu * NTHR + tid); idx < 2 * 16 * 64; idx += G * NTHR) { const int p = idx & 63, lg = idx >> 6;
        const float lam_re = a->in[I_S5ARE][idx], lam_im = a->in[I_S5AIM][idx]; const float dt = expf(a->in[I_S5LDT][lg]); const float mag = expf(lam_re * dt), ang = lam_im * dt;
        const float are = mag * cosf(ang), aim = mag * sinf(ang); const float inv = 1.f / (lam_re * lam_re + lam_im * lam_im);
        const float cre = ((are - 1.f) * lam_re + aim * lam_im) * inv, cim = (aim * lam_re - (are - 1.f) * lam_im) * inv;
        ((float*)(ws + WS_S5AP))[idx * 2] = are; ((float*)(ws + WS_S5AP))[idx * 2 + 1] = aim;
        const float* br = a->in[I_S5BRE] + (size_t)idx * 16; const float* bi = a->in[I_S5BIM] + (size_t)idx * 16; bf16* o = (bf16*)(ws + WS_S5BB) + ((size_t)lg * 128 + 2 * p) * 16;
        for (int c = 0; c < 16; ++c) { o[c] = (bf16)f2bf(cre * br[c] - cim * bi[c]); o[16 + c] = (bf16)f2bf(cre * bi[c] + cim * br[c]); } }
    { bf16* CM = (bf16*)(ws + WS_S5CM);
      for (int idx = (vcu * NTHR + tid); idx < 2 * 16 * 16 * 128; idx += G * NTHR) { const int k = idx & 127, lgc = idx >> 7;
          CM[idx] = (bf16)f2bf((k & 1) ? -a->in[I_S5CIM][(size_t)lgc * 64 + (k >> 1)] : a->in[I_S5CRE][(size_t)lgc * 64 + (k >> 1)]); } }
    for (int it = gw; it < 2 * 16; it += NGW) { const int l = it >> 4, r = it & 15;
        transpose_item(a->in[I_S5GLUW] + (size_t)l * DC * DC, DC, DC, 64 * (r >> 2), 64 * (r & 3), (bf16*)(ws + WS_GLUT) + (size_t)l * DC * DC, DC, scr, lane, RmId{}); }
    { bf16* MLW = (bf16*)(ws + WS_MLW);
      for (int idx = (vcu * NTHR + tid); idx < 2 * NH * 2 * 4096; idx += G * NTHR) { const int d = idx & 63, e = (idx >> 6) & 63, which = (idx >> 12) & 1, lh = idx >> 13;
          MLW[idx] = (bf16)f2bf(a->in[which ? I_WK : I_WQ][(size_t)lh * 4096 + d * 64 + e]); } }
    __syncthreads();
    if (vcu < 192) {
        const int q = vcu, l = q / 96, cb = (q >> 3) % 12, kc = q & 7;
        LAS float* cond = (LAS float*)lds;
        { const int b = tid >> 7, kk = tid & 127; const float cv = a->in[I_C][b * DM + kc * 128 + kk]; cond[tid] = cv / (1.f + __expf(-cv)); }
        __syncthreads();
        const int col = cb * 512 + tid; const float* wp = a->in[I_ADA_W] + ((size_t)l * DM + kc * 128) * 6144 + col;
        float acc0 = 0.f, acc1 = 0.f, acc2 = 0.f, acc3 = 0.f;
#pragma unroll 8
        for (int kk = 0; kk < 128; ++kk) { const float w = wp[(size_t)kk * 6144]; acc0 += cond[kk] * w; acc1 += cond[128 + kk] * w; acc2 += cond[256 + kk] * w; acc3 += cond[384 + kk] * w; }
        const float bias = (kc == 0) ? a->in[I_ADA_B][l * 6144 + col] : 0.f;
        float* MP = (float*)(ws + WS_MODP) + ((size_t)(kc * 2 + l) * 4) * 6144 + col;
        MP[0] = acc0 + bias; MP[6144] = acc1 + bias; MP[2 * 6144] = acc2 + bias; MP[3 * 6144] = acc3 + bias;
    }
}

__device__ __forceinline__ float modval(const unsigned char* ws, bool part, int l, int b, int idx) {
    if (!part) return ((const float*)(ws + WS_MODF))[(size_t)(l * 4 + b) * 6144 + idx];
    const float* mp = (const float*)(ws + WS_MODP) + (size_t)(l * 4 + b) * 6144 + idx; float s = 0.f;
#pragma unroll
    for (int kc = 0; kc < 8; ++kc) s += mp[(size_t)kc * 2 * 4 * 6144];
    return s;
}
template <int MODE, bool COMBINE>
__device__ __forceinline__ void phase_rownorm(KArgsP a, LAS unsigned char* lds, int tid, int lane, int wave, int G,
                                              const float* xsrc, float* xdst, const float* gvec, bool part, int l, int isc  , int lprev) {
    unsigned char* ws = a->ws;
    LAS float* sc = (LAS float*)lds; LAS float* sh = sc + 1024; LAS float* gt = sh + 1024;
    bf16* HN = (bf16*)(ws + WS_HN); const bf16* YM = (const bf16*)(ws + WS_YMOE); const float* TW = (const float*)(ws + WS_TOKW);
    for (int c = blockIdx.x; c < NTOK / 128; c += G) {
        const int b = c >> 6;
        __syncthreads();
        for (int j = tid; j < 1024; j += NTHR) {
            if (MODE == 0) { sc[j] = gvec[j] * (1.f + modval(ws, part, l, b, (isc + 1) * 1024 + j)); sh[j] = modval(ws, part, l, b, isc * 1024 + j); }
            else { sc[j] = gvec[j]; sh[j] = 0.f; }
            if (COMBINE) gt[j] = 1.f + modval(ws, false, lprev, b, 5 * 1024 + j);
        }
        __syncthreads();
        f32x4 vn[4]; v2u yn0[4], yn1[4]; float wn0 = 0.f, wn1 = 0.f;
        { const int row = c * 128 + wave * 16; const GAS f32x4* xr = (const GAS f32x4*)(xsrc + (size_t)row * DM) + lane;
#pragma unroll
          for (int j = 0; j < 4; ++j) vn[j] = xr[64 * j];
          if (COMBINE) { wn0 = TW[2 * row]; wn1 = TW[2 * row + 1]; const GAS v2u* y0 = (const GAS v2u*)(YM + (size_t)(2 * row) * DM) + lane; const GAS v2u* y1 = (const GAS v2u*)(YM + (size_t)(2 * row + 1) * DM) + lane;
#pragma unroll
              for (int j = 0; j < 4; ++j) { yn0[j] = y0[64 * j]; yn1[j] = y1[64 * j]; } } }
        for (int i = 0; i < 16; ++i) {
            const int row = c * 128 + wave * 16 + i;
            f32x4 v[4]; v2u q0[4], q1[4]; const float w0 = wn0, w1 = wn1;
#pragma unroll
            for (int j = 0; j < 4; ++j) { v[j] = vn[j]; q0[j] = yn0[j]; q1[j] = yn1[j]; }
            if (i + 1 < 16) { const int rn = row + 1; const GAS f32x4* xr = (const GAS f32x4*)(xsrc + (size_t)rn * DM) + lane;
#pragma unroll
                for (int j = 0; j < 4; ++j) vn[j] = xr[64 * j];
                if (COMBINE) { wn0 = TW[2 * rn]; wn1 = TW[2 * rn + 1]; const GAS v2u* y0 = (const GAS v2u*)(YM + (size_t)(2 * rn) * DM) + lane; const GAS v2u* y1 = (const GAS v2u*)(YM + (size_t)(2 * rn + 1) * DM) + lane;
#pragma unroll
                    for (int j = 0; j < 4; ++j) { yn0[j] = y0[64 * j]; yn1[j] = y1[64 * j]; } } }
            if (COMBINE) {
#pragma unroll
                for (int j = 0; j < 4; ++j) { const v2u p0 = q0[j], p1 = q1[j]; const f32x4 g4 = *(const LAS f32x4*)(gt + lane * 4 + 256 * j);
                    f32x4 m; m.x = w0 * bflo(p0.x) + w1 * bflo(p1.x); m.y = w0 * bfhi(p0.x) + w1 * bfhi(p1.x); m.z = w0 * bflo(p0.y) + w1 * bflo(p1.y); m.w = w0 * bfhi(p0.y) + w1 * bfhi(p1.y);
                    v[j] = v[j] + g4 * m; }
                if (MODE == 0) { GAS f32x4* xo = (GAS f32x4*)(xdst + (size_t)row * DM) + lane;
#pragma unroll
                    for (int j = 0; j < 4; ++j) xo[64 * j] = v[j]; }
            }
            float ss = 0.f;
#pragma unroll
            for (int j = 0; j < 4; ++j) ss += (v[j].x * v[j].x + v[j].y * v[j].y) + (v[j].z * v[j].z + v[j].w * v[j].w);
            const float rstd = rsqrtf(wave_sum(ss) * (1.f / DM) + NORM_EPS);
            if (MODE == 0) {
                GAS v2u* o = (GAS v2u*)(HN + (size_t)row * DM) + lane;
#pragma unroll
                for (int j = 0; j < 4; ++j) { const f32x4 s4 = *(const LAS f32x4*)(sc + lane * 4 + 256 * j), h4 = *(const LAS f32x4*)(sh + lane * 4 + 256 * j); const f32x4 h = v[j] * rstd * s4 + h4;
                    v2u w; w.x = pk2(h.x, h.y); w.y = pk2(h.z, h.w); o[64 * j] = w; }
            } else {
                GAS f32x4* o = (GAS f32x4*)(xdst + (size_t)row * DM) + lane;
#pragma unroll
                for (int j = 0; j < 4; ++j) { const f32x4 s4 = *(const LAS f32x4*)(sc + lane * 4 + 256 * j); o[64 * j] = v[j] * rstd * s4; }
            }
        }
    }
}
__device__ __forceinline__ void mod_finalize(unsigned char* ws, int tid, int G) {
    float* MF = (float*)(ws + WS_MODF);
    for (int idx = blockIdx.x * NTHR + tid; idx < 2 * 4 * 6144; idx += G * NTHR) { const float* mp = (const float*)(ws + WS_MODP) + idx; float s = 0.f;
#pragma unroll
        for (int kc = 0; kc < 8; ++kc) s += mp[(size_t)kc * 2 * 4 * 6144];
        MF[idx] = s; }
}

typedef float f32x4m __attribute__((ext_vector_type(4)));
__device__ __forceinline__ void phase_router(KArgsP a, LAS unsigned char* lds, int tid, int lane, int wave, int G, int l) {
    unsigned char* ws = a->ws;
    LAS float* sc = (LAS float*)lds; LAS float* sh = sc + 1024; LAS float* rstd_s = sh + 1024  ; LAS float* cvec = rstd_s + 128  ; LAS float* cpart = cvec + 64  ;
    LAS float* lg = cpart + 8 * 48  ; LAS int* hist = (LAS int*)(lg + 8 * 16 * 48)  ; LAS int* basev = hist + 32; LAS int* asg_e = basev + 32  ; LAS int* asg_lp = asg_e + 256;
    bf16* HN = (bf16*)(ws + WS_HN); const float* x = a->out; const float* RTW = (const float*)(ws + WS_RTW) + (size_t)l * 1024 * 48;
    int* TOKE = (int*)(ws + WS_TOKE); float* TOKW = (float*)(ws + WS_TOKW); int* LIST = (int*)(ws + WS_LIST); unsigned* CNT = (unsigned*)(ws + WS_CTL) + CW_CNT + l * 32;
    const float* gvec = a->in[I_NORM_FFN] + l * DM;
    for (int c = blockIdx.x; c < NTOK / 128; c += G) {
        const int b = c >> 6;
        __syncthreads();
        for (int j = tid; j < 1024; j += NTHR) { sc[j] = gvec[j] * (1.f + modval(ws, false, l, b, 4 * 1024 + j)); sh[j] = modval(ws, false, l, b, 3 * 1024 + j); }
        if (tid < 32) hist[tid] = 0;
        __syncthreads();
        if (tid < 384) { const int j = tid % 48, part = tid / 48; float s = 0.f;
            for (int k = part * 128; k < part * 128 + 128; ++k) s += sh[k] * RTW[(size_t)k * 48 + j];
            cpart[part * 48 + j] = s; }
        { f32x4 vn[4];
          { const GAS f32x4* xr = (const GAS f32x4*)(x + (size_t)(c * 128 + wave * 16) * DM) + lane;
#pragma unroll
            for (int j = 0; j < 4; ++j) vn[j] = xr[64 * j]; }
          for (int i = 0; i < 16; ++i) {
            const int row = c * 128 + wave * 16 + i;
            f32x4 v[4]; float ss = 0.f;
#pragma unroll
            for (int j = 0; j < 4; ++j) { v[j] = vn[j]; ss += (v[j].x * v[j].x + v[j].y * v[j].y) + (v[j].z * v[j].z + v[j].w * v[j].w); }
            if (i + 1 < 16) { const GAS f32x4* xr = (const GAS f32x4*)(x + (size_t)(row + 1) * DM) + lane;
#pragma unroll
                for (int j = 0; j < 4; ++j) vn[j] = xr[64 * j]; }
            const float rstd = rsqrtf(wave_sum(ss) * (1.f / DM) + NORM_EPS);
            if (lane == 0) rstd_s[wave * 16 + i] = rstd;
            GAS v2u* o = (GAS v2u*)(HN + (size_t)row * DM) + lane;
#pragma unroll
            for (int j = 0; j < 4; ++j) { const f32x4 s4 = *(const LAS f32x4*)(sc + lane * 4 + 256 * j), h4 = *(const LAS f32x4*)(sh + lane * 4 + 256 * j); const f32x4 h = v[j] * rstd * s4 + h4;
                v2u w; w.x = pk2(h.x, h.y); w.y = pk2(h.z, h.w); o[64 * j] = w; }
          } }
        __syncthreads();
        if (tid < 48) { float s = 0.f;
#pragma unroll
            for (int p = 0; p < 8; ++p) s += cpart[p * 48 + tid];
            s += tid < 4 ? a->in[I_MBRG][l * 4 + tid] : (tid < 36 ? a->in[I_MBRE][l * 32 + tid - 4] : 0.f); cvec[tid] = s; }
        {
            const int i16 = lane & 15, kq = lane >> 4, r0 = c * 128 + wave * 16;
            f32x4m acc0 = {0.f, 0.f, 0.f, 0.f}, acc1 = acc0, acc2 = acc0;
            const float* xrow = x + (size_t)(r0 + i16) * DM + 4 * kq;
#pragma unroll 4
            for (int k0 = 0; k0 < DM; k0 += 16) {
                const f32x4 xv = *(const GAS f32x4*)(xrow + k0); const f32x4 sv = *(const LAS f32x4*)(sc + k0 + 4 * kq);
                const float* wp = RTW + (size_t)(k0 + 4 * kq) * 48 + i16;
#pragma unroll
                for (int j = 0; j < 4; ++j) { const float av = xv[j] * sv[j];
                    acc0 = __builtin_amdgcn_mfma_f32_16x16x4f32(av, wp[j * 48], acc0, 0, 0, 0);
                    acc1 = __builtin_amdgcn_mfma_f32_16x16x4f32(av, wp[j * 48 + 16], acc1, 0, 0, 0);
                    acc2 = __builtin_amdgcn_mfma_f32_16x16x4f32(av, wp[j * 48 + 32], acc2, 0, 0, 0); }
            }
            __syncthreads();
            LAS float* lw = lg + wave * 16 * 48;
#pragma unroll
            for (int r = 0; r < 4; ++r) { const int rr = 4 * kq + r; const float rs = rstd_s[wave * 16 + rr];
                lw[rr * 48 + i16] = acc0[r] * rs + cvec[i16]; lw[rr * 48 + 16 + i16] = acc1[r] * rs + cvec[16 + i16]; lw[rr * 48 + 32 + i16] = acc2[r] * rs + cvec[32 + i16]; }
            LDS_WAIT(); asm volatile("" ::: "memory");
            if (lane < 16) {
                const LAS float* lr = lw + lane * 48; const int row = r0 + lane;
                float g0 = lr[0], g1 = lr[1], g2 = lr[2], g3 = lr[3]; const float gm = fmaxf(fmaxf(g0, g1), fmaxf(g2, g3));
                float p0 = __expf(g0 - gm), p1 = __expf(g1 - gm), p2 = __expf(g2 - gm), p3 = __expf(g3 - gm); const float inv = 1.f / (p0 + p1 + p2 + p3);
                p0 *= inv; p1 *= inv; p2 *= inv; p3 *= inv;
                int gi = 0; float gp = p0; if (p1 > gp) { gp = p1; gi = 1; } if (p2 > gp) { gp = p2; gi = 2; } if (p3 > gp) { gp = p3; gi = 3; }
                float ev0 = -3.4e38f, ev1 = -3.4e38f; int e0 = 0, e1 = 0;
#pragma unroll
                for (int j = 0; j < 8; ++j) { const float s = lr[4 + gi * 8 + j]; if (s > ev0) { ev1 = ev0; e1 = e0; ev0 = s; e0 = j; } else if (s > ev1) { ev1 = s; e1 = j; } }
                const float q = __expf(ev1 - ev0), w0 = gp / (1.f + q), w1 = gp * q / (1.f + q);
                e0 += gi * 8; e1 += gi * 8;
                TOKE[2 * row] = e0; TOKE[2 * row + 1] = e1; TOKW[2 * row] = w0; TOKW[2 * row + 1] = w1;
                const int a0 = 2 * (wave * 16 + lane);
                asg_e[a0] = e0; asg_e[a0 + 1] = e1; asg_lp[a0] = atomicAdd((int*)&hist[e0], 1); asg_lp[a0 + 1] = atomicAdd((int*)&hist[e1], 1);
            }
        }
        __syncthreads();
        if (tid < 32) { const int h = hist[tid]; basev[tid] = h ? (int)atomicAdd(CNT + tid, (unsigned)h) : 0; }
        __syncthreads();
        if (tid < 256) { const int e = asg_e[tid]; LIST[(size_t)e * 65536 + basev[e] + asg_lp[tid]] = (c * 128) * 2 + tid; }
    }
}
__device__ __forceinline__ void build_ptab(const unsigned* CNT, LAS int* ptab, LAS int* pst, LAS int* cnt, int tid) {
    __syncthreads();
    if (tid == 0) { int np = 0;
        for (int e = 0; e < NEXP; ++e) { const int ce = (int)__hip_atomic_load(CNT + e, RLX_AGENT); cnt[e] = ce; pst[e] = np * 256; const int pe = (ce + 255) >> 8;
            for (int p = 0; p < pe; ++p) ptab[1 + np + p] = e;
            np += pe; }
        ptab[0] = np; }
    __syncthreads();
}
__device__ __forceinline__ void phase_gather(KArgsP a, LAS unsigned char* lds, int tid, int lane, int wave, int vcu, int G, int l) {
    unsigned char* ws = a->ws;
    LAS int* ptab = (LAS int*)lds; LAS int* pst = ptab + 512; LAS int* cnt = pst + 32;
    build_ptab((const unsigned*)(ws + WS_CTL) + CW_CNT + l * 32, ptab, pst, cnt, tid);
    const bf16* HN = (const bf16*)(ws + WS_HN); bf16* XG = (bf16*)(ws + WS_XG); int* ROWMAP = (int*)(ws + WS_ROWMAP); const int* LIST = (const int*)(ws + WS_LIST);
    const int nrows = ptab[0] * 256;
    for (int row0 = (vcu * NWAVES + wave) * 8; row0 < nrows; row0 += G * NWAVES * 8) {
        int tok2[8]; v4u p0[8], p1[8];
#pragma unroll
        for (int j = 0; j < 8; ++j) { const int row = row0 + j, e = ptab[1 + (row >> 8)], pos = row - pst[e]; tok2[j] = (pos < cnt[e]) ? LIST[(size_t)e * 65536 + pos] : -1; }
#pragma unroll
        for (int j = 0; j < 8; ++j) { if (tok2[j] >= 0) { const GAS v4u* s = (const GAS v4u*)(HN + (size_t)(tok2[j] >> 1) * DM) + lane; p0[j] = s[0]; p1[j] = s[64]; } else { p0[j] = (v4u){0u, 0u, 0u, 0u}; p1[j] = p0[j]; } }
#pragma unroll
        for (int j = 0; j < 8; ++j) { GAS v4u* d = (GAS v4u*)(XG + (size_t)(row0 + j) * DM) + lane; d[0] = p0[j]; d[64] = p1[j]; if (lane == 0) ROWMAP[row0 + j] = tok2[j]; }
    }
}

__device__ __forceinline__ void phase_rowmap(KArgsP a, LAS unsigned char* lds, int tid, int vcu, int G, int l) {
    unsigned char* ws = a->ws;
    LAS int* ptab = (LAS int*)lds; LAS int* pst = ptab + 512; LAS int* cnt = pst + 32;
    build_ptab((const unsigned*)(ws + WS_CTL) + CW_CNT + l * 32, ptab, pst, cnt, tid);
    int* ROWMAP = (int*)(ws + WS_ROWMAP); const int* LIST = (const int*)(ws + WS_LIST);
    const int nrows = ptab[0] * 256;
    for (int row = vcu * NTHR + tid; row < nrows; row += G * NTHR) { const int e = ptab[1 + (row >> 8)], pos = row - pst[e]; ROWMAP[row] = (pos < cnt[e]) ? LIST[(size_t)e * 65536 + pos] : -1; }
}

typedef short bf16x8 __attribute__((ext_vector_type(8)));
constexpr int MT = 72;
constexpr int ML_XP = 0;
constexpr int ML_CX = 17152;
constexpr int ML_WQ = ML_CX + 9216, ML_WK = ML_WQ + 9216;
constexpr int ML_Q = ML_WK + 9216, ML_K = ML_Q + 9216;
constexpr int ML_S = ML_K + 9216;
constexpr int ML_VT = ML_S + 9216;
constexpr int ML_CT = ML_VT + 11520;
constexpr int ML_H = ML_CT + 11520;
constexpr int ML_SM = ML_H + 16640;
static_assert(ML_SM + 2048 <= RING_BYTES, "mLSTM LDS map");
__device__ __forceinline__ float logsigmoidf_(float x) { return fminf(x, 0.f) - log1pf(__expf(-fabsf(x))); }
__device__ __forceinline__ void mma64(const LAS bf16* A, int arow0, const LAS bf16* Bt, int brow0, int lane, f32x4& acc) {
    const LAS bf16* ap = A + (arow0 + (lane & 15)) * MT + 8 * (lane >> 4); const LAS bf16* bp = Bt + (brow0 + (lane & 15)) * MT + 8 * (lane >> 4);
    const bf16x8 a0 = *(const LAS bf16x8*)ap, a1 = *(const LAS bf16x8*)(ap + 32), b0 = *(const LAS bf16x8*)bp, b1 = *(const LAS bf16x8*)(bp + 32);
    acc = __builtin_amdgcn_mfma_f32_16x16x32_bf16(a0, b0, acc, 0, 0, 0); acc = __builtin_amdgcn_mfma_f32_16x16x32_bf16(a1, b1, acc, 0, 0, 0);
}
__device__ __forceinline__ void ml_front(KArgsP a, LAS unsigned char* lds, int tid, int l, int b, int c, int h, bool want_q) {
    const bf16* PROJ = (const bf16*)(a->ws + WS_PROJ); const size_t row0 = (size_t)b * SEQ + c * 64;
    LAS float* xp = (LAS float*)(lds + ML_XP);
    for (int idx = tid; idx < 67 * 8; idx += NTHR) { const int r = idx >> 3, c8 = idx & 7, tr = c * 64 + r - 3; LAS float* d = xp + r * 64 + c8 * 8;
        if (tr >= 0) { const v4u p = *(const GAS v4u*)(PROJ + ((size_t)b * SEQ + tr) * NPROJ + PC_QK + h * 64 + c8 * 8);
            *(LAS f32x4*)d = (f32x4){bflo(p.x), bfhi(p.x), bflo(p.y), bfhi(p.y)}; *(LAS f32x4*)(d + 4) = (f32x4){bflo(p.z), bfhi(p.z), bflo(p.w), bfhi(p.w)}; }
        else { *(LAS f32x4*)d = (f32x4){0.f, 0.f, 0.f, 0.f}; *(LAS f32x4*)(d + 4) = (f32x4){0.f, 0.f, 0.f, 0.f}; } }
    {
        const int t = tid >> 3, vg = tid & 7; LAS bf16* VT = (LAS bf16*)(lds + ML_VT);
        const v4u p = *(const GAS v4u*)(PROJ + (row0 + t) * NPROJ + PC_V + h * 64 + vg * 8);
        const unsigned w[4] = {p.x, p.y, p.z, p.w};
#pragma unroll
        for (int j = 0; j < 4; ++j) { VT[(vg * 8 + 2 * j) * MT + t] = (bf16)(w[j] & 0xffffu); VT[(vg * 8 + 2 * j + 1) * MT + t] = (bf16)(w[j] >> 16); }
        for (int idx = tid; idx < 16 * 64; idx += NTHR) VT[(64 + (idx >> 6)) * MT + (idx & 63)] = (idx < 64) ? (bf16)0x3F80 : (bf16)0;
        const bf16* WT = (const bf16*)(a->ws + WS_MLW) + (size_t)((l * NH + h) * 2) * 4096;
        const int e = tid >> 3, d8 = tid & 7;
        if (want_q) *(LAS v4u*)(lds + ML_WQ + (e * MT + d8 * 8) * 2) = *(const GAS v4u*)(WT + e * 64 + d8 * 8);
        *(LAS v4u*)(lds + ML_WK + (e * MT + d8 * 8) * 2) = *(const GAS v4u*)(WT + 4096 + e * 64 + d8 * 8);
    }
    __syncthreads();
    const float* cw = a->in[I_CONV_W] + (size_t)l * 4 * DA + h * 64; const float* cb = a->in[I_CONV_B] + (size_t)l * DA + h * 64;
    {
        const int t = tid >> 3, c8 = (tid & 7) * 8; float s[8];
#pragma unroll
        for (int j = 0; j < 8; ++j) s[j] = cb[c8 + j];
#pragma unroll
        for (int q = 0; q < 4; ++q) { const f32x4 x0 = *(const LAS f32x4*)(xp + (t + q) * 64 + c8), x1 = *(const LAS f32x4*)(xp + (t + q) * 64 + c8 + 4); const float* w = cw + q * DA + c8;
            s[0] += x0.x * w[0]; s[1] += x0.y * w[1]; s[2] += x0.z * w[2]; s[3] += x0.w * w[3]; s[4] += x1.x * w[4]; s[5] += x1.y * w[5]; s[6] += x1.z * w[6]; s[7] += x1.w * w[7]; }
#pragma unroll
        for (int j = 0; j < 8; ++j) s[j] = s[j] / (1.f + __expf(-s[j]));
        v4u o; o.x = pk2(s[0], s[1]); o.y = pk2(s[2], s[3]); o.z = pk2(s[4], s[5]); o.w = pk2(s[6], s[7]);
        *(LAS v4u*)(lds + ML_CX + (t * MT + c8) * 2) = o;
    }
}
__device__ __forceinline__ void phase_m1(KArgsP a, LAS unsigned char* lds, int tid, int lane, int wave, int vcu, int G, int l) {
    unsigned char* ws = a->ws; const float* GT = (const float*)(ws + WS_GATES);
    float* CLOC = (float*)(ws + WS_CLOC); float* MLG = (float*)(ws + WS_MSC); float* MLM = MLG + 4096;
    LAS float* sm = (LAS float*)(lds + ML_SM);
    for (int u = vcu; u < NUNIT_M; u += G) {
        const int h = u % NH, c = (u / NH) % NCH, b = u / (NH * NCH); const size_t row0 = (size_t)b * SEQ + c * 64;
        __syncthreads();
        ml_front(a, lds, tid, l, b, c, h, false);
        if (wave == 0) {
            const float ig = GT[(row0 + lane) * 16 + h] + a->in[I_BI][l * NH + h];
            const float fl = logsigmoidf_(GT[(row0 + lane) * 16 + 6 + h] + a->in[I_BF][l * NH + h]);
            float bc = fl;
#pragma unroll
            for (int o = 1; o < 64; o <<= 1) { const float t = __shfl_up(bc, o); if (lane >= o) bc += t; }
            const float gtot = __shfl(bc, 63); const float lw = gtot - bc + ig; const float ml = wave_max(lw);
            sm[lane] = __expf(lw - ml);
            if (lane == 0) { MLG[u] = gtot; MLM[u] = ml; }
        }
        __syncthreads();
        {
            const int rt = wave >> 1; LAS bf16* KT = (LAS bf16*)(lds + ML_K);
#pragma unroll
            for (int q = 0; q < 2; ++q) { const int ct = 2 * (wave & 1) + q; f32x4 acc = {0.f, 0.f, 0.f, 0.f};
                mma64((const LAS bf16*)(lds + ML_CX), 16 * rt, (const LAS bf16*)(lds + ML_WK), 16 * ct, lane, acc);
                const int t0 = 16 * rt + 4 * (lane >> 4), e = 16 * ct + (lane & 15);
                const float w0 = sm[t0] * 0.125f, w1 = sm[t0 + 1] * 0.125f, w2 = sm[t0 + 2] * 0.125f, w3 = sm[t0 + 3] * 0.125f;
                v2u o; o.x = pk2(acc[0] * w0, acc[1] * w1); o.y = pk2(acc[2] * w2, acc[3] * w3);
                *(LAS v2u*)(KT + e * MT + t0) = o; }
        }
        __syncthreads();
        {
            const int ct = wave & 3, r_lo = wave < 4 ? 0 : 3, r_hi = wave < 4 ? 3 : 5; float* cl = CLOC + (size_t)u * CL_STRIDE;
            for (int rt = r_lo; rt < r_hi; ++rt) { f32x4 acc = {0.f, 0.f, 0.f, 0.f};
                mma64((const LAS bf16*)(lds + ML_VT), 16 * rt, (const LAS bf16*)(lds + ML_K), 16 * ct, lane, acc);
                const int v0 = 16 * rt + 4 * (lane >> 4), e = 16 * ct + (lane & 15);
                if (rt < 4) {
#pragma unroll
                    for (int r = 0; r < 4; ++r) cl[(v0 + r) * 64 + e] = acc[r];
                } else if ((lane >> 4) == 0) cl[4096 + e] = acc[0]; }
        }
    }
}
__device__ __forceinline__ void phase_m2(unsigned char* ws, int tid, int wg, int nwg) {
    float* CLOC = (float*)(ws + WS_CLOC); const float* MLG = (const float*)(ws + WS_MSC); const float* MLM = MLG + 4096; float* MST = (float*)(ws + WS_MSC) + 8192;
    for (int idx = wg * NTHR + tid; idx < NB * NH * CL_STRIDE; idx += nwg * NTHR) {
        const int e = idx % CL_STRIDE, bh = idx / CL_STRIDE, b = bh / NH, h = bh % NH;
        float m = 0.f, cs = 0.f;
        for (int c0 = 0; c0 < NCH; c0 += 8) {
            float cl[8], g[8], ml[8];
#pragma unroll
            for (int j = 0; j < 8; ++j) { const int u = (b * NCH + c0 + j) * NH + h; cl[j] = CLOC[(size_t)u * CL_STRIDE + e]; g[j] = MLG[u]; ml[j] = MLM[u]; }
#pragma unroll
            for (int j = 0; j < 8; ++j) { const int u = (b * NCH + c0 + j) * NH + h;
                CLOC[(size_t)u * CL_STRIDE + e] = cs; if (e == 0) MST[u] = m;
                const float mn = fmaxf(g[j] + m, ml[j]); const float ao = __expf(g[j] + m - mn), al = __expf(ml[j] - mn);
                cs = ao * cs + al * cl[j]; m = mn; }
        }
    }
}
__device__ __forceinline__ void phase_m3(KArgsP a, LAS unsigned char* lds, int tid, int lane, int wave, int vcu, int G, int l) {
    unsigned char* ws = a->ws; const bf16* PROJ = (const bf16*)(ws + WS_PROJ); const float* GT = (const float*)(ws + WS_GATES);
    const float* CLOC = (const float*)(ws + WS_CLOC); const float* MST = (const float*)(ws + WS_MSC) + 8192; bf16* YC = (bf16*)(ws + WS_YC);
    LAS float* sm = (LAS float*)(lds + ML_SM); LAS float* hb = (LAS float*)(lds + ML_H);
    for (int u = vcu; u < NUNIT_M; u += G) {
        const int h = u % NH, c = (u / NH) % NCH, b = u / (NH * NCH); const size_t row0 = (size_t)b * SEQ + c * 64;
        __syncthreads();
        ml_front(a, lds, tid, l, b, c, h, true);
        {
            const float* cl = CLOC + (size_t)u * CL_STRIDE; LAS bf16* CT = (LAS bf16*)(lds + ML_CT);
            for (int idx = tid; idx < 65 * 16; idx += NTHR) { const int r = idx >> 4, c4 = idx & 15; const f32x4 v = *(const GAS f32x4*)(cl + r * 64 + c4 * 4);
                v2u o; o.x = pk2(v.x, v.y); o.y = pk2(v.z, v.w); *(LAS v2u*)(CT + r * MT + c4 * 4) = o; }
            for (int idx = tid; idx < 15 * 64; idx += NTHR) CT[(65 + (idx >> 6)) * MT + (idx & 63)] = 0;
        }
        if (wave == 0) {
            const float ig = GT[(row0 + lane) * 16 + h] + a->in[I_BI][l * NH + h];
            const float fl = logsigmoidf_(GT[(row0 + lane) * 16 + 6 + h] + a->in[I_BF][l * NH + h]);
            float bc = fl;
#pragma unroll
            for (int o = 1; o < 64; o <<= 1) { const float t = __shfl_up(bc, o); if (lane >= o) bc += t; }
            float pm = ig - bc;
#pragma unroll
            for (int o = 1; o < 64; o <<= 1) { const float t = __shfl_up(pm, o); if (lane >= o) pm = fmaxf(pm, t); }
            const float mst = MST[u]; const float inter = bc + mst, mt = fmaxf(inter, bc + pm);
            sm[lane] = ig - bc; sm[64 + lane] = bc - mt; sm[128 + lane] = __expf(inter - mt); sm[192 + lane] = __expf(-mt);
        }
        __syncthreads();
        {
            const int rt = wave >> 1; LAS bf16* Qs = (LAS bf16*)(lds + ML_Q); LAS bf16* Ks = (LAS bf16*)(lds + ML_K);
#pragma unroll
            for (int q = 0; q < 2; ++q) { const int ct = 2 * (wave & 1) + q; f32x4 aq = {0.f, 0.f, 0.f, 0.f}, ak = {0.f, 0.f, 0.f, 0.f};
                mma64((const LAS bf16*)(lds + ML_CX), 16 * rt, (const LAS bf16*)(lds + ML_WQ), 16 * ct, lane, aq);
                mma64((const LAS bf16*)(lds + ML_CX), 16 * rt, (const LAS bf16*)(lds + ML_WK), 16 * ct, lane, ak);
                const int t0 = 16 * rt + 4 * (lane >> 4), e = 16 * ct + (lane & 15);
#pragma unroll
                for (int r = 0; r < 4; ++r) { Qs[(t0 + r) * MT + e] = (bf16)f2bf(aq[r]); Ks[(t0 + r) * MT + e] = (bf16)f2bf(ak[r] * 0.125f); } }
        }
        __syncthreads();
        {
            const int rt = wave >> 1; LAS bf16* Ss = (LAS bf16*)(lds + ML_S);
#pragma unroll
            for (int q = 0; q < 2; ++q) { const int ct = 2 * (wave & 1) + q; f32x4 acc = {0.f, 0.f, 0.f, 0.f};
                if (ct <= rt) mma64((const LAS bf16*)(lds + ML_Q), 16 * rt, (const LAS bf16*)(lds + ML_K), 16 * ct, lane, acc);
                const int t0 = 16 * rt + 4 * (lane >> 4), s = 16 * ct + (lane & 15); const float qs = sm[s];
#pragma unroll
                for (int r = 0; r < 4; ++r) { const int t = t0 + r; Ss[t * MT + s] = (bf16)f2bf((s <= t) ? acc[r] * __expf(sm[64 + t] + qs) : 0.f); } }
        }
        __syncthreads();
        {
            const int rt = wave >> 1, nt = (wave & 1) ? 2 : 3;
            for (int q = 0; q < nt; ++q) { const int ct = (wave & 1) ? 2 + q : (q < 2 ? q : 4); f32x4 aA = {0.f, 0.f, 0.f, 0.f}, aB = {0.f, 0.f, 0.f, 0.f};
                mma64((const LAS bf16*)(lds + ML_Q), 16 * rt, (const LAS bf16*)(lds + ML_CT), 16 * ct, lane, aA);
                mma64((const LAS bf16*)(lds + ML_S), 16 * rt, (const LAS bf16*)(lds + ML_VT), 16 * ct, lane, aB);
                const int t0 = 16 * rt + 4 * (lane >> 4), v = 16 * ct + (lane & 15);
#pragma unroll
                for (int r = 0; r < 4; ++r) { const int t = t0 + r; const float x = sm[128 + t] * aA[r] + aB[r];
                    if (ct < 4) hb[t * 65 + v] = x; else if ((lane & 15) == 0) sm[256 + t] = x; } }
        }
        __syncthreads();
        {
            const int t = tid >> 3, vg = tid & 7; float acc[8];
            const float dn = 1.f / fmaxf(fabsf(sm[256 + t]), sm[192 + t]);
            float s1 = 0.f;
#pragma unroll
            for (int j = 0; j < 8; ++j) { acc[j] = hb[t * 65 + vg * 8 + j] * dn; s1 += acc[j]; }
            s1 += __shfl_xor(s1, 1); s1 += __shfl_xor(s1, 2); s1 += __shfl_xor(s1, 4);
            const float mu = s1 * (1.f / 64.f); float s2 = 0.f;
#pragma unroll
            for (int j = 0; j < 8; ++j) { acc[j] -= mu; s2 += acc[j] * acc[j]; }
            s2 += __shfl_xor(s2, 1); s2 += __shfl_xor(s2, 2); s2 += __shfl_xor(s2, 4);
            const float rs = rsqrtf(s2 * (1.f / 64.f) + HEAD_NORM_EPS);
            const float* nw = a->in[I_MNORM_W] + (size_t)l * DA + h * 64 + vg * 8;
            const v4u ov = *(const GAS v4u*)(PROJ + (row0 + t) * NPROJ + PC_O + h * 64 + vg * 8);
            const float o[8] = {bflo(ov.x), bfhi(ov.x), bflo(ov.y), bfhi(ov.y), bflo(ov.z), bfhi(ov.z), bflo(ov.w), bfhi(ov.w)};
            float r[8];
#pragma unroll
            for (int j = 0; j < 8; ++j) r[j] = acc[j] * rs * nw[j] * sigmoidf_(o[j]);
            v4u w; w.x = pk2(r[0], r[1]); w.y = pk2(r[2], r[3]); w.z = pk2(r[4], r[5]); w.w = pk2(r[6], r[7]);
            *(GAS v4u*)(YC + (row0 + t) * DM + h * 64 + vg * 8) = w;
        }
    }
}

constexpr int S5_UT = 264, S5_XT = 2056;
constexpr int S5_U = 0, S5_Z = 33792, S5_X = 67584;
static_assert(S5_X + 16 * S5_XT * 2 <= MISC_OFF, "S5 LDS map");
struct S5A { float are, aim, cre, cim; };
__device__ __forceinline__ S5A s5_a(KArgsP a, int l, int g, int p) {
    const float lam_re = a->in[I_S5ARE][(size_t)(l * 16 + g) * 64 + p], lam_im = a->in[I_S5AIM][(size_t)(l * 16 + g) * 64 + p];
    const float dt = expf(a->in[I_S5LDT][l * 16 + g]); const float mag = expf(lam_re * dt), ang = lam_im * dt;
    S5A r; r.are = mag * cosf(ang); r.aim = mag * sinf(ang);
    const float inv = 1.f / (lam_re * lam_re + lam_im * lam_im);
    r.cre = ((r.are - 1.f) * lam_re + r.aim * lam_im) * inv; r.cim = (r.aim * lam_re - (r.are - 1.f) * lam_im) * inv; return r;
}
__device__ __forceinline__ bf16x8 pack8(const float* v) { v4u o; o.x = pk2(v[0], v[1]); o.y = pk2(v[2], v[3]); o.z = pk2(v[4], v[5]); o.w = pk2(v[6], v[7]); return __builtin_bit_cast(bf16x8, o); }
__device__ __forceinline__ void s5_bfrag(const unsigned char* ws, int l, int g, int lane, bf16x8 (&bf)[8]) {
    const bf16* BB = (const bf16*)(ws + WS_S5BB) + (size_t)(l * 16 + g) * 128 * 16;
#pragma unroll
    for (int j = 0; j < 8; ++j) { v4u o = {0u, 0u, 0u, 0u}; if ((lane >> 4) < 2) o = *(const GAS v4u*)(BB + (16 * j + (lane & 15)) * 16 + 8 * (lane >> 4)); bf[j] = __builtin_bit_cast(bf16x8, o); }
}
__device__ __forceinline__ f32x2 s5_ap(const unsigned char* ws, int l, int g, int p) { return *(const GAS f32x2*)((const float*)(ws + WS_S5AP) + ((size_t)(l * 16 + g) * 64 + p) * 2); }
__device__ __forceinline__ void s5_load_u(const unsigned char* ws, LAS unsigned char* lds, int tid, size_t row0) {
    const bf16* PROJ = (const bf16*)(ws + WS_PROJ);
    for (int idx = tid; idx < 64 * 32; idx += NTHR) { const int t = idx >> 5, c8 = idx & 31;
        *(LAS v4u*)(lds + S5_U + (t * S5_UT + c8 * 8) * 2) = *(const GAS v4u*)(PROJ + (row0 + t) * NPROJ + PC_S5 + c8 * 8); }
}
__device__ __forceinline__ void s5_block(LAS unsigned char* lds, int lane, int tb, int g, const bf16x8 (&bf)[8], float are, float aim, float& xr, float& xi) {
    const int kq = lane >> 4; bf16x8 uf = {0, 0, 0, 0, 0, 0, 0, 0};
    if (kq < 2) uf = *(const LAS bf16x8*)(lds + S5_U + ((16 * tb + (lane & 15)) * S5_UT + g * 16 + 8 * kq) * 2);
    LAS bf16* X = (LAS bf16*)(lds + S5_X);
#pragma unroll
    for (int j = 0; j < 8; ++j) { f32x4 acc = {0.f, 0.f, 0.f, 0.f}; acc = __builtin_amdgcn_mfma_f32_16x16x32_bf16(bf[j], uf, acc, 0, 0, 0);
        v2u o; o.x = pk2(acc[0], acc[1]); o.y = pk2(acc[2], acc[3]); *(LAS v2u*)(X + (lane & 15) * S5_XT + g * 128 + 16 * j + 4 * kq) = o; }
    LDS_WAIT(); asm volatile("" ::: "memory");
    LAS unsigned* xw = (LAS unsigned*)(lds + S5_X) + (g * 128 + 2 * lane) / 2;
    unsigned wv[16];
#pragma unroll
    for (int t = 0; t < 16; ++t) wv[t] = xw[t * (S5_XT / 2)];
#pragma unroll
    for (int t = 0; t < 16; ++t) { const float br = bflo(wv[t]), bi = bfhi(wv[t]);
        const float nr = are * xr - aim * xi + br, ni = are * xi + aim * xr + bi; xr = nr; xi = ni;
        wv[t] = pk2(xr, xi); }
#pragma unroll
    for (int t = 0; t < 16; ++t) xw[t * (S5_XT / 2)] = wv[t];
    LDS_WAIT(); asm volatile("" ::: "memory");
}
__device__ __forceinline__ void phase_s1(KArgsP a, LAS unsigned char* lds, int tid, int lane, int wave, int vcu, int G, int l) {
    unsigned char* ws = a->ws; float* ST = (float*)(ws + WS_S5ST);
    bf16x8 bf0[8], bf1[8]; s5_bfrag(ws, l, wave, lane, bf0); s5_bfrag(ws, l, wave + 8, lane, bf1);
    struct { float are, aim; } A0, A1; { const f32x2 q0 = s5_ap(ws, l, wave, lane), q1 = s5_ap(ws, l, wave + 8, lane); A0.are = q0.x; A0.aim = q0.y; A1.are = q1.x; A1.aim = q1.y; }
    for (int u = vcu; u < NB * NCH; u += G) {
        const size_t row0 = (size_t)u * 64;
        __syncthreads();
        s5_load_u(ws, lds, tid, row0);
        __syncthreads();
        float x0r = 0.f, x0i = 0.f, x1r = 0.f, x1i = 0.f;
        for (int tb = 0; tb < 4; ++tb) { s5_block(lds, lane, tb, wave, bf0, A0.are, A0.aim, x0r, x0i); s5_block(lds, lane, tb, wave + 8, bf1, A1.are, A1.aim, x1r, x1i); }
        *(f32x2*)(ST + (((size_t)u * 16 + wave) * 64 + lane) * 2) = (f32x2){x0r, x0i};
        *(f32x2*)(ST + (((size_t)u * 16 + wave + 8) * 64 + lane) * 2) = (f32x2){x1r, x1i};
    }
}
__device__ __forceinline__ void phase_s2(KArgsP a, int tid, int wg, int nwg, int l) {
    float* ST = (float*)(a->ws + WS_S5ST);
    for (int idx = wg * NTHR + tid; idx < NB * 1024; idx += nwg * NTHR) {
        const int b = idx >> 10, gp = idx & 1023, g = gp >> 6, p = gp & 63;
        const f32x2 A = s5_ap(a->ws, l, g, p); float ar = A.x, ai = A.y;
#pragma unroll
        for (int s = 0; s < 6; ++s) { const float nr = ar * ar - ai * ai, ni = 2.f * ar * ai; ar = nr; ai = ni; }
        float cr = 0.f, ci = 0.f;
        for (int c0 = 0; c0 < NCH; c0 += 8) {
            f32x2 e[8];
#pragma unroll
            for (int j = 0; j < 8; ++j) e[j] = *(const f32x2*)(ST + (((size_t)(b * NCH + c0 + j) * 16 + g) * 64 + p) * 2);
#pragma unroll
            for (int j = 0; j < 8; ++j) { *(f32x2*)(ST + (((size_t)(b * NCH + c0 + j) * 16 + g) * 64 + p) * 2) = (f32x2){cr, ci};
                const float nr = ar * cr - ai * ci + e[j].x, ni = ar * ci + ai * cr + e[j].y; cr = nr; ci = ni; }
        }
    }
}
__device__ __forceinline__ float tanh_fast(float x) { return 1.f - 2.f / (1.f + __expf(2.f * x)); }
__device__ __forceinline__ float gelu_tanh_(float x) { const float t = tanh_fast(0.7978845608f * (x + 0.044715f * x * x * x)); return 0.5f * x * (1.f + t); }
__device__ __forceinline__ void s5_cload(const bf16* cmt  , int lane, bf16x8 (&cf)[4]) {
#pragma unroll
    for (int s = 0; s < 4; ++s) cf[s] = __builtin_bit_cast(bf16x8, *(const GAS v4u*)(cmt + (lane & 15) * 128 + 32 * s + 8 * (lane >> 4)));
}
__device__ __forceinline__ void s5_cproj(LAS unsigned char* lds, int lane, int tb, int g, const bf16x8 (&cf)[4], const float (&dv)[4]) {
    const int kq = lane >> 4; f32x4 acc = {0.f, 0.f, 0.f, 0.f};
    const LAS bf16* xp = (const LAS bf16*)(lds + S5_X) + (lane & 15) * S5_XT + g * 128 + 8 * kq;
#pragma unroll
    for (int s = 0; s < 4; ++s) acc = __builtin_amdgcn_mfma_f32_16x16x32_bf16(cf[s], *(const LAS bf16x8*)(xp + 32 * s), acc, 0, 0, 0);
    const int t = 16 * tb + (lane & 15), c0 = g * 16 + 4 * kq;
    const v2u uw = *(const LAS v2u*)(lds + S5_U + (t * S5_UT + c0) * 2);
    const float u4[4] = {bflo(uw.x), bfhi(uw.x), bflo(uw.y), bfhi(uw.y)}; float z[4];
#pragma unroll
    for (int r = 0; r < 4; ++r) z[r] = gelu_tanh_(acc[r] + dv[r] * u4[r]);
    v2u o; o.x = pk2(z[0], z[1]); o.y = pk2(z[2], z[3]); *(LAS v2u*)(lds + S5_Z + (t * S5_UT + c0) * 2) = o;
}
__device__ __forceinline__ void phase_s3(KArgsP a, LAS unsigned char* lds, int tid, int lane, int wave, int vcu, int G, int l, unsigned* qctr = nullptr) {
    unsigned char* ws = a->ws; const float* ST = (const float*)(ws + WS_S5ST); bf16* YC = (bf16*)(ws + WS_YC);
    const bf16* GLUT = (const bf16*)(ws + WS_GLUT) + (size_t)l * DC * DC;
    bf16x8 bf0[8], bf1[8]; s5_bfrag(ws, l, wave, lane, bf0); s5_bfrag(ws, l, wave + 8, lane, bf1);
    const bf16* cm0 = (const bf16*)(ws + WS_S5CM) + (size_t)(l * 16 + wave) * 2048; const bf16* cm1 = cm0 + 8 * 2048;
    struct { float are, aim; } A0, A1; { const f32x2 q0 = s5_ap(ws, l, wave, lane), q1 = s5_ap(ws, l, wave + 8, lane); A0.are = q0.x; A0.aim = q0.y; A1.are = q1.x; A1.aim = q1.y; }
    float d0[4], d1[4];
#pragma unroll
    for (int r = 0; r < 4; ++r) { d0[r] = a->in[I_S5D][l * DC + wave * 16 + 4 * (lane >> 4) + r]; d1[r] = a->in[I_S5D][l * DC + (wave + 8) * 16 + 4 * (lane >> 4) + r]; }
    volatile LAS unsigned* qw = (volatile LAS unsigned*)(lds + MISC_OFF) + 20;
    for (int u = vcu; ; u += G) {
        if (qctr) { __syncthreads(); if (tid == 0) *qw = __hip_atomic_fetch_add(qctr, 1u, __ATOMIC_RELAXED, __HIP_MEMORY_SCOPE_AGENT); __syncthreads(); u = (int)*qw; }
        if (u >= NB * NCH) break;
        const size_t row0 = (size_t)u * 64;
        __syncthreads();
        s5_load_u(ws, lds, tid, row0);
        const f32x2 s0 = *(const f32x2*)(ST + (((size_t)u * 16 + wave) * 64 + lane) * 2), s1 = *(const f32x2*)(ST + (((size_t)u * 16 + wave + 8) * 64 + lane) * 2);
        float x0r = s0.x, x0i = s0.y, x1r = s1.x, x1i = s1.y;
        __syncthreads();
        for (int tb = 0; tb < 4; ++tb) {
            { bf16x8 cf[4]; s5_cload(cm0, lane, cf); s5_block(lds, lane, tb, wave, bf0, A0.are, A0.aim, x0r, x0i); s5_cproj(lds, lane, tb, wave, cf, d0); }
            { bf16x8 cf[4]; s5_cload(cm1, lane, cf); s5_block(lds, lane, tb, wave + 8, bf1, A1.are, A1.aim, x1r, x1i); s5_cproj(lds, lane, tb, wave + 8, cf, d1); }
        }
        __syncthreads();
        {
            const int kq = lane >> 4;
#pragma unroll
            for (int q = 0; q < 2; ++q) { const int ct = 2 * wave + q; f32x4 acc[4];
#pragma unroll
                for (int rt = 0; rt < 4; ++rt) acc[rt] = (f32x4){0.f, 0.f, 0.f, 0.f};
                const bf16* gp = GLUT + (size_t)(16 * ct + (lane & 15)) * DC + 8 * kq;
#pragma unroll 2
                for (int s = 0; s < 8; ++s) { const bf16x8 gf = __builtin_bit_cast(bf16x8, *(const GAS v4u*)(gp + 32 * s));
#pragma unroll
                    for (int rt = 0; rt < 4; ++rt) acc[rt] = __builtin_amdgcn_mfma_f32_16x16x32_bf16(gf, *(const LAS bf16x8*)(lds + S5_Z + ((16 * rt + (lane & 15)) * S5_UT + 32 * s + 8 * kq) * 2), acc[rt], 0, 0, 0); }
                const int j0 = 16 * ct + 4 * kq; const f32x4 gb = *(const GAS f32x4*)(a->in[I_S5GLUB] + l * DC + j0);
#pragma unroll
                for (int rt = 0; rt < 4; ++rt) { const int t = 16 * rt + (lane & 15); const v2u zw = *(const LAS v2u*)(lds + S5_Z + (t * S5_UT + j0) * 2);
                    const float z0 = bflo(zw.x), z1 = bfhi(zw.x), z2 = bflo(zw.y), z3 = bfhi(zw.y);
                    v2u o; o.x = pk2(z0 * sigmoidf_(acc[rt][0] + gb.x), z1 * sigmoidf_(acc[rt][1] + gb.y)); o.y = pk2(z2 * sigmoidf_(acc[rt][2] + gb.z), z3 * sigmoidf_(acc[rt][3] + gb.w));
                    *(GAS v2u*)(YC + (row0 + t) * DM + 768 + j0) = o; } }
        }
    }
}

__device__ __forceinline__ float rw_shift(const bf16* PROJ, const float* mu, size_t row, int col) {
    const float cur = bf2f(PROJ[row * NPROJ + PC_RW + col]); const float prv = (row % SEQ) ? bf2f(PROJ[(row - 1) * NPROJ + PC_RW + col]) : 0.f;
    return cur + mu[col] * (prv - cur);
}
constexpr int R1_TH = 0, R1_AD = 9216, R1_SG = 18432, R1_VS = 35840, R1_TMP = 86016;
template <int KS, int MODE>
__device__ __forceinline__ void r1_prod(const bf16* WT, const LAS bf16* act, int astride, const float* bias, bf16* OUT, size_t row0, int lane, int wave) {
    const int kq = lane >> 4, n0 = 48 * wave; constexpr int K = 32 * KS;
    f32x4 acc[3][4];
#pragma unroll
    for (int nt = 0; nt < 3; ++nt)
#pragma unroll
        for (int ti = 0; ti < 4; ++ti) acc[nt][ti] = (f32x4){0.f, 0.f, 0.f, 0.f};
#pragma unroll
    for (int s = 0; s < KS; ++s) { bf16x8 wf[3], af[4];
#pragma unroll
        for (int nt = 0; nt < 3; ++nt) wf[nt] = __builtin_bit_cast(bf16x8, *(const GAS v4u*)(WT + (size_t)(n0 + 16 * nt + (lane & 15)) * K + 32 * s + 8 * kq));
#pragma unroll
        for (int ti = 0; ti < 4; ++ti) af[ti] = *(const LAS bf16x8*)(act + (16 * ti + (lane & 15)) * astride + 32 * s + 8 * kq);
#pragma unroll
        for (int nt = 0; nt < 3; ++nt)
#pragma unroll
            for (int ti = 0; ti < 4; ++ti) acc[nt][ti] = __builtin_amdgcn_mfma_f32_16x16x32_bf16(wf[nt], af[ti], acc[nt][ti], 0, 0, 0); }
#pragma unroll
    for (int nt = 0; nt < 3; ++nt) { const int n = n0 + 16 * nt + 4 * kq; f32x4 bv = {0.f, 0.f, 0.f, 0.f}; if (MODE != 2) bv = *(const GAS f32x4*)(bias + n);
#pragma unroll
        for (int ti = 0; ti < 4; ++ti) { float o[4];
#pragma unroll
            for (int r = 0; r < 4; ++r) { const float x = acc[nt][ti][r] + bv[r]; o[r] = MODE == 0 ? 0.60653066f * sigmoidf_(x) : (MODE == 1 ? sigmoidf_(x) : x); }
            v2u w; w.x = pk2(o[0], o[1]); w.y = pk2(o[2], o[3]);
            *(GAS v2u*)(OUT + (row0 + 16 * ti + (lane & 15)) * DBR + n) = w; } }
}
__device__ __forceinline__ void phase_r1(KArgsP a, LAS unsigned char* lds, int tid, int lane, int wave, int vcu, int G, int l) {
    unsigned char* ws = a->ws; const bf16* PROJ = (const bf16*)(ws + WS_PROJ); const float* mu = a->in[I_RMU] + (size_t)l * RW_COLS;
    const bf16* W1 = (const bf16*)(ws + WS_R1W) + (size_t)l * 98304;
    const bf16* WV = (const bf16*)(ws + WS_R1W) + 2 * 98304;
    for (int u = vcu; u < NTOK / 64; u += G) {
        const size_t row0 = (size_t)u * 64;
        __syncthreads();
        for (int idx = tid; idx < 64 * 128; idx += NTHR) { const int tt = idx >> 7, col = 2 * (idx & 127); const size_t r = row0 + tt;
            const unsigned cw = *(const GAS unsigned*)(PROJ + r * NPROJ + PC_RW + RWC_WD + col); const unsigned pw = (r % SEQ) ? *(const GAS unsigned*)(PROJ + (r - 1) * NPROJ + PC_RW + RWC_WD + col) : 0u;
            const float c0 = bflo(cw), c1 = bfhi(cw); const float x0 = c0 + mu[RWC_WD + col] * (bflo(pw) - c0), x1 = c1 + mu[RWC_WD + col + 1] * (bfhi(pw) - c1);
            if (col < 64) *(LAS unsigned*)(lds + R1_TH + (tt * 72 + col) * 2) = pk2(tanh_fast(x0), tanh_fast(x1));
            else if (col < 128) *(LAS unsigned*)(lds + R1_AD + (tt * 72 + col - 64) * 2) = pk2(x0, x1);
            else *(LAS unsigned*)(lds + R1_SG + (tt * 136 + col - 128) * 2) = pk2(sigmoidf_(x0), sigmoidf_(x1)); }
        if (l > 0) for (int idx = tid; idx < 64 * 192; idx += NTHR) { const int tt = idx / 192, col = 2 * (idx % 192); const size_t r = row0 + tt;
            const unsigned cw = *(const GAS unsigned*)(PROJ + r * NPROJ + PC_RW + RWC_V + col); const unsigned pw = (r % SEQ) ? *(const GAS unsigned*)(PROJ + (r - 1) * NPROJ + PC_RW + RWC_V + col) : 0u;
            const float c0 = bflo(cw), c1 = bfhi(cw);
            *(LAS unsigned*)(lds + R1_VS + (tt * 392 + col) * 2) = pk2(c0 + mu[RWC_V + col] * (bflo(pw) - c0), c1 + mu[RWC_V + col + 1] * (bfhi(pw) - c1)); }
        __syncthreads();
        r1_prod<2, 0>(W1, (const LAS bf16*)(lds + R1_TH), 72, a->in[I_RW0] + l * DBR, (bf16*)(ws + WS_RE), row0, lane, wave);
        r1_prod<2, 1>(W1 + 24576, (const LAS bf16*)(lds + R1_AD), 72, a->in[I_RA0] + l * DBR, (bf16*)(ws + WS_RA), row0, lane, wave);
        r1_prod<4, 2>(W1 + 49152, (const LAS bf16*)(lds + R1_SG), 136, nullptr, (bf16*)(ws + WS_RG), row0, lane, wave);
        if (l > 0) {
            { const int kq = lane >> 4, mt = wave & 1, ti = wave >> 1; f32x4 acc = {0.f, 0.f, 0.f, 0.f};
#pragma unroll
              for (int s = 0; s < 12; ++s) acc = __builtin_amdgcn_mfma_f32_16x16x32_bf16(__builtin_bit_cast(bf16x8, *(const GAS v4u*)(WV + (size_t)(16 * mt + (lane & 15)) * 384 + 32 * s + 8 * kq)),
                                                                                          *(const LAS bf16x8*)(lds + R1_VS + ((16 * ti + (lane & 15)) * 392 + 32 * s + 8 * kq) * 2), acc, 0, 0, 0);
              v2u w; w.x = pk2(acc[0], acc[1]); w.y = pk2(acc[2], acc[3]); *(LAS v2u*)(lds + R1_TMP + ((16 * ti + (lane & 15)) * 40 + 16 * mt + 4 * kq) * 2) = w; }
            __syncthreads();
            r1_prod<1, 1>(WV + 12288, (const LAS bf16*)(lds + R1_TMP), 40, a->in[I_RV0], (bf16*)(ws + WS_RVG), row0, lane, wave);
        }
    }
}
__device__ __forceinline__ float dpp_allsum(float x) {
    x += __builtin_bit_cast(float, __builtin_amdgcn_update_dpp(0, __builtin_bit_cast(int, x), 0x128, 0xf, 0xf, false));
    x += __builtin_bit_cast(float, __builtin_amdgcn_update_dpp(0, __builtin_bit_cast(int, x), 0x124, 0xf, 0xf, false));
    x += __builtin_bit_cast(float, __builtin_amdgcn_update_dpp(0, __builtin_bit_cast(int, x), 0x122, 0xf, 0xf, false));
    x += __builtin_bit_cast(float, __builtin_amdgcn_update_dpp(0, __builtin_bit_cast(int, x), 0x121, 0xf, 0xf, false));
    { const unsigned xi = __builtin_bit_cast(unsigned, x); auto r = __builtin_amdgcn_permlane16_swap(xi, xi, false, false); const unsigned r0 = r[0], r1 = r[1]; x = __uint_as_float(r0) + __uint_as_float(r1); }
    { const unsigned xi = __builtin_bit_cast(unsigned, x); auto r = __builtin_amdgcn_permlane32_swap(xi, xi, false, false); const unsigned r0 = r[0], r1 = r[1]; x = __uint_as_float(r0) + __uint_as_float(r1); }
    return x;
}

constexpr int RC_EF = 0, RC_ATF = 4096, RC_QF = 8448, RC_PFT = 9472, RC_AT = 10496, RC_RT = 12800, RC_BH = 15104, RC_KH = 17408, RC_AH = 19712, RC_BTT = 22016, RC_KTT = 25088, RC_VS = 28160,
              RC_PRL = 31232, RC_QRL = 32000, RC_TQL = 32768, RC_G15 = 33536, RC_CH = 33792;
struct RCRegs { v2u r0, r1, k0, k1, aa, ee, v0, v1, vg, vf, gg; };
__device__ __forceinline__ void rc_issue(const unsigned char* ws, int l, size_t row, int h, int tid, RCRegs& R) {
    const bf16* PROJ = (const bf16*)(ws + WS_PROJ); const int tt = tid >> 4, c0 = h * 64 + 4 * (tid & 15); const size_t r = row + tt; const bool first = (r % SEQ) == 0; const size_t rp = first ? r : r - 1;
    R.r0 = *(const GAS v2u*)(PROJ + r * NPROJ + PC_RW + RWC_R + c0); R.r1 = *(const GAS v2u*)(PROJ + rp * NPROJ + PC_RW + RWC_R + c0);
    R.k0 = *(const GAS v2u*)(PROJ + r * NPROJ + PC_RW + RWC_K + c0); R.k1 = *(const GAS v2u*)(PROJ + rp * NPROJ + PC_RW + RWC_K + c0);
    R.v0 = *(const GAS v2u*)(PROJ + r * NPROJ + PC_RW + RWC_V + c0); R.v1 = *(const GAS v2u*)(PROJ + rp * NPROJ + PC_RW + RWC_V + c0);
    R.aa = *(const GAS v2u*)((const bf16*)(ws + WS_RA) + r * DBR + c0); R.ee = *(const GAS v2u*)((const bf16*)(ws + WS_RE) + r * DBR + c0);
    R.gg = *(const GAS v2u*)((const bf16*)(ws + WS_RG) + r * DBR + c0);
    if (l > 0) { R.vg = *(const GAS v2u*)((const bf16*)(ws + WS_RVG) + r * DBR + c0); R.vf = *(const GAS v2u*)((const bf16*)(ws + WS_VF) + r * DBR + c0); }
    if (first) { R.r1 = (v2u){0u, 0u}; R.k1 = (v2u){0u, 0u}; R.v1 = (v2u){0u, 0u}; }
}
__device__ __forceinline__ void unpack4(const v2u p, float (&o)[4]) { o[0] = bflo(p.x); o[1] = bfhi(p.x); o[2] = bflo(p.y); o[3] = bfhi(p.y); }
__device__ __forceinline__ v2u pack4(const float (&v)[4]) { v2u o; o.x = pk2(v[0], v[1]); o.y = pk2(v[2], v[3]); return o; }
__device__ __forceinline__ v2u pack4v(const f32x4 v) { v2u o; o.x = pk2(v[0], v[1]); o.y = pk2(v[2], v[3]); return o; }
__device__ __forceinline__ bf16x8 cat8(const v2u a, const v2u b) { v4u o; o.x = a.x; o.y = a.y; o.z = b.x; o.w = b.y; return __builtin_bit_cast(bf16x8, o); }
#define RC_BAR() asm volatile("s_waitcnt lgkmcnt(0)\n\ts_barrier" ::: "memory")

constexpr int REC_BYTES = 12288, REC_UNITS = 752;
__device__ __forceinline__ unsigned char* rc_rec(unsigned char* ws, size_t cu) { return cu < 8192 ? ws + WS_OPA + cu * REC_BYTES : ws + WS_OPB + (cu - 8192) * REC_BYTES; }
__device__ __forceinline__ v4u rc_gather_unit(const LAS unsigned char* wb, int u) {
    v2u lo, hi;
    if (u < 256) { const int base = u < 128 ? RC_AH : RC_RT, uu = u & 127, row = uu >> 3, s = (uu >> 2) & 1, lq = uu & 3; const LAS unsigned char* p = wb + base + (row * 72 + 32 * s + 4 * lq) * 2;
        lo = *(const LAS v2u*)p; hi = *(const LAS v2u*)(p + 32); }
    else if (u < 512) { const int k = (u - 256) >> 2, lq = (u - 256) & 3; lo = *(const LAS v2u*)(wb + RC_BTT + (k * 24 + 4 * lq) * 2); hi = *(const LAS v2u*)(wb + RC_KTT + (k * 24 + 4 * lq) * 2); }
    else if (u < 576) { const int t = (u - 512) >> 2, lq = (u - 512) & 3; lo = *(const LAS v2u*)(wb + RC_PRL + (t * 24 + 4 * lq) * 2); hi = *(const LAS v2u*)(wb + RC_QRL + (t * 24 + 4 * lq) * 2); }
    else if (u < 608) { const LAS unsigned char* p = wb + RC_TQL + (((u - 576) >> 1) * 24 + 8 * ((u - 576) & 1)) * 2; lo = *(const LAS v2u*)p; hi = *(const LAS v2u*)(p + 8); }
    else if (u < 736) { const LAS unsigned char* p = wb + RC_VS + (((u - 608) >> 1) * 24 + 8 * ((u - 608) & 1)) * 2; lo = *(const LAS v2u*)p; hi = *(const LAS v2u*)(p + 8); }
    else { const LAS unsigned char* p = wb + RC_G15 + (u - 736) * 16; lo = *(const LAS v2u*)p; hi = *(const LAS v2u*)(p + 8); }
    v4u o; o.x = lo.x; o.y = lo.y; o.z = hi.x; o.w = hi.y; return o;
}
__device__ __forceinline__ void rc_copy_out(unsigned char* rec, const LAS unsigned char* wb, int u) {
#pragma unroll
    for (int q = 0; q < 3; ++q) { const int uu = u + 256 * q; if (uu < REC_UNITS) *(GAS v4u*)(rec + uu * 16) = rc_gather_unit(wb, uu); }
}
constexpr int RS_AH = 0, RS_RT = 2304, RS_BK = 4608, RS_PQ = 9728, RS_TQL = 11008, RS_VS = 11776, RS_G15 = 14848, RS_CH = 15360;
__device__ __forceinline__ int rs_unit_off(int u) {
    if (u < 128) return RS_AH + (u >> 3) * 144 + (u & 7) * 16;
    if (u < 256) return RS_RT + ((u - 128) >> 3) * 144 + (u & 7) * 16;
    if (u < 512) return RS_BK + ((u - 256) >> 2) * 80 + (u & 3) * 16;
    if (u < 576) return RS_PQ + ((u - 512) >> 2) * 80 + (u & 3) * 16;
    if (u < 608) return RS_TQL + ((u - 576) >> 1) * 48 + (u & 1) * 16;
    if (u < 736) return RS_VS + ((u - 608) >> 1) * 48 + (u & 1) * 16;
    return RS_G15 + (u - 736) * 16;
}
#define RC_BUILD(RUSE, q) do { const int bh_ = (q) >> 8, b = bh_ / NH, h = bh_ % NH, blk_ = (q) & 255, c0 = h * 64 + 4 * kq; const size_t row0 = (size_t)b * SEQ + (size_t)blk_ * 32; \
        float kkw[4], kaw[4], mur[4], muk[4], muv[4]; \
_Pragma("unroll") \
        for (int j = 0; j < 4; ++j) { kkw[j] = a->in[I_RKK][(size_t)l * DBR + c0 + j]; kaw[j] = a->in[I_RKA][(size_t)l * DBR + c0 + j]; mur[j] = mu[RWC_R + c0 + j]; muk[j] = mu[RWC_K + c0 + j]; muv[j] = mu[RWC_V + c0 + j]; } \
        float an[4], bk[4], km[4], rs[4], ev[4]; \
        {   const RCRegs& R = RUSE; \
            float rc[4], rp[4], kc[4], kp[4], av[4], vc[4], vp[4], ks[4], kk[4], vs[4]; unpack4(R.r0, rc); unpack4(R.r1, rp); unpack4(R.k0, kc); unpack4(R.k1, kp); unpack4(R.aa, av); unpack4(R.ee, ev); unpack4(R.v0, vc); unpack4(R.v1, vp); \
            float ss = 0.f; \
_Pragma("unroll") \
            for (int j = 0; j < 4; ++j) { rs[j] = rc[j] + mur[j] * (rp[j] - rc[j]); ks[j] = kc[j] + muk[j] * (kp[j] - kc[j]); kk[j] = ks[j] * kkw[j]; ss += kk[j] * kk[j]; vs[j] = vc[j] + muv[j] * (vp[j] - vc[j]); } \
            ss += __shfl_xor(ss, 1); ss += __shfl_xor(ss, 2); ss += __shfl_xor(ss, 4); ss += __shfl_xor(ss, 8); \
            const float inv = 1.f / fmaxf(sqrtf(ss), 1e-12f); \
_Pragma("unroll") \
            for (int j = 0; j < 4; ++j) { const float kn = kk[j] * inv; an[j] = -kn; bk[j] = kn * av[j]; km[j] = ks[j] * (1.f + (av[j] - 1.f) * kaw[j]); } \
            if (l == 0) *(GAS v2u*)((bf16*)(ws + WS_VF) + (row0 + tt) * DBR + c0) = pack4(vs); \
            else { float g[4], f[4]; unpack4(R.vg, g); unpack4(R.vf, f); \
_Pragma("unroll") \
                for (int j = 0; j < 4; ++j) vs[j] = vs[j] + (f[j] - vs[j]) * g[j]; } \
            {     \
                float gq[4], o1[4], o2[4]; unpack4(R.gg, gq); float rkp = 0.f; \
_Pragma("unroll") \
                for (int j = 0; j < 4; ++j) rkp += rs[j] * km[j] * a->in[I_RRK][(size_t)l * DBR + c0 + j]; \
                rkp += __shfl_xor(rkp, 1); rkp += __shfl_xor(rkp, 2); rkp += __shfl_xor(rkp, 4); rkp += __shfl_xor(rkp, 8); \
_Pragma("unroll") \
                for (int j = 0; j < 4; ++j) { o1[j] = a->in[I_RLNW][(size_t)l * DBR + c0 + j] * gq[j]; o2[j] = (a->in[I_RLNB][(size_t)l * DBR + c0 + j] + rkp * vs[j]) * gq[j]; } \
                *(GAS v2u*)((bf16*)(ws + WS_RG) + (row0 + tt) * DBR + c0) = pack4(o1); *(GAS v2u*)((bf16*)(ws + WS_RA) + (row0 + tt) * DBR + c0) = pack4(o2); } \
            *(LAS f32x4*)(cb + RC_EF + (t * 64 + 4 * kq) * 4) = (f32x4){ev[0], ev[1], ev[2], ev[3]}; \
_Pragma("unroll") \
            for (int j = 0; j < 4; ++j) *(LAS bf16*)(cb + RC_VS + ((4 * kq + j) * 24 + t) * 2) = (bf16)f2bf(vs[j]); \
        } \
        if ((q) + 2 * G < NQ) rc_issue(ws, l, (size_t)(((q) + 2 * G) >> 8) / NH * SEQ + (size_t)(((q) + 2 * G) & 255) * 32, (((q) + 2 * G) >> 8) % NH, tid, RUSE); \
        RC_BAR(); \
        {   f32x4 inc = {0.f, 0.f, 0.f, 0.f}, tot = inc; \
_Pragma("unroll") \
            for (int i = 0; i < 16; ++i) { const f32x4 ei = *(const LAS f32x4*)(cb + RC_EF + (i * 64 + 4 * kq) * 4); tot = tot + ei; if (i <= t) inc = inc + ei; } \
            float At[4], Rt[4], Bh[4], Kh[4], Bt[4], Kt[4], Gt[4]; \
_Pragma("unroll") \
            for (int j = 0; j < 4; ++j) { const float Gi = __expf(-inc[j]), Ge = __expf(ev[j] - inc[j]), Gn = __expf(inc[j]); Gt[j] = __expf(-tot[j]); \
                At[j] = an[j] * Ge; Rt[j] = rs[j] * Gi; Bh[j] = bk[j] * Gn; Kh[j] = km[j] * Gn; Bt[j] = Bh[j] * Gt[j]; Kt[j] = Kh[j] * Gt[j]; } \
            *(LAS f32x4*)(cb + RC_ATF + (t * 68 + 4 * kq) * 4) = (f32x4){At[0], At[1], At[2], At[3]}; \
            *(LAS v2u*)(cb + RC_AT + (t * 72 + 4 * kq) * 2) = pack4(At); *(LAS v2u*)(cb + RC_RT + (t * 72 + 4 * kq) * 2) = pack4(Rt); \
            *(LAS v2u*)(cb + RC_BH + (t * 72 + 4 * kq) * 2) = pack4(Bh); *(LAS v2u*)(cb + RC_KH + (t * 72 + 4 * kq) * 2) = pack4(Kh); \
_Pragma("unroll") \
            for (int j = 0; j < 4; ++j) { *(LAS bf16*)(cb + RC_BTT + ((4 * kq + j) * 24 + t) * 2) = (bf16)f2bf(Bt[j]); *(LAS bf16*)(cb + RC_KTT + ((4 * kq + j) * 24 + t) * 2) = (bf16)f2bf(Kt[j]); } \
            if (t == 0) *(LAS f32x4*)(cb + RC_G15 + 4 * kq * 4) = (f32x4){Gt[0], Gt[1], Gt[2], Gt[3]}; \
        } \
        RC_BAR(); \
        {   LAS unsigned char* wb = lds + (wave >> 2) * RC_CH; const int pi = wave & 3; \
            const LAS bf16* Ap = (const LAS bf16*)(wb + (pi < 2 ? RC_AT : RC_RT)) + li * 72 + 8 * lq; const LAS bf16* Bp = (const LAS bf16*)(wb + ((pi & 1) ? RC_KH : RC_BH)) + li * 72 + 8 * lq; \
            f32x4 acc = {0.f, 0.f, 0.f, 0.f}; \
            acc = __builtin_amdgcn_mfma_f32_16x16x32_bf16(*(const LAS bf16x8*)Ap, *(const LAS bf16x8*)Bp, acc, 0, 0, 0); \
            acc = __builtin_amdgcn_mfma_f32_16x16x32_bf16(*(const LAS bf16x8*)(Ap + 32), *(const LAS bf16x8*)(Bp + 32), acc, 0, 0, 0); \
_Pragma("unroll") \
            for (int r = 0; r < 4; ++r) { const int tr = 4 * lq + r; if (pi < 2 ? !(li < tr) : !(li <= tr)) acc[r] = 0.f; } \
            if (pi == 0) *(LAS f32x4*)(wb + RC_PFT + (li * 16 + 4 * lq) * 4) = acc; \
            else if (pi == 1) { \
_Pragma("unroll") \
                for (int r = 0; r < 4; ++r) *(LAS float*)(wb + RC_QF + ((4 * lq + r) * 16 + li) * 4) = acc[r]; } \
            else { LAS bf16* o = (LAS bf16*)(wb + (pi == 2 ? RC_PRL : RC_QRL)); \
_Pragma("unroll") \
                for (int r = 0; r < 4; ++r) o[(4 * lq + r) * 24 + li] = (bf16)f2bf(acc[r]); } \
        } \
        RC_BAR(); \
        if (wave < 4) { \
            LAS unsigned char* wb = lds + (wave >> 1) * RC_CH; const bool isq = wave & 1; \
            float X[16]; \
_Pragma("unroll") \
            for (int r = 0; r < 16; ++r) X[r] = isq ? *(const LAS float*)(wb + RC_QF + (r * 16 + li) * 4) : *(const LAS float*)(wb + RC_ATF + (r * 68 + lane) * 4); \
_Pragma("unroll") \
            for (int j = 0; j < 15; ++j) { const LAS f32x4* pc = (const LAS f32x4*)(wb + RC_PFT + j * 64); const f32x4 c0v = pc[0], c1v = pc[1], c2v = pc[2], c3v = pc[3]; \
                const float c[16] = {c0v[0], c0v[1], c0v[2], c0v[3], c1v[0], c1v[1], c1v[2], c1v[3], c2v[0], c2v[1], c2v[2], c2v[3], c3v[0], c3v[1], c3v[2], c3v[3]}; \
_Pragma("unroll") \
                for (int r = j + 1; r < 16; ++r) X[r] = fmaf(c[r], X[j], X[r]); } \
            if (!isq) { LAS bf16* o = (LAS bf16*)(wb + RC_AH); \
_Pragma("unroll") \
                for (int r = 0; r < 16; ++r) o[r * 72 + lane] = (bf16)f2bf(X[r]); } \
            else if (lane < 16) { LAS bf16* o = (LAS bf16*)(wb + RC_TQL); \
_Pragma("unroll") \
                for (int r = 0; r < 16; ++r) o[r * 24 + lane] = (bf16)f2bf(X[r]); } \
        } \
        RC_BAR(); \
        { const int cc = tid >> 8, u = tid & 255; unsigned char* rec = rc_rec(ws, (size_t)bh_ * 512 + 2 * blk_ + cc); const LAS unsigned char* wb = lds + cc * RC_CH; \
          rc_copy_out(rec, wb, u); } \
        RC_BAR(); \
    } while (0)
struct RSOps { bf16x8 a01, a23, r01, r23, tq, pq, bk[4]; v2u vb; f32x4 g[4]; };
__device__ __forceinline__ void rs_load(const LAS unsigned char* wb, int wave, int li, int lq, RSOps& O) {
    O.a01 = *(const LAS bf16x8*)(wb + RS_AH + li * 144 + lq * 16); O.a23 = *(const LAS bf16x8*)(wb + RS_AH + li * 144 + 64 + lq * 16);
    O.r01 = *(const LAS bf16x8*)(wb + RS_RT + li * 144 + lq * 16); O.r23 = *(const LAS bf16x8*)(wb + RS_RT + li * 144 + 64 + lq * 16);
    O.pq = *(const LAS bf16x8*)(wb + RS_PQ + li * 80 + lq * 16);
    { const v2u t = *(const LAS v2u*)(wb + RS_TQL + li * 48 + lq * 8); v4u o; o.x = t.x; o.y = t.y; o.z = 0u; o.w = 0u; O.tq = __builtin_bit_cast(bf16x8, o); }
    O.vb = *(const LAS v2u*)(wb + RS_VS + (16 * wave + li) * 48 + lq * 8);
#pragma unroll
    for (int kt = 0; kt < 4; ++kt) { O.bk[kt] = *(const LAS bf16x8*)(wb + RS_BK + (16 * kt + li) * 80 + lq * 16); O.g[kt] = *(const LAS f32x4*)(wb + RS_G15 + (16 * kt + 4 * lq) * 4); }
}
#define RC_CHUNK(O, cc, yb) do { const v2u z2_ = {0u, 0u}; \
        f32x4 aD = {0.f, 0.f, 0.f, 0.f}, aY = {0.f, 0.f, 0.f, 0.f}; \
        aD = __builtin_amdgcn_mfma_f32_16x16x32_bf16(O.a01, Sb01, aD, 0, 0, 0); \
        aD = __builtin_amdgcn_mfma_f32_16x16x32_bf16(O.a23, Sb23, aD, 0, 0, 0); \
        aD = __builtin_amdgcn_mfma_f32_16x16x32_bf16(O.tq, cat8(O.vb, z2_), aD, 0, 0, 0); \
        aY = __builtin_amdgcn_mfma_f32_16x16x32_bf16(Sb01, O.r01, aY, 0, 0, 0); \
        aY = __builtin_amdgcn_mfma_f32_16x16x32_bf16(Sb23, O.r23, aY, 0, 0, 0); \
        const bf16x8 DV = cat8(pack4v(aD), O.vb); \
_Pragma("unroll") \
        for (int kt = 0; kt < 4; ++kt) Sacc[kt] = __builtin_amdgcn_mfma_f32_16x16x32_bf16(O.bk[kt], DV, Sacc[kt] * O.g[kt], 0, 0, 0); \
        aY = __builtin_amdgcn_mfma_f32_16x16x32_bf16(DV, O.pq, aY, 0, 0, 0); \
        Sb01 = cat8(pack4v(Sacc[0]), pack4v(Sacc[1])); Sb23 = cat8(pack4v(Sacc[2]), pack4v(Sacc[3])); \
        *(LAS f32x4*)((yb) + (((cc) * 16 + li) * 68 + 16 * wave + 4 * lq) * 4) = aY;     \
    } while (0)
#define RC_SCAN(slot, yb) do { { RSOps O0; rs_load(slot, wave, li, lq, O0); __builtin_amdgcn_sched_barrier(0); RC_CHUNK(O0, 0, yb); } \
        { RSOps O1; rs_load(slot + RS_CH, wave, li, lq, O1); __builtin_amdgcn_sched_barrier(0); RC_CHUNK(O1, 1, yb); } } while (0)

__device__ __forceinline__ void phase_r2_build(KArgsP a, LAS unsigned char* lds, int tid, int lane, int wave, int vcu, int G, int l) {
    unsigned char* ws = a->ws;
    const int tt = tid >> 4, kq = tid & 15, ch = tt >> 4, t = tt & 15;
    const int lq = lane >> 4, li = lane & 15;
    LAS unsigned char* cb = lds + ch * RC_CH;
    const float* mu = a->in[I_RMU] + (size_t)l * RW_COLS;
    constexpr int NQ = NB * NH * 256;
    RCRegs RA, RB;
    if (vcu < NQ) rc_issue(ws, l, (size_t)(vcu >> 8) / NH * SEQ + (size_t)(vcu & 255) * 32, (vcu >> 8) % NH, tid, RA);
    if (vcu + G < NQ) rc_issue(ws, l, (size_t)((vcu + G) >> 8) / NH * SEQ + (size_t)((vcu + G) & 255) * 32, ((vcu + G) >> 8) % NH, tid, RB);
    for (int q0 = vcu; q0 < NQ; q0 += 2 * G) { { const int q = q0; RC_BUILD(RA, q); } if (q0 + G < NQ) { const int q = q0 + G; RC_BUILD(RB, q); } }
}
struct RSRegs { v4u p[6]; };
__device__ __forceinline__ void rs_issue(unsigned char* ws, size_t cu0, int lt, RSRegs& R) {
#pragma unroll
    for (int j = 0; j < 6; ++j) { const int uu = lt + 256 * j; if (uu < 2 * REC_UNITS) { const int cc = uu >= REC_UNITS, u = uu - cc * REC_UNITS; R.p[j] = *(const GAS v4u*)(rc_rec(ws, cu0 + cc) + u * 16); } }
}
__device__ __forceinline__ void rs_store(LAS unsigned char* slot, int lt, const RSRegs& R) {
#pragma unroll
    for (int j = 0; j < 6; ++j) { const int uu = lt + 256 * j; if (uu < 2 * REC_UNITS) { const int cc = uu >= REC_UNITS, u = uu - cc * REC_UNITS;
        *(LAS v4u*)(slot + cc * RS_CH + rs_unit_off(u)) = R.p[j]; } }
}
struct R3Q { v4u a1, a2; };
__device__ __forceinline__ void r3q_issue(const unsigned char* ws, size_t row0, int h, int lt, R3Q& Q) {
    const size_t off = (row0 + (lt >> 3)) * DBR + h * 64 + 8 * (lt & 7);
    Q.a1 = *(const GAS v4u*)((const bf16*)(ws + WS_RG) + off); Q.a2 = *(const GAS v4u*)((const bf16*)(ws + WS_RA) + off);
}
__device__ __forceinline__ float dpp8sum(float x) {
    x += __builtin_bit_cast(float, __builtin_amdgcn_update_dpp(0, __builtin_bit_cast(int, x), 0xB1, 0xf, 0xf, false));
    x += __builtin_bit_cast(float, __builtin_amdgcn_update_dpp(0, __builtin_bit_cast(int, x), 0x4E, 0xf, 0xf, false));
    x += __builtin_bit_cast(float, __builtin_amdgcn_update_dpp(0, __builtin_bit_cast(int, x), 0x141, 0xf, 0xf, false));
    return x;
}
__device__ __forceinline__ void r3_block(const LAS unsigned char* yb, bf16* YC, size_t row0, int h, int lt, const R3Q& Q) {
    const int tk = lt >> 3, c8 = 8 * (lt & 7);
    const f32x4 y0 = *(const LAS f32x4*)(yb + (tk * 68 + c8) * 4), y1 = *(const LAS f32x4*)(yb + (tk * 68 + c8 + 4) * 4);
    float d[8] = {y0[0], y0[1], y0[2], y0[3], y1[0], y1[1], y1[2], y1[3]};
    const float m = dpp8sum(((d[0] + d[1]) + (d[2] + d[3])) + ((d[4] + d[5]) + (d[6] + d[7]))) * (1.f / 64.f);
    float q = 0.f;
#pragma unroll
    for (int j = 0; j < 8; ++j) { d[j] -= m; q = fmaf(d[j], d[j], q); }
    const float rstd = rsqrtf(dpp8sum(q) * (1.f / 64.f) + RWKV_GN_EPS);
    const unsigned a1[4] = {Q.a1.x, Q.a1.y, Q.a1.z, Q.a1.w}, a2[4] = {Q.a2.x, Q.a2.y, Q.a2.z, Q.a2.w}; unsigned o[4];
#pragma unroll
    for (int j = 0; j < 4; ++j) o[j] = pk2(fmaf(d[2 * j] * rstd, bflo(a1[j]), bflo(a2[j])), fmaf(d[2 * j + 1] * rstd, bfhi(a1[j]), bfhi(a2[j])));
    v4u w; w.x = o[0]; w.y = o[1]; w.z = o[2]; w.w = o[3];
    *(GAS v4u*)(YC + (row0 + tk) * DM + 384 + h * 64 + c8) = w;
}
__device__ __forceinline__ void phase_r2_scan(KArgsP a, LAS unsigned char* lds, int tid, int lane, int wave, int wg, int l) {
    unsigned char* ws = a->ws; bf16* YC = (bf16*)(ws + WS_YC);
    const int b = wg / NH, h = wg % NH; const size_t rowb = (size_t)b * SEQ, cub = (size_t)wg * 512;
    const int lq = lane >> 4, li = lane & 15, lt = tid - 256; const bool loader = wave >= 4;
    f32x4 Sacc[4]; bf16x8 Sb01, Sb23;
#pragma unroll
    for (int kt = 0; kt < 4; ++kt) Sacc[kt] = (f32x4){0.f, 0.f, 0.f, 0.f};
    Sb01 = (bf16x8){0, 0, 0, 0, 0, 0, 0, 0}; Sb23 = Sb01;
    constexpr int NBLK = SEQ / 32;
    LAS unsigned char* slot0 = lds; LAS unsigned char* slot1 = lds + 2 * RS_CH;
    LAS unsigned char* yb0 = lds + 4 * RS_CH; LAS unsigned char* yb1 = yb0 + 32 * 68 * 4;
    if (!loader) {
        RC_BAR();
        for (int bb = 0; bb < NBLK; bb += 2) {
            { LAS unsigned char* slot = slot0; RC_SCAN(slot, yb0); }
            RC_BAR();
            { LAS unsigned char* slot = slot1; RC_SCAN(slot, yb1); }
            RC_BAR();
        }
    } else {
        RSRegs RA, RB; R3Q QA, QB;
        rs_issue(ws, cub, lt, RA); rs_store(slot0, lt, RA); rs_issue(ws, cub + 2, lt, RB); rs_issue(ws, cub + 4, lt, RA); r3q_issue(ws, rowb, h, lt, QA);
        RC_BAR();
        for (int bb = 0; bb < NBLK; bb += 2) {
            if (bb > 0) r3_block(yb1, YC, rowb + (size_t)(bb - 1) * 32, h, lt, QB);
            rs_store(slot1, lt, RB); if (bb + 3 < NBLK) rs_issue(ws, cub + 2 * (size_t)(bb + 3), lt, RB); r3q_issue(ws, rowb + (size_t)(bb + 1) * 32, h, lt, QB);
            RC_BAR();
            r3_block(yb0, YC, rowb + (size_t)bb * 32, h, lt, QA);
            if (bb + 2 < NBLK) { rs_store(slot0, lt, RA); r3q_issue(ws, rowb + (size_t)(bb + 2) * 32, h, lt, QA); } if (bb + 4 < NBLK) rs_issue(ws, cub + 2 * (size_t)(bb + 4), lt, RA);
            RC_BAR();
        }
        r3_block(yb1, YC, rowb + (size_t)(NBLK - 1) * 32, h, lt, QB);
    }
}
__device__ __forceinline__ void phase_r3(KArgsP a, int lane, int gw, int ngw, int l) {
    unsigned char* ws = a->ws; const bf16* PROJ = (const bf16*)(ws + WS_PROJ); bf16* YC = (bf16*)(ws + WS_YC);
    const bf16* RA = (const bf16*)(ws + WS_RA); const bf16* RG = (const bf16*)(ws + WS_RG); const bf16* RVG = (const bf16*)(ws + WS_RVG); const bf16* VF = (const bf16*)(ws + WS_VF);
    const float* mu = a->in[I_RMU] + (size_t)l * RW_COLS;
    for (size_t row = gw; row < NTOK; row += ngw) {
#pragma unroll
        for (int h = 0; h < NH; ++h) {
            const int c = h * 64 + lane;
            const float y = bf2f(YC[row * DM + 384 + c]);
            const float m = dpp_allsum(y) * (1.f / 64.f); const float d = y - m; const float var = dpp_allsum(d * d) * (1.f / 64.f);
            const float yn = d * rsqrtf(var + RWKV_GN_EPS) * a->in[I_RLNW][l * DBR + c] + a->in[I_RLNB][l * DBR + c];
            const float rs = rw_shift(PROJ, mu, row, RWC_R + c), ks = rw_shift(PROJ, mu, row, RWC_K + c); float v = rw_shift(PROJ, mu, row, RWC_V + c);
            if (l > 0) v = v + (bf2f(VF[row * DBR + c]) - v) * bf2f(RVG[row * DBR + c]);
            const float av = bf2f(RA[row * DBR + c]);
            const float km = ks * (1.f + (av - 1.f) * a->in[I_RKA][l * DBR + c]);
            const float rk = dpp_allsum(rs * km * a->in[I_RRK][l * DBR + c]);
            YC[row * DM + 384 + c] = (bf16)f2bf((yn + rk * v) * bf2f(RG[row * DBR + c]));
        }
    }
}

constexpr int PH_PER_LAYER = 10, PH_FINAL = 1 + 2 * PH_PER_LAYER, N_PHASES = PH_FINAL + 1;
constexpr int R2_WGS = 24;
__global__ void __launch_bounds__(NTHR, 2) fwd(Args args) {
    extern __shared__ __attribute__((aligned(16))) unsigned char lds_raw[];
    LAS unsigned char* lds = (LAS unsigned char*)lds_raw;
    volatile LAS unsigned* MISC = (volatile LAS unsigned*)(lds + MISC_OFF);
    const int tid0 = threadIdx.x;
    const int G = gridDim.x;
#define PHASE_IDS int tid_ = threadIdx.x; asm volatile("" : "+v"(tid_)); const int tid = tid_, lane = tid & 63, wave = __builtin_amdgcn_readfirstlane(tid >> 6); \
    int bx_ = blockIdx.x; asm volatile("" : "+s"(bx_)); const int bx = bx_; const int vcu = (G % 8 == 0) ? (bx % 8) * (G / 8) + bx / 8 : bx; (void)lane; (void)wave; (void)vcu; (void)bx;
    unsigned char* ws0 = fresh_args()->ws;
    for (int u = tid0; u < (LDS_BYTES - RING_BYTES) / 4; u += NTHR) ((LAS unsigned*)(lds + RING_BYTES))[u] = 0u;
    __syncthreads();
    XcdBarrier bar; bar.bar = (unsigned*)(ws0 + WS_CTL) + CW_BAR; bar.x = 0; bar.st = nullptr;
    if (!MK_PER_PHASE) bar = xcd_barrier_post((unsigned*)(ws0 + WS_CTL) + CW_BAR, MISC + 8);
#if MK_PER_PHASE
    const int lo = args.ph_lo, hi = args.ph_hi;
#define IN(k) (lo <= (k) && (k) < hi)
#else
#define IN(k) true
#endif
#define SEAM(k) do { if (IN(k) && IN((k) + 1)) { XcdBarrier b2 = bar; asm volatile("" : "+s"(b2.bar)); xcd_barrier(b2); } } while (0)

#ifndef GEMM_SP2
#define GEMM_SP2 true
#endif
#ifndef GEMM_ALIGN
#define GEMM_ALIGN true
#endif
#ifndef DBL_SUB
#define DBL_SUB 0
#endif
#ifndef DBL_PHASE
#define DBL_PHASE (-1)
#endif
#ifndef REPN
#define REPN 2
#endif
#define REP(k) for (int rep_ = 0; rep_ < ((k) == DBL_PHASE ? REPN : 1); ++rep_)
#define REPBAR if (rep_ > 0) { XcdBarrier b2 = bar; asm volatile("" : "+s"(b2.bar)); xcd_barrier(b2); }
    REP(0) if (IN(0)) { REPBAR KArgsP ap = fresh_args(); PHASE_IDS phase_prologue(ap, lds, tid, lane, wave, vcu, G); }
    SEAM(0);
#ifdef EXTRA_BAR
    for (int eb_ = 0; eb_ < EXTRA_BAR; ++eb_) { XcdBarrier b2 = bar; asm volatile("" : "+s"(b2.bar)); xcd_barrier(b2); }
#endif
#define LCONST 0
    {
        constexpr int l = LCONST; constexpr int pb = 1 + l * PH_PER_LAYER;
        REP(pb + 0) if (IN(pb + 0)) { REPBAR KArgsP ap = fresh_args(); PHASE_IDS unsigned char* ws = ap->ws; (void)ws;
            if (l == 0) { mod_finalize(ws, tid, G); phase_rownorm<0, false>(ap, lds, tid, lane, wave, G, ap->in[I_X], ap->out, ap->in[I_NORM_MIX], true, 0, 0, 0); }
            else {
#if EN_MOE
                phase_rownorm<0, true>(ap, lds, tid, lane, wave, G, ap->out, ap->out, ap->in[I_NORM_MIX] + l * DM, false, l, 0, l - 1);
#else
                phase_rownorm<0, false>(ap, lds, tid, lane, wave, G, ap->out, ap->out, ap->in[I_NORM_MIX] + l * DM, false, l, 0, l - 1);
#endif
            }
        }
        SEAM(pb + 0);
        REP(pb + 1) if (IN(pb + 1)) { REPBAR KArgsP ap = fresh_args(); PHASE_IDS unsigned char* ws = ap->ws; (void)ws;
            pg8::Gemm g{(const pg8::bf16_t*)(ws + WS_HN), (const pg8::bf16_t*)(ws + WS_WIN) + (size_t)l * NPROJ_PAD * DM, NTOK, NPROJ_PAD, DM};
            pg8::StaticOrder S; S.init(NTOK, NPROJ_PAD, G, bx);
            pg8::EpiProj E{(pg8::bf16_t*)(ws + WS_PROJ), (float*)(ws + WS_GATES)};
            pg8::gemm_phase<pg8::EpiProj, pg8::StaticOrder, GEMM_ALIGN, GEMM_SP2>(lds, g, S, E);
        }
        SEAM(pb + 1);
        REP(pb + 2) if (IN(pb + 2)) { REPBAR KArgsP ap = fresh_args(); PHASE_IDS unsigned char* ws = ap->ws; (void)ws;
#if EN_MLSTM
            for (int q_ = 0; q_ < 1 + (REPN - 1) * ((DBL_SUB == 1) && l == 0); ++q_) { phase_m1(ap, lds, tid, lane, wave, vcu, G, l); __syncthreads(); }
            __syncthreads();
#endif
#if EN_S5
            phase_s1(ap, lds, tid, lane, wave, vcu, G, l); __syncthreads();
#if DBL_SUB == 2
            if (l == 0) { phase_s1(ap, lds, tid, lane, wave, vcu, G, l); __syncthreads(); phase_s1(ap, lds, tid, lane, wave, vcu, G, l); __syncthreads(); phase_s1(ap, lds, tid, lane, wave, vcu, G, l); __syncthreads(); phase_s1(ap, lds, tid, lane, wave, vcu, G, l); __syncthreads(); }
#endif
            __syncthreads();
#endif
#if EN_RWKV
            for (int q_ = 0; q_ < 1 + (REPN - 1) * ((DBL_SUB == 3) && l == 0); ++q_) { phase_r1(ap, lds, tid, lane, wave, vcu, G, l); __syncthreads(); }
#endif
        }
        SEAM(pb + 2);
        REP(pb + 3) if (IN(pb + 3)) { REPBAR KArgsP ap = fresh_args(); PHASE_IDS unsigned char* ws = ap->ws; (void)ws;
            phase_m2(ws, tid, vcu, G);
            phase_s2(ap, tid, vcu, G, l);
            __syncthreads();
            phase_r2_build(ap, lds, tid, lane, wave, vcu, G, l);
        }
        SEAM(pb + 3);
        REP(pb + 4) if (IN(pb + 4)) { REPBAR KArgsP ap = fresh_args(); PHASE_IDS unsigned char* ws = ap->ws; (void)ws;
            if (bx < R2_WGS) {
_Pragma("nounroll")
 for (int q_ = 0; q_ < 1 + (REPN - 1) * ((DBL_SUB == 4) && l == 0); ++q_) { phase_r2_scan(ap, lds, tid, lane, wave, bx, l); __syncthreads(); } }
            else { phase_s3(ap, lds, tid, lane, wave, 0, 1, l, (unsigned*)(ws + WS_CTL) + CW_Q + 64 * l + 32); __syncthreads(); }
            {
                unsigned* qctr = (unsigned*)(ws + WS_CTL) + CW_Q + 64 * l; volatile LAS unsigned* qw = (volatile LAS unsigned*)(lds + MISC_OFF) + 16;
                for (;;) {
                    if (tid == 0) *qw = __hip_atomic_fetch_add(qctr, 1u, __ATOMIC_RELAXED, __HIP_MEMORY_SCOPE_AGENT);
                    __syncthreads();
                    const int u = (int)*qw;
                    __syncthreads();
                    if (u >= NUNIT_M) break;
                    phase_m3(ap, lds, tid, lane, wave, u, NUNIT_M, l);
                }
            }
        }
        SEAM(pb + 4);
        REP(pb + 6) if (IN(pb + 6)) { REPBAR KArgsP ap = fresh_args(); PHASE_IDS unsigned char* ws = ap->ws; (void)ws;
            pg8::Gemm g{(const pg8::bf16_t*)(ws + WS_YC), (const pg8::bf16_t*)(ws + WS_WOUT) + (size_t)l * DM * DM, NTOK, DM, DM};
            pg8::StaticOrder S; S.init(NTOK, DM, G, bx);
            pg8::EpiResid E{l == 0 ? ap->in[I_X] : (const float*)ap->out, ap->out, (const float*)(ws + WS_MODF) + (size_t)l * 4 * 6144, 2048};
            pg8::gemm_phase<pg8::EpiResid, pg8::StaticOrder, GEMM_ALIGN, GEMM_SP2>(lds, g, S, E);
        }
        SEAM(pb + 6);
#if EN_MOE
        REP(pb + 7) if (IN(pb + 7)) { REPBAR KArgsP ap = fresh_args(); PHASE_IDS phase_router(ap, lds, tid, lane, wave, G, l); __syncthreads();
            moe_convert13(ap->in[I_MW1], ap->in[I_MW3], l, (bf16*)(ap->ws + WS_W13), vcu * NWAVES + wave, G * NWAVES, (LAS float*)(lds + wave * 16640), lane);
            moe_convert2(ap->in[I_MW2], l, (bf16*)(ap->ws + WS_W2), vcu * NWAVES + wave, G * NWAVES, (LAS float*)(lds + wave * 16640), lane); }
        SEAM(pb + 7);
        REP(pb + 8) if (IN(pb + 8)) { REPBAR KArgsP ap = fresh_args(); PHASE_IDS unsigned char* ws = ap->ws; (void)ws;
            LAS int* ptab = (LAS int*)(lds + PTAB_OFF); LAS int* pst = ptab + 512; LAS int* cnt = pst + 32;
            build_ptab((const unsigned*)(ws + WS_CTL) + CW_CNT + l * 32, ptab, pst, cnt, tid);
            pg8::Gemm g{(const pg8::bf16_t*)(ws + WS_HN), (const pg8::bf16_t*)(ws + WS_W13), 0, 0, DM, (const int*)(ws + WS_LIST), ptab};
            pg8::MoeOrder S{ptab, G, vcu};
            pg8::EpiSwiglu E{(pg8::bf16_t*)(ws + WS_HMID)};
            pg8::gemm_phase<pg8::EpiSwiglu, pg8::MoeOrder, false, true, true>(lds, g, S, E);
        }
        SEAM(pb + 8);
        REP(pb + 9) if (IN(pb + 9)) { REPBAR KArgsP ap = fresh_args(); PHASE_IDS unsigned char* ws = ap->ws; (void)ws;
            LAS int* ptab = (LAS int*)(lds + PTAB_OFF); LAS int* pst = ptab + 512; LAS int* cnt = pst + 32;
            build_ptab((const unsigned*)(ws + WS_CTL) + CW_CNT + l * 32, ptab, pst, cnt, tid);
            pg8::Gemm g{(const pg8::bf16_t*)(ws + WS_HMID), (const pg8::bf16_t*)(ws + WS_W2), 0, 0, DEXP};
            pg8::MoeOrder S{ptab, G, vcu};
            pg8::EpiMoeOut E{(pg8::bf16_t*)(ws + WS_YMOE), (const int*)(ws + WS_LIST), ptab};
            pg8::gemm_phase<pg8::EpiMoeOut, pg8::MoeOrder, true, true>(lds, g, S, E);
        }
        SEAM(pb + 9);
#else
        SEAM(pb + 6); SEAM(pb + 7); SEAM(pb + 8); SEAM(pb + 9);
#endif
    }
#undef LCONST
#if N_LAYERS > 1
#define LCONST 1
    {
        constexpr int l = LCONST; constexpr int pb = 1 + l * PH_PER_LAYER;
        REP(pb + 0) if (IN(pb + 0)) { REPBAR KArgsP ap = fresh_args(); PHASE_IDS unsigned char* ws = ap->ws; (void)ws;
            if (l == 0) { mod_finalize(ws, tid, G); phase_rownorm<0, false>(ap, lds, tid, lane, wave, G, ap->in[I_X], ap->out, ap->in[I_NORM_MIX], true, 0, 0, 0); }
            else {
#if EN_MOE
                phase_rownorm<0, true>(ap, lds, tid, lane, wave, G, ap->out, ap->out, ap->in[I_NORM_MIX] + l * DM, false, l, 0, l - 1);
#else
                phase_rownorm<0, false>(ap, lds, tid, lane, wave, G, ap->out, ap->out, ap->in[I_NORM_MIX] + l * DM, false, l, 0, l - 1);
#endif
            }
        }
        SEAM(pb + 0);
        REP(pb + 1) if (IN(pb + 1)) { REPBAR KArgsP ap = fresh_args(); PHASE_IDS unsigned char* ws = ap->ws; (void)ws;
            pg8::Gemm g{(const pg8::bf16_t*)(ws + WS_HN), (const pg8::bf16_t*)(ws + WS_WIN) + (size_t)l * NPROJ_PAD * DM, NTOK, NPROJ_PAD, DM};
            pg8::StaticOrder S; S.init(NTOK, NPROJ_PAD, G, bx);
            pg8::EpiProj E{(pg8::bf16_t*)(ws + WS_PROJ), (float*)(ws + WS_GATES)};
            pg8::gemm_phase<pg8::EpiProj, pg8::StaticOrder, GEMM_ALIGN, GEMM_SP2>(lds, g, S, E);
        }
        SEAM(pb + 1);
        REP(pb + 2) if (IN(pb + 2)) { REPBAR KArgsP ap = fresh_args(); PHASE_IDS unsigned char* ws = ap->ws; (void)ws;
#if EN_MLSTM
            for (int q_ = 0; q_ < 1 + (REPN - 1) * ((DBL_SUB == 1) && l == 0); ++q_) { phase_m1(ap, lds, tid, lane, wave, vcu, G, l); __syncthreads(); }
            __syncthreads();
#endif
#if EN_S5
            phase_s1(ap, lds, tid, lane, wave, vcu, G, l); __syncthreads();
#if DBL_SUB == 2
            if (l == 0) { phase_s1(ap, lds, tid, lane, wave, vcu, G, l); __syncthreads(); phase_s1(ap, lds, tid, lane, wave, vcu, G, l); __syncthreads(); phase_s1(ap, lds, tid, lane, wave, vcu, G, l); __syncthreads(); phase_s1(ap, lds, tid, lane, wave, vcu, G, l); __syncthreads(); }
#endif
            __syncthreads();
#endif
#if EN_RWKV
            for (int q_ = 0; q_ < 1 + (REPN - 1) * ((DBL_SUB == 3) && l == 0); ++q_) { phase_r1(ap, lds, tid, lane, wave, vcu, G, l); __syncthreads(); }
#endif
        }
        SEAM(pb + 2);
        REP(pb + 3) if (IN(pb + 3)) { REPBAR KArgsP ap = fresh_args(); PHASE_IDS unsigned char* ws = ap->ws; (void)ws;
            phase_m2(ws, tid, vcu, G);
            phase_s2(ap, tid, vcu, G, l);
            __syncthreads();
            phase_r2_build(ap, lds, tid, lane, wave, vcu, G, l);
        }
        SEAM(pb + 3);
        REP(pb + 4) if (IN(pb + 4)) { REPBAR KArgsP ap = fresh_args(); PHASE_IDS unsigned char* ws = ap->ws; (void)ws;
            if (bx < R2_WGS) {
_Pragma("nounroll")
 for (int q_ = 0; q_ < 1 + (REPN - 1) * ((DBL_SUB == 4) && l == 0); ++q_) { phase_r2_scan(ap, lds, tid, lane, wave, bx, l); __syncthreads(); } }
            else { phase_s3(ap, lds, tid, lane, wave, 0, 1, l, (unsigned*)(ws + WS_CTL) + CW_Q + 64 * l + 32); __syncthreads(); }
            {
                unsigned* qctr = (unsigned*)(ws + WS_CTL) + CW_Q + 64 * l; volatile LAS unsigned* qw = (volatile LAS unsigned*)(lds + MISC_OFF) + 16;
                for (;;) {
                    if (tid == 0) *qw = __hip_atomic_fetch_add(qctr, 1u, __ATOMIC_RELAXED, __HIP_MEMORY_SCOPE_AGENT);
                    __syncthreads();
                    const int u = (int)*qw;
                    __syncthreads();
                    if (u >= NUNIT_M) break;
                    phase_m3(ap, lds, tid, lane, wave, u, NUNIT_M, l);
                }
            }
        }
        SEAM(pb + 4);
        REP(pb + 6) if (IN(pb + 6)) { REPBAR KArgsP ap = fresh_args(); PHASE_IDS unsigned char* ws = ap->ws; (void)ws;
            pg8::Gemm g{(const pg8::bf16_t*)(ws + WS_YC), (const pg8::bf16_t*)(ws + WS_WOUT) + (size_t)l * DM * DM, NTOK, DM, DM};
            pg8::StaticOrder S; S.init(NTOK, DM, G, bx);
            pg8::EpiResid E{l == 0 ? ap->in[I_X] : (const float*)ap->out, ap->out, (const float*)(ws + WS_MODF) + (size_t)l * 4 * 6144, 2048};
            pg8::gemm_phase<pg8::EpiResid, pg8::StaticOrder, GEMM_ALIGN, GEMM_SP2>(lds, g, S, E);
        }
        SEAM(pb + 6);
#if EN_MOE
        REP(pb + 7) if (IN(pb + 7)) { REPBAR KArgsP ap = fresh_args(); PHASE_IDS phase_router(ap, lds, tid, lane, wave, G, l); __syncthreads();
            moe_convert13(ap->in[I_MW1], ap->in[I_MW3], l, (bf16*)(ap->ws + WS_W13), vcu * NWAVES + wave, G * NWAVES, (LAS float*)(lds + wave * 16640), lane);
            moe_convert2(ap->in[I_MW2], l, (bf16*)(ap->ws + WS_W2), vcu * NWAVES + wave, G * NWAVES, (LAS float*)(lds + wave * 16640), lane); }
        SEAM(pb + 7);
        REP(pb + 8) if (IN(pb + 8)) { REPBAR KArgsP ap = fresh_args(); PHASE_IDS unsigned char* ws = ap->ws; (void)ws;
            LAS int* ptab = (LAS int*)(lds + PTAB_OFF); LAS int* pst = ptab + 512; LAS int* cnt = pst + 32;
            build_ptab((const unsigned*)(ws + WS_CTL) + CW_CNT + l * 32, ptab, pst, cnt, tid);
            pg8::Gemm g{(const pg8::bf16_t*)(ws + WS_HN), (const pg8::bf16_t*)(ws + WS_W13), 0, 0, DM, (const int*)(ws + WS_LIST), ptab};
            pg8::MoeOrder S{ptab, G, vcu};
            pg8::EpiSwiglu E{(pg8::bf16_t*)(ws + WS_HMID)};
            pg8::gemm_phase<pg8::EpiSwiglu, pg8::MoeOrder, false, true, true>(lds, g, S, E);
        }
        SEAM(pb + 8);
        REP(pb + 9) if (IN(pb + 9)) { REPBAR KArgsP ap = fresh_args(); PHASE_IDS unsigned char* ws = ap->ws; (void)ws;
            LAS int* ptab = (LAS int*)(lds + PTAB_OFF); LAS int* pst = ptab + 512; LAS int* cnt = pst + 32;
            build_ptab((const unsigned*)(ws + WS_CTL) + CW_CNT + l * 32, ptab, pst, cnt, tid);
            pg8::Gemm g{(const pg8::bf16_t*)(ws + WS_HMID), (const pg8::bf16_t*)(ws + WS_W2), 0, 0, DEXP};
            pg8::MoeOrder S{ptab, G, vcu};
            pg8::EpiMoeOut E{(pg8::bf16_t*)(ws + WS_YMOE), (const int*)(ws + WS_LIST), ptab};
            pg8::gemm_phase<pg8::EpiMoeOut, pg8::MoeOrder, true, true>(lds, g, S, E);
        }
        SEAM(pb + 9);
#else
        SEAM(pb + 6); SEAM(pb + 7); SEAM(pb + 8); SEAM(pb + 9);
#endif
    }
#undef LCONST
#endif
    if (IN(PH_FINAL)) { KArgsP ap = fresh_args(); PHASE_IDS
#if EN_MOE
        if (N_LAYERS > 0) phase_rownorm<1, true>(ap, lds, tid, lane, wave, G, ap->out, ap->out, ap->in[I_NORM_FINAL], false, 0, 0, N_LAYERS - 1);
        else phase_rownorm<1, false>(ap, lds, tid, lane, wave, G, ap->in[I_X], ap->out, ap->in[I_NORM_FINAL], false, 0, 0, 0);
#else
        phase_rownorm<1, false>(ap, lds, tid, lane, wave, G, N_LAYERS > 0 ? (const float*)ap->out : ap->in[I_X], ap->out, ap->in[I_NORM_FINAL], false, 0, 0, 0);
#endif
    }
#undef IN
#undef SEAM
}

extern "C" void kernel_launch(void* const* d_in, const int* in_sizes, int n_in, void* d_out, int out_size, void* d_ws, size_t ws_size, hipStream_t stream) {
    static int grid = 0;
    if (grid == 0) {
        if (n_in != 47 || out_size != NTOK * DM || ws_size < WS_END) { fprintf(stderr, "kernel_launch: unexpected problem (n_in %d, out %d, ws %zu < %zu)\n", n_in, out_size, ws_size, (size_t)WS_END); grid = -1; return; }
        int dev = 0, cus = 0, per_cu = 0;
        if (hipGetDevice(&dev) != hipSuccess || hipDeviceGetAttribute(&cus, hipDeviceAttributeMultiprocessorCount, dev) != hipSuccess) { grid = -1; return; }
        if (hipFuncSetAttribute((const void*)fwd, hipFuncAttributeMaxDynamicSharedMemorySize, LDS_BYTES) != hipSuccess) { fprintf(stderr, "kernel_launch: hipFuncSetAttribute failed\n"); grid = -1; return; }
        if (hipOccupancyMaxActiveBlocksPerMultiprocessor(&per_cu, (const void*)fwd, NTHR, LDS_BYTES) != hipSuccess || per_cu < 1) fprintf(stderr, "kernel_launch: occupancy query says %d\n", per_cu);
        (void)hipGetLastError();
        grid = cus;
        if (grid != 256) fprintf(stderr, "kernel_launch: %d CUs (built for 256)\n", grid);
    }
    if (grid < 0) return;
    (void)hipMemsetAsync((char*)d_ws + WS_CTL, 0, CTL_ZERO_BYTES, stream);
    Args a{};
    for (int i = 0; i < 47; ++i) a.in[i] = (const float*)d_in[i];
    a.out = (float*)d_out; a.ws = (unsigned char*)d_ws;
#if MK_PER_PHASE
    for (int p = 0; p < N_PHASES; ++p) { a.ph_lo = p; a.ph_hi = p + 1; hipLaunchKernelGGL(fwd, dim3(grid), dim3(NTHR), LDS_BYTES, stream, a); }
#else
    a.ph_lo = 0; a.ph_hi = N_PHASES; hipLaunchKernelGGL(fwd, dim3(grid), dim3(NTHR), LDS_BYTES, stream, a);
#endif
}
#ifdef DIAG_KERNELS
#define DK(name, ...) __global__ void __launch_bounds__(NTHR, 2) name(Args args) { extern __shared__ __attribute__((aligned(16))) unsigned char lds_raw[]; LAS unsigned char* lds = (LAS unsigned char*)lds_raw; \
    const int tid = threadIdx.x, lane = tid & 63, wave = __builtin_amdgcn_readfirstlane(tid >> 6); const int G = gridDim.x; const int bx = blockIdx.x; const int vcu = bx; KArgsP ap = fresh_args(); int l = ap->ph_lo; (void)lane; (void)wave; (void)vcu; (void)G; (void)l; __VA_ARGS__ }
DK(k_prologue, phase_prologue(ap, lds, tid, lane, wave, vcu, G);)
DK(k_norm0, phase_rownorm<0, false>(ap, lds, tid, lane, wave, G, ap->in[I_X], ap->out, ap->in[I_NORM_MIX], true, 0, 0, 0);)
DK(k_norm1, phase_rownorm<0, true>(ap, lds, tid, lane, wave, G, ap->out, ap->out, ap->in[I_NORM_MIX], false, l, 0, 0);)
DK(k_normf, phase_rownorm<1, true>(ap, lds, tid, lane, wave, G, ap->out, ap->out, ap->in[I_NORM_MIX], false, l, 0, 0);)
DK(k_m1, phase_m1(ap, lds, tid, lane, wave, vcu, G, l);)
DK(k_m2, phase_m2(ap->ws, tid, vcu, G);)
DK(k_m3, phase_m3(ap, lds, tid, lane, wave, vcu, G, l);)
DK(k_s1, phase_s1(ap, lds, tid, lane, wave, vcu, G, l);)
DK(k_s2, phase_s2(ap, tid, vcu, G, l);)
DK(k_s3, phase_s3(ap, lds, tid, lane, wave, vcu, G, l);)
DK(k_r1, phase_r1(ap, lds, tid, lane, wave, vcu, G, l);)
DK(k_r2b, phase_r2_build(ap, lds, tid, lane, wave, vcu, G, l);)
DK(k_r2s, phase_r2_scan(ap, lds, tid, lane, wave, vcu, l);)
DK(k_r3, phase_r3(ap, lane, vcu * NWAVES + wave, G * NWAVES, l);)
DK(k_router, phase_router(ap, lds, tid, lane, wave, G, l);)
DK(k_gather, phase_gather(ap, lds, tid, lane, wave, vcu, G, l);)
DK(k_moecv, moe_convert13(ap->in[I_MW1], ap->in[I_MW3], 1, (bf16*)(ap->ws + WS_W13), vcu * NWAVES + wave, G * NWAVES, (LAS float*)(lds + wave * 16640), lane);)
#endif
```

```cpp
#include <hip/hip_runtime.h>
#include <cstdio>
#include <cstdint>
#define MK_PER_PHASE 0
#define RS_DEPTH 2

#ifndef MK_PER_PHASE
#define MK_PER_PHASE 0
#endif
#ifndef EN_MLSTM
#define EN_MLSTM 1
#endif
#ifndef EN_S5
#define EN_S5 1
#endif
#ifndef EN_RWKV
#define EN_RWKV 1
#endif
#ifndef EN_MOE
#define EN_MOE 1
#endif
#ifndef N_LAYERS
#define N_LAYERS 2
#endif
constexpr int NWAVES = 8, NTHR = 512;
constexpr int DM = 1024, NB = 4, SEQ = 8192, NTOK = NB * SEQ;
constexpr int DA = 384, DBR = 384, DC = 256, NH = 6, HD = 64, NCH = SEQ / 64;
constexpr int IN_COLS = 2828, NPROJ = 2816, NPROJ_PAD = 3072;
constexpr int PC_QK = 0, PC_V = 384, PC_O = 768, PC_RW = 1152, PC_S5 = 2560;
constexpr int RWC_R = 0, RWC_K = 384, RWC_V = 768, RWC_WD = 1152, RWC_AD = 1216, RWC_GD = 1280, RW_COLS = 1408;
constexpr int NEXP = 32, DEXP = 512, MOE_ROWS_MAX = 73728;
constexpr int NUNIT_M = NB * NCH * NH;
constexpr int CL_STRIDE = 4160;
constexpr float NORM_EPS = 1e-6f, HEAD_NORM_EPS = 1e-5f, RWKV_GN_EPS = 64e-5f;

constexpr size_t MiB = 1u << 20;
constexpr size_t WS_CTL = 0, CTL_ZERO_BYTES = 1 * MiB;
constexpr size_t WS_MODP = 1 * MiB;
constexpr size_t WS_MODF = 2 * MiB + 512 * 1024;
constexpr size_t WS_S5BB = 2 * MiB + 896 * 1024;
constexpr size_t WS_RTW = 3 * MiB;
constexpr size_t WS_S5AP = 3 * MiB + 384 * 1024;
constexpr size_t WS_MLW = 3 * MiB + 512 * 1024;
constexpr size_t WS_S5CM = 2 * MiB + 768 * 1024;
constexpr size_t WS_GLUT = 3 * MiB + 768 * 1024;
constexpr size_t WS_WIN = 4 * MiB;
constexpr size_t WS_WOUT = 16 * MiB;
constexpr size_t WS_GATES = 20 * MiB;
constexpr size_t WS_W13 = 22 * MiB;
constexpr size_t WS_W2 = 86 * MiB;
constexpr size_t WS_HN = 118 * MiB;
constexpr size_t WS_CLOC = 118 * MiB;
constexpr size_t WS_MSC = 168 * MiB;
constexpr size_t WS_S5ST = 170 * MiB;
constexpr size_t WS_VF = 182 * MiB;
constexpr size_t WS_YC = 206 * MiB;
constexpr size_t WS_LIST = 206 * MiB;
constexpr size_t WS_ROWMAP = 214 * MiB;
constexpr size_t WS_TOKE = 215 * MiB;
constexpr size_t WS_TOKW = 215 * MiB + 512 * 1024;
constexpr size_t WS_PROJ = 270 * MiB;
constexpr size_t WS_RE = 446 * MiB, WS_RA = 470 * MiB, WS_RG = 494 * MiB, WS_RVG = 518 * MiB;
constexpr size_t WS_XG = 270 * MiB;
constexpr size_t WS_HMID = 414 * MiB;
constexpr size_t WS_YMOE = 270 * MiB;
constexpr size_t WS_R1W = 542 * MiB;
constexpr size_t WS_OPA = 22 * MiB;
constexpr size_t WS_OPB = 543 * MiB;
constexpr size_t WS_END = 591 * MiB;
constexpr int CW_TMO = 0, CW_BAR = 4096, CW_CNT = 8192, CW_Q = 8320;

constexpr int RING_BYTES = 131072, MISC_OFF = 135168, PTAB_OFF = MISC_OFF + 1024, LDS_BYTES = 147456;

#define GAS __attribute__((address_space(1)))
#define LAS __attribute__((address_space(3)))
typedef unsigned short bf16;
typedef unsigned v4u __attribute__((ext_vector_type(4)));
typedef unsigned v2u __attribute__((ext_vector_type(2)));
typedef float f32x4 __attribute__((ext_vector_type(4)));
typedef float f32x2 __attribute__((ext_vector_type(2)));
typedef GAS unsigned gu32;
#define RLX_AGENT __ATOMIC_RELAXED, __HIP_MEMORY_SCOPE_AGENT
#define LDS_WAIT() asm volatile("s_waitcnt lgkmcnt(0)" ::: "memory")
#define VM_WAIT() asm volatile("s_waitcnt vmcnt(0)" ::: "memory")
typedef float f32x2v __attribute__((ext_vector_type(2)));
typedef __bf16 bf16x2v __attribute__((ext_vector_type(2)));
__device__ __forceinline__ unsigned pk2(float lo, float hi) { const f32x2v v = {lo, hi}; const bf16x2v b = __builtin_convertvector(v, bf16x2v); return __builtin_bit_cast(unsigned, b); }
__device__ __forceinline__ unsigned f2bf(float f) { return pk2(f, 0.f) & 0xffffu; }
__device__ __forceinline__ float bf2f(unsigned v) { return __builtin_bit_cast(float, v << 16); }
__device__ __forceinline__ float bflo(unsigned w) { return __builtin_bit_cast(float, w << 16); }
__device__ __forceinline__ float bfhi(unsigned w) { return __builtin_bit_cast(float, w & 0xffff0000u); }
__device__ __forceinline__ float sigmoidf_(float x) { return 1.f / (1.f + __expf(-x)); }
__device__ __forceinline__ float wave_sum(float v) {
#pragma unroll
    for (int o = 1; o < 64; o <<= 1) v += __shfl_xor(v, o);
    return v;
}
__device__ __forceinline__ float wave_max(float v) {
#pragma unroll
    for (int o = 1; o < 64; o <<= 1) v = fmaxf(v, __shfl_xor(v, o));
    return v;
}
namespace pg8 {
#define PG8_LAS __attribute__((address_space(3)))
typedef unsigned short bf16_t;
typedef short bf16x8 __attribute__((ext_vector_type(8)));
typedef float f32x4 __attribute__((ext_vector_type(4)));
typedef unsigned u32x4 __attribute__((ext_vector_type(4)));
constexpr int BM = 256, BK = 64, HALF = 128, HTB = HALF * BK * 2  , STAGE_BYTES = 8 * HTB, NXCD = 8, WGM = 8;

__host__ __device__ __forceinline__ int lds_byte(int r, int c) { const int st = (r >> 4) * 2 + (c >> 5), rr = r & 15, cc = c & 31, ob = rr * 64 + cc * 2; return st * 1024 + (ob ^ (((ob >> 9) & 1) << 5)); }
__host__ __device__ __forceinline__ void stage_rc(int b, int& R, int& C) { const int st = b / 1024, sb = b % 1024, swz = sb ^ (((sb >> 9) & 1) << 5); R = (st >> 1) * 16 + swz / 64; C = (st & 1) * 32 + (swz % 64) / 2; }
__host__ __device__ __forceinline__ int perm32(int rho) { const int n = rho >> 4, i = rho & 15; return 8 * (i >> 2) + 4 * n + (i & 3); }

struct Unit { int pm, pn; };
__device__ __forceinline__ int moe_tok2(const int* list, PG8_LAS const int* ptab, int row) { const int e = ptab[1 + (row >> 8)], pos = row - ptab[512 + e]; return pos < ptab[544 + e] ? list[(size_t)e * 65536 + pos] : -1; }
struct Gemm { const bf16_t* A; const bf16_t* Bt; int M, N, K; const int* list = nullptr; PG8_LAS const int* ptab = nullptr; };

struct StaticOrder {
    int nM, nN, nwg, G, c;
    __host__ __device__ void init(int M, int N, int G_, int c_) { nM = M / BM; nN = N / BM; nwg = nM * nN; G = G_; c = c_; }
    __host__ __device__ bool next(int i, Unit& u) const {
        const long L = (long)i * G + c; if (L >= nwg) return false;
        int wgid = (int)L; { const int q = nwg / NXCD, r = nwg % NXCD, xcd = wgid % NXCD, off = wgid / NXCD; wgid = (xcd < r ? xcd * (q + 1) : r * (q + 1) + (xcd - r) * q) + off; }
        const int nig = WGM * nN, gid = wgid / nig, fm = gid * WGM, gsz = (nM - fm) < WGM ? (nM - fm) : WGM;
        u.pm = fm + ((wgid % nig) % gsz); u.pn = (wgid % nig) / gsz; return true;
    }
    __device__ __forceinline__ void a_ready(const Unit&) const {}
    __device__ __forceinline__ void done(const Unit&) const {}
};

__device__ __forceinline__ unsigned cvt_pk_bf16(float lo, float hi) { unsigned r; asm volatile("v_cvt_pk_bf16_f32 %0, %1, %2" : "=v"(r) : "v"(lo), "v"(hi)); return r; }

struct EpiProj {
    static constexpr bool PERM = true, AFTER_DRAIN = false;
    bf16_t* O; float* G;
    __device__ __forceinline__ void operator()(const f32x4 (&acc)[2][2][4][2], const Unit& u, int wr, int wc, int fr, int fq) const {
        const int row0 = u.pm * BM + wr * 64 + fr;
        if (u.pn < 11) {
            const int col0 = u.pn * BM + wc * 32 + 8 * fq;
#pragma unroll
            for (int ai = 0; ai < 2; ++ai)
#pragma unroll
                for (int m = 0; m < 4; ++m) { bf16_t* rowp = O + (size_t)(row0 + ai * HALF + m * 16) * 2816 + col0;
#pragma unroll
                    for (int bj = 0; bj < 2; ++bj) { const f32x4 v0 = acc[ai][bj][m][0], v1 = acc[ai][bj][m][1];
                        u32x4 w; w.x = cvt_pk_bf16(v0[0], v0[1]); w.y = cvt_pk_bf16(v0[2], v0[3]); w.z = cvt_pk_bf16(v1[0], v1[1]); w.w = cvt_pk_bf16(v1[2], v1[3]);
                        *(u32x4*)(rowp + bj * HALF) = w; } }
        } else if (wc == 0 && fq < 2) {
#pragma unroll
            for (int ai = 0; ai < 2; ++ai)
#pragma unroll
                for (int m = 0; m < 4; ++m) { float* rowp = G + (size_t)(row0 + ai * HALF + m * 16) * 16 + 8 * fq;
                    *(f32x4*)(rowp) = acc[ai][0][m][0]; *(f32x4*)(rowp + 4) = acc[ai][0][m][1]; }
        }
    }
};
struct EpiResid {
    static constexpr bool PERM = true, AFTER_DRAIN = false;
    const float* xin; float* out; const float* gate;
    int goff;
    __device__ __forceinline__ void operator()(const f32x4 (&acc)[2][2][4][2], const Unit& u, int wr, int wc, int fr, int fq) const {
        const int row0 = u.pm * BM + wr * 64 + fr, col0 = u.pn * BM + wc * 32 + 8 * fq;
        const float* gp = gate + (size_t)(row0 >> 13) * 6144 + goff + col0;
        f32x4 g[2][2];
#pragma unroll
        for (int bj = 0; bj < 2; ++bj)
#pragma unroll
            for (int n = 0; n < 2; ++n) g[bj][n] = *(const f32x4*)(gp + bj * HALF + 4 * n) + 1.0f;
#pragma unroll
        for (int ai = 0; ai < 2; ++ai)
#pragma unroll
            for (int m = 0; m < 4; ++m) { const size_t off = (size_t)(row0 + ai * HALF + m * 16) * 1024 + col0;
#pragma unroll
                for (int bj = 0; bj < 2; ++bj)
#pragma unroll
                    for (int n = 0; n < 2; ++n) { const f32x4 xv = *(const f32x4*)(xin + off + bj * HALF + 4 * n);
                        *(f32x4*)(out + off + bj * HALF + 4 * n) = xv + g[bj][n] * acc[ai][bj][m][n]; } }
    }
};
struct EpiSwiglu {
    static constexpr bool PERM = true, AFTER_DRAIN = false;
    bf16_t* H;
    __device__ __forceinline__ void operator()(const f32x4 (&acc)[2][2][4][2], const Unit& u, int wr, int wc, int fr, int fq) const {
        const int row0 = u.pm * BM + wr * 64 + fr, hid0 = 128 * (u.pn & 3) + 16 * wc + 4 * fq;
#pragma unroll
        for (int ai = 0; ai < 2; ++ai)
#pragma unroll
            for (int m = 0; m < 4; ++m) { bf16_t* rowp = H + (size_t)(row0 + ai * HALF + m * 16) * 512 + hid0;
#pragma unroll
                for (int bj = 0; bj < 2; ++bj) { const f32x4 g = acc[ai][bj][m][0], uu = acc[ai][bj][m][1]; float h[4];
#pragma unroll
                    for (int i = 0; i < 4; ++i) h[i] = g[i] / (1.f + __expf(-g[i])) * uu[i];
                    unsigned w0 = cvt_pk_bf16(h[0], h[1]), w1 = cvt_pk_bf16(h[2], h[3]);
                    *(unsigned long long*)(rowp + 64 * bj) = (unsigned long long)w0 | ((unsigned long long)w1 << 32); } }
    }
};
struct EpiMoeOut {
    static constexpr bool PERM = true, AFTER_DRAIN = false;
    bf16_t* Y; const int* list; PG8_LAS const int* ptab;
    __device__ __forceinline__ void operator()(const f32x4 (&acc)[2][2][4][2], const Unit& u, int wr, int wc, int fr, int fq) const {
        const int row0 = u.pm * BM + wr * 64 + fr, col0 = (u.pn & 3) * BM + wc * 32 + 8 * fq;
#pragma unroll
        for (int ai = 0; ai < 2; ++ai)
#pragma unroll
            for (int m = 0; m < 4; ++m) { const int dst = moe_tok2(list, ptab, row0 + ai * HALF + m * 16);
                if (dst >= 0) { bf16_t* rowp = Y + (size_t)dst * 1024 + col0;
#pragma unroll
                    for (int bj = 0; bj < 2; ++bj) { const f32x4 v0 = acc[ai][bj][m][0], v1 = acc[ai][bj][m][1];
                        u32x4 w; w.x = cvt_pk_bf16(v0[0], v0[1]); w.y = cvt_pk_bf16(v0[2], v0[3]); w.z = cvt_pk_bf16(v1[0], v1[1]); w.w = cvt_pk_bf16(v1[2], v1[3]);
                        *(u32x4*)(rowp + bj * HALF) = w; } } }
    }
};
struct MoeOrder {
    PG8_LAS const int* ptab; int G, c;
    __device__ __forceinline__ bool next(int i, Unit& u) const {
        const int L = i * G + c, np = __builtin_amdgcn_readfirstlane(ptab[0]);
        if (L >= np * 4) return false;
        const int p = L >> 2; u.pm = p; u.pn = __builtin_amdgcn_readfirstlane(ptab[1 + p]) * 4 + (L & 3); return true;
    }
    __device__ __forceinline__ void a_ready(const Unit&) const {}
    __device__ __forceinline__ void done(const Unit&) const {}
};
template <class Epi, class Sched, bool ALIGN_EPI = false, bool SP2 = false, bool GATHER = false>
__device__ __forceinline__ void gemm_phase(PG8_LAS unsigned char* lds, const Gemm g, const Sched& S, const Epi& E) {
    const int tid = threadIdx.x, wid = __builtin_amdgcn_readfirstlane(tid >> 6), lane = tid & 63, wr = wid >> 2, wc = wid & 3, fr = lane & 15, fq = lane >> 4;
    const int K = g.K, nt = K / BK;
    static_assert(!GATHER || SP2, "the gathered-A variant exists for the SP2 loop only");
    unsigned voffA[2], voffB[2];
    unsigned vAc[2] = {0u, 0u}, vAn[2] = {0u, 0u};
#pragma unroll
    for (int i = 0; i < 2; ++i) { int R, C; stage_rc(tid * 16 + i * 8192, R, C); const int Rb = Epi::PERM ? ((R & ~31) + perm32(R & 31)) : R;
        voffA[i] = (unsigned)(R * K + C) * 2u; voffB[i] = (unsigned)(Rb * K + C) * 2u; }
    const size_t kstep = (size_t)(BK * 2);
    const size_t hstep = (size_t)HALF * K * 2;
    const size_t tstep = 2 * hstep;
    const unsigned ldsw = (unsigned)wid * 1024u;
    const int aoff = lds_byte(wr * 64 + fr, fq * 8), boff = lds_byte(wc * 32 + fr, fq * 8);
#define PG8_SA(b, h) (((b) * 2 + (h)) * HTB)
#define PG8_SB(b, h) ((4 + (b) * 2 + (h)) * HTB)
#define PG8_STAGE(bufoff, gbase, voff) do { _Pragma("unroll") for (int _i = 0; _i < 2; ++_i) \
        __builtin_amdgcn_global_load_lds((const unsigned*)((const char*)(gbase) + (voff)[_i]), (PG8_LAS unsigned*)(lds + (bufoff) + ldsw + _i * 8192), 16, 0, 0); } while (0)
#define PG8_STAGEG(bufoff, base, pk) do { unsigned vg_[2]; _Pragma("unroll") for (int i_ = 0; i_ < 2; ++i_) { int R_, C_; stage_rc(tid * 16 + i_ * 8192, R_, C_); vg_[i_] = (((pk) >> (16 * i_)) & 0xffffu) * (unsigned)(2 * K) + (unsigned)(2 * C_); } PG8_STAGE(bufoff, base, vg_); } while (0)
#define PG8_STAGEA(bufoff, base, hh, nx) do { if constexpr (GATHER) { const unsigned pk_ = (nx) ? vAn[hh] : vAc[hh]; PG8_STAGEG(bufoff, base, pk_); } else PG8_STAGE(bufoff, (base) + (hh) * hstep, voffA); } while (0)
#define PG8_GOFF(dst, unit) do { _Pragma("unroll") for (int hh_ = 0; hh_ < 2; ++hh_) { unsigned pk_ = 0u; _Pragma("unroll") for (int i_ = 0; i_ < 2; ++i_) { int R_, C_; stage_rc(tid * 16 + i_ * 8192, R_, C_); \
        const int t2_ = moe_tok2(g.list, g.ptab, (unit).pm * BM + hh_ * HALF + R_); pk_ |= (unsigned)(t2_ < 0 ? 0 : (t2_ >> 1)) << (16 * i_); } dst[hh_] = pk_; } } while (0)
#define PG8_LDA(dst, b, h) do { _Pragma("unroll") for (int m = 0; m < 4; ++m) _Pragma("unroll") for (int k = 0; k < 2; ++k) dst[m][k] = *(const PG8_LAS bf16x8*)(lds + PG8_SA(b, h) + aoff + m * 2048 + k * 1024); } while (0)
#define PG8_LDB(dst, b, h) do { _Pragma("unroll") for (int n = 0; n < 2; ++n) _Pragma("unroll") for (int k = 0; k < 2; ++k) dst[n][k] = *(const PG8_LAS bf16x8*)(lds + PG8_SB(b, h) + boff + n * 2048 + k * 1024); } while (0)
#define PG8_MMA(ai, bj, At, Bt) do { __builtin_amdgcn_s_setprio(1); _Pragma("unroll") for (int m = 0; m < 4; ++m) _Pragma("unroll") for (int n = 0; n < 2; ++n) _Pragma("unroll") for (int k = 0; k < 2; ++k) \
        acc[ai][bj][m][n] = __builtin_amdgcn_mfma_f32_16x16x32_bf16(Bt[n][k], At[m][k], acc[ai][bj][m][n], 0, 0, 0); __builtin_amdgcn_s_setprio(0); } while (0)
#define PG8_WAIT_V(n) asm volatile("s_waitcnt vmcnt(" #n ")" ::: "memory")
#define PG8_WAIT_L(n) asm volatile("s_waitcnt lgkmcnt(" #n ")" ::: "memory")
#define PG8_BAR __builtin_amdgcn_s_barrier()
#define PG8_SCHED __builtin_amdgcn_sched_barrier(0)
    Unit cur, nxt; int ui = 0;
    if (!S.next(0, cur)) return;
    f32x4 acc[2][2][4][2];
#pragma unroll
    for (int a = 0; a < 2; ++a)
#pragma unroll
        for (int b = 0; b < 2; ++b)
#pragma unroll
            for (int m = 0; m < 4; ++m)
#pragma unroll
                for (int n = 0; n < 2; ++n) acc[a][b][m][n] = (f32x4){0.f, 0.f, 0.f, 0.f};
    bf16x8 At[4][2], B0[2][2], B1[2][2];
    const char* cA = (const char*)g.A + (GATHER ? (size_t)0 : (size_t)cur.pm * tstep); const char* cB = (const char*)g.Bt + (size_t)cur.pn * tstep;
    if constexpr (GATHER) { PG8_GOFF(vAc, cur); }
    S.a_ready(cur);
    if constexpr (SP2) {
        PG8_STAGE(PG8_SB(0, 0), cB, voffB); PG8_STAGE(PG8_SB(0, 1), cB + hstep, voffB); PG8_STAGEA(PG8_SA(0, 0), cA, 0, false); PG8_STAGEA(PG8_SA(0, 1), cA, 1, false);
        if (wr == 1) PG8_BAR;
        PG8_WAIT_V(2); PG8_BAR;
        PG8_STAGE(PG8_SB(1, 0), cB + kstep, voffB); PG8_STAGEA(PG8_SA(1, 0), cA + kstep, 0, false); PG8_STAGE(PG8_SB(1, 1), cB + hstep + kstep, voffB);
        PG8_WAIT_V(6); PG8_BAR;
    } else {
        PG8_STAGE(PG8_SB(0, 0), cB, voffB); PG8_STAGE(PG8_SA(0, 0), cA, voffA); PG8_STAGE(PG8_SB(0, 1), cB + hstep, voffB); PG8_STAGE(PG8_SA(0, 1), cA + hstep, voffA);
        if (wr == 1) PG8_BAR;
        PG8_WAIT_V(4); PG8_BAR;
        PG8_STAGE(PG8_SB(1, 0), cB + kstep, voffB); PG8_STAGE(PG8_SA(1, 0), cA + kstep, voffA); PG8_STAGE(PG8_SB(1, 1), cB + hstep + kstep, voffB);
        PG8_WAIT_V(6); PG8_BAR;
    }
    for (;;) {
        const bool has_next = S.next(ui + 1, nxt);
        const char* nA = (has_next && !GATHER) ? (const char*)g.A + (size_t)nxt.pm * tstep : cA;
        if constexpr (GATHER) { if (has_next) { PG8_GOFF(vAn, nxt); } else { vAn[0] = vAc[0]; vAn[1] = vAc[1]; } } const char* nB = has_next ? (const char*)g.Bt + (size_t)nxt.pn * tstep : cB;
        for (int t = 0; t < nt; t += 2) {
            const bool last = (t == nt - 2);
            const char* a1 = cA + (size_t)(t + 1) * kstep;
            const char* a2 = last ? nA : cA + (size_t)(t + 2) * kstep; const char* b2 = last ? nB : cB + (size_t)(t + 2) * kstep;
            const char* a3 = a2 + kstep; const char* b3 = b2 + kstep;
            if (last && has_next) S.a_ready(nxt);
            if constexpr (SP2) {
            PG8_LDB(B0, 0, 0); PG8_LDB(B1, 0, 1); PG8_SCHED; PG8_LDA(At, 0, 0); PG8_STAGEA(PG8_SA(1, 1), a1, 1, false);
            PG8_WAIT_V(8); PG8_WAIT_L(0); PG8_BAR; PG8_MMA(0, 0, At, B0); PG8_MMA(0, 1, At, B1); PG8_BAR; PG8_SCHED;
            PG8_LDA(At, 0, 1); PG8_STAGE(PG8_SB(0, 0), b2, voffB); PG8_STAGE(PG8_SB(0, 1), b2 + hstep, voffB); PG8_STAGEA(PG8_SA(0, 0), a2, 0, last);
            PG8_WAIT_V(8); PG8_WAIT_L(0); PG8_BAR; PG8_MMA(1, 0, At, B0); PG8_MMA(1, 1, At, B1); PG8_BAR; PG8_SCHED;
            PG8_LDB(B0, 1, 0); PG8_LDB(B1, 1, 1); PG8_SCHED; PG8_LDA(At, 1, 0); PG8_STAGEA(PG8_SA(0, 1), a2, 1, last);
            PG8_WAIT_V(8); PG8_WAIT_L(0); PG8_BAR; PG8_MMA(0, 0, At, B0); PG8_MMA(0, 1, At, B1); PG8_BAR; PG8_SCHED;
            PG8_LDA(At, 1, 1); PG8_STAGE(PG8_SB(1, 0), b3, voffB); PG8_STAGE(PG8_SB(1, 1), b3 + hstep, voffB); PG8_STAGEA(PG8_SA(1, 0), a3, 0, last);
            PG8_WAIT_V(8); PG8_WAIT_L(0); PG8_BAR; PG8_MMA(1, 0, At, B0); PG8_MMA(1, 1, At, B1); PG8_BAR; PG8_SCHED;
            } else {
            PG8_LDB(B0, 0, 0); PG8_SCHED; PG8_LDA(At, 0, 0); PG8_STAGE(PG8_SA(1, 1), a1 + hstep, voffA);
            PG8_WAIT_L(8); PG8_BAR; PG8_WAIT_L(0); PG8_MMA(0, 0, At, B0); PG8_BAR; PG8_SCHED;
            PG8_LDB(B1, 0, 1); PG8_STAGE(PG8_SB(0, 0), b2, voffB);
            PG8_BAR; PG8_WAIT_L(0); PG8_MMA(0, 1, At, B1); PG8_BAR;
            PG8_LDA(At, 0, 1); PG8_STAGE(PG8_SA(0, 0), a2, voffA);
            PG8_BAR; PG8_WAIT_L(0); PG8_MMA(1, 0, At, B0); PG8_BAR; PG8_SCHED;
            PG8_STAGE(PG8_SB(0, 1), b2 + hstep, voffB);
            PG8_WAIT_V(6); PG8_BAR; PG8_MMA(1, 1, At, B1); PG8_BAR;
            PG8_LDB(B0, 1, 0); PG8_SCHED; PG8_LDA(At, 1, 0); PG8_STAGE(PG8_SA(0, 1), a2 + hstep, voffA);
            PG8_WAIT_L(8); PG8_BAR; PG8_WAIT_L(0); PG8_MMA(0, 0, At, B0); PG8_BAR; PG8_SCHED;
            PG8_LDB(B1, 1, 1); PG8_STAGE(PG8_SB(1, 0), b3, voffB);
            PG8_BAR; PG8_WAIT_L(0); PG8_MMA(0, 1, At, B1); PG8_BAR;
            PG8_LDA(At, 1, 1); PG8_STAGE(PG8_SA(1, 0), a3, voffA);
            PG8_BAR; PG8_WAIT_L(0); PG8_MMA(1, 0, At, B0); PG8_BAR; PG8_SCHED;
            PG8_STAGE(PG8_SB(1, 1), b3 + hstep, voffB);
            PG8_WAIT_V(6); PG8_BAR; PG8_MMA(1, 1, At, B1); PG8_BAR;
            }
        }
        if constexpr (ALIGN_EPI) { if (wr == 0) PG8_BAR; }
        if constexpr (!Epi::AFTER_DRAIN) { E(acc, cur, wr, wc, fr, fq); S.done(cur); }
        if (!has_next) break;
#pragma unroll
        for (int a = 0; a < 2; ++a)
#pragma unroll
            for (int b = 0; b < 2; ++b)
#pragma unroll
                for (int m = 0; m < 4; ++m)
#pragma unroll
                    for (int n = 0; n < 2; ++n) acc[a][b][m][n] = (f32x4){0.f, 0.f, 0.f, 0.f};
        cur = nxt; cA = nA; cB = nB; ++ui;
        if constexpr (GATHER) { vAc[0] = vAn[0]; vAc[1] = vAn[1]; }
        if constexpr (ALIGN_EPI) { if (wr == 1) PG8_BAR; }
    }
    PG8_WAIT_V(0);
    if constexpr (!ALIGN_EPI) { if (wr == 0) PG8_BAR; }
    PG8_BAR;
    if constexpr (Epi::AFTER_DRAIN) { E.fused(acc, cur, wr, wc, fr, fq, lds, wid, lane); S.done(cur); }
#undef PG8_SA
#undef PG8_SB
#undef PG8_STAGE
#undef PG8_STAGEA
#undef PG8_STAGEG
#undef PG8_GOFF
#undef PG8_LDA
#undef PG8_LDB
#undef PG8_MMA
#undef PG8_WAIT_V
#undef PG8_WAIT_L
#undef PG8_BAR
#undef PG8_SCHED
}
}
#define XB_TMO      128
#define XB_XCNT(j)  (256  + 64 * (j))
#define XB_XSUB(j)  (1280 + 64 * (j))
#define XB_XGEN(j)  (2304 + 64 * (j))
#define XB_TOP      3328
#define XB_TOPGEN   3392
#define XCD_BAR_WORDS 3456
#define XB_SPIN_CAP (1u << 18)
#define LAS __attribute__((address_space(3)))

__device__ __forceinline__ unsigned xb_ld(unsigned* p)              { return __hip_atomic_load(p, __ATOMIC_RELAXED, __HIP_MEMORY_SCOPE_AGENT); }
__device__ __forceinline__ unsigned xb_add(unsigned* p, unsigned v) { return __hip_atomic_fetch_add(p, v, __ATOMIC_RELAXED, __HIP_MEMORY_SCOPE_AGENT); }
__device__ __forceinline__ unsigned xb_xcc_id() { return (unsigned)__builtin_amdgcn_s_getreg((3 << 11) | 20) & 0xFu; }
#define XB_SPIN(cond, bar) do { unsigned _sp = 0; while (cond) { __builtin_amdgcn_s_sleep(1); \
    if ((++_sp & 255u) == 0u) { if (xb_ld(&(bar)[XB_TMO])) break; if (_sp > XB_SPIN_CAP) { atomicAdd(&(bar)[XB_TMO], 1u); break; } } } } while (0)

struct XcdBarrier {
    unsigned* bar; unsigned x;
    volatile LAS unsigned* st;
};

__device__ __forceinline__ XcdBarrier xcd_barrier_post(unsigned* bar, volatile LAS unsigned* st) {
    XcdBarrier b; b.bar = bar; b.x = xb_xcc_id(); b.st = st;
    if (threadIdx.x == 0) (void)xb_add(&bar[XB_XCNT(b.x)], 1u);
    return b;
}
__device__ __forceinline__ void xcd_barrier_complete(unsigned* bar, unsigned x, unsigned& nloc, unsigned& nx) {
    const unsigned G = gridDim.x * gridDim.y * gridDim.z;
    unsigned sum, cnt, mine, sp = 0u;
    for (;;) {
        sum = 0u; cnt = 0u; mine = 0u;
#pragma unroll
        for (unsigned j = 0; j < 16; ++j) { const unsigned c = xb_ld(&bar[XB_XCNT(j)]); sum += c; cnt += (c > 0u) ? 1u : 0u; mine = (j == x) ? c : mine; }
        if (sum == G) break;
        __builtin_amdgcn_s_sleep(1);
        if ((++sp & 255u) == 0u) { if (xb_ld(&bar[XB_TMO])) break; if (sp > XB_SPIN_CAP) { atomicAdd(&bar[XB_TMO], 1u); break; } }
    }
    nloc = mine > 0u ? mine : 1u; nx = cnt > 0u ? cnt : 1u;
}

__device__ __forceinline__ void xcd_barrier(const XcdBarrier& b) {
    asm volatile("s_waitcnt vmcnt(0)" ::: "memory");
    __syncthreads();
    if (threadIdx.x == 0) {
        unsigned* bar = b.bar;
        __builtin_amdgcn_s_waitcnt(0);
        unsigned nloc = b.st[0], nx = b.st[1];
        if (nloc == 0u) { xcd_barrier_complete(bar, b.x, nloc, nx); b.st[0] = nloc; b.st[1] = nx; }
        const unsigned old = xb_add(&bar[XB_XSUB(b.x)], 1u);
        const unsigned gen = old / nloc;
        if (old + 1u == (gen + 1u) * nloc) {
            __builtin_amdgcn_fence(__ATOMIC_RELEASE, "agent");
            asm volatile("s_waitcnt vmcnt(0)" ::: "memory");
            const unsigned og = xb_add(&bar[XB_TOP], 1u);
            const unsigned tg = og / nx;
            if (og + 1u == (tg + 1u) * nx) xb_add(&bar[XB_TOPGEN], 1u);
            else XB_SPIN(xb_ld(&bar[XB_TOPGEN]) == tg, bar);
            __builtin_amdgcn_fence(__ATOMIC_ACQUIRE, "agent");
            xb_add(&bar[XB_XGEN(b.x)], 1u);
            asm volatile("s_waitcnt vmcnt(0)" ::: "memory");
        } else {
            XB_SPIN(xb_ld(&bar[XB_XGEN(b.x)]) == gen, bar);
            __builtin_amdgcn_fence(__ATOMIC_ACQUIRE, "agent");
            asm volatile("s_waitcnt vmcnt(0)" ::: "memory");
        }
    }
    __syncthreads();
}

struct Args { const float* in[47]; float* out; unsigned char* ws; int ph_lo, ph_hi; };
typedef const __attribute__((address_space(4))) Args* KArgsP;
__device__ __forceinline__ KArgsP fresh_args() { KArgsP p = (KArgsP)__builtin_amdgcn_kernarg_segment_ptr(); asm volatile("" : "+s"(p)); return p; }
enum { I_X = 0, I_C, I_ADA_W, I_ADA_B, I_NORM_MIX, I_NORM_FFN, I_NORM_FINAL, I_W_IN, I_W_OUT, I_CONV_W, I_CONV_B, I_WQ, I_WK, I_BI, I_BF, I_MNORM_W,
       I_RMU, I_RW0, I_RWUP, I_RA0, I_RAUP, I_RGUP, I_RKK, I_RKA, I_RRK, I_RLNW, I_RLNB, I_RV0, I_RVDN, I_RVUP,
       I_S5ARE, I_S5AIM, I_S5LDT, I_S5BRE, I_S5BIM, I_S5CRE, I_S5CIM, I_S5D, I_S5GLUW, I_S5GLUB,
       I_MWRG, I_MBRG, I_MWRE, I_MBRE, I_MW1, I_MW3, I_MW2 };

struct RmWin { __device__ __forceinline__ int operator()(int n) const { return n < 1152 ? n : (n < 1164 ? 2816 + (n - 1152) : (n < 2572 ? 1152 + (n - 1164) : 2560 + (n - 2572))); } };
struct RmId  { __device__ __forceinline__ int operator()(int n) const { return n; } };
struct RmGU  { int add; __device__ __forceinline__ int operator()(int n) const { return 8 * (n >> 2) + (n & 3) + add; } };
template <class RM>
__device__ __forceinline__ void transpose_item(const float* W, int ldw, int ncols, int k0, int n0, bf16* WT, int ldt, LAS float* scr, int lane, const RM rm) {
    const int nn = n0 + lane; const bool ok = nn < ncols; const float* src = W + (size_t)k0 * ldw + (ok ? nn : n0);
    float v[64];
#pragma unroll
    for (int kk = 0; kk < 64; ++kk) v[kk] = src[(size_t)kk * ldw];
#pragma unroll
    for (int kk = 0; kk < 64; ++kk) scr[kk * 65 + lane] = v[kk];
    LDS_WAIT(); asm volatile("" ::: "memory");
    const int c = lane & 7;
#pragma unroll
    for (int j = 0; j < 8; ++j) { const int nl = (lane >> 3) + 8 * j; const LAS float* s = scr + (8 * c) * 65 + nl;
        v4u o; o.x = pk2(s[0 * 65], s[1 * 65]); o.y = pk2(s[2 * 65], s[3 * 65]); o.z = pk2(s[4 * 65], s[5 * 65]); o.w = pk2(s[6 * 65], s[7 * 65]);
        if (n0 + nl < ncols) *(GAS v4u*)(WT + (size_t)rm(n0 + nl) * ldt + k0 + 8 * c) = o; }
    LDS_WAIT(); asm volatile("" ::: "memory");
}
__device__ __forceinline__ void moe_convert13(const float* w1, const float* w3, int l, bf16* W13, int worker, int nworkers, LAS float* scr, int lane) {
    for (int it = worker; it < NEXP * 256; it += nworkers) {
        const int e = it >> 8, r = it & 255; const size_t eo = (size_t)(l * NEXP + e) * DM * DEXP;
        if (r < 128) transpose_item(w1 + eo, DEXP, DEXP, 64 * (r >> 3), 64 * (r & 7), W13 + (size_t)e * 1024 * 1024, 1024, scr, lane, RmGU{0});
        else         transpose_item(w3 + eo, DEXP, DEXP, 64 * ((r - 128) >> 3), 64 * ((r - 128) & 7), W13 + (size_t)e * 1024 * 1024, 1024, scr, lane, RmGU{4});
    }
}
__device__ __forceinline__ void moe_convert2(const float* w2, int l, bf16* W2T, int worker, int nworkers, LAS float* scr, int lane) {
    for (int it = worker; it < NEXP * 128; it += nworkers) {
        const int e = it >> 7, r = it & 127; const size_t eo = (size_t)(l * NEXP + e) * DM * DEXP;
        transpose_item(w2 + eo, DM, DM, 64 * (r >> 4), 64 * (r & 15), W2T + (size_t)e * 1024 * 512, 512, scr, lane, RmId{});
    }
}
__device__ __forceinline__ void phase_prologue(KArgsP a, LAS unsigned char* lds, int tid, int lane, int wave, int vcu, int G) {
    unsigned char* ws = a->ws;
    LAS float* scr = (LAS float*)(lds + wave * 16640);
    const int gw = vcu * NWAVES + wave, NGW = G * NWAVES;
    bf16* WIN = (bf16*)(ws + WS_WIN); bf16* WOUT = (bf16*)(ws + WS_WOUT);
    for (int it = gw; it < 2 * 16 * 45; it += NGW) { const int l = it / (16 * 45), r = it % (16 * 45);
        transpose_item(a->in[I_W_IN] + (size_t)l * DM * IN_COLS, IN_COLS, IN_COLS, 64 * (r / 45), 64 * (r % 45), WIN + (size_t)l * NPROJ_PAD * DM, DM, scr, lane, RmWin{}); }
    for (int it = gw; it < 2 * 16 * 16; it += NGW) { const int l = it / 256, r = it % 256;
        transpose_item(a->in[I_W_OUT] + (size_t)l * DM * DM, DM, DM, 64 * (r >> 4), 64 * (r & 15), WOUT + (size_t)l * DM * DM, DM, scr, lane, RmId{}); }
    for (int it = gw; it < 2 * 244; it += NGW) { const int l = it / 244, r = 2828 + it % 244; GAS v4u* p = (GAS v4u*)(WIN + ((size_t)l * NPROJ_PAD + r) * DM);
        p[lane] = (v4u){0u, 0u, 0u, 0u}; p[lane + 64] = (v4u){0u, 0u, 0u, 0u}; }
    { float* RTW = (float*)(ws + WS_RTW);
      for (int idx = (vcu * NTHR + tid); idx < 2 * 1024 * 48; idx += G * NTHR) { const int j = idx % 48, k = (idx / 48) % 1024, l = idx / (48 * 1024);
          RTW[idx] = j < 4 ? a->in[I_MWRG][(size_t)(l * 1024 + k) * 4 + j] : (j < 36 ? a->in[I_MWRE][(size_t)(l * 1024 + k) * 32 + (j - 4)] : 0.f); } }
    { bf16* RW = (bf16*)(ws + WS_R1W);
      for (int idx = (vcu * NTHR + tid); idx < 2 * 98304 + 24576; idx += G * NTHR) { float v;
          if (idx < 2 * 98304) { const int l = idx / 98304, r = idx % 98304;
              if (r < 24576)      v = a->in[I_RWUP][(size_t)l * 64 * DBR + (r & 63) * DBR + (r >> 6)];
              else if (r < 49152) v = a->in[I_RAUP][(size_t)l * 64 * DBR + ((r - 24576) & 63) * DBR + ((r - 24576) >> 6)];
              else                v = a->in[I_RGUP][(size_t)l * 128 * DBR + ((r - 49152) & 127) * DBR + ((r - 49152) >> 7)];
          } else { const int r = idx - 2 * 98304;
              if (r < 12288) v = a->in[I_RVDN][(size_t)(r % 384) * 32 + (r / 384)];
              else           v = a->in[I_RVUP][(size_t)((r - 12288) & 31) * DBR + ((r - 12288) >> 5)]; }
          RW[idx] = (bf16)f2bf(v); } }
    for (int idx = (vcu * NTHR + tid); idx < 2 * 16 * 64; idx += G * NTHR) { const int p = idx & 63, lg = idx >> 6;
        const float lam_re = a->in[I_S5ARE][idx], lam_im = a->in[I_S5AIM][idx]; const float dt = expf(a->in[I_S5LDT][lg]); const float mag = expf(lam_re * dt), ang = lam_im * dt;
        const float are = mag * cosf(ang), aim = mag * sinf(ang); const float inv = 1.f / (lam_re * lam_re + lam_im * lam_im);
        const float cre = ((are - 1.f) * lam_re + aim * lam_im) * inv, cim = (aim * lam_re - (are - 1.f) * lam_im) * inv;
        ((float*)(ws + WS_S5AP))[idx * 2] = are; ((float*)(ws + WS_S5AP))[idx * 2 + 1] = aim;
        const float* br = a->in[I_S5BRE] + (size_t)idx * 16; const float* bi = a->in[I_S5BIM] + (size_t)idx * 16; bf16* o = (bf16*)(ws + WS_S5BB) + ((size_t)lg * 128 + 2 * p) * 16;
        for (int c = 0; c < 16; ++c) { o[c] = (bf16)f2bf(cre * br[c] - cim * bi[c]); o[16 + c] = (bf16)f2bf(cre * bi[c] + cim * br[c]); } }
    { bf16* CM = (bf16*)(ws + WS_S5CM);
      for (int idx = (vcu * NTHR + tid); idx < 2 * 16 * 16 * 128; idx += G * NTHR) { const int k = idx & 127, lgc = idx >> 7;
          CM[idx] = (bf16)f2bf((k & 1) ? -a->in[I_S5CIM][(size_t)lgc * 64 + (k >> 1)] : a->in[I_S5CRE][(size_t)lgc * 64 + (k >> 1)]); } }
    for (int it = gw; it < 2 * 16; it += NGW) { const int l = it >> 4, r = it & 15;
        transpose_item(a->in[I_S5GLUW] + (size_t)l * DC * DC, DC, DC, 64 * (r >> 2), 64 * (r & 3), (bf16*)(ws + WS_GLUT) + (size_t)l * DC * DC, DC, scr, lane, RmId{}); }
    { bf16* MLW = (bf16*)(ws + WS_MLW);
      for (int idx = (vcu * NTHR + tid); idx < 2 * NH * 2 * 4096; idx += G * NTHR) { const int d = idx & 63, e = (idx >> 6) & 63, which = (idx >> 12) & 1, lh = idx >> 13;
          MLW[idx] = (bf16)f2bf(a->in[which ? I_WK : I_WQ][(size_t)lh * 4096 + d * 64 + e]); } }
    __syncthreads();
    if (vcu < 192) {
        const int q = vcu, l = q / 96, cb = (q >> 3) % 12, kc = q & 7;
        LAS float* cond = (LAS float*)lds;
        { const int b = tid >> 7, kk = tid & 127; const float cv = a->in[I_C][b * DM + kc * 128 + kk]; cond[tid] = cv / (1.f + __expf(-cv)); }
        __syncthreads();
        const int col = cb * 512 + tid; const float* wp = a->in[I_ADA_W] + ((size_t)l * DM + kc * 128) * 6144 + col;
        float acc0 = 0.f, acc1 = 0.f, acc2 = 0.f, acc3 = 0.f;
#pragma unroll 8
        for (int kk = 0; kk < 128; ++kk) { const float w = wp[(size_t)kk * 6144]; acc0 += cond[kk] * w; acc1 += cond[128 + kk] * w; acc2 += cond[256 + kk] * w; acc3 += cond[384 + kk] * w; }
        const float bias = (kc == 0) ? a->in[I_ADA_B][l * 6144 + col] : 0.f;
        float* MP = (float*)(ws + WS_MODP) + ((size_t)(kc * 2 + l) * 4) * 6144 + col;
        MP[0] = acc0 + bias; MP[6144] = acc1 + bias; MP[2 * 6144] = acc2 + bias; MP[3 * 6144] = acc3 + bias;
    }
}

__device__ __forceinline__ float modval(const unsigned char* ws, bool part, int l, int b, int idx) {
    if (!part) return ((const float*)(ws + WS_MODF))[(size_t)(l * 4 + b) * 6144 + idx];
    const float* mp = (const float*)(ws + WS_MODP) + (size_t)(l * 4 + b) * 6144 + idx; float s = 0.f;
#pragma unroll
    for (int kc = 0; kc < 8; ++kc) s += mp[(size_t)kc * 2 * 4 * 6144];
    return s;
}
template <int MODE, bool COMBINE>
__device__ __forceinline__ void phase_rownorm(KArgsP a, LAS unsigned char* lds, int tid, int lane, int wave, int G,
                                              const float* xsrc, float* xdst, const float* gvec, bool part, int l, int isc  , int lprev) {
    unsigned char* ws = a->ws;
    LAS float* sc = (LAS float*)lds; LAS float* sh = sc + 1024; LAS float* gt = sh + 1024;
    bf16* HN = (bf16*)(ws + WS_HN); const bf16* YM = (const bf16*)(ws + WS_YMOE); const float* TW = (const float*)(ws + WS_TOKW);
    for (int c = blockIdx.x; c < NTOK / 128; c += G) {
        const int b = c >> 6;
        __syncthreads();
        for (int j = tid; j < 1024; j += NTHR) {
            if (MODE == 0) { sc[j] = gvec[j] * (1.f + modval(ws, part, l, b, (isc + 1) * 1024 + j)); sh[j] = modval(ws, part, l, b, isc * 1024 + j); }
            else { sc[j] = gvec[j]; sh[j] = 0.f; }
            if (COMBINE) gt[j] = 1.f + modval(ws, false, lprev, b, 5 * 1024 + j);
        }
        __syncthreads();
        f32x4 vn[4]; v2u yn0[4], yn1[4]; float wn0 = 0.f, wn1 = 0.f;
        { const int row = c * 128 + wave * 16; const GAS f32x4* xr = (const GAS f32x4*)(xsrc + (size_t)row * DM) + lane;
#pragma unroll
          for (int j = 0; j < 4; ++j) vn[j] = xr[64 * j];
          if (COMBINE) { wn0 = TW[2 * row]; wn1 = TW[2 * row + 1]; const GAS v2u* y0 = (const GAS v2u*)(YM + (size_t)(2 * row) * DM) + lane; const GAS v2u* y1 = (const GAS v2u*)(YM + (size_t)(2 * row + 1) * DM) + lane;
#pragma unroll
              for (int j = 0; j < 4; ++j) { yn0[j] = y0[64 * j]; yn1[j] = y1[64 * j]; } } }
        for (int i = 0; i < 16; ++i) {
            const int row = c * 128 + wave * 16 + i;
            f32x4 v[4]; v2u q0[4], q1[4]; const float w0 = wn0, w1 = wn1;
#pragma unroll
            for (int j = 0; j < 4; ++j) { v[j] = vn[j]; q0[j] = yn0[j]; q1[j] = yn1[j]; }
            if (i + 1 < 16) { const int rn = row + 1; const GAS f32x4* xr = (const GAS f32x4*)(xsrc + (size_t)rn * DM) + lane;
#pragma unroll
                for (int j = 0; j < 4; ++j) vn[j] = xr[64 * j];
                if (COMBINE) { wn0 = TW[2 * rn]; wn1 = TW[2 * rn + 1]; const GAS v2u* y0 = (const GAS v2u*)(YM + (size_t)(2 * rn) * DM) + lane; const GAS v2u* y1 = (const GAS v2u*)(YM + (size_t)(2 * rn + 1) * DM) + lane;
#pragma unroll
                    for (int j = 0; j < 4; ++j) { yn0[j] = y0[64 * j]; yn1[j] = y1[64 * j]; } } }
            if (COMBINE) {
#pragma unroll
                for (int j = 0; j < 4; ++j) { const v2u p0 = q0[j], p1 = q1[j]; const f32x4 g4 = *(const LAS f32x4*)(gt + lane * 4 + 256 * j);
                    f32x4 m; m.x = w0 * bflo(p0.x) + w1 * bflo(p1.x); m.y = w0 * bfhi(p0.x) + w1 * bfhi(p1.x); m.z = w0 * bflo(p0.y) + w1 * bflo(p1.y); m.w = w0 * bfhi(p0.y) + w1 * bfhi(p1.y);
                    v[j] = v[j] + g4 * m; }
                if (MODE == 0) { GAS f32x4* xo = (GAS f32x4*)(xdst + (size_t)row * DM) + lane;
#pragma unroll
                    for (int j = 0; j < 4; ++j) xo[64 * j] = v[j]; }
            }
            float ss = 0.f;
#pragma unroll
            for (int j = 0; j < 4; ++j) ss += (v[j].x * v[j].x + v[j].y * v[j].y) + (v[j].z * v[j].z + v[j].w * v[j].w);
            const float rstd = rsqrtf(wave_sum(ss) * (1.f / DM) + NORM_EPS);
            if (MODE == 0) {
                GAS v2u* o = (GAS v2u*)(HN + (size_t)row * DM) + lane;
#pragma unroll
                for (int j = 0; j < 4; ++j) { const f32x4 s4 = *(const LAS f32x4*)(sc + lane * 4 + 256 * j), h4 = *(const LAS f32x4*)(sh + lane * 4 + 256 * j); const f32x4 h = v[j] * rstd * s4 + h4;
                    v2u w; w.x = pk2(h.x, h.y); w.y = pk2(h.z, h.w); o[64 * j] = w; }
            } else {
                GAS f32x4* o = (GAS f32x4*)(xdst + (size_t)row * DM) + lane;
#pragma unroll
                for (int j = 0; j < 4; ++j) { const f32x4 s4 = *(const LAS f32x4*)(sc + lane * 4 + 256 * j); o[64 * j] = v[j] * rstd * s4; }
            }
        }
    }
}
__device__ __forceinline__ void mod_finalize(unsigned char* ws, int tid, int G) {
    float* MF = (float*)(ws + WS_MODF);
    for (int idx = blockIdx.x * NTHR + tid; idx < 2 * 4 * 6144; idx += G * NTHR) { const float* mp = (const float*)(ws + WS_MODP) + idx; float s = 0.f;
#pragma unroll
        for (int kc = 0; kc < 8; ++kc) s += mp[(size_t)kc * 2 * 4 * 6144];
        MF[idx] = s; }
}

typedef float f32x4m __attribute__((ext_vector_type(4)));
__device__ __forceinline__ void phase_router(KArgsP a, LAS unsigned char* lds, int tid, int lane, int wave, int G, int l) {
    unsigned char* ws = a->ws;
    LAS float* sc = (LAS float*)lds; LAS float* sh = sc + 1024; LAS float* rstd_s = sh + 1024  ; LAS float* cvec = rstd_s + 128  ; LAS float* cpart = cvec + 64  ;
    LAS float* lg = cpart + 8 * 48  ; LAS int* hist = (LAS int*)(lg + 8 * 16 * 48)  ; LAS int* basev = hist + 32; LAS int* asg_e = basev + 32  ; LAS int* asg_lp = asg_e + 256;
    bf16* HN = (bf16*)(ws + WS_HN); const float* x = a->out; const float* RTW = (const float*)(ws + WS_RTW) + (size_t)l * 1024 * 48;
    int* TOKE = (int*)(ws + WS_TOKE); float* TOKW = (float*)(ws + WS_TOKW); int* LIST = (int*)(ws + WS_LIST); unsigned* CNT = (unsigned*)(ws + WS_CTL) + CW_CNT + l * 32;
    const float* gvec = a->in[I_NORM_FFN] + l * DM;
    for (int c = blockIdx.x; c < NTOK / 128; c += G) {
        const int b = c >> 6;
        __syncthreads();
        for (int j = tid; j < 1024; j += NTHR) { sc[j] = gvec[j] * (1.f + modval(ws, false, l, b, 4 * 1024 + j)); sh[j] = modval(ws, false, l, b, 3 * 1024 + j); }
        if (tid < 32) hist[tid] = 0;
        __syncthreads();
        if (tid < 384) { const int j = tid % 48, part = tid / 48; float s = 0.f;
            for (int k = part * 128; k < part * 128 + 128; ++k) s += sh[k] * RTW[(size_t)k * 48 + j];
            cpart[part * 48 + j] = s; }
        { f32x4 vn[4];
          { const GAS f32x4* xr = (const GAS f32x4*)(x + (size_t)(c * 128 + wave * 16) * DM) + lane;
#pragma unroll
            for (int j = 0; j < 4; ++j) vn[j] = xr[64 * j]; }
          for (int i = 0; i < 16; ++i) {
            const int row = c * 128 + wave * 16 + i;
            f32x4 v[4]; float ss = 0.f;
#pragma unroll
            for (int j = 0; j < 4; ++j) { v[j] = vn[j]; ss += (v[j].x * v[j].x + v[j].y * v[j].y) + (v[j].z * v[j].z + v[j].w * v[j].w); }
            if (i + 1 < 16) { const GAS f32x4* xr = (const GAS f32x4*)(x + (size_t)(row + 1) * DM) + lane;
#pragma unroll
                for (int j = 0; j < 4; ++j) vn[j] = xr[64 * j]; }
            const float rstd = rsqrtf(wave_sum(ss) * (1.f / DM) + NORM_EPS);
            if (lane == 0) rstd_s[wave * 16 + i] = rstd;
            GAS v2u* o = (GAS v2u*)(HN + (size_t)row * DM) + lane;
#pragma unroll
            for (int j = 0; j < 4; ++j) { const f32x4 s4 = *(const LAS f32x4*)(sc + lane * 4 + 256 * j), h4 = *(const LAS f32x4*)(sh + lane * 4 + 256 * j); const f32x4 h = v[j] * rstd * s4 + h4;
                v2u w; w.x = pk2(h.x, h.y); w.y = pk2(h.z, h.w); o[64 * j] = w; }
          } }
        __syncthreads();
        if (tid < 48) { float s = 0.f;
#pragma unroll
            for (int p = 0; p < 8; ++p) s += cpart[p * 48 + tid];
            s += tid < 4 ? a->in[I_MBRG][l * 4 + tid] : (tid < 36 ? a->in[I_MBRE][l * 32 + tid - 4] : 0.f); cvec[tid] = s; }
        {
            const int i16 = lane & 15, kq = lane >> 4, r0 = c * 128 + wave * 16;
            f32x4m acc0 = {0.f, 0.f, 0.f, 0.f}, acc1 = acc0, acc2 = acc0;
            const float* xrow = x + (size_t)(r0 + i16) * DM + 4 * kq;
#pragma unroll 4
            for (int k0 = 0; k0 < DM; k0 += 16) {
                const f32x4 xv = *(const GAS f32x4*)(xrow + k0); const f32x4 sv = *(const LAS f32x4*)(sc + k0 + 4 * kq);
                const float* wp = RTW + (size_t)(k0 + 4 * kq) * 48 + i16;
#pragma unroll
                for (int j = 0; j < 4; ++j) { const float av = xv[j] * sv[j];
                    acc0 = __builtin_amdgcn_mfma_f32_16x16x4f32(av, wp[j * 48], acc0, 0, 0, 0);
                    acc1 = __builtin_amdgcn_mfma_f32_16x16x4f32(av, wp[j * 48 + 16], acc1, 0, 0, 0);
                    acc2 = __builtin_amdgcn_mfma_f32_16x16x4f32(av, wp[j * 48 + 32], acc2, 0, 0, 0); }
            }
            __syncthreads();
            LAS float* lw = lg + wave * 16 * 48;
#pragma unroll
            for (int r = 0; r < 4; ++r) { const int rr = 4 * kq + r; const float rs = rstd_s[wave * 16 + rr];
                lw[rr * 48 + i16] = acc0[r] * rs + cvec[i16]; lw[rr * 48 + 16 + i16] = acc1[r] * rs + cvec[16 + i16]; lw[rr * 48 + 32 + i16] = acc2[r] * rs + cvec[32 + i16]; }
            LDS_WAIT(); asm volatile("" ::: "memory");
            if (lane < 16) {
                const LAS float* lr = lw + lane * 48; const int row = r0 + lane;
                float g0 = lr[0], g1 = lr[1], g2 = lr[2], g3 = lr[3]; const float gm = fmaxf(fmaxf(g0, g1), fmaxf(g2, g3));
                float p0 = __expf(g0 - gm), p1 = __expf(g1 - gm), p2 = __expf(g2 - gm), p3 = __expf(g3 - gm); const float inv = 1.f / (p0 + p1 + p2 + p3);
                p0 *= inv; p1 *= inv; p2 *= inv; p3 *= inv;
                int gi = 0; float gp = p0; if (p1 > gp) { gp = p1; gi = 1; } if (p2 > gp) { gp = p2; gi = 2; } if (p3 > gp) { gp = p3; gi = 3; }
                float ev0 = -3.4e38f, ev1 = -3.4e38f; int e0 = 0, e1 = 0;
#pragma unroll
                for (int j = 0; j < 8; ++j) { const float s = lr[4 + gi * 8 + j]; if (s > ev0) { ev1 = ev0; e1 = e0; ev0 = s; e0 = j; } else if (s > ev1) { ev1 = s; e1 = j; } }
                const float q = __expf(ev1 - ev0), w0 = gp / (1.f + q), w1 = gp * q / (1.f + q);
                e0 += gi * 8; e1 += gi * 8;
                TOKE[2 * row] = e0; TOKE[2 * row + 1] = e1; TOKW[2 * row] = w0; TOKW[2 * row + 1] = w1;
                const int a0 = 2 * (wave * 16 + lane);
                asg_e[a0] = e0; asg_e[a0 + 1] = e1; asg_lp[a0] = atomicAdd((int*)&hist[e0], 1); asg_lp[a0 + 1] = atomicAdd((int*)&hist[e1], 1);
            }
        }
        __syncthreads();
        if (tid < 32) { const int h = hist[tid]; basev[tid] = h ? (int)atomicAdd(CNT + tid, (unsigned)h) : 0; }
        __syncthreads();
        if (tid < 256) { const int e = asg_e[tid]; LIST[(size_t)e * 65536 + basev[e] + asg_lp[tid]] = (c * 128) * 2 + tid; }
    }
}
__device__ __forceinline__ void build_ptab(const unsigned* CNT, LAS int* ptab, LAS int* pst, LAS int* cnt, int tid) {
    __syncthreads();
    if (tid == 0) { int np = 0;
        for (int e = 0; e < NEXP; ++e) { const int ce = (int)__hip_atomic_load(CNT + e, RLX_AGENT); cnt[e] = ce; pst[e] = np * 256; const int pe = (ce + 255) >> 8;
            for (int p = 0; p < pe; ++p) ptab[1 + np + p] = e;
            np += pe; }
        ptab[0] = np; }
    __syncthreads();
}
__device__ __forceinline__ void phase_gather(KArgsP a, LAS unsigned char* lds, int tid, int lane, int wave, int vcu, int G, int l) {
    unsigned char* ws = a->ws;
    LAS int* ptab = (LAS int*)lds; LAS int* pst = ptab + 512; LAS int* cnt = pst + 32;
    build_ptab((const unsigned*)(ws + WS_CTL) + CW_CNT + l * 32, ptab, pst, cnt, tid);
    const bf16* HN = (const bf16*)(ws + WS_HN); bf16* XG = (bf16*)(ws + WS_XG); int* ROWMAP = (int*)(ws + WS_ROWMAP); const int* LIST = (const int*)(ws + WS_LIST);
    const int nrows = ptab[0] * 256;
    for (int row0 = (vcu * NWAVES + wave) * 8; row0 < nrows; row0 += G * NWAVES * 8) {
        int tok2[8]; v4u p0[8], p1[8];
#pragma unroll
        for (int j = 0; j < 8; ++j) { const int row = row0 + j, e = ptab[1 + (row >> 8)], pos = row - pst[e]; tok2[j] = (pos < cnt[e]) ? LIST[(size_t)e * 65536 + pos] : -1; }
#pragma unroll
        for (int j = 0; j < 8; ++j) { if (tok2[j] >= 0) { const GAS v4u* s = (const GAS v4u*)(HN + (size_t)(tok2[j] >> 1) * DM) + lane; p0[j] = s[0]; p1[j] = s[64]; } else { p0[j] = (v4u){0u, 0u, 0u, 0u}; p1[j] = p0[j]; } }
#pragma unroll
        for (int j = 0; j < 8; ++j) { GAS v4u* d = (GAS v4u*)(XG + (size_t)(row0 + j) * DM) + lane; d[0] = p0[j]; d[64] = p1[j]; if (lane == 0) ROWMAP[row0 + j] = tok2[j]; }
    }
}

__device__ __forceinline__ void phase_rowmap(KArgsP a, LAS unsigned char* lds, int tid, int vcu, int G, int l) {
    unsigned char* ws = a->ws;
    LAS int* ptab = (LAS int*)lds; LAS int* pst = ptab + 512; LAS int* cnt = pst + 32;
    build_ptab((const unsigned*)(ws + WS_CTL) + CW_CNT + l * 32, ptab, pst, cnt, tid);
    int* ROWMAP = (int*)(ws + WS_ROWMAP); const int* LIST = (const int*)(ws + WS_LIST);
    const int nrows = ptab[0] * 256;
    for (int row = vcu * NTHR + tid; row < nrows; row += G * NTHR) { const int e = ptab[1 + (row >> 8)], pos = row - pst[e]; ROWMAP[row] = (pos < cnt[e]) ? LIST[(size_t)e * 65536 + pos] : -1; }
}

typedef short bf16x8 __attribute__((ext_vector_type(8)));
constexpr int MT = 72;
constexpr int ML_XP = 0;
constexpr int ML_CX = 17152;
constexpr int ML_WQ = ML_CX + 9216, ML_WK = ML_WQ + 9216;
constexpr int ML_Q = ML_WK + 9216, ML_K = ML_Q + 9216;
constexpr int ML_S = ML_K + 9216;
constexpr int ML_VT = ML_S + 9216;
constexpr int ML_CT = ML_VT + 11520;
constexpr int ML_H = ML_CT + 11520;
constexpr int ML_SM = ML_H + 16640;
static_assert(ML_SM + 2048 <= RING_BYTES, "mLSTM LDS map");
__device__ __forceinline__ float logsigmoidf_(float x) { return fminf(x, 0.f) - log1pf(__expf(-fabsf(x))); }
__device__ __forceinline__ void mma64(const LAS bf16* A, int arow0, const LAS bf16* Bt, int brow0, int lane, f32x4& acc) {
    const LAS bf16* ap = A + (arow0 + (lane & 15)) * MT + 8 * (lane >> 4); const LAS bf16* bp = Bt + (brow0 + (lane & 15)) * MT + 8 * (lane >> 4);
    const bf16x8 a0 = *(const LAS bf16x8*)ap, a1 = *(const LAS bf16x8*)(ap + 32), b0 = *(const LAS bf16x8*)bp, b1 = *(const LAS bf16x8*)(bp + 32);
    acc = __builtin_amdgcn_mfma_f32_16x16x32_bf16(a0, b0, acc, 0, 0, 0); acc = __builtin_amdgcn_mfma_f32_16x16x32_bf16(a1, b1, acc, 0, 0, 0);
}
__device__ __forceinline__ void ml_front(KArgsP a, LAS unsigned char* lds, int tid, int l, int b, int c, int h, bool want_q) {
    const bf16* PROJ = (const bf16*)(a->ws + WS_PROJ); const size_t row0 = (size_t)b * SEQ + c * 64;
    LAS float* xp = (LAS float*)(lds + ML_XP);
    for (int idx = tid; idx < 67 * 8; idx += NTHR) { const int r = idx >> 3, c8 = idx & 7, tr = c * 64 + r - 3; LAS float* d = xp + r * 64 + c8 * 8;
        if (tr >= 0) { const v4u p = *(const GAS v4u*)(PROJ + ((size_t)b * SEQ + tr) * NPROJ + PC_QK + h * 64 + c8 * 8);
            *(LAS f32x4*)d = (f32x4){bflo(p.x), bfhi(p.x), bflo(p.y), bfhi(p.y)}; *(LAS f32x4*)(d + 4) = (f32x4){bflo(p.z), bfhi(p.z), bflo(p.w), bfhi(p.w)}; }
        else { *(LAS f32x4*)d = (f32x4){0.f, 0.f, 0.f, 0.f}; *(LAS f32x4*)(d + 4) = (f32x4){0.f, 0.f, 0.f, 0.f}; } }
    {
        const int t = tid >> 3, vg = tid & 7; LAS bf16* VT = (LAS bf16*)(lds + ML_VT);
        const v4u p = *(const GAS v4u*)(PROJ + (row0 + t) * NPROJ + PC_V + h * 64 + vg * 8);
        const unsigned w[4] = {p.x, p.y, p.z, p.w};
#pragma unroll
        for (int j = 0; j < 4; ++j) { VT[(vg * 8 + 2 * j) * MT + t] = (bf16)(w[j] & 0xffffu); VT[(vg * 8 + 2 * j + 1) * MT + t] = (bf16)(w[j] >> 16); }
        for (int idx = tid; idx < 16 * 64; idx += NTHR) VT[(64 + (idx >> 6)) * MT + (idx & 63)] = (idx < 64) ? (bf16)0x3F80 : (bf16)0;
        const bf16* WT = (const bf16*)(a->ws + WS_MLW) + (size_t)((l * NH + h) * 2) * 4096;
        const int e = tid >> 3, d8 = tid & 7;
        if (want_q) *(LAS v4u*)(lds + ML_WQ + (e * MT + d8 * 8) * 2) = *(const GAS v4u*)(WT + e * 64 + d8 * 8);
        *(LAS v4u*)(lds + ML_WK + (e * MT + d8 * 8) * 2) = *(const GAS v4u*)(WT + 4096 + e * 64 + d8 * 8);
    }
    __syncthreads();
    const float* cw = a->in[I_CONV_W] + (size_t)l * 4 * DA + h * 64; const float* cb = a->in[I_CONV_B] + (size_t)l * DA + h * 64;
    {
        const int t = tid >> 3, c8 = (tid & 7) * 8; float s[8];
#pragma unroll
        for (int j = 0; j < 8; ++j) s[j] = cb[c8 + j];
#pragma unroll
        for (int q = 0; q < 4; ++q) { const f32x4 x0 = *(const LAS f32x4*)(xp + (t + q) * 64 + c8), x1 = *(const LAS f32x4*)(xp + (t + q) * 64 + c8 + 4); const float* w = cw + q * DA + c8;
            s[0] += x0.x * w[0]; s[1] += x0.y * w[1]; s[2] += x0.z * w[2]; s[3] += x0.w * w[3]; s[4] += x1.x * w[4]; s[5] += x1.y * w[5]; s[6] += x1.z * w[6]; s[7] += x1.w * w[7]; }
#pragma unroll
        for (int j = 0; j < 8; ++j) s[j] = s[j] / (1.f + __expf(-s[j]));
        v4u o; o.x = pk2(s[0], s[1]); o.y = pk2(s[2], s[3]); o.z = pk2(s[4], s[5]); o.w = pk2(s[6], s[7]);
        *(LAS v4u*)(lds + ML_CX + (t * MT + c8) * 2) = o;
    }
}
__device__ __forceinline__ void phase_m1(KArgsP a, LAS unsigned char* lds, int tid, int lane, int wave, int vcu, int G, int l) {
    unsigned char* ws = a->ws; const float* GT = (const float*)(ws + WS_GATES);
    float* CLOC = (float*)(ws + WS_CLOC); float* MLG = (float*)(ws + WS_MSC); float* MLM = MLG + 4096;
    LAS float* sm = (LAS float*)(lds + ML_SM);
    for (int u = vcu; u < NUNIT_M; u += G) {
        const int h = u % NH, c = (u / NH) % NCH, b = u / (NH * NCH); const size_t row0 = (size_t)b * SEQ + c * 64;
        __syncthreads();
        ml_front(a, lds, tid, l, b, c, h, false);
        if (wave == 0) {
            const float ig = GT[(row0 + lane) * 16 + h] + a->in[I_BI][l * NH + h];
            const float fl = logsigmoidf_(GT[(row0 + lane) * 16 + 6 + h] + a->in[I_BF][l * NH + h]);
            float bc = fl;
#pragma unroll
            for (int o = 1; o < 64; o <<= 1) { const float t = __shfl_up(bc, o); if (lane >= o) bc += t; }
            const float gtot = __shfl(bc, 63); const float lw = gtot - bc + ig; const float ml = wave_max(lw);
            sm[lane] = __expf(lw - ml);
            if (lane == 0) { MLG[u] = gtot; MLM[u] = ml; }
        }
        __syncthreads();
        {
            const int rt = wave >> 1; LAS bf16* KT = (LAS bf16*)(lds + ML_K);
#pragma unroll
            for (int q = 0; q < 2; ++q) { const int ct = 2 * (wave & 1) + q; f32x4 acc = {0.f, 0.f, 0.f, 0.f};
                mma64((const LAS bf16*)(lds + ML_CX), 16 * rt, (const LAS bf16*)(lds + ML_WK), 16 * ct, lane, acc);
                const int t0 = 16 * rt + 4 * (lane >> 4), e = 16 * ct + (lane & 15);
                const float w0 = sm[t0] * 0.125f, w1 = sm[t0 + 1] * 0.125f, w2 = sm[t0 + 2] * 0.125f, w3 = sm[t0 + 3] * 0.125f;
                v2u o; o.x = pk2(acc[0] * w0, acc[1] * w1); o.y = pk2(acc[2] * w2, acc[3] * w3);
                *(LAS v2u*)(KT + e * MT + t0) = o; }
        }
        __syncthreads();
        {
            const int ct = wave & 3, r_lo = wave < 4 ? 0 : 3, r_hi = wave < 4 ? 3 : 5; float* cl = CLOC + (size_t)u * CL_STRIDE;
            for (int rt = r_lo; rt < r_hi; ++rt) { f32x4 acc = {0.f, 0.f, 0.f, 0.f};
                mma64((const LAS bf16*)(lds + ML_VT), 16 * rt, (const LAS bf16*)(lds + ML_K), 16 * ct, lane, acc);
                const int v0 = 16 * rt + 4 * (lane >> 4), e = 16 * ct + (lane & 15);
                if (rt < 4) {
#pragma unroll
                    for (int r = 0; r < 4; ++r) cl[(v0 + r) * 64 + e] = acc[r];
                } else if ((lane >> 4) == 0) cl[4096 + e] = acc[0]; }
        }
    }
}
__device__ __forceinline__ void phase_m2(unsigned char* ws, int tid, int wg, int nwg) {
    float* CLOC = (float*)(ws + WS_CLOC); const float* MLG = (const float*)(ws + WS_MSC); const float* MLM = MLG + 4096; float* MST = (float*)(ws + WS_MSC) + 8192;
    for (int idx = wg * NTHR + tid; idx < NB * NH * CL_STRIDE; idx += nwg * NTHR) {
        const int e = idx % CL_STRIDE, bh = idx / CL_STRIDE, b = bh / NH, h = bh % NH;
        float m = 0.f, cs = 0.f;
        for (int c0 = 0; c0 < NCH; c0 += 8) {
            float cl[8], g[8], ml[8];
#pragma unroll
            for (int j = 0; j < 8; ++j) { const int u = (b * NCH + c0 + j) * NH + h; cl[j] = CLOC[(size_t)u * CL_STRIDE + e]; g[j] = MLG[u]; ml[j] = MLM[u]; }
#pragma unroll
            for (int j = 0; j < 8; ++j) { const int u = (b * NCH + c0 + j) * NH + h;
                CLOC[(size_t)u * CL_STRIDE + e] = cs; if (e == 0) MST[u] = m;
                const float mn = fmaxf(g[j] + m, ml[j]); const float ao = __expf(g[j] + m - mn), al = __expf(ml[j] - mn);
                cs = ao * cs + al * cl[j]; m = mn; }
        }
    }
}
__device__ __forceinline__ void phase_m3(KArgsP a, LAS unsigned char* lds, int tid, int lane, int wave, int vcu, int G, int l) {
    unsigned char* ws = a->ws; const bf16* PROJ = (const bf16*)(ws + WS_PROJ); const float* GT = (const float*)(ws + WS_GATES);
    const float* CLOC = (const float*)(ws + WS_CLOC); const float* MST = (const float*)(ws + WS_MSC) + 8192; bf16* YC = (bf16*)(ws + WS_YC);
    LAS float* sm = (LAS float*)(lds + ML_SM); LAS float* hb = (LAS float*)(lds + ML_H);
    for (int u = vcu; u < NUNIT_M; u += G) {
        const int h = u % NH, c = (u / NH) % NCH, b = u / (NH * NCH); const size_t row0 = (size_t)b * SEQ + c * 64;
        __syncthreads();
        ml_front(a, lds, tid, l, b, c, h, true);
        {
            const float* cl = CLOC + (size_t)u * CL_STRIDE; LAS bf16* CT = (LAS bf16*)(lds + ML_CT);
            for (int idx = tid; idx < 65 * 16; idx += NTHR) { const int r = idx >> 4, c4 = idx & 15; const f32x4 v = *(const GAS f32x4*)(cl + r * 64 + c4 * 4);
                v2u o; o.x = pk2(v.x, v.y); o.y = pk2(v.z, v.w); *(LAS v2u*)(CT + r * MT + c4 * 4) = o; }
            for (int idx = tid; idx < 15 * 64; idx += NTHR) CT[(65 + (idx >> 6)) * MT + (idx & 63)] = 0;
        }
        if (wave == 0) {
            const float ig = GT[(row0 + lane) * 16 + h] + a->in[I_BI][l * NH + h];
            const float fl = logsigmoidf_(GT[(row0 + lane) * 16 + 6 + h] + a->in[I_BF][l * NH + h]);
            float bc = fl;
#pragma unroll
            for (int o = 1; o < 64; o <<= 1) { const float t = __shfl_up(bc, o); if (lane >= o) bc += t; }
            float pm = ig - bc;
#pragma unroll
            for (int o = 1; o < 64; o <<= 1) { const float t = __shfl_up(pm, o); if (lane >= o) pm = fmaxf(pm, t); }
            const float mst = MST[u]; const float inter = bc + mst, mt = fmaxf(inter, bc + pm);
            sm[lane] = ig - bc; sm[64 + lane] = bc - mt; sm[128 + lane] = __expf(inter - mt); sm[192 + lane] = __expf(-mt);
        }
        __syncthreads();
        {
            const int rt = wave >> 1; LAS bf16* Qs = (LAS bf16*)(lds + ML_Q); LAS bf16* Ks = (LAS bf16*)(lds + ML_K);
#pragma unroll
            for (int q = 0; q < 2; ++q) { const int ct = 2 * (wave & 1) + q; f32x4 aq = {0.f, 0.f, 0.f, 0.f}, ak = {0.f, 0.f, 0.f, 0.f};
                mma64((const LAS bf16*)(lds + ML_CX), 16 * rt, (const LAS bf16*)(lds + ML_WQ), 16 * ct, lane, aq);
                mma64((const LAS bf16*)(lds + ML_CX), 16 * rt, (const LAS bf16*)(lds + ML_WK), 16 * ct, lane, ak);
                const int t0 = 16 * rt + 4 * (lane >> 4), e = 16 * ct + (lane & 15);
#pragma unroll
                for (int r = 0; r < 4; ++r) { Qs[(t0 + r) * MT + e] = (bf16)f2bf(aq[r]); Ks[(t0 + r) * MT + e] = (bf16)f2bf(ak[r] * 0.125f); } }
        }
        __syncthreads();
        {
            const int rt = wave >> 1; LAS bf16* Ss = (LAS bf16*)(lds + ML_S);
#pragma unroll
            for (int q = 0; q < 2; ++q) { const int ct = 2 * (wave & 1) + q; f32x4 acc = {0.f, 0.f, 0.f, 0.f};
                if (ct <= rt) mma64((const LAS bf16*)(lds + ML_Q), 16 * rt, (const LAS bf16*)(lds + ML_K), 16 * ct, lane, acc);
                const int t0 = 16 * rt + 4 * (lane >> 4), s = 16 * ct + (lane & 15); const float qs = sm[s];
#pragma unroll
                for (int r = 0; r < 4; ++r) { const int t = t0 + r; Ss[t * MT + s] = (bf16)f2bf((s <= t) ? acc[r] * __expf(sm[64 + t] + qs) : 0.f); } }
        }
        __syncthreads();
        {
            const int rt = wave >> 1, nt = (wave & 1) ? 2 : 3;
            for (int q = 0; q < nt; ++q) { const int ct = (wave & 1) ? 2 + q : (q < 2 ? q : 4); f32x4 aA = {0.f, 0.f, 0.f, 0.f}, aB = {0.f, 0.f, 0.f, 0.f};
                mma64((const LAS bf16*)(lds + ML_Q), 16 * rt, (const LAS bf16*)(lds + ML_CT), 16 * ct, lane, aA);
                mma64((const LAS bf16*)(lds + ML_S), 16 * rt, (const LAS bf16*)(lds + ML_VT), 16 * ct, lane, aB);
                const int t0 = 16 * rt + 4 * (lane >> 4), v = 16 * ct + (lane & 15);
#pragma unroll
                for (int r = 0; r < 4; ++r) { const int t = t0 + r; const float x = sm[128 + t] * aA[r] + aB[r];
                    if (ct < 4) hb[t * 65 + v] = x; else if ((lane & 15) == 0) sm[256 + t] = x; } }
        }
        __syncthreads();
        {
            const int t = tid >> 3, vg = tid & 7; float acc[8];
            const float dn = 1.f / fmaxf(fabsf(sm[256 + t]), sm[192 + t]);
            float s1 = 0.f;
#pragma unroll
            for (int j = 0; j < 8; ++j) { acc[j] = hb[t * 65 + vg * 8 + j] * dn; s1 += acc[j]; }
            s1 += __shfl_xor(s1, 1); s1 += __shfl_xor(s1, 2); s1 += __shfl_xor(s1, 4);
            const float mu = s1 * (1.f / 64.f); float s2 = 0.f;
#pragma unroll
            for (int j = 0; j < 8; ++j) { acc[j] -= mu; s2 += acc[j] * acc[j]; }
            s2 += __shfl_xor(s2, 1); s2 += __shfl_xor(s2, 2); s2 += __shfl_xor(s2, 4);
            const float rs = rsqrtf(s2 * (1.f / 64.f) + HEAD_NORM_EPS);
            const float* nw = a->in[I_MNORM_W] + (size_t)l * DA + h * 64 + vg * 8;
            const v4u ov = *(const GAS v4u*)(PROJ + (row0 + t) * NPROJ + PC_O + h * 64 + vg * 8);
            const float o[8] = {bflo(ov.x), bfhi(ov.x), bflo(ov.y), bfhi(ov.y), bflo(ov.z), bfhi(ov.z), bflo(ov.w), bfhi(ov.w)};
            float r[8];
#pragma unroll
            for (int j = 0; j < 8; ++j) r[j] = acc[j] * rs * nw[j] * sigmoidf_(o[j]);
            v4u w; w.x = pk2(r[0], r[1]); w.y = pk2(r[2], r[3]); w.z = pk2(r[4], r[5]); w.w = pk2(r[6], r[7]);
            *(GAS v4u*)(YC + (row0 + t) * DM + h * 64 + vg * 8) = w;
        }
    }
}

constexpr int S5_UT = 264, S5_XT = 2056;
constexpr int S5_U = 0, S5_Z = 33792, S5_X = 67584;
static_assert(S5_X + 16 * S5_XT * 2 <= MISC_OFF, "S5 LDS map");
struct S5A { float are, aim, cre, cim; };
__device__ __forceinline__ S5A s5_a(KArgsP a, int l, int g, int p) {
    const float lam_re = a->in[I_S5ARE][(size_t)(l * 16 + g) * 64 + p], lam_im = a->in[I_S5AIM][(size_t)(l * 16 + g) * 64 + p];
    const float dt = expf(a->in[I_S5LDT][l * 16 + g]); const float mag = expf(lam_re * dt), ang = lam_im * dt;
    S5A r; r.are = mag * cosf(ang); r.aim = mag * sinf(ang);
    const float inv = 1.f / (lam_re * lam_re + lam_im * lam_im);
    r.cre = ((r.are - 1.f) * lam_re + r.aim * lam_im) * inv; r.cim = (r.aim * lam_re - (r.are - 1.f) * lam_im) * inv; return r;
}
__device__ __forceinline__ bf16x8 pack8(const float* v) { v4u o; o.x = pk2(v[0], v[1]); o.y = pk2(v[2], v[3]); o.z = pk2(v[4], v[5]); o.w = pk2(v[6], v[7]); return __builtin_bit_cast(bf16x8, o); }
__device__ __forceinline__ void s5_bfrag(const unsigned char* ws, int l, int g, int lane, bf16x8 (&bf)[8]) {
    const bf16* BB = (const bf16*)(ws + WS_S5BB) + (size_t)(l * 16 + g) * 128 * 16;
#pragma unroll
    for (int j = 0; j < 8; ++j) { v4u o = {0u, 0u, 0u, 0u}; if ((lane >> 4) < 2) o = *(const GAS v4u*)(BB + (16 * j + (lane & 15)) * 16 + 8 * (lane >> 4)); bf[j] = __builtin_bit_cast(bf16x8, o); }
}
__device__ __forceinline__ f32x2 s5_ap(const unsigned char* ws, int l, int g, int p) { return *(const GAS f32x2*)((const float*)(ws + WS_S5AP) + ((size_t)(l * 16 + g) * 64 + p) * 2); }
__device__ __forceinline__ void s5_load_u(const unsigned char* ws, LAS unsigned char* lds, int tid, size_t row0) {
    const bf16* PROJ = (const bf16*)(ws + WS_PROJ);
    for (int idx = tid; idx < 64 * 32; idx += NTHR) { const int t = idx >> 5, c8 = idx & 31;
        *(LAS v4u*)(lds + S5_U + (t * S5_UT + c8 * 8) * 2) = *(const GAS v4u*)(PROJ + (row0 + t) * NPROJ + PC_S5 + c8 * 8); }
}
__device__ __forceinline__ void s5_block(LAS unsigned char* lds, int lane, int tb, int g, const bf16x8 (&bf)[8], float are, float aim, float& xr, float& xi) {
    const int kq = lane >> 4; bf16x8 uf = {0, 0, 0, 0, 0, 0, 0, 0};
    if (kq < 2) uf = *(const LAS bf16x8*)(lds + S5_U + ((16 * tb + (lane & 15)) * S5_UT + g * 16 + 8 * kq) * 2);
    LAS bf16* X = (LAS bf16*)(lds + S5_X);
#pragma unroll
    for (int j = 0; j < 8; ++j) { f32x4 acc = {0.f, 0.f, 0.f, 0.f}; acc = __builtin_amdgcn_mfma_f32_16x16x32_bf16(bf[j], uf, acc, 0, 0, 0);
        v2u o; o.x = pk2(acc[0], acc[1]); o.y = pk2(acc[2], acc[3]); *(LAS v2u*)(X + (lane & 15) * S5_XT + g * 128 + 16 * j + 4 * kq) = o; }
    LDS_WAIT(); asm volatile("" ::: "memory");
    LAS unsigned* xw = (LAS unsigned*)(lds + S5_X) + (g * 128 + 2 * lane) / 2;
    unsigned wv[16];
#pragma unroll
    for (int t = 0; t < 16; ++t) wv[t] = xw[t * (S5_XT / 2)];
#pragma unroll
    for (int t = 0; t < 16; ++t) { const float br = bflo(wv[t]), bi = bfhi(wv[t]);
        const float nr = are * xr - aim * xi + br, ni = are * xi + aim * xr + bi; xr = nr; xi = ni;
        wv[t] = pk2(xr, xi); }
#pragma unroll
    for (int t = 0; t < 16; ++t) xw[t * (S5_XT / 2)] = wv[t];
    LDS_WAIT(); asm volatile("" ::: "memory");
}
__device__ __forceinline__ void phase_s1(KArgsP a, LAS unsigned char* lds, int tid, int lane, int wave, int vcu, int G, int l) {
    unsigned char* ws = a->ws; float* ST = (float*)(ws + WS_S5ST);
    bf16x8 bf0[8], bf1[8]; s5_bfrag(ws, l, wave, lane, bf0); s5_bfrag(ws, l, wave + 8, lane, bf1);
    struct { float are, aim; } A0, A1; { const f32x2 q0 = s5_ap(ws, l, wave, lane), q1 = s5_ap(ws, l, wave + 8, lane); A0.are = q0.x; A0.aim = q0.y; A1.are = q1.x; A1.aim = q1.y; }
    for (int u = vcu; u < NB * NCH; u += G) {
        const size_t row0 = (size_t)u * 64;
        __syncthreads();
        s5_load_u(ws, lds, tid, row0);
        __syncthreads();
        float x0r = 0.f, x0i = 0.f, x1r = 0.f, x1i = 0.f;
        for (int tb = 0; tb < 4; ++tb) { s5_block(lds, lane, tb, wave, bf0, A0.are, A0.aim, x0r, x0i); s5_block(lds, lane, tb, wave + 8, bf1, A1.are, A1.aim, x1r, x1i); }
        *(f32x2*)(ST + (((size_t)u * 16 + wave) * 64 + lane) * 2) = (f32x2){x0r, x0i};
        *(f32x2*)(ST + (((size_t)u * 16 + wave + 8) * 64 + lane) * 2) = (f32x2){x1r, x1i};
    }
}
__device__ __forceinline__ void phase_s2(KArgsP a, int tid, int wg, int nwg, int l) {
    float* ST = (float*)(a->ws + WS_S5ST);
    for (int idx = wg * NTHR + tid; idx < NB * 1024; idx += nwg * NTHR) {
        const int b = idx >> 10, gp = idx & 1023, g = gp >> 6, p = gp & 63;
        const f32x2 A = s5_ap(a->ws, l, g, p); float ar = A.x, ai = A.y;
#pragma unroll
        for (int s = 0; s < 6; ++s) { const float nr = ar * ar - ai * ai, ni = 2.f * ar * ai; ar = nr; ai = ni; }
        float cr = 0.f, ci = 0.f;
        for (int c0 = 0; c0 < NCH; c0 += 8) {
            f32x2 e[8];
#pragma unroll
            for (int j = 0; j < 8; ++j) e[j] = *(const f32x2*)(ST + (((size_t)(b * NCH + c0 + j) * 16 + g) * 64 + p) * 2);
#pragma unroll
            for (int j = 0; j < 8; ++j) { *(f32x2*)(ST + (((size_t)(b * NCH + c0 + j) * 16 + g) * 64 + p) * 2) = (f32x2){cr, ci};
                const float nr = ar * cr - ai * ci + e[j].x, ni = ar * ci + ai * cr + e[j].y; cr = nr; ci = ni; }
        }
    }
}
__device__ __forceinline__ float tanh_fast(float x) { return 1.f - 2.f / (1.f + __expf(2.f * x)); }
__device__ __forceinline__ float gelu_tanh_(float x) { const float t = tanh_fast(0.7978845608f * (x + 0.044715f * x * x * x)); return 0.5f * x * (1.f + t); }
__device__ __forceinline__ void s5_cload(const bf16* cmt  , int lane, bf16x8 (&cf)[4]) {
#pragma unroll
    for (int s = 0; s < 4; ++s) cf[s] = __builtin_bit_cast(bf16x8, *(const GAS v4u*)(cmt + (lane & 15) * 128 + 32 * s + 8 * (lane >> 4)));
}
__device__ __forceinline__ void s5_cproj(LAS unsigned char* lds, int lane, int tb, int g, const bf16x8 (&cf)[4], const float (&dv)[4]) {
    const int kq = lane >> 4; f32x4 acc = {0.f, 0.f, 0.f, 0.f};
    const LAS bf16* xp = (const LAS bf16*)(lds + S5_X) + (lane & 15) * S5_XT + g * 128 + 8 * kq;
#pragma unroll
    for (int s = 0; s < 4; ++s) acc = __builtin_amdgcn_mfma_f32_16x16x32_bf16(cf[s], *(const LAS bf16x8*)(xp + 32 * s), acc, 0, 0, 0);
    const int t = 16 * tb + (lane & 15), c0 = g * 16 + 4 * kq;
    const v2u uw = *(const LAS v2u*)(lds + S5_U + (t * S5_UT + c0) * 2);
    const float u4[4] = {bflo(uw.x), bfhi(uw.x), bflo(uw.y), bfhi(uw.y)}; float z[4];
#pragma unroll
    for (int r = 0; r < 4; ++r) z[r] = gelu_tanh_(acc[r] + dv[r] * u4[r]);
    v2u o; o.x = pk2(z[0], z[1]); o.y = pk2(z[2], z[3]); *(LAS v2u*)(lds + S5_Z + (t * S5_UT + c0) * 2) = o;
}
__device__ __forceinline__ void phase_s3(KArgsP a, LAS unsigned char* lds, int tid, int lane, int wave, int vcu, int G, int l, unsigned* qctr = nullptr) {
    unsigned char* ws = a->ws; const float* ST = (const float*)(ws + WS_S5ST); bf16* YC = (bf16*)(ws + WS_YC);
    const bf16* GLUT = (const bf16*)(ws + WS_GLUT) + (size_t)l * DC * DC;
    bf16x8 bf0[8], bf1[8]; s5_bfrag(ws, l, wave, lane, bf0); s5_bfrag(ws, l, wave + 8, lane, bf1);
    const bf16* cm0 = (const bf16*)(ws + WS_S5CM) + (size_t)(l * 16 + wave) * 2048; const bf16* cm1 = cm0 + 8 * 2048;
    struct { float are, aim; } A0, A1; { const f32x2 q0 = s5_ap(ws, l, wave, lane), q1 = s5_ap(ws, l, wave + 8, lane); A0.are = q0.x; A0.aim = q0.y; A1.are = q1.x; A1.aim = q1.y; }
    float d0[4], d1[4];
#pragma unroll
    for (int r = 0; r < 4; ++r) { d0[r] = a->in[I_S5D][l * DC + wave * 16 + 4 * (lane >> 4) + r]; d1[r] = a->in[I_S5D][l * DC + (wave + 8) * 16 + 4 * (lane >> 4) + r]; }
    volatile LAS unsigned* qw = (volatile LAS unsigned*)(lds + MISC_OFF) + 20;
    for (int u = vcu; ; u += G) {
        if (qctr) { __syncthreads(); if (tid == 0) *qw = __hip_atomic_fetch_add(qctr, 1u, __ATOMIC_RELAXED, __HIP_MEMORY_SCOPE_AGENT); __syncthreads(); u = (int)*qw; }
        if (u >= NB * NCH) break;
        const size_t row0 = (size_t)u * 64;
        __syncthreads();
        s5_load_u(ws, lds, tid, row0);
        const f32x2 s0 = *(const f32x2*)(ST + (((size_t)u * 16 + wave) * 64 + lane) * 2), s1 = *(const f32x2*)(ST + (((size_t)u * 16 + wave + 8) * 64 + lane) * 2);
        float x0r = s0.x, x0i = s0.y, x1r = s1.x, x1i = s1.y;
        __syncthreads();
        for (int tb = 0; tb < 4; ++tb) {
            { bf16x8 cf[4]; s5_cload(cm0, lane, cf); s5_block(lds, lane, tb, wave, bf0, A0.are, A0.aim, x0r, x0i); s5_cproj(lds, lane, tb, wave, cf, d0); }
            { bf16x8 cf[4]; s5_cload(cm1, lane, cf); s5_block(lds, lane, tb, wave + 8, bf1, A1.are, A1.aim, x1r, x1i); s5_cproj(lds, lane, tb, wave + 8, cf, d1); }
        }
        __syncthreads();
        {
            const int kq = lane >> 4;
#pragma unroll
            for (int q = 0; q < 2; ++q) { const int ct = 2 * wave + q; f32x4 acc[4];
#pragma unroll
                for (int rt = 0; rt < 4; ++rt) acc[rt] = (f32x4){0.f, 0.f, 0.f, 0.f};
                const bf16* gp = GLUT + (size_t)(16 * ct + (lane & 15)) * DC + 8 * kq;
#pragma unroll 2
                for (int s = 0; s < 8; ++s) { const bf16x8 gf = __builtin_bit_cast(bf16x8, *(const GAS v4u*)(gp + 32 * s));
#pragma unroll
                    for (int rt = 0; rt < 4; ++rt) acc[rt] = __builtin_amdgcn_mfma_f32_16x16x32_bf16(gf, *(const LAS bf16x8*)(lds + S5_Z + ((16 * rt + (lane & 15)) * S5_UT + 32 * s + 8 * kq) * 2), acc[rt], 0, 0, 0); }
                const int j0 = 16 * ct + 4 * kq; const f32x4 gb = *(const GAS f32x4*)(a->in[I_S5GLUB] + l * DC + j0);
#pragma unroll
                for (int rt = 0; rt < 4; ++rt) { const int t = 16 * rt + (lane & 15); const v2u zw = *(const LAS v2u*)(lds + S5_Z + (t * S5_UT + j0) * 2);
                    const float z0 = bflo(zw.x), z1 = bfhi(zw.x), z2 = bflo(zw.y), z3 = bfhi(zw.y);
                    v2u o; o.x = pk2(z0 * sigmoidf_(acc[rt][0] + gb.x), z1 * sigmoidf_(acc[rt][1] + gb.y)); o.y = pk2(z2 * sigmoidf_(acc[rt][2] + gb.z), z3 * sigmoidf_(acc[rt][3] + gb.w));
                    *(GAS v2u*)(YC + (row0 + t) * DM + 768 + j0) = o; } }
        }
    }
}

__device__ __forceinline__ float rw_shift(const bf16* PROJ, const float* mu, size_t row, int col) {
    const float cur = bf2f(PROJ[row * NPROJ + PC_RW + col]); const float prv = (row % SEQ) ? bf2f(PROJ[(row - 1) * NPROJ + PC_RW + col]) : 0.f;
    return cur + mu[col] * (prv - cur);
}
constexpr int R1_TH = 0, R1_AD = 9216, R1_SG = 18432, R1_VS = 35840, R1_TMP = 86016;
template <int KS, int MODE>
__device__ __forceinline__ void r1_prod(const bf16* WT, const LAS bf16* act, int astride, const float* bias, bf16* OUT, size_t row0, int lane, int wave) {
    const int kq = lane >> 4, n0 = 48 * wave; constexpr int K = 32 * KS;
    f32x4 acc[3][4];
#pragma unroll
    for (int nt = 0; nt < 3; ++nt)
#pragma unroll
        for (int ti = 0; ti < 4; ++ti) acc[nt][ti] = (f32x4){0.f, 0.f, 0.f, 0.f};
#pragma unroll
    for (int s = 0; s < KS; ++s) { bf16x8 wf[3], af[4];
#pragma unroll
        for (int nt = 0; nt < 3; ++nt) wf[nt] = __builtin_bit_cast(bf16x8, *(const GAS v4u*)(WT + (size_t)(n0 + 16 * nt + (lane & 15)) * K + 32 * s + 8 * kq));
#pragma unroll
        for (int ti = 0; ti < 4; ++ti) af[ti] = *(const LAS bf16x8*)(act + (16 * ti + (lane & 15)) * astride + 32 * s + 8 * kq);
#pragma unroll
        for (int nt = 0; nt < 3; ++nt)
#pragma unroll
            for (int ti = 0; ti < 4; ++ti) acc[nt][ti] = __builtin_amdgcn_mfma_f32_16x16x32_bf16(wf[nt], af[ti], acc[nt][ti], 0, 0, 0); }
#pragma unroll
    for (int nt = 0; nt < 3; ++nt) { const int n = n0 + 16 * nt + 4 * kq; f32x4 bv = {0.f, 0.f, 0.f, 0.f}; if (MODE != 2) bv = *(const GAS f32x4*)(bias + n);
#pragma unroll
        for (int ti = 0; ti < 4; ++ti) { float o[4];
#pragma unroll
            for (int r = 0; r < 4; ++r) { const float x = acc[nt][ti][r] + bv[r]; o[r] = MODE == 0 ? 0.60653066f * sigmoidf_(x) : (MODE == 1 ? sigmoidf_(x) : x); }
            v2u w; w.x = pk2(o[0], o[1]); w.y = pk2(o[2], o[3]);
            *(GAS v2u*)(OUT + (row0 + 16 * ti + (lane & 15)) * DBR + n) = w; } }
}
__device__ __forceinline__ void phase_r1(KArgsP a, LAS unsigned char* lds, int tid, int lane, int wave, int vcu, int G, int l) {
    unsigned char* ws = a->ws; const bf16* PROJ = (const bf16*)(ws + WS_PROJ); const float* mu = a->in[I_RMU] + (size_t)l * RW_COLS;
    const bf16* W1 = (const bf16*)(ws + WS_R1W) + (size_t)l * 98304;
    const bf16* WV = (const bf16*)(ws + WS_R1W) + 2 * 98304;
    for (int u = vcu; u < NTOK / 64; u += G) {
        const size_t row0 = (size_t)u * 64;
        __syncthreads();
        for (int idx = tid; idx < 64 * 128; idx += NTHR) { const int tt = idx >> 7, col = 2 * (idx & 127); const size_t r = row0 + tt;
            const unsigned cw = *(const GAS unsigned*)(PROJ + r * NPROJ + PC_RW + RWC_WD + col); const unsigned pw = (r % SEQ) ? *(const GAS unsigned*)(PROJ + (r - 1) * NPROJ + PC_RW + RWC_WD + col) : 0u;
            const float c0 = bflo(cw), c1 = bfhi(cw); const float x0 = c0 + mu[RWC_WD + col] * (bflo(pw) - c0), x1 = c1 + mu[RWC_WD + col + 1] * (bfhi(pw) - c1);
            if (col < 64) *(LAS unsigned*)(lds + R1_TH + (tt * 72 + col) * 2) = pk2(tanh_fast(x0), tanh_fast(x1));
            else if (col < 128) *(LAS unsigned*)(lds + R1_AD + (tt * 72 + col - 64) * 2) = pk2(x0, x1);
            else *(LAS unsigned*)(lds + R1_SG + (tt * 136 + col - 128) * 2) = pk2(sigmoidf_(x0), sigmoidf_(x1)); }
        if (l > 0) for (int idx = tid; idx < 64 * 192; idx += NTHR) { const int tt = idx / 192, col = 2 * (idx % 192); const size_t r = row0 + tt;
            const unsigned cw = *(const GAS unsigned*)(PROJ + r * NPROJ + PC_RW + RWC_V + col); const unsigned pw = (r % SEQ) ? *(const GAS unsigned*)(PROJ + (r - 1) * NPROJ + PC_RW + RWC_V + col) : 0u;
            const float c0 = bflo(cw), c1 = bfhi(cw);
            *(LAS unsigned*)(lds + R1_VS + (tt * 392 + col) * 2) = pk2(c0 + mu[RWC_V + col] * (bflo(pw) - c0), c1 + mu[RWC_V + col + 1] * (bfhi(pw) - c1)); }
        __syncthreads();
        r1_prod<2, 0>(W1, (const LAS bf16*)(lds + R1_TH), 72, a->in[I_RW0] + l * DBR, (bf16*)(ws + WS_RE), row0, lane, wave);
        r1_prod<2, 1>(W1 + 24576, (const LAS bf16*)(lds + R1_AD), 72, a->in[I_RA0] + l * DBR, (bf16*)(ws + WS_RA), row0, lane, wave);
        r1_prod<4, 2>(W1 + 49152, (const LAS bf16*)(lds + R1_SG), 136, nullptr, (bf16*)(ws + WS_RG), row0, lane, wave);
        if (l > 0) {
            { const int kq = lane >> 4, mt = wave & 1, ti = wave >> 1; f32x4 acc = {0.f, 0.f, 0.f, 0.f};
#pragma unroll
              for (int s = 0; s < 12; ++s) acc = __builtin_amdgcn_mfma_f32_16x16x32_bf16(__builtin_bit_cast(bf16x8, *(const GAS v4u*)(WV + (size_t)(16 * mt + (lane & 15)) * 384 + 32 * s + 8 * kq)),
                                                                                          *(const LAS bf16x8*)(lds + R1_VS + ((16 * ti + (lane & 15)) * 392 + 32 * s + 8 * kq) * 2), acc, 0, 0, 0);
              v2u w; w.x = pk2(acc[0], acc[1]); w.y = pk2(acc[2], acc[3]); *(LAS v2u*)(lds + R1_TMP + ((16 * ti + (lane & 15)) * 40 + 16 * mt + 4 * kq) * 2) = w; }
            __syncthreads();
            r1_prod<1, 1>(WV + 12288, (const LAS bf16*)(lds + R1_TMP), 40, a->in[I_RV0], (bf16*)(ws + WS_RVG), row0, lane, wave);
        }
    }
}
__device__ __forceinline__ float dpp_allsum(float x) {
    x += __builtin_bit_cast(float, __builtin_amdgcn_update_dpp(0, __builtin_bit_cast(int, x), 0x128, 0xf, 0xf, false));
    x += __builtin_bit_cast(float, __builtin_amdgcn_update_dpp(0, __builtin_bit_cast(int, x), 0x124, 0xf, 0xf, false));
    x += __builtin_bit_cast(float, __builtin_amdgcn_update_dpp(0, __builtin_bit_cast(int, x), 0x122, 0xf, 0xf, false));
    x += __builtin_bit_cast(float, __builtin_amdgcn_update_dpp(0, __builtin_bit_cast(int, x), 0x121, 0xf, 0xf, false));
    { const unsigned xi = __builtin_bit_cast(unsigned, x); auto r = __builtin_amdgcn_permlane16_swap(xi, xi, false, false); const unsigned r0 = r[0], r1 = r[1]; x = __uint_as_float(r0) + __uint_as_float(r1); }
    { const unsigned xi = __builtin_bit_cast(unsigned, x); auto r = __builtin_amdgcn_permlane32_swap(xi, xi, false, false); const unsigned r0 = r[0], r1 = r[1]; x = __uint_as_float(r0) + __uint_as_float(r1); }
    return x;
}

constexpr int RC_EF = 0, RC_ATF = 4096, RC_QF = 8448, RC_PFT = 9472, RC_AT = 10496, RC_RT = 12800, RC_BH = 15104, RC_KH = 17408, RC_AH = 19712, RC_BTT = 22016, RC_KTT = 25088, RC_VS = 28160,
              RC_PRL = 31232, RC_QRL = 32000, RC_TQL = 32768, RC_G15 = 33536, RC_CH = 33792;
struct RCRegs { v2u r0, r1, k0, k1, aa, ee, v0, v1, vg, vf, gg; };
__device__ __forceinline__ void rc_issue(const unsigned char* ws, int l, size_t row, int h, int tid, RCRegs& R) {
    const bf16* PROJ = (const bf16*)(ws + WS_PROJ); const int tt = tid >> 4, c0 = h * 64 + 4 * (tid & 15); const size_t r = row + tt; const bool first = (r % SEQ) == 0; const size_t rp = first ? r : r - 1;
    R.r0 = *(const GAS v2u*)(PROJ + r * NPROJ + PC_RW + RWC_R + c0); R.r1 = *(const GAS v2u*)(PROJ + rp * NPROJ + PC_RW + RWC_R + c0);
    R.k0 = *(const GAS v2u*)(PROJ + r * NPROJ + PC_RW + RWC_K + c0); R.k1 = *(const GAS v2u*)(PROJ + rp * NPROJ + PC_RW + RWC_K + c0);
    R.v0 = *(const GAS v2u*)(PROJ + r * NPROJ + PC_RW + RWC_V + c0); R.v1 = *(const GAS v2u*)(PROJ + rp * NPROJ + PC_RW + RWC_V + c0);
    R.aa = *(const GAS v2u*)((const bf16*)(ws + WS_RA) + r * DBR + c0); R.ee = *(const GAS v2u*)((const bf16*)(ws + WS_RE) + r * DBR + c0);
    R.gg = *(const GAS v2u*)((const bf16*)(ws + WS_RG) + r * DBR + c0);
    if (l > 0) { R.vg = *(const GAS v2u*)((const bf16*)(ws + WS_RVG) + r * DBR + c0); R.vf = *(const GAS v2u*)((const bf16*)(ws + WS_VF) + r * DBR + c0); }
    if (first) { R.r1 = (v2u){0u, 0u}; R.k1 = (v2u){0u, 0u}; R.v1 = (v2u){0u, 0u}; }
}
__device__ __forceinline__ void unpack4(const v2u p, float (&o)[4]) { o[0] = bflo(p.x); o[1] = bfhi(p.x); o[2] = bflo(p.y); o[3] = bfhi(p.y); }
__device__ __forceinline__ v2u pack4(const float (&v)[4]) { v2u o; o.x = pk2(v[0], v[1]); o.y = pk2(v[2], v[3]); return o; }
__device__ __forceinline__ v2u pack4v(const f32x4 v) { v2u o; o.x = pk2(v[0], v[1]); o.y = pk2(v[2], v[3]); return o; }
__device__ __forceinline__ bf16x8 cat8(const v2u a, const v2u b) { v4u o; o.x = a.x; o.y = a.y; o.z = b.x; o.w = b.y; return __builtin_bit_cast(bf16x8, o); }
#define RC_BAR() asm volatile("s_waitcnt lgkmcnt(0)\n\ts_barrier" ::: "memory")

constexpr int REC_BYTES = 12288, REC_UNITS = 752;
__device__ __forceinline__ unsigned char* rc_rec(unsigned char* ws, size_t cu) { return cu < 8192 ? ws + WS_OPA + cu * REC_BYTES : ws + WS_OPB + (cu - 8192) * REC_BYTES; }
__device__ __forceinline__ v4u rc_gather_unit(const LAS unsigned char* wb, int u) {
    v2u lo, hi;
    if (u < 256) { const int base = u < 128 ? RC_AH : RC_RT, uu = u & 127, row = uu >> 3, s = (uu >> 2) & 1, lq = uu & 3; const LAS unsigned char* p = wb + base + (row * 72 + 32 * s + 4 * lq) * 2;
        lo = *(const LAS v2u*)p; hi = *(const LAS v2u*)(p + 32); }
    else if (u < 512) { const int k = (u - 256) >> 2, lq = (u - 256) & 3; lo = *(const LAS v2u*)(wb + RC_BTT + (k * 24 + 4 * lq) * 2); hi = *(const LAS v2u*)(wb + RC_KTT + (k * 24 + 4 * lq) * 2); }
    else if (u < 576) { const int t = (u - 512) >> 2, lq = (u - 512) & 3; lo = *(const LAS v2u*)(wb + RC_PRL + (t * 24 + 4 * lq) * 2); hi = *(const LAS v2u*)(wb + RC_QRL + (t * 24 + 4 * lq) * 2); }
    else if (u < 608) { const LAS unsigned char* p = wb + RC_TQL + (((u - 576) >> 1) * 24 + 8 * ((u - 576) & 1)) * 2; lo = *(const LAS v2u*)p; hi = *(const LAS v2u*)(p + 8); }
    else if (u < 736) { const LAS unsigned char* p = wb + RC_VS + (((u - 608) >> 1) * 24 + 8 * ((u - 608) & 1)) * 2; lo = *(const LAS v2u*)p; hi = *(const LAS v2u*)(p + 8); }
    else { const LAS unsigned char* p = wb + RC_G15 + (u - 736) * 16; lo = *(const LAS v2u*)p; hi = *(const LAS v2u*)(p + 8); }
    v4u o; o.x = lo.x; o.y = lo.y; o.z = hi.x; o.w = hi.y; return o;
}
__device__ __forceinline__ void rc_copy_out(unsigned char* rec, const LAS unsigned char* wb, int u) {
#pragma unroll
    for (int q = 0; q < 3; ++q) { const int uu = u + 256 * q; if (uu < REC_UNITS) *(GAS v4u*)(rec + uu * 16) = rc_gather_unit(wb, uu); }
}
constexpr int RS_AH = 0, RS_RT = 2304, RS_BK = 4608, RS_PQ = 9728, RS_TQL = 11008, RS_VS = 11776, RS_G15 = 14848, RS_CH = 15360;
__device__ __forceinline__ int rs_unit_off(int u) {
    if (u < 128) return RS_AH + (u >> 3) * 144 + (u & 7) * 16;
    if (u < 256) return RS_RT + ((u - 128) >> 3) * 144 + (u & 7) * 16;
    if (u < 512) return RS_BK + ((u - 256) >> 2) * 80 + (u & 3) * 16;
    if (u < 576) return RS_PQ + ((u - 512) >> 2) * 80 + (u & 3) * 16;
    if (u < 608) return RS_TQL + ((u - 576) >> 1) * 48 + (u & 1) * 16;
    if (u < 736) return RS_VS + ((u - 608) >> 1) * 48 + (u & 1) * 16;
    return RS_G15 + (u - 736) * 16;
}
#define RC_BUILD(RUSE, q) do { const int bh_ = (q) >> 8, b = bh_ / NH, h = bh_ % NH, blk_ = (q) & 255, c0 = h * 64 + 4 * kq; const size_t row0 = (size_t)b * SEQ + (size_t)blk_ * 32; \
        float kkw[4], kaw[4], mur[4], muk[4], muv[4]; \
_Pragma("unroll") \
        for (int j = 0; j < 4; ++j) { kkw[j] = a->in[I_RKK][(size_t)l * DBR + c0 + j]; kaw[j] = a->in[I_RKA][(size_t)l * DBR + c0 + j]; mur[j] = mu[RWC_R + c0 + j]; muk[j] = mu[RWC_K + c0 + j]; muv[j] = mu[RWC_V + c0 + j]; } \
        float an[4], bk[4], km[4], rs[4], ev[4]; \
        {   const RCRegs& R = RUSE; \
            float rc[4], rp[4], kc[4], kp[4], av[4], vc[4], vp[4], ks[4], kk[4], vs[4]; unpack4(R.r0, rc); unpack4(R.r1, rp); unpack4(R.k0, kc); unpack4(R.k1, kp); unpack4(R.aa, av); unpack4(R.ee, ev); unpack4(R.v0, vc); unpack4(R.v1, vp); \
            float ss = 0.f; \
_Pragma("unroll") \
            for (int j = 0; j < 4; ++j) { rs[j] = rc[j] + mur[j] * (rp[j] - rc[j]); ks[j] = kc[j] + muk[j] * (kp[j] - kc[j]); kk[j] = ks[j] * kkw[j]; ss += kk[j] * kk[j]; vs[j] = vc[j] + muv[j] * (vp[j] - vc[j]); } \
            ss += __shfl_xor(ss, 1); ss += __shfl_xor(ss, 2); ss += __shfl_xor(ss, 4); ss += __shfl_xor(ss, 8); \
            const float inv = 1.f / fmaxf(sqrtf(ss), 1e-12f); \
_Pragma("unroll") \
            for (int j = 0; j < 4; ++j) { const float kn = kk[j] * inv; an[j] = -kn; bk[j] = kn * av[j]; km[j] = ks[j] * (1.f + (av[j] - 1.f) * kaw[j]); } \
            if (l == 0) *(GAS v2u*)((bf16*)(ws + WS_VF) + (row0 + tt) * DBR + c0) = pack4(vs); \
            else { float g[4], f[4]; unpack4(R.vg, g); unpack4(R.vf, f); \
_Pragma("unroll") \
                for (int j = 0; j < 4; ++j) vs[j] = vs[j] + (f[j] - vs[j]) * g[j]; } \
            {     \
                float gq[4], o1[4], o2[4]; unpack4(R.gg, gq); float rkp = 0.f; \
_Pragma("unroll") \
                for (int j = 0; j < 4; ++j) rkp += rs[j] * km[j] * a->in[I_RRK][(size_t)l * DBR + c0 + j]; \
                rkp += __shfl_xor(rkp, 1); rkp += __shfl_xor(rkp, 2); rkp += __shfl_xor(rkp, 4); rkp += __shfl_xor(rkp, 8); \
_Pragma("unroll") \
                for (int j = 0; j < 4; ++j) { o1[j] = a->in[I_RLNW][(size_t)l * DBR + c0 + j] * gq[j]; o2[j] = (a->in[I_RLNB][(size_t)l * DBR + c0 + j] + rkp * vs[j]) * gq[j]; } \
                *(GAS v2u*)((bf16*)(ws + WS_RG) + (row0 + tt) * DBR + c0) = pack4(o1); *(GAS v2u*)((bf16*)(ws + WS_RA) + (row0 + tt) * DBR + c0) = pack4(o2); } \
            *(LAS f32x4*)(cb + RC_EF + (t * 64 + 4 * kq) * 4) = (f32x4){ev[0], ev[1], ev[2], ev[3]}; \
_Pragma("unroll") \
            for (int j = 0; j < 4; ++j) *(LAS bf16*)(cb + RC_VS + ((4 * kq + j) * 24 + t) * 2) = (bf16)f2bf(vs[j]); \
        } \
        if ((q) + 2 * G < NQ) rc_issue(ws, l, (size_t)(((q) + 2 * G) >> 8) / NH * SEQ + (size_t)(((q) + 2 * G) & 255) * 32, (((q) + 2 * G) >> 8) % NH, tid, RUSE); \
        RC_BAR(); \
        {   f32x4 inc = {0.f, 0.f, 0.f, 0.f}, tot = inc; \
_Pragma("unroll") \
            for (int i = 0; i < 16; ++i) { const f32x4 ei = *(const LAS f32x4*)(cb + RC_EF + (i * 64 + 4 * kq) * 4); tot = tot + ei; if (i <= t) inc = inc + ei; } \
            float At[4], Rt[4], Bh[4], Kh[4], Bt[4], Kt[4], Gt[4]; \
_Pragma("unroll") \
            for (int j = 0; j < 4; ++j) { const float Gi = __expf(-inc[j]), Ge = __expf(ev[j] - inc[j]), Gn = __expf(inc[j]); Gt[j] = __expf(-tot[j]); \
                At[j] = an[j] * Ge; Rt[j] = rs[j] * Gi; Bh[j] = bk[j] * Gn; Kh[j] = km[j] * Gn; Bt[j] = Bh[j] * Gt[j]; Kt[j] = Kh[j] * Gt[j]; } \
            *(LAS f32x4*)(cb + RC_ATF + (t * 68 + 4 * kq) * 4) = (f32x4){At[0], At[1], At[2], At[3]}; \
            *(LAS v2u*)(cb + RC_AT + (t * 72 + 4 * kq) * 2) = pack4(At); *(LAS v2u*)(cb + RC_RT + (t * 72 + 4 * kq) * 2) = pack4(Rt); \
            *(LAS v2u*)(cb + RC_BH + (t * 72 + 4 * kq) * 2) = pack4(Bh); *(LAS v2u*)(cb + RC_KH + (t * 72 + 4 * kq) * 2) = pack4(Kh); \
_Pragma("unroll") \
            for (int j = 0; j < 4; ++j) { *(LAS bf16*)(cb + RC_BTT + ((4 * kq + j) * 24 + t) * 2) = (bf16)f2bf(Bt[j]); *(LAS bf16*)(cb + RC_KTT + ((4 * kq + j) * 24 + t) * 2) = (bf16)f2bf(Kt[j]); } \
            if (t == 0) *(LAS f32x4*)(cb + RC_G15 + 4 * kq * 4) = (f32x4){Gt[0], Gt[1], Gt[2], Gt[3]}; \
        } \
        RC_BAR(); \
        {   LAS unsigned char* wb = lds + (wave >> 2) * RC_CH; const int pi = wave & 3; \
            const LAS bf16* Ap = (const LAS bf16*)(wb + (pi < 2 ? RC_AT : RC_RT)) + li * 72 + 8 * lq; const LAS bf16* Bp = (const LAS bf16*)(wb + ((pi & 1) ? RC_KH : RC_BH)) + li * 72 + 8 * lq; \
            f32x4 acc = {0.f, 0.f, 0.f, 0.f}; \
            acc = __builtin_amdgcn_mfma_f32_16x16x32_bf16(*(const LAS bf16x8*)Ap, *(const LAS bf16x8*)Bp, acc, 0, 0, 0); \
            acc = __builtin_amdgcn_mfma_f32_16x16x32_bf16(*(const LAS bf16x8*)(Ap + 32), *(const LAS bf16x8*)(Bp + 32), acc, 0, 0, 0); \
_Pragma("unroll") \
            for (int r = 0; r < 4; ++r) { const int tr = 4 * lq + r; if (pi < 2 ? !(li < tr) : !(li <= tr)) acc[r] = 0.f; } \
            if (pi == 0) *(LAS f32x4*)(wb + RC_PFT + (li * 16 + 4 * lq) * 4) = acc; \
            else if (pi == 1) { \
_Pragma("unroll") \
                for (int r = 0; r < 4; ++r) *(LAS float*)(wb + RC_QF + ((4 * lq + r) * 16 + li) * 4) = acc[r]; } \
            else { LAS bf16* o = (LAS bf16*)(wb + (pi == 2 ? RC_PRL : RC_QRL)); \
_Pragma("unroll") \
                for (int r = 0; r < 4; ++r) o[(4 * lq + r) * 24 + li] = (bf16)f2bf(acc[r]); } \
        } \
        RC_BAR(); \
        if (wave < 4) { \
            LAS unsigned char* wb = lds + (wave >> 1) * RC_CH; const bool isq = wave & 1; \
            float X[16]; \
_Pragma("unroll") \
            for (int r = 0; r < 16; ++r) X[r] = isq ? *(const LAS float*)(wb + RC_QF + (r * 16 + li) * 4) : *(const LAS float*)(wb + RC_ATF + (r * 68 + lane) * 4); \
_Pragma("unroll") \
            for (int j = 0; j < 15; ++j) { const LAS f32x4* pc = (const LAS f32x4*)(wb + RC_PFT + j * 64); const f32x4 c0v = pc[0], c1v = pc[1], c2v = pc[2], c3v = pc[3]; \
                const float c[16] = {c0v[0], c0v[1], c0v[2], c0v[3], c1v[0], c1v[1], c1v[2], c1v[3], c2v[0], c2v[1], c2v[2], c2v[3], c3v[0], c3v[1], c3v[2], c3v[3]}; \
_Pragma("unroll") \
                for (int r = j + 1; r < 16; ++r) X[r] = fmaf(c[r], X[j], X[r]); } \
            if (!isq) { LAS bf16* o = (LAS bf16*)(wb + RC_AH); \
_Pragma("unroll") \
                for (int r = 0; r < 16; ++r) o[r * 72 + lane] = (bf16)f2bf(X[r]); } \
            else if (lane < 16) { LAS bf16* o = (LAS bf16*)(wb + RC_TQL); \
_Pragma("unroll") \
                for (int r = 0; r < 16; ++r) o[r * 24 + lane] = (bf16)f2bf(X[r]); } \
        } \
        RC_BAR(); \
        { const int cc = tid >> 8, u = tid & 255; unsigned char* rec = rc_rec(ws, (size_t)bh_ * 512 + 2 * blk_ + cc); const LAS unsigned char* wb = lds + cc * RC_CH; \
          rc_copy_out(rec, wb, u); } \
        RC_BAR(); \
    } while (0)
struct RSOps { bf16x8 a01, a23, r01, r23, tq, pq, bk[4]; v2u vb; f32x4 g[4]; };
__device__ __forceinline__ void rs_load(const LAS unsigned char* wb, int wave, int li, int lq, RSOps& O) {
    O.a01 = *(const LAS bf16x8*)(wb + RS_AH + li * 144 + lq * 16); O.a23 = *(const LAS bf16x8*)(wb + RS_AH + li * 144 + 64 + lq * 16);
    O.r01 = *(const LAS bf16x8*)(wb + RS_RT + li * 144 + lq * 16); O.r23 = *(const LAS bf16x8*)(wb + RS_RT + li * 144 + 64 + lq * 16);
    O.pq = *(const LAS bf16x8*)(wb + RS_PQ + li * 80 + lq * 16);
    { const v2u t = *(const LAS v2u*)(wb + RS_TQL + li * 48 + lq * 8); v4u o; o.x = t.x; o.y = t.y; o.z = 0u; o.w = 0u; O.tq = __builtin_bit_cast(bf16x8, o); }
    O.vb = *(const LAS v2u*)(wb + RS_VS + (16 * wave + li) * 48 + lq * 8);
#pragma unroll
    for (int kt = 0; kt < 4; ++kt) { O.bk[kt] = *(const LAS bf16x8*)(wb + RS_BK + (16 * kt + li) * 80 + lq * 16); O.g[kt] = *(const LAS f32x4*)(wb + RS_G15 + (16 * kt + 4 * lq) * 4); }
}
#define RC_CHUNK(O, cc, yb) do { const v2u z2_ = {0u, 0u}; \
        f32x4 aD = {0.f, 0.f, 0.f, 0.f}, aY = {0.f, 0.f, 0.f, 0.f}; \
        aD = __builtin_amdgcn_mfma_f32_16x16x32_bf16(O.a01, Sb01, aD, 0, 0, 0); \
        aD = __builtin_amdgcn_mfma_f32_16x16x32_bf16(O.a23, Sb23, aD, 0, 0, 0); \
        aD = __builtin_amdgcn_mfma_f32_16x16x32_bf16(O.tq, cat8(O.vb, z2_), aD, 0, 0, 0); \
        aY = __builtin_amdgcn_mfma_f32_16x16x32_bf16(Sb01, O.r01, aY, 0, 0, 0); \
        aY = __builtin_amdgcn_mfma_f32_16x16x32_bf16(Sb23, O.r23, aY, 0, 0, 0); \
        const bf16x8 DV = cat8(pack4v(aD), O.vb); \
_Pragma("unroll") \
        for (int kt = 0; kt < 4; ++kt) Sacc[kt] = __builtin_amdgcn_mfma_f32_16x16x32_bf16(O.bk[kt], DV, Sacc[kt] * O.g[kt], 0, 0, 0); \
        aY = __builtin_amdgcn_mfma_f32_16x16x32_bf16(DV, O.pq, aY, 0, 0, 0); \
        Sb01 = cat8(pack4v(Sacc[0]), pack4v(Sacc[1])); Sb23 = cat8(pack4v(Sacc[2]), pack4v(Sacc[3])); \
        *(LAS f32x4*)((yb) + (((cc) * 16 + li) * 68 + 16 * wave + 4 * lq) * 4) = aY;     \
    } while (0)
#define RC_SCAN(slot, yb) do { { RSOps O0; rs_load(slot, wave, li, lq, O0); __builtin_amdgcn_sched_barrier(0); RC_CHUNK(O0, 0, yb); } \
        { RSOps O1; rs_load(slot + RS_CH, wave, li, lq, O1); __builtin_amdgcn_sched_barrier(0); RC_CHUNK(O1, 1, yb); } } while (0)

__device__ __forceinline__ void phase_r2_build(KArgsP a, LAS unsigned char* lds, int tid, int lane, int wave, int vcu, int G, int l) {
    unsigned char* ws = a->ws;
    const int tt = tid >> 4, kq = tid & 15, ch = tt >> 4, t = tt & 15;
    const int lq = lane >> 4, li = lane & 15;
    LAS unsigned char* cb = lds + ch * RC_CH;
    const float* mu = a->in[I_RMU] + (size_t)l * RW_COLS;
    constexpr int NQ = NB * NH * 256;
    RCRegs RA, RB;
    if (vcu < NQ) rc_issue(ws, l, (size_t)(vcu >> 8) / NH * SEQ + (size_t)(vcu & 255) * 32, (vcu >> 8) % NH, tid, RA);
    if (vcu + G < NQ) rc_issue(ws, l, (size_t)((vcu + G) >> 8) / NH * SEQ + (size_t)((vcu + G) & 255) * 32, ((vcu + G) >> 8) % NH, tid, RB);
    for (int q0 = vcu; q0 < NQ; q0 += 2 * G) { { const int q = q0; RC_BUILD(RA, q); } if (q0 + G < NQ) { const int q = q0 + G; RC_BUILD(RB, q); } }
}
#ifndef RS_DEPTH
#define RS_DEPTH 4
#endif
struct RSRegs { v4u p[6]; };
__device__ __forceinline__ void rs_issue(unsigned char* ws, size_t cu0, int lt, RSRegs& R) {
    const unsigned char* base = rc_rec(ws, cu0);
#pragma unroll
    for (int j = 0; j < 6; ++j) { const int uu = min(lt + 256 * j, 2 * REC_UNITS - 1); const int cc = uu >= REC_UNITS; R.p[j] = *(const GAS v4u*)(base + uu * 16 + cc * (REC_BYTES - REC_UNITS * 16)); }
}
__device__ __forceinline__ void rs_store(LAS unsigned char* slot, int lt, const RSRegs& R) {
#pragma unroll
    for (int j = 0; j < 6; ++j) { const int uu = min(lt + 256 * j, 2 * REC_UNITS - 1); const int cc = uu >= REC_UNITS, u = uu - cc * REC_UNITS;
        *(LAS v4u*)(slot + cc * RS_CH + rs_unit_off(u)) = R.p[j]; }
}
struct R3Q { v4u a1, a2; };
__device__ __forceinline__ void r3q_issue(const unsigned char* ws, size_t row0, int h, int lt, R3Q& Q) {
    const size_t off = (row0 + (lt >> 3)) * DBR + h * 64 + 8 * (lt & 7);
    Q.a1 = *(const GAS v4u*)((const bf16*)(ws + WS_RG) + off); Q.a2 = *(const GAS v4u*)((const bf16*)(ws + WS_RA) + off);
}
__device__ __forceinline__ float dpp8sum(float x) {
    x += __builtin_bit_cast(float, __builtin_amdgcn_update_dpp(0, __builtin_bit_cast(int, x), 0xB1, 0xf, 0xf, false));
    x += __builtin_bit_cast(float, __builtin_amdgcn_update_dpp(0, __builtin_bit_cast(int, x), 0x4E, 0xf, 0xf, false));
    x += __builtin_bit_cast(float, __builtin_amdgcn_update_dpp(0, __builtin_bit_cast(int, x), 0x141, 0xf, 0xf, false));
    return x;
}
__device__ __forceinline__ void r3_block(const LAS unsigned char* yb, bf16* YC, size_t row0, int h, int lt, const R3Q& Q) {
    const int tk = lt >> 3, c8 = 8 * (lt & 7);
    const f32x4 y0 = *(const LAS f32x4*)(yb + (tk * 68 + c8) * 4), y1 = *(const LAS f32x4*)(yb + (tk * 68 + c8 + 4) * 4);
    float d[8] = {y0[0], y0[1], y0[2], y0[3], y1[0], y1[1], y1[2], y1[3]};
    const float m = dpp8sum(((d[0] + d[1]) + (d[2] + d[3])) + ((d[4] + d[5]) + (d[6] + d[7]))) * (1.f / 64.f);
    float q = 0.f;
#pragma unroll
    for (int j = 0; j < 8; ++j) { d[j] -= m; q = fmaf(d[j], d[j], q); }
    const float rstd = rsqrtf(dpp8sum(q) * (1.f / 64.f) + RWKV_GN_EPS);
    const unsigned a1[4] = {Q.a1.x, Q.a1.y, Q.a1.z, Q.a1.w}, a2[4] = {Q.a2.x, Q.a2.y, Q.a2.z, Q.a2.w}; unsigned o[4];
#pragma unroll
    for (int j = 0; j < 4; ++j) o[j] = pk2(fmaf(d[2 * j] * rstd, bflo(a1[j]), bflo(a2[j])), fmaf(d[2 * j + 1] * rstd, bfhi(a1[j]), bfhi(a2[j])));
    v4u w; w.x = o[0]; w.y = o[1]; w.z = o[2]; w.w = o[3];
    *(GAS v4u*)(YC + (row0 + tk) * DM + 384 + h * 64 + c8) = w;
}
__device__ __forceinline__ void phase_r2_scan(KArgsP a, LAS unsigned char* lds, int tid, int lane, int wave, int wg, int l) {
    unsigned char* ws = a->ws; bf16* YC = (bf16*)(ws + WS_YC);
    const int b = wg / NH, h = wg % NH; const size_t rowb = (size_t)b * SEQ, cub = (size_t)wg * 512;
    const int lq = lane >> 4, li = lane & 15, lt = tid - 256; const bool loader = wave >= 4;
    f32x4 Sacc[4]; bf16x8 Sb01, Sb23;
#pragma unroll
    for (int kt = 0; kt < 4; ++kt) Sacc[kt] = (f32x4){0.f, 0.f, 0.f, 0.f};
    Sb01 = (bf16x8){0, 0, 0, 0, 0, 0, 0, 0}; Sb23 = Sb01;
    constexpr int NBLK = SEQ / 32;
    LAS unsigned char* slot0 = lds; LAS unsigned char* slot1 = lds + 2 * RS_CH;
    LAS unsigned char* yb0 = lds + 4 * RS_CH; LAS unsigned char* yb1 = yb0 + 32 * 68 * 4;
    if (!loader) {
        RC_BAR();
        for (int bb = 0; bb < NBLK; bb += 2) {
            { LAS unsigned char* slot = slot0; RC_SCAN(slot, yb0); }
            RC_BAR();
            { LAS unsigned char* slot = slot1; RC_SCAN(slot, yb1); }
            RC_BAR();
        }
    } else {
        constexpr int ND = RS_DEPTH;
        RSRegs R[ND]; R3Q Q[ND];
#pragma unroll
        for (int j = 0; j < ND; ++j) { rs_issue(ws, cub + 2 * j, lt, R[j]); r3q_issue(ws, rowb + 32 * j, h, lt, Q[j]); }
        rs_store(slot0, lt, R[0]); rs_issue(ws, cub + 2 * ND, lt, R[0]);
        RC_BAR();
        for (int bb = 0; bb < NBLK; bb += ND) {
#pragma unroll
            for (int j = 0; j < ND; ++j) { const int X = bb + j;
                r3_block((j & 1) ? yb0 : yb1, YC, rowb + (size_t)max(X - 1, 0) * 32, h, lt, Q[(j + ND - 1) % ND]);
                r3q_issue(ws, rowb + (size_t)min(X - 1 + ND, NBLK - 1) * 32, h, lt, Q[(j + ND - 1) % ND]);
                rs_store((j & 1) ? slot0 : slot1, lt, R[(j + 1) % ND]);
                rs_issue(ws, cub + 2 * (size_t)min(X + 1 + ND, NBLK - 1), lt, R[(j + 1) % ND]);
                RC_BAR();
            }
        }
        r3_block(yb1, YC, rowb + (size_t)(NBLK - 1) * 32, h, lt, Q[(NBLK - 1) % ND]);
    }
}
__device__ __forceinline__ void phase_r3(KArgsP a, int lane, int gw, int ngw, int l) {
    unsigned char* ws = a->ws; const bf16* PROJ = (const bf16*)(ws + WS_PROJ); bf16* YC = (bf16*)(ws + WS_YC);
    const bf16* RA = (const bf16*)(ws + WS_RA); const bf16* RG = (const bf16*)(ws + WS_RG); const bf16* RVG = (const bf16*)(ws + WS_RVG); const bf16* VF = (const bf16*)(ws + WS_VF);
    const float* mu = a->in[I_RMU] + (size_t)l * RW_COLS;
    for (size_t row = gw; row < NTOK; row += ngw) {
#pragma unroll
        for (int h = 0; h < NH; ++h) {
            const int c = h * 64 + lane;
            const float y = bf2f(YC[row * DM + 384 + c]);
            const float m = dpp_allsum(y) * (1.f / 64.f); const float d = y - m; const float var = dpp_allsum(d * d) * (1.f / 64.f);
            const float yn = d * rsqrtf(var + RWKV_GN_EPS) * a->in[I_RLNW][l * DBR + c] + a->in[I_RLNB][l * DBR + c];
            const float rs = rw_shift(PROJ, mu, row, RWC_R + c), ks = rw_shift(PROJ, mu, row, RWC_K + c); float v = rw_shift(PROJ, mu, row, RWC_V + c);
            if (l > 0) v = v + (bf2f(VF[row * DBR + c]) - v) * bf2f(RVG[row * DBR + c]);
            const float av = bf2f(RA[row * DBR + c]);
            const float km = ks * (1.f + (av - 1.f) * a->in[I_RKA][l * DBR + c]);
            const float rk = dpp_allsum(rs * km * a->in[I_RRK][l * DBR + c]);
            YC[row * DM + 384 + c] = (bf16)f2bf((yn + rk * v) * bf2f(RG[row * DBR + c]));
        }
    }
}

constexpr int PH_PER_LAYER = 10, PH_FINAL = 1 + 2 * PH_PER_LAYER, N_PHASES = PH_FINAL + 1;
constexpr int R2_WGS = 24;
__global__ void __launch_bounds__(NTHR, 2) fwd(Args args) {
    extern __shared__ __attribute__((aligned(16))) unsigned char lds_raw[];
    LAS unsigned char* lds = (LAS unsigned char*)lds_raw;
    volatile LAS unsigned* MISC = (volatile LAS unsigned*)(lds + MISC_OFF);
    const int tid0 = threadIdx.x;
    const int G = gridDim.x;
#define PHASE_IDS int tid_ = threadIdx.x; asm volatile("" : "+v"(tid_)); const int tid = tid_, lane = tid & 63, wave = __builtin_amdgcn_readfirstlane(tid >> 6); \
    int bx_ = blockIdx.x; asm volatile("" : "+s"(bx_)); const int bx = bx_; const int vcu = (G % 8 == 0) ? (bx % 8) * (G / 8) + bx / 8 : bx; (void)lane; (void)wave; (void)vcu; (void)bx;
    unsigned char* ws0 = fresh_args()->ws;
    for (int u = tid0; u < (LDS_BYTES - RING_BYTES) / 4; u += NTHR) ((LAS unsigned*)(lds + RING_BYTES))[u] = 0u;
    __syncthreads();
    XcdBarrier bar; bar.bar = (unsigned*)(ws0 + WS_CTL) + CW_BAR; bar.x = 0; bar.st = nullptr;
    if (!MK_PER_PHASE) bar = xcd_barrier_post((unsigned*)(ws0 + WS_CTL) + CW_BAR, MISC + 8);
#if MK_PER_PHASE
    const int lo = args.ph_lo, hi = args.ph_hi;
#define IN(k) (lo <= (k) && (k) < hi)
#else
#define IN(k) true
#endif
#define SEAM(k) do { if (IN(k) && IN((k) + 1)) { XcdBarrier b2 = bar; asm volatile("" : "+s"(b2.bar)); xcd_barrier(b2); } } while (0)

#ifndef GEMM_SP2
#define GEMM_SP2 true
#endif
#ifndef GEMM_ALIGN
#define GEMM_ALIGN true
#endif
#ifndef RS_DEPTH
#define RS_DEPTH 4
#endif
#ifndef DBL_SUB
#define DBL_SUB 0
#endif
#ifndef DBL_PHASE
#define DBL_PHASE (-1)
#endif
#ifndef REPN
#define REPN 2
#endif
#define REP(k) for (int rep_ = 0; rep_ < ((k) == DBL_PHASE ? REPN : 1); ++rep_)
#define REPBAR if (rep_ > 0) { XcdBarrier b2 = bar; asm volatile("" : "+s"(b2.bar)); xcd_barrier(b2); }
    REP(0) if (IN(0)) { REPBAR KArgsP ap = fresh_args(); PHASE_IDS phase_prologue(ap, lds, tid, lane, wave, vcu, G); }
    SEAM(0);
#ifdef EXTRA_BAR
    for (int eb_ = 0; eb_ < EXTRA_BAR; ++eb_) { XcdBarrier b2 = bar; asm volatile("" : "+s"(b2.bar)); xcd_barrier(b2); }
#endif
#define LCONST 0
    {
        constexpr int l = LCONST; constexpr int pb = 1 + l * PH_PER_LAYER;
        REP(pb + 0) if (IN(pb + 0)) { REPBAR KArgsP ap = fresh_args(); PHASE_IDS unsigned char* ws = ap->ws; (void)ws;
            if (l == 0) { mod_finalize(ws, tid, G); phase_rownorm<0, false>(ap, lds, tid, lane, wave, G, ap->in[I_X], ap->out, ap->in[I_NORM_MIX], true, 0, 0, 0); }
            else {
#if EN_MOE
                phase_rownorm<0, true>(ap, lds, tid, lane, wave, G, ap->out, ap->out, ap->in[I_NORM_MIX] + l * DM, false, l, 0, l - 1);
#else
                phase_rownorm<0, false>(ap, lds, tid, lane, wave, G, ap->out, ap->out, ap->in[I_NORM_MIX] + l * DM, false, l, 0, l - 1);
#endif
            }
        }
        SEAM(pb + 0);
        REP(pb + 1) if (IN(pb + 1)) { REPBAR KArgsP ap = fresh_args(); PHASE_IDS unsigned char* ws = ap->ws; (void)ws;
            pg8::Gemm g{(const pg8::bf16_t*)(ws + WS_HN), (const pg8::bf16_t*)(ws + WS_WIN) + (size_t)l * NPROJ_PAD * DM, NTOK, NPROJ_PAD, DM};
            pg8::StaticOrder S; S.init(NTOK, NPROJ_PAD, G, bx);
            pg8::EpiProj E{(pg8::bf16_t*)(ws + WS_PROJ), (float*)(ws + WS_GATES)};
            pg8::gemm_phase<pg8::EpiProj, pg8::StaticOrder, GEMM_ALIGN, GEMM_SP2>(lds, g, S, E);
        }
        SEAM(pb + 1);
        REP(pb + 2) if (IN(pb + 2)) { REPBAR KArgsP ap = fresh_args(); PHASE_IDS unsigned char* ws = ap->ws; (void)ws;
#if EN_MLSTM
            for (int q_ = 0; q_ < 1 + (REPN - 1) * ((DBL_SUB == 1) && l == 0); ++q_) { phase_m1(ap, lds, tid, lane, wave, vcu, G, l); __syncthreads(); }
            __syncthreads();
#endif
#if EN_S5
            phase_s1(ap, lds, tid, lane, wave, vcu, G, l); __syncthreads();
#if DBL_SUB == 2
            if (l == 0) { phase_s1(ap, lds, tid, lane, wave, vcu, G, l); __syncthreads(); phase_s1(ap, lds, tid, lane, wave, vcu, G, l); __syncthreads(); phase_s1(ap, lds, tid, lane, wave, vcu, G, l); __syncthreads(); phase_s1(ap, lds, tid, lane, wave, vcu, G, l); __syncthreads(); }
#endif
            __syncthreads();
#endif
#if EN_RWKV
            for (int q_ = 0; q_ < 1 + (REPN - 1) * ((DBL_SUB == 3) && l == 0); ++q_) { phase_r1(ap, lds, tid, lane, wave, vcu, G, l); __syncthreads(); }
#endif
        }
        SEAM(pb + 2);
        REP(pb + 3) if (IN(pb + 3)) { REPBAR KArgsP ap = fresh_args(); PHASE_IDS unsigned char* ws = ap->ws; (void)ws;
            phase_m2(ws, tid, vcu, G);
            phase_s2(ap, tid, vcu, G, l);
            __syncthreads();
            phase_r2_build(ap, lds, tid, lane, wave, vcu, G, l);
        }
        SEAM(pb + 3);
        REP(pb + 4) if (IN(pb + 4)) { REPBAR KArgsP ap = fresh_args(); PHASE_IDS unsigned char* ws = ap->ws; (void)ws;
            if (bx < R2_WGS) {
_Pragma("nounroll")
 for (int q_ = 0; q_ < 1 + (REPN - 1) * ((DBL_SUB == 4) && l == 0); ++q_) { phase_r2_scan(ap, lds, tid, lane, wave, bx, l); __syncthreads(); } }
            else { phase_s3(ap, lds, tid, lane, wave, 0, 1, l, (unsigned*)(ws + WS_CTL) + CW_Q + 64 * l + 32); __syncthreads(); }
            {
                unsigned* qctr = (unsigned*)(ws + WS_CTL) + CW_Q + 64 * l; volatile LAS unsigned* qw = (volatile LAS unsigned*)(lds + MISC_OFF) + 16;
                for (;;) {
                    if (tid == 0) *qw = __hip_atomic_fetch_add(qctr, 1u, __ATOMIC_RELAXED, __HIP_MEMORY_SCOPE_AGENT);
                    __syncthreads();
                    const int u = (int)*qw;
                    __syncthreads();
                    if (u >= NUNIT_M) break;
                    phase_m3(ap, lds, tid, lane, wave, u, NUNIT_M, l);
                }
            }
        }
        SEAM(pb + 4);
        REP(pb + 6) if (IN(pb + 6)) { REPBAR KArgsP ap = fresh_args(); PHASE_IDS unsigned char* ws = ap->ws; (void)ws;
            pg8::Gemm g{(const pg8::bf16_t*)(ws + WS_YC), (const pg8::bf16_t*)(ws + WS_WOUT) + (size_t)l * DM * DM, NTOK, DM, DM};
            pg8::StaticOrder S; S.init(NTOK, DM, G, bx);
            pg8::EpiResid E{l == 0 ? ap->in[I_X] : (const float*)ap->out, ap->out, (const float*)(ws + WS_MODF) + (size_t)l * 4 * 6144, 2048};
            pg8::gemm_phase<pg8::EpiResid, pg8::StaticOrder, GEMM_ALIGN, GEMM_SP2>(lds, g, S, E);
        }
        SEAM(pb + 6);
#if EN_MOE
        REP(pb + 7) if (IN(pb + 7)) { REPBAR KArgsP ap = fresh_args(); PHASE_IDS phase_router(ap, lds, tid, lane, wave, G, l); __syncthreads();
            moe_convert13(ap->in[I_MW1], ap->in[I_MW3], l, (bf16*)(ap->ws + WS_W13), vcu * NWAVES + wave, G * NWAVES, (LAS float*)(lds + wave * 16640), lane);
            moe_convert2(ap->in[I_MW2], l, (bf16*)(ap->ws + WS_W2), vcu * NWAVES + wave, G * NWAVES, (LAS float*)(lds + wave * 16640), lane); }
        SEAM(pb + 7);
        REP(pb + 8) if (IN(pb + 8)) { REPBAR KArgsP ap = fresh_args(); PHASE_IDS unsigned char* ws = ap->ws; (void)ws;
            LAS int* ptab = (LAS int*)(lds + PTAB_OFF); LAS int* pst = ptab + 512; LAS int* cnt = pst + 32;
            build_ptab((const unsigned*)(ws + WS_CTL) + CW_CNT + l * 32, ptab, pst, cnt, tid);
            pg8::Gemm g{(const pg8::bf16_t*)(ws + WS_HN), (const pg8::bf16_t*)(ws + WS_W13), 0, 0, DM, (const int*)(ws + WS_LIST), ptab};
            pg8::MoeOrder S{ptab, G, vcu};
            pg8::EpiSwiglu E{(pg8::bf16_t*)(ws + WS_HMID)};
            pg8::gemm_phase<pg8::EpiSwiglu, pg8::MoeOrder, false, true, true>(lds, g, S, E);
        }
        SEAM(pb + 8);
        REP(pb + 9) if (IN(pb + 9)) { REPBAR KArgsP ap = fresh_args(); PHASE_IDS unsigned char* ws = ap->ws; (void)ws;
            LAS int* ptab = (LAS int*)(lds + PTAB_OFF); LAS int* pst = ptab + 512; LAS int* cnt = pst + 32;
            build_ptab((const unsigned*)(ws + WS_CTL) + CW_CNT + l * 32, ptab, pst, cnt, tid);
            pg8::Gemm g{(const pg8::bf16_t*)(ws + WS_HMID), (const pg8::bf16_t*)(ws + WS_W2), 0, 0, DEXP};
            pg8::MoeOrder S{ptab, G, vcu};
            pg8::EpiMoeOut E{(pg8::bf16_t*)(ws + WS_YMOE), (const int*)(ws + WS_LIST), ptab};
            pg8::gemm_phase<pg8::EpiMoeOut, pg8::MoeOrder, true, true>(lds, g, S, E);
        }
        SEAM(pb + 9);
#else
        SEAM(pb + 6); SEAM(pb + 7); SEAM(pb + 8); SEAM(pb + 9);
#endif
    }
#undef LCONST
#if N_LAYERS > 1
#define LCONST 1
    {
        constexpr int l = LCONST; constexpr int pb = 1 + l * PH_PER_LAYER;
        REP(pb + 0) if (IN(pb + 0)) { REPBAR KArgsP ap = fresh_args(); PHASE_IDS unsigned char* ws = ap->ws; (void)ws;
            if (l == 0) { mod_finalize(ws, tid, G); phase_rownorm<0, false>(ap, lds, tid, lane, wave, G, ap->in[I_X], ap->out, ap->in[I_NORM_MIX], true, 0, 0, 0); }
            else {
#if EN_MOE
                phase_rownorm<0, true>(ap, lds, tid, lane, wave, G, ap->out, ap->out, ap->in[I_NORM_MIX] + l * DM, false, l, 0, l - 1);
#else
                phase_rownorm<0, false>(ap, lds, tid, lane, wave, G, ap->out, ap->out, ap->in[I_NORM_MIX] + l * DM, false, l, 0, l - 1);
#endif
            }
        }
        SEAM(pb + 0);
        REP(pb + 1) if (IN(pb + 1)) { REPBAR KArgsP ap = fresh_args(); PHASE_IDS unsigned char* ws = ap->ws; (void)ws;
            pg8::Gemm g{(const pg8::bf16_t*)(ws + WS_HN), (const pg8::bf16_t*)(ws + WS_WIN) + (size_t)l * NPROJ_PAD * DM, NTOK, NPROJ_PAD, DM};
            pg8::StaticOrder S; S.init(NTOK, NPROJ_PAD, G, bx);
            pg8::EpiProj E{(pg8::bf16_t*)(ws + WS_PROJ), (float*)(ws + WS_GATES)};
            pg8::gemm_phase<pg8::EpiProj, pg8::StaticOrder, GEMM_ALIGN, GEMM_SP2>(lds, g, S, E);
        }
        SEAM(pb + 1);
        REP(pb + 2) if (IN(pb + 2)) { REPBAR KArgsP ap = fresh_args(); PHASE_IDS unsigned char* ws = ap->ws; (void)ws;
#if EN_MLSTM
            for (int q_ = 0; q_ < 1 + (REPN - 1) * ((DBL_SUB == 1) && l == 0); ++q_) { phase_m1(ap, lds, tid, lane, wave, vcu, G, l); __syncthreads(); }
            __syncthreads();
#endif
#if EN_S5
            phase_s1(ap, lds, tid, lane, wave, vcu, G, l); __syncthreads();
#if DBL_SUB == 2
            if (l == 0) { phase_s1(ap, lds, tid, lane, wave, vcu, G, l); __syncthreads(); phase_s1(ap, lds, tid, lane, wave, vcu, G, l); __syncthreads(); phase_s1(ap, lds, tid, lane, wave, vcu, G, l); __syncthreads(); phase_s1(ap, lds, tid, lane, wave, vcu, G, l); __syncthreads(); }
#endif
            __syncthreads();
#endif
#if EN_RWKV
            for (int q_ = 0; q_ < 1 + (REPN - 1) * ((DBL_SUB == 3) && l == 0); ++q_) { phase_r1(ap, lds, tid, lane, wave, vcu, G, l); __syncthreads(); }
#endif
        }
        SEAM(pb + 2);
        REP(pb + 3) if (IN(pb + 3)) { REPBAR KArgsP ap = fresh_args(); PHASE_IDS unsigned char* ws = ap->ws; (void)ws;
            phase_m2(ws, tid, vcu, G);
            phase_s2(ap, tid, vcu, G, l);
            __syncthreads();
            phase_r2_build(ap, lds, tid, lane, wave, vcu, G, l);
        }
        SEAM(pb + 3);
        REP(pb + 4) if (IN(pb + 4)) { REPBAR KArgsP ap = fresh_args(); PHASE_IDS unsigned char* ws = ap->ws; (void)ws;
            if (bx < R2_WGS) {
_Pragma("nounroll")
 for (int q_ = 0; q_ < 1 + (REPN - 1) * ((DBL_SUB == 4) && l == 0); ++q_) { phase_r2_scan(ap, lds, tid, lane, wave, bx, l); __syncthreads(); } }
            else { phase_s3(ap, lds, tid, lane, wave, 0, 1, l, (unsigned*)(ws + WS_CTL) + CW_Q + 64 * l + 32); __syncthreads(); }
            {
                unsigned* qctr = (unsigned*)(ws + WS_CTL) + CW_Q + 64 * l; volatile LAS unsigned* qw = (volatile LAS unsigned*)(lds + MISC_OFF) + 16;
                for (;;) {
                    if (tid == 0) *qw = __hip_atomic_fetch_add(qctr, 1u, __ATOMIC_RELAXED, __HIP_MEMORY_SCOPE_AGENT);
                    __syncthreads();
                    const int u = (int)*qw;
                    __syncthreads();
                    if (u >= NUNIT_M) break;
                    phase_m3(ap, lds, tid, lane, wave, u, NUNIT_M, l);
                }
            }
        }
        SEAM(pb + 4);
        REP(pb + 6) if (IN(pb + 6)) { REPBAR KArgsP ap = fresh_args(); PHASE_IDS unsigned char* ws = ap->ws; (void)ws;
            pg8::Gemm g{(const pg8::bf16_t*)(ws + WS_YC), (const pg8::bf16_t*)(ws + WS_WOUT) + (size_t)l * DM * DM, NTOK, DM, DM};
            pg8::StaticOrder S; S.init(NTOK, DM, G, bx);
            pg8::EpiResid E{l == 0 ? ap->in[I_X] : (const float*)ap->out, ap->out, (const float*)(ws + WS_MODF) + (size_t)l * 4 * 6144, 2048};
            pg8::gemm_phase<pg8::EpiResid, pg8::StaticOrder, GEMM_ALIGN, GEMM_SP2>(lds, g, S, E);
        }
        SEAM(pb + 6);
#if EN_MOE
        REP(pb + 7) if (IN(pb + 7)) { REPBAR KArgsP ap = fresh_args(); PHASE_IDS phase_router(ap, lds, tid, lane, wave, G, l); __syncthreads();
            moe_convert13(ap->in[I_MW1], ap->in[I_MW3], l, (bf16*)(ap->ws + WS_W13), vcu * NWAVES + wave, G * NWAVES, (LAS float*)(lds + wave * 16640), lane);
            moe_convert2(ap->in[I_MW2], l, (bf16*)(ap->ws + WS_W2), vcu * NWAVES + wave, G * NWAVES, (LAS float*)(lds + wave * 16640), lane); }
        SEAM(pb + 7);
        REP(pb + 8) if (IN(pb + 8)) { REPBAR KArgsP ap = fresh_args(); PHASE_IDS unsigned char* ws = ap->ws; (void)ws;
            LAS int* ptab = (LAS int*)(lds + PTAB_OFF); LAS int* pst = ptab + 512; LAS int* cnt = pst + 32;
            build_ptab((const unsigned*)(ws + WS_CTL) + CW_CNT + l * 32, ptab, pst, cnt, tid);
            pg8::Gemm g{(const pg8::bf16_t*)(ws + WS_HN), (const pg8::bf16_t*)(ws + WS_W13), 0, 0, DM, (const int*)(ws + WS_LIST), ptab};
            pg8::MoeOrder S{ptab, G, vcu};
            pg8::EpiSwiglu E{(pg8::bf16_t*)(ws + WS_HMID)};
            pg8::gemm_phase<pg8::EpiSwiglu, pg8::MoeOrder, false, true, true>(lds, g, S, E);
        }
        SEAM(pb + 8);
        REP(pb + 9) if (IN(pb + 9)) { REPBAR KArgsP ap = fresh_args(); PHASE_IDS unsigned char* ws = ap->ws; (void)ws;
            LAS int* ptab = (LAS int*)(lds + PTAB_OFF); LAS int* pst = ptab + 512; LAS int* cnt = pst + 32;
            build_ptab((const unsigned*)(ws + WS_CTL) + CW_CNT + l * 32, ptab, pst, cnt, tid);
            pg8::Gemm g{(const pg8::bf16_t*)(ws + WS_HMID), (const pg8::bf16_t*)(ws + WS_W2), 0, 0, DEXP};
            pg8::MoeOrder S{ptab, G, vcu};
            pg8::EpiMoeOut E{(pg8::bf16_t*)(ws + WS_YMOE), (const int*)(ws + WS_LIST), ptab};
            pg8::gemm_phase<pg8::EpiMoeOut, pg8::MoeOrder, true, true>(lds, g, S, E);
        }
        SEAM(pb + 9);
#else
        SEAM(pb + 6); SEAM(pb + 7); SEAM(pb + 8); SEAM(pb + 9);
#endif
    }
#undef LCONST
#endif
    if (IN(PH_FINAL)) { KArgsP ap = fresh_args(); PHASE_IDS
#if EN_MOE
        if (N_LAYERS > 0) phase_rownorm<1, true>(ap, lds, tid, lane, wave, G, ap->out, ap->out, ap->in[I_NORM_FINAL], false, 0, 0, N_LAYERS - 1);
        else phase_rownorm<1, false>(ap, lds, tid, lane, wave, G, ap->in[I_X], ap->out, ap->in[I_NORM_FINAL], false, 0, 0, 0);
#else
        phase_rownorm<1, false>(ap, lds, tid, lane, wave, G, N_LAYERS > 0 ? (const float*)ap->out : ap->in[I_X], ap->out, ap->in[I_NORM_FINAL], false, 0, 0, 0);
#endif
    }
#undef IN
#undef SEAM
}

extern "C" void kernel_launch(void* const* d_in, const int* in_sizes, int n_in, void* d_out, int out_size, void* d_ws, size_t ws_size, hipStream_t stream) {
    static int grid = 0;
    if (grid == 0) {
        if (n_in != 47 || out_size != NTOK * DM || ws_size < WS_END) { fprintf(stderr, "kernel_launch: unexpected problem (n_in %d, out %d, ws %zu < %zu)\n", n_in, out_size, ws_size, (size_t)WS_END); grid = -1; return; }
        int dev = 0, cus = 0, per_cu = 0;
        if (hipGetDevice(&dev) != hipSuccess || hipDeviceGetAttribute(&cus, hipDeviceAttributeMultiprocessorCount, dev) != hipSuccess) { grid = -1; return; }
        if (hipFuncSetAttribute((const void*)fwd, hipFuncAttributeMaxDynamicSharedMemorySize, LDS_BYTES) != hipSuccess) { fprintf(stderr, "kernel_launch: hipFuncSetAttribute failed\n"); grid = -1; return; }
        if (hipOccupancyMaxActiveBlocksPerMultiprocessor(&per_cu, (const void*)fwd, NTHR, LDS_BYTES) != hipSuccess || per_cu < 1) fprintf(stderr, "kernel_launch: occupancy query says %d\n", per_cu);
        (void)hipGetLastError();
        grid = cus;
        if (grid != 256) fprintf(stderr, "kernel_launch: %d CUs (built for 256)\n", grid);
    }
    if (grid < 0) return;
    (void)hipMemsetAsync((char*)d_ws + WS_CTL, 0, CTL_ZERO_BYTES, stream);
    Args a{};
    for (int i = 0; i < 47; ++i) a.in[i] = (const float*)d_in[i];
    a.out = (float*)d_out; a.ws = (unsigned char*)d_ws;
#if MK_PER_PHASE
    for (int p = 0; p < N_PHASES; ++p) { a.ph_lo = p; a.ph_hi = p + 1; hipLaunchKernelGGL(fwd, dim3(grid), dim3(NTHR), LDS_BYTES, stream, a); }
#else
    a.ph_lo = 0; a.ph_hi = N_PHASES; hipLaunchKernelGGL(fwd, dim3(grid), dim3(NTHR), LDS_BYTES, stream, a);
#endif
}
#ifdef DIAG_KERNELS
#define DK(name, ...) __global__ void __launch_bounds__(NTHR, 2) name(Args args) { extern __shared__ __attribute__((aligned(16))) unsigned char lds_raw[]; LAS unsigned char* lds = (LAS unsigned char*)lds_raw; \
    const int tid = threadIdx.x, lane = tid & 63, wave = __builtin_amdgcn_readfirstlane(tid >> 6); const int G = gridDim.x; const int bx = blockIdx.x; const int vcu = bx; KArgsP ap = fresh_args(); int l = ap->ph_lo; (void)lane; (void)wave; (void)vcu; (void)G; (void)l; __VA_ARGS__ }
DK(k_prologue, phase_prologue(ap, lds, tid, lane, wave, vcu, G);)
DK(k_norm0, phase_rownorm<0, false>(ap, lds, tid, lane, wave, G, ap->in[I_X], ap->out, ap->in[I_NORM_MIX], true, 0, 0, 0);)
DK(k_norm1, phase_rownorm<0, true>(ap, lds, tid, lane, wave, G, ap->out, ap->out, ap->in[I_NORM_MIX], false, l, 0, 0);)
DK(k_normf, phase_rownorm<1, true>(ap, lds, tid, lane, wave, G, ap->out, ap->out, ap->in[I_NORM_MIX], false, l, 0, 0);)
DK(k_m1, phase_m1(ap, lds, tid, lane, wave, vcu, G, l);)
DK(k_m2, phase_m2(ap->ws, tid, vcu, G);)
DK(k_m3, phase_m3(ap, lds, tid, lane, wave, vcu, G, l);)
DK(k_s1, phase_s1(ap, lds, tid, lane, wave, vcu, G, l);)
DK(k_s2, phase_s2(ap, tid, vcu, G, l);)
DK(k_s3, phase_s3(ap, lds, tid, lane, wave, vcu, G, l);)
DK(k_r1, phase_r1(ap, lds, tid, lane, wave, vcu, G, l);)
DK(k_r2b, phase_r2_build(ap, lds, tid, lane, wave, vcu, G, l);)
DK(k_r2s, phase_r2_scan(ap, lds, tid, lane, wave, vcu, l);)
DK(k_r3, phase_r3(ap, lane, vcu * NWAVES + wave, G * NWAVES, l);)
DK(k_router, phase_router(ap, lds, tid, lane, wave, G, l);)
DK(k_gather, phase_gather(ap, lds, tid, lane, wave, vcu, G, l);)
DK(k_moecv, moe_convert13(ap->in[I_MW1], ap->in[I_MW3], 1, (bf16*)(ap->ws + WS_W13), vcu * NWAVES + wave, G * NWAVES, (LAS float*)(lds + wave * 16640), lane);)
#endif
```

```cpp
#include <hip/hip_runtime.h>
#include <cstdio>
#include <cstdint>
#define MK_PER_PHASE 0
#define RS_DEPTH 4

#ifndef MK_PER_PHASE
#define MK_PER_PHASE 0
#endif
#ifndef EN_MLSTM
#define EN_MLSTM 1
#endif
#ifndef EN_S5
#define EN_S5 1
#endif
#ifndef EN_RWKV
#define EN_RWKV 1
#endif
#ifndef EN_MOE
#define EN_MOE 1
#endif
#ifndef N_LAYERS
#define N_LAYERS 2
#endif
constexpr int NWAVES = 8, NTHR = 512;
constexpr int DM = 1024, NB = 4, SEQ = 8192, NTOK = NB * SEQ;
constexpr int DA = 384, DBR = 384, DC = 256, NH = 6, HD = 64, NCH = SEQ / 64;
constexpr int IN_COLS = 2828, NPROJ = 2816, NPROJ_PAD = 3072;
constexpr int PC_QK = 0, PC_V = 384, PC_O = 768, PC_RW = 1152, PC_S5 = 2560;
constexpr int RWC_R = 0, RWC_K = 384, RWC_V = 768, RWC_WD = 1152, RWC_AD = 1216, RWC_GD = 1280, RW_COLS = 1408;
constexpr int NEXP = 32, DEXP = 512, MOE_ROWS_MAX = 73728;
constexpr int NUNIT_M = NB * NCH * NH;
constexpr int CL_STRIDE = 4160;
constexpr float NORM_EPS = 1e-6f, HEAD_NORM_EPS = 1e-5f, RWKV_GN_EPS = 64e-5f;

constexpr size_t MiB = 1u << 20;
constexpr size_t WS_CTL = 0, CTL_ZERO_BYTES = 1 * MiB;
constexpr size_t WS_MODP = 1 * MiB;
constexpr size_t WS_MODF = 2 * MiB + 512 * 1024;
constexpr size_t WS_S5BB = 2 * MiB + 896 * 1024;
constexpr size_t WS_RTW = 3 * MiB;
constexpr size_t WS_S5AP = 3 * MiB + 384 * 1024;
constexpr size_t WS_MLW = 3 * MiB + 512 * 1024;
constexpr size_t WS_S5CM = 2 * MiB + 768 * 1024;
constexpr size_t WS_GLUT = 3 * MiB + 768 * 1024;
constexpr size_t WS_WIN = 4 * MiB;
constexpr size_t WS_WOUT = 16 * MiB;
constexpr size_t WS_GATES = 20 * MiB;
constexpr size_t WS_W13 = 22 * MiB;
constexpr size_t WS_W2 = 86 * MiB;
constexpr size_t WS_HN = 118 * MiB;
constexpr size_t WS_CLOC = 118 * MiB;
constexpr size_t WS_MSC = 168 * MiB;
constexpr size_t WS_S5ST = 170 * MiB;
constexpr size_t WS_VF = 182 * MiB;
constexpr size_t WS_YC = 206 * MiB;
constexpr size_t WS_LIST = 206 * MiB;
constexpr size_t WS_ROWMAP = 214 * MiB;
constexpr size_t WS_TOKE = 215 * MiB;
constexpr size_t WS_TOKW = 215 * MiB + 512 * 1024;
constexpr size_t WS_PROJ = 270 * MiB;
constexpr size_t WS_RE = 446 * MiB, WS_RA = 470 * MiB, WS_RG = 494 * MiB, WS_RVG = 518 * MiB;
constexpr size_t WS_XG = 270 * MiB;
constexpr size_t WS_HMID = 414 * MiB;
constexpr size_t WS_YMOE = 270 * MiB;
constexpr size_t WS_R1W = 542 * MiB;
constexpr size_t WS_OPA = 22 * MiB;
constexpr size_t WS_OPB = 543 * MiB;
constexpr size_t WS_END = 591 * MiB;
constexpr int CW_TMO = 0, CW_BAR = 4096, CW_CNT = 8192, CW_Q = 8320;

constexpr int RING_BYTES = 131072, MISC_OFF = 135168, PTAB_OFF = MISC_OFF + 1024, LDS_BYTES = 147456;

#define GAS __attribute__((address_space(1)))
#define LAS __attribute__((address_space(3)))
typedef unsigned short bf16;
typedef unsigned v4u __attribute__((ext_vector_type(4)));
typedef unsigned v2u __attribute__((ext_vector_type(2)));
typedef float f32x4 __attribute__((ext_vector_type(4)));
typedef float f32x2 __attribute__((ext_vector_type(2)));
typedef GAS unsigned gu32;
#define RLX_AGENT __ATOMIC_RELAXED, __HIP_MEMORY_SCOPE_AGENT
#define LDS_WAIT() asm volatile("s_waitcnt lgkmcnt(0)" ::: "memory")
#define VM_WAIT() asm volatile("s_waitcnt vmcnt(0)" ::: "memory")
typedef float f32x2v __attribute__((ext_vector_type(2)));
typedef __bf16 bf16x2v __attribute__((ext_vector_type(2)));
__device__ __forceinline__ unsigned pk2(float lo, float hi) { const f32x2v v = {lo, hi}; const bf16x2v b = __builtin_convertvector(v, bf16x2v); return __builtin_bit_cast(unsigned, b); }
__device__ __forceinline__ unsigned f2bf(float f) { return pk2(f, 0.f) & 0xffffu; }
__device__ __forceinline__ float bf2f(unsigned v) { return __builtin_bit_cast(float, v << 16); }
__device__ __forceinline__ float bflo(unsigned w) { return __builtin_bit_cast(float, w << 16); }
__device__ __forceinline__ float bfhi(unsigned w) { return __builtin_bit_cast(float, w & 0xffff0000u); }
__device__ __forceinline__ float sigmoidf_(float x) { return 1.f / (1.f + __expf(-x)); }
__device__ __forceinline__ float wave_sum(float v) {
#pragma unroll
    for (int o = 1; o < 64; o <<= 1) v += __shfl_xor(v, o);
    return v;
}
__device__ __forceinline__ float wave_max(float v) {
#pragma unroll
    for (int o = 1; o < 64; o <<= 1) v = fmaxf(v, __shfl_xor(v, o));
    return v;
}
namespace pg8 {
#define PG8_LAS __attribute__((address_space(3)))
typedef unsigned short bf16_t;
typedef short bf16x8 __attribute__((ext_vector_type(8)));
typedef float f32x4 __attribute__((ext_vector_type(4)));
typedef unsigned u32x4 __attribute__((ext_vector_type(4)));
constexpr int BM = 256, BK = 64, HALF = 128, HTB = HALF * BK * 2  , STAGE_BYTES = 8 * HTB, NXCD = 8, WGM = 8;

__host__ __device__ __forceinline__ int lds_byte(int r, int c) { const int st = (r >> 4) * 2 + (c >> 5), rr = r & 15, cc = c & 31, ob = rr * 64 + cc * 2; return st * 1024 + (ob ^ (((ob >> 9) & 1) << 5)); }
__host__ __device__ __forceinline__ void stage_rc(int b, int& R, int& C) { const int st = b / 1024, sb = b % 1024, swz = sb ^ (((sb >> 9) & 1) << 5); R = (st >> 1) * 16 + swz / 64; C = (st & 1) * 32 + (swz % 64) / 2; }
__host__ __device__ __forceinline__ int perm32(int rho) { const int n = rho >> 4, i = rho & 15; return 8 * (i >> 2) + 4 * n + (i & 3); }

struct Unit { int pm, pn; };
__device__ __forceinline__ int moe_tok2(const int* list, PG8_LAS const int* ptab, int row) { const int e = ptab[1 + (row >> 8)], pos = row - ptab[512 + e]; return pos < ptab[544 + e] ? list[(size_t)e * 65536 + pos] : -1; }
struct Gemm { const bf16_t* A; const bf16_t* Bt; int M, N, K; const int* list = nullptr; PG8_LAS const int* ptab = nullptr; };

struct StaticOrder {
    int nM, nN, nwg, G, c;
    __host__ __device__ void init(int M, int N, int G_, int c_) { nM = M / BM; nN = N / BM; nwg = nM * nN; G = G_; c = c_; }
    __host__ __device__ bool next(int i, Unit& u) const {
        const long L = (long)i * G + c; if (L >= nwg) return false;
        int wgid = (int)L; { const int q = nwg / NXCD, r = nwg % NXCD, xcd = wgid % NXCD, off = wgid / NXCD; wgid = (xcd < r ? xcd * (q + 1) : r * (q + 1) + (xcd - r) * q) + off; }
        const int nig = WGM * nN, gid = wgid / nig, fm = gid * WGM, gsz = (nM - fm) < WGM ? (nM - fm) : WGM;
        u.pm = fm + ((wgid % nig) % gsz); u.pn = (wgid % nig) / gsz; return true;
    }
    __device__ __forceinline__ void a_ready(const Unit&) const {}
    __device__ __forceinline__ void done(const Unit&) const {}
};

__device__ __forceinline__ unsigned cvt_pk_bf16(float lo, float hi) { unsigned r; asm volatile("v_cvt_pk_bf16_f32 %0, %1, %2" : "=v"(r) : "v"(lo), "v"(hi)); return r; }

struct EpiProj {
    static constexpr bool PERM = true, AFTER_DRAIN = false;
    bf16_t* O; float* G;
    __device__ __forceinline__ void operator()(const f32x4 (&acc)[2][2][4][2], const Unit& u, int wr, int wc, int fr, int fq) const {
        const int row0 = u.pm * BM + wr * 64 + fr;
        if (u.pn < 11) {
            const int col0 = u.pn * BM + wc * 32 + 8 * fq;
#pragma unroll
            for (int ai = 0; ai < 2; ++ai)
#pragma unroll
                for (int m = 0; m < 4; ++m) { bf16_t* rowp = O + (size_t)(row0 + ai * HALF + m * 16) * 2816 + col0;
#pragma unroll
                    for (int bj = 0; bj < 2; ++bj) { const f32x4 v0 = acc[ai][bj][m][0], v1 = acc[ai][bj][m][1];
                        u32x4 w; w.x = cvt_pk_bf16(v0[0], v0[1]); w.y = cvt_pk_bf16(v0[2], v0[3]); w.z = cvt_pk_bf16(v1[0], v1[1]); w.w = cvt_pk_bf16(v1[2], v1[3]);
                        *(u32x4*)(rowp + bj * HALF) = w; } }
        } else if (wc == 0 && fq < 2) {
#pragma unroll
            for (int ai = 0; ai < 2; ++ai)
#pragma unroll
                for (int m = 0; m < 4; ++m) { float* rowp = G + (size_t)(row0 + ai * HALF + m * 16) * 16 + 8 * fq;
                    *(f32x4*)(rowp) = acc[ai][0][m][0]; *(f32x4*)(rowp + 4) = acc[ai][0][m][1]; }
        }
    }
};
struct EpiResid {
    static constexpr bool PERM = true, AFTER_DRAIN = false;
    const float* xin; float* out; const float* gate;
    int goff;
    __device__ __forceinline__ void operator()(const f32x4 (&acc)[2][2][4][2], const Unit& u, int wr, int wc, int fr, int fq) const {
        const int row0 = u.pm * BM + wr * 64 + fr, col0 = u.pn * BM + wc * 32 + 8 * fq;
        const float* gp = gate + (size_t)(row0 >> 13) * 6144 + goff + col0;
        f32x4 g[2][2];
#pragma unroll
        for (int bj = 0; bj < 2; ++bj)
#pragma unroll
            for (int n = 0; n < 2; ++n) g[bj][n] = *(const f32x4*)(gp + bj * HALF + 4 * n) + 1.0f;
#pragma unroll
        for (int ai = 0; ai < 2; ++ai)
#pragma unroll
            for (int m = 0; m < 4; ++m) { const size_t off = (size_t)(row0 + ai * HALF + m * 16) * 1024 + col0;
#pragma unroll
                for (int bj = 0; bj < 2; ++bj)
#pragma unroll
                    for (int n = 0; n < 2; ++n) { const f32x4 xv = *(const f32x4*)(xin + off + bj * HALF + 4 * n);
                        *(f32x4*)(out + off + bj * HALF + 4 * n) = xv + g[bj][n] * acc[ai][bj][m][n]; } }
    }
};
struct EpiSwiglu {
    static constexpr bool PERM = true, AFTER_DRAIN = false;
    bf16_t* H;
    __device__ __forceinline__ void operator()(const f32x4 (&acc)[2][2][4][2], const Unit& u, int wr, int wc, int fr, int fq) const {
        const int row0 = u.pm * BM + wr * 64 + fr, hid0 = 128 * (u.pn & 3) + 16 * wc + 4 * fq;
#pragma unroll
        for (int ai = 0; ai < 2; ++ai)
#pragma unroll
            for (int m = 0; m < 4; ++m) { bf16_t* rowp = H + (size_t)(row0 + ai * HALF + m * 16) * 512 + hid0;
#pragma unroll
                for (int bj = 0; bj < 2; ++bj) { const f32x4 g = acc[ai][bj][m][0], uu = acc[ai][bj][m][1]; float h[4];
#pragma unroll
                    for (int i = 0; i < 4; ++i) h[i] = g[i] / (1.f + __expf(-g[i])) * uu[i];
                    unsigned w0 = cvt_pk_bf16(h[0], h[1]), w1 = cvt_pk_bf16(h[2], h[3]);
                    *(unsigned long long*)(rowp + 64 * bj) = (unsigned long long)w0 | ((unsigned long long)w1 << 32); } }
    }
};
struct EpiMoeOut {
    static constexpr bool PERM = true, AFTER_DRAIN = false;
    bf16_t* Y; const int* list; PG8_LAS const int* ptab;
    __device__ __forceinline__ void operator()(const f32x4 (&acc)[2][2][4][2], const Unit& u, int wr, int wc, int fr, int fq) const {
        const int row0 = u.pm * BM + wr * 64 + fr, col0 = (u.pn & 3) * BM + wc * 32 + 8 * fq;
#pragma unroll
        for (int ai = 0; ai < 2; ++ai)
#pragma unroll
            for (int m = 0; m < 4; ++m) { const int dst = moe_tok2(list, ptab, row0 + ai * HALF + m * 16);
                if (dst >= 0) { bf16_t* rowp = Y + (size_t)dst * 1024 + col0;
#pragma unroll
                    for (int bj = 0; bj < 2; ++bj) { const f32x4 v0 = acc[ai][bj][m][0], v1 = acc[ai][bj][m][1];
                        u32x4 w; w.x = cvt_pk_bf16(v0[0], v0[1]); w.y = cvt_pk_bf16(v0[2], v0[3]); w.z = cvt_pk_bf16(v1[0], v1[1]); w.w = cvt_pk_bf16(v1[2], v1[3]);
                        *(u32x4*)(rowp + bj * HALF) = w; } } }
    }
};
struct MoeOrder {
    PG8_LAS const int* ptab; int G, c;
    __device__ __forceinline__ bool next(int i, Unit& u) const {
        const int L = i * G + c, np = __builtin_amdgcn_readfirstlane(ptab[0]);
        if (L >= np * 4) return false;
        const int p = L >> 2; u.pm = p; u.pn = __builtin_amdgcn_readfirstlane(ptab[1 + p]) * 4 + (L & 3); return true;
    }
    __device__ __forceinline__ void a_ready(const Unit&) const {}
    __device__ __forceinline__ void done(const Unit&) const {}
};
template <class Epi, class Sched, bool ALIGN_EPI = false, bool SP2 = false, bool GATHER = false>
__device__ __forceinline__ void gemm_phase(PG8_LAS unsigned char* lds, const Gemm g, const Sched& S, const Epi& E) {
    const int tid = threadIdx.x, wid = __builtin_amdgcn_readfirstlane(tid >> 6), lane = tid & 63, wr = wid >> 2, wc = wid & 3, fr = lane & 15, fq = lane >> 4;
    const int K = g.K, nt = K / BK;
    static_assert(!GATHER || SP2, "the gathered-A variant exists for the SP2 loop only");
    unsigned voffA[2], voffB[2];
    unsigned vAc[2] = {0u, 0u}, vAn[2] = {0u, 0u};
#pragma unroll
    for (int i = 0; i < 2; ++i) { int R, C; stage_rc(tid * 16 + i * 8192, R, C); const int Rb = Epi::PERM ? ((R & ~31) + perm32(R & 31)) : R;
        voffA[i] = (unsigned)(R * K + C) * 2u; voffB[i] = (unsigned)(Rb * K + C) * 2u; }
    const size_t kstep = (size_t)(BK * 2);
    const size_t hstep = (size_t)HALF * K * 2;
    const size_t tstep = 2 * hstep;
    const unsigned ldsw = (unsigned)wid * 1024u;
    const int aoff = lds_byte(wr * 64 + fr, fq * 8), boff = lds_byte(wc * 32 + fr, fq * 8);
#define PG8_SA(b, h) (((b) * 2 + (h)) * HTB)
#define PG8_SB(b, h) ((4 + (b) * 2 + (h)) * HTB)
#define PG8_STAGE(bufoff, gbase, voff) do { _Pragma("unroll") for (int _i = 0; _i < 2; ++_i) \
        __builtin_amdgcn_global_load_lds((const unsigned*)((const char*)(gbase) + (voff)[_i]), (PG8_LAS unsigned*)(lds + (bufoff) + ldsw + _i * 8192), 16, 0, 0); } while (0)
#define PG8_STAGEG(bufoff, base, pk) do { unsigned vg_[2]; _Pragma("unroll") for (int i_ = 0; i_ < 2; ++i_) { int R_, C_; stage_rc(tid * 16 + i_ * 8192, R_, C_); vg_[i_] = (((pk) >> (16 * i_)) & 0xffffu) * (unsigned)(2 * K) + (unsigned)(2 * C_); } PG8_STAGE(bufoff, base, vg_); } while (0)
#define PG8_STAGEA(bufoff, base, hh, nx) do { if constexpr (GATHER) { const unsigned pk_ = (nx) ? vAn[hh] : vAc[hh]; PG8_STAGEG(bufoff, base, pk_); } else PG8_STAGE(bufoff, (base) + (hh) * hstep, voffA); } while (0)
#define PG8_GOFF(dst, unit) do { _Pragma("unroll") for (int hh_ = 0; hh_ < 2; ++hh_) { unsigned pk_ = 0u; _Pragma("unroll") for (int i_ = 0; i_ < 2; ++i_) { int R_, C_; stage_rc(tid * 16 + i_ * 8192, R_, C_); \
        const int t2_ = moe_tok2(g.list, g.ptab, (unit).pm * BM + hh_ * HALF + R_); pk_ |= (unsigned)(t2_ < 0 ? 0 : (t2_ >> 1)) << (16 * i_); } dst[hh_] = pk_; } } while (0)
#define PG8_LDA(dst, b, h) do { _Pragma("unroll") for (int m = 0; m < 4; ++m) _Pragma("unroll") for (int k = 0; k < 2; ++k) dst[m][k] = *(const PG8_LAS bf16x8*)(lds + PG8_SA(b, h) + aoff + m * 2048 + k * 1024); } while (0)
#define PG8_LDB(dst, b, h) do { _Pragma("unroll") for (int n = 0; n < 2; ++n) _Pragma("unroll") for (int k = 0; k < 2; ++k) dst[n][k] = *(const PG8_LAS bf16x8*)(lds + PG8_SB(b, h) + boff + n * 2048 + k * 1024); } while (0)
#define PG8_MMA(ai, bj, At, Bt) do { __builtin_amdgcn_s_setprio(1); _Pragma("unroll") for (int m = 0; m < 4; ++m) _Pragma("unroll") for (int n = 0; n < 2; ++n) _Pragma("unroll") for (int k = 0; k < 2; ++k) \
        acc[ai][bj][m][n] = __builtin_amdgcn_mfma_f32_16x16x32_bf16(Bt[n][k], At[m][k], acc[ai][bj][m][n], 0, 0, 0); __builtin_amdgcn_s_setprio(0); } while (0)
#define PG8_WAIT_V(n) asm volatile("s_waitcnt vmcnt(" #n ")" ::: "memory")
#define PG8_WAIT_L(n) asm volatile("s_waitcnt lgkmcnt(" #n ")" ::: "memory")
#define PG8_BAR __builtin_amdgcn_s_barrier()
#define PG8_SCHED __builtin_amdgcn_sched_barrier(0)
    Unit cur, nxt; int ui = 0;
    if (!S.next(0, cur)) return;
    f32x4 acc[2][2][4][2];
#pragma unroll
    for (int a = 0; a < 2; ++a)
#pragma unroll
        for (int b = 0; b < 2; ++b)
#pragma unroll
            for (int m = 0; m < 4; ++m)
#pragma unroll
                for (int n = 0; n < 2; ++n) acc[a][b][m][n] = (f32x4){0.f, 0.f, 0.f, 0.f};
    bf16x8 At[4][2], B0[2][2], B1[2][2];
    const char* cA = (const char*)g.A + (GATHER ? (size_t)0 : (size_t)cur.pm * tstep); const char* cB = (const char*)g.Bt + (size_t)cur.pn * tstep;
    if constexpr (GATHER) { PG8_GOFF(vAc, cur); }
    S.a_ready(cur);
    if constexpr (SP2) {
        PG8_STAGE(PG8_SB(0, 0), cB, voffB); PG8_STAGE(PG8_SB(0, 1), cB + hstep, voffB); PG8_STAGEA(PG8_SA(0, 0), cA, 0, false); PG8_STAGEA(PG8_SA(0, 1), cA, 1, false);
        if (wr == 1) PG8_BAR;
        PG8_WAIT_V(2); PG8_BAR;
        PG8_STAGE(PG8_SB(1, 0), cB + kstep, voffB); PG8_STAGEA(PG8_SA(1, 0), cA + kstep, 0, false); PG8_STAGE(PG8_SB(1, 1), cB + hstep + kstep, voffB);
        PG8_WAIT_V(6); PG8_BAR;
    } else {
        PG8_STAGE(PG8_SB(0, 0), cB, voffB); PG8_STAGE(PG8_SA(0, 0), cA, voffA); PG8_STAGE(PG8_SB(0, 1), cB + hstep, voffB); PG8_STAGE(PG8_SA(0, 1), cA + hstep, voffA);
        if (wr == 1) PG8_BAR;
        PG8_WAIT_V(4); PG8_BAR;
        PG8_STAGE(PG8_SB(1, 0), cB + kstep, voffB); PG8_STAGE(PG8_SA(1, 0), cA + kstep, voffA); PG8_STAGE(PG8_SB(1, 1), cB + hstep + kstep, voffB);
        PG8_WAIT_V(6); PG8_BAR;
    }
    for (;;) {
        const bool has_next = S.next(ui + 1, nxt);
        const char* nA = (has_next && !GATHER) ? (const char*)g.A + (size_t)nxt.pm * tstep : cA;
        if constexpr (GATHER) { if (has_next) { PG8_GOFF(vAn, nxt); } else { vAn[0] = vAc[0]; vAn[1] = vAc[1]; } } const char* nB = has_next ? (const char*)g.Bt + (size_t)nxt.pn * tstep : cB;
        for (int t = 0; t < nt; t += 2) {
            const bool last = (t == nt - 2);
            const char* a1 = cA + (size_t)(t + 1) * kstep;
            const char* a2 = last ? nA : cA + (size_t)(t + 2) * kstep; const char* b2 = last ? nB : cB + (size_t)(t + 2) * kstep;
            const char* a3 = a2 + kstep; const char* b3 = b2 + kstep;
            if (last && has_next) S.a_ready(nxt);
            if constexpr (SP2) {
            PG8_LDB(B0, 0, 0); PG8_LDB(B1, 0, 1); PG8_SCHED; PG8_LDA(At, 0, 0); PG8_STAGEA(PG8_SA(1, 1), a1, 1, false);
            PG8_WAIT_V(8); PG8_WAIT_L(0); PG8_BAR; PG8_MMA(0, 0, At, B0); PG8_MMA(0, 1, At, B1); PG8_BAR; PG8_SCHED;
            PG8_LDA(At, 0, 1); PG8_STAGE(PG8_SB(0, 0), b2, voffB); PG8_STAGE(PG8_SB(0, 1), b2 + hstep, voffB); PG8_STAGEA(PG8_SA(0, 0), a2, 0, last);
            PG8_WAIT_V(8); PG8_WAIT_L(0); PG8_BAR; PG8_MMA(1, 0, At, B0); PG8_MMA(1, 1, At, B1); PG8_BAR; PG8_SCHED;
            PG8_LDB(B0, 1, 0); PG8_LDB(B1, 1, 1); PG8_SCHED; PG8_LDA(At, 1, 0); PG8_STAGEA(PG8_SA(0, 1), a2, 1, last);
            PG8_WAIT_V(8); PG8_WAIT_L(0); PG8_BAR; PG8_MMA(0, 0, At, B0); PG8_MMA(0, 1, At, B1); PG8_BAR; PG8_SCHED;
            PG8_LDA(At, 1, 1); PG8_STAGE(PG8_SB(1, 0), b3, voffB); PG8_STAGE(PG8_SB(1, 1), b3 + hstep, voffB); PG8_STAGEA(PG8_SA(1, 0), a3, 0, last);
            PG8_WAIT_V(8); PG8_WAIT_L(0); PG8_BAR; PG8_MMA(1, 0, At, B0); PG8_MMA(1, 1, At, B1); PG8_BAR; PG8_SCHED;
            } else {
            PG8_LDB(B0, 0, 0); PG8_SCHED; PG8_LDA(At, 0, 0); PG8_STAGE(PG8_SA(1, 1), a1 + hstep, voffA);
            PG8_WAIT_L(8); PG8_BAR; PG8_WAIT_L(0); PG8_MMA(0, 0, At, B0); PG8_BAR; PG8_SCHED;
            PG8_LDB(B1, 0, 1); PG8_STAGE(PG8_SB(0, 0), b2, voffB);
            PG8_BAR; PG8_WAIT_L(0); PG8_MMA(0, 1, At, B1); PG8_BAR;
            PG8_LDA(At, 0, 1); PG8_STAGE(PG8_SA(0, 0), a2, voffA);
            PG8_BAR; PG8_WAIT_L(0); PG8_MMA(1, 0, At, B0); PG8_BAR; PG8_SCHED;
            PG8_STAGE(PG8_SB(0, 1), b2 + hstep, voffB);
            PG8_WAIT_V(6); PG8_BAR; PG8_MMA(1, 1, At, B1); PG8_BAR;
            PG8_LDB(B0, 1, 0); PG8_SCHED; PG8_LDA(At, 1, 0); PG8_STAGE(PG8_SA(0, 1), a2 + hstep, voffA);
            PG8_WAIT_L(8); PG8_BAR; PG8_WAIT_L(0); PG8_MMA(0, 0, At, B0); PG8_BAR; PG8_SCHED;
            PG8_LDB(B1, 1, 1); PG8_STAGE(PG8_SB(1, 0), b3, voffB);
            PG8_BAR; PG8_WAIT_L(0); PG8_MMA(0, 1, At, B1); PG8_BAR;
            PG8_LDA(At, 1, 1); PG8_STAGE(PG8_SA(1, 0), a3, voffA);
            PG8_BAR; PG8_WAIT_L(0); PG8_MMA(1, 0, At, B0); PG8_BAR; PG8_SCHED;
            PG8_STAGE(PG8_SB(1, 1), b3 + hstep, voffB);
            PG8_WAIT_V(6); PG8_BAR; PG8_MMA(1, 1, At, B1); PG8_BAR;
            }
        }
        if constexpr (ALIGN_EPI) { if (wr == 0) PG8_BAR; }
        if constexpr (!Epi::AFTER_DRAIN) { E(acc, cur, wr, wc, fr, fq); S.done(cur); }
        if (!has_next) break;
#pragma unroll
        for (int a = 0; a < 2; ++a)
#pragma unroll
            for (int b = 0; b < 2; ++b)
#pragma unroll
                for (int m = 0; m < 4; ++m)
#pragma unroll
                    for (int n = 0; n < 2; ++n) acc[a][b][m][n] = (f32x4){0.f, 0.f, 0.f, 0.f};
        cur = nxt; cA = nA; cB = nB; ++ui;
        if constexpr (GATHER) { vAc[0] = vAn[0]; vAc[1] = vAn[1]; }
        if constexpr (ALIGN_EPI) { if (wr == 1) PG8_BAR; }
    }
    PG8_WAIT_V(0);
    if constexpr (!ALIGN_EPI) { if (wr == 0) PG8_BAR; }
    PG8_BAR;
    if constexpr (Epi::AFTER_DRAIN) { E.fused(acc, cur, wr, wc, fr, fq, lds, wid, lane); S.done(cur); }
#undef PG8_SA
#undef PG8_SB
#undef PG8_STAGE
#undef PG8_STAGEA
#undef PG8_STAGEG
#undef PG8_GOFF
#undef PG8_LDA
#undef PG8_LDB
#undef PG8_MMA
#undef PG8_WAIT_V
#undef PG8_WAIT_L
#undef PG8_BAR
#undef PG8_SCHED
}
}
#define XB_TMO      128
#define XB_XCNT(j)  (256  + 64 * (j))
#define XB_XSUB(j)  (1280 + 64 * (j))
#define XB_XGEN(j)  (2304 + 64 * (j))
#define XB_TOP      3328
#define XB_TOPGEN   3392
#define XCD_BAR_WORDS 3456
#define XB_SPIN_CAP (1u << 18)
#define LAS __attribute__((address_space(3)))

__device__ __forceinline__ unsigned xb_ld(unsigned* p)              { return __hip_atomic_load(p, __ATOMIC_RELAXED, __HIP_MEMORY_SCOPE_AGENT); }
__device__ __forceinline__ unsigned xb_add(unsigned* p, unsigned v) { return __hip_atomic_fetch_add(p, v, __ATOMIC_RELAXED, __HIP_MEMORY_SCOPE_AGENT); }
__device__ __forceinline__ unsigned xb_xcc_id() { return (unsigned)__builtin_amdgcn_s_getreg((3 << 11) | 20) & 0xFu; }
#define XB_SPIN(cond, bar) do { unsigned _sp = 0; while (cond) { __builtin_amdgcn_s_sleep(1); \
    if ((++_sp & 255u) == 0u) { if (xb_ld(&(bar)[XB_TMO])) break; if (_sp > XB_SPIN_CAP) { atomicAdd(&(bar)[XB_TMO], 1u); break; } } } } while (0)

struct XcdBarrier {
    unsigned* bar; unsigned x;
    volatile LAS unsigned* st;
};

__device__ __forceinline__ XcdBarrier xcd_barrier_post(unsigned* bar, volatile LAS unsigned* st) {
    XcdBarrier b; b.bar = bar; b.x = xb_xcc_id(); b.st = st;
    if (threadIdx.x == 0) (void)xb_add(&bar[XB_XCNT(b.x)], 1u);
    return b;
}
__device__ __forceinline__ void xcd_barrier_complete(unsigned* bar, unsigned x, unsigned& nloc, unsigned& nx) {
    const unsigned G = gridDim.x * gridDim.y * gridDim.z;
    unsigned sum, cnt, mine, sp = 0u;
    for (;;) {
        sum = 0u; cnt = 0u; mine = 0u;
#pragma unroll
        for (unsigned j = 0; j < 16; ++j) { const unsigned c = xb_ld(&bar[XB_XCNT(j)]); sum += c; cnt += (c > 0u) ? 1u : 0u; mine = (j == x) ? c : mine; }
        if (sum == G) break;
        __builtin_amdgcn_s_sleep(1);
        if ((++sp & 255u) == 0u) { if (xb_ld(&bar[XB_TMO])) break; if (sp > XB_SPIN_CAP) { atomicAdd(&bar[XB_TMO], 1u); break; } }
    }
    nloc = mine > 0u ? mine : 1u; nx = cnt > 0u ? cnt : 1u;
}

__device__ __forceinline__ void xcd_barrier(const XcdBarrier& b) {
    asm volatile("s_waitcnt vmcnt(0)" ::: "memory");
    __syncthreads();
    if (threadIdx.x == 0) {
        unsigned* bar = b.bar;
        __builtin_amdgcn_s_waitcnt(0);
        unsigned nloc = b.st[0], nx = b.st[1];
        if (nloc == 0u) { xcd_barrier_complete(bar, b.x, nloc, nx); b.st[0] = nloc; b.st[1] = nx; }
        const unsigned old = xb_add(&bar[XB_XSUB(b.x)], 1u);
        const unsigned gen = old / nloc;
        if (old + 1u == (gen + 1u) * nloc) {
            __builtin_amdgcn_fence(__ATOMIC_RELEASE, "agent");
            asm volatile("s_waitcnt vmcnt(0)" ::: "memory");
            const unsigned og = xb_add(&bar[XB_TOP], 1u);
            const unsigned tg = og / nx;
            if (og + 1u == (tg + 1u) * nx) xb_add(&bar[XB_TOPGEN], 1u);
            else XB_SPIN(xb_ld(&bar[XB_TOPGEN]) == tg, bar);
            __builtin_amdgcn_fence(__ATOMIC_ACQUIRE, "agent");
            xb_add(&bar[XB_XGEN(b.x)], 1u);
            asm volatile("s_waitcnt vmcnt(0)" ::: "memory");
        } else {
            XB_SPIN(xb_ld(&bar[XB_XGEN(b.x)]) == gen, bar);
            __builtin_amdgcn_fence(__ATOMIC_ACQUIRE, "agent");
            asm volatile("s_waitcnt vmcnt(0)" ::: "memory");
        }
    }
    __syncthreads();
}

struct Args { const float* in[47]; float* out; unsigned char* ws; int ph_lo, ph_hi; };
typedef const __attribute__((address_space(4))) Args* KArgsP;
__device__ __forceinline__ KArgsP fresh_args() { KArgsP p = (KArgsP)__builtin_amdgcn_kernarg_segment_ptr(); asm volatile("" : "+s"(p)); return p; }
enum { I_X = 0, I_C, I_ADA_W, I_ADA_B, I_NORM_MIX, I_NORM_FFN, I_NORM_FINAL, I_W_IN, I_W_OUT, I_CONV_W, I_CONV_B, I_WQ, I_WK, I_BI, I_BF, I_MNORM_W,
       I_RMU, I_RW0, I_RWUP, I_RA0, I_RAUP, I_RGUP, I_RKK, I_RKA, I_RRK, I_RLNW, I_RLNB, I_RV0, I_RVDN, I_RVUP,
       I_S5ARE, I_S5AIM, I_S5LDT, I_S5BRE, I_S5BIM, I_S5CRE, I_S5CIM, I_S5D, I_S5GLUW, I_S5GLUB,
       I_MWRG, I_MBRG, I_MWRE, I_MBRE, I_MW1, I_MW3, I_MW2 };

struct RmWin { __device__ __forceinline__ int operator()(int n) const { return n < 1152 ? n : (n < 1164 ? 2816 + (n - 1152) : (n < 2572 ? 1152 + (n - 1164) : 2560 + (n - 2572))); } };
struct RmId  { __device__ __forceinline__ int operator()(int n) const { return n; } };
struct RmGU  { int add; __device__ __forceinline__ int operator()(int n) const { return 8 * (n >> 2) + (n & 3) + add; } };
template <class RM>
__device__ __forceinline__ void transpose_item(const float* W, int ldw, int ncols, int k0, int n0, bf16* WT, int ldt, LAS float* scr, int lane, const RM rm) {
    const int nn = n0 + lane; const bool ok = nn < ncols; const float* src = W + (size_t)k0 * ldw + (ok ? nn : n0);
    float v[64];
#pragma unroll
    for (int kk = 0; kk < 64; ++kk) v[kk] = src[(size_t)kk * ldw];
#pragma unroll
    for (int kk = 0; kk < 64; ++kk) scr[kk * 65 + lane] = v[kk];
    LDS_WAIT(); asm volatile("" ::: "memory");
    const int c = lane & 7;
#pragma unroll
    for (int j = 0; j < 8; ++j) { const int nl = (lane >> 3) + 8 * j; const LAS float* s = scr + (8 * c) * 65 + nl;
        v4u o; o.x = pk2(s[0 * 65], s[1 * 65]); o.y = pk2(s[2 * 65], s[3 * 65]); o.z = pk2(s[4 * 65], s[5 * 65]); o.w = pk2(s[6 * 65], s[7 * 65]);
        if (n0 + nl < ncols) *(GAS v4u*)(WT + (size_t)rm(n0 + nl) * ldt + k0 + 8 * c) = o; }
    LDS_WAIT(); asm volatile("" ::: "memory");
}
__device__ __forceinline__ void moe_convert13(const float* w1, const float* w3, int l, bf16* W13, int worker, int nworkers, LAS float* scr, int lane) {
    for (int it = worker; it < NEXP * 256; it += nworkers) {
        const int e = it >> 8, r = it & 255; const size_t eo = (size_t)(l * NEXP + e) * DM * DEXP;
        if (r < 128) transpose_item(w1 + eo, DEXP, DEXP, 64 * (r >> 3), 64 * (r & 7), W13 + (size_t)e * 1024 * 1024, 1024, scr, lane, RmGU{0});
        else         transpose_item(w3 + eo, DEXP, DEXP, 64 * ((r - 128) >> 3), 64 * ((r - 128) & 7), W13 + (size_t)e * 1024 * 1024, 1024, scr, lane, RmGU{4});
    }
}
__device__ __forceinline__ void moe_convert2(const float* w2, int l, bf16* W2T, int worker, int nworkers, LAS float* scr, int lane) {
    for (int it = worker; it < NEXP * 128; it += nworkers) {
        const int e = it >> 7, r = it & 127; const size_t eo = (size_t)(l * NEXP + e) * DM * DEXP;
        transpose_item(w2 + eo, DM, DM, 64 * (r >> 4), 64 * (r & 15), W2T + (size_t)e * 1024 * 512, 512, scr, lane, RmId{});
    }
}
__device__ __forceinline__ void phase_prologue(KArgsP a, LAS unsigned char* lds, int tid, int lane, int wave, int vcu, int G) {
    unsigned char* ws = a->ws;
    LAS float* scr = (LAS float*)(lds + wave * 16640);
    const int gw = vcu * NWAVES + wave, NGW = G * NWAVES;
    bf16* WIN = (bf16*)(ws + WS_WIN); bf16* WOUT = (bf16*)(ws + WS_WOUT);
    for (int it = gw; it < 2 * 16 * 45; it += NGW) { const int l = it / (16 * 45), r = it % (16 * 45);
        transpose_item(a->in[I_W_IN] + (size_t)l * DM * IN_COLS, IN_COLS, IN_COLS, 64 * (r / 45), 64 * (r % 45), WIN + (size_t)l * NPROJ_PAD * DM, DM, scr, lane, RmWin{}); }
    for (int it = gw; it < 2 * 16 * 16; it += NGW) { const int l = it / 256, r = it % 256;
        transpose_item(a->in[I_W_OUT] + (size_t)l * DM * DM, DM, DM, 64 * (r >> 4), 64 * (r & 15), WOUT + (size_t)l * DM * DM, DM, scr, lane, RmId{}); }
    for (int it = gw; it < 2 * 244; it += NGW) { const int l = it / 244, r = 2828 + it % 244; GAS v4u* p = (GAS v4u*)(WIN + ((size_t)l * NPROJ_PAD + r) * DM);
        p[lane] = (v4u){0u, 0u, 0u, 0u}; p[lane + 64] = (v4u){0u, 0u, 0u, 0u}; }
    { float* RTW = (float*)(ws + WS_RTW);
      for (int idx = (vcu * NTHR + tid); idx < 2 * 1024 * 48; idx += G * NTHR) { const int j = idx % 48, k = (idx / 48) % 1024, l = idx / (48 * 1024);
          RTW[idx] = j < 4 ? a->in[I_MWRG][(size_t)(l * 1024 + k) * 4 + j] : (j < 36 ? a->in[I_MWRE][(size_t)(l * 1024 + k) * 32 + (j - 4)] : 0.f); } }
    { bf16* RW = (bf16*)(ws + WS_R1W);
      for (int idx = (vcu * NTHR + tid); idx < 2 * 98304 + 24576; idx += G * NTHR) { float v;
          if (idx < 2 * 98304) { const int l = idx / 98304, r = idx % 98304;
              if (r < 24576)      v = a->in[I_RWUP][(size_t)l * 64 * DBR + (r & 63) * DBR + (r >> 6)];
              else if (r < 49152) v = a->in[I_RAUP][(size_t)l * 64 * DBR + ((r - 24576) & 63) * DBR + ((r - 24576) >> 6)];
              else                v = a->in[I_RGUP][(size_t)l * 128 * DBR + ((r - 49152) & 127) * DBR + ((r - 49152) >> 7)];
          } else { const int r = idx - 2 * 98304;
              if (r < 12288) v = a->in[I_RVDN][(size_t)(r % 384) * 32 + (r / 384)];
              else           v = a->in[I_RVUP][(size_t)((r - 12288) & 31) * DBR + ((r - 12288) >> 5)]; }
          RW[idx] = (bf16)f2bf(v); } }
    for (int idx = (vcu * NTHR + tid); idx < 2 * 16 * 64; idx += G * NTHR) { const int p = idx & 63, lg = idx >> 6;
        const float lam_re = a->in[I_S5ARE][idx], lam_im = a->in[I_S5AIM][idx]; const float dt = expf(a->in[I_S5LDT][lg]); const float mag = expf(lam_re * dt), ang = lam_im * dt;
        const float are = mag * cosf(ang), aim = mag * sinf(ang); const float inv = 1.f / (lam_re * lam_re + lam_im * lam_im);
        const float cre = ((are - 1.f) * lam_re + aim * lam_im) * inv, cim = (aim * lam_re - (are - 1.f) * lam_im) * inv;
        ((float*)(ws + WS_S5AP))[idx * 2] = are; ((float*)(ws + WS_S5AP))[idx * 2 + 1] = aim;
        const float* br = a->in[I_S5BRE] + (size_t)idx * 16; const float* bi = a->in[I_S5BIM] + (size_t)idx * 16; bf16* o = (bf16*)(ws + WS_S5BB) + ((size_t)lg * 128 + 2 * p) * 16;
        for (int c = 0; c < 16; ++c) { o[c] = (bf16)f2bf(cre * br[c] - cim * bi[c]); o[16 + c] = (bf16)f2bf(cre * bi[c] + cim * br[c]); } }
    { bf16* CM = (bf16*)(ws + WS_S5CM);
      for (int idx = (vcu * NTHR + tid); idx < 2 * 16 * 16 * 128; idx += G * NTHR) { const int k = idx & 127, lgc = idx >> 7;
          CM[idx] = (bf16)f2bf((k & 1) ? -a->in[I_S5CIM][(size_t)lgc * 64 + (k >> 1)] : a->in[I_S5CRE][(size_t)lgc * 64 + (k >> 1)]); } }
    for (int it = gw; it < 2 * 16; it += NGW) { const int l = it >> 4, r = it & 15;
        transpose_item(a->in[I_S5GLUW] + (size_t)l * DC * DC, DC, DC, 64 * (r >> 2), 64 * (r & 3), (bf16*)(ws + WS_GLUT) + (size_t)l * DC * DC, DC, scr, lane, RmId{}); }
    { bf16* MLW = (bf16*)(ws + WS_MLW);
      for (int idx = (vcu * NTHR + tid); idx < 2 * NH * 2 * 4096; idx += G * NTHR) { const int d = idx & 63, e = (idx >> 6) & 63, which = (idx >> 12) & 1, lh = idx >> 13;
          MLW[idx] = (bf16)f2bf(a->in[which ? I_WK : I_WQ][(size_t)lh * 4096 + d * 64 + e]); } }
    __syncthreads();
    if (vcu < 192) {
        const int q = vcu, l = q / 96, cb = (q >> 3) % 12, kc = q & 7;
        LAS float* cond = (LAS float*)lds;
        { const int b = tid >> 7, kk = tid & 127; const float cv = a->in[I_C][b * DM + kc * 128 + kk]; cond[tid] = cv / (1.f + __expf(-cv)); }
        __syncthreads();
        const int col = cb * 512 + tid; const float* wp = a->in[I_ADA_W] + ((size_t)l * DM + kc * 128) * 6144 + col;
        float acc0 = 0.f, acc1 = 0.f, acc2 = 0.f, acc3 = 0.f;
#pragma unroll 8
        for (int kk = 0; kk < 128; ++kk) { const float w = wp[(size_t)kk * 6144]; acc0 += cond[kk] * w; acc1 += cond[128 + kk] * w; acc2 += cond[256 + kk] * w; acc3 += cond[384 + kk] * w; }
        const float bias = (kc == 0) ? a->in[I_ADA_B][l * 6144 + col] : 0.f;
        float* MP = (float*)(ws + WS_MODP) + ((size_t)(kc * 2 + l) * 4) * 6144 + col;
        MP[0] = acc0 + bias; MP[6144] = acc1 + bias; MP[2 * 6144] = acc2 + bias; MP[3 * 6144] = acc3 + bias;
    }
}

__device__ __forceinline__ float modval(const unsigned char* ws, bool part, int l, int b, int idx) {
    if (!part) return ((const float*)(ws + WS_MODF))[(size_t)(l * 4 + b) * 6144 + idx];
    const float* mp = (const float*)(ws + WS_MODP) + (size_t)(l * 4 + b) * 6144 + idx; float s = 0.f;
#pragma unroll
    for (int kc = 0; kc < 8; ++kc) s += mp[(size_t)kc * 2 * 4 * 6144];
    return s;
}
template <int MODE, bool COMBINE>
__device__ __forceinline__ void phase_rownorm(KArgsP a, LAS unsigned char* lds, int tid, int lane, int wave, int G,
                                              const float* xsrc, float* xdst, const float* gvec, bool part, int l, int isc  , int lprev) {
    unsigned char* ws = a->ws;
    LAS float* sc = (LAS float*)lds; LAS float* sh = sc + 1024; LAS float* gt = sh + 1024;
    bf16* HN = (bf16*)(ws + WS_HN); const bf16* YM = (const bf16*)(ws + WS_YMOE); const float* TW = (const float*)(ws + WS_TOKW);
    for (int c = blockIdx.x; c < NTOK / 128; c += G) {
        const int b = c >> 6;
        __syncthreads();
        for (int j = tid; j < 1024; j += NTHR) {
            if (MODE == 0) { sc[j] = gvec[j] * (1.f + modval(ws, part, l, b, (isc + 1) * 1024 + j)); sh[j] = modval(ws, part, l, b, isc * 1024 + j); }
            else { sc[j] = gvec[j]; sh[j] = 0.f; }
            if (COMBINE) gt[j] = 1.f + modval(ws, false, lprev, b, 5 * 1024 + j);
        }
        __syncthreads();
        f32x4 vn[4]; v2u yn0[4], yn1[4]; float wn0 = 0.f, wn1 = 0.f;
        { const int row = c * 128 + wave * 16; const GAS f32x4* xr = (const GAS f32x4*)(xsrc + (size_t)row * DM) + lane;
#pragma unroll
          for (int j = 0; j < 4; ++j) vn[j] = xr[64 * j];
          if (COMBINE) { wn0 = TW[2 * row]; wn1 = TW[2 * row + 1]; const GAS v2u* y0 = (const GAS v2u*)(YM + (size_t)(2 * row) * DM) + lane; const GAS v2u* y1 = (const GAS v2u*)(YM + (size_t)(2 * row + 1) * DM) + lane;
#pragma unroll
              for (int j = 0; j < 4; ++j) { yn0[j] = y0[64 * j]; yn1[j] = y1[64 * j]; } } }
        for (int i = 0; i < 16; ++i) {
            const int row = c * 128 + wave * 16 + i;
            f32x4 v[4]; v2u q0[4], q1[4]; const float w0 = wn0, w1 = wn1;
#pragma unroll
            for (int j = 0; j < 4; ++j) { v[j] = vn[j]; q0[j] = yn0[j]; q1[j] = yn1[j]; }
            if (i + 1 < 16) { const int rn = row + 1; const GAS f32x4* xr = (const GAS f32x4*)(xsrc + (size_t)rn * DM) + lane;
#pragma unroll
                for (int j = 0; j < 4; ++j) vn[j] = xr[64 * j];
                if (COMBINE) { wn0 = TW[2 * rn]; wn1 = TW[2 * rn + 1]; const GAS v2u* y0 = (const GAS v2u*)(YM + (size_t)(2 * rn) * DM) + lane; const GAS v2u* y1 = (const GAS v2u*)(YM + (size_t)(2 * rn + 1) * DM) + lane;
#pragma unroll
                    for (int j = 0; j < 4; ++j) { yn0[j] = y0[64 * j]; yn1[j] = y1[64 * j]; } } }
            if (COMBINE) {
#pragma unroll
                for (int j = 0; j < 4; ++j) { const v2u p0 = q0[j], p1 = q1[j]; const f32x4 g4 = *(const LAS f32x4*)(gt + lane * 4 + 256 * j);
                    f32x4 m; m.x = w0 * bflo(p0.x) + w1 * bflo(p1.x); m.y = w0 * bfhi(p0.x) + w1 * bfhi(p1.x); m.z = w0 * bflo(p0.y) + w1 * bflo(p1.y); m.w = w0 * bfhi(p0.y) + w1 * bfhi(p1.y);
                    v[j] = v[j] + g4 * m; }
                if (MODE == 0) { GAS f32x4* xo = (GAS f32x4*)(xdst + (size_t)row * DM) + lane;
#pragma unroll
                    for (int j = 0; j < 4; ++j) xo[64 * j] = v[j]; }
            }
            float ss = 0.f;
#pragma unroll
            for (int j = 0; j < 4; ++j) ss += (v[j].x * v[j].x + v[j].y * v[j].y) + (v[j].z * v[j].z + v[j].w * v[j].w);
            const float rstd = rsqrtf(wave_sum(ss) * (1.f / DM) + NORM_EPS);
            if (MODE == 0) {
                GAS v2u* o = (GAS v2u*)(HN + (size_t)row * DM) + lane;
#pragma unroll
                for (int j = 0; j < 4; ++j) { const f32x4 s4 = *(const LAS f32x4*)(sc + lane * 4 + 256 * j), h4 = *(const LAS f32x4*)(sh + lane * 4 + 256 * j); const f32x4 h = v[j] * rstd * s4 + h4;
                    v2u w; w.x = pk2(h.x, h.y); w.y = pk2(h.z, h.w); o[64 * j] = w; }
            } else {
                GAS f32x4* o = (GAS f32x4*)(xdst + (size_t)row * DM) + lane;
#pragma unroll
                for (int j = 0; j < 4; ++j) { const f32x4 s4 = *(const LAS f32x4*)(sc + lane * 4 + 256 * j); o[64 * j] = v[j] * rstd * s4; }
            }
        }
    }
}
__device__ __forceinline__ void mod_finalize(unsigned char* ws, int tid, int G) {
    float* MF = (float*)(ws + WS_MODF);
    for (int idx = blockIdx.x * NTHR + tid; idx < 2 * 4 * 6144; idx += G * NTHR) { const float* mp = (const float*)(ws + WS_MODP) + idx; float s = 0.f;
#pragma unroll
        for (int kc = 0; kc < 8; ++kc) s += mp[(size_t)kc * 2 * 4 * 6144];
        MF[idx] = s; }
}

typedef float f32x4m __attribute__((ext_vector_type(4)));
__device__ __forceinline__ void phase_router(KArgsP a, LAS unsigned char* lds, int tid, int lane, int wave, int G, int l) {
    unsigned char* ws = a->ws;
    LAS float* sc = (LAS float*)lds; LAS float* sh = sc + 1024; LAS float* rstd_s = sh + 1024  ; LAS float* cvec = rstd_s + 128  ; LAS float* cpart = cvec + 64  ;
    LAS float* lg = cpart + 8 * 48  ; LAS int* hist = (LAS int*)(lg + 8 * 16 * 48)  ; LAS int* basev = hist + 32; LAS int* asg_e = basev + 32  ; LAS int* asg_lp = asg_e + 256;
    bf16* HN = (bf16*)(ws + WS_HN); const float* x = a->out; const float* RTW = (const float*)(ws + WS_RTW) + (size_t)l * 1024 * 48;
    int* TOKE = (int*)(ws + WS_TOKE); float* TOKW = (float*)(ws + WS_TOKW); int* LIST = (int*)(ws + WS_LIST); unsigned* CNT = (unsigned*)(ws + WS_CTL) + CW_CNT + l * 32;
    const float* gvec = a->in[I_NORM_FFN] + l * DM;
    for (int c = blockIdx.x; c < NTOK / 128; c += G) {
        const int b = c >> 6;
        __syncthreads();
        for (int j = tid; j < 1024; j += NTHR) { sc[j] = gvec[j] * (1.f + modval(ws, false, l, b, 4 * 1024 + j)); sh[j] = modval(ws, false, l, b, 3 * 1024 + j); }
        if (tid < 32) hist[tid] = 0;
        __syncthreads();
        if (tid < 384) { const int j = tid % 48, part = tid / 48; float s = 0.f;
            for (int k = part * 128; k < part * 128 + 128; ++k) s += sh[k] * RTW[(size_t)k * 48 + j];
            cpart[part * 48 + j] = s; }
        { f32x4 vn[4];
          { const GAS f32x4* xr = (const GAS f32x4*)(x + (size_t)(c * 128 + wave * 16) * DM) + lane;
#pragma unroll
            for (int j = 0; j < 4; ++j) vn[j] = xr[64 * j]; }
          for (int i = 0; i < 16; ++i) {
            const int row = c * 128 + wave * 16 + i;
            f32x4 v[4]; float ss = 0.f;
#pragma unroll
            for (int j = 0; j < 4; ++j) { v[j] = vn[j]; ss += (v[j].x * v[j].x + v[j].y * v[j].y) + (v[j].z * v[j].z + v[j].w * v[j].w); }
            if (i + 1 < 16) { const GAS f32x4* xr = (const GAS f32x4*)(x + (size_t)(row + 1) * DM) + lane;
#pragma unroll
                for (int j = 0; j < 4; ++j) vn[j] = xr[64 * j]; }
            const float rstd = rsqrtf(wave_sum(ss) * (1.f / DM) + NORM_EPS);
            if (lane == 0) rstd_s[wave * 16 + i] = rstd;
            GAS v2u* o = (GAS v2u*)(HN + (size_t)row * DM) + lane;
#pragma unroll
            for (int j = 0; j < 4; ++j) { const f32x4 s4 = *(const LAS f32x4*)(sc + lane * 4 + 256 * j), h4 = *(const LAS f32x4*)(sh + lane * 4 + 256 * j); const f32x4 h = v[j] * rstd * s4 + h4;
                v2u w; w.x = pk2(h.x, h.y); w.y = pk2(h.z, h.w); o[64 * j] = w; }
          } }
        __syncthreads();
        if (tid < 48) { float s = 0.f;
#pragma unroll
            for (int p = 0; p < 8; ++p) s += cpart[p * 48 + tid];
            s += tid < 4 ? a->in[I_MBRG][l * 4 + tid] : (tid < 36 ? a->in[I_MBRE][l * 32 + tid - 4] : 0.f); cvec[tid] = s; }
        {
            const int i16 = lane & 15, kq = lane >> 4, r0 = c * 128 + wave * 16;
            f32x4m acc0 = {0.f, 0.f, 0.f, 0.f}, acc1 = acc0, acc2 = acc0;
            const float* xrow = x + (size_t)(r0 + i16) * DM + 4 * kq;
#pragma unroll 4
            for (int k0 = 0; k0 < DM; k0 += 16) {
                const f32x4 xv = *(const GAS f32x4*)(xrow + k0); const f32x4 sv = *(const LAS f32x4*)(sc + k0 + 4 * kq);
                const float* wp = RTW + (size_t)(k0 + 4 * kq) * 48 + i16;
#pragma unroll
                for (int j = 0; j < 4; ++j) { const float av = xv[j] * sv[j];
                    acc0 = __builtin_amdgcn_mfma_f32_16x16x4f32(av, wp[j * 48], acc0, 0, 0, 0);
                    acc1 = __builtin_amdgcn_mfma_f32_16x16x4f32(av, wp[j * 48 + 16], acc1, 0, 0, 0);
                    acc2 = __builtin_amdgcn_mfma_f32_16x16x4f32(av, wp[j * 48 + 32], acc2, 0, 0, 0); }
            }
            __syncthreads();
            LAS float* lw = lg + wave * 16 * 48;
#pragma unroll
            for (int r = 0; r < 4; ++r) { const int rr = 4 * kq + r; const float rs = rstd_s[wave * 16 + rr];
                lw[rr * 48 + i16] = acc0[r] * rs + cvec[i16]; lw[rr * 48 + 16 + i16] = acc1[r] * rs + cvec[16 + i16]; lw[rr * 48 + 32 + i16] = acc2[r] * rs + cvec[32 + i16]; }
            LDS_WAIT(); asm volatile("" ::: "memory");
            if (lane < 16) {
                const LAS float* lr = lw + lane * 48; const int row = r0 + lane;
                float g0 = lr[0], g1 = lr[1], g2 = lr[2], g3 = lr[3]; const float gm = fmaxf(fmaxf(g0, g1), fmaxf(g2, g3));
                float p0 = __expf(g0 - gm), p1 = __expf(g1 - gm), p2 = __expf(g2 - gm), p3 = __expf(g3 - gm); const float inv = 1.f / (p0 + p1 + p2 + p3);
                p0 *= inv; p1 *= inv; p2 *= inv; p3 *= inv;
                int gi = 0; float gp = p0; if (p1 > gp) { gp = p1; gi = 1; } if (p2 > gp) { gp = p2; gi = 2; } if (p3 > gp) { gp = p3; gi = 3; }
                float ev0 = -3.4e38f, ev1 = -3.4e38f; int e0 = 0, e1 = 0;
#pragma unroll
                for (int j = 0; j < 8; ++j) { const float s = lr[4 + gi * 8 + j]; if (s > ev0) { ev1 = ev0; e1 = e0; ev0 = s; e0 = j; } else if (s > ev1) { ev1 = s; e1 = j; } }
                const float q = __expf(ev1 - ev0), w0 = gp / (1.f + q), w1 = gp * q / (1.f + q);
                e0 += gi * 8; e1 += gi * 8;
                TOKE[2 * row] = e0; TOKE[2 * row + 1] = e1; TOKW[2 * row] = w0; TOKW[2 * row + 1] = w1;
                const int a0 = 2 * (wave * 16 + lane);
                asg_e[a0] = e0; asg_e[a0 + 1] = e1; asg_lp[a0] = atomicAdd((int*)&hist[e0], 1); asg_lp[a0 + 1] = atomicAdd((int*)&hist[e1], 1);
            }
        }
        __syncthreads();
        if (tid < 32) { const int h = hist[tid]; basev[tid] = h ? (int)atomicAdd(CNT + tid, (unsigned)h) : 0; }
        __syncthreads();
        if (tid < 256) { const int e = asg_e[tid]; LIST[(size_t)e * 65536 + basev[e] + asg_lp[tid]] = (c * 128) * 2 + tid; }
    }
}
__device__ __forceinline__ void build_ptab(const unsigned* CNT, LAS int* ptab, LAS int* pst, LAS int* cnt, int tid) {
    __syncthreads();
    if (tid == 0) { int np = 0;
        for (int e = 0; e < NEXP; ++e) { const int ce = (int)__hip_atomic_load(CNT + e, RLX_AGENT); cnt[e] = ce; pst[e] = np * 256; const int pe = (ce + 255) >> 8;
            for (int p = 0; p < pe; ++p) ptab[1 + np + p] = e;
            np += pe; }
        ptab[0] = np; }
    __syncthreads();
}
__device__ __forceinline__ void phase_gather(KArgsP a, LAS unsigned char* lds, int tid, int lane, int wave, int vcu, int G, int l) {
    unsigned char* ws = a->ws;
    LAS int* ptab = (LAS int*)lds; LAS int* pst = ptab + 512; LAS int* cnt = pst + 32;
    build_ptab((const unsigned*)(ws + WS_CTL) + CW_CNT + l * 32, ptab, pst, cnt, tid);
    const bf16* HN = (const bf16*)(ws + WS_HN); bf16* XG = (bf16*)(ws + WS_XG); int* ROWMAP = (int*)(ws + WS_ROWMAP); const int* LIST = (const int*)(ws + WS_LIST);
    const int nrows = ptab[0] * 256;
    for (int row0 = (vcu * NWAVES + wave) * 8; row0 < nrows; row0 += G * NWAVES * 8) {
        int tok2[8]; v4u p0[8], p1[8];
#pragma unroll
        for (int j = 0; j < 8; ++j) { const int row = row0 + j, e = ptab[1 + (row >> 8)], pos = row - pst[e]; tok2[j] = (pos < cnt[e]) ? LIST[(size_t)e * 65536 + pos] : -1; }
#pragma unroll
        for (int j = 0; j < 8; ++j) { if (tok2[j] >= 0) { const GAS v4u* s = (const GAS v4u*)(HN + (size_t)(tok2[j] >> 1) * DM) + lane; p0[j] = s[0]; p1[j] = s[64]; } else { p0[j] = (v4u){0u, 0u, 0u, 0u}; p1[j] = p0[j]; } }
#pragma unroll
        for (int j = 0; j < 8; ++j) { GAS v4u* d = (GAS v4u*)(XG + (size_t)(row0 + j) * DM) + lane; d[0] = p0[j]; d[64] = p1[j]; if (lane == 0) ROWMAP[row0 + j] = tok2[j]; }
    }
}

__device__ __forceinline__ void phase_rowmap(KArgsP a, LAS unsigned char* lds, int tid, int vcu, int G, int l) {
    unsigned char* ws = a->ws;
    LAS int* ptab = (LAS int*)lds; LAS int* pst = ptab + 512; LAS int* cnt = pst + 32;
    build_ptab((const unsigned*)(ws + WS_CTL) + CW_CNT + l * 32, ptab, pst, cnt, tid);
    int* ROWMAP = (int*)(ws + WS_ROWMAP); const int* LIST = (const int*)(ws + WS_LIST);
    const int nrows = ptab[0] * 256;
    for (int row = vcu * NTHR + tid; row < nrows; row += G * NTHR) { const int e = ptab[1 + (row >> 8)], pos = row - pst[e]; ROWMAP[row] = (pos < cnt[e]) ? LIST[(size_t)e * 65536 + pos] : -1; }
}

typedef short bf16x8 __attribute__((ext_vector_type(8)));
constexpr int MT = 72;
constexpr int ML_XP = 0;
constexpr int ML_CX = 17152;
constexpr int ML_WQ = ML_CX + 9216, ML_WK = ML_WQ + 9216;
constexpr int ML_Q = ML_WK + 9216, ML_K = ML_Q + 9216;
constexpr int ML_S = ML_K + 9216;
constexpr int ML_VT = ML_S + 9216;
constexpr int ML_CT = ML_VT + 11520;
constexpr int ML_H = ML_CT + 11520;
constexpr int ML_SM = ML_H + 16640;
static_assert(ML_SM + 2048 <= RING_BYTES, "mLSTM LDS map");
__device__ __forceinline__ float logsigmoidf_(float x) { return fminf(x, 0.f) - log1pf(__expf(-fabsf(x))); }
__device__ __forceinline__ void mma64(const LAS bf16* A, int arow0, const LAS bf16* Bt, int brow0, int lane, f32x4& acc) {
    const LAS bf16* ap = A + (arow0 + (lane & 15)) * MT + 8 * (lane >> 4); const LAS bf16* bp = Bt + (brow0 + (lane & 15)) * MT + 8 * (lane >> 4);
    const bf16x8 a0 = *(const LAS bf16x8*)ap, a1 = *(const LAS bf16x8*)(ap + 32), b0 = *(const LAS bf16x8*)bp, b1 = *(const LAS bf16x8*)(bp + 32);
    acc = __builtin_amdgcn_mfma_f32_16x16x32_bf16(a0, b0, acc, 0, 0, 0); acc = __builtin_amdgcn_mfma_f32_16x16x32_bf16(a1, b1, acc, 0, 0, 0);
}
__device__ __forceinline__ void ml_front(KArgsP a, LAS unsigned char* lds, int tid, int l, int b, int c, int h, bool want_q) {
    const bf16* PROJ = (const bf16*)(a->ws + WS_PROJ); const size_t row0 = (size_t)b * SEQ + c * 64;
    LAS float* xp = (LAS float*)(lds + ML_XP);
    for (int idx = tid; idx < 67 * 8; idx += NTHR) { const int r = idx >> 3, c8 = idx & 7, tr = c * 64 + r - 3; LAS float* d = xp + r * 64 + c8 * 8;
        if (tr >= 0) { const v4u p = *(const GAS v4u*)(PROJ + ((size_t)b * SEQ + tr) * NPROJ + PC_QK + h * 64 + c8 * 8);
            *(LAS f32x4*)d = (f32x4){bflo(p.x), bfhi(p.x), bflo(p.y), bfhi(p.y)}; *(LAS f32x4*)(d + 4) = (f32x4){bflo(p.z), bfhi(p.z), bflo(p.w), bfhi(p.w)}; }
        else { *(LAS f32x4*)d = (f32x4){0.f, 0.f, 0.f, 0.f}; *(LAS f32x4*)(d + 4) = (f32x4){0.f, 0.f, 0.f, 0.f}; } }
    {
        const int t = tid >> 3, vg = tid & 7; LAS bf16* VT = (LAS bf16*)(lds + ML_VT);
        const v4u p = *(const GAS v4u*)(PROJ + (row0 + t) * NPROJ + PC_V + h * 64 + vg * 8);
        const unsigned w[4] = {p.x, p.y, p.z, p.w};
#pragma unroll
        for (int j = 0; j < 4; ++j) { VT[(vg * 8 + 2 * j) * MT + t] = (bf16)(w[j] & 0xffffu); VT[(vg * 8 + 2 * j + 1) * MT + t] = (bf16)(w[j] >> 16); }
        for (int idx = tid; idx < 16 * 64; idx += NTHR) VT[(64 + (idx >> 6)) * MT + (idx & 63)] = (idx < 64) ? (bf16)0x3F80 : (bf16)0;
        const bf16* WT = (const bf16*)(a->ws + WS_MLW) + (size_t)((l * NH + h) * 2) * 4096;
        const int e = tid >> 3, d8 = tid & 7;
        if (want_q) *(LAS v4u*)(lds + ML_WQ + (e * MT + d8 * 8) * 2) = *(const GAS v4u*)(WT + e * 64 + d8 * 8);
        *(LAS v4u*)(lds + ML_WK + (e * MT + d8 * 8) * 2) = *(const GAS v4u*)(WT + 4096 + e * 64 + d8 * 8);
    }
    __syncthreads();
    const float* cw = a->in[I_CONV_W] + (size_t)l * 4 * DA + h * 64; const float* cb = a->in[I_CONV_B] + (size_t)l * DA + h * 64;
    {
        const int t = tid >> 3, c8 = (tid & 7) * 8; float s[8];
#pragma unroll
        for (int j = 0; j < 8; ++j) s[j] = cb[c8 + j];
#pragma unroll
        for (int q = 0; q < 4; ++q) { const f32x4 x0 = *(const LAS f32x4*)(xp + (t + q) * 64 + c8), x1 = *(const LAS f32x4*)(xp + (t + q) * 64 + c8 + 4); const float* w = cw + q * DA + c8;
            s[0] += x0.x * w[0]; s[1] += x0.y * w[1]; s[2] += x0.z * w[2]; s[3] += x0.w * w[3]; s[4] += x1.x * w[4]; s[5] += x1.y * w[5]; s[6] += x1.z * w[6]; s[7] += x1.w * w[7]; }
#pragma unroll
        for (int j = 0; j < 8; ++j) s[j] = s[j] / (1.f + __expf(-s[j]));
        v4u o; o.x = pk2(s[0], s[1]); o.y = pk2(s[2], s[3]); o.z = pk2(s[4], s[5]); o.w = pk2(s[6], s[7]);
        *(LAS v4u*)(lds + ML_CX + (t * MT + c8) * 2) = o;
    }
}
__device__ __forceinline__ void phase_m1(KArgsP a, LAS unsigned char* lds, int tid, int lane, int wave, int vcu, int G, int l) {
    unsigned char* ws = a->ws; const float* GT = (const float*)(ws + WS_GATES);
    float* CLOC = (float*)(ws + WS_CLOC); float* MLG = (float*)(ws + WS_MSC); float* MLM = MLG + 4096;
    LAS float* sm = (LAS float*)(lds + ML_SM);
    for (int u = vcu; u < NUNIT_M; u += G) {
        const int h = u % NH, c = (u / NH) % NCH, b = u / (NH * NCH); const size_t row0 = (size_t)b * SEQ + c * 64;
        __syncthreads();
        ml_front(a, lds, tid, l, b, c, h, false);
        if (wave == 0) {
            const float ig = GT[(row0 + lane) * 16 + h] + a->in[I_BI][l * NH + h];
            const float fl = logsigmoidf_(GT[(row0 + lane) * 16 + 6 + h] + a->in[I_BF][l * NH + h]);
            float bc = fl;
#pragma unroll
            for (int o = 1; o < 64; o <<= 1) { const float t = __shfl_up(bc, o); if (lane >= o) bc += t; }
            const float gtot = __shfl(bc, 63); const float lw = gtot - bc + ig; const float ml = wave_max(lw);
            sm[lane] = __expf(lw - ml);
            if (lane == 0) { MLG[u] = gtot; MLM[u] = ml; }
        }
        __syncthreads();
        {
            const int rt = wave >> 1; LAS bf16* KT = (LAS bf16*)(lds + ML_K);
#pragma unroll
            for (int q = 0; q < 2; ++q) { const int ct = 2 * (wave & 1) + q; f32x4 acc = {0.f, 0.f, 0.f, 0.f};
                mma64((const LAS bf16*)(lds + ML_CX), 16 * rt, (const LAS bf16*)(lds + ML_WK), 16 * ct, lane, acc);
                const int t0 = 16 * rt + 4 * (lane >> 4), e = 16 * ct + (lane & 15);
                const float w0 = sm[t0] * 0.125f, w1 = sm[t0 + 1] * 0.125f, w2 = sm[t0 + 2] * 0.125f, w3 = sm[t0 + 3] * 0.125f;
                v2u o; o.x = pk2(acc[0] * w0, acc[1] * w1); o.y = pk2(acc[2] * w2, acc[3] * w3);
                *(LAS v2u*)(KT + e * MT + t0) = o; }
        }
        __syncthreads();
        {
            const int ct = wave & 3, r_lo = wave < 4 ? 0 : 3, r_hi = wave < 4 ? 3 : 5; float* cl = CLOC + (size_t)u * CL_STRIDE;
            for (int rt = r_lo; rt < r_hi; ++rt) { f32x4 acc = {0.f, 0.f, 0.f, 0.f};
                mma64((const LAS bf16*)(lds + ML_VT), 16 * rt, (const LAS bf16*)(lds + ML_K), 16 * ct, lane, acc);
                const int v0 = 16 * rt + 4 * (lane >> 4), e = 16 * ct + (lane & 15);
                if (rt < 4) {
#pragma unroll
                    for (int r = 0; r < 4; ++r) cl[(v0 + r) * 64 + e] = acc[r];
                } else if ((lane >> 4) == 0) cl[4096 + e] = acc[0]; }
        }
    }
}
__device__ __forceinline__ void phase_m2(unsigned char* ws, int tid, int wg, int nwg) {
    float* CLOC = (float*)(ws + WS_CLOC); const float* MLG = (const float*)(ws + WS_MSC); const float* MLM = MLG + 4096; float* MST = (float*)(ws + WS_MSC) + 8192;
    for (int idx = wg * NTHR + tid; idx < NB * NH * CL_STRIDE; idx += nwg * NTHR) {
        const int e = idx % CL_STRIDE, bh = idx / CL_STRIDE, b = bh / NH, h = bh % NH;
        float m = 0.f, cs = 0.f;
        for (int c0 = 0; c0 < NCH; c0 += 8) {
            float cl[8], g[8], ml[8];
#pragma unroll
            for (int j = 0; j < 8; ++j) { const int u = (b * NCH + c0 + j) * NH + h; cl[j] = CLOC[(size_t)u * CL_STRIDE + e]; g[j] = MLG[u]; ml[j] = MLM[u]; }
#pragma unroll
            for (int j = 0; j < 8; ++j) { const int u = (b * NCH + c0 + j) * NH + h;
                CLOC[(size_t)u * CL_STRIDE + e] = cs; if (e == 0) MST[u] = m;
                const float mn = fmaxf(g[j] + m, ml[j]); const float ao = __expf(g[j] + m - mn), al = __expf(ml[j] - mn);
                cs = ao * cs + al * cl[j]; m = mn; }
        }
    }
}
__device__ __forceinline__ void phase_m3(KArgsP a, LAS unsigned char* lds, int tid, int lane, int wave, int vcu, int G, int l) {
    unsigned char* ws = a->ws; const bf16* PROJ = (const bf16*)(ws + WS_PROJ); const float* GT = (const float*)(ws + WS_GATES);
    const float* CLOC = (const float*)(ws + WS_CLOC); const float* MST = (const float*)(ws + WS_MSC) + 8192; bf16* YC = (bf16*)(ws + WS_YC);
    LAS float* sm = (LAS float*)(lds + ML_SM); LAS float* hb = (LAS float*)(lds + ML_H);
    for (int u = vcu; u < NUNIT_M; u += G) {
        const int h = u % NH, c = (u / NH) % NCH, b = u / (NH * NCH); const size_t row0 = (size_t)b * SEQ + c * 64;
        __syncthreads();
        ml_front(a, lds, tid, l, b, c, h, true);
        {
            const float* cl = CLOC + (size_t)u * CL_STRIDE; LAS bf16* CT = (LAS bf16*)(lds + ML_CT);
            for (int idx = tid; idx < 65 * 16; idx += NTHR) { const int r = idx >> 4, c4 = idx & 15; const f32x4 v = *(const GAS f32x4*)(cl + r * 64 + c4 * 4);
                v2u o; o.x = pk2(v.x, v.y); o.y = pk2(v.z, v.w); *(LAS v2u*)(CT + r * MT + c4 * 4) = o; }
            for (int idx = tid; idx < 15 * 64; idx += NTHR) CT[(65 + (idx >> 6)) * MT + (idx & 63)] = 0;
        }
        if (wave == 0) {
            const float ig = GT[(row0 + lane) * 16 + h] + a->in[I_BI][l * NH + h];
            const float fl = logsigmoidf_(GT[(row0 + lane) * 16 + 6 + h] + a->in[I_BF][l * NH + h]);
            float bc = fl;
#pragma unroll
            for (int o = 1; o < 64; o <<= 1) { const float t = __shfl_up(bc, o); if (lane >= o) bc += t; }
            float pm = ig - bc;
#pragma unroll
            for (int o = 1; o < 64; o <<= 1) { const float t = __shfl_up(pm, o); if (lane >= o) pm = fmaxf(pm, t); }
            const float mst = MST[u]; const float inter = bc + mst, mt = fmaxf(inter, bc + pm);
            sm[lane] = ig - bc; sm[64 + lane] = bc - mt; sm[128 + lane] = __expf(inter - mt); sm[192 + lane] = __expf(-mt);
        }
        __syncthreads();
        {
            const int rt = wave >> 1; LAS bf16* Qs = (LAS bf16*)(lds + ML_Q); LAS bf16* Ks = (LAS bf16*)(lds + ML_K);
#pragma unroll
            for (int q = 0; q < 2; ++q) { const int ct = 2 * (wave & 1) + q; f32x4 aq = {0.f, 0.f, 0.f, 0.f}, ak = {0.f, 0.f, 0.f, 0.f};
                mma64((const LAS bf16*)(lds + ML_CX), 16 * rt, (const LAS bf16*)(lds + ML_WQ), 16 * ct, lane, aq);
                mma64((const LAS bf16*)(lds + ML_CX), 16 * rt, (const LAS bf16*)(lds + ML_WK), 16 * ct, lane, ak);
                const int t0 = 16 * rt + 4 * (lane >> 4), e = 16 * ct + (lane & 15);
#pragma unroll
                for (int r = 0; r < 4; ++r) { Qs[(t0 + r) * MT + e] = (bf16)f2bf(aq[r]); Ks[(t0 + r) * MT + e] = (bf16)f2bf(ak[r] * 0.125f); } }
        }
        __syncthreads();
        {
            const int rt = wave >> 1; LAS bf16* Ss = (LAS bf16*)(lds + ML_S);
#pragma unroll
            for (int q = 0; q < 2; ++q) { const int ct = 2 * (wave & 1) + q; f32x4 acc = {0.f, 0.f, 0.f, 0.f};
                if (ct <= rt) mma64((const LAS bf16*)(lds + ML_Q), 16 * rt, (const LAS bf16*)(lds + ML_K), 16 * ct, lane, acc);
                const int t0 = 16 * rt + 4 * (lane >> 4), s = 16 * ct + (lane & 15); const float qs = sm[s];
#pragma unroll
                for (int r = 0; r < 4; ++r) { const int t = t0 + r; Ss[t * MT + s] = (bf16)f2bf((s <= t) ? acc[r] * __expf(sm[64 + t] + qs) : 0.f); } }
        }
        __syncthreads();
        {
            const int rt = wave >> 1, nt = (wave & 1) ? 2 : 3;
            for (int q = 0; q < nt; ++q) { const int ct = (wave & 1) ? 2 + q : (q < 2 ? q : 4); f32x4 aA = {0.f, 0.f, 0.f, 0.f}, aB = {0.f, 0.f, 0.f, 0.f};
                mma64((const LAS bf16*)(lds + ML_Q), 16 * rt, (const LAS bf16*)(lds + ML_CT), 16 * ct, lane, aA);
                mma64((const LAS bf16*)(lds + ML_S), 16 * rt, (const LAS bf16*)(lds + ML_VT), 16 * ct, lane, aB);
                const int t0 = 16 * rt + 4 * (lane >> 4), v = 16 * ct + (lane & 15);
#pragma unroll
                for (int r = 0; r < 4; ++r) { const int t = t0 + r; const float x = sm[128 + t] * aA[r] + aB[r];
                    if (ct < 4) hb[t * 65 + v] = x; else if ((lane & 15) == 0) sm[256 + t] = x; } }
        }
        __syncthreads();
        {
            const int t = tid >> 3, vg = tid & 7; float acc[8];
            const float dn = 1.f / fmaxf(fabsf(sm[256 + t]), sm[192 + t]);
            float s1 = 0.f;
#pragma unroll
            for (int j = 0; j < 8; ++j) { acc[j] = hb[t * 65 + vg * 8 + j] * dn; s1 += acc[j]; }
            s1 += __shfl_xor(s1, 1); s1 += __shfl_xor(s1, 2); s1 += __shfl_xor(s1, 4);
            const float mu = s1 * (1.f / 64.f); float s2 = 0.f;
#pragma unroll
            for (int j = 0; j < 8; ++j) { acc[j] -= mu; s2 += acc[j] * acc[j]; }
            s2 += __shfl_xor(s2, 1); s2 += __shfl_xor(s2, 2); s2 += __shfl_xor(s2, 4);
            const float rs = rsqrtf(s2 * (1.f / 64.f) + HEAD_NORM_EPS);
            const float* nw = a->in[I_MNORM_W] + (size_t)l * DA + h * 64 + vg * 8;
            const v4u ov = *(const GAS v4u*)(PROJ + (row0 + t) * NPROJ + PC_O + h * 64 + vg * 8);
            const float o[8] = {bflo(ov.x), bfhi(ov.x), bflo(ov.y), bfhi(ov.y), bflo(ov.z), bfhi(ov.z), bflo(ov.w), bfhi(ov.w)};
            float r[8];
#pragma unroll
            for (int j = 0; j < 8; ++j) r[j] = acc[j] * rs * nw[j] * sigmoidf_(o[j]);
            v4u w; w.x = pk2(r[0], r[1]); w.y = pk2(r[2], r[3]); w.z = pk2(r[4], r[5]); w.w = pk2(r[6], r[7]);
            *(GAS v4u*)(YC + (row0 + t) * DM + h * 64 + vg * 8) = w;
        }
    }
}

constexpr int S5_UT = 264, S5_XT = 2056;
constexpr int S5_U = 0, S5_Z = 33792, S5_X = 67584;
static_assert(S5_X + 16 * S5_XT * 2 <= MISC_OFF, "S5 LDS map");
struct S5A { float are, aim, cre, cim; };
__device__ __forceinline__ S5A s5_a(KArgsP a, int l, int g, int p) {
    const float lam_re = a->in[I_S5ARE][(size_t)(l * 16 + g) * 64 + p], lam_im = a->in[I_S5AIM][(size_t)(l * 16 + g) * 64 + p];
    const float dt = expf(a->in[I_S5LDT][l * 16 + g]); const float mag = expf(lam_re * dt), ang = lam_im * dt;
    S5A r; r.are = mag * cosf(ang); r.aim = mag * sinf(ang);
    const float inv = 1.f / (lam_re * lam_re + lam_im * lam_im);
    r.cre = ((r.are - 1.f) * lam_re + r.aim * lam_im) * inv; r.cim = (r.aim * lam_re - (r.are - 1.f) * lam_im) * inv; return r;
}
__device__ __forceinline__ bf16x8 pack8(const float* v) { v4u o; o.x = pk2(v[0], v[1]); o.y = pk2(v[2], v[3]); o.z = pk2(v[4], v[5]); o.w = pk2(v[6], v[7]); return __builtin_bit_cast(bf16x8, o); }
__device__ __forceinline__ void s5_bfrag(const unsigned char* ws, int l, int g, int lane, bf16x8 (&bf)[8]) {
    const bf16* BB = (const bf16*)(ws + WS_S5BB) + (size_t)(l * 16 + g) * 128 * 16;
#pragma unroll
    for (int j = 0; j < 8; ++j) { v4u o = {0u, 0u, 0u, 0u}; if ((lane >> 4) < 2) o = *(const GAS v4u*)(BB + (16 * j + (lane & 15)) * 16 + 8 * (lane >> 4)); bf[j] = __builtin_bit_cast(bf16x8, o); }
}
__device__ __forceinline__ f32x2 s5_ap(const unsigned char* ws, int l, int g, int p) { return *(const GAS f32x2*)((const float*)(ws + WS_S5AP) + ((size_t)(l * 16 + g) * 64 + p) * 2); }
__device__ __forceinline__ void s5_load_u(const unsigned char* ws, LAS unsigned char* lds, int tid, size_t row0) {
    const bf16* PROJ = (const bf16*)(ws + WS_PROJ);
    for (int idx = tid; idx < 64 * 32; idx += NTHR) { const int t = idx >> 5, c8 = idx & 31;
        *(LAS v4u*)(lds + S5_U + (t * S5_UT + c8 * 8) * 2) = *(const GAS v4u*)(PROJ + (row0 + t) * NPROJ + PC_S5 + c8 * 8); }
}
__device__ __forceinline__ void s5_block(LAS unsigned char* lds, int lane, int tb, int g, const bf16x8 (&bf)[8], float are, float aim, float& xr, float& xi) {
    const int kq = lane >> 4; bf16x8 uf = {0, 0, 0, 0, 0, 0, 0, 0};
    if (kq < 2) uf = *(const LAS bf16x8*)(lds + S5_U + ((16 * tb + (lane & 15)) * S5_UT + g * 16 + 8 * kq) * 2);
    LAS bf16* X = (LAS bf16*)(lds + S5_X);
#pragma unroll
    for (int j = 0; j < 8; ++j) { f32x4 acc = {0.f, 0.f, 0.f, 0.f}; acc = __builtin_amdgcn_mfma_f32_16x16x32_bf16(bf[j], uf, acc, 0, 0, 0);
        v2u o; o.x = pk2(acc[0], acc[1]); o.y = pk2(acc[2], acc[3]); *(LAS v2u*)(X + (lane & 15) * S5_XT + g * 128 + 16 * j + 4 * kq) = o; }
    LDS_WAIT(); asm volatile("" ::: "memory");
    LAS unsigned* xw = (LAS unsigned*)(lds + S5_X) + (g * 128 + 2 * lane) / 2;
    unsigned wv[16];
#pragma unroll
    for (int t = 0; t < 16; ++t) wv[t] = xw[t * (S5_XT / 2)];
#pragma unroll
    for (int t = 0; t < 16; ++t) { const float br = bflo(wv[t]), bi = bfhi(wv[t]);
        const float nr = are * xr - aim * xi + br, ni = are * xi + aim * xr + bi; xr = nr; xi = ni;
        wv[t] = pk2(xr, xi); }
#pragma unroll
    for (int t = 0; t < 16; ++t) xw[t * (S5_XT / 2)] = wv[t];
    LDS_WAIT(); asm volatile("" ::: "memory");
}
__device__ __forceinline__ void phase_s1(KArgsP a, LAS unsigned char* lds, int tid, int lane, int wave, int vcu, int G, int l) {
    unsigned char* ws = a->ws; float* ST = (float*)(ws + WS_S5ST);
    bf16x8 bf0[8], bf1[8]; s5_bfrag(ws, l, wave, lane, bf0); s5_bfrag(ws, l, wave + 8, lane, bf1);
    struct { float are, aim; } A0, A1; { const f32x2 q0 = s5_ap(ws, l, wave, lane), q1 = s5_ap(ws, l, wave + 8, lane); A0.are = q0.x; A0.aim = q0.y; A1.are = q1.x; A1.aim = q1.y; }
    for (int u = vcu; u < NB * NCH; u += G) {
        const size_t row0 = (size_t)u * 64;
        __syncthreads();
        s5_load_u(ws, lds, tid, row0);
        __syncthreads();
        float x0r = 0.f, x0i = 0.f, x1r = 0.f, x1i = 0.f;
        for (int tb = 0; tb < 4; ++tb) { s5_block(lds, lane, tb, wave, bf0, A0.are, A0.aim, x0r, x0i); s5_block(lds, lane, tb, wave + 8, bf1, A1.are, A1.aim, x1r, x1i); }
        *(f32x2*)(ST + (((size_t)u * 16 + wave) * 64 + lane) * 2) = (f32x2){x0r, x0i};
        *(f32x2*)(ST + (((size_t)u * 16 + wave + 8) * 64 + lane) * 2) = (f32x2){x1r, x1i};
    }
}
__device__ __forceinline__ void phase_s2(KArgsP a, int tid, int wg, int nwg, int l) {
    float* ST = (float*)(a->ws + WS_S5ST);
    for (int idx = wg * NTHR + tid; idx < NB * 1024; idx += nwg * NTHR) {
        const int b = idx >> 10, gp = idx & 1023, g = gp >> 6, p = gp & 63;
        const f32x2 A = s5_ap(a->ws, l, g, p); float ar = A.x, ai = A.y;
#pragma unroll
        for (int s = 0; s < 6; ++s) { const float nr = ar * ar - ai * ai, ni = 2.f * ar * ai; ar = nr; ai = ni; }
        float cr = 0.f, ci = 0.f;
        for (int c0 = 0; c0 < NCH; c0 += 8) {
            f32x2 e[8];
#pragma unroll
            for (int j = 0; j < 8; ++j) e[j] = *(const f32x2*)(ST + (((size_t)(b * NCH + c0 + j) * 16 + g) * 64 + p) * 2);
#pragma unroll
            for (int j = 0; j < 8; ++j) { *(f32x2*)(ST + (((size_t)(b * NCH + c0 + j) * 16 + g) * 64 + p) * 2) = (f32x2){cr, ci};
                const float nr = ar * cr - ai * ci + e[j].x, ni = ar * ci + ai * cr + e[j].y; cr = nr; ci = ni; }
        }
    }
}
__device__ __forceinline__ float tanh_fast(float x) { return 1.f - 2.f / (1.f + __expf(2.f * x)); }
__device__ __forceinline__ float gelu_tanh_(float x) { const float t = tanh_fast(0.7978845608f * (x + 0.044715f * x * x * x)); return 0.5f * x * (1.f + t); }
__device__ __forceinline__ void s5_cload(const bf16* cmt  , int lane, bf16x8 (&cf)[4]) {
#pragma unroll
    for (int s = 0; s < 4; ++s) cf[s] = __builtin_bit_cast(bf16x8, *(const GAS v4u*)(cmt + (lane & 15) * 128 + 32 * s + 8 * (lane >> 4)));
}
__device__ __forceinline__ void s5_cproj(LAS unsigned char* lds, int lane, int tb, int g, const bf16x8 (&cf)[4], const float (&dv)[4]) {
    const int kq = lane >> 4; f32x4 acc = {0.f, 0.f, 0.f, 0.f};
    const LAS bf16* xp = (const LAS bf16*)(lds + S5_X) + (lane & 15) * S5_XT + g * 128 + 8 * kq;
#pragma unroll
    for (int s = 0; s < 4; ++s) acc = __builtin_amdgcn_mfma_f32_16x16x32_bf16(cf[s], *(const LAS bf16x8*)(xp + 32 * s), acc, 0, 0, 0);
    const int t = 16 * tb + (lane & 15), c0 = g * 16 + 4 * kq;
    const v2u uw = *(const LAS v2u*)(lds + S5_U + (t * S5_UT + c0) * 2);
    const float u4[4] = {bflo(uw.x), bfhi(uw.x), bflo(uw.y), bfhi(uw.y)}; float z[4];
#pragma unroll
    for (int r = 0; r < 4; ++r) z[r] = gelu_tanh_(acc[r] + dv[r] * u4[r]);
    v2u o; o.x = pk2(z[0], z[1]); o.y = pk2(z[2], z[3]); *(LAS v2u*)(lds + S5_Z + (t * S5_UT + c0) * 2) = o;
}
__device__ __forceinline__ void phase_s3(KArgsP a, LAS unsigned char* lds, int tid, int lane, int wave, int vcu, int G, int l, unsigned* qctr = nullptr) {
    unsigned char* ws = a->ws; const float* ST = (const float*)(ws + WS_S5ST); bf16* YC = (bf16*)(ws + WS_YC);
    const bf16* GLUT = (const bf16*)(ws + WS_GLUT) + (size_t)l * DC * DC;
    bf16x8 bf0[8], bf1[8]; s5_bfrag(ws, l, wave, lane, bf0); s5_bfrag(ws, l, wave + 8, lane, bf1);
    const bf16* cm0 = (const bf16*)(ws + WS_S5CM) + (size_t)(l * 16 + wave) * 2048; const bf16* cm1 = cm0 + 8 * 2048;
    struct { float are, aim; } A0, A1; { const f32x2 q0 = s5_ap(ws, l, wave, lane), q1 = s5_ap(ws, l, wave + 8, lane); A0.are = q0.x; A0.aim = q0.y; A1.are = q1.x; A1.aim = q1.y; }
    float d0[4], d1[4];
#pragma unroll
    for (int r = 0; r < 4; ++r) { d0[r] = a->in[I_S5D][l * DC + wave * 16 + 4 * (lane >> 4) + r]; d1[r] = a->in[I_S5D][l * DC + (wave + 8) * 16 + 4 * (lane >> 4) + r]; }
    volatile LAS unsigned* qw = (volatile LAS unsigned*)(lds + MISC_OFF) + 20;
    for (int u = vcu; ; u += G) {
        if (qctr) { __syncthreads(); if (tid == 0) *qw = __hip_atomic_fetch_add(qctr, 1u, __ATOMIC_RELAXED, __HIP_MEMORY_SCOPE_AGENT); __syncthreads(); u = (int)*qw; }
        if (u >= NB * NCH) break;
        const size_t row0 = (size_t)u * 64;
        __syncthreads();
        s5_load_u(ws, lds, tid, row0);
        const f32x2 s0 = *(const f32x2*)(ST + (((size_t)u * 16 + wave) * 64 + lane) * 2), s1 = *(const f32x2*)(ST + (((size_t)u * 16 + wave + 8) * 64 + lane) * 2);
        float x0r = s0.x, x0i = s0.y, x1r = s1.x, x1i = s1.y;
        __syncthreads();
        for (int tb = 0; tb < 4; ++tb) {
            { bf16x8 cf[4]; s5_cload(cm0, lane, cf); s5_block(lds, lane, tb, wave, bf0, A0.are, A0.aim, x0r, x0i); s5_cproj(lds, lane, tb, wave, cf, d0); }
            { bf16x8 cf[4]; s5_cload(cm1, lane, cf); s5_block(lds, lane, tb, wave + 8, bf1, A1.are, A1.aim, x1r, x1i); s5_cproj(lds, lane, tb, wave + 8, cf, d1); }
        }
        __syncthreads();
        {
            const int kq = lane >> 4;
#pragma unroll
            for (int q = 0; q < 2; ++q) { const int ct = 2 * wave + q; f32x4 acc[4];
#pragma unroll
                for (int rt = 0; rt < 4; ++rt) acc[rt] = (f32x4){0.f, 0.f, 0.f, 0.f};
                const bf16* gp = GLUT + (size_t)(16 * ct + (lane & 15)) * DC + 8 * kq;
#pragma unroll 2
                for (int s = 0; s < 8; ++s) { const bf16x8 gf = __builtin_bit_cast(bf16x8, *(const GAS v4u*)(gp + 32 * s));
#pragma unroll
                    for (int rt = 0; rt < 4; ++rt) acc[rt] = __builtin_amdgcn_mfma_f32_16x16x32_bf16(gf, *(const LAS bf16x8*)(lds + S5_Z + ((16 * rt + (lane & 15)) * S5_UT + 32 * s + 8 * kq) * 2), acc[rt], 0, 0, 0); }
                const int j0 = 16 * ct + 4 * kq; const f32x4 gb = *(const GAS f32x4*)(a->in[I_S5GLUB] + l * DC + j0);
#pragma unroll
                for (int rt = 0; rt < 4; ++rt) { const int t = 16 * rt + (lane & 15); const v2u zw = *(const LAS v2u*)(lds + S5_Z + (t * S5_UT + j0) * 2);
                    const float z0 = bflo(zw.x), z1 = bfhi(zw.x), z2 = bflo(zw.y), z3 = bfhi(zw.y);
                    v2u o; o.x = pk2(z0 * sigmoidf_(acc[rt][0] + gb.x), z1 * sigmoidf_(acc[rt][1] + gb.y)); o.y = pk2(z2 * sigmoidf_(acc[rt][2] + gb.z), z3 * sigmoidf_(acc[rt][3] + gb.w));
                    *(GAS v2u*)(YC + (row0 + t) * DM + 768 + j0) = o; } }
        }
    }
}

__device__ __forceinline__ float rw_shift(const bf16* PROJ, const float* mu, size_t row, int col) {
    const float cur = bf2f(PROJ[row * NPROJ + PC_RW + col]); const float prv = (row % SEQ) ? bf2f(PROJ[(row - 1) * NPROJ + PC_RW + col]) : 0.f;
    return cur + mu[col] * (prv - cur);
}
constexpr int R1_TH = 0, R1_AD = 9216, R1_SG = 18432, R1_VS = 35840, R1_TMP = 86016;
template <int KS, int MODE>
__device__ __forceinline__ void r1_prod(const bf16* WT, const LAS bf16* act, int astride, const float* bias, bf16* OUT, size_t row0, int lane, int wave) {
    const int kq = lane >> 4, n0 = 48 * wave; constexpr int K = 32 * KS;
    f32x4 acc[3][4];
#pragma unroll
    for (int nt = 0; nt < 3; ++nt)
#pragma unroll
        for (int ti = 0; ti < 4; ++ti) acc[nt][ti] = (f32x4){0.f, 0.f, 0.f, 0.f};
#pragma unroll
    for (int s = 0; s < KS; ++s) { bf16x8 wf[3], af[4];
#pragma unroll
        for (int nt = 0; nt < 3; ++nt) wf[nt] = __builtin_bit_cast(bf16x8, *(const GAS v4u*)(WT + (size_t)(n0 + 16 * nt + (lane & 15)) * K + 32 * s + 8 * kq));
#pragma unroll
        for (int ti = 0; ti < 4; ++ti) af[ti] = *(const LAS bf16x8*)(act + (16 * ti + (lane & 15)) * astride + 32 * s + 8 * kq);
#pragma unroll
        for (int nt = 0; nt < 3; ++nt)
#pragma unroll
            for (int ti = 0; ti < 4; ++ti) acc[nt][ti] = __builtin_amdgcn_mfma_f32_16x16x32_bf16(wf[nt], af[ti], acc[nt][ti], 0, 0, 0); }
#pragma unroll
    for (int nt = 0; nt < 3; ++nt) { const int n = n0 + 16 * nt + 4 * kq; f32x4 bv = {0.f, 0.f, 0.f, 0.f}; if (MODE != 2) bv = *(const GAS f32x4*)(bias + n);
#pragma unroll
        for (int ti = 0; ti < 4; ++ti) { float o[4];
#pragma unroll
            for (int r = 0; r < 4; ++r) { const float x = acc[nt][ti][r] + bv[r]; o[r] = MODE == 0 ? 0.60653066f * sigmoidf_(x) : (MODE == 1 ? sigmoidf_(x) : x); }
            v2u w; w.x = pk2(o[0], o[1]); w.y = pk2(o[2], o[3]);
            *(GAS v2u*)(OUT + (row0 + 16 * ti + (lane & 15)) * DBR + n) = w; } }
}
__device__ __forceinline__ void phase_r1(KArgsP a, LAS unsigned char* lds, int tid, int lane, int wave, int vcu, int G, int l) {
    unsigned char* ws = a->ws; const bf16* PROJ = (const bf16*)(ws + WS_PROJ); const float* mu = a->in[I_RMU] + (size_t)l * RW_COLS;
    const bf16* W1 = (const bf16*)(ws + WS_R1W) + (size_t)l * 98304;
    const bf16* WV = (const bf16*)(ws + WS_R1W) + 2 * 98304;
    for (int u = vcu; u < NTOK / 64; u += G) {
        const size_t row0 = (size_t)u * 64;
        __syncthreads();
        for (int idx = tid; idx < 64 * 128; idx += NTHR) { const int tt = idx >> 7, col = 2 * (idx & 127); const size_t r = row0 + tt;
            const unsigned cw = *(const GAS unsigned*)(PROJ + r * NPROJ + PC_RW + RWC_WD + col); const unsigned pw = (r % SEQ) ? *(const GAS unsigned*)(PROJ + (r - 1) * NPROJ + PC_RW + RWC_WD + col) : 0u;
            const float c0 = bflo(cw), c1 = bfhi(cw); const float x0 = c0 + mu[RWC_WD + col] * (bflo(pw) - c0), x1 = c1 + mu[RWC_WD + col + 1] * (bfhi(pw) - c1);
            if (col < 64) *(LAS unsigned*)(lds + R1_TH + (tt * 72 + col) * 2) = pk2(tanh_fast(x0), tanh_fast(x1));
            else if (col < 128) *(LAS unsigned*)(lds + R1_AD + (tt * 72 + col - 64) * 2) = pk2(x0, x1);
            else *(LAS unsigned*)(lds + R1_SG + (tt * 136 + col - 128) * 2) = pk2(sigmoidf_(x0), sigmoidf_(x1)); }
        if (l > 0) for (int idx = tid; idx < 64 * 192; idx += NTHR) { const int tt = idx / 192, col = 2 * (idx % 192); const size_t r = row0 + tt;
            const unsigned cw = *(const GAS unsigned*)(PROJ + r * NPROJ + PC_RW + RWC_V + col); const unsigned pw = (r % SEQ) ? *(const GAS unsigned*)(PROJ + (r - 1) * NPROJ + PC_RW + RWC_V + col) : 0u;
            const float c0 = bflo(cw), c1 = bfhi(cw);
            *(LAS unsigned*)(lds + R1_VS + (tt * 392 + col) * 2) = pk2(c0 + mu[RWC_V + col] * (bflo(pw) - c0), c1 + mu[RWC_V + col + 1] * (bfhi(pw) - c1)); }
        __syncthreads();
        r1_prod<2, 0>(W1, (const LAS bf16*)(lds + R1_TH), 72, a->in[I_RW0] + l * DBR, (bf16*)(ws + WS_RE), row0, lane, wave);
        r1_prod<2, 1>(W1 + 24576, (const LAS bf16*)(lds + R1_AD), 72, a->in[I_RA0] + l * DBR, (bf16*)(ws + WS_RA), row0, lane, wave);
        r1_prod<4, 2>(W1 + 49152, (const LAS bf16*)(lds + R1_SG), 136, nullptr, (bf16*)(ws + WS_RG), row0, lane, wave);
        if (l > 0) {
            { const int kq = lane >> 4, mt = wave & 1, ti = wave >> 1; f32x4 acc = {0.f, 0.f, 0.f, 0.f};
#pragma unroll
              for (int s = 0; s < 12; ++s) acc = __builtin_amdgcn_mfma_f32_16x16x32_bf16(__builtin_bit_cast(bf16x8, *(const GAS v4u*)(WV + (size_t)(16 * mt + (lane & 15)) * 384 + 32 * s + 8 * kq)),
                                                                                          *(const LAS bf16x8*)(lds + R1_VS + ((16 * ti + (lane & 15)) * 392 + 32 * s + 8 * kq) * 2), acc, 0, 0, 0);
              v2u w; w.x = pk2(acc[0], acc[1]); w.y = pk2(acc[2], acc[3]); *(LAS v2u*)(lds + R1_TMP + ((16 * ti + (lane & 15)) * 40 + 16 * mt + 4 * kq) * 2) = w; }
            __syncthreads();
            r1_prod<1, 1>(WV + 12288, (const LAS bf16*)(lds + R1_TMP), 40, a->in[I_RV0], (bf16*)(ws + WS_RVG), row0, lane, wave);
        }
    }
}
__device__ __forceinline__ float dpp_allsum(float x) {
    x += __builtin_bit_cast(float, __builtin_amdgcn_update_dpp(0, __builtin_bit_cast(int, x), 0x128, 0xf, 0xf, false));
    x += __builtin_bit_cast(float, __builtin_amdgcn_update_dpp(0, __builtin_bit_cast(int, x), 0x124, 0xf, 0xf, false));
    x += __builtin_bit_cast(float, __builtin_amdgcn_update_dpp(0, __builtin_bit_cast(int, x), 0x122, 0xf, 0xf, false));
    x += __builtin_bit_cast(float, __builtin_amdgcn_update_dpp(0, __builtin_bit_cast(int, x), 0x121, 0xf, 0xf, false));
    { const unsigned xi = __builtin_bit_cast(unsigned, x); auto r = __builtin_amdgcn_permlane16_swap(xi, xi, false, false); const unsigned r0 = r[0], r1 = r[1]; x = __uint_as_float(r0) + __uint_as_float(r1); }
    { const unsigned xi = __builtin_bit_cast(unsigned, x); auto r = __builtin_amdgcn_permlane32_swap(xi, xi, false, false); const unsigned r0 = r[0], r1 = r[1]; x = __uint_as_float(r0) + __uint_as_float(r1); }
    return x;
}

constexpr int RC_EF = 0, RC_ATF = 4096, RC_QF = 8448, RC_PFT = 9472, RC_AT = 10496, RC_RT = 12800, RC_BH = 15104, RC_KH = 17408, RC_AH = 19712, RC_BTT = 22016, RC_KTT = 25088, RC_VS = 28160,
              RC_PRL = 31232, RC_QRL = 32000, RC_TQL = 32768, RC_G15 = 33536, RC_CH = 33792;
struct RCRegs { v2u r0, r1, k0, k1, aa, ee, v0, v1, vg, vf, gg; };
__device__ __forceinline__ void rc_issue(const unsigned char* ws, int l, size_t row, int h, int tid, RCRegs& R) {
    const bf16* PROJ = (const bf16*)(ws + WS_PROJ); const int tt = tid >> 4, c0 = h * 64 + 4 * (tid & 15); const size_t r = row + tt; const bool first = (r % SEQ) == 0; const size_t rp = first ? r : r - 1;
    R.r0 = *(const GAS v2u*)(PROJ + r * NPROJ + PC_RW + RWC_R + c0); R.r1 = *(const GAS v2u*)(PROJ + rp * NPROJ + PC_RW + RWC_R + c0);
    R.k0 = *(const GAS v2u*)(PROJ + r * NPROJ + PC_RW + RWC_K + c0); R.k1 = *(const GAS v2u*)(PROJ + rp * NPROJ + PC_RW + RWC_K + c0);
    R.v0 = *(const GAS v2u*)(PROJ + r * NPROJ + PC_RW + RWC_V + c0); R.v1 = *(const GAS v2u*)(PROJ + rp * NPROJ + PC_RW + RWC_V + c0);
    R.aa = *(const GAS v2u*)((const bf16*)(ws + WS_RA) + r * DBR + c0); R.ee = *(const GAS v2u*)((const bf16*)(ws + WS_RE) + r * DBR + c0);
    R.gg = *(const GAS v2u*)((const bf16*)(ws + WS_RG) + r * DBR + c0);
    if (l > 0) { R.vg = *(const GAS v2u*)((const bf16*)(ws + WS_RVG) + r * DBR + c0); R.vf = *(const GAS v2u*)((const bf16*)(ws + WS_VF) + r * DBR + c0); }
    if (first) { R.r1 = (v2u){0u, 0u}; R.k1 = (v2u){0u, 0u}; R.v1 = (v2u){0u, 0u}; }
}
__device__ __forceinline__ void unpack4(const v2u p, float (&o)[4]) { o[0] = bflo(p.x); o[1] = bfhi(p.x); o[2] = bflo(p.y); o[3] = bfhi(p.y); }
__device__ __forceinline__ v2u pack4(const float (&v)[4]) { v2u o; o.x = pk2(v[0], v[1]); o.y = pk2(v[2], v[3]); return o; }
__device__ __forceinline__ v2u pack4v(const f32x4 v) { v2u o; o.x = pk2(v[0], v[1]); o.y = pk2(v[2], v[3]); return o; }
__device__ __forceinline__ bf16x8 cat8(const v2u a, const v2u b) { v4u o; o.x = a.x; o.y = a.y; o.z = b.x; o.w = b.y; return __builtin_bit_cast(bf16x8, o); }
#define RC_BAR() asm volatile("s_waitcnt lgkmcnt(0)\n\ts_barrier" ::: "memory")

constexpr int REC_BYTES = 12288, REC_UNITS = 752;
__device__ __forceinline__ unsigned char* rc_rec(unsigned char* ws, size_t cu) { return cu < 8192 ? ws + WS_OPA + cu * REC_BYTES : ws + WS_OPB + (cu - 8192) * REC_BYTES; }
__device__ __forceinline__ v4u rc_gather_unit(const LAS unsigned char* wb, int u) {
    v2u lo, hi;
    if (u < 256) { const int base = u < 128 ? RC_AH : RC_RT, uu = u & 127, row = uu >> 3, s = (uu >> 2) & 1, lq = uu & 3; const LAS unsigned char* p = wb + base + (row * 72 + 32 * s + 4 * lq) * 2;
        lo = *(const LAS v2u*)p; hi = *(const LAS v2u*)(p + 32); }
    else if (u < 512) { const int k = (u - 256) >> 2, lq = (u - 256) & 3; lo = *(const LAS v2u*)(wb + RC_BTT + (k * 24 + 4 * lq) * 2); hi = *(const LAS v2u*)(wb + RC_KTT + (k * 24 + 4 * lq) * 2); }
    else if (u < 576) { const int t = (u - 512) >> 2, lq = (u - 512) & 3; lo = *(const LAS v2u*)(wb + RC_PRL + (t * 24 + 4 * lq) * 2); hi = *(const LAS v2u*)(wb + RC_QRL + (t * 24 + 4 * lq) * 2); }
    else if (u < 608) { const LAS unsigned char* p = wb + RC_TQL + (((u - 576) >> 1) * 24 + 8 * ((u - 576) & 1)) * 2; lo = *(const LAS v2u*)p; hi = *(const LAS v2u*)(p + 8); }
    else if (u < 736) { const LAS unsigned char* p = wb + RC_VS + (((u - 608) >> 1) * 24 + 8 * ((u - 608) & 1)) * 2; lo = *(const LAS v2u*)p; hi = *(const LAS v2u*)(p + 8); }
    else { const LAS unsigned char* p = wb + RC_G15 + (u - 736) * 16; lo = *(const LAS v2u*)p; hi = *(const LAS v2u*)(p + 8); }
    v4u o; o.x = lo.x; o.y = lo.y; o.z = hi.x; o.w = hi.y; return o;
}
__device__ __forceinline__ void rc_copy_out(unsigned char* rec, const LAS unsigned char* wb, int u) {
#pragma unroll
    for (int q = 0; q < 3; ++q) { const int uu = u + 256 * q; if (uu < REC_UNITS) *(GAS v4u*)(rec + uu * 16) = rc_gather_unit(wb, uu); }
}
constexpr int RS_AH = 0, RS_RT = 2304, RS_BK = 4608, RS_PQ = 9728, RS_TQL = 11008, RS_VS = 11776, RS_G15 = 14848, RS_CH = 15360;
__device__ __forceinline__ int rs_unit_off(int u) {
    if (u < 128) return RS_AH + (u >> 3) * 144 + (u & 7) * 16;
    if (u < 256) return RS_RT + ((u - 128) >> 3) * 144 + (u & 7) * 16;
    if (u < 512) return RS_BK + ((u - 256) >> 2) * 80 + (u & 3) * 16;
    if (u < 576) return RS_PQ + ((u - 512) >> 2) * 80 + (u & 3) * 16;
    if (u < 608) return RS_TQL + ((u - 576) >> 1) * 48 + (u & 1) * 16;
    if (u < 736) return RS_VS + ((u - 608) >> 1) * 48 + (u & 1) * 16;
    return RS_G15 + (u - 736) * 16;
}
#define RC_BUILD(RUSE, q) do { const int bh_ = (q) >> 8, b = bh_ / NH, h = bh_ % NH, blk_ = (q) & 255, c0 = h * 64 + 4 * kq; const size_t row0 = (size_t)b * SEQ + (size_t)blk_ * 32; \
        float kkw[4], kaw[4], mur[4], muk[4], muv[4]; \
_Pragma("unroll") \
        for (int j = 0; j < 4; ++j) { kkw[j] = a->in[I_RKK][(size_t)l * DBR + c0 + j]; kaw[j] = a->in[I_RKA][(size_t)l * DBR + c0 + j]; mur[j] = mu[RWC_R + c0 + j]; muk[j] = mu[RWC_K + c0 + j]; muv[j] = mu[RWC_V + c0 + j]; } \
        float an[4], bk[4], km[4], rs[4], ev[4]; \
        {   const RCRegs& R = RUSE; \
            float rc[4], rp[4], kc[4], kp[4], av[4], vc[4], vp[4], ks[4], kk[4], vs[4]; unpack4(R.r0, rc); unpack4(R.r1, rp); unpack4(R.k0, kc); unpack4(R.k1, kp); unpack4(R.aa, av); unpack4(R.ee, ev); unpack4(R.v0, vc); unpack4(R.v1, vp); \
            float ss = 0.f; \
_Pragma("unroll") \
            for (int j = 0; j < 4; ++j) { rs[j] = rc[j] + mur[j] * (rp[j] - rc[j]); ks[j] = kc[j] + muk[j] * (kp[j] - kc[j]); kk[j] = ks[j] * kkw[j]; ss += kk[j] * kk[j]; vs[j] = vc[j] + muv[j] * (vp[j] - vc[j]); } \
            ss += __shfl_xor(ss, 1); ss += __shfl_xor(ss, 2); ss += __shfl_xor(ss, 4); ss += __shfl_xor(ss, 8); \
            const float inv = 1.f / fmaxf(sqrtf(ss), 1e-12f); \
_Pragma("unroll") \
            for (int j = 0; j < 4; ++j) { const float kn = kk[j] * inv; an[j] = -kn; bk[j] = kn * av[j]; km[j] = ks[j] * (1.f + (av[j] - 1.f) * kaw[j]); } \
            if (l == 0) *(GAS v2u*)((bf16*)(ws + WS_VF) + (row0 + tt) * DBR + c0) = pack4(vs); \
            else { float g[4], f[4]; unpack4(R.vg, g); unpack4(R.vf, f); \
_Pragma("unroll") \
                for (int j = 0; j < 4; ++j) vs[j] = vs[j] + (f[j] - vs[j]) * g[j]; } \
            {     \
                float gq[4], o1[4], o2[4]; unpack4(R.gg, gq); float rkp = 0.f; \
_Pragma("unroll") \
                for (int j = 0; j < 4; ++j) rkp += rs[j] * km[j] * a->in[I_RRK][(size_t)l * DBR + c0 + j]; \
                rkp += __shfl_xor(rkp, 1); rkp += __shfl_xor(rkp, 2); rkp += __shfl_xor(rkp, 4); rkp += __shfl_xor(rkp, 8); \
_Pragma("unroll") \
                for (int j = 0; j < 4; ++j) { o1[j] = a->in[I_RLNW][(size_t)l * DBR + c0 + j] * gq[j]; o2[j] = (a->in[I_RLNB][(size_t)l * DBR + c0 + j] + rkp * vs[j]) * gq[j]; } \
                if (ST12) { *(GAS v2u*)((bf16*)(ws + WS_RG) + (row0 + tt) * DBR + c0) = pack4(o1); *(GAS v2u*)((bf16*)(ws + WS_RA) + (row0 + tt) * DBR + c0) = pack4(o2); } } \
            *(LAS f32x4*)(cb + RC_EF + (t * 64 + 4 * kq) * 4) = (f32x4){ev[0], ev[1], ev[2], ev[3]}; \
_Pragma("unroll") \
            for (int j = 0; j < 4; ++j) *(LAS bf16*)(cb + RC_VS + ((4 * kq + j) * 24 + t) * 2) = (bf16)f2bf(vs[j]); \
        } \
        if ((q) + 2 * G < NQ) rc_issue(ws, l, (size_t)(((q) + 2 * G) >> 8) / NH * SEQ + (size_t)(((q) + 2 * G) & 255) * 32, (((q) + 2 * G) >> 8) % NH, tid, RUSE); \
        RC_BAR(); \
        {   f32x4 inc = {0.f, 0.f, 0.f, 0.f}, tot = inc; \
_Pragma("unroll") \
            for (int i = 0; i < 16; ++i) { const f32x4 ei = *(const LAS f32x4*)(cb + RC_EF + (i * 64 + 4 * kq) * 4); tot = tot + ei; if (i <= t) inc = inc + ei; } \
            float At[4], Rt[4], Bh[4], Kh[4], Bt[4], Kt[4], Gt[4]; \
_Pragma("unroll") \
            for (int j = 0; j < 4; ++j) { const float Gi = __expf(-inc[j]), Ge = __expf(ev[j] - inc[j]), Gn = __expf(inc[j]); Gt[j] = __expf(-tot[j]); \
                At[j] = an[j] * Ge; Rt[j] = rs[j] * Gi; Bh[j] = bk[j] * Gn; Kh[j] = km[j] * Gn; Bt[j] = Bh[j] * Gt[j]; Kt[j] = Kh[j] * Gt[j]; } \
            *(LAS f32x4*)(cb + RC_ATF + (t * 68 + 4 * kq) * 4) = (f32x4){At[0], At[1], At[2], At[3]}; \
            *(LAS v2u*)(cb + RC_AT + (t * 72 + 4 * kq) * 2) = pack4(At); *(LAS v2u*)(cb + RC_RT + (t * 72 + 4 * kq) * 2) = pack4(Rt); \
            *(LAS v2u*)(cb + RC_BH + (t * 72 + 4 * kq) * 2) = pack4(Bh); *(LAS v2u*)(cb + RC_KH + (t * 72 + 4 * kq) * 2) = pack4(Kh); \
_Pragma("unroll") \
            for (int j = 0; j < 4; ++j) { *(LAS bf16*)(cb + RC_BTT + ((4 * kq + j) * 24 + t) * 2) = (bf16)f2bf(Bt[j]); *(LAS bf16*)(cb + RC_KTT + ((4 * kq + j) * 24 + t) * 2) = (bf16)f2bf(Kt[j]); } \
            if (t == 0) *(LAS f32x4*)(cb + RC_G15 + 4 * kq * 4) = (f32x4){Gt[0], Gt[1], Gt[2], Gt[3]}; \
        } \
        RC_BAR(); \
        {   LAS unsigned char* wb = lds + (wave >> 2) * RC_CH; const int pi = wave & 3; \
            const LAS bf16* Ap = (const LAS bf16*)(wb + (pi < 2 ? RC_AT : RC_RT)) + li * 72 + 8 * lq; const LAS bf16* Bp = (const LAS bf16*)(wb + ((pi & 1) ? RC_KH : RC_BH)) + li * 72 + 8 * lq; \
            f32x4 acc = {0.f, 0.f, 0.f, 0.f}; \
            acc = __builtin_amdgcn_mfma_f32_16x16x32_bf16(*(const LAS bf16x8*)Ap, *(const LAS bf16x8*)Bp, acc, 0, 0, 0); \
            acc = __builtin_amdgcn_mfma_f32_16x16x32_bf16(*(const LAS bf16x8*)(Ap + 32), *(const LAS bf16x8*)(Bp + 32), acc, 0, 0, 0); \
_Pragma("unroll") \
            for (int r = 0; r < 4; ++r) { const int tr = 4 * lq + r; if (pi < 2 ? !(li < tr) : !(li <= tr)) acc[r] = 0.f; } \
            if (pi == 0) *(LAS f32x4*)(wb + RC_PFT + (li * 16 + 4 * lq) * 4) = acc; \
            else if (pi == 1) { \
_Pragma("unroll") \
                for (int r = 0; r < 4; ++r) *(LAS float*)(wb + RC_QF + ((4 * lq + r) * 16 + li) * 4) = acc[r]; } \
            else { LAS bf16* o = (LAS bf16*)(wb + (pi == 2 ? RC_PRL : RC_QRL)); \
_Pragma("unroll") \
                for (int r = 0; r < 4; ++r) o[(4 * lq + r) * 24 + li] = (bf16)f2bf(acc[r]); } \
        } \
        RC_BAR(); \
        if (wave < 4) { \
            LAS unsigned char* wb = lds + (wave >> 1) * RC_CH; const bool isq = wave & 1; \
            float X[16]; \
_Pragma("unroll") \
            for (int r = 0; r < 16; ++r) X[r] = isq ? *(const LAS float*)(wb + RC_QF + (r * 16 + li) * 4) : *(const LAS float*)(wb + RC_ATF + (r * 68 + lane) * 4); \
_Pragma("unroll") \
            for (int j = 0; j < 15; ++j) { const LAS f32x4* pc = (const LAS f32x4*)(wb + RC_PFT + j * 64); const f32x4 c0v = pc[0], c1v = pc[1], c2v = pc[2], c3v = pc[3]; \
                const float c[16] = {c0v[0], c0v[1], c0v[2], c0v[3], c1v[0], c1v[1], c1v[2], c1v[3], c2v[0], c2v[1], c2v[2], c2v[3], c3v[0], c3v[1], c3v[2], c3v[3]}; \
_Pragma("unroll") \
                for (int r = j + 1; r < 16; ++r) X[r] = fmaf(c[r], X[j], X[r]); } \
            if (!isq) { LAS bf16* o = (LAS bf16*)(wb + RC_AH); \
_Pragma("unroll") \
                for (int r = 0; r < 16; ++r) o[r * 72 + lane] = (bf16)f2bf(X[r]); } \
            else if (lane < 16) { LAS bf16* o = (LAS bf16*)(wb + RC_TQL); \
_Pragma("unroll") \
                for (int r = 0; r < 16; ++r) o[r * 24 + lane] = (bf16)f2bf(X[r]); } \
        } \
        RC_BAR(); \
        { const int cc = tid >> 8, u = tid & 255; unsigned char* rec = rc_rec(ws, (size_t)bh_ * 512 + 2 * blk_ + cc); const LAS unsigned char* wb = lds + cc * RC_CH; \
          rc_copy_out(rec, wb, u); } \
        RC_BAR(); \
    } while (0)
struct RSOps { bf16x8 a01, a23, r01, r23, tq, pq, bk[4]; v2u vb[2]; f32x4 g[4]; };
__device__ __forceinline__ void rs_load(const LAS unsigned char* wb, int wave, int li, int lq, RSOps& O) {
    O.a01 = *(const LAS bf16x8*)(wb + RS_AH + li * 144 + lq * 16); O.a23 = *(const LAS bf16x8*)(wb + RS_AH + li * 144 + 64 + lq * 16);
    O.r01 = *(const LAS bf16x8*)(wb + RS_RT + li * 144 + lq * 16); O.r23 = *(const LAS bf16x8*)(wb + RS_RT + li * 144 + 64 + lq * 16);
    O.pq = *(const LAS bf16x8*)(wb + RS_PQ + li * 80 + lq * 16);
    { const v2u t = *(const LAS v2u*)(wb + RS_TQL + li * 48 + lq * 8); v4u o; o.x = t.x; o.y = t.y; o.z = 0u; o.w = 0u; O.tq = __builtin_bit_cast(bf16x8, o); }
    O.vb[0] = *(const LAS v2u*)(wb + RS_VS + (32 * wave + li) * 48 + lq * 8); O.vb[1] = *(const LAS v2u*)(wb + RS_VS + (32 * wave + 16 + li) * 48 + lq * 8);
#pragma unroll
    for (int kt = 0; kt < 4; ++kt) { O.bk[kt] = *(const LAS bf16x8*)(wb + RS_BK + (16 * kt + li) * 80 + lq * 16); O.g[kt] = *(const LAS f32x4*)(wb + RS_G15 + (16 * kt + 4 * lq) * 4); }
}
#define RC_CHUNK(O, cc, yb) do { const v2u z2_ = {0u, 0u}; \
_Pragma("unroll") \
        for (int vt = 0; vt < 2; ++vt) {     \
            f32x4 aD = {0.f, 0.f, 0.f, 0.f}, aY = {0.f, 0.f, 0.f, 0.f}; \
            aD = __builtin_amdgcn_mfma_f32_16x16x32_bf16(O.tq, cat8(O.vb[vt], z2_), aD, 0, 0, 0); \
            aD = __builtin_amdgcn_mfma_f32_16x16x32_bf16(O.a01, Sb01[vt], aD, 0, 0, 0); \
            aD = __builtin_amdgcn_mfma_f32_16x16x32_bf16(O.a23, Sb23[vt], aD, 0, 0, 0); \
            aY = __builtin_amdgcn_mfma_f32_16x16x32_bf16(Sb01[vt], O.r01, aY, 0, 0, 0); \
            aY = __builtin_amdgcn_mfma_f32_16x16x32_bf16(Sb23[vt], O.r23, aY, 0, 0, 0); \
            const bf16x8 DV = cat8(pack4v(aD), O.vb[vt]); \
_Pragma("unroll") \
            for (int kt = 0; kt < 4; ++kt) Sacc[vt][kt] = __builtin_amdgcn_mfma_f32_16x16x32_bf16(O.bk[kt], DV, Sacc[vt][kt] * O.g[kt], 0, 0, 0); \
            aY = __builtin_amdgcn_mfma_f32_16x16x32_bf16(DV, O.pq, aY, 0, 0, 0); \
            Sb01[vt] = cat8(pack4v(Sacc[vt][0]), pack4v(Sacc[vt][1])); Sb23[vt] = cat8(pack4v(Sacc[vt][2]), pack4v(Sacc[vt][3])); \
            *(LAS f32x4*)((yb) + (((cc) * 16 + li) * 68 + 32 * wave + 16 * vt + 4 * lq) * 4) = aY;     \
        } \
    } while (0)
#define RC_SCAN(slot, yb) do { { RSOps O0; rs_load(slot, wave, li, lq, O0); __builtin_amdgcn_sched_barrier(0); RC_CHUNK(O0, 0, yb); } \
        { RSOps O1; rs_load(slot + RS_CH, wave, li, lq, O1); __builtin_amdgcn_sched_barrier(0); RC_CHUNK(O1, 1, yb); } } while (0)

template <bool ST12 = true>
__device__ __forceinline__ void phase_r2_build(KArgsP a, LAS unsigned char* lds, int tid, int lane, int wave, int vcu, int G, int l) {
    unsigned char* ws = a->ws;
    const int tt = tid >> 4, kq = tid & 15, ch = tt >> 4, t = tt & 15;
    const int lq = lane >> 4, li = lane & 15;
    LAS unsigned char* cb = lds + ch * RC_CH;
    const float* mu = a->in[I_RMU] + (size_t)l * RW_COLS;
    constexpr int NQ = NB * NH * 256;
    RCRegs RA, RB;
    if (vcu < NQ) rc_issue(ws, l, (size_t)(vcu >> 8) / NH * SEQ + (size_t)(vcu & 255) * 32, (vcu >> 8) % NH, tid, RA);
    if (vcu + G < NQ) rc_issue(ws, l, (size_t)((vcu + G) >> 8) / NH * SEQ + (size_t)((vcu + G) & 255) * 32, ((vcu + G) >> 8) % NH, tid, RB);
    for (int q0 = vcu; q0 < NQ; q0 += 2 * G) { { const int q = q0; RC_BUILD(RA, q); } if (q0 + G < NQ) { const int q = q0 + G; RC_BUILD(RB, q); } }
}
#ifndef RS_DEPTH
#define RS_DEPTH 4
#endif
struct RSRegs { v4u p[6]; };
__device__ __forceinline__ unsigned char* ubase(const unsigned char* p) {
    const unsigned lo = __builtin_amdgcn_readfirstlane((unsigned)(uintptr_t)p), hi = __builtin_amdgcn_readfirstlane((unsigned)((uintptr_t)p >> 32));
    return (unsigned char*)(((uintptr_t)hi << 32) | lo);
}
struct RSOff { unsigned g[6], s[6]; };
__device__ __forceinline__ void rs_offsets(int lt, RSOff& F) {
#pragma unroll
    for (int j = 0; j < 6; ++j) { const int uu = min(lt + 256 * j, 2 * REC_UNITS - 1); const int cc = uu >= REC_UNITS, u = uu - cc * REC_UNITS;
        F.g[j] = uu * 16 + cc * (REC_BYTES - REC_UNITS * 16); F.s[j] = cc * RS_CH + rs_unit_off(u); }
}
__device__ __forceinline__ void rs_issue(unsigned char* ws, size_t cu0, const RSOff& F, RSRegs& R) {
    const unsigned char* base = ubase(rc_rec(ws, cu0));
#pragma unroll
    for (int j = 0; j < 6; ++j) R.p[j] = *(const GAS v4u*)(base + F.g[j]);
}
__device__ __forceinline__ void rs_store(LAS unsigned char* slot, const RSOff& F, const RSRegs& R) {
#pragma unroll
    for (int j = 0; j < 6; ++j) *(LAS v4u*)(slot + F.s[j]) = R.p[j];
}
struct R3Q { v4u a1, a2; };
__device__ __forceinline__ void r3q_issue(const unsigned char* ws, size_t row0, int h, int lt, R3Q& Q) {
    const unsigned off = (unsigned)(((lt >> 3) * DBR + 8 * (lt & 7)) * 2); const size_t ub = (row0 * DBR + h * 64) * 2;
    Q.a1 = *(const GAS v4u*)(ubase(ws + WS_RG + ub) + off); Q.a2 = *(const GAS v4u*)(ubase(ws + WS_RA + ub) + off);
}
__device__ __forceinline__ float dpp8sum(float x) {
    x += __builtin_bit_cast(float, __builtin_amdgcn_update_dpp(0, __builtin_bit_cast(int, x), 0xB1, 0xf, 0xf, false));
    x += __builtin_bit_cast(float, __builtin_amdgcn_update_dpp(0, __builtin_bit_cast(int, x), 0x4E, 0xf, 0xf, false));
    x += __builtin_bit_cast(float, __builtin_amdgcn_update_dpp(0, __builtin_bit_cast(int, x), 0x141, 0xf, 0xf, false));
    return x;
}
__device__ __forceinline__ void r3_block(const LAS unsigned char* yb, bf16* YC, size_t row0, int h, int lt, const R3Q& Q) {
    const int tk = lt >> 3, c8 = 8 * (lt & 7);
    const f32x4 y0 = *(const LAS f32x4*)(yb + (tk * 68 + c8) * 4), y1 = *(const LAS f32x4*)(yb + (tk * 68 + c8 + 4) * 4);
    float d[8] = {y0[0], y0[1], y0[2], y0[3], y1[0], y1[1], y1[2], y1[3]};
    const float m = dpp8sum(((d[0] + d[1]) + (d[2] + d[3])) + ((d[4] + d[5]) + (d[6] + d[7]))) * (1.f / 64.f);
    float q = 0.f;
#pragma unroll
    for (int j = 0; j < 8; ++j) { d[j] -= m; q = fmaf(d[j], d[j], q); }
    const float rstd = rsqrtf(dpp8sum(q) * (1.f / 64.f) + RWKV_GN_EPS);
    const unsigned a1[4] = {Q.a1.x, Q.a1.y, Q.a1.z, Q.a1.w}, a2[4] = {Q.a2.x, Q.a2.y, Q.a2.z, Q.a2.w}; unsigned o[4];
#pragma unroll
    for (int j = 0; j < 4; ++j) o[j] = pk2(fmaf(d[2 * j] * rstd, bflo(a1[j]), bflo(a2[j])), fmaf(d[2 * j + 1] * rstd, bfhi(a1[j]), bfhi(a2[j])));
    v4u w; w.x = o[0]; w.y = o[1]; w.z = o[2]; w.w = o[3];
    *(GAS v4u*)(ubase((const unsigned char*)(YC + row0 * DM + 384 + h * 64)) + (unsigned)((tk * DM + c8) * 2)) = w;
}
__device__ __forceinline__ void phase_r2_scan(KArgsP a, LAS unsigned char* lds, int tid, int lane, int wave, int wg, int l) {
    unsigned char* ws = a->ws; bf16* YC = (bf16*)(ws + WS_YC);
    const int b = wg / NH, h = wg % NH; const size_t rowb = (size_t)b * SEQ, cub = (size_t)wg * 512;
    const int lq = lane >> 4, li = lane & 15, lt = tid - 256; const bool loader = wave >= 4;
    f32x4 Sacc[2][4]; bf16x8 Sb01[2], Sb23[2];
#pragma unroll
    for (int vt = 0; vt < 2; ++vt) {
#pragma unroll
        for (int kt = 0; kt < 4; ++kt) Sacc[vt][kt] = (f32x4){0.f, 0.f, 0.f, 0.f};
        Sb01[vt] = (bf16x8){0, 0, 0, 0, 0, 0, 0, 0}; Sb23[vt] = Sb01[vt]; }
    constexpr int NBLK = SEQ / 32;
    LAS unsigned char* slot0 = lds; LAS unsigned char* slot1 = lds + 2 * RS_CH;
    LAS unsigned char* yb0 = lds + 4 * RS_CH; LAS unsigned char* yb1 = yb0 + 32 * 68 * 4;
    if (wave < 2) {
        RC_BAR();
        for (int bb = 0; bb < NBLK; bb += 2) {
            { LAS unsigned char* slot = slot0; RC_SCAN(slot, yb0); }
            RC_BAR();
            { LAS unsigned char* slot = slot1; RC_SCAN(slot, yb1); }
            RC_BAR();
        }
    } else if (!loader) {
        RC_BAR();
        for (int bb = 0; bb < NBLK; bb += 2) { RC_BAR(); RC_BAR(); }
    } else {
        constexpr int ND = RS_DEPTH;
        RSRegs R[ND]; R3Q Q[ND]; RSOff F; rs_offsets(lt, F);
#pragma unroll
        for (int j = 0; j < ND; ++j) { rs_issue(ws, cub + 2 * j, F, R[j]); r3q_issue(ws, rowb + 32 * j, h, lt, Q[j]); }
        rs_store(slot0, F, R[0]); rs_issue(ws, cub + 2 * ND, F, R[0]);
        RC_BAR();
        for (int bb = 0; bb < NBLK; bb += ND) {
#pragma unroll
            for (int j = 0; j < ND; ++j) { const int X = bb + j;
                r3_block((j & 1) ? yb0 : yb1, YC, rowb + (size_t)max(X - 1, 0) * 32, h, lt, Q[(j + ND - 1) % ND]);
                r3q_issue(ws, rowb + (size_t)min(X - 1 + ND, NBLK - 1) * 32, h, lt, Q[(j + ND - 1) % ND]);
                rs_store((j & 1) ? slot0 : slot1, F, R[(j + 1) % ND]);
                rs_issue(ws, cub + 2 * (size_t)min(X + 1 + ND, NBLK - 1), F, R[(j + 1) % ND]);
                RC_BAR();
            }
        }
        r3_block(yb1, YC, rowb + (size_t)(NBLK - 1) * 32, h, lt, Q[(NBLK - 1) % ND]);
    }
}
__device__ __forceinline__ void phase_r3(KArgsP a, int lane, int gw, int ngw, int l) {
    unsigned char* ws = a->ws; const bf16* PROJ = (const bf16*)(ws + WS_PROJ); bf16* YC = (bf16*)(ws + WS_YC);
    const bf16* RA = (const bf16*)(ws + WS_RA); const bf16* RG = (const bf16*)(ws + WS_RG); const bf16* RVG = (const bf16*)(ws + WS_RVG); const bf16* VF = (const bf16*)(ws + WS_VF);
    const float* mu = a->in[I_RMU] + (size_t)l * RW_COLS;
    for (size_t row = gw; row < NTOK; row += ngw) {
#pragma unroll
        for (int h = 0; h < NH; ++h) {
            const int c = h * 64 + lane;
            const float y = bf2f(YC[row * DM + 384 + c]);
            const float m = dpp_allsum(y) * (1.f / 64.f); const float d = y - m; const float var = dpp_allsum(d * d) * (1.f / 64.f);
            const float yn = d * rsqrtf(var + RWKV_GN_EPS) * a->in[I_RLNW][l * DBR + c] + a->in[I_RLNB][l * DBR + c];
            const float rs = rw_shift(PROJ, mu, row, RWC_R + c), ks = rw_shift(PROJ, mu, row, RWC_K + c); float v = rw_shift(PROJ, mu, row, RWC_V + c);
            if (l > 0) v = v + (bf2f(VF[row * DBR + c]) - v) * bf2f(RVG[row * DBR + c]);
            const float av = bf2f(RA[row * DBR + c]);
            const float km = ks * (1.f + (av - 1.f) * a->in[I_RKA][l * DBR + c]);
            const float rk = dpp_allsum(rs * km * a->in[I_RRK][l * DBR + c]);
            YC[row * DM + 384 + c] = (bf16)f2bf((yn + rk * v) * bf2f(RG[row * DBR + c]));
        }
    }
}

constexpr int PH_PER_LAYER = 10, PH_FINAL = 1 + 2 * PH_PER_LAYER, N_PHASES = PH_FINAL + 1;
constexpr int R2_WGS = 24;
__global__ void __launch_bounds__(NTHR, 2) fwd(Args args) {
    extern __shared__ __attribute__((aligned(16))) unsigned char lds_raw[];
    LAS unsigned char* lds = (LAS unsigned char*)lds_raw;
    volatile LAS unsigned* MISC = (volatile LAS unsigned*)(lds + MISC_OFF);
    const int tid0 = threadIdx.x;
    const int G = gridDim.x;
#define PHASE_IDS int tid_ = threadIdx.x; asm volatile("" : "+v"(tid_)); const int tid = tid_, lane = tid & 63, wave = __builtin_amdgcn_readfirstlane(tid >> 6); \
    int bx_ = blockIdx.x; asm volatile("" : "+s"(bx_)); const int bx = bx_; const int vcu = (G % 8 == 0) ? (bx % 8) * (G / 8) + bx / 8 : bx; (void)lane; (void)wave; (void)vcu; (void)bx;
    unsigned char* ws0 = fresh_args()->ws;
    for (int u = tid0; u < (LDS_BYTES - RING_BYTES) / 4; u += NTHR) ((LAS unsigned*)(lds + RING_BYTES))[u] = 0u;
    __syncthreads();
    XcdBarrier bar; bar.bar = (unsigned*)(ws0 + WS_CTL) + CW_BAR; bar.x = 0; bar.st = nullptr;
    if (!MK_PER_PHASE) bar = xcd_barrier_post((unsigned*)(ws0 + WS_CTL) + CW_BAR, MISC + 8);
#if MK_PER_PHASE
    const int lo = args.ph_lo, hi = args.ph_hi;
#define IN(k) (lo <= (k) && (k) < hi)
#else
#define IN(k) true
#endif
#define SEAM(k) do { if (IN(k) && IN((k) + 1)) { XcdBarrier b2 = bar; asm volatile("" : "+s"(b2.bar)); xcd_barrier(b2); } } while (0)

#ifndef GEMM_SP2
#define GEMM_SP2 true
#endif
#ifndef GEMM_ALIGN
#define GEMM_ALIGN true
#endif
#ifndef RS_DEPTH
#define RS_DEPTH 4
#endif
#ifndef DBL_SUB
#define DBL_SUB 0
#endif
#ifndef DBL_PHASE
#define DBL_PHASE (-1)
#endif
#ifndef REPN
#define REPN 2
#endif
#define REP(k) for (int rep_ = 0; rep_ < ((k) == DBL_PHASE ? REPN : 1); ++rep_)
#define REPBAR if (rep_ > 0) { XcdBarrier b2 = bar; asm volatile("" : "+s"(b2.bar)); xcd_barrier(b2); }
    REP(0) if (IN(0)) { REPBAR KArgsP ap = fresh_args(); PHASE_IDS phase_prologue(ap, lds, tid, lane, wave, vcu, G); }
    SEAM(0);
#ifdef EXTRA_BAR
    for (int eb_ = 0; eb_ < EXTRA_BAR; ++eb_) { XcdBarrier b2 = bar; asm volatile("" : "+s"(b2.bar)); xcd_barrier(b2); }
#endif
#define LCONST 0
    {
        constexpr int l = LCONST; constexpr int pb = 1 + l * PH_PER_LAYER;
        REP(pb + 0) if (IN(pb + 0)) { REPBAR KArgsP ap = fresh_args(); PHASE_IDS unsigned char* ws = ap->ws; (void)ws;
            if (l == 0) { mod_finalize(ws, tid, G); phase_rownorm<0, false>(ap, lds, tid, lane, wave, G, ap->in[I_X], ap->out, ap->in[I_NORM_MIX], true, 0, 0, 0); }
            else {
#if EN_MOE
                phase_rownorm<0, true>(ap, lds, tid, lane, wave, G, ap->out, ap->out, ap->in[I_NORM_MIX] + l * DM, false, l, 0, l - 1);
#else
                phase_rownorm<0, false>(ap, lds, tid, lane, wave, G, ap->out, ap->out, ap->in[I_NORM_MIX] + l * DM, false, l, 0, l - 1);
#endif
            }
        }
        SEAM(pb + 0);
        REP(pb + 1) if (IN(pb + 1)) { REPBAR KArgsP ap = fresh_args(); PHASE_IDS unsigned char* ws = ap->ws; (void)ws;
            pg8::Gemm g{(const pg8::bf16_t*)(ws + WS_HN), (const pg8::bf16_t*)(ws + WS_WIN) + (size_t)l * NPROJ_PAD * DM, NTOK, NPROJ_PAD, DM};
            pg8::StaticOrder S; S.init(NTOK, NPROJ_PAD, G, bx);
            pg8::EpiProj E{(pg8::bf16_t*)(ws + WS_PROJ), (float*)(ws + WS_GATES)};
            pg8::gemm_phase<pg8::EpiProj, pg8::StaticOrder, GEMM_ALIGN, GEMM_SP2>(lds, g, S, E);
        }
        SEAM(pb + 1);
        REP(pb + 2) if (IN(pb + 2)) { REPBAR KArgsP ap = fresh_args(); PHASE_IDS unsigned char* ws = ap->ws; (void)ws;
#if EN_MLSTM
            for (int q_ = 0; q_ < 1 + (REPN - 1) * ((DBL_SUB == 1) && l == 0); ++q_) { phase_m1(ap, lds, tid, lane, wave, vcu, G, l); __syncthreads(); }
            __syncthreads();
#endif
#if EN_S5
            phase_s1(ap, lds, tid, lane, wave, vcu, G, l); __syncthreads();
#if DBL_SUB == 2
            if (l == 0) { phase_s1(ap, lds, tid, lane, wave, vcu, G, l); __syncthreads(); phase_s1(ap, lds, tid, lane, wave, vcu, G, l); __syncthreads(); phase_s1(ap, lds, tid, lane, wave, vcu, G, l); __syncthreads(); phase_s1(ap, lds, tid, lane, wave, vcu, G, l); __syncthreads(); }
#endif
            __syncthreads();
#endif
#if EN_RWKV
            for (int q_ = 0; q_ < 1 + (REPN - 1) * ((DBL_SUB == 3) && l == 0); ++q_) { phase_r1(ap, lds, tid, lane, wave, vcu, G, l); __syncthreads(); }
#endif
        }
        SEAM(pb + 2);
        REP(pb + 3) if (IN(pb + 3)) { REPBAR KArgsP ap = fresh_args(); PHASE_IDS unsigned char* ws = ap->ws; (void)ws;
            phase_m2(ws, tid, vcu, G);
            phase_s2(ap, tid, vcu, G, l);
            __syncthreads();
#if DBL_SUB == 5
            if (l == 0) { phase_r2_build<false>(ap, lds, tid, lane, wave, vcu, G, l); __syncthreads(); }
#endif
            phase_r2_build(ap, lds, tid, lane, wave, vcu, G, l);
        }
        SEAM(pb + 3);
        REP(pb + 4) if (IN(pb + 4)) { REPBAR KArgsP ap = fresh_args(); PHASE_IDS unsigned char* ws = ap->ws; (void)ws;
            if (bx < R2_WGS) {
_Pragma("nounroll")
 for (int q_ = 0; q_ < 1 + (REPN - 1) * ((DBL_SUB == 4) && l == 0); ++q_) { phase_r2_scan(ap, lds, tid, lane, wave, bx, l); __syncthreads(); } }
            else { phase_s3(ap, lds, tid, lane, wave, 0, 1, l, (unsigned*)(ws + WS_CTL) + CW_Q + 64 * l + 32); __syncthreads(); }
            {
                unsigned* qctr = (unsigned*)(ws + WS_CTL) + CW_Q + 64 * l; volatile LAS unsigned* qw = (volatile LAS unsigned*)(lds + MISC_OFF) + 16;
                for (;;) {
                    if (tid == 0) *qw = __hip_atomic_fetch_add(qctr, 1u, __ATOMIC_RELAXED, __HIP_MEMORY_SCOPE_AGENT);
                    __syncthreads();
                    const int u = (int)*qw;
                    __syncthreads();
                    if (u >= NUNIT_M) break;
                    phase_m3(ap, lds, tid, lane, wave, u, NUNIT_M, l);
                }
            }
        }
        SEAM(pb + 4);
        REP(pb + 6) if (IN(pb + 6)) { REPBAR KArgsP ap = fresh_args(); PHASE_IDS unsigned char* ws = ap->ws; (void)ws;
            pg8::Gemm g{(const pg8::bf16_t*)(ws + WS_YC), (const pg8::bf16_t*)(ws + WS_WOUT) + (size_t)l * DM * DM, NTOK, DM, DM};
            pg8::StaticOrder S; S.init(NTOK, DM, G, bx);
            pg8::EpiResid E{l == 0 ? ap->in[I_X] : (const float*)ap->out, ap->out, (const float*)(ws + WS_MODF) + (size_t)l * 4 * 6144, 2048};
            pg8::gemm_phase<pg8::EpiResid, pg8::StaticOrder, GEMM_ALIGN, GEMM_SP2>(lds, g, S, E);
        }
        SEAM(pb + 6);
#if EN_MOE
        REP(pb + 7) if (IN(pb + 7)) { REPBAR KArgsP ap = fresh_args(); PHASE_IDS phase_router(ap, lds, tid, lane, wave, G, l); __syncthreads();
            moe_convert13(ap->in[I_MW1], ap->in[I_MW3], l, (bf16*)(ap->ws + WS_W13), vcu * NWAVES + wave, G * NWAVES, (LAS float*)(lds + wave * 16640), lane);
            moe_convert2(ap->in[I_MW2], l, (bf16*)(ap->ws + WS_W2), vcu * NWAVES + wave, G * NWAVES, (LAS float*)(lds + wave * 16640), lane); }
        SEAM(pb + 7);
        REP(pb + 8) if (IN(pb + 8)) { REPBAR KArgsP ap = fresh_args(); PHASE_IDS unsigned char* ws = ap->ws; (void)ws;
            LAS int* ptab = (LAS int*)(lds + PTAB_OFF); LAS int* pst = ptab + 512; LAS int* cnt = pst + 32;
            build_ptab((const unsigned*)(ws + WS_CTL) + CW_CNT + l * 32, ptab, pst, cnt, tid);
            pg8::Gemm g{(const pg8::bf16_t*)(ws + WS_HN), (const pg8::bf16_t*)(ws + WS_W13), 0, 0, DM, (const int*)(ws + WS_LIST), ptab};
            pg8::MoeOrder S{ptab, G, vcu};
            pg8::EpiSwiglu E{(pg8::bf16_t*)(ws + WS_HMID)};
            pg8::gemm_phase<pg8::EpiSwiglu, pg8::MoeOrder, false, true, true>(lds, g, S, E);
        }
        SEAM(pb + 8);
        REP(pb + 9) if (IN(pb + 9)) { REPBAR KArgsP ap = fresh_args(); PHASE_IDS unsigned char* ws = ap->ws; (void)ws;
            LAS int* ptab = (LAS int*)(lds + PTAB_OFF); LAS int* pst = ptab + 512; LAS int* cnt = pst + 32;
            build_ptab((const unsigned*)(ws + WS_CTL) + CW_CNT + l * 32, ptab, pst, cnt, tid);
            pg8::Gemm g{(const pg8::bf16_t*)(ws + WS_HMID), (const pg8::bf16_t*)(ws + WS_W2), 0, 0, DEXP};
            pg8::MoeOrder S{ptab, G, vcu};
            pg8::EpiMoeOut E{(pg8::bf16_t*)(ws + WS_YMOE), (const int*)(ws + WS_LIST), ptab};
            pg8::gemm_phase<pg8::EpiMoeOut, pg8::MoeOrder, true, true>(lds, g, S, E);
        }
        SEAM(pb + 9);
#else
        SEAM(pb + 6); SEAM(pb + 7); SEAM(pb + 8); SEAM(pb + 9);
#endif
    }
#undef LCONST
#if N_LAYERS > 1
#define LCONST 1
    {
        constexpr int l = LCONST; constexpr int pb = 1 + l * PH_PER_LAYER;
        REP(pb + 0) if (IN(pb + 0)) { REPBAR KArgsP ap = fresh_args(); PHASE_IDS unsigned char* ws = ap->ws; (void)ws;
            if (l == 0) { mod_finalize(ws, tid, G); phase_rownorm<0, false>(ap, lds, tid, lane, wave, G, ap->in[I_X], ap->out, ap->in[I_NORM_MIX], true, 0, 0, 0); }
            else {
#if EN_MOE
                phase_rownorm<0, true>(ap, lds, tid, lane, wave, G, ap->out, ap->out, ap->in[I_NORM_MIX] + l * DM, false, l, 0, l - 1);
#else
                phase_rownorm<0, false>(ap, lds, tid, lane, wave, G, ap->out, ap->out, ap->in[I_NORM_MIX] + l * DM, false, l, 0, l - 1);
#endif
            }
        }
        SEAM(pb + 0);
        REP(pb + 1) if (IN(pb + 1)) { REPBAR KArgsP ap = fresh_args(); PHASE_IDS unsigned char* ws = ap->ws; (void)ws;
            pg8::Gemm g{(const pg8::bf16_t*)(ws + WS_HN), (const pg8::bf16_t*)(ws + WS_WIN) + (size_t)l * NPROJ_PAD * DM, NTOK, NPROJ_PAD, DM};
            pg8::StaticOrder S; S.init(NTOK, NPROJ_PAD, G, bx);
            pg8::EpiProj E{(pg8::bf16_t*)(ws + WS_PROJ), (float*)(ws + WS_GATES)};
            pg8::gemm_phase<pg8::EpiProj, pg8::StaticOrder, GEMM_ALIGN, GEMM_SP2>(lds, g, S, E);
        }
        SEAM(pb + 1);
        REP(pb + 2) if (IN(pb + 2)) { REPBAR KArgsP ap = fresh_args(); PHASE_IDS unsigned char* ws = ap->ws; (void)ws;
#if EN_MLSTM
            for (int q_ = 0; q_ < 1 + (REPN - 1) * ((DBL_SUB == 1) && l == 0); ++q_) { phase_m1(ap, lds, tid, lane, wave, vcu, G, l); __syncthreads(); }
            __syncthreads();
#endif
#if EN_S5
            phase_s1(ap, lds, tid, lane, wave, vcu, G, l); __syncthreads();
#if DBL_SUB == 2
            if (l == 0) { phase_s1(ap, lds, tid, lane, wave, vcu, G, l); __syncthreads(); phase_s1(ap, lds, tid, lane, wave, vcu, G, l); __syncthreads(); phase_s1(ap, lds, tid, lane, wave, vcu, G, l); __syncthreads(); phase_s1(ap, lds, tid, lane, wave, vcu, G, l); __syncthreads(); }
#endif
            __syncthreads();
#endif
#if EN_RWKV
            for (int q_ = 0; q_ < 1 + (REPN - 1) * ((DBL_SUB == 3) && l == 0); ++q_) { phase_r1(ap, lds, tid, lane, wave, vcu, G, l); __syncthreads(); }
#endif
        }
        SEAM(pb + 2);
        REP(pb + 3) if (IN(pb + 3)) { REPBAR KArgsP ap = fresh_args(); PHASE_IDS unsigned char* ws = ap->ws; (void)ws;
            phase_m2(ws, tid, vcu, G);
            phase_s2(ap, tid, vcu, G, l);
            __syncthreads();
#if DBL_SUB == 5
            if (l == 0) { phase_r2_build<false>(ap, lds, tid, lane, wave, vcu, G, l); __syncthreads(); }
#endif
            phase_r2_build(ap, lds, tid, lane, wave, vcu, G, l);
        }
        SEAM(pb + 3);
        REP(pb + 4) if (IN(pb + 4)) { REPBAR KArgsP ap = fresh_args(); PHASE_IDS unsigned char* ws = ap->ws; (void)ws;
            if (bx < R2_WGS) {
_Pragma("nounroll")
 for (int q_ = 0; q_ < 1 + (REPN - 1) * ((DBL_SUB == 4) && l == 0); ++q_) { phase_r2_scan(ap, lds, tid, lane, wave, bx, l); __syncthreads(); } }
            else { phase_s3(ap, lds, tid, lane, wave, 0, 1, l, (unsigned*)(ws + WS_CTL) + CW_Q + 64 * l + 32); __syncthreads(); }
            {
                unsigned* qctr = (unsigned*)(ws + WS_CTL) + CW_Q + 64 * l; volatile LAS unsigned* qw = (volatile LAS unsigned*)(lds + MISC_OFF) + 16;
                for (;;) {
                    if (tid == 0) *qw = __hip_atomic_fetch_add(qctr, 1u, __ATOMIC_RELAXED, __HIP_MEMORY_SCOPE_AGENT);
                    __syncthreads();
                    const int u = (int)*qw;
                    __syncthreads();
                    if (u >= NUNIT_M) break;
                    phase_m3(ap, lds, tid, lane, wave, u, NUNIT_M, l);
                }
            }
        }
        SEAM(pb + 4);
        REP(pb + 6) if (IN(pb + 6)) { REPBAR KArgsP ap = fresh_args(); PHASE_IDS unsigned char* ws = ap->ws; (void)ws;
            pg8::Gemm g{(const pg8::bf16_t*)(ws + WS_YC), (const pg8::bf16_t*)(ws + WS_WOUT) + (size_t)l * DM * DM, NTOK, DM, DM};
            pg8::StaticOrder S; S.init(NTOK, DM, G, bx);
            pg8::EpiResid E{l == 0 ? ap->in[I_X] : (const float*)ap->out, ap->out, (const float*)(ws + WS_MODF) + (size_t)l * 4 * 6144, 2048};
            pg8::gemm_phase<pg8::EpiResid, pg8::StaticOrder, GEMM_ALIGN, GEMM_SP2>(lds, g, S, E);
        }
        SEAM(pb + 6);
#if EN_MOE
        REP(pb + 7) if (IN(pb + 7)) { REPBAR KArgsP ap = fresh_args(); PHASE_IDS phase_router(ap, lds, tid, lane, wave, G, l); __syncthreads();
            moe_convert13(ap->in[I_MW1], ap->in[I_MW3], l, (bf16*)(ap->ws + WS_W13), vcu * NWAVES + wave, G * NWAVES, (LAS float*)(lds + wave * 16640), lane);
            moe_convert2(ap->in[I_MW2], l, (bf16*)(ap->ws + WS_W2), vcu * NWAVES + wave, G * NWAVES, (LAS float*)(lds + wave * 16640), lane); }
        SEAM(pb + 7);
        REP(pb + 8) if (IN(pb + 8)) { REPBAR KArgsP ap = fresh_args(); PHASE_IDS unsigned char* ws = ap->ws; (void)ws;
            LAS int* ptab = (LAS int*)(lds + PTAB_OFF); LAS int* pst = ptab + 512; LAS int* cnt = pst + 32;
            build_ptab((const unsigned*)(ws + WS_CTL) + CW_CNT + l * 32, ptab, pst, cnt, tid);
            pg8::Gemm g{(const pg8::bf16_t*)(ws + WS_HN), (const pg8::bf16_t*)(ws + WS_W13), 0, 0, DM, (const int*)(ws + WS_LIST), ptab};
            pg8::MoeOrder S{ptab, G, vcu};
            pg8::EpiSwiglu E{(pg8::bf16_t*)(ws + WS_HMID)};
            pg8::gemm_phase<pg8::EpiSwiglu, pg8::MoeOrder, false, true, true>(lds, g, S, E);
        }
        SEAM(pb + 8);
        REP(pb + 9) if (IN(pb + 9)) { REPBAR KArgsP ap = fresh_args(); PHASE_IDS unsigned char* ws = ap->ws; (void)ws;
            LAS int* ptab = (LAS int*)(lds + PTAB_OFF); LAS int* pst = ptab + 512; LAS int* cnt = pst + 32;
            build_ptab((const unsigned*)(ws + WS_CTL) + CW_CNT + l * 32, ptab, pst, cnt, tid);
            pg8::Gemm g{(const pg8::bf16_t*)(ws + WS_HMID), (const pg8::bf16_t*)(ws + WS_W2), 0, 0, DEXP};
            pg8::MoeOrder S{ptab, G, vcu};
            pg8::EpiMoeOut E{(pg8::bf16_t*)(ws + WS_YMOE), (const int*)(ws + WS_LIST), ptab};
            pg8::gemm_phase<pg8::EpiMoeOut, pg8::MoeOrder, true, true>(lds, g, S, E);
        }
        SEAM(pb + 9);
#else
        SEAM(pb + 6); SEAM(pb + 7); SEAM(pb + 8); SEAM(pb + 9);
#endif
    }
#undef LCONST
#endif
    if (IN(PH_FINAL)) { KArgsP ap = fresh_args(); PHASE_IDS
#if EN_MOE
        if (N_LAYERS > 0) phase_rownorm<1, true>(ap, lds, tid, lane, wave, G, ap->out, ap->out, ap->in[I_NORM_FINAL], false, 0, 0, N_LAYERS - 1);
        else phase_rownorm<1, false>(ap, lds, tid, lane, wave, G, ap->in[I_X], ap->out, ap->in[I_NORM_FINAL], false, 0, 0, 0);
#else
        phase_rownorm<1, false>(ap, lds, tid, lane, wave, G, N_LAYERS > 0 ? (const float*)ap->out : ap->in[I_X], ap->out, ap->in[I_NORM_FINAL], false, 0, 0, 0);
#endif
    }
#undef IN
#undef SEAM
}

extern "C" void kernel_launch(void* const* d_in, const int* in_sizes, int n_in, void* d_out, int out_size, void* d_ws, size_t ws_size, hipStream_t stream) {
    static int grid = 0;
    if (grid == 0) {
        if (n_in != 47 || out_size != NTOK * DM || ws_size < WS_END) { fprintf(stderr, "kernel_launch: unexpected problem (n_in %d, out %d, ws %zu < %zu)\n", n_in, out_size, ws_size, (size_t)WS_END); grid = -1; return; }
        int dev = 0, cus = 0, per_cu = 0;
        if (hipGetDevice(&dev) != hipSuccess || hipDeviceGetAttribute(&cus, hipDeviceAttributeMultiprocessorCount, dev) != hipSuccess) { grid = -1; return; }
        if (hipFuncSetAttribute((const void*)fwd, hipFuncAttributeMaxDynamicSharedMemorySize, LDS_BYTES) != hipSuccess) { fprintf(stderr, "kernel_launch: hipFuncSetAttribute failed\n"); grid = -1; return; }
        if (hipOccupancyMaxActiveBlocksPerMultiprocessor(&per_cu, (const void*)fwd, NTHR, LDS_BYTES) != hipSuccess || per_cu < 1) fprintf(stderr, "kernel_launch: occupancy query says %d\n", per_cu);
        (void)hipGetLastError();
        grid = cus;
        if (grid != 256) fprintf(stderr, "kernel_launch: %d CUs (built for 256)\n", grid);
    }
    if (grid < 0) return;
    (void)hipMemsetAsync((char*)d_ws + WS_CTL, 0, CTL_ZERO_BYTES, stream);
    Args a{};
    for (int i = 0; i < 47; ++i) a.in[i] = (const float*)d_in[i];
    a.out = (float*)d_out; a.ws = (unsigned char*)d_ws;
#if MK_PER_PHASE
    for (int p = 0; p < N_PHASES; ++p) { a.ph_lo = p; a.ph_hi = p + 1; hipLaunchKernelGGL(fwd, dim3(grid), dim3(NTHR), LDS_BYTES, stream, a); }
#else
    a.ph_lo = 0; a.ph_hi = N_PHASES; hipLaunchKernelGGL(fwd, dim3(grid), dim3(NTHR), LDS_BYTES, stream, a);
#endif
}
#ifdef DIAG_KERNELS
#define DK(name, ...) __global__ void __launch_bounds__(NTHR, 2) name(Args args) { extern __shared__ __attribute__((aligned(16))) unsigned char lds_raw[]; LAS unsigned char* lds = (LAS unsigned char*)lds_raw; \
    const int tid = threadIdx.x, lane = tid & 63, wave = __builtin_amdgcn_readfirstlane(tid >> 6); const int G = gridDim.x; const int bx = blockIdx.x; const int vcu = bx; KArgsP ap = fresh_args(); int l = ap->ph_lo; (void)lane; (void)wave; (void)vcu; (void)G; (void)l; __VA_ARGS__ }
DK(k_prologue, phase_prologue(ap, lds, tid, lane, wave, vcu, G);)
DK(k_norm0, phase_rownorm<0, false>(ap, lds, tid, lane, wave, G, ap->in[I_X], ap->out, ap->in[I_NORM_MIX], true, 0, 0, 0);)
DK(k_norm1, phase_rownorm<0, true>(ap, lds, tid, lane, wave, G, ap->out, ap->out, ap->in[I_NORM_MIX], false, l, 0, 0);)
DK(k_normf, phase_rownorm<1, true>(ap, lds, tid, lane, wave, G, ap->out, ap->out, ap->in[I_NORM_MIX], false, l, 0, 0);)
DK(k_m1, phase_m1(ap, lds, tid, lane, wave, vcu, G, l);)
DK(k_m2, phase_m2(ap->ws, tid, vcu, G);)
DK(k_m3, phase_m3(ap, lds, tid, lane, wave, vcu, G, l);)
DK(k_s1, phase_s1(ap, lds, tid, lane, wave, vcu, G, l);)
DK(k_s2, phase_s2(ap, tid, vcu, G, l);)
DK(k_s3, phase_s3(ap, lds, tid, lane, wave, vcu, G, l);)
DK(k_r1, phase_r1(ap, lds, tid, lane, wave, vcu, G, l);)
DK(k_r2b, phase_r2_build(ap, lds, tid, lane, wave, vcu, G, l);)
DK(k_r2s, phase_r2_scan(ap, lds, tid, lane, wave, vcu, l);)
DK(k_r3, phase_r3(ap, lane, vcu * NWAVES + wave, G * NWAVES, l);)
DK(k_router, phase_router(ap, lds, tid, lane, wave, G, l);)
DK(k_gather, phase_gather(ap, lds, tid, lane, wave, vcu, G, l);)
DK(k_moecv, moe_convert13(ap->in[I_MW1], ap->in[I_MW3], 1, (bf16*)(ap->ws + WS_W13), vcu * NWAVES + wave, G * NWAVES, (LAS float*)(lds + wave * 16640), lane);)
#endif
```

```cpp
#include <hip/hip_runtime.h>
#include <cstdio>
#include <cstdint>
#define MK_PER_PHASE 0

#ifndef MK_PER_PHASE
#define MK_PER_PHASE 0
#endif
#ifndef EN_MLSTM
#define EN_MLSTM 1
#endif
#ifndef EN_S5
#define EN_S5 1
#endif
#ifndef EN_RWKV
#define EN_RWKV 1
#endif
#ifndef EN_MOE
#define EN_MOE 1
#endif
#ifndef N_LAYERS
#define N_LAYERS 2
#endif
constexpr int NWAVES = 8, NTHR = 512;
constexpr int DM = 1024, NB = 4, SEQ = 8192, NTOK = NB * SEQ;
constexpr int DA = 384, DBR = 384, DC = 256, NH = 6, HD = 64, NCH = SEQ / 64;
constexpr int IN_COLS = 2828, NPROJ = 2816, NPROJ_PAD = 3072;
constexpr int PC_QK = 0, PC_V = 384, PC_O = 768, PC_RW = 1152, PC_S5 = 2560;
constexpr int RWC_R = 0, RWC_K = 384, RWC_V = 768, RWC_WD = 1152, RWC_AD = 1216, RWC_GD = 1280, RW_COLS = 1408;
constexpr int NEXP = 32, DEXP = 512, MOE_ROWS_MAX = 73728;
constexpr int NUNIT_M = NB * NCH * NH;
constexpr int CL_STRIDE = 4160;
constexpr float NORM_EPS = 1e-6f, HEAD_NORM_EPS = 1e-5f, RWKV_GN_EPS = 64e-5f;

constexpr size_t MiB = 1u << 20;
constexpr size_t WS_CTL = 0, CTL_ZERO_BYTES = 1 * MiB;
constexpr size_t WS_MODP = 1 * MiB;
constexpr size_t WS_MODF = 2 * MiB + 512 * 1024;
constexpr size_t WS_S5BB = 2 * MiB + 896 * 1024;
constexpr size_t WS_RTW = 3 * MiB;
constexpr size_t WS_S5AP = 3 * MiB + 384 * 1024;
constexpr size_t WS_MLW = 3 * MiB + 512 * 1024;
constexpr size_t WS_S5CM = 2 * MiB + 768 * 1024;
constexpr size_t WS_GLUT = 3 * MiB + 768 * 1024;
constexpr size_t WS_WIN = 4 * MiB;
constexpr size_t WS_WOUT = 16 * MiB;
constexpr size_t WS_GATES = 20 * MiB;
constexpr size_t WS_W13 = 22 * MiB;
constexpr size_t WS_W2 = 86 * MiB;
constexpr size_t WS_HN = 118 * MiB;
constexpr size_t WS_CLOC = 118 * MiB;
constexpr size_t WS_MSC = 168 * MiB;
constexpr size_t WS_S5ST = 170 * MiB;
constexpr size_t WS_VF = 182 * MiB;
constexpr size_t WS_YC = 206 * MiB;
constexpr size_t WS_LIST = 206 * MiB;
constexpr size_t WS_ROWMAP = 214 * MiB;
constexpr size_t WS_TOKE = 215 * MiB;
constexpr size_t WS_TOKW = 215 * MiB + 512 * 1024;
constexpr size_t WS_PROJ = 270 * MiB;
constexpr size_t WS_RE = 446 * MiB, WS_RA = 470 * MiB, WS_RG = 494 * MiB, WS_RVG = 518 * MiB;
constexpr size_t WS_XG = 270 * MiB;
constexpr size_t WS_HMID = 414 * MiB;
constexpr size_t WS_YMOE = 270 * MiB;
constexpr size_t WS_R1W = 542 * MiB;
constexpr size_t WS_OPA = 22 * MiB;
constexpr size_t WS_OPB = 543 * MiB;
constexpr size_t WS_END = 591 * MiB;
constexpr int CW_TMO = 0, CW_BAR = 4096, CW_CNT = 8192, CW_Q = 8320;

constexpr int RING_BYTES = 131072, MISC_OFF = 135168, PTAB_OFF = MISC_OFF + 1024, LDS_BYTES = 147456;

#define GAS __attribute__((address_space(1)))
#define LAS __attribute__((address_space(3)))
typedef unsigned short bf16;
typedef unsigned v4u __attribute__((ext_vector_type(4)));
typedef unsigned v2u __attribute__((ext_vector_type(2)));
typedef float f32x4 __attribute__((ext_vector_type(4)));
typedef float f32x2 __attribute__((ext_vector_type(2)));
typedef GAS unsigned gu32;
#define RLX_AGENT __ATOMIC_RELAXED, __HIP_MEMORY_SCOPE_AGENT
#define LDS_WAIT() asm volatile("s_waitcnt lgkmcnt(0)" ::: "memory")
#define VM_WAIT() asm volatile("s_waitcnt vmcnt(0)" ::: "memory")
typedef float f32x2v __attribute__((ext_vector_type(2)));
typedef __bf16 bf16x2v __attribute__((ext_vector_type(2)));
__device__ __forceinline__ unsigned pk2(float lo, float hi) { const f32x2v v = {lo, hi}; const bf16x2v b = __builtin_convertvector(v, bf16x2v); return __builtin_bit_cast(unsigned, b); }
__device__ __forceinline__ unsigned f2bf(float f) { return pk2(f, 0.f) & 0xffffu; }
__device__ __forceinline__ float bf2f(unsigned v) { return __builtin_bit_cast(float, v << 16); }
__device__ __forceinline__ float bflo(unsigned w) { return __builtin_bit_cast(float, w << 16); }
__device__ __forceinline__ float bfhi(unsigned w) { return __builtin_bit_cast(float, w & 0xffff0000u); }
__device__ __forceinline__ float sigmoidf_(float x) { return 1.f / (1.f + __expf(-x)); }
__device__ __forceinline__ float wave_sum(float v) {
#pragma unroll
    for (int o = 1; o < 64; o <<= 1) v += __shfl_xor(v, o);
    return v;
}
__device__ __forceinline__ float wave_max(float v) {
#pragma unroll
    for (int o = 1; o < 64; o <<= 1) v = fmaxf(v, __shfl_xor(v, o));
    return v;
}
namespace pg8 {
#define PG8_LAS __attribute__((address_space(3)))
typedef unsigned short bf16_t;
typedef short bf16x8 __attribute__((ext_vector_type(8)));
typedef float f32x4 __attribute__((ext_vector_type(4)));
typedef unsigned u32x4 __attribute__((ext_vector_type(4)));
constexpr int BM = 256, BK = 64, HALF = 128, HTB = HALF * BK * 2  , STAGE_BYTES = 8 * HTB, NXCD = 8, WGM = 8;

__host__ __device__ __forceinline__ int lds_byte(int r, int c) { const int st = (r >> 4) * 2 + (c >> 5), rr = r & 15, cc = c & 31, ob = rr * 64 + cc * 2; return st * 1024 + (ob ^ (((ob >> 9) & 1) << 5)); }
__host__ __device__ __forceinline__ void stage_rc(int b, int& R, int& C) { const int st = b / 1024, sb = b % 1024, swz = sb ^ (((sb >> 9) & 1) << 5); R = (st >> 1) * 16 + swz / 64; C = (st & 1) * 32 + (swz % 64) / 2; }
__host__ __device__ __forceinline__ int perm32(int rho) { const int n = rho >> 4, i = rho & 15; return 8 * (i >> 2) + 4 * n + (i & 3); }

struct Unit { int pm, pn; };
__device__ __forceinline__ int moe_tok2(const int* list, PG8_LAS const int* ptab, int row) { const int e = ptab[1 + (row >> 8)], pos = row - ptab[512 + e]; return pos < ptab[544 + e] ? list[(size_t)e * 65536 + pos] : -1; }
struct Gemm { const bf16_t* A; const bf16_t* Bt; int M, N, K; const int* list = nullptr; PG8_LAS const int* ptab = nullptr; };

struct StaticOrder {
    int nM, nN, nwg, G, c;
    __host__ __device__ void init(int M, int N, int G_, int c_) { nM = M / BM; nN = N / BM; nwg = nM * nN; G = G_; c = c_; }
    __host__ __device__ bool next(int i, Unit& u) const {
        const long L = (long)i * G + c; if (L >= nwg) return false;
        int wgid = (int)L; { const int q = nwg / NXCD, r = nwg % NXCD, xcd = wgid % NXCD, off = wgid / NXCD; wgid = (xcd < r ? xcd * (q + 1) : r * (q + 1) + (xcd - r) * q) + off; }
        const int nig = WGM * nN, gid = wgid / nig, fm = gid * WGM, gsz = (nM - fm) < WGM ? (nM - fm) : WGM;
        u.pm = fm + ((wgid % nig) % gsz); u.pn = (wgid % nig) / gsz; return true;
    }
    __device__ __forceinline__ void a_ready(const Unit&) const {}
    __device__ __forceinline__ void done(const Unit&) const {}
};

__device__ __forceinline__ unsigned cvt_pk_bf16(float lo, float hi) { unsigned r; asm volatile("v_cvt_pk_bf16_f32 %0, %1, %2" : "=v"(r) : "v"(lo), "v"(hi)); return r; }

struct EpiProj {
    static constexpr bool PERM = true, AFTER_DRAIN = false;
    bf16_t* O; float* G;
    __device__ __forceinline__ void operator()(const f32x4 (&acc)[2][2][4][2], const Unit& u, int wr, int wc, int fr, int fq) const {
        const int row0 = u.pm * BM + wr * 64 + fr;
        if (u.pn < 11) {
            const int col0 = u.pn * BM + wc * 32 + 8 * fq;
#pragma unroll
            for (int ai = 0; ai < 2; ++ai)
#pragma unroll
                for (int m = 0; m < 4; ++m) { bf16_t* rowp = O + (size_t)(row0 + ai * HALF + m * 16) * 2816 + col0;
#pragma unroll
                    for (int bj = 0; bj < 2; ++bj) { const f32x4 v0 = acc[ai][bj][m][0], v1 = acc[ai][bj][m][1];
                        u32x4 w; w.x = cvt_pk_bf16(v0[0], v0[1]); w.y = cvt_pk_bf16(v0[2], v0[3]); w.z = cvt_pk_bf16(v1[0], v1[1]); w.w = cvt_pk_bf16(v1[2], v1[3]);
                        *(u32x4*)(rowp + bj * HALF) = w; } }
        } else if (wc == 0 && fq < 2) {
#pragma unroll
            for (int ai = 0; ai < 2; ++ai)
#pragma unroll
                for (int m = 0; m < 4; ++m) { float* rowp = G + (size_t)(row0 + ai * HALF + m * 16) * 16 + 8 * fq;
                    *(f32x4*)(rowp) = acc[ai][0][m][0]; *(f32x4*)(rowp + 4) = acc[ai][0][m][1]; }
        }
    }
};
struct EpiResid {
    static constexpr bool PERM = true, AFTER_DRAIN = false;
    const float* xin; float* out; const float* gate;
    int goff;
    __device__ __forceinline__ void operator()(const f32x4 (&acc)[2][2][4][2], const Unit& u, int wr, int wc, int fr, int fq) const {
        const int row0 = u.pm * BM + wr * 64 + fr, col0 = u.pn * BM + wc * 32 + 8 * fq;
        const float* gp = gate + (size_t)(row0 >> 13) * 6144 + goff + col0;
        f32x4 g[2][2];
#pragma unroll
        for (int bj = 0; bj < 2; ++bj)
#pragma unroll
            for (int n = 0; n < 2; ++n) g[bj][n] = *(const f32x4*)(gp + bj * HALF + 4 * n) + 1.0f;
#pragma unroll
        for (int ai = 0; ai < 2; ++ai)
#pragma unroll
            for (int m = 0; m < 4; ++m) { const size_t off = (size_t)(row0 + ai * HALF + m * 16) * 1024 + col0;
#pragma unroll
                for (int bj = 0; bj < 2; ++bj)
#pragma unroll
                    for (int n = 0; n < 2; ++n) { const f32x4 xv = *(const f32x4*)(xin + off + bj * HALF + 4 * n);
                        *(f32x4*)(out + off + bj * HALF + 4 * n) = xv + g[bj][n] * acc[ai][bj][m][n]; } }
    }
};
struct EpiSwiglu {
    static constexpr bool PERM = true, AFTER_DRAIN = false;
    bf16_t* H;
    __device__ __forceinline__ void operator()(const f32x4 (&acc)[2][2][4][2], const Unit& u, int wr, int wc, int fr, int fq) const {
        const int row0 = u.pm * BM + wr * 64 + fr, hid0 = 128 * (u.pn & 3) + 16 * wc + 4 * fq;
#pragma unroll
        for (int ai = 0; ai < 2; ++ai)
#pragma unroll
            for (int m = 0; m < 4; ++m) { bf16_t* rowp = H + (size_t)(row0 + ai * HALF + m * 16) * 512 + hid0;
#pragma unroll
                for (int bj = 0; bj < 2; ++bj) { const f32x4 g = acc[ai][bj][m][0], uu = acc[ai][bj][m][1]; float h[4];
#pragma unroll
                    for (int i = 0; i < 4; ++i) h[i] = g[i] / (1.f + __expf(-g[i])) * uu[i];
                    unsigned w0 = cvt_pk_bf16(h[0], h[1]), w1 = cvt_pk_bf16(h[2], h[3]);
                    *(unsigned long long*)(rowp + 64 * bj) = (unsigned long long)w0 | ((unsigned long long)w1 << 32); } }
    }
};
struct EpiMoeOut {
    static constexpr bool PERM = true, AFTER_DRAIN = false;
    bf16_t* Y; const int* list; PG8_LAS const int* ptab;
    __device__ __forceinline__ void operator()(const f32x4 (&acc)[2][2][4][2], const Unit& u, int wr, int wc, int fr, int fq) const {
        const int row0 = u.pm * BM + wr * 64 + fr, col0 = (u.pn & 3) * BM + wc * 32 + 8 * fq;
#pragma unroll
        for (int ai = 0; ai < 2; ++ai)
#pragma unroll
            for (int m = 0; m < 4; ++m) { const int dst = moe_tok2(list, ptab, row0 + ai * HALF + m * 16);
                if (dst >= 0) { bf16_t* rowp = Y + (size_t)dst * 1024 + col0;
#pragma unroll
                    for (int bj = 0; bj < 2; ++bj) { const f32x4 v0 = acc[ai][bj][m][0], v1 = acc[ai][bj][m][1];
                        u32x4 w; w.x = cvt_pk_bf16(v0[0], v0[1]); w.y = cvt_pk_bf16(v0[2], v0[3]); w.z = cvt_pk_bf16(v1[0], v1[1]); w.w = cvt_pk_bf16(v1[2], v1[3]);
                        *(u32x4*)(rowp + bj * HALF) = w; } } }
    }
};
struct MoeOrder {
    PG8_LAS const int* ptab; int G, c;
    __device__ __forceinline__ bool next(int i, Unit& u) const {
        const int L = i * G + c, np = __builtin_amdgcn_readfirstlane(ptab[0]);
        if (L >= np * 4) return false;
        const int p = L >> 2; u.pm = p; u.pn = __builtin_amdgcn_readfirstlane(ptab[1 + p]) * 4 + (L & 3); return true;
    }
    __device__ __forceinline__ void a_ready(const Unit&) const {}
    __device__ __forceinline__ void done(const Unit&) const {}
};
template <class Epi, class Sched, bool ALIGN_EPI = false, bool SP2 = false, bool GATHER = false>
__device__ __forceinline__ void gemm_phase(PG8_LAS unsigned char* lds, const Gemm g, const Sched& S, const Epi& E) {
    int tid_ = threadIdx.x; asm volatile("" : "+v"(tid_));
    const int tid = tid_, wid = __builtin_amdgcn_readfirstlane(tid >> 6), lane = tid & 63, wr = wid >> 2, wc = wid & 3, fr = lane & 15, fq = lane >> 4;
    const int K = g.K, nt = K / BK;
    static_assert(!GATHER || SP2, "the gathered-A variant exists for the SP2 loop only");
    unsigned voffA[2], voffB[2];
    unsigned vAc[2] = {0u, 0u}, vAn[2] = {0u, 0u};
#pragma unroll
    for (int i = 0; i < 2; ++i) { int R, C; stage_rc(tid * 16 + i * 8192, R, C); const int Rb = Epi::PERM ? ((R & ~31) + perm32(R & 31)) : R;
        voffA[i] = (unsigned)(R * K + C) * 2u; voffB[i] = (unsigned)(Rb * K + C) * 2u; }
    const size_t kstep = (size_t)(BK * 2);
    const size_t hstep = (size_t)HALF * K * 2;
    const size_t tstep = 2 * hstep;
    const unsigned ldsw = (unsigned)wid * 1024u;
    const int aoff = lds_byte(wr * 64 + fr, fq * 8), boff = lds_byte(wc * 32 + fr, fq * 8);
#define PG8_SA(b, h) (((b) * 2 + (h)) * HTB)
#define PG8_SB(b, h) ((4 + (b) * 2 + (h)) * HTB)
#define PG8_STAGE(bufoff, gbase, voff) do { _Pragma("unroll") for (int _i = 0; _i < 2; ++_i) \
        __builtin_amdgcn_global_load_lds((const unsigned*)((const char*)(gbase) + (voff)[_i]), (PG8_LAS unsigned*)(lds + (bufoff) + ldsw + _i * 8192), 16, 0, 0); } while (0)
#define PG8_STAGEG(bufoff, base, pk) do { unsigned vg_[2]; _Pragma("unroll") for (int i_ = 0; i_ < 2; ++i_) { int R_, C_; stage_rc(tid * 16 + i_ * 8192, R_, C_); vg_[i_] = (((pk) >> (16 * i_)) & 0xffffu) * (unsigned)(2 * K) + (unsigned)(2 * C_); } PG8_STAGE(bufoff, base, vg_); } while (0)
#define PG8_STAGEA(bufoff, base, hh, nx) do { if constexpr (GATHER) { const unsigned pk_ = (nx) ? vAn[hh] : vAc[hh]; PG8_STAGEG(bufoff, base, pk_); } else PG8_STAGE(bufoff, (base) + (hh) * hstep, voffA); } while (0)
#define PG8_GOFF(dst, unit) do { _Pragma("unroll") for (int hh_ = 0; hh_ < 2; ++hh_) { unsigned pk_ = 0u; _Pragma("unroll") for (int i_ = 0; i_ < 2; ++i_) { int R_, C_; stage_rc(tid * 16 + i_ * 8192, R_, C_); \
        const int t2_ = moe_tok2(g.list, g.ptab, (unit).pm * BM + hh_ * HALF + R_); pk_ |= (unsigned)(t2_ < 0 ? 0 : (t2_ >> 1)) << (16 * i_); } dst[hh_] = pk_; } } while (0)
#define PG8_LDA(dst, b, h) do { _Pragma("unroll") for (int m = 0; m < 4; ++m) _Pragma("unroll") for (int k = 0; k < 2; ++k) dst[m][k] = *(const PG8_LAS bf16x8*)(lds + PG8_SA(b, h) + aoff + m * 2048 + k * 1024); } while (0)
#define PG8_LDB(dst, b, h) do { _Pragma("unroll") for (int n = 0; n < 2; ++n) _Pragma("unroll") for (int k = 0; k < 2; ++k) dst[n][k] = *(const PG8_LAS bf16x8*)(lds + PG8_SB(b, h) + boff + n * 2048 + k * 1024); } while (0)
#define PG8_MMA(ai, bj, At, Bt) do { __builtin_amdgcn_s_setprio(1); _Pragma("unroll") for (int m = 0; m < 4; ++m) _Pragma("unroll") for (int n = 0; n < 2; ++n) _Pragma("unroll") for (int k = 0; k < 2; ++k) \
        acc[ai][bj][m][n] = __builtin_amdgcn_mfma_f32_16x16x32_bf16(Bt[n][k], At[m][k], acc[ai][bj][m][n], 0, 0, 0); __builtin_amdgcn_s_setprio(0); } while (0)
#define PG8_WAIT_V(n) asm volatile("s_waitcnt vmcnt(" #n ")" ::: "memory")
#define PG8_WAIT_L(n) asm volatile("s_waitcnt lgkmcnt(" #n ")" ::: "memory")
#define PG8_BAR __builtin_amdgcn_s_barrier()
#define PG8_SCHED __builtin_amdgcn_sched_barrier(0)
    Unit cur, nxt; int ui = 0;
    if (!S.next(0, cur)) return;
    f32x4 acc[2][2][4][2];
#pragma unroll
    for (int a = 0; a < 2; ++a)
#pragma unroll
        for (int b = 0; b < 2; ++b)
#pragma unroll
            for (int m = 0; m < 4; ++m)
#pragma unroll
                for (int n = 0; n < 2; ++n) acc[a][b][m][n] = (f32x4){0.f, 0.f, 0.f, 0.f};
    bf16x8 At[4][2], B0[2][2], B1[2][2];
    const char* cA = (const char*)g.A + (GATHER ? (size_t)0 : (size_t)cur.pm * tstep); const char* cB = (const char*)g.Bt + (size_t)cur.pn * tstep;
    if constexpr (GATHER) { PG8_GOFF(vAc, cur); }
    S.a_ready(cur);
    if constexpr (SP2) {
        PG8_STAGE(PG8_SB(0, 0), cB, voffB); PG8_STAGE(PG8_SB(0, 1), cB + hstep, voffB); PG8_STAGEA(PG8_SA(0, 0), cA, 0, false); PG8_STAGEA(PG8_SA(0, 1), cA, 1, false);
        if (wr == 1) PG8_BAR;
        PG8_WAIT_V(2); PG8_BAR;
        PG8_STAGE(PG8_SB(1, 0), cB + kstep, voffB); PG8_STAGEA(PG8_SA(1, 0), cA + kstep, 0, false); PG8_STAGE(PG8_SB(1, 1), cB + hstep + kstep, voffB);
        PG8_WAIT_V(6); PG8_BAR;
    } else {
        PG8_STAGE(PG8_SB(0, 0), cB, voffB); PG8_STAGE(PG8_SA(0, 0), cA, voffA); PG8_STAGE(PG8_SB(0, 1), cB + hstep, voffB); PG8_STAGE(PG8_SA(0, 1), cA + hstep, voffA);
        if (wr == 1) PG8_BAR;
        PG8_WAIT_V(4); PG8_BAR;
        PG8_STAGE(PG8_SB(1, 0), cB + kstep, voffB); PG8_STAGE(PG8_SA(1, 0), cA + kstep, voffA); PG8_STAGE(PG8_SB(1, 1), cB + hstep + kstep, voffB);
        PG8_WAIT_V(6); PG8_BAR;
    }
    for (;;) {
        const bool has_next = S.next(ui + 1, nxt);
        const char* nA = (has_next && !GATHER) ? (const char*)g.A + (size_t)nxt.pm * tstep : cA;
        if constexpr (GATHER) { if (has_next) { PG8_GOFF(vAn, nxt); } else { vAn[0] = vAc[0]; vAn[1] = vAc[1]; } } const char* nB = has_next ? (const char*)g.Bt + (size_t)nxt.pn * tstep : cB;
        for (int t = 0; t < nt; t += 2) {
            const bool last = (t == nt - 2);
            const char* a1 = cA + (size_t)(t + 1) * kstep;
            const char* a2 = last ? nA : cA + (size_t)(t + 2) * kstep; const char* b2 = last ? nB : cB + (size_t)(t + 2) * kstep;
            const char* a3 = a2 + kstep; const char* b3 = b2 + kstep;
            if (last && has_next) S.a_ready(nxt);
            if constexpr (SP2) {
            PG8_LDB(B0, 0, 0); PG8_LDB(B1, 0, 1); PG8_SCHED; PG8_LDA(At, 0, 0); PG8_STAGEA(PG8_SA(1, 1), a1, 1, false);
            PG8_WAIT_V(8); PG8_WAIT_L(0); PG8_BAR; PG8_MMA(0, 0, At, B0); PG8_MMA(0, 1, At, B1); PG8_BAR; PG8_SCHED;
            PG8_LDA(At, 0, 1); PG8_STAGE(PG8_SB(0, 0), b2, voffB); PG8_STAGE(PG8_SB(0, 1), b2 + hstep, voffB); PG8_STAGEA(PG8_SA(0, 0), a2, 0, last);
            PG8_WAIT_V(8); PG8_WAIT_L(0); PG8_BAR; PG8_MMA(1, 0, At, B0); PG8_MMA(1, 1, At, B1); PG8_BAR; PG8_SCHED;
            PG8_LDB(B0, 1, 0); PG8_LDB(B1, 1, 1); PG8_SCHED; PG8_LDA(At, 1, 0); PG8_STAGEA(PG8_SA(0, 1), a2, 1, last);
            PG8_WAIT_V(8); PG8_WAIT_L(0); PG8_BAR; PG8_MMA(0, 0, At, B0); PG8_MMA(0, 1, At, B1); PG8_BAR; PG8_SCHED;
            PG8_LDA(At, 1, 1); PG8_STAGE(PG8_SB(1, 0), b3, voffB); PG8_STAGE(PG8_SB(1, 1), b3 + hstep, voffB); PG8_STAGEA(PG8_SA(1, 0), a3, 0, last);
            PG8_WAIT_V(8); PG8_WAIT_L(0); PG8_BAR; PG8_MMA(1, 0, At, B0); PG8_MMA(1, 1, At, B1); PG8_BAR; PG8_SCHED;
            } else {
            PG8_LDB(B0, 0, 0); PG8_SCHED; PG8_LDA(At, 0, 0); PG8_STAGE(PG8_SA(1, 1), a1 + hstep, voffA);
            PG8_WAIT_L(8); PG8_BAR; PG8_WAIT_L(0); PG8_MMA(0, 0, At, B0); PG8_BAR; PG8_SCHED;
            PG8_LDB(B1, 0, 1); PG8_STAGE(PG8_SB(0, 0), b2, voffB);
            PG8_BAR; PG8_WAIT_L(0); PG8_MMA(0, 1, At, B1); PG8_BAR;
            PG8_LDA(At, 0, 1); PG8_STAGE(PG8_SA(0, 0), a2, voffA);
            PG8_BAR; PG8_WAIT_L(0); PG8_MMA(1, 0, At, B0); PG8_BAR; PG8_SCHED;
            PG8_STAGE(PG8_SB(0, 1), b2 + hstep, voffB);
            PG8_WAIT_V(6); PG8_BAR; PG8_MMA(1, 1, At, B1); PG8_BAR;
            PG8_LDB(B0, 1, 0); PG8_SCHED; PG8_LDA(At, 1, 0); PG8_STAGE(PG8_SA(0, 1), a2 + hstep, voffA);
            PG8_WAIT_L(8); PG8_BAR; PG8_WAIT_L(0); PG8_MMA(0, 0, At, B0); PG8_BAR; PG8_SCHED;
            PG8_LDB(B1, 1, 1); PG8_STAGE(PG8_SB(1, 0), b3, voffB);
            PG8_BAR; PG8_WAIT_L(0); PG8_MMA(0, 1, At, B1); PG8_BAR;
            PG8_LDA(At, 1, 1); PG8_STAGE(PG8_SA(1, 0), a3, voffA);
            PG8_BAR; PG8_WAIT_L(0); PG8_MMA(1, 0, At, B0); PG8_BAR; PG8_SCHED;
            PG8_STAGE(PG8_SB(1, 1), b3 + hstep, voffB);
            PG8_WAIT_V(6); PG8_BAR; PG8_MMA(1, 1, At, B1); PG8_BAR;
            }
        }
        if constexpr (ALIGN_EPI) { if (wr == 0) PG8_BAR; }
        if constexpr (!Epi::AFTER_DRAIN) { E(acc, cur, wr, wc, fr, fq); S.done(cur); }
        if (!has_next) break;
#pragma unroll
        for (int a = 0; a < 2; ++a)
#pragma unroll
            for (int b = 0; b < 2; ++b)
#pragma unroll
                for (int m = 0; m < 4; ++m)
#pragma unroll
                    for (int n = 0; n < 2; ++n) acc[a][b][m][n] = (f32x4){0.f, 0.f, 0.f, 0.f};
        cur = nxt; cA = nA; cB = nB; ++ui;
        if constexpr (GATHER) { vAc[0] = vAn[0]; vAc[1] = vAn[1]; }
        if constexpr (ALIGN_EPI) { if (wr == 1) PG8_BAR; }
    }
    PG8_WAIT_V(0);
    if constexpr (!ALIGN_EPI) { if (wr == 0) PG8_BAR; }
    PG8_BAR;
    if constexpr (Epi::AFTER_DRAIN) { E.fused(acc, cur, wr, wc, fr, fq, lds, wid, lane); S.done(cur); }
#undef PG8_SA
#undef PG8_SB
#undef PG8_STAGE
#undef PG8_STAGEA
#undef PG8_STAGEG
#undef PG8_GOFF
#undef PG8_LDA
#undef PG8_LDB
#undef PG8_MMA
#undef PG8_WAIT_V
#undef PG8_WAIT_L
#undef PG8_BAR
#undef PG8_SCHED
}
}
#define XB_TMO      128
#define XB_XCNT(j)  (256  + 64 * (j))
#define XB_XSUB(j)  (1280 + 64 * (j))
#define XB_XGEN(j)  (2304 + 64 * (j))
#define XB_TOP      3328
#define XB_TOPGEN   3392
#define XCD_BAR_WORDS 3456
#define XB_SPIN_CAP (1u << 18)
#define LAS __attribute__((address_space(3)))

__device__ __forceinline__ unsigned xb_ld(unsigned* p)              { return __hip_atomic_load(p, __ATOMIC_RELAXED, __HIP_MEMORY_SCOPE_AGENT); }
__device__ __forceinline__ unsigned xb_add(unsigned* p, unsigned v) { return __hip_atomic_fetch_add(p, v, __ATOMIC_RELAXED, __HIP_MEMORY_SCOPE_AGENT); }
__device__ __forceinline__ unsigned xb_xcc_id() { return (unsigned)__builtin_amdgcn_s_getreg((3 << 11) | 20) & 0xFu; }
#define XB_SPIN(cond, bar) do { unsigned _sp = 0; while (cond) { __builtin_amdgcn_s_sleep(1); \
    if ((++_sp & 255u) == 0u) { if (xb_ld(&(bar)[XB_TMO])) break; if (_sp > XB_SPIN_CAP) { atomicAdd(&(bar)[XB_TMO], 1u); break; } } } } while (0)

struct XcdBarrier {
    unsigned* bar; unsigned x;
    volatile LAS unsigned* st;
};

__device__ __forceinline__ XcdBarrier xcd_barrier_post(unsigned* bar, volatile LAS unsigned* st) {
    XcdBarrier b; b.bar = bar; b.x = xb_xcc_id(); b.st = st;
    if (threadIdx.x == 0) (void)xb_add(&bar[XB_XCNT(b.x)], 1u);
    return b;
}
__device__ __forceinline__ void xcd_barrier_complete(unsigned* bar, unsigned x, unsigned& nloc, unsigned& nx) {
    const unsigned G = gridDim.x * gridDim.y * gridDim.z;
    unsigned sum, cnt, mine, sp = 0u;
    for (;;) {
        sum = 0u; cnt = 0u; mine = 0u;
#pragma unroll
        for (unsigned j = 0; j < 16; ++j) { const unsigned c = xb_ld(&bar[XB_XCNT(j)]); sum += c; cnt += (c > 0u) ? 1u : 0u; mine = (j == x) ? c : mine; }
        if (sum == G) break;
        __builtin_amdgcn_s_sleep(1);
        if ((++sp & 255u) == 0u) { if (xb_ld(&bar[XB_TMO])) break; if (sp > XB_SPIN_CAP) { atomicAdd(&bar[XB_TMO], 1u); break; } }
    }
    nloc = mine > 0u ? mine : 1u; nx = cnt > 0u ? cnt : 1u;
}

__device__ __forceinline__ void xcd_barrier(const XcdBarrier& b) {
    asm volatile("s_waitcnt vmcnt(0)" ::: "memory");
    __syncthreads();
    if (threadIdx.x == 0) {
        unsigned* bar = b.bar;
        __builtin_amdgcn_s_waitcnt(0);
        unsigned nloc = b.st[0], nx = b.st[1];
        if (nloc == 0u) { xcd_barrier_complete(bar, b.x, nloc, nx); b.st[0] = nloc; b.st[1] = nx; }
        const unsigned old = xb_add(&bar[XB_XSUB(b.x)], 1u);
        const unsigned gen = old / nloc;
        if (old + 1u == (gen + 1u) * nloc) {
            __builtin_amdgcn_fence(__ATOMIC_RELEASE, "agent");
            asm volatile("s_waitcnt vmcnt(0)" ::: "memory");
            const unsigned og = xb_add(&bar[XB_TOP], 1u);
            const unsigned tg = og / nx;
            if (og + 1u == (tg + 1u) * nx) xb_add(&bar[XB_TOPGEN], 1u);
            else XB_SPIN(xb_ld(&bar[XB_TOPGEN]) == tg, bar);
            __builtin_amdgcn_fence(__ATOMIC_ACQUIRE, "agent");
            xb_add(&bar[XB_XGEN(b.x)], 1u);
            asm volatile("s_waitcnt vmcnt(0)" ::: "memory");
        } else {
            XB_SPIN(xb_ld(&bar[XB_XGEN(b.x)]) == gen, bar);
            __builtin_amdgcn_fence(__ATOMIC_ACQUIRE, "agent");
            asm volatile("s_waitcnt vmcnt(0)" ::: "memory");
        }
    }
    __syncthreads();
}

struct Args { const float* in[47]; float* out; unsigned char* ws; int ph_lo, ph_hi; };
typedef const __attribute__((address_space(4))) Args* KArgsP;
__device__ __forceinline__ KArgsP fresh_args() { KArgsP p = (KArgsP)__builtin_amdgcn_kernarg_segment_ptr(); asm volatile("" : "+s"(p)); return p; }
enum { I_X = 0, I_C, I_ADA_W, I_ADA_B, I_NORM_MIX, I_NORM_FFN, I_NORM_FINAL, I_W_IN, I_W_OUT, I_CONV_W, I_CONV_B, I_WQ, I_WK, I_BI, I_BF, I_MNORM_W,
       I_RMU, I_RW0, I_RWUP, I_RA0, I_RAUP, I_RGUP, I_RKK, I_RKA, I_RRK, I_RLNW, I_RLNB, I_RV0, I_RVDN, I_RVUP,
       I_S5ARE, I_S5AIM, I_S5LDT, I_S5BRE, I_S5BIM, I_S5CRE, I_S5CIM, I_S5D, I_S5GLUW, I_S5GLUB,
       I_MWRG, I_MBRG, I_MWRE, I_MBRE, I_MW1, I_MW3, I_MW2 };

struct RmWin { __device__ __forceinline__ int operator()(int n) const { return n < 1152 ? n : (n < 1164 ? 2816 + (n - 1152) : (n < 2572 ? 1152 + (n - 1164) : 2560 + (n - 2572))); } };
struct RmId  { __device__ __forceinline__ int operator()(int n) const { return n; } };
struct RmGU  { int add; __device__ __forceinline__ int operator()(int n) const { return 8 * (n >> 2) + (n & 3) + add; } };
template <class RM>
__device__ __forceinline__ void transpose_item(const float* W, int ldw, int ncols, int k0, int n0, bf16* WT, int ldt, LAS float* scr, int lane, const RM rm) {
    const int nn = n0 + lane; const bool ok = nn < ncols; const float* src = W + (size_t)k0 * ldw + (ok ? nn : n0);
    float v[64];
#pragma unroll
    for (int kk = 0; kk < 64; ++kk) v[kk] = src[(size_t)kk * ldw];
#pragma unroll
    for (int kk = 0; kk < 64; ++kk) scr[kk * 65 + lane] = v[kk];
    LDS_WAIT(); asm volatile("" ::: "memory");
    const int c = lane & 7;
#pragma unroll
    for (int j = 0; j < 8; ++j) { const int nl = (lane >> 3) + 8 * j; const LAS float* s = scr + (8 * c) * 65 + nl;
        v4u o; o.x = pk2(s[0 * 65], s[1 * 65]); o.y = pk2(s[2 * 65], s[3 * 65]); o.z = pk2(s[4 * 65], s[5 * 65]); o.w = pk2(s[6 * 65], s[7 * 65]);
        if (n0 + nl < ncols) *(GAS v4u*)(WT + (size_t)rm(n0 + nl) * ldt + k0 + 8 * c) = o; }
    LDS_WAIT(); asm volatile("" ::: "memory");
}
__device__ __forceinline__ void moe_convert13(const float* w1, const float* w3, int l, bf16* W13, int worker, int nworkers, LAS float* scr, int lane) {
    for (int it = worker; it < NEXP * 256; it += nworkers) {
        const int e = it >> 8, r = it & 255; const size_t eo = (size_t)(l * NEXP + e) * DM * DEXP;
        if (r < 128) transpose_item(w1 + eo, DEXP, DEXP, 64 * (r >> 3), 64 * (r & 7), W13 + (size_t)e * 1024 * 1024, 1024, scr, lane, RmGU{0});
        else         transpose_item(w3 + eo, DEXP, DEXP, 64 * ((r - 128) >> 3), 64 * ((r - 128) & 7), W13 + (size_t)e * 1024 * 1024, 1024, scr, lane, RmGU{4});
    }
}
__device__ __forceinline__ void moe_convert2(const float* w2, int l, bf16* W2T, int worker, int nworkers, LAS float* scr, int lane) {
    for (int it = worker; it < NEXP * 128; it += nworkers) {
        const int e = it >> 7, r = it & 127; const size_t eo = (size_t)(l * NEXP + e) * DM * DEXP;
        transpose_item(w2 + eo, DM, DM, 64 * (r >> 4), 64 * (r & 15), W2T + (size_t)e * 1024 * 512, 512, scr, lane, RmId{});
    }
}
__device__ __forceinline__ void phase_prologue(KArgsP a, LAS unsigned char* lds, int tid, int lane, int wave, int vcu, int G) {
    unsigned char* ws = a->ws;
    LAS float* scr = (LAS float*)(lds + wave * 16640);
    const int gw = vcu * NWAVES + wave, NGW = G * NWAVES;
    bf16* WIN = (bf16*)(ws + WS_WIN); bf16* WOUT = (bf16*)(ws + WS_WOUT);
    for (int it = gw; it < 2 * 16 * 45; it += NGW) { const int l = it / (16 * 45), r = it % (16 * 45);
        transpose_item(a->in[I_W_IN] + (size_t)l * DM * IN_COLS, IN_COLS, IN_COLS, 64 * (r / 45), 64 * (r % 45), WIN + (size_t)l * NPROJ_PAD * DM, DM, scr, lane, RmWin{}); }
    for (int it = gw; it < 2 * 16 * 16; it += NGW) { const int l = it / 256, r = it % 256;
        transpose_item(a->in[I_W_OUT] + (size_t)l * DM * DM, DM, DM, 64 * (r >> 4), 64 * (r & 15), WOUT + (size_t)l * DM * DM, DM, scr, lane, RmId{}); }
    for (int it = gw; it < 2 * 244; it += NGW) { const int l = it / 244, r = 2828 + it % 244; GAS v4u* p = (GAS v4u*)(WIN + ((size_t)l * NPROJ_PAD + r) * DM);
        p[lane] = (v4u){0u, 0u, 0u, 0u}; p[lane + 64] = (v4u){0u, 0u, 0u, 0u}; }
    { float* RTW = (float*)(ws + WS_RTW);
      for (int idx = (vcu * NTHR + tid); idx < 2 * 1024 * 48; idx += G * NTHR) { const int j = idx % 48, k = (idx / 48) % 1024, l = idx / (48 * 1024);
          RTW[idx] = j < 4 ? a->in[I_MWRG][(size_t)(l * 1024 + k) * 4 + j] : (j < 36 ? a->in[I_MWRE][(size_t)(l * 1024 + k) * 32 + (j - 4)] : 0.f); } }
    { bf16* RW = (bf16*)(ws + WS_R1W);
      for (int idx = (vcu * NTHR + tid); idx < 2 * 98304 + 24576; idx += G * NTHR) { float v;
          if (idx < 2 * 98304) { const int l = idx / 98304, r = idx % 98304;
              if (r < 24576)      v = a->in[I_RWUP][(size_t)l * 64 * DBR + (r & 63) * DBR + (r >> 6)];
              else if (r < 49152) v = a->in[I_RAUP][(size_t)l * 64 * DBR + ((r - 24576) & 63) * DBR + ((r - 24576) >> 6)];
              else                v = a->in[I_RGUP][(size_t)l * 128 * DBR + ((r - 49152) & 127) * DBR + ((r - 49152) >> 7)];
          } else { const int r = idx - 2 * 98304;
              if (r < 12288) v = a->in[I_RVDN][(size_t)(r % 384) * 32 + (r / 384)];
              else           v = a->in[I_RVUP][(size_t)((r - 12288) & 31) * DBR + ((r - 12288) >> 5)]; }
          RW[idx] = (bf16)f2bf(v); } }
    for (int idx = (vcu * NTHR + tid); idx < 2 * 16 * 64; idx += G * NTHR) { const int p = idx & 63, lg = idx >> 6;
        const float lam_re = a->in[I_S5ARE][idx], lam_im = a->in[I_S5AIM][idx]; const float dt = expf(a->in[I_S5LDT][lg]); const float mag = expf(lam_re * dt), ang = lam_im * dt;
        const float are = mag * cosf(ang), aim = mag * sinf(ang); const float inv = 1.f / (lam_re * lam_re + lam_im * lam_im);
        const float cre = ((are - 1.f) * lam_re + aim * lam_im) * inv, cim = (aim * lam_re - (are - 1.f) * lam_im) * inv;
        ((float*)(ws + WS_S5AP))[idx * 2] = are; ((float*)(ws + WS_S5AP))[idx * 2 + 1] = aim;
        const float* br = a->in[I_S5BRE] + (size_t)idx * 16; const float* bi = a->in[I_S5BIM] + (size_t)idx * 16; bf16* o = (bf16*)(ws + WS_S5BB) + ((size_t)lg * 128 + 2 * p) * 16;
        for (int c = 0; c < 16; ++c) { o[c] = (bf16)f2bf(cre * br[c] - cim * bi[c]); o[16 + c] = (bf16)f2bf(cre * bi[c] + cim * br[c]); } }
    { bf16* CM = (bf16*)(ws + WS_S5CM);
      for (int idx = (vcu * NTHR + tid); idx < 2 * 16 * 16 * 128; idx += G * NTHR) { const int k = idx & 127, lgc = idx >> 7;
          CM[idx] = (bf16)f2bf((k & 1) ? -a->in[I_S5CIM][(size_t)lgc * 64 + (k >> 1)] : a->in[I_S5CRE][(size_t)lgc * 64 + (k >> 1)]); } }
    for (int it = gw; it < 2 * 16; it += NGW) { const int l = it >> 4, r = it & 15;
        transpose_item(a->in[I_S5GLUW] + (size_t)l * DC * DC, DC, DC, 64 * (r >> 2), 64 * (r & 3), (bf16*)(ws + WS_GLUT) + (size_t)l * DC * DC, DC, scr, lane, RmId{}); }
    { bf16* MLW = (bf16*)(ws + WS_MLW);
      for (int idx = (vcu * NTHR + tid); idx < 2 * NH * 2 * 4096; idx += G * NTHR) { const int d = idx & 63, e = (idx >> 6) & 63, which = (idx >> 12) & 1, lh = idx >> 13;
          MLW[idx] = (bf16)f2bf(a->in[which ? I_WK : I_WQ][(size_t)lh * 4096 + d * 64 + e]); } }
    __syncthreads();
    if (vcu < 192) {
        const int q = vcu, l = q / 96, cb = (q >> 3) % 12, kc = q & 7;
        LAS float* cond = (LAS float*)lds;
        { const int b = tid >> 7, kk = tid & 127; const float cv = a->in[I_C][b * DM + kc * 128 + kk]; cond[tid] = cv / (1.f + __expf(-cv)); }
        __syncthreads();
        const int col = cb * 512 + tid; const float* wp = a->in[I_ADA_W] + ((size_t)l * DM + kc * 128) * 6144 + col;
        float acc0 = 0.f, acc1 = 0.f, acc2 = 0.f, acc3 = 0.f;
#pragma unroll 8
        for (int kk = 0; kk < 128; ++kk) { const float w = wp[(size_t)kk * 6144]; acc0 += cond[kk] * w; acc1 += cond[128 + kk] * w; acc2 += cond[256 + kk] * w; acc3 += cond[384 + kk] * w; }
        const float bias = (kc == 0) ? a->in[I_ADA_B][l * 6144 + col] : 0.f;
        float* MP = (float*)(ws + WS_MODP) + ((size_t)(kc * 2 + l) * 4) * 6144 + col;
        MP[0] = acc0 + bias; MP[6144] = acc1 + bias; MP[2 * 6144] = acc2 + bias; MP[3 * 6144] = acc3 + bias;
    }
}

__device__ __forceinline__ float modval(const unsigned char* ws, bool part, int l, int b, int idx) {
    if (!part) return ((const float*)(ws + WS_MODF))[(size_t)(l * 4 + b) * 6144 + idx];
    const float* mp = (const float*)(ws + WS_MODP) + (size_t)(l * 4 + b) * 6144 + idx; float s = 0.f;
#pragma unroll
    for (int kc = 0; kc < 8; ++kc) s += mp[(size_t)kc * 2 * 4 * 6144];
    return s;
}
template <int MODE, bool COMBINE>
__device__ __forceinline__ void phase_rownorm(KArgsP a, LAS unsigned char* lds, int tid, int lane, int wave, int G,
                                              const float* xsrc, float* xdst, const float* gvec, bool part, int l, int isc  , int lprev) {
    unsigned char* ws = a->ws;
    LAS float* sc = (LAS float*)lds; LAS float* sh = sc + 1024; LAS float* gt = sh + 1024;
    bf16* HN = (bf16*)(ws + WS_HN); const bf16* YM = (const bf16*)(ws + WS_YMOE); const float* TW = (const float*)(ws + WS_TOKW);
    for (int c = blockIdx.x; c < NTOK / 128; c += G) {
        const int b = c >> 6;
        __syncthreads();
        for (int j = tid; j < 1024; j += NTHR) {
            if (MODE == 0) { sc[j] = gvec[j] * (1.f + modval(ws, part, l, b, (isc + 1) * 1024 + j)); sh[j] = modval(ws, part, l, b, isc * 1024 + j); }
            else { sc[j] = gvec[j]; sh[j] = 0.f; }
            if (COMBINE) gt[j] = 1.f + modval(ws, false, lprev, b, 5 * 1024 + j);
        }
        __syncthreads();
        f32x4 vn[4]; v2u yn0[4], yn1[4]; float wn0 = 0.f, wn1 = 0.f;
        { const int row = c * 128 + wave * 16; const GAS f32x4* xr = (const GAS f32x4*)(xsrc + (size_t)row * DM) + lane;
#pragma unroll
          for (int j = 0; j < 4; ++j) vn[j] = xr[64 * j];
          if (COMBINE) { wn0 = TW[2 * row]; wn1 = TW[2 * row + 1]; const GAS v2u* y0 = (const GAS v2u*)(YM + (size_t)(2 * row) * DM) + lane; const GAS v2u* y1 = (const GAS v2u*)(YM + (size_t)(2 * row + 1) * DM) + lane;
#pragma unroll
              for (int j = 0; j < 4; ++j) { yn0[j] = y0[64 * j]; yn1[j] = y1[64 * j]; } } }
        for (int i = 0; i < 16; ++i) {
            const int row = c * 128 + wave * 16 + i;
            f32x4 v[4]; v2u q0[4], q1[4]; const float w0 = wn0, w1 = wn1;
#pragma unroll
            for (int j = 0; j < 4; ++j) { v[j] = vn[j]; q0[j] = yn0[j]; q1[j] = yn1[j]; }
            if (i + 1 < 16) { const int rn = row + 1; const GAS f32x4* xr = (const GAS f32x4*)(xsrc + (size_t)rn * DM) + lane;
#pragma unroll
                for (int j = 0; j < 4; ++j) vn[j] = xr[64 * j];
                if (COMBINE) { wn0 = TW[2 * rn]; wn1 = TW[2 * rn + 1]; const GAS v2u* y0 = (const GAS v2u*)(YM + (size_t)(2 * rn) * DM) + lane; const GAS v2u* y1 = (const GAS v2u*)(YM + (size_t)(2 * rn + 1) * DM) + lane;
#pragma unroll
                    for (int j = 0; j < 4; ++j) { yn0[j] = y0[64 * j]; yn1[j] = y1[64 * j]; } } }
            if (COMBINE) {
#pragma unroll
                for (int j = 0; j < 4; ++j) { const v2u p0 = q0[j], p1 = q1[j]; const f32x4 g4 = *(const LAS f32x4*)(gt + lane * 4 + 256 * j);
                    f32x4 m; m.x = w0 * bflo(p0.x) + w1 * bflo(p1.x); m.y = w0 * bfhi(p0.x) + w1 * bfhi(p1.x); m.z = w0 * bflo(p0.y) + w1 * bflo(p1.y); m.w = w0 * bfhi(p0.y) + w1 * bfhi(p1.y);
                    v[j] = v[j] + g4 * m; }
                if (MODE == 0) { GAS f32x4* xo = (GAS f32x4*)(xdst + (size_t)row * DM) + lane;
#pragma unroll
                    for (int j = 0; j < 4; ++j) xo[64 * j] = v[j]; }
            }
            float ss = 0.f;
#pragma unroll
            for (int j = 0; j < 4; ++j) ss += (v[j].x * v[j].x + v[j].y * v[j].y) + (v[j].z * v[j].z + v[j].w * v[j].w);
            const float rstd = rsqrtf(wave_sum(ss) * (1.f / DM) + NORM_EPS);
            if (MODE == 0) {
                GAS v2u* o = (GAS v2u*)(HN + (size_t)row * DM) + lane;
#pragma unroll
                for (int j = 0; j < 4; ++j) { const f32x4 s4 = *(const LAS f32x4*)(sc + lane * 4 + 256 * j), h4 = *(const LAS f32x4*)(sh + lane * 4 + 256 * j); const f32x4 h = v[j] * rstd * s4 + h4;
                    v2u w; w.x = pk2(h.x, h.y); w.y = pk2(h.z, h.w); o[64 * j] = w; }
            } else {
                GAS f32x4* o = (GAS f32x4*)(xdst + (size_t)row * DM) + lane;
#pragma unroll
                for (int j = 0; j < 4; ++j) { const f32x4 s4 = *(const LAS f32x4*)(sc + lane * 4 + 256 * j); o[64 * j] = v[j] * rstd * s4; }
            }
        }
    }
}
__device__ __forceinline__ void mod_finalize(unsigned char* ws, int tid, int G) {
    float* MF = (float*)(ws + WS_MODF);
    for (int idx = blockIdx.x * NTHR + tid; idx < 2 * 4 * 6144; idx += G * NTHR) { const float* mp = (const float*)(ws + WS_MODP) + idx; float s = 0.f;
#pragma unroll
        for (int kc = 0; kc < 8; ++kc) s += mp[(size_t)kc * 2 * 4 * 6144];
        MF[idx] = s; }
}

typedef float f32x4m __attribute__((ext_vector_type(4)));
__device__ __forceinline__ void phase_router(KArgsP a, LAS unsigned char* lds, int tid, int lane, int wave, int G, int l) {
    unsigned char* ws = a->ws;
    LAS float* sc = (LAS float*)lds; LAS float* sh = sc + 1024; LAS float* rstd_s = sh + 1024  ; LAS float* cvec = rstd_s + 128  ; LAS float* cpart = cvec + 64  ;
    LAS float* lg = cpart + 8 * 48  ; LAS int* hist = (LAS int*)(lg + 8 * 16 * 48)  ; LAS int* basev = hist + 32; LAS int* asg_e = basev + 32  ; LAS int* asg_lp = asg_e + 256;
    bf16* HN = (bf16*)(ws + WS_HN); const float* x = a->out; const float* RTW = (const float*)(ws + WS_RTW) + (size_t)l * 1024 * 48;
    int* TOKE = (int*)(ws + WS_TOKE); float* TOKW = (float*)(ws + WS_TOKW); int* LIST = (int*)(ws + WS_LIST); unsigned* CNT = (unsigned*)(ws + WS_CTL) + CW_CNT + l * 32;
    const float* gvec = a->in[I_NORM_FFN] + l * DM;
    for (int c = blockIdx.x; c < NTOK / 128; c += G) {
        const int b = c >> 6;
        __syncthreads();
        for (int j = tid; j < 1024; j += NTHR) { sc[j] = gvec[j] * (1.f + modval(ws, false, l, b, 4 * 1024 + j)); sh[j] = modval(ws, false, l, b, 3 * 1024 + j); }
        if (tid < 32) hist[tid] = 0;
        __syncthreads();
        if (tid < 384) { const int j = tid % 48, part = tid / 48; float s = 0.f;
            for (int k = part * 128; k < part * 128 + 128; ++k) s += sh[k] * RTW[(size_t)k * 48 + j];
            cpart[part * 48 + j] = s; }
        { f32x4 vn[4];
          { const GAS f32x4* xr = (const GAS f32x4*)(x + (size_t)(c * 128 + wave * 16) * DM) + lane;
#pragma unroll
            for (int j = 0; j < 4; ++j) vn[j] = xr[64 * j]; }
          for (int i = 0; i < 16; ++i) {
            const int row = c * 128 + wave * 16 + i;
            f32x4 v[4]; float ss = 0.f;
#pragma unroll
            for (int j = 0; j < 4; ++j) { v[j] = vn[j]; ss += (v[j].x * v[j].x + v[j].y * v[j].y) + (v[j].z * v[j].z + v[j].w * v[j].w); }
            if (i + 1 < 16) { const GAS f32x4* xr = (const GAS f32x4*)(x + (size_t)(row + 1) * DM) + lane;
#pragma unroll
                for (int j = 0; j < 4; ++j) vn[j] = xr[64 * j]; }
            const float rstd = rsqrtf(wave_sum(ss) * (1.f / DM) + NORM_EPS);
            if (lane == 0) rstd_s[wave * 16 + i] = rstd;
            GAS v2u* o = (GAS v2u*)(HN + (size_t)row * DM) + lane;
#pragma unroll
            for (int j = 0; j < 4; ++j) { const f32x4 s4 = *(const LAS f32x4*)(sc + lane * 4 + 256 * j), h4 = *(const LAS f32x4*)(sh + lane * 4 + 256 * j); const f32x4 h = v[j] * rstd * s4 + h4;
                v2u w; w.x = pk2(h.x, h.y); w.y = pk2(h.z, h.w); o[64 * j] = w; }
          } }
        __syncthreads();
        if (tid < 48) { float s = 0.f;
#pragma unroll
            for (int p = 0; p < 8; ++p) s += cpart[p * 48 + tid];
            s += tid < 4 ? a->in[I_MBRG][l * 4 + tid] : (tid < 36 ? a->in[I_MBRE][l * 32 + tid - 4] : 0.f); cvec[tid] = s; }
        {
            const int i16 = lane & 15, kq = lane >> 4, r0 = c * 128 + wave * 16;
            f32x4m acc0 = {0.f, 0.f, 0.f, 0.f}, acc1 = acc0, acc2 = acc0;
            const float* xrow = x + (size_t)(r0 + i16) * DM + 4 * kq;
#pragma unroll 4
            for (int k0 = 0; k0 < DM; k0 += 16) {
                const f32x4 xv = *(const GAS f32x4*)(xrow + k0); const f32x4 sv = *(const LAS f32x4*)(sc + k0 + 4 * kq);
                const float* wp = RTW + (size_t)(k0 + 4 * kq) * 48 + i16;
#pragma unroll
                for (int j = 0; j < 4; ++j) { const float av = xv[j] * sv[j];
                    acc0 = __builtin_amdgcn_mfma_f32_16x16x4f32(av, wp[j * 48], acc0, 0, 0, 0);
                    acc1 = __builtin_amdgcn_mfma_f32_16x16x4f32(av, wp[j * 48 + 16], acc1, 0, 0, 0);
                    acc2 = __builtin_amdgcn_mfma_f32_16x16x4f32(av, wp[j * 48 + 32], acc2, 0, 0, 0); }
            }
            __syncthreads();
            LAS float* lw = lg + wave * 16 * 48;
#pragma unroll
            for (int r = 0; r < 4; ++r) { const int rr = 4 * kq + r; const float rs = rstd_s[wave * 16 + rr];
                lw[rr * 48 + i16] = acc0[r] * rs + cvec[i16]; lw[rr * 48 + 16 + i16] = acc1[r] * rs + cvec[16 + i16]; lw[rr * 48 + 32 + i16] = acc2[r] * rs + cvec[32 + i16]; }
            LDS_WAIT(); asm volatile("" ::: "memory");
            if (lane < 16) {
                const LAS float* lr = lw + lane * 48; const int row = r0 + lane;
                float g0 = lr[0], g1 = lr[1], g2 = lr[2], g3 = lr[3]; const float gm = fmaxf(fmaxf(g0, g1), fmaxf(g2, g3));
                float p0 = __expf(g0 - gm), p1 = __expf(g1 - gm), p2 = __expf(g2 - gm), p3 = __expf(g3 - gm); const float inv = 1.f / (p0 + p1 + p2 + p3);
                p0 *= inv; p1 *= inv; p2 *= inv; p3 *= inv;
                int gi = 0; float gp = p0; if (p1 > gp) { gp = p1; gi = 1; } if (p2 > gp) { gp = p2; gi = 2; } if (p3 > gp) { gp = p3; gi = 3; }
                float ev0 = -3.4e38f, ev1 = -3.4e38f; int e0 = 0, e1 = 0;
#pragma unroll
                for (int j = 0; j < 8; ++j) { const float s = lr[4 + gi * 8 + j]; if (s > ev0) { ev1 = ev0; e1 = e0; ev0 = s; e0 = j; } else if (s > ev1) { ev1 = s; e1 = j; } }
                const float q = __expf(ev1 - ev0), w0 = gp / (1.f + q), w1 = gp * q / (1.f + q);
                e0 += gi * 8; e1 += gi * 8;
                TOKE[2 * row] = e0; TOKE[2 * row + 1] = e1; TOKW[2 * row] = w0; TOKW[2 * row + 1] = w1;
                const int a0 = 2 * (wave * 16 + lane);
                asg_e[a0] = e0; asg_e[a0 + 1] = e1; asg_lp[a0] = atomicAdd((int*)&hist[e0], 1); asg_lp[a0 + 1] = atomicAdd((int*)&hist[e1], 1);
            }
        }
        __syncthreads();
        if (tid < 32) { const int h = hist[tid]; basev[tid] = h ? (int)atomicAdd(CNT + tid, (unsigned)h) : 0; }
        __syncthreads();
        if (tid < 256) { const int e = asg_e[tid]; LIST[(size_t)e * 65536 + basev[e] + asg_lp[tid]] = (c * 128) * 2 + tid; }
    }
}
__device__ __forceinline__ void build_ptab(const unsigned* CNT, LAS int* ptab, LAS int* pst, LAS int* cnt, int tid) {
    __syncthreads();
    if (tid == 0) { int np = 0;
        for (int e = 0; e < NEXP; ++e) { const int ce = (int)__hip_atomic_load(CNT + e, RLX_AGENT); cnt[e] = ce; pst[e] = np * 256; const int pe = (ce + 255) >> 8;
            for (int p = 0; p < pe; ++p) ptab[1 + np + p] = e;
            np += pe; }
        ptab[0] = np; }
    __syncthreads();
}
__device__ __forceinline__ void phase_gather(KArgsP a, LAS unsigned char* lds, int tid, int lane, int wave, int vcu, int G, int l) {
    unsigned char* ws = a->ws;
    LAS int* ptab = (LAS int*)lds; LAS int* pst = ptab + 512; LAS int* cnt = pst + 32;
    build_ptab((const unsigned*)(ws + WS_CTL) + CW_CNT + l * 32, ptab, pst, cnt, tid);
    const bf16* HN = (const bf16*)(ws + WS_HN); bf16* XG = (bf16*)(ws + WS_XG); int* ROWMAP = (int*)(ws + WS_ROWMAP); const int* LIST = (const int*)(ws + WS_LIST);
    const int nrows = ptab[0] * 256;
    for (int row0 = (vcu * NWAVES + wave) * 8; row0 < nrows; row0 += G * NWAVES * 8) {
        int tok2[8]; v4u p0[8], p1[8];
#pragma unroll
        for (int j = 0; j < 8; ++j) { const int row = row0 + j, e = ptab[1 + (row >> 8)], pos = row - pst[e]; tok2[j] = (pos < cnt[e]) ? LIST[(size_t)e * 65536 + pos] : -1; }
#pragma unroll
        for (int j = 0; j < 8; ++j) { if (tok2[j] >= 0) { const GAS v4u* s = (const GAS v4u*)(HN + (size_t)(tok2[j] >> 1) * DM) + lane; p0[j] = s[0]; p1[j] = s[64]; } else { p0[j] = (v4u){0u, 0u, 0u, 0u}; p1[j] = p0[j]; } }
#pragma unroll
        for (int j = 0; j < 8; ++j) { GAS v4u* d = (GAS v4u*)(XG + (size_t)(row0 + j) * DM) + lane; d[0] = p0[j]; d[64] = p1[j]; if (lane == 0) ROWMAP[row0 + j] = tok2[j]; }
    }
}

__device__ __forceinline__ void phase_rowmap(KArgsP a, LAS unsigned char* lds, int tid, int vcu, int G, int l) {
    unsigned char* ws = a->ws;
    LAS int* ptab = (LAS int*)lds; LAS int* pst = ptab + 512; LAS int* cnt = pst + 32;
    build_ptab((const unsigned*)(ws + WS_CTL) + CW_CNT + l * 32, ptab, pst, cnt, tid);
    int* ROWMAP = (int*)(ws + WS_ROWMAP); const int* LIST = (const int*)(ws + WS_LIST);
    const int nrows = ptab[0] * 256;
    for (int row = vcu * NTHR + tid; row < nrows; row += G * NTHR) { const int e = ptab[1 + (row >> 8)], pos = row - pst[e]; ROWMAP[row] = (pos < cnt[e]) ? LIST[(size_t)e * 65536 + pos] : -1; }
}

typedef short bf16x8 __attribute__((ext_vector_type(8)));
constexpr int MT = 72;
constexpr int ML_XP = 0;
constexpr int ML_CX = 17152;
constexpr int ML_WQ = ML_CX + 9216, ML_WK = ML_WQ + 9216;
constexpr int ML_Q = ML_WK + 9216, ML_K = ML_Q + 9216;
constexpr int ML_S = ML_K + 9216;
constexpr int ML_VT = ML_S + 9216;
constexpr int ML_CT = ML_VT + 11520;
constexpr int ML_H = ML_CT + 11520;
constexpr int ML_SM = ML_H + 16640;
static_assert(ML_SM + 2048 <= RING_BYTES, "mLSTM LDS map");
__device__ __forceinline__ float logsigmoidf_(float x) { return fminf(x, 0.f) - log1pf(__expf(-fabsf(x))); }
__device__ __forceinline__ void mma64(const LAS bf16* A, int arow0, const LAS bf16* Bt, int brow0, int lane, f32x4& acc) {
    const LAS bf16* ap = A + (arow0 + (lane & 15)) * MT + 8 * (lane >> 4); const LAS bf16* bp = Bt + (brow0 + (lane & 15)) * MT + 8 * (lane >> 4);
    const bf16x8 a0 = *(const LAS bf16x8*)ap, a1 = *(const LAS bf16x8*)(ap + 32), b0 = *(const LAS bf16x8*)bp, b1 = *(const LAS bf16x8*)(bp + 32);
    acc = __builtin_amdgcn_mfma_f32_16x16x32_bf16(a0, b0, acc, 0, 0, 0); acc = __builtin_amdgcn_mfma_f32_16x16x32_bf16(a1, b1, acc, 0, 0, 0);
}
__device__ __forceinline__ void ml_front(KArgsP a, LAS unsigned char* lds, int tid, int l, int b, int c, int h, bool want_q) {
    const bf16* PROJ = (const bf16*)(a->ws + WS_PROJ); const size_t row0 = (size_t)b * SEQ + c * 64;
    LAS float* xp = (LAS float*)(lds + ML_XP);
    for (int idx = tid; idx < 67 * 8; idx += NTHR) { const int r = idx >> 3, c8 = idx & 7, tr = c * 64 + r - 3; LAS float* d = xp + r * 64 + c8 * 8;
        if (tr >= 0) { const v4u p = *(const GAS v4u*)(PROJ + ((size_t)b * SEQ + tr) * NPROJ + PC_QK + h * 64 + c8 * 8);
            *(LAS f32x4*)d = (f32x4){bflo(p.x), bfhi(p.x), bflo(p.y), bfhi(p.y)}; *(LAS f32x4*)(d + 4) = (f32x4){bflo(p.z), bfhi(p.z), bflo(p.w), bfhi(p.w)}; }
        else { *(LAS f32x4*)d = (f32x4){0.f, 0.f, 0.f, 0.f}; *(LAS f32x4*)(d + 4) = (f32x4){0.f, 0.f, 0.f, 0.f}; } }
    {
        const int t = tid >> 3, vg = tid & 7; LAS bf16* VT = (LAS bf16*)(lds + ML_VT);
        const v4u p = *(const GAS v4u*)(PROJ + (row0 + t) * NPROJ + PC_V + h * 64 + vg * 8);
        const unsigned w[4] = {p.x, p.y, p.z, p.w};
#pragma unroll
        for (int j = 0; j < 4; ++j) { VT[(vg * 8 + 2 * j) * MT + t] = (bf16)(w[j] & 0xffffu); VT[(vg * 8 + 2 * j + 1) * MT + t] = (bf16)(w[j] >> 16); }
        for (int idx = tid; idx < 16 * 64; idx += NTHR) VT[(64 + (idx >> 6)) * MT + (idx & 63)] = (idx < 64) ? (bf16)0x3F80 : (bf16)0;
        const bf16* WT = (const bf16*)(a->ws + WS_MLW) + (size_t)((l * NH + h) * 2) * 4096;
        const int e = tid >> 3, d8 = tid & 7;
        if (want_q) *(LAS v4u*)(lds + ML_WQ + (e * MT + d8 * 8) * 2) = *(const GAS v4u*)(WT + e * 64 + d8 * 8);
        *(LAS v4u*)(lds + ML_WK + (e * MT + d8 * 8) * 2) = *(const GAS v4u*)(WT + 4096 + e * 64 + d8 * 8);
    }
    __syncthreads();
    const float* cw = a->in[I_CONV_W] + (size_t)l * 4 * DA + h * 64; const float* cb = a->in[I_CONV_B] + (size_t)l * DA + h * 64;
    {
        const int t = tid >> 3, c8 = (tid & 7) * 8; float s[8];
#pragma unroll
        for (int j = 0; j < 8; ++j) s[j] = cb[c8 + j];
#pragma unroll
        for (int q = 0; q < 4; ++q) { const f32x4 x0 = *(const LAS f32x4*)(xp + (t + q) * 64 + c8), x1 = *(const LAS f32x4*)(xp + (t + q) * 64 + c8 + 4); const float* w = cw + q * DA + c8;
            s[0] += x0.x * w[0]; s[1] += x0.y * w[1]; s[2] += x0.z * w[2]; s[3] += x0.w * w[3]; s[4] += x1.x * w[4]; s[5] += x1.y * w[5]; s[6] += x1.z * w[6]; s[7] += x1.w * w[7]; }
#pragma unroll
        for (int j = 0; j < 8; ++j) s[j] = s[j] / (1.f + __expf(-s[j]));
        v4u o; o.x = pk2(s[0], s[1]); o.y = pk2(s[2], s[3]); o.z = pk2(s[4], s[5]); o.w = pk2(s[6], s[7]);
        *(LAS v4u*)(lds + ML_CX + (t * MT + c8) * 2) = o;
    }
}
__device__ __forceinline__ void phase_m1(KArgsP a, LAS unsigned char* lds, int tid, int lane, int wave, int vcu, int G, int l) {
    unsigned char* ws = a->ws; const float* GT = (const float*)(ws + WS_GATES);
    float* CLOC = (float*)(ws + WS_CLOC); float* MLG = (float*)(ws + WS_MSC); float* MLM = MLG + 4096;
    LAS float* sm = (LAS float*)(lds + ML_SM);
    for (int u = vcu; u < NUNIT_M; u += G) {
        const int h = u % NH, c = (u / NH) % NCH, b = u / (NH * NCH); const size_t row0 = (size_t)b * SEQ + c * 64;
        __syncthreads();
        ml_front(a, lds, tid, l, b, c, h, false);
        if (wave == 0) {
            const float ig = GT[(row0 + lane) * 16 + h] + a->in[I_BI][l * NH + h];
            const float fl = logsigmoidf_(GT[(row0 + lane) * 16 + 6 + h] + a->in[I_BF][l * NH + h]);
            float bc = fl;
#pragma unroll
            for (int o = 1; o < 64; o <<= 1) { const float t = __shfl_up(bc, o); if (lane >= o) bc += t; }
            const float gtot = __shfl(bc, 63); const float lw = gtot - bc + ig; const float ml = wave_max(lw);
            sm[lane] = __expf(lw - ml);
            if (lane == 0) { MLG[u] = gtot; MLM[u] = ml; }
        }
        __syncthreads();
        {
            const int rt = wave >> 1; LAS bf16* KT = (LAS bf16*)(lds + ML_K);
#pragma unroll
            for (int q = 0; q < 2; ++q) { const int ct = 2 * (wave & 1) + q; f32x4 acc = {0.f, 0.f, 0.f, 0.f};
                mma64((const LAS bf16*)(lds + ML_CX), 16 * rt, (const LAS bf16*)(lds + ML_WK), 16 * ct, lane, acc);
                const int t0 = 16 * rt + 4 * (lane >> 4), e = 16 * ct + (lane & 15);
                const float w0 = sm[t0] * 0.125f, w1 = sm[t0 + 1] * 0.125f, w2 = sm[t0 + 2] * 0.125f, w3 = sm[t0 + 3] * 0.125f;
                v2u o; o.x = pk2(acc[0] * w0, acc[1] * w1); o.y = pk2(acc[2] * w2, acc[3] * w3);
                *(LAS v2u*)(KT + e * MT + t0) = o; }
        }
        __syncthreads();
        {
            const int ct = wave & 3, r_lo = wave < 4 ? 0 : 3, r_hi = wave < 4 ? 3 : 5; float* cl = CLOC + (size_t)u * CL_STRIDE;
            for (int rt = r_lo; rt < r_hi; ++rt) { f32x4 acc = {0.f, 0.f, 0.f, 0.f};
                mma64((const LAS bf16*)(lds + ML_VT), 16 * rt, (const LAS bf16*)(lds + ML_K), 16 * ct, lane, acc);
                const int v0 = 16 * rt + 4 * (lane >> 4), e = 16 * ct + (lane & 15);
                if (rt < 4) {
#pragma unroll
                    for (int r = 0; r < 4; ++r) cl[(v0 + r) * 64 + e] = acc[r];
                } else if ((lane >> 4) == 0) cl[4096 + e] = acc[0]; }
        }
    }
}
__device__ __forceinline__ void phase_m2(unsigned char* ws, int tid, int wg, int nwg) {
    float* CLOC = (float*)(ws + WS_CLOC); const float* MLG = (const float*)(ws + WS_MSC); const float* MLM = MLG + 4096; float* MST = (float*)(ws + WS_MSC) + 8192;
    for (int idx = wg * NTHR + tid; idx < NB * NH * CL_STRIDE; idx += nwg * NTHR) {
        const int e = idx % CL_STRIDE, bh = idx / CL_STRIDE, b = bh / NH, h = bh % NH;
        float m = 0.f, cs = 0.f;
        for (int c0 = 0; c0 < NCH; c0 += 8) {
            float cl[8], g[8], ml[8];
#pragma unroll
            for (int j = 0; j < 8; ++j) { const int u = (b * NCH + c0 + j) * NH + h; cl[j] = CLOC[(size_t)u * CL_STRIDE + e]; g[j] = MLG[u]; ml[j] = MLM[u]; }
#pragma unroll
            for (int j = 0; j < 8; ++j) { const int u = (b * NCH + c0 + j) * NH + h;
                CLOC[(size_t)u * CL_STRIDE + e] = cs; if (e == 0) MST[u] = m;
                const float mn = fmaxf(g[j] + m, ml[j]); const float ao = __expf(g[j] + m - mn), al = __expf(ml[j] - mn);
                cs = ao * cs + al * cl[j]; m = mn; }
        }
    }
}
__device__ __forceinline__ void phase_m3(KArgsP a, LAS unsigned char* lds, int tid, int lane, int wave, int vcu, int G, int l) {
    unsigned char* ws = a->ws; const bf16* PROJ = (const bf16*)(ws + WS_PROJ); const float* GT = (const float*)(ws + WS_GATES);
    const float* CLOC = (const float*)(ws + WS_CLOC); const float* MST = (const float*)(ws + WS_MSC) + 8192; bf16* YC = (bf16*)(ws + WS_YC);
    LAS float* sm = (LAS float*)(lds + ML_SM); LAS float* hb = (LAS float*)(lds + ML_H);
    for (int u = vcu; u < NUNIT_M; u += G) {
        const int h = u % NH, c = (u / NH) % NCH, b = u / (NH * NCH); const size_t row0 = (size_t)b * SEQ + c * 64;
        __syncthreads();
        ml_front(a, lds, tid, l, b, c, h, true);
        {
            const float* cl = CLOC + (size_t)u * CL_STRIDE; LAS bf16* CT = (LAS bf16*)(lds + ML_CT);
            for (int idx = tid; idx < 65 * 16; idx += NTHR) { const int r = idx >> 4, c4 = idx & 15; const f32x4 v = *(const GAS f32x4*)(cl + r * 64 + c4 * 4);
                v2u o; o.x = pk2(v.x, v.y); o.y = pk2(v.z, v.w); *(LAS v2u*)(CT + r * MT + c4 * 4) = o; }
            for (int idx = tid; idx < 15 * 64; idx += NTHR) CT[(65 + (idx >> 6)) * MT + (idx & 63)] = 0;
        }
        if (wave == 0) {
            const float ig = GT[(row0 + lane) * 16 + h] + a->in[I_BI][l * NH + h];
            const float fl = logsigmoidf_(GT[(row0 + lane) * 16 + 6 + h] + a->in[I_BF][l * NH + h]);
            float bc = fl;
#pragma unroll
            for (int o = 1; o < 64; o <<= 1) { const float t = __shfl_up(bc, o); if (lane >= o) bc += t; }
            float pm = ig - bc;
#pragma unroll
            for (int o = 1; o < 64; o <<= 1) { const float t = __shfl_up(pm, o); if (lane >= o) pm = fmaxf(pm, t); }
            const float mst = MST[u]; const float inter = bc + mst, mt = fmaxf(inter, bc + pm);
            sm[lane] = ig - bc; sm[64 + lane] = bc - mt; sm[128 + lane] = __expf(inter - mt); sm[192 + lane] = __expf(-mt);
        }
        __syncthreads();
        {
            const int rt = wave >> 1; LAS bf16* Qs = (LAS bf16*)(lds + ML_Q); LAS bf16* Ks = (LAS bf16*)(lds + ML_K);
#pragma unroll
            for (int q = 0; q < 2; ++q) { const int ct = 2 * (wave & 1) + q; f32x4 aq = {0.f, 0.f, 0.f, 0.f}, ak = {0.f, 0.f, 0.f, 0.f};
                mma64((const LAS bf16*)(lds + ML_CX), 16 * rt, (const LAS bf16*)(lds + ML_WQ), 16 * ct, lane, aq);
                mma64((const LAS bf16*)(lds + ML_CX), 16 * rt, (const LAS bf16*)(lds + ML_WK), 16 * ct, lane, ak);
                const int t0 = 16 * rt + 4 * (lane >> 4), e = 16 * ct + (lane & 15);
#pragma unroll
                for (int r = 0; r < 4; ++r) { Qs[(t0 + r) * MT + e] = (bf16)f2bf(aq[r]); Ks[(t0 + r) * MT + e] = (bf16)f2bf(ak[r] * 0.125f); } }
        }
        __syncthreads();
        {
            const int rt = wave >> 1; LAS bf16* Ss = (LAS bf16*)(lds + ML_S);
#pragma unroll
            for (int q = 0; q < 2; ++q) { const int ct = 2 * (wave & 1) + q; f32x4 acc = {0.f, 0.f, 0.f, 0.f};
                if (ct <= rt) mma64((const LAS bf16*)(lds + ML_Q), 16 * rt, (const LAS bf16*)(lds + ML_K), 16 * ct, lane, acc);
                const int t0 = 16 * rt + 4 * (lane >> 4), s = 16 * ct + (lane & 15); const float qs = sm[s];
#pragma unroll
                for (int r = 0; r < 4; ++r) { const int t = t0 + r; Ss[t * MT + s] = (bf16)f2bf((s <= t) ? acc[r] * __expf(sm[64 + t] + qs) : 0.f); } }
        }
        __syncthreads();
        {
            const int rt = wave >> 1, nt = (wave & 1) ? 2 : 3;
            for (int q = 0; q < nt; ++q) { const int ct = (wave & 1) ? 2 + q : (q < 2 ? q : 4); f32x4 aA = {0.f, 0.f, 0.f, 0.f}, aB = {0.f, 0.f, 0.f, 0.f};
                mma64((const LAS bf16*)(lds + ML_Q), 16 * rt, (const LAS bf16*)(lds + ML_CT), 16 * ct, lane, aA);
                mma64((const LAS bf16*)(lds + ML_S), 16 * rt, (const LAS bf16*)(lds + ML_VT), 16 * ct, lane, aB);
                const int t0 = 16 * rt + 4 * (lane >> 4), v = 16 * ct + (lane & 15);
#pragma unroll
                for (int r = 0; r < 4; ++r) { const int t = t0 + r; const float x = sm[128 + t] * aA[r] + aB[r];
                    if (ct < 4) hb[t * 65 + v] = x; else if ((lane & 15) == 0) sm[256 + t] = x; } }
        }
        __syncthreads();
        {
            const int t = tid >> 3, vg = tid & 7; float acc[8];
            const float dn = 1.f / fmaxf(fabsf(sm[256 + t]), sm[192 + t]);
            float s1 = 0.f;
#pragma unroll
            for (int j = 0; j < 8; ++j) { acc[j] = hb[t * 65 + vg * 8 + j] * dn; s1 += acc[j]; }
            s1 += __shfl_xor(s1, 1); s1 += __shfl_xor(s1, 2); s1 += __shfl_xor(s1, 4);
            const float mu = s1 * (1.f / 64.f); float s2 = 0.f;
#pragma unroll
            for (int j = 0; j < 8; ++j) { acc[j] -= mu; s2 += acc[j] * acc[j]; }
            s2 += __shfl_xor(s2, 1); s2 += __shfl_xor(s2, 2); s2 += __shfl_xor(s2, 4);
            const float rs = rsqrtf(s2 * (1.f / 64.f) + HEAD_NORM_EPS);
            const float* nw = a->in[I_MNORM_W] + (size_t)l * DA + h * 64 + vg * 8;
            const v4u ov = *(const GAS v4u*)(PROJ + (row0 + t) * NPROJ + PC_O + h * 64 + vg * 8);
            const float o[8] = {bflo(ov.x), bfhi(ov.x), bflo(ov.y), bfhi(ov.y), bflo(ov.z), bfhi(ov.z), bflo(ov.w), bfhi(ov.w)};
            float r[8];
#pragma unroll
            for (int j = 0; j < 8; ++j) r[j] = acc[j] * rs * nw[j] * sigmoidf_(o[j]);
            v4u w; w.x = pk2(r[0], r[1]); w.y = pk2(r[2], r[3]); w.z = pk2(r[4], r[5]); w.w = pk2(r[6], r[7]);
            *(GAS v4u*)(YC + (row0 + t) * DM + h * 64 + vg * 8) = w;
        }
    }
}

constexpr int S5_UT = 264, S5_XT = 2056;
constexpr int S5_U = 0, S5_Z = 33792, S5_X = 67584;
static_assert(S5_X + 16 * S5_XT * 2 <= MISC_OFF, "S5 LDS map");
struct S5A { float are, aim, cre, cim; };
__device__ __forceinline__ S5A s5_a(KArgsP a, int l, int g, int p) {
    const float lam_re = a->in[I_S5ARE][(size_t)(l * 16 + g) * 64 + p], lam_im = a->in[I_S5AIM][(size_t)(l * 16 + g) * 64 + p];
    const float dt = expf(a->in[I_S5LDT][l * 16 + g]); const float mag = expf(lam_re * dt), ang = lam_im * dt;
    S5A r; r.are = mag * cosf(ang); r.aim = mag * sinf(ang);
    const float inv = 1.f / (lam_re * lam_re + lam_im * lam_im);
    r.cre = ((r.are - 1.f) * lam_re + r.aim * lam_im) * inv; r.cim = (r.aim * lam_re - (r.are - 1.f) * lam_im) * inv; return r;
}
__device__ __forceinline__ bf16x8 pack8(const float* v) { v4u o; o.x = pk2(v[0], v[1]); o.y = pk2(v[2], v[3]); o.z = pk2(v[4], v[5]); o.w = pk2(v[6], v[7]); return __builtin_bit_cast(bf16x8, o); }
__device__ __forceinline__ void s5_bfrag(const unsigned char* ws, int l, int g, int lane, bf16x8 (&bf)[8]) {
    const bf16* BB = (const bf16*)(ws + WS_S5BB) + (size_t)(l * 16 + g) * 128 * 16;
#pragma unroll
    for (int j = 0; j < 8; ++j) { v4u o = {0u, 0u, 0u, 0u}; if ((lane >> 4) < 2) o = *(const GAS v4u*)(BB + (16 * j + (lane & 15)) * 16 + 8 * (lane >> 4)); bf[j] = __builtin_bit_cast(bf16x8, o); }
}
__device__ __forceinline__ f32x2 s5_ap(const unsigned char* ws, int l, int g, int p) { return *(const GAS f32x2*)((const float*)(ws + WS_S5AP) + ((size_t)(l * 16 + g) * 64 + p) * 2); }
__device__ __forceinline__ void s5_load_u(const unsigned char* ws, LAS unsigned char* lds, int tid, size_t row0) {
    const bf16* PROJ = (const bf16*)(ws + WS_PROJ);
    for (int idx = tid; idx < 64 * 32; idx += NTHR) { const int t = idx >> 5, c8 = idx & 31;
        *(LAS v4u*)(lds + S5_U + (t * S5_UT + c8 * 8) * 2) = *(const GAS v4u*)(PROJ + (row0 + t) * NPROJ + PC_S5 + c8 * 8); }
}
__device__ __forceinline__ void s5_block(LAS unsigned char* lds, int lane, int tb, int g, const bf16x8 (&bf)[8], float are, float aim, float& xr, float& xi) {
    const int kq = lane >> 4; bf16x8 uf = {0, 0, 0, 0, 0, 0, 0, 0};
    if (kq < 2) uf = *(const LAS bf16x8*)(lds + S5_U + ((16 * tb + (lane & 15)) * S5_UT + g * 16 + 8 * kq) * 2);
    LAS bf16* X = (LAS bf16*)(lds + S5_X);
#pragma unroll
    for (int j = 0; j < 8; ++j) { f32x4 acc = {0.f, 0.f, 0.f, 0.f}; acc = __builtin_amdgcn_mfma_f32_16x16x32_bf16(bf[j], uf, acc, 0, 0, 0);
        v2u o; o.x = pk2(acc[0], acc[1]); o.y = pk2(acc[2], acc[3]); *(LAS v2u*)(X + (lane & 15) * S5_XT + g * 128 + 16 * j + 4 * kq) = o; }
    LDS_WAIT(); asm volatile("" ::: "memory");
    LAS unsigned* xw = (LAS unsigned*)(lds + S5_X) + (g * 128 + 2 * lane) / 2;
    unsigned wv[16];
#pragma unroll
    for (int t = 0; t < 16; ++t) wv[t] = xw[t * (S5_XT / 2)];
#pragma unroll
    for (int t = 0; t < 16; ++t) { const float br = bflo(wv[t]), bi = bfhi(wv[t]);
        const float nr = are * xr - aim * xi + br, ni = are * xi + aim * xr + bi; xr = nr; xi = ni;
        wv[t] = pk2(xr, xi); }
#pragma unroll
    for (int t = 0; t < 16; ++t) xw[t * (S5_XT / 2)] = wv[t];
    LDS_WAIT(); asm volatile("" ::: "memory");
}
__device__ __forceinline__ void phase_s1(KArgsP a, LAS unsigned char* lds, int tid, int lane, int wave, int vcu, int G, int l) {
    unsigned char* ws = a->ws; float* ST = (float*)(ws + WS_S5ST);
    bf16x8 bf0[8], bf1[8]; s5_bfrag(ws, l, wave, lane, bf0); s5_bfrag(ws, l, wave + 8, lane, bf1);
    struct { float are, aim; } A0, A1; { const f32x2 q0 = s5_ap(ws, l, wave, lane), q1 = s5_ap(ws, l, wave + 8, lane); A0.are = q0.x; A0.aim = q0.y; A1.are = q1.x; A1.aim = q1.y; }
    for (int u = vcu; u < NB * NCH; u += G) {
        const size_t row0 = (size_t)u * 64;
        __syncthreads();
        s5_load_u(ws, lds, tid, row0);
        __syncthreads();
        float x0r = 0.f, x0i = 0.f, x1r = 0.f, x1i = 0.f;
        for (int tb = 0; tb < 4; ++tb) { s5_block(lds, lane, tb, wave, bf0, A0.are, A0.aim, x0r, x0i); s5_block(lds, lane, tb, wave + 8, bf1, A1.are, A1.aim, x1r, x1i); }
        *(f32x2*)(ST + (((size_t)u * 16 + wave) * 64 + lane) * 2) = (f32x2){x0r, x0i};
        *(f32x2*)(ST + (((size_t)u * 16 + wave + 8) * 64 + lane) * 2) = (f32x2){x1r, x1i};
    }
}
__device__ __forceinline__ void phase_s2(KArgsP a, int tid, int wg, int nwg, int l) {
    float* ST = (float*)(a->ws + WS_S5ST);
    for (int idx = wg * NTHR + tid; idx < NB * 1024; idx += nwg * NTHR) {
        const int b = idx >> 10, gp = idx & 1023, g = gp >> 6, p = gp & 63;
        const f32x2 A = s5_ap(a->ws, l, g, p); float ar = A.x, ai = A.y;
#pragma unroll
        for (int s = 0; s < 6; ++s) { const float nr = ar * ar - ai * ai, ni = 2.f * ar * ai; ar = nr; ai = ni; }
        float cr = 0.f, ci = 0.f;
        for (int c0 = 0; c0 < NCH; c0 += 8) {
            f32x2 e[8];
#pragma unroll
            for (int j = 0; j < 8; ++j) e[j] = *(const f32x2*)(ST + (((size_t)(b * NCH + c0 + j) * 16 + g) * 64 + p) * 2);
#pragma unroll
            for (int j = 0; j < 8; ++j) { *(f32x2*)(ST + (((size_t)(b * NCH + c0 + j) * 16 + g) * 64 + p) * 2) = (f32x2){cr, ci};
                const float nr = ar * cr - ai * ci + e[j].x, ni = ar * ci + ai * cr + e[j].y; cr = nr; ci = ni; }
        }
    }
}
__device__ __forceinline__ float tanh_fast(float x) { return 1.f - 2.f / (1.f + __expf(2.f * x)); }
__device__ __forceinline__ float gelu_tanh_(float x) { const float t = tanh_fast(0.7978845608f * (x + 0.044715f * x * x * x)); return 0.5f * x * (1.f + t); }
__device__ __forceinline__ void s5_cload(const bf16* cmt  , int lane, bf16x8 (&cf)[4]) {
#pragma unroll
    for (int s = 0; s < 4; ++s) cf[s] = __builtin_bit_cast(bf16x8, *(const GAS v4u*)(cmt + (lane & 15) * 128 + 32 * s + 8 * (lane >> 4)));
}
__device__ __forceinline__ void s5_cproj(LAS unsigned char* lds, int lane, int tb, int g, const bf16x8 (&cf)[4], const float (&dv)[4]) {
    const int kq = lane >> 4; f32x4 acc = {0.f, 0.f, 0.f, 0.f};
    const LAS bf16* xp = (const LAS bf16*)(lds + S5_X) + (lane & 15) * S5_XT + g * 128 + 8 * kq;
#pragma unroll
    for (int s = 0; s < 4; ++s) acc = __builtin_amdgcn_mfma_f32_16x16x32_bf16(cf[s], *(const LAS bf16x8*)(xp + 32 * s), acc, 0, 0, 0);
    const int t = 16 * tb + (lane & 15), c0 = g * 16 + 4 * kq;
    const v2u uw = *(const LAS v2u*)(lds + S5_U + (t * S5_UT + c0) * 2);
    const float u4[4] = {bflo(uw.x), bfhi(uw.x), bflo(uw.y), bfhi(uw.y)}; float z[4];
#pragma unroll
    for (int r = 0; r < 4; ++r) z[r] = gelu_tanh_(acc[r] + dv[r] * u4[r]);
    v2u o; o.x = pk2(z[0], z[1]); o.y = pk2(z[2], z[3]); *(LAS v2u*)(lds + S5_Z + (t * S5_UT + c0) * 2) = o;
}
__device__ __forceinline__ void phase_s3(KArgsP a, LAS unsigned char* lds, int tid, int lane, int wave, int vcu, int G, int l, unsigned* qctr = nullptr) {
    unsigned char* ws = a->ws; const float* ST = (const float*)(ws + WS_S5ST); bf16* YC = (bf16*)(ws + WS_YC);
    const bf16* GLUT = (const bf16*)(ws + WS_GLUT) + (size_t)l * DC * DC;
    bf16x8 bf0[8], bf1[8]; s5_bfrag(ws, l, wave, lane, bf0); s5_bfrag(ws, l, wave + 8, lane, bf1);
    const bf16* cm0 = (const bf16*)(ws + WS_S5CM) + (size_t)(l * 16 + wave) * 2048; const bf16* cm1 = cm0 + 8 * 2048;
    struct { float are, aim; } A0, A1; { const f32x2 q0 = s5_ap(ws, l, wave, lane), q1 = s5_ap(ws, l, wave + 8, lane); A0.are = q0.x; A0.aim = q0.y; A1.are = q1.x; A1.aim = q1.y; }
    float d0[4], d1[4];
#pragma unroll
    for (int r = 0; r < 4; ++r) { d0[r] = a->in[I_S5D][l * DC + wave * 16 + 4 * (lane >> 4) + r]; d1[r] = a->in[I_S5D][l * DC + (wave + 8) * 16 + 4 * (lane >> 4) + r]; }
    volatile LAS unsigned* qw = (volatile LAS unsigned*)(lds + MISC_OFF) + 20;
    for (int u = vcu; ; u += G) {
        if (qctr) { __syncthreads(); if (tid == 0) *qw = __hip_atomic_fetch_add(qctr, 1u, __ATOMIC_RELAXED, __HIP_MEMORY_SCOPE_AGENT); __syncthreads(); u = (int)*qw; }
        if (u >= NB * NCH) break;
        const size_t row0 = (size_t)u * 64;
        __syncthreads();
        s5_load_u(ws, lds, tid, row0);
        const f32x2 s0 = *(const f32x2*)(ST + (((size_t)u * 16 + wave) * 64 + lane) * 2), s1 = *(const f32x2*)(ST + (((size_t)u * 16 + wave + 8) * 64 + lane) * 2);
        float x0r = s0.x, x0i = s0.y, x1r = s1.x, x1i = s1.y;
        __syncthreads();
        for (int tb = 0; tb < 4; ++tb) {
            { bf16x8 cf[4]; s5_cload(cm0, lane, cf); s5_block(lds, lane, tb, wave, bf0, A0.are, A0.aim, x0r, x0i); s5_cproj(lds, lane, tb, wave, cf, d0); }
            { bf16x8 cf[4]; s5_cload(cm1, lane, cf); s5_block(lds, lane, tb, wave + 8, bf1, A1.are, A1.aim, x1r, x1i); s5_cproj(lds, lane, tb, wave + 8, cf, d1); }
        }
        __syncthreads();
        {
            const int kq = lane >> 4;
#pragma unroll
            for (int q = 0; q < 2; ++q) { const int ct = 2 * wave + q; f32x4 acc[4];
#pragma unroll
                for (int rt = 0; rt < 4; ++rt) acc[rt] = (f32x4){0.f, 0.f, 0.f, 0.f};
                const bf16* gp = GLUT + (size_t)(16 * ct + (lane & 15)) * DC + 8 * kq;
#pragma unroll 2
                for (int s = 0; s < 8; ++s) { const bf16x8 gf = __builtin_bit_cast(bf16x8, *(const GAS v4u*)(gp + 32 * s));
#pragma unroll
                    for (int rt = 0; rt < 4; ++rt) acc[rt] = __builtin_amdgcn_mfma_f32_16x16x32_bf16(gf, *(const LAS bf16x8*)(lds + S5_Z + ((16 * rt + (lane & 15)) * S5_UT + 32 * s + 8 * kq) * 2), acc[rt], 0, 0, 0); }
                const int j0 = 16 * ct + 4 * kq; const f32x4 gb = *(const GAS f32x4*)(a->in[I_S5GLUB] + l * DC + j0);
#pragma unroll
                for (int rt = 0; rt < 4; ++rt) { const int t = 16 * rt + (lane & 15); const v2u zw = *(const LAS v2u*)(lds + S5_Z + (t * S5_UT + j0) * 2);
                    const float z0 = bflo(zw.x), z1 = bfhi(zw.x), z2 = bflo(zw.y), z3 = bfhi(zw.y);
                    v2u o; o.x = pk2(z0 * sigmoidf_(acc[rt][0] + gb.x), z1 * sigmoidf_(acc[rt][1] + gb.y)); o.y = pk2(z2 * sigmoidf_(acc[rt][2] + gb.z), z3 * sigmoidf_(acc[rt][3] + gb.w));
                    *(GAS v2u*)(YC + (row0 + t) * DM + 768 + j0) = o; } }
        }
    }
}

__device__ __forceinline__ float rw_shift(const bf16* PROJ, const float* mu, size_t row, int col) {
    const float cur = bf2f(PROJ[row * NPROJ + PC_RW + col]); const float prv = (row % SEQ) ? bf2f(PROJ[(row - 1) * NPROJ + PC_RW + col]) : 0.f;
    return cur + mu[col] * (prv - cur);
}
constexpr int R1_TH = 0, R1_AD = 9216, R1_SG = 18432, R1_VS = 35840, R1_TMP = 86016;
template <int KS, int MODE>
__device__ __forceinline__ void r1_prod(const bf16* WT, const LAS bf16* act, int astride, const float* bias, bf16* OUT, size_t row0, int lane, int wave) {
    const int kq = lane >> 4, n0 = 48 * wave; constexpr int K = 32 * KS;
    f32x4 acc[3][4];
#pragma unroll
    for (int nt = 0; nt < 3; ++nt)
#pragma unroll
        for (int ti = 0; ti < 4; ++ti) acc[nt][ti] = (f32x4){0.f, 0.f, 0.f, 0.f};
#pragma unroll
    for (int s = 0; s < KS; ++s) { bf16x8 wf[3], af[4];
#pragma unroll
        for (int nt = 0; nt < 3; ++nt) wf[nt] = __builtin_bit_cast(bf16x8, *(const GAS v4u*)(WT + (size_t)(n0 + 16 * nt + (lane & 15)) * K + 32 * s + 8 * kq));
#pragma unroll
        for (int ti = 0; ti < 4; ++ti) af[ti] = *(const LAS bf16x8*)(act + (16 * ti + (lane & 15)) * astride + 32 * s + 8 * kq);
#pragma unroll
        for (int nt = 0; nt < 3; ++nt)
#pragma unroll
            for (int ti = 0; ti < 4; ++ti) acc[nt][ti] = __builtin_amdgcn_mfma_f32_16x16x32_bf16(wf[nt], af[ti], acc[nt][ti], 0, 0, 0); }
#pragma unroll
    for (int nt = 0; nt < 3; ++nt) { const int n = n0 + 16 * nt + 4 * kq; f32x4 bv = {0.f, 0.f, 0.f, 0.f}; if (MODE != 2) bv = *(const GAS f32x4*)(bias + n);
#pragma unroll
        for (int ti = 0; ti < 4; ++ti) { float o[4];
#pragma unroll
            for (int r = 0; r < 4; ++r) { const float x = acc[nt][ti][r] + bv[r]; o[r] = MODE == 0 ? 0.60653066f * sigmoidf_(x) : (MODE == 1 ? sigmoidf_(x) : x); }
            v2u w; w.x = pk2(o[0], o[1]); w.y = pk2(o[2], o[3]);
            *(GAS v2u*)(OUT + (row0 + 16 * ti + (lane & 15)) * DBR + n) = w; } }
}
__device__ __forceinline__ void phase_r1(KArgsP a, LAS unsigned char* lds, int tid, int lane, int wave, int vcu, int G, int l) {
    unsigned char* ws = a->ws; const bf16* PROJ = (const bf16*)(ws + WS_PROJ); const float* mu = a->in[I_RMU] + (size_t)l * RW_COLS;
    const bf16* W1 = (const bf16*)(ws + WS_R1W) + (size_t)l * 98304;
    const bf16* WV = (const bf16*)(ws + WS_R1W) + 2 * 98304;
    for (int u = vcu; u < NTOK / 64; u += G) {
        const size_t row0 = (size_t)u * 64;
        __syncthreads();
        for (int idx = tid; idx < 64 * 128; idx += NTHR) { const int tt = idx >> 7, col = 2 * (idx & 127); const size_t r = row0 + tt;
            const unsigned cw = *(const GAS unsigned*)(PROJ + r * NPROJ + PC_RW + RWC_WD + col); const unsigned pw = (r % SEQ) ? *(const GAS unsigned*)(PROJ + (r - 1) * NPROJ + PC_RW + RWC_WD + col) : 0u;
            const float c0 = bflo(cw), c1 = bfhi(cw); const float x0 = c0 + mu[RWC_WD + col] * (bflo(pw) - c0), x1 = c1 + mu[RWC_WD + col + 1] * (bfhi(pw) - c1);
            if (col < 64) *(LAS unsigned*)(lds + R1_TH + (tt * 72 + col) * 2) = pk2(tanh_fast(x0), tanh_fast(x1));
            else if (col < 128) *(LAS unsigned*)(lds + R1_AD + (tt * 72 + col - 64) * 2) = pk2(x0, x1);
            else *(LAS unsigned*)(lds + R1_SG + (tt * 136 + col - 128) * 2) = pk2(sigmoidf_(x0), sigmoidf_(x1)); }
        if (l > 0) for (int idx = tid; idx < 64 * 192; idx += NTHR) { const int tt = idx / 192, col = 2 * (idx % 192); const size_t r = row0 + tt;
            const unsigned cw = *(const GAS unsigned*)(PROJ + r * NPROJ + PC_RW + RWC_V + col); const unsigned pw = (r % SEQ) ? *(const GAS unsigned*)(PROJ + (r - 1) * NPROJ + PC_RW + RWC_V + col) : 0u;
            const float c0 = bflo(cw), c1 = bfhi(cw);
            *(LAS unsigned*)(lds + R1_VS + (tt * 392 + col) * 2) = pk2(c0 + mu[RWC_V + col] * (bflo(pw) - c0), c1 + mu[RWC_V + col + 1] * (bfhi(pw) - c1)); }
        __syncthreads();
        r1_prod<2, 0>(W1, (const LAS bf16*)(lds + R1_TH), 72, a->in[I_RW0] + l * DBR, (bf16*)(ws + WS_RE), row0, lane, wave);
        r1_prod<2, 1>(W1 + 24576, (const LAS bf16*)(lds + R1_AD), 72, a->in[I_RA0] + l * DBR, (bf16*)(ws + WS_RA), row0, lane, wave);
        r1_prod<4, 2>(W1 + 49152, (const LAS bf16*)(lds + R1_SG), 136, nullptr, (bf16*)(ws + WS_RG), row0, lane, wave);
        if (l > 0) {
            { const int kq = lane >> 4, mt = wave & 1, ti = wave >> 1; f32x4 acc = {0.f, 0.f, 0.f, 0.f};
#pragma unroll
              for (int s = 0; s < 12; ++s) acc = __builtin_amdgcn_mfma_f32_16x16x32_bf16(__builtin_bit_cast(bf16x8, *(const GAS v4u*)(WV + (size_t)(16 * mt + (lane & 15)) * 384 + 32 * s + 8 * kq)),
                                                                                          *(const LAS bf16x8*)(lds + R1_VS + ((16 * ti + (lane & 15)) * 392 + 32 * s + 8 * kq) * 2), acc, 0, 0, 0);
              v2u w; w.x = pk2(acc[0], acc[1]); w.y = pk2(acc[2], acc[3]); *(LAS v2u*)(lds + R1_TMP + ((16 * ti + (lane & 15)) * 40 + 16 * mt + 4 * kq) * 2) = w; }
            __syncthreads();
            r1_prod<1, 1>(WV + 12288, (const LAS bf16*)(lds + R1_TMP), 40, a->in[I_RV0], (bf16*)(ws + WS_RVG), row0, lane, wave);
        }
    }
}
__device__ __forceinline__ float dpp_allsum(float x) {
    x += __builtin_bit_cast(float, __builtin_amdgcn_update_dpp(0, __builtin_bit_cast(int, x), 0x128, 0xf, 0xf, false));
    x += __builtin_bit_cast(float, __builtin_amdgcn_update_dpp(0, __builtin_bit_cast(int, x), 0x124, 0xf, 0xf, false));
    x += __builtin_bit_cast(float, __builtin_amdgcn_update_dpp(0, __builtin_bit_cast(int, x), 0x122, 0xf, 0xf, false));
    x += __builtin_bit_cast(float, __builtin_amdgcn_update_dpp(0, __builtin_bit_cast(int, x), 0x121, 0xf, 0xf, false));
    { const unsigned xi = __builtin_bit_cast(unsigned, x); auto r = __builtin_amdgcn_permlane16_swap(xi, xi, false, false); const unsigned r0 = r[0], r1 = r[1]; x = __uint_as_float(r0) + __uint_as_float(r1); }
    { const unsigned xi = __builtin_bit_cast(unsigned, x); auto r = __builtin_amdgcn_permlane32_swap(xi, xi, false, false); const unsigned r0 = r[0], r1 = r[1]; x = __uint_as_float(r0) + __uint_as_float(r1); }
    return x;
}

constexpr int RC_EF = 0, RC_ATF = 4096, RC_QF = 8448, RC_PFT = 9472, RC_AT = 10496, RC_RT = 12800, RC_BH = 15104, RC_KH = 17408, RC_AH = 19712, RC_BTT = 22016, RC_KTT = 25088, RC_VS = 28160,
              RC_PRL = 31232, RC_QRL = 32000, RC_TQL = 32768, RC_G15 = 33536, RC_CH = 33792;
struct RCRegs { v2u r0, r1, k0, k1, aa, ee, v0, v1, vg, vf, gg; };
__device__ __forceinline__ void rc_issue(const unsigned char* ws, int l, size_t row, int h, int tid, RCRegs& R) {
    const bf16* PROJ = (const bf16*)(ws + WS_PROJ); const int tt = tid >> 4, c0 = h * 64 + 4 * (tid & 15); const size_t r = row + tt; const bool first = (r % SEQ) == 0; const size_t rp = first ? r : r - 1;
    R.r0 = *(const GAS v2u*)(PROJ + r * NPROJ + PC_RW + RWC_R + c0); R.r1 = *(const GAS v2u*)(PROJ + rp * NPROJ + PC_RW + RWC_R + c0);
    R.k0 = *(const GAS v2u*)(PROJ + r * NPROJ + PC_RW + RWC_K + c0); R.k1 = *(const GAS v2u*)(PROJ + rp * NPROJ + PC_RW + RWC_K + c0);
    R.v0 = *(const GAS v2u*)(PROJ + r * NPROJ + PC_RW + RWC_V + c0); R.v1 = *(const GAS v2u*)(PROJ + rp * NPROJ + PC_RW + RWC_V + c0);
    R.aa = *(const GAS v2u*)((const bf16*)(ws + WS_RA) + r * DBR + c0); R.ee = *(const GAS v2u*)((const bf16*)(ws + WS_RE) + r * DBR + c0);
    R.gg = *(const GAS v2u*)((const bf16*)(ws + WS_RG) + r * DBR + c0);
    if (l > 0) { R.vg = *(const GAS v2u*)((const bf16*)(ws + WS_RVG) + r * DBR + c0); R.vf = *(const GAS v2u*)((const bf16*)(ws + WS_VF) + r * DBR + c0); }
    if (first) { R.r1 = (v2u){0u, 0u}; R.k1 = (v2u){0u, 0u}; R.v1 = (v2u){0u, 0u}; }
}
__device__ __forceinline__ void unpack4(const v2u p, float (&o)[4]) { o[0] = bflo(p.x); o[1] = bfhi(p.x); o[2] = bflo(p.y); o[3] = bfhi(p.y); }
__device__ __forceinline__ v2u pack4(const float (&v)[4]) { v2u o; o.x = pk2(v[0], v[1]); o.y = pk2(v[2], v[3]); return o; }
__device__ __forceinline__ v2u pack4v(const f32x4 v) { v2u o; o.x = pk2(v[0], v[1]); o.y = pk2(v[2], v[3]); return o; }
__device__ __forceinline__ bf16x8 cat8(const v2u a, const v2u b) { v4u o; o.x = a.x; o.y = a.y; o.z = b.x; o.w = b.y; return __builtin_bit_cast(bf16x8, o); }
#define RC_BAR() asm volatile("s_waitcnt lgkmcnt(0)\n\ts_barrier" ::: "memory")

constexpr int REC_BYTES = 12288, REC_UNITS = 752;
__device__ __forceinline__ unsigned char* rc_rec(unsigned char* ws, size_t cu) { return cu < 8192 ? ws + WS_OPA + cu * REC_BYTES : ws + WS_OPB + (cu - 8192) * REC_BYTES; }
__device__ __forceinline__ v4u rc_gather_unit(const LAS unsigned char* wb, int u) {
    v2u lo, hi;
    if (u < 256) { const int base = u < 128 ? RC_AH : RC_RT, uu = u & 127, row = uu >> 3, s = (uu >> 2) & 1, lq = uu & 3; const LAS unsigned char* p = wb + base + (row * 72 + 32 * s + 4 * lq) * 2;
        lo = *(const LAS v2u*)p; hi = *(const LAS v2u*)(p + 32); }
    else if (u < 512) { const int k = (u - 256) >> 2, lq = (u - 256) & 3; lo = *(const LAS v2u*)(wb + RC_BTT + (k * 24 + 4 * lq) * 2); hi = *(const LAS v2u*)(wb + RC_KTT + (k * 24 + 4 * lq) * 2); }
    else if (u < 576) { const int t = (u - 512) >> 2, lq = (u - 512) & 3; lo = *(const LAS v2u*)(wb + RC_PRL + (t * 24 + 4 * lq) * 2); hi = *(const LAS v2u*)(wb + RC_QRL + (t * 24 + 4 * lq) * 2); }
    else if (u < 608) { const LAS unsigned char* p = wb + RC_TQL + (((u - 576) >> 1) * 24 + 8 * ((u - 576) & 1)) * 2; lo = *(const LAS v2u*)p; hi = *(const LAS v2u*)(p + 8); }
    else if (u < 736) { const LAS unsigned char* p = wb + RC_VS + (((u - 608) >> 1) * 24 + 8 * ((u - 608) & 1)) * 2; lo = *(const LAS v2u*)p; hi = *(const LAS v2u*)(p + 8); }
    else { const LAS unsigned char* p = wb + RC_G15 + (u - 736) * 16; lo = *(const LAS v2u*)p; hi = *(const LAS v2u*)(p + 8); }
    v4u o; o.x = lo.x; o.y = lo.y; o.z = hi.x; o.w = hi.y; return o;
}
__device__ __forceinline__ void rc_copy_out(unsigned char* rec, const LAS unsigned char* wb, int u) {
#pragma unroll
    for (int q = 0; q < 3; ++q) { const int uu = u + 256 * q; if (uu < REC_UNITS) *(GAS v4u*)(rec + uu * 16) = rc_gather_unit(wb, uu); }
}
constexpr int RS_AH = 0, RS_RT = 2304, RS_BK = 4608, RS_PQ = 9728, RS_TQL = 11008, RS_VS = 11776, RS_G15 = 14848, RS_CH = 15360;
__device__ __forceinline__ int rs_unit_off(int u) {
    if (u < 128) return RS_AH + (u >> 3) * 144 + (u & 7) * 16;
    if (u < 256) return RS_RT + ((u - 128) >> 3) * 144 + (u & 7) * 16;
    if (u < 512) return RS_BK + ((u - 256) >> 2) * 80 + (u & 3) * 16;
    if (u < 576) return RS_PQ + ((u - 512) >> 2) * 80 + (u & 3) * 16;
    if (u < 608) return RS_TQL + ((u - 576) >> 1) * 48 + (u & 1) * 16;
    if (u < 736) return RS_VS + ((u - 608) >> 1) * 48 + (u & 1) * 16;
    return RS_G15 + (u - 736) * 16;
}
#define RC_BUILD(RUSE, q) do { const int bh_ = (q) % (NB * NH), b = bh_ / NH, h = bh_ % NH, blk_ = blk0 + (q) / (NB * NH), c0 = h * 64 + 4 * kq; const size_t row0 = (size_t)b * SEQ + (size_t)blk_ * 32; \
        float kkw[4], kaw[4], mur[4], muk[4], muv[4]; \
_Pragma("unroll") \
        for (int j = 0; j < 4; ++j) { kkw[j] = a->in[I_RKK][(size_t)l * DBR + c0 + j]; kaw[j] = a->in[I_RKA][(size_t)l * DBR + c0 + j]; mur[j] = mu[RWC_R + c0 + j]; muk[j] = mu[RWC_K + c0 + j]; muv[j] = mu[RWC_V + c0 + j]; } \
        float an[4], bk[4], km[4], rs[4], ev[4]; \
        {   const RCRegs& R = RUSE; \
            float rc[4], rp[4], kc[4], kp[4], av[4], vc[4], vp[4], ks[4], kk[4], vs[4]; unpack4(R.r0, rc); unpack4(R.r1, rp); unpack4(R.k0, kc); unpack4(R.k1, kp); unpack4(R.aa, av); unpack4(R.ee, ev); unpack4(R.v0, vc); unpack4(R.v1, vp); \
            float ss = 0.f; \
_Pragma("unroll") \
            for (int j = 0; j < 4; ++j) { rs[j] = rc[j] + mur[j] * (rp[j] - rc[j]); ks[j] = kc[j] + muk[j] * (kp[j] - kc[j]); kk[j] = ks[j] * kkw[j]; ss += kk[j] * kk[j]; vs[j] = vc[j] + muv[j] * (vp[j] - vc[j]); } \
            ss += __shfl_xor(ss, 1); ss += __shfl_xor(ss, 2); ss += __shfl_xor(ss, 4); ss += __shfl_xor(ss, 8); \
            const float inv = 1.f / fmaxf(sqrtf(ss), 1e-12f); \
_Pragma("unroll") \
            for (int j = 0; j < 4; ++j) { const float kn = kk[j] * inv; an[j] = -kn; bk[j] = kn * av[j]; km[j] = ks[j] * (1.f + (av[j] - 1.f) * kaw[j]); } \
            if (l == 0) *(GAS v2u*)((bf16*)(ws + WS_VF) + (row0 + tt) * DBR + c0) = pack4(vs); \
            else { float g[4], f[4]; unpack4(R.vg, g); unpack4(R.vf, f); \
_Pragma("unroll") \
                for (int j = 0; j < 4; ++j) vs[j] = vs[j] + (f[j] - vs[j]) * g[j]; } \
            {     \
                float gq[4], o1[4], o2[4]; unpack4(R.gg, gq); float rkp = 0.f; \
_Pragma("unroll") \
                for (int j = 0; j < 4; ++j) rkp += rs[j] * km[j] * a->in[I_RRK][(size_t)l * DBR + c0 + j]; \
                rkp += __shfl_xor(rkp, 1); rkp += __shfl_xor(rkp, 2); rkp += __shfl_xor(rkp, 4); rkp += __shfl_xor(rkp, 8); \
_Pragma("unroll") \
                for (int j = 0; j < 4; ++j) { o1[j] = a->in[I_RLNW][(size_t)l * DBR + c0 + j] * gq[j]; o2[j] = (a->in[I_RLNB][(size_t)l * DBR + c0 + j] + rkp * vs[j]) * gq[j]; } \
                if (ST12) { *(GAS v2u*)((bf16*)(ws + WS_RG) + (row0 + tt) * DBR + c0) = pack4(o1); *(GAS v2u*)((bf16*)(ws + WS_RA) + (row0 + tt) * DBR + c0) = pack4(o2); } } \
            *(LAS f32x4*)(cb + RC_EF + (t * 64 + 4 * kq) * 4) = (f32x4){ev[0], ev[1], ev[2], ev[3]}; \
_Pragma("unroll") \
            for (int j = 0; j < 4; ++j) *(LAS bf16*)(cb + RC_VS + ((4 * kq + j) * 24 + t) * 2) = (bf16)f2bf(vs[j]); \
        } \
        if ((q) + 2 * G < NQ) rc_issue_q(ws, l, (q) + 2 * G, blk0, tid, RUSE); \
        RC_BAR(); \
        {   f32x4 inc = {0.f, 0.f, 0.f, 0.f}, tot = inc; \
_Pragma("unroll") \
            for (int i = 0; i < 16; ++i) { const f32x4 ei = *(const LAS f32x4*)(cb + RC_EF + (i * 64 + 4 * kq) * 4); tot = tot + ei; if (i <= t) inc = inc + ei; } \
            float At[4], Rt[4], Bh[4], Kh[4], Bt[4], Kt[4], Gt[4]; \
_Pragma("unroll") \
            for (int j = 0; j < 4; ++j) { const float Gi = __expf(-inc[j]), Ge = __expf(ev[j] - inc[j]), Gn = __expf(inc[j]); Gt[j] = __expf(-tot[j]); \
                At[j] = an[j] * Ge; Rt[j] = rs[j] * Gi; Bh[j] = bk[j] * Gn; Kh[j] = km[j] * Gn; Bt[j] = Bh[j] * Gt[j]; Kt[j] = Kh[j] * Gt[j]; } \
            *(LAS f32x4*)(cb + RC_ATF + (t * 68 + 4 * kq) * 4) = (f32x4){At[0], At[1], At[2], At[3]}; \
            *(LAS v2u*)(cb + RC_AT + (t * 72 + 4 * kq) * 2) = pack4(At); *(LAS v2u*)(cb + RC_RT + (t * 72 + 4 * kq) * 2) = pack4(Rt); \
            *(LAS v2u*)(cb + RC_BH + (t * 72 + 4 * kq) * 2) = pack4(Bh); *(LAS v2u*)(cb + RC_KH + (t * 72 + 4 * kq) * 2) = pack4(Kh); \
_Pragma("unroll") \
            for (int j = 0; j < 4; ++j) { *(LAS bf16*)(cb + RC_BTT + ((4 * kq + j) * 24 + t) * 2) = (bf16)f2bf(Bt[j]); *(LAS bf16*)(cb + RC_KTT + ((4 * kq + j) * 24 + t) * 2) = (bf16)f2bf(Kt[j]); } \
            if (t == 0) *(LAS f32x4*)(cb + RC_G15 + 4 * kq * 4) = (f32x4){Gt[0], Gt[1], Gt[2], Gt[3]}; \
        } \
        RC_BAR(); \
        {   LAS unsigned char* wb = lds + (wave >> 2) * RC_CH; const int pi = wave & 3; \
            const LAS bf16* Ap = (const LAS bf16*)(wb + (pi < 2 ? RC_AT : RC_RT)) + li * 72 + 8 * lq; const LAS bf16* Bp = (const LAS bf16*)(wb + ((pi & 1) ? RC_KH : RC_BH)) + li * 72 + 8 * lq; \
            f32x4 acc = {0.f, 0.f, 0.f, 0.f}; \
            acc = __builtin_amdgcn_mfma_f32_16x16x32_bf16(*(const LAS bf16x8*)Ap, *(const LAS bf16x8*)Bp, acc, 0, 0, 0); \
            acc = __builtin_amdgcn_mfma_f32_16x16x32_bf16(*(const LAS bf16x8*)(Ap + 32), *(const LAS bf16x8*)(Bp + 32), acc, 0, 0, 0); \
_Pragma("unroll") \
            for (int r = 0; r < 4; ++r) { const int tr = 4 * lq + r; if (pi < 2 ? !(li < tr) : !(li <= tr)) acc[r] = 0.f; } \
            if (pi == 0) *(LAS f32x4*)(wb + RC_PFT + (li * 16 + 4 * lq) * 4) = acc; \
            else if (pi == 1) { \
_Pragma("unroll") \
                for (int r = 0; r < 4; ++r) *(LAS float*)(wb + RC_QF + ((4 * lq + r) * 16 + li) * 4) = acc[r]; } \
            else { LAS bf16* o = (LAS bf16*)(wb + (pi == 2 ? RC_PRL : RC_QRL)); \
_Pragma("unroll") \
                for (int r = 0; r < 4; ++r) o[(4 * lq + r) * 24 + li] = (bf16)f2bf(acc[r]); } \
        } \
        RC_BAR(); \
        if (wave < 4) { \
            LAS unsigned char* wb = lds + (wave >> 1) * RC_CH; const bool isq = wave & 1; \
            float X[16]; \
_Pragma("unroll") \
            for (int r = 0; r < 16; ++r) X[r] = isq ? *(const LAS float*)(wb + RC_QF + (r * 16 + li) * 4) : *(const LAS float*)(wb + RC_ATF + (r * 68 + lane) * 4); \
_Pragma("unroll") \
            for (int j = 0; j < 15; ++j) { const LAS f32x4* pc = (const LAS f32x4*)(wb + RC_PFT + j * 64); const f32x4 c0v = pc[0], c1v = pc[1], c2v = pc[2], c3v = pc[3]; \
                const float c[16] = {c0v[0], c0v[1], c0v[2], c0v[3], c1v[0], c1v[1], c1v[2], c1v[3], c2v[0], c2v[1], c2v[2], c2v[3], c3v[0], c3v[1], c3v[2], c3v[3]}; \
_Pragma("unroll") \
                for (int r = j + 1; r < 16; ++r) X[r] = fmaf(c[r], X[j], X[r]); } \
            if (!isq) { LAS bf16* o = (LAS bf16*)(wb + RC_AH); \
_Pragma("unroll") \
                for (int r = 0; r < 16; ++r) o[r * 72 + lane] = (bf16)f2bf(X[r]); } \
            else if (lane < 16) { LAS bf16* o = (LAS bf16*)(wb + RC_TQL); \
_Pragma("unroll") \
                for (int r = 0; r < 16; ++r) o[r * 24 + lane] = (bf16)f2bf(X[r]); } \
        } \
        RC_BAR(); \
        { const int cc = tid >> 8, u = tid & 255; unsigned char* rec = rc_rec(ws, (size_t)bh_ * 512 + 2 * blk_ + cc); const LAS unsigned char* wb = lds + cc * RC_CH; \
          rc_copy_out(rec, wb, u); } \
        RC_BAR(); \
    } while (0)
#ifndef RS_NT
#define RS_NT 1
#endif
constexpr int RS_TILES = RS_NT;
struct RSOps { bf16x8 a01, a23, r01, r23, tq, pq, bk[4]; v2u vb[RS_TILES]; f32x4 g[4]; };
__device__ __forceinline__ void rs_load(const LAS unsigned char* wb, int wave, int li, int lq, RSOps& O) {
    O.a01 = *(const LAS bf16x8*)(wb + RS_AH + li * 144 + lq * 16); O.a23 = *(const LAS bf16x8*)(wb + RS_AH + li * 144 + 64 + lq * 16);
    O.r01 = *(const LAS bf16x8*)(wb + RS_RT + li * 144 + lq * 16); O.r23 = *(const LAS bf16x8*)(wb + RS_RT + li * 144 + 64 + lq * 16);
    O.pq = *(const LAS bf16x8*)(wb + RS_PQ + li * 80 + lq * 16);
    { const v2u t = *(const LAS v2u*)(wb + RS_TQL + li * 48 + lq * 8); v4u o; o.x = t.x; o.y = t.y; o.z = 0u; o.w = 0u; O.tq = __builtin_bit_cast(bf16x8, o); }
#pragma unroll
    for (int vt = 0; vt < RS_TILES; ++vt) O.vb[vt] = *(const LAS v2u*)(wb + RS_VS + (16 * (RS_TILES * wave + vt) + li) * 48 + lq * 8);
#pragma unroll
    for (int kt = 0; kt < 4; ++kt) { O.bk[kt] = *(const LAS bf16x8*)(wb + RS_BK + (16 * kt + li) * 80 + lq * 16); O.g[kt] = *(const LAS f32x4*)(wb + RS_G15 + (16 * kt + 4 * lq) * 4); }
}
#define RC_CHUNK(O, cc, yb) do { const v2u z2_ = {0u, 0u}; \
_Pragma("unroll") \
        for (int vt = 0; vt < RS_TILES; ++vt) {     \
            f32x4 aD = {0.f, 0.f, 0.f, 0.f}, aY = {0.f, 0.f, 0.f, 0.f}; \
            aD = __builtin_amdgcn_mfma_f32_16x16x32_bf16(O.tq, cat8(O.vb[vt], z2_), aD, 0, 0, 0); \
            aD = __builtin_amdgcn_mfma_f32_16x16x32_bf16(O.a01, Sb01[vt], aD, 0, 0, 0); \
            aD = __builtin_amdgcn_mfma_f32_16x16x32_bf16(O.a23, Sb23[vt], aD, 0, 0, 0); \
            aY = __builtin_amdgcn_mfma_f32_16x16x32_bf16(Sb01[vt], O.r01, aY, 0, 0, 0); \
            aY = __builtin_amdgcn_mfma_f32_16x16x32_bf16(Sb23[vt], O.r23, aY, 0, 0, 0); \
            const bf16x8 DV = cat8(pack4v(aD), O.vb[vt]); \
_Pragma("unroll") \
            for (int kt = 0; kt < 4; ++kt) Sacc[vt][kt] = __builtin_amdgcn_mfma_f32_16x16x32_bf16(O.bk[kt], DV, Sacc[vt][kt] * O.g[kt], 0, 0, 0); \
            aY = __builtin_amdgcn_mfma_f32_16x16x32_bf16(DV, O.pq, aY, 0, 0, 0); \
            Sb01[vt] = cat8(pack4v(Sacc[vt][0]), pack4v(Sacc[vt][1])); Sb23[vt] = cat8(pack4v(Sacc[vt][2]), pack4v(Sacc[vt][3])); \
            *(LAS v2u*)((yb) + (((cc) * 16 + li) * 72 + 16 * (RS_TILES * wave + vt) + 4 * lq) * 2) = pack4v(aY);     \
        } \
    } while (0)
#define RC_SCAN(slot, yb) do { { RSOps O0; rs_load(slot, wave, li, lq, O0); __builtin_amdgcn_sched_barrier(0); RC_CHUNK(O0, 0, yb); } \
        { RSOps O1; rs_load(slot + RS_CH, wave, li, lq, O1); __builtin_amdgcn_sched_barrier(0); RC_CHUNK(O1, 1, yb); } } while (0)

__device__ __forceinline__ void rc_issue_q(const unsigned char* ws, int l, int q, int blk0, int tid, RCRegs& R) {
    const int bh = q % (NB * NH), blk = blk0 + q / (NB * NH);
    rc_issue(ws, l, (size_t)(bh / NH) * SEQ + (size_t)blk * 32, bh % NH, tid, R);
}
template <bool ST12 = true>
__device__ __forceinline__ void phase_r2_build(KArgsP a, LAS unsigned char* lds, int tid, int lane, int wave, int vcu, int G, int l, int blk0 = 0, int nblk = SEQ / 32) {
    unsigned char* ws = a->ws;
    const int tt = tid >> 4, kq = tid & 15, ch = tt >> 4, t = tt & 15;
    const int lq = lane >> 4, li = lane & 15;
    LAS unsigned char* cb = lds + ch * RC_CH;
    const float* mu = a->in[I_RMU] + (size_t)l * RW_COLS;
    const int NQ = NB * NH * nblk;
    RCRegs RA, RB;
    if (vcu < NQ) rc_issue_q(ws, l, vcu, blk0, tid, RA);
    if (vcu + G < NQ) rc_issue_q(ws, l, vcu + G, blk0, tid, RB);
    for (int q0 = vcu; q0 < NQ; q0 += 2 * G) { { const int q = q0; RC_BUILD(RA, q); } if (q0 + G < NQ) { const int q = q0 + G; RC_BUILD(RB, q); } }
}
#ifndef RS_DEPTH
#define RS_DEPTH 4
#endif
struct RSRegs { v4u p[6]; };
__device__ __forceinline__ unsigned char* ubase(const unsigned char* p) {
    const unsigned lo = __builtin_amdgcn_readfirstlane((unsigned)(uintptr_t)p), hi = __builtin_amdgcn_readfirstlane((unsigned)((uintptr_t)p >> 32));
    return (unsigned char*)(((uintptr_t)hi << 32) | lo);
}
struct RSOff { unsigned g[6], s[6]; };
__device__ __forceinline__ void rs_offsets(int lt, RSOff& F) {
#pragma unroll
    for (int j = 0; j < 6; ++j) { const int uu = min(lt + 256 * j, 2 * REC_UNITS - 1); const int cc = uu >= REC_UNITS, u = uu - cc * REC_UNITS;
        F.g[j] = uu * 16 + cc * (REC_BYTES - REC_UNITS * 16); F.s[j] = cc * RS_CH + rs_unit_off(u); }
}
__device__ __forceinline__ void rs_issue(unsigned char* ws, size_t cu0, const RSOff& F, RSRegs& R) {
    const unsigned char* base = ubase(rc_rec(ws, cu0));
#pragma unroll
    for (int j = 0; j < 6; ++j) R.p[j] = *(const GAS v4u*)(base + F.g[j]);
}
__device__ __forceinline__ void rs_store(LAS unsigned char* slot, const RSOff& F, const RSRegs& R) {
#pragma unroll
    for (int j = 0; j < 6; ++j) *(LAS v4u*)(slot + F.s[j]) = R.p[j];
}
struct R3Q { v4u a1, a2; };
__device__ __forceinline__ void r3q_issue(const unsigned char* ws, size_t row0, int h, int lt, R3Q& Q) {
    const unsigned off = (unsigned)(((lt >> 3) * DBR + 8 * (lt & 7)) * 2); const size_t ub = (row0 * DBR + h * 64) * 2;
    Q.a1 = *(const GAS v4u*)(ubase(ws + WS_RG + ub) + off); Q.a2 = *(const GAS v4u*)(ubase(ws + WS_RA + ub) + off);
}
__device__ __forceinline__ float dpp8sum(float x) {
    x += __builtin_bit_cast(float, __builtin_amdgcn_update_dpp(0, __builtin_bit_cast(int, x), 0xB1, 0xf, 0xf, false));
    x += __builtin_bit_cast(float, __builtin_amdgcn_update_dpp(0, __builtin_bit_cast(int, x), 0x4E, 0xf, 0xf, false));
    x += __builtin_bit_cast(float, __builtin_amdgcn_update_dpp(0, __builtin_bit_cast(int, x), 0x141, 0xf, 0xf, false));
    return x;
}
__device__ __forceinline__ void r3_block(const LAS unsigned char* yb, bf16* YC, size_t row0, int h, int lt, const R3Q& Q) {
    const int tk = lt >> 3, c8 = 8 * (lt & 7);
    const v4u yy = *(const LAS v4u*)(yb + (tk * 72 + c8) * 2);
    float d[8] = {bflo(yy.x), bfhi(yy.x), bflo(yy.y), bfhi(yy.y), bflo(yy.z), bfhi(yy.z), bflo(yy.w), bfhi(yy.w)};
    const float m = dpp8sum(((d[0] + d[1]) + (d[2] + d[3])) + ((d[4] + d[5]) + (d[6] + d[7]))) * (1.f / 64.f);
    float q = 0.f;
#pragma unroll
    for (int j = 0; j < 8; ++j) { d[j] -= m; q = fmaf(d[j], d[j], q); }
    const float rstd = rsqrtf(dpp8sum(q) * (1.f / 64.f) + RWKV_GN_EPS);
    const unsigned a1[4] = {Q.a1.x, Q.a1.y, Q.a1.z, Q.a1.w}, a2[4] = {Q.a2.x, Q.a2.y, Q.a2.z, Q.a2.w}; unsigned o[4];
#pragma unroll
    for (int j = 0; j < 4; ++j) o[j] = pk2(fmaf(d[2 * j] * rstd, bflo(a1[j]), bflo(a2[j])), fmaf(d[2 * j + 1] * rstd, bfhi(a1[j]), bfhi(a2[j])));
    v4u w; w.x = o[0]; w.y = o[1]; w.z = o[2]; w.w = o[3];
    *(GAS v4u*)(ubase((const unsigned char*)(YC + row0 * DM + 384 + h * 64)) + (unsigned)((tk * DM + c8) * 2)) = w;
}
__device__ __forceinline__ void phase_r2_scan(KArgsP a, LAS unsigned char* lds, int tid, int lane, int wave, int wg, int l, int bsplit = SEQ / 32, unsigned nbuilders = 0u) {
    unsigned char* ws = a->ws; bf16* YC = (bf16*)(ws + WS_YC);
    const int b = wg / NH, h = wg % NH; const size_t rowb = (size_t)b * SEQ, cub = (size_t)wg * 512;
    const int lq = lane >> 4, li = lane & 15, lt = tid - 256; const bool loader = wave >= 4;
    f32x4 Sacc[RS_TILES][4]; bf16x8 Sb01[RS_TILES], Sb23[RS_TILES];
#pragma unroll
    for (int vt = 0; vt < RS_TILES; ++vt) {
#pragma unroll
        for (int kt = 0; kt < 4; ++kt) Sacc[vt][kt] = (f32x4){0.f, 0.f, 0.f, 0.f};
        Sb01[vt] = (bf16x8){0, 0, 0, 0, 0, 0, 0, 0}; Sb23[vt] = Sb01[vt]; }
    constexpr int NBLK = SEQ / 32;
    LAS unsigned char* yb0 = lds + 8 * RS_CH; LAS unsigned char* yb1 = yb0 + 32 * 72 * 2;
    static_assert(8 * RS_CH + 2 * 32 * 72 * 2 <= MISC_OFF, "scan LDS layout");
    if (wave < 4 / RS_TILES) {
        RSOps OA, OB;
        RC_BAR();
        rs_load(lds, wave, li, lq, OA);
#pragma unroll 1
        for (int X = 0; X < NBLK; ++X) {
            LAS unsigned char* sl = lds + (X & 3) * 2 * RS_CH; LAS unsigned char* sn = lds + ((X + 1) & 3) * 2 * RS_CH; LAS unsigned char* yb = yb0 + (X & 1) * (32 * 72 * 2);
            if (X == bsplit - 7 && wave == 0) {
                if (lane == 0) { unsigned* bar_ = (unsigned*)(ws + WS_CTL) + CW_BAR; unsigned* cnt_ = (unsigned*)(ws + WS_CTL) + CW_Q + 64 * l + 48; XB_SPIN(xb_ld(cnt_) < nbuilders, bar_); }
                __builtin_amdgcn_fence(__ATOMIC_ACQUIRE, "agent"); asm volatile("s_waitcnt vmcnt(0)" ::: "memory");
            }
            rs_load(sl + RS_CH, wave, li, lq, OB); __builtin_amdgcn_sched_barrier(0); RC_CHUNK(OA, 0, yb);
            rs_load(sn, wave, li, lq, OA); __builtin_amdgcn_sched_barrier(0); RC_CHUNK(OB, 1, yb);
            RC_BAR();
        }
    } else if (!loader) {
        RC_BAR();
        for (int X = 0; X < NBLK; ++X) RC_BAR();
    } else {
        constexpr int ND = 4;
        RSRegs R[ND]; R3Q Q[ND]; RSOff F; rs_offsets(lt, F);
#pragma unroll
        for (int j = 0; j < ND; ++j) { rs_issue(ws, cub + 2 * j, F, R[j]); r3q_issue(ws, rowb + 32 * j, h, lt, Q[j]); }
        rs_store(lds, F, R[0]); rs_issue(ws, cub + 2 * ND, F, R[0]); rs_store(lds + 2 * RS_CH, F, R[1]); rs_issue(ws, cub + 2 * (ND + 1), F, R[1]);
        RC_BAR();
        for (int bb = 0; bb < NBLK; bb += ND) {
#pragma unroll
            for (int j = 0; j < ND; ++j) { const int X = bb + j;
                r3_block((j & 1) ? yb0 : yb1, YC, rowb + (size_t)max(X - 1, 0) * 32, h, lt, Q[(j + ND - 1) % ND]);
                r3q_issue(ws, rowb + (size_t)min(X - 1 + ND, NBLK - 1) * 32, h, lt, Q[(j + ND - 1) % ND]);
                rs_store(lds + ((j + 2) & 3) * 2 * RS_CH, F, R[(j + 2) % ND]);
                rs_issue(ws, cub + 2 * (size_t)min(X + 2 + ND, NBLK - 1), F, R[(j + 2) % ND]);
                RC_BAR();
            }
        }
        r3_block(yb1, YC, rowb + (size_t)(NBLK - 1) * 32, h, lt, Q[(NBLK - 1) % ND]);
    }
}
__device__ __forceinline__ void phase_r3(KArgsP a, int lane, int gw, int ngw, int l) {
    unsigned char* ws = a->ws; const bf16* PROJ = (const bf16*)(ws + WS_PROJ); bf16* YC = (bf16*)(ws + WS_YC);
    const bf16* RA = (const bf16*)(ws + WS_RA); const bf16* RG = (const bf16*)(ws + WS_RG); const bf16* RVG = (const bf16*)(ws + WS_RVG); const bf16* VF = (const bf16*)(ws + WS_VF);
    const float* mu = a->in[I_RMU] + (size_t)l * RW_COLS;
    for (size_t row = gw; row < NTOK; row += ngw) {
#pragma unroll
        for (int h = 0; h < NH; ++h) {
            const int c = h * 64 + lane;
            const float y = bf2f(YC[row * DM + 384 + c]);
            const float m = dpp_allsum(y) * (1.f / 64.f); const float d = y - m; const float var = dpp_allsum(d * d) * (1.f / 64.f);
            const float yn = d * rsqrtf(var + RWKV_GN_EPS) * a->in[I_RLNW][l * DBR + c] + a->in[I_RLNB][l * DBR + c];
            const float rs = rw_shift(PROJ, mu, row, RWC_R + c), ks = rw_shift(PROJ, mu, row, RWC_K + c); float v = rw_shift(PROJ, mu, row, RWC_V + c);
            if (l > 0) v = v + (bf2f(VF[row * DBR + c]) - v) * bf2f(RVG[row * DBR + c]);
            const float av = bf2f(RA[row * DBR + c]);
            const float km = ks * (1.f + (av - 1.f) * a->in[I_RKA][l * DBR + c]);
            const float rk = dpp_allsum(rs * km * a->in[I_RRK][l * DBR + c]);
            YC[row * DM + 384 + c] = (bf16)f2bf((yn + rk * v) * bf2f(RG[row * DBR + c]));
        }
    }
}

constexpr int PH_PER_LAYER = 10, PH_FINAL = 1 + 2 * PH_PER_LAYER, N_PHASES = PH_FINAL + 1;
constexpr int R2_WGS = 24;
__global__ void __launch_bounds__(NTHR, 2) fwd(Args args) {
    extern __shared__ __attribute__((aligned(16))) unsigned char lds_raw[];
    LAS unsigned char* lds = (LAS unsigned char*)lds_raw;
    volatile LAS unsigned* MISC = (volatile LAS unsigned*)(lds + MISC_OFF);
    const int tid0 = threadIdx.x;
    const int G = gridDim.x;
#define PHASE_IDS int tid_ = threadIdx.x; asm volatile("" : "+v"(tid_)); const int tid = tid_, lane = tid & 63, wave = __builtin_amdgcn_readfirstlane(tid >> 6); \
    int bx_ = blockIdx.x; asm volatile("" : "+s"(bx_)); const int bx = bx_; const int vcu = (G % 8 == 0) ? (bx % 8) * (G / 8) + bx / 8 : bx; (void)lane; (void)wave; (void)vcu; (void)bx;
    unsigned char* ws0 = fresh_args()->ws;
    for (int u = tid0; u < (LDS_BYTES - RING_BYTES) / 4; u += NTHR) ((LAS unsigned*)(lds + RING_BYTES))[u] = 0u;
    __syncthreads();
    XcdBarrier bar; bar.bar = (unsigned*)(ws0 + WS_CTL) + CW_BAR; bar.x = 0; bar.st = nullptr;
    if (!MK_PER_PHASE) bar = xcd_barrier_post((unsigned*)(ws0 + WS_CTL) + CW_BAR, MISC + 8);
#if MK_PER_PHASE
    const int lo = args.ph_lo, hi = args.ph_hi;
#define IN(k) (lo <= (k) && (k) < hi)
#else
#define IN(k) true
#endif
#define SEAM(k) do { if (IN(k) && IN((k) + 1)) { XcdBarrier b2 = bar; asm volatile("" : "+s"(b2.bar)); xcd_barrier(b2); } } while (0)

#ifndef GEMM_SP2
#define GEMM_SP2 true
#endif
#ifndef GEMM_ALIGN
#define GEMM_ALIGN true
#endif
#ifndef RS_DEPTH
#define RS_DEPTH 4
#endif
#ifndef R2_SPLIT
#define R2_SPLIT 160
#endif
#ifndef DBL_SUB
#define DBL_SUB 0
#endif
#ifndef DBL_PHASE
#define DBL_PHASE (-1)
#endif
#ifndef REPN
#define REPN 2
#endif
#define SUBREP(k) _Pragma("nounroll") for (int q_ = 0; q_ < 1 + (REPN - 1) * (((k) == DBL_SUB) && l == 0); ++q_)
#define REP(k) for (int rep_ = 0; rep_ < ((k) == DBL_PHASE ? REPN : 1); ++rep_)
#define REPBAR if (rep_ > 0) { XcdBarrier b2 = bar; asm volatile("" : "+s"(b2.bar)); xcd_barrier(b2); }
    REP(0) if (IN(0)) { REPBAR KArgsP ap = fresh_args(); PHASE_IDS phase_prologue(ap, lds, tid, lane, wave, vcu, G); }
    SEAM(0);
#ifdef EXTRA_BAR
    for (int eb_ = 0; eb_ < EXTRA_BAR; ++eb_) { XcdBarrier b2 = bar; asm volatile("" : "+s"(b2.bar)); xcd_barrier(b2); }
#endif
#define LCONST 0
    {
        constexpr int l = LCONST; constexpr int pb = 1 + l * PH_PER_LAYER;
        REP(pb + 0) if (IN(pb + 0)) { REPBAR KArgsP ap = fresh_args(); PHASE_IDS unsigned char* ws = ap->ws; (void)ws;
            if (l == 0) { mod_finalize(ws, tid, G); SUBREP(6) { phase_rownorm<0, false>(ap, lds, tid, lane, wave, G, ap->in[I_X], ap->out, ap->in[I_NORM_MIX], true, 0, 0, 0); __syncthreads(); } }
            else {
#if EN_MOE
                phase_rownorm<0, true>(ap, lds, tid, lane, wave, G, ap->out, ap->out, ap->in[I_NORM_MIX] + l * DM, false, l, 0, l - 1);
#else
                phase_rownorm<0, false>(ap, lds, tid, lane, wave, G, ap->out, ap->out, ap->in[I_NORM_MIX] + l * DM, false, l, 0, l - 1);
#endif
            }
        }
        SEAM(pb + 0);
        REP(pb + 1) if (IN(pb + 1)) { REPBAR KArgsP ap = fresh_args(); PHASE_IDS unsigned char* ws = ap->ws; (void)ws;
            pg8::Gemm g{(const pg8::bf16_t*)(ws + WS_HN), (const pg8::bf16_t*)(ws + WS_WIN) + (size_t)l * NPROJ_PAD * DM, NTOK, NPROJ_PAD, DM};
            pg8::StaticOrder S; S.init(NTOK, NPROJ_PAD, G, bx);
            pg8::EpiProj E{(pg8::bf16_t*)(ws + WS_PROJ), (float*)(ws + WS_GATES)};
SUBREP(7) { pg8::gemm_phase<pg8::EpiProj, pg8::StaticOrder, GEMM_ALIGN, GEMM_SP2>(lds, g, S, E); __syncthreads(); }
        }
        SEAM(pb + 1);
        REP(pb + 2) if (IN(pb + 2)) { REPBAR KArgsP ap = fresh_args(); PHASE_IDS unsigned char* ws = ap->ws; (void)ws;
#if EN_MLSTM
            for (int q_ = 0; q_ < 1 + (REPN - 1) * ((DBL_SUB == 1) && l == 0); ++q_) { phase_m1(ap, lds, tid, lane, wave, vcu, G, l); __syncthreads(); }
            __syncthreads();
#endif
#if EN_S5
            phase_s1(ap, lds, tid, lane, wave, vcu, G, l); __syncthreads();
#if DBL_SUB == 2
            if (l == 0) { phase_s1(ap, lds, tid, lane, wave, vcu, G, l); __syncthreads(); phase_s1(ap, lds, tid, lane, wave, vcu, G, l); __syncthreads(); phase_s1(ap, lds, tid, lane, wave, vcu, G, l); __syncthreads(); phase_s1(ap, lds, tid, lane, wave, vcu, G, l); __syncthreads(); }
#endif
            __syncthreads();
#endif
#if EN_RWKV
            for (int q_ = 0; q_ < 1 + (REPN - 1) * ((DBL_SUB == 3) && l == 0); ++q_) { phase_r1(ap, lds, tid, lane, wave, vcu, G, l); __syncthreads(); }
#endif
        }
        SEAM(pb + 2);
        REP(pb + 3) if (IN(pb + 3)) { REPBAR KArgsP ap = fresh_args(); PHASE_IDS unsigned char* ws = ap->ws; (void)ws;
            phase_m2(ws, tid, vcu, G);
            phase_s2(ap, tid, vcu, G, l);
            __syncthreads();
            phase_r2_build(ap, lds, tid, lane, wave, vcu, G, l, 0, R2_SPLIT);
        }
        SEAM(pb + 3);
        REP(pb + 4) if (IN(pb + 4)) { REPBAR KArgsP ap = fresh_args(); PHASE_IDS unsigned char* ws = ap->ws; (void)ws;
            if (bx < R2_WGS) { phase_r2_scan(ap, lds, tid, lane, wave, bx, l, R2_SPLIT, (unsigned)(G - R2_WGS)); __syncthreads(); }
            else {
                phase_r2_build(ap, lds, tid, lane, wave, bx - R2_WGS, G - R2_WGS, l, R2_SPLIT, SEQ / 32 - R2_SPLIT);
                asm volatile("s_waitcnt vmcnt(0)" ::: "memory"); __syncthreads();
                if (tid == 0) { __builtin_amdgcn_fence(__ATOMIC_RELEASE, "agent"); asm volatile("s_waitcnt vmcnt(0)" ::: "memory"); (void)xb_add((unsigned*)(ws + WS_CTL) + CW_Q + 64 * l + 48, 1u); }
                phase_s3(ap, lds, tid, lane, wave, 0, 1, l, (unsigned*)(ws + WS_CTL) + CW_Q + 64 * l + 32); __syncthreads();
            }
            {
                unsigned* qctr = (unsigned*)(ws + WS_CTL) + CW_Q + 64 * l; volatile LAS unsigned* qw = (volatile LAS unsigned*)(lds + MISC_OFF) + 16;
                for (;;) {
                    if (tid == 0) *qw = __hip_atomic_fetch_add(qctr, 1u, __ATOMIC_RELAXED, __HIP_MEMORY_SCOPE_AGENT);
                    __syncthreads();
                    const int u = (int)*qw;
                    __syncthreads();
                    if (u >= NUNIT_M) break;
                    phase_m3(ap, lds, tid, lane, wave, u, NUNIT_M, l);
                }
            }
        }
        SEAM(pb + 4);
        REP(pb + 6) if (IN(pb + 6)) { REPBAR KArgsP ap = fresh_args(); PHASE_IDS unsigned char* ws = ap->ws; (void)ws;
            pg8::Gemm g{(const pg8::bf16_t*)(ws + WS_YC), (const pg8::bf16_t*)(ws + WS_WOUT) + (size_t)l * DM * DM, NTOK, DM, DM};
            pg8::StaticOrder S; S.init(NTOK, DM, G, bx);
            pg8::EpiResid E{l == 0 ? ap->in[I_X] : (const float*)ap->out, ap->out, (const float*)(ws + WS_MODF) + (size_t)l * 4 * 6144, 2048};
SUBREP(8) { pg8::gemm_phase<pg8::EpiResid, pg8::StaticOrder, GEMM_ALIGN, GEMM_SP2>(lds, g, S, E); __syncthreads(); }
        }
        SEAM(pb + 6);
#if EN_MOE
        REP(pb + 7) if (IN(pb + 7)) { REPBAR KArgsP ap = fresh_args(); PHASE_IDS phase_router(ap, lds, tid, lane, wave, G, l); __syncthreads();
            SUBREP(11) {
            moe_convert13(ap->in[I_MW1], ap->in[I_MW3], l, (bf16*)(ap->ws + WS_W13), vcu * NWAVES + wave, G * NWAVES, (LAS float*)(lds + wave * 16640), lane);
            moe_convert2(ap->in[I_MW2], l, (bf16*)(ap->ws + WS_W2), vcu * NWAVES + wave, G * NWAVES, (LAS float*)(lds + wave * 16640), lane); __syncthreads(); } }
        SEAM(pb + 7);
        REP(pb + 8) if (IN(pb + 8)) { REPBAR KArgsP ap = fresh_args(); PHASE_IDS unsigned char* ws = ap->ws; (void)ws;
            LAS int* ptab = (LAS int*)(lds + PTAB_OFF); LAS int* pst = ptab + 512; LAS int* cnt = pst + 32;
            build_ptab((const unsigned*)(ws + WS_CTL) + CW_CNT + l * 32, ptab, pst, cnt, tid);
            pg8::Gemm g{(const pg8::bf16_t*)(ws + WS_HN), (const pg8::bf16_t*)(ws + WS_W13), 0, 0, DM, (const int*)(ws + WS_LIST), ptab};
            pg8::MoeOrder S{ptab, G, vcu};
            pg8::EpiSwiglu E{(pg8::bf16_t*)(ws + WS_HMID)};
SUBREP(9) { pg8::gemm_phase<pg8::EpiSwiglu, pg8::MoeOrder, false, true, true>(lds, g, S, E); __syncthreads(); }
        }
        SEAM(pb + 8);
        REP(pb + 9) if (IN(pb + 9)) { REPBAR KArgsP ap = fresh_args(); PHASE_IDS unsigned char* ws = ap->ws; (void)ws;
            LAS int* ptab = (LAS int*)(lds + PTAB_OFF); LAS int* pst = ptab + 512; LAS int* cnt = pst + 32;
            build_ptab((const unsigned*)(ws + WS_CTL) + CW_CNT + l * 32, ptab, pst, cnt, tid);
            pg8::Gemm g{(const pg8::bf16_t*)(ws + WS_HMID), (const pg8::bf16_t*)(ws + WS_W2), 0, 0, DEXP};
            pg8::MoeOrder S{ptab, G, vcu};
            pg8::EpiMoeOut E{(pg8::bf16_t*)(ws + WS_YMOE), (const int*)(ws + WS_LIST), ptab};
SUBREP(10) { pg8::gemm_phase<pg8::EpiMoeOut, pg8::MoeOrder, true, true>(lds, g, S, E); __syncthreads(); }
        }
        SEAM(pb + 9);
#else
        SEAM(pb + 6); SEAM(pb + 7); SEAM(pb + 8); SEAM(pb + 9);
#endif
    }
#undef LCONST
#if N_LAYERS > 1
#define LCONST 1
    {
        constexpr int l = LCONST; constexpr int pb = 1 + l * PH_PER_LAYER;
        REP(pb + 0) if (IN(pb + 0)) { REPBAR KArgsP ap = fresh_args(); PHASE_IDS unsigned char* ws = ap->ws; (void)ws;
            if (l == 0) { mod_finalize(ws, tid, G); SUBREP(6) { phase_rownorm<0, false>(ap, lds, tid, lane, wave, G, ap->in[I_X], ap->out, ap->in[I_NORM_MIX], true, 0, 0, 0); __syncthreads(); } }
            else {
#if EN_MOE
                phase_rownorm<0, true>(ap, lds, tid, lane, wave, G, ap->out, ap->out, ap->in[I_NORM_MIX] + l * DM, false, l, 0, l - 1);
#else
                phase_rownorm<0, false>(ap, lds, tid, lane, wave, G, ap->out, ap->out, ap->in[I_NORM_MIX] + l * DM, false, l, 0, l - 1);
#endif
            }
        }
        SEAM(pb + 0);
        REP(pb + 1) if (IN(pb + 1)) { REPBAR KArgsP ap = fresh_args(); PHASE_IDS unsigned char* ws = ap->ws; (void)ws;
            pg8::Gemm g{(const pg8::bf16_t*)(ws + WS_HN), (const pg8::bf16_t*)(ws + WS_WIN) + (size_t)l * NPROJ_PAD * DM, NTOK, NPROJ_PAD, DM};
            pg8::StaticOrder S; S.init(NTOK, NPROJ_PAD, G, bx);
            pg8::EpiProj E{(pg8::bf16_t*)(ws + WS_PROJ), (float*)(ws + WS_GATES)};
SUBREP(7) { pg8::gemm_phase<pg8::EpiProj, pg8::StaticOrder, GEMM_ALIGN, GEMM_SP2>(lds, g, S, E); __syncthreads(); }
        }
        SEAM(pb + 1);
        REP(pb + 2) if (IN(pb + 2)) { REPBAR KArgsP ap = fresh_args(); PHASE_IDS unsigned char* ws = ap->ws; (void)ws;
#if EN_MLSTM
            for (int q_ = 0; q_ < 1 + (REPN - 1) * ((DBL_SUB == 1) && l == 0); ++q_) { phase_m1(ap, lds, tid, lane, wave, vcu, G, l); __syncthreads(); }
            __syncthreads();
#endif
#if EN_S5
            phase_s1(ap, lds, tid, lane, wave, vcu, G, l); __syncthreads();
#if DBL_SUB == 2
            if (l == 0) { phase_s1(ap, lds, tid, lane, wave, vcu, G, l); __syncthreads(); phase_s1(ap, lds, tid, lane, wave, vcu, G, l); __syncthreads(); phase_s1(ap, lds, tid, lane, wave, vcu, G, l); __syncthreads(); phase_s1(ap, lds, tid, lane, wave, vcu, G, l); __syncthreads(); }
#endif
            __syncthreads();
#endif
#if EN_RWKV
            for (int q_ = 0; q_ < 1 + (REPN - 1) * ((DBL_SUB == 3) && l == 0); ++q_) { phase_r1(ap, lds, tid, lane, wave, vcu, G, l); __syncthreads(); }
#endif
        }
        SEAM(pb + 2);
        REP(pb + 3) if (IN(pb + 3)) { REPBAR KArgsP ap = fresh_args(); PHASE_IDS unsigned char* ws = ap->ws; (void)ws;
            phase_m2(ws, tid, vcu, G);
            phase_s2(ap, tid, vcu, G, l);
            __syncthreads();
            phase_r2_build(ap, lds, tid, lane, wave, vcu, G, l, 0, R2_SPLIT);
        }
        SEAM(pb + 3);
        REP(pb + 4) if (IN(pb + 4)) { REPBAR KArgsP ap = fresh_args(); PHASE_IDS unsigned char* ws = ap->ws; (void)ws;
            if (bx < R2_WGS) { phase_r2_scan(ap, lds, tid, lane, wave, bx, l, R2_SPLIT, (unsigned)(G - R2_WGS)); __syncthreads(); }
            else {
                phase_r2_build(ap, lds, tid, lane, wave, bx - R2_WGS, G - R2_WGS, l, R2_SPLIT, SEQ / 32 - R2_SPLIT);
                asm volatile("s_waitcnt vmcnt(0)" ::: "memory"); __syncthreads();
                if (tid == 0) { __builtin_amdgcn_fence(__ATOMIC_RELEASE, "agent"); asm volatile("s_waitcnt vmcnt(0)" ::: "memory"); (void)xb_add((unsigned*)(ws + WS_CTL) + CW_Q + 64 * l + 48, 1u); }
                phase_s3(ap, lds, tid, lane, wave, 0, 1, l, (unsigned*)(ws + WS_CTL) + CW_Q + 64 * l + 32); __syncthreads();
            }
            {
                unsigned* qctr = (unsigned*)(ws + WS_CTL) + CW_Q + 64 * l; volatile LAS unsigned* qw = (volatile LAS unsigned*)(lds + MISC_OFF) + 16;
                for (;;) {
                    if (tid == 0) *qw = __hip_atomic_fetch_add(qctr, 1u, __ATOMIC_RELAXED, __HIP_MEMORY_SCOPE_AGENT);
                    __syncthreads();
                    const int u = (int)*qw;
                    __syncthreads();
                    if (u >= NUNIT_M) break;
                    phase_m3(ap, lds, tid, lane, wave, u, NUNIT_M, l);
                }
            }
        }
        SEAM(pb + 4);
        REP(pb + 6) if (IN(pb + 6)) { REPBAR KArgsP ap = fresh_args(); PHASE_IDS unsigned char* ws = ap->ws; (void)ws;
            pg8::Gemm g{(const pg8::bf16_t*)(ws + WS_YC), (const pg8::bf16_t*)(ws + WS_WOUT) + (size_t)l * DM * DM, NTOK, DM, DM};
            pg8::StaticOrder S; S.init(NTOK, DM, G, bx);
            pg8::EpiResid E{l == 0 ? ap->in[I_X] : (const float*)ap->out, ap->out, (const float*)(ws + WS_MODF) + (size_t)l * 4 * 6144, 2048};
SUBREP(8) { pg8::gemm_phase<pg8::EpiResid, pg8::StaticOrder, GEMM_ALIGN, GEMM_SP2>(lds, g, S, E); __syncthreads(); }
        }
        SEAM(pb + 6);
#if EN_MOE
        REP(pb + 7) if (IN(pb + 7)) { REPBAR KArgsP ap = fresh_args(); PHASE_IDS phase_router(ap, lds, tid, lane, wave, G, l); __syncthreads();
            SUBREP(11) {
            moe_convert13(ap->in[I_MW1], ap->in[I_MW3], l, (bf16*)(ap->ws + WS_W13), vcu * NWAVES + wave, G * NWAVES, (LAS float*)(lds + wave * 16640), lane);
            moe_convert2(ap->in[I_MW2], l, (bf16*)(ap->ws + WS_W2), vcu * NWAVES + wave, G * NWAVES, (LAS float*)(lds + wave * 16640), lane); __syncthreads(); } }
        SEAM(pb + 7);
        REP(pb + 8) if (IN(pb + 8)) { REPBAR KArgsP ap = fresh_args(); PHASE_IDS unsigned char* ws = ap->ws; (void)ws;
            LAS int* ptab = (LAS int*)(lds + PTAB_OFF); LAS int* pst = ptab + 512; LAS int* cnt = pst + 32;
            build_ptab((const unsigned*)(ws + WS_CTL) + CW_CNT + l * 32, ptab, pst, cnt, tid);
            pg8::Gemm g{(const pg8::bf16_t*)(ws + WS_HN), (const pg8::bf16_t*)(ws + WS_W13), 0, 0, DM, (const int*)(ws + WS_LIST), ptab};
            pg8::MoeOrder S{ptab, G, vcu};
            pg8::EpiSwiglu E{(pg8::bf16_t*)(ws + WS_HMID)};
SUBREP(9) { pg8::gemm_phase<pg8::EpiSwiglu, pg8::MoeOrder, false, true, true>(lds, g, S, E); __syncthreads(); }
        }
        SEAM(pb + 8);
        REP(pb + 9) if (IN(pb + 9)) { REPBAR KArgsP ap = fresh_args(); PHASE_IDS unsigned char* ws = ap->ws; (void)ws;
            LAS int* ptab = (LAS int*)(lds + PTAB_OFF); LAS int* pst = ptab + 512; LAS int* cnt = pst + 32;
            build_ptab((const unsigned*)(ws + WS_CTL) + CW_CNT + l * 32, ptab, pst, cnt, tid);
            pg8::Gemm g{(const pg8::bf16_t*)(ws + WS_HMID), (const pg8::bf16_t*)(ws + WS_W2), 0, 0, DEXP};
            pg8::MoeOrder S{ptab, G, vcu};
            pg8::EpiMoeOut E{(pg8::bf16_t*)(ws + WS_YMOE), (const int*)(ws + WS_LIST), ptab};
SUBREP(10) { pg8::gemm_phase<pg8::EpiMoeOut, pg8::MoeOrder, true, true>(lds, g, S, E); __syncthreads(); }
        }
        SEAM(pb + 9);
#else
        SEAM(pb + 6); SEAM(pb + 7); SEAM(pb + 8); SEAM(pb + 9);
#endif
    }
#undef LCONST
#endif
    if (IN(PH_FINAL)) { KArgsP ap = fresh_args(); PHASE_IDS
#if EN_MOE
        if (N_LAYERS > 0) phase_rownorm<1, true>(ap, lds, tid, lane, wave, G, ap->out, ap->out, ap->in[I_NORM_FINAL], false, 0, 0, N_LAYERS - 1);
        else phase_rownorm<1, false>(ap, lds, tid, lane, wave, G, ap->in[I_X], ap->out, ap->in[I_NORM_FINAL], false, 0, 0, 0);
#else
        phase_rownorm<1, false>(ap, lds, tid, lane, wave, G, N_LAYERS > 0 ? (const float*)ap->out : ap->in[I_X], ap->out, ap->in[I_NORM_FINAL], false, 0, 0, 0);
#endif
    }
#undef IN
#undef SEAM
}

extern "C" void kernel_launch(void* const* d_in, const int* in_sizes, int n_in, void* d_out, int out_size, void* d_ws, size_t ws_size, hipStream_t stream) {
    static int grid = 0;
    if (grid == 0) {
        if (n_in != 47 || out_size != NTOK * DM || ws_size < WS_END) { fprintf(stderr, "kernel_launch: unexpected problem (n_in %d, out %d, ws %zu < %zu)\n", n_in, out_size, ws_size, (size_t)WS_END); grid = -1; return; }
        int dev = 0, cus = 0, per_cu = 0;
        if (hipGetDevice(&dev) != hipSuccess || hipDeviceGetAttribute(&cus, hipDeviceAttributeMultiprocessorCount, dev) != hipSuccess) { grid = -1; return; }
        if (hipFuncSetAttribute((const void*)fwd, hipFuncAttributeMaxDynamicSharedMemorySize, LDS_BYTES) != hipSuccess) { fprintf(stderr, "kernel_launch: hipFuncSetAttribute failed\n"); grid = -1; return; }
        if (hipOccupancyMaxActiveBlocksPerMultiprocessor(&per_cu, (const void*)fwd, NTHR, LDS_BYTES) != hipSuccess || per_cu < 1) fprintf(stderr, "kernel_launch: occupancy query says %d\n", per_cu);
        (void)hipGetLastError();
        grid = cus;
        if (grid != 256) fprintf(stderr, "kernel_launch: %d CUs (built for 256)\n", grid);
    }
    if (grid < 0) return;
    (void)hipMemsetAsync((char*)d_ws + WS_CTL, 0, CTL_ZERO_BYTES, stream);
    Args a{};
    for (int i = 0; i < 47; ++i) a.in[i] = (const float*)d_in[i];
    a.out = (float*)d_out; a.ws = (unsigned char*)d_ws;
#if MK_PER_PHASE
    for (int p = 0; p < N_PHASES; ++p) { a.ph_lo = p; a.ph_hi = p + 1; hipLaunchKernelGGL(fwd, dim3(grid), dim3(NTHR), LDS_BYTES, stream, a); }
#else
    a.ph_lo = 0; a.ph_hi = N_PHASES; hipLaunchKernelGGL(fwd, dim3(grid), dim3(NTHR), LDS_BYTES, stream, a);
#endif
}
#ifdef DIAG_KERNELS
#define DK(name, ...) __global__ void __launch_bounds__(NTHR, 2) name(Args args) { extern __shared__ __attribute__((aligned(16))) unsigned char lds_raw[]; LAS unsigned char* lds = (LAS unsigned char*)lds_raw; \
    const int tid = threadIdx.x, lane = tid & 63, wave = __builtin_amdgcn_readfirstlane(tid >> 6); const int G = gridDim.x; const int bx = blockIdx.x; const int vcu = bx; KArgsP ap = fresh_args(); int l = ap->ph_lo; (void)lane; (void)wave; (void)vcu; (void)G; (void)l; __VA_ARGS__ }
DK(k_prologue, phase_prologue(ap, lds, tid, lane, wave, vcu, G);)
DK(k_norm0, phase_rownorm<0, false>(ap, lds, tid, lane, wave, G, ap->in[I_X], ap->out, ap->in[I_NORM_MIX], true, 0, 0, 0);)
DK(k_norm1, phase_rownorm<0, true>(ap, lds, tid, lane, wave, G, ap->out, ap->out, ap->in[I_NORM_MIX], false, l, 0, 0);)
DK(k_normf, phase_rownorm<1, true>(ap, lds, tid, lane, wave, G, ap->out, ap->out, ap->in[I_NORM_MIX], false, l, 0, 0);)
DK(k_m1, phase_m1(ap, lds, tid, lane, wave, vcu, G, l);)
DK(k_m2, phase_m2(ap->ws, tid, vcu, G);)
DK(k_m3, phase_m3(ap, lds, tid, lane, wave, vcu, G, l);)
DK(k_s1, phase_s1(ap, lds, tid, lane, wave, vcu, G, l);)
DK(k_s2, phase_s2(ap, tid, vcu, G, l);)
DK(k_s3, phase_s3(ap, lds, tid, lane, wave, vcu, G, l);)
DK(k_r1, phase_r1(ap, lds, tid, lane, wave, vcu, G, l);)
DK(k_r2b, phase_r2_build(ap, lds, tid, lane, wave, vcu, G, l);)
DK(k_r2s, phase_r2_scan(ap, lds, tid, lane, wave, vcu, l);)
DK(k_r3, phase_r3(ap, lane, vcu * NWAVES + wave, G * NWAVES, l);)
DK(k_router, phase_router(ap, lds, tid, lane, wave, G, l);)
DK(k_gather, phase_gather(ap, lds, tid, lane, wave, vcu, G, l);)
DK(k_moecv, moe_convert13(ap->in[I_MW1], ap->in[I_MW3], 1, (bf16*)(ap->ws + WS_W13), vcu * NWAVES + wave, G * NWAVES, (LAS float*)(lds + wave * 16640), lane);)
#endif
```

```cpp
#include <hip/hip_runtime.h>
#include <cstdio>
#include <cstdint>
#define MK_PER_PHASE 0

#ifndef MK_PER_PHASE
#define MK_PER_PHASE 0
#endif
#ifndef EN_MLSTM
#define EN_MLSTM 1
#endif
#ifndef EN_S5
#define EN_S5 1
#endif
#ifndef EN_RWKV
#define EN_RWKV 1
#endif
#ifndef EN_MOE
#define EN_MOE 1
#endif
#ifndef N_LAYERS
#define N_LAYERS 2
#endif
constexpr int NWAVES = 8, NTHR = 512;
constexpr int DM = 1024, NB = 4, SEQ = 8192, NTOK = NB * SEQ;
constexpr int DA = 384, DBR = 384, DC = 256, NH = 6, HD = 64, NCH = SEQ / 64;
constexpr int IN_COLS = 2828, NPROJ = 2816, NPROJ_PAD = 3072;
constexpr int PC_QK = 0, PC_V = 384, PC_O = 768, PC_RW = 1152, PC_S5 = 2560;
constexpr int RWC_R = 0, RWC_K = 384, RWC_V = 768, RWC_WD = 1152, RWC_AD = 1216, RWC_GD = 1280, RW_COLS = 1408;
constexpr int NEXP = 32, DEXP = 512, MOE_ROWS_MAX = 73728;
constexpr int NUNIT_M = NB * NCH * NH;
constexpr int CL_STRIDE = 4160;
constexpr float NORM_EPS = 1e-6f, HEAD_NORM_EPS = 1e-5f, RWKV_GN_EPS = 64e-5f;

constexpr size_t MiB = 1u << 20;
constexpr size_t WS_CTL = 0, CTL_ZERO_BYTES = 1 * MiB;
constexpr size_t WS_MODP = 1 * MiB;
constexpr size_t WS_MODF = 2 * MiB + 512 * 1024;
constexpr size_t WS_S5BB = 2 * MiB + 896 * 1024;
constexpr size_t WS_RTW = 3 * MiB;
constexpr size_t WS_S5AP = 3 * MiB + 384 * 1024;
constexpr size_t WS_MLW = 3 * MiB + 512 * 1024;
constexpr size_t WS_S5CM = 2 * MiB + 768 * 1024;
constexpr size_t WS_GLUT = 3 * MiB + 768 * 1024;
constexpr size_t WS_WIN = 4 * MiB;
constexpr size_t WS_WOUT = 16 * MiB;
constexpr size_t WS_GATES = 20 * MiB;
constexpr size_t WS_W13 = 22 * MiB;
constexpr size_t WS_W2 = 86 * MiB;
constexpr size_t WS_HN = 118 * MiB;
constexpr size_t WS_CLOC = 118 * MiB;
constexpr size_t WS_MSC = 168 * MiB;
constexpr size_t WS_S5ST = 170 * MiB;
constexpr size_t WS_VF = 182 * MiB;
constexpr size_t WS_YC = 206 * MiB;
constexpr size_t WS_LIST = 206 * MiB;
constexpr size_t WS_ROWMAP = 214 * MiB;
constexpr size_t WS_TOKE = 215 * MiB;
constexpr size_t WS_TOKW = 215 * MiB + 512 * 1024;
constexpr size_t WS_PROJ = 270 * MiB;
constexpr size_t WS_RE = 446 * MiB, WS_RA = 470 * MiB, WS_RG = 494 * MiB, WS_RVG = 518 * MiB;
constexpr size_t WS_XG = 270 * MiB;
constexpr size_t WS_HMID = 414 * MiB;
constexpr size_t WS_YMOE = 270 * MiB;
constexpr size_t WS_R1W = 542 * MiB;
constexpr size_t WS_OPA = 22 * MiB;
constexpr size_t WS_OPB = 543 * MiB;
constexpr size_t WS_END = 591 * MiB;
constexpr int CW_TMO = 0, CW_BAR = 4096, CW_CNT = 8192, CW_Q = 8320;

constexpr int RING_BYTES = 131072, MISC_OFF = 135168, PTAB_OFF = MISC_OFF + 1024, LDS_BYTES = 147456;

#define GAS __attribute__((address_space(1)))
#define LAS __attribute__((address_space(3)))
typedef unsigned short bf16;
typedef unsigned v4u __attribute__((ext_vector_type(4)));
typedef unsigned v2u __attribute__((ext_vector_type(2)));
typedef float f32x4 __attribute__((ext_vector_type(4)));
typedef float f32x2 __attribute__((ext_vector_type(2)));
typedef GAS unsigned gu32;
#define RLX_AGENT __ATOMIC_RELAXED, __HIP_MEMORY_SCOPE_AGENT
#define LDS_WAIT() asm volatile("s_waitcnt lgkmcnt(0)" ::: "memory")
#define VM_WAIT() asm volatile("s_waitcnt vmcnt(0)" ::: "memory")
typedef float f32x2v __attribute__((ext_vector_type(2)));
typedef __bf16 bf16x2v __attribute__((ext_vector_type(2)));
__device__ __forceinline__ unsigned pk2(float lo, float hi) { const f32x2v v = {lo, hi}; const bf16x2v b = __builtin_convertvector(v, bf16x2v); return __builtin_bit_cast(unsigned, b); }
__device__ __forceinline__ unsigned f2bf(float f) { return pk2(f, 0.f) & 0xffffu; }
__device__ __forceinline__ float bf2f(unsigned v) { return __builtin_bit_cast(float, v << 16); }
__device__ __forceinline__ float bflo(unsigned w) { return __builtin_bit_cast(float, w << 16); }
__device__ __forceinline__ float bfhi(unsigned w) { return __builtin_bit_cast(float, w & 0xffff0000u); }
__device__ __forceinline__ float sigmoidf_(float x) { return 1.f / (1.f + __expf(-x)); }
__device__ __forceinline__ float wave_sum(float v) {
#pragma unroll
    for (int o = 1; o < 64; o <<= 1) v += __shfl_xor(v, o);
    return v;
}
__device__ __forceinline__ float wave_max(float v) {
#pragma unroll
    for (int o = 1; o < 64; o <<= 1) v = fmaxf(v, __shfl_xor(v, o));
    return v;
}
namespace pg8 {
#define PG8_LAS __attribute__((address_space(3)))
typedef unsigned short bf16_t;
typedef short bf16x8 __attribute__((ext_vector_type(8)));
typedef float f32x4 __attribute__((ext_vector_type(4)));
typedef unsigned u32x4 __attribute__((ext_vector_type(4)));
constexpr int BM = 256, BK = 64, HALF = 128, HTB = HALF * BK * 2  , STAGE_BYTES = 8 * HTB, NXCD = 8, WGM = 8;

__host__ __device__ __forceinline__ int lds_byte(int r, int c) { const int st = (r >> 4) * 2 + (c >> 5), rr = r & 15, cc = c & 31, ob = rr * 64 + cc * 2; return st * 1024 + (ob ^ (((ob >> 9) & 1) << 5)); }
__host__ __device__ __forceinline__ void stage_rc(int b, int& R, int& C) { const int st = b / 1024, sb = b % 1024, swz = sb ^ (((sb >> 9) & 1) << 5); R = (st >> 1) * 16 + swz / 64; C = (st & 1) * 32 + (swz % 64) / 2; }
__host__ __device__ __forceinline__ int perm32(int rho) { const int n = rho >> 4, i = rho & 15; return 8 * (i >> 2) + 4 * n + (i & 3); }

struct Unit { int pm, pn; };
__device__ __forceinline__ int moe_tok2(const int* list, PG8_LAS const int* ptab, int row) { const int e = ptab[1 + (row >> 8)], pos = row - ptab[512 + e]; return pos < ptab[544 + e] ? list[(size_t)e * 65536 + pos] : -1; }
struct Gemm { const bf16_t* A; const bf16_t* Bt; int M, N, K; const int* list = nullptr; PG8_LAS const int* ptab = nullptr; };

struct StaticOrder {
    int nM, nN, nwg, G, c;
    __host__ __device__ void init(int M, int N, int G_, int c_) { nM = M / BM; nN = N / BM; nwg = nM * nN; G = G_; c = c_; }
    __host__ __device__ bool next(int i, Unit& u) const {
        const long L = (long)i * G + c; if (L >= nwg) return false;
        int wgid = (int)L; { const int q = nwg / NXCD, r = nwg % NXCD, xcd = wgid % NXCD, off = wgid / NXCD; wgid = (xcd < r ? xcd * (q + 1) : r * (q + 1) + (xcd - r) * q) + off; }
        const int nig = WGM * nN, gid = wgid / nig, fm = gid * WGM, gsz = (nM - fm) < WGM ? (nM - fm) : WGM;
        u.pm = fm + ((wgid % nig) % gsz); u.pn = (wgid % nig) / gsz; return true;
    }
    __device__ __forceinline__ void a_ready(const Unit&) const {}
    __device__ __forceinline__ void done(const Unit&) const {}
};

__device__ __forceinline__ unsigned cvt_pk_bf16(float lo, float hi) { unsigned r; asm volatile("v_cvt_pk_bf16_f32 %0, %1, %2" : "=v"(r) : "v"(lo), "v"(hi)); return r; }

struct EpiProj {
    static constexpr bool PERM = true, AFTER_DRAIN = false;
    bf16_t* O; float* G;
    __device__ __forceinline__ void operator()(const f32x4 (&acc)[2][2][4][2], const Unit& u, int wr, int wc, int fr, int fq) const {
        const int row0 = u.pm * BM + wr * 64 + fr;
        if (u.pn < 11) {
            const int col0 = u.pn * BM + wc * 32 + 8 * fq;
#pragma unroll
            for (int ai = 0; ai < 2; ++ai)
#pragma unroll
                for (int m = 0; m < 4; ++m) { bf16_t* rowp = O + (size_t)(row0 + ai * HALF + m * 16) * 2816 + col0;
#pragma unroll
                    for (int bj = 0; bj < 2; ++bj) { const f32x4 v0 = acc[ai][bj][m][0], v1 = acc[ai][bj][m][1];
                        u32x4 w; w.x = cvt_pk_bf16(v0[0], v0[1]); w.y = cvt_pk_bf16(v0[2], v0[3]); w.z = cvt_pk_bf16(v1[0], v1[1]); w.w = cvt_pk_bf16(v1[2], v1[3]);
                        *(u32x4*)(rowp + bj * HALF) = w; } }
        } else if (wc == 0 && fq < 2) {
#pragma unroll
            for (int ai = 0; ai < 2; ++ai)
#pragma unroll
                for (int m = 0; m < 4; ++m) { float* rowp = G + (size_t)(row0 + ai * HALF + m * 16) * 16 + 8 * fq;
                    *(f32x4*)(rowp) = acc[ai][0][m][0]; *(f32x4*)(rowp + 4) = acc[ai][0][m][1]; }
        }
    }
};
struct EpiResid {
    static constexpr bool PERM = true, AFTER_DRAIN = false;
    const float* xin; float* out; const float* gate;
    int goff;
    __device__ __forceinline__ void operator()(const f32x4 (&acc)[2][2][4][2], const Unit& u, int wr, int wc, int fr, int fq) const {
        const int row0 = u.pm * BM + wr * 64 + fr, col0 = u.pn * BM + wc * 32 + 8 * fq;
        const float* gp = gate + (size_t)(row0 >> 13) * 6144 + goff + col0;
        f32x4 g[2][2];
#pragma unroll
        for (int bj = 0; bj < 2; ++bj)
#pragma unroll
            for (int n = 0; n < 2; ++n) g[bj][n] = *(const f32x4*)(gp + bj * HALF + 4 * n) + 1.0f;
#pragma unroll
        for (int ai = 0; ai < 2; ++ai)
#pragma unroll
            for (int m = 0; m < 4; ++m) { const size_t off = (size_t)(row0 + ai * HALF + m * 16) * 1024 + col0;
#pragma unroll
                for (int bj = 0; bj < 2; ++bj)
#pragma unroll
                    for (int n = 0; n < 2; ++n) { const f32x4 xv = *(const f32x4*)(xin + off + bj * HALF + 4 * n);
                        *(f32x4*)(out + off + bj * HALF + 4 * n) = xv + g[bj][n] * acc[ai][bj][m][n]; } }
    }
};
struct EpiSwiglu {
    static constexpr bool PERM = true, AFTER_DRAIN = false;
    bf16_t* H;
    __device__ __forceinline__ void operator()(const f32x4 (&acc)[2][2][4][2], const Unit& u, int wr, int wc, int fr, int fq) const {
        const int row0 = u.pm * BM + wr * 64 + fr, hid0 = 128 * (u.pn & 3) + 16 * wc + 4 * fq;
#pragma unroll
        for (int ai = 0; ai < 2; ++ai)
#pragma unroll
            for (int m = 0; m < 4; ++m) { bf16_t* rowp = H + (size_t)(row0 + ai * HALF + m * 16) * 512 + hid0;
#pragma unroll
                for (int bj = 0; bj < 2; ++bj) { const f32x4 g = acc[ai][bj][m][0], uu = acc[ai][bj][m][1]; float h[4];
#pragma unroll
                    for (int i = 0; i < 4; ++i) h[i] = g[i] / (1.f + __expf(-g[i])) * uu[i];
                    unsigned w0 = cvt_pk_bf16(h[0], h[1]), w1 = cvt_pk_bf16(h[2], h[3]);
                    *(unsigned long long*)(rowp + 64 * bj) = (unsigned long long)w0 | ((unsigned long long)w1 << 32); } }
    }
};
struct EpiMoeOut {
    static constexpr bool PERM = true, AFTER_DRAIN = false;
    bf16_t* Y; const int* list; PG8_LAS const int* ptab;
    __device__ __forceinline__ void operator()(const f32x4 (&acc)[2][2][4][2], const Unit& u, int wr, int wc, int fr, int fq) const {
        const int row0 = u.pm * BM + wr * 64 + fr, col0 = (u.pn & 3) * BM + wc * 32 + 8 * fq;
#pragma unroll
        for (int ai = 0; ai < 2; ++ai)
#pragma unroll
            for (int m = 0; m < 4; ++m) { const int dst = moe_tok2(list, ptab, row0 + ai * HALF + m * 16);
                if (dst >= 0) { bf16_t* rowp = Y + (size_t)dst * 1024 + col0;
#pragma unroll
                    for (int bj = 0; bj < 2; ++bj) { const f32x4 v0 = acc[ai][bj][m][0], v1 = acc[ai][bj][m][1];
                        u32x4 w; w.x = cvt_pk_bf16(v0[0], v0[1]); w.y = cvt_pk_bf16(v0[2], v0[3]); w.z = cvt_pk_bf16(v1[0], v1[1]); w.w = cvt_pk_bf16(v1[2], v1[3]);
                        *(u32x4*)(rowp + bj * HALF) = w; } } }
    }
};
struct MoeOrder {
    PG8_LAS const int* ptab; int G, c;
    __device__ __forceinline__ bool next(int i, Unit& u) const {
        const int L = i * G + c, np = __builtin_amdgcn_readfirstlane(ptab[0]);
        if (L >= np * 4) return false;
        const int p = L >> 2; u.pm = p; u.pn = __builtin_amdgcn_readfirstlane(ptab[1 + p]) * 4 + (L & 3); return true;
    }
    __device__ __forceinline__ void a_ready(const Unit&) const {}
    __device__ __forceinline__ void done(const Unit&) const {}
};
template <class Epi, class Sched, bool ALIGN_EPI = false, bool SP2 = false, bool GATHER = false>
__device__ __forceinline__ void gemm_phase(PG8_LAS unsigned char* lds, const Gemm g, const Sched& S, const Epi& E) {
    int tid_ = threadIdx.x; asm volatile("" : "+v"(tid_));
    const int tid = tid_, wid = __builtin_amdgcn_readfirstlane(tid >> 6), lane = tid & 63, wr = wid >> 2, wc = wid & 3, fr = lane & 15, fq = lane >> 4;
    const int K = g.K, nt = K / BK;
    static_assert(!GATHER || SP2, "the gathered-A variant exists for the SP2 loop only");
    unsigned voffA[2], voffB[2];
    unsigned vAc[2] = {0u, 0u}, vAn[2] = {0u, 0u};
#pragma unroll
    for (int i = 0; i < 2; ++i) { int R, C; stage_rc(tid * 16 + i * 8192, R, C); const int Rb = Epi::PERM ? ((R & ~31) + perm32(R & 31)) : R;
        voffA[i] = (unsigned)(R * K + C) * 2u; voffB[i] = (unsigned)(Rb * K + C) * 2u; }
    const size_t kstep = (size_t)(BK * 2);
    const size_t hstep = (size_t)HALF * K * 2;
    const size_t tstep = 2 * hstep;
    const unsigned ldsw = (unsigned)wid * 1024u;
    const int aoff = lds_byte(wr * 64 + fr, fq * 8), boff = lds_byte(wc * 32 + fr, fq * 8);
#define PG8_SA(b, h) (((b) * 2 + (h)) * HTB)
#define PG8_SB(b, h) ((4 + (b) * 2 + (h)) * HTB)
#define PG8_STAGE(bufoff, gbase, voff) do { _Pragma("unroll") for (int _i = 0; _i < 2; ++_i) \
        __builtin_amdgcn_global_load_lds((const unsigned*)((const char*)(gbase) + (voff)[_i]), (PG8_LAS unsigned*)(lds + (bufoff) + ldsw + _i * 8192), 16, 0, 0); } while (0)
#define PG8_STAGEG(bufoff, base, pk) do { unsigned vg_[2]; _Pragma("unroll") for (int i_ = 0; i_ < 2; ++i_) { int R_, C_; stage_rc(tid * 16 + i_ * 8192, R_, C_); vg_[i_] = (((pk) >> (16 * i_)) & 0xffffu) * (unsigned)(2 * K) + (unsigned)(2 * C_); } PG8_STAGE(bufoff, base, vg_); } while (0)
#define PG8_STAGEA(bufoff, base, hh, nx) do { if constexpr (GATHER) { const unsigned pk_ = (nx) ? vAn[hh] : vAc[hh]; PG8_STAGEG(bufoff, base, pk_); } else PG8_STAGE(bufoff, (base) + (hh) * hstep, voffA); } while (0)
#define PG8_GOFF(dst, unit) do { _Pragma("unroll") for (int hh_ = 0; hh_ < 2; ++hh_) { unsigned pk_ = 0u; _Pragma("unroll") for (int i_ = 0; i_ < 2; ++i_) { int R_, C_; stage_rc(tid * 16 + i_ * 8192, R_, C_); \
        const int t2_ = moe_tok2(g.list, g.ptab, (unit).pm * BM + hh_ * HALF + R_); pk_ |= (unsigned)(t2_ < 0 ? 0 : (t2_ >> 1)) << (16 * i_); } dst[hh_] = pk_; } } while (0)
#define PG8_LDA(dst, b, h) do { _Pragma("unroll") for (int m = 0; m < 4; ++m) _Pragma("unroll") for (int k = 0; k < 2; ++k) dst[m][k] = *(const PG8_LAS bf16x8*)(lds + PG8_SA(b, h) + aoff + m * 2048 + k * 1024); } while (0)
#define PG8_LDB(dst, b, h) do { _Pragma("unroll") for (int n = 0; n < 2; ++n) _Pragma("unroll") for (int k = 0; k < 2; ++k) dst[n][k] = *(const PG8_LAS bf16x8*)(lds + PG8_SB(b, h) + boff + n * 2048 + k * 1024); } while (0)
#define PG8_MMA(ai, bj, At, Bt) do { __builtin_amdgcn_s_setprio(1); _Pragma("unroll") for (int m = 0; m < 4; ++m) _Pragma("unroll") for (int n = 0; n < 2; ++n) _Pragma("unroll") for (int k = 0; k < 2; ++k) \
        acc[ai][bj][m][n] = __builtin_amdgcn_mfma_f32_16x16x32_bf16(Bt[n][k], At[m][k], acc[ai][bj][m][n], 0, 0, 0); __builtin_amdgcn_s_setprio(0); } while (0)
#define PG8_WAIT_V(n) asm volatile("s_waitcnt vmcnt(" #n ")" ::: "memory")
#define PG8_WAIT_L(n) asm volatile("s_waitcnt lgkmcnt(" #n ")" ::: "memory")
#define PG8_BAR __builtin_amdgcn_s_barrier()
#define PG8_SCHED __builtin_amdgcn_sched_barrier(0)
    Unit cur, nxt; int ui = 0;
    if (!S.next(0, cur)) return;
    f32x4 acc[2][2][4][2];
#pragma unroll
    for (int a = 0; a < 2; ++a)
#pragma unroll
        for (int b = 0; b < 2; ++b)
#pragma unroll
            for (int m = 0; m < 4; ++m)
#pragma unroll
                for (int n = 0; n < 2; ++n) acc[a][b][m][n] = (f32x4){0.f, 0.f, 0.f, 0.f};
    bf16x8 At[4][2], B0[2][2], B1[2][2];
    const char* cA = (const char*)g.A + (GATHER ? (size_t)0 : (size_t)cur.pm * tstep); const char* cB = (const char*)g.Bt + (size_t)cur.pn * tstep;
    if constexpr (GATHER) { PG8_GOFF(vAc, cur); }
    S.a_ready(cur);
    if constexpr (SP2) {
        PG8_STAGE(PG8_SB(0, 0), cB, voffB); PG8_STAGE(PG8_SB(0, 1), cB + hstep, voffB); PG8_STAGEA(PG8_SA(0, 0), cA, 0, false); PG8_STAGEA(PG8_SA(0, 1), cA, 1, false);
        if (wr == 1) PG8_BAR;
        PG8_WAIT_V(2); PG8_BAR;
        PG8_STAGE(PG8_SB(1, 0), cB + kstep, voffB); PG8_STAGEA(PG8_SA(1, 0), cA + kstep, 0, false); PG8_STAGE(PG8_SB(1, 1), cB + hstep + kstep, voffB);
        PG8_WAIT_V(6); PG8_BAR;
    } else {
        PG8_STAGE(PG8_SB(0, 0), cB, voffB); PG8_STAGE(PG8_SA(0, 0), cA, voffA); PG8_STAGE(PG8_SB(0, 1), cB + hstep, voffB); PG8_STAGE(PG8_SA(0, 1), cA + hstep, voffA);
        if (wr == 1) PG8_BAR;
        PG8_WAIT_V(4); PG8_BAR;
        PG8_STAGE(PG8_SB(1, 0), cB + kstep, voffB); PG8_STAGE(PG8_SA(1, 0), cA + kstep, voffA); PG8_STAGE(PG8_SB(1, 1), cB + hstep + kstep, voffB);
        PG8_WAIT_V(6); PG8_BAR;
    }
    for (;;) {
        const bool has_next = S.next(ui + 1, nxt);
        const char* nA = (has_next && !GATHER) ? (const char*)g.A + (size_t)nxt.pm * tstep : cA;
        if constexpr (GATHER) { if (has_next) { PG8_GOFF(vAn, nxt); } else { vAn[0] = vAc[0]; vAn[1] = vAc[1]; } } const char* nB = has_next ? (const char*)g.Bt + (size_t)nxt.pn * tstep : cB;
        for (int t = 0; t < nt; t += 2) {
            const bool last = (t == nt - 2);
            const char* a1 = cA + (size_t)(t + 1) * kstep;
            const char* a2 = last ? nA : cA + (size_t)(t + 2) * kstep; const char* b2 = last ? nB : cB + (size_t)(t + 2) * kstep;
            const char* a3 = a2 + kstep; const char* b3 = b2 + kstep;
            if (last && has_next) S.a_ready(nxt);
            if constexpr (SP2) {
            PG8_LDB(B0, 0, 0); PG8_LDB(B1, 0, 1); PG8_SCHED; PG8_LDA(At, 0, 0); PG8_STAGEA(PG8_SA(1, 1), a1, 1, false);
            PG8_WAIT_V(8); PG8_WAIT_L(0); PG8_BAR; PG8_MMA(0, 0, At, B0); PG8_MMA(0, 1, At, B1); PG8_BAR; PG8_SCHED;
            PG8_LDA(At, 0, 1); PG8_STAGE(PG8_SB(0, 0), b2, voffB); PG8_STAGE(PG8_SB(0, 1), b2 + hstep, voffB); PG8_STAGEA(PG8_SA(0, 0), a2, 0, last);
            PG8_WAIT_V(8); PG8_WAIT_L(0); PG8_BAR; PG8_MMA(1, 0, At, B0); PG8_MMA(1, 1, At, B1); PG8_BAR; PG8_SCHED;
            PG8_LDB(B0, 1, 0); PG8_LDB(B1, 1, 1); PG8_SCHED; PG8_LDA(At, 1, 0); PG8_STAGEA(PG8_SA(0, 1), a2, 1, last);
            PG8_WAIT_V(8); PG8_WAIT_L(0); PG8_BAR; PG8_MMA(0, 0, At, B0); PG8_MMA(0, 1, At, B1); PG8_BAR; PG8_SCHED;
            PG8_LDA(At, 1, 1); PG8_STAGE(PG8_SB(1, 0), b3, voffB); PG8_STAGE(PG8_SB(1, 1), b3 + hstep, voffB); PG8_STAGEA(PG8_SA(1, 0), a3, 0, last);
            PG8_WAIT_V(8); PG8_WAIT_L(0); PG8_BAR; PG8_MMA(1, 0, At, B0); PG8_MMA(1, 1, At, B1); PG8_BAR; PG8_SCHED;
            } else {
            PG8_LDB(B0, 0, 0); PG8_SCHED; PG8_LDA(At, 0, 0); PG8_STAGE(PG8_SA(1, 1), a1 + hstep, voffA);
            PG8_WAIT_L(8); PG8_BAR; PG8_WAIT_L(0); PG8_MMA(0, 0, At, B0); PG8_BAR; PG8_SCHED;
            PG8_LDB(B1, 0, 1); PG8_STAGE(PG8_SB(0, 0), b2, voffB);
            PG8_BAR; PG8_WAIT_L(0); PG8_MMA(0, 1, At, B1); PG8_BAR;
            PG8_LDA(At, 0, 1); PG8_STAGE(PG8_SA(0, 0), a2, voffA);
            PG8_BAR; PG8_WAIT_L(0); PG8_MMA(1, 0, At, B0); PG8_BAR; PG8_SCHED;
            PG8_STAGE(PG8_SB(0, 1), b2 + hstep, voffB);
            PG8_WAIT_V(6); PG8_BAR; PG8_MMA(1, 1, At, B1); PG8_BAR;
            PG8_LDB(B0, 1, 0); PG8_SCHED; PG8_LDA(At, 1, 0); PG8_STAGE(PG8_SA(0, 1), a2 + hstep, voffA);
            PG8_WAIT_L(8); PG8_BAR; PG8_WAIT_L(0); PG8_MMA(0, 0, At, B0); PG8_BAR; PG8_SCHED;
            PG8_LDB(B1, 1, 1); PG8_STAGE(PG8_SB(1, 0), b3, voffB);
            PG8_BAR; PG8_WAIT_L(0); PG8_MMA(0, 1, At, B1); PG8_BAR;
            PG8_LDA(At, 1, 1); PG8_STAGE(PG8_SA(1, 0), a3, voffA);
            PG8_BAR; PG8_WAIT_L(0); PG8_MMA(1, 0, At, B0); PG8_BAR; PG8_SCHED;
            PG8_STAGE(PG8_SB(1, 1), b3 + hstep, voffB);
            PG8_WAIT_V(6); PG8_BAR; PG8_MMA(1, 1, At, B1); PG8_BAR;
            }
        }
        if constexpr (ALIGN_EPI) { if (wr == 0) PG8_BAR; }
        if constexpr (!Epi::AFTER_DRAIN) { E(acc, cur, wr, wc, fr, fq); S.done(cur); }
        if (!has_next) break;
#pragma unroll
        for (int a = 0; a < 2; ++a)
#pragma unroll
            for (int b = 0; b < 2; ++b)
#pragma unroll
                for (int m = 0; m < 4; ++m)
#pragma unroll
                    for (int n = 0; n < 2; ++n) acc[a][b][m][n] = (f32x4){0.f, 0.f, 0.f, 0.f};
        cur = nxt; cA = nA; cB = nB; ++ui;
        if constexpr (GATHER) { vAc[0] = vAn[0]; vAc[1] = vAn[1]; }
        if constexpr (ALIGN_EPI) { if (wr == 1) PG8_BAR; }
    }
    PG8_WAIT_V(0);
    if constexpr (!ALIGN_EPI) { if (wr == 0) PG8_BAR; }
    PG8_BAR;
    if constexpr (Epi::AFTER_DRAIN) { E.fused(acc, cur, wr, wc, fr, fq, lds, wid, lane); S.done(cur); }
#undef PG8_SA
#undef PG8_SB
#undef PG8_STAGE
#undef PG8_STAGEA
#undef PG8_STAGEG
#undef PG8_GOFF
#undef PG8_LDA
#undef PG8_LDB
#undef PG8_MMA
#undef PG8_WAIT_V
#undef PG8_WAIT_L
#undef PG8_BAR
#undef PG8_SCHED
}
}
#define XB_TMO      128
#define XB_XCNT(j)  (256  + 64 * (j))
#define XB_XSUB(j)  (1280 + 64 * (j))
#define XB_XGEN(j)  (2304 + 64 * (j))
#define XB_TOP      3328
#define XB_TOPGEN   3392
#define XCD_BAR_WORDS 3456
#define XB_SPIN_CAP (1u << 18)
#define LAS __attribute__((address_space(3)))

__device__ __forceinline__ unsigned xb_ld(unsigned* p)              { return __hip_atomic_load(p, __ATOMIC_RELAXED, __HIP_MEMORY_SCOPE_AGENT); }
__device__ __forceinline__ unsigned xb_add(unsigned* p, unsigned v) { return __hip_atomic_fetch_add(p, v, __ATOMIC_RELAXED, __HIP_MEMORY_SCOPE_AGENT); }
__device__ __forceinline__ unsigned xb_xcc_id() { return (unsigned)__builtin_amdgcn_s_getreg((3 << 11) | 20) & 0xFu; }
#define XB_SPIN(cond, bar) do { unsigned _sp = 0; while (cond) { __builtin_amdgcn_s_sleep(1); \
    if ((++_sp & 255u) == 0u) { if (xb_ld(&(bar)[XB_TMO])) break; if (_sp > XB_SPIN_CAP) { atomicAdd(&(bar)[XB_TMO], 1u); break; } } } } while (0)

struct XcdBarrier {
    unsigned* bar; unsigned x;
    volatile LAS unsigned* st;
};

__device__ __forceinline__ XcdBarrier xcd_barrier_post(unsigned* bar, volatile LAS unsigned* st) {
    XcdBarrier b; b.bar = bar; b.x = xb_xcc_id(); b.st = st;
    if (threadIdx.x == 0) (void)xb_add(&bar[XB_XCNT(b.x)], 1u);
    return b;
}
__device__ __forceinline__ void xcd_barrier_complete(unsigned* bar, unsigned x, unsigned& nloc, unsigned& nx) {
    const unsigned G = gridDim.x * gridDim.y * gridDim.z;
    unsigned sum, cnt, mine, sp = 0u;
    for (;;) {
        sum = 0u; cnt = 0u; mine = 0u;
#pragma unroll
        for (unsigned j = 0; j < 16; ++j) { const unsigned c = xb_ld(&bar[XB_XCNT(j)]); sum += c; cnt += (c > 0u) ? 1u : 0u; mine = (j == x) ? c : mine; }
        if (sum == G) break;
        __builtin_amdgcn_s_sleep(1);
        if ((++sp & 255u) == 0u) { if (xb_ld(&bar[XB_TMO])) break; if (sp > XB_SPIN_CAP) { atomicAdd(&bar[XB_TMO], 1u); break; } }
    }
    nloc = mine > 0u ? mine : 1u; nx = cnt > 0u ? cnt : 1u;
}

__device__ __forceinline__ void xcd_barrier(const XcdBarrier& b) {
    asm volatile("s_waitcnt vmcnt(0)" ::: "memory");
    __syncthreads();
    if (threadIdx.x == 0) {
        unsigned* bar = b.bar;
        __builtin_amdgcn_s_waitcnt(0);
        unsigned nloc = b.st[0], nx = b.st[1];
        if (nloc == 0u) { xcd_barrier_complete(bar, b.x, nloc, nx); b.st[0] = nloc; b.st[1] = nx; }
        const unsigned old = xb_add(&bar[XB_XSUB(b.x)], 1u);
        const unsigned gen = old / nloc;
        if (old + 1u == (gen + 1u) * nloc) {
            __builtin_amdgcn_fence(__ATOMIC_RELEASE, "agent");
            asm volatile("s_waitcnt vmcnt(0)" ::: "memory");
            const unsigned og = xb_add(&bar[XB_TOP], 1u);
            const unsigned tg = og / nx;
            if (og + 1u == (tg + 1u) * nx) xb_add(&bar[XB_TOPGEN], 1u);
            else XB_SPIN(xb_ld(&bar[XB_TOPGEN]) == tg, bar);
            __builtin_amdgcn_fence(__ATOMIC_ACQUIRE, "agent");
            xb_add(&bar[XB_XGEN(b.x)], 1u);
            asm volatile("s_waitcnt vmcnt(0)" ::: "memory");
        } else {
            XB_SPIN(xb_ld(&bar[XB_XGEN(b.x)]) == gen, bar);
            __builtin_amdgcn_fence(__ATOMIC_ACQUIRE, "agent");
            asm volatile("s_waitcnt vmcnt(0)" ::: "memory");
        }
    }
    __syncthreads();
}

struct Args { const float* in[47]; float* out; unsigned char* ws; int ph_lo, ph_hi; };
typedef const __attribute__((address_space(4))) Args* KArgsP;
__device__ __forceinline__ KArgsP fresh_args() { KArgsP p = (KArgsP)__builtin_amdgcn_kernarg_segment_ptr(); asm volatile("" : "+s"(p)); return p; }
enum { I_X = 0, I_C, I_ADA_W, I_ADA_B, I_NORM_MIX, I_NORM_FFN, I_NORM_FINAL, I_W_IN, I_W_OUT, I_CONV_W, I_CONV_B, I_WQ, I_WK, I_BI, I_BF, I_MNORM_W,
       I_RMU, I_RW0, I_RWUP, I_RA0, I_RAUP, I_RGUP, I_RKK, I_RKA, I_RRK, I_RLNW, I_RLNB, I_RV0, I_RVDN, I_RVUP,
       I_S5ARE, I_S5AIM, I_S5LDT, I_S5BRE, I_S5BIM, I_S5CRE, I_S5CIM, I_S5D, I_S5GLUW, I_S5GLUB,
       I_MWRG, I_MBRG, I_MWRE, I_MBRE, I_MW1, I_MW3, I_MW2 };

struct RmWin { __device__ __forceinline__ int operator()(int n) const { return n < 1152 ? n : (n < 1164 ? 2816 + (n - 1152) : (n < 2572 ? 1152 + (n - 1164) : 2560 + (n - 2572))); } };
struct RmId  { __device__ __forceinline__ int operator()(int n) const { return n; } };
struct RmGU  { int add; __device__ __forceinline__ int operator()(int n) const { return 8 * (n >> 2) + (n & 3) + add; } };
template <class RM>
__device__ __forceinline__ void transpose_item(const float* W, int ldw, int ncols, int k0, int n0, bf16* WT, int ldt, LAS float* scr, int lane, const RM rm) {
    const int nn = n0 + lane; const bool ok = nn < ncols; const float* src = W + (size_t)k0 * ldw + (ok ? nn : n0);
    float v[64];
#pragma unroll
    for (int kk = 0; kk < 64; ++kk) v[kk] = src[(size_t)kk * ldw];
#pragma unroll
    for (int kk = 0; kk < 64; ++kk) scr[kk * 65 + lane] = v[kk];
    LDS_WAIT(); asm volatile("" ::: "memory");
    const int c = lane & 7;
#pragma unroll
    for (int j = 0; j < 8; ++j) { const int nl = (lane >> 3) + 8 * j; const LAS float* s = scr + (8 * c) * 65 + nl;
        v4u o; o.x = pk2(s[0 * 65], s[1 * 65]); o.y = pk2(s[2 * 65], s[3 * 65]); o.z = pk2(s[4 * 65], s[5 * 65]); o.w = pk2(s[6 * 65], s[7 * 65]);
        if (n0 + nl < ncols) *(GAS v4u*)(WT + (size_t)rm(n0 + nl) * ldt + k0 + 8 * c) = o; }
    LDS_WAIT(); asm volatile("" ::: "memory");
}
__device__ __forceinline__ void moe_convert13(const float* w1, const float* w3, int l, bf16* W13, int worker, int nworkers, LAS float* scr, int lane) {
    for (int it = worker; it < NEXP * 256; it += nworkers) {
        const int e = it >> 8, r = it & 255; const size_t eo = (size_t)(l * NEXP + e) * DM * DEXP;
        if (r < 128) transpose_item(w1 + eo, DEXP, DEXP, 64 * (r >> 3), 64 * (r & 7), W13 + (size_t)e * 1024 * 1024, 1024, scr, lane, RmGU{0});
        else         transpose_item(w3 + eo, DEXP, DEXP, 64 * ((r - 128) >> 3), 64 * ((r - 128) & 7), W13 + (size_t)e * 1024 * 1024, 1024, scr, lane, RmGU{4});
    }
}
__device__ __forceinline__ void moe_convert2(const float* w2, int l, bf16* W2T, int worker, int nworkers, LAS float* scr, int lane) {
    for (int it = worker; it < NEXP * 128; it += nworkers) {
        const int e = it >> 7, r = it & 127; const size_t eo = (size_t)(l * NEXP + e) * DM * DEXP;
        transpose_item(w2 + eo, DM, DM, 64 * (r >> 4), 64 * (r & 15), W2T + (size_t)e * 1024 * 512, 512, scr, lane, RmId{});
    }
}
__device__ __forceinline__ void phase_prologue(KArgsP a, LAS unsigned char* lds, int tid, int lane, int wave, int vcu, int G) {
    unsigned char* ws = a->ws;
    LAS float* scr = (LAS float*)(lds + wave * 16640);
    const int gw = vcu * NWAVES + wave, NGW = G * NWAVES;
    bf16* WIN = (bf16*)(ws + WS_WIN); bf16* WOUT = (bf16*)(ws + WS_WOUT);
    for (int it = gw; it < 2 * 16 * 45; it += NGW) { const int l = it / (16 * 45), r = it % (16 * 45);
        transpose_item(a->in[I_W_IN] + (size_t)l * DM * IN_COLS, IN_COLS, IN_COLS, 64 * (r / 45), 64 * (r % 45), WIN + (size_t)l * NPROJ_PAD * DM, DM, scr, lane, RmWin{}); }
    for (int it = gw; it < 2 * 16 * 16; it += NGW) { const int l = it / 256, r = it % 256;
        transpose_item(a->in[I_W_OUT] + (size_t)l * DM * DM, DM, DM, 64 * (r >> 4), 64 * (r & 15), WOUT + (size_t)l * DM * DM, DM, scr, lane, RmId{}); }
    for (int it = gw; it < 2 * 244; it += NGW) { const int l = it / 244, r = 2828 + it % 244; GAS v4u* p = (GAS v4u*)(WIN + ((size_t)l * NPROJ_PAD + r) * DM);
        p[lane] = (v4u){0u, 0u, 0u, 0u}; p[lane + 64] = (v4u){0u, 0u, 0u, 0u}; }
    { float* RTW = (float*)(ws + WS_RTW);
      for (int idx = (vcu * NTHR + tid); idx < 2 * 1024 * 48; idx += G * NTHR) { const int j = idx % 48, k = (idx / 48) % 1024, l = idx / (48 * 1024);
          RTW[(size_t)l * 49152 + ((k >> 2) * 16 + (j & 15)) * 12 + (k & 3) * 3 + (j >> 4)] = j < 4 ? a->in[I_MWRG][(size_t)(l * 1024 + k) * 4 + j] : (j < 36 ? a->in[I_MWRE][(size_t)(l * 1024 + k) * 32 + (j - 4)] : 0.f); } }
    { bf16* RW = (bf16*)(ws + WS_R1W);
      for (int idx = (vcu * NTHR + tid); idx < 2 * 98304 + 24576; idx += G * NTHR) { float v;
          if (idx < 2 * 98304) { const int l = idx / 98304, r = idx % 98304;
              if (r < 24576)      v = a->in[I_RWUP][(size_t)l * 64 * DBR + (r & 63) * DBR + (r >> 6)];
              else if (r < 49152) v = a->in[I_RAUP][(size_t)l * 64 * DBR + ((r - 24576) & 63) * DBR + ((r - 24576) >> 6)];
              else                v = a->in[I_RGUP][(size_t)l * 128 * DBR + ((r - 49152) & 127) * DBR + ((r - 49152) >> 7)];
          } else { const int r = idx - 2 * 98304;
              if (r < 12288) v = a->in[I_RVDN][(size_t)(r % 384) * 32 + (r / 384)];
              else           v = a->in[I_RVUP][(size_t)((r - 12288) & 31) * DBR + ((r - 12288) >> 5)]; }
          RW[idx] = (bf16)f2bf(v); } }
    for (int idx = (vcu * NTHR + tid); idx < 2 * 16 * 64; idx += G * NTHR) { const int p = idx & 63, lg = idx >> 6;
        const float lam_re = a->in[I_S5ARE][idx], lam_im = a->in[I_S5AIM][idx]; const float dt = expf(a->in[I_S5LDT][lg]); const float mag = expf(lam_re * dt), ang = lam_im * dt;
        const float are = mag * cosf(ang), aim = mag * sinf(ang); const float inv = 1.f / (lam_re * lam_re + lam_im * lam_im);
        const float cre = ((are - 1.f) * lam_re + aim * lam_im) * inv, cim = (aim * lam_re - (are - 1.f) * lam_im) * inv;
        ((float*)(ws + WS_S5AP))[idx * 2] = are; ((float*)(ws + WS_S5AP))[idx * 2 + 1] = aim;
        const float* br = a->in[I_S5BRE] + (size_t)idx * 16; const float* bi = a->in[I_S5BIM] + (size_t)idx * 16; bf16* o = (bf16*)(ws + WS_S5BB) + ((size_t)lg * 128 + 2 * p) * 16;
        for (int c = 0; c < 16; ++c) { o[c] = (bf16)f2bf(cre * br[c] - cim * bi[c]); o[16 + c] = (bf16)f2bf(cre * bi[c] + cim * br[c]); } }
    { bf16* CM = (bf16*)(ws + WS_S5CM);
      for (int idx = (vcu * NTHR + tid); idx < 2 * 16 * 16 * 128; idx += G * NTHR) { const int k = idx & 127, lgc = idx >> 7;
          CM[idx] = (bf16)f2bf((k & 1) ? -a->in[I_S5CIM][(size_t)lgc * 64 + (k >> 1)] : a->in[I_S5CRE][(size_t)lgc * 64 + (k >> 1)]); } }
    for (int it = gw; it < 2 * 16; it += NGW) { const int l = it >> 4, r = it & 15;
        transpose_item(a->in[I_S5GLUW] + (size_t)l * DC * DC, DC, DC, 64 * (r >> 2), 64 * (r & 3), (bf16*)(ws + WS_GLUT) + (size_t)l * DC * DC, DC, scr, lane, RmId{}); }
    { bf16* MLW = (bf16*)(ws + WS_MLW);
      for (int idx = (vcu * NTHR + tid); idx < 2 * NH * 2 * 4096; idx += G * NTHR) { const int d = idx & 63, e = (idx >> 6) & 63, which = (idx >> 12) & 1, lh = idx >> 13;
          MLW[idx] = (bf16)f2bf(a->in[which ? I_WK : I_WQ][(size_t)lh * 4096 + d * 64 + e]); } }
    __syncthreads();
    if (vcu < 192) {
        const int q = vcu, l = q / 96, cb = (q >> 3) % 12, kc = q & 7;
        LAS float* cond = (LAS float*)lds;
        { const int b = tid >> 7, kk = tid & 127; const float cv = a->in[I_C][b * DM + kc * 128 + kk]; cond[tid] = cv / (1.f + __expf(-cv)); }
        __syncthreads();
        const int col = cb * 512 + tid; const float* wp = a->in[I_ADA_W] + ((size_t)l * DM + kc * 128) * 6144 + col;
        float acc0 = 0.f, acc1 = 0.f, acc2 = 0.f, acc3 = 0.f;
#pragma unroll 8
        for (int kk = 0; kk < 128; ++kk) { const float w = wp[(size_t)kk * 6144]; acc0 += cond[kk] * w; acc1 += cond[128 + kk] * w; acc2 += cond[256 + kk] * w; acc3 += cond[384 + kk] * w; }
        const float bias = (kc == 0) ? a->in[I_ADA_B][l * 6144 + col] : 0.f;
        float* MP = (float*)(ws + WS_MODP) + ((size_t)(kc * 2 + l) * 4) * 6144 + col;
        MP[0] = acc0 + bias; MP[6144] = acc1 + bias; MP[2 * 6144] = acc2 + bias; MP[3 * 6144] = acc3 + bias;
    }
}

__device__ __forceinline__ float modval(const unsigned char* ws, bool part, int l, int b, int idx) {
    if (!part) return ((const float*)(ws + WS_MODF))[(size_t)(l * 4 + b) * 6144 + idx];
    const float* mp = (const float*)(ws + WS_MODP) + (size_t)(l * 4 + b) * 6144 + idx; float s = 0.f;
#pragma unroll
    for (int kc = 0; kc < 8; ++kc) s += mp[(size_t)kc * 2 * 4 * 6144];
    return s;
}
template <int MODE, bool COMBINE>
__device__ __forceinline__ void phase_rownorm(KArgsP a, LAS unsigned char* lds, int tid, int lane, int wave, int G,
                                              const float* xsrc, float* xdst, const float* gvec, bool part, int l, int isc  , int lprev) {
    unsigned char* ws = a->ws;
    LAS float* sc = (LAS float*)lds; LAS float* sh = sc + 1024; LAS float* gt = sh + 1024;
    bf16* HN = (bf16*)(ws + WS_HN); const bf16* YM = (const bf16*)(ws + WS_YMOE); const float* TW = (const float*)(ws + WS_TOKW);
    for (int c = blockIdx.x; c < NTOK / 128; c += G) {
        const int b = c >> 6;
        __syncthreads();
        for (int j = tid; j < 1024; j += NTHR) {
            if (MODE == 0) { sc[j] = gvec[j] * (1.f + modval(ws, part, l, b, (isc + 1) * 1024 + j)); sh[j] = modval(ws, part, l, b, isc * 1024 + j); }
            else { sc[j] = gvec[j]; sh[j] = 0.f; }
            if (COMBINE) gt[j] = 1.f + modval(ws, false, lprev, b, 5 * 1024 + j);
        }
        __syncthreads();
        f32x4 vn[4]; v2u yn0[4], yn1[4]; float wn0 = 0.f, wn1 = 0.f;
        { const int row = c * 128 + wave * 16; const GAS f32x4* xr = (const GAS f32x4*)(xsrc + (size_t)row * DM) + lane;
#pragma unroll
          for (int j = 0; j < 4; ++j) vn[j] = xr[64 * j];
          if (COMBINE) { wn0 = TW[2 * row]; wn1 = TW[2 * row + 1]; const GAS v2u* y0 = (const GAS v2u*)(YM + (size_t)(2 * row) * DM) + lane; const GAS v2u* y1 = (const GAS v2u*)(YM + (size_t)(2 * row + 1) * DM) + lane;
#pragma unroll
              for (int j = 0; j < 4; ++j) { yn0[j] = y0[64 * j]; yn1[j] = y1[64 * j]; } } }
        for (int i = 0; i < 16; ++i) {
            const int row = c * 128 + wave * 16 + i;
            f32x4 v[4]; v2u q0[4], q1[4]; const float w0 = wn0, w1 = wn1;
#pragma unroll
            for (int j = 0; j < 4; ++j) { v[j] = vn[j]; q0[j] = yn0[j]; q1[j] = yn1[j]; }
            if (i + 1 < 16) { const int rn = row + 1; const GAS f32x4* xr = (const GAS f32x4*)(xsrc + (size_t)rn * DM) + lane;
#pragma unroll
                for (int j = 0; j < 4; ++j) vn[j] = xr[64 * j];
                if (COMBINE) { wn0 = TW[2 * rn]; wn1 = TW[2 * rn + 1]; const GAS v2u* y0 = (const GAS v2u*)(YM + (size_t)(2 * rn) * DM) + lane; const GAS v2u* y1 = (const GAS v2u*)(YM + (size_t)(2 * rn + 1) * DM) + lane;
#pragma unroll
                    for (int j = 0; j < 4; ++j) { yn0[j] = y0[64 * j]; yn1[j] = y1[64 * j]; } } }
            if (COMBINE) {
#pragma unroll
                for (int j = 0; j < 4; ++j) { const v2u p0 = q0[j], p1 = q1[j]; const f32x4 g4 = *(const LAS f32x4*)(gt + lane * 4 + 256 * j);
                    f32x4 m; m.x = w0 * bflo(p0.x) + w1 * bflo(p1.x); m.y = w0 * bfhi(p0.x) + w1 * bfhi(p1.x); m.z = w0 * bflo(p0.y) + w1 * bflo(p1.y); m.w = w0 * bfhi(p0.y) + w1 * bfhi(p1.y);
                    v[j] = v[j] + g4 * m; }
                if (MODE == 0) { GAS f32x4* xo = (GAS f32x4*)(xdst + (size_t)row * DM) + lane;
#pragma unroll
                    for (int j = 0; j < 4; ++j) xo[64 * j] = v[j]; }
            }
            float ss = 0.f;
#pragma unroll
            for (int j = 0; j < 4; ++j) ss += (v[j].x * v[j].x + v[j].y * v[j].y) + (v[j].z * v[j].z + v[j].w * v[j].w);
            const float rstd = rsqrtf(wave_sum(ss) * (1.f / DM) + NORM_EPS);
            if (MODE == 0) {
                GAS v2u* o = (GAS v2u*)(HN + (size_t)row * DM) + lane;
#pragma unroll
                for (int j = 0; j < 4; ++j) { const f32x4 s4 = *(const LAS f32x4*)(sc + lane * 4 + 256 * j), h4 = *(const LAS f32x4*)(sh + lane * 4 + 256 * j); const f32x4 h = v[j] * rstd * s4 + h4;
                    v2u w; w.x = pk2(h.x, h.y); w.y = pk2(h.z, h.w); o[64 * j] = w; }
            } else {
                GAS f32x4* o = (GAS f32x4*)(xdst + (size_t)row * DM) + lane;
#pragma unroll
                for (int j = 0; j < 4; ++j) { const f32x4 s4 = *(const LAS f32x4*)(sc + lane * 4 + 256 * j); o[64 * j] = v[j] * rstd * s4; }
            }
        }
    }
}
__device__ __forceinline__ void mod_finalize(unsigned char* ws, int tid, int G) {
    float* MF = (float*)(ws + WS_MODF);
    for (int idx = blockIdx.x * NTHR + tid; idx < 2 * 4 * 6144; idx += G * NTHR) { const float* mp = (const float*)(ws + WS_MODP) + idx; float s = 0.f;
#pragma unroll
        for (int kc = 0; kc < 8; ++kc) s += mp[(size_t)kc * 2 * 4 * 6144];
        MF[idx] = s; }
}

typedef float f32x4m __attribute__((ext_vector_type(4)));
__device__ __forceinline__ void phase_router(KArgsP a, LAS unsigned char* lds, int tid, int lane, int wave, int G, int l) {
    unsigned char* ws = a->ws;
    LAS float* sc = (LAS float*)lds; LAS float* sh = sc + 1024; LAS float* rstd_s = sh + 1024  ; LAS float* cvec = rstd_s + 128  ; LAS float* cpart = cvec + 64  ;
    LAS float* lg = cpart + 8 * 48  ; LAS int* hist = (LAS int*)(lg + 8 * 16 * 48)  ; LAS int* basev = hist + 32; LAS int* asg_e = basev + 32  ; LAS int* asg_lp = asg_e + 256;
    bf16* HN = (bf16*)(ws + WS_HN); const float* x = a->out; const float* RTW = (const float*)(ws + WS_RTW) + (size_t)l * 1024 * 48;
    int* TOKE = (int*)(ws + WS_TOKE); float* TOKW = (float*)(ws + WS_TOKW); int* LIST = (int*)(ws + WS_LIST); unsigned* CNT = (unsigned*)(ws + WS_CTL) + CW_CNT + l * 32;
    const float* gvec = a->in[I_NORM_FFN] + l * DM;
    for (int c = blockIdx.x; c < NTOK / 128; c += G) {
        const int b = c >> 6;
        __syncthreads();
        for (int j = tid; j < 1024; j += NTHR) { sc[j] = gvec[j] * (1.f + modval(ws, false, l, b, 4 * 1024 + j)); sh[j] = modval(ws, false, l, b, 3 * 1024 + j); }
        if (tid < 32) hist[tid] = 0;
        __syncthreads();
        if (tid < 384) { const int j = tid % 48, part = tid / 48; float s = 0.f;
            for (int k = part * 128; k < part * 128 + 128; ++k) s += sh[k] * RTW[((k >> 2) * 16 + (j & 15)) * 12 + (k & 3) * 3 + (j >> 4)];
            cpart[part * 48 + j] = s; }
        { f32x4 vn[4];
          { const GAS f32x4* xr = (const GAS f32x4*)(x + (size_t)(c * 128 + wave * 16) * DM) + lane;
#pragma unroll
            for (int j = 0; j < 4; ++j) vn[j] = xr[64 * j]; }
          for (int i = 0; i < 16; ++i) {
            const int row = c * 128 + wave * 16 + i;
            f32x4 v[4]; float ss = 0.f;
#pragma unroll
            for (int j = 0; j < 4; ++j) { v[j] = vn[j]; ss += (v[j].x * v[j].x + v[j].y * v[j].y) + (v[j].z * v[j].z + v[j].w * v[j].w); }
            if (i + 1 < 16) { const GAS f32x4* xr = (const GAS f32x4*)(x + (size_t)(row + 1) * DM) + lane;
#pragma unroll
                for (int j = 0; j < 4; ++j) vn[j] = xr[64 * j]; }
            const float rstd = rsqrtf(wave_sum(ss) * (1.f / DM) + NORM_EPS);
            if (lane == 0) rstd_s[wave * 16 + i] = rstd;
            GAS v2u* o = (GAS v2u*)(HN + (size_t)row * DM) + lane;
#pragma unroll
            for (int j = 0; j < 4; ++j) { const f32x4 s4 = *(const LAS f32x4*)(sc + lane * 4 + 256 * j), h4 = *(const LAS f32x4*)(sh + lane * 4 + 256 * j); const f32x4 h = v[j] * rstd * s4 + h4;
                v2u w; w.x = pk2(h.x, h.y); w.y = pk2(h.z, h.w); o[64 * j] = w; }
          } }
        __syncthreads();
        if (tid < 48) { float s = 0.f;
#pragma unroll
            for (int p = 0; p < 8; ++p) s += cpart[p * 48 + tid];
            s += tid < 4 ? a->in[I_MBRG][l * 4 + tid] : (tid < 36 ? a->in[I_MBRE][l * 32 + tid - 4] : 0.f); cvec[tid] = s; }
        {
            const int i16 = lane & 15, kq = lane >> 4, r0 = c * 128 + wave * 16;
            f32x4m acc0 = {0.f, 0.f, 0.f, 0.f}, acc1 = acc0, acc2 = acc0;
            const float* xrow = x + (size_t)(r0 + i16) * DM + 4 * kq;
#pragma unroll 4
            for (int k0 = 0; k0 < DM; k0 += 16) {
                const f32x4 xv = *(const GAS f32x4*)(xrow + k0); const f32x4 sv = *(const LAS f32x4*)(sc + k0 + 4 * kq);
                const GAS f32x4* wp = (const GAS f32x4*)(RTW + (size_t)(((k0 >> 2) + kq) * 16 + i16) * 12);
                const f32x4 w0 = wp[0], w1 = wp[1], w2 = wp[2]; const float wf[12] = {w0[0], w0[1], w0[2], w0[3], w1[0], w1[1], w1[2], w1[3], w2[0], w2[1], w2[2], w2[3]};
#pragma unroll
                for (int j = 0; j < 4; ++j) { const float av = xv[j] * sv[j];
                    acc0 = __builtin_amdgcn_mfma_f32_16x16x4f32(av, wf[j * 3], acc0, 0, 0, 0);
                    acc1 = __builtin_amdgcn_mfma_f32_16x16x4f32(av, wf[j * 3 + 1], acc1, 0, 0, 0);
                    acc2 = __builtin_amdgcn_mfma_f32_16x16x4f32(av, wf[j * 3 + 2], acc2, 0, 0, 0); }
            }
            __syncthreads();
            LAS float* lw = lg + wave * 16 * 48;
#pragma unroll
            for (int r = 0; r < 4; ++r) { const int rr = 4 * kq + r; const float rs = rstd_s[wave * 16 + rr];
                lw[rr * 48 + i16] = acc0[r] * rs + cvec[i16]; lw[rr * 48 + 16 + i16] = acc1[r] * rs + cvec[16 + i16]; lw[rr * 48 + 32 + i16] = acc2[r] * rs + cvec[32 + i16]; }
            LDS_WAIT(); asm volatile("" ::: "memory");
            if (lane < 16) {
                const LAS float* lr = lw + lane * 48; const int row = r0 + lane;
                float g0 = lr[0], g1 = lr[1], g2 = lr[2], g3 = lr[3]; const float gm = fmaxf(fmaxf(g0, g1), fmaxf(g2, g3));
                float p0 = __expf(g0 - gm), p1 = __expf(g1 - gm), p2 = __expf(g2 - gm), p3 = __expf(g3 - gm); const float inv = 1.f / (p0 + p1 + p2 + p3);
                p0 *= inv; p1 *= inv; p2 *= inv; p3 *= inv;
                int gi = 0; float gp = p0; if (p1 > gp) { gp = p1; gi = 1; } if (p2 > gp) { gp = p2; gi = 2; } if (p3 > gp) { gp = p3; gi = 3; }
                float ev0 = -3.4e38f, ev1 = -3.4e38f; int e0 = 0, e1 = 0;
#pragma unroll
                for (int j = 0; j < 8; ++j) { const float s = lr[4 + gi * 8 + j]; if (s > ev0) { ev1 = ev0; e1 = e0; ev0 = s; e0 = j; } else if (s > ev1) { ev1 = s; e1 = j; } }
                const float q = __expf(ev1 - ev0), w0 = gp / (1.f + q), w1 = gp * q / (1.f + q);
                e0 += gi * 8; e1 += gi * 8;
                TOKE[2 * row] = e0; TOKE[2 * row + 1] = e1; TOKW[2 * row] = w0; TOKW[2 * row + 1] = w1;
                const int a0 = 2 * (wave * 16 + lane);
                asg_e[a0] = e0; asg_e[a0 + 1] = e1; asg_lp[a0] = atomicAdd((int*)&hist[e0], 1); asg_lp[a0 + 1] = atomicAdd((int*)&hist[e1], 1);
            }
        }
        __syncthreads();
        if (tid < 32) { const int h = hist[tid]; basev[tid] = h ? (int)atomicAdd(CNT + tid, (unsigned)h) : 0; }
        __syncthreads();
        if (tid < 256) { const int e = asg_e[tid]; LIST[(size_t)e * 65536 + basev[e] + asg_lp[tid]] = (c * 128) * 2 + tid; }
    }
}
__device__ __forceinline__ void build_ptab(const unsigned* CNT, LAS int* ptab, LAS int* pst, LAS int* cnt, int tid) {
    __syncthreads();
    if (tid == 0) { int np = 0;
        for (int e = 0; e < NEXP; ++e) { const int ce = (int)__hip_atomic_load(CNT + e, RLX_AGENT); cnt[e] = ce; pst[e] = np * 256; const int pe = (ce + 255) >> 8;
            for (int p = 0; p < pe; ++p) ptab[1 + np + p] = e;
            np += pe; }
        ptab[0] = np; }
    __syncthreads();
}
__device__ __forceinline__ void phase_gather(KArgsP a, LAS unsigned char* lds, int tid, int lane, int wave, int vcu, int G, int l) {
    unsigned char* ws = a->ws;
    LAS int* ptab = (LAS int*)lds; LAS int* pst = ptab + 512; LAS int* cnt = pst + 32;
    build_ptab((const unsigned*)(ws + WS_CTL) + CW_CNT + l * 32, ptab, pst, cnt, tid);
    const bf16* HN = (const bf16*)(ws + WS_HN); bf16* XG = (bf16*)(ws + WS_XG); int* ROWMAP = (int*)(ws + WS_ROWMAP); const int* LIST = (const int*)(ws + WS_LIST);
    const int nrows = ptab[0] * 256;
    for (int row0 = (vcu * NWAVES + wave) * 8; row0 < nrows; row0 += G * NWAVES * 8) {
        int tok2[8]; v4u p0[8], p1[8];
#pragma unroll
        for (int j = 0; j < 8; ++j) { const int row = row0 + j, e = ptab[1 + (row >> 8)], pos = row - pst[e]; tok2[j] = (pos < cnt[e]) ? LIST[(size_t)e * 65536 + pos] : -1; }
#pragma unroll
        for (int j = 0; j < 8; ++j) { if (tok2[j] >= 0) { const GAS v4u* s = (const GAS v4u*)(HN + (size_t)(tok2[j] >> 1) * DM) + lane; p0[j] = s[0]; p1[j] = s[64]; } else { p0[j] = (v4u){0u, 0u, 0u, 0u}; p1[j] = p0[j]; } }
#pragma unroll
        for (int j = 0; j < 8; ++j) { GAS v4u* d = (GAS v4u*)(XG + (size_t)(row0 + j) * DM) + lane; d[0] = p0[j]; d[64] = p1[j]; if (lane == 0) ROWMAP[row0 + j] = tok2[j]; }
    }
}

__device__ __forceinline__ void phase_rowmap(KArgsP a, LAS unsigned char* lds, int tid, int vcu, int G, int l) {
    unsigned char* ws = a->ws;
    LAS int* ptab = (LAS int*)lds; LAS int* pst = ptab + 512; LAS int* cnt = pst + 32;
    build_ptab((const unsigned*)(ws + WS_CTL) + CW_CNT + l * 32, ptab, pst, cnt, tid);
    int* ROWMAP = (int*)(ws + WS_ROWMAP); const int* LIST = (const int*)(ws + WS_LIST);
    const int nrows = ptab[0] * 256;
    for (int row = vcu * NTHR + tid; row < nrows; row += G * NTHR) { const int e = ptab[1 + (row >> 8)], pos = row - pst[e]; ROWMAP[row] = (pos < cnt[e]) ? LIST[(size_t)e * 65536 + pos] : -1; }
}

typedef short bf16x8 __attribute__((ext_vector_type(8)));
constexpr int MT = 72;
constexpr int ML_XP = 0;
constexpr int ML_CX = 17152;
constexpr int ML_WQ = ML_CX + 9216, ML_WK = ML_WQ + 9216;
constexpr int ML_Q = ML_WK + 9216, ML_K = ML_Q + 9216;
constexpr int ML_S = ML_K + 9216;
constexpr int ML_VT = ML_S + 9216;
constexpr int ML_CT = ML_VT + 11520;
constexpr int ML_H = ML_CT + 11520;
constexpr int ML_SM = ML_H + 16640;
static_assert(ML_SM + 2048 <= RING_BYTES, "mLSTM LDS map");
__device__ __forceinline__ float logsigmoidf_(float x) { return fminf(x, 0.f) - log1pf(__expf(-fabsf(x))); }
__device__ __forceinline__ void mma64(const LAS bf16* A, int arow0, const LAS bf16* Bt, int brow0, int lane, f32x4& acc) {
    const LAS bf16* ap = A + (arow0 + (lane & 15)) * MT + 8 * (lane >> 4); const LAS bf16* bp = Bt + (brow0 + (lane & 15)) * MT + 8 * (lane >> 4);
    const bf16x8 a0 = *(const LAS bf16x8*)ap, a1 = *(const LAS bf16x8*)(ap + 32), b0 = *(const LAS bf16x8*)bp, b1 = *(const LAS bf16x8*)(bp + 32);
    acc = __builtin_amdgcn_mfma_f32_16x16x32_bf16(a0, b0, acc, 0, 0, 0); acc = __builtin_amdgcn_mfma_f32_16x16x32_bf16(a1, b1, acc, 0, 0, 0);
}
__device__ __forceinline__ void ml_front(KArgsP a, LAS unsigned char* lds, int tid, int l, int b, int c, int h, bool want_q) {
    const bf16* PROJ = (const bf16*)(a->ws + WS_PROJ); const size_t row0 = (size_t)b * SEQ + c * 64;
    LAS float* xp = (LAS float*)(lds + ML_XP);
    for (int idx = tid; idx < 67 * 8; idx += NTHR) { const int r = idx >> 3, c8 = idx & 7, tr = c * 64 + r - 3; LAS float* d = xp + r * 64 + c8 * 8;
        if (tr >= 0) { const v4u p = *(const GAS v4u*)(PROJ + ((size_t)b * SEQ + tr) * NPROJ + PC_QK + h * 64 + c8 * 8);
            *(LAS f32x4*)d = (f32x4){bflo(p.x), bfhi(p.x), bflo(p.y), bfhi(p.y)}; *(LAS f32x4*)(d + 4) = (f32x4){bflo(p.z), bfhi(p.z), bflo(p.w), bfhi(p.w)}; }
        else { *(LAS f32x4*)d = (f32x4){0.f, 0.f, 0.f, 0.f}; *(LAS f32x4*)(d + 4) = (f32x4){0.f, 0.f, 0.f, 0.f}; } }
    {
        const int t = tid >> 3, vg = tid & 7; LAS bf16* VT = (LAS bf16*)(lds + ML_VT);
        const v4u p = *(const GAS v4u*)(PROJ + (row0 + t) * NPROJ + PC_V + h * 64 + vg * 8);
        const unsigned w[4] = {p.x, p.y, p.z, p.w};
#pragma unroll
        for (int j = 0; j < 4; ++j) { VT[(vg * 8 + 2 * j) * MT + t] = (bf16)(w[j] & 0xffffu); VT[(vg * 8 + 2 * j + 1) * MT + t] = (bf16)(w[j] >> 16); }
        for (int idx = tid; idx < 16 * 64; idx += NTHR) VT[(64 + (idx >> 6)) * MT + (idx & 63)] = (idx < 64) ? (bf16)0x3F80 : (bf16)0;
        const bf16* WT = (const bf16*)(a->ws + WS_MLW) + (size_t)((l * NH + h) * 2) * 4096;
        const int e = tid >> 3, d8 = tid & 7;
        if (want_q) *(LAS v4u*)(lds + ML_WQ + (e * MT + d8 * 8) * 2) = *(const GAS v4u*)(WT + e * 64 + d8 * 8);
        *(LAS v4u*)(lds + ML_WK + (e * MT + d8 * 8) * 2) = *(const GAS v4u*)(WT + 4096 + e * 64 + d8 * 8);
    }
    __syncthreads();
    const float* cw = a->in[I_CONV_W] + (size_t)l * 4 * DA + h * 64; const float* cb = a->in[I_CONV_B] + (size_t)l * DA + h * 64;
    {
        const int t = tid >> 3, c8 = (tid & 7) * 8; float s[8];
#pragma unroll
        for (int j = 0; j < 8; ++j) s[j] = cb[c8 + j];
#pragma unroll
        for (int q = 0; q < 4; ++q) { const f32x4 x0 = *(const LAS f32x4*)(xp + (t + q) * 64 + c8), x1 = *(const LAS f32x4*)(xp + (t + q) * 64 + c8 + 4); const float* w = cw + q * DA + c8;
            s[0] += x0.x * w[0]; s[1] += x0.y * w[1]; s[2] += x0.z * w[2]; s[3] += x0.w * w[3]; s[4] += x1.x * w[4]; s[5] += x1.y * w[5]; s[6] += x1.z * w[6]; s[7] += x1.w * w[7]; }
#pragma unroll
        for (int j = 0; j < 8; ++j) s[j] = s[j] / (1.f + __expf(-s[j]));
        v4u o; o.x = pk2(s[0], s[1]); o.y = pk2(s[2], s[3]); o.z = pk2(s[4], s[5]); o.w = pk2(s[6], s[7]);
        *(LAS v4u*)(lds + ML_CX + (t * MT + c8) * 2) = o;
    }
}
__device__ __forceinline__ void phase_m1(KArgsP a, LAS unsigned char* lds, int tid, int lane, int wave, int vcu, int G, int l) {
    unsigned char* ws = a->ws; const float* GT = (const float*)(ws + WS_GATES);
    float* CLOC = (float*)(ws + WS_CLOC); float* MLG = (float*)(ws + WS_MSC); float* MLM = MLG + 4096;
    LAS float* sm = (LAS float*)(lds + ML_SM);
    for (int u = vcu; u < NUNIT_M; u += G) {
        const int h = u % NH, c = (u / NH) % NCH, b = u / (NH * NCH); const size_t row0 = (size_t)b * SEQ + c * 64;
        __syncthreads();
        ml_front(a, lds, tid, l, b, c, h, false);
        if (wave == 0) {
            const float ig = GT[(row0 + lane) * 16 + h] + a->in[I_BI][l * NH + h];
            const float fl = logsigmoidf_(GT[(row0 + lane) * 16 + 6 + h] + a->in[I_BF][l * NH + h]);
            float bc = fl;
#pragma unroll
            for (int o = 1; o < 64; o <<= 1) { const float t = __shfl_up(bc, o); if (lane >= o) bc += t; }
            const float gtot = __shfl(bc, 63); const float lw = gtot - bc + ig; const float ml = wave_max(lw);
            sm[lane] = __expf(lw - ml);
            if (lane == 0) { MLG[u] = gtot; MLM[u] = ml; }
        }
        __syncthreads();
        {
            const int rt = wave >> 1; LAS bf16* KT = (LAS bf16*)(lds + ML_K);
#pragma unroll
            for (int q = 0; q < 2; ++q) { const int ct = 2 * (wave & 1) + q; f32x4 acc = {0.f, 0.f, 0.f, 0.f};
                mma64((const LAS bf16*)(lds + ML_CX), 16 * rt, (const LAS bf16*)(lds + ML_WK), 16 * ct, lane, acc);
                const int t0 = 16 * rt + 4 * (lane >> 4), e = 16 * ct + (lane & 15);
                const float w0 = sm[t0] * 0.125f, w1 = sm[t0 + 1] * 0.125f, w2 = sm[t0 + 2] * 0.125f, w3 = sm[t0 + 3] * 0.125f;
                v2u o; o.x = pk2(acc[0] * w0, acc[1] * w1); o.y = pk2(acc[2] * w2, acc[3] * w3);
                *(LAS v2u*)(KT + e * MT + t0) = o; }
        }
        __syncthreads();
        {
            const int ct = wave & 3, r_lo = wave < 4 ? 0 : 3, r_hi = wave < 4 ? 3 : 5; float* cl = CLOC + (size_t)u * CL_STRIDE;
            for (int rt = r_lo; rt < r_hi; ++rt) { f32x4 acc = {0.f, 0.f, 0.f, 0.f};
                mma64((const LAS bf16*)(lds + ML_VT), 16 * rt, (const LAS bf16*)(lds + ML_K), 16 * ct, lane, acc);
                const int v0 = 16 * rt + 4 * (lane >> 4), e = 16 * ct + (lane & 15);
                if (rt < 4) {
#pragma unroll
                    for (int r = 0; r < 4; ++r) cl[(v0 + r) * 64 + e] = acc[r];
                } else if ((lane >> 4) == 0) cl[4096 + e] = acc[0]; }
        }
    }
}
__device__ __forceinline__ void phase_m2(unsigned char* ws, int tid, int wg, int nwg) {
    float* CLOC = (float*)(ws + WS_CLOC); const float* MLG = (const float*)(ws + WS_MSC); const float* MLM = MLG + 4096; float* MST = (float*)(ws + WS_MSC) + 8192;
    for (int idx = wg * NTHR + tid; idx < NB * NH * CL_STRIDE; idx += nwg * NTHR) {
        const int e = idx % CL_STRIDE, bh = idx / CL_STRIDE, b = bh / NH, h = bh % NH;
        float m = 0.f, cs = 0.f;
        for (int c0 = 0; c0 < NCH; c0 += 8) {
            float cl[8], g[8], ml[8];
#pragma unroll
            for (int j = 0; j < 8; ++j) { const int u = (b * NCH + c0 + j) * NH + h; cl[j] = CLOC[(size_t)u * CL_STRIDE + e]; g[j] = MLG[u]; ml[j] = MLM[u]; }
#pragma unroll
            for (int j = 0; j < 8; ++j) { const int u = (b * NCH + c0 + j) * NH + h;
                CLOC[(size_t)u * CL_STRIDE + e] = cs; if (e == 0) MST[u] = m;
                const float mn = fmaxf(g[j] + m, ml[j]); const float ao = __expf(g[j] + m - mn), al = __expf(ml[j] - mn);
                cs = ao * cs + al * cl[j]; m = mn; }
        }
    }
}
__device__ __forceinline__ void phase_m3(KArgsP a, LAS unsigned char* lds, int tid, int lane, int wave, int vcu, int G, int l) {
    unsigned char* ws = a->ws; const bf16* PROJ = (const bf16*)(ws + WS_PROJ); const float* GT = (const float*)(ws + WS_GATES);
    const float* CLOC = (const float*)(ws + WS_CLOC); const float* MST = (const float*)(ws + WS_MSC) + 8192; bf16* YC = (bf16*)(ws + WS_YC);
    LAS float* sm = (LAS float*)(lds + ML_SM); LAS float* hb = (LAS float*)(lds + ML_H);
    for (int u = vcu; u < NUNIT_M; u += G) {
        const int h = u % NH, c = (u / NH) % NCH, b = u / (NH * NCH); const size_t row0 = (size_t)b * SEQ + c * 64;
        __syncthreads();
        ml_front(a, lds, tid, l, b, c, h, true);
        {
            const float* cl = CLOC + (size_t)u * CL_STRIDE; LAS bf16* CT = (LAS bf16*)(lds + ML_CT);
            for (int idx = tid; idx < 65 * 16; idx += NTHR) { const int r = idx >> 4, c4 = idx & 15; const f32x4 v = *(const GAS f32x4*)(cl + r * 64 + c4 * 4);
                v2u o; o.x = pk2(v.x, v.y); o.y = pk2(v.z, v.w); *(LAS v2u*)(CT + r * MT + c4 * 4) = o; }
            for (int idx = tid; idx < 15 * 64; idx += NTHR) CT[(65 + (idx >> 6)) * MT + (idx & 63)] = 0;
        }
        if (wave == 0) {
            const float ig = GT[(row0 + lane) * 16 + h] + a->in[I_BI][l * NH + h];
            const float fl = logsigmoidf_(GT[(row0 + lane) * 16 + 6 + h] + a->in[I_BF][l * NH + h]);
            float bc = fl;
#pragma unroll
            for (int o = 1; o < 64; o <<= 1) { const float t = __shfl_up(bc, o); if (lane >= o) bc += t; }
            float pm = ig - bc;
#pragma unroll
            for (int o = 1; o < 64; o <<= 1) { const float t = __shfl_up(pm, o); if (lane >= o) pm = fmaxf(pm, t); }
            const float mst = MST[u]; const float inter = bc + mst, mt = fmaxf(inter, bc + pm);
            sm[lane] = ig - bc; sm[64 + lane] = bc - mt; sm[128 + lane] = __expf(inter - mt); sm[192 + lane] = __expf(-mt);
        }
        __syncthreads();
        {
            const int rt = wave >> 1; LAS bf16* Qs = (LAS bf16*)(lds + ML_Q); LAS bf16* Ks = (LAS bf16*)(lds + ML_K);
#pragma unroll
            for (int q = 0; q < 2; ++q) { const int ct = 2 * (wave & 1) + q; f32x4 aq = {0.f, 0.f, 0.f, 0.f}, ak = {0.f, 0.f, 0.f, 0.f};
                mma64((const LAS bf16*)(lds + ML_CX), 16 * rt, (const LAS bf16*)(lds + ML_WQ), 16 * ct, lane, aq);
                mma64((const LAS bf16*)(lds + ML_CX), 16 * rt, (const LAS bf16*)(lds + ML_WK), 16 * ct, lane, ak);
                const int t0 = 16 * rt + 4 * (lane >> 4), e = 16 * ct + (lane & 15);
#pragma unroll
                for (int r = 0; r < 4; ++r) { Qs[(t0 + r) * MT + e] = (bf16)f2bf(aq[r]); Ks[(t0 + r) * MT + e] = (bf16)f2bf(ak[r] * 0.125f); } }
        }
        __syncthreads();
        {
            const int rt = wave >> 1; LAS bf16* Ss = (LAS bf16*)(lds + ML_S);
#pragma unroll
            for (int q = 0; q < 2; ++q) { const int ct = 2 * (wave & 1) + q; f32x4 acc = {0.f, 0.f, 0.f, 0.f};
                if (ct <= rt) mma64((const LAS bf16*)(lds + ML_Q), 16 * rt, (const LAS bf16*)(lds + ML_K), 16 * ct, lane, acc);
                const int t0 = 16 * rt + 4 * (lane >> 4), s = 16 * ct + (lane & 15); const float qs = sm[s];
#pragma unroll
                for (int r = 0; r < 4; ++r) { const int t = t0 + r; Ss[t * MT + s] = (bf16)f2bf((s <= t) ? acc[r] * __expf(sm[64 + t] + qs) : 0.f); } }
        }
        __syncthreads();
        {
            const int rt = wave >> 1, nt = (wave & 1) ? 2 : 3;
            for (int q = 0; q < nt; ++q) { const int ct = (wave & 1) ? 2 + q : (q < 2 ? q : 4); f32x4 aA = {0.f, 0.f, 0.f, 0.f}, aB = {0.f, 0.f, 0.f, 0.f};
                mma64((const LAS bf16*)(lds + ML_Q), 16 * rt, (const LAS bf16*)(lds + ML_CT), 16 * ct, lane, aA);
                mma64((const LAS bf16*)(lds + ML_S), 16 * rt, (const LAS bf16*)(lds + ML_VT), 16 * ct, lane, aB);
                const int t0 = 16 * rt + 4 * (lane >> 4), v = 16 * ct + (lane & 15);
#pragma unroll
                for (int r = 0; r < 4; ++r) { const int t = t0 + r; const float x = sm[128 + t] * aA[r] + aB[r];
                    if (ct < 4) hb[t * 65 + v] = x; else if ((lane & 15) == 0) sm[256 + t] = x; } }
        }
        __syncthreads();
        {
            const int t = tid >> 3, vg = tid & 7; float acc[8];
            const float dn = 1.f / fmaxf(fabsf(sm[256 + t]), sm[192 + t]);
            float s1 = 0.f;
#pragma unroll
            for (int j = 0; j < 8; ++j) { acc[j] = hb[t * 65 + vg * 8 + j] * dn; s1 += acc[j]; }
            s1 += __shfl_xor(s1, 1); s1 += __shfl_xor(s1, 2); s1 += __shfl_xor(s1, 4);
            const float mu = s1 * (1.f / 64.f); float s2 = 0.f;
#pragma unroll
            for (int j = 0; j < 8; ++j) { acc[j] -= mu; s2 += acc[j] * acc[j]; }
            s2 += __shfl_xor(s2, 1); s2 += __shfl_xor(s2, 2); s2 += __shfl_xor(s2, 4);
            const float rs = rsqrtf(s2 * (1.f / 64.f) + HEAD_NORM_EPS);
            const float* nw = a->in[I_MNORM_W] + (size_t)l * DA + h * 64 + vg * 8;
            const v4u ov = *(const GAS v4u*)(PROJ + (row0 + t) * NPROJ + PC_O + h * 64 + vg * 8);
            const float o[8] = {bflo(ov.x), bfhi(ov.x), bflo(ov.y), bfhi(ov.y), bflo(ov.z), bfhi(ov.z), bflo(ov.w), bfhi(ov.w)};
            float r[8];
#pragma unroll
            for (int j = 0; j < 8; ++j) r[j] = acc[j] * rs * nw[j] * sigmoidf_(o[j]);
            v4u w; w.x = pk2(r[0], r[1]); w.y = pk2(r[2], r[3]); w.z = pk2(r[4], r[5]); w.w = pk2(r[6], r[7]);
            *(GAS v4u*)(YC + (row0 + t) * DM + h * 64 + vg * 8) = w;
        }
    }
}

constexpr int S5_UT = 264, S5_XT = 2056;
constexpr int S5_U = 0, S5_Z = 33792, S5_X = 67584;
static_assert(S5_X + 16 * S5_XT * 2 <= MISC_OFF, "S5 LDS map");
struct S5A { float are, aim, cre, cim; };
__device__ __forceinline__ S5A s5_a(KArgsP a, int l, int g, int p) {
    const float lam_re = a->in[I_S5ARE][(size_t)(l * 16 + g) * 64 + p], lam_im = a->in[I_S5AIM][(size_t)(l * 16 + g) * 64 + p];
    const float dt = expf(a->in[I_S5LDT][l * 16 + g]); const float mag = expf(lam_re * dt), ang = lam_im * dt;
    S5A r; r.are = mag * cosf(ang); r.aim = mag * sinf(ang);
    const float inv = 1.f / (lam_re * lam_re + lam_im * lam_im);
    r.cre = ((r.are - 1.f) * lam_re + r.aim * lam_im) * inv; r.cim = (r.aim * lam_re - (r.are - 1.f) * lam_im) * inv; return r;
}
__device__ __forceinline__ bf16x8 pack8(const float* v) { v4u o; o.x = pk2(v[0], v[1]); o.y = pk2(v[2], v[3]); o.z = pk2(v[4], v[5]); o.w = pk2(v[6], v[7]); return __builtin_bit_cast(bf16x8, o); }
__device__ __forceinline__ void s5_bfrag(const unsigned char* ws, int l, int g, int lane, bf16x8 (&bf)[8]) {
    const bf16* BB = (const bf16*)(ws + WS_S5BB) + (size_t)(l * 16 + g) * 128 * 16;
#pragma unroll
    for (int j = 0; j < 8; ++j) { v4u o = {0u, 0u, 0u, 0u}; if ((lane >> 4) < 2) o = *(const GAS v4u*)(BB + (16 * j + (lane & 15)) * 16 + 8 * (lane >> 4)); bf[j] = __builtin_bit_cast(bf16x8, o); }
}
__device__ __forceinline__ f32x2 s5_ap(const unsigned char* ws, int l, int g, int p) { return *(const GAS f32x2*)((const float*)(ws + WS_S5AP) + ((size_t)(l * 16 + g) * 64 + p) * 2); }
__device__ __forceinline__ void s5_load_u(const unsigned char* ws, LAS unsigned char* lds, int tid, size_t row0) {
    const bf16* PROJ = (const bf16*)(ws + WS_PROJ);
    for (int idx = tid; idx < 64 * 32; idx += NTHR) { const int t = idx >> 5, c8 = idx & 31;
        *(LAS v4u*)(lds + S5_U + (t * S5_UT + c8 * 8) * 2) = *(const GAS v4u*)(PROJ + (row0 + t) * NPROJ + PC_S5 + c8 * 8); }
}
__device__ __forceinline__ void s5_block(LAS unsigned char* lds, int lane, int tb, int g, const bf16x8 (&bf)[8], float are, float aim, float& xr, float& xi) {
    const int kq = lane >> 4; bf16x8 uf = {0, 0, 0, 0, 0, 0, 0, 0};
    if (kq < 2) uf = *(const LAS bf16x8*)(lds + S5_U + ((16 * tb + (lane & 15)) * S5_UT + g * 16 + 8 * kq) * 2);
    LAS bf16* X = (LAS bf16*)(lds + S5_X);
#pragma unroll
    for (int j = 0; j < 8; ++j) { f32x4 acc = {0.f, 0.f, 0.f, 0.f}; acc = __builtin_amdgcn_mfma_f32_16x16x32_bf16(bf[j], uf, acc, 0, 0, 0);
        v2u o; o.x = pk2(acc[0], acc[1]); o.y = pk2(acc[2], acc[3]); *(LAS v2u*)(X + (lane & 15) * S5_XT + g * 128 + 16 * j + 4 * kq) = o; }
    LDS_WAIT(); asm volatile("" ::: "memory");
    LAS unsigned* xw = (LAS unsigned*)(lds + S5_X) + (g * 128 + 2 * lane) / 2;
    unsigned wv[16];
#pragma unroll
    for (int t = 0; t < 16; ++t) wv[t] = xw[t * (S5_XT / 2)];
#pragma unroll
    for (int t = 0; t < 16; ++t) { const float br = bflo(wv[t]), bi = bfhi(wv[t]);
        const float nr = are * xr - aim * xi + br, ni = are * xi + aim * xr + bi; xr = nr; xi = ni;
        wv[t] = pk2(xr, xi); }
#pragma unroll
    for (int t = 0; t < 16; ++t) xw[t * (S5_XT / 2)] = wv[t];
    LDS_WAIT(); asm volatile("" ::: "memory");
}
__device__ __forceinline__ void phase_s1(KArgsP a, LAS unsigned char* lds, int tid, int lane, int wave, int vcu, int G, int l) {
    unsigned char* ws = a->ws; float* ST = (float*)(ws + WS_S5ST);
    bf16x8 bf0[8], bf1[8]; s5_bfrag(ws, l, wave, lane, bf0); s5_bfrag(ws, l, wave + 8, lane, bf1);
    struct { float are, aim; } A0, A1; { const f32x2 q0 = s5_ap(ws, l, wave, lane), q1 = s5_ap(ws, l, wave + 8, lane); A0.are = q0.x; A0.aim = q0.y; A1.are = q1.x; A1.aim = q1.y; }
    for (int u = vcu; u < NB * NCH; u += G) {
        const size_t row0 = (size_t)u * 64;
        __syncthreads();
        s5_load_u(ws, lds, tid, row0);
        __syncthreads();
        float x0r = 0.f, x0i = 0.f, x1r = 0.f, x1i = 0.f;
        for (int tb = 0; tb < 4; ++tb) { s5_block(lds, lane, tb, wave, bf0, A0.are, A0.aim, x0r, x0i); s5_block(lds, lane, tb, wave + 8, bf1, A1.are, A1.aim, x1r, x1i); }
        *(f32x2*)(ST + (((size_t)u * 16 + wave) * 64 + lane) * 2) = (f32x2){x0r, x0i};
        *(f32x2*)(ST + (((size_t)u * 16 + wave + 8) * 64 + lane) * 2) = (f32x2){x1r, x1i};
    }
}
__device__ __forceinline__ void phase_s2(KArgsP a, int tid, int wg, int nwg, int l) {
    float* ST = (float*)(a->ws + WS_S5ST);
    for (int idx = wg * NTHR + tid; idx < NB * 1024; idx += nwg * NTHR) {
        const int b = idx >> 10, gp = idx & 1023, g = gp >> 6, p = gp & 63;
        const f32x2 A = s5_ap(a->ws, l, g, p); float ar = A.x, ai = A.y;
#pragma unroll
        for (int s = 0; s < 6; ++s) { const float nr = ar * ar - ai * ai, ni = 2.f * ar * ai; ar = nr; ai = ni; }
        float cr = 0.f, ci = 0.f;
        for (int c0 = 0; c0 < NCH; c0 += 8) {
            f32x2 e[8];
#pragma unroll
            for (int j = 0; j < 8; ++j) e[j] = *(const f32x2*)(ST + (((size_t)(b * NCH + c0 + j) * 16 + g) * 64 + p) * 2);
#pragma unroll
            for (int j = 0; j < 8; ++j) { *(f32x2*)(ST + (((size_t)(b * NCH + c0 + j) * 16 + g) * 64 + p) * 2) = (f32x2){cr, ci};
                const float nr = ar * cr - ai * ci + e[j].x, ni = ar * ci + ai * cr + e[j].y; cr = nr; ci = ni; }
        }
    }
}
__device__ __forceinline__ float tanh_fast(float x) { return 1.f - 2.f / (1.f + __expf(2.f * x)); }
__device__ __forceinline__ float gelu_tanh_(float x) { const float t = tanh_fast(0.7978845608f * (x + 0.044715f * x * x * x)); return 0.5f * x * (1.f + t); }
__device__ __forceinline__ void s5_cload(const bf16* cmt  , int lane, bf16x8 (&cf)[4]) {
#pragma unroll
    for (int s = 0; s < 4; ++s) cf[s] = __builtin_bit_cast(bf16x8, *(const GAS v4u*)(cmt + (lane & 15) * 128 + 32 * s + 8 * (lane >> 4)));
}
__device__ __forceinline__ void s5_cproj(LAS unsigned char* lds, int lane, int tb, int g, const bf16x8 (&cf)[4], const float (&dv)[4]) {
    const int kq = lane >> 4; f32x4 acc = {0.f, 0.f, 0.f, 0.f};
    const LAS bf16* xp = (const LAS bf16*)(lds + S5_X) + (lane & 15) * S5_XT + g * 128 + 8 * kq;
#pragma unroll
    for (int s = 0; s < 4; ++s) acc = __builtin_amdgcn_mfma_f32_16x16x32_bf16(cf[s], *(const LAS bf16x8*)(xp + 32 * s), acc, 0, 0, 0);
    const int t = 16 * tb + (lane & 15), c0 = g * 16 + 4 * kq;
    const v2u uw = *(const LAS v2u*)(lds + S5_U + (t * S5_UT + c0) * 2);
    const float u4[4] = {bflo(uw.x), bfhi(uw.x), bflo(uw.y), bfhi(uw.y)}; float z[4];
#pragma unroll
    for (int r = 0; r < 4; ++r) z[r] = gelu_tanh_(acc[r] + dv[r] * u4[r]);
    v2u o; o.x = pk2(z[0], z[1]); o.y = pk2(z[2], z[3]); *(LAS v2u*)(lds + S5_Z + (t * S5_UT + c0) * 2) = o;
}
__device__ __forceinline__ void phase_s3(KArgsP a, LAS unsigned char* lds, int tid, int lane, int wave, int vcu, int G, int l, unsigned* qctr = nullptr) {
    unsigned char* ws = a->ws; const float* ST = (const float*)(ws + WS_S5ST); bf16* YC = (bf16*)(ws + WS_YC);
    const bf16* GLUT = (const bf16*)(ws + WS_GLUT) + (size_t)l * DC * DC;
    bf16x8 bf0[8], bf1[8]; s5_bfrag(ws, l, wave, lane, bf0); s5_bfrag(ws, l, wave + 8, lane, bf1);
    const bf16* cm0 = (const bf16*)(ws + WS_S5CM) + (size_t)(l * 16 + wave) * 2048; const bf16* cm1 = cm0 + 8 * 2048;
    struct { float are, aim; } A0, A1; { const f32x2 q0 = s5_ap(ws, l, wave, lane), q1 = s5_ap(ws, l, wave + 8, lane); A0.are = q0.x; A0.aim = q0.y; A1.are = q1.x; A1.aim = q1.y; }
    float d0[4], d1[4];
#pragma unroll
    for (int r = 0; r < 4; ++r) { d0[r] = a->in[I_S5D][l * DC + wave * 16 + 4 * (lane >> 4) + r]; d1[r] = a->in[I_S5D][l * DC + (wave + 8) * 16 + 4 * (lane >> 4) + r]; }
    volatile LAS unsigned* qw = (volatile LAS unsigned*)(lds + MISC_OFF) + 20;
    unsigned qn = 0u; if (qctr && tid == 0) qn = __hip_atomic_fetch_add(qctr, 1u, __ATOMIC_RELAXED, __HIP_MEMORY_SCOPE_AGENT);
    for (int u = vcu; ; u += G) {
        if (qctr) { __syncthreads(); if (tid == 0) *qw = qn; __syncthreads(); u = (int)*qw; }
        if (u >= NB * NCH) break;
        if (qctr && tid == 0) qn = __hip_atomic_fetch_add(qctr, 1u, __ATOMIC_RELAXED, __HIP_MEMORY_SCOPE_AGENT);
        const size_t row0 = (size_t)u * 64;
        __syncthreads();
        s5_load_u(ws, lds, tid, row0);
        const f32x2 s0 = *(const f32x2*)(ST + (((size_t)u * 16 + wave) * 64 + lane) * 2), s1 = *(const f32x2*)(ST + (((size_t)u * 16 + wave + 8) * 64 + lane) * 2);
        float x0r = s0.x, x0i = s0.y, x1r = s1.x, x1i = s1.y;
        __syncthreads();
        for (int tb = 0; tb < 4; ++tb) {
            { bf16x8 cf[4]; s5_cload(cm0, lane, cf); s5_block(lds, lane, tb, wave, bf0, A0.are, A0.aim, x0r, x0i); s5_cproj(lds, lane, tb, wave, cf, d0); }
            { bf16x8 cf[4]; s5_cload(cm1, lane, cf); s5_block(lds, lane, tb, wave + 8, bf1, A1.are, A1.aim, x1r, x1i); s5_cproj(lds, lane, tb, wave + 8, cf, d1); }
        }
        __syncthreads();
        {
            const int kq = lane >> 4;
#pragma unroll
            for (int q = 0; q < 2; ++q) { const int ct = 2 * wave + q; f32x4 acc[4];
#pragma unroll
                for (int rt = 0; rt < 4; ++rt) acc[rt] = (f32x4){0.f, 0.f, 0.f, 0.f};
                const bf16* gp = GLUT + (size_t)(16 * ct + (lane & 15)) * DC + 8 * kq;
#pragma unroll 2
                for (int s = 0; s < 8; ++s) { const bf16x8 gf = __builtin_bit_cast(bf16x8, *(const GAS v4u*)(gp + 32 * s));
#pragma unroll
                    for (int rt = 0; rt < 4; ++rt) acc[rt] = __builtin_amdgcn_mfma_f32_16x16x32_bf16(gf, *(const LAS bf16x8*)(lds + S5_Z + ((16 * rt + (lane & 15)) * S5_UT + 32 * s + 8 * kq) * 2), acc[rt], 0, 0, 0); }
                const int j0 = 16 * ct + 4 * kq; const f32x4 gb = *(const GAS f32x4*)(a->in[I_S5GLUB] + l * DC + j0);
#pragma unroll
                for (int rt = 0; rt < 4; ++rt) { const int t = 16 * rt + (lane & 15); const v2u zw = *(const LAS v2u*)(lds + S5_Z + (t * S5_UT + j0) * 2);
                    const float z0 = bflo(zw.x), z1 = bfhi(zw.x), z2 = bflo(zw.y), z3 = bfhi(zw.y);
                    v2u o; o.x = pk2(z0 * sigmoidf_(acc[rt][0] + gb.x), z1 * sigmoidf_(acc[rt][1] + gb.y)); o.y = pk2(z2 * sigmoidf_(acc[rt][2] + gb.z), z3 * sigmoidf_(acc[rt][3] + gb.w));
                    *(GAS v2u*)(YC + (row0 + t) * DM + 768 + j0) = o; } }
        }
    }
}

__device__ __forceinline__ float rw_shift(const bf16* PROJ, const float* mu, size_t row, int col) {
    const float cur = bf2f(PROJ[row * NPROJ + PC_RW + col]); const float prv = (row % SEQ) ? bf2f(PROJ[(row - 1) * NPROJ + PC_RW + col]) : 0.f;
    return cur + mu[col] * (prv - cur);
}
constexpr int R1_TH = 0, R1_AD = 9216, R1_SG = 18432, R1_VS = 35840, R1_TMP = 86016;
template <int KS, int MODE>
__device__ __forceinline__ void r1_prod(const bf16* WT, const LAS bf16* act, int astride, const float* bias, bf16* OUT, size_t row0, int lane, int wave) {
    const int kq = lane >> 4, n0 = 48 * wave; constexpr int K = 32 * KS;
    f32x4 acc[3][4];
#pragma unroll
    for (int nt = 0; nt < 3; ++nt)
#pragma unroll
        for (int ti = 0; ti < 4; ++ti) acc[nt][ti] = (f32x4){0.f, 0.f, 0.f, 0.f};
#pragma unroll
    for (int s = 0; s < KS; ++s) { bf16x8 wf[3], af[4];
#pragma unroll
        for (int nt = 0; nt < 3; ++nt) wf[nt] = __builtin_bit_cast(bf16x8, *(const GAS v4u*)(WT + (size_t)(n0 + 16 * nt + (lane & 15)) * K + 32 * s + 8 * kq));
#pragma unroll
        for (int ti = 0; ti < 4; ++ti) af[ti] = *(const LAS bf16x8*)(act + (16 * ti + (lane & 15)) * astride + 32 * s + 8 * kq);
#pragma unroll
        for (int nt = 0; nt < 3; ++nt)
#pragma unroll
            for (int ti = 0; ti < 4; ++ti) acc[nt][ti] = __builtin_amdgcn_mfma_f32_16x16x32_bf16(wf[nt], af[ti], acc[nt][ti], 0, 0, 0); }
#pragma unroll
    for (int nt = 0; nt < 3; ++nt) { const int n = n0 + 16 * nt + 4 * kq; f32x4 bv = {0.f, 0.f, 0.f, 0.f}; if (MODE != 2) bv = *(const GAS f32x4*)(bias + n);
#pragma unroll
        for (int ti = 0; ti < 4; ++ti) { float o[4];
#pragma unroll
            for (int r = 0; r < 4; ++r) { const float x = acc[nt][ti][r] + bv[r]; o[r] = MODE == 0 ? 0.60653066f * sigmoidf_(x) : (MODE == 1 ? sigmoidf_(x) : x); }
            v2u w; w.x = pk2(o[0], o[1]); w.y = pk2(o[2], o[3]);
            *(GAS v2u*)(OUT + (row0 + 16 * ti + (lane & 15)) * DBR + n) = w; } }
}
__device__ __forceinline__ void phase_r1(KArgsP a, LAS unsigned char* lds, int tid, int lane, int wave, int vcu, int G, int l) {
    unsigned char* ws = a->ws; const bf16* PROJ = (const bf16*)(ws + WS_PROJ); const float* mu = a->in[I_RMU] + (size_t)l * RW_COLS;
    const bf16* W1 = (const bf16*)(ws + WS_R1W) + (size_t)l * 98304;
    const bf16* WV = (const bf16*)(ws + WS_R1W) + 2 * 98304;
    for (int u = vcu; u < NTOK / 64; u += G) {
        const size_t row0 = (size_t)u * 64;
        __syncthreads();
        for (int idx = tid; idx < 64 * 32; idx += NTHR) { const int tt = idx >> 5, col = 8 * (idx & 31); const size_t r = row0 + tt;
            const v4u cw = *(const GAS v4u*)(PROJ + r * NPROJ + PC_RW + RWC_WD + col); v4u pw = {0u, 0u, 0u, 0u}; if (r % SEQ) pw = *(const GAS v4u*)(PROJ + (r - 1) * NPROJ + PC_RW + RWC_WD + col);
            const f32x4 m0 = *(const GAS f32x4*)(mu + RWC_WD + col), m1 = *(const GAS f32x4*)(mu + RWC_WD + col + 4);
            const unsigned cu[4] = {cw.x, cw.y, cw.z, cw.w}, pu[4] = {pw.x, pw.y, pw.z, pw.w}; const float mm[8] = {m0[0], m0[1], m0[2], m0[3], m1[0], m1[1], m1[2], m1[3]}; unsigned o[4];
#pragma unroll
            for (int j = 0; j < 4; ++j) { const float c0 = bflo(cu[j]), c1 = bfhi(cu[j]); const float x0 = c0 + mm[2 * j] * (bflo(pu[j]) - c0), x1 = c1 + mm[2 * j + 1] * (bfhi(pu[j]) - c1);
                o[j] = col < 64 ? pk2(tanh_fast(x0), tanh_fast(x1)) : (col < 128 ? pk2(x0, x1) : pk2(sigmoidf_(x0), sigmoidf_(x1))); }
            v4u w; w.x = o[0]; w.y = o[1]; w.z = o[2]; w.w = o[3];
            if (col < 64) *(LAS v4u*)(lds + R1_TH + (tt * 72 + col) * 2) = w;
            else if (col < 128) *(LAS v4u*)(lds + R1_AD + (tt * 72 + col - 64) * 2) = w;
            else *(LAS v4u*)(lds + R1_SG + (tt * 136 + col - 128) * 2) = w; }
        if (l > 0) for (int idx = tid; idx < 64 * 48; idx += NTHR) { const int tt = idx / 48, col = 8 * (idx % 48); const size_t r = row0 + tt;
            const v4u cw = *(const GAS v4u*)(PROJ + r * NPROJ + PC_RW + RWC_V + col); v4u pw = {0u, 0u, 0u, 0u}; if (r % SEQ) pw = *(const GAS v4u*)(PROJ + (r - 1) * NPROJ + PC_RW + RWC_V + col);
            const f32x4 m0 = *(const GAS f32x4*)(mu + RWC_V + col), m1 = *(const GAS f32x4*)(mu + RWC_V + col + 4);
            const unsigned cu[4] = {cw.x, cw.y, cw.z, cw.w}, pu[4] = {pw.x, pw.y, pw.z, pw.w}; const float mm[8] = {m0[0], m0[1], m0[2], m0[3], m1[0], m1[1], m1[2], m1[3]}; unsigned o[4];
#pragma unroll
            for (int j = 0; j < 4; ++j) { const float c0 = bflo(cu[j]), c1 = bfhi(cu[j]); o[j] = pk2(c0 + mm[2 * j] * (bflo(pu[j]) - c0), c1 + mm[2 * j + 1] * (bfhi(pu[j]) - c1)); }
            v4u w; w.x = o[0]; w.y = o[1]; w.z = o[2]; w.w = o[3];
            *(LAS v4u*)(lds + R1_VS + (tt * 392 + col) * 2) = w; }
        __syncthreads();
        r1_prod<2, 0>(W1, (const LAS bf16*)(lds + R1_TH), 72, a->in[I_RW0] + l * DBR, (bf16*)(ws + WS_RE), row0, lane, wave);
        r1_prod<2, 1>(W1 + 24576, (const LAS bf16*)(lds + R1_AD), 72, a->in[I_RA0] + l * DBR, (bf16*)(ws + WS_RA), row0, lane, wave);
        r1_prod<4, 2>(W1 + 49152, (const LAS bf16*)(lds + R1_SG), 136, nullptr, (bf16*)(ws + WS_RG), row0, lane, wave);
        if (l > 0) {
            { const int kq = lane >> 4, mt = wave & 1, ti = wave >> 1; f32x4 acc = {0.f, 0.f, 0.f, 0.f};
#pragma unroll
              for (int s = 0; s < 12; ++s) acc = __builtin_amdgcn_mfma_f32_16x16x32_bf16(__builtin_bit_cast(bf16x8, *(const GAS v4u*)(WV + (size_t)(16 * mt + (lane & 15)) * 384 + 32 * s + 8 * kq)),
                                                                                          *(const LAS bf16x8*)(lds + R1_VS + ((16 * ti + (lane & 15)) * 392 + 32 * s + 8 * kq) * 2), acc, 0, 0, 0);
              v2u w; w.x = pk2(acc[0], acc[1]); w.y = pk2(acc[2], acc[3]); *(LAS v2u*)(lds + R1_TMP + ((16 * ti + (lane & 15)) * 40 + 16 * mt + 4 * kq) * 2) = w; }
            __syncthreads();
            r1_prod<1, 1>(WV + 12288, (const LAS bf16*)(lds + R1_TMP), 40, a->in[I_RV0], (bf16*)(ws + WS_RVG), row0, lane, wave);
        }
    }
}
__device__ __forceinline__ float dpp_allsum(float x) {
    x += __builtin_bit_cast(float, __builtin_amdgcn_update_dpp(0, __builtin_bit_cast(int, x), 0x128, 0xf, 0xf, false));
    x += __builtin_bit_cast(float, __builtin_amdgcn_update_dpp(0, __builtin_bit_cast(int, x), 0x124, 0xf, 0xf, false));
    x += __builtin_bit_cast(float, __builtin_amdgcn_update_dpp(0, __builtin_bit_cast(int, x), 0x122, 0xf, 0xf, false));
    x += __builtin_bit_cast(float, __builtin_amdgcn_update_dpp(0, __builtin_bit_cast(int, x), 0x121, 0xf, 0xf, false));
    { const unsigned xi = __builtin_bit_cast(unsigned, x); auto r = __builtin_amdgcn_permlane16_swap(xi, xi, false, false); const unsigned r0 = r[0], r1 = r[1]; x = __uint_as_float(r0) + __uint_as_float(r1); }
    { const unsigned xi = __builtin_bit_cast(unsigned, x); auto r = __builtin_amdgcn_permlane32_swap(xi, xi, false, false); const unsigned r0 = r[0], r1 = r[1]; x = __uint_as_float(r0) + __uint_as_float(r1); }
    return x;
}

constexpr int RC_EF = 0, RC_ATF = 4096, RC_QF = 8448, RC_PFT = 9472, RC_AT = 10496, RC_RT = 12800, RC_BH = 15104, RC_KH = 17408, RC_AH = 19712, RC_BTT = 22016, RC_KTT = 25088, RC_VS = 28160,
              RC_PRL = 31232, RC_QRL = 32000, RC_TQL = 32768, RC_G15 = 33536, RC_CH = 33792;
struct RCRegs { v2u r0, r1, k0, k1, aa, ee, v0, v1, vg, vf, gg; };
__device__ __forceinline__ void rc_issue(const unsigned char* ws, int l, size_t row, int h, int tid, RCRegs& R) {
    const bf16* PROJ = (const bf16*)(ws + WS_PROJ); const int tt = tid >> 4, c0 = h * 64 + 4 * (tid & 15); const size_t r = row + tt; const bool first = (r % SEQ) == 0; const size_t rp = first ? r : r - 1;
    R.r0 = *(const GAS v2u*)(PROJ + r * NPROJ + PC_RW + RWC_R + c0); R.r1 = *(const GAS v2u*)(PROJ + rp * NPROJ + PC_RW + RWC_R + c0);
    R.k0 = *(const GAS v2u*)(PROJ + r * NPROJ + PC_RW + RWC_K + c0); R.k1 = *(const GAS v2u*)(PROJ + rp * NPROJ + PC_RW + RWC_K + c0);
    R.v0 = *(const GAS v2u*)(PROJ + r * NPROJ + PC_RW + RWC_V + c0); R.v1 = *(const GAS v2u*)(PROJ + rp * NPROJ + PC_RW + RWC_V + c0);
    R.aa = *(const GAS v2u*)((const bf16*)(ws + WS_RA) + r * DBR + c0); R.ee = *(const GAS v2u*)((const bf16*)(ws + WS_RE) + r * DBR + c0);
    R.gg = *(const GAS v2u*)((const bf16*)(ws + WS_RG) + r * DBR + c0);
    if (l > 0) { R.vg = *(const GAS v2u*)((const bf16*)(ws + WS_RVG) + r * DBR + c0); R.vf = *(const GAS v2u*)((const bf16*)(ws + WS_VF) + r * DBR + c0); }
    if (first) { R.r1 = (v2u){0u, 0u}; R.k1 = (v2u){0u, 0u}; R.v1 = (v2u){0u, 0u}; }
}
__device__ __forceinline__ void unpack4(const v2u p, float (&o)[4]) { o[0] = bflo(p.x); o[1] = bfhi(p.x); o[2] = bflo(p.y); o[3] = bfhi(p.y); }
__device__ __forceinline__ v2u pack4(const float (&v)[4]) { v2u o; o.x = pk2(v[0], v[1]); o.y = pk2(v[2], v[3]); return o; }
__device__ __forceinline__ v2u pack4v(const f32x4 v) { v2u o; o.x = pk2(v[0], v[1]); o.y = pk2(v[2], v[3]); return o; }
__device__ __forceinline__ bf16x8 cat8(const v2u a, const v2u b) { v4u o; o.x = a.x; o.y = a.y; o.z = b.x; o.w = b.y; return __builtin_bit_cast(bf16x8, o); }
#define RC_BAR() asm volatile("s_waitcnt lgkmcnt(0)\n\ts_barrier" ::: "memory")

constexpr int REC_BYTES = 12288, REC_UNITS = 752;
__device__ __forceinline__ unsigned char* rc_rec(unsigned char* ws, size_t cu) { return cu < 8192 ? ws + WS_OPA + cu * REC_BYTES : ws + WS_OPB + (cu - 8192) * REC_BYTES; }
__device__ __forceinline__ v4u rc_gather_unit(const LAS unsigned char* wb, int u) {
    v2u lo, hi;
    if (u < 256) { const int base = u < 128 ? RC_AH : RC_RT, uu = u & 127, row = uu >> 3, s = (uu >> 2) & 1, lq = uu & 3; const LAS unsigned char* p = wb + base + (row * 72 + 32 * s + 4 * lq) * 2;
        lo = *(const LAS v2u*)p; hi = *(const LAS v2u*)(p + 32); }
    else if (u < 512) { const int k = (u - 256) >> 2, lq = (u - 256) & 3; lo = *(const LAS v2u*)(wb + RC_BTT + (k * 24 + 4 * lq) * 2); hi = *(const LAS v2u*)(wb + RC_KTT + (k * 24 + 4 * lq) * 2); }
    else if (u < 576) { const int t = (u - 512) >> 2, lq = (u - 512) & 3; lo = *(const LAS v2u*)(wb + RC_PRL + (t * 24 + 4 * lq) * 2); hi = *(const LAS v2u*)(wb + RC_QRL + (t * 24 + 4 * lq) * 2); }
    else if (u < 608) { const LAS unsigned char* p = wb + RC_TQL + (((u - 576) >> 1) * 24 + 8 * ((u - 576) & 1)) * 2; lo = *(const LAS v2u*)p; hi = *(const LAS v2u*)(p + 8); }
    else if (u < 736) { const LAS unsigned char* p = wb + RC_VS + (((u - 608) >> 1) * 24 + 8 * ((u - 608) & 1)) * 2; lo = *(const LAS v2u*)p; hi = *(const LAS v2u*)(p + 8); }
    else { const LAS unsigned char* p = wb + RC_G15 + (u - 736) * 16; lo = *(const LAS v2u*)p; hi = *(const LAS v2u*)(p + 8); }
    v4u o; o.x = lo.x; o.y = lo.y; o.z = hi.x; o.w = hi.y; return o;
}
__device__ __forceinline__ void rc_copy_out(unsigned char* rec, const LAS unsigned char* wb, int u) {
#pragma unroll
    for (int q = 0; q < 3; ++q) { const int uu = u + 256 * q; if (uu < REC_UNITS) *(GAS v4u*)(rec + uu * 16) = rc_gather_unit(wb, uu); }
}
constexpr int RS_AH = 0, RS_RT = 2304, RS_BK = 4608, RS_PQ = 9728, RS_TQL = 11008, RS_VS = 11776, RS_G15 = 14848, RS_CH = 15360;
__device__ __forceinline__ int rs_unit_off(int u) {
    if (u < 128) return RS_AH + (u >> 3) * 144 + (u & 7) * 16;
    if (u < 256) return RS_RT + ((u - 128) >> 3) * 144 + (u & 7) * 16;
    if (u < 512) return RS_BK + ((u - 256) >> 2) * 80 + (u & 3) * 16;
    if (u < 576) return RS_PQ + ((u - 512) >> 2) * 80 + (u & 3) * 16;
    if (u < 608) return RS_TQL + ((u - 576) >> 1) * 48 + (u & 1) * 16;
    if (u < 736) return RS_VS + ((u - 608) >> 1) * 48 + (u & 1) * 16;
    return RS_G15 + (u - 736) * 16;
}
#define RC_BUILD(RUSE, q) do { const int bh_ = (q) % (NB * NH), b = bh_ / NH, h = bh_ % NH, blk_ = blk0 + (q) / (NB * NH), c0 = h * 64 + 4 * kq; const size_t row0 = (size_t)b * SEQ + (size_t)blk_ * 32; \
        float kkw[4], kaw[4], mur[4], muk[4], muv[4]; \
_Pragma("unroll") \
        for (int j = 0; j < 4; ++j) { kkw[j] = a->in[I_RKK][(size_t)l * DBR + c0 + j]; kaw[j] = a->in[I_RKA][(size_t)l * DBR + c0 + j]; mur[j] = mu[RWC_R + c0 + j]; muk[j] = mu[RWC_K + c0 + j]; muv[j] = mu[RWC_V + c0 + j]; } \
        float an[4], bk[4], km[4], rs[4], ev[4]; \
        {   const RCRegs& R = RUSE; \
            float rc[4], rp[4], kc[4], kp[4], av[4], vc[4], vp[4], ks[4], kk[4], vs[4]; unpack4(R.r0, rc); unpack4(R.r1, rp); unpack4(R.k0, kc); unpack4(R.k1, kp); unpack4(R.aa, av); unpack4(R.ee, ev); unpack4(R.v0, vc); unpack4(R.v1, vp); \
            float ss = 0.f; \
_Pragma("unroll") \
            for (int j = 0; j < 4; ++j) { rs[j] = rc[j] + mur[j] * (rp[j] - rc[j]); ks[j] = kc[j] + muk[j] * (kp[j] - kc[j]); kk[j] = ks[j] * kkw[j]; ss += kk[j] * kk[j]; vs[j] = vc[j] + muv[j] * (vp[j] - vc[j]); } \
            ss += __shfl_xor(ss, 1); ss += __shfl_xor(ss, 2); ss += __shfl_xor(ss, 4); ss += __shfl_xor(ss, 8); \
            const float inv = 1.f / fmaxf(sqrtf(ss), 1e-12f); \
_Pragma("unroll") \
            for (int j = 0; j < 4; ++j) { const float kn = kk[j] * inv; an[j] = -kn; bk[j] = kn * av[j]; km[j] = ks[j] * (1.f + (av[j] - 1.f) * kaw[j]); } \
            if (l == 0) *(GAS v2u*)((bf16*)(ws + WS_VF) + (row0 + tt) * DBR + c0) = pack4(vs); \
            else { float g[4], f[4]; unpack4(R.vg, g); unpack4(R.vf, f); \
_Pragma("unroll") \
                for (int j = 0; j < 4; ++j) vs[j] = vs[j] + (f[j] - vs[j]) * g[j]; } \
            {     \
                float gq[4], o1[4], o2[4]; unpack4(R.gg, gq); float rkp = 0.f; \
_Pragma("unroll") \
                for (int j = 0; j < 4; ++j) rkp += rs[j] * km[j] * a->in[I_RRK][(size_t)l * DBR + c0 + j]; \
                rkp += __shfl_xor(rkp, 1); rkp += __shfl_xor(rkp, 2); rkp += __shfl_xor(rkp, 4); rkp += __shfl_xor(rkp, 8); \
_Pragma("unroll") \
                for (int j = 0; j < 4; ++j) { o1[j] = a->in[I_RLNW][(size_t)l * DBR + c0 + j] * gq[j]; o2[j] = (a->in[I_RLNB][(size_t)l * DBR + c0 + j] + rkp * vs[j]) * gq[j]; } \
                if (ST12) { *(GAS v2u*)((bf16*)(ws + WS_RG) + (row0 + tt) * DBR + c0) = pack4(o1); *(GAS v2u*)((bf16*)(ws + WS_RA) + (row0 + tt) * DBR + c0) = pack4(o2); } } \
            *(LAS f32x4*)(cb + RC_EF + (t * 64 + 4 * kq) * 4) = (f32x4){ev[0], ev[1], ev[2], ev[3]}; \
_Pragma("unroll") \
            for (int j = 0; j < 4; ++j) *(LAS bf16*)(cb + RC_VS + ((4 * kq + j) * 24 + t) * 2) = (bf16)f2bf(vs[j]); \
        } \
        if ((q) + 2 * G < NQ) rc_issue_q(ws, l, (q) + 2 * G, blk0, tid, RUSE); \
        RC_BAR(); \
        {   f32x4 inc = {0.f, 0.f, 0.f, 0.f}, tot = inc; \
_Pragma("unroll") \
            for (int i = 0; i < 16; ++i) { const f32x4 ei = *(const LAS f32x4*)(cb + RC_EF + (i * 64 + 4 * kq) * 4); tot = tot + ei; if (i <= t) inc = inc + ei; } \
            float At[4], Rt[4], Bh[4], Kh[4], Bt[4], Kt[4], Gt[4]; \
_Pragma("unroll") \
            for (int j = 0; j < 4; ++j) { const float Gi = __expf(-inc[j]), Ge = __expf(ev[j] - inc[j]), Gn = __expf(inc[j]); Gt[j] = __expf(-tot[j]); \
                At[j] = an[j] * Ge; Rt[j] = rs[j] * Gi; Bh[j] = bk[j] * Gn; Kh[j] = km[j] * Gn; Bt[j] = Bh[j] * Gt[j]; Kt[j] = Kh[j] * Gt[j]; } \
            *(LAS f32x4*)(cb + RC_ATF + (t * 68 + 4 * kq) * 4) = (f32x4){At[0], At[1], At[2], At[3]}; \
            *(LAS v2u*)(cb + RC_AT + (t * 72 + 4 * kq) * 2) = pack4(At); *(LAS v2u*)(cb + RC_RT + (t * 72 + 4 * kq) * 2) = pack4(Rt); \
            *(LAS v2u*)(cb + RC_BH + (t * 72 + 4 * kq) * 2) = pack4(Bh); *(LAS v2u*)(cb + RC_KH + (t * 72 + 4 * kq) * 2) = pack4(Kh); \
_Pragma("unroll") \
            for (int j = 0; j < 4; ++j) { *(LAS bf16*)(cb + RC_BTT + ((4 * kq + j) * 24 + t) * 2) = (bf16)f2bf(Bt[j]); *(LAS bf16*)(cb + RC_KTT + ((4 * kq + j) * 24 + t) * 2) = (bf16)f2bf(Kt[j]); } \
            if (t == 0) *(LAS f32x4*)(cb + RC_G15 + 4 * kq * 4) = (f32x4){Gt[0], Gt[1], Gt[2], Gt[3]}; \
        } \
        RC_BAR(); \
        {   LAS unsigned char* wb = lds + (wave >> 2) * RC_CH; const int pi = wave & 3; \
            const LAS bf16* Ap = (const LAS bf16*)(wb + (pi < 2 ? RC_AT : RC_RT)) + li * 72 + 8 * lq; const LAS bf16* Bp = (const LAS bf16*)(wb + ((pi & 1) ? RC_KH : RC_BH)) + li * 72 + 8 * lq; \
            f32x4 acc = {0.f, 0.f, 0.f, 0.f}; \
            acc = __builtin_amdgcn_mfma_f32_16x16x32_bf16(*(const LAS bf16x8*)Ap, *(const LAS bf16x8*)Bp, acc, 0, 0, 0); \
            acc = __builtin_amdgcn_mfma_f32_16x16x32_bf16(*(const LAS bf16x8*)(Ap + 32), *(const LAS bf16x8*)(Bp + 32), acc, 0, 0, 0); \
_Pragma("unroll") \
            for (int r = 0; r < 4; ++r) { const int tr = 4 * lq + r; if (pi < 2 ? !(li < tr) : !(li <= tr)) acc[r] = 0.f; } \
            if (pi == 0) *(LAS f32x4*)(wb + RC_PFT + (li * 16 + 4 * lq) * 4) = acc; \
            else if (pi == 1) { \
_Pragma("unroll") \
                for (int r = 0; r < 4; ++r) *(LAS float*)(wb + RC_QF + ((4 * lq + r) * 16 + li) * 4) = acc[r]; } \
            else { LAS bf16* o = (LAS bf16*)(wb + (pi == 2 ? RC_PRL : RC_QRL)); \
_Pragma("unroll") \
                for (int r = 0; r < 4; ++r) o[(4 * lq + r) * 24 + li] = (bf16)f2bf(acc[r]); } \
        } \
        RC_BAR(); \
        if (wave < 4) { \
            LAS unsigned char* wb = lds + (wave >> 1) * RC_CH; const bool isq = wave & 1; \
            float X[16]; \
_Pragma("unroll") \
            for (int r = 0; r < 16; ++r) X[r] = isq ? *(const LAS float*)(wb + RC_QF + (r * 16 + li) * 4) : *(const LAS float*)(wb + RC_ATF + (r * 68 + lane) * 4); \
_Pragma("unroll") \
            for (int j = 0; j < 15; ++j) { const LAS f32x4* pc = (const LAS f32x4*)(wb + RC_PFT + j * 64); const f32x4 c0v = pc[0], c1v = pc[1], c2v = pc[2], c3v = pc[3]; \
                const float c[16] = {c0v[0], c0v[1], c0v[2], c0v[3], c1v[0], c1v[1], c1v[2], c1v[3], c2v[0], c2v[1], c2v[2], c2v[3], c3v[0], c3v[1], c3v[2], c3v[3]}; \
_Pragma("unroll") \
                for (int r = j + 1; r < 16; ++r) X[r] = fmaf(c[r], X[j], X[r]); } \
            if (!isq) { LAS bf16* o = (LAS bf16*)(wb + RC_AH); \
_Pragma("unroll") \
                for (int r = 0; r < 16; ++r) o[r * 72 + lane] = (bf16)f2bf(X[r]); } \
            else if (lane < 16) { LAS bf16* o = (LAS bf16*)(wb + RC_TQL); \
_Pragma("unroll") \
                for (int r = 0; r < 16; ++r) o[r * 24 + lane] = (bf16)f2bf(X[r]); } \
        } \
        RC_BAR(); \
        { const int cc = tid >> 8, u = tid & 255; unsigned char* rec = rc_rec(ws, (size_t)bh_ * 512 + 2 * blk_ + cc); const LAS unsigned char* wb = lds + cc * RC_CH; \
          rc_copy_out(rec, wb, u); } \
        RC_BAR(); \
    } while (0)
#ifndef RS_NT
#define RS_NT 1
#endif
constexpr int RS_TILES = RS_NT;
struct RSOps { bf16x8 a01, a23, r01, r23, tq, pq, bk[4]; v2u vb[RS_TILES]; f32x4 g[4]; };
__device__ __forceinline__ void rs_load(const LAS unsigned char* wb, int wave, int li, int lq, RSOps& O) {
    O.a01 = *(const LAS bf16x8*)(wb + RS_AH + li * 144 + lq * 16); O.a23 = *(const LAS bf16x8*)(wb + RS_AH + li * 144 + 64 + lq * 16);
    O.r01 = *(const LAS bf16x8*)(wb + RS_RT + li * 144 + lq * 16); O.r23 = *(const LAS bf16x8*)(wb + RS_RT + li * 144 + 64 + lq * 16);
    O.pq = *(const LAS bf16x8*)(wb + RS_PQ + li * 80 + lq * 16);
    { const v2u t = *(const LAS v2u*)(wb + RS_TQL + li * 48 + lq * 8); v4u o; o.x = t.x; o.y = t.y; o.z = 0u; o.w = 0u; O.tq = __builtin_bit_cast(bf16x8, o); }
#pragma unroll
    for (int vt = 0; vt < RS_TILES; ++vt) O.vb[vt] = *(const LAS v2u*)(wb + RS_VS + (16 * (RS_TILES * wave + vt) + li) * 48 + lq * 8);
#pragma unroll
    for (int kt = 0; kt < 4; ++kt) { O.bk[kt] = *(const LAS bf16x8*)(wb + RS_BK + (16 * kt + li) * 80 + lq * 16); O.g[kt] = *(const LAS f32x4*)(wb + RS_G15 + (16 * kt + 4 * lq) * 4); }
}
#define RC_CHUNK(O, cc, yb) do { const v2u z2_ = {0u, 0u}; \
_Pragma("unroll") \
        for (int vt = 0; vt < RS_TILES; ++vt) {     \
            f32x4 aD = {0.f, 0.f, 0.f, 0.f}, aY = {0.f, 0.f, 0.f, 0.f}; \
            aD = __builtin_amdgcn_mfma_f32_16x16x32_bf16(O.tq, cat8(O.vb[vt], z2_), aD, 0, 0, 0); \
            aD = __builtin_amdgcn_mfma_f32_16x16x32_bf16(O.a01, Sb01[vt], aD, 0, 0, 0); \
            aD = __builtin_amdgcn_mfma_f32_16x16x32_bf16(O.a23, Sb23[vt], aD, 0, 0, 0); \
            aY = __builtin_amdgcn_mfma_f32_16x16x32_bf16(Sb01[vt], O.r01, aY, 0, 0, 0); \
            aY = __builtin_amdgcn_mfma_f32_16x16x32_bf16(Sb23[vt], O.r23, aY, 0, 0, 0); \
            const bf16x8 DV = cat8(pack4v(aD), O.vb[vt]); \
_Pragma("unroll") \
            for (int kt = 0; kt < 4; ++kt) Sacc[vt][kt] = __builtin_amdgcn_mfma_f32_16x16x32_bf16(O.bk[kt], DV, Sacc[vt][kt] * O.g[kt], 0, 0, 0); \
            aY = __builtin_amdgcn_mfma_f32_16x16x32_bf16(DV, O.pq, aY, 0, 0, 0); \
            Sb01[vt] = cat8(pack4v(Sacc[vt][0]), pack4v(Sacc[vt][1])); Sb23[vt] = cat8(pack4v(Sacc[vt][2]), pack4v(Sacc[vt][3])); \
            *(LAS v2u*)((yb) + (((cc) * 16 + li) * 72 + 16 * (RS_TILES * wave + vt) + 4 * lq) * 2) = pack4v(aY);     \
        } \
    } while (0)
#define RC_SCAN(slot, yb) do { { RSOps O0; rs_load(slot, wave, li, lq, O0); __builtin_amdgcn_sched_barrier(0); RC_CHUNK(O0, 0, yb); } \
        { RSOps O1; rs_load(slot + RS_CH, wave, li, lq, O1); __builtin_amdgcn_sched_barrier(0); RC_CHUNK(O1, 1, yb); } } while (0)

__device__ __forceinline__ void rc_issue_q(const unsigned char* ws, int l, int q, int blk0, int tid, RCRegs& R) {
    const int bh = q % (NB * NH), blk = blk0 + q / (NB * NH);
    rc_issue(ws, l, (size_t)(bh / NH) * SEQ + (size_t)blk * 32, bh % NH, tid, R);
}
template <bool ST12 = true>
__device__ __forceinline__ void phase_r2_build(KArgsP a, LAS unsigned char* lds, int tid, int lane, int wave, int vcu, int G, int l, int blk0 = 0, int nblk = SEQ / 32) {
    unsigned char* ws = a->ws;
    const int tt = tid >> 4, kq = tid & 15, ch = tt >> 4, t = tt & 15;
    const int lq = lane >> 4, li = lane & 15;
    LAS unsigned char* cb = lds + ch * RC_CH;
    const float* mu = a->in[I_RMU] + (size_t)l * RW_COLS;
    const int NQ = NB * NH * nblk;
    RCRegs RA, RB;
    if (vcu < NQ) rc_issue_q(ws, l, vcu, blk0, tid, RA);
    if (vcu + G < NQ) rc_issue_q(ws, l, vcu + G, blk0, tid, RB);
    for (int q0 = vcu; q0 < NQ; q0 += 2 * G) { { const int q = q0; RC_BUILD(RA, q); } if (q0 + G < NQ) { const int q = q0 + G; RC_BUILD(RB, q); } }
}
#ifndef RS_DEPTH
#define RS_DEPTH 4
#endif
struct RSRegs { v4u p[6]; };
__device__ __forceinline__ unsigned char* ubase(const unsigned char* p) {
    const unsigned lo = __builtin_amdgcn_readfirstlane((unsigned)(uintptr_t)p), hi = __builtin_amdgcn_readfirstlane((unsigned)((uintptr_t)p >> 32));
    return (unsigned char*)(((uintptr_t)hi << 32) | lo);
}
struct RSOff { unsigned g[6], s[6]; };
__device__ __forceinline__ void rs_offsets(int lt, RSOff& F) {
#pragma unroll
    for (int j = 0; j < 6; ++j) { const int uu = min(lt + 256 * j, 2 * REC_UNITS - 1); const int cc = uu >= REC_UNITS, u = uu - cc * REC_UNITS;
        F.g[j] = uu * 16 + cc * (REC_BYTES - REC_UNITS * 16); F.s[j] = cc * RS_CH + rs_unit_off(u); }
}
__device__ __forceinline__ void rs_issue(unsigned char* ws, size_t cu0, const RSOff& F, RSRegs& R) {
    const unsigned char* base = ubase(rc_rec(ws, cu0));
#pragma unroll
    for (int j = 0; j < 6; ++j) R.p[j] = *(const GAS v4u*)(base + F.g[j]);
}
__device__ __forceinline__ void rs_store(LAS unsigned char* slot, const RSOff& F, const RSRegs& R) {
#pragma unroll
    for (int j = 0; j < 6; ++j) *(LAS v4u*)(slot + F.s[j]) = R.p[j];
}
struct R3Q { v4u a1, a2; };
__device__ __forceinline__ void r3q_issue(const unsigned char* ws, size_t row0, int h, int lt, R3Q& Q) {
    const unsigned off = (unsigned)(((lt >> 3) * DBR + 8 * (lt & 7)) * 2); const size_t ub = (row0 * DBR + h * 64) * 2;
    Q.a1 = *(const GAS v4u*)(ubase(ws + WS_RG + ub) + off); Q.a2 = *(const GAS v4u*)(ubase(ws + WS_RA + ub) + off);
}
__device__ __forceinline__ float dpp8sum(float x) {
    x += __builtin_bit_cast(float, __builtin_amdgcn_update_dpp(0, __builtin_bit_cast(int, x), 0xB1, 0xf, 0xf, false));
    x += __builtin_bit_cast(float, __builtin_amdgcn_update_dpp(0, __builtin_bit_cast(int, x), 0x4E, 0xf, 0xf, false));
    x += __builtin_bit_cast(float, __builtin_amdgcn_update_dpp(0, __builtin_bit_cast(int, x), 0x141, 0xf, 0xf, false));
    return x;
}
__device__ __forceinline__ void r3_block(const LAS unsigned char* yb, bf16* YC, size_t row0, int h, int lt, const R3Q& Q) {
    const int tk = lt >> 3, c8 = 8 * (lt & 7);
    const v4u yy = *(const LAS v4u*)(yb + (tk * 72 + c8) * 2);
    float d[8] = {bflo(yy.x), bfhi(yy.x), bflo(yy.y), bfhi(yy.y), bflo(yy.z), bfhi(yy.z), bflo(yy.w), bfhi(yy.w)};
    const float m = dpp8sum(((d[0] + d[1]) + (d[2] + d[3])) + ((d[4] + d[5]) + (d[6] + d[7]))) * (1.f / 64.f);
    float q = 0.f;
#pragma unroll
    for (int j = 0; j < 8; ++j) { d[j] -= m; q = fmaf(d[j], d[j], q); }
    const float rstd = rsqrtf(dpp8sum(q) * (1.f / 64.f) + RWKV_GN_EPS);
    const unsigned a1[4] = {Q.a1.x, Q.a1.y, Q.a1.z, Q.a1.w}, a2[4] = {Q.a2.x, Q.a2.y, Q.a2.z, Q.a2.w}; unsigned o[4];
#pragma unroll
    for (int j = 0; j < 4; ++j) o[j] = pk2(fmaf(d[2 * j] * rstd, bflo(a1[j]), bflo(a2[j])), fmaf(d[2 * j + 1] * rstd, bfhi(a1[j]), bfhi(a2[j])));
    v4u w; w.x = o[0]; w.y = o[1]; w.z = o[2]; w.w = o[3];
    *(GAS v4u*)(ubase((const unsigned char*)(YC + row0 * DM + 384 + h * 64)) + (unsigned)((tk * DM + c8) * 2)) = w;
}
template <int VAR = 0>
__device__ __forceinline__ void phase_r2_scan(KArgsP a, LAS unsigned char* lds, int tid, int lane, int wave, int wg, int l, int bsplit = SEQ / 32, unsigned nbuilders = 0u) {
    unsigned char* ws = a->ws; bf16* YC = (bf16*)(ws + WS_YC);
    const int b = wg / NH, h = wg % NH; const size_t rowb = (size_t)b * SEQ, cub = (size_t)wg * 512;
    const int lq = lane >> 4, li = lane & 15, lt = tid - 256; const bool loader = wave >= 4;
    f32x4 Sacc[RS_TILES][4]; bf16x8 Sb01[RS_TILES], Sb23[RS_TILES];
#pragma unroll
    for (int vt = 0; vt < RS_TILES; ++vt) {
#pragma unroll
        for (int kt = 0; kt < 4; ++kt) Sacc[vt][kt] = (f32x4){0.f, 0.f, 0.f, 0.f};
        Sb01[vt] = (bf16x8){0, 0, 0, 0, 0, 0, 0, 0}; Sb23[vt] = Sb01[vt]; }
    constexpr int NBLK = SEQ / 32;
    LAS unsigned char* yb0 = lds + 8 * RS_CH; LAS unsigned char* yb1 = yb0 + 32 * 72 * 2;
    static_assert(8 * RS_CH + 2 * 32 * 72 * 2 <= MISC_OFF, "scan LDS layout");
    if (wave < 4 / RS_TILES) {
        RSOps OA, OB;
        RC_BAR();
        rs_load(lds, wave, li, lq, OA);
#pragma unroll 1
        for (int X = 0; X < NBLK; ++X) {
            LAS unsigned char* sl = lds + (X & 3) * 2 * RS_CH; LAS unsigned char* sn = lds + ((X + 1) & 3) * 2 * RS_CH; LAS unsigned char* yb = yb0 + (X & 1) * (32 * 72 * 2);
            if (X == bsplit - 7 && wave == 0) {
                if (lane == 0) { unsigned* bar_ = (unsigned*)(ws + WS_CTL) + CW_BAR; unsigned* cnt_ = (unsigned*)(ws + WS_CTL) + CW_Q + 64 * l + 48; XB_SPIN(xb_ld(cnt_) < nbuilders, bar_); }
                __builtin_amdgcn_fence(__ATOMIC_ACQUIRE, "agent"); asm volatile("s_waitcnt vmcnt(0)" ::: "memory");
            }
            rs_load(sl + RS_CH, wave, li, lq, OB); __builtin_amdgcn_sched_barrier(0); if (VAR != 2) { RC_CHUNK(OA, 0, yb); } else { asm volatile("" :: "v"(OA.a01), "v"(OA.bk[3]), "v"(OA.g[3])); }
            rs_load(sn, wave, li, lq, OA); __builtin_amdgcn_sched_barrier(0); if (VAR != 2) { RC_CHUNK(OB, 1, yb); } else { asm volatile("" :: "v"(OB.a01), "v"(OB.bk[3]), "v"(OB.g[3])); }
            RC_BAR();
        }
    } else if (!loader) {
        RC_BAR();
        for (int X = 0; X < NBLK; ++X) RC_BAR();
    } else {
        constexpr int ND = 4;
        RSRegs R[ND]; R3Q Q[ND]; RSOff F; rs_offsets(lt, F);
#pragma unroll
        for (int j = 0; j < ND; ++j) { rs_issue(ws, cub + 2 * j, F, R[j]); r3q_issue(ws, rowb + 32 * j, h, lt, Q[j]); }
        rs_store(lds, F, R[0]); rs_issue(ws, cub + 2 * ND, F, R[0]); rs_store(lds + 2 * RS_CH, F, R[1]); rs_issue(ws, cub + 2 * (ND + 1), F, R[1]);
        RC_BAR();
        for (int bb = 0; bb < NBLK; bb += ND) {
#pragma unroll
            for (int j = 0; j < ND; ++j) { const int X = bb + j;
                if (VAR != 1) { r3_block((j & 1) ? yb0 : yb1, YC, rowb + (size_t)max(X - 1, 0) * 32, h, lt, Q[(j + ND - 1) % ND]);
                r3q_issue(ws, rowb + (size_t)min(X - 1 + ND, NBLK - 1) * 32, h, lt, Q[(j + ND - 1) % ND]); }
                rs_store(lds + ((j + 2) & 3) * 2 * RS_CH, F, R[(j + 2) % ND]);
                rs_issue(ws, cub + 2 * (size_t)min(X + 2 + ND, NBLK - 1), F, R[(j + 2) % ND]);
                RC_BAR();
            }
        }
        r3_block(yb1, YC, rowb + (size_t)(NBLK - 1) * 32, h, lt, Q[(NBLK - 1) % ND]);
    }
}
__device__ __forceinline__ void phase_r3(KArgsP a, int lane, int gw, int ngw, int l) {
    unsigned char* ws = a->ws; const bf16* PROJ = (const bf16*)(ws + WS_PROJ); bf16* YC = (bf16*)(ws + WS_YC);
    const bf16* RA = (const bf16*)(ws + WS_RA); const bf16* RG = (const bf16*)(ws + WS_RG); const bf16* RVG = (const bf16*)(ws + WS_RVG); const bf16* VF = (const bf16*)(ws + WS_VF);
    const float* mu = a->in[I_RMU] + (size_t)l * RW_COLS;
    for (size_t row = gw; row < NTOK; row += ngw) {
#pragma unroll
        for (int h = 0; h < NH; ++h) {
            const int c = h * 64 + lane;
            const float y = bf2f(YC[row * DM + 384 + c]);
            const float m = dpp_allsum(y) * (1.f / 64.f); const float d = y - m; const float var = dpp_allsum(d * d) * (1.f / 64.f);
            const float yn = d * rsqrtf(var + RWKV_GN_EPS) * a->in[I_RLNW][l * DBR + c] + a->in[I_RLNB][l * DBR + c];
            const float rs = rw_shift(PROJ, mu, row, RWC_R + c), ks = rw_shift(PROJ, mu, row, RWC_K + c); float v = rw_shift(PROJ, mu, row, RWC_V + c);
            if (l > 0) v = v + (bf2f(VF[row * DBR + c]) - v) * bf2f(RVG[row * DBR + c]);
            const float av = bf2f(RA[row * DBR + c]);
            const float km = ks * (1.f + (av - 1.f) * a->in[I_RKA][l * DBR + c]);
            const float rk = dpp_allsum(rs * km * a->in[I_RRK][l * DBR + c]);
            YC[row * DM + 384 + c] = (bf16)f2bf((yn + rk * v) * bf2f(RG[row * DBR + c]));
        }
    }
}

constexpr int PH_PER_LAYER = 10, PH_FINAL = 1 + 2 * PH_PER_LAYER, N_PHASES = PH_FINAL + 1;
constexpr int R2_WGS = 24;
__global__ void __launch_bounds__(NTHR, 2) fwd(Args args) {
    extern __shared__ __attribute__((aligned(16))) unsigned char lds_raw[];
    LAS unsigned char* lds = (LAS unsigned char*)lds_raw;
    volatile LAS unsigned* MISC = (volatile LAS unsigned*)(lds + MISC_OFF);
    const int tid0 = threadIdx.x;
    const int G = gridDim.x;
#define PHASE_IDS int tid_ = threadIdx.x; asm volatile("" : "+v"(tid_)); const int tid = tid_, lane = tid & 63, wave = __builtin_amdgcn_readfirstlane(tid >> 6); \
    int bx_ = blockIdx.x; asm volatile("" : "+s"(bx_)); const int bx = bx_; const int vcu = (G % 8 == 0) ? (bx % 8) * (G / 8) + bx / 8 : bx; (void)lane; (void)wave; (void)vcu; (void)bx;
    unsigned char* ws0 = fresh_args()->ws;
    for (int u = tid0; u < (LDS_BYTES - RING_BYTES) / 4; u += NTHR) ((LAS unsigned*)(lds + RING_BYTES))[u] = 0u;
    __syncthreads();
    XcdBarrier bar; bar.bar = (unsigned*)(ws0 + WS_CTL) + CW_BAR; bar.x = 0; bar.st = nullptr;
    if (!MK_PER_PHASE) bar = xcd_barrier_post((unsigned*)(ws0 + WS_CTL) + CW_BAR, MISC + 8);
#if MK_PER_PHASE
    const int lo = args.ph_lo, hi = args.ph_hi;
#define IN(k) (lo <= (k) && (k) < hi)
#else
#define IN(k) true
#endif
#define SEAM(k) do { if (IN(k) && IN((k) + 1)) { XcdBarrier b2 = bar; asm volatile("" : "+s"(b2.bar)); xcd_barrier(b2); } } while (0)

#ifndef GEMM_SP2
#define GEMM_SP2 true
#endif
#ifndef GEMM_ALIGN
#define GEMM_ALIGN true
#endif
#ifndef RS_DEPTH
#define RS_DEPTH 4
#endif
#ifndef R2_SPLIT
#define R2_SPLIT 160
#endif
#ifndef SCANVAR
#define SCANVAR 0
#endif
#ifndef DBL_SUB
#define DBL_SUB 0
#endif
#ifndef DBL_PHASE
#define DBL_PHASE (-1)
#endif
#ifndef REPN
#define REPN 2
#endif
#define SUBREP(k) _Pragma("nounroll") for (int q_ = 0; q_ < 1 + (REPN - 1) * (((k) == DBL_SUB) && l == 0); ++q_)
#define REP(k) for (int rep_ = 0; rep_ < ((k) == DBL_PHASE ? REPN : 1); ++rep_)
#define REPBAR if (rep_ > 0) { XcdBarrier b2 = bar; asm volatile("" : "+s"(b2.bar)); xcd_barrier(b2); }
    REP(0) if (IN(0)) { REPBAR KArgsP ap = fresh_args(); PHASE_IDS
_Pragma("nounroll")
 for (int q_ = 0; q_ < 1 + (REPN - 1) * (DBL_SUB == 12); ++q_) { phase_prologue(ap, lds, tid, lane, wave, vcu, G); __syncthreads(); } }
    SEAM(0);
#ifdef EXTRA_BAR
    for (int eb_ = 0; eb_ < EXTRA_BAR; ++eb_) { XcdBarrier b2 = bar; asm volatile("" : "+s"(b2.bar)); xcd_barrier(b2); }
#endif
#define LCONST 0
    {
        constexpr int l = LCONST; constexpr int pb = 1 + l * PH_PER_LAYER;
        REP(pb + 0) if (IN(pb + 0)) { REPBAR KArgsP ap = fresh_args(); PHASE_IDS unsigned char* ws = ap->ws; (void)ws;
            if (l == 0) { mod_finalize(ws, tid, G); SUBREP(6) { phase_rownorm<0, false>(ap, lds, tid, lane, wave, G, ap->in[I_X], ap->out, ap->in[I_NORM_MIX], true, 0, 0, 0); __syncthreads(); } }
            else {
#if EN_MOE
                phase_rownorm<0, true>(ap, lds, tid, lane, wave, G, ap->out, ap->out, ap->in[I_NORM_MIX] + l * DM, false, l, 0, l - 1);
#else
                phase_rownorm<0, false>(ap, lds, tid, lane, wave, G, ap->out, ap->out, ap->in[I_NORM_MIX] + l * DM, false, l, 0, l - 1);
#endif
            }
        }
        SEAM(pb + 0);
        REP(pb + 1) if (IN(pb + 1)) { REPBAR KArgsP ap = fresh_args(); PHASE_IDS unsigned char* ws = ap->ws; (void)ws;
            pg8::Gemm g{(const pg8::bf16_t*)(ws + WS_HN), (const pg8::bf16_t*)(ws + WS_WIN) + (size_t)l * NPROJ_PAD * DM, NTOK, NPROJ_PAD, DM};
            pg8::StaticOrder S; S.init(NTOK, NPROJ_PAD, G, bx);
            pg8::EpiProj E{(pg8::bf16_t*)(ws + WS_PROJ), (float*)(ws + WS_GATES)};
SUBREP(7) { pg8::gemm_phase<pg8::EpiProj, pg8::StaticOrder, GEMM_ALIGN, GEMM_SP2>(lds, g, S, E); __syncthreads(); }
        }
        SEAM(pb + 1);
        REP(pb + 2) if (IN(pb + 2)) { REPBAR KArgsP ap = fresh_args(); PHASE_IDS unsigned char* ws = ap->ws; (void)ws;
#if EN_MLSTM
            for (int q_ = 0; q_ < 1 + (REPN - 1) * ((DBL_SUB == 1) && l == 0); ++q_) { phase_m1(ap, lds, tid, lane, wave, vcu, G, l); __syncthreads(); }
            __syncthreads();
#endif
#if EN_S5
            phase_s1(ap, lds, tid, lane, wave, vcu, G, l); __syncthreads();
#if DBL_SUB == 2
            if (l == 0) { phase_s1(ap, lds, tid, lane, wave, vcu, G, l); __syncthreads(); phase_s1(ap, lds, tid, lane, wave, vcu, G, l); __syncthreads(); phase_s1(ap, lds, tid, lane, wave, vcu, G, l); __syncthreads(); phase_s1(ap, lds, tid, lane, wave, vcu, G, l); __syncthreads(); }
#endif
            __syncthreads();
#endif
#if EN_RWKV
            for (int q_ = 0; q_ < 1 + (REPN - 1) * ((DBL_SUB == 3) && l == 0); ++q_) { phase_r1(ap, lds, tid, lane, wave, vcu, G, l); __syncthreads(); }
#endif
        }
        SEAM(pb + 2);
        REP(pb + 3) if (IN(pb + 3)) { REPBAR KArgsP ap = fresh_args(); PHASE_IDS unsigned char* ws = ap->ws; (void)ws;
            phase_m2(ws, tid, vcu, G);
            phase_s2(ap, tid, vcu, G, l);
            __syncthreads();
            phase_r2_build(ap, lds, tid, lane, wave, vcu, G, l, 0, R2_SPLIT);
        }
        SEAM(pb + 3);
        REP(pb + 4) if (IN(pb + 4)) { REPBAR KArgsP ap = fresh_args(); PHASE_IDS unsigned char* ws = ap->ws; (void)ws;
            if (bx < R2_WGS) {
#if DBL_SUB == 4
                if (l == 0) { for (int q_ = 0; q_ < REPN - 1; ++q_) { phase_r2_scan<SCANVAR>(ap, lds, tid, lane, wave, bx, l, R2_SPLIT, (unsigned)(G - R2_WGS)); __syncthreads(); } }
#endif
                phase_r2_scan(ap, lds, tid, lane, wave, bx, l, R2_SPLIT, (unsigned)(G - R2_WGS)); __syncthreads(); }
            else {
                phase_r2_build(ap, lds, tid, lane, wave, bx - R2_WGS, G - R2_WGS, l, R2_SPLIT, SEQ / 32 - R2_SPLIT);
                asm volatile("s_waitcnt vmcnt(0)" ::: "memory"); __syncthreads();
                if (tid == 0) { __builtin_amdgcn_fence(__ATOMIC_RELEASE, "agent"); asm volatile("s_waitcnt vmcnt(0)" ::: "memory"); (void)xb_add((unsigned*)(ws + WS_CTL) + CW_Q + 64 * l + 48, 1u); }
                phase_s3(ap, lds, tid, lane, wave, 0, 1, l, (unsigned*)(ws + WS_CTL) + CW_Q + 64 * l + 32); __syncthreads();
            }
            {
                unsigned* qctr = (unsigned*)(ws + WS_CTL) + CW_Q + 64 * l; volatile LAS unsigned* qw = (volatile LAS unsigned*)(lds + MISC_OFF) + 16;
                unsigned nxt = 0u; if (tid == 0) nxt = __hip_atomic_fetch_add(qctr, 1u, __ATOMIC_RELAXED, __HIP_MEMORY_SCOPE_AGENT);
                for (;;) {
                    if (tid == 0) *qw = nxt;
                    __syncthreads();
                    const int u = (int)*qw;
                    __syncthreads();
                    if (u >= NUNIT_M) break;
                    if (tid == 0) nxt = __hip_atomic_fetch_add(qctr, 1u, __ATOMIC_RELAXED, __HIP_MEMORY_SCOPE_AGENT);
                    phase_m3(ap, lds, tid, lane, wave, u, NUNIT_M, l);
                }
            }
        }
        SEAM(pb + 4);
        REP(pb + 6) if (IN(pb + 6)) { REPBAR KArgsP ap = fresh_args(); PHASE_IDS unsigned char* ws = ap->ws; (void)ws;
            pg8::Gemm g{(const pg8::bf16_t*)(ws + WS_YC), (const pg8::bf16_t*)(ws + WS_WOUT) + (size_t)l * DM * DM, NTOK, DM, DM};
            pg8::StaticOrder S; S.init(NTOK, DM, G, bx);
            pg8::EpiResid E{l == 0 ? ap->in[I_X] : (const float*)ap->out, ap->out, (const float*)(ws + WS_MODF) + (size_t)l * 4 * 6144, 2048};
SUBREP(8) { pg8::gemm_phase<pg8::EpiResid, pg8::StaticOrder, GEMM_ALIGN, GEMM_SP2>(lds, g, S, E); __syncthreads(); }
        }
        SEAM(pb + 6);
#if EN_MOE
        REP(pb + 7) if (IN(pb + 7)) { REPBAR KArgsP ap = fresh_args(); PHASE_IDS phase_router(ap, lds, tid, lane, wave, G, l); __syncthreads();
            SUBREP(11) {
            moe_convert13(ap->in[I_MW1], ap->in[I_MW3], l, (bf16*)(ap->ws + WS_W13), vcu * NWAVES + wave, G * NWAVES, (LAS float*)(lds + wave * 16640), lane);
            moe_convert2(ap->in[I_MW2], l, (bf16*)(ap->ws + WS_W2), vcu * NWAVES + wave, G * NWAVES, (LAS float*)(lds + wave * 16640), lane); __syncthreads(); } }
        SEAM(pb + 7);
        REP(pb + 8) if (IN(pb + 8)) { REPBAR KArgsP ap = fresh_args(); PHASE_IDS unsigned char* ws = ap->ws; (void)ws;
            LAS int* ptab = (LAS int*)(lds + PTAB_OFF); LAS int* pst = ptab + 512; LAS int* cnt = pst + 32;
            build_ptab((const unsigned*)(ws + WS_CTL) + CW_CNT + l * 32, ptab, pst, cnt, tid);
            pg8::Gemm g{(const pg8::bf16_t*)(ws + WS_HN), (const pg8::bf16_t*)(ws + WS_W13), 0, 0, DM, (const int*)(ws + WS_LIST), ptab};
            pg8::MoeOrder S{ptab, G, vcu};
            pg8::EpiSwiglu E{(pg8::bf16_t*)(ws + WS_HMID)};
SUBREP(9) { pg8::gemm_phase<pg8::EpiSwiglu, pg8::MoeOrder, false, true, true>(lds, g, S, E); __syncthreads(); }
        }
        SEAM(pb + 8);
        REP(pb + 9) if (IN(pb + 9)) { REPBAR KArgsP ap = fresh_args(); PHASE_IDS unsigned char* ws = ap->ws; (void)ws;
            LAS int* ptab = (LAS int*)(lds + PTAB_OFF); LAS int* pst = ptab + 512; LAS int* cnt = pst + 32;
            build_ptab((const unsigned*)(ws + WS_CTL) + CW_CNT + l * 32, ptab, pst, cnt, tid);
            pg8::Gemm g{(const pg8::bf16_t*)(ws + WS_HMID), (const pg8::bf16_t*)(ws + WS_W2), 0, 0, DEXP};
            pg8::MoeOrder S{ptab, G, vcu};
            pg8::EpiMoeOut E{(pg8::bf16_t*)(ws + WS_YMOE), (const int*)(ws + WS_LIST), ptab};
SUBREP(10) { pg8::gemm_phase<pg8::EpiMoeOut, pg8::MoeOrder, true, true>(lds, g, S, E); __syncthreads(); }
        }
        SEAM(pb + 9);
#else
        SEAM(pb + 6); SEAM(pb + 7); SEAM(pb + 8); SEAM(pb + 9);
#endif
    }
#undef LCONST
#if N_LAYERS > 1
#define LCONST 1
    {
        constexpr int l = LCONST; constexpr int pb = 1 + l * PH_PER_LAYER;
        REP(pb + 0) if (IN(pb + 0)) { REPBAR KArgsP ap = fresh_args(); PHASE_IDS unsigned char* ws = ap->ws; (void)ws;
            if (l == 0) { mod_finalize(ws, tid, G); SUBREP(6) { phase_rownorm<0, false>(ap, lds, tid, lane, wave, G, ap->in[I_X], ap->out, ap->in[I_NORM_MIX], true, 0, 0, 0); __syncthreads(); } }
            else {
#if EN_MOE
                phase_rownorm<0, true>(ap, lds, tid, lane, wave, G, ap->out, ap->out, ap->in[I_NORM_MIX] + l * DM, false, l, 0, l - 1);
#else
                phase_rownorm<0, false>(ap, lds, tid, lane, wave, G, ap->out, ap->out, ap->in[I_NORM_MIX] + l * DM, false, l, 0, l - 1);
#endif
            }
        }
        SEAM(pb + 0);
        REP(pb + 1) if (IN(pb + 1)) { REPBAR KArgsP ap = fresh_args(); PHASE_IDS unsigned char* ws = ap->ws; (void)ws;
            pg8::Gemm g{(const pg8::bf16_t*)(ws + WS_HN), (const pg8::bf16_t*)(ws + WS_WIN) + (size_t)l * NPROJ_PAD * DM, NTOK, NPROJ_PAD, DM};
            pg8::StaticOrder S; S.init(NTOK, NPROJ_PAD, G, bx);
            pg8::EpiProj E{(pg8::bf16_t*)(ws + WS_PROJ), (float*)(ws + WS_GATES)};
SUBREP(7) { pg8::gemm_phase<pg8::EpiProj, pg8::StaticOrder, GEMM_ALIGN, GEMM_SP2>(lds, g, S, E); __syncthreads(); }
        }
        SEAM(pb + 1);
        REP(pb + 2) if (IN(pb + 2)) { REPBAR KArgsP ap = fresh_args(); PHASE_IDS unsigned char* ws = ap->ws; (void)ws;
#if EN_MLSTM
            for (int q_ = 0; q_ < 1 + (REPN - 1) * ((DBL_SUB == 1) && l == 0); ++q_) { phase_m1(ap, lds, tid, lane, wave, vcu, G, l); __syncthreads(); }
            __syncthreads();
#endif
#if EN_S5
            phase_s1(ap, lds, tid, lane, wave, vcu, G, l); __syncthreads();
#if DBL_SUB == 2
            if (l == 0) { phase_s1(ap, lds, tid, lane, wave, vcu, G, l); __syncthreads(); phase_s1(ap, lds, tid, lane, wave, vcu, G, l); __syncthreads(); phase_s1(ap, lds, tid, lane, wave, vcu, G, l); __syncthreads(); phase_s1(ap, lds, tid, lane, wave, vcu, G, l); __syncthreads(); }
#endif
            __syncthreads();
#endif
#if EN_RWKV
            for (int q_ = 0; q_ < 1 + (REPN - 1) * ((DBL_SUB == 3) && l == 0); ++q_) { phase_r1(ap, lds, tid, lane, wave, vcu, G, l); __syncthreads(); }
#endif
        }
        SEAM(pb + 2);
        REP(pb + 3) if (IN(pb + 3)) { REPBAR KArgsP ap = fresh_args(); PHASE_IDS unsigned char* ws = ap->ws; (void)ws;
            phase_m2(ws, tid, vcu, G);
            phase_s2(ap, tid, vcu, G, l);
            __syncthreads();
            phase_r2_build(ap, lds, tid, lane, wave, vcu, G, l, 0, R2_SPLIT);
        }
        SEAM(pb + 3);
        REP(pb + 4) if (IN(pb + 4)) { REPBAR KArgsP ap = fresh_args(); PHASE_IDS unsigned char* ws = ap->ws; (void)ws;
            if (bx < R2_WGS) {
#if DBL_SUB == 4
                if (l == 0) { for (int q_ = 0; q_ < REPN - 1; ++q_) { phase_r2_scan<SCANVAR>(ap, lds, tid, lane, wave, bx, l, R2_SPLIT, (unsigned)(G - R2_WGS)); __syncthreads(); } }
#endif
                phase_r2_scan(ap, lds, tid, lane, wave, bx, l, R2_SPLIT, (unsigned)(G - R2_WGS)); __syncthreads(); }
            else {
                phase_r2_build(ap, lds, tid, lane, wave, bx - R2_WGS, G - R2_WGS, l, R2_SPLIT, SEQ / 32 - R2_SPLIT);
                asm volatile("s_waitcnt vmcnt(0)" ::: "memory"); __syncthreads();
                if (tid == 0) { __builtin_amdgcn_fence(__ATOMIC_RELEASE, "agent"); asm volatile("s_waitcnt vmcnt(0)" ::: "memory"); (void)xb_add((unsigned*)(ws + WS_CTL) + CW_Q + 64 * l + 48, 1u); }
                phase_s3(ap, lds, tid, lane, wave, 0, 1, l, (unsigned*)(ws + WS_CTL) + CW_Q + 64 * l + 32); __syncthreads();
            }
            {
                unsigned* qctr = (unsigned*)(ws + WS_CTL) + CW_Q + 64 * l; volatile LAS unsigned* qw = (volatile LAS unsigned*)(lds + MISC_OFF) + 16;
                unsigned nxt = 0u; if (tid == 0) nxt = __hip_atomic_fetch_add(qctr, 1u, __ATOMIC_RELAXED, __HIP_MEMORY_SCOPE_AGENT);
                for (;;) {
                    if (tid == 0) *qw = nxt;
                    __syncthreads();
                    const int u = (int)*qw;
                    __syncthreads();
                    if (u >= NUNIT_M) break;
                    if (tid == 0) nxt = __hip_atomic_fetch_add(qctr, 1u, __ATOMIC_RELAXED, __HIP_MEMORY_SCOPE_AGENT);
                    phase_m3(ap, lds, tid, lane, wave, u, NUNIT_M, l);
                }
            }
        }
        SEAM(pb + 4);
        REP(pb + 6) if (IN(pb + 6)) { REPBAR KArgsP ap = fresh_args(); PHASE_IDS unsigned char* ws = ap->ws; (void)ws;
            pg8::Gemm g{(const pg8::bf16_t*)(ws + WS_YC), (const pg8::bf16_t*)(ws + WS_WOUT) + (size_t)l * DM * DM, NTOK, DM, DM};
            pg8::StaticOrder S; S.init(NTOK, DM, G, bx);
            pg8::EpiResid E{l == 0 ? ap->in[I_X] : (const float*)ap->out, ap->out, (const float*)(ws + WS_MODF) + (size_t)l * 4 * 6144, 2048};
SUBREP(8) { pg8::gemm_phase<pg8::EpiResid, pg8::StaticOrder, GEMM_ALIGN, GEMM_SP2>(lds, g, S, E); __syncthreads(); }
        }
        SEAM(pb + 6);
#if EN_MOE
        REP(pb + 7) if (IN(pb + 7)) { REPBAR KArgsP ap = fresh_args(); PHASE_IDS phase_router(ap, lds, tid, lane, wave, G, l); __syncthreads();
            SUBREP(11) {
            moe_convert13(ap->in[I_MW1], ap->in[I_MW3], l, (bf16*)(ap->ws + WS_W13), vcu * NWAVES + wave, G * NWAVES, (LAS float*)(lds + wave * 16640), lane);
            moe_convert2(ap->in[I_MW2], l, (bf16*)(ap->ws + WS_W2), vcu * NWAVES + wave, G * NWAVES, (LAS float*)(lds + wave * 16640), lane); __syncthreads(); } }
        SEAM(pb + 7);
        REP(pb + 8) if (IN(pb + 8)) { REPBAR KArgsP ap = fresh_args(); PHASE_IDS unsigned char* ws = ap->ws; (void)ws;
            LAS int* ptab = (LAS int*)(lds + PTAB_OFF); LAS int* pst = ptab + 512; LAS int* cnt = pst + 32;
            build_ptab((const unsigned*)(ws + WS_CTL) + CW_CNT + l * 32, ptab, pst, cnt, tid);
            pg8::Gemm g{(const pg8::bf16_t*)(ws + WS_HN), (const pg8::bf16_t*)(ws + WS_W13), 0, 0, DM, (const int*)(ws + WS_LIST), ptab};
            pg8::MoeOrder S{ptab, G, vcu};
            pg8::EpiSwiglu E{(pg8::bf16_t*)(ws + WS_HMID)};
SUBREP(9) { pg8::gemm_phase<pg8::EpiSwiglu, pg8::MoeOrder, false, true, true>(lds, g, S, E); __syncthreads(); }
        }
        SEAM(pb + 8);
        REP(pb + 9) if (IN(pb + 9)) { REPBAR KArgsP ap = fresh_args(); PHASE_IDS unsigned char* ws = ap->ws; (void)ws;
            LAS int* ptab = (LAS int*)(lds + PTAB_OFF); LAS int* pst = ptab + 512; LAS int* cnt = pst + 32;
            build_ptab((const unsigned*)(ws + WS_CTL) + CW_CNT + l * 32, ptab, pst, cnt, tid);
            pg8::Gemm g{(const pg8::bf16_t*)(ws + WS_HMID), (const pg8::bf16_t*)(ws + WS_W2), 0, 0, DEXP};
            pg8::MoeOrder S{ptab, G, vcu};
            pg8::EpiMoeOut E{(pg8::bf16_t*)(ws + WS_YMOE), (const int*)(ws + WS_LIST), ptab};
SUBREP(10) { pg8::gemm_phase<pg8::EpiMoeOut, pg8::MoeOrder, true, true>(lds, g, S, E); __syncthreads(); }
        }
        SEAM(pb + 9);
#else
        SEAM(pb + 6); SEAM(pb + 7); SEAM(pb + 8); SEAM(pb + 9);
#endif
    }
#undef LCONST
#endif
    if (IN(PH_FINAL)) { KArgsP ap = fresh_args(); PHASE_IDS
#if EN_MOE
        if (N_LAYERS > 0) phase_rownorm<1, true>(ap, lds, tid, lane, wave, G, ap->out, ap->out, ap->in[I_NORM_FINAL], false, 0, 0, N_LAYERS - 1);
        else phase_rownorm<1, false>(ap, lds, tid, lane, wave, G, ap->in[I_X], ap->out, ap->in[I_NORM_FINAL], false, 0, 0, 0);
#else
        phase_rownorm<1, false>(ap, lds, tid, lane, wave, G, N_LAYERS > 0 ? (const float*)ap->out : ap->in[I_X], ap->out, ap->in[I_NORM_FINAL], false, 0, 0, 0);
#endif
    }
#undef IN
#undef SEAM
}

extern "C" void kernel_launch(void* const* d_in, const int* in_sizes, int n_in, void* d_out, int out_size, void* d_ws, size_t ws_size, hipStream_t stream) {
    static int grid = 0;
    if (grid == 0) {
        if (n_in != 47 || out_size != NTOK * DM || ws_size < WS_END) { fprintf(stderr, "kernel_launch: unexpected problem (n_in %d, out %d, ws %zu < %zu)\n", n_in, out_size, ws_size, (size_t)WS_END); grid = -1; return; }
        int dev = 0, cus = 0, per_cu = 0;
        if (hipGetDevice(&dev) != hipSuccess || hipDeviceGetAttribute(&cus, hipDeviceAttributeMultiprocessorCount, dev) != hipSuccess) { grid = -1; return; }
        if (hipFuncSetAttribute((const void*)fwd, hipFuncAttributeMaxDynamicSharedMemorySize, LDS_BYTES) != hipSuccess) { fprintf(stderr, "kernel_launch: hipFuncSetAttribute failed\n"); grid = -1; return; }
        if (hipOccupancyMaxActiveBlocksPerMultiprocessor(&per_cu, (const void*)fwd, NTHR, LDS_BYTES) != hipSuccess || per_cu < 1) fprintf(stderr, "kernel_launch: occupancy query says %d\n", per_cu);
        (void)hipGetLastError();
        grid = cus;
        if (grid != 256) fprintf(stderr, "kernel_launch: %d CUs (built for 256)\n", grid);
    }
    if (grid < 0) return;
    (void)hipMemsetAsync((char*)d_ws + WS_CTL, 0, CTL_ZERO_BYTES, stream);
    Args a{};
    for (int i = 0; i < 47; ++i) a.in[i] = (const float*)d_in[i];
    a.out = (float*)d_out; a.ws = (unsigned char*)d_ws;
#if MK_PER_PHASE
    for (int p = 0; p < N_PHASES; ++p) { a.ph_lo = p; a.ph_hi = p + 1; hipLaunchKernelGGL(fwd, dim3(grid), dim3(NTHR), LDS_BYTES, stream, a); }
#else
    a.ph_lo = 0; a.ph_hi = N_PHASES; hipLaunchKernelGGL(fwd, dim3(grid), dim3(NTHR), LDS_BYTES, stream, a);
#endif
}
#ifdef DIAG_KERNELS
#define DK(name, ...) __global__ void __launch_bounds__(NTHR, 2) name(Args args) { extern __shared__ __attribute__((aligned(16))) unsigned char lds_raw[]; LAS unsigned char* lds = (LAS unsigned char*)lds_raw; \
    const int tid = threadIdx.x, lane = tid & 63, wave = __builtin_amdgcn_readfirstlane(tid >> 6); const int G = gridDim.x; const int bx = blockIdx.x; const int vcu = bx; KArgsP ap = fresh_args(); int l = ap->ph_lo; (void)lane; (void)wave; (void)vcu; (void)G; (void)l; __VA_ARGS__ }
DK(k_prologue, phase_prologue(ap, lds, tid, lane, wave, vcu, G);)
DK(k_norm0, phase_rownorm<0, false>(ap, lds, tid, lane, wave, G, ap->in[I_X], ap->out, ap->in[I_NORM_MIX], true, 0, 0, 0);)
DK(k_norm1, phase_rownorm<0, true>(ap, lds, tid, lane, wave, G, ap->out, ap->out, ap->in[I_NORM_MIX], false, l, 0, 0);)
DK(k_normf, phase_rownorm<1, true>(ap, lds, tid, lane, wave, G, ap->out, ap->out, ap->in[I_NORM_MIX], false, l, 0, 0);)
DK(k_m1, phase_m1(ap, lds, tid, lane, wave, vcu, G, l);)
DK(k_m2, phase_m2(ap->ws, tid, vcu, G);)
DK(k_m3, phase_m3(ap, lds, tid, lane, wave, vcu, G, l);)
DK(k_s1, phase_s1(ap, lds, tid, lane, wave, vcu, G, l);)
DK(k_s2, phase_s2(ap, tid, vcu, G, l);)
DK(k_s3, phase_s3(ap, lds, tid, lane, wave, vcu, G, l);)
DK(k_r1, phase_r1(ap, lds, tid, lane, wave, vcu, G, l);)
DK(k_r2b, phase_r2_build(ap, lds, tid, lane, wave, vcu, G, l);)
DK(k_r2s, phase_r2_scan(ap, lds, tid, lane, wave, vcu, l);)
DK(k_r3, phase_r3(ap, lane, vcu * NWAVES + wave, G * NWAVES, l);)
DK(k_router, phase_router(ap, lds, tid, lane, wave, G, l);)
DK(k_gather, phase_gather(ap, lds, tid, lane, wave, vcu, G, l);)
DK(k_moecv, moe_convert13(ap->in[I_MW1], ap->in[I_MW3], 1, (bf16*)(ap->ws + WS_W13), vcu * NWAVES + wave, G * NWAVES, (LAS float*)(lds + wave * 16640), lane);)
#endif
```

```cpp
#include <hip/hip_runtime.h>
#include <cstdio>
#include <cstdint>
#define MK_PER_PHASE 0

#ifndef MK_PER_PHASE
#define MK_PER_PHASE 0
#endif
#ifndef EN_MLSTM
#define EN_MLSTM 1
#endif
#ifndef EN_S5
#define EN_S5 1
#endif
#ifndef EN_RWKV
#define EN_RWKV 1
#endif
#ifndef EN_MOE
#define EN_MOE 1
#endif
#ifndef N_LAYERS
#define N_LAYERS 2
#endif
constexpr int NWAVES = 8, NTHR = 512;
constexpr int DM = 1024, NB = 4, SEQ = 8192, NTOK = NB * SEQ;
constexpr int DA = 384, DBR = 384, DC = 256, NH = 6, HD = 64, NCH = SEQ / 64;
constexpr int IN_COLS = 2828, NPROJ = 2816, NPROJ_PAD = 3072;
constexpr int PC_QK = 0, PC_V = 384, PC_O = 768, PC_RW = 1152, PC_S5 = 2560;
constexpr int RWC_R = 0, RWC_K = 384, RWC_V = 768, RWC_WD = 1152, RWC_AD = 1216, RWC_GD = 1280, RW_COLS = 1408;
constexpr int NEXP = 32, DEXP = 512, MOE_ROWS_MAX = 73728;
constexpr int NUNIT_M = NB * NCH * NH;
constexpr int CL_STRIDE = 4160;
constexpr float NORM_EPS = 1e-6f, HEAD_NORM_EPS = 1e-5f, RWKV_GN_EPS = 64e-5f;

constexpr size_t MiB = 1u << 20;
constexpr size_t WS_CTL = 0, CTL_ZERO_BYTES = 1 * MiB;
constexpr size_t WS_MODP = 1 * MiB;
constexpr size_t WS_MODF = 2 * MiB + 512 * 1024;
constexpr size_t WS_S5BB = 2 * MiB + 896 * 1024;
constexpr size_t WS_RTW = 3 * MiB;
constexpr size_t WS_S5AP = 3 * MiB + 384 * 1024;
constexpr size_t WS_MLW = 3 * MiB + 512 * 1024;
constexpr size_t WS_S5CM = 2 * MiB + 768 * 1024;
constexpr size_t WS_GLUT = 3 * MiB + 768 * 1024;
constexpr size_t WS_WIN = 4 * MiB;
constexpr size_t WS_WOUT = 16 * MiB;
constexpr size_t WS_GATES = 20 * MiB;
constexpr size_t WS_W13 = 22 * MiB;
constexpr size_t WS_W2 = 86 * MiB;
constexpr size_t WS_HN = 118 * MiB;
constexpr size_t WS_CLOC = 118 * MiB;
constexpr size_t WS_MSC = 168 * MiB;
constexpr size_t WS_S5ST = 170 * MiB;
constexpr size_t WS_VF = 182 * MiB;
constexpr size_t WS_YC = 206 * MiB;
constexpr size_t WS_LIST = 206 * MiB;
constexpr size_t WS_ROWMAP = 214 * MiB;
constexpr size_t WS_TOKE = 215 * MiB;
constexpr size_t WS_TOKW = 215 * MiB + 512 * 1024;
constexpr size_t WS_PROJ = 270 * MiB;
constexpr size_t WS_RE = 446 * MiB, WS_RA = 470 * MiB, WS_RG = 494 * MiB, WS_RVG = 518 * MiB;
constexpr size_t WS_XG = 270 * MiB;
constexpr size_t WS_HMID = 414 * MiB;
constexpr size_t WS_YMOE = 270 * MiB;
constexpr size_t WS_R1W = 542 * MiB;
constexpr size_t WS_OPA = 22 * MiB;
constexpr size_t WS_OPB = 543 * MiB;
constexpr size_t WS_END = 591 * MiB;
constexpr int CW_TMO = 0, CW_BAR = 4096, CW_CNT = 8192, CW_Q = 8320;

constexpr int RING_BYTES = 131072, MISC_OFF = 135168, PTAB_OFF = MISC_OFF + 1024, LDS_BYTES = 147456;

#define GAS __attribute__((address_space(1)))
#define LAS __attribute__((address_space(3)))
typedef unsigned short bf16;
typedef unsigned v4u __attribute__((ext_vector_type(4)));
typedef unsigned v2u __attribute__((ext_vector_type(2)));
typedef float f32x4 __attribute__((ext_vector_type(4)));
typedef float f32x2 __attribute__((ext_vector_type(2)));
typedef GAS unsigned gu32;
#define RLX_AGENT __ATOMIC_RELAXED, __HIP_MEMORY_SCOPE_AGENT
#define LDS_WAIT() asm volatile("s_waitcnt lgkmcnt(0)" ::: "memory")
#define VM_WAIT() asm volatile("s_waitcnt vmcnt(0)" ::: "memory")
typedef float f32x2v __attribute__((ext_vector_type(2)));
typedef __bf16 bf16x2v __attribute__((ext_vector_type(2)));
__device__ __forceinline__ unsigned pk2(float lo, float hi) { const f32x2v v = {lo, hi}; const bf16x2v b = __builtin_convertvector(v, bf16x2v); return __builtin_bit_cast(unsigned, b); }
__device__ __forceinline__ unsigned f2bf(float f) { return pk2(f, 0.f) & 0xffffu; }
__device__ __forceinline__ float bf2f(unsigned v) { return __builtin_bit_cast(float, v << 16); }
__device__ __forceinline__ float bflo(unsigned w) { return __builtin_bit_cast(float, w << 16); }
__device__ __forceinline__ float bfhi(unsigned w) { return __builtin_bit_cast(float, w & 0xffff0000u); }
__device__ __forceinline__ float sigmoidf_(float x) { return 1.f / (1.f + __expf(-x)); }
__device__ __forceinline__ float wave_sum(float v) {
#pragma unroll
    for (int o = 1; o < 64; o <<= 1) v += __shfl_xor(v, o);
    return v;
}
__device__ __forceinline__ float wave_max(float v) {
#pragma unroll
    for (int o = 1; o < 64; o <<= 1) v = fmaxf(v, __shfl_xor(v, o));
    return v;
}
namespace pg8 {
#define PG8_LAS __attribute__((address_space(3)))
typedef unsigned short bf16_t;
typedef short bf16x8 __attribute__((ext_vector_type(8)));
typedef float f32x4 __attribute__((ext_vector_type(4)));
typedef unsigned u32x4 __attribute__((ext_vector_type(4)));
constexpr int BM = 256, BK = 64, HALF = 128, HTB = HALF * BK * 2  , STAGE_BYTES = 8 * HTB, NXCD = 8, WGM = 8;

__host__ __device__ __forceinline__ int lds_byte(int r, int c) { const int st = (r >> 4) * 2 + (c >> 5), rr = r & 15, cc = c & 31, ob = rr * 64 + cc * 2; return st * 1024 + (ob ^ (((ob >> 9) & 1) << 5)); }
__host__ __device__ __forceinline__ void stage_rc(int b, int& R, int& C) { const int st = b / 1024, sb = b % 1024, swz = sb ^ (((sb >> 9) & 1) << 5); R = (st >> 1) * 16 + swz / 64; C = (st & 1) * 32 + (swz % 64) / 2; }
__host__ __device__ __forceinline__ int perm32(int rho) { const int n = rho >> 4, i = rho & 15; return 8 * (i >> 2) + 4 * n + (i & 3); }

struct Unit { int pm, pn; };
__device__ __forceinline__ int moe_tok2(const int* list, PG8_LAS const int* ptab, int row) { const int e = ptab[1 + (row >> 8)], pos = row - ptab[512 + e]; return pos < ptab[544 + e] ? list[(size_t)e * 65536 + pos] : -1; }
struct Gemm { const bf16_t* A; const bf16_t* Bt; int M, N, K; const int* list = nullptr; PG8_LAS const int* ptab = nullptr; };

struct StaticOrder {
    int nM, nN, nwg, G, c;
    __host__ __device__ void init(int M, int N, int G_, int c_) { nM = M / BM; nN = N / BM; nwg = nM * nN; G = G_; c = c_; }
    __host__ __device__ bool next(int i, Unit& u) const {
        const long L = (long)i * G + c; if (L >= nwg) return false;
        int wgid = (int)L; { const int q = nwg / NXCD, r = nwg % NXCD, xcd = wgid % NXCD, off = wgid / NXCD; wgid = (xcd < r ? xcd * (q + 1) : r * (q + 1) + (xcd - r) * q) + off; }
        const int nig = WGM * nN, gid = wgid / nig, fm = gid * WGM, gsz = (nM - fm) < WGM ? (nM - fm) : WGM;
        u.pm = fm + ((wgid % nig) % gsz); u.pn = (wgid % nig) / gsz; return true;
    }
    __device__ __forceinline__ void a_ready(const Unit&) const {}
    __device__ __forceinline__ void done(const Unit&) const {}
};

__device__ __forceinline__ unsigned cvt_pk_bf16(float lo, float hi) { unsigned r; asm volatile("v_cvt_pk_bf16_f32 %0, %1, %2" : "=v"(r) : "v"(lo), "v"(hi)); return r; }

struct EpiProj {
    static constexpr bool PERM = true, AFTER_DRAIN = false;
    bf16_t* O; float* G;
    __device__ __forceinline__ void operator()(const f32x4 (&acc)[2][2][4][2], const Unit& u, int wr, int wc, int fr, int fq) const {
        const int row0 = u.pm * BM + wr * 64 + fr;
        if (u.pn < 11) {
            const int col0 = u.pn * BM + wc * 32 + 8 * fq;
#pragma unroll
            for (int ai = 0; ai < 2; ++ai)
#pragma unroll
                for (int m = 0; m < 4; ++m) { bf16_t* rowp = O + (size_t)(row0 + ai * HALF + m * 16) * 2816 + col0;
#pragma unroll
                    for (int bj = 0; bj < 2; ++bj) { const f32x4 v0 = acc[ai][bj][m][0], v1 = acc[ai][bj][m][1];
                        u32x4 w; w.x = cvt_pk_bf16(v0[0], v0[1]); w.y = cvt_pk_bf16(v0[2], v0[3]); w.z = cvt_pk_bf16(v1[0], v1[1]); w.w = cvt_pk_bf16(v1[2], v1[3]);
                        *(u32x4*)(rowp + bj * HALF) = w; } }
        } else if (wc == 0 && fq < 2) {
#pragma unroll
            for (int ai = 0; ai < 2; ++ai)
#pragma unroll
                for (int m = 0; m < 4; ++m) { float* rowp = G + (size_t)(row0 + ai * HALF + m * 16) * 16 + 8 * fq;
                    *(f32x4*)(rowp) = acc[ai][0][m][0]; *(f32x4*)(rowp + 4) = acc[ai][0][m][1]; }
        }
    }
};
struct EpiResid {
    static constexpr bool PERM = true, AFTER_DRAIN = false;
    const float* xin; float* out; const float* gate;
    int goff;
    __device__ __forceinline__ void operator()(const f32x4 (&acc)[2][2][4][2], const Unit& u, int wr, int wc, int fr, int fq) const {
        const int row0 = u.pm * BM + wr * 64 + fr, col0 = u.pn * BM + wc * 32 + 8 * fq;
        const float* gp = gate + (size_t)(row0 >> 13) * 6144 + goff + col0;
        f32x4 g[2][2];
#pragma unroll
        for (int bj = 0; bj < 2; ++bj)
#pragma unroll
            for (int n = 0; n < 2; ++n) g[bj][n] = *(const f32x4*)(gp + bj * HALF + 4 * n) + 1.0f;
#pragma unroll
        for (int ai = 0; ai < 2; ++ai)
#pragma unroll
            for (int m = 0; m < 4; ++m) { const size_t off = (size_t)(row0 + ai * HALF + m * 16) * 1024 + col0;
#pragma unroll
                for (int bj = 0; bj < 2; ++bj)
#pragma unroll
                    for (int n = 0; n < 2; ++n) { const f32x4 xv = *(const f32x4*)(xin + off + bj * HALF + 4 * n);
                        *(f32x4*)(out + off + bj * HALF + 4 * n) = xv + g[bj][n] * acc[ai][bj][m][n]; } }
    }
};
struct EpiSwiglu {
    static constexpr bool PERM = true, AFTER_DRAIN = false;
    bf16_t* H;
    __device__ __forceinline__ void operator()(const f32x4 (&acc)[2][2][4][2], const Unit& u, int wr, int wc, int fr, int fq) const {
        const int row0 = u.pm * BM + wr * 64 + fr, hid0 = 128 * (u.pn & 3) + 16 * wc + 4 * fq;
#pragma unroll
        for (int ai = 0; ai < 2; ++ai)
#pragma unroll
            for (int m = 0; m < 4; ++m) { bf16_t* rowp = H + (size_t)(row0 + ai * HALF + m * 16) * 512 + hid0;
#pragma unroll
                for (int bj = 0; bj < 2; ++bj) { const f32x4 g = acc[ai][bj][m][0], uu = acc[ai][bj][m][1]; float h[4];
#pragma unroll
                    for (int i = 0; i < 4; ++i) h[i] = g[i] / (1.f + __expf(-g[i])) * uu[i];
                    unsigned w0 = cvt_pk_bf16(h[0], h[1]), w1 = cvt_pk_bf16(h[2], h[3]);
                    *(unsigned long long*)(rowp + 64 * bj) = (unsigned long long)w0 | ((unsigned long long)w1 << 32); } }
    }
};
struct EpiMoeOut {
    static constexpr bool PERM = true, AFTER_DRAIN = false;
    bf16_t* Y; const int* list; PG8_LAS const int* ptab;
    __device__ __forceinline__ void operator()(const f32x4 (&acc)[2][2][4][2], const Unit& u, int wr, int wc, int fr, int fq) const {
        const int row0 = u.pm * BM + wr * 64 + fr, col0 = (u.pn & 3) * BM + wc * 32 + 8 * fq;
#pragma unroll
        for (int ai = 0; ai < 2; ++ai)
#pragma unroll
            for (int m = 0; m < 4; ++m) { const int dst = moe_tok2(list, ptab, row0 + ai * HALF + m * 16);
                if (dst >= 0) { bf16_t* rowp = Y + (size_t)dst * 1024 + col0;
#pragma unroll
                    for (int bj = 0; bj < 2; ++bj) { const f32x4 v0 = acc[ai][bj][m][0], v1 = acc[ai][bj][m][1];
                        u32x4 w; w.x = cvt_pk_bf16(v0[0], v0[1]); w.y = cvt_pk_bf16(v0[2], v0[3]); w.z = cvt_pk_bf16(v1[0], v1[1]); w.w = cvt_pk_bf16(v1[2], v1[3]);
                        *(u32x4*)(rowp + bj * HALF) = w; } } }
    }
};
struct MoeOrder {
    PG8_LAS const int* ptab; int G, c;
    __device__ __forceinline__ bool next(int i, Unit& u) const {
        const int L = i * G + c, np = __builtin_amdgcn_readfirstlane(ptab[0]);
        if (L >= np * 4) return false;
        const int p = L >> 2; u.pm = p; u.pn = __builtin_amdgcn_readfirstlane(ptab[1 + p]) * 4 + (L & 3); return true;
    }
    __device__ __forceinline__ void a_ready(const Unit&) const {}
    __device__ __forceinline__ void done(const Unit&) const {}
};
template <class Epi, class Sched, bool ALIGN_EPI = false, bool SP2 = false, bool GATHER = false>
__device__ __forceinline__ void gemm_phase(PG8_LAS unsigned char* lds, const Gemm g, const Sched& S, const Epi& E) {
    int tid_ = threadIdx.x; asm volatile("" : "+v"(tid_));
    const int tid = tid_, wid = __builtin_amdgcn_readfirstlane(tid >> 6), lane = tid & 63, wr = wid >> 2, wc = wid & 3, fr = lane & 15, fq = lane >> 4;
    const int K = g.K, nt = K / BK;
    static_assert(!GATHER || SP2, "the gathered-A variant exists for the SP2 loop only");
    unsigned voffA[2], voffB[2];
    unsigned vAc[2] = {0u, 0u}, vAn[2] = {0u, 0u};
#pragma unroll
    for (int i = 0; i < 2; ++i) { int R, C; stage_rc(tid * 16 + i * 8192, R, C); const int Rb = Epi::PERM ? ((R & ~31) + perm32(R & 31)) : R;
        voffA[i] = (unsigned)(R * K + C) * 2u; voffB[i] = (unsigned)(Rb * K + C) * 2u; }
    const size_t kstep = (size_t)(BK * 2);
    const size_t hstep = (size_t)HALF * K * 2;
    const size_t tstep = 2 * hstep;
    const unsigned ldsw = (unsigned)wid * 1024u;
    const int aoff = lds_byte(wr * 64 + fr, fq * 8), boff = lds_byte(wc * 32 + fr, fq * 8);
#define PG8_SA(b, h) (((b) * 2 + (h)) * HTB)
#define PG8_SB(b, h) ((4 + (b) * 2 + (h)) * HTB)
#define PG8_STAGE(bufoff, gbase, voff) do { _Pragma("unroll") for (int _i = 0; _i < 2; ++_i) \
        __builtin_amdgcn_global_load_lds((const unsigned*)((const char*)(gbase) + (voff)[_i]), (PG8_LAS unsigned*)(lds + (bufoff) + ldsw + _i * 8192), 16, 0, 0); } while (0)
#define PG8_STAGEG(bufoff, base, pk) do { unsigned vg_[2]; _Pragma("unroll") for (int i_ = 0; i_ < 2; ++i_) { int R_, C_; stage_rc(tid * 16 + i_ * 8192, R_, C_); vg_[i_] = (((pk) >> (16 * i_)) & 0xffffu) * (unsigned)(2 * K) + (unsigned)(2 * C_); } PG8_STAGE(bufoff, base, vg_); } while (0)
#define PG8_STAGEA(bufoff, base, hh, nx) do { if constexpr (GATHER) { const unsigned pk_ = (nx) ? vAn[hh] : vAc[hh]; PG8_STAGEG(bufoff, base, pk_); } else PG8_STAGE(bufoff, (base) + (hh) * hstep, voffA); } while (0)
#define PG8_GOFF(dst, unit) do { _Pragma("unroll") for (int hh_ = 0; hh_ < 2; ++hh_) { unsigned pk_ = 0u; _Pragma("unroll") for (int i_ = 0; i_ < 2; ++i_) { int R_, C_; stage_rc(tid * 16 + i_ * 8192, R_, C_); \
        const int t2_ = moe_tok2(g.list, g.ptab, (unit).pm * BM + hh_ * HALF + R_); pk_ |= (unsigned)(t2_ < 0 ? 0 : (t2_ >> 1)) << (16 * i_); } dst[hh_] = pk_; } } while (0)
#define PG8_LDA(dst, b, h) do { _Pragma("unroll") for (int m = 0; m < 4; ++m) _Pragma("unroll") for (int k = 0; k < 2; ++k) dst[m][k] = *(const PG8_LAS bf16x8*)(lds + PG8_SA(b, h) + aoff + m * 2048 + k * 1024); } while (0)
#define PG8_LDB(dst, b, h) do { _Pragma("unroll") for (int n = 0; n < 2; ++n) _Pragma("unroll") for (int k = 0; k < 2; ++k) dst[n][k] = *(const PG8_LAS bf16x8*)(lds + PG8_SB(b, h) + boff + n * 2048 + k * 1024); } while (0)
#define PG8_MMA(ai, bj, At, Bt) do { __builtin_amdgcn_s_setprio(1); _Pragma("unroll") for (int m = 0; m < 4; ++m) _Pragma("unroll") for (int n = 0; n < 2; ++n) _Pragma("unroll") for (int k = 0; k < 2; ++k) \
        acc[ai][bj][m][n] = __builtin_amdgcn_mfma_f32_16x16x32_bf16(Bt[n][k], At[m][k], acc[ai][bj][m][n], 0, 0, 0); __builtin_amdgcn_s_setprio(0); } while (0)
#define PG8_WAIT_V(n) asm volatile("s_waitcnt vmcnt(" #n ")" ::: "memory")
#define PG8_WAIT_L(n) asm volatile("s_waitcnt lgkmcnt(" #n ")" ::: "memory")
#define PG8_BAR __builtin_amdgcn_s_barrier()
#define PG8_SCHED __builtin_amdgcn_sched_barrier(0)
    Unit cur, nxt; int ui = 0;
    if (!S.next(0, cur)) return;
    f32x4 acc[2][2][4][2];
#pragma unroll
    for (int a = 0; a < 2; ++a)
#pragma unroll
        for (int b = 0; b < 2; ++b)
#pragma unroll
            for (int m = 0; m < 4; ++m)
#pragma unroll
                for (int n = 0; n < 2; ++n) acc[a][b][m][n] = (f32x4){0.f, 0.f, 0.f, 0.f};
    bf16x8 At[4][2], B0[2][2], B1[2][2];
    const char* cA = (const char*)g.A + (GATHER ? (size_t)0 : (size_t)cur.pm * tstep); const char* cB = (const char*)g.Bt + (size_t)cur.pn * tstep;
    if constexpr (GATHER) { PG8_GOFF(vAc, cur); }
    S.a_ready(cur);
    if constexpr (SP2) {
        PG8_STAGE(PG8_SB(0, 0), cB, voffB); PG8_STAGE(PG8_SB(0, 1), cB + hstep, voffB); PG8_STAGEA(PG8_SA(0, 0), cA, 0, false); PG8_STAGEA(PG8_SA(0, 1), cA, 1, false);
        if (wr == 1) PG8_BAR;
        PG8_WAIT_V(2); PG8_BAR;
        PG8_STAGE(PG8_SB(1, 0), cB + kstep, voffB); PG8_STAGEA(PG8_SA(1, 0), cA + kstep, 0, false); PG8_STAGE(PG8_SB(1, 1), cB + hstep + kstep, voffB);
        PG8_WAIT_V(6); PG8_BAR;
    } else {
        PG8_STAGE(PG8_SB(0, 0), cB, voffB); PG8_STAGE(PG8_SA(0, 0), cA, voffA); PG8_STAGE(PG8_SB(0, 1), cB + hstep, voffB); PG8_STAGE(PG8_SA(0, 1), cA + hstep, voffA);
        if (wr == 1) PG8_BAR;
        PG8_WAIT_V(4); PG8_BAR;
        PG8_STAGE(PG8_SB(1, 0), cB + kstep, voffB); PG8_STAGE(PG8_SA(1, 0), cA + kstep, voffA); PG8_STAGE(PG8_SB(1, 1), cB + hstep + kstep, voffB);
        PG8_WAIT_V(6); PG8_BAR;
    }
    for (;;) {
        const bool has_next = S.next(ui + 1, nxt);
        const char* nA = (has_next && !GATHER) ? (const char*)g.A + (size_t)nxt.pm * tstep : cA;
        if constexpr (GATHER) { if (has_next) { PG8_GOFF(vAn, nxt); } else { vAn[0] = vAc[0]; vAn[1] = vAc[1]; } } const char* nB = has_next ? (const char*)g.Bt + (size_t)nxt.pn * tstep : cB;
        for (int t = 0; t < nt; t += 2) {
            const bool last = (t == nt - 2);
            const char* a1 = cA + (size_t)(t + 1) * kstep;
            const char* a2 = last ? nA : cA + (size_t)(t + 2) * kstep; const char* b2 = last ? nB : cB + (size_t)(t + 2) * kstep;
            const char* a3 = a2 + kstep; const char* b3 = b2 + kstep;
            if (last && has_next) S.a_ready(nxt);
            if constexpr (SP2) {
            PG8_LDB(B0, 0, 0); PG8_LDB(B1, 0, 1); PG8_SCHED; PG8_LDA(At, 0, 0); PG8_STAGEA(PG8_SA(1, 1), a1, 1, false);
            PG8_WAIT_V(8); PG8_WAIT_L(0); PG8_BAR; PG8_MMA(0, 0, At, B0); PG8_MMA(0, 1, At, B1); PG8_BAR; PG8_SCHED;
            PG8_LDA(At, 0, 1); PG8_STAGE(PG8_SB(0, 0), b2, voffB); PG8_STAGE(PG8_SB(0, 1), b2 + hstep, voffB); PG8_STAGEA(PG8_SA(0, 0), a2, 0, last);
            PG8_WAIT_V(8); PG8_WAIT_L(0); PG8_BAR; PG8_MMA(1, 0, At, B0); PG8_MMA(1, 1, At, B1); PG8_BAR; PG8_SCHED;
            PG8_LDB(B0, 1, 0); PG8_LDB(B1, 1, 1); PG8_SCHED; PG8_LDA(At, 1, 0); PG8_STAGEA(PG8_SA(0, 1), a2, 1, last);
            PG8_WAIT_V(8); PG8_WAIT_L(0); PG8_BAR; PG8_MMA(0, 0, At, B0); PG8_MMA(0, 1, At, B1); PG8_BAR; PG8_SCHED;
            PG8_LDA(At, 1, 1); PG8_STAGE(PG8_SB(1, 0), b3, voffB); PG8_STAGE(PG8_SB(1, 1), b3 + hstep, voffB); PG8_STAGEA(PG8_SA(1, 0), a3, 0, last);
            PG8_WAIT_V(8); PG8_WAIT_L(0); PG8_BAR; PG8_MMA(1, 0, At, B0); PG8_MMA(1, 1, At, B1); PG8_BAR; PG8_SCHED;
            } else {
            PG8_LDB(B0, 0, 0); PG8_SCHED; PG8_LDA(At, 0, 0); PG8_STAGE(PG8_SA(1, 1), a1 + hstep, voffA);
            PG8_WAIT_L(8); PG8_BAR; PG8_WAIT_L(0); PG8_MMA(0, 0, At, B0); PG8_BAR; PG8_SCHED;
            PG8_LDB(B1, 0, 1); PG8_STAGE(PG8_SB(0, 0), b2, voffB);
            PG8_BAR; PG8_WAIT_L(0); PG8_MMA(0, 1, At, B1); PG8_BAR;
            PG8_LDA(At, 0, 1); PG8_STAGE(PG8_SA(0, 0), a2, voffA);
            PG8_BAR; PG8_WAIT_L(0); PG8_MMA(1, 0, At, B0); PG8_BAR; PG8_SCHED;
            PG8_STAGE(PG8_SB(0, 1), b2 + hstep, voffB);
            PG8_WAIT_V(6); PG8_BAR; PG8_MMA(1, 1, At, B1); PG8_BAR;
            PG8_LDB(B0, 1, 0); PG8_SCHED; PG8_LDA(At, 1, 0); PG8_STAGE(PG8_SA(0, 1), a2 + hstep, voffA);
            PG8_WAIT_L(8); PG8_BAR; PG8_WAIT_L(0); PG8_MMA(0, 0, At, B0); PG8_BAR; PG8_SCHED;
            PG8_LDB(B1, 1, 1); PG8_STAGE(PG8_SB(1, 0), b3, voffB);
            PG8_BAR; PG8_WAIT_L(0); PG8_MMA(0, 1, At, B1); PG8_BAR;
            PG8_LDA(At, 1, 1); PG8_STAGE(PG8_SA(1, 0), a3, voffA);
            PG8_BAR; PG8_WAIT_L(0); PG8_MMA(1, 0, At, B0); PG8_BAR; PG8_SCHED;
            PG8_STAGE(PG8_SB(1, 1), b3 + hstep, voffB);
            PG8_WAIT_V(6); PG8_BAR; PG8_MMA(1, 1, At, B1); PG8_BAR;
            }
        }
        if constexpr (ALIGN_EPI) { if (wr == 0) PG8_BAR; }
        if constexpr (!Epi::AFTER_DRAIN) { E(acc, cur, wr, wc, fr, fq); S.done(cur); }
        if (!has_next) break;
#pragma unroll
        for (int a = 0; a < 2; ++a)
#pragma unroll
            for (int b = 0; b < 2; ++b)
#pragma unroll
                for (int m = 0; m < 4; ++m)
#pragma unroll
                    for (int n = 0; n < 2; ++n) acc[a][b][m][n] = (f32x4){0.f, 0.f, 0.f, 0.f};
        cur = nxt; cA = nA; cB = nB; ++ui;
        if constexpr (GATHER) { vAc[0] = vAn[0]; vAc[1] = vAn[1]; }
        if constexpr (ALIGN_EPI) { if (wr == 1) PG8_BAR; }
    }
    PG8_WAIT_V(0);
    if constexpr (!ALIGN_EPI) { if (wr == 0) PG8_BAR; }
    PG8_BAR;
    if constexpr (Epi::AFTER_DRAIN) { E.fused(acc, cur, wr, wc, fr, fq, lds, wid, lane); S.done(cur); }
#undef PG8_SA
#undef PG8_SB
#undef PG8_STAGE
#undef PG8_STAGEA
#undef PG8_STAGEG
#undef PG8_GOFF
#undef PG8_LDA
#undef PG8_LDB
#undef PG8_MMA
#undef PG8_WAIT_V
#undef PG8_WAIT_L
#undef PG8_BAR
#undef PG8_SCHED
}
}
#define XB_TMO      128
#define XB_XCNT(j)  (256  + 64 * (j))
#define XB_XSUB(j)  (1280 + 64 * (j))
#define XB_XGEN(j)  (2304 + 64 * (j))
#define XB_TOP      3328
#define XB_TOPGEN   3392
#define XCD_BAR_WORDS 3456
#define XB_SPIN_CAP (1u << 18)
#define LAS __attribute__((address_space(3)))

__device__ __forceinline__ unsigned xb_ld(unsigned* p)              { return __hip_atomic_load(p, __ATOMIC_RELAXED, __HIP_MEMORY_SCOPE_AGENT); }
__device__ __forceinline__ unsigned xb_add(unsigned* p, unsigned v) { return __hip_atomic_fetch_add(p, v, __ATOMIC_RELAXED, __HIP_MEMORY_SCOPE_AGENT); }
__device__ __forceinline__ unsigned xb_xcc_id() { return (unsigned)__builtin_amdgcn_s_getreg((3 << 11) | 20) & 0xFu; }
#define XB_SPIN(cond, bar) do { unsigned _sp = 0; while (cond) { __builtin_amdgcn_s_sleep(1); \
    if ((++_sp & 255u) == 0u) { if (xb_ld(&(bar)[XB_TMO])) break; if (_sp > XB_SPIN_CAP) { atomicAdd(&(bar)[XB_TMO], 1u); break; } } } } while (0)

struct XcdBarrier {
    unsigned* bar; unsigned x;
    volatile LAS unsigned* st;
};

__device__ __forceinline__ XcdBarrier xcd_barrier_post(unsigned* bar, volatile LAS unsigned* st) {
    XcdBarrier b; b.bar = bar; b.x = xb_xcc_id(); b.st = st;
    if (threadIdx.x == 0) (void)xb_add(&bar[XB_XCNT(b.x)], 1u);
    return b;
}
__device__ __forceinline__ void xcd_barrier_complete(unsigned* bar, unsigned x, unsigned& nloc, unsigned& nx) {
    const unsigned G = gridDim.x * gridDim.y * gridDim.z;
    unsigned sum, cnt, mine, sp = 0u;
    for (;;) {
        sum = 0u; cnt = 0u; mine = 0u;
#pragma unroll
        for (unsigned j = 0; j < 16; ++j) { const unsigned c = xb_ld(&bar[XB_XCNT(j)]); sum += c; cnt += (c > 0u) ? 1u : 0u; mine = (j == x) ? c : mine; }
        if (sum == G) break;
        __builtin_amdgcn_s_sleep(1);
        if ((++sp & 255u) == 0u) { if (xb_ld(&bar[XB_TMO])) break; if (sp > XB_SPIN_CAP) { atomicAdd(&bar[XB_TMO], 1u); break; } }
    }
    nloc = mine > 0u ? mine : 1u; nx = cnt > 0u ? cnt : 1u;
}

__device__ __forceinline__ void xcd_barrier(const XcdBarrier& b) {
    asm volatile("s_waitcnt vmcnt(0)" ::: "memory");
    __syncthreads();
    if (threadIdx.x == 0) {
        unsigned* bar = b.bar;
        __builtin_amdgcn_s_waitcnt(0);
        unsigned nloc = b.st[0], nx = b.st[1];
        if (nloc == 0u) { xcd_barrier_complete(bar, b.x, nloc, nx); b.st[0] = nloc; b.st[1] = nx; }
        const unsigned old = xb_add(&bar[XB_XSUB(b.x)], 1u);
        const unsigned gen = old / nloc;
        if (old + 1u == (gen + 1u) * nloc) {
            __builtin_amdgcn_fence(__ATOMIC_RELEASE, "agent");
            asm volatile("s_waitcnt vmcnt(0)" ::: "memory");
            const unsigned og = xb_add(&bar[XB_TOP], 1u);
            const unsigned tg = og / nx;
            if (og + 1u == (tg + 1u) * nx) xb_add(&bar[XB_TOPGEN], 1u);
            else XB_SPIN(xb_ld(&bar[XB_TOPGEN]) == tg, bar);
            __builtin_amdgcn_fence(__ATOMIC_ACQUIRE, "agent");
            xb_add(&bar[XB_XGEN(b.x)], 1u);
            asm volatile("s_waitcnt vmcnt(0)" ::: "memory");
        } else {
            XB_SPIN(xb_ld(&bar[XB_XGEN(b.x)]) == gen, bar);
            __builtin_amdgcn_fence(__ATOMIC_ACQUIRE, "agent");
            asm volatile("s_waitcnt vmcnt(0)" ::: "memory");
        }
    }
    __syncthreads();
}

struct Args { const float* in[47]; float* out; unsigned char* ws; int ph_lo, ph_hi; };
typedef const __attribute__((address_space(4))) Args* KArgsP;
__device__ __forceinline__ KArgsP fresh_args() { KArgsP p = (KArgsP)__builtin_amdgcn_kernarg_segment_ptr(); asm volatile("" : "+s"(p)); return p; }
enum { I_X = 0, I_C, I_ADA_W, I_ADA_B, I_NORM_MIX, I_NORM_FFN, I_NORM_FINAL, I_W_IN, I_W_OUT, I_CONV_W, I_CONV_B, I_WQ, I_WK, I_BI, I_BF, I_MNORM_W,
       I_RMU, I_RW0, I_RWUP, I_RA0, I_RAUP, I_RGUP, I_RKK, I_RKA, I_RRK, I_RLNW, I_RLNB, I_RV0, I_RVDN, I_RVUP,
       I_S5ARE, I_S5AIM, I_S5LDT, I_S5BRE, I_S5BIM, I_S5CRE, I_S5CIM, I_S5D, I_S5GLUW, I_S5GLUB,
       I_MWRG, I_MBRG, I_MWRE, I_MBRE, I_MW1, I_MW3, I_MW2 };

struct RmWin { __device__ __forceinline__ int operator()(int n) const { return n < 1152 ? n : (n < 1164 ? 2816 + (n - 1152) : (n < 2572 ? 1152 + (n - 1164) : 2560 + (n - 2572))); } };
struct RmId  { __device__ __forceinline__ int operator()(int n) const { return n; } };
struct RmGU  { int add; __device__ __forceinline__ int operator()(int n) const { return 8 * (n >> 2) + (n & 3) + add; } };
template <class RM>
__device__ __forceinline__ void transpose_item(const float* W, int ldw, int ncols, int k0, int n0, bf16* WT, int ldt, LAS float* scr, int lane, const RM rm) {
    if (n0 + 64 <= ncols && (ldw & 3) == 0) {
        const float* src = W + (size_t)(k0 + (lane >> 4)) * ldw + n0 + 4 * (lane & 15);
        f32x4 v[16];
#pragma unroll
        for (int i = 0; i < 16; ++i) v[i] = *(const GAS f32x4*)(src + (size_t)(4 * i) * ldw);
#pragma unroll
        for (int i = 0; i < 16; ++i) { LAS float* d = scr + (4 * i + (lane >> 4)) * 65 + 4 * (lane & 15); d[0] = v[i][0]; d[1] = v[i][1]; d[2] = v[i][2]; d[3] = v[i][3]; }
    } else {
    const int nn = n0 + lane; const bool ok = nn < ncols; const float* src = W + (size_t)k0 * ldw + (ok ? nn : n0);
    float v[64];
#pragma unroll
    for (int kk = 0; kk < 64; ++kk) v[kk] = src[(size_t)kk * ldw];
#pragma unroll
    for (int kk = 0; kk < 64; ++kk) scr[kk * 65 + lane] = v[kk];
    }
    LDS_WAIT(); asm volatile("" ::: "memory");
    const int c = lane & 7;
#pragma unroll
    for (int j = 0; j < 8; ++j) { const int nl = (lane >> 3) + 8 * j; const LAS float* s = scr + (8 * c) * 65 + nl;
        v4u o; o.x = pk2(s[0 * 65], s[1 * 65]); o.y = pk2(s[2 * 65], s[3 * 65]); o.z = pk2(s[4 * 65], s[5 * 65]); o.w = pk2(s[6 * 65], s[7 * 65]);
        if (n0 + nl < ncols) *(GAS v4u*)(WT + (size_t)rm(n0 + nl) * ldt + k0 + 8 * c) = o; }
    LDS_WAIT(); asm volatile("" ::: "memory");
}
__device__ __forceinline__ void moe_convert13(const float* w1, const float* w3, int l, bf16* W13, int worker, int nworkers, LAS float* scr, int lane) {
    for (int it = worker; it < NEXP * 256; it += nworkers) {
        const int e = it >> 8, r = it & 255; const size_t eo = (size_t)(l * NEXP + e) * DM * DEXP;
        if (r < 128) transpose_item(w1 + eo, DEXP, DEXP, 64 * (r >> 3), 64 * (r & 7), W13 + (size_t)e * 1024 * 1024, 1024, scr, lane, RmGU{0});
        else         transpose_item(w3 + eo, DEXP, DEXP, 64 * ((r - 128) >> 3), 64 * ((r - 128) & 7), W13 + (size_t)e * 1024 * 1024, 1024, scr, lane, RmGU{4});
    }
}
__device__ __forceinline__ void moe_convert2(const float* w2, int l, bf16* W2T, int worker, int nworkers, LAS float* scr, int lane) {
    for (int it = worker; it < NEXP * 128; it += nworkers) {
        const int e = it >> 7, r = it & 127; const size_t eo = (size_t)(l * NEXP + e) * DM * DEXP;
        transpose_item(w2 + eo, DM, DM, 64 * (r >> 4), 64 * (r & 15), W2T + (size_t)e * 1024 * 512, 512, scr, lane, RmId{});
    }
}
__device__ __forceinline__ void phase_prologue(KArgsP a, LAS unsigned char* lds, int tid, int lane, int wave, int vcu, int G) {
    unsigned char* ws = a->ws;
    LAS float* scr = (LAS float*)(lds + wave * 16640);
    const int gw = vcu * NWAVES + wave, NGW = G * NWAVES;
    bf16* WIN = (bf16*)(ws + WS_WIN); bf16* WOUT = (bf16*)(ws + WS_WOUT);
    for (int it = gw; it < 2 * 16 * 45; it += NGW) { const int l = it / (16 * 45), r = it % (16 * 45);
        transpose_item(a->in[I_W_IN] + (size_t)l * DM * IN_COLS, IN_COLS, IN_COLS, 64 * (r / 45), 64 * (r % 45), WIN + (size_t)l * NPROJ_PAD * DM, DM, scr, lane, RmWin{}); }
    for (int it = gw; it < 2 * 16 * 16; it += NGW) { const int l = it / 256, r = it % 256;
        transpose_item(a->in[I_W_OUT] + (size_t)l * DM * DM, DM, DM, 64 * (r >> 4), 64 * (r & 15), WOUT + (size_t)l * DM * DM, DM, scr, lane, RmId{}); }
    for (int it = gw; it < 2 * 244; it += NGW) { const int l = it / 244, r = 2828 + it % 244; GAS v4u* p = (GAS v4u*)(WIN + ((size_t)l * NPROJ_PAD + r) * DM);
        p[lane] = (v4u){0u, 0u, 0u, 0u}; p[lane + 64] = (v4u){0u, 0u, 0u, 0u}; }
    { float* RTW = (float*)(ws + WS_RTW);
      for (int idx = (vcu * NTHR + tid); idx < 2 * 1024 * 48; idx += G * NTHR) { const int j = idx % 48, k = (idx / 48) % 1024, l = idx / (48 * 1024);
          RTW[(size_t)l * 49152 + ((k >> 2) * 16 + (j & 15)) * 12 + (k & 3) * 3 + (j >> 4)] = j < 4 ? a->in[I_MWRG][(size_t)(l * 1024 + k) * 4 + j] : (j < 36 ? a->in[I_MWRE][(size_t)(l * 1024 + k) * 32 + (j - 4)] : 0.f); } }
    { bf16* RW = (bf16*)(ws + WS_R1W);
      for (int idx = (vcu * NTHR + tid); idx < 2 * 98304 + 24576; idx += G * NTHR) { float v;
          if (idx < 2 * 98304) { const int l = idx / 98304, r = idx % 98304;
              if (r < 24576)      v = a->in[I_RWUP][(size_t)l * 64 * DBR + (r & 63) * DBR + (r >> 6)];
              else if (r < 49152) v = a->in[I_RAUP][(size_t)l * 64 * DBR + ((r - 24576) & 63) * DBR + ((r - 24576) >> 6)];
              else                v = a->in[I_RGUP][(size_t)l * 128 * DBR + ((r - 49152) & 127) * DBR + ((r - 49152) >> 7)];
          } else { const int r = idx - 2 * 98304;
              if (r < 12288) v = a->in[I_RVDN][(size_t)(r % 384) * 32 + (r / 384)];
              else           v = a->in[I_RVUP][(size_t)((r - 12288) & 31) * DBR + ((r - 12288) >> 5)]; }
          RW[idx] = (bf16)f2bf(v); } }
    for (int idx = (vcu * NTHR + tid); idx < 2 * 16 * 64; idx += G * NTHR) { const int p = idx & 63, lg = idx >> 6;
        const float lam_re = a->in[I_S5ARE][idx], lam_im = a->in[I_S5AIM][idx]; const float dt = expf(a->in[I_S5LDT][lg]); const float mag = expf(lam_re * dt), ang = lam_im * dt;
        const float are = mag * cosf(ang), aim = mag * sinf(ang); const float inv = 1.f / (lam_re * lam_re + lam_im * lam_im);
        const float cre = ((are - 1.f) * lam_re + aim * lam_im) * inv, cim = (aim * lam_re - (are - 1.f) * lam_im) * inv;
        ((float*)(ws + WS_S5AP))[idx * 2] = are; ((float*)(ws + WS_S5AP))[idx * 2 + 1] = aim;
        const float* br = a->in[I_S5BRE] + (size_t)idx * 16; const float* bi = a->in[I_S5BIM] + (size_t)idx * 16; bf16* o = (bf16*)(ws + WS_S5BB) + ((size_t)lg * 128 + 2 * p) * 16;
        for (int c = 0; c < 16; ++c) { o[c] = (bf16)f2bf(cre * br[c] - cim * bi[c]); o[16 + c] = (bf16)f2bf(cre * bi[c] + cim * br[c]); } }
    { bf16* CM = (bf16*)(ws + WS_S5CM);
      for (int idx = (vcu * NTHR + tid); idx < 2 * 16 * 16 * 128; idx += G * NTHR) { const int k = idx & 127, lgc = idx >> 7;
          CM[idx] = (bf16)f2bf((k & 1) ? -a->in[I_S5CIM][(size_t)lgc * 64 + (k >> 1)] : a->in[I_S5CRE][(size_t)lgc * 64 + (k >> 1)]); } }
    for (int it = gw; it < 2 * 16; it += NGW) { const int l = it >> 4, r = it & 15;
        transpose_item(a->in[I_S5GLUW] + (size_t)l * DC * DC, DC, DC, 64 * (r >> 2), 64 * (r & 3), (bf16*)(ws + WS_GLUT) + (size_t)l * DC * DC, DC, scr, lane, RmId{}); }
    { bf16* MLW = (bf16*)(ws + WS_MLW);
      for (int idx = (vcu * NTHR + tid); idx < 2 * NH * 2 * 4096; idx += G * NTHR) { const int d = idx & 63, e = (idx >> 6) & 63, which = (idx >> 12) & 1, lh = idx >> 13;
          MLW[idx] = (bf16)f2bf(a->in[which ? I_WK : I_WQ][(size_t)lh * 4096 + d * 64 + e]); } }
    __syncthreads();
    if (vcu < 192) {
        const int q = vcu, l = q / 96, cb = (q >> 3) % 12, kc = q & 7;
        LAS float* cond = (LAS float*)lds;
        { const int b = tid >> 7, kk = tid & 127; const float cv = a->in[I_C][b * DM + kc * 128 + kk]; cond[tid] = cv / (1.f + __expf(-cv)); }
        __syncthreads();
        const int col = cb * 512 + tid; const float* wp = a->in[I_ADA_W] + ((size_t)l * DM + kc * 128) * 6144 + col;
        float acc0 = 0.f, acc1 = 0.f, acc2 = 0.f, acc3 = 0.f;
#pragma unroll 8
        for (int kk = 0; kk < 128; ++kk) { const float w = wp[(size_t)kk * 6144]; acc0 += cond[kk] * w; acc1 += cond[128 + kk] * w; acc2 += cond[256 + kk] * w; acc3 += cond[384 + kk] * w; }
        const float bias = (kc == 0) ? a->in[I_ADA_B][l * 6144 + col] : 0.f;
        float* MP = (float*)(ws + WS_MODP) + ((size_t)(kc * 2 + l) * 4) * 6144 + col;
        MP[0] = acc0 + bias; MP[6144] = acc1 + bias; MP[2 * 6144] = acc2 + bias; MP[3 * 6144] = acc3 + bias;
    }
}

__device__ __forceinline__ float modval(const unsigned char* ws, bool part, int l, int b, int idx) {
    if (!part) return ((const float*)(ws + WS_MODF))[(size_t)(l * 4 + b) * 6144 + idx];
    const float* mp = (const float*)(ws + WS_MODP) + (size_t)(l * 4 + b) * 6144 + idx; float s = 0.f;
#pragma unroll
    for (int kc = 0; kc < 8; ++kc) s += mp[(size_t)kc * 2 * 4 * 6144];
    return s;
}
template <int MODE, bool COMBINE>
__device__ __forceinline__ void phase_rownorm(KArgsP a, LAS unsigned char* lds, int tid, int lane, int wave, int G,
                                              const float* xsrc, float* xdst, const float* gvec, bool part, int l, int isc  , int lprev) {
    unsigned char* ws = a->ws;
    LAS float* sc = (LAS float*)lds; LAS float* sh = sc + 1024; LAS float* gt = sh + 1024;
    bf16* HN = (bf16*)(ws + WS_HN); const bf16* YM = (const bf16*)(ws + WS_YMOE); const float* TW = (const float*)(ws + WS_TOKW);
    for (int c = blockIdx.x; c < NTOK / 128; c += G) {
        const int b = c >> 6;
        __syncthreads();
        for (int j = tid; j < 1024; j += NTHR) {
            if (MODE == 0) { sc[j] = gvec[j] * (1.f + modval(ws, part, l, b, (isc + 1) * 1024 + j)); sh[j] = modval(ws, part, l, b, isc * 1024 + j); }
            else { sc[j] = gvec[j]; sh[j] = 0.f; }
            if (COMBINE) gt[j] = 1.f + modval(ws, false, lprev, b, 5 * 1024 + j);
        }
        __syncthreads();
        f32x4 vn[4]; v2u yn0[4], yn1[4]; float wn0 = 0.f, wn1 = 0.f;
        { const int row = c * 128 + wave * 16; const GAS f32x4* xr = (const GAS f32x4*)(xsrc + (size_t)row * DM) + lane;
#pragma unroll
          for (int j = 0; j < 4; ++j) vn[j] = xr[64 * j];
          if (COMBINE) { wn0 = TW[2 * row]; wn1 = TW[2 * row + 1]; const GAS v2u* y0 = (const GAS v2u*)(YM + (size_t)(2 * row) * DM) + lane; const GAS v2u* y1 = (const GAS v2u*)(YM + (size_t)(2 * row + 1) * DM) + lane;
#pragma unroll
              for (int j = 0; j < 4; ++j) { yn0[j] = y0[64 * j]; yn1[j] = y1[64 * j]; } } }
        for (int i = 0; i < 16; ++i) {
            const int row = c * 128 + wave * 16 + i;
            f32x4 v[4]; v2u q0[4], q1[4]; const float w0 = wn0, w1 = wn1;
#pragma unroll
            for (int j = 0; j < 4; ++j) { v[j] = vn[j]; q0[j] = yn0[j]; q1[j] = yn1[j]; }
            if (i + 1 < 16) { const int rn = row + 1; const GAS f32x4* xr = (const GAS f32x4*)(xsrc + (size_t)rn * DM) + lane;
#pragma unroll
                for (int j = 0; j < 4; ++j) vn[j] = xr[64 * j];
                if (COMBINE) { wn0 = TW[2 * rn]; wn1 = TW[2 * rn + 1]; const GAS v2u* y0 = (const GAS v2u*)(YM + (size_t)(2 * rn) * DM) + lane; const GAS v2u* y1 = (const GAS v2u*)(YM + (size_t)(2 * rn + 1) * DM) + lane;
#pragma unroll
                    for (int j = 0; j < 4; ++j) { yn0[j] = y0[64 * j]; yn1[j] = y1[64 * j]; } } }
            if (COMBINE) {
#pragma unroll
                for (int j = 0; j < 4; ++j) { const v2u p0 = q0[j], p1 = q1[j]; const f32x4 g4 = *(const LAS f32x4*)(gt + lane * 4 + 256 * j);
                    f32x4 m; m.x = w0 * bflo(p0.x) + w1 * bflo(p1.x); m.y = w0 * bfhi(p0.x) + w1 * bfhi(p1.x); m.z = w0 * bflo(p0.y) + w1 * bflo(p1.y); m.w = w0 * bfhi(p0.y) + w1 * bfhi(p1.y);
                    v[j] = v[j] + g4 * m; }
                if (MODE == 0) { GAS f32x4* xo = (GAS f32x4*)(xdst + (size_t)row * DM) + lane;
#pragma unroll
                    for (int j = 0; j < 4; ++j) xo[64 * j] = v[j]; }
            }
            float ss = 0.f;
#pragma unroll
            for (int j = 0; j < 4; ++j) ss += (v[j].x * v[j].x + v[j].y * v[j].y) + (v[j].z * v[j].z + v[j].w * v[j].w);
            const float rstd = rsqrtf(wave_sum(ss) * (1.f / DM) + NORM_EPS);
            if (MODE == 0) {
                GAS v2u* o = (GAS v2u*)(HN + (size_t)row * DM) + lane;
#pragma unroll
                for (int j = 0; j < 4; ++j) { const f32x4 s4 = *(const LAS f32x4*)(sc + lane * 4 + 256 * j), h4 = *(const LAS f32x4*)(sh + lane * 4 + 256 * j); const f32x4 h = v[j] * rstd * s4 + h4;
                    v2u w; w.x = pk2(h.x, h.y); w.y = pk2(h.z, h.w); o[64 * j] = w; }
            } else {
                GAS f32x4* o = (GAS f32x4*)(xdst + (size_t)row * DM) + lane;
#pragma unroll
                for (int j = 0; j < 4; ++j) { const f32x4 s4 = *(const LAS f32x4*)(sc + lane * 4 + 256 * j); o[64 * j] = v[j] * rstd * s4; }
            }
        }
    }
}
__device__ __forceinline__ void mod_finalize(unsigned char* ws, int tid, int G) {
    float* MF = (float*)(ws + WS_MODF);
    for (int idx = blockIdx.x * NTHR + tid; idx < 2 * 4 * 6144; idx += G * NTHR) { const float* mp = (const float*)(ws + WS_MODP) + idx; float s = 0.f;
#pragma unroll
        for (int kc = 0; kc < 8; ++kc) s += mp[(size_t)kc * 2 * 4 * 6144];
        MF[idx] = s; }
}

typedef float f32x4m __attribute__((ext_vector_type(4)));
__device__ __forceinline__ void phase_router(KArgsP a, LAS unsigned char* lds, int tid, int lane, int wave, int G, int l) {
    unsigned char* ws = a->ws;
    LAS float* sc = (LAS float*)lds; LAS float* sh = sc + 1024; LAS float* rstd_s = sh + 1024  ; LAS float* cvec = rstd_s + 128  ; LAS float* cpart = cvec + 64  ;
    LAS float* lg = cpart + 8 * 48  ; LAS int* hist = (LAS int*)(lg + 8 * 16 * 48)  ; LAS int* basev = hist + 32; LAS int* asg_e = basev + 32  ; LAS int* asg_lp = asg_e + 256;
    bf16* HN = (bf16*)(ws + WS_HN); const float* x = a->out; const float* RTW = (const float*)(ws + WS_RTW) + (size_t)l * 1024 * 48;
    int* TOKE = (int*)(ws + WS_TOKE); float* TOKW = (float*)(ws + WS_TOKW); int* LIST = (int*)(ws + WS_LIST); unsigned* CNT = (unsigned*)(ws + WS_CTL) + CW_CNT + l * 32;
    const float* gvec = a->in[I_NORM_FFN] + l * DM;
    for (int c = blockIdx.x; c < NTOK / 128; c += G) {
        const int b = c >> 6;
        __syncthreads();
        for (int j = tid; j < 1024; j += NTHR) { sc[j] = gvec[j] * (1.f + modval(ws, false, l, b, 4 * 1024 + j)); sh[j] = modval(ws, false, l, b, 3 * 1024 + j); }
        if (tid < 32) hist[tid] = 0;
        __syncthreads();
        if (tid < 384) { const int j = tid % 48, part = tid / 48; float s = 0.f;
#pragma unroll 16
            for (int k = part * 128; k < part * 128 + 128; ++k) s += sh[k] * RTW[((k >> 2) * 16 + (j & 15)) * 12 + (k & 3) * 3 + (j >> 4)];
            cpart[part * 48 + j] = s; }
        { f32x4 vn[4];
          { const GAS f32x4* xr = (const GAS f32x4*)(x + (size_t)(c * 128 + wave * 16) * DM) + lane;
#pragma unroll
            for (int j = 0; j < 4; ++j) vn[j] = xr[64 * j]; }
          for (int i = 0; i < 16; ++i) {
            const int row = c * 128 + wave * 16 + i;
            f32x4 v[4]; float ss = 0.f;
#pragma unroll
            for (int j = 0; j < 4; ++j) { v[j] = vn[j]; ss += (v[j].x * v[j].x + v[j].y * v[j].y) + (v[j].z * v[j].z + v[j].w * v[j].w); }
            if (i + 1 < 16) { const GAS f32x4* xr = (const GAS f32x4*)(x + (size_t)(row + 1) * DM) + lane;
#pragma unroll
                for (int j = 0; j < 4; ++j) vn[j] = xr[64 * j]; }
            const float rstd = rsqrtf(wave_sum(ss) * (1.f / DM) + NORM_EPS);
            if (lane == 0) rstd_s[wave * 16 + i] = rstd;
            GAS v2u* o = (GAS v2u*)(HN + (size_t)row * DM) + lane;
#pragma unroll
            for (int j = 0; j < 4; ++j) { const f32x4 s4 = *(const LAS f32x4*)(sc + lane * 4 + 256 * j), h4 = *(const LAS f32x4*)(sh + lane * 4 + 256 * j); const f32x4 h = v[j] * rstd * s4 + h4;
                v2u w; w.x = pk2(h.x, h.y); w.y = pk2(h.z, h.w); o[64 * j] = w; }
          } }
        __syncthreads();
        if (tid < 48) { float s = 0.f;
#pragma unroll
            for (int p = 0; p < 8; ++p) s += cpart[p * 48 + tid];
            s += tid < 4 ? a->in[I_MBRG][l * 4 + tid] : (tid < 36 ? a->in[I_MBRE][l * 32 + tid - 4] : 0.f); cvec[tid] = s; }
        {
            const int i16 = lane & 15, kq = lane >> 4, r0 = c * 128 + wave * 16;
            f32x4m acc0 = {0.f, 0.f, 0.f, 0.f}, acc1 = acc0, acc2 = acc0;
            const float* xrow = x + (size_t)(r0 + i16) * DM + 4 * kq;
#pragma unroll 8
            for (int k0 = 0; k0 < DM; k0 += 16) {
                const f32x4 xv = *(const GAS f32x4*)(xrow + k0); const f32x4 sv = *(const LAS f32x4*)(sc + k0 + 4 * kq);
                const GAS f32x4* wp = (const GAS f32x4*)(RTW + (size_t)(((k0 >> 2) + kq) * 16 + i16) * 12);
                const f32x4 w0 = wp[0], w1 = wp[1], w2 = wp[2]; const float wf[12] = {w0[0], w0[1], w0[2], w0[3], w1[0], w1[1], w1[2], w1[3], w2[0], w2[1], w2[2], w2[3]};
#pragma unroll
                for (int j = 0; j < 4; ++j) { const float av = xv[j] * sv[j];
                    acc0 = __builtin_amdgcn_mfma_f32_16x16x4f32(av, wf[j * 3], acc0, 0, 0, 0);
                    acc1 = __builtin_amdgcn_mfma_f32_16x16x4f32(av, wf[j * 3 + 1], acc1, 0, 0, 0);
                    acc2 = __builtin_amdgcn_mfma_f32_16x16x4f32(av, wf[j * 3 + 2], acc2, 0, 0, 0); }
            }
            __syncthreads();
            LAS float* lw = lg + wave * 16 * 48;
#pragma unroll
            for (int r = 0; r < 4; ++r) { const int rr = 4 * kq + r; const float rs = rstd_s[wave * 16 + rr];
                lw[rr * 48 + i16] = acc0[r] * rs + cvec[i16]; lw[rr * 48 + 16 + i16] = acc1[r] * rs + cvec[16 + i16]; lw[rr * 48 + 32 + i16] = acc2[r] * rs + cvec[32 + i16]; }
            LDS_WAIT(); asm volatile("" ::: "memory");
            if (lane < 16) {
                const LAS float* lr = lw + lane * 48; const int row = r0 + lane;
                float g0 = lr[0], g1 = lr[1], g2 = lr[2], g3 = lr[3]; const float gm = fmaxf(fmaxf(g0, g1), fmaxf(g2, g3));
                float p0 = __expf(g0 - gm), p1 = __expf(g1 - gm), p2 = __expf(g2 - gm), p3 = __expf(g3 - gm); const float inv = 1.f / (p0 + p1 + p2 + p3);
                p0 *= inv; p1 *= inv; p2 *= inv; p3 *= inv;
                int gi = 0; float gp = p0; if (p1 > gp) { gp = p1; gi = 1; } if (p2 > gp) { gp = p2; gi = 2; } if (p3 > gp) { gp = p3; gi = 3; }
                float ev0 = -3.4e38f, ev1 = -3.4e38f; int e0 = 0, e1 = 0;
#pragma unroll
                for (int j = 0; j < 8; ++j) { const float s = lr[4 + gi * 8 + j]; if (s > ev0) { ev1 = ev0; e1 = e0; ev0 = s; e0 = j; } else if (s > ev1) { ev1 = s; e1 = j; } }
                const float q = __expf(ev1 - ev0), w0 = gp / (1.f + q), w1 = gp * q / (1.f + q);
                e0 += gi * 8; e1 += gi * 8;
                TOKE[2 * row] = e0; TOKE[2 * row + 1] = e1; TOKW[2 * row] = w0; TOKW[2 * row + 1] = w1;
                const int a0 = 2 * (wave * 16 + lane);
                asg_e[a0] = e0; asg_e[a0 + 1] = e1; asg_lp[a0] = atomicAdd((int*)&hist[e0], 1); asg_lp[a0 + 1] = atomicAdd((int*)&hist[e1], 1);
            }
        }
        __syncthreads();
        if (tid < 32) { const int h = hist[tid]; basev[tid] = h ? (int)atomicAdd(CNT + tid, (unsigned)h) : 0; }
        __syncthreads();
        if (tid < 256) { const int e = asg_e[tid]; LIST[(size_t)e * 65536 + basev[e] + asg_lp[tid]] = (c * 128) * 2 + tid; }
    }
}
__device__ __forceinline__ void build_ptab(const unsigned* CNT, LAS int* ptab, LAS int* pst, LAS int* cnt, int tid) {
    __syncthreads();
    if (tid == 0) { int np = 0;
        for (int e = 0; e < NEXP; ++e) { const int ce = (int)__hip_atomic_load(CNT + e, RLX_AGENT); cnt[e] = ce; pst[e] = np * 256; const int pe = (ce + 255) >> 8;
            for (int p = 0; p < pe; ++p) ptab[1 + np + p] = e;
            np += pe; }
        ptab[0] = np; }
    __syncthreads();
}
__device__ __forceinline__ void phase_gather(KArgsP a, LAS unsigned char* lds, int tid, int lane, int wave, int vcu, int G, int l) {
    unsigned char* ws = a->ws;
    LAS int* ptab = (LAS int*)lds; LAS int* pst = ptab + 512; LAS int* cnt = pst + 32;
    build_ptab((const unsigned*)(ws + WS_CTL) + CW_CNT + l * 32, ptab, pst, cnt, tid);
    const bf16* HN = (const bf16*)(ws + WS_HN); bf16* XG = (bf16*)(ws + WS_XG); int* ROWMAP = (int*)(ws + WS_ROWMAP); const int* LIST = (const int*)(ws + WS_LIST);
    const int nrows = ptab[0] * 256;
    for (int row0 = (vcu * NWAVES + wave) * 8; row0 < nrows; row0 += G * NWAVES * 8) {
        int tok2[8]; v4u p0[8], p1[8];
#pragma unroll
        for (int j = 0; j < 8; ++j) { const int row = row0 + j, e = ptab[1 + (row >> 8)], pos = row - pst[e]; tok2[j] = (pos < cnt[e]) ? LIST[(size_t)e * 65536 + pos] : -1; }
#pragma unroll
        for (int j = 0; j < 8; ++j) { if (tok2[j] >= 0) { const GAS v4u* s = (const GAS v4u*)(HN + (size_t)(tok2[j] >> 1) * DM) + lane; p0[j] = s[0]; p1[j] = s[64]; } else { p0[j] = (v4u){0u, 0u, 0u, 0u}; p1[j] = p0[j]; } }
#pragma unroll
        for (int j = 0; j < 8; ++j) { GAS v4u* d = (GAS v4u*)(XG + (size_t)(row0 + j) * DM) + lane; d[0] = p0[j]; d[64] = p1[j]; if (lane == 0) ROWMAP[row0 + j] = tok2[j]; }
    }
}

__device__ __forceinline__ void phase_rowmap(KArgsP a, LAS unsigned char* lds, int tid, int vcu, int G, int l) {
    unsigned char* ws = a->ws;
    LAS int* ptab = (LAS int*)lds; LAS int* pst = ptab + 512; LAS int* cnt = pst + 32;
    build_ptab((const unsigned*)(ws + WS_CTL) + CW_CNT + l * 32, ptab, pst, cnt, tid);
    int* ROWMAP = (int*)(ws + WS_ROWMAP); const int* LIST = (const int*)(ws + WS_LIST);
    const int nrows = ptab[0] * 256;
    for (int row = vcu * NTHR + tid; row < nrows; row += G * NTHR) { const int e = ptab[1 + (row >> 8)], pos = row - pst[e]; ROWMAP[row] = (pos < cnt[e]) ? LIST[(size_t)e * 65536 + pos] : -1; }
}

typedef short bf16x8 __attribute__((ext_vector_type(8)));
constexpr int MT = 72;
constexpr int ML_XP = 0;
constexpr int ML_CX = 17152;
constexpr int ML_WQ = ML_CX + 9216, ML_WK = ML_WQ + 9216;
constexpr int ML_Q = ML_WK + 9216, ML_K = ML_Q + 9216;
constexpr int ML_S = ML_K + 9216;
constexpr int ML_VT = ML_S + 9216;
constexpr int ML_CT = ML_VT + 11520;
constexpr int ML_H = ML_CT + 11520;
constexpr int ML_SM = ML_H + 16640;
static_assert(ML_SM + 2048 <= RING_BYTES, "mLSTM LDS map");
__device__ __forceinline__ float logsigmoidf_(float x) { return fminf(x, 0.f) - log1pf(__expf(-fabsf(x))); }
__device__ __forceinline__ void mma64(const LAS bf16* A, int arow0, const LAS bf16* Bt, int brow0, int lane, f32x4& acc) {
    const LAS bf16* ap = A + (arow0 + (lane & 15)) * MT + 8 * (lane >> 4); const LAS bf16* bp = Bt + (brow0 + (lane & 15)) * MT + 8 * (lane >> 4);
    const bf16x8 a0 = *(const LAS bf16x8*)ap, a1 = *(const LAS bf16x8*)(ap + 32), b0 = *(const LAS bf16x8*)bp, b1 = *(const LAS bf16x8*)(bp + 32);
    acc = __builtin_amdgcn_mfma_f32_16x16x32_bf16(a0, b0, acc, 0, 0, 0); acc = __builtin_amdgcn_mfma_f32_16x16x32_bf16(a1, b1, acc, 0, 0, 0);
}
__device__ __forceinline__ void ml_front(KArgsP a, LAS unsigned char* lds, int tid, int l, int b, int c, int h, bool want_q) {
    const bf16* PROJ = (const bf16*)(a->ws + WS_PROJ); const size_t row0 = (size_t)b * SEQ + c * 64;
    LAS float* xp = (LAS float*)(lds + ML_XP);
    for (int idx = tid; idx < 67 * 8; idx += NTHR) { const int r = idx >> 3, c8 = idx & 7, tr = c * 64 + r - 3; LAS float* d = xp + r * 64 + c8 * 8;
        if (tr >= 0) { const v4u p = *(const GAS v4u*)(PROJ + ((size_t)b * SEQ + tr) * NPROJ + PC_QK + h * 64 + c8 * 8);
            *(LAS f32x4*)d = (f32x4){bflo(p.x), bfhi(p.x), bflo(p.y), bfhi(p.y)}; *(LAS f32x4*)(d + 4) = (f32x4){bflo(p.z), bfhi(p.z), bflo(p.w), bfhi(p.w)}; }
        else { *(LAS f32x4*)d = (f32x4){0.f, 0.f, 0.f, 0.f}; *(LAS f32x4*)(d + 4) = (f32x4){0.f, 0.f, 0.f, 0.f}; } }
    {
        const int t = tid >> 3, vg = tid & 7; LAS bf16* VT = (LAS bf16*)(lds + ML_VT);
        const v4u p = *(const GAS v4u*)(PROJ + (row0 + t) * NPROJ + PC_V + h * 64 + vg * 8);
        const unsigned w[4] = {p.x, p.y, p.z, p.w};
#pragma unroll
        for (int j = 0; j < 4; ++j) { VT[(vg * 8 + 2 * j) * MT + t] = (bf16)(w[j] & 0xffffu); VT[(vg * 8 + 2 * j + 1) * MT + t] = (bf16)(w[j] >> 16); }
        for (int idx = tid; idx < 16 * 64; idx += NTHR) VT[(64 + (idx >> 6)) * MT + (idx & 63)] = (idx < 64) ? (bf16)0x3F80 : (bf16)0;
        const bf16* WT = (const bf16*)(a->ws + WS_MLW) + (size_t)((l * NH + h) * 2) * 4096;
        const int e = tid >> 3, d8 = tid & 7;
        if (want_q) *(LAS v4u*)(lds + ML_WQ + (e * MT + d8 * 8) * 2) = *(const GAS v4u*)(WT + e * 64 + d8 * 8);
        *(LAS v4u*)(lds + ML_WK + (e * MT + d8 * 8) * 2) = *(const GAS v4u*)(WT + 4096 + e * 64 + d8 * 8);
    }
    __syncthreads();
    const float* cw = a->in[I_CONV_W] + (size_t)l * 4 * DA + h * 64; const float* cb = a->in[I_CONV_B] + (size_t)l * DA + h * 64;
    {
        const int t = tid >> 3, c8 = (tid & 7) * 8; float s[8];
#pragma unroll
        for (int j = 0; j < 8; ++j) s[j] = cb[c8 + j];
#pragma unroll
        for (int q = 0; q < 4; ++q) { const f32x4 x0 = *(const LAS f32x4*)(xp + (t + q) * 64 + c8), x1 = *(const LAS f32x4*)(xp + (t + q) * 64 + c8 + 4); const float* w = cw + q * DA + c8;
            s[0] += x0.x * w[0]; s[1] += x0.y * w[1]; s[2] += x0.z * w[2]; s[3] += x0.w * w[3]; s[4] += x1.x * w[4]; s[5] += x1.y * w[5]; s[6] += x1.z * w[6]; s[7] += x1.w * w[7]; }
#pragma unroll
        for (int j = 0; j < 8; ++j) s[j] = s[j] / (1.f + __expf(-s[j]));
        v4u o; o.x = pk2(s[0], s[1]); o.y = pk2(s[2], s[3]); o.z = pk2(s[4], s[5]); o.w = pk2(s[6], s[7]);
        *(LAS v4u*)(lds + ML_CX + (t * MT + c8) * 2) = o;
    }
}
__device__ __forceinline__ void phase_m1(KArgsP a, LAS unsigned char* lds, int tid, int lane, int wave, int vcu, int G, int l) {
    unsigned char* ws = a->ws; const float* GT = (const float*)(ws + WS_GATES);
    float* CLOC = (float*)(ws + WS_CLOC); float* MLG = (float*)(ws + WS_MSC); float* MLM = MLG + 4096;
    LAS float* sm = (LAS float*)(lds + ML_SM);
    for (int u = vcu; u < NUNIT_M; u += G) {
        const int h = u % NH, c = (u / NH) % NCH, b = u / (NH * NCH); const size_t row0 = (size_t)b * SEQ + c * 64;
        __syncthreads();
        ml_front(a, lds, tid, l, b, c, h, false);
        if (wave == 0) {
            const float ig = GT[(row0 + lane) * 16 + h] + a->in[I_BI][l * NH + h];
            const float fl = logsigmoidf_(GT[(row0 + lane) * 16 + 6 + h] + a->in[I_BF][l * NH + h]);
            float bc = fl;
#pragma unroll
            for (int o = 1; o < 64; o <<= 1) { const float t = __shfl_up(bc, o); if (lane >= o) bc += t; }
            const float gtot = __shfl(bc, 63); const float lw = gtot - bc + ig; const float ml = wave_max(lw);
            sm[lane] = __expf(lw - ml);
            if (lane == 0) { MLG[u] = gtot; MLM[u] = ml; }
        }
        __syncthreads();
        {
            const int rt = wave >> 1; LAS bf16* KT = (LAS bf16*)(lds + ML_K);
#pragma unroll
            for (int q = 0; q < 2; ++q) { const int ct = 2 * (wave & 1) + q; f32x4 acc = {0.f, 0.f, 0.f, 0.f};
                mma64((const LAS bf16*)(lds + ML_CX), 16 * rt, (const LAS bf16*)(lds + ML_WK), 16 * ct, lane, acc);
                const int t0 = 16 * rt + 4 * (lane >> 4), e = 16 * ct + (lane & 15);
                const float w0 = sm[t0] * 0.125f, w1 = sm[t0 + 1] * 0.125f, w2 = sm[t0 + 2] * 0.125f, w3 = sm[t0 + 3] * 0.125f;
                v2u o; o.x = pk2(acc[0] * w0, acc[1] * w1); o.y = pk2(acc[2] * w2, acc[3] * w3);
                *(LAS v2u*)(KT + e * MT + t0) = o; }
        }
        __syncthreads();
        {
            const int ct = wave & 3, r_lo = wave < 4 ? 0 : 3, r_hi = wave < 4 ? 3 : 5; float* cl = CLOC + (size_t)u * CL_STRIDE;
            for (int rt = r_lo; rt < r_hi; ++rt) { f32x4 acc = {0.f, 0.f, 0.f, 0.f};
                mma64((const LAS bf16*)(lds + ML_VT), 16 * rt, (const LAS bf16*)(lds + ML_K), 16 * ct, lane, acc);
                const int v0 = 16 * rt + 4 * (lane >> 4), e = 16 * ct + (lane & 15);
                if (rt < 4) {
#pragma unroll
                    for (int r = 0; r < 4; ++r) cl[(v0 + r) * 64 + e] = acc[r];
                } else if ((lane >> 4) == 0) cl[4096 + e] = acc[0]; }
        }
    }
}
__device__ __forceinline__ void phase_m2(unsigned char* ws, int tid, int wg, int nwg) {
    float* CLOC = (float*)(ws + WS_CLOC); const float* MLG = (const float*)(ws + WS_MSC); const float* MLM = MLG + 4096; float* MST = (float*)(ws + WS_MSC) + 8192;
    for (int idx = wg * NTHR + tid; idx < NB * NH * CL_STRIDE; idx += nwg * NTHR) {
        const int e = idx % CL_STRIDE, bh = idx / CL_STRIDE, b = bh / NH, h = bh % NH;
        float m = 0.f, cs = 0.f;
        float cn[8], gn[8], mn8[8];
#pragma unroll
        for (int j = 0; j < 8; ++j) { const int u = (b * NCH + j) * NH + h; cn[j] = CLOC[(size_t)u * CL_STRIDE + e]; gn[j] = MLG[u]; mn8[j] = MLM[u]; }
        for (int c0 = 0; c0 < NCH; c0 += 8) {
            float cl[8], g[8], ml[8];
#pragma unroll
            for (int j = 0; j < 8; ++j) { cl[j] = cn[j]; g[j] = gn[j]; ml[j] = mn8[j]; }
            { const int cq = min(c0 + 8, NCH - 8);
#pragma unroll
              for (int j = 0; j < 8; ++j) { const int u = (b * NCH + cq + j) * NH + h; cn[j] = CLOC[(size_t)u * CL_STRIDE + e]; gn[j] = MLG[u]; mn8[j] = MLM[u]; } }
#pragma unroll
            for (int j = 0; j < 8; ++j) { const int u = (b * NCH + c0 + j) * NH + h;
                CLOC[(size_t)u * CL_STRIDE + e] = cs; if (e == 0) MST[u] = m;
                const float mn = fmaxf(g[j] + m, ml[j]); const float ao = __expf(g[j] + m - mn), al = __expf(ml[j] - mn);
                cs = ao * cs + al * cl[j]; m = mn; }
        }
    }
}
__device__ __forceinline__ void phase_m3(KArgsP a, LAS unsigned char* lds, int tid, int lane, int wave, int vcu, int G, int l) {
    unsigned char* ws = a->ws; const bf16* PROJ = (const bf16*)(ws + WS_PROJ); const float* GT = (const float*)(ws + WS_GATES);
    const float* CLOC = (const float*)(ws + WS_CLOC); const float* MST = (const float*)(ws + WS_MSC) + 8192; bf16* YC = (bf16*)(ws + WS_YC);
    LAS float* sm = (LAS float*)(lds + ML_SM); LAS float* hb = (LAS float*)(lds + ML_H);
    for (int u = vcu; u < NUNIT_M; u += G) {
        const int h = u % NH, c = (u / NH) % NCH, b = u / (NH * NCH); const size_t row0 = (size_t)b * SEQ + c * 64;
        __syncthreads();
        ml_front(a, lds, tid, l, b, c, h, true);
        {
            const float* cl = CLOC + (size_t)u * CL_STRIDE; LAS bf16* CT = (LAS bf16*)(lds + ML_CT);
            for (int idx = tid; idx < 65 * 16; idx += NTHR) { const int r = idx >> 4, c4 = idx & 15; const f32x4 v = *(const GAS f32x4*)(cl + r * 64 + c4 * 4);
                v2u o; o.x = pk2(v.x, v.y); o.y = pk2(v.z, v.w); *(LAS v2u*)(CT + r * MT + c4 * 4) = o; }
            for (int idx = tid; idx < 15 * 64; idx += NTHR) CT[(65 + (idx >> 6)) * MT + (idx & 63)] = 0;
        }
        if (wave == 0) {
            const float ig = GT[(row0 + lane) * 16 + h] + a->in[I_BI][l * NH + h];
            const float fl = logsigmoidf_(GT[(row0 + lane) * 16 + 6 + h] + a->in[I_BF][l * NH + h]);
            float bc = fl;
#pragma unroll
            for (int o = 1; o < 64; o <<= 1) { const float t = __shfl_up(bc, o); if (lane >= o) bc += t; }
            float pm = ig - bc;
#pragma unroll
            for (int o = 1; o < 64; o <<= 1) { const float t = __shfl_up(pm, o); if (lane >= o) pm = fmaxf(pm, t); }
            const float mst = MST[u]; const float inter = bc + mst, mt = fmaxf(inter, bc + pm);
            sm[lane] = ig - bc; sm[64 + lane] = bc - mt; sm[128 + lane] = __expf(inter - mt); sm[192 + lane] = __expf(-mt);
        }
        __syncthreads();
        {
            const int rt = wave >> 1; LAS bf16* Qs = (LAS bf16*)(lds + ML_Q); LAS bf16* Ks = (LAS bf16*)(lds + ML_K);
#pragma unroll
            for (int q = 0; q < 2; ++q) { const int ct = 2 * (wave & 1) + q; f32x4 aq = {0.f, 0.f, 0.f, 0.f}, ak = {0.f, 0.f, 0.f, 0.f};
                mma64((const LAS bf16*)(lds + ML_CX), 16 * rt, (const LAS bf16*)(lds + ML_WQ), 16 * ct, lane, aq);
                mma64((const LAS bf16*)(lds + ML_CX), 16 * rt, (const LAS bf16*)(lds + ML_WK), 16 * ct, lane, ak);
                const int t0 = 16 * rt + 4 * (lane >> 4), e = 16 * ct + (lane & 15);
#pragma unroll
                for (int r = 0; r < 4; ++r) { Qs[(t0 + r) * MT + e] = (bf16)f2bf(aq[r]); Ks[(t0 + r) * MT + e] = (bf16)f2bf(ak[r] * 0.125f); } }
        }
        __syncthreads();
        {
            const int rt = wave >> 1; LAS bf16* Ss = (LAS bf16*)(lds + ML_S);
#pragma unroll
            for (int q = 0; q < 2; ++q) { const int ct = 2 * (wave & 1) + q; f32x4 acc = {0.f, 0.f, 0.f, 0.f};
                if (ct <= rt) mma64((const LAS bf16*)(lds + ML_Q), 16 * rt, (const LAS bf16*)(lds + ML_K), 16 * ct, lane, acc);
                const int t0 = 16 * rt + 4 * (lane >> 4), s = 16 * ct + (lane & 15); const float qs = sm[s];
#pragma unroll
                for (int r = 0; r < 4; ++r) { const int t = t0 + r; Ss[t * MT + s] = (bf16)f2bf((s <= t) ? acc[r] * __expf(sm[64 + t] + qs) : 0.f); } }
        }
        __syncthreads();
        {
            const int rt = wave >> 1, nt = (wave & 1) ? 2 : 3;
            for (int q = 0; q < nt; ++q) { const int ct = (wave & 1) ? 2 + q : (q < 2 ? q : 4); f32x4 aA = {0.f, 0.f, 0.f, 0.f}, aB = {0.f, 0.f, 0.f, 0.f};
                mma64((const LAS bf16*)(lds + ML_Q), 16 * rt, (const LAS bf16*)(lds + ML_CT), 16 * ct, lane, aA);
                mma64((const LAS bf16*)(lds + ML_S), 16 * rt, (const LAS bf16*)(lds + ML_VT), 16 * ct, lane, aB);
                const int t0 = 16 * rt + 4 * (lane >> 4), v = 16 * ct + (lane & 15);
#pragma unroll
                for (int r = 0; r < 4; ++r) { const int t = t0 + r; const float x = sm[128 + t] * aA[r] + aB[r];
                    if (ct < 4) hb[t * 65 + v] = x; else if ((lane & 15) == 0) sm[256 + t] = x; } }
        }
        __syncthreads();
        {
            const int t = tid >> 3, vg = tid & 7; float acc[8];
            const float dn = 1.f / fmaxf(fabsf(sm[256 + t]), sm[192 + t]);
            float s1 = 0.f;
#pragma unroll
            for (int j = 0; j < 8; ++j) { acc[j] = hb[t * 65 + vg * 8 + j] * dn; s1 += acc[j]; }
            s1 += __shfl_xor(s1, 1); s1 += __shfl_xor(s1, 2); s1 += __shfl_xor(s1, 4);
            const float mu = s1 * (1.f / 64.f); float s2 = 0.f;
#pragma unroll
            for (int j = 0; j < 8; ++j) { acc[j] -= mu; s2 += acc[j] * acc[j]; }
            s2 += __shfl_xor(s2, 1); s2 += __shfl_xor(s2, 2); s2 += __shfl_xor(s2, 4);
            const float rs = rsqrtf(s2 * (1.f / 64.f) + HEAD_NORM_EPS);
            const float* nw = a->in[I_MNORM_W] + (size_t)l * DA + h * 64 + vg * 8;
            const v4u ov = *(const GAS v4u*)(PROJ + (row0 + t) * NPROJ + PC_O + h * 64 + vg * 8);
            const float o[8] = {bflo(ov.x), bfhi(ov.x), bflo(ov.y), bfhi(ov.y), bflo(ov.z), bfhi(ov.z), bflo(ov.w), bfhi(ov.w)};
            float r[8];
#pragma unroll
            for (int j = 0; j < 8; ++j) r[j] = acc[j] * rs * nw[j] * sigmoidf_(o[j]);
            v4u w; w.x = pk2(r[0], r[1]); w.y = pk2(r[2], r[3]); w.z = pk2(r[4], r[5]); w.w = pk2(r[6], r[7]);
            *(GAS v4u*)(YC + (row0 + t) * DM + h * 64 + vg * 8) = w;
        }
    }
}

constexpr int S5_UT = 264, S5_XT = 2056;
constexpr int S5_U = 0, S5_Z = 33792, S5_X = 67584;
static_assert(S5_X + 16 * S5_XT * 2 <= MISC_OFF, "S5 LDS map");
struct S5A { float are, aim, cre, cim; };
__device__ __forceinline__ S5A s5_a(KArgsP a, int l, int g, int p) {
    const float lam_re = a->in[I_S5ARE][(size_t)(l * 16 + g) * 64 + p], lam_im = a->in[I_S5AIM][(size_t)(l * 16 + g) * 64 + p];
    const float dt = expf(a->in[I_S5LDT][l * 16 + g]); const float mag = expf(lam_re * dt), ang = lam_im * dt;
    S5A r; r.are = mag * cosf(ang); r.aim = mag * sinf(ang);
    const float inv = 1.f / (lam_re * lam_re + lam_im * lam_im);
    r.cre = ((r.are - 1.f) * lam_re + r.aim * lam_im) * inv; r.cim = (r.aim * lam_re - (r.are - 1.f) * lam_im) * inv; return r;
}
__device__ __forceinline__ bf16x8 pack8(const float* v) { v4u o; o.x = pk2(v[0], v[1]); o.y = pk2(v[2], v[3]); o.z = pk2(v[4], v[5]); o.w = pk2(v[6], v[7]); return __builtin_bit_cast(bf16x8, o); }
__device__ __forceinline__ void s5_bfrag(const unsigned char* ws, int l, int g, int lane, bf16x8 (&bf)[8]) {
    const bf16* BB = (const bf16*)(ws + WS_S5BB) + (size_t)(l * 16 + g) * 128 * 16;
#pragma unroll
    for (int j = 0; j < 8; ++j) { v4u o = {0u, 0u, 0u, 0u}; if ((lane >> 4) < 2) o = *(const GAS v4u*)(BB + (16 * j + (lane & 15)) * 16 + 8 * (lane >> 4)); bf[j] = __builtin_bit_cast(bf16x8, o); }
}
__device__ __forceinline__ f32x2 s5_ap(const unsigned char* ws, int l, int g, int p) { return *(const GAS f32x2*)((const float*)(ws + WS_S5AP) + ((size_t)(l * 16 + g) * 64 + p) * 2); }
__device__ __forceinline__ void s5_load_u(const unsigned char* ws, LAS unsigned char* lds, int tid, size_t row0) {
    const bf16* PROJ = (const bf16*)(ws + WS_PROJ);
    for (int idx = tid; idx < 64 * 32; idx += NTHR) { const int t = idx >> 5, c8 = idx & 31;
        *(LAS v4u*)(lds + S5_U + (t * S5_UT + c8 * 8) * 2) = *(const GAS v4u*)(PROJ + (row0 + t) * NPROJ + PC_S5 + c8 * 8); }
}
__device__ __forceinline__ void s5_block(LAS unsigned char* lds, int lane, int tb, int g, const bf16x8 (&bf)[8], float are, float aim, float& xr, float& xi) {
    const int kq = lane >> 4; bf16x8 uf = {0, 0, 0, 0, 0, 0, 0, 0};
    if (kq < 2) uf = *(const LAS bf16x8*)(lds + S5_U + ((16 * tb + (lane & 15)) * S5_UT + g * 16 + 8 * kq) * 2);
    LAS bf16* X = (LAS bf16*)(lds + S5_X);
#pragma unroll
    for (int j = 0; j < 8; ++j) { f32x4 acc = {0.f, 0.f, 0.f, 0.f}; acc = __builtin_amdgcn_mfma_f32_16x16x32_bf16(bf[j], uf, acc, 0, 0, 0);
        v2u o; o.x = pk2(acc[0], acc[1]); o.y = pk2(acc[2], acc[3]); *(LAS v2u*)(X + (lane & 15) * S5_XT + g * 128 + 16 * j + 4 * kq) = o; }
    LDS_WAIT(); asm volatile("" ::: "memory");
    LAS unsigned* xw = (LAS unsigned*)(lds + S5_X) + (g * 128 + 2 * lane) / 2;
    unsigned wv[16];
#pragma unroll
    for (int t = 0; t < 16; ++t) wv[t] = xw[t * (S5_XT / 2)];
#pragma unroll
    for (int t = 0; t < 16; ++t) { const float br = bflo(wv[t]), bi = bfhi(wv[t]);
        const float nr = are * xr - aim * xi + br, ni = are * xi + aim * xr + bi; xr = nr; xi = ni;
        wv[t] = pk2(xr, xi); }
#pragma unroll
    for (int t = 0; t < 16; ++t) xw[t * (S5_XT / 2)] = wv[t];
    LDS_WAIT(); asm volatile("" ::: "memory");
}
__device__ __forceinline__ void phase_s1(KArgsP a, LAS unsigned char* lds, int tid, int lane, int wave, int vcu, int G, int l) {
    unsigned char* ws = a->ws; float* ST = (float*)(ws + WS_S5ST);
    bf16x8 bf0[8], bf1[8]; s5_bfrag(ws, l, wave, lane, bf0); s5_bfrag(ws, l, wave + 8, lane, bf1);
    struct { float are, aim; } A0, A1; { const f32x2 q0 = s5_ap(ws, l, wave, lane), q1 = s5_ap(ws, l, wave + 8, lane); A0.are = q0.x; A0.aim = q0.y; A1.are = q1.x; A1.aim = q1.y; }
    for (int u = vcu; u < NB * NCH; u += G) {
        const size_t row0 = (size_t)u * 64;
        __syncthreads();
        s5_load_u(ws, lds, tid, row0);
        __syncthreads();
        float x0r = 0.f, x0i = 0.f, x1r = 0.f, x1i = 0.f;
        for (int tb = 0; tb < 4; ++tb) { s5_block(lds, lane, tb, wave, bf0, A0.are, A0.aim, x0r, x0i); s5_block(lds, lane, tb, wave + 8, bf1, A1.are, A1.aim, x1r, x1i); }
        *(f32x2*)(ST + (((size_t)u * 16 + wave) * 64 + lane) * 2) = (f32x2){x0r, x0i};
        *(f32x2*)(ST + (((size_t)u * 16 + wave + 8) * 64 + lane) * 2) = (f32x2){x1r, x1i};
    }
}
__device__ __forceinline__ void phase_s2(KArgsP a, int tid, int wg, int nwg, int l) {
    float* ST = (float*)(a->ws + WS_S5ST);
    for (int idx = wg * NTHR + tid; idx < NB * 1024; idx += nwg * NTHR) {
        const int b = idx >> 10, gp = idx & 1023, g = gp >> 6, p = gp & 63;
        const f32x2 A = s5_ap(a->ws, l, g, p); float ar = A.x, ai = A.y;
#pragma unroll
        for (int s = 0; s < 6; ++s) { const float nr = ar * ar - ai * ai, ni = 2.f * ar * ai; ar = nr; ai = ni; }
        float cr = 0.f, ci = 0.f;
        f32x2 en[8];
#pragma unroll
        for (int j = 0; j < 8; ++j) en[j] = *(const f32x2*)(ST + (((size_t)(b * NCH + j) * 16 + g) * 64 + p) * 2);
        for (int c0 = 0; c0 < NCH; c0 += 8) {
            f32x2 e[8];
#pragma unroll
            for (int j = 0; j < 8; ++j) e[j] = en[j];
            { const int cq = min(c0 + 8, NCH - 8);
#pragma unroll
              for (int j = 0; j < 8; ++j) en[j] = *(const f32x2*)(ST + (((size_t)(b * NCH + cq + j) * 16 + g) * 64 + p) * 2); }
#pragma unroll
            for (int j = 0; j < 8; ++j) { *(f32x2*)(ST + (((size_t)(b * NCH + c0 + j) * 16 + g) * 64 + p) * 2) = (f32x2){cr, ci};
                const float nr = ar * cr - ai * ci + e[j].x, ni = ar * ci + ai * cr + e[j].y; cr = nr; ci = ni; }
        }
    }
}
__device__ __forceinline__ float tanh_fast(float x) { return 1.f - 2.f / (1.f + __expf(2.f * x)); }
__device__ __forceinline__ float gelu_tanh_(float x) { const float t = tanh_fast(0.7978845608f * (x + 0.044715f * x * x * x)); return 0.5f * x * (1.f + t); }
__device__ __forceinline__ void s5_cload(const bf16* cmt  , int lane, bf16x8 (&cf)[4]) {
#pragma unroll
    for (int s = 0; s < 4; ++s) cf[s] = __builtin_bit_cast(bf16x8, *(const GAS v4u*)(cmt + (lane & 15) * 128 + 32 * s + 8 * (lane >> 4)));
}
__device__ __forceinline__ void s5_cproj(LAS unsigned char* lds, int lane, int tb, int g, const bf16x8 (&cf)[4], const float (&dv)[4]) {
    const int kq = lane >> 4; f32x4 acc = {0.f, 0.f, 0.f, 0.f};
    const LAS bf16* xp = (const LAS bf16*)(lds + S5_X) + (lane & 15) * S5_XT + g * 128 + 8 * kq;
#pragma unroll
    for (int s = 0; s < 4; ++s) acc = __builtin_amdgcn_mfma_f32_16x16x32_bf16(cf[s], *(const LAS bf16x8*)(xp + 32 * s), acc, 0, 0, 0);
    const int t = 16 * tb + (lane & 15), c0 = g * 16 + 4 * kq;
    const v2u uw = *(const LAS v2u*)(lds + S5_U + (t * S5_UT + c0) * 2);
    const float u4[4] = {bflo(uw.x), bfhi(uw.x), bflo(uw.y), bfhi(uw.y)}; float z[4];
#pragma unroll
    for (int r = 0; r < 4; ++r) z[r] = gelu_tanh_(acc[r] + dv[r] * u4[r]);
    v2u o; o.x = pk2(z[0], z[1]); o.y = pk2(z[2], z[3]); *(LAS v2u*)(lds + S5_Z + (t * S5_UT + c0) * 2) = o;
}
__device__ __forceinline__ void phase_s3(KArgsP a, LAS unsigned char* lds, int tid, int lane, int wave, int vcu, int G, int l, unsigned* qctr = nullptr) {
    unsigned char* ws = a->ws; const float* ST = (const float*)(ws + WS_S5ST); bf16* YC = (bf16*)(ws + WS_YC);
    const bf16* GLUT = (const bf16*)(ws + WS_GLUT) + (size_t)l * DC * DC;
    bf16x8 bf0[8], bf1[8]; s5_bfrag(ws, l, wave, lane, bf0); s5_bfrag(ws, l, wave + 8, lane, bf1);
    const bf16* cm0 = (const bf16*)(ws + WS_S5CM) + (size_t)(l * 16 + wave) * 2048; const bf16* cm1 = cm0 + 8 * 2048;
    struct { float are, aim; } A0, A1; { const f32x2 q0 = s5_ap(ws, l, wave, lane), q1 = s5_ap(ws, l, wave + 8, lane); A0.are = q0.x; A0.aim = q0.y; A1.are = q1.x; A1.aim = q1.y; }
    float d0[4], d1[4];
#pragma unroll
    for (int r = 0; r < 4; ++r) { d0[r] = a->in[I_S5D][l * DC + wave * 16 + 4 * (lane >> 4) + r]; d1[r] = a->in[I_S5D][l * DC + (wave + 8) * 16 + 4 * (lane >> 4) + r]; }
    volatile LAS unsigned* qw = (volatile LAS unsigned*)(lds + MISC_OFF) + 20;
    unsigned qn = 0u; if (qctr && tid == 0) qn = __hip_atomic_fetch_add(qctr, 1u, __ATOMIC_RELAXED, __HIP_MEMORY_SCOPE_AGENT);
    for (int u = vcu; ; u += G) {
        if (qctr) { __syncthreads(); if (tid == 0) *qw = qn; __syncthreads(); u = (int)*qw; }
        if (u >= NB * NCH) break;
        if (qctr && tid == 0) qn = __hip_atomic_fetch_add(qctr, 1u, __ATOMIC_RELAXED, __HIP_MEMORY_SCOPE_AGENT);
        const size_t row0 = (size_t)u * 64;
        __syncthreads();
        s5_load_u(ws, lds, tid, row0);
        const f32x2 s0 = *(const f32x2*)(ST + (((size_t)u * 16 + wave) * 64 + lane) * 2), s1 = *(const f32x2*)(ST + (((size_t)u * 16 + wave + 8) * 64 + lane) * 2);
        float x0r = s0.x, x0i = s0.y, x1r = s1.x, x1i = s1.y;
        __syncthreads();
        for (int tb = 0; tb < 4; ++tb) {
            { bf16x8 cf[4]; s5_cload(cm0, lane, cf); s5_block(lds, lane, tb, wave, bf0, A0.are, A0.aim, x0r, x0i); s5_cproj(lds, lane, tb, wave, cf, d0); }
            { bf16x8 cf[4]; s5_cload(cm1, lane, cf); s5_block(lds, lane, tb, wave + 8, bf1, A1.are, A1.aim, x1r, x1i); s5_cproj(lds, lane, tb, wave + 8, cf, d1); }
        }
        __syncthreads();
        {
            const int kq = lane >> 4;
#pragma unroll
            for (int q = 0; q < 2; ++q) { const int ct = 2 * wave + q; f32x4 acc[4];
#pragma unroll
                for (int rt = 0; rt < 4; ++rt) acc[rt] = (f32x4){0.f, 0.f, 0.f, 0.f};
                const bf16* gp = GLUT + (size_t)(16 * ct + (lane & 15)) * DC + 8 * kq;
#pragma unroll 2
                for (int s = 0; s < 8; ++s) { const bf16x8 gf = __builtin_bit_cast(bf16x8, *(const GAS v4u*)(gp + 32 * s));
#pragma unroll
                    for (int rt = 0; rt < 4; ++rt) acc[rt] = __builtin_amdgcn_mfma_f32_16x16x32_bf16(gf, *(const LAS bf16x8*)(lds + S5_Z + ((16 * rt + (lane & 15)) * S5_UT + 32 * s + 8 * kq) * 2), acc[rt], 0, 0, 0); }
                const int j0 = 16 * ct + 4 * kq; const f32x4 gb = *(const GAS f32x4*)(a->in[I_S5GLUB] + l * DC + j0);
#pragma unroll
                for (int rt = 0; rt < 4; ++rt) { const int t = 16 * rt + (lane & 15); const v2u zw = *(const LAS v2u*)(lds + S5_Z + (t * S5_UT + j0) * 2);
                    const float z0 = bflo(zw.x), z1 = bfhi(zw.x), z2 = bflo(zw.y), z3 = bfhi(zw.y);
                    v2u o; o.x = pk2(z0 * sigmoidf_(acc[rt][0] + gb.x), z1 * sigmoidf_(acc[rt][1] + gb.y)); o.y = pk2(z2 * sigmoidf_(acc[rt][2] + gb.z), z3 * sigmoidf_(acc[rt][3] + gb.w));
                    *(GAS v2u*)(YC + (row0 + t) * DM + 768 + j0) = o; } }
        }
    }
}

__device__ __forceinline__ float rw_shift(const bf16* PROJ, const float* mu, size_t row, int col) {
    const float cur = bf2f(PROJ[row * NPROJ + PC_RW + col]); const float prv = (row % SEQ) ? bf2f(PROJ[(row - 1) * NPROJ + PC_RW + col]) : 0.f;
    return cur + mu[col] * (prv - cur);
}
constexpr int R1_TH = 0, R1_AD = 9216, R1_SG = 18432, R1_VS = 35840, R1_TMP = 86016;
template <int KS, int MODE>
__device__ __forceinline__ void r1_prod(const bf16* WT, const LAS bf16* act, int astride, const float* bias, bf16* OUT, size_t row0, int lane, int wave) {
    const int kq = lane >> 4, n0 = 48 * wave; constexpr int K = 32 * KS;
    f32x4 acc[3][4];
#pragma unroll
    for (int nt = 0; nt < 3; ++nt)
#pragma unroll
        for (int ti = 0; ti < 4; ++ti) acc[nt][ti] = (f32x4){0.f, 0.f, 0.f, 0.f};
#pragma unroll
    for (int s = 0; s < KS; ++s) { bf16x8 wf[3], af[4];
#pragma unroll
        for (int nt = 0; nt < 3; ++nt) wf[nt] = __builtin_bit_cast(bf16x8, *(const GAS v4u*)(WT + (size_t)(n0 + 16 * nt + (lane & 15)) * K + 32 * s + 8 * kq));
#pragma unroll
        for (int ti = 0; ti < 4; ++ti) af[ti] = *(const LAS bf16x8*)(act + (16 * ti + (lane & 15)) * astride + 32 * s + 8 * kq);
#pragma unroll
        for (int nt = 0; nt < 3; ++nt)
#pragma unroll
            for (int ti = 0; ti < 4; ++ti) acc[nt][ti] = __builtin_amdgcn_mfma_f32_16x16x32_bf16(wf[nt], af[ti], acc[nt][ti], 0, 0, 0); }
#pragma unroll
    for (int nt = 0; nt < 3; ++nt) { const int n = n0 + 16 * nt + 4 * kq; f32x4 bv = {0.f, 0.f, 0.f, 0.f}; if (MODE != 2) bv = *(const GAS f32x4*)(bias + n);
#pragma unroll
        for (int ti = 0; ti < 4; ++ti) { float o[4];
#pragma unroll
            for (int r = 0; r < 4; ++r) { const float x = acc[nt][ti][r] + bv[r]; o[r] = MODE == 0 ? 0.60653066f * sigmoidf_(x) : (MODE == 1 ? sigmoidf_(x) : x); }
            v2u w; w.x = pk2(o[0], o[1]); w.y = pk2(o[2], o[3]);
            *(GAS v2u*)(OUT + (row0 + 16 * ti + (lane & 15)) * DBR + n) = w; } }
}
__device__ __forceinline__ void phase_r1(KArgsP a, LAS unsigned char* lds, int tid, int lane, int wave, int vcu, int G, int l) {
    unsigned char* ws = a->ws; const bf16* PROJ = (const bf16*)(ws + WS_PROJ); const float* mu = a->in[I_RMU] + (size_t)l * RW_COLS;
    const bf16* W1 = (const bf16*)(ws + WS_R1W) + (size_t)l * 98304;
    const bf16* WV = (const bf16*)(ws + WS_R1W) + 2 * 98304;
    for (int u = vcu; u < NTOK / 64; u += G) {
        const size_t row0 = (size_t)u * 64;
        __syncthreads();
        for (int idx = tid; idx < 64 * 32; idx += NTHR) { const int tt = idx >> 5, col = 8 * (idx & 31); const size_t r = row0 + tt;
            const v4u cw = *(const GAS v4u*)(PROJ + r * NPROJ + PC_RW + RWC_WD + col); v4u pw = {0u, 0u, 0u, 0u}; if (r % SEQ) pw = *(const GAS v4u*)(PROJ + (r - 1) * NPROJ + PC_RW + RWC_WD + col);
            const f32x4 m0 = *(const GAS f32x4*)(mu + RWC_WD + col), m1 = *(const GAS f32x4*)(mu + RWC_WD + col + 4);
            const unsigned cu[4] = {cw.x, cw.y, cw.z, cw.w}, pu[4] = {pw.x, pw.y, pw.z, pw.w}; const float mm[8] = {m0[0], m0[1], m0[2], m0[3], m1[0], m1[1], m1[2], m1[3]}; unsigned o[4];
#pragma unroll
            for (int j = 0; j < 4; ++j) { const float c0 = bflo(cu[j]), c1 = bfhi(cu[j]); const float x0 = c0 + mm[2 * j] * (bflo(pu[j]) - c0), x1 = c1 + mm[2 * j + 1] * (bfhi(pu[j]) - c1);
                o[j] = col < 64 ? pk2(tanh_fast(x0), tanh_fast(x1)) : (col < 128 ? pk2(x0, x1) : pk2(sigmoidf_(x0), sigmoidf_(x1))); }
            v4u w; w.x = o[0]; w.y = o[1]; w.z = o[2]; w.w = o[3];
            if (col < 64) *(LAS v4u*)(lds + R1_TH + (tt * 72 + col) * 2) = w;
            else if (col < 128) *(LAS v4u*)(lds + R1_AD + (tt * 72 + col - 64) * 2) = w;
            else *(LAS v4u*)(lds + R1_SG + (tt * 136 + col - 128) * 2) = w; }
        if (l > 0) for (int idx = tid; idx < 64 * 48; idx += NTHR) { const int tt = idx / 48, col = 8 * (idx % 48); const size_t r = row0 + tt;
            const v4u cw = *(const GAS v4u*)(PROJ + r * NPROJ + PC_RW + RWC_V + col); v4u pw = {0u, 0u, 0u, 0u}; if (r % SEQ) pw = *(const GAS v4u*)(PROJ + (r - 1) * NPROJ + PC_RW + RWC_V + col);
            const f32x4 m0 = *(const GAS f32x4*)(mu + RWC_V + col), m1 = *(const GAS f32x4*)(mu + RWC_V + col + 4);
            const unsigned cu[4] = {cw.x, cw.y, cw.z, cw.w}, pu[4] = {pw.x, pw.y, pw.z, pw.w}; const float mm[8] = {m0[0], m0[1], m0[2], m0[3], m1[0], m1[1], m1[2], m1[3]}; unsigned o[4];
#pragma unroll
            for (int j = 0; j < 4; ++j) { const float c0 = bflo(cu[j]), c1 = bfhi(cu[j]); o[j] = pk2(c0 + mm[2 * j] * (bflo(pu[j]) - c0), c1 + mm[2 * j + 1] * (bfhi(pu[j]) - c1)); }
            v4u w; w.x = o[0]; w.y = o[1]; w.z = o[2]; w.w = o[3];
            *(LAS v4u*)(lds + R1_VS + (tt * 392 + col) * 2) = w; }
        __syncthreads();
        r1_prod<2, 0>(W1, (const LAS bf16*)(lds + R1_TH), 72, a->in[I_RW0] + l * DBR, (bf16*)(ws + WS_RE), row0, lane, wave);
        r1_prod<2, 1>(W1 + 24576, (const LAS bf16*)(lds + R1_AD), 72, a->in[I_RA0] + l * DBR, (bf16*)(ws + WS_RA), row0, lane, wave);
        r1_prod<4, 2>(W1 + 49152, (const LAS bf16*)(lds + R1_SG), 136, nullptr, (bf16*)(ws + WS_RG), row0, lane, wave);
        if (l > 0) {
            { const int kq = lane >> 4, mt = wave & 1, ti = wave >> 1; f32x4 acc = {0.f, 0.f, 0.f, 0.f};
#pragma unroll
              for (int s = 0; s < 12; ++s) acc = __builtin_amdgcn_mfma_f32_16x16x32_bf16(__builtin_bit_cast(bf16x8, *(const GAS v4u*)(WV + (size_t)(16 * mt + (lane & 15)) * 384 + 32 * s + 8 * kq)),
                                                                                          *(const LAS bf16x8*)(lds + R1_VS + ((16 * ti + (lane & 15)) * 392 + 32 * s + 8 * kq) * 2), acc, 0, 0, 0);
              v2u w; w.x = pk2(acc[0], acc[1]); w.y = pk2(acc[2], acc[3]); *(LAS v2u*)(lds + R1_TMP + ((16 * ti + (lane & 15)) * 40 + 16 * mt + 4 * kq) * 2) = w; }
            __syncthreads();
            r1_prod<1, 1>(WV + 12288, (const LAS bf16*)(lds + R1_TMP), 40, a->in[I_RV0], (bf16*)(ws + WS_RVG), row0, lane, wave);
        }
    }
}
__device__ __forceinline__ float dpp_allsum(float x) {
    x += __builtin_bit_cast(float, __builtin_amdgcn_update_dpp(0, __builtin_bit_cast(int, x), 0x128, 0xf, 0xf, false));
    x += __builtin_bit_cast(float, __builtin_amdgcn_update_dpp(0, __builtin_bit_cast(int, x), 0x124, 0xf, 0xf, false));
    x += __builtin_bit_cast(float, __builtin_amdgcn_update_dpp(0, __builtin_bit_cast(int, x), 0x122, 0xf, 0xf, false));
    x += __builtin_bit_cast(float, __builtin_amdgcn_update_dpp(0, __builtin_bit_cast(int, x), 0x121, 0xf, 0xf, false));
    { const unsigned xi = __builtin_bit_cast(unsigned, x); auto r = __builtin_amdgcn_permlane16_swap(xi, xi, false, false); const unsigned r0 = r[0], r1 = r[1]; x = __uint_as_float(r0) + __uint_as_float(r1); }
    { const unsigned xi = __builtin_bit_cast(unsigned, x); auto r = __builtin_amdgcn_permlane32_swap(xi, xi, false, false); const unsigned r0 = r[0], r1 = r[1]; x = __uint_as_float(r0) + __uint_as_float(r1); }
    return x;
}

constexpr int RC_EF = 0, RC_ATF = 4096, RC_QF = 8448, RC_PFT = 9472, RC_AT = 10496, RC_RT = 12800, RC_BH = 15104, RC_KH = 17408, RC_AH = 19712, RC_BTT = 22016, RC_KTT = 25088, RC_VS = 28160,
              RC_PRL = 31232, RC_QRL = 32000, RC_TQL = 32768, RC_G15 = 33536, RC_CH = 33792;
struct RCRegs { v2u r0, r1, k0, k1, aa, ee, v0, v1, vg, vf, gg; };
__device__ __forceinline__ void rc_issue(const unsigned char* ws, int l, size_t row, int h, int tid, RCRegs& R) {
    const bf16* PROJ = (const bf16*)(ws + WS_PROJ); const int tt = tid >> 4, c0 = h * 64 + 4 * (tid & 15); const size_t r = row + tt; const bool first = (r % SEQ) == 0; const size_t rp = first ? r : r - 1;
    R.r0 = *(const GAS v2u*)(PROJ + r * NPROJ + PC_RW + RWC_R + c0); R.r1 = *(const GAS v2u*)(PROJ + rp * NPROJ + PC_RW + RWC_R + c0);
    R.k0 = *(const GAS v2u*)(PROJ + r * NPROJ + PC_RW + RWC_K + c0); R.k1 = *(const GAS v2u*)(PROJ + rp * NPROJ + PC_RW + RWC_K + c0);
    R.v0 = *(const GAS v2u*)(PROJ + r * NPROJ + PC_RW + RWC_V + c0); R.v1 = *(const GAS v2u*)(PROJ + rp * NPROJ + PC_RW + RWC_V + c0);
    R.aa = *(const GAS v2u*)((const bf16*)(ws + WS_RA) + r * DBR + c0); R.ee = *(const GAS v2u*)((const bf16*)(ws + WS_RE) + r * DBR + c0);
    R.gg = *(const GAS v2u*)((const bf16*)(ws + WS_RG) + r * DBR + c0);
    if (l > 0) { R.vg = *(const GAS v2u*)((const bf16*)(ws + WS_RVG) + r * DBR + c0); R.vf = *(const GAS v2u*)((const bf16*)(ws + WS_VF) + r * DBR + c0); }
    if (first) { R.r1 = (v2u){0u, 0u}; R.k1 = (v2u){0u, 0u}; R.v1 = (v2u){0u, 0u}; }
}
__device__ __forceinline__ void unpack4(const v2u p, float (&o)[4]) { o[0] = bflo(p.x); o[1] = bfhi(p.x); o[2] = bflo(p.y); o[3] = bfhi(p.y); }
__device__ __forceinline__ v2u pack4(const float (&v)[4]) { v2u o; o.x = pk2(v[0], v[1]); o.y = pk2(v[2], v[3]); return o; }
__device__ __forceinline__ v2u pack4v(const f32x4 v) { v2u o; o.x = pk2(v[0], v[1]); o.y = pk2(v[2], v[3]); return o; }
__device__ __forceinline__ bf16x8 cat8(const v2u a, const v2u b) { v4u o; o.x = a.x; o.y = a.y; o.z = b.x; o.w = b.y; return __builtin_bit_cast(bf16x8, o); }
#define RC_BAR() asm volatile("s_waitcnt lgkmcnt(0)\n\ts_barrier" ::: "memory")

constexpr int REC_BYTES = 12288, REC_UNITS = 752;
__device__ __forceinline__ unsigned char* rc_rec(unsigned char* ws, size_t cu) { return cu < 8192 ? ws + WS_OPA + cu * REC_BYTES : ws + WS_OPB + (cu - 8192) * REC_BYTES; }
__device__ __forceinline__ v4u rc_gather_unit(const LAS unsigned char* wb, int u) {
    v2u lo, hi;
    if (u < 256) { const int base = u < 128 ? RC_AH : RC_RT, uu = u & 127, row = uu >> 3, s = (uu >> 2) & 1, lq = uu & 3; const LAS unsigned char* p = wb + base + (row * 72 + 32 * s + 4 * lq) * 2;
        lo = *(const LAS v2u*)p; hi = *(const LAS v2u*)(p + 32); }
    else if (u < 512) { const int k = (u - 256) >> 2, lq = (u - 256) & 3; lo = *(const LAS v2u*)(wb + RC_BTT + (k * 24 + 4 * lq) * 2); hi = *(const LAS v2u*)(wb + RC_KTT + (k * 24 + 4 * lq) * 2); }
    else if (u < 576) { const int t = (u - 512) >> 2, lq = (u - 512) & 3; lo = *(const LAS v2u*)(wb + RC_PRL + (t * 24 + 4 * lq) * 2); hi = *(const LAS v2u*)(wb + RC_QRL + (t * 24 + 4 * lq) * 2); }
    else if (u < 608) { const LAS unsigned char* p = wb + RC_TQL + (((u - 576) >> 1) * 24 + 8 * ((u - 576) & 1)) * 2; lo = *(const LAS v2u*)p; hi = *(const LAS v2u*)(p + 8); }
    else if (u < 736) { const LAS unsigned char* p = wb + RC_VS + (((u - 608) >> 1) * 24 + 8 * ((u - 608) & 1)) * 2; lo = *(const LAS v2u*)p; hi = *(const LAS v2u*)(p + 8); }
    else { const LAS unsigned char* p = wb + RC_G15 + (u - 736) * 16; lo = *(const LAS v2u*)p; hi = *(const LAS v2u*)(p + 8); }
    v4u o; o.x = lo.x; o.y = lo.y; o.z = hi.x; o.w = hi.y; return o;
}
__device__ __forceinline__ void rc_copy_out(unsigned char* rec, const LAS unsigned char* wb, int u) {
#pragma unroll
    for (int q = 0; q < 3; ++q) { const int uu = u + 256 * q; if (uu < REC_UNITS) *(GAS v4u*)(rec + uu * 16) = rc_gather_unit(wb, uu); }
}
constexpr int RS_AH = 0, RS_RT = 2304, RS_BK = 4608, RS_PQ = 9728, RS_TQL = 11008, RS_VS = 11776, RS_G15 = 14848, RS_CH = 15360;
__device__ __forceinline__ int rs_unit_off(int u) {
    if (u < 128) return RS_AH + (u >> 3) * 144 + (u & 7) * 16;
    if (u < 256) return RS_RT + ((u - 128) >> 3) * 144 + (u & 7) * 16;
    if (u < 512) return RS_BK + ((u - 256) >> 2) * 80 + (u & 3) * 16;
    if (u < 576) return RS_PQ + ((u - 512) >> 2) * 80 + (u & 3) * 16;
    if (u < 608) return RS_TQL + ((u - 576) >> 1) * 48 + (u & 1) * 16;
    if (u < 736) return RS_VS + ((u - 608) >> 1) * 48 + (u & 1) * 16;
    return RS_G15 + (u - 736) * 16;
}
#define RC_BUILD(RUSE, q) do { const int bh_ = (q) % (NB * NH), b = bh_ / NH, h = bh_ % NH, blk_ = blk0 + (q) / (NB * NH), c0 = h * 64 + 4 * kq; const size_t row0 = (size_t)b * SEQ + (size_t)blk_ * 32; \
        float kkw[4], kaw[4], mur[4], muk[4], muv[4]; \
_Pragma("unroll") \
        for (int j = 0; j < 4; ++j) { kkw[j] = a->in[I_RKK][(size_t)l * DBR + c0 + j]; kaw[j] = a->in[I_RKA][(size_t)l * DBR + c0 + j]; mur[j] = mu[RWC_R + c0 + j]; muk[j] = mu[RWC_K + c0 + j]; muv[j] = mu[RWC_V + c0 + j]; } \
        float an[4], bk[4], km[4], rs[4], ev[4]; \
        {   const RCRegs& R = RUSE; \
            float rc[4], rp[4], kc[4], kp[4], av[4], vc[4], vp[4], ks[4], kk[4], vs[4]; unpack4(R.r0, rc); unpack4(R.r1, rp); unpack4(R.k0, kc); unpack4(R.k1, kp); unpack4(R.aa, av); unpack4(R.ee, ev); unpack4(R.v0, vc); unpack4(R.v1, vp); \
            float ss = 0.f; \
_Pragma("unroll") \
            for (int j = 0; j < 4; ++j) { rs[j] = rc[j] + mur[j] * (rp[j] - rc[j]); ks[j] = kc[j] + muk[j] * (kp[j] - kc[j]); kk[j] = ks[j] * kkw[j]; ss += kk[j] * kk[j]; vs[j] = vc[j] + muv[j] * (vp[j] - vc[j]); } \
            ss += __shfl_xor(ss, 1); ss += __shfl_xor(ss, 2); ss += __shfl_xor(ss, 4); ss += __shfl_xor(ss, 8); \
            const float inv = 1.f / fmaxf(sqrtf(ss), 1e-12f); \
_Pragma("unroll") \
            for (int j = 0; j < 4; ++j) { const float kn = kk[j] * inv; an[j] = -kn; bk[j] = kn * av[j]; km[j] = ks[j] * (1.f + (av[j] - 1.f) * kaw[j]); } \
            if (l == 0) *(GAS v2u*)((bf16*)(ws + WS_VF) + (row0 + tt) * DBR + c0) = pack4(vs); \
            else { float g[4], f[4]; unpack4(R.vg, g); unpack4(R.vf, f); \
_Pragma("unroll") \
                for (int j = 0; j < 4; ++j) vs[j] = vs[j] + (f[j] - vs[j]) * g[j]; } \
            {     \
                float gq[4], o1[4], o2[4]; unpack4(R.gg, gq); float rkp = 0.f; \
_Pragma("unroll") \
                for (int j = 0; j < 4; ++j) rkp += rs[j] * km[j] * a->in[I_RRK][(size_t)l * DBR + c0 + j]; \
                rkp += __shfl_xor(rkp, 1); rkp += __shfl_xor(rkp, 2); rkp += __shfl_xor(rkp, 4); rkp += __shfl_xor(rkp, 8); \
_Pragma("unroll") \
                for (int j = 0; j < 4; ++j) { o1[j] = a->in[I_RLNW][(size_t)l * DBR + c0 + j] * gq[j]; o2[j] = (a->in[I_RLNB][(size_t)l * DBR + c0 + j] + rkp * vs[j]) * gq[j]; } \
                if (ST12) { *(GAS v2u*)((bf16*)(ws + WS_RG) + (row0 + tt) * DBR + c0) = pack4(o1); *(GAS v2u*)((bf16*)(ws + WS_RA) + (row0 + tt) * DBR + c0) = pack4(o2); } } \
            *(LAS f32x4*)(cb + RC_EF + (t * 64 + 4 * kq) * 4) = (f32x4){ev[0], ev[1], ev[2], ev[3]}; \
_Pragma("unroll") \
            for (int j = 0; j < 4; ++j) *(LAS bf16*)(cb + RC_VS + ((4 * kq + j) * 24 + t) * 2) = (bf16)f2bf(vs[j]); \
        } \
        if ((q) + 2 * G < NQ) rc_issue_q(ws, l, (q) + 2 * G, blk0, tid, RUSE); \
        RC_BAR(); \
        {   f32x4 inc = {0.f, 0.f, 0.f, 0.f}, tot = inc; \
_Pragma("unroll") \
            for (int i = 0; i < 16; ++i) { const f32x4 ei = *(const LAS f32x4*)(cb + RC_EF + (i * 64 + 4 * kq) * 4); tot = tot + ei; if (i <= t) inc = inc + ei; } \
            float At[4], Rt[4], Bh[4], Kh[4], Bt[4], Kt[4], Gt[4]; \
_Pragma("unroll") \
            for (int j = 0; j < 4; ++j) { const float Gi = __expf(-inc[j]), Ge = __expf(ev[j] - inc[j]), Gn = __expf(inc[j]); Gt[j] = __expf(-tot[j]); \
                At[j] = an[j] * Ge; Rt[j] = rs[j] * Gi; Bh[j] = bk[j] * Gn; Kh[j] = km[j] * Gn; Bt[j] = Bh[j] * Gt[j]; Kt[j] = Kh[j] * Gt[j]; } \
            *(LAS f32x4*)(cb + RC_ATF + (t * 68 + 4 * kq) * 4) = (f32x4){At[0], At[1], At[2], At[3]}; \
            *(LAS v2u*)(cb + RC_AT + (t * 72 + 4 * kq) * 2) = pack4(At); *(LAS v2u*)(cb + RC_RT + (t * 72 + 4 * kq) * 2) = pack4(Rt); \
            *(LAS v2u*)(cb + RC_BH + (t * 72 + 4 * kq) * 2) = pack4(Bh); *(LAS v2u*)(cb + RC_KH + (t * 72 + 4 * kq) * 2) = pack4(Kh); \
_Pragma("unroll") \
            for (int j = 0; j < 4; ++j) { *(LAS bf16*)(cb + RC_BTT + ((4 * kq + j) * 24 + t) * 2) = (bf16)f2bf(Bt[j]); *(LAS bf16*)(cb + RC_KTT + ((4 * kq + j) * 24 + t) * 2) = (bf16)f2bf(Kt[j]); } \
            if (t == 0) *(LAS f32x4*)(cb + RC_G15 + 4 * kq * 4) = (f32x4){Gt[0], Gt[1], Gt[2], Gt[3]}; \
        } \
        RC_BAR(); \
        {   LAS unsigned char* wb = lds + (wave >> 2) * RC_CH; const int pi = wave & 3; \
            const LAS bf16* Ap = (const LAS bf16*)(wb + (pi < 2 ? RC_AT : RC_RT)) + li * 72 + 8 * lq; const LAS bf16* Bp = (const LAS bf16*)(wb + ((pi & 1) ? RC_KH : RC_BH)) + li * 72 + 8 * lq; \
            f32x4 acc = {0.f, 0.f, 0.f, 0.f}; \
            acc = __builtin_amdgcn_mfma_f32_16x16x32_bf16(*(const LAS bf16x8*)Ap, *(const LAS bf16x8*)Bp, acc, 0, 0, 0); \
            acc = __builtin_amdgcn_mfma_f32_16x16x32_bf16(*(const LAS bf16x8*)(Ap + 32), *(const LAS bf16x8*)(Bp + 32), acc, 0, 0, 0); \
_Pragma("unroll") \
            for (int r = 0; r < 4; ++r) { const int tr = 4 * lq + r; if (pi < 2 ? !(li < tr) : !(li <= tr)) acc[r] = 0.f; } \
            if (pi == 0) *(LAS f32x4*)(wb + RC_PFT + (li * 16 + 4 * lq) * 4) = acc; \
            else if (pi == 1) { \
_Pragma("unroll") \
                for (int r = 0; r < 4; ++r) *(LAS float*)(wb + RC_QF + ((4 * lq + r) * 16 + li) * 4) = acc[r]; } \
            else { LAS bf16* o = (LAS bf16*)(wb + (pi == 2 ? RC_PRL : RC_QRL)); \
_Pragma("unroll") \
                for (int r = 0; r < 4; ++r) o[(4 * lq + r) * 24 + li] = (bf16)f2bf(acc[r]); } \
        } \
        RC_BAR(); \
        if (wave < 4) { \
            LAS unsigned char* wb = lds + (wave >> 1) * RC_CH; const bool isq = wave & 1; \
            float X[16]; \
_Pragma("unroll") \
            for (int r = 0; r < 16; ++r) X[r] = isq ? *(const LAS float*)(wb + RC_QF + (r * 16 + li) * 4) : *(const LAS float*)(wb + RC_ATF + (r * 68 + lane) * 4); \
_Pragma("unroll") \
            for (int j = 0; j < 15; ++j) { const LAS f32x4* pc = (const LAS f32x4*)(wb + RC_PFT + j * 64); const f32x4 c0v = pc[0], c1v = pc[1], c2v = pc[2], c3v = pc[3]; \
                const float c[16] = {c0v[0], c0v[1], c0v[2], c0v[3], c1v[0], c1v[1], c1v[2], c1v[3], c2v[0], c2v[1], c2v[2], c2v[3], c3v[0], c3v[1], c3v[2], c3v[3]}; \
_Pragma("unroll") \
                for (int r = j + 1; r < 16; ++r) X[r] = fmaf(c[r], X[j], X[r]); } \
            if (!isq) { LAS bf16* o = (LAS bf16*)(wb + RC_AH); \
_Pragma("unroll") \
                for (int r = 0; r < 16; ++r) o[r * 72 + lane] = (bf16)f2bf(X[r]); } \
            else if (lane < 16) { LAS bf16* o = (LAS bf16*)(wb + RC_TQL); \
_Pragma("unroll") \
                for (int r = 0; r < 16; ++r) o[r * 24 + lane] = (bf16)f2bf(X[r]); } \
        } \
        RC_BAR(); \
        { const int cc = tid >> 8, u = tid & 255; unsigned char* rec = rc_rec(ws, (size_t)bh_ * 512 + 2 * blk_ + cc); const LAS unsigned char* wb = lds + cc * RC_CH; \
          rc_copy_out(rec, wb, u); } \
        RC_BAR(); \
    } while (0)
#ifndef RS_NT
#define RS_NT 1
#endif
constexpr int RS_TILES = RS_NT;
struct RSOps { bf16x8 a01, a23, r01, r23, tq, pq, bk[4]; v2u vb[RS_TILES]; f32x4 g[4]; };
__device__ __forceinline__ void rs_load(const LAS unsigned char* wb, int wave, int li, int lq, RSOps& O) {
    O.a01 = *(const LAS bf16x8*)(wb + RS_AH + li * 144 + lq * 16); O.a23 = *(const LAS bf16x8*)(wb + RS_AH + li * 144 + 64 + lq * 16);
    O.r01 = *(const LAS bf16x8*)(wb + RS_RT + li * 144 + lq * 16); O.r23 = *(const LAS bf16x8*)(wb + RS_RT + li * 144 + 64 + lq * 16);
    O.pq = *(const LAS bf16x8*)(wb + RS_PQ + li * 80 + lq * 16);
    { const v2u t = *(const LAS v2u*)(wb + RS_TQL + li * 48 + lq * 8); v4u o; o.x = t.x; o.y = t.y; o.z = 0u; o.w = 0u; O.tq = __builtin_bit_cast(bf16x8, o); }
#pragma unroll
    for (int vt = 0; vt < RS_TILES; ++vt) O.vb[vt] = *(const LAS v2u*)(wb + RS_VS + (16 * (RS_TILES * wave + vt) + li) * 48 + lq * 8);
#pragma unroll
    for (int kt = 0; kt < 4; ++kt) { O.bk[kt] = *(const LAS bf16x8*)(wb + RS_BK + (16 * kt + li) * 80 + lq * 16); O.g[kt] = *(const LAS f32x4*)(wb + RS_G15 + (16 * kt + 4 * lq) * 4); }
}
#define RC_CHUNK(O, cc, yb) do { const v2u z2_ = {0u, 0u}; \
_Pragma("unroll") \
        for (int vt = 0; vt < RS_TILES; ++vt) {     \
            f32x4 aD = {0.f, 0.f, 0.f, 0.f}, aY = {0.f, 0.f, 0.f, 0.f}; \
            aD = __builtin_amdgcn_mfma_f32_16x16x32_bf16(O.tq, cat8(O.vb[vt], z2_), aD, 0, 0, 0); \
            aD = __builtin_amdgcn_mfma_f32_16x16x32_bf16(O.a01, Sb01[vt], aD, 0, 0, 0); \
            aD = __builtin_amdgcn_mfma_f32_16x16x32_bf16(O.a23, Sb23[vt], aD, 0, 0, 0); \
            aY = __builtin_amdgcn_mfma_f32_16x16x32_bf16(Sb01[vt], O.r01, aY, 0, 0, 0); \
            aY = __builtin_amdgcn_mfma_f32_16x16x32_bf16(Sb23[vt], O.r23, aY, 0, 0, 0); \
            const bf16x8 DV = cat8(pack4v(aD), O.vb[vt]); \
_Pragma("unroll") \
            for (int kt = 0; kt < 4; ++kt) Sacc[vt][kt] = __builtin_amdgcn_mfma_f32_16x16x32_bf16(O.bk[kt], DV, Sacc[vt][kt] * O.g[kt], 0, 0, 0); \
            aY = __builtin_amdgcn_mfma_f32_16x16x32_bf16(DV, O.pq, aY, 0, 0, 0); \
            Sb01[vt] = cat8(pack4v(Sacc[vt][0]), pack4v(Sacc[vt][1])); Sb23[vt] = cat8(pack4v(Sacc[vt][2]), pack4v(Sacc[vt][3])); \
            *(LAS v2u*)((yb) + (((cc) * 16 + li) * 72 + 16 * (RS_TILES * wave + vt) + 4 * lq) * 2) = pack4v(aY);     \
        } \
    } while (0)
#define RC_SCAN(slot, yb) do { { RSOps O0; rs_load(slot, wave, li, lq, O0); __builtin_amdgcn_sched_barrier(0); RC_CHUNK(O0, 0, yb); } \
        { RSOps O1; rs_load(slot + RS_CH, wave, li, lq, O1); __builtin_amdgcn_sched_barrier(0); RC_CHUNK(O1, 1, yb); } } while (0)

__device__ __forceinline__ void rc_issue_q(const unsigned char* ws, int l, int q, int blk0, int tid, RCRegs& R) {
    const int bh = q % (NB * NH), blk = blk0 + q / (NB * NH);
    rc_issue(ws, l, (size_t)(bh / NH) * SEQ + (size_t)blk * 32, bh % NH, tid, R);
}
template <bool ST12 = true>
__device__ __forceinline__ void phase_r2_build(KArgsP a, LAS unsigned char* lds, int tid, int lane, int wave, int vcu, int G, int l, int blk0 = 0, int nblk = SEQ / 32) {
    unsigned char* ws = a->ws;
    const int tt = tid >> 4, kq = tid & 15, ch = tt >> 4, t = tt & 15;
    const int lq = lane >> 4, li = lane & 15;
    LAS unsigned char* cb = lds + ch * RC_CH;
    const float* mu = a->in[I_RMU] + (size_t)l * RW_COLS;
    const int NQ = NB * NH * nblk;
    RCRegs RA, RB;
    if (vcu < NQ) rc_issue_q(ws, l, vcu, blk0, tid, RA);
    if (vcu + G < NQ) rc_issue_q(ws, l, vcu + G, blk0, tid, RB);
    for (int q0 = vcu; q0 < NQ; q0 += 2 * G) { { const int q = q0; RC_BUILD(RA, q); } if (q0 + G < NQ) { const int q = q0 + G; RC_BUILD(RB, q); } }
}
#ifndef RS_DEPTH
#define RS_DEPTH 4
#endif
struct RSRegs { v4u p[6]; };
__device__ __forceinline__ unsigned char* ubase(const unsigned char* p) {
    const unsigned lo = __builtin_amdgcn_readfirstlane((unsigned)(uintptr_t)p), hi = __builtin_amdgcn_readfirstlane((unsigned)((uintptr_t)p >> 32));
    return (unsigned char*)(((uintptr_t)hi << 32) | lo);
}
struct RSOff { unsigned g[6], s[6]; };
__device__ __forceinline__ void rs_offsets(int lt, RSOff& F) {
#pragma unroll
    for (int j = 0; j < 6; ++j) { const int uu = min(lt + 256 * j, 2 * REC_UNITS - 1); const int cc = uu >= REC_UNITS, u = uu - cc * REC_UNITS;
        F.g[j] = uu * 16 + cc * (REC_BYTES - REC_UNITS * 16); F.s[j] = cc * RS_CH + rs_unit_off(u); }
}
__device__ __forceinline__ void rs_issue(unsigned char* ws, size_t cu0, const RSOff& F, RSRegs& R) {
    const unsigned char* base = ubase(rc_rec(ws, cu0));
#pragma unroll
    for (int j = 0; j < 6; ++j) R.p[j] = *(const GAS v4u*)(base + F.g[j]);
}
__device__ __forceinline__ void rs_store(LAS unsigned char* slot, const RSOff& F, const RSRegs& R) {
#pragma unroll
    for (int j = 0; j < 6; ++j) *(LAS v4u*)(slot + F.s[j]) = R.p[j];
}
struct R3Q { v4u a1, a2; };
__device__ __forceinline__ void r3q_issue(const unsigned char* ws, size_t row0, int h, int lt, R3Q& Q) {
    const unsigned off = (unsigned)(((lt >> 3) * DBR + 8 * (lt & 7)) * 2); const size_t ub = (row0 * DBR + h * 64) * 2;
    Q.a1 = *(const GAS v4u*)(ubase(ws + WS_RG + ub) + off); Q.a2 = *(const GAS v4u*)(ubase(ws + WS_RA + ub) + off);
}
__device__ __forceinline__ float dpp8sum(float x) {
    x += __builtin_bit_cast(float, __builtin_amdgcn_update_dpp(0, __builtin_bit_cast(int, x), 0xB1, 0xf, 0xf, false));
    x += __builtin_bit_cast(float, __builtin_amdgcn_update_dpp(0, __builtin_bit_cast(int, x), 0x4E, 0xf, 0xf, false));
    x += __builtin_bit_cast(float, __builtin_amdgcn_update_dpp(0, __builtin_bit_cast(int, x), 0x141, 0xf, 0xf, false));
    return x;
}
__device__ __forceinline__ void r3_block(const LAS unsigned char* yb, bf16* YC, size_t row0, int h, int lt, const R3Q& Q) {
    const int tk = lt >> 3, c8 = 8 * (lt & 7);
    const v4u yy = *(const LAS v4u*)(yb + (tk * 72 + c8) * 2);
    float d[8] = {bflo(yy.x), bfhi(yy.x), bflo(yy.y), bfhi(yy.y), bflo(yy.z), bfhi(yy.z), bflo(yy.w), bfhi(yy.w)};
    const float m = dpp8sum(((d[0] + d[1]) + (d[2] + d[3])) + ((d[4] + d[5]) + (d[6] + d[7]))) * (1.f / 64.f);
    float q = 0.f;
#pragma unroll
    for (int j = 0; j < 8; ++j) { d[j] -= m; q = fmaf(d[j], d[j], q); }
    const float rstd = rsqrtf(dpp8sum(q) * (1.f / 64.f) + RWKV_GN_EPS);
    const unsigned a1[4] = {Q.a1.x, Q.a1.y, Q.a1.z, Q.a1.w}, a2[4] = {Q.a2.x, Q.a2.y, Q.a2.z, Q.a2.w}; unsigned o[4];
#pragma unroll
    for (int j = 0; j < 4; ++j) o[j] = pk2(fmaf(d[2 * j] * rstd, bflo(a1[j]), bflo(a2[j])), fmaf(d[2 * j + 1] * rstd, bfhi(a1[j]), bfhi(a2[j])));
    v4u w; w.x = o[0]; w.y = o[1]; w.z = o[2]; w.w = o[3];
    *(GAS v4u*)(ubase((const unsigned char*)(YC + row0 * DM + 384 + h * 64)) + (unsigned)((tk * DM + c8) * 2)) = w;
}
template <int VAR = 0>
__device__ __forceinline__ void phase_r2_scan(KArgsP a, LAS unsigned char* lds, int tid, int lane, int wave, int wg, int l, int bsplit = SEQ / 32, unsigned nbuilders = 0u) {
    unsigned char* ws = a->ws; bf16* YC = (bf16*)(ws + WS_YC);
    const int b = wg / NH, h = wg % NH; const size_t rowb = (size_t)b * SEQ, cub = (size_t)wg * 512;
    const int lq = lane >> 4, li = lane & 15, lt = tid - 256; const bool loader = wave >= 4;
    f32x4 Sacc[RS_TILES][4]; bf16x8 Sb01[RS_TILES], Sb23[RS_TILES];
#pragma unroll
    for (int vt = 0; vt < RS_TILES; ++vt) {
#pragma unroll
        for (int kt = 0; kt < 4; ++kt) Sacc[vt][kt] = (f32x4){0.f, 0.f, 0.f, 0.f};
        Sb01[vt] = (bf16x8){0, 0, 0, 0, 0, 0, 0, 0}; Sb23[vt] = Sb01[vt]; }
    constexpr int NBLK = SEQ / 32;
    LAS unsigned char* yb0 = lds + 8 * RS_CH; LAS unsigned char* yb1 = yb0 + 32 * 72 * 2;
    static_assert(8 * RS_CH + 2 * 32 * 72 * 2 <= MISC_OFF, "scan LDS layout");
    if (wave < 4 / RS_TILES) {
        RSOps OA, OB;
        RC_BAR();
        rs_load(lds, wave, li, lq, OA);
#pragma unroll 1
        for (int X = 0; X < NBLK; ++X) {
            LAS unsigned char* sl = lds + (X & 3) * 2 * RS_CH; LAS unsigned char* sn = lds + ((X + 1) & 3) * 2 * RS_CH; LAS unsigned char* yb = yb0 + (X & 1) * (32 * 72 * 2);
            if (X == bsplit - 7 && wave == 0) {
                if (lane == 0) { unsigned* bar_ = (unsigned*)(ws + WS_CTL) + CW_BAR; unsigned* cnt_ = (unsigned*)(ws + WS_CTL) + CW_Q + 64 * l + 48; XB_SPIN(xb_ld(cnt_) < nbuilders, bar_); }
                __builtin_amdgcn_fence(__ATOMIC_ACQUIRE, "agent"); asm volatile("s_waitcnt vmcnt(0)" ::: "memory");
            }
            rs_load(sl + RS_CH, wave, li, lq, OB); __builtin_amdgcn_sched_barrier(0); if (VAR != 2) { RC_CHUNK(OA, 0, yb); } else { asm volatile("" :: "v"(OA.a01), "v"(OA.bk[3]), "v"(OA.g[3])); }
            rs_load(sn, wave, li, lq, OA); __builtin_amdgcn_sched_barrier(0); if (VAR != 2) { RC_CHUNK(OB, 1, yb); } else { asm volatile("" :: "v"(OB.a01), "v"(OB.bk[3]), "v"(OB.g[3])); }
            RC_BAR();
        }
    } else if (!loader) {
        RC_BAR();
        for (int X = 0; X < NBLK; ++X) RC_BAR();
    } else {
        constexpr int ND = 4;
        RSRegs R[ND]; R3Q Q[ND]; RSOff F; rs_offsets(lt, F);
#pragma unroll
        for (int j = 0; j < ND; ++j) { rs_issue(ws, cub + 2 * j, F, R[j]); r3q_issue(ws, rowb + 32 * j, h, lt, Q[j]); }
        rs_store(lds, F, R[0]); rs_issue(ws, cub + 2 * ND, F, R[0]); rs_store(lds + 2 * RS_CH, F, R[1]); rs_issue(ws, cub + 2 * (ND + 1), F, R[1]);
        RC_BAR();
        for (int bb = 0; bb < NBLK; bb += ND) {
#pragma unroll
            for (int j = 0; j < ND; ++j) { const int X = bb + j;
                if (VAR != 1) { r3_block((j & 1) ? yb0 : yb1, YC, rowb + (size_t)max(X - 1, 0) * 32, h, lt, Q[(j + ND - 1) % ND]);
                r3q_issue(ws, rowb + (size_t)min(X - 1 + ND, NBLK - 1) * 32, h, lt, Q[(j + ND - 1) % ND]); }
                rs_store(lds + ((j + 2) & 3) * 2 * RS_CH, F, R[(j + 2) % ND]);
                rs_issue(ws, cub + 2 * (size_t)min(X + 2 + ND, NBLK - 1), F, R[(j + 2) % ND]);
                RC_BAR();
            }
        }
        r3_block(yb1, YC, rowb + (size_t)(NBLK - 1) * 32, h, lt, Q[(NBLK - 1) % ND]);
    }
}
__device__ __forceinline__ void phase_r3(KArgsP a, int lane, int gw, int ngw, int l) {
    unsigned char* ws = a->ws; const bf16* PROJ = (const bf16*)(ws + WS_PROJ); bf16* YC = (bf16*)(ws + WS_YC);
    const bf16* RA = (const bf16*)(ws + WS_RA); const bf16* RG = (const bf16*)(ws + WS_RG); const bf16* RVG = (const bf16*)(ws + WS_RVG); const bf16* VF = (const bf16*)(ws + WS_VF);
    const float* mu = a->in[I_RMU] + (size_t)l * RW_COLS;
    for (size_t row = gw; row < NTOK; row += ngw) {
#pragma unroll
        for (int h = 0; h < NH; ++h) {
            const int c = h * 64 + lane;
            const float y = bf2f(YC[row * DM + 384 + c]);
            const float m = dpp_allsum(y) * (1.f / 64.f); const float d = y - m; const float var = dpp_allsum(d * d) * (1.f / 64.f);
            const float yn = d * rsqrtf(var + RWKV_GN_EPS) * a->in[I_RLNW][l * DBR + c] + a->in[I_RLNB][l * DBR + c];
            const float rs = rw_shift(PROJ, mu, row, RWC_R + c), ks = rw_shift(PROJ, mu, row, RWC_K + c); float v = rw_shift(PROJ, mu, row, RWC_V + c);
            if (l > 0) v = v + (bf2f(VF[row * DBR + c]) - v) * bf2f(RVG[row * DBR + c]);
            const float av = bf2f(RA[row * DBR + c]);
            const float km = ks * (1.f + (av - 1.f) * a->in[I_RKA][l * DBR + c]);
            const float rk = dpp_allsum(rs * km * a->in[I_RRK][l * DBR + c]);
            YC[row * DM + 384 + c] = (bf16)f2bf((yn + rk * v) * bf2f(RG[row * DBR + c]));
        }
    }
}

constexpr int PH_PER_LAYER = 10, PH_FINAL = 1 + 2 * PH_PER_LAYER, N_PHASES = PH_FINAL + 1;
constexpr int R2_WGS = 24;
__global__ void __launch_bounds__(NTHR, 2) fwd(Args args) {
    extern __shared__ __attribute__((aligned(16))) unsigned char lds_raw[];
    LAS unsigned char* lds = (LAS unsigned char*)lds_raw;
    volatile LAS unsigned* MISC = (volatile LAS unsigned*)(lds + MISC_OFF);
    const int tid0 = threadIdx.x;
    const int G = gridDim.x;
#define PHASE_IDS int tid_ = threadIdx.x; asm volatile("" : "+v"(tid_)); const int tid = tid_, lane = tid & 63, wave = __builtin_amdgcn_readfirstlane(tid >> 6); \
    int bx_ = blockIdx.x; asm volatile("" : "+s"(bx_)); const int bx = bx_; const int vcu = (G % 8 == 0) ? (bx % 8) * (G / 8) + bx / 8 : bx; (void)lane; (void)wave; (void)vcu; (void)bx;
    unsigned char* ws0 = fresh_args()->ws;
    for (int u = tid0; u < (LDS_BYTES - RING_BYTES) / 4; u += NTHR) ((LAS unsigned*)(lds + RING_BYTES))[u] = 0u;
    __syncthreads();
    XcdBarrier bar; bar.bar = (unsigned*)(ws0 + WS_CTL) + CW_BAR; bar.x = 0; bar.st = nullptr;
    if (!MK_PER_PHASE) bar = xcd_barrier_post((unsigned*)(ws0 + WS_CTL) + CW_BAR, MISC + 8);
#if MK_PER_PHASE
    const int lo = args.ph_lo, hi = args.ph_hi;
#define IN(k) (lo <= (k) && (k) < hi)
#else
#define IN(k) true
#endif
#define SEAM(k) do { if (IN(k) && IN((k) + 1)) { XcdBarrier b2 = bar; asm volatile("" : "+s"(b2.bar)); xcd_barrier(b2); } } while (0)

#ifndef GEMM_SP2
#define GEMM_SP2 true
#endif
#ifndef GEMM_ALIGN
#define GEMM_ALIGN true
#endif
#ifndef RS_DEPTH
#define RS_DEPTH 4
#endif
#ifndef R2_SPLIT
#define R2_SPLIT 160
#endif
#ifndef SCANVAR
#define SCANVAR 0
#endif
#ifndef DBL_SUB
#define DBL_SUB 0
#endif
#ifndef DBL_PHASE
#define DBL_PHASE (-1)
#endif
#ifndef REPN
#define REPN 2
#endif
#define SUBREP(k) _Pragma("nounroll") for (int q_ = 0; q_ < 1 + (REPN - 1) * (((k) == DBL_SUB) && l == 0); ++q_)
#define REP(k) for (int rep_ = 0; rep_ < ((k) == DBL_PHASE ? REPN : 1); ++rep_)
#define REPBAR if (rep_ > 0) { XcdBarrier b2 = bar; asm volatile("" : "+s"(b2.bar)); xcd_barrier(b2); }
    REP(0) if (IN(0)) { REPBAR KArgsP ap = fresh_args(); PHASE_IDS
_Pragma("nounroll")
 for (int q_ = 0; q_ < 1 + (REPN - 1) * (DBL_SUB == 12); ++q_) { phase_prologue(ap, lds, tid, lane, wave, vcu, G); __syncthreads(); } }
    SEAM(0);
#ifdef EXTRA_BAR
    for (int eb_ = 0; eb_ < EXTRA_BAR; ++eb_) { XcdBarrier b2 = bar; asm volatile("" : "+s"(b2.bar)); xcd_barrier(b2); }
#endif
#define LCONST 0
    {
        constexpr int l = LCONST; constexpr int pb = 1 + l * PH_PER_LAYER;
        REP(pb + 0) if (IN(pb + 0)) { REPBAR KArgsP ap = fresh_args(); PHASE_IDS unsigned char* ws = ap->ws; (void)ws;
            if (l == 0) { mod_finalize(ws, tid, G); SUBREP(6) { phase_rownorm<0, false>(ap, lds, tid, lane, wave, G, ap->in[I_X], ap->out, ap->in[I_NORM_MIX], true, 0, 0, 0); __syncthreads(); } }
            else {
#if EN_MOE
                phase_rownorm<0, true>(ap, lds, tid, lane, wave, G, ap->out, ap->out, ap->in[I_NORM_MIX] + l * DM, false, l, 0, l - 1);
#else
                phase_rownorm<0, false>(ap, lds, tid, lane, wave, G, ap->out, ap->out, ap->in[I_NORM_MIX] + l * DM, false, l, 0, l - 1);
#endif
            }
        }
        SEAM(pb + 0);
        REP(pb + 1) if (IN(pb + 1)) { REPBAR KArgsP ap = fresh_args(); PHASE_IDS unsigned char* ws = ap->ws; (void)ws;
            pg8::Gemm g{(const pg8::bf16_t*)(ws + WS_HN), (const pg8::bf16_t*)(ws + WS_WIN) + (size_t)l * NPROJ_PAD * DM, NTOK, NPROJ_PAD, DM};
            pg8::StaticOrder S; S.init(NTOK, NPROJ_PAD, G, bx);
            pg8::EpiProj E{(pg8::bf16_t*)(ws + WS_PROJ), (float*)(ws + WS_GATES)};
SUBREP(7) { pg8::gemm_phase<pg8::EpiProj, pg8::StaticOrder, GEMM_ALIGN, GEMM_SP2>(lds, g, S, E); __syncthreads(); }
        }
        SEAM(pb + 1);
        REP(pb + 2) if (IN(pb + 2)) { REPBAR KArgsP ap = fresh_args(); PHASE_IDS unsigned char* ws = ap->ws; (void)ws;
#if EN_MLSTM
            for (int q_ = 0; q_ < 1 + (REPN - 1) * ((DBL_SUB == 1) && l == 0); ++q_) { phase_m1(ap, lds, tid, lane, wave, vcu, G, l); __syncthreads(); }
            __syncthreads();
#endif
#if EN_S5
            phase_s1(ap, lds, tid, lane, wave, vcu, G, l); __syncthreads();
#if DBL_SUB == 2
            if (l == 0) { phase_s1(ap, lds, tid, lane, wave, vcu, G, l); __syncthreads(); phase_s1(ap, lds, tid, lane, wave, vcu, G, l); __syncthreads(); phase_s1(ap, lds, tid, lane, wave, vcu, G, l); __syncthreads(); phase_s1(ap, lds, tid, lane, wave, vcu, G, l); __syncthreads(); }
#endif
            __syncthreads();
#endif
#if EN_RWKV
            for (int q_ = 0; q_ < 1 + (REPN - 1) * ((DBL_SUB == 3) && l == 0); ++q_) { phase_r1(ap, lds, tid, lane, wave, vcu, G, l); __syncthreads(); }
#endif
        }
        SEAM(pb + 2);
        REP(pb + 3) if (IN(pb + 3)) { REPBAR KArgsP ap = fresh_args(); PHASE_IDS unsigned char* ws = ap->ws; (void)ws;
            phase_m2(ws, tid, vcu, G);
            phase_s2(ap, tid, vcu, G, l);
            __syncthreads();
            phase_r2_build(ap, lds, tid, lane, wave, vcu, G, l, 0, R2_SPLIT);
        }
        SEAM(pb + 3);
        REP(pb + 4) if (IN(pb + 4)) { REPBAR KArgsP ap = fresh_args(); PHASE_IDS unsigned char* ws = ap->ws; (void)ws;
            if (bx < R2_WGS) {
#if DBL_SUB == 4
                if (l == 0) { for (int q_ = 0; q_ < REPN - 1; ++q_) { phase_r2_scan<SCANVAR>(ap, lds, tid, lane, wave, bx, l, R2_SPLIT, (unsigned)(G - R2_WGS)); __syncthreads(); } }
#endif
                phase_r2_scan(ap, lds, tid, lane, wave, bx, l, R2_SPLIT, (unsigned)(G - R2_WGS)); __syncthreads(); }
            else {
                phase_r2_build(ap, lds, tid, lane, wave, bx - R2_WGS, G - R2_WGS, l, R2_SPLIT, SEQ / 32 - R2_SPLIT);
                asm volatile("s_waitcnt vmcnt(0)" ::: "memory"); __syncthreads();
                if (tid == 0) { __builtin_amdgcn_fence(__ATOMIC_RELEASE, "agent"); asm volatile("s_waitcnt vmcnt(0)" ::: "memory"); (void)xb_add((unsigned*)(ws + WS_CTL) + CW_Q + 64 * l + 48, 1u); }
                phase_s3(ap, lds, tid, lane, wave, 0, 1, l, (unsigned*)(ws + WS_CTL) + CW_Q + 64 * l + 32); __syncthreads();
            }
            {
                unsigned* qctr = (unsigned*)(ws + WS_CTL) + CW_Q + 64 * l; volatile LAS unsigned* qw = (volatile LAS unsigned*)(lds + MISC_OFF) + 16;
                unsigned nxt = 0u; if (tid == 0) nxt = __hip_atomic_fetch_add(qctr, 1u, __ATOMIC_RELAXED, __HIP_MEMORY_SCOPE_AGENT);
                for (;;) {
                    if (tid == 0) *qw = nxt;
                    __syncthreads();
                    const int u = (int)*qw;
                    __syncthreads();
                    if (u >= NUNIT_M) break;
                    if (tid == 0) nxt = __hip_atomic_fetch_add(qctr, 1u, __ATOMIC_RELAXED, __HIP_MEMORY_SCOPE_AGENT);
                    phase_m3(ap, lds, tid, lane, wave, u, NUNIT_M, l);
                }
            }
        }
        SEAM(pb + 4);
        REP(pb + 6) if (IN(pb + 6)) { REPBAR KArgsP ap = fresh_args(); PHASE_IDS unsigned char* ws = ap->ws; (void)ws;
            pg8::Gemm g{(const pg8::bf16_t*)(ws + WS_YC), (const pg8::bf16_t*)(ws + WS_WOUT) + (size_t)l * DM * DM, NTOK, DM, DM};
            pg8::StaticOrder S; S.init(NTOK, DM, G, bx);
            pg8::EpiResid E{l == 0 ? ap->in[I_X] : (const float*)ap->out, ap->out, (const float*)(ws + WS_MODF) + (size_t)l * 4 * 6144, 2048};
SUBREP(8) { pg8::gemm_phase<pg8::EpiResid, pg8::StaticOrder, GEMM_ALIGN, GEMM_SP2>(lds, g, S, E); __syncthreads(); }
        }
        SEAM(pb + 6);
#if EN_MOE
        REP(pb + 7) if (IN(pb + 7)) { REPBAR KArgsP ap = fresh_args(); PHASE_IDS phase_router(ap, lds, tid, lane, wave, G, l); __syncthreads();
            SUBREP(11) {
            moe_convert13(ap->in[I_MW1], ap->in[I_MW3], l, (bf16*)(ap->ws + WS_W13), vcu * NWAVES + wave, G * NWAVES, (LAS float*)(lds + wave * 16640), lane);
            moe_convert2(ap->in[I_MW2], l, (bf16*)(ap->ws + WS_W2), vcu * NWAVES + wave, G * NWAVES, (LAS float*)(lds + wave * 16640), lane); __syncthreads(); } }
        SEAM(pb + 7);
        REP(pb + 8) if (IN(pb + 8)) { REPBAR KArgsP ap = fresh_args(); PHASE_IDS unsigned char* ws = ap->ws; (void)ws;
            LAS int* ptab = (LAS int*)(lds + PTAB_OFF); LAS int* pst = ptab + 512; LAS int* cnt = pst + 32;
            build_ptab((const unsigned*)(ws + WS_CTL) + CW_CNT + l * 32, ptab, pst, cnt, tid);
            pg8::Gemm g{(const pg8::bf16_t*)(ws + WS_HN), (const pg8::bf16_t*)(ws + WS_W13), 0, 0, DM, (const int*)(ws + WS_LIST), ptab};
            pg8::MoeOrder S{ptab, G, vcu};
            pg8::EpiSwiglu E{(pg8::bf16_t*)(ws + WS_HMID)};
SUBREP(9) { pg8::gemm_phase<pg8::EpiSwiglu, pg8::MoeOrder, false, true, true>(lds, g, S, E); __syncthreads(); }
        }
        SEAM(pb + 8);
        REP(pb + 9) if (IN(pb + 9)) { REPBAR KArgsP ap = fresh_args(); PHASE_IDS unsigned char* ws = ap->ws; (void)ws;
            LAS int* ptab = (LAS int*)(lds + PTAB_OFF); LAS int* pst = ptab + 512; LAS int* cnt = pst + 32;
            build_ptab((const unsigned*)(ws + WS_CTL) + CW_CNT + l * 32, ptab, pst, cnt, tid);
            pg8::Gemm g{(const pg8::bf16_t*)(ws + WS_HMID), (const pg8::bf16_t*)(ws + WS_W2), 0, 0, DEXP};
            pg8::MoeOrder S{ptab, G, vcu};
            pg8::EpiMoeOut E{(pg8::bf16_t*)(ws + WS_YMOE), (const int*)(ws + WS_LIST), ptab};
SUBREP(10) { pg8::gemm_phase<pg8::EpiMoeOut, pg8::MoeOrder, true, true>(lds, g, S, E); __syncthreads(); }
        }
        SEAM(pb + 9);
#else
        SEAM(pb + 6); SEAM(pb + 7); SEAM(pb + 8); SEAM(pb + 9);
#endif
    }
#undef LCONST
#if N_LAYERS > 1
#define LCONST 1
    {
        constexpr int l = LCONST; constexpr int pb = 1 + l * PH_PER_LAYER;
        REP(pb + 0) if (IN(pb + 0)) { REPBAR KArgsP ap = fresh_args(); PHASE_IDS unsigned char* ws = ap->ws; (void)ws;
            if (l == 0) { mod_finalize(ws, tid, G); SUBREP(6) { phase_rownorm<0, false>(ap, lds, tid, lane, wave, G, ap->in[I_X], ap->out, ap->in[I_NORM_MIX], true, 0, 0, 0); __syncthreads(); } }
            else {
#if EN_MOE
                phase_rownorm<0, true>(ap, lds, tid, lane, wave, G, ap->out, ap->out, ap->in[I_NORM_MIX] + l * DM, false, l, 0, l - 1);
#else
                phase_rownorm<0, false>(ap, lds, tid, lane, wave, G, ap->out, ap->out, ap->in[I_NORM_MIX] + l * DM, false, l, 0, l - 1);
#endif
            }
        }
        SEAM(pb + 0);
        REP(pb + 1) if (IN(pb + 1)) { REPBAR KArgsP ap = fresh_args(); PHASE_IDS unsigned char* ws = ap->ws; (void)ws;
            pg8::Gemm g{(const pg8::bf16_t*)(ws + WS_HN), (const pg8::bf16_t*)(ws + WS_WIN) + (size_t)l * NPROJ_PAD * DM, NTOK, NPROJ_PAD, DM};
            pg8::StaticOrder S; S.init(NTOK, NPROJ_PAD, G, bx);
            pg8::EpiProj E{(pg8::bf16_t*)(ws + WS_PROJ), (float*)(ws + WS_GATES)};
SUBREP(7) { pg8::gemm_phase<pg8::EpiProj, pg8::StaticOrder, GEMM_ALIGN, GEMM_SP2>(lds, g, S, E); __syncthreads(); }
        }
        SEAM(pb + 1);
        REP(pb + 2) if (IN(pb + 2)) { REPBAR KArgsP ap = fresh_args(); PHASE_IDS unsigned char* ws = ap->ws; (void)ws;
#if EN_MLSTM
            for (int q_ = 0; q_ < 1 + (REPN - 1) * ((DBL_SUB == 1) && l == 0); ++q_) { phase_m1(ap, lds, tid, lane, wave, vcu, G, l); __syncthreads(); }
            __syncthreads();
#endif
#if EN_S5
            phase_s1(ap, lds, tid, lane, wave, vcu, G, l); __syncthreads();
#if DBL_SUB == 2
            if (l == 0) { phase_s1(ap, lds, tid, lane, wave, vcu, G, l); __syncthreads(); phase_s1(ap, lds, tid, lane, wave, vcu, G, l); __syncthreads(); phase_s1(ap, lds, tid, lane, wave, vcu, G, l); __syncthreads(); phase_s1(ap, lds, tid, lane, wave, vcu, G, l); __syncthreads(); }
#endif
            __syncthreads();
#endif
#if EN_RWKV
            for (int q_ = 0; q_ < 1 + (REPN - 1) * ((DBL_SUB == 3) && l == 0); ++q_) { phase_r1(ap, lds, tid, lane, wave, vcu, G, l); __syncthreads(); }
#endif
        }
        SEAM(pb + 2);
        REP(pb + 3) if (IN(pb + 3)) { REPBAR KArgsP ap = fresh_args(); PHASE_IDS unsigned char* ws = ap->ws; (void)ws;
            phase_m2(ws, tid, vcu, G);
            phase_s2(ap, tid, vcu, G, l);
            __syncthreads();
            phase_r2_build(ap, lds, tid, lane, wave, vcu, G, l, 0, R2_SPLIT);
        }
        SEAM(pb + 3);
        REP(pb + 4) if (IN(pb + 4)) { REPBAR KArgsP ap = fresh_args(); PHASE_IDS unsigned char* ws = ap->ws; (void)ws;
            if (bx < R2_WGS) {
#if DBL_SUB == 4
                if (l == 0) { for (int q_ = 0; q_ < REPN - 1; ++q_) { phase_r2_scan<SCANVAR>(ap, lds, tid, lane, wave, bx, l, R2_SPLIT, (unsigned)(G - R2_WGS)); __syncthreads(); } }
#endif
                phase_r2_scan(ap, lds, tid, lane, wave, bx, l, R2_SPLIT, (unsigned)(G - R2_WGS)); __syncthreads(); }
            else {
                phase_r2_build(ap, lds, tid, lane, wave, bx - R2_WGS, G - R2_WGS, l, R2_SPLIT, SEQ / 32 - R2_SPLIT);
                asm volatile("s_waitcnt vmcnt(0)" ::: "memory"); __syncthreads();
                if (tid == 0) { __builtin_amdgcn_fence(__ATOMIC_RELEASE, "agent"); asm volatile("s_waitcnt vmcnt(0)" ::: "memory"); (void)xb_add((unsigned*)(ws + WS_CTL) + CW_Q + 64 * l + 48, 1u); }
                phase_s3(ap, lds, tid, lane, wave, 0, 1, l, (unsigned*)(ws + WS_CTL) + CW_Q + 64 * l + 32); __syncthreads();
            }
            {
                unsigned* qctr = (unsigned*)(ws + WS_CTL) + CW_Q + 64 * l; volatile LAS unsigned* qw = (volatile LAS unsigned*)(lds + MISC_OFF) + 16;
                unsigned nxt = 0u; if (tid == 0) nxt = __hip_atomic_fetch_add(qctr, 1u, __ATOMIC_RELAXED, __HIP_MEMORY_SCOPE_AGENT);
                for (;;) {
                    if (tid == 0) *qw = nxt;
                    __syncthreads();
                    const int u = (int)*qw;
                    __syncthreads();
                    if (u >= NUNIT_M) break;
                    if (tid == 0) nxt = __hip_atomic_fetch_add(qctr, 1u, __ATOMIC_RELAXED, __HIP_MEMORY_SCOPE_AGENT);
                    phase_m3(ap, lds, tid, lane, wave, u, NUNIT_M, l);
                }
            }
        }
        SEAM(pb + 4);
        REP(pb + 6) if (IN(pb + 6)) { REPBAR KArgsP ap = fresh_args(); PHASE_IDS unsigned char* ws = ap->ws; (void)ws;
            pg8::Gemm g{(const pg8::bf16_t*)(ws + WS_YC), (const pg8::bf16_t*)(ws + WS_WOUT) + (size_t)l * DM * DM, NTOK, DM, DM};
            pg8::StaticOrder S; S.init(NTOK, DM, G, bx);
            pg8::EpiResid E{l == 0 ? ap->in[I_X] : (const float*)ap->out, ap->out, (const float*)(ws + WS_MODF) + (size_t)l * 4 * 6144, 2048};
SUBREP(8) { pg8::gemm_phase<pg8::EpiResid, pg8::StaticOrder, GEMM_ALIGN, GEMM_SP2>(lds, g, S, E); __syncthreads(); }
        }
        SEAM(pb + 6);
#if EN_MOE
        REP(pb + 7) if (IN(pb + 7)) { REPBAR KArgsP ap = fresh_args(); PHASE_IDS phase_router(ap, lds, tid, lane, wave, G, l); __syncthreads();
            SUBREP(11) {
            moe_convert13(ap->in[I_MW1], ap->in[I_MW3], l, (bf16*)(ap->ws + WS_W13), vcu * NWAVES + wave, G * NWAVES, (LAS float*)(lds + wave * 16640), lane);
            moe_convert2(ap->in[I_MW2], l, (bf16*)(ap->ws + WS_W2), vcu * NWAVES + wave, G * NWAVES, (LAS float*)(lds + wave * 16640), lane); __syncthreads(); } }
        SEAM(pb + 7);
        REP(pb + 8) if (IN(pb + 8)) { REPBAR KArgsP ap = fresh_args(); PHASE_IDS unsigned char* ws = ap->ws; (void)ws;
            LAS int* ptab = (LAS int*)(lds + PTAB_OFF); LAS int* pst = ptab + 512; LAS int* cnt = pst + 32;
            build_ptab((const unsigned*)(ws + WS_CTL) + CW_CNT + l * 32, ptab, pst, cnt, tid);
            pg8::Gemm g{(const pg8::bf16_t*)(ws + WS_HN), (const pg8::bf16_t*)(ws + WS_W13), 0, 0, DM, (const int*)(ws + WS_LIST), ptab};
            pg8::MoeOrder S{ptab, G, vcu};
            pg8::EpiSwiglu E{(pg8::bf16_t*)(ws + WS_HMID)};
SUBREP(9) { pg8::gemm_phase<pg8::EpiSwiglu, pg8::MoeOrder, false, true, true>(lds, g, S, E); __syncthreads(); }
        }
        SEAM(pb + 8);
        REP(pb + 9) if (IN(pb + 9)) { REPBAR KArgsP ap = fresh_args(); PHASE_IDS unsigned char* ws = ap->ws; (void)ws;
            LAS int* ptab = (LAS int*)(lds + PTAB_OFF); LAS int* pst = ptab + 512; LAS int* cnt = pst + 32;
            build_ptab((const unsigned*)(ws + WS_CTL) + CW_CNT + l * 32, ptab, pst, cnt, tid);
            pg8::Gemm g{(const pg8::bf16_t*)(ws + WS_HMID), (const pg8::bf16_t*)(ws + WS_W2), 0, 0, DEXP};
            pg8::MoeOrder S{ptab, G, vcu};
            pg8::EpiMoeOut E{(pg8::bf16_t*)(ws + WS_YMOE), (const int*)(ws + WS_LIST), ptab};
SUBREP(10) { pg8::gemm_phase<pg8::EpiMoeOut, pg8::MoeOrder, true, true>(lds, g, S, E); __syncthreads(); }
        }
        SEAM(pb + 9);
#else
        SEAM(pb + 6); SEAM(pb + 7); SEAM(pb + 8); SEAM(pb + 9);
#endif
    }
#undef LCONST
#endif
    if (IN(PH_FINAL)) { KArgsP ap = fresh_args(); PHASE_IDS
#if EN_MOE
        if (N_LAYERS > 0) phase_rownorm<1, true>(ap, lds, tid, lane, wave, G, ap->out, ap->out, ap->in[I_NORM_FINAL], false, 0, 0, N_LAYERS - 1);
        else phase_rownorm<1, false>(ap, lds, tid, lane, wave, G, ap->in[I_X], ap->out, ap->in[I_NORM_FINAL], false, 0, 0, 0);
#else
        phase_rownorm<1, false>(ap, lds, tid, lane, wave, G, N_LAYERS > 0 ? (const float*)ap->out : ap->in[I_X], ap->out, ap->in[I_NORM_FINAL], false, 0, 0, 0);
#endif
    }
#undef IN
#undef SEAM
}

extern "C" void kernel_launch(void* const* d_in, const int* in_sizes, int n_in, void* d_out, int out_size, void* d_ws, size_t ws_size, hipStream_t stream) {
    static int grid = 0;
    if (grid == 0) {
        if (n_in != 47 || out_size != NTOK * DM || ws_size < WS_END) { fprintf(stderr, "kernel_launch: unexpected problem (n_in %d, out %d, ws %zu < %zu)\n", n_in, out_size, ws_size, (size_t)WS_END); grid = -1; return; }
        int dev = 0, cus = 0, per_cu = 0;
        if (hipGetDevice(&dev) != hipSuccess || hipDeviceGetAttribute(&cus, hipDeviceAttributeMultiprocessorCount, dev) != hipSuccess) { grid = -1; return; }
        if (hipFuncSetAttribute((const void*)fwd, hipFuncAttributeMaxDynamicSharedMemorySize, LDS_BYTES) != hipSuccess) { fprintf(stderr, "kernel_launch: hipFuncSetAttribute failed\n"); grid = -1; return; }
        if (hipOccupancyMaxActiveBlocksPerMultiprocessor(&per_cu, (const void*)fwd, NTHR, LDS_BYTES) != hipSuccess || per_cu < 1) fprintf(stderr, "kernel_launch: occupancy query says %d\n", per_cu);
        (void)hipGetLastError();
        grid = cus;
        if (grid != 256) fprintf(stderr, "kernel_launch: %d CUs (built for 256)\n", grid);
    }
    if (grid < 0) return;
    (void)hipMemsetAsync((char*)d_ws + WS_CTL, 0, CTL_ZERO_BYTES, stream);
    Args a{};
    for (int i = 0; i < 47; ++i) a.in[i] = (const float*)d_in[i];
    a.out = (float*)d_out; a.ws = (unsigned char*)d_ws;
#if MK_PER_PHASE
    for (int p = 0; p < N_PHASES; ++p) { a.ph_lo = p; a.ph_hi = p + 1; hipLaunchKernelGGL(fwd, dim3(grid), dim3(NTHR), LDS_BYTES, stream, a); }
#else
    a.ph_lo = 0; a.ph_hi = N_PHASES; hipLaunchKernelGGL(fwd, dim3(grid), dim3(NTHR), LDS_BYTES, stream, a);
#endif
}
#ifdef DIAG_KERNELS
#define DK(name, ...) __global__ void __launch_bounds__(NTHR, 2) name(Args args) { extern __shared__ __attribute__((aligned(16))) unsigned char lds_raw[]; LAS unsigned char* lds = (LAS unsigned char*)lds_raw; \
    const int tid = threadIdx.x, lane = tid & 63, wave = __builtin_amdgcn_readfirstlane(tid >> 6); const int G = gridDim.x; const int bx = blockIdx.x; const int vcu = bx; KArgsP ap = fresh_args(); int l = ap->ph_lo; (void)lane; (void)wave; (void)vcu; (void)G; (void)l; __VA_ARGS__ }
DK(k_prologue, phase_prologue(ap, lds, tid, lane, wave, vcu, G);)
DK(k_norm0, phase_rownorm<0, false>(ap, lds, tid, lane, wave, G, ap->in[I_X], ap->out, ap->in[I_NORM_MIX], true, 0, 0, 0);)
DK(k_norm1, phase_rownorm<0, true>(ap, lds, tid, lane, wave, G, ap->out, ap->out, ap->in[I_NORM_MIX], false, l, 0, 0);)
DK(k_normf, phase_rownorm<1, true>(ap, lds, tid, lane, wave, G, ap->out, ap->out, ap->in[I_NORM_MIX], false, l, 0, 0);)
DK(k_m1, phase_m1(ap, lds, tid, lane, wave, vcu, G, l);)
DK(k_m2, phase_m2(ap->ws, tid, vcu, G);)
DK(k_m3, phase_m3(ap, lds, tid, lane, wave, vcu, G, l);)
DK(k_s1, phase_s1(ap, lds, tid, lane, wave, vcu, G, l);)
DK(k_s2, phase_s2(ap, tid, vcu, G, l);)
DK(k_s3, phase_s3(ap, lds, tid, lane, wave, vcu, G, l);)
DK(k_r1, phase_r1(ap, lds, tid, lane, wave, vcu, G, l);)
DK(k_r2b, phase_r2_build(ap, lds, tid, lane, wave, vcu, G, l);)
DK(k_r2s, phase_r2_scan(ap, lds, tid, lane, wave, vcu, l);)
DK(k_r3, phase_r3(ap, lane, vcu * NWAVES + wave, G * NWAVES, l);)
DK(k_router, phase_router(ap, lds, tid, lane, wave, G, l);)
DK(k_gather, phase_gather(ap, lds, tid, lane, wave, vcu, G, l);)
DK(k_moecv, moe_convert13(ap->in[I_MW1], ap->in[I_MW3], 1, (bf16*)(ap->ws + WS_W13), vcu * NWAVES + wave, G * NWAVES, (LAS float*)(lds + wave * 16640), lane);)
#endif
```

```cpp
#include <hip/hip_runtime.h>
#include <cstdio>
#include <cstdint>
#define MK_PER_PHASE 0

#ifndef MK_PER_PHASE
#define MK_PER_PHASE 0
#endif
#ifndef EN_MLSTM
#define EN_MLSTM 1
#endif
#ifndef EN_S5
#define EN_S5 1
#endif
#ifndef EN_RWKV
#define EN_RWKV 1
#endif
#ifndef EN_MOE
#define EN_MOE 1
#endif
#ifndef N_LAYERS
#define N_LAYERS 2
#endif
constexpr int NWAVES = 8, NTHR = 512;
constexpr int DM = 1024, NB = 4, SEQ = 8192, NTOK = NB * SEQ;
constexpr int DA = 384, DBR = 384, DC = 256, NH = 6, HD = 64, NCH = SEQ / 64;
constexpr int IN_COLS = 2828, NPROJ = 2816, NPROJ_PAD = 3072;
constexpr int PC_QK = 0, PC_V = 384, PC_O = 768, PC_RW = 1152, PC_S5 = 2560;
constexpr int RWC_R = 0, RWC_K = 384, RWC_V = 768, RWC_WD = 1152, RWC_AD = 1216, RWC_GD = 1280, RW_COLS = 1408;
constexpr int NEXP = 32, DEXP = 512, MOE_ROWS_MAX = 73728;
constexpr int NUNIT_M = NB * NCH * NH;
constexpr int CL_STRIDE = 4160;
constexpr float NORM_EPS = 1e-6f, HEAD_NORM_EPS = 1e-5f, RWKV_GN_EPS = 64e-5f;

constexpr size_t MiB = 1u << 20;
constexpr size_t WS_CTL = 0, CTL_ZERO_BYTES = 1 * MiB;
constexpr size_t WS_MODP = 1 * MiB;
constexpr size_t WS_MODF = 2 * MiB + 512 * 1024;
constexpr size_t WS_S5BB = 2 * MiB + 896 * 1024;
constexpr size_t WS_RTW = 3 * MiB;
constexpr size_t WS_S5AP = 3 * MiB + 384 * 1024;
constexpr size_t WS_MLW = 3 * MiB + 512 * 1024;
constexpr size_t WS_S5CM = 2 * MiB + 768 * 1024;
constexpr size_t WS_GLUT = 3 * MiB + 768 * 1024;
constexpr size_t WS_WIN = 4 * MiB;
constexpr size_t WS_WOUT = 16 * MiB;
constexpr size_t WS_GATES = 20 * MiB;
constexpr size_t WS_W13 = 22 * MiB;
constexpr size_t WS_W2 = 86 * MiB;
constexpr size_t WS_HN = 118 * MiB;
constexpr size_t WS_CLOC = 118 * MiB;
constexpr size_t WS_MSC = 168 * MiB;
constexpr size_t WS_S5ST = 170 * MiB;
constexpr size_t WS_VF = 182 * MiB;
constexpr size_t WS_YC = 206 * MiB;
constexpr size_t WS_LIST = 206 * MiB;
constexpr size_t WS_ROWMAP = 214 * MiB;
constexpr size_t WS_TOKE = 215 * MiB;
constexpr size_t WS_TOKW = 215 * MiB + 512 * 1024;
constexpr size_t WS_PROJ = 270 * MiB;
constexpr size_t WS_RE = 446 * MiB, WS_RA = 470 * MiB, WS_RG = 494 * MiB, WS_RVG = 518 * MiB;
constexpr size_t WS_XG = 270 * MiB;
constexpr size_t WS_HMID = 414 * MiB;
constexpr size_t WS_YMOE = 270 * MiB;
constexpr size_t WS_R1W = 542 * MiB;
constexpr size_t WS_OPA = 22 * MiB;
constexpr size_t WS_OPB = 543 * MiB;
constexpr size_t WS_END = 591 * MiB;
constexpr int CW_TMO = 0, CW_BAR = 4096, CW_CNT = 8192, CW_Q = 8320;

constexpr int RING_BYTES = 131072, MISC_OFF = 135168, PTAB_OFF = MISC_OFF + 1024, LDS_BYTES = 147456;

#define GAS __attribute__((address_space(1)))
#define LAS __attribute__((address_space(3)))
typedef unsigned short bf16;
typedef unsigned v4u __attribute__((ext_vector_type(4)));
typedef unsigned v2u __attribute__((ext_vector_type(2)));
typedef float f32x4 __attribute__((ext_vector_type(4)));
typedef float f32x2 __attribute__((ext_vector_type(2)));
typedef GAS unsigned gu32;
#define RLX_AGENT __ATOMIC_RELAXED, __HIP_MEMORY_SCOPE_AGENT
#define LDS_WAIT() asm volatile("s_waitcnt lgkmcnt(0)" ::: "memory")
#define VM_WAIT() asm volatile("s_waitcnt vmcnt(0)" ::: "memory")
typedef float f32x2v __attribute__((ext_vector_type(2)));
typedef __bf16 bf16x2v __attribute__((ext_vector_type(2)));
__device__ __forceinline__ unsigned pk2(float lo, float hi) { const f32x2v v = {lo, hi}; const bf16x2v b = __builtin_convertvector(v, bf16x2v); return __builtin_bit_cast(unsigned, b); }
__device__ __forceinline__ unsigned f2bf(float f) { return pk2(f, 0.f) & 0xffffu; }
__device__ __forceinline__ float bf2f(unsigned v) { return __builtin_bit_cast(float, v << 16); }
__device__ __forceinline__ float bflo(unsigned w) { return __builtin_bit_cast(float, w << 16); }
__device__ __forceinline__ float bfhi(unsigned w) { return __builtin_bit_cast(float, w & 0xffff0000u); }
__device__ __forceinline__ float sigmoidf_(float x) { return 1.f / (1.f + __expf(-x)); }
__device__ __forceinline__ float wave_sum(float v) {
#pragma unroll
    for (int o = 1; o < 64; o <<= 1) v += __shfl_xor(v, o);
    return v;
}
__device__ __forceinline__ float wave_max(float v) {
#pragma unroll
    for (int o = 1; o < 64; o <<= 1) v = fmaxf(v, __shfl_xor(v, o));
    return v;
}
namespace pg8 {
#define PG8_LAS __attribute__((address_space(3)))
typedef unsigned short bf16_t;
typedef short bf16x8 __attribute__((ext_vector_type(8)));
typedef float f32x4 __attribute__((ext_vector_type(4)));
typedef unsigned u32x4 __attribute__((ext_vector_type(4)));
constexpr int BM = 256, BK = 64, HALF = 128, HTB = HALF * BK * 2  , STAGE_BYTES = 8 * HTB, NXCD = 8, WGM = 8;

__host__ __device__ __forceinline__ int lds_byte(int r, int c) { const int st = (r >> 4) * 2 + (c >> 5), rr = r & 15, cc = c & 31, ob = rr * 64 + cc * 2; return st * 1024 + (ob ^ (((ob >> 9) & 1) << 5)); }
__host__ __device__ __forceinline__ void stage_rc(int b, int& R, int& C) { const int st = b / 1024, sb = b % 1024, swz = sb ^ (((sb >> 9) & 1) << 5); R = (st >> 1) * 16 + swz / 64; C = (st & 1) * 32 + (swz % 64) / 2; }
__host__ __device__ __forceinline__ int perm32(int rho) { const int n = rho >> 4, i = rho & 15; return 8 * (i >> 2) + 4 * n + (i & 3); }

struct Unit { int pm, pn; };
__device__ __forceinline__ int moe_tok2(const int* list, PG8_LAS const int* ptab, int row) { const int e = ptab[1 + (row >> 8)], pos = row - ptab[512 + e]; return pos < ptab[544 + e] ? list[(size_t)e * 65536 + pos] : -1; }
struct Gemm { const bf16_t* A; const bf16_t* Bt; int M, N, K; const int* list = nullptr; PG8_LAS const int* ptab = nullptr; };

struct StaticOrder {
    int nM, nN, nwg, G, c;
    __host__ __device__ void init(int M, int N, int G_, int c_) { nM = M / BM; nN = N / BM; nwg = nM * nN; G = G_; c = c_; }
    __host__ __device__ bool next(int i, Unit& u) const {
        const long L = (long)i * G + c; if (L >= nwg) return false;
        int wgid = (int)L; { const int q = nwg / NXCD, r = nwg % NXCD, xcd = wgid % NXCD, off = wgid / NXCD; wgid = (xcd < r ? xcd * (q + 1) : r * (q + 1) + (xcd - r) * q) + off; }
        const int nig = WGM * nN, gid = wgid / nig, fm = gid * WGM, gsz = (nM - fm) < WGM ? (nM - fm) : WGM;
        u.pm = fm + ((wgid % nig) % gsz); u.pn = (wgid % nig) / gsz; return true;
    }
    __device__ __forceinline__ void a_ready(const Unit&) const {}
    __device__ __forceinline__ void done(const Unit&) const {}
};

__device__ __forceinline__ unsigned cvt_pk_bf16(float lo, float hi) { unsigned r; asm volatile("v_cvt_pk_bf16_f32 %0, %1, %2" : "=v"(r) : "v"(lo), "v"(hi)); return r; }

struct EpiProj {
    static constexpr bool PERM = true, AFTER_DRAIN = false;
    bf16_t* O; float* G;
    __device__ __forceinline__ void operator()(const f32x4 (&acc)[2][2][4][2], const Unit& u, int wr, int wc, int fr, int fq) const {
        const int row0 = u.pm * BM + wr * 64 + fr;
        if (u.pn < 11) {
            const int col0 = u.pn * BM + wc * 32 + 8 * fq;
#pragma unroll
            for (int ai = 0; ai < 2; ++ai)
#pragma unroll
                for (int m = 0; m < 4; ++m) { bf16_t* rowp = O + (size_t)(row0 + ai * HALF + m * 16) * 2816 + col0;
#pragma unroll
                    for (int bj = 0; bj < 2; ++bj) { const f32x4 v0 = acc[ai][bj][m][0], v1 = acc[ai][bj][m][1];
                        u32x4 w; w.x = cvt_pk_bf16(v0[0], v0[1]); w.y = cvt_pk_bf16(v0[2], v0[3]); w.z = cvt_pk_bf16(v1[0], v1[1]); w.w = cvt_pk_bf16(v1[2], v1[3]);
                        *(u32x4*)(rowp + bj * HALF) = w; } }
        } else if (wc == 0 && fq < 2) {
#pragma unroll
            for (int ai = 0; ai < 2; ++ai)
#pragma unroll
                for (int m = 0; m < 4; ++m) { float* rowp = G + (size_t)(row0 + ai * HALF + m * 16) * 16 + 8 * fq;
                    *(f32x4*)(rowp) = acc[ai][0][m][0]; *(f32x4*)(rowp + 4) = acc[ai][0][m][1]; }
        }
    }
};
struct EpiResid {
    static constexpr bool PERM = true, AFTER_DRAIN = false;
    const float* xin; float* out; const float* gate;
    int goff;
    __device__ __forceinline__ void operator()(const f32x4 (&acc)[2][2][4][2], const Unit& u, int wr, int wc, int fr, int fq) const {
        const int row0 = u.pm * BM + wr * 64 + fr, col0 = u.pn * BM + wc * 32 + 8 * fq;
        const float* gp = gate + (size_t)(row0 >> 13) * 6144 + goff + col0;
        f32x4 g[2][2];
#pragma unroll
        for (int bj = 0; bj < 2; ++bj)
#pragma unroll
            for (int n = 0; n < 2; ++n) g[bj][n] = *(const f32x4*)(gp + bj * HALF + 4 * n) + 1.0f;
#pragma unroll
        for (int ai = 0; ai < 2; ++ai)
#pragma unroll
            for (int m = 0; m < 4; ++m) { const size_t off = (size_t)(row0 + ai * HALF + m * 16) * 1024 + col0;
#pragma unroll
                for (int bj = 0; bj < 2; ++bj)
#pragma unroll
                    for (int n = 0; n < 2; ++n) { const f32x4 xv = *(const f32x4*)(xin + off + bj * HALF + 4 * n);
                        *(f32x4*)(out + off + bj * HALF + 4 * n) = xv + g[bj][n] * acc[ai][bj][m][n]; } }
    }
};
struct EpiSwiglu {
    static constexpr bool PERM = true, AFTER_DRAIN = false;
    bf16_t* H;
    __device__ __forceinline__ void operator()(const f32x4 (&acc)[2][2][4][2], const Unit& u, int wr, int wc, int fr, int fq) const {
        const int row0 = u.pm * BM + wr * 64 + fr, hid0 = 128 * (u.pn & 3) + 16 * wc + 4 * fq;
#pragma unroll
        for (int ai = 0; ai < 2; ++ai)
#pragma unroll
            for (int m = 0; m < 4; ++m) { bf16_t* rowp = H + (size_t)(row0 + ai * HALF + m * 16) * 512 + hid0;
#pragma unroll
                for (int bj = 0; bj < 2; ++bj) { const f32x4 g = acc[ai][bj][m][0], uu = acc[ai][bj][m][1]; float h[4];
#pragma unroll
                    for (int i = 0; i < 4; ++i) h[i] = g[i] / (1.f + __expf(-g[i])) * uu[i];
                    unsigned w0 = cvt_pk_bf16(h[0], h[1]), w1 = cvt_pk_bf16(h[2], h[3]);
                    *(unsigned long long*)(rowp + 64 * bj) = (unsigned long long)w0 | ((unsigned long long)w1 << 32); } }
    }
};
struct EpiMoeOut {
    static constexpr bool PERM = true, AFTER_DRAIN = false;
    bf16_t* Y; const int* list; PG8_LAS const int* ptab;
    __device__ __forceinline__ void operator()(const f32x4 (&acc)[2][2][4][2], const Unit& u, int wr, int wc, int fr, int fq) const {
        const int row0 = u.pm * BM + wr * 64 + fr, col0 = (u.pn & 3) * BM + wc * 32 + 8 * fq;
#pragma unroll
        for (int ai = 0; ai < 2; ++ai)
#pragma unroll
            for (int m = 0; m < 4; ++m) { const int dst = moe_tok2(list, ptab, row0 + ai * HALF + m * 16);
                if (dst >= 0) { bf16_t* rowp = Y + (size_t)dst * 1024 + col0;
#pragma unroll
                    for (int bj = 0; bj < 2; ++bj) { const f32x4 v0 = acc[ai][bj][m][0], v1 = acc[ai][bj][m][1];
                        u32x4 w; w.x = cvt_pk_bf16(v0[0], v0[1]); w.y = cvt_pk_bf16(v0[2], v0[3]); w.z = cvt_pk_bf16(v1[0], v1[1]); w.w = cvt_pk_bf16(v1[2], v1[3]);
                        *(u32x4*)(rowp + bj * HALF) = w; } } }
    }
};
struct MoeOrder {
    PG8_LAS const int* ptab; int G, c;
    __device__ __forceinline__ bool next(int i, Unit& u) const {
        const int L = i * G + c, np = __builtin_amdgcn_readfirstlane(ptab[0]);
        if (L >= np * 4) return false;
        const int p = L >> 2; u.pm = p; u.pn = __builtin_amdgcn_readfirstlane(ptab[1 + p]) * 4 + (L & 3); return true;
    }
    __device__ __forceinline__ void a_ready(const Unit&) const {}
    __device__ __forceinline__ void done(const Unit&) const {}
};
template <class Epi, class Sched, bool ALIGN_EPI = false, bool SP2 = false, bool GATHER = false>
__device__ __forceinline__ void gemm_phase(PG8_LAS unsigned char* lds, const Gemm g, const Sched& S, const Epi& E) {
    int tid_ = threadIdx.x; asm volatile("" : "+v"(tid_));
    const int tid = tid_, wid = __builtin_amdgcn_readfirstlane(tid >> 6), lane = tid & 63, wr = wid >> 2, wc = wid & 3, fr = lane & 15, fq = lane >> 4;
    const int K = g.K, nt = K / BK;
    static_assert(!GATHER || SP2, "the gathered-A variant exists for the SP2 loop only");
    unsigned voffA[2], voffB[2];
    unsigned vAc[2] = {0u, 0u}, vAn[2] = {0u, 0u};
#pragma unroll
    for (int i = 0; i < 2; ++i) { int R, C; stage_rc(tid * 16 + i * 8192, R, C); const int Rb = Epi::PERM ? ((R & ~31) + perm32(R & 31)) : R;
        voffA[i] = (unsigned)(R * K + C) * 2u; voffB[i] = (unsigned)(Rb * K + C) * 2u; }
    const size_t kstep = (size_t)(BK * 2);
    const size_t hstep = (size_t)HALF * K * 2;
    const size_t tstep = 2 * hstep;
    const unsigned ldsw = (unsigned)wid * 1024u;
    const int aoff = lds_byte(wr * 64 + fr, fq * 8), boff = lds_byte(wc * 32 + fr, fq * 8);
#define PG8_SA(b, h) (((b) * 2 + (h)) * HTB)
#define PG8_SB(b, h) ((4 + (b) * 2 + (h)) * HTB)
#define PG8_STAGE(bufoff, gbase, voff) do { _Pragma("unroll") for (int _i = 0; _i < 2; ++_i) \
        __builtin_amdgcn_global_load_lds((const unsigned*)((const char*)(gbase) + (voff)[_i]), (PG8_LAS unsigned*)(lds + (bufoff) + ldsw + _i * 8192), 16, 0, 0); } while (0)
#define PG8_STAGEG(bufoff, base, pk) do { unsigned vg_[2]; _Pragma("unroll") for (int i_ = 0; i_ < 2; ++i_) { int R_, C_; stage_rc(tid * 16 + i_ * 8192, R_, C_); vg_[i_] = (((pk) >> (16 * i_)) & 0xffffu) * (unsigned)(2 * K) + (unsigned)(2 * C_); } PG8_STAGE(bufoff, base, vg_); } while (0)
#define PG8_STAGEA(bufoff, base, hh, nx) do { if constexpr (GATHER) { const unsigned pk_ = (nx) ? vAn[hh] : vAc[hh]; PG8_STAGEG(bufoff, base, pk_); } else PG8_STAGE(bufoff, (base) + (hh) * hstep, voffA); } while (0)
#define PG8_GOFF(dst, unit) do { _Pragma("unroll") for (int hh_ = 0; hh_ < 2; ++hh_) { unsigned pk_ = 0u; _Pragma("unroll") for (int i_ = 0; i_ < 2; ++i_) { int R_, C_; stage_rc(tid * 16 + i_ * 8192, R_, C_); \
        const int t2_ = moe_tok2(g.list, g.ptab, (unit).pm * BM + hh_ * HALF + R_); pk_ |= (unsigned)(t2_ < 0 ? 0 : (t2_ >> 1)) << (16 * i_); } dst[hh_] = pk_; } } while (0)
#define PG8_LDA(dst, b, h) do { _Pragma("unroll") for (int m = 0; m < 4; ++m) _Pragma("unroll") for (int k = 0; k < 2; ++k) dst[m][k] = *(const PG8_LAS bf16x8*)(lds + PG8_SA(b, h) + aoff + m * 2048 + k * 1024); } while (0)
#define PG8_LDB(dst, b, h) do { _Pragma("unroll") for (int n = 0; n < 2; ++n) _Pragma("unroll") for (int k = 0; k < 2; ++k) dst[n][k] = *(const PG8_LAS bf16x8*)(lds + PG8_SB(b, h) + boff + n * 2048 + k * 1024); } while (0)
#define PG8_MMA(ai, bj, At, Bt) do { __builtin_amdgcn_s_setprio(1); _Pragma("unroll") for (int m = 0; m < 4; ++m) _Pragma("unroll") for (int n = 0; n < 2; ++n) _Pragma("unroll") for (int k = 0; k < 2; ++k) \
        acc[ai][bj][m][n] = __builtin_amdgcn_mfma_f32_16x16x32_bf16(Bt[n][k], At[m][k], acc[ai][bj][m][n], 0, 0, 0); __builtin_amdgcn_s_setprio(0); } while (0)
#define PG8_WAIT_V(n) asm volatile("s_waitcnt vmcnt(" #n ")" ::: "memory")
#define PG8_WAIT_L(n) asm volatile("s_waitcnt lgkmcnt(" #n ")" ::: "memory")
#define PG8_BAR __builtin_amdgcn_s_barrier()
#define PG8_SCHED __builtin_amdgcn_sched_barrier(0)
    Unit cur, nxt; int ui = 0;
    if (!S.next(0, cur)) return;
    f32x4 acc[2][2][4][2];
#pragma unroll
    for (int a = 0; a < 2; ++a)
#pragma unroll
        for (int b = 0; b < 2; ++b)
#pragma unroll
            for (int m = 0; m < 4; ++m)
#pragma unroll
                for (int n = 0; n < 2; ++n) acc[a][b][m][n] = (f32x4){0.f, 0.f, 0.f, 0.f};
    bf16x8 At[4][2], B0[2][2], B1[2][2];
    const char* cA = (const char*)g.A + (GATHER ? (size_t)0 : (size_t)cur.pm * tstep); const char* cB = (const char*)g.Bt + (size_t)cur.pn * tstep;
    if constexpr (GATHER) { PG8_GOFF(vAc, cur); }
    S.a_ready(cur);
    if constexpr (SP2) {
        PG8_STAGE(PG8_SB(0, 0), cB, voffB); PG8_STAGE(PG8_SB(0, 1), cB + hstep, voffB); PG8_STAGEA(PG8_SA(0, 0), cA, 0, false); PG8_STAGEA(PG8_SA(0, 1), cA, 1, false);
        if (wr == 1) PG8_BAR;
        PG8_WAIT_V(2); PG8_BAR;
        PG8_STAGE(PG8_SB(1, 0), cB + kstep, voffB); PG8_STAGEA(PG8_SA(1, 0), cA + kstep, 0, false); PG8_STAGE(PG8_SB(1, 1), cB + hstep + kstep, voffB);
        PG8_WAIT_V(6); PG8_BAR;
    } else {
        PG8_STAGE(PG8_SB(0, 0), cB, voffB); PG8_STAGE(PG8_SA(0, 0), cA, voffA); PG8_STAGE(PG8_SB(0, 1), cB + hstep, voffB); PG8_STAGE(PG8_SA(0, 1), cA + hstep, voffA);
        if (wr == 1) PG8_BAR;
        PG8_WAIT_V(4); PG8_BAR;
        PG8_STAGE(PG8_SB(1, 0), cB + kstep, voffB); PG8_STAGE(PG8_SA(1, 0), cA + kstep, voffA); PG8_STAGE(PG8_SB(1, 1), cB + hstep + kstep, voffB);
        PG8_WAIT_V(6); PG8_BAR;
    }
    for (;;) {
        const bool has_next = S.next(ui + 1, nxt);
        const char* nA = (has_next && !GATHER) ? (const char*)g.A + (size_t)nxt.pm * tstep : cA;
        if constexpr (GATHER) { if (has_next) { PG8_GOFF(vAn, nxt); } else { vAn[0] = vAc[0]; vAn[1] = vAc[1]; } } const char* nB = has_next ? (const char*)g.Bt + (size_t)nxt.pn * tstep : cB;
        for (int t = 0; t < nt; t += 2) {
            const bool last = (t == nt - 2);
            const char* a1 = cA + (size_t)(t + 1) * kstep;
            const char* a2 = last ? nA : cA + (size_t)(t + 2) * kstep; const char* b2 = last ? nB : cB + (size_t)(t + 2) * kstep;
            const char* a3 = a2 + kstep; const char* b3 = b2 + kstep;
            if (last && has_next) S.a_ready(nxt);
            if constexpr (SP2) {
            PG8_LDB(B0, 0, 0); PG8_LDB(B1, 0, 1); PG8_SCHED; PG8_LDA(At, 0, 0); PG8_STAGEA(PG8_SA(1, 1), a1, 1, false);
            PG8_WAIT_V(8); PG8_WAIT_L(0); PG8_BAR; PG8_MMA(0, 0, At, B0); PG8_MMA(0, 1, At, B1); PG8_BAR; PG8_SCHED;
            PG8_LDA(At, 0, 1); PG8_STAGE(PG8_SB(0, 0), b2, voffB); PG8_STAGE(PG8_SB(0, 1), b2 + hstep, voffB); PG8_STAGEA(PG8_SA(0, 0), a2, 0, last);
            PG8_WAIT_V(8); PG8_WAIT_L(0); PG8_BAR; PG8_MMA(1, 0, At, B0); PG8_MMA(1, 1, At, B1); PG8_BAR; PG8_SCHED;
            PG8_LDB(B0, 1, 0); PG8_LDB(B1, 1, 1); PG8_SCHED; PG8_LDA(At, 1, 0); PG8_STAGEA(PG8_SA(0, 1), a2, 1, last);
            PG8_WAIT_V(8); PG8_WAIT_L(0); PG8_BAR; PG8_MMA(0, 0, At, B0); PG8_MMA(0, 1, At, B1); PG8_BAR; PG8_SCHED;
            PG8_LDA(At, 1, 1); PG8_STAGE(PG8_SB(1, 0), b3, voffB); PG8_STAGE(PG8_SB(1, 1), b3 + hstep, voffB); PG8_STAGEA(PG8_SA(1, 0), a3, 0, last);
            PG8_WAIT_V(8); PG8_WAIT_L(0); PG8_BAR; PG8_MMA(1, 0, At, B0); PG8_MMA(1, 1, At, B1); PG8_BAR; PG8_SCHED;
            } else {
            PG8_LDB(B0, 0, 0); PG8_SCHED; PG8_LDA(At, 0, 0); PG8_STAGE(PG8_SA(1, 1), a1 + hstep, voffA);
            PG8_WAIT_L(8); PG8_BAR; PG8_WAIT_L(0); PG8_MMA(0, 0, At, B0); PG8_BAR; PG8_SCHED;
            PG8_LDB(B1, 0, 1); PG8_STAGE(PG8_SB(0, 0), b2, voffB);
            PG8_BAR; PG8_WAIT_L(0); PG8_MMA(0, 1, At, B1); PG8_BAR;
            PG8_LDA(At, 0, 1); PG8_STAGE(PG8_SA(0, 0), a2, voffA);
            PG8_BAR; PG8_WAIT_L(0); PG8_MMA(1, 0, At, B0); PG8_BAR; PG8_SCHED;
            PG8_STAGE(PG8_SB(0, 1), b2 + hstep, voffB);
            PG8_WAIT_V(6); PG8_BAR; PG8_MMA(1, 1, At, B1); PG8_BAR;
            PG8_LDB(B0, 1, 0); PG8_SCHED; PG8_LDA(At, 1, 0); PG8_STAGE(PG8_SA(0, 1), a2 + hstep, voffA);
            PG8_WAIT_L(8); PG8_BAR; PG8_WAIT_L(0); PG8_MMA(0, 0, At, B0); PG8_BAR; PG8_SCHED;
            PG8_LDB(B1, 1, 1); PG8_STAGE(PG8_SB(1, 0), b3, voffB);
            PG8_BAR; PG8_WAIT_L(0); PG8_MMA(0, 1, At, B1); PG8_BAR;
            PG8_LDA(At, 1, 1); PG8_STAGE(PG8_SA(1, 0), a3, voffA);
            PG8_BAR; PG8_WAIT_L(0); PG8_MMA(1, 0, At, B0); PG8_BAR; PG8_SCHED;
            PG8_STAGE(PG8_SB(1, 1), b3 + hstep, voffB);
            PG8_WAIT_V(6); PG8_BAR; PG8_MMA(1, 1, At, B1); PG8_BAR;
            }
        }
        if constexpr (ALIGN_EPI) { if (wr == 0) PG8_BAR; }
        if constexpr (!Epi::AFTER_DRAIN) { E(acc, cur, wr, wc, fr, fq); S.done(cur); }
        if (!has_next) break;
#pragma unroll
        for (int a = 0; a < 2; ++a)
#pragma unroll
            for (int b = 0; b < 2; ++b)
#pragma unroll
                for (int m = 0; m < 4; ++m)
#pragma unroll
                    for (int n = 0; n < 2; ++n) acc[a][b][m][n] = (f32x4){0.f, 0.f, 0.f, 0.f};
        cur = nxt; cA = nA; cB = nB; ++ui;
        if constexpr (GATHER) { vAc[0] = vAn[0]; vAc[1] = vAn[1]; }
        if constexpr (ALIGN_EPI) { if (wr == 1) PG8_BAR; }
    }
    PG8_WAIT_V(0);
    if constexpr (!ALIGN_EPI) { if (wr == 0) PG8_BAR; }
    PG8_BAR;
    if constexpr (Epi::AFTER_DRAIN) { E.fused(acc, cur, wr, wc, fr, fq, lds, wid, lane); S.done(cur); }
#undef PG8_SA
#undef PG8_SB
#undef PG8_STAGE
#undef PG8_STAGEA
#undef PG8_STAGEG
#undef PG8_GOFF
#undef PG8_LDA
#undef PG8_LDB
#undef PG8_MMA
#undef PG8_WAIT_V
#undef PG8_WAIT_L
#undef PG8_BAR
#undef PG8_SCHED
}
}
#define XB_TMO      128
#define XB_XCNT(j)  (256  + 64 * (j))
#define XB_XSUB(j)  (1280 + 64 * (j))
#define XB_XGEN(j)  (2304 + 64 * (j))
#define XB_TOP      3328
#define XB_TOPGEN   3392
#define XCD_BAR_WORDS 3456
#define XB_SPIN_CAP (1u << 18)
#define LAS __attribute__((address_space(3)))

__device__ __forceinline__ unsigned xb_ld(unsigned* p)              { return __hip_atomic_load(p, __ATOMIC_RELAXED, __HIP_MEMORY_SCOPE_AGENT); }
__device__ __forceinline__ unsigned xb_add(unsigned* p, unsigned v) { return __hip_atomic_fetch_add(p, v, __ATOMIC_RELAXED, __HIP_MEMORY_SCOPE_AGENT); }
__device__ __forceinline__ unsigned xb_xcc_id() { return (unsigned)__builtin_amdgcn_s_getreg((3 << 11) | 20) & 0xFu; }
#define XB_SPIN(cond, bar) do { unsigned _sp = 0; while (cond) { __builtin_amdgcn_s_sleep(1); \
    if ((++_sp & 255u) == 0u) { if (xb_ld(&(bar)[XB_TMO])) break; if (_sp > XB_SPIN_CAP) { atomicAdd(&(bar)[XB_TMO], 1u); break; } } } } while (0)

struct XcdBarrier {
    unsigned* bar; unsigned x;
    volatile LAS unsigned* st;
};

__device__ __forceinline__ XcdBarrier xcd_barrier_post(unsigned* bar, volatile LAS unsigned* st) {
    XcdBarrier b; b.bar = bar; b.x = xb_xcc_id(); b.st = st;
    if (threadIdx.x == 0) (void)xb_add(&bar[XB_XCNT(b.x)], 1u);
    return b;
}
__device__ __forceinline__ void xcd_barrier_complete(unsigned* bar, unsigned x, unsigned& nloc, unsigned& nx) {
    const unsigned G = gridDim.x * gridDim.y * gridDim.z;
    unsigned sum, cnt, mine, sp = 0u;
    for (;;) {
        sum = 0u; cnt = 0u; mine = 0u;
#pragma unroll
        for (unsigned j = 0; j < 16; ++j) { const unsigned c = xb_ld(&bar[XB_XCNT(j)]); sum += c; cnt += (c > 0u) ? 1u : 0u; mine = (j == x) ? c : mine; }
        if (sum == G) break;
        __builtin_amdgcn_s_sleep(1);
        if ((++sp & 255u) == 0u) { if (xb_ld(&bar[XB_TMO])) break; if (sp > XB_SPIN_CAP) { atomicAdd(&bar[XB_TMO], 1u); break; } }
    }
    nloc = mine > 0u ? mine : 1u; nx = cnt > 0u ? cnt : 1u;
}

__device__ __forceinline__ void xcd_barrier(const XcdBarrier& b) {
    asm volatile("s_waitcnt vmcnt(0)" ::: "memory");
    __syncthreads();
    if (threadIdx.x == 0) {
        unsigned* bar = b.bar;
        __builtin_amdgcn_s_waitcnt(0);
        unsigned nloc = b.st[0], nx = b.st[1];
        if (nloc == 0u) { xcd_barrier_complete(bar, b.x, nloc, nx); b.st[0] = nloc; b.st[1] = nx; }
        const unsigned old = xb_add(&bar[XB_XSUB(b.x)], 1u);
        const unsigned gen = old / nloc;
        if (old + 1u == (gen + 1u) * nloc) {
            __builtin_amdgcn_fence(__ATOMIC_RELEASE, "agent");
            asm volatile("s_waitcnt vmcnt(0)" ::: "memory");
            const unsigned og = xb_add(&bar[XB_TOP], 1u);
            const unsigned tg = og / nx;
            if (og + 1u == (tg + 1u) * nx) xb_add(&bar[XB_TOPGEN], 1u);
            else XB_SPIN(xb_ld(&bar[XB_TOPGEN]) == tg, bar);
            __builtin_amdgcn_fence(__ATOMIC_ACQUIRE, "agent");
            xb_add(&bar[XB_XGEN(b.x)], 1u);
            asm volatile("s_waitcnt vmcnt(0)" ::: "memory");
        } else {
            XB_SPIN(xb_ld(&bar[XB_XGEN(b.x)]) == gen, bar);
            __builtin_amdgcn_fence(__ATOMIC_ACQUIRE, "agent");
            asm volatile("s_waitcnt vmcnt(0)" ::: "memory");
        }
    }
    __syncthreads();
}

struct Args { const float* in[47]; float* out; unsigned char* ws; int ph_lo, ph_hi; };
typedef const __attribute__((address_space(4))) Args* KArgsP;
__device__ __forceinline__ KArgsP fresh_args() { KArgsP p = (KArgsP)__builtin_amdgcn_kernarg_segment_ptr(); asm volatile("" : "+s"(p)); return p; }
enum { I_X = 0, I_C, I_ADA_W, I_ADA_B, I_NORM_MIX, I_NORM_FFN, I_NORM_FINAL, I_W_IN, I_W_OUT, I_CONV_W, I_CONV_B, I_WQ, I_WK, I_BI, I_BF, I_MNORM_W,
       I_RMU, I_RW0, I_RWUP, I_RA0, I_RAUP, I_RGUP, I_RKK, I_RKA, I_RRK, I_RLNW, I_RLNB, I_RV0, I_RVDN, I_RVUP,
       I_S5ARE, I_S5AIM, I_S5LDT, I_S5BRE, I_S5BIM, I_S5CRE, I_S5CIM, I_S5D, I_S5GLUW, I_S5GLUB,
       I_MWRG, I_MBRG, I_MWRE, I_MBRE, I_MW1, I_MW3, I_MW2 };

struct RmWin { __device__ __forceinline__ int operator()(int n) const { return n < 1152 ? n : (n < 1164 ? 2816 + (n - 1152) : (n < 2572 ? 1152 + (n - 1164) : 2560 + (n - 2572))); } };
struct RmId  { __device__ __forceinline__ int operator()(int n) const { return n; } };
struct RmGU  { int add; __device__ __forceinline__ int operator()(int n) const { return 8 * (n >> 2) + (n & 3) + add; } };
template <class RM>
__device__ __forceinline__ void transpose_item(const float* W, int ldw, int ncols, int k0, int n0, bf16* WT, int ldt, LAS float* scr, int lane, const RM rm) {
    if (n0 + 64 <= ncols && (ldw & 3) == 0) {
        const float* src = W + (size_t)(k0 + (lane >> 4)) * ldw + n0 + 4 * (lane & 15);
        f32x4 v[16];
#pragma unroll
        for (int i = 0; i < 16; ++i) v[i] = *(const GAS f32x4*)(src + (size_t)(4 * i) * ldw);
#pragma unroll
        for (int i = 0; i < 16; ++i) { LAS float* d = scr + (4 * i + (lane >> 4)) * 65 + 4 * (lane & 15); d[0] = v[i][0]; d[1] = v[i][1]; d[2] = v[i][2]; d[3] = v[i][3]; }
    } else {
    const int nn = n0 + lane; const bool ok = nn < ncols; const float* src = W + (size_t)k0 * ldw + (ok ? nn : n0);
    float v[64];
#pragma unroll
    for (int kk = 0; kk < 64; ++kk) v[kk] = src[(size_t)kk * ldw];
#pragma unroll
    for (int kk = 0; kk < 64; ++kk) scr[kk * 65 + lane] = v[kk];
    }
    LDS_WAIT(); asm volatile("" ::: "memory");
    const int c = lane & 7;
#pragma unroll
    for (int j = 0; j < 8; ++j) { const int nl = (lane >> 3) + 8 * j; const LAS float* s = scr + (8 * c) * 65 + nl;
        v4u o; o.x = pk2(s[0 * 65], s[1 * 65]); o.y = pk2(s[2 * 65], s[3 * 65]); o.z = pk2(s[4 * 65], s[5 * 65]); o.w = pk2(s[6 * 65], s[7 * 65]);
        if (n0 + nl < ncols) *(GAS v4u*)(WT + (size_t)rm(n0 + nl) * ldt + k0 + 8 * c) = o; }
    LDS_WAIT(); asm volatile("" ::: "memory");
}
__device__ __forceinline__ void moe_convert13(const float* w1, const float* w3, int l, bf16* W13, int worker, int nworkers, LAS float* scr, int lane) {
    for (int it = worker; it < NEXP * 256; it += nworkers) {
        const int e = it >> 8, r = it & 255; const size_t eo = (size_t)(l * NEXP + e) * DM * DEXP;
        if (r < 128) transpose_item(w1 + eo, DEXP, DEXP, 64 * (r >> 3), 64 * (r & 7), W13 + (size_t)e * 1024 * 1024, 1024, scr, lane, RmGU{0});
        else         transpose_item(w3 + eo, DEXP, DEXP, 64 * ((r - 128) >> 3), 64 * ((r - 128) & 7), W13 + (size_t)e * 1024 * 1024, 1024, scr, lane, RmGU{4});
    }
}
__device__ __forceinline__ void moe_convert2(const float* w2, int l, bf16* W2T, int worker, int nworkers, LAS float* scr, int lane) {
    for (int it = worker; it < NEXP * 128; it += nworkers) {
        const int e = it >> 7, r = it & 127; const size_t eo = (size_t)(l * NEXP + e) * DM * DEXP;
        transpose_item(w2 + eo, DM, DM, 64 * (r >> 4), 64 * (r & 15), W2T + (size_t)e * 1024 * 512, 512, scr, lane, RmId{});
    }
}
__device__ __forceinline__ void phase_prologue(KArgsP a, LAS unsigned char* lds, int tid, int lane, int wave, int vcu, int G) {
    unsigned char* ws = a->ws;
    LAS float* scr = (LAS float*)(lds + wave * 16640);
    const int gw = vcu * NWAVES + wave, NGW = G * NWAVES;
    bf16* WIN = (bf16*)(ws + WS_WIN); bf16* WOUT = (bf16*)(ws + WS_WOUT);
    for (int it = gw; it < 2 * 16 * 45; it += NGW) { const int l = it / (16 * 45), r = it % (16 * 45);
        transpose_item(a->in[I_W_IN] + (size_t)l * DM * IN_COLS, IN_COLS, IN_COLS, 64 * (r / 45), 64 * (r % 45), WIN + (size_t)l * NPROJ_PAD * DM, DM, scr, lane, RmWin{}); }
    for (int it = gw; it < 2 * 16 * 16; it += NGW) { const int l = it / 256, r = it % 256;
        transpose_item(a->in[I_W_OUT] + (size_t)l * DM * DM, DM, DM, 64 * (r >> 4), 64 * (r & 15), WOUT + (size_t)l * DM * DM, DM, scr, lane, RmId{}); }
    for (int it = gw; it < 2 * 244; it += NGW) { const int l = it / 244, r = 2828 + it % 244; GAS v4u* p = (GAS v4u*)(WIN + ((size_t)l * NPROJ_PAD + r) * DM);
        p[lane] = (v4u){0u, 0u, 0u, 0u}; p[lane + 64] = (v4u){0u, 0u, 0u, 0u}; }
    { float* RTW = (float*)(ws + WS_RTW);
      for (int idx = (vcu * NTHR + tid); idx < 2 * 1024 * 48; idx += G * NTHR) { const int j = idx % 48, k = (idx / 48) % 1024, l = idx / (48 * 1024);
          RTW[(size_t)l * 49152 + ((k >> 2) * 16 + (j & 15)) * 12 + (k & 3) * 3 + (j >> 4)] = j < 4 ? a->in[I_MWRG][(size_t)(l * 1024 + k) * 4 + j] : (j < 36 ? a->in[I_MWRE][(size_t)(l * 1024 + k) * 32 + (j - 4)] : 0.f); } }
    { bf16* RW = (bf16*)(ws + WS_R1W);
      for (int idx = (vcu * NTHR + tid); idx < 2 * 98304 + 24576; idx += G * NTHR) { float v;
          if (idx < 2 * 98304) { const int l = idx / 98304, r = idx % 98304;
              if (r < 24576)      v = a->in[I_RWUP][(size_t)l * 64 * DBR + (r & 63) * DBR + (r >> 6)];
              else if (r < 49152) v = a->in[I_RAUP][(size_t)l * 64 * DBR + ((r - 24576) & 63) * DBR + ((r - 24576) >> 6)];
              else                v = a->in[I_RGUP][(size_t)l * 128 * DBR + ((r - 49152) & 127) * DBR + ((r - 49152) >> 7)];
          } else { const int r = idx - 2 * 98304;
              if (r < 12288) v = a->in[I_RVDN][(size_t)(r % 384) * 32 + (r / 384)];
              else           v = a->in[I_RVUP][(size_t)((r - 12288) & 31) * DBR + ((r - 12288) >> 5)]; }
          RW[idx] = (bf16)f2bf(v); } }
    for (int idx = (vcu * NTHR + tid); idx < 2 * 16 * 64; idx += G * NTHR) { const int p = idx & 63, lg = idx >> 6;
        const float lam_re = a->in[I_S5ARE][idx], lam_im = a->in[I_S5AIM][idx]; const float dt = expf(a->in[I_S5LDT][lg]); const float mag = expf(lam_re * dt), ang = lam_im * dt;
        const float are = mag * cosf(ang), aim = mag * sinf(ang); const float inv = 1.f / (lam_re * lam_re + lam_im * lam_im);
        const float cre = ((are - 1.f) * lam_re + aim * lam_im) * inv, cim = (aim * lam_re - (are - 1.f) * lam_im) * inv;
        ((float*)(ws + WS_S5AP))[idx * 2] = are; ((float*)(ws + WS_S5AP))[idx * 2 + 1] = aim;
        const float* br = a->in[I_S5BRE] + (size_t)idx * 16; const float* bi = a->in[I_S5BIM] + (size_t)idx * 16; bf16* o = (bf16*)(ws + WS_S5BB) + ((size_t)lg * 128 + 2 * p) * 16;
        for (int c = 0; c < 16; ++c) { o[c] = (bf16)f2bf(cre * br[c] - cim * bi[c]); o[16 + c] = (bf16)f2bf(cre * bi[c] + cim * br[c]); } }
    { bf16* CM = (bf16*)(ws + WS_S5CM);
      for (int idx = (vcu * NTHR + tid); idx < 2 * 16 * 16 * 128; idx += G * NTHR) { const int k = idx & 127, lgc = idx >> 7;
          CM[idx] = (bf16)f2bf((k & 1) ? -a->in[I_S5CIM][(size_t)lgc * 64 + (k >> 1)] : a->in[I_S5CRE][(size_t)lgc * 64 + (k >> 1)]); } }
    for (int it = gw; it < 2 * 16; it += NGW) { const int l = it >> 4, r = it & 15;
        transpose_item(a->in[I_S5GLUW] + (size_t)l * DC * DC, DC, DC, 64 * (r >> 2), 64 * (r & 3), (bf16*)(ws + WS_GLUT) + (size_t)l * DC * DC, DC, scr, lane, RmId{}); }
    { bf16* MLW = (bf16*)(ws + WS_MLW);
      for (int idx = (vcu * NTHR + tid); idx < 2 * NH * 2 * 4096; idx += G * NTHR) { const int d = idx & 63, e = (idx >> 6) & 63, which = (idx >> 12) & 1, lh = idx >> 13;
          MLW[idx] = (bf16)f2bf(a->in[which ? I_WK : I_WQ][(size_t)lh * 4096 + d * 64 + e]); } }
    __syncthreads();
    if (vcu < 192) {
        const int q = vcu, l = q / 96, cb = (q >> 3) % 12, kc = q & 7;
        LAS float* cond = (LAS float*)lds;
        { const int b = tid >> 7, kk = tid & 127; const float cv = a->in[I_C][b * DM + kc * 128 + kk]; cond[tid] = cv / (1.f + __expf(-cv)); }
        __syncthreads();
        const int col = cb * 512 + tid; const float* wp = a->in[I_ADA_W] + ((size_t)l * DM + kc * 128) * 6144 + col;
        float acc0 = 0.f, acc1 = 0.f, acc2 = 0.f, acc3 = 0.f;
#pragma unroll 8
        for (int kk = 0; kk < 128; ++kk) { const float w = wp[(size_t)kk * 6144]; acc0 += cond[kk] * w; acc1 += cond[128 + kk] * w; acc2 += cond[256 + kk] * w; acc3 += cond[384 + kk] * w; }
        const float bias = (kc == 0) ? a->in[I_ADA_B][l * 6144 + col] : 0.f;
        float* MP = (float*)(ws + WS_MODP) + ((size_t)(kc * 2 + l) * 4) * 6144 + col;
        MP[0] = acc0 + bias; MP[6144] = acc1 + bias; MP[2 * 6144] = acc2 + bias; MP[3 * 6144] = acc3 + bias;
    }
}

__device__ __forceinline__ float modval(const unsigned char* ws, bool part, int l, int b, int idx) {
    if (!part) return ((const float*)(ws + WS_MODF))[(size_t)(l * 4 + b) * 6144 + idx];
    const float* mp = (const float*)(ws + WS_MODP) + (size_t)(l * 4 + b) * 6144 + idx; float s = 0.f;
#pragma unroll
    for (int kc = 0; kc < 8; ++kc) s += mp[(size_t)kc * 2 * 4 * 6144];
    return s;
}
template <int MODE, bool COMBINE>
__device__ __forceinline__ void phase_rownorm(KArgsP a, LAS unsigned char* lds, int tid, int lane, int wave, int G,
                                              const float* xsrc, float* xdst, const float* gvec, bool part, int l, int isc  , int lprev) {
    unsigned char* ws = a->ws;
    LAS float* sc = (LAS float*)lds; LAS float* sh = sc + 1024; LAS float* gt = sh + 1024;
    bf16* HN = (bf16*)(ws + WS_HN); const bf16* YM = (const bf16*)(ws + WS_YMOE); const float* TW = (const float*)(ws + WS_TOKW);
    for (int c = blockIdx.x; c < NTOK / 128; c += G) {
        const int b = c >> 6;
        __syncthreads();
        for (int j = tid; j < 1024; j += NTHR) {
            if (MODE == 0) { sc[j] = gvec[j] * (1.f + modval(ws, part, l, b, (isc + 1) * 1024 + j)); sh[j] = modval(ws, part, l, b, isc * 1024 + j); }
            else { sc[j] = gvec[j]; sh[j] = 0.f; }
            if (COMBINE) gt[j] = 1.f + modval(ws, false, lprev, b, 5 * 1024 + j);
        }
        __syncthreads();
        f32x4 vn[4]; v2u yn0[4], yn1[4]; float wn0 = 0.f, wn1 = 0.f;
        { const int row = c * 128 + wave * 16; const GAS f32x4* xr = (const GAS f32x4*)(xsrc + (size_t)row * DM) + lane;
#pragma unroll
          for (int j = 0; j < 4; ++j) vn[j] = xr[64 * j];
          if (COMBINE) { wn0 = TW[2 * row]; wn1 = TW[2 * row + 1]; const GAS v2u* y0 = (const GAS v2u*)(YM + (size_t)(2 * row) * DM) + lane; const GAS v2u* y1 = (const GAS v2u*)(YM + (size_t)(2 * row + 1) * DM) + lane;
#pragma unroll
              for (int j = 0; j < 4; ++j) { yn0[j] = y0[64 * j]; yn1[j] = y1[64 * j]; } } }
        for (int i = 0; i < 16; ++i) {
            const int row = c * 128 + wave * 16 + i;
            f32x4 v[4]; v2u q0[4], q1[4]; const float w0 = wn0, w1 = wn1;
#pragma unroll
            for (int j = 0; j < 4; ++j) { v[j] = vn[j]; q0[j] = yn0[j]; q1[j] = yn1[j]; }
            if (i + 1 < 16) { const int rn = row + 1; const GAS f32x4* xr = (const GAS f32x4*)(xsrc + (size_t)rn * DM) + lane;
#pragma unroll
                for (int j = 0; j < 4; ++j) vn[j] = xr[64 * j];
                if (COMBINE) { wn0 = TW[2 * rn]; wn1 = TW[2 * rn + 1]; const GAS v2u* y0 = (const GAS v2u*)(YM + (size_t)(2 * rn) * DM) + lane; const GAS v2u* y1 = (const GAS v2u*)(YM + (size_t)(2 * rn + 1) * DM) + lane;
#pragma unroll
                    for (int j = 0; j < 4; ++j) { yn0[j] = y0[64 * j]; yn1[j] = y1[64 * j]; } } }
            if (COMBINE) {
#pragma unroll
                for (int j = 0; j < 4; ++j) { const v2u p0 = q0[j], p1 = q1[j]; const f32x4 g4 = *(const LAS f32x4*)(gt + lane * 4 + 256 * j);
                    f32x4 m; m.x = w0 * bflo(p0.x) + w1 * bflo(p1.x); m.y = w0 * bfhi(p0.x) + w1 * bfhi(p1.x); m.z = w0 * bflo(p0.y) + w1 * bflo(p1.y); m.w = w0 * bfhi(p0.y) + w1 * bfhi(p1.y);
                    v[j] = v[j] + g4 * m; }
                if (MODE == 0) { GAS f32x4* xo = (GAS f32x4*)(xdst + (size_t)row * DM) + lane;
#pragma unroll
                    for (int j = 0; j < 4; ++j) xo[64 * j] = v[j]; }
            }
            float ss = 0.f;
#pragma unroll
            for (int j = 0; j < 4; ++j) ss += (v[j].x * v[j].x + v[j].y * v[j].y) + (v[j].z * v[j].z + v[j].w * v[j].w);
            const float rstd = rsqrtf(wave_sum(ss) * (1.f / DM) + NORM_EPS);
            if (MODE == 0) {
                GAS v2u* o = (GAS v2u*)(HN + (size_t)row * DM) + lane;
#pragma unroll
                for (int j = 0; j < 4; ++j) { const f32x4 s4 = *(const LAS f32x4*)(sc + lane * 4 + 256 * j), h4 = *(const LAS f32x4*)(sh + lane * 4 + 256 * j); const f32x4 h = v[j] * rstd * s4 + h4;
                    v2u w; w.x = pk2(h.x, h.y); w.y = pk2(h.z, h.w); o[64 * j] = w; }
            } else {
                GAS f32x4* o = (GAS f32x4*)(xdst + (size_t)row * DM) + lane;
#pragma unroll
                for (int j = 0; j < 4; ++j) { const f32x4 s4 = *(const LAS f32x4*)(sc + lane * 4 + 256 * j); o[64 * j] = v[j] * rstd * s4; }
            }
        }
    }
}
__device__ __forceinline__ void mod_finalize(unsigned char* ws, int tid, int G) {
    float* MF = (float*)(ws + WS_MODF);
    for (int idx = blockIdx.x * NTHR + tid; idx < 2 * 4 * 6144; idx += G * NTHR) { const float* mp = (const float*)(ws + WS_MODP) + idx; float s = 0.f;
#pragma unroll
        for (int kc = 0; kc < 8; ++kc) s += mp[(size_t)kc * 2 * 4 * 6144];
        MF[idx] = s; }
}

typedef float f32x4m __attribute__((ext_vector_type(4)));
__device__ __forceinline__ void phase_router(KArgsP a, LAS unsigned char* lds, int tid, int lane, int wave, int G, int l) {
    unsigned char* ws = a->ws;
    LAS float* sc = (LAS float*)lds; LAS float* sh = sc + 1024; LAS float* rstd_s = sh + 1024  ; LAS float* cvec = rstd_s + 128  ; LAS float* cpart = cvec + 64  ;
    LAS float* lg = cpart + 8 * 48  ; LAS int* hist = (LAS int*)(lg + 8 * 16 * 48)  ; LAS int* basev = hist + 32; LAS int* asg_e = basev + 32  ; LAS int* asg_lp = asg_e + 256;
    bf16* HN = (bf16*)(ws + WS_HN); const float* x = a->out; const float* RTW = (const float*)(ws + WS_RTW) + (size_t)l * 1024 * 48;
    int* TOKE = (int*)(ws + WS_TOKE); float* TOKW = (float*)(ws + WS_TOKW); int* LIST = (int*)(ws + WS_LIST); unsigned* CNT = (unsigned*)(ws + WS_CTL) + CW_CNT + l * 32;
    const float* gvec = a->in[I_NORM_FFN] + l * DM;
    for (int c = blockIdx.x; c < NTOK / 128; c += G) {
        const int b = c >> 6;
        __syncthreads();
        for (int j = tid; j < 1024; j += NTHR) { sc[j] = gvec[j] * (1.f + modval(ws, false, l, b, 4 * 1024 + j)); sh[j] = modval(ws, false, l, b, 3 * 1024 + j); }
        if (tid < 32) hist[tid] = 0;
        __syncthreads();
        if (tid < 384) { const int j = tid % 48, part = tid / 48; float s = 0.f;
#pragma unroll 16
            for (int k = part * 128; k < part * 128 + 128; ++k) s += sh[k] * RTW[((k >> 2) * 16 + (j & 15)) * 12 + (k & 3) * 3 + (j >> 4)];
            cpart[part * 48 + j] = s; }
        { f32x4 vn[4];
          { const GAS f32x4* xr = (const GAS f32x4*)(x + (size_t)(c * 128 + wave * 16) * DM) + lane;
#pragma unroll
            for (int j = 0; j < 4; ++j) vn[j] = xr[64 * j]; }
          for (int i = 0; i < 16; ++i) {
            const int row = c * 128 + wave * 16 + i;
            f32x4 v[4]; float ss = 0.f;
#pragma unroll
            for (int j = 0; j < 4; ++j) { v[j] = vn[j]; ss += (v[j].x * v[j].x + v[j].y * v[j].y) + (v[j].z * v[j].z + v[j].w * v[j].w); }
            if (i + 1 < 16) { const GAS f32x4* xr = (const GAS f32x4*)(x + (size_t)(row + 1) * DM) + lane;
#pragma unroll
                for (int j = 0; j < 4; ++j) vn[j] = xr[64 * j]; }
            const float rstd = rsqrtf(wave_sum(ss) * (1.f / DM) + NORM_EPS);
            if (lane == 0) rstd_s[wave * 16 + i] = rstd;
            GAS v2u* o = (GAS v2u*)(HN + (size_t)row * DM) + lane;
#pragma unroll
            for (int j = 0; j < 4; ++j) { const f32x4 s4 = *(const LAS f32x4*)(sc + lane * 4 + 256 * j), h4 = *(const LAS f32x4*)(sh + lane * 4 + 256 * j); const f32x4 h = v[j] * rstd * s4 + h4;
                v2u w; w.x = pk2(h.x, h.y); w.y = pk2(h.z, h.w); o[64 * j] = w; }
          } }
        __syncthreads();
        if (tid < 48) { float s = 0.f;
#pragma unroll
            for (int p = 0; p < 8; ++p) s += cpart[p * 48 + tid];
            s += tid < 4 ? a->in[I_MBRG][l * 4 + tid] : (tid < 36 ? a->in[I_MBRE][l * 32 + tid - 4] : 0.f); cvec[tid] = s; }
        {
            const int i16 = lane & 15, kq = lane >> 4, r0 = c * 128 + wave * 16;
            f32x4m acc0 = {0.f, 0.f, 0.f, 0.f}, acc1 = acc0, acc2 = acc0;
            const float* xrow = x + (size_t)(r0 + i16) * DM + 4 * kq;
#pragma unroll 8
            for (int k0 = 0; k0 < DM; k0 += 16) {
                const f32x4 xv = *(const GAS f32x4*)(xrow + k0); const f32x4 sv = *(const LAS f32x4*)(sc + k0 + 4 * kq);
                const GAS f32x4* wp = (const GAS f32x4*)(RTW + (size_t)(((k0 >> 2) + kq) * 16 + i16) * 12);
                const f32x4 w0 = wp[0], w1 = wp[1], w2 = wp[2]; const float wf[12] = {w0[0], w0[1], w0[2], w0[3], w1[0], w1[1], w1[2], w1[3], w2[0], w2[1], w2[2], w2[3]};
#pragma unroll
                for (int j = 0; j < 4; ++j) { const float av = xv[j] * sv[j];
                    acc0 = __builtin_amdgcn_mfma_f32_16x16x4f32(av, wf[j * 3], acc0, 0, 0, 0);
                    acc1 = __builtin_amdgcn_mfma_f32_16x16x4f32(av, wf[j * 3 + 1], acc1, 0, 0, 0);
                    acc2 = __builtin_amdgcn_mfma_f32_16x16x4f32(av, wf[j * 3 + 2], acc2, 0, 0, 0); }
            }
            __syncthreads();
            LAS float* lw = lg + wave * 16 * 48;
#pragma unroll
            for (int r = 0; r < 4; ++r) { const int rr = 4 * kq + r; const float rs = rstd_s[wave * 16 + rr];
                lw[rr * 48 + i16] = acc0[r] * rs + cvec[i16]; lw[rr * 48 + 16 + i16] = acc1[r] * rs + cvec[16 + i16]; lw[rr * 48 + 32 + i16] = acc2[r] * rs + cvec[32 + i16]; }
            LDS_WAIT(); asm volatile("" ::: "memory");
            if (lane < 16) {
                const LAS float* lr = lw + lane * 48; const int row = r0 + lane;
                float g0 = lr[0], g1 = lr[1], g2 = lr[2], g3 = lr[3]; const float gm = fmaxf(fmaxf(g0, g1), fmaxf(g2, g3));
                float p0 = __expf(g0 - gm), p1 = __expf(g1 - gm), p2 = __expf(g2 - gm), p3 = __expf(g3 - gm); const float inv = 1.f / (p0 + p1 + p2 + p3);
                p0 *= inv; p1 *= inv; p2 *= inv; p3 *= inv;
                int gi = 0; float gp = p0; if (p1 > gp) { gp = p1; gi = 1; } if (p2 > gp) { gp = p2; gi = 2; } if (p3 > gp) { gp = p3; gi = 3; }
                float ev0 = -3.4e38f, ev1 = -3.4e38f; int e0 = 0, e1 = 0;
#pragma unroll
                for (int j = 0; j < 8; ++j) { const float s = lr[4 + gi * 8 + j]; if (s > ev0) { ev1 = ev0; e1 = e0; ev0 = s; e0 = j; } else if (s > ev1) { ev1 = s; e1 = j; } }
                const float q = __expf(ev1 - ev0), w0 = gp / (1.f + q), w1 = gp * q / (1.f + q);
                e0 += gi * 8; e1 += gi * 8;
                TOKE[2 * row] = e0; TOKE[2 * row + 1] = e1; TOKW[2 * row] = w0; TOKW[2 * row + 1] = w1;
                const int a0 = 2 * (wave * 16 + lane);
                asg_e[a0] = e0; asg_e[a0 + 1] = e1; asg_lp[a0] = atomicAdd((int*)&hist[e0], 1); asg_lp[a0 + 1] = atomicAdd((int*)&hist[e1], 1);
            }
        }
        __syncthreads();
        if (tid < 32) { const int h = hist[tid]; basev[tid] = h ? (int)atomicAdd(CNT + tid, (unsigned)h) : 0; }
        __syncthreads();
        if (tid < 256) { const int e = asg_e[tid]; LIST[(size_t)e * 65536 + basev[e] + asg_lp[tid]] = (c * 128) * 2 + tid; }
    }
}
__device__ __forceinline__ void build_ptab(const unsigned* CNT, LAS int* ptab, LAS int* pst, LAS int* cnt, int tid) {
    __syncthreads();
    if (tid < NEXP) {
        const int ce = (int)__hip_atomic_load(CNT + tid, RLX_AGENT); cnt[tid] = ce; const int pe = (ce + 255) >> 8;
        int incl = pe;
#pragma unroll
        for (int d = 1; d < NEXP; d <<= 1) { const int t = __shfl_up(incl, d, 64); if (tid >= d) incl += t; }
        const int start = incl - pe; pst[tid] = start * 256;
        for (int p = 0; p < pe; ++p) ptab[1 + start + p] = tid;
        if (tid == NEXP - 1) ptab[0] = incl; }
    __syncthreads();
}
__device__ __forceinline__ void phase_gather(KArgsP a, LAS unsigned char* lds, int tid, int lane, int wave, int vcu, int G, int l) {
    unsigned char* ws = a->ws;
    LAS int* ptab = (LAS int*)lds; LAS int* pst = ptab + 512; LAS int* cnt = pst + 32;
    build_ptab((const unsigned*)(ws + WS_CTL) + CW_CNT + l * 32, ptab, pst, cnt, tid);
    const bf16* HN = (const bf16*)(ws + WS_HN); bf16* XG = (bf16*)(ws + WS_XG); int* ROWMAP = (int*)(ws + WS_ROWMAP); const int* LIST = (const int*)(ws + WS_LIST);
    const int nrows = ptab[0] * 256;
    for (int row0 = (vcu * NWAVES + wave) * 8; row0 < nrows; row0 += G * NWAVES * 8) {
        int tok2[8]; v4u p0[8], p1[8];
#pragma unroll
        for (int j = 0; j < 8; ++j) { const int row = row0 + j, e = ptab[1 + (row >> 8)], pos = row - pst[e]; tok2[j] = (pos < cnt[e]) ? LIST[(size_t)e * 65536 + pos] : -1; }
#pragma unroll
        for (int j = 0; j < 8; ++j) { if (tok2[j] >= 0) { const GAS v4u* s = (const GAS v4u*)(HN + (size_t)(tok2[j] >> 1) * DM) + lane; p0[j] = s[0]; p1[j] = s[64]; } else { p0[j] = (v4u){0u, 0u, 0u, 0u}; p1[j] = p0[j]; } }
#pragma unroll
        for (int j = 0; j < 8; ++j) { GAS v4u* d = (GAS v4u*)(XG + (size_t)(row0 + j) * DM) + lane; d[0] = p0[j]; d[64] = p1[j]; if (lane == 0) ROWMAP[row0 + j] = tok2[j]; }
    }
}

__device__ __forceinline__ void phase_rowmap(KArgsP a, LAS unsigned char* lds, int tid, int vcu, int G, int l) {
    unsigned char* ws = a->ws;
    LAS int* ptab = (LAS int*)lds; LAS int* pst = ptab + 512; LAS int* cnt = pst + 32;
    build_ptab((const unsigned*)(ws + WS_CTL) + CW_CNT + l * 32, ptab, pst, cnt, tid);
    int* ROWMAP = (int*)(ws + WS_ROWMAP); const int* LIST = (const int*)(ws + WS_LIST);
    const int nrows = ptab[0] * 256;
    for (int row = vcu * NTHR + tid; row < nrows; row += G * NTHR) { const int e = ptab[1 + (row >> 8)], pos = row - pst[e]; ROWMAP[row] = (pos < cnt[e]) ? LIST[(size_t)e * 65536 + pos] : -1; }
}

typedef short bf16x8 __attribute__((ext_vector_type(8)));
constexpr int MT = 72;
constexpr int ML_XP = 0;
constexpr int ML_CX = 17152;
constexpr int ML_WQ = ML_CX + 9216, ML_WK = ML_WQ + 9216;
constexpr int ML_Q = ML_WK + 9216, ML_K = ML_Q + 9216;
constexpr int ML_S = ML_K + 9216;
constexpr int ML_VT = ML_S + 9216;
constexpr int ML_CT = ML_VT + 11520;
constexpr int ML_H = ML_CT + 11520;
constexpr int ML_SM = ML_H + 16640;
static_assert(ML_SM + 2048 <= RING_BYTES, "mLSTM LDS map");
__device__ __forceinline__ float logsigmoidf_(float x) { return fminf(x, 0.f) - log1pf(__expf(-fabsf(x))); }
__device__ __forceinline__ void mma64(const LAS bf16* A, int arow0, const LAS bf16* Bt, int brow0, int lane, f32x4& acc) {
    const LAS bf16* ap = A + (arow0 + (lane & 15)) * MT + 8 * (lane >> 4); const LAS bf16* bp = Bt + (brow0 + (lane & 15)) * MT + 8 * (lane >> 4);
    const bf16x8 a0 = *(const LAS bf16x8*)ap, a1 = *(const LAS bf16x8*)(ap + 32), b0 = *(const LAS bf16x8*)bp, b1 = *(const LAS bf16x8*)(bp + 32);
    acc = __builtin_amdgcn_mfma_f32_16x16x32_bf16(a0, b0, acc, 0, 0, 0); acc = __builtin_amdgcn_mfma_f32_16x16x32_bf16(a1, b1, acc, 0, 0, 0);
}
__device__ __forceinline__ void ml_front(KArgsP a, LAS unsigned char* lds, int tid, int l, int b, int c, int h, bool want_q) {
    const bf16* PROJ = (const bf16*)(a->ws + WS_PROJ); const size_t row0 = (size_t)b * SEQ + c * 64;
    LAS float* xp = (LAS float*)(lds + ML_XP);
    for (int idx = tid; idx < 67 * 8; idx += NTHR) { const int r = idx >> 3, c8 = idx & 7, tr = c * 64 + r - 3; LAS float* d = xp + r * 64 + c8 * 8;
        if (tr >= 0) { const v4u p = *(const GAS v4u*)(PROJ + ((size_t)b * SEQ + tr) * NPROJ + PC_QK + h * 64 + c8 * 8);
            *(LAS f32x4*)d = (f32x4){bflo(p.x), bfhi(p.x), bflo(p.y), bfhi(p.y)}; *(LAS f32x4*)(d + 4) = (f32x4){bflo(p.z), bfhi(p.z), bflo(p.w), bfhi(p.w)}; }
        else { *(LAS f32x4*)d = (f32x4){0.f, 0.f, 0.f, 0.f}; *(LAS f32x4*)(d + 4) = (f32x4){0.f, 0.f, 0.f, 0.f}; } }
    {
        const int t = tid >> 3, vg = tid & 7; LAS bf16* VT = (LAS bf16*)(lds + ML_VT);
        const v4u p = *(const GAS v4u*)(PROJ + (row0 + t) * NPROJ + PC_V + h * 64 + vg * 8);
        const unsigned w[4] = {p.x, p.y, p.z, p.w};
#pragma unroll
        for (int j = 0; j < 4; ++j) { VT[(vg * 8 + 2 * j) * MT + t] = (bf16)(w[j] & 0xffffu); VT[(vg * 8 + 2 * j + 1) * MT + t] = (bf16)(w[j] >> 16); }
        for (int idx = tid; idx < 16 * 64; idx += NTHR) VT[(64 + (idx >> 6)) * MT + (idx & 63)] = (idx < 64) ? (bf16)0x3F80 : (bf16)0;
        const bf16* WT = (const bf16*)(a->ws + WS_MLW) + (size_t)((l * NH + h) * 2) * 4096;
        const int e = tid >> 3, d8 = tid & 7;
        if (want_q) *(LAS v4u*)(lds + ML_WQ + (e * MT + d8 * 8) * 2) = *(const GAS v4u*)(WT + e * 64 + d8 * 8);
        *(LAS v4u*)(lds + ML_WK + (e * MT + d8 * 8) * 2) = *(const GAS v4u*)(WT + 4096 + e * 64 + d8 * 8);
    }
    __syncthreads();
    const float* cw = a->in[I_CONV_W] + (size_t)l * 4 * DA + h * 64; const float* cb = a->in[I_CONV_B] + (size_t)l * DA + h * 64;
    {
        const int t = tid >> 3, c8 = (tid & 7) * 8; float s[8];
#pragma unroll
        for (int j = 0; j < 8; ++j) s[j] = cb[c8 + j];
#pragma unroll
        for (int q = 0; q < 4; ++q) { const f32x4 x0 = *(const LAS f32x4*)(xp + (t + q) * 64 + c8), x1 = *(const LAS f32x4*)(xp + (t + q) * 64 + c8 + 4); const float* w = cw + q * DA + c8;
            s[0] += x0.x * w[0]; s[1] += x0.y * w[1]; s[2] += x0.z * w[2]; s[3] += x0.w * w[3]; s[4] += x1.x * w[4]; s[5] += x1.y * w[5]; s[6] += x1.z * w[6]; s[7] += x1.w * w[7]; }
#pragma unroll
        for (int j = 0; j < 8; ++j) s[j] = s[j] / (1.f + __expf(-s[j]));
        v4u o; o.x = pk2(s[0], s[1]); o.y = pk2(s[2], s[3]); o.z = pk2(s[4], s[5]); o.w = pk2(s[6], s[7]);
        *(LAS v4u*)(lds + ML_CX + (t * MT + c8) * 2) = o;
    }
}
__device__ __forceinline__ void phase_m1(KArgsP a, LAS unsigned char* lds, int tid, int lane, int wave, int vcu, int G, int l) {
    unsigned char* ws = a->ws; const float* GT = (const float*)(ws + WS_GATES);
    float* CLOC = (float*)(ws + WS_CLOC); float* MLG = (float*)(ws + WS_MSC); float* MLM = MLG + 4096;
    LAS float* sm = (LAS float*)(lds + ML_SM);
    for (int u = vcu; u < NUNIT_M; u += G) {
        const int h = u % NH, c = (u / NH) % NCH, b = u / (NH * NCH); const size_t row0 = (size_t)b * SEQ + c * 64;
        __syncthreads();
        ml_front(a, lds, tid, l, b, c, h, false);
        if (wave == 0) {
            const float ig = GT[(row0 + lane) * 16 + h] + a->in[I_BI][l * NH + h];
            const float fl = logsigmoidf_(GT[(row0 + lane) * 16 + 6 + h] + a->in[I_BF][l * NH + h]);
            float bc = fl;
#pragma unroll
            for (int o = 1; o < 64; o <<= 1) { const float t = __shfl_up(bc, o); if (lane >= o) bc += t; }
            const float gtot = __shfl(bc, 63); const float lw = gtot - bc + ig; const float ml = wave_max(lw);
            sm[lane] = __expf(lw - ml);
            if (lane == 0) { MLG[u] = gtot; MLM[u] = ml; }
        }
        __syncthreads();
        {
            const int rt = wave >> 1; LAS bf16* KT = (LAS bf16*)(lds + ML_K);
#pragma unroll
            for (int q = 0; q < 2; ++q) { const int ct = 2 * (wave & 1) + q; f32x4 acc = {0.f, 0.f, 0.f, 0.f};
                mma64((const LAS bf16*)(lds + ML_CX), 16 * rt, (const LAS bf16*)(lds + ML_WK), 16 * ct, lane, acc);
                const int t0 = 16 * rt + 4 * (lane >> 4), e = 16 * ct + (lane & 15);
                const float w0 = sm[t0] * 0.125f, w1 = sm[t0 + 1] * 0.125f, w2 = sm[t0 + 2] * 0.125f, w3 = sm[t0 + 3] * 0.125f;
                v2u o; o.x = pk2(acc[0] * w0, acc[1] * w1); o.y = pk2(acc[2] * w2, acc[3] * w3);
                *(LAS v2u*)(KT + e * MT + t0) = o; }
        }
        __syncthreads();
        {
            const int ct = wave & 3, r_lo = wave < 4 ? 0 : 3, r_hi = wave < 4 ? 3 : 5; float* cl = CLOC + (size_t)u * CL_STRIDE;
            for (int rt = r_lo; rt < r_hi; ++rt) { f32x4 acc = {0.f, 0.f, 0.f, 0.f};
                mma64((const LAS bf16*)(lds + ML_VT), 16 * rt, (const LAS bf16*)(lds + ML_K), 16 * ct, lane, acc);
                const int v0 = 16 * rt + 4 * (lane >> 4), e = 16 * ct + (lane & 15);
                if (rt < 4) {
#pragma unroll
                    for (int r = 0; r < 4; ++r) cl[(v0 + r) * 64 + e] = acc[r];
                } else if ((lane >> 4) == 0) cl[4096 + e] = acc[0]; }
        }
    }
}
__device__ __forceinline__ void phase_m2(unsigned char* ws, int tid, int wg, int nwg) {
    float* CLOC = (float*)(ws + WS_CLOC); const float* MLG = (const float*)(ws + WS_MSC); const float* MLM = MLG + 4096; float* MST = (float*)(ws + WS_MSC) + 8192;
    for (int idx = wg * NTHR + tid; idx < NB * NH * CL_STRIDE; idx += nwg * NTHR) {
        const int e = idx % CL_STRIDE, bh = idx / CL_STRIDE, b = bh / NH, h = bh % NH;
        float m = 0.f, cs = 0.f;
        float cn[8], gn[8], mn8[8];
#pragma unroll
        for (int j = 0; j < 8; ++j) { const int u = (b * NCH + j) * NH + h; cn[j] = CLOC[(size_t)u * CL_STRIDE + e]; gn[j] = MLG[u]; mn8[j] = MLM[u]; }
        for (int c0 = 0; c0 < NCH; c0 += 8) {
            float cl[8], g[8], ml[8];
#pragma unroll
            for (int j = 0; j < 8; ++j) { cl[j] = cn[j]; g[j] = gn[j]; ml[j] = mn8[j]; }
            { const int cq = min(c0 + 8, NCH - 8);
#pragma unroll
              for (int j = 0; j < 8; ++j) { const int u = (b * NCH + cq + j) * NH + h; cn[j] = CLOC[(size_t)u * CL_STRIDE + e]; gn[j] = MLG[u]; mn8[j] = MLM[u]; } }
#pragma unroll
            for (int j = 0; j < 8; ++j) { const int u = (b * NCH + c0 + j) * NH + h;
                CLOC[(size_t)u * CL_STRIDE + e] = cs; if (e == 0) MST[u] = m;
                const float mn = fmaxf(g[j] + m, ml[j]); const float ao = __expf(g[j] + m - mn), al = __expf(ml[j] - mn);
                cs = ao * cs + al * cl[j]; m = mn; }
        }
    }
}
__device__ __forceinline__ void phase_m3(KArgsP a, LAS unsigned char* lds, int tid, int lane, int wave, int vcu, int G, int l) {
    unsigned char* ws = a->ws; const bf16* PROJ = (const bf16*)(ws + WS_PROJ); const float* GT = (const float*)(ws + WS_GATES);
    const float* CLOC = (const float*)(ws + WS_CLOC); const float* MST = (const float*)(ws + WS_MSC) + 8192; bf16* YC = (bf16*)(ws + WS_YC);
    LAS float* sm = (LAS float*)(lds + ML_SM); LAS float* hb = (LAS float*)(lds + ML_H);
    for (int u = vcu; u < NUNIT_M; u += G) {
        const int h = u % NH, c = (u / NH) % NCH, b = u / (NH * NCH); const size_t row0 = (size_t)b * SEQ + c * 64;
        __syncthreads();
        ml_front(a, lds, tid, l, b, c, h, true);
        {
            const float* cl = CLOC + (size_t)u * CL_STRIDE; LAS bf16* CT = (LAS bf16*)(lds + ML_CT);
            for (int idx = tid; idx < 65 * 16; idx += NTHR) { const int r = idx >> 4, c4 = idx & 15; const f32x4 v = *(const GAS f32x4*)(cl + r * 64 + c4 * 4);
                v2u o; o.x = pk2(v.x, v.y); o.y = pk2(v.z, v.w); *(LAS v2u*)(CT + r * MT + c4 * 4) = o; }
            for (int idx = tid; idx < 15 * 64; idx += NTHR) CT[(65 + (idx >> 6)) * MT + (idx & 63)] = 0;
        }
        if (wave == 0) {
            const float ig = GT[(row0 + lane) * 16 + h] + a->in[I_BI][l * NH + h];
            const float fl = logsigmoidf_(GT[(row0 + lane) * 16 + 6 + h] + a->in[I_BF][l * NH + h]);
            float bc = fl;
#pragma unroll
            for (int o = 1; o < 64; o <<= 1) { const float t = __shfl_up(bc, o); if (lane >= o) bc += t; }
            float pm = ig - bc;
#pragma unroll
            for (int o = 1; o < 64; o <<= 1) { const float t = __shfl_up(pm, o); if (lane >= o) pm = fmaxf(pm, t); }
            const float mst = MST[u]; const float inter = bc + mst, mt = fmaxf(inter, bc + pm);
            sm[lane] = ig - bc; sm[64 + lane] = bc - mt; sm[128 + lane] = __expf(inter - mt); sm[192 + lane] = __expf(-mt);
        }
        __syncthreads();
        {
            const int rt = wave >> 1; LAS bf16* Qs = (LAS bf16*)(lds + ML_Q); LAS bf16* Ks = (LAS bf16*)(lds + ML_K);
#pragma unroll
            for (int q = 0; q < 2; ++q) { const int ct = 2 * (wave & 1) + q; f32x4 aq = {0.f, 0.f, 0.f, 0.f}, ak = {0.f, 0.f, 0.f, 0.f};
                mma64((const LAS bf16*)(lds + ML_CX), 16 * rt, (const LAS bf16*)(lds + ML_WQ), 16 * ct, lane, aq);
                mma64((const LAS bf16*)(lds + ML_CX), 16 * rt, (const LAS bf16*)(lds + ML_WK), 16 * ct, lane, ak);
                const int t0 = 16 * rt + 4 * (lane >> 4), e = 16 * ct + (lane & 15);
#pragma unroll
                for (int r = 0; r < 4; ++r) { Qs[(t0 + r) * MT + e] = (bf16)f2bf(aq[r]); Ks[(t0 + r) * MT + e] = (bf16)f2bf(ak[r] * 0.125f); } }
        }
        __syncthreads();
        {
            const int rt = wave >> 1; LAS bf16* Ss = (LAS bf16*)(lds + ML_S);
#pragma unroll
            for (int q = 0; q < 2; ++q) { const int ct = 2 * (wave & 1) + q; f32x4 acc = {0.f, 0.f, 0.f, 0.f};
                if (ct <= rt) mma64((const LAS bf16*)(lds + ML_Q), 16 * rt, (const LAS bf16*)(lds + ML_K), 16 * ct, lane, acc);
                const int t0 = 16 * rt + 4 * (lane >> 4), s = 16 * ct + (lane & 15); const float qs = sm[s];
#pragma unroll
                for (int r = 0; r < 4; ++r) { const int t = t0 + r; Ss[t * MT + s] = (bf16)f2bf((s <= t) ? acc[r] * __expf(sm[64 + t] + qs) : 0.f); } }
        }
        __syncthreads();
        {
            const int rt = wave >> 1, nt = (wave & 1) ? 2 : 3;
            for (int q = 0; q < nt; ++q) { const int ct = (wave & 1) ? 2 + q : (q < 2 ? q : 4); f32x4 aA = {0.f, 0.f, 0.f, 0.f}, aB = {0.f, 0.f, 0.f, 0.f};
                mma64((const LAS bf16*)(lds + ML_Q), 16 * rt, (const LAS bf16*)(lds + ML_CT), 16 * ct, lane, aA);
                mma64((const LAS bf16*)(lds + ML_S), 16 * rt, (const LAS bf16*)(lds + ML_VT), 16 * ct, lane, aB);
                const int t0 = 16 * rt + 4 * (lane >> 4), v = 16 * ct + (lane & 15);
#pragma unroll
                for (int r = 0; r < 4; ++r) { const int t = t0 + r; const float x = sm[128 + t] * aA[r] + aB[r];
                    if (ct < 4) hb[t * 65 + v] = x; else if ((lane & 15) == 0) sm[256 + t] = x; } }
        }
        __syncthreads();
        {
            const int t = tid >> 3, vg = tid & 7; float acc[8];
            const float dn = 1.f / fmaxf(fabsf(sm[256 + t]), sm[192 + t]);
            float s1 = 0.f;
#pragma unroll
            for (int j = 0; j < 8; ++j) { acc[j] = hb[t * 65 + vg * 8 + j] * dn; s1 += acc[j]; }
            s1 += __shfl_xor(s1, 1); s1 += __shfl_xor(s1, 2); s1 += __shfl_xor(s1, 4);
            const float mu = s1 * (1.f / 64.f); float s2 = 0.f;
#pragma unroll
            for (int j = 0; j < 8; ++j) { acc[j] -= mu; s2 += acc[j] * acc[j]; }
            s2 += __shfl_xor(s2, 1); s2 += __shfl_xor(s2, 2); s2 += __shfl_xor(s2, 4);
            const float rs = rsqrtf(s2 * (1.f / 64.f) + HEAD_NORM_EPS);
            const float* nw = a->in[I_MNORM_W] + (size_t)l * DA + h * 64 + vg * 8;
            const v4u ov = *(const GAS v4u*)(PROJ + (row0 + t) * NPROJ + PC_O + h * 64 + vg * 8);
            const float o[8] = {bflo(ov.x), bfhi(ov.x), bflo(ov.y), bfhi(ov.y), bflo(ov.z), bfhi(ov.z), bflo(ov.w), bfhi(ov.w)};
            float r[8];
#pragma unroll
            for (int j = 0; j < 8; ++j) r[j] = acc[j] * rs * nw[j] * sigmoidf_(o[j]);
            v4u w; w.x = pk2(r[0], r[1]); w.y = pk2(r[2], r[3]); w.z = pk2(r[4], r[5]); w.w = pk2(r[6], r[7]);
            *(GAS v4u*)(YC + (row0 + t) * DM + h * 64 + vg * 8) = w;
        }
    }
}

constexpr int S5_UT = 264, S5_XT = 2056;
constexpr int S5_U = 0, S5_Z = 33792, S5_X = 67584;
static_assert(S5_X + 16 * S5_XT * 2 <= MISC_OFF, "S5 LDS map");
struct S5A { float are, aim, cre, cim; };
__device__ __forceinline__ S5A s5_a(KArgsP a, int l, int g, int p) {
    const float lam_re = a->in[I_S5ARE][(size_t)(l * 16 + g) * 64 + p], lam_im = a->in[I_S5AIM][(size_t)(l * 16 + g) * 64 + p];
    const float dt = expf(a->in[I_S5LDT][l * 16 + g]); const float mag = expf(lam_re * dt), ang = lam_im * dt;
    S5A r; r.are = mag * cosf(ang); r.aim = mag * sinf(ang);
    const float inv = 1.f / (lam_re * lam_re + lam_im * lam_im);
    r.cre = ((r.are - 1.f) * lam_re + r.aim * lam_im) * inv; r.cim = (r.aim * lam_re - (r.are - 1.f) * lam_im) * inv; return r;
}
__device__ __forceinline__ bf16x8 pack8(const float* v) { v4u o; o.x = pk2(v[0], v[1]); o.y = pk2(v[2], v[3]); o.z = pk2(v[4], v[5]); o.w = pk2(v[6], v[7]); return __builtin_bit_cast(bf16x8, o); }
__device__ __forceinline__ void s5_bfrag(const unsigned char* ws, int l, int g, int lane, bf16x8 (&bf)[8]) {
    const bf16* BB = (const bf16*)(ws + WS_S5BB) + (size_t)(l * 16 + g) * 128 * 16;
#pragma unroll
    for (int j = 0; j < 8; ++j) { v4u o = {0u, 0u, 0u, 0u}; if ((lane >> 4) < 2) o = *(const GAS v4u*)(BB + (16 * j + (lane & 15)) * 16 + 8 * (lane >> 4)); bf[j] = __builtin_bit_cast(bf16x8, o); }
}
__device__ __forceinline__ f32x2 s5_ap(const unsigned char* ws, int l, int g, int p) { return *(const GAS f32x2*)((const float*)(ws + WS_S5AP) + ((size_t)(l * 16 + g) * 64 + p) * 2); }
__device__ __forceinline__ void s5_load_u(const unsigned char* ws, LAS unsigned char* lds, int tid, size_t row0) {
    const bf16* PROJ = (const bf16*)(ws + WS_PROJ);
    for (int idx = tid; idx < 64 * 32; idx += NTHR) { const int t = idx >> 5, c8 = idx & 31;
        *(LAS v4u*)(lds + S5_U + (t * S5_UT + c8 * 8) * 2) = *(const GAS v4u*)(PROJ + (row0 + t) * NPROJ + PC_S5 + c8 * 8); }
}
__device__ __forceinline__ void s5_block(LAS unsigned char* lds, int lane, int tb, int g, const bf16x8 (&bf)[8], float are, float aim, float& xr, float& xi) {
    const int kq = lane >> 4; bf16x8 uf = {0, 0, 0, 0, 0, 0, 0, 0};
    if (kq < 2) uf = *(const LAS bf16x8*)(lds + S5_U + ((16 * tb + (lane & 15)) * S5_UT + g * 16 + 8 * kq) * 2);
    LAS bf16* X = (LAS bf16*)(lds + S5_X);
#pragma unroll
    for (int j = 0; j < 8; ++j) { f32x4 acc = {0.f, 0.f, 0.f, 0.f}; acc = __builtin_amdgcn_mfma_f32_16x16x32_bf16(bf[j], uf, acc, 0, 0, 0);
        v2u o; o.x = pk2(acc[0], acc[1]); o.y = pk2(acc[2], acc[3]); *(LAS v2u*)(X + (lane & 15) * S5_XT + g * 128 + 16 * j + 4 * kq) = o; }
    LDS_WAIT(); asm volatile("" ::: "memory");
    LAS unsigned* xw = (LAS unsigned*)(lds + S5_X) + (g * 128 + 2 * lane) / 2;
    unsigned wv[16];
#pragma unroll
    for (int t = 0; t < 16; ++t) wv[t] = xw[t * (S5_XT / 2)];
#pragma unroll
    for (int t = 0; t < 16; ++t) { const float br = bflo(wv[t]), bi = bfhi(wv[t]);
        const float nr = are * xr - aim * xi + br, ni = are * xi + aim * xr + bi; xr = nr; xi = ni;
        wv[t] = pk2(xr, xi); }
#pragma unroll
    for (int t = 0; t < 16; ++t) xw[t * (S5_XT / 2)] = wv[t];
    LDS_WAIT(); asm volatile("" ::: "memory");
}
__device__ __forceinline__ void phase_s1(KArgsP a, LAS unsigned char* lds, int tid, int lane, int wave, int vcu, int G, int l) {
    unsigned char* ws = a->ws; float* ST = (float*)(ws + WS_S5ST);
    bf16x8 bf0[8], bf1[8]; s5_bfrag(ws, l, wave, lane, bf0); s5_bfrag(ws, l, wave + 8, lane, bf1);
    struct { float are, aim; } A0, A1; { const f32x2 q0 = s5_ap(ws, l, wave, lane), q1 = s5_ap(ws, l, wave + 8, lane); A0.are = q0.x; A0.aim = q0.y; A1.are = q1.x; A1.aim = q1.y; }
    for (int u = vcu; u < NB * NCH; u += G) {
        const size_t row0 = (size_t)u * 64;
        __syncthreads();
        s5_load_u(ws, lds, tid, row0);
        __syncthreads();
        float x0r = 0.f, x0i = 0.f, x1r = 0.f, x1i = 0.f;
        for (int tb = 0; tb < 4; ++tb) { s5_block(lds, lane, tb, wave, bf0, A0.are, A0.aim, x0r, x0i); s5_block(lds, lane, tb, wave + 8, bf1, A1.are, A1.aim, x1r, x1i); }
        *(f32x2*)(ST + (((size_t)u * 16 + wave) * 64 + lane) * 2) = (f32x2){x0r, x0i};
        *(f32x2*)(ST + (((size_t)u * 16 + wave + 8) * 64 + lane) * 2) = (f32x2){x1r, x1i};
    }
}
__device__ __forceinline__ void phase_s2(KArgsP a, int tid, int wg, int nwg, int l) {
    float* ST = (float*)(a->ws + WS_S5ST);
    for (int idx = wg * NTHR + tid; idx < NB * 1024; idx += nwg * NTHR) {
        const int b = idx >> 10, gp = idx & 1023, g = gp >> 6, p = gp & 63;
        const f32x2 A = s5_ap(a->ws, l, g, p); float ar = A.x, ai = A.y;
#pragma unroll
        for (int s = 0; s < 6; ++s) { const float nr = ar * ar - ai * ai, ni = 2.f * ar * ai; ar = nr; ai = ni; }
        float cr = 0.f, ci = 0.f;
        f32x2 en[8];
#pragma unroll
        for (int j = 0; j < 8; ++j) en[j] = *(const f32x2*)(ST + (((size_t)(b * NCH + j) * 16 + g) * 64 + p) * 2);
        for (int c0 = 0; c0 < NCH; c0 += 8) {
            f32x2 e[8];
#pragma unroll
            for (int j = 0; j < 8; ++j) e[j] = en[j];
            { const int cq = min(c0 + 8, NCH - 8);
#pragma unroll
              for (int j = 0; j < 8; ++j) en[j] = *(const f32x2*)(ST + (((size_t)(b * NCH + cq + j) * 16 + g) * 64 + p) * 2); }
#pragma unroll
            for (int j = 0; j < 8; ++j) { *(f32x2*)(ST + (((size_t)(b * NCH + c0 + j) * 16 + g) * 64 + p) * 2) = (f32x2){cr, ci};
                const float nr = ar * cr - ai * ci + e[j].x, ni = ar * ci + ai * cr + e[j].y; cr = nr; ci = ni; }
        }
    }
}
__device__ __forceinline__ float tanh_fast(float x) { return 1.f - 2.f / (1.f + __expf(2.f * x)); }
__device__ __forceinline__ float gelu_tanh_(float x) { const float t = tanh_fast(0.7978845608f * (x + 0.044715f * x * x * x)); return 0.5f * x * (1.f + t); }
__device__ __forceinline__ void s5_cload(const bf16* cmt  , int lane, bf16x8 (&cf)[4]) {
#pragma unroll
    for (int s = 0; s < 4; ++s) cf[s] = __builtin_bit_cast(bf16x8, *(const GAS v4u*)(cmt + (lane & 15) * 128 + 32 * s + 8 * (lane >> 4)));
}
__device__ __forceinline__ void s5_cproj(LAS unsigned char* lds, int lane, int tb, int g, const bf16x8 (&cf)[4], const float (&dv)[4]) {
    const int kq = lane >> 4; f32x4 acc = {0.f, 0.f, 0.f, 0.f};
    const LAS bf16* xp = (const LAS bf16*)(lds + S5_X) + (lane & 15) * S5_XT + g * 128 + 8 * kq;
#pragma unroll
    for (int s = 0; s < 4; ++s) acc = __builtin_amdgcn_mfma_f32_16x16x32_bf16(cf[s], *(const LAS bf16x8*)(xp + 32 * s), acc, 0, 0, 0);
    const int t = 16 * tb + (lane & 15), c0 = g * 16 + 4 * kq;
    const v2u uw = *(const LAS v2u*)(lds + S5_U + (t * S5_UT + c0) * 2);
    const float u4[4] = {bflo(uw.x), bfhi(uw.x), bflo(uw.y), bfhi(uw.y)}; float z[4];
#pragma unroll
    for (int r = 0; r < 4; ++r) z[r] = gelu_tanh_(acc[r] + dv[r] * u4[r]);
    v2u o; o.x = pk2(z[0], z[1]); o.y = pk2(z[2], z[3]); *(LAS v2u*)(lds + S5_Z + (t * S5_UT + c0) * 2) = o;
}
__device__ __forceinline__ void phase_s3(KArgsP a, LAS unsigned char* lds, int tid, int lane, int wave, int vcu, int G, int l, unsigned* qctr = nullptr) {
    unsigned char* ws = a->ws; const float* ST = (const float*)(ws + WS_S5ST); bf16* YC = (bf16*)(ws + WS_YC);
    const bf16* GLUT = (const bf16*)(ws + WS_GLUT) + (size_t)l * DC * DC;
    bf16x8 bf0[8], bf1[8]; s5_bfrag(ws, l, wave, lane, bf0); s5_bfrag(ws, l, wave + 8, lane, bf1);
    const bf16* cm0 = (const bf16*)(ws + WS_S5CM) + (size_t)(l * 16 + wave) * 2048; const bf16* cm1 = cm0 + 8 * 2048;
    struct { float are, aim; } A0, A1; { const f32x2 q0 = s5_ap(ws, l, wave, lane), q1 = s5_ap(ws, l, wave + 8, lane); A0.are = q0.x; A0.aim = q0.y; A1.are = q1.x; A1.aim = q1.y; }
    float d0[4], d1[4];
#pragma unroll
    for (int r = 0; r < 4; ++r) { d0[r] = a->in[I_S5D][l * DC + wave * 16 + 4 * (lane >> 4) + r]; d1[r] = a->in[I_S5D][l * DC + (wave + 8) * 16 + 4 * (lane >> 4) + r]; }
    volatile LAS unsigned* qw = (volatile LAS unsigned*)(lds + MISC_OFF) + 20;
    unsigned qn = 0u; if (qctr && tid == 0) qn = __hip_atomic_fetch_add(qctr, 1u, __ATOMIC_RELAXED, __HIP_MEMORY_SCOPE_AGENT);
    for (int u = vcu; ; u += G) {
        if (qctr) { __syncthreads(); if (tid == 0) *qw = qn; __syncthreads(); u = (int)*qw; }
        if (u >= NB * NCH) break;
        if (qctr && tid == 0) qn = __hip_atomic_fetch_add(qctr, 1u, __ATOMIC_RELAXED, __HIP_MEMORY_SCOPE_AGENT);
        const size_t row0 = (size_t)u * 64;
        __syncthreads();
        s5_load_u(ws, lds, tid, row0);
        const f32x2 s0 = *(const f32x2*)(ST + (((size_t)u * 16 + wave) * 64 + lane) * 2), s1 = *(const f32x2*)(ST + (((size_t)u * 16 + wave + 8) * 64 + lane) * 2);
        float x0r = s0.x, x0i = s0.y, x1r = s1.x, x1i = s1.y;
        __syncthreads();
        for (int tb = 0; tb < 4; ++tb) {
            { bf16x8 cf[4]; s5_cload(cm0, lane, cf); s5_block(lds, lane, tb, wave, bf0, A0.are, A0.aim, x0r, x0i); s5_cproj(lds, lane, tb, wave, cf, d0); }
            { bf16x8 cf[4]; s5_cload(cm1, lane, cf); s5_block(lds, lane, tb, wave + 8, bf1, A1.are, A1.aim, x1r, x1i); s5_cproj(lds, lane, tb, wave + 8, cf, d1); }
        }
        __syncthreads();
        {
            const int kq = lane >> 4;
#pragma unroll
            for (int q = 0; q < 2; ++q) { const int ct = 2 * wave + q; f32x4 acc[4];
#pragma unroll
                for (int rt = 0; rt < 4; ++rt) acc[rt] = (f32x4){0.f, 0.f, 0.f, 0.f};
                const bf16* gp = GLUT + (size_t)(16 * ct + (lane & 15)) * DC + 8 * kq;
#pragma unroll 2
                for (int s = 0; s < 8; ++s) { const bf16x8 gf = __builtin_bit_cast(bf16x8, *(const GAS v4u*)(gp + 32 * s));
#pragma unroll
                    for (int rt = 0; rt < 4; ++rt) acc[rt] = __builtin_amdgcn_mfma_f32_16x16x32_bf16(gf, *(const LAS bf16x8*)(lds + S5_Z + ((16 * rt + (lane & 15)) * S5_UT + 32 * s + 8 * kq) * 2), acc[rt], 0, 0, 0); }
                const int j0 = 16 * ct + 4 * kq; const f32x4 gb = *(const GAS f32x4*)(a->in[I_S5GLUB] + l * DC + j0);
#pragma unroll
                for (int rt = 0; rt < 4; ++rt) { const int t = 16 * rt + (lane & 15); const v2u zw = *(const LAS v2u*)(lds + S5_Z + (t * S5_UT + j0) * 2);
                    const float z0 = bflo(zw.x), z1 = bfhi(zw.x), z2 = bflo(zw.y), z3 = bfhi(zw.y);
                    v2u o; o.x = pk2(z0 * sigmoidf_(acc[rt][0] + gb.x), z1 * sigmoidf_(acc[rt][1] + gb.y)); o.y = pk2(z2 * sigmoidf_(acc[rt][2] + gb.z), z3 * sigmoidf_(acc[rt][3] + gb.w));
                    *(GAS v2u*)(YC + (row0 + t) * DM + 768 + j0) = o; } }
        }
    }
}

__device__ __forceinline__ float rw_shift(const bf16* PROJ, const float* mu, size_t row, int col) {
    const float cur = bf2f(PROJ[row * NPROJ + PC_RW + col]); const float prv = (row % SEQ) ? bf2f(PROJ[(row - 1) * NPROJ + PC_RW + col]) : 0.f;
    return cur + mu[col] * (prv - cur);
}
constexpr int R1_TH = 0, R1_AD = 9216, R1_SG = 18432, R1_VS = 35840, R1_TMP = 86016;
template <int KS, int MODE>
__device__ __forceinline__ void r1_prod(const bf16* WT, const LAS bf16* act, int astride, const float* bias, bf16* OUT, size_t row0, int lane, int wave) {
    const int kq = lane >> 4, n0 = 48 * wave; constexpr int K = 32 * KS;
    f32x4 acc[3][4];
#pragma unroll
    for (int nt = 0; nt < 3; ++nt)
#pragma unroll
        for (int ti = 0; ti < 4; ++ti) acc[nt][ti] = (f32x4){0.f, 0.f, 0.f, 0.f};
#pragma unroll
    for (int s = 0; s < KS; ++s) { bf16x8 wf[3], af[4];
#pragma unroll
        for (int nt = 0; nt < 3; ++nt) wf[nt] = __builtin_bit_cast(bf16x8, *(const GAS v4u*)(WT + (size_t)(n0 + 16 * nt + (lane & 15)) * K + 32 * s + 8 * kq));
#pragma unroll
        for (int ti = 0; ti < 4; ++ti) af[ti] = *(const LAS bf16x8*)(act + (16 * ti + (lane & 15)) * astride + 32 * s + 8 * kq);
#pragma unroll
        for (int nt = 0; nt < 3; ++nt)
#pragma unroll
            for (int ti = 0; ti < 4; ++ti) acc[nt][ti] = __builtin_amdgcn_mfma_f32_16x16x32_bf16(wf[nt], af[ti], acc[nt][ti], 0, 0, 0); }
#pragma unroll
    for (int nt = 0; nt < 3; ++nt) { const int n = n0 + 16 * nt + 4 * kq; f32x4 bv = {0.f, 0.f, 0.f, 0.f}; if (MODE != 2) bv = *(const GAS f32x4*)(bias + n);
#pragma unroll
        for (int ti = 0; ti < 4; ++ti) { float o[4];
#pragma unroll
            for (int r = 0; r < 4; ++r) { const float x = acc[nt][ti][r] + bv[r]; o[r] = MODE == 0 ? 0.60653066f * sigmoidf_(x) : (MODE == 1 ? sigmoidf_(x) : x); }
            v2u w; w.x = pk2(o[0], o[1]); w.y = pk2(o[2], o[3]);
            *(GAS v2u*)(OUT + (row0 + 16 * ti + (lane & 15)) * DBR + n) = w; } }
}
__device__ __forceinline__ void phase_r1(KArgsP a, LAS unsigned char* lds, int tid, int lane, int wave, int vcu, int G, int l) {
    unsigned char* ws = a->ws; const bf16* PROJ = (const bf16*)(ws + WS_PROJ); const float* mu = a->in[I_RMU] + (size_t)l * RW_COLS;
    const bf16* W1 = (const bf16*)(ws + WS_R1W) + (size_t)l * 98304;
    const bf16* WV = (const bf16*)(ws + WS_R1W) + 2 * 98304;
    for (int u = vcu; u < NTOK / 64; u += G) {
        const size_t row0 = (size_t)u * 64;
        __syncthreads();
        for (int idx = tid; idx < 64 * 32; idx += NTHR) { const int tt = idx >> 5, col = 8 * (idx & 31); const size_t r = row0 + tt;
            const v4u cw = *(const GAS v4u*)(PROJ + r * NPROJ + PC_RW + RWC_WD + col); v4u pw = {0u, 0u, 0u, 0u}; if (r % SEQ) pw = *(const GAS v4u*)(PROJ + (r - 1) * NPROJ + PC_RW + RWC_WD + col);
            const f32x4 m0 = *(const GAS f32x4*)(mu + RWC_WD + col), m1 = *(const GAS f32x4*)(mu + RWC_WD + col + 4);
            const unsigned cu[4] = {cw.x, cw.y, cw.z, cw.w}, pu[4] = {pw.x, pw.y, pw.z, pw.w}; const float mm[8] = {m0[0], m0[1], m0[2], m0[3], m1[0], m1[1], m1[2], m1[3]}; unsigned o[4];
#pragma unroll
            for (int j = 0; j < 4; ++j) { const float c0 = bflo(cu[j]), c1 = bfhi(cu[j]); const float x0 = c0 + mm[2 * j] * (bflo(pu[j]) - c0), x1 = c1 + mm[2 * j + 1] * (bfhi(pu[j]) - c1);
                o[j] = col < 64 ? pk2(tanh_fast(x0), tanh_fast(x1)) : (col < 128 ? pk2(x0, x1) : pk2(sigmoidf_(x0), sigmoidf_(x1))); }
            v4u w; w.x = o[0]; w.y = o[1]; w.z = o[2]; w.w = o[3];
            if (col < 64) *(LAS v4u*)(lds + R1_TH + (tt * 72 + col) * 2) = w;
            else if (col < 128) *(LAS v4u*)(lds + R1_AD + (tt * 72 + col - 64) * 2) = w;
            else *(LAS v4u*)(lds + R1_SG + (tt * 136 + col - 128) * 2) = w; }
        if (l > 0) for (int idx = tid; idx < 64 * 48; idx += NTHR) { const int tt = idx / 48, col = 8 * (idx % 48); const size_t r = row0 + tt;
            const v4u cw = *(const GAS v4u*)(PROJ + r * NPROJ + PC_RW + RWC_V + col); v4u pw = {0u, 0u, 0u, 0u}; if (r % SEQ) pw = *(const GAS v4u*)(PROJ + (r - 1) * NPROJ + PC_RW + RWC_V + col);
            const f32x4 m0 = *(const GAS f32x4*)(mu + RWC_V + col), m1 = *(const GAS f32x4*)(mu + RWC_V + col + 4);
            const unsigned cu[4] = {cw.x, cw.y, cw.z, cw.w}, pu[4] = {pw.x, pw.y, pw.z, pw.w}; const float mm[8] = {m0[0], m0[1], m0[2], m0[3], m1[0], m1[1], m1[2], m1[3]}; unsigned o[4];
#pragma unroll
            for (int j = 0; j < 4; ++j) { const float c0 = bflo(cu[j]), c1 = bfhi(cu[j]); o[j] = pk2(c0 + mm[2 * j] * (bflo(pu[j]) - c0), c1 + mm[2 * j + 1] * (bfhi(pu[j]) - c1)); }
            v4u w; w.x = o[0]; w.y = o[1]; w.z = o[2]; w.w = o[3];
            *(LAS v4u*)(lds + R1_VS + (tt * 392 + col) * 2) = w; }
        __syncthreads();
        r1_prod<2, 0>(W1, (const LAS bf16*)(lds + R1_TH), 72, a->in[I_RW0] + l * DBR, (bf16*)(ws + WS_RE), row0, lane, wave);
        r1_prod<2, 1>(W1 + 24576, (const LAS bf16*)(lds + R1_AD), 72, a->in[I_RA0] + l * DBR, (bf16*)(ws + WS_RA), row0, lane, wave);
        r1_prod<4, 2>(W1 + 49152, (const LAS bf16*)(lds + R1_SG), 136, nullptr, (bf16*)(ws + WS_RG), row0, lane, wave);
        if (l > 0) {
            { const int kq = lane >> 4, mt = wave & 1, ti = wave >> 1; f32x4 acc = {0.f, 0.f, 0.f, 0.f};
#pragma unroll
              for (int s = 0; s < 12; ++s) acc = __builtin_amdgcn_mfma_f32_16x16x32_bf16(__builtin_bit_cast(bf16x8, *(const GAS v4u*)(WV + (size_t)(16 * mt + (lane & 15)) * 384 + 32 * s + 8 * kq)),
                                                                                          *(const LAS bf16x8*)(lds + R1_VS + ((16 * ti + (lane & 15)) * 392 + 32 * s + 8 * kq) * 2), acc, 0, 0, 0);
              v2u w; w.x = pk2(acc[0], acc[1]); w.y = pk2(acc[2], acc[3]); *(LAS v2u*)(lds + R1_TMP + ((16 * ti + (lane & 15)) * 40 + 16 * mt + 4 * kq) * 2) = w; }
            __syncthreads();
            r1_prod<1, 1>(WV + 12288, (const LAS bf16*)(lds + R1_TMP), 40, a->in[I_RV0], (bf16*)(ws + WS_RVG), row0, lane, wave);
        }
    }
}
__device__ __forceinline__ float dpp_allsum(float x) {
    x += __builtin_bit_cast(float, __builtin_amdgcn_update_dpp(0, __builtin_bit_cast(int, x), 0x128, 0xf, 0xf, false));
    x += __builtin_bit_cast(float, __builtin_amdgcn_update_dpp(0, __builtin_bit_cast(int, x), 0x124, 0xf, 0xf, false));
    x += __builtin_bit_cast(float, __builtin_amdgcn_update_dpp(0, __builtin_bit_cast(int, x), 0x122, 0xf, 0xf, false));
    x += __builtin_bit_cast(float, __builtin_amdgcn_update_dpp(0, __builtin_bit_cast(int, x), 0x121, 0xf, 0xf, false));
    { const unsigned xi = __builtin_bit_cast(unsigned, x); auto r = __builtin_amdgcn_permlane16_swap(xi, xi, false, false); const unsigned r0 = r[0], r1 = r[1]; x = __uint_as_float(r0) + __uint_as_float(r1); }
    { const unsigned xi = __builtin_bit_cast(unsigned, x); auto r = __builtin_amdgcn_permlane32_swap(xi, xi, false, false); const unsigned r0 = r[0], r1 = r[1]; x = __uint_as_float(r0) + __uint_as_float(r1); }
    return x;
}

constexpr int RC_EF = 0, RC_ATF = 4096, RC_QF = 8448, RC_PFT = 9472, RC_AT = 10496, RC_RT = 12800, RC_BH = 15104, RC_KH = 17408, RC_AH = 19712, RC_BTT = 22016, RC_KTT = 25088, RC_VS = 28160,
              RC_PRL = 31232, RC_QRL = 32000, RC_TQL = 32768, RC_G15 = 33536, RC_CH = 33792;
struct RCRegs { v2u r0, r1, k0, k1, aa, ee, v0, v1, vg, vf, gg; };
__device__ __forceinline__ void rc_issue(const unsigned char* ws, int l, size_t row, int h, int tid, RCRegs& R) {
    const bf16* PROJ = (const bf16*)(ws + WS_PROJ); const int tt = tid >> 4, c0 = h * 64 + 4 * (tid & 15); const size_t r = row + tt; const bool first = (r % SEQ) == 0; const size_t rp = first ? r : r - 1;
    R.r0 = *(const GAS v2u*)(PROJ + r * NPROJ + PC_RW + RWC_R + c0); R.r1 = *(const GAS v2u*)(PROJ + rp * NPROJ + PC_RW + RWC_R + c0);
    R.k0 = *(const GAS v2u*)(PROJ + r * NPROJ + PC_RW + RWC_K + c0); R.k1 = *(const GAS v2u*)(PROJ + rp * NPROJ + PC_RW + RWC_K + c0);
    R.v0 = *(const GAS v2u*)(PROJ + r * NPROJ + PC_RW + RWC_V + c0); R.v1 = *(const GAS v2u*)(PROJ + rp * NPROJ + PC_RW + RWC_V + c0);
    R.aa = *(const GAS v2u*)((const bf16*)(ws + WS_RA) + r * DBR + c0); R.ee = *(const GAS v2u*)((const bf16*)(ws + WS_RE) + r * DBR + c0);
    R.gg = *(const GAS v2u*)((const bf16*)(ws + WS_RG) + r * DBR + c0);
    if (l > 0) { R.vg = *(const GAS v2u*)((const bf16*)(ws + WS_RVG) + r * DBR + c0); R.vf = *(const GAS v2u*)((const bf16*)(ws + WS_VF) + r * DBR + c0); }
    if (first) { R.r1 = (v2u){0u, 0u}; R.k1 = (v2u){0u, 0u}; R.v1 = (v2u){0u, 0u}; }
}
__device__ __forceinline__ void unpack4(const v2u p, float (&o)[4]) { o[0] = bflo(p.x); o[1] = bfhi(p.x); o[2] = bflo(p.y); o[3] = bfhi(p.y); }
__device__ __forceinline__ v2u pack4(const float (&v)[4]) { v2u o; o.x = pk2(v[0], v[1]); o.y = pk2(v[2], v[3]); return o; }
__device__ __forceinline__ v2u pack4v(const f32x4 v) { v2u o; o.x = pk2(v[0], v[1]); o.y = pk2(v[2], v[3]); return o; }
__device__ __forceinline__ bf16x8 cat8(const v2u a, const v2u b) { v4u o; o.x = a.x; o.y = a.y; o.z = b.x; o.w = b.y; return __builtin_bit_cast(bf16x8, o); }
#define RC_BAR() asm volatile("s_waitcnt lgkmcnt(0)\n\ts_barrier" ::: "memory")

constexpr int REC_BYTES = 12288, REC_UNITS = 752;
__device__ __forceinline__ unsigned char* rc_rec(unsigned char* ws, size_t cu) { return cu < 8192 ? ws + WS_OPA + cu * REC_BYTES : ws + WS_OPB + (cu - 8192) * REC_BYTES; }
__device__ __forceinline__ v4u rc_gather_unit(const LAS unsigned char* wb, int u) {
    v2u lo, hi;
    if (u < 256) { const int base = u < 128 ? RC_AH : RC_RT, uu = u & 127, row = uu >> 3, s = (uu >> 2) & 1, lq = uu & 3; const LAS unsigned char* p = wb + base + (row * 72 + 32 * s + 4 * lq) * 2;
        lo = *(const LAS v2u*)p; hi = *(const LAS v2u*)(p + 32); }
    else if (u < 512) { const int k = (u - 256) >> 2, lq = (u - 256) & 3; lo = *(const LAS v2u*)(wb + RC_BTT + (k * 24 + 4 * lq) * 2); hi = *(const LAS v2u*)(wb + RC_KTT + (k * 24 + 4 * lq) * 2); }
    else if (u < 576) { const int t = (u - 512) >> 2, lq = (u - 512) & 3; lo = *(const LAS v2u*)(wb + RC_PRL + (t * 24 + 4 * lq) * 2); hi = *(const LAS v2u*)(wb + RC_QRL + (t * 24 + 4 * lq) * 2); }
    else if (u < 608) { const LAS unsigned char* p = wb + RC_TQL + (((u - 576) >> 1) * 24 + 8 * ((u - 576) & 1)) * 2; lo = *(const LAS v2u*)p; hi = *(const LAS v2u*)(p + 8); }
    else if (u < 736) { const LAS unsigned char* p = wb + RC_VS + (((u - 608) >> 1) * 24 + 8 * ((u - 608) & 1)) * 2; lo = *(const LAS v2u*)p; hi = *(const LAS v2u*)(p + 8); }
    else { const LAS unsigned char* p = wb + RC_G15 + (u - 736) * 16; lo = *(const LAS v2u*)p; hi = *(const LAS v2u*)(p + 8); }
    v4u o; o.x = lo.x; o.y = lo.y; o.z = hi.x; o.w = hi.y; return o;
}
__device__ __forceinline__ void rc_copy_out(unsigned char* rec, const LAS unsigned char* wb, int u) {
#pragma unroll
    for (int q = 0; q < 3; ++q) { const int uu = u + 256 * q; if (uu < REC_UNITS) *(GAS v4u*)(rec + uu * 16) = rc_gather_unit(wb, uu); }
}
constexpr int RS_AH = 0, RS_RT = 2304, RS_BK = 4608, RS_PQ = 9728, RS_TQL = 11008, RS_VS = 11776, RS_G15 = 14848, RS_CH = 15360;
__device__ __forceinline__ int rs_unit_off(int u) {
    if (u < 128) return RS_AH + (u >> 3) * 144 + (u & 7) * 16;
    if (u < 256) return RS_RT + ((u - 128) >> 3) * 144 + (u & 7) * 16;
    if (u < 512) return RS_BK + ((u - 256) >> 2) * 80 + (u & 3) * 16;
    if (u < 576) return RS_PQ + ((u - 512) >> 2) * 80 + (u & 3) * 16;
    if (u < 608) return RS_TQL + ((u - 576) >> 1) * 48 + (u & 1) * 16;
    if (u < 736) return RS_VS + ((u - 608) >> 1) * 48 + (u & 1) * 16;
    return RS_G15 + (u - 736) * 16;
}
#define RC_BUILD(RUSE, q) do { const int bh_ = (q) % (NB * NH), b = bh_ / NH, h = bh_ % NH, blk_ = blk0 + (q) / (NB * NH), c0 = h * 64 + 4 * kq; const size_t row0 = (size_t)b * SEQ + (size_t)blk_ * 32; \
        float kkw[4], kaw[4], mur[4], muk[4], muv[4]; \
_Pragma("unroll") \
        for (int j = 0; j < 4; ++j) { kkw[j] = a->in[I_RKK][(size_t)l * DBR + c0 + j]; kaw[j] = a->in[I_RKA][(size_t)l * DBR + c0 + j]; mur[j] = mu[RWC_R + c0 + j]; muk[j] = mu[RWC_K + c0 + j]; muv[j] = mu[RWC_V + c0 + j]; } \
        float an[4], bk[4], km[4], rs[4], ev[4]; \
        {   const RCRegs& R = RUSE; \
            float rc[4], rp[4], kc[4], kp[4], av[4], vc[4], vp[4], ks[4], kk[4], vs[4]; unpack4(R.r0, rc); unpack4(R.r1, rp); unpack4(R.k0, kc); unpack4(R.k1, kp); unpack4(R.aa, av); unpack4(R.ee, ev); unpack4(R.v0, vc); unpack4(R.v1, vp); \
            float ss = 0.f; \
_Pragma("unroll") \
            for (int j = 0; j < 4; ++j) { rs[j] = rc[j] + mur[j] * (rp[j] - rc[j]); ks[j] = kc[j] + muk[j] * (kp[j] - kc[j]); kk[j] = ks[j] * kkw[j]; ss += kk[j] * kk[j]; vs[j] = vc[j] + muv[j] * (vp[j] - vc[j]); } \
            ss += __shfl_xor(ss, 1); ss += __shfl_xor(ss, 2); ss += __shfl_xor(ss, 4); ss += __shfl_xor(ss, 8); \
            const float inv = 1.f / fmaxf(sqrtf(ss), 1e-12f); \
_Pragma("unroll") \
            for (int j = 0; j < 4; ++j) { const float kn = kk[j] * inv; an[j] = -kn; bk[j] = kn * av[j]; km[j] = ks[j] * (1.f + (av[j] - 1.f) * kaw[j]); } \
            if (l == 0) *(GAS v2u*)((bf16*)(ws + WS_VF) + (row0 + tt) * DBR + c0) = pack4(vs); \
            else { float g[4], f[4]; unpack4(R.vg, g); unpack4(R.vf, f); \
_Pragma("unroll") \
                for (int j = 0; j < 4; ++j) vs[j] = vs[j] + (f[j] - vs[j]) * g[j]; } \
            {     \
                float gq[4], o1[4], o2[4]; unpack4(R.gg, gq); float rkp = 0.f; \
_Pragma("unroll") \
                for (int j = 0; j < 4; ++j) rkp += rs[j] * km[j] * a->in[I_RRK][(size_t)l * DBR + c0 + j]; \
                rkp += __shfl_xor(rkp, 1); rkp += __shfl_xor(rkp, 2); rkp += __shfl_xor(rkp, 4); rkp += __shfl_xor(rkp, 8); \
_Pragma("unroll") \
                for (int j = 0; j < 4; ++j) { o1[j] = a->in[I_RLNW][(size_t)l * DBR + c0 + j] * gq[j]; o2[j] = (a->in[I_RLNB][(size_t)l * DBR + c0 + j] + rkp * vs[j]) * gq[j]; } \
                if (ST12) { *(GAS v2u*)((bf16*)(ws + WS_RG) + (row0 + tt) * DBR + c0) = pack4(o1); *(GAS v2u*)((bf16*)(ws + WS_RA) + (row0 + tt) * DBR + c0) = pack4(o2); } } \
            *(LAS f32x4*)(cb + RC_EF + (t * 64 + 4 * kq) * 4) = (f32x4){ev[0], ev[1], ev[2], ev[3]}; \
_Pragma("unroll") \
            for (int j = 0; j < 4; ++j) *(LAS bf16*)(cb + RC_VS + ((4 * kq + j) * 24 + t) * 2) = (bf16)f2bf(vs[j]); \
        } \
        if ((q) + 2 * G < NQ) rc_issue_q(ws, l, (q) + 2 * G, blk0, tid, RUSE); \
        RC_BAR(); \
        {   f32x4 inc = {0.f, 0.f, 0.f, 0.f}, tot = inc; \
_Pragma("unroll") \
            for (int i = 0; i < 16; ++i) { const f32x4 ei = *(const LAS f32x4*)(cb + RC_EF + (i * 64 + 4 * kq) * 4); tot = tot + ei; if (i <= t) inc = inc + ei; } \
            float At[4], Rt[4], Bh[4], Kh[4], Bt[4], Kt[4], Gt[4]; \
_Pragma("unroll") \
            for (int j = 0; j < 4; ++j) { const float Gi = __expf(-inc[j]), Ge = __expf(ev[j] - inc[j]), Gn = __expf(inc[j]); Gt[j] = __expf(-tot[j]); \
                At[j] = an[j] * Ge; Rt[j] = rs[j] * Gi; Bh[j] = bk[j] * Gn; Kh[j] = km[j] * Gn; Bt[j] = Bh[j] * Gt[j]; Kt[j] = Kh[j] * Gt[j]; } \
            *(LAS f32x4*)(cb + RC_ATF + (t * 68 + 4 * kq) * 4) = (f32x4){At[0], At[1], At[2], At[3]}; \
            *(LAS v2u*)(cb + RC_AT + (t * 72 + 4 * kq) * 2) = pack4(At); *(LAS v2u*)(cb + RC_RT + (t * 72 + 4 * kq) * 2) = pack4(Rt); \
            *(LAS v2u*)(cb + RC_BH + (t * 72 + 4 * kq) * 2) = pack4(Bh); *(LAS v2u*)(cb + RC_KH + (t * 72 + 4 * kq) * 2) = pack4(Kh); \
_Pragma("unroll") \
            for (int j = 0; j < 4; ++j) { *(LAS bf16*)(cb + RC_BTT + ((4 * kq + j) * 24 + t) * 2) = (bf16)f2bf(Bt[j]); *(LAS bf16*)(cb + RC_KTT + ((4 * kq + j) * 24 + t) * 2) = (bf16)f2bf(Kt[j]); } \
            if (t == 0) *(LAS f32x4*)(cb + RC_G15 + 4 * kq * 4) = (f32x4){Gt[0], Gt[1], Gt[2], Gt[3]}; \
        } \
        RC_BAR(); \
        {   LAS unsigned char* wb = lds + (wave >> 2) * RC_CH; const int pi = wave & 3; \
            const LAS bf16* Ap = (const LAS bf16*)(wb + (pi < 2 ? RC_AT : RC_RT)) + li * 72 + 8 * lq; const LAS bf16* Bp = (const LAS bf16*)(wb + ((pi & 1) ? RC_KH : RC_BH)) + li * 72 + 8 * lq; \
            f32x4 acc = {0.f, 0.f, 0.f, 0.f}; \
            acc = __builtin_amdgcn_mfma_f32_16x16x32_bf16(*(const LAS bf16x8*)Ap, *(const LAS bf16x8*)Bp, acc, 0, 0, 0); \
            acc = __builtin_amdgcn_mfma_f32_16x16x32_bf16(*(const LAS bf16x8*)(Ap + 32), *(const LAS bf16x8*)(Bp + 32), acc, 0, 0, 0); \
_Pragma("unroll") \
            for (int r = 0; r < 4; ++r) { const int tr = 4 * lq + r; if (pi < 2 ? !(li < tr) : !(li <= tr)) acc[r] = 0.f; } \
            if (pi == 0) *(LAS f32x4*)(wb + RC_PFT + (li * 16 + 4 * lq) * 4) = acc; \
            else if (pi == 1) { \
_Pragma("unroll") \
                for (int r = 0; r < 4; ++r) *(LAS float*)(wb + RC_QF + ((4 * lq + r) * 16 + li) * 4) = acc[r]; } \
            else { LAS bf16* o = (LAS bf16*)(wb + (pi == 2 ? RC_PRL : RC_QRL)); \
_Pragma("unroll") \
                for (int r = 0; r < 4; ++r) o[(4 * lq + r) * 24 + li] = (bf16)f2bf(acc[r]); } \
        } \
        RC_BAR(); \
        if (wave < 4) { \
            LAS unsigned char* wb = lds + (wave >> 1) * RC_CH; const bool isq = wave & 1; \
            float X[16]; \
_Pragma("unroll") \
            for (int r = 0; r < 16; ++r) X[r] = isq ? *(const LAS float*)(wb + RC_QF + (r * 16 + li) * 4) : *(const LAS float*)(wb + RC_ATF + (r * 68 + lane) * 4); \
_Pragma("unroll") \
            for (int j = 0; j < 15; ++j) { const LAS f32x4* pc = (const LAS f32x4*)(wb + RC_PFT + j * 64); const f32x4 c0v = pc[0], c1v = pc[1], c2v = pc[2], c3v = pc[3]; \
                const float c[16] = {c0v[0], c0v[1], c0v[2], c0v[3], c1v[0], c1v[1], c1v[2], c1v[3], c2v[0], c2v[1], c2v[2], c2v[3], c3v[0], c3v[1], c3v[2], c3v[3]}; \
_Pragma("unroll") \
                for (int r = j + 1; r < 16; ++r) X[r] = fmaf(c[r], X[j], X[r]); } \
            if (!isq) { LAS bf16* o = (LAS bf16*)(wb + RC_AH); \
_Pragma("unroll") \
                for (int r = 0; r < 16; ++r) o[r * 72 + lane] = (bf16)f2bf(X[r]); } \
            else if (lane < 16) { LAS bf16* o = (LAS bf16*)(wb + RC_TQL); \
_Pragma("unroll") \
                for (int r = 0; r < 16; ++r) o[r * 24 + lane] = (bf16)f2bf(X[r]); } \
        } \
        RC_BAR(); \
        { const int cc = tid >> 8, u = tid & 255; unsigned char* rec = rc_rec(ws, (size_t)bh_ * 512 + 2 * blk_ + cc); const LAS unsigned char* wb = lds + cc * RC_CH; \
          rc_copy_out(rec, wb, u); } \
        RC_BAR(); \
    } while (0)
#ifndef RS_NT
#define RS_NT 1
#endif
constexpr int RS_TILES = RS_NT;
struct RSOps { bf16x8 a01, a23, r01, r23, tq, pq, bk[4]; v2u vb[RS_TILES]; f32x4 g[4]; };
__device__ __forceinline__ void rs_load(const LAS unsigned char* wb, int wave, int li, int lq, RSOps& O) {
    O.a01 = *(const LAS bf16x8*)(wb + RS_AH + li * 144 + lq * 16); O.a23 = *(const LAS bf16x8*)(wb + RS_AH + li * 144 + 64 + lq * 16);
    O.r01 = *(const LAS bf16x8*)(wb + RS_RT + li * 144 + lq * 16); O.r23 = *(const LAS bf16x8*)(wb + RS_RT + li * 144 + 64 + lq * 16);
    O.pq = *(const LAS bf16x8*)(wb + RS_PQ + li * 80 + lq * 16);
    { const v2u t = *(const LAS v2u*)(wb + RS_TQL + li * 48 + lq * 8); v4u o; o.x = t.x; o.y = t.y; o.z = 0u; o.w = 0u; O.tq = __builtin_bit_cast(bf16x8, o); }
#pragma unroll
    for (int vt = 0; vt < RS_TILES; ++vt) O.vb[vt] = *(const LAS v2u*)(wb + RS_VS + (16 * (RS_TILES * wave + vt) + li) * 48 + lq * 8);
#pragma unroll
    for (int kt = 0; kt < 4; ++kt) { O.bk[kt] = *(const LAS bf16x8*)(wb + RS_BK + (16 * kt + li) * 80 + lq * 16); O.g[kt] = *(const LAS f32x4*)(wb + RS_G15 + (16 * kt + 4 * lq) * 4); }
}
#define RC_CHUNK(O, cc, yb) do { const v2u z2_ = {0u, 0u}; \
_Pragma("unroll") \
        for (int vt = 0; vt < RS_TILES; ++vt) {     \
            f32x4 aD = {0.f, 0.f, 0.f, 0.f}, aY = {0.f, 0.f, 0.f, 0.f}; \
            aD = __builtin_amdgcn_mfma_f32_16x16x32_bf16(O.tq, cat8(O.vb[vt], z2_), aD, 0, 0, 0); \
            aD = __builtin_amdgcn_mfma_f32_16x16x32_bf16(O.a01, Sb01[vt], aD, 0, 0, 0); \
            aD = __builtin_amdgcn_mfma_f32_16x16x32_bf16(O.a23, Sb23[vt], aD, 0, 0, 0); \
            aY = __builtin_amdgcn_mfma_f32_16x16x32_bf16(Sb01[vt], O.r01, aY, 0, 0, 0); \
            aY = __builtin_amdgcn_mfma_f32_16x16x32_bf16(Sb23[vt], O.r23, aY, 0, 0, 0); \
            const bf16x8 DV = cat8(pack4v(aD), O.vb[vt]); \
_Pragma("unroll") \
            for (int kt = 0; kt < 4; ++kt) Sacc[vt][kt] = __builtin_amdgcn_mfma_f32_16x16x32_bf16(O.bk[kt], DV, Sacc[vt][kt] * O.g[kt], 0, 0, 0); \
            aY = __builtin_amdgcn_mfma_f32_16x16x32_bf16(DV, O.pq, aY, 0, 0, 0); \
            Sb01[vt] = cat8(pack4v(Sacc[vt][0]), pack4v(Sacc[vt][1])); Sb23[vt] = cat8(pack4v(Sacc[vt][2]), pack4v(Sacc[vt][3])); \
            *(LAS v2u*)((yb) + (((cc) * 16 + li) * 72 + 16 * (RS_TILES * wave + vt) + 4 * lq) * 2) = pack4v(aY);     \
        } \
    } while (0)
#define RC_SCAN(slot, yb) do { { RSOps O0; rs_load(slot, wave, li, lq, O0); __builtin_amdgcn_sched_barrier(0); RC_CHUNK(O0, 0, yb); } \
        { RSOps O1; rs_load(slot + RS_CH, wave, li, lq, O1); __builtin_amdgcn_sched_barrier(0); RC_CHUNK(O1, 1, yb); } } while (0)

__device__ __forceinline__ void rc_issue_q(const unsigned char* ws, int l, int q, int blk0, int tid, RCRegs& R) {
    const int bh = q % (NB * NH), blk = blk0 + q / (NB * NH);
    rc_issue(ws, l, (size_t)(bh / NH) * SEQ + (size_t)blk * 32, bh % NH, tid, R);
}
template <bool ST12 = true>
__device__ __forceinline__ void phase_r2_build(KArgsP a, LAS unsigned char* lds, int tid, int lane, int wave, int vcu, int G, int l, int blk0 = 0, int nblk = SEQ / 32) {
    unsigned char* ws = a->ws;
    const int tt = tid >> 4, kq = tid & 15, ch = tt >> 4, t = tt & 15;
    const int lq = lane >> 4, li = lane & 15;
    LAS unsigned char* cb = lds + ch * RC_CH;
    const float* mu = a->in[I_RMU] + (size_t)l * RW_COLS;
    const int NQ = NB * NH * nblk;
    RCRegs RA, RB;
    if (vcu < NQ) rc_issue_q(ws, l, vcu, blk0, tid, RA);
    if (vcu + G < NQ) rc_issue_q(ws, l, vcu + G, blk0, tid, RB);
    for (int q0 = vcu; q0 < NQ; q0 += 2 * G) { { const int q = q0; RC_BUILD(RA, q); } if (q0 + G < NQ) { const int q = q0 + G; RC_BUILD(RB, q); } }
}
#ifndef RS_DEPTH
#define RS_DEPTH 4
#endif
struct RSRegs { v4u p[6]; };
__device__ __forceinline__ unsigned char* ubase(const unsigned char* p) {
    const unsigned lo = __builtin_amdgcn_readfirstlane((unsigned)(uintptr_t)p), hi = __builtin_amdgcn_readfirstlane((unsigned)((uintptr_t)p >> 32));
    return (unsigned char*)(((uintptr_t)hi << 32) | lo);
}
struct RSOff { unsigned g[6], s[6]; };
__device__ __forceinline__ void rs_offsets(int lt, RSOff& F) {
#pragma unroll
    for (int j = 0; j < 6; ++j) { const int uu = min(lt + 256 * j, 2 * REC_UNITS - 1); const int cc = uu >= REC_UNITS, u = uu - cc * REC_UNITS;
        F.g[j] = uu * 16 + cc * (REC_BYTES - REC_UNITS * 16); F.s[j] = cc * RS_CH + rs_unit_off(u); }
}
__device__ __forceinline__ void rs_issue(unsigned char* ws, size_t cu0, const RSOff& F, RSRegs& R) {
    const unsigned char* base = ubase(rc_rec(ws, cu0));
#pragma unroll
    for (int j = 0; j < 6; ++j) R.p[j] = *(const GAS v4u*)(base + F.g[j]);
}
__device__ __forceinline__ void rs_store(LAS unsigned char* slot, const RSOff& F, const RSRegs& R) {
#pragma unroll
    for (int j = 0; j < 6; ++j) *(LAS v4u*)(slot + F.s[j]) = R.p[j];
}
struct R3Q { v4u a1, a2; };
__device__ __forceinline__ void r3q_issue(const unsigned char* ws, size_t row0, int h, int lt, R3Q& Q) {
    const unsigned off = (unsigned)(((lt >> 3) * DBR + 8 * (lt & 7)) * 2); const size_t ub = (row0 * DBR + h * 64) * 2;
    Q.a1 = *(const GAS v4u*)(ubase(ws + WS_RG + ub) + off); Q.a2 = *(const GAS v4u*)(ubase(ws + WS_RA + ub) + off);
}
__device__ __forceinline__ float dpp8sum(float x) {
    x += __builtin_bit_cast(float, __builtin_amdgcn_update_dpp(0, __builtin_bit_cast(int, x), 0xB1, 0xf, 0xf, false));
    x += __builtin_bit_cast(float, __builtin_amdgcn_update_dpp(0, __builtin_bit_cast(int, x), 0x4E, 0xf, 0xf, false));
    x += __builtin_bit_cast(float, __builtin_amdgcn_update_dpp(0, __builtin_bit_cast(int, x), 0x141, 0xf, 0xf, false));
    return x;
}
__device__ __forceinline__ void r3_block(const LAS unsigned char* yb, bf16* YC, size_t row0, int h, int lt, const R3Q& Q) {
    const int tk = lt >> 3, c8 = 8 * (lt & 7);
    const v4u yy = *(const LAS v4u*)(yb + (tk * 72 + c8) * 2);
    float d[8] = {bflo(yy.x), bfhi(yy.x), bflo(yy.y), bfhi(yy.y), bflo(yy.z), bfhi(yy.z), bflo(yy.w), bfhi(yy.w)};
    const float m = dpp8sum(((d[0] + d[1]) + (d[2] + d[3])) + ((d[4] + d[5]) + (d[6] + d[7]))) * (1.f / 64.f);
    float q = 0.f;
#pragma unroll
    for (int j = 0; j < 8; ++j) { d[j] -= m; q = fmaf(d[j], d[j], q); }
    const float rstd = rsqrtf(dpp8sum(q) * (1.f / 64.f) + RWKV_GN_EPS);
    const unsigned a1[4] = {Q.a1.x, Q.a1.y, Q.a1.z, Q.a1.w}, a2[4] = {Q.a2.x, Q.a2.y, Q.a2.z, Q.a2.w}; unsigned o[4];
#pragma unroll
    for (int j = 0; j < 4; ++j) o[j] = pk2(fmaf(d[2 * j] * rstd, bflo(a1[j]), bflo(a2[j])), fmaf(d[2 * j + 1] * rstd, bfhi(a1[j]), bfhi(a2[j])));
    v4u w; w.x = o[0]; w.y = o[1]; w.z = o[2]; w.w = o[3];
    *(GAS v4u*)(ubase((const unsigned char*)(YC + row0 * DM + 384 + h * 64)) + (unsigned)((tk * DM + c8) * 2)) = w;
}
template <int VAR = 0>
__device__ __forceinline__ void phase_r2_scan(KArgsP a, LAS unsigned char* lds, int tid, int lane, int wave, int wg, int l, int bsplit = SEQ / 32, unsigned nbuilders = 0u) {
    unsigned char* ws = a->ws; bf16* YC = (bf16*)(ws + WS_YC);
    const int b = wg / NH, h = wg % NH; const size_t rowb = (size_t)b * SEQ, cub = (size_t)wg * 512;
    const int lq = lane >> 4, li = lane & 15, lt = tid - 256; const bool loader = wave >= 4;
    f32x4 Sacc[RS_TILES][4]; bf16x8 Sb01[RS_TILES], Sb23[RS_TILES];
#pragma unroll
    for (int vt = 0; vt < RS_TILES; ++vt) {
#pragma unroll
        for (int kt = 0; kt < 4; ++kt) Sacc[vt][kt] = (f32x4){0.f, 0.f, 0.f, 0.f};
        Sb01[vt] = (bf16x8){0, 0, 0, 0, 0, 0, 0, 0}; Sb23[vt] = Sb01[vt]; }
    constexpr int NBLK = SEQ / 32;
    LAS unsigned char* yb0 = lds + 8 * RS_CH; LAS unsigned char* yb1 = yb0 + 32 * 72 * 2;
    static_assert(8 * RS_CH + 2 * 32 * 72 * 2 <= MISC_OFF, "scan LDS layout");
    if (wave < 4 / RS_TILES) {
        RSOps OA, OB;
        RC_BAR();
        rs_load(lds, wave, li, lq, OA);
#pragma unroll 1
        for (int X = 0; X < NBLK; ++X) {
            LAS unsigned char* sl = lds + (X & 3) * 2 * RS_CH; LAS unsigned char* sn = lds + ((X + 1) & 3) * 2 * RS_CH; LAS unsigned char* yb = yb0 + (X & 1) * (32 * 72 * 2);
            if (X == bsplit - 7 && wave == 0) {
                if (lane == 0) { unsigned* bar_ = (unsigned*)(ws + WS_CTL) + CW_BAR; unsigned* cnt_ = (unsigned*)(ws + WS_CTL) + CW_Q + 64 * l + 48; XB_SPIN(xb_ld(cnt_) < nbuilders, bar_); }
                __builtin_amdgcn_fence(__ATOMIC_ACQUIRE, "agent"); asm volatile("s_waitcnt vmcnt(0)" ::: "memory");
            }
            rs_load(sl + RS_CH, wave, li, lq, OB); __builtin_amdgcn_sched_barrier(0); if (VAR != 2) { RC_CHUNK(OA, 0, yb); } else { asm volatile("" :: "v"(OA.a01), "v"(OA.bk[3]), "v"(OA.g[3])); }
            rs_load(sn, wave, li, lq, OA); __builtin_amdgcn_sched_barrier(0); if (VAR != 2) { RC_CHUNK(OB, 1, yb); } else { asm volatile("" :: "v"(OB.a01), "v"(OB.bk[3]), "v"(OB.g[3])); }
            RC_BAR();
        }
    } else if (!loader) {
        RC_BAR();
        for (int X = 0; X < NBLK; ++X) RC_BAR();
    } else {
        constexpr int ND = 4;
        RSRegs R[ND]; R3Q Q[ND]; RSOff F; rs_offsets(lt, F);
#pragma unroll
        for (int j = 0; j < ND; ++j) { rs_issue(ws, cub + 2 * j, F, R[j]); r3q_issue(ws, rowb + 32 * j, h, lt, Q[j]); }
        rs_store(lds, F, R[0]); rs_issue(ws, cub + 2 * ND, F, R[0]); rs_store(lds + 2 * RS_CH, F, R[1]); rs_issue(ws, cub + 2 * (ND + 1), F, R[1]);
        RC_BAR();
        for (int bb = 0; bb < NBLK; bb += ND) {
#pragma unroll
            for (int j = 0; j < ND; ++j) { const int X = bb + j;
                if (VAR != 1) { r3_block((j & 1) ? yb0 : yb1, YC, rowb + (size_t)max(X - 1, 0) * 32, h, lt, Q[(j + ND - 1) % ND]);
                r3q_issue(ws, rowb + (size_t)min(X - 1 + ND, NBLK - 1) * 32, h, lt, Q[(j + ND - 1) % ND]); }
                rs_store(lds + ((j + 2) & 3) * 2 * RS_CH, F, R[(j + 2) % ND]);
                rs_issue(ws, cub + 2 * (size_t)min(X + 2 + ND, NBLK - 1), F, R[(j + 2) % ND]);
                RC_BAR();
            }
        }
        r3_block(yb1, YC, rowb + (size_t)(NBLK - 1) * 32, h, lt, Q[(NBLK - 1) % ND]);
    }
}
__device__ __forceinline__ void phase_r3(KArgsP a, int lane, int gw, int ngw, int l) {
    unsigned char* ws = a->ws; const bf16* PROJ = (const bf16*)(ws + WS_PROJ); bf16* YC = (bf16*)(ws + WS_YC);
    const bf16* RA = (const bf16*)(ws + WS_RA); const bf16* RG = (const bf16*)(ws + WS_RG); const bf16* RVG = (const bf16*)(ws + WS_RVG); const bf16* VF = (const bf16*)(ws + WS_VF);
    const float* mu = a->in[I_RMU] + (size_t)l * RW_COLS;
    for (size_t row = gw; row < NTOK; row += ngw) {
#pragma unroll
        for (int h = 0; h < NH; ++h) {
            const int c = h * 64 + lane;
            const float y = bf2f(YC[row * DM + 384 + c]);
            const float m = dpp_allsum(y) * (1.f / 64.f); const float d = y - m; const float var = dpp_allsum(d * d) * (1.f / 64.f);
            const float yn = d * rsqrtf(var + RWKV_GN_EPS) * a->in[I_RLNW][l * DBR + c] + a->in[I_RLNB][l * DBR + c];
            const float rs = rw_shift(PROJ, mu, row, RWC_R + c), ks = rw_shift(PROJ, mu, row, RWC_K + c); float v = rw_shift(PROJ, mu, row, RWC_V + c);
            if (l > 0) v = v + (bf2f(VF[row * DBR + c]) - v) * bf2f(RVG[row * DBR + c]);
            const float av = bf2f(RA[row * DBR + c]);
            const float km = ks * (1.f + (av - 1.f) * a->in[I_RKA][l * DBR + c]);
            const float rk = dpp_allsum(rs * km * a->in[I_RRK][l * DBR + c]);
            YC[row * DM + 384 + c] = (bf16)f2bf((yn + rk * v) * bf2f(RG[row * DBR + c]));
        }
    }
}

constexpr int PH_PER_LAYER = 10, PH_FINAL = 1 + 2 * PH_PER_LAYER, N_PHASES = PH_FINAL + 1;
constexpr int R2_WGS = 24;
__global__ void __launch_bounds__(NTHR, 2) fwd(Args args) {
    extern __shared__ __attribute__((aligned(16))) unsigned char lds_raw[];
    LAS unsigned char* lds = (LAS unsigned char*)lds_raw;
    volatile LAS unsigned* MISC = (volatile LAS unsigned*)(lds + MISC_OFF);
    const int tid0 = threadIdx.x;
    const int G = gridDim.x;
#define PHASE_IDS int tid_ = threadIdx.x; asm volatile("" : "+v"(tid_)); const int tid = tid_, lane = tid & 63, wave = __builtin_amdgcn_readfirstlane(tid >> 6); \
    int bx_ = blockIdx.x; asm volatile("" : "+s"(bx_)); const int bx = bx_; const int vcu = (G % 8 == 0) ? (bx % 8) * (G / 8) + bx / 8 : bx; (void)lane; (void)wave; (void)vcu; (void)bx;
    unsigned char* ws0 = fresh_args()->ws;
    for (int u = tid0; u < (LDS_BYTES - RING_BYTES) / 4; u += NTHR) ((LAS unsigned*)(lds + RING_BYTES))[u] = 0u;
    __syncthreads();
    XcdBarrier bar; bar.bar = (unsigned*)(ws0 + WS_CTL) + CW_BAR; bar.x = 0; bar.st = nullptr;
    if (!MK_PER_PHASE) bar = xcd_barrier_post((unsigned*)(ws0 + WS_CTL) + CW_BAR, MISC + 8);
#if MK_PER_PHASE
    const int lo = args.ph_lo, hi = args.ph_hi;
#define IN(k) (lo <= (k) && (k) < hi)
#else
#define IN(k) true
#endif
#define SEAM(k) do { if (IN(k) && IN((k) + 1)) { XcdBarrier b2 = bar; asm volatile("" : "+s"(b2.bar)); xcd_barrier(b2); } } while (0)

#ifndef GEMM_SP2
#define GEMM_SP2 true
#endif
#ifndef GEMM_ALIGN
#define GEMM_ALIGN true
#endif
#ifndef RS_DEPTH
#define RS_DEPTH 4
#endif
#ifndef R2_SPLIT
#define R2_SPLIT 160
#endif
#ifndef SCANVAR
#define SCANVAR 0
#endif
#ifndef DBL_SUB
#define DBL_SUB 0
#endif
#ifndef DBL_PHASE
#define DBL_PHASE (-1)
#endif
#ifndef REPN
#define REPN 2
#endif
#define SUBREP(k) _Pragma("nounroll") for (int q_ = 0; q_ < 1 + (REPN - 1) * (((k) == DBL_SUB) && l == 0); ++q_)
#define REP(k) for (int rep_ = 0; rep_ < ((k) == DBL_PHASE ? REPN : 1); ++rep_)
#define REPBAR if (rep_ > 0) { XcdBarrier b2 = bar; asm volatile("" : "+s"(b2.bar)); xcd_barrier(b2); }
    REP(0) if (IN(0)) { REPBAR KArgsP ap = fresh_args(); PHASE_IDS
_Pragma("nounroll")
 for (int q_ = 0; q_ < 1 + (REPN - 1) * (DBL_SUB == 12); ++q_) { phase_prologue(ap, lds, tid, lane, wave, vcu, G); __syncthreads(); } }
    SEAM(0);
#ifdef EXTRA_BAR
    for (int eb_ = 0; eb_ < EXTRA_BAR; ++eb_) { XcdBarrier b2 = bar; asm volatile("" : "+s"(b2.bar)); xcd_barrier(b2); }
#endif
#define LCONST 0
    {
        constexpr int l = LCONST; constexpr int pb = 1 + l * PH_PER_LAYER;
        REP(pb + 0) if (IN(pb + 0)) { REPBAR KArgsP ap = fresh_args(); PHASE_IDS unsigned char* ws = ap->ws; (void)ws;
            if (l == 0) { mod_finalize(ws, tid, G); SUBREP(6) { phase_rownorm<0, false>(ap, lds, tid, lane, wave, G, ap->in[I_X], ap->out, ap->in[I_NORM_MIX], true, 0, 0, 0); __syncthreads(); } }
            else {
#if EN_MOE
                phase_rownorm<0, true>(ap, lds, tid, lane, wave, G, ap->out, ap->out, ap->in[I_NORM_MIX] + l * DM, false, l, 0, l - 1);
#else
                phase_rownorm<0, false>(ap, lds, tid, lane, wave, G, ap->out, ap->out, ap->in[I_NORM_MIX] + l * DM, false, l, 0, l - 1);
#endif
            }
        }
        SEAM(pb + 0);
        REP(pb + 1) if (IN(pb + 1)) { REPBAR KArgsP ap = fresh_args(); PHASE_IDS unsigned char* ws = ap->ws; (void)ws;
            pg8::Gemm g{(const pg8::bf16_t*)(ws + WS_HN), (const pg8::bf16_t*)(ws + WS_WIN) + (size_t)l * NPROJ_PAD * DM, NTOK, NPROJ_PAD, DM};
            pg8::StaticOrder S; S.init(NTOK, NPROJ_PAD, G, bx);
            pg8::EpiProj E{(pg8::bf16_t*)(ws + WS_PROJ), (float*)(ws + WS_GATES)};
SUBREP(7) { pg8::gemm_phase<pg8::EpiProj, pg8::StaticOrder, GEMM_ALIGN, GEMM_SP2>(lds, g, S, E); __syncthreads(); }
        }
        SEAM(pb + 1);
        REP(pb + 2) if (IN(pb + 2)) { REPBAR KArgsP ap = fresh_args(); PHASE_IDS unsigned char* ws = ap->ws; (void)ws;
#if EN_MLSTM
            for (int q_ = 0; q_ < 1 + (REPN - 1) * ((DBL_SUB == 1) && l == 0); ++q_) { phase_m1(ap, lds, tid, lane, wave, vcu, G, l); __syncthreads(); }
            __syncthreads();
#endif
#if EN_S5
            phase_s1(ap, lds, tid, lane, wave, vcu, G, l); __syncthreads();
#if DBL_SUB == 2
            if (l == 0) { phase_s1(ap, lds, tid, lane, wave, vcu, G, l); __syncthreads(); phase_s1(ap, lds, tid, lane, wave, vcu, G, l); __syncthreads(); phase_s1(ap, lds, tid, lane, wave, vcu, G, l); __syncthreads(); phase_s1(ap, lds, tid, lane, wave, vcu, G, l); __syncthreads(); }
#endif
            __syncthreads();
#endif
#if EN_RWKV
            for (int q_ = 0; q_ < 1 + (REPN - 1) * ((DBL_SUB == 3) && l == 0); ++q_) { phase_r1(ap, lds, tid, lane, wave, vcu, G, l); __syncthreads(); }
#endif
        }
        SEAM(pb + 2);
        REP(pb + 3) if (IN(pb + 3)) { REPBAR KArgsP ap = fresh_args(); PHASE_IDS unsigned char* ws = ap->ws; (void)ws;
            phase_m2(ws, tid, vcu, G);
            phase_s2(ap, tid, vcu, G, l);
            __syncthreads();
            phase_r2_build(ap, lds, tid, lane, wave, vcu, G, l, 0, R2_SPLIT);
        }
        SEAM(pb + 3);
        REP(pb + 4) if (IN(pb + 4)) { REPBAR KArgsP ap = fresh_args(); PHASE_IDS unsigned char* ws = ap->ws; (void)ws;
            if (bx < R2_WGS) {
#if DBL_SUB == 4
                if (l == 0) { for (int q_ = 0; q_ < REPN - 1; ++q_) { phase_r2_scan<SCANVAR>(ap, lds, tid, lane, wave, bx, l, R2_SPLIT, (unsigned)(G - R2_WGS)); __syncthreads(); } }
#endif
                phase_r2_scan(ap, lds, tid, lane, wave, bx, l, R2_SPLIT, (unsigned)(G - R2_WGS)); __syncthreads(); }
            else {
                phase_r2_build(ap, lds, tid, lane, wave, bx - R2_WGS, G - R2_WGS, l, R2_SPLIT, SEQ / 32 - R2_SPLIT);
                asm volatile("s_waitcnt vmcnt(0)" ::: "memory"); __syncthreads();
                if (tid == 0) { __builtin_amdgcn_fence(__ATOMIC_RELEASE, "agent"); asm volatile("s_waitcnt vmcnt(0)" ::: "memory"); (void)xb_add((unsigned*)(ws + WS_CTL) + CW_Q + 64 * l + 48, 1u); }
                phase_s3(ap, lds, tid, lane, wave, 0, 1, l, (unsigned*)(ws + WS_CTL) + CW_Q + 64 * l + 32); __syncthreads();
            }
            {
                unsigned* qctr = (unsigned*)(ws + WS_CTL) + CW_Q + 64 * l; volatile LAS unsigned* qw = (volatile LAS unsigned*)(lds + MISC_OFF) + 16;
                unsigned nxt = 0u; if (tid == 0) nxt = __hip_atomic_fetch_add(qctr, 1u, __ATOMIC_RELAXED, __HIP_MEMORY_SCOPE_AGENT);
                for (;;) {
                    if (tid == 0) *qw = nxt;
                    __syncthreads();
                    const int u = (int)*qw;
                    __syncthreads();
                    if (u >= NUNIT_M) break;
                    if (tid == 0) nxt = __hip_atomic_fetch_add(qctr, 1u, __ATOMIC_RELAXED, __HIP_MEMORY_SCOPE_AGENT);
                    phase_m3(ap, lds, tid, lane, wave, u, NUNIT_M, l);
                }
            }
        }
        SEAM(pb + 4);
        REP(pb + 6) if (IN(pb + 6)) { REPBAR KArgsP ap = fresh_args(); PHASE_IDS unsigned char* ws = ap->ws; (void)ws;
            pg8::Gemm g{(const pg8::bf16_t*)(ws + WS_YC), (const pg8::bf16_t*)(ws + WS_WOUT) + (size_t)l * DM * DM, NTOK, DM, DM};
            pg8::StaticOrder S; S.init(NTOK, DM, G, bx);
            pg8::EpiResid E{l == 0 ? ap->in[I_X] : (const float*)ap->out, ap->out, (const float*)(ws + WS_MODF) + (size_t)l * 4 * 6144, 2048};
SUBREP(8) { pg8::gemm_phase<pg8::EpiResid, pg8::StaticOrder, GEMM_ALIGN, GEMM_SP2>(lds, g, S, E); __syncthreads(); }
        }
        SEAM(pb + 6);
#if EN_MOE
        REP(pb + 7) if (IN(pb + 7)) { REPBAR KArgsP ap = fresh_args(); PHASE_IDS phase_router(ap, lds, tid, lane, wave, G, l); __syncthreads();
            SUBREP(11) {
            moe_convert13(ap->in[I_MW1], ap->in[I_MW3], l, (bf16*)(ap->ws + WS_W13), vcu * NWAVES + wave, G * NWAVES, (LAS float*)(lds + wave * 16640), lane);
            moe_convert2(ap->in[I_MW2], l, (bf16*)(ap->ws + WS_W2), vcu * NWAVES + wave, G * NWAVES, (LAS float*)(lds + wave * 16640), lane); __syncthreads(); } }
        SEAM(pb + 7);
        REP(pb + 8) if (IN(pb + 8)) { REPBAR KArgsP ap = fresh_args(); PHASE_IDS unsigned char* ws = ap->ws; (void)ws;
            LAS int* ptab = (LAS int*)(lds + PTAB_OFF); LAS int* pst = ptab + 512; LAS int* cnt = pst + 32;
            build_ptab((const unsigned*)(ws + WS_CTL) + CW_CNT + l * 32, ptab, pst, cnt, tid);
            pg8::Gemm g{(const pg8::bf16_t*)(ws + WS_HN), (const pg8::bf16_t*)(ws + WS_W13), 0, 0, DM, (const int*)(ws + WS_LIST), ptab};
            pg8::MoeOrder S{ptab, G, vcu};
            pg8::EpiSwiglu E{(pg8::bf16_t*)(ws + WS_HMID)};
SUBREP(9) { pg8::gemm_phase<pg8::EpiSwiglu, pg8::MoeOrder, false, true, true>(lds, g, S, E); __syncthreads(); }
        }
        SEAM(pb + 8);
        REP(pb + 9) if (IN(pb + 9)) { REPBAR KArgsP ap = fresh_args(); PHASE_IDS unsigned char* ws = ap->ws; (void)ws;
            LAS int* ptab = (LAS int*)(lds + PTAB_OFF); LAS int* pst = ptab + 512; LAS int* cnt = pst + 32;
            build_ptab((const unsigned*)(ws + WS_CTL) + CW_CNT + l * 32, ptab, pst, cnt, tid);
            pg8::Gemm g{(const pg8::bf16_t*)(ws + WS_HMID), (const pg8::bf16_t*)(ws + WS_W2), 0, 0, DEXP};
            pg8::MoeOrder S{ptab, G, vcu};
            pg8::EpiMoeOut E{(pg8::bf16_t*)(ws + WS_YMOE), (const int*)(ws + WS_LIST), ptab};
SUBREP(10) { pg8::gemm_phase<pg8::EpiMoeOut, pg8::MoeOrder, true, true>(lds, g, S, E); __syncthreads(); }
        }
        SEAM(pb + 9);
#else
        SEAM(pb + 6); SEAM(pb + 7); SEAM(pb + 8); SEAM(pb + 9);
#endif
    }
#undef LCONST
#if N_LAYERS > 1
#define LCONST 1
    {
        constexpr int l = LCONST; constexpr int pb = 1 + l * PH_PER_LAYER;
        REP(pb + 0) if (IN(pb + 0)) { REPBAR KArgsP ap = fresh_args(); PHASE_IDS unsigned char* ws = ap->ws; (void)ws;
            if (l == 0) { mod_finalize(ws, tid, G); SUBREP(6) { phase_rownorm<0, false>(ap, lds, tid, lane, wave, G, ap->in[I_X], ap->out, ap->in[I_NORM_MIX], true, 0, 0, 0); __syncthreads(); } }
            else {
#if EN_MOE
                phase_rownorm<0, true>(ap, lds, tid, lane, wave, G, ap->out, ap->out, ap->in[I_NORM_MIX] + l * DM, false, l, 0, l - 1);
#else
                phase_rownorm<0, false>(ap, lds, tid, lane, wave, G, ap->out, ap->out, ap->in[I_NORM_MIX] + l * DM, false, l, 0, l - 1);
#endif
            }
        }
        SEAM(pb + 0);
        REP(pb + 1) if (IN(pb + 1)) { REPBAR KArgsP ap = fresh_args(); PHASE_IDS unsigned char* ws = ap->ws; (void)ws;
            pg8::Gemm g{(const pg8::bf16_t*)(ws + WS_HN), (const pg8::bf16_t*)(ws + WS_WIN) + (size_t)l * NPROJ_PAD * DM, NTOK, NPROJ_PAD, DM};
            pg8::StaticOrder S; S.init(NTOK, NPROJ_PAD, G, bx);
            pg8::EpiProj E{(pg8::bf16_t*)(ws + WS_PROJ), (float*)(ws + WS_GATES)};
SUBREP(7) { pg8::gemm_phase<pg8::EpiProj, pg8::StaticOrder, GEMM_ALIGN, GEMM_SP2>(lds, g, S, E); __syncthreads(); }
        }
        SEAM(pb + 1);
        REP(pb + 2) if (IN(pb + 2)) { REPBAR KArgsP ap = fresh_args(); PHASE_IDS unsigned char* ws = ap->ws; (void)ws;
#if EN_MLSTM
            for (int q_ = 0; q_ < 1 + (REPN - 1) * ((DBL_SUB == 1) && l == 0); ++q_) { phase_m1(ap, lds, tid, lane, wave, vcu, G, l); __syncthreads(); }
            __syncthreads();
#endif
#if EN_S5
            phase_s1(ap, lds, tid, lane, wave, vcu, G, l); __syncthreads();
#if DBL_SUB == 2
            if (l == 0) { phase_s1(ap, lds, tid, lane, wave, vcu, G, l); __syncthreads(); phase_s1(ap, lds, tid, lane, wave, vcu, G, l); __syncthreads(); phase_s1(ap, lds, tid, lane, wave, vcu, G, l); __syncthreads(); phase_s1(ap, lds, tid, lane, wave, vcu, G, l); __syncthreads(); }
#endif
            __syncthreads();
#endif
#if EN_RWKV
            for (int q_ = 0; q_ < 1 + (REPN - 1) * ((DBL_SUB == 3) && l == 0); ++q_) { phase_r1(ap, lds, tid, lane, wave, vcu, G, l); __syncthreads(); }
#endif
        }
        SEAM(pb + 2);
        REP(pb + 3) if (IN(pb + 3)) { REPBAR KArgsP ap = fresh_args(); PHASE_IDS unsigned char* ws = ap->ws; (void)ws;
            phase_m2(ws, tid, vcu, G);
            phase_s2(ap, tid, vcu, G, l);
            __syncthreads();
            phase_r2_build(ap, lds, tid, lane, wave, vcu, G, l, 0, R2_SPLIT);
        }
        SEAM(pb + 3);
        REP(pb + 4) if (IN(pb + 4)) { REPBAR KArgsP ap = fresh_args(); PHASE_IDS unsigned char* ws = ap->ws; (void)ws;
            if (bx < R2_WGS) {
#if DBL_SUB == 4
                if (l == 0) { for (int q_ = 0; q_ < REPN - 1; ++q_) { phase_r2_scan<SCANVAR>(ap, lds, tid, lane, wave, bx, l, R2_SPLIT, (unsigned)(G - R2_WGS)); __syncthreads(); } }
#endif
                phase_r2_scan(ap, lds, tid, lane, wave, bx, l, R2_SPLIT, (unsigned)(G - R2_WGS)); __syncthreads(); }
            else {
                phase_r2_build(ap, lds, tid, lane, wave, bx - R2_WGS, G - R2_WGS, l, R2_SPLIT, SEQ / 32 - R2_SPLIT);
                asm volatile("s_waitcnt vmcnt(0)" ::: "memory"); __syncthreads();
                if (tid == 0) { __builtin_amdgcn_fence(__ATOMIC_RELEASE, "agent"); asm volatile("s_waitcnt vmcnt(0)" ::: "memory"); (void)xb_add((unsigned*)(ws + WS_CTL) + CW_Q + 64 * l + 48, 1u); }
                phase_s3(ap, lds, tid, lane, wave, 0, 1, l, (unsigned*)(ws + WS_CTL) + CW_Q + 64 * l + 32); __syncthreads();
            }
            {
                unsigned* qctr = (unsigned*)(ws + WS_CTL) + CW_Q + 64 * l; volatile LAS unsigned* qw = (volatile LAS unsigned*)(lds + MISC_OFF) + 16;
                unsigned nxt = 0u; if (tid == 0) nxt = __hip_atomic_fetch_add(qctr, 1u, __ATOMIC_RELAXED, __HIP_MEMORY_SCOPE_AGENT);
                for (;;) {
                    if (tid == 0) *qw = nxt;
                    __syncthreads();
                    const int u = (int)*qw;
                    __syncthreads();
                    if (u >= NUNIT_M) break;
                    if (tid == 0) nxt = __hip_atomic_fetch_add(qctr, 1u, __ATOMIC_RELAXED, __HIP_MEMORY_SCOPE_AGENT);
                    phase_m3(ap, lds, tid, lane, wave, u, NUNIT_M, l);
                }
            }
        }
        SEAM(pb + 4);
        REP(pb + 6) if (IN(pb + 6)) { REPBAR KArgsP ap = fresh_args(); PHASE_IDS unsigned char* ws = ap->ws; (void)ws;
            pg8::Gemm g{(const pg8::bf16_t*)(ws + WS_YC), (const pg8::bf16_t*)(ws + WS_WOUT) + (size_t)l * DM * DM, NTOK, DM, DM};
            pg8::StaticOrder S; S.init(NTOK, DM, G, bx);
            pg8::EpiResid E{l == 0 ? ap->in[I_X] : (const float*)ap->out, ap->out, (const float*)(ws + WS_MODF) + (size_t)l * 4 * 6144, 2048};
SUBREP(8) { pg8::gemm_phase<pg8::EpiResid, pg8::StaticOrder, GEMM_ALIGN, GEMM_SP2>(lds, g, S, E); __syncthreads(); }
        }
        SEAM(pb + 6);
#if EN_MOE
        REP(pb + 7) if (IN(pb + 7)) { REPBAR KArgsP ap = fresh_args(); PHASE_IDS phase_router(ap, lds, tid, lane, wave, G, l); __syncthreads();
            SUBREP(11) {
            moe_convert13(ap->in[I_MW1], ap->in[I_MW3], l, (bf16*)(ap->ws + WS_W13), vcu * NWAVES + wave, G * NWAVES, (LAS float*)(lds + wave * 16640), lane);
            moe_convert2(ap->in[I_MW2], l, (bf16*)(ap->ws + WS_W2), vcu * NWAVES + wave, G * NWAVES, (LAS float*)(lds + wave * 16640), lane); __syncthreads(); } }
        SEAM(pb + 7);
        REP(pb + 8) if (IN(pb + 8)) { REPBAR KArgsP ap = fresh_args(); PHASE_IDS unsigned char* ws = ap->ws; (void)ws;
            LAS int* ptab = (LAS int*)(lds + PTAB_OFF); LAS int* pst = ptab + 512; LAS int* cnt = pst + 32;
            build_ptab((const unsigned*)(ws + WS_CTL) + CW_CNT + l * 32, ptab, pst, cnt, tid);
            pg8::Gemm g{(const pg8::bf16_t*)(ws + WS_HN), (const pg8::bf16_t*)(ws + WS_W13), 0, 0, DM, (const int*)(ws + WS_LIST), ptab};
            pg8::MoeOrder S{ptab, G, vcu};
            pg8::EpiSwiglu E{(pg8::bf16_t*)(ws + WS_HMID)};
SUBREP(9) { pg8::gemm_phase<pg8::EpiSwiglu, pg8::MoeOrder, false, true, true>(lds, g, S, E); __syncthreads(); }
        }
        SEAM(pb + 8);
        REP(pb + 9) if (IN(pb + 9)) { REPBAR KArgsP ap = fresh_args(); PHASE_IDS unsigned char* ws = ap->ws; (void)ws;
            LAS int* ptab = (LAS int*)(lds + PTAB_OFF); LAS int* pst = ptab + 512; LAS int* cnt = pst + 32;
            build_ptab((const unsigned*)(ws + WS_CTL) + CW_CNT + l * 32, ptab, pst, cnt, tid);
            pg8::Gemm g{(const pg8::bf16_t*)(ws + WS_HMID), (const pg8::bf16_t*)(ws + WS_W2), 0, 0, DEXP};
            pg8::MoeOrder S{ptab, G, vcu};
            pg8::EpiMoeOut E{(pg8::bf16_t*)(ws + WS_YMOE), (const int*)(ws + WS_LIST), ptab};
SUBREP(10) { pg8::gemm_phase<pg8::EpiMoeOut, pg8::MoeOrder, true, true>(lds, g, S, E); __syncthreads(); }
        }
        SEAM(pb + 9);
#else
        SEAM(pb + 6); SEAM(pb + 7); SEAM(pb + 8); SEAM(pb + 9);
#endif
    }
#undef LCONST
#endif
    if (IN(PH_FINAL)) { KArgsP ap = fresh_args(); PHASE_IDS
#if EN_MOE
        if (N_LAYERS > 0) phase_rownorm<1, true>(ap, lds, tid, lane, wave, G, ap->out, ap->out, ap->in[I_NORM_FINAL], false, 0, 0, N_LAYERS - 1);
        else phase_rownorm<1, false>(ap, lds, tid, lane, wave, G, ap->in[I_X], ap->out, ap->in[I_NORM_FINAL], false, 0, 0, 0);
#else
        phase_rownorm<1, false>(ap, lds, tid, lane, wave, G, N_LAYERS > 0 ? (const float*)ap->out : ap->in[I_X], ap->out, ap->in[I_NORM_FINAL], false, 0, 0, 0);
#endif
    }
#undef IN
#undef SEAM
}

extern "C" void kernel_launch(void* const* d_in, const int* in_sizes, int n_in, void* d_out, int out_size, void* d_ws, size_t ws_size, hipStream_t stream) {
    static int grid = 0;
    if (grid == 0) {
        if (n_in != 47 || out_size != NTOK * DM || ws_size < WS_END) { fprintf(stderr, "kernel_launch: unexpected problem (n_in %d, out %d, ws %zu < %zu)\n", n_in, out_size, ws_size, (size_t)WS_END); grid = -1; return; }
        int dev = 0, cus = 0, per_cu = 0;
        if (hipGetDevice(&dev) != hipSuccess || hipDeviceGetAttribute(&cus, hipDeviceAttributeMultiprocessorCount, dev) != hipSuccess) { grid = -1; return; }
        if (hipFuncSetAttribute((const void*)fwd, hipFuncAttributeMaxDynamicSharedMemorySize, LDS_BYTES) != hipSuccess) { fprintf(stderr, "kernel_launch: hipFuncSetAttribute failed\n"); grid = -1; return; }
        if (hipOccupancyMaxActiveBlocksPerMultiprocessor(&per_cu, (const void*)fwd, NTHR, LDS_BYTES) != hipSuccess || per_cu < 1) fprintf(stderr, "kernel_launch: occupancy query says %d\n", per_cu);
        (void)hipGetLastError();
        grid = cus;
        if (grid != 256) fprintf(stderr, "kernel_launch: %d CUs (built for 256)\n", grid);
    }
    if (grid < 0) return;
    (void)hipMemsetAsync((char*)d_ws + WS_CTL, 0, CTL_ZERO_BYTES, stream);
    Args a{};
    for (int i = 0; i < 47; ++i) a.in[i] = (const float*)d_in[i];
    a.out = (float*)d_out; a.ws = (unsigned char*)d_ws;
#if MK_PER_PHASE
    for (int p = 0; p < N_PHASES; ++p) { a.ph_lo = p; a.ph_hi = p + 1; hipLaunchKernelGGL(fwd, dim3(grid), dim3(NTHR), LDS_BYTES, stream, a); }
#else
    a.ph_lo = 0; a.ph_hi = N_PHASES; hipLaunchKernelGGL(fwd, dim3(grid), dim3(NTHR), LDS_BYTES, stream, a);
#endif
}
#ifdef DIAG_KERNELS
#define DK(name, ...) __global__ void __launch_bounds__(NTHR, 2) name(Args args) { extern __shared__ __attribute__((aligned(16))) unsigned char lds_raw[]; LAS unsigned char* lds = (LAS unsigned char*)lds_raw; \
    const int tid = threadIdx.x, lane = tid & 63, wave = __builtin_amdgcn_readfirstlane(tid >> 6); const int G = gridDim.x; const int bx = blockIdx.x; const int vcu = bx; KArgsP ap = fresh_args(); int l = ap->ph_lo; (void)lane; (void)wave; (void)vcu; (void)G; (void)l; __VA_ARGS__ }
DK(k_prologue, phase_prologue(ap, lds, tid, lane, wave, vcu, G);)
DK(k_norm0, phase_rownorm<0, false>(ap, lds, tid, lane, wave, G, ap->in[I_X], ap->out, ap->in[I_NORM_MIX], true, 0, 0, 0);)
DK(k_norm1, phase_rownorm<0, true>(ap, lds, tid, lane, wave, G, ap->out, ap->out, ap->in[I_NORM_MIX], false, l, 0, 0);)
DK(k_normf, phase_rownorm<1, true>(ap, lds, tid, lane, wave, G, ap->out, ap->out, ap->in[I_NORM_MIX], false, l, 0, 0);)
DK(k_m1, phase_m1(ap, lds, tid, lane, wave, vcu, G, l);)
DK(k_m2, phase_m2(ap->ws, tid, vcu, G);)
DK(k_m3, phase_m3(ap, lds, tid, lane, wave, vcu, G, l);)
DK(k_s1, phase_s1(ap, lds, tid, lane, wave, vcu, G, l);)
DK(k_s2, phase_s2(ap, tid, vcu, G, l);)
DK(k_s3, phase_s3(ap, lds, tid, lane, wave, vcu, G, l);)
DK(k_r1, phase_r1(ap, lds, tid, lane, wave, vcu, G, l);)
DK(k_r2b, phase_r2_build(ap, lds, tid, lane, wave, vcu, G, l);)
DK(k_r2s, phase_r2_scan(ap, lds, tid, lane, wave, vcu, l);)
DK(k_r3, phase_r3(ap, lane, vcu * NWAVES + wave, G * NWAVES, l);)
DK(k_router, phase_router(ap, lds, tid, lane, wave, G, l);)
DK(k_gather, phase_gather(ap, lds, tid, lane, wave, vcu, G, l);)
DK(k_moecv, moe_convert13(ap->in[I_MW1], ap->in[I_MW3], 1, (bf16*)(ap->ws + WS_W13), vcu * NWAVES + wave, G * NWAVES, (LAS float*)(lds + wave * 16640), lane);)
#endif
```

```cpp
#include <hip/hip_runtime.h>
#include <cstdio>
#include <cstdint>
#define MK_PER_PHASE 0

#ifndef MK_PER_PHASE
#define MK_PER_PHASE 0
#endif
#ifndef EN_MLSTM
#define EN_MLSTM 1
#endif
#ifndef EN_S5
#define EN_S5 1
#endif
#ifndef EN_RWKV
#define EN_RWKV 1
#endif
#ifndef EN_MOE
#define EN_MOE 1
#endif
#ifndef N_LAYERS
#define N_LAYERS 2
#endif
constexpr int NWAVES = 8, NTHR = 512;
constexpr int DM = 1024, NB = 4, SEQ = 8192, NTOK = NB * SEQ;
constexpr int DA = 384, DBR = 384, DC = 256, NH = 6, HD = 64, NCH = SEQ / 64;
constexpr int IN_COLS = 2828, NPROJ = 2816, NPROJ_PAD = 3072;
constexpr int PC_QK = 0, PC_V = 384, PC_O = 768, PC_RW = 1152, PC_S5 = 2560;
constexpr int RWC_R = 0, RWC_K = 384, RWC_V = 768, RWC_WD = 1152, RWC_AD = 1216, RWC_GD = 1280, RW_COLS = 1408;
constexpr int NEXP = 32, DEXP = 512, MOE_ROWS_MAX = 73728;
constexpr int NUNIT_M = NB * NCH * NH;
constexpr int CL_STRIDE = 4160;
constexpr float NORM_EPS = 1e-6f, HEAD_NORM_EPS = 1e-5f, RWKV_GN_EPS = 64e-5f;

constexpr size_t MiB = 1u << 20;
constexpr size_t WS_CTL = 0, CTL_ZERO_BYTES = 1 * MiB;
constexpr size_t WS_MODP = 1 * MiB;
constexpr size_t WS_MODF = 2 * MiB + 512 * 1024;
constexpr size_t WS_S5BB = 2 * MiB + 896 * 1024;
constexpr size_t WS_RTW = 3 * MiB;
constexpr size_t WS_S5AP = 3 * MiB + 384 * 1024;
constexpr size_t WS_MLW = 3 * MiB + 512 * 1024;
constexpr size_t WS_S5CM = 2 * MiB + 768 * 1024;
constexpr size_t WS_GLUT = 3 * MiB + 768 * 1024;
constexpr size_t WS_WIN = 4 * MiB;
constexpr size_t WS_WOUT = 16 * MiB;
constexpr size_t WS_GATES = 20 * MiB;
constexpr size_t WS_W13 = 22 * MiB;
constexpr size_t WS_W2 = 86 * MiB;
constexpr size_t WS_HN = 118 * MiB;
constexpr size_t WS_CLOC = 118 * MiB;
constexpr size_t WS_MSC = 168 * MiB;
constexpr size_t WS_S5ST = 170 * MiB;
constexpr size_t WS_VF = 182 * MiB;
constexpr size_t WS_YC = 206 * MiB;
constexpr size_t WS_LIST = 206 * MiB;
constexpr size_t WS_ROWMAP = 214 * MiB;
constexpr size_t WS_TOKE = 215 * MiB;
constexpr size_t WS_TOKW = 215 * MiB + 512 * 1024;
constexpr size_t WS_PROJ = 270 * MiB;
constexpr size_t WS_RE = 446 * MiB, WS_RA = 470 * MiB, WS_RG = 494 * MiB, WS_RVG = 518 * MiB;
constexpr size_t WS_XG = 270 * MiB;
constexpr size_t WS_HMID = 414 * MiB;
constexpr size_t WS_YMOE = 270 * MiB;
constexpr size_t WS_R1W = 542 * MiB;
constexpr size_t WS_OPA = 22 * MiB;
constexpr size_t WS_OPB = 543 * MiB;
constexpr size_t WS_END = 591 * MiB;
constexpr int CW_TMO = 0, CW_BAR = 4096, CW_CNT = 8192, CW_Q = 8320;

constexpr int RING_BYTES = 131072, MISC_OFF = 135168, PTAB_OFF = MISC_OFF + 1024, LDS_BYTES = 147456;

#define GAS __attribute__((address_space(1)))
#define LAS __attribute__((address_space(3)))
typedef unsigned short bf16;
typedef unsigned v4u __attribute__((ext_vector_type(4)));
typedef unsigned v2u __attribute__((ext_vector_type(2)));
typedef float f32x4 __attribute__((ext_vector_type(4)));
typedef float f32x2 __attribute__((ext_vector_type(2)));
typedef GAS unsigned gu32;
#define RLX_AGENT __ATOMIC_RELAXED, __HIP_MEMORY_SCOPE_AGENT
#define LDS_WAIT() asm volatile("s_waitcnt lgkmcnt(0)" ::: "memory")
#define VM_WAIT() asm volatile("s_waitcnt vmcnt(0)" ::: "memory")
typedef float f32x2v __attribute__((ext_vector_type(2)));
typedef __bf16 bf16x2v __attribute__((ext_vector_type(2)));
__device__ __forceinline__ unsigned pk2(float lo, float hi) { const f32x2v v = {lo, hi}; const bf16x2v b = __builtin_convertvector(v, bf16x2v); return __builtin_bit_cast(unsigned, b); }
__device__ __forceinline__ unsigned f2bf(float f) { return pk2(f, 0.f) & 0xffffu; }
__device__ __forceinline__ float bf2f(unsigned v) { return __builtin_bit_cast(float, v << 16); }
__device__ __forceinline__ float bflo(unsigned w) { return __builtin_bit_cast(float, w << 16); }
__device__ __forceinline__ float bfhi(unsigned w) { return __builtin_bit_cast(float, w & 0xffff0000u); }
__device__ __forceinline__ float sigmoidf_(float x) { return 1.f / (1.f + __expf(-x)); }
__device__ __forceinline__ float wave_sum(float v) {
#pragma unroll
    for (int o = 1; o < 64; o <<= 1) v += __shfl_xor(v, o);
    return v;
}
__device__ __forceinline__ float wave_max(float v) {
#pragma unroll
    for (int o = 1; o < 64; o <<= 1) v = fmaxf(v, __shfl_xor(v, o));
    return v;
}
namespace pg8 {
#define PG8_LAS __attribute__((address_space(3)))
typedef unsigned short bf16_t;
typedef short bf16x8 __attribute__((ext_vector_type(8)));
typedef float f32x4 __attribute__((ext_vector_type(4)));
typedef unsigned u32x4 __attribute__((ext_vector_type(4)));
constexpr int BM = 256, BK = 64, HALF = 128, HTB = HALF * BK * 2  , STAGE_BYTES = 8 * HTB, NXCD = 8, WGM = 8;

__host__ __device__ __forceinline__ int lds_byte(int r, int c) { const int st = (r >> 4) * 2 + (c >> 5), rr = r & 15, cc = c & 31, ob = rr * 64 + cc * 2; return st * 1024 + (ob ^ (((ob >> 9) & 1) << 5)); }
__host__ __device__ __forceinline__ void stage_rc(int b, int& R, int& C) { const int st = b / 1024, sb = b % 1024, swz = sb ^ (((sb >> 9) & 1) << 5); R = (st >> 1) * 16 + swz / 64; C = (st & 1) * 32 + (swz % 64) / 2; }
__host__ __device__ __forceinline__ int perm32(int rho) { const int n = rho >> 4, i = rho & 15; return 8 * (i >> 2) + 4 * n + (i & 3); }

struct Unit { int pm, pn; };
__device__ __forceinline__ int moe_tok2(const int* list, PG8_LAS const int* ptab, int row) { const int e = ptab[1 + (row >> 8)], pos = row - ptab[512 + e]; return pos < ptab[544 + e] ? list[(size_t)e * 65536 + pos] : -1; }
struct Gemm { const bf16_t* A; const bf16_t* Bt; int M, N, K; const int* list = nullptr; PG8_LAS const int* ptab = nullptr; };

struct StaticOrder {
    int nM, nN, nwg, G, c;
    __host__ __device__ void init(int M, int N, int G_, int c_) { nM = M / BM; nN = N / BM; nwg = nM * nN; G = G_; c = c_; }
    __host__ __device__ bool next(int i, Unit& u) const {
        const long L = (long)i * G + c; if (L >= nwg) return false;
        int wgid = (int)L; { const int q = nwg / NXCD, r = nwg % NXCD, xcd = wgid % NXCD, off = wgid / NXCD; wgid = (xcd < r ? xcd * (q + 1) : r * (q + 1) + (xcd - r) * q) + off; }
        const int nig = WGM * nN, gid = wgid / nig, fm = gid * WGM, gsz = (nM - fm) < WGM ? (nM - fm) : WGM;
        u.pm = fm + ((wgid % nig) % gsz); u.pn = (wgid % nig) / gsz; return true;
    }
    __device__ __forceinline__ void a_ready(const Unit&) const {}
    __device__ __forceinline__ void done(const Unit&) const {}
};

__device__ __forceinline__ unsigned cvt_pk_bf16(float lo, float hi) { unsigned r; asm volatile("v_cvt_pk_bf16_f32 %0, %1, %2" : "=v"(r) : "v"(lo), "v"(hi)); return r; }

struct EpiProj {
    static constexpr bool PERM = true, AFTER_DRAIN = false;
    bf16_t* O; float* G;
    __device__ __forceinline__ void operator()(const f32x4 (&acc)[2][2][4][2], const Unit& u, int wr, int wc, int fr, int fq) const {
        const int row0 = u.pm * BM + wr * 64 + fr;
        if (u.pn < 11) {
            const int col0 = u.pn * BM + wc * 32 + 8 * fq;
#pragma unroll
            for (int ai = 0; ai < 2; ++ai)
#pragma unroll
                for (int m = 0; m < 4; ++m) { bf16_t* rowp = O + (size_t)(row0 + ai * HALF + m * 16) * 2816 + col0;
#pragma unroll
                    for (int bj = 0; bj < 2; ++bj) { const f32x4 v0 = acc[ai][bj][m][0], v1 = acc[ai][bj][m][1];
                        u32x4 w; w.x = cvt_pk_bf16(v0[0], v0[1]); w.y = cvt_pk_bf16(v0[2], v0[3]); w.z = cvt_pk_bf16(v1[0], v1[1]); w.w = cvt_pk_bf16(v1[2], v1[3]);
                        *(u32x4*)(rowp + bj * HALF) = w; } }
        } else if (wc == 0 && fq < 2) {
#pragma unroll
            for (int ai = 0; ai < 2; ++ai)
#pragma unroll
                for (int m = 0; m < 4; ++m) { float* rowp = G + (size_t)(row0 + ai * HALF + m * 16) * 16 + 8 * fq;
                    *(f32x4*)(rowp) = acc[ai][0][m][0]; *(f32x4*)(rowp + 4) = acc[ai][0][m][1]; }
        }
    }
};
struct EpiResid {
    static constexpr bool PERM = true, AFTER_DRAIN = false;
    const float* xin; float* out; const float* gate;
    int goff;
    __device__ __forceinline__ void operator()(const f32x4 (&acc)[2][2][4][2], const Unit& u, int wr, int wc, int fr, int fq) const {
        const int row0 = u.pm * BM + wr * 64 + fr, col0 = u.pn * BM + wc * 32 + 8 * fq;
        const float* gp = gate + (size_t)(row0 >> 13) * 6144 + goff + col0;
        f32x4 g[2][2];
#pragma unroll
        for (int bj = 0; bj < 2; ++bj)
#pragma unroll
            for (int n = 0; n < 2; ++n) g[bj][n] = *(const f32x4*)(gp + bj * HALF + 4 * n) + 1.0f;
#pragma unroll
        for (int ai = 0; ai < 2; ++ai) { f32x4 xv[4][2][2];
#pragma unroll
            for (int m = 0; m < 4; ++m) { const size_t off = (size_t)(row0 + ai * HALF + m * 16) * 1024 + col0;
#pragma unroll
                for (int bj = 0; bj < 2; ++bj)
#pragma unroll
                    for (int n = 0; n < 2; ++n) xv[m][bj][n] = *(const f32x4*)(xin + off + bj * HALF + 4 * n); }
#pragma unroll
            for (int m = 0; m < 4; ++m) { const size_t off = (size_t)(row0 + ai * HALF + m * 16) * 1024 + col0;
#pragma unroll
                for (int bj = 0; bj < 2; ++bj)
#pragma unroll
                    for (int n = 0; n < 2; ++n) *(f32x4*)(out + off + bj * HALF + 4 * n) = xv[m][bj][n] + g[bj][n] * acc[ai][bj][m][n]; } }
    }
};
struct EpiSwiglu {
    static constexpr bool PERM = true, AFTER_DRAIN = false;
    bf16_t* H;
    __device__ __forceinline__ void operator()(const f32x4 (&acc)[2][2][4][2], const Unit& u, int wr, int wc, int fr, int fq) const {
        const int row0 = u.pm * BM + wr * 64 + fr, hid0 = 128 * (u.pn & 3) + 16 * wc + 4 * fq;
#pragma unroll
        for (int ai = 0; ai < 2; ++ai)
#pragma unroll
            for (int m = 0; m < 4; ++m) { bf16_t* rowp = H + (size_t)(row0 + ai * HALF + m * 16) * 512 + hid0;
#pragma unroll
                for (int bj = 0; bj < 2; ++bj) { const f32x4 g = acc[ai][bj][m][0], uu = acc[ai][bj][m][1]; float h[4];
#pragma unroll
                    for (int i = 0; i < 4; ++i) h[i] = g[i] / (1.f + __expf(-g[i])) * uu[i];
                    unsigned w0 = cvt_pk_bf16(h[0], h[1]), w1 = cvt_pk_bf16(h[2], h[3]);
                    *(unsigned long long*)(rowp + 64 * bj) = (unsigned long long)w0 | ((unsigned long long)w1 << 32); } }
    }
};
struct EpiMoeOut {
    static constexpr bool PERM = true, AFTER_DRAIN = false;
    bf16_t* Y; const int* list; PG8_LAS const int* ptab;
    __device__ __forceinline__ void operator()(const f32x4 (&acc)[2][2][4][2], const Unit& u, int wr, int wc, int fr, int fq) const {
        const int row0 = u.pm * BM + wr * 64 + fr, col0 = (u.pn & 3) * BM + wc * 32 + 8 * fq;
        int dsts[2][4];
#pragma unroll
        for (int ai = 0; ai < 2; ++ai)
#pragma unroll
            for (int m = 0; m < 4; ++m) dsts[ai][m] = moe_tok2(list, ptab, row0 + ai * HALF + m * 16);
#pragma unroll
        for (int ai = 0; ai < 2; ++ai)
#pragma unroll
            for (int m = 0; m < 4; ++m) { const int dst = dsts[ai][m];
                if (dst >= 0) { bf16_t* rowp = Y + (size_t)dst * 1024 + col0;
#pragma unroll
                    for (int bj = 0; bj < 2; ++bj) { const f32x4 v0 = acc[ai][bj][m][0], v1 = acc[ai][bj][m][1];
                        u32x4 w; w.x = cvt_pk_bf16(v0[0], v0[1]); w.y = cvt_pk_bf16(v0[2], v0[3]); w.z = cvt_pk_bf16(v1[0], v1[1]); w.w = cvt_pk_bf16(v1[2], v1[3]);
                        *(u32x4*)(rowp + bj * HALF) = w; } } }
    }
};
struct MoeOrder {
    PG8_LAS const int* ptab; int G, c;
    __device__ __forceinline__ bool next(int i, Unit& u) const {
        const int L = i * G + c, np = __builtin_amdgcn_readfirstlane(ptab[0]);
        if (L >= np * 4) return false;
        const int p = L >> 2; u.pm = p; u.pn = __builtin_amdgcn_readfirstlane(ptab[1 + p]) * 4 + (L & 3); return true;
    }
    __device__ __forceinline__ void a_ready(const Unit&) const {}
    __device__ __forceinline__ void done(const Unit&) const {}
};
template <class Epi, class Sched, bool ALIGN_EPI = false, bool SP2 = false, bool GATHER = false>
__device__ __forceinline__ void gemm_phase(PG8_LAS unsigned char* lds, const Gemm g, const Sched& S, const Epi& E) {
    int tid_ = threadIdx.x; asm volatile("" : "+v"(tid_));
    const int tid = tid_, wid = __builtin_amdgcn_readfirstlane(tid >> 6), lane = tid & 63, wr = wid >> 2, wc = wid & 3, fr = lane & 15, fq = lane >> 4;
    const int K = g.K, nt = K / BK;
    static_assert(!GATHER || SP2, "the gathered-A variant exists for the SP2 loop only");
    unsigned voffA[2], voffB[2];
    unsigned vAc[2] = {0u, 0u}, vAn[2] = {0u, 0u};
#pragma unroll
    for (int i = 0; i < 2; ++i) { int R, C; stage_rc(tid * 16 + i * 8192, R, C); const int Rb = Epi::PERM ? ((R & ~31) + perm32(R & 31)) : R;
        voffA[i] = (unsigned)(R * K + C) * 2u; voffB[i] = (unsigned)(Rb * K + C) * 2u; }
    const size_t kstep = (size_t)(BK * 2);
    const size_t hstep = (size_t)HALF * K * 2;
    const size_t tstep = 2 * hstep;
    const unsigned ldsw = (unsigned)wid * 1024u;
    const int aoff = lds_byte(wr * 64 + fr, fq * 8), boff = lds_byte(wc * 32 + fr, fq * 8);
#define PG8_SA(b, h) (((b) * 2 + (h)) * HTB)
#define PG8_SB(b, h) ((4 + (b) * 2 + (h)) * HTB)
#define PG8_STAGE(bufoff, gbase, voff) do { _Pragma("unroll") for (int _i = 0; _i < 2; ++_i) \
        __builtin_amdgcn_global_load_lds((const unsigned*)((const char*)(gbase) + (voff)[_i]), (PG8_LAS unsigned*)(lds + (bufoff) + ldsw + _i * 8192), 16, 0, 0); } while (0)
#define PG8_STAGEG(bufoff, base, pk) do { unsigned vg_[2]; _Pragma("unroll") for (int i_ = 0; i_ < 2; ++i_) { int R_, C_; stage_rc(tid * 16 + i_ * 8192, R_, C_); vg_[i_] = (((pk) >> (16 * i_)) & 0xffffu) * (unsigned)(2 * K) + (unsigned)(2 * C_); } PG8_STAGE(bufoff, base, vg_); } while (0)
#define PG8_STAGEA(bufoff, base, hh, nx) do { if constexpr (GATHER) { const unsigned pk_ = (nx) ? vAn[hh] : vAc[hh]; PG8_STAGEG(bufoff, base, pk_); } else PG8_STAGE(bufoff, (base) + (hh) * hstep, voffA); } while (0)
#define PG8_GOFF(dst, unit) do { _Pragma("unroll") for (int hh_ = 0; hh_ < 2; ++hh_) { unsigned pk_ = 0u; _Pragma("unroll") for (int i_ = 0; i_ < 2; ++i_) { int R_, C_; stage_rc(tid * 16 + i_ * 8192, R_, C_); \
        const int t2_ = moe_tok2(g.list, g.ptab, (unit).pm * BM + hh_ * HALF + R_); pk_ |= (unsigned)(t2_ < 0 ? 0 : (t2_ >> 1)) << (16 * i_); } dst[hh_] = pk_; } } while (0)
#define PG8_LDA(dst, b, h) do { _Pragma("unroll") for (int m = 0; m < 4; ++m) _Pragma("unroll") for (int k = 0; k < 2; ++k) dst[m][k] = *(const PG8_LAS bf16x8*)(lds + PG8_SA(b, h) + aoff + m * 2048 + k * 1024); } while (0)
#define PG8_LDB(dst, b, h) do { _Pragma("unroll") for (int n = 0; n < 2; ++n) _Pragma("unroll") for (int k = 0; k < 2; ++k) dst[n][k] = *(const PG8_LAS bf16x8*)(lds + PG8_SB(b, h) + boff + n * 2048 + k * 1024); } while (0)
#define PG8_MMA(ai, bj, At, Bt) do { __builtin_amdgcn_s_setprio(1); _Pragma("unroll") for (int m = 0; m < 4; ++m) _Pragma("unroll") for (int n = 0; n < 2; ++n) _Pragma("unroll") for (int k = 0; k < 2; ++k) \
        acc[ai][bj][m][n] = __builtin_amdgcn_mfma_f32_16x16x32_bf16(Bt[n][k], At[m][k], acc[ai][bj][m][n], 0, 0, 0); __builtin_amdgcn_s_setprio(0); } while (0)
#define PG8_WAIT_V(n) asm volatile("s_waitcnt vmcnt(" #n ")" ::: "memory")
#define PG8_WAIT_L(n) asm volatile("s_waitcnt lgkmcnt(" #n ")" ::: "memory")
#define PG8_BAR __builtin_amdgcn_s_barrier()
#define PG8_SCHED __builtin_amdgcn_sched_barrier(0)
    Unit cur, nxt; int ui = 0;
    if (!S.next(0, cur)) return;
    f32x4 acc[2][2][4][2];
#pragma unroll
    for (int a = 0; a < 2; ++a)
#pragma unroll
        for (int b = 0; b < 2; ++b)
#pragma unroll
            for (int m = 0; m < 4; ++m)
#pragma unroll
                for (int n = 0; n < 2; ++n) acc[a][b][m][n] = (f32x4){0.f, 0.f, 0.f, 0.f};
    bf16x8 At[4][2], B0[2][2], B1[2][2];
    const char* cA = (const char*)g.A + (GATHER ? (size_t)0 : (size_t)cur.pm * tstep); const char* cB = (const char*)g.Bt + (size_t)cur.pn * tstep;
    if constexpr (GATHER) { PG8_GOFF(vAc, cur); }
    S.a_ready(cur);
    if constexpr (SP2) {
        PG8_STAGE(PG8_SB(0, 0), cB, voffB); PG8_STAGE(PG8_SB(0, 1), cB + hstep, voffB); PG8_STAGEA(PG8_SA(0, 0), cA, 0, false); PG8_STAGEA(PG8_SA(0, 1), cA, 1, false);
        if (wr == 1) PG8_BAR;
        PG8_WAIT_V(2); PG8_BAR;
        PG8_STAGE(PG8_SB(1, 0), cB + kstep, voffB); PG8_STAGEA(PG8_SA(1, 0), cA + kstep, 0, false); PG8_STAGE(PG8_SB(1, 1), cB + hstep + kstep, voffB);
        PG8_WAIT_V(6); PG8_BAR;
    } else {
        PG8_STAGE(PG8_SB(0, 0), cB, voffB); PG8_STAGE(PG8_SA(0, 0), cA, voffA); PG8_STAGE(PG8_SB(0, 1), cB + hstep, voffB); PG8_STAGE(PG8_SA(0, 1), cA + hstep, voffA);
        if (wr == 1) PG8_BAR;
        PG8_WAIT_V(4); PG8_BAR;
        PG8_STAGE(PG8_SB(1, 0), cB + kstep, voffB); PG8_STAGE(PG8_SA(1, 0), cA + kstep, voffA); PG8_STAGE(PG8_SB(1, 1), cB + hstep + kstep, voffB);
        PG8_WAIT_V(6); PG8_BAR;
    }
    for (;;) {
        const bool has_next = S.next(ui + 1, nxt);
        const char* nA = (has_next && !GATHER) ? (const char*)g.A + (size_t)nxt.pm * tstep : cA;
        if constexpr (GATHER) { if (has_next) { PG8_GOFF(vAn, nxt); } else { vAn[0] = vAc[0]; vAn[1] = vAc[1]; } } const char* nB = has_next ? (const char*)g.Bt + (size_t)nxt.pn * tstep : cB;
        for (int t = 0; t < nt; t += 2) {
            const bool last = (t == nt - 2);
            const char* a1 = cA + (size_t)(t + 1) * kstep;
            const char* a2 = last ? nA : cA + (size_t)(t + 2) * kstep; const char* b2 = last ? nB : cB + (size_t)(t + 2) * kstep;
            const char* a3 = a2 + kstep; const char* b3 = b2 + kstep;
            if (last && has_next) S.a_ready(nxt);
            if constexpr (SP2) {
            PG8_LDB(B0, 0, 0); PG8_LDB(B1, 0, 1); PG8_SCHED; PG8_LDA(At, 0, 0); PG8_STAGEA(PG8_SA(1, 1), a1, 1, false);
            PG8_WAIT_V(8); PG8_WAIT_L(0); PG8_BAR; PG8_MMA(0, 0, At, B0); PG8_MMA(0, 1, At, B1); PG8_BAR; PG8_SCHED;
            PG8_LDA(At, 0, 1); PG8_STAGE(PG8_SB(0, 0), b2, voffB); PG8_STAGE(PG8_SB(0, 1), b2 + hstep, voffB); PG8_STAGEA(PG8_SA(0, 0), a2, 0, last);
            PG8_WAIT_V(8); PG8_WAIT_L(0); PG8_BAR; PG8_MMA(1, 0, At, B0); PG8_MMA(1, 1, At, B1); PG8_BAR; PG8_SCHED;
            PG8_LDB(B0, 1, 0); PG8_LDB(B1, 1, 1); PG8_SCHED; PG8_LDA(At, 1, 0); PG8_STAGEA(PG8_SA(0, 1), a2, 1, last);
            PG8_WAIT_V(8); PG8_WAIT_L(0); PG8_BAR; PG8_MMA(0, 0, At, B0); PG8_MMA(0, 1, At, B1); PG8_BAR; PG8_SCHED;
            PG8_LDA(At, 1, 1); PG8_STAGE(PG8_SB(1, 0), b3, voffB); PG8_STAGE(PG8_SB(1, 1), b3 + hstep, voffB); PG8_STAGEA(PG8_SA(1, 0), a3, 0, last);
            PG8_WAIT_V(8); PG8_WAIT_L(0); PG8_BAR; PG8_MMA(1, 0, At, B0); PG8_MMA(1, 1, At, B1); PG8_BAR; PG8_SCHED;
            } else {
            PG8_LDB(B0, 0, 0); PG8_SCHED; PG8_LDA(At, 0, 0); PG8_STAGE(PG8_SA(1, 1), a1 + hstep, voffA);
            PG8_WAIT_L(8); PG8_BAR; PG8_WAIT_L(0); PG8_MMA(0, 0, At, B0); PG8_BAR; PG8_SCHED;
            PG8_LDB(B1, 0, 1); PG8_STAGE(PG8_SB(0, 0), b2, voffB);
            PG8_BAR; PG8_WAIT_L(0); PG8_MMA(0, 1, At, B1); PG8_BAR;
            PG8_LDA(At, 0, 1); PG8_STAGE(PG8_SA(0, 0), a2, voffA);
            PG8_BAR; PG8_WAIT_L(0); PG8_MMA(1, 0, At, B0); PG8_BAR; PG8_SCHED;
            PG8_STAGE(PG8_SB(0, 1), b2 + hstep, voffB);
            PG8_WAIT_V(6); PG8_BAR; PG8_MMA(1, 1, At, B1); PG8_BAR;
            PG8_LDB(B0, 1, 0); PG8_SCHED; PG8_LDA(At, 1, 0); PG8_STAGE(PG8_SA(0, 1), a2 + hstep, voffA);
            PG8_WAIT_L(8); PG8_BAR; PG8_WAIT_L(0); PG8_MMA(0, 0, At, B0); PG8_BAR; PG8_SCHED;
            PG8_LDB(B1, 1, 1); PG8_STAGE(PG8_SB(1, 0), b3, voffB);
            PG8_BAR; PG8_WAIT_L(0); PG8_MMA(0, 1, At, B1); PG8_BAR;
            PG8_LDA(At, 1, 1); PG8_STAGE(PG8_SA(1, 0), a3, voffA);
            PG8_BAR; PG8_WAIT_L(0); PG8_MMA(1, 0, At, B0); PG8_BAR; PG8_SCHED;
            PG8_STAGE(PG8_SB(1, 1), b3 + hstep, voffB);
            PG8_WAIT_V(6); PG8_BAR; PG8_MMA(1, 1, At, B1); PG8_BAR;
            }
        }
        if constexpr (ALIGN_EPI) { if (wr == 0) PG8_BAR; }
        if constexpr (!Epi::AFTER_DRAIN) { E(acc, cur, wr, wc, fr, fq); S.done(cur); }
        if (!has_next) break;
#pragma unroll
        for (int a = 0; a < 2; ++a)
#pragma unroll
            for (int b = 0; b < 2; ++b)
#pragma unroll
                for (int m = 0; m < 4; ++m)
#pragma unroll
                    for (int n = 0; n < 2; ++n) acc[a][b][m][n] = (f32x4){0.f, 0.f, 0.f, 0.f};
        cur = nxt; cA = nA; cB = nB; ++ui;
        if constexpr (GATHER) { vAc[0] = vAn[0]; vAc[1] = vAn[1]; }
        if constexpr (ALIGN_EPI) { if (wr == 1) PG8_BAR; }
    }
    PG8_WAIT_V(0);
    if constexpr (!ALIGN_EPI) { if (wr == 0) PG8_BAR; }
    PG8_BAR;
    if constexpr (Epi::AFTER_DRAIN) { E.fused(acc, cur, wr, wc, fr, fq, lds, wid, lane); S.done(cur); }
#undef PG8_SA
#undef PG8_SB
#undef PG8_STAGE
#undef PG8_STAGEA
#undef PG8_STAGEG
#undef PG8_GOFF
#undef PG8_LDA
#undef PG8_LDB
#undef PG8_MMA
#undef PG8_WAIT_V
#undef PG8_WAIT_L
#undef PG8_BAR
#undef PG8_SCHED
}
}
#define XB_TMO      128
#define XB_XCNT(j)  (256  + 64 * (j))
#define XB_XSUB(j)  (1280 + 64 * (j))
#define XB_XGEN(j)  (2304 + 64 * (j))
#define XB_TOP      3328
#define XB_TOPGEN   3392
#define XCD_BAR_WORDS 3456
#define XB_SPIN_CAP (1u << 18)
#define LAS __attribute__((address_space(3)))

__device__ __forceinline__ unsigned xb_ld(unsigned* p)              { return __hip_atomic_load(p, __ATOMIC_RELAXED, __HIP_MEMORY_SCOPE_AGENT); }
__device__ __forceinline__ unsigned xb_add(unsigned* p, unsigned v) { return __hip_atomic_fetch_add(p, v, __ATOMIC_RELAXED, __HIP_MEMORY_SCOPE_AGENT); }
__device__ __forceinline__ unsigned xb_xcc_id() { return (unsigned)__builtin_amdgcn_s_getreg((3 << 11) | 20) & 0xFu; }
#define XB_SPIN(cond, bar) do { unsigned _sp = 0; while (cond) { __builtin_amdgcn_s_sleep(1); \
    if ((++_sp & 255u) == 0u) { if (xb_ld(&(bar)[XB_TMO])) break; if (_sp > XB_SPIN_CAP) { atomicAdd(&(bar)[XB_TMO], 1u); break; } } } } while (0)

struct XcdBarrier {
    unsigned* bar; unsigned x;
    volatile LAS unsigned* st;
};

__device__ __forceinline__ XcdBarrier xcd_barrier_post(unsigned* bar, volatile LAS unsigned* st) {
    XcdBarrier b; b.bar = bar; b.x = xb_xcc_id(); b.st = st;
    if (threadIdx.x == 0) (void)xb_add(&bar[XB_XCNT(b.x)], 1u);
    return b;
}
__device__ __forceinline__ void xcd_barrier_complete(unsigned* bar, unsigned x, unsigned& nloc, unsigned& nx) {
    const unsigned G = gridDim.x * gridDim.y * gridDim.z;
    unsigned sum, cnt, mine, sp = 0u;
    for (;;) {
        sum = 0u; cnt = 0u; mine = 0u;
#pragma unroll
        for (unsigned j = 0; j < 16; ++j) { const unsigned c = xb_ld(&bar[XB_XCNT(j)]); sum += c; cnt += (c > 0u) ? 1u : 0u; mine = (j == x) ? c : mine; }
        if (sum == G) break;
        __builtin_amdgcn_s_sleep(1);
        if ((++sp & 255u) == 0u) { if (xb_ld(&bar[XB_TMO])) break; if (sp > XB_SPIN_CAP) { atomicAdd(&bar[XB_TMO], 1u); break; } }
    }
    nloc = mine > 0u ? mine : 1u; nx = cnt > 0u ? cnt : 1u;
}

__device__ __forceinline__ void xcd_barrier(const XcdBarrier& b) {
    asm volatile("s_waitcnt vmcnt(0)" ::: "memory");
    __syncthreads();
    if (threadIdx.x == 0) {
        unsigned* bar = b.bar;
        __builtin_amdgcn_s_waitcnt(0);
        unsigned nloc = b.st[0], nx = b.st[1];
        if (nloc == 0u) { xcd_barrier_complete(bar, b.x, nloc, nx); b.st[0] = nloc; b.st[1] = nx; }
        const unsigned old = xb_add(&bar[XB_XSUB(b.x)], 1u);
        const unsigned gen = old / nloc;
        if (old + 1u == (gen + 1u) * nloc) {
            __builtin_amdgcn_fence(__ATOMIC_RELEASE, "agent");
            asm volatile("s_waitcnt vmcnt(0)" ::: "memory");
            const unsigned og = xb_add(&bar[XB_TOP], 1u);
            const unsigned tg = og / nx;
            if (og + 1u == (tg + 1u) * nx) xb_add(&bar[XB_TOPGEN], 1u);
            else XB_SPIN(xb_ld(&bar[XB_TOPGEN]) == tg, bar);
            __builtin_amdgcn_fence(__ATOMIC_ACQUIRE, "agent");
            xb_add(&bar[XB_XGEN(b.x)], 1u);
            asm volatile("s_waitcnt vmcnt(0)" ::: "memory");
        } else {
            XB_SPIN(xb_ld(&bar[XB_XGEN(b.x)]) == gen, bar);
            __builtin_amdgcn_fence(__ATOMIC_ACQUIRE, "agent");
            asm volatile("s_waitcnt vmcnt(0)" ::: "memory");
        }
    }
    __syncthreads();
}

struct Args { const float* in[47]; float* out; unsigned char* ws; int ph_lo, ph_hi; };
typedef const __attribute__((address_space(4))) Args* KArgsP;
__device__ __forceinline__ KArgsP fresh_args() { KArgsP p = (KArgsP)__builtin_amdgcn_kernarg_segment_ptr(); asm volatile("" : "+s"(p)); return p; }
enum { I_X = 0, I_C, I_ADA_W, I_ADA_B, I_NORM_MIX, I_NORM_FFN, I_NORM_FINAL, I_W_IN, I_W_OUT, I_CONV_W, I_CONV_B, I_WQ, I_WK, I_BI, I_BF, I_MNORM_W,
       I_RMU, I_RW0, I_RWUP, I_RA0, I_RAUP, I_RGUP, I_RKK, I_RKA, I_RRK, I_RLNW, I_RLNB, I_RV0, I_RVDN, I_RVUP,
       I_S5ARE, I_S5AIM, I_S5LDT, I_S5BRE, I_S5BIM, I_S5CRE, I_S5CIM, I_S5D, I_S5GLUW, I_S5GLUB,
       I_MWRG, I_MBRG, I_MWRE, I_MBRE, I_MW1, I_MW3, I_MW2 };

struct RmWin { __device__ __forceinline__ int operator()(int n) const { return n < 1152 ? n : (n < 1164 ? 2816 + (n - 1152) : (n < 2572 ? 1152 + (n - 1164) : 2560 + (n - 2572))); } };
struct RmId  { __device__ __forceinline__ int operator()(int n) const { return n; } };
struct RmGU  { int add; __device__ __forceinline__ int operator()(int n) const { return 8 * (n >> 2) + (n & 3) + add; } };
template <class RM>
__device__ __forceinline__ void transpose_item(const float* W, int ldw, int ncols, int k0, int n0, bf16* WT, int ldt, LAS float* scr, int lane, const RM rm) {
    if (n0 + 64 <= ncols && (ldw & 3) == 0) {
        const float* src = W + (size_t)(k0 + (lane >> 4)) * ldw + n0 + 4 * (lane & 15);
        f32x4 v[16];
#pragma unroll
        for (int i = 0; i < 16; ++i) v[i] = *(const GAS f32x4*)(src + (size_t)(4 * i) * ldw);
#pragma unroll
        for (int i = 0; i < 16; ++i) { LAS float* d = scr + (4 * i + (lane >> 4)) * 65 + 4 * (lane & 15); d[0] = v[i][0]; d[1] = v[i][1]; d[2] = v[i][2]; d[3] = v[i][3]; }
    } else {
    const int nn = n0 + lane; const bool ok = nn < ncols; const float* src = W + (size_t)k0 * ldw + (ok ? nn : n0);
    float v[64];
#pragma unroll
    for (int kk = 0; kk < 64; ++kk) v[kk] = src[(size_t)kk * ldw];
#pragma unroll
    for (int kk = 0; kk < 64; ++kk) scr[kk * 65 + lane] = v[kk];
    }
    LDS_WAIT(); asm volatile("" ::: "memory");
    const int c = lane & 7;
#pragma unroll
    for (int j = 0; j < 8; ++j) { const int nl = (lane >> 3) + 8 * j; const LAS float* s = scr + (8 * c) * 65 + nl;
        v4u o; o.x = pk2(s[0 * 65], s[1 * 65]); o.y = pk2(s[2 * 65], s[3 * 65]); o.z = pk2(s[4 * 65], s[5 * 65]); o.w = pk2(s[6 * 65], s[7 * 65]);
        if (n0 + nl < ncols) *(GAS v4u*)(WT + (size_t)rm(n0 + nl) * ldt + k0 + 8 * c) = o; }
    LDS_WAIT(); asm volatile("" ::: "memory");
}
__device__ __forceinline__ void moe_convert13(const float* w1, const float* w3, int l, bf16* W13, int worker, int nworkers, LAS float* scr, int lane) {
    for (int it = worker; it < NEXP * 256; it += nworkers) {
        const int e = it >> 8, r = it & 255; const size_t eo = (size_t)(l * NEXP + e) * DM * DEXP;
        if (r < 128) transpose_item(w1 + eo, DEXP, DEXP, 64 * (r >> 3), 64 * (r & 7), W13 + (size_t)e * 1024 * 1024, 1024, scr, lane, RmGU{0});
        else         transpose_item(w3 + eo, DEXP, DEXP, 64 * ((r - 128) >> 3), 64 * ((r - 128) & 7), W13 + (size_t)e * 1024 * 1024, 1024, scr, lane, RmGU{4});
    }
}
__device__ __forceinline__ void moe_convert2(const float* w2, int l, bf16* W2T, int worker, int nworkers, LAS float* scr, int lane) {
    for (int it = worker; it < NEXP * 128; it += nworkers) {
        const int e = it >> 7, r = it & 127; const size_t eo = (size_t)(l * NEXP + e) * DM * DEXP;
        transpose_item(w2 + eo, DM, DM, 64 * (r >> 4), 64 * (r & 15), W2T + (size_t)e * 1024 * 512, 512, scr, lane, RmId{});
    }
}
__device__ __forceinline__ void phase_prologue(KArgsP a, LAS unsigned char* lds, int tid, int lane, int wave, int vcu, int G) {
    unsigned char* ws = a->ws;
    LAS float* scr = (LAS float*)(lds + wave * 16640);
    const int gw = vcu * NWAVES + wave, NGW = G * NWAVES;
    bf16* WIN = (bf16*)(ws + WS_WIN); bf16* WOUT = (bf16*)(ws + WS_WOUT);
    for (int it = gw; it < 2 * 16 * 45; it += NGW) { const int l = it / (16 * 45), r = it % (16 * 45);
        transpose_item(a->in[I_W_IN] + (size_t)l * DM * IN_COLS, IN_COLS, IN_COLS, 64 * (r / 45), 64 * (r % 45), WIN + (size_t)l * NPROJ_PAD * DM, DM, scr, lane, RmWin{}); }
    for (int it = gw; it < 2 * 16 * 16; it += NGW) { const int l = it / 256, r = it % 256;
        transpose_item(a->in[I_W_OUT] + (size_t)l * DM * DM, DM, DM, 64 * (r >> 4), 64 * (r & 15), WOUT + (size_t)l * DM * DM, DM, scr, lane, RmId{}); }
    for (int it = gw; it < 2 * 244; it += NGW) { const int l = it / 244, r = 2828 + it % 244; GAS v4u* p = (GAS v4u*)(WIN + ((size_t)l * NPROJ_PAD + r) * DM);
        p[lane] = (v4u){0u, 0u, 0u, 0u}; p[lane + 64] = (v4u){0u, 0u, 0u, 0u}; }
    { float* RTW = (float*)(ws + WS_RTW);
      for (int idx = (vcu * NTHR + tid); idx < 2 * 1024 * 48; idx += G * NTHR) { const int j = idx % 48, k = (idx / 48) % 1024, l = idx / (48 * 1024);
          RTW[(size_t)l * 49152 + ((k >> 2) * 16 + (j & 15)) * 12 + (k & 3) * 3 + (j >> 4)] = j < 4 ? a->in[I_MWRG][(size_t)(l * 1024 + k) * 4 + j] : (j < 36 ? a->in[I_MWRE][(size_t)(l * 1024 + k) * 32 + (j - 4)] : 0.f); } }
    { bf16* RW = (bf16*)(ws + WS_R1W);
      for (int idx = (vcu * NTHR + tid); idx < 2 * 98304 + 24576; idx += G * NTHR) { float v;
          if (idx < 2 * 98304) { const int l = idx / 98304, r = idx % 98304;
              if (r < 24576)      v = a->in[I_RWUP][(size_t)l * 64 * DBR + (r & 63) * DBR + (r >> 6)];
              else if (r < 49152) v = a->in[I_RAUP][(size_t)l * 64 * DBR + ((r - 24576) & 63) * DBR + ((r - 24576) >> 6)];
              else                v = a->in[I_RGUP][(size_t)l * 128 * DBR + ((r - 49152) & 127) * DBR + ((r - 49152) >> 7)];
          } else { const int r = idx - 2 * 98304;
              if (r < 12288) v = a->in[I_RVDN][(size_t)(r % 384) * 32 + (r / 384)];
              else           v = a->in[I_RVUP][(size_t)((r - 12288) & 31) * DBR + ((r - 12288) >> 5)]; }
          RW[idx] = (bf16)f2bf(v); } }
    for (int idx = (vcu * NTHR + tid); idx < 2 * 16 * 64; idx += G * NTHR) { const int p = idx & 63, lg = idx >> 6;
        const float lam_re = a->in[I_S5ARE][idx], lam_im = a->in[I_S5AIM][idx]; const float dt = expf(a->in[I_S5LDT][lg]); const float mag = expf(lam_re * dt), ang = lam_im * dt;
        const float are = mag * cosf(ang), aim = mag * sinf(ang); const float inv = 1.f / (lam_re * lam_re + lam_im * lam_im);
        const float cre = ((are - 1.f) * lam_re + aim * lam_im) * inv, cim = (aim * lam_re - (are - 1.f) * lam_im) * inv;
        ((float*)(ws + WS_S5AP))[idx * 2] = are; ((float*)(ws + WS_S5AP))[idx * 2 + 1] = aim;
        const float* br = a->in[I_S5BRE] + (size_t)idx * 16; const float* bi = a->in[I_S5BIM] + (size_t)idx * 16; bf16* o = (bf16*)(ws + WS_S5BB) + ((size_t)lg * 128 + 2 * p) * 16;
        for (int c = 0; c < 16; ++c) { o[c] = (bf16)f2bf(cre * br[c] - cim * bi[c]); o[16 + c] = (bf16)f2bf(cre * bi[c] + cim * br[c]); } }
    { bf16* CM = (bf16*)(ws + WS_S5CM);
      for (int idx = (vcu * NTHR + tid); idx < 2 * 16 * 16 * 128; idx += G * NTHR) { const int k = idx & 127, lgc = idx >> 7;
          CM[idx] = (bf16)f2bf((k & 1) ? -a->in[I_S5CIM][(size_t)lgc * 64 + (k >> 1)] : a->in[I_S5CRE][(size_t)lgc * 64 + (k >> 1)]); } }
    for (int it = gw; it < 2 * 16; it += NGW) { const int l = it >> 4, r = it & 15;
        transpose_item(a->in[I_S5GLUW] + (size_t)l * DC * DC, DC, DC, 64 * (r >> 2), 64 * (r & 3), (bf16*)(ws + WS_GLUT) + (size_t)l * DC * DC, DC, scr, lane, RmId{}); }
    { bf16* MLW = (bf16*)(ws + WS_MLW);
      for (int idx = (vcu * NTHR + tid); idx < 2 * NH * 2 * 4096; idx += G * NTHR) { const int d = idx & 63, e = (idx >> 6) & 63, which = (idx >> 12) & 1, lh = idx >> 13;
          MLW[idx] = (bf16)f2bf(a->in[which ? I_WK : I_WQ][(size_t)lh * 4096 + d * 64 + e]); } }
    __syncthreads();
    if (vcu < 192) {
        const int q = vcu, l = q / 96, cb = (q >> 3) % 12, kc = q & 7;
        LAS float* cond = (LAS float*)lds;
        { const int b = tid >> 7, kk = tid & 127; const float cv = a->in[I_C][b * DM + kc * 128 + kk]; cond[tid] = cv / (1.f + __expf(-cv)); }
        __syncthreads();
        const int col = cb * 512 + tid; const float* wp = a->in[I_ADA_W] + ((size_t)l * DM + kc * 128) * 6144 + col;
        float acc0 = 0.f, acc1 = 0.f, acc2 = 0.f, acc3 = 0.f;
#pragma unroll 8
        for (int kk = 0; kk < 128; ++kk) { const float w = wp[(size_t)kk * 6144]; acc0 += cond[kk] * w; acc1 += cond[128 + kk] * w; acc2 += cond[256 + kk] * w; acc3 += cond[384 + kk] * w; }
        const float bias = (kc == 0) ? a->in[I_ADA_B][l * 6144 + col] : 0.f;
        float* MP = (float*)(ws + WS_MODP) + ((size_t)(kc * 2 + l) * 4) * 6144 + col;
        MP[0] = acc0 + bias; MP[6144] = acc1 + bias; MP[2 * 6144] = acc2 + bias; MP[3 * 6144] = acc3 + bias;
    }
}

__device__ __forceinline__ float modval(const unsigned char* ws, bool part, int l, int b, int idx) {
    if (!part) return ((const float*)(ws + WS_MODF))[(size_t)(l * 4 + b) * 6144 + idx];
    const float* mp = (const float*)(ws + WS_MODP) + (size_t)(l * 4 + b) * 6144 + idx; float s = 0.f;
#pragma unroll
    for (int kc = 0; kc < 8; ++kc) s += mp[(size_t)kc * 2 * 4 * 6144];
    return s;
}
template <int MODE, bool COMBINE>
__device__ __forceinline__ void phase_rownorm(KArgsP a, LAS unsigned char* lds, int tid, int lane, int wave, int G,
                                              const float* xsrc, float* xdst, const float* gvec, bool part, int l, int isc  , int lprev) {
    unsigned char* ws = a->ws;
    LAS float* sc = (LAS float*)lds; LAS float* sh = sc + 1024; LAS float* gt = sh + 1024;
    bf16* HN = (bf16*)(ws + WS_HN); const bf16* YM = (const bf16*)(ws + WS_YMOE); const float* TW = (const float*)(ws + WS_TOKW);
    for (int c = blockIdx.x; c < NTOK / 128; c += G) {
        const int b = c >> 6;
        __syncthreads();
        for (int j = tid; j < 1024; j += NTHR) {
            if (MODE == 0) { sc[j] = gvec[j] * (1.f + modval(ws, part, l, b, (isc + 1) * 1024 + j)); sh[j] = modval(ws, part, l, b, isc * 1024 + j); }
            else { sc[j] = gvec[j]; sh[j] = 0.f; }
            if (COMBINE) gt[j] = 1.f + modval(ws, false, lprev, b, 5 * 1024 + j);
        }
        __syncthreads();
        f32x4 vn[4]; v2u yn0[4], yn1[4]; float wn0 = 0.f, wn1 = 0.f;
        { const int row = c * 128 + wave * 16; const GAS f32x4* xr = (const GAS f32x4*)(xsrc + (size_t)row * DM) + lane;
#pragma unroll
          for (int j = 0; j < 4; ++j) vn[j] = xr[64 * j];
          if (COMBINE) { wn0 = TW[2 * row]; wn1 = TW[2 * row + 1]; const GAS v2u* y0 = (const GAS v2u*)(YM + (size_t)(2 * row) * DM) + lane; const GAS v2u* y1 = (const GAS v2u*)(YM + (size_t)(2 * row + 1) * DM) + lane;
#pragma unroll
              for (int j = 0; j < 4; ++j) { yn0[j] = y0[64 * j]; yn1[j] = y1[64 * j]; } } }
        for (int i = 0; i < 16; ++i) {
            const int row = c * 128 + wave * 16 + i;
            f32x4 v[4]; v2u q0[4], q1[4]; const float w0 = wn0, w1 = wn1;
#pragma unroll
            for (int j = 0; j < 4; ++j) { v[j] = vn[j]; q0[j] = yn0[j]; q1[j] = yn1[j]; }
            if (i + 1 < 16) { const int rn = row + 1; const GAS f32x4* xr = (const GAS f32x4*)(xsrc + (size_t)rn * DM) + lane;
#pragma unroll
                for (int j = 0; j < 4; ++j) vn[j] = xr[64 * j];
                if (COMBINE) { wn0 = TW[2 * rn]; wn1 = TW[2 * rn + 1]; const GAS v2u* y0 = (const GAS v2u*)(YM + (size_t)(2 * rn) * DM) + lane; const GAS v2u* y1 = (const GAS v2u*)(YM + (size_t)(2 * rn + 1) * DM) + lane;
#pragma unroll
                    for (int j = 0; j < 4; ++j) { yn0[j] = y0[64 * j]; yn1[j] = y1[64 * j]; } } }
            if (COMBINE) {
#pragma unroll
                for (int j = 0; j < 4; ++j) { const v2u p0 = q0[j], p1 = q1[j]; const f32x4 g4 = *(const LAS f32x4*)(gt + lane * 4 + 256 * j);
                    f32x4 m; m.x = w0 * bflo(p0.x) + w1 * bflo(p1.x); m.y = w0 * bfhi(p0.x) + w1 * bfhi(p1.x); m.z = w0 * bflo(p0.y) + w1 * bflo(p1.y); m.w = w0 * bfhi(p0.y) + w1 * bfhi(p1.y);
                    v[j] = v[j] + g4 * m; }
                if (MODE == 0) { GAS f32x4* xo = (GAS f32x4*)(xdst + (size_t)row * DM) + lane;
#pragma unroll
                    for (int j = 0; j < 4; ++j) xo[64 * j] = v[j]; }
            }
            float ss = 0.f;
#pragma unroll
            for (int j = 0; j < 4; ++j) ss += (v[j].x * v[j].x + v[j].y * v[j].y) + (v[j].z * v[j].z + v[j].w * v[j].w);
            const float rstd = rsqrtf(wave_sum(ss) * (1.f / DM) + NORM_EPS);
            if (MODE == 0) {
                GAS v2u* o = (GAS v2u*)(HN + (size_t)row * DM) + lane;
#pragma unroll
                for (int j = 0; j < 4; ++j) { const f32x4 s4 = *(const LAS f32x4*)(sc + lane * 4 + 256 * j), h4 = *(const LAS f32x4*)(sh + lane * 4 + 256 * j); const f32x4 h = v[j] * rstd * s4 + h4;
                    v2u w; w.x = pk2(h.x, h.y); w.y = pk2(h.z, h.w); o[64 * j] = w; }
            } else {
                GAS f32x4* o = (GAS f32x4*)(xdst + (size_t)row * DM) + lane;
#pragma unroll
                for (int j = 0; j < 4; ++j) { const f32x4 s4 = *(const LAS f32x4*)(sc + lane * 4 + 256 * j); o[64 * j] = v[j] * rstd * s4; }
            }
        }
    }
}
__device__ __forceinline__ void mod_finalize(unsigned char* ws, int tid, int G) {
    float* MF = (float*)(ws + WS_MODF);
    for (int idx = blockIdx.x * NTHR + tid; idx < 2 * 4 * 6144; idx += G * NTHR) { const float* mp = (const float*)(ws + WS_MODP) + idx; float s = 0.f;
#pragma unroll
        for (int kc = 0; kc < 8; ++kc) s += mp[(size_t)kc * 2 * 4 * 6144];
        MF[idx] = s; }
}

typedef float f32x4m __attribute__((ext_vector_type(4)));
__device__ __forceinline__ void phase_router(KArgsP a, LAS unsigned char* lds, int tid, int lane, int wave, int G, int l) {
    unsigned char* ws = a->ws;
    LAS float* sc = (LAS float*)lds; LAS float* sh = sc + 1024; LAS float* rstd_s = sh + 1024  ; LAS float* cvec = rstd_s + 128  ; LAS float* cpart = cvec + 64  ;
    LAS float* lg = cpart + 8 * 48  ; LAS int* hist = (LAS int*)(lg + 8 * 16 * 48)  ; LAS int* basev = hist + 32; LAS int* asg_e = basev + 32  ; LAS int* asg_lp = asg_e + 256;
    bf16* HN = (bf16*)(ws + WS_HN); const float* x = a->out; const float* RTW = (const float*)(ws + WS_RTW) + (size_t)l * 1024 * 48;
    int* TOKE = (int*)(ws + WS_TOKE); float* TOKW = (float*)(ws + WS_TOKW); int* LIST = (int*)(ws + WS_LIST); unsigned* CNT = (unsigned*)(ws + WS_CTL) + CW_CNT + l * 32;
    const float* gvec = a->in[I_NORM_FFN] + l * DM;
    for (int c = blockIdx.x; c < NTOK / 128; c += G) {
        const int b = c >> 6;
        __syncthreads();
        for (int j = tid; j < 1024; j += NTHR) { sc[j] = gvec[j] * (1.f + modval(ws, false, l, b, 4 * 1024 + j)); sh[j] = modval(ws, false, l, b, 3 * 1024 + j); }
        if (tid < 32) hist[tid] = 0;
        __syncthreads();
        if (tid < 384) { const int j = tid % 48, part = tid / 48; float s = 0.f;
#pragma unroll 16
            for (int k = part * 128; k < part * 128 + 128; ++k) s += sh[k] * RTW[((k >> 2) * 16 + (j & 15)) * 12 + (k & 3) * 3 + (j >> 4)];
            cpart[part * 48 + j] = s; }
        { f32x4 vn[4];
          { const GAS f32x4* xr = (const GAS f32x4*)(x + (size_t)(c * 128 + wave * 16) * DM) + lane;
#pragma unroll
            for (int j = 0; j < 4; ++j) vn[j] = xr[64 * j]; }
          for (int i = 0; i < 16; ++i) {
            const int row = c * 128 + wave * 16 + i;
            f32x4 v[4]; float ss = 0.f;
#pragma unroll
            for (int j = 0; j < 4; ++j) { v[j] = vn[j]; ss += (v[j].x * v[j].x + v[j].y * v[j].y) + (v[j].z * v[j].z + v[j].w * v[j].w); }
            if (i + 1 < 16) { const GAS f32x4* xr = (const GAS f32x4*)(x + (size_t)(row + 1) * DM) + lane;
#pragma unroll
                for (int j = 0; j < 4; ++j) vn[j] = xr[64 * j]; }
            const float rstd = rsqrtf(wave_sum(ss) * (1.f / DM) + NORM_EPS);
            if (lane == 0) rstd_s[wave * 16 + i] = rstd;
            GAS v2u* o = (GAS v2u*)(HN + (size_t)row * DM) + lane;
#pragma unroll
            for (int j = 0; j < 4; ++j) { const f32x4 s4 = *(const LAS f32x4*)(sc + lane * 4 + 256 * j), h4 = *(const LAS f32x4*)(sh + lane * 4 + 256 * j); const f32x4 h = v[j] * rstd * s4 + h4;
                v2u w; w.x = pk2(h.x, h.y); w.y = pk2(h.z, h.w); o[64 * j] = w; }
          } }
        __syncthreads();
        if (tid < 48) { float s = 0.f;
#pragma unroll
            for (int p = 0; p < 8; ++p) s += cpart[p * 48 + tid];
            s += tid < 4 ? a->in[I_MBRG][l * 4 + tid] : (tid < 36 ? a->in[I_MBRE][l * 32 + tid - 4] : 0.f); cvec[tid] = s; }
        {
            const int i16 = lane & 15, kq = lane >> 4, r0 = c * 128 + wave * 16;
            f32x4m acc0 = {0.f, 0.f, 0.f, 0.f}, acc1 = acc0, acc2 = acc0;
            const float* xrow = x + (size_t)(r0 + i16) * DM + 4 * kq;
            constexpr int PD = 2;
            const float* wbase = RTW + (size_t)(kq * 16 + i16) * 12;
            f32x4 xq[PD], wq[PD][3];
#pragma unroll
            for (int s = 0; s < PD; ++s) { xq[s] = *(const GAS f32x4*)(xrow + 16 * s); const GAS f32x4* wp = (const GAS f32x4*)(wbase + (size_t)(4 * s) * 16 * 12); wq[s][0] = wp[0]; wq[s][1] = wp[1]; wq[s][2] = wp[2]; }
            for (int k0 = 0; k0 < DM; k0 += 16 * PD) {
#pragma unroll
                for (int s = 0; s < PD; ++s) {
                    const f32x4 xv = xq[s], w0 = wq[s][0], w1 = wq[s][1], w2 = wq[s][2];
                    { const int kn = min(k0 + 16 * (s + PD), DM - 16); xq[s] = *(const GAS f32x4*)(xrow + kn); const GAS f32x4* wp = (const GAS f32x4*)(wbase + (size_t)(kn >> 2) * 16 * 12); wq[s][0] = wp[0]; wq[s][1] = wp[1]; wq[s][2] = wp[2]; }
                    __builtin_amdgcn_sched_barrier(0);
                    const f32x4 sv = *(const LAS f32x4*)(sc + k0 + 16 * s + 4 * kq);
                    const float wf[12] = {w0[0], w0[1], w0[2], w0[3], w1[0], w1[1], w1[2], w1[3], w2[0], w2[1], w2[2], w2[3]};
#pragma unroll
                    for (int j = 0; j < 4; ++j) { const float av = xv[j] * sv[j];
                        acc0 = __builtin_amdgcn_mfma_f32_16x16x4f32(av, wf[j * 3], acc0, 0, 0, 0);
                        acc1 = __builtin_amdgcn_mfma_f32_16x16x4f32(av, wf[j * 3 + 1], acc1, 0, 0, 0);
                        acc2 = __builtin_amdgcn_mfma_f32_16x16x4f32(av, wf[j * 3 + 2], acc2, 0, 0, 0); }
                }
            }
            __syncthreads();
            LAS float* lw = lg + wave * 16 * 48;
#pragma unroll
            for (int r = 0; r < 4; ++r) { const int rr = 4 * kq + r; const float rs = rstd_s[wave * 16 + rr];
                lw[rr * 48 + i16] = acc0[r] * rs + cvec[i16]; lw[rr * 48 + 16 + i16] = acc1[r] * rs + cvec[16 + i16]; lw[rr * 48 + 32 + i16] = acc2[r] * rs + cvec[32 + i16]; }
            LDS_WAIT(); asm volatile("" ::: "memory");
            if (lane < 16) {
                const LAS float* lr = lw + lane * 48; const int row = r0 + lane;
                float g0 = lr[0], g1 = lr[1], g2 = lr[2], g3 = lr[3]; const float gm = fmaxf(fmaxf(g0, g1), fmaxf(g2, g3));
                float p0 = __expf(g0 - gm), p1 = __expf(g1 - gm), p2 = __expf(g2 - gm), p3 = __expf(g3 - gm); const float inv = 1.f / (p0 + p1 + p2 + p3);
                p0 *= inv; p1 *= inv; p2 *= inv; p3 *= inv;
                int gi = 0; float gp = p0; if (p1 > gp) { gp = p1; gi = 1; } if (p2 > gp) { gp = p2; gi = 2; } if (p3 > gp) { gp = p3; gi = 3; }
                float ev0 = -3.4e38f, ev1 = -3.4e38f; int e0 = 0, e1 = 0;
#pragma unroll
                for (int j = 0; j < 8; ++j) { const float s = lr[4 + gi * 8 + j]; if (s > ev0) { ev1 = ev0; e1 = e0; ev0 = s; e0 = j; } else if (s > ev1) { ev1 = s; e1 = j; } }
                const float q = __expf(ev1 - ev0), w0 = gp / (1.f + q), w1 = gp * q / (1.f + q);
                e0 += gi * 8; e1 += gi * 8;
                TOKE[2 * row] = e0; TOKE[2 * row + 1] = e1; TOKW[2 * row] = w0; TOKW[2 * row + 1] = w1;
                const int a0 = 2 * (wave * 16 + lane);
                asg_e[a0] = e0; asg_e[a0 + 1] = e1; asg_lp[a0] = atomicAdd((int*)&hist[e0], 1); asg_lp[a0 + 1] = atomicAdd((int*)&hist[e1], 1);
            }
        }
        __syncthreads();
        if (tid < 32) { const int h = hist[tid]; basev[tid] = h ? (int)atomicAdd(CNT + tid, (unsigned)h) : 0; }
        __syncthreads();
        if (tid < 256) { const int e = asg_e[tid]; LIST[(size_t)e * 65536 + basev[e] + asg_lp[tid]] = (c * 128) * 2 + tid; }
    }
}
__device__ __forceinline__ void build_ptab(const unsigned* CNT, LAS int* ptab, LAS int* pst, LAS int* cnt, int tid) {
    __syncthreads();
    if (tid < NEXP) {
        const int ce = (int)__hip_atomic_load(CNT + tid, RLX_AGENT); cnt[tid] = ce; const int pe = (ce + 255) >> 8;
        int incl = pe;
#pragma unroll
        for (int d = 1; d < NEXP; d <<= 1) { const int t = __shfl_up(incl, d, 64); if (tid >= d) incl += t; }
        const int start = incl - pe; pst[tid] = start * 256;
        for (int p = 0; p < pe; ++p) ptab[1 + start + p] = tid;
        if (tid == NEXP - 1) ptab[0] = incl; }
    __syncthreads();
}
__device__ __forceinline__ void phase_gather(KArgsP a, LAS unsigned char* lds, int tid, int lane, int wave, int vcu, int G, int l) {
    unsigned char* ws = a->ws;
    LAS int* ptab = (LAS int*)lds; LAS int* pst = ptab + 512; LAS int* cnt = pst + 32;
    build_ptab((const unsigned*)(ws + WS_CTL) + CW_CNT + l * 32, ptab, pst, cnt, tid);
    const bf16* HN = (const bf16*)(ws + WS_HN); bf16* XG = (bf16*)(ws + WS_XG); int* ROWMAP = (int*)(ws + WS_ROWMAP); const int* LIST = (const int*)(ws + WS_LIST);
    const int nrows = ptab[0] * 256;
    for (int row0 = (vcu * NWAVES + wave) * 8; row0 < nrows; row0 += G * NWAVES * 8) {
        int tok2[8]; v4u p0[8], p1[8];
#pragma unroll
        for (int j = 0; j < 8; ++j) { const int row = row0 + j, e = ptab[1 + (row >> 8)], pos = row - pst[e]; tok2[j] = (pos < cnt[e]) ? LIST[(size_t)e * 65536 + pos] : -1; }
#pragma unroll
        for (int j = 0; j < 8; ++j) { if (tok2[j] >= 0) { const GAS v4u* s = (const GAS v4u*)(HN + (size_t)(tok2[j] >> 1) * DM) + lane; p0[j] = s[0]; p1[j] = s[64]; } else { p0[j] = (v4u){0u, 0u, 0u, 0u}; p1[j] = p0[j]; } }
#pragma unroll
        for (int j = 0; j < 8; ++j) { GAS v4u* d = (GAS v4u*)(XG + (size_t)(row0 + j) * DM) + lane; d[0] = p0[j]; d[64] = p1[j]; if (lane == 0) ROWMAP[row0 + j] = tok2[j]; }
    }
}

__device__ __forceinline__ void phase_rowmap(KArgsP a, LAS unsigned char* lds, int tid, int vcu, int G, int l) {
    unsigned char* ws = a->ws;
    LAS int* ptab = (LAS int*)lds; LAS int* pst = ptab + 512; LAS int* cnt = pst + 32;
    build_ptab((const unsigned*)(ws + WS_CTL) + CW_CNT + l * 32, ptab, pst, cnt, tid);
    int* ROWMAP = (int*)(ws + WS_ROWMAP); const int* LIST = (const int*)(ws + WS_LIST);
    const int nrows = ptab[0] * 256;
    for (int row = vcu * NTHR + tid; row < nrows; row += G * NTHR) { const int e = ptab[1 + (row >> 8)], pos = row - pst[e]; ROWMAP[row] = (pos < cnt[e]) ? LIST[(size_t)e * 65536 + pos] : -1; }
}

typedef short bf16x8 __attribute__((ext_vector_type(8)));
constexpr int MT = 72;
constexpr int ML_XP = 0;
constexpr int ML_CX = 17152;
constexpr int ML_WQ = ML_CX + 9216, ML_WK = ML_WQ + 9216;
constexpr int ML_Q = ML_WK + 9216, ML_K = ML_Q + 9216;
constexpr int ML_S = ML_K + 9216;
constexpr int ML_VT = ML_S + 9216;
constexpr int ML_CT = ML_VT + 11520;
constexpr int ML_H = ML_CT + 11520;
constexpr int ML_SM = ML_H + 16640;
static_assert(ML_SM + 2048 <= RING_BYTES, "mLSTM LDS map");
__device__ __forceinline__ float logsigmoidf_(float x) { return fminf(x, 0.f) - log1pf(__expf(-fabsf(x))); }
__device__ __forceinline__ void mma64(const LAS bf16* A, int arow0, const LAS bf16* Bt, int brow0, int lane, f32x4& acc) {
    const LAS bf16* ap = A + (arow0 + (lane & 15)) * MT + 8 * (lane >> 4); const LAS bf16* bp = Bt + (brow0 + (lane & 15)) * MT + 8 * (lane >> 4);
    const bf16x8 a0 = *(const LAS bf16x8*)ap, a1 = *(const LAS bf16x8*)(ap + 32), b0 = *(const LAS bf16x8*)bp, b1 = *(const LAS bf16x8*)(bp + 32);
    acc = __builtin_amdgcn_mfma_f32_16x16x32_bf16(a0, b0, acc, 0, 0, 0); acc = __builtin_amdgcn_mfma_f32_16x16x32_bf16(a1, b1, acc, 0, 0, 0);
}
__device__ __forceinline__ void ml_front(KArgsP a, LAS unsigned char* lds, int tid, int l, int b, int c, int h, bool want_q) {
    const bf16* PROJ = (const bf16*)(a->ws + WS_PROJ); const size_t row0 = (size_t)b * SEQ + c * 64;
    LAS float* xp = (LAS float*)(lds + ML_XP);
    for (int idx = tid; idx < 67 * 8; idx += NTHR) { const int r = idx >> 3, c8 = idx & 7, tr = c * 64 + r - 3; LAS float* d = xp + r * 64 + c8 * 8;
        if (tr >= 0) { const v4u p = *(const GAS v4u*)(PROJ + ((size_t)b * SEQ + tr) * NPROJ + PC_QK + h * 64 + c8 * 8);
            *(LAS f32x4*)d = (f32x4){bflo(p.x), bfhi(p.x), bflo(p.y), bfhi(p.y)}; *(LAS f32x4*)(d + 4) = (f32x4){bflo(p.z), bfhi(p.z), bflo(p.w), bfhi(p.w)}; }
        else { *(LAS f32x4*)d = (f32x4){0.f, 0.f, 0.f, 0.f}; *(LAS f32x4*)(d + 4) = (f32x4){0.f, 0.f, 0.f, 0.f}; } }
    {
        const int t = tid >> 3, vg = tid & 7; LAS bf16* VT = (LAS bf16*)(lds + ML_VT);
        const v4u p = *(const GAS v4u*)(PROJ + (row0 + t) * NPROJ + PC_V + h * 64 + vg * 8);
        const unsigned w[4] = {p.x, p.y, p.z, p.w};
#pragma unroll
        for (int j = 0; j < 4; ++j) { VT[(vg * 8 + 2 * j) * MT + t] = (bf16)(w[j] & 0xffffu); VT[(vg * 8 + 2 * j + 1) * MT + t] = (bf16)(w[j] >> 16); }
        for (int idx = tid; idx < 16 * 64; idx += NTHR) VT[(64 + (idx >> 6)) * MT + (idx & 63)] = (idx < 64) ? (bf16)0x3F80 : (bf16)0;
        const bf16* WT = (const bf16*)(a->ws + WS_MLW) + (size_t)((l * NH + h) * 2) * 4096;
        const int e = tid >> 3, d8 = tid & 7;
        if (want_q) *(LAS v4u*)(lds + ML_WQ + (e * MT + d8 * 8) * 2) = *(const GAS v4u*)(WT + e * 64 + d8 * 8);
        *(LAS v4u*)(lds + ML_WK + (e * MT + d8 * 8) * 2) = *(const GAS v4u*)(WT + 4096 + e * 64 + d8 * 8);
    }
    __syncthreads();
    const float* cw = a->in[I_CONV_W] + (size_t)l * 4 * DA + h * 64; const float* cb = a->in[I_CONV_B] + (size_t)l * DA + h * 64;
    {
        const int t = tid >> 3, c8 = (tid & 7) * 8; float s[8];
#pragma unroll
        for (int j = 0; j < 8; ++j) s[j] = cb[c8 + j];
#pragma unroll
        for (int q = 0; q < 4; ++q) { const f32x4 x0 = *(const LAS f32x4*)(xp + (t + q) * 64 + c8), x1 = *(const LAS f32x4*)(xp + (t + q) * 64 + c8 + 4); const float* w = cw + q * DA + c8;
            s[0] += x0.x * w[0]; s[1] += x0.y * w[1]; s[2] += x0.z * w[2]; s[3] += x0.w * w[3]; s[4] += x1.x * w[4]; s[5] += x1.y * w[5]; s[6] += x1.z * w[6]; s[7] += x1.w * w[7]; }
#pragma unroll
        for (int j = 0; j < 8; ++j) s[j] = s[j] / (1.f + __expf(-s[j]));
        v4u o; o.x = pk2(s[0], s[1]); o.y = pk2(s[2], s[3]); o.z = pk2(s[4], s[5]); o.w = pk2(s[6], s[7]);
        *(LAS v4u*)(lds + ML_CX + (t * MT + c8) * 2) = o;
    }
}
__device__ __forceinline__ void phase_m1(KArgsP a, LAS unsigned char* lds, int tid, int lane, int wave, int vcu, int G, int l) {
    unsigned char* ws = a->ws; const float* GT = (const float*)(ws + WS_GATES);
    float* CLOC = (float*)(ws + WS_CLOC); float* MLG = (float*)(ws + WS_MSC); float* MLM = MLG + 4096;
    LAS float* sm = (LAS float*)(lds + ML_SM);
    for (int u = vcu; u < NUNIT_M; u += G) {
        const int h = u % NH, c = (u / NH) % NCH, b = u / (NH * NCH); const size_t row0 = (size_t)b * SEQ + c * 64;
        __syncthreads();
        ml_front(a, lds, tid, l, b, c, h, false);
        if (wave == 0) {
            const float ig = GT[(row0 + lane) * 16 + h] + a->in[I_BI][l * NH + h];
            const float fl = logsigmoidf_(GT[(row0 + lane) * 16 + 6 + h] + a->in[I_BF][l * NH + h]);
            float bc = fl;
#pragma unroll
            for (int o = 1; o < 64; o <<= 1) { const float t = __shfl_up(bc, o); if (lane >= o) bc += t; }
            const float gtot = __shfl(bc, 63); const float lw = gtot - bc + ig; const float ml = wave_max(lw);
            sm[lane] = __expf(lw - ml);
            if (lane == 0) { MLG[u] = gtot; MLM[u] = ml; }
        }
        __syncthreads();
        {
            const int rt = wave >> 1; LAS bf16* KT = (LAS bf16*)(lds + ML_K);
#pragma unroll
            for (int q = 0; q < 2; ++q) { const int ct = 2 * (wave & 1) + q; f32x4 acc = {0.f, 0.f, 0.f, 0.f};
                mma64((const LAS bf16*)(lds + ML_CX), 16 * rt, (const LAS bf16*)(lds + ML_WK), 16 * ct, lane, acc);
                const int t0 = 16 * rt + 4 * (lane >> 4), e = 16 * ct + (lane & 15);
                const float w0 = sm[t0] * 0.125f, w1 = sm[t0 + 1] * 0.125f, w2 = sm[t0 + 2] * 0.125f, w3 = sm[t0 + 3] * 0.125f;
                v2u o; o.x = pk2(acc[0] * w0, acc[1] * w1); o.y = pk2(acc[2] * w2, acc[3] * w3);
                *(LAS v2u*)(KT + e * MT + t0) = o; }
        }
        __syncthreads();
        {
            const int ct = wave & 3, r_lo = wave < 4 ? 0 : 3, r_hi = wave < 4 ? 3 : 5; float* cl = CLOC + (size_t)u * CL_STRIDE;
            for (int rt = r_lo; rt < r_hi; ++rt) { f32x4 acc = {0.f, 0.f, 0.f, 0.f};
                mma64((const LAS bf16*)(lds + ML_VT), 16 * rt, (const LAS bf16*)(lds + ML_K), 16 * ct, lane, acc);
                const int v0 = 16 * rt + 4 * (lane >> 4), e = 16 * ct + (lane & 15);
                if (rt < 4) {
#pragma unroll
                    for (int r = 0; r < 4; ++r) cl[(v0 + r) * 64 + e] = acc[r];
                } else if ((lane >> 4) == 0) cl[4096 + e] = acc[0]; }
        }
    }
}
__device__ __forceinline__ void phase_m2(unsigned char* ws, int tid, int wg, int nwg) {
    float* CLOC = (float*)(ws + WS_CLOC); const float* MLG = (const float*)(ws + WS_MSC); const float* MLM = MLG + 4096; float* MST = (float*)(ws + WS_MSC) + 8192;
    for (int idx = wg * NTHR + tid; idx < NB * NH * CL_STRIDE; idx += nwg * NTHR) {
        const int e = idx % CL_STRIDE, bh = idx / CL_STRIDE, b = bh / NH, h = bh % NH;
        float m = 0.f, cs = 0.f;
        float cn[8], gn[8], mn8[8];
#pragma unroll
        for (int j = 0; j < 8; ++j) { const int u = (b * NCH + j) * NH + h; cn[j] = CLOC[(size_t)u * CL_STRIDE + e]; gn[j] = MLG[u]; mn8[j] = MLM[u]; }
        for (int c0 = 0; c0 < NCH; c0 += 8) {
            float cl[8], g[8], ml[8];
#pragma unroll
            for (int j = 0; j < 8; ++j) { cl[j] = cn[j]; g[j] = gn[j]; ml[j] = mn8[j]; }
            { const int cq = min(c0 + 8, NCH - 8);
#pragma unroll
              for (int j = 0; j < 8; ++j) { const int u = (b * NCH + cq + j) * NH + h; cn[j] = CLOC[(size_t)u * CL_STRIDE + e]; gn[j] = MLG[u]; mn8[j] = MLM[u]; } }
#pragma unroll
            for (int j = 0; j < 8; ++j) { const int u = (b * NCH + c0 + j) * NH + h;
                CLOC[(size_t)u * CL_STRIDE + e] = cs; if (e == 0) MST[u] = m;
                const float mn = fmaxf(g[j] + m, ml[j]); const float ao = __expf(g[j] + m - mn), al = __expf(ml[j] - mn);
                cs = ao * cs + al * cl[j]; m = mn; }
        }
    }
}
__device__ __forceinline__ void phase_m3(KArgsP a, LAS unsigned char* lds, int tid, int lane, int wave, int vcu, int G, int l) {
    unsigned char* ws = a->ws; const bf16* PROJ = (const bf16*)(ws + WS_PROJ); const float* GT = (const float*)(ws + WS_GATES);
    const float* CLOC = (const float*)(ws + WS_CLOC); const float* MST = (const float*)(ws + WS_MSC) + 8192; bf16* YC = (bf16*)(ws + WS_YC);
    LAS float* sm = (LAS float*)(lds + ML_SM); LAS float* hb = (LAS float*)(lds + ML_H);
    for (int u = vcu; u < NUNIT_M; u += G) {
        const int h = u % NH, c = (u / NH) % NCH, b = u / (NH * NCH); const size_t row0 = (size_t)b * SEQ + c * 64;
        __syncthreads();
        ml_front(a, lds, tid, l, b, c, h, true);
        {
            const float* cl = CLOC + (size_t)u * CL_STRIDE; LAS bf16* CT = (LAS bf16*)(lds + ML_CT);
            for (int idx = tid; idx < 65 * 16; idx += NTHR) { const int r = idx >> 4, c4 = idx & 15; const f32x4 v = *(const GAS f32x4*)(cl + r * 64 + c4 * 4);
                v2u o; o.x = pk2(v.x, v.y); o.y = pk2(v.z, v.w); *(LAS v2u*)(CT + r * MT + c4 * 4) = o; }
            for (int idx = tid; idx < 15 * 64; idx += NTHR) CT[(65 + (idx >> 6)) * MT + (idx & 63)] = 0;
        }
        if (wave == 0) {
            const float ig = GT[(row0 + lane) * 16 + h] + a->in[I_BI][l * NH + h];
            const float fl = logsigmoidf_(GT[(row0 + lane) * 16 + 6 + h] + a->in[I_BF][l * NH + h]);
            float bc = fl;
#pragma unroll
            for (int o = 1; o < 64; o <<= 1) { const float t = __shfl_up(bc, o); if (lane >= o) bc += t; }
            float pm = ig - bc;
#pragma unroll
            for (int o = 1; o < 64; o <<= 1) { const float t = __shfl_up(pm, o); if (lane >= o) pm = fmaxf(pm, t); }
            const float mst = MST[u]; const float inter = bc + mst, mt = fmaxf(inter, bc + pm);
            sm[lane] = ig - bc; sm[64 + lane] = bc - mt; sm[128 + lane] = __expf(inter - mt); sm[192 + lane] = __expf(-mt);
        }
        __syncthreads();
        {
            const int rt = wave >> 1; LAS bf16* Qs = (LAS bf16*)(lds + ML_Q); LAS bf16* Ks = (LAS bf16*)(lds + ML_K);
#pragma unroll
            for (int q = 0; q < 2; ++q) { const int ct = 2 * (wave & 1) + q; f32x4 aq = {0.f, 0.f, 0.f, 0.f}, ak = {0.f, 0.f, 0.f, 0.f};
                mma64((const LAS bf16*)(lds + ML_CX), 16 * rt, (const LAS bf16*)(lds + ML_WQ), 16 * ct, lane, aq);
                mma64((const LAS bf16*)(lds + ML_CX), 16 * rt, (const LAS bf16*)(lds + ML_WK), 16 * ct, lane, ak);
                const int t0 = 16 * rt + 4 * (lane >> 4), e = 16 * ct + (lane & 15);
#pragma unroll
                for (int r = 0; r < 4; ++r) { Qs[(t0 + r) * MT + e] = (bf16)f2bf(aq[r]); Ks[(t0 + r) * MT + e] = (bf16)f2bf(ak[r] * 0.125f); } }
        }
        __syncthreads();
        {
            const int rt = wave >> 1; LAS bf16* Ss = (LAS bf16*)(lds + ML_S);
#pragma unroll
            for (int q = 0; q < 2; ++q) { const int ct = 2 * (wave & 1) + q; f32x4 acc = {0.f, 0.f, 0.f, 0.f};
                if (ct <= rt) mma64((const LAS bf16*)(lds + ML_Q), 16 * rt, (const LAS bf16*)(lds + ML_K), 16 * ct, lane, acc);
                const int t0 = 16 * rt + 4 * (lane >> 4), s = 16 * ct + (lane & 15); const float qs = sm[s];
#pragma unroll
                for (int r = 0; r < 4; ++r) { const int t = t0 + r; Ss[t * MT + s] = (bf16)f2bf((s <= t) ? acc[r] * __expf(sm[64 + t] + qs) : 0.f); } }
        }
        __syncthreads();
        {
            const int rt = wave >> 1, nt = (wave & 1) ? 2 : 3;
            for (int q = 0; q < nt; ++q) { const int ct = (wave & 1) ? 2 + q : (q < 2 ? q : 4); f32x4 aA = {0.f, 0.f, 0.f, 0.f}, aB = {0.f, 0.f, 0.f, 0.f};
                mma64((const LAS bf16*)(lds + ML_Q), 16 * rt, (const LAS bf16*)(lds + ML_CT), 16 * ct, lane, aA);
                mma64((const LAS bf16*)(lds + ML_S), 16 * rt, (const LAS bf16*)(lds + ML_VT), 16 * ct, lane, aB);
                const int t0 = 16 * rt + 4 * (lane >> 4), v = 16 * ct + (lane & 15);
#pragma unroll
                for (int r = 0; r < 4; ++r) { const int t = t0 + r; const float x = sm[128 + t] * aA[r] + aB[r];
                    if (ct < 4) hb[t * 65 + v] = x; else if ((lane & 15) == 0) sm[256 + t] = x; } }
        }
        __syncthreads();
        {
            const int t = tid >> 3, vg = tid & 7; float acc[8];
            const float dn = 1.f / fmaxf(fabsf(sm[256 + t]), sm[192 + t]);
            float s1 = 0.f;
#pragma unroll
            for (int j = 0; j < 8; ++j) { acc[j] = hb[t * 65 + vg * 8 + j] * dn; s1 += acc[j]; }
            s1 += __shfl_xor(s1, 1); s1 += __shfl_xor(s1, 2); s1 += __shfl_xor(s1, 4);
            const float mu = s1 * (1.f / 64.f); float s2 = 0.f;
#pragma unroll
            for (int j = 0; j < 8; ++j) { acc[j] -= mu; s2 += acc[j] * acc[j]; }
            s2 += __shfl_xor(s2, 1); s2 += __shfl_xor(s2, 2); s2 += __shfl_xor(s2, 4);
            const float rs = rsqrtf(s2 * (1.f / 64.f) + HEAD_NORM_EPS);
            const float* nw = a->in[I_MNORM_W] + (size_t)l * DA + h * 64 + vg * 8;
            const v4u ov = *(const GAS v4u*)(PROJ + (row0 + t) * NPROJ + PC_O + h * 64 + vg * 8);
            const float o[8] = {bflo(ov.x), bfhi(ov.x), bflo(ov.y), bfhi(ov.y), bflo(ov.z), bfhi(ov.z), bflo(ov.w), bfhi(ov.w)};
            float r[8];
#pragma unroll
            for (int j = 0; j < 8; ++j) r[j] = acc[j] * rs * nw[j] * sigmoidf_(o[j]);
            v4u w; w.x = pk2(r[0], r[1]); w.y = pk2(r[2], r[3]); w.z = pk2(r[4], r[5]); w.w = pk2(r[6], r[7]);
            *(GAS v4u*)(YC + (row0 + t) * DM + h * 64 + vg * 8) = w;
        }
    }
}

constexpr int S5_UT = 264, S5_XT = 2056;
constexpr int S5_U = 0, S5_Z = 33792, S5_X = 67584;
static_assert(S5_X + 16 * S5_XT * 2 <= MISC_OFF, "S5 LDS map");
struct S5A { float are, aim, cre, cim; };
__device__ __forceinline__ S5A s5_a(KArgsP a, int l, int g, int p) {
    const float lam_re = a->in[I_S5ARE][(size_t)(l * 16 + g) * 64 + p], lam_im = a->in[I_S5AIM][(size_t)(l * 16 + g) * 64 + p];
    const float dt = expf(a->in[I_S5LDT][l * 16 + g]); const float mag = expf(lam_re * dt), ang = lam_im * dt;
    S5A r; r.are = mag * cosf(ang); r.aim = mag * sinf(ang);
    const float inv = 1.f / (lam_re * lam_re + lam_im * lam_im);
    r.cre = ((r.are - 1.f) * lam_re + r.aim * lam_im) * inv; r.cim = (r.aim * lam_re - (r.are - 1.f) * lam_im) * inv; return r;
}
__device__ __forceinline__ bf16x8 pack8(const float* v) { v4u o; o.x = pk2(v[0], v[1]); o.y = pk2(v[2], v[3]); o.z = pk2(v[4], v[5]); o.w = pk2(v[6], v[7]); return __builtin_bit_cast(bf16x8, o); }
__device__ __forceinline__ void s5_bfrag(const unsigned char* ws, int l, int g, int lane, bf16x8 (&bf)[8]) {
    const bf16* BB = (const bf16*)(ws + WS_S5BB) + (size_t)(l * 16 + g) * 128 * 16;
#pragma unroll
    for (int j = 0; j < 8; ++j) { v4u o = {0u, 0u, 0u, 0u}; if ((lane >> 4) < 2) o = *(const GAS v4u*)(BB + (16 * j + (lane & 15)) * 16 + 8 * (lane >> 4)); bf[j] = __builtin_bit_cast(bf16x8, o); }
}
__device__ __forceinline__ f32x2 s5_ap(const unsigned char* ws, int l, int g, int p) { return *(const GAS f32x2*)((const float*)(ws + WS_S5AP) + ((size_t)(l * 16 + g) * 64 + p) * 2); }
__device__ __forceinline__ void s5_load_u(const unsigned char* ws, LAS unsigned char* lds, int tid, size_t row0) {
    const bf16* PROJ = (const bf16*)(ws + WS_PROJ);
    for (int idx = tid; idx < 64 * 32; idx += NTHR) { const int t = idx >> 5, c8 = idx & 31;
        *(LAS v4u*)(lds + S5_U + (t * S5_UT + c8 * 8) * 2) = *(const GAS v4u*)(PROJ + (row0 + t) * NPROJ + PC_S5 + c8 * 8); }
}
__device__ __forceinline__ void s5_block(LAS unsigned char* lds, int lane, int tb, int g, const bf16x8 (&bf)[8], float are, float aim, float& xr, float& xi) {
    const int kq = lane >> 4; bf16x8 uf = {0, 0, 0, 0, 0, 0, 0, 0};
    if (kq < 2) uf = *(const LAS bf16x8*)(lds + S5_U + ((16 * tb + (lane & 15)) * S5_UT + g * 16 + 8 * kq) * 2);
    LAS bf16* X = (LAS bf16*)(lds + S5_X);
#pragma unroll
    for (int j = 0; j < 8; ++j) { f32x4 acc = {0.f, 0.f, 0.f, 0.f}; acc = __builtin_amdgcn_mfma_f32_16x16x32_bf16(bf[j], uf, acc, 0, 0, 0);
        v2u o; o.x = pk2(acc[0], acc[1]); o.y = pk2(acc[2], acc[3]); *(LAS v2u*)(X + (lane & 15) * S5_XT + g * 128 + 16 * j + 4 * kq) = o; }
    LDS_WAIT(); asm volatile("" ::: "memory");
    LAS unsigned* xw = (LAS unsigned*)(lds + S5_X) + (g * 128 + 2 * lane) / 2;
    unsigned wv[16];
#pragma unroll
    for (int t = 0; t < 16; ++t) wv[t] = xw[t * (S5_XT / 2)];
#pragma unroll
    for (int t = 0; t < 16; ++t) { const float br = bflo(wv[t]), bi = bfhi(wv[t]);
        const float nr = are * xr - aim * xi + br, ni = are * xi + aim * xr + bi; xr = nr; xi = ni;
        wv[t] = pk2(xr, xi); }
#pragma unroll
    for (int t = 0; t < 16; ++t) xw[t * (S5_XT / 2)] = wv[t];
    LDS_WAIT(); asm volatile("" ::: "memory");
}
__device__ __forceinline__ void phase_s1(KArgsP a, LAS unsigned char* lds, int tid, int lane, int wave, int vcu, int G, int l) {
    unsigned char* ws = a->ws; float* ST = (float*)(ws + WS_S5ST);
    bf16x8 bf0[8], bf1[8]; s5_bfrag(ws, l, wave, lane, bf0); s5_bfrag(ws, l, wave + 8, lane, bf1);
    struct { float are, aim; } A0, A1; { const f32x2 q0 = s5_ap(ws, l, wave, lane), q1 = s5_ap(ws, l, wave + 8, lane); A0.are = q0.x; A0.aim = q0.y; A1.are = q1.x; A1.aim = q1.y; }
    for (int u = vcu; u < NB * NCH; u += G) {
        const size_t row0 = (size_t)u * 64;
        __syncthreads();
        s5_load_u(ws, lds, tid, row0);
        __syncthreads();
        float x0r = 0.f, x0i = 0.f, x1r = 0.f, x1i = 0.f;
        for (int tb = 0; tb < 4; ++tb) { s5_block(lds, lane, tb, wave, bf0, A0.are, A0.aim, x0r, x0i); s5_block(lds, lane, tb, wave + 8, bf1, A1.are, A1.aim, x1r, x1i); }
        *(f32x2*)(ST + (((size_t)u * 16 + wave) * 64 + lane) * 2) = (f32x2){x0r, x0i};
        *(f32x2*)(ST + (((size_t)u * 16 + wave + 8) * 64 + lane) * 2) = (f32x2){x1r, x1i};
    }
}
__device__ __forceinline__ void phase_s2(KArgsP a, int tid, int wg, int nwg, int l) {
    float* ST = (float*)(a->ws + WS_S5ST);
    for (int idx = wg * NTHR + tid; idx < NB * 1024; idx += nwg * NTHR) {
        const int b = idx >> 10, gp = idx & 1023, g = gp >> 6, p = gp & 63;
        const f32x2 A = s5_ap(a->ws, l, g, p); float ar = A.x, ai = A.y;
#pragma unroll
        for (int s = 0; s < 6; ++s) { const float nr = ar * ar - ai * ai, ni = 2.f * ar * ai; ar = nr; ai = ni; }
        float cr = 0.f, ci = 0.f;
        f32x2 en[8];
#pragma unroll
        for (int j = 0; j < 8; ++j) en[j] = *(const f32x2*)(ST + (((size_t)(b * NCH + j) * 16 + g) * 64 + p) * 2);
        for (int c0 = 0; c0 < NCH; c0 += 8) {
            f32x2 e[8];
#pragma unroll
            for (int j = 0; j < 8; ++j) e[j] = en[j];
            { const int cq = min(c0 + 8, NCH - 8);
#pragma unroll
              for (int j = 0; j < 8; ++j) en[j] = *(const f32x2*)(ST + (((size_t)(b * NCH + cq + j) * 16 + g) * 64 + p) * 2); }
#pragma unroll
            for (int j = 0; j < 8; ++j) { *(f32x2*)(ST + (((size_t)(b * NCH + c0 + j) * 16 + g) * 64 + p) * 2) = (f32x2){cr, ci};
                const float nr = ar * cr - ai * ci + e[j].x, ni = ar * ci + ai * cr + e[j].y; cr = nr; ci = ni; }
        }
    }
}
__device__ __forceinline__ float tanh_fast(float x) { return 1.f - 2.f / (1.f + __expf(2.f * x)); }
__device__ __forceinline__ float gelu_tanh_(float x) { const float t = tanh_fast(0.7978845608f * (x + 0.044715f * x * x * x)); return 0.5f * x * (1.f + t); }
__device__ __forceinline__ void s5_cload(const bf16* cmt  , int lane, bf16x8 (&cf)[4]) {
#pragma unroll
    for (int s = 0; s < 4; ++s) cf[s] = __builtin_bit_cast(bf16x8, *(const GAS v4u*)(cmt + (lane & 15) * 128 + 32 * s + 8 * (lane >> 4)));
}
__device__ __forceinline__ void s5_cproj(LAS unsigned char* lds, int lane, int tb, int g, const bf16x8 (&cf)[4], const float (&dv)[4]) {
    const int kq = lane >> 4; f32x4 acc = {0.f, 0.f, 0.f, 0.f};
    const LAS bf16* xp = (const LAS bf16*)(lds + S5_X) + (lane & 15) * S5_XT + g * 128 + 8 * kq;
#pragma unroll
    for (int s = 0; s < 4; ++s) acc = __builtin_amdgcn_mfma_f32_16x16x32_bf16(cf[s], *(const LAS bf16x8*)(xp + 32 * s), acc, 0, 0, 0);
    const int t = 16 * tb + (lane & 15), c0 = g * 16 + 4 * kq;
    const v2u uw = *(const LAS v2u*)(lds + S5_U + (t * S5_UT + c0) * 2);
    const float u4[4] = {bflo(uw.x), bfhi(uw.x), bflo(uw.y), bfhi(uw.y)}; float z[4];
#pragma unroll
    for (int r = 0; r < 4; ++r) z[r] = gelu_tanh_(acc[r] + dv[r] * u4[r]);
    v2u o; o.x = pk2(z[0], z[1]); o.y = pk2(z[2], z[3]); *(LAS v2u*)(lds + S5_Z + (t * S5_UT + c0) * 2) = o;
}
__device__ __forceinline__ void phase_s3(KArgsP a, LAS unsigned char* lds, int tid, int lane, int wave, int vcu, int G, int l, unsigned* qctr = nullptr) {
    unsigned char* ws = a->ws; const float* ST = (const float*)(ws + WS_S5ST); bf16* YC = (bf16*)(ws + WS_YC);
    const bf16* GLUT = (const bf16*)(ws + WS_GLUT) + (size_t)l * DC * DC;
    bf16x8 bf0[8], bf1[8]; s5_bfrag(ws, l, wave, lane, bf0); s5_bfrag(ws, l, wave + 8, lane, bf1);
    const bf16* cm0 = (const bf16*)(ws + WS_S5CM) + (size_t)(l * 16 + wave) * 2048; const bf16* cm1 = cm0 + 8 * 2048;
    struct { float are, aim; } A0, A1; { const f32x2 q0 = s5_ap(ws, l, wave, lane), q1 = s5_ap(ws, l, wave + 8, lane); A0.are = q0.x; A0.aim = q0.y; A1.are = q1.x; A1.aim = q1.y; }
    float d0[4], d1[4];
#pragma unroll
    for (int r = 0; r < 4; ++r) { d0[r] = a->in[I_S5D][l * DC + wave * 16 + 4 * (lane >> 4) + r]; d1[r] = a->in[I_S5D][l * DC + (wave + 8) * 16 + 4 * (lane >> 4) + r]; }
    volatile LAS unsigned* qw = (volatile LAS unsigned*)(lds + MISC_OFF) + 20;
    unsigned qn = 0u; if (qctr && tid == 0) qn = __hip_atomic_fetch_add(qctr, 1u, __ATOMIC_RELAXED, __HIP_MEMORY_SCOPE_AGENT);
    for (int u = vcu; ; u += G) {
        if (qctr) { __syncthreads(); if (tid == 0) *qw = qn; __syncthreads(); u = (int)*qw; }
        if (u >= NB * NCH) break;
        if (qctr && tid == 0) qn = __hip_atomic_fetch_add(qctr, 1u, __ATOMIC_RELAXED, __HIP_MEMORY_SCOPE_AGENT);
        const size_t row0 = (size_t)u * 64;
        __syncthreads();
        s5_load_u(ws, lds, tid, row0);
        const f32x2 s0 = *(const f32x2*)(ST + (((size_t)u * 16 + wave) * 64 + lane) * 2), s1 = *(const f32x2*)(ST + (((size_t)u * 16 + wave + 8) * 64 + lane) * 2);
        float x0r = s0.x, x0i = s0.y, x1r = s1.x, x1i = s1.y;
        __syncthreads();
        for (int tb = 0; tb < 4; ++tb) {
            { bf16x8 cf[4]; s5_cload(cm0, lane, cf); s5_block(lds, lane, tb, wave, bf0, A0.are, A0.aim, x0r, x0i); s5_cproj(lds, lane, tb, wave, cf, d0); }
            { bf16x8 cf[4]; s5_cload(cm1, lane, cf); s5_block(lds, lane, tb, wave + 8, bf1, A1.are, A1.aim, x1r, x1i); s5_cproj(lds, lane, tb, wave + 8, cf, d1); }
        }
        __syncthreads();
        {
            const int kq = lane >> 4;
#pragma unroll
            for (int q = 0; q < 2; ++q) { const int ct = 2 * wave + q; f32x4 acc[4];
#pragma unroll
                for (int rt = 0; rt < 4; ++rt) acc[rt] = (f32x4){0.f, 0.f, 0.f, 0.f};
                const bf16* gp = GLUT + (size_t)(16 * ct + (lane & 15)) * DC + 8 * kq;
#pragma unroll 2
                for (int s = 0; s < 8; ++s) { const bf16x8 gf = __builtin_bit_cast(bf16x8, *(const GAS v4u*)(gp + 32 * s));
#pragma unroll
                    for (int rt = 0; rt < 4; ++rt) acc[rt] = __builtin_amdgcn_mfma_f32_16x16x32_bf16(gf, *(const LAS bf16x8*)(lds + S5_Z + ((16 * rt + (lane & 15)) * S5_UT + 32 * s + 8 * kq) * 2), acc[rt], 0, 0, 0); }
                const int j0 = 16 * ct + 4 * kq; const f32x4 gb = *(const GAS f32x4*)(a->in[I_S5GLUB] + l * DC + j0);
#pragma unroll
                for (int rt = 0; rt < 4; ++rt) { const int t = 16 * rt + (lane & 15); const v2u zw = *(const LAS v2u*)(lds + S5_Z + (t * S5_UT + j0) * 2);
                    const float z0 = bflo(zw.x), z1 = bfhi(zw.x), z2 = bflo(zw.y), z3 = bfhi(zw.y);
                    v2u o; o.x = pk2(z0 * sigmoidf_(acc[rt][0] + gb.x), z1 * sigmoidf_(acc[rt][1] + gb.y)); o.y = pk2(z2 * sigmoidf_(acc[rt][2] + gb.z), z3 * sigmoidf_(acc[rt][3] + gb.w));
                    *(GAS v2u*)(YC + (row0 + t) * DM + 768 + j0) = o; } }
        }
    }
}

__device__ __forceinline__ float rw_shift(const bf16* PROJ, const float* mu, size_t row, int col) {
    const float cur = bf2f(PROJ[row * NPROJ + PC_RW + col]); const float prv = (row % SEQ) ? bf2f(PROJ[(row - 1) * NPROJ + PC_RW + col]) : 0.f;
    return cur + mu[col] * (prv - cur);
}
constexpr int R1_TH = 0, R1_AD = 9216, R1_SG = 18432, R1_VS = 35840, R1_TMP = 86016;
template <int KS, int MODE>
__device__ __forceinline__ void r1_prod(const bf16* WT, const LAS bf16* act, int astride, const float* bias, bf16* OUT, size_t row0, int lane, int wave) {
    const int kq = lane >> 4, n0 = 48 * wave; constexpr int K = 32 * KS;
    f32x4 acc[3][4];
#pragma unroll
    for (int nt = 0; nt < 3; ++nt)
#pragma unroll
        for (int ti = 0; ti < 4; ++ti) acc[nt][ti] = (f32x4){0.f, 0.f, 0.f, 0.f};
#pragma unroll
    for (int s = 0; s < KS; ++s) { bf16x8 wf[3], af[4];
#pragma unroll
        for (int nt = 0; nt < 3; ++nt) wf[nt] = __builtin_bit_cast(bf16x8, *(const GAS v4u*)(WT + (size_t)(n0 + 16 * nt + (lane & 15)) * K + 32 * s + 8 * kq));
#pragma unroll
        for (int ti = 0; ti < 4; ++ti) af[ti] = *(const LAS bf16x8*)(act + (16 * ti + (lane & 15)) * astride + 32 * s + 8 * kq);
#pragma unroll
        for (int nt = 0; nt < 3; ++nt)
#pragma unroll
            for (int ti = 0; ti < 4; ++ti) acc[nt][ti] = __builtin_amdgcn_mfma_f32_16x16x32_bf16(wf[nt], af[ti], acc[nt][ti], 0, 0, 0); }
#pragma unroll
    for (int nt = 0; nt < 3; ++nt) { const int n = n0 + 16 * nt + 4 * kq; f32x4 bv = {0.f, 0.f, 0.f, 0.f}; if (MODE != 2) bv = *(const GAS f32x4*)(bias + n);
#pragma unroll
        for (int ti = 0; ti < 4; ++ti) { float o[4];
#pragma unroll
            for (int r = 0; r < 4; ++r) { const float x = acc[nt][ti][r] + bv[r]; o[r] = MODE == 0 ? 0.60653066f * sigmoidf_(x) : (MODE == 1 ? sigmoidf_(x) : x); }
            v2u w; w.x = pk2(o[0], o[1]); w.y = pk2(o[2], o[3]);
            *(GAS v2u*)(OUT + (row0 + 16 * ti + (lane & 15)) * DBR + n) = w; } }
}
__device__ __forceinline__ void phase_r1(KArgsP a, LAS unsigned char* lds, int tid, int lane, int wave, int vcu, int G, int l) {
    unsigned char* ws = a->ws; const bf16* PROJ = (const bf16*)(ws + WS_PROJ); const float* mu = a->in[I_RMU] + (size_t)l * RW_COLS;
    const bf16* W1 = (const bf16*)(ws + WS_R1W) + (size_t)l * 98304;
    const bf16* WV = (const bf16*)(ws + WS_R1W) + 2 * 98304;
    for (int u = vcu; u < NTOK / 64; u += G) {
        const size_t row0 = (size_t)u * 64;
        __syncthreads();
        for (int idx = tid; idx < 64 * 32; idx += NTHR) { const int tt = idx >> 5, col = 8 * (idx & 31); const size_t r = row0 + tt;
            const v4u cw = *(const GAS v4u*)(PROJ + r * NPROJ + PC_RW + RWC_WD + col); v4u pw = {0u, 0u, 0u, 0u}; if (r % SEQ) pw = *(const GAS v4u*)(PROJ + (r - 1) * NPROJ + PC_RW + RWC_WD + col);
            const f32x4 m0 = *(const GAS f32x4*)(mu + RWC_WD + col), m1 = *(const GAS f32x4*)(mu + RWC_WD + col + 4);
            const unsigned cu[4] = {cw.x, cw.y, cw.z, cw.w}, pu[4] = {pw.x, pw.y, pw.z, pw.w}; const float mm[8] = {m0[0], m0[1], m0[2], m0[3], m1[0], m1[1], m1[2], m1[3]}; unsigned o[4];
#pragma unroll
            for (int j = 0; j < 4; ++j) { const float c0 = bflo(cu[j]), c1 = bfhi(cu[j]); const float x0 = c0 + mm[2 * j] * (bflo(pu[j]) - c0), x1 = c1 + mm[2 * j + 1] * (bfhi(pu[j]) - c1);
                o[j] = col < 64 ? pk2(tanh_fast(x0), tanh_fast(x1)) : (col < 128 ? pk2(x0, x1) : pk2(sigmoidf_(x0), sigmoidf_(x1))); }
            v4u w; w.x = o[0]; w.y = o[1]; w.z = o[2]; w.w = o[3];
            if (col < 64) *(LAS v4u*)(lds + R1_TH + (tt * 72 + col) * 2) = w;
            else if (col < 128) *(LAS v4u*)(lds + R1_AD + (tt * 72 + col - 64) * 2) = w;
            else *(LAS v4u*)(lds + R1_SG + (tt * 136 + col - 128) * 2) = w; }
        if (l > 0) for (int idx = tid; idx < 64 * 48; idx += NTHR) { const int tt = idx / 48, col = 8 * (idx % 48); const size_t r = row0 + tt;
            const v4u cw = *(const GAS v4u*)(PROJ + r * NPROJ + PC_RW + RWC_V + col); v4u pw = {0u, 0u, 0u, 0u}; if (r % SEQ) pw = *(const GAS v4u*)(PROJ + (r - 1) * NPROJ + PC_RW + RWC_V + col);
            const f32x4 m0 = *(const GAS f32x4*)(mu + RWC_V + col), m1 = *(const GAS f32x4*)(mu + RWC_V + col + 4);
            const unsigned cu[4] = {cw.x, cw.y, cw.z, cw.w}, pu[4] = {pw.x, pw.y, pw.z, pw.w}; const float mm[8] = {m0[0], m0[1], m0[2], m0[3], m1[0], m1[1], m1[2], m1[3]}; unsigned o[4];
#pragma unroll
            for (int j = 0; j < 4; ++j) { const float c0 = bflo(cu[j]), c1 = bfhi(cu[j]); o[j] = pk2(c0 + mm[2 * j] * (bflo(pu[j]) - c0), c1 + mm[2 * j + 1] * (bfhi(pu[j]) - c1)); }
            v4u w; w.x = o[0]; w.y = o[1]; w.z = o[2]; w.w = o[3];
            *(LAS v4u*)(lds + R1_VS + (tt * 392 + col) * 2) = w; }
        __syncthreads();
        r1_prod<2, 0>(W1, (const LAS bf16*)(lds + R1_TH), 72, a->in[I_RW0] + l * DBR, (bf16*)(ws + WS_RE), row0, lane, wave);
        r1_prod<2, 1>(W1 + 24576, (const LAS bf16*)(lds + R1_AD), 72, a->in[I_RA0] + l * DBR, (bf16*)(ws + WS_RA), row0, lane, wave);
        r1_prod<4, 2>(W1 + 49152, (const LAS bf16*)(lds + R1_SG), 136, nullptr, (bf16*)(ws + WS_RG), row0, lane, wave);
        if (l > 0) {
            { const int kq = lane >> 4, mt = wave & 1, ti = wave >> 1; f32x4 acc = {0.f, 0.f, 0.f, 0.f};
#pragma unroll
              for (int s = 0; s < 12; ++s) acc = __builtin_amdgcn_mfma_f32_16x16x32_bf16(__builtin_bit_cast(bf16x8, *(const GAS v4u*)(WV + (size_t)(16 * mt + (lane & 15)) * 384 + 32 * s + 8 * kq)),
                                                                                          *(const LAS bf16x8*)(lds + R1_VS + ((16 * ti + (lane & 15)) * 392 + 32 * s + 8 * kq) * 2), acc, 0, 0, 0);
              v2u w; w.x = pk2(acc[0], acc[1]); w.y = pk2(acc[2], acc[3]); *(LAS v2u*)(lds + R1_TMP + ((16 * ti + (lane & 15)) * 40 + 16 * mt + 4 * kq) * 2) = w; }
            __syncthreads();
            r1_prod<1, 1>(WV + 12288, (const LAS bf16*)(lds + R1_TMP), 40, a->in[I_RV0], (bf16*)(ws + WS_RVG), row0, lane, wave);
        }
    }
}
__device__ __forceinline__ float dpp_allsum(float x) {
    x += __builtin_bit_cast(float, __builtin_amdgcn_update_dpp(0, __builtin_bit_cast(int, x), 0x128, 0xf, 0xf, false));
    x += __builtin_bit_cast(float, __builtin_amdgcn_update_dpp(0, __builtin_bit_cast(int, x), 0x124, 0xf, 0xf, false));
    x += __builtin_bit_cast(float, __builtin_amdgcn_update_dpp(0, __builtin_bit_cast(int, x), 0x122, 0xf, 0xf, false));
    x += __builtin_bit_cast(float, __builtin_amdgcn_update_dpp(0, __builtin_bit_cast(int, x), 0x121, 0xf, 0xf, false));
    { const unsigned xi = __builtin_bit_cast(unsigned, x); auto r = __builtin_amdgcn_permlane16_swap(xi, xi, false, false); const unsigned r0 = r[0], r1 = r[1]; x = __uint_as_float(r0) + __uint_as_float(r1); }
    { const unsigned xi = __builtin_bit_cast(unsigned, x); auto r = __builtin_amdgcn_permlane32_swap(xi, xi, false, false); const unsigned r0 = r[0], r1 = r[1]; x = __uint_as_float(r0) + __uint_as_float(r1); }
    return x;
}

constexpr int RC_EF = 0, RC_ATF = 4096, RC_QF = 8448, RC_PFT = 9472, RC_AT = 10496, RC_RT = 12800, RC_BH = 15104, RC_KH = 17408, RC_AH = 19712, RC_BTT = 22016, RC_KTT = 25088, RC_VS = 28160,
              RC_PRL = 31232, RC_QRL = 32000, RC_TQL = 32768, RC_G15 = 33536, RC_CH = 33792;
struct RCRegs { v2u r0, r1, k0, k1, aa, ee, v0, v1, vg, vf, gg; };
__device__ __forceinline__ void rc_issue(const unsigned char* ws, int l, size_t row, int h, int tid, RCRegs& R) {
    const bf16* PROJ = (const bf16*)(ws + WS_PROJ); const int tt = tid >> 4, c0 = h * 64 + 4 * (tid & 15); const size_t r = row + tt; const bool first = (r % SEQ) == 0; const size_t rp = first ? r : r - 1;
    R.r0 = *(const GAS v2u*)(PROJ + r * NPROJ + PC_RW + RWC_R + c0); R.r1 = *(const GAS v2u*)(PROJ + rp * NPROJ + PC_RW + RWC_R + c0);
    R.k0 = *(const GAS v2u*)(PROJ + r * NPROJ + PC_RW + RWC_K + c0); R.k1 = *(const GAS v2u*)(PROJ + rp * NPROJ + PC_RW + RWC_K + c0);
    R.v0 = *(const GAS v2u*)(PROJ + r * NPROJ + PC_RW + RWC_V + c0); R.v1 = *(const GAS v2u*)(PROJ + rp * NPROJ + PC_RW + RWC_V + c0);
    R.aa = *(const GAS v2u*)((const bf16*)(ws + WS_RA) + r * DBR + c0); R.ee = *(const GAS v2u*)((const bf16*)(ws + WS_RE) + r * DBR + c0);
    R.gg = *(const GAS v2u*)((const bf16*)(ws + WS_RG) + r * DBR + c0);
    if (l > 0) { R.vg = *(const GAS v2u*)((const bf16*)(ws + WS_RVG) + r * DBR + c0); R.vf = *(const GAS v2u*)((const bf16*)(ws + WS_VF) + r * DBR + c0); }
    if (first) { R.r1 = (v2u){0u, 0u}; R.k1 = (v2u){0u, 0u}; R.v1 = (v2u){0u, 0u}; }
}
__device__ __forceinline__ void unpack4(const v2u p, float (&o)[4]) { o[0] = bflo(p.x); o[1] = bfhi(p.x); o[2] = bflo(p.y); o[3] = bfhi(p.y); }
__device__ __forceinline__ v2u pack4(const float (&v)[4]) { v2u o; o.x = pk2(v[0], v[1]); o.y = pk2(v[2], v[3]); return o; }
__device__ __forceinline__ v2u pack4v(const f32x4 v) { v2u o; o.x = pk2(v[0], v[1]); o.y = pk2(v[2], v[3]); return o; }
__device__ __forceinline__ bf16x8 cat8(const v2u a, const v2u b) { v4u o; o.x = a.x; o.y = a.y; o.z = b.x; o.w = b.y; return __builtin_bit_cast(bf16x8, o); }
#define RC_BAR() asm volatile("s_waitcnt lgkmcnt(0)\n\ts_barrier" ::: "memory")

constexpr int REC_BYTES = 12288, REC_UNITS = 752;
__device__ __forceinline__ unsigned char* rc_rec(unsigned char* ws, size_t cu) { return cu < 8192 ? ws + WS_OPA + cu * REC_BYTES : ws + WS_OPB + (cu - 8192) * REC_BYTES; }
__device__ __forceinline__ v4u rc_gather_unit(const LAS unsigned char* wb, int u) {
    v2u lo, hi;
    if (u < 256) { const int base = u < 128 ? RC_AH : RC_RT, uu = u & 127, row = uu >> 3, s = (uu >> 2) & 1, lq = uu & 3; const LAS unsigned char* p = wb + base + (row * 72 + 32 * s + 4 * lq) * 2;
        lo = *(const LAS v2u*)p; hi = *(const LAS v2u*)(p + 32); }
    else if (u < 512) { const int k = (u - 256) >> 2, lq = (u - 256) & 3; lo = *(const LAS v2u*)(wb + RC_BTT + (k * 24 + 4 * lq) * 2); hi = *(const LAS v2u*)(wb + RC_KTT + (k * 24 + 4 * lq) * 2); }
    else if (u < 576) { const int t = (u - 512) >> 2, lq = (u - 512) & 3; lo = *(const LAS v2u*)(wb + RC_PRL + (t * 24 + 4 * lq) * 2); hi = *(const LAS v2u*)(wb + RC_QRL + (t * 24 + 4 * lq) * 2); }
    else if (u < 608) { const LAS unsigned char* p = wb + RC_TQL + (((u - 576) >> 1) * 24 + 8 * ((u - 576) & 1)) * 2; lo = *(const LAS v2u*)p; hi = *(const LAS v2u*)(p + 8); }
    else if (u < 736) { const LAS unsigned char* p = wb + RC_VS + (((u - 608) >> 1) * 24 + 8 * ((u - 608) & 1)) * 2; lo = *(const LAS v2u*)p; hi = *(const LAS v2u*)(p + 8); }
    else { const LAS unsigned char* p = wb + RC_G15 + (u - 736) * 16; lo = *(const LAS v2u*)p; hi = *(const LAS v2u*)(p + 8); }
    v4u o; o.x = lo.x; o.y = lo.y; o.z = hi.x; o.w = hi.y; return o;
}
__device__ __forceinline__ void rc_copy_out(unsigned char* rec, const LAS unsigned char* wb, int u) {
#pragma unroll
    for (int q = 0; q < 3; ++q) { const int uu = u + 256 * q; if (uu < REC_UNITS) *(GAS v4u*)(rec + uu * 16) = rc_gather_unit(wb, uu); }
}
constexpr int RS_AH = 0, RS_RT = 2304, RS_BK = 4608, RS_PQ = 9728, RS_TQL = 11008, RS_VS = 11776, RS_G15 = 14848, RS_CH = 15360;
__device__ __forceinline__ int rs_unit_off(int u) {
    if (u < 128) return RS_AH + (u >> 3) * 144 + (u & 7) * 16;
    if (u < 256) return RS_RT + ((u - 128) >> 3) * 144 + (u & 7) * 16;
    if (u < 512) return RS_BK + ((u - 256) >> 2) * 80 + (u & 3) * 16;
    if (u < 576) return RS_PQ + ((u - 512) >> 2) * 80 + (u & 3) * 16;
    if (u < 608) return RS_TQL + ((u - 576) >> 1) * 48 + (u & 1) * 16;
    if (u < 736) return RS_VS + ((u - 608) >> 1) * 48 + (u & 1) * 16;
    return RS_G15 + (u - 736) * 16;
}
#define RC_BUILD(RUSE, q) do { const int bh_ = (q) % (NB * NH), b = bh_ / NH, h = bh_ % NH, blk_ = blk0 + (q) / (NB * NH), c0 = h * 64 + 4 * kq; const size_t row0 = (size_t)b * SEQ + (size_t)blk_ * 32; \
        float kkw[4], kaw[4], mur[4], muk[4], muv[4]; \
_Pragma("unroll") \
        for (int j = 0; j < 4; ++j) { kkw[j] = a->in[I_RKK][(size_t)l * DBR + c0 + j]; kaw[j] = a->in[I_RKA][(size_t)l * DBR + c0 + j]; mur[j] = mu[RWC_R + c0 + j]; muk[j] = mu[RWC_K + c0 + j]; muv[j] = mu[RWC_V + c0 + j]; } \
        float an[4], bk[4], km[4], rs[4], ev[4]; \
        {   const RCRegs& R = RUSE; \
            float rc[4], rp[4], kc[4], kp[4], av[4], vc[4], vp[4], ks[4], kk[4], vs[4]; unpack4(R.r0, rc); unpack4(R.r1, rp); unpack4(R.k0, kc); unpack4(R.k1, kp); unpack4(R.aa, av); unpack4(R.ee, ev); unpack4(R.v0, vc); unpack4(R.v1, vp); \
            float ss = 0.f; \
_Pragma("unroll") \
            for (int j = 0; j < 4; ++j) { rs[j] = rc[j] + mur[j] * (rp[j] - rc[j]); ks[j] = kc[j] + muk[j] * (kp[j] - kc[j]); kk[j] = ks[j] * kkw[j]; ss += kk[j] * kk[j]; vs[j] = vc[j] + muv[j] * (vp[j] - vc[j]); } \
            ss += __shfl_xor(ss, 1); ss += __shfl_xor(ss, 2); ss += __shfl_xor(ss, 4); ss += __shfl_xor(ss, 8); \
            const float inv = 1.f / fmaxf(sqrtf(ss), 1e-12f); \
_Pragma("unroll") \
            for (int j = 0; j < 4; ++j) { const float kn = kk[j] * inv; an[j] = -kn; bk[j] = kn * av[j]; km[j] = ks[j] * (1.f + (av[j] - 1.f) * kaw[j]); } \
            if (l == 0) *(GAS v2u*)((bf16*)(ws + WS_VF) + (row0 + tt) * DBR + c0) = pack4(vs); \
            else { float g[4], f[4]; unpack4(R.vg, g); unpack4(R.vf, f); \
_Pragma("unroll") \
                for (int j = 0; j < 4; ++j) vs[j] = vs[j] + (f[j] - vs[j]) * g[j]; } \
            {     \
                float gq[4], o1[4], o2[4]; unpack4(R.gg, gq); float rkp = 0.f; \
_Pragma("unroll") \
                for (int j = 0; j < 4; ++j) rkp += rs[j] * km[j] * a->in[I_RRK][(size_t)l * DBR + c0 + j]; \
                rkp += __shfl_xor(rkp, 1); rkp += __shfl_xor(rkp, 2); rkp += __shfl_xor(rkp, 4); rkp += __shfl_xor(rkp, 8); \
_Pragma("unroll") \
                for (int j = 0; j < 4; ++j) { o1[j] = a->in[I_RLNW][(size_t)l * DBR + c0 + j] * gq[j]; o2[j] = (a->in[I_RLNB][(size_t)l * DBR + c0 + j] + rkp * vs[j]) * gq[j]; } \
                if (ST12) { *(GAS v2u*)((bf16*)(ws + WS_RG) + (row0 + tt) * DBR + c0) = pack4(o1); *(GAS v2u*)((bf16*)(ws + WS_RA) + (row0 + tt) * DBR + c0) = pack4(o2); } } \
            *(LAS f32x4*)(cb + RC_EF + (t * 64 + 4 * kq) * 4) = (f32x4){ev[0], ev[1], ev[2], ev[3]}; \
_Pragma("unroll") \
            for (int j = 0; j < 4; ++j) *(LAS bf16*)(cb + RC_VS + ((4 * kq + j) * 24 + t) * 2) = (bf16)f2bf(vs[j]); \
        } \
        if ((q) + 2 * G < NQ) rc_issue_q(ws, l, (q) + 2 * G, blk0, tid, RUSE); \
        RC_BAR(); \
        {   f32x4 inc = {0.f, 0.f, 0.f, 0.f}, tot = inc; \
_Pragma("unroll") \
            for (int i = 0; i < 16; ++i) { const f32x4 ei = *(const LAS f32x4*)(cb + RC_EF + (i * 64 + 4 * kq) * 4); tot = tot + ei; if (i <= t) inc = inc + ei; } \
            float At[4], Rt[4], Bh[4], Kh[4], Bt[4], Kt[4], Gt[4]; \
_Pragma("unroll") \
            for (int j = 0; j < 4; ++j) { const float Gi = __expf(-inc[j]), Ge = __expf(ev[j] - inc[j]), Gn = __expf(inc[j]); Gt[j] = __expf(-tot[j]); \
                At[j] = an[j] * Ge; Rt[j] = rs[j] * Gi; Bh[j] = bk[j] * Gn; Kh[j] = km[j] * Gn; Bt[j] = Bh[j] * Gt[j]; Kt[j] = Kh[j] * Gt[j]; } \
            *(LAS f32x4*)(cb + RC_ATF + (t * 68 + 4 * kq) * 4) = (f32x4){At[0], At[1], At[2], At[3]}; \
            *(LAS v2u*)(cb + RC_AT + (t * 72 + 4 * kq) * 2) = pack4(At); *(LAS v2u*)(cb + RC_RT + (t * 72 + 4 * kq) * 2) = pack4(Rt); \
            *(LAS v2u*)(cb + RC_BH + (t * 72 + 4 * kq) * 2) = pack4(Bh); *(LAS v2u*)(cb + RC_KH + (t * 72 + 4 * kq) * 2) = pack4(Kh); \
_Pragma("unroll") \
            for (int j = 0; j < 4; ++j) { *(LAS bf16*)(cb + RC_BTT + ((4 * kq + j) * 24 + t) * 2) = (bf16)f2bf(Bt[j]); *(LAS bf16*)(cb + RC_KTT + ((4 * kq + j) * 24 + t) * 2) = (bf16)f2bf(Kt[j]); } \
            if (t == 0) *(LAS f32x4*)(cb + RC_G15 + 4 * kq * 4) = (f32x4){Gt[0], Gt[1], Gt[2], Gt[3]}; \
        } \
        RC_BAR(); \
        {   LAS unsigned char* wb = lds + (wave >> 2) * RC_CH; const int pi = wave & 3; \
            const LAS bf16* Ap = (const LAS bf16*)(wb + (pi < 2 ? RC_AT : RC_RT)) + li * 72 + 8 * lq; const LAS bf16* Bp = (const LAS bf16*)(wb + ((pi & 1) ? RC_KH : RC_BH)) + li * 72 + 8 * lq; \
            f32x4 acc = {0.f, 0.f, 0.f, 0.f}; \
            acc = __builtin_amdgcn_mfma_f32_16x16x32_bf16(*(const LAS bf16x8*)Ap, *(const LAS bf16x8*)Bp, acc, 0, 0, 0); \
            acc = __builtin_amdgcn_mfma_f32_16x16x32_bf16(*(const LAS bf16x8*)(Ap + 32), *(const LAS bf16x8*)(Bp + 32), acc, 0, 0, 0); \
_Pragma("unroll") \
            for (int r = 0; r < 4; ++r) { const int tr = 4 * lq + r; if (pi < 2 ? !(li < tr) : !(li <= tr)) acc[r] = 0.f; } \
            if (pi == 0) *(LAS f32x4*)(wb + RC_PFT + (li * 16 + 4 * lq) * 4) = acc; \
            else if (pi == 1) { \
_Pragma("unroll") \
                for (int r = 0; r < 4; ++r) *(LAS float*)(wb + RC_QF + ((4 * lq + r) * 16 + li) * 4) = acc[r]; } \
            else { LAS bf16* o = (LAS bf16*)(wb + (pi == 2 ? RC_PRL : RC_QRL)); \
_Pragma("unroll") \
                for (int r = 0; r < 4; ++r) o[(4 * lq + r) * 24 + li] = (bf16)f2bf(acc[r]); } \
        } \
        RC_BAR(); \
        if (wave < 4) { \
            LAS unsigned char* wb = lds + (wave >> 1) * RC_CH; const bool isq = wave & 1; \
            float X[16]; \
_Pragma("unroll") \
            for (int r = 0; r < 16; ++r) X[r] = isq ? *(const LAS float*)(wb + RC_QF + (r * 16 + li) * 4) : *(const LAS float*)(wb + RC_ATF + (r * 68 + lane) * 4); \
_Pragma("unroll") \
            for (int j = 0; j < 15; ++j) { const LAS f32x4* pc = (const LAS f32x4*)(wb + RC_PFT + j * 64); const f32x4 c0v = pc[0], c1v = pc[1], c2v = pc[2], c3v = pc[3]; \
                const float c[16] = {c0v[0], c0v[1], c0v[2], c0v[3], c1v[0], c1v[1], c1v[2], c1v[3], c2v[0], c2v[1], c2v[2], c2v[3], c3v[0], c3v[1], c3v[2], c3v[3]}; \
_Pragma("unroll") \
                for (int r = j + 1; r < 16; ++r) X[r] = fmaf(c[r], X[j], X[r]); } \
            if (!isq) { LAS bf16* o = (LAS bf16*)(wb + RC_AH); \
_Pragma("unroll") \
                for (int r = 0; r < 16; ++r) o[r * 72 + lane] = (bf16)f2bf(X[r]); } \
            else if (lane < 16) { LAS bf16* o = (LAS bf16*)(wb + RC_TQL); \
_Pragma("unroll") \
                for (int r = 0; r < 16; ++r) o[r * 24 + lane] = (bf16)f2bf(X[r]); } \
        } \
        RC_BAR(); \
        { const int cc = tid >> 8, u = tid & 255; unsigned char* rec = rc_rec(ws, (size_t)bh_ * 512 + 2 * blk_ + cc); const LAS unsigned char* wb = lds + cc * RC_CH; \
          rc_copy_out(rec, wb, u); } \
        RC_BAR(); \
    } while (0)
#ifndef RS_NT
#define RS_NT 1
#endif
constexpr int RS_TILES = RS_NT;
struct RSOps { bf16x8 a01, a23, r01, r23, tq, pq, bk[4]; v2u vb[RS_TILES]; f32x4 g[4]; };
__device__ __forceinline__ void rs_load(const LAS unsigned char* wb, int wave, int li, int lq, RSOps& O) {
    O.a01 = *(const LAS bf16x8*)(wb + RS_AH + li * 144 + lq * 16); O.a23 = *(const LAS bf16x8*)(wb + RS_AH + li * 144 + 64 + lq * 16);
    O.r01 = *(const LAS bf16x8*)(wb + RS_RT + li * 144 + lq * 16); O.r23 = *(const LAS bf16x8*)(wb + RS_RT + li * 144 + 64 + lq * 16);
    O.pq = *(const LAS bf16x8*)(wb + RS_PQ + li * 80 + lq * 16);
    { const v2u t = *(const LAS v2u*)(wb + RS_TQL + li * 48 + lq * 8); v4u o; o.x = t.x; o.y = t.y; o.z = 0u; o.w = 0u; O.tq = __builtin_bit_cast(bf16x8, o); }
#pragma unroll
    for (int vt = 0; vt < RS_TILES; ++vt) O.vb[vt] = *(const LAS v2u*)(wb + RS_VS + (16 * (RS_TILES * wave + vt) + li) * 48 + lq * 8);
#pragma unroll
    for (int kt = 0; kt < 4; ++kt) { O.bk[kt] = *(const LAS bf16x8*)(wb + RS_BK + (16 * kt + li) * 80 + lq * 16); O.g[kt] = *(const LAS f32x4*)(wb + RS_G15 + (16 * kt + 4 * lq) * 4); }
}
#define RC_CHUNK(O, cc, yb) do { const v2u z2_ = {0u, 0u}; \
_Pragma("unroll") \
        for (int vt = 0; vt < RS_TILES; ++vt) {     \
            f32x4 aD = {0.f, 0.f, 0.f, 0.f}, aY = {0.f, 0.f, 0.f, 0.f}; \
            aD = __builtin_amdgcn_mfma_f32_16x16x32_bf16(O.tq, cat8(O.vb[vt], z2_), aD, 0, 0, 0); \
            aD = __builtin_amdgcn_mfma_f32_16x16x32_bf16(O.a01, Sb01[vt], aD, 0, 0, 0); \
            aD = __builtin_amdgcn_mfma_f32_16x16x32_bf16(O.a23, Sb23[vt], aD, 0, 0, 0); \
            aY = __builtin_amdgcn_mfma_f32_16x16x32_bf16(Sb01[vt], O.r01, aY, 0, 0, 0); \
            aY = __builtin_amdgcn_mfma_f32_16x16x32_bf16(Sb23[vt], O.r23, aY, 0, 0, 0); \
            const bf16x8 DV = cat8(pack4v(aD), O.vb[vt]); \
_Pragma("unroll") \
            for (int kt = 0; kt < 4; ++kt) Sacc[vt][kt] = __builtin_amdgcn_mfma_f32_16x16x32_bf16(O.bk[kt], DV, Sacc[vt][kt] * O.g[kt], 0, 0, 0); \
            aY = __builtin_amdgcn_mfma_f32_16x16x32_bf16(DV, O.pq, aY, 0, 0, 0); \
            Sb01[vt] = cat8(pack4v(Sacc[vt][0]), pack4v(Sacc[vt][1])); Sb23[vt] = cat8(pack4v(Sacc[vt][2]), pack4v(Sacc[vt][3])); \
            *(LAS v2u*)((yb) + (((cc) * 16 + li) * 72 + 16 * (RS_TILES * wave + vt) + 4 * lq) * 2) = pack4v(aY);     \
        } \
    } while (0)
#define RC_SCAN(slot, yb) do { { RSOps O0; rs_load(slot, wave, li, lq, O0); __builtin_amdgcn_sched_barrier(0); RC_CHUNK(O0, 0, yb); } \
        { RSOps O1; rs_load(slot + RS_CH, wave, li, lq, O1); __builtin_amdgcn_sched_barrier(0); RC_CHUNK(O1, 1, yb); } } while (0)

__device__ __forceinline__ void rc_issue_q(const unsigned char* ws, int l, int q, int blk0, int tid, RCRegs& R) {
    const int bh = q % (NB * NH), blk = blk0 + q / (NB * NH);
    rc_issue(ws, l, (size_t)(bh / NH) * SEQ + (size_t)blk * 32, bh % NH, tid, R);
}
template <bool ST12 = true>
__device__ __forceinline__ void phase_r2_build(KArgsP a, LAS unsigned char* lds, int tid, int lane, int wave, int vcu, int G, int l, int blk0 = 0, int nblk = SEQ / 32) {
    unsigned char* ws = a->ws;
    const int tt = tid >> 4, kq = tid & 15, ch = tt >> 4, t = tt & 15;
    const int lq = lane >> 4, li = lane & 15;
    LAS unsigned char* cb = lds + ch * RC_CH;
    const float* mu = a->in[I_RMU] + (size_t)l * RW_COLS;
    const int NQ = NB * NH * nblk;
    RCRegs RA, RB;
    if (vcu < NQ) rc_issue_q(ws, l, vcu, blk0, tid, RA);
    if (vcu + G < NQ) rc_issue_q(ws, l, vcu + G, blk0, tid, RB);
    for (int q0 = vcu; q0 < NQ; q0 += 2 * G) { { const int q = q0; RC_BUILD(RA, q); } if (q0 + G < NQ) { const int q = q0 + G; RC_BUILD(RB, q); } }
}
#ifndef RS_DEPTH
#define RS_DEPTH 4
#endif
struct RSRegs { v4u p[6]; };
__device__ __forceinline__ unsigned char* ubase(const unsigned char* p) {
    const unsigned lo = __builtin_amdgcn_readfirstlane((unsigned)(uintptr_t)p), hi = __builtin_amdgcn_readfirstlane((unsigned)((uintptr_t)p >> 32));
    return (unsigned char*)(((uintptr_t)hi << 32) | lo);
}
struct RSOff { unsigned g[6], s[6]; };
__device__ __forceinline__ void rs_offsets(int lt, RSOff& F) {
#pragma unroll
    for (int j = 0; j < 6; ++j) { const int uu = min(lt + 256 * j, 2 * REC_UNITS - 1); const int cc = uu >= REC_UNITS, u = uu - cc * REC_UNITS;
        F.g[j] = uu * 16 + cc * (REC_BYTES - REC_UNITS * 16); F.s[j] = cc * RS_CH + rs_unit_off(u); }
}
__device__ __forceinline__ void rs_issue(unsigned char* ws, size_t cu0, const RSOff& F, RSRegs& R) {
    const unsigned char* base = ubase(rc_rec(ws, cu0));
#pragma unroll
    for (int j = 0; j < 6; ++j) R.p[j] = *(const GAS v4u*)(base + F.g[j]);
}
__device__ __forceinline__ void rs_store(LAS unsigned char* slot, const RSOff& F, const RSRegs& R) {
#pragma unroll
    for (int j = 0; j < 6; ++j) *(LAS v4u*)(slot + F.s[j]) = R.p[j];
}
struct R3Q { v4u a1, a2; };
__device__ __forceinline__ void r3q_issue(const unsigned char* ws, size_t row0, int h, int lt, R3Q& Q) {
    const unsigned off = (unsigned)(((lt >> 3) * DBR + 8 * (lt & 7)) * 2); const size_t ub = (row0 * DBR + h * 64) * 2;
    Q.a1 = *(const GAS v4u*)(ubase(ws + WS_RG + ub) + off); Q.a2 = *(const GAS v4u*)(ubase(ws + WS_RA + ub) + off);
}
__device__ __forceinline__ float dpp8sum(float x) {
    x += __builtin_bit_cast(float, __builtin_amdgcn_update_dpp(0, __builtin_bit_cast(int, x), 0xB1, 0xf, 0xf, false));
    x += __builtin_bit_cast(float, __builtin_amdgcn_update_dpp(0, __builtin_bit_cast(int, x), 0x4E, 0xf, 0xf, false));
    x += __builtin_bit_cast(float, __builtin_amdgcn_update_dpp(0, __builtin_bit_cast(int, x), 0x141, 0xf, 0xf, false));
    return x;
}
__device__ __forceinline__ void r3_block(const LAS unsigned char* yb, bf16* YC, size_t row0, int h, int lt, const R3Q& Q) {
    const int tk = lt >> 3, c8 = 8 * (lt & 7);
    const v4u yy = *(const LAS v4u*)(yb + (tk * 72 + c8) * 2);
    float d[8] = {bflo(yy.x), bfhi(yy.x), bflo(yy.y), bfhi(yy.y), bflo(yy.z), bfhi(yy.z), bflo(yy.w), bfhi(yy.w)};
    const float m = dpp8sum(((d[0] + d[1]) + (d[2] + d[3])) + ((d[4] + d[5]) + (d[6] + d[7]))) * (1.f / 64.f);
    float q = 0.f;
#pragma unroll
    for (int j = 0; j < 8; ++j) { d[j] -= m; q = fmaf(d[j], d[j], q); }
    const float rstd = rsqrtf(dpp8sum(q) * (1.f / 64.f) + RWKV_GN_EPS);
    const unsigned a1[4] = {Q.a1.x, Q.a1.y, Q.a1.z, Q.a1.w}, a2[4] = {Q.a2.x, Q.a2.y, Q.a2.z, Q.a2.w}; unsigned o[4];
#pragma unroll
    for (int j = 0; j < 4; ++j) o[j] = pk2(fmaf(d[2 * j] * rstd, bflo(a1[j]), bflo(a2[j])), fmaf(d[2 * j + 1] * rstd, bfhi(a1[j]), bfhi(a2[j])));
    v4u w; w.x = o[0]; w.y = o[1]; w.z = o[2]; w.w = o[3];
    *(GAS v4u*)(ubase((const unsigned char*)(YC + row0 * DM + 384 + h * 64)) + (unsigned)((tk * DM + c8) * 2)) = w;
}
template <int VAR = 0>
__device__ __forceinline__ void phase_r2_scan(KArgsP a, LAS unsigned char* lds, int tid, int lane, int wave, int wg, int l, int bsplit = SEQ / 32, unsigned nbuilders = 0u) {
    unsigned char* ws = a->ws; bf16* YC = (bf16*)(ws + WS_YC);
    const int b = wg / NH, h = wg % NH; const size_t rowb = (size_t)b * SEQ, cub = (size_t)wg * 512;
    const int lq = lane >> 4, li = lane & 15, lt = tid - 256; const bool loader = wave >= 4;
    f32x4 Sacc[RS_TILES][4]; bf16x8 Sb01[RS_TILES], Sb23[RS_TILES];
#pragma unroll
    for (int vt = 0; vt < RS_TILES; ++vt) {
#pragma unroll
        for (int kt = 0; kt < 4; ++kt) Sacc[vt][kt] = (f32x4){0.f, 0.f, 0.f, 0.f};
        Sb01[vt] = (bf16x8){0, 0, 0, 0, 0, 0, 0, 0}; Sb23[vt] = Sb01[vt]; }
    constexpr int NBLK = SEQ / 32;
    LAS unsigned char* yb0 = lds + 8 * RS_CH; LAS unsigned char* yb1 = yb0 + 32 * 72 * 2;
    static_assert(8 * RS_CH + 2 * 32 * 72 * 2 <= MISC_OFF, "scan LDS layout");
    if (wave < 4 / RS_TILES) {
        RSOps OA, OB;
        RC_BAR();
        rs_load(lds, wave, li, lq, OA);
#pragma unroll 1
        for (int X = 0; X < NBLK; ++X) {
            LAS unsigned char* sl = lds + (X & 3) * 2 * RS_CH; LAS unsigned char* sn = lds + ((X + 1) & 3) * 2 * RS_CH; LAS unsigned char* yb = yb0 + (X & 1) * (32 * 72 * 2);
            if (X == bsplit - 7 && wave == 0) {
                if (lane == 0) { unsigned* bar_ = (unsigned*)(ws + WS_CTL) + CW_BAR; unsigned* cnt_ = (unsigned*)(ws + WS_CTL) + CW_Q + 64 * l + 48; XB_SPIN(xb_ld(cnt_) < nbuilders, bar_); }
                __builtin_amdgcn_fence(__ATOMIC_ACQUIRE, "agent"); asm volatile("s_waitcnt vmcnt(0)" ::: "memory");
            }
            rs_load(sl + RS_CH, wave, li, lq, OB); __builtin_amdgcn_sched_barrier(0); if (VAR != 2) { RC_CHUNK(OA, 0, yb); } else { asm volatile("" :: "v"(OA.a01), "v"(OA.bk[3]), "v"(OA.g[3])); }
            rs_load(sn, wave, li, lq, OA); __builtin_amdgcn_sched_barrier(0); if (VAR != 2) { RC_CHUNK(OB, 1, yb); } else { asm volatile("" :: "v"(OB.a01), "v"(OB.bk[3]), "v"(OB.g[3])); }
            RC_BAR();
        }
    } else if (!loader) {
        RC_BAR();
        for (int X = 0; X < NBLK; ++X) RC_BAR();
    } else {
        constexpr int ND = 4;
        RSRegs R[ND]; R3Q Q[ND]; RSOff F; rs_offsets(lt, F);
#pragma unroll
        for (int j = 0; j < ND; ++j) { rs_issue(ws, cub + 2 * j, F, R[j]); r3q_issue(ws, rowb + 32 * j, h, lt, Q[j]); }
        rs_store(lds, F, R[0]); rs_issue(ws, cub + 2 * ND, F, R[0]); rs_store(lds + 2 * RS_CH, F, R[1]); rs_issue(ws, cub + 2 * (ND + 1), F, R[1]);
        RC_BAR();
        for (int bb = 0; bb < NBLK; bb += ND) {
#pragma unroll
            for (int j = 0; j < ND; ++j) { const int X = bb + j;
                if (VAR != 1) { r3_block((j & 1) ? yb0 : yb1, YC, rowb + (size_t)max(X - 1, 0) * 32, h, lt, Q[(j + ND - 1) % ND]);
                r3q_issue(ws, rowb + (size_t)min(X - 1 + ND, NBLK - 1) * 32, h, lt, Q[(j + ND - 1) % ND]); }
                rs_store(lds + ((j + 2) & 3) * 2 * RS_CH, F, R[(j + 2) % ND]);
                rs_issue(ws, cub + 2 * (size_t)min(X + 2 + ND, NBLK - 1), F, R[(j + 2) % ND]);
                RC_BAR();
            }
        }
        r3_block(yb1, YC, rowb + (size_t)(NBLK - 1) * 32, h, lt, Q[(NBLK - 1) % ND]);
    }
}
__device__ __forceinline__ void phase_r3(KArgsP a, int lane, int gw, int ngw, int l) {
    unsigned char* ws = a->ws; const bf16* PROJ = (const bf16*)(ws + WS_PROJ); bf16* YC = (bf16*)(ws + WS_YC);
    const bf16* RA = (const bf16*)(ws + WS_RA); const bf16* RG = (const bf16*)(ws + WS_RG); const bf16* RVG = (const bf16*)(ws + WS_RVG); const bf16* VF = (const bf16*)(ws + WS_VF);
    const float* mu = a->in[I_RMU] + (size_t)l * RW_COLS;
    for (size_t row = gw; row < NTOK; row += ngw) {
#pragma unroll
        for (int h = 0; h < NH; ++h) {
            const int c = h * 64 + lane;
            const float y = bf2f(YC[row * DM + 384 + c]);
            const float m = dpp_allsum(y) * (1.f / 64.f); const float d = y - m; const float var = dpp_allsum(d * d) * (1.f / 64.f);
            const float yn = d * rsqrtf(var + RWKV_GN_EPS) * a->in[I_RLNW][l * DBR + c] + a->in[I_RLNB][l * DBR + c];
            const float rs = rw_shift(PROJ, mu, row, RWC_R + c), ks = rw_shift(PROJ, mu, row, RWC_K + c); float v = rw_shift(PROJ, mu, row, RWC_V + c);
            if (l > 0) v = v + (bf2f(VF[row * DBR + c]) - v) * bf2f(RVG[row * DBR + c]);
            const float av = bf2f(RA[row * DBR + c]);
            const float km = ks * (1.f + (av - 1.f) * a->in[I_RKA][l * DBR + c]);
            const float rk = dpp_allsum(rs * km * a->in[I_RRK][l * DBR + c]);
            YC[row * DM + 384 + c] = (bf16)f2bf((yn + rk * v) * bf2f(RG[row * DBR + c]));
        }
    }
}

constexpr int PH_PER_LAYER = 10, PH_FINAL = 1 + 2 * PH_PER_LAYER, N_PHASES = PH_FINAL + 1;
constexpr int R2_WGS = 24;
__global__ void __launch_bounds__(NTHR, 2) fwd(Args args) {
    extern __shared__ __attribute__((aligned(16))) unsigned char lds_raw[];
    LAS unsigned char* lds = (LAS unsigned char*)lds_raw;
    volatile LAS unsigned* MISC = (volatile LAS unsigned*)(lds + MISC_OFF);
    const int tid0 = threadIdx.x;
    const int G = gridDim.x;
#define PHASE_IDS int tid_ = threadIdx.x; asm volatile("" : "+v"(tid_)); const int tid = tid_, lane = tid & 63, wave = __builtin_amdgcn_readfirstlane(tid >> 6); \
    int bx_ = blockIdx.x; asm volatile("" : "+s"(bx_)); const int bx = bx_; const int vcu = (G % 8 == 0) ? (bx % 8) * (G / 8) + bx / 8 : bx; (void)lane; (void)wave; (void)vcu; (void)bx;
    unsigned char* ws0 = fresh_args()->ws;
    for (int u = tid0; u < (LDS_BYTES - RING_BYTES) / 4; u += NTHR) ((LAS unsigned*)(lds + RING_BYTES))[u] = 0u;
    __syncthreads();
    XcdBarrier bar; bar.bar = (unsigned*)(ws0 + WS_CTL) + CW_BAR; bar.x = 0; bar.st = nullptr;
    if (!MK_PER_PHASE) bar = xcd_barrier_post((unsigned*)(ws0 + WS_CTL) + CW_BAR, MISC + 8);
#if MK_PER_PHASE
    const int lo = args.ph_lo, hi = args.ph_hi;
#define IN(k) (lo <= (k) && (k) < hi)
#else
#define IN(k) true
#endif
#define SEAM(k) do { if (IN(k) && IN((k) + 1)) { XcdBarrier b2 = bar; asm volatile("" : "+s"(b2.bar)); xcd_barrier(b2); } } while (0)

#ifndef GEMM_SP2
#define GEMM_SP2 true
#endif
#ifndef GEMM_ALIGN
#define GEMM_ALIGN true
#endif
#ifndef RS_DEPTH
#define RS_DEPTH 4
#endif
#ifndef R2_SPLIT
#define R2_SPLIT 160
#endif
#ifndef SCANVAR
#define SCANVAR 0
#endif
#ifndef DBL_SUB
#define DBL_SUB 0
#endif
#ifndef DBL_PHASE
#define DBL_PHASE (-1)
#endif
#ifndef REPN
#define REPN 2
#endif
#define SUBREP(k) _Pragma("nounroll") for (int q_ = 0; q_ < 1 + (REPN - 1) * (((k) == DBL_SUB) && l == 0); ++q_)
#define REP(k) for (int rep_ = 0; rep_ < ((k) == DBL_PHASE ? REPN : 1); ++rep_)
#define REPBAR if (rep_ > 0) { XcdBarrier b2 = bar; asm volatile("" : "+s"(b2.bar)); xcd_barrier(b2); }
    REP(0) if (IN(0)) { REPBAR KArgsP ap = fresh_args(); PHASE_IDS
_Pragma("nounroll")
 for (int q_ = 0; q_ < 1 + (REPN - 1) * (DBL_SUB == 12); ++q_) { phase_prologue(ap, lds, tid, lane, wave, vcu, G); __syncthreads(); } }
    SEAM(0);
#ifdef EXTRA_BAR
    for (int eb_ = 0; eb_ < EXTRA_BAR; ++eb_) { XcdBarrier b2 = bar; asm volatile("" : "+s"(b2.bar)); xcd_barrier(b2); }
#endif
#define LCONST 0
    {
        constexpr int l = LCONST; constexpr int pb = 1 + l * PH_PER_LAYER;
        REP(pb + 0) if (IN(pb + 0)) { REPBAR KArgsP ap = fresh_args(); PHASE_IDS unsigned char* ws = ap->ws; (void)ws;
            if (l == 0) { mod_finalize(ws, tid, G); SUBREP(6) { phase_rownorm<0, false>(ap, lds, tid, lane, wave, G, ap->in[I_X], ap->out, ap->in[I_NORM_MIX], true, 0, 0, 0); __syncthreads(); } }
            else {
#if EN_MOE
                phase_rownorm<0, true>(ap, lds, tid, lane, wave, G, ap->out, ap->out, ap->in[I_NORM_MIX] + l * DM, false, l, 0, l - 1);
#else
                phase_rownorm<0, false>(ap, lds, tid, lane, wave, G, ap->out, ap->out, ap->in[I_NORM_MIX] + l * DM, false, l, 0, l - 1);
#endif
            }
        }
        SEAM(pb + 0);
        REP(pb + 1) if (IN(pb + 1)) { REPBAR KArgsP ap = fresh_args(); PHASE_IDS unsigned char* ws = ap->ws; (void)ws;
            pg8::Gemm g{(const pg8::bf16_t*)(ws + WS_HN), (const pg8::bf16_t*)(ws + WS_WIN) + (size_t)l * NPROJ_PAD * DM, NTOK, NPROJ_PAD, DM};
            pg8::StaticOrder S; S.init(NTOK, NPROJ_PAD, G, bx);
            pg8::EpiProj E{(pg8::bf16_t*)(ws + WS_PROJ), (float*)(ws + WS_GATES)};
SUBREP(7) { pg8::gemm_phase<pg8::EpiProj, pg8::StaticOrder, GEMM_ALIGN, GEMM_SP2>(lds, g, S, E); __syncthreads(); }
        }
        SEAM(pb + 1);
        REP(pb + 2) if (IN(pb + 2)) { REPBAR KArgsP ap = fresh_args(); PHASE_IDS unsigned char* ws = ap->ws; (void)ws;
#if EN_MLSTM
            for (int q_ = 0; q_ < 1 + (REPN - 1) * ((DBL_SUB == 1) && l == 0); ++q_) { phase_m1(ap, lds, tid, lane, wave, vcu, G, l); __syncthreads(); }
            __syncthreads();
#endif
#if EN_S5
            phase_s1(ap, lds, tid, lane, wave, vcu, G, l); __syncthreads();
#if DBL_SUB == 2
            if (l == 0) { phase_s1(ap, lds, tid, lane, wave, vcu, G, l); __syncthreads(); phase_s1(ap, lds, tid, lane, wave, vcu, G, l); __syncthreads(); phase_s1(ap, lds, tid, lane, wave, vcu, G, l); __syncthreads(); phase_s1(ap, lds, tid, lane, wave, vcu, G, l); __syncthreads(); }
#endif
            __syncthreads();
#endif
#if EN_RWKV
            for (int q_ = 0; q_ < 1 + (REPN - 1) * ((DBL_SUB == 3) && l == 0); ++q_) { phase_r1(ap, lds, tid, lane, wave, vcu, G, l); __syncthreads(); }
#endif
        }
        SEAM(pb + 2);
        REP(pb + 3) if (IN(pb + 3)) { REPBAR KArgsP ap = fresh_args(); PHASE_IDS unsigned char* ws = ap->ws; (void)ws;
            phase_m2(ws, tid, vcu, G);
            phase_s2(ap, tid, vcu, G, l);
            __syncthreads();
            phase_r2_build(ap, lds, tid, lane, wave, vcu, G, l, 0, R2_SPLIT);
        }
        SEAM(pb + 3);
        REP(pb + 4) if (IN(pb + 4)) { REPBAR KArgsP ap = fresh_args(); PHASE_IDS unsigned char* ws = ap->ws; (void)ws;
            if (bx < R2_WGS) {
#if DBL_SUB == 4
                if (l == 0) { for (int q_ = 0; q_ < REPN - 1; ++q_) { phase_r2_scan<SCANVAR>(ap, lds, tid, lane, wave, bx, l, R2_SPLIT, (unsigned)(G - R2_WGS)); __syncthreads(); } }
#endif
                phase_r2_scan(ap, lds, tid, lane, wave, bx, l, R2_SPLIT, (unsigned)(G - R2_WGS)); __syncthreads(); }
            else {
                phase_r2_build(ap, lds, tid, lane, wave, bx - R2_WGS, G - R2_WGS, l, R2_SPLIT, SEQ / 32 - R2_SPLIT);
                asm volatile("s_waitcnt vmcnt(0)" ::: "memory"); __syncthreads();
                if (tid == 0) { __builtin_amdgcn_fence(__ATOMIC_RELEASE, "agent"); asm volatile("s_waitcnt vmcnt(0)" ::: "memory"); (void)xb_add((unsigned*)(ws + WS_CTL) + CW_Q + 64 * l + 48, 1u); }
                phase_s3(ap, lds, tid, lane, wave, 0, 1, l, (unsigned*)(ws + WS_CTL) + CW_Q + 64 * l + 32); __syncthreads();
            }
            {
                unsigned* qctr = (unsigned*)(ws + WS_CTL) + CW_Q + 64 * l; volatile LAS unsigned* qw = (volatile LAS unsigned*)(lds + MISC_OFF) + 16;
                unsigned nxt = 0u; if (tid == 0) nxt = __hip_atomic_fetch_add(qctr, 1u, __ATOMIC_RELAXED, __HIP_MEMORY_SCOPE_AGENT);
                for (;;) {
                    if (tid == 0) *qw = nxt;
                    __syncthreads();
                    const int u = (int)*qw;
                    __syncthreads();
                    if (u >= NUNIT_M) break;
                    if (tid == 0) nxt = __hip_atomic_fetch_add(qctr, 1u, __ATOMIC_RELAXED, __HIP_MEMORY_SCOPE_AGENT);
                    phase_m3(ap, lds, tid, lane, wave, u, NUNIT_M, l);
                }
            }
        }
        SEAM(pb + 4);
        REP(pb + 6) if (IN(pb + 6)) { REPBAR KArgsP ap = fresh_args(); PHASE_IDS unsigned char* ws = ap->ws; (void)ws;
            pg8::Gemm g{(const pg8::bf16_t*)(ws + WS_YC), (const pg8::bf16_t*)(ws + WS_WOUT) + (size_t)l * DM * DM, NTOK, DM, DM};
            pg8::StaticOrder S; S.init(NTOK, DM, G, bx);
            pg8::EpiResid E{l == 0 ? ap->in[I_X] : (const float*)ap->out, ap->out, (const float*)(ws + WS_MODF) + (size_t)l * 4 * 6144, 2048};
SUBREP(8) { pg8::gemm_phase<pg8::EpiResid, pg8::StaticOrder, GEMM_ALIGN, GEMM_SP2>(lds, g, S, E); __syncthreads(); }
        }
        SEAM(pb + 6);
#if EN_MOE
        REP(pb + 7) if (IN(pb + 7)) { REPBAR KArgsP ap = fresh_args(); PHASE_IDS phase_router(ap, lds, tid, lane, wave, G, l); __syncthreads();
            SUBREP(11) {
            moe_convert13(ap->in[I_MW1], ap->in[I_MW3], l, (bf16*)(ap->ws + WS_W13), vcu * NWAVES + wave, G * NWAVES, (LAS float*)(lds + wave * 16640), lane);
            moe_convert2(ap->in[I_MW2], l, (bf16*)(ap->ws + WS_W2), vcu * NWAVES + wave, G * NWAVES, (LAS float*)(lds + wave * 16640), lane); __syncthreads(); } }
        SEAM(pb + 7);
        REP(pb + 8) if (IN(pb + 8)) { REPBAR KArgsP ap = fresh_args(); PHASE_IDS unsigned char* ws = ap->ws; (void)ws;
            LAS int* ptab = (LAS int*)(lds + PTAB_OFF); LAS int* pst = ptab + 512; LAS int* cnt = pst + 32;
            build_ptab((const unsigned*)(ws + WS_CTL) + CW_CNT + l * 32, ptab, pst, cnt, tid);
            pg8::Gemm g{(const pg8::bf16_t*)(ws + WS_HN), (const pg8::bf16_t*)(ws + WS_W13), 0, 0, DM, (const int*)(ws + WS_LIST), ptab};
            pg8::MoeOrder S{ptab, G, vcu};
            pg8::EpiSwiglu E{(pg8::bf16_t*)(ws + WS_HMID)};
SUBREP(9) { pg8::gemm_phase<pg8::EpiSwiglu, pg8::MoeOrder, false, true, true>(lds, g, S, E); __syncthreads(); }
        }
        SEAM(pb + 8);
        REP(pb + 9) if (IN(pb + 9)) { REPBAR KArgsP ap = fresh_args(); PHASE_IDS unsigned char* ws = ap->ws; (void)ws;
            LAS int* ptab = (LAS int*)(lds + PTAB_OFF); LAS int* pst = ptab + 512; LAS int* cnt = pst + 32;
            build_ptab((const unsigned*)(ws + WS_CTL) + CW_CNT + l * 32, ptab, pst, cnt, tid);
            pg8::Gemm g{(const pg8::bf16_t*)(ws + WS_HMID), (const pg8::bf16_t*)(ws + WS_W2), 0, 0, DEXP};
            pg8::MoeOrder S{ptab, G, vcu};
            pg8::EpiMoeOut E{(pg8::bf16_t*)(ws + WS_YMOE), (const int*)(ws + WS_LIST), ptab};
SUBREP(10) { pg8::gemm_phase<pg8::EpiMoeOut, pg8::MoeOrder, true, true>(lds, g, S, E); __syncthreads(); }
        }
        SEAM(pb + 9);
#else
        SEAM(pb + 6); SEAM(pb + 7); SEAM(pb + 8); SEAM(pb + 9);
#endif
    }
#undef LCONST
#if N_LAYERS > 1
#define LCONST 1
    {
        constexpr int l = LCONST; constexpr int pb = 1 + l * PH_PER_LAYER;
        REP(pb + 0) if (IN(pb + 0)) { REPBAR KArgsP ap = fresh_args(); PHASE_IDS unsigned char* ws = ap->ws; (void)ws;
            if (l == 0) { mod_finalize(ws, tid, G); SUBREP(6) { phase_rownorm<0, false>(ap, lds, tid, lane, wave, G, ap->in[I_X], ap->out, ap->in[I_NORM_MIX], true, 0, 0, 0); __syncthreads(); } }
            else {
#if EN_MOE
                phase_rownorm<0, true>(ap, lds, tid, lane, wave, G, ap->out, ap->out, ap->in[I_NORM_MIX] + l * DM, false, l, 0, l - 1);
#else
                phase_rownorm<0, false>(ap, lds, tid, lane, wave, G, ap->out, ap->out, ap->in[I_NORM_MIX] + l * DM, false, l, 0, l - 1);
#endif
            }
        }
        SEAM(pb + 0);
        REP(pb + 1) if (IN(pb + 1)) { REPBAR KArgsP ap = fresh_args(); PHASE_IDS unsigned char* ws = ap->ws; (void)ws;
            pg8::Gemm g{(const pg8::bf16_t*)(ws + WS_HN), (const pg8::bf16_t*)(ws + WS_WIN) + (size_t)l * NPROJ_PAD * DM, NTOK, NPROJ_PAD, DM};
            pg8::StaticOrder S; S.init(NTOK, NPROJ_PAD, G, bx);
            pg8::EpiProj E{(pg8::bf16_t*)(ws + WS_PROJ), (float*)(ws + WS_GATES)};
SUBREP(7) { pg8::gemm_phase<pg8::EpiProj, pg8::StaticOrder, GEMM_ALIGN, GEMM_SP2>(lds, g, S, E); __syncthreads(); }
        }
        SEAM(pb + 1);
        REP(pb + 2) if (IN(pb + 2)) { REPBAR KArgsP ap = fresh_args(); PHASE_IDS unsigned char* ws = ap->ws; (void)ws;
#if EN_MLSTM
            for (int q_ = 0; q_ < 1 + (REPN - 1) * ((DBL_SUB == 1) && l == 0); ++q_) { phase_m1(ap, lds, tid, lane, wave, vcu, G, l); __syncthreads(); }
            __syncthreads();
#endif
#if EN_S5
            phase_s1(ap, lds, tid, lane, wave, vcu, G, l); __syncthreads();
#if DBL_SUB == 2
            if (l == 0) { phase_s1(ap, lds, tid, lane, wave, vcu, G, l); __syncthreads(); phase_s1(ap, lds, tid, lane, wave, vcu, G, l); __syncthreads(); phase_s1(ap, lds, tid, lane, wave, vcu, G, l); __syncthreads(); phase_s1(ap, lds, tid, lane, wave, vcu, G, l); __syncthreads(); }
#endif
            __syncthreads();
#endif
#if EN_RWKV
            for (int q_ = 0; q_ < 1 + (REPN - 1) * ((DBL_SUB == 3) && l == 0); ++q_) { phase_r1(ap, lds, tid, lane, wave, vcu, G, l); __syncthreads(); }
#endif
        }
        SEAM(pb + 2);
        REP(pb + 3) if (IN(pb + 3)) { REPBAR KArgsP ap = fresh_args(); PHASE_IDS unsigned char* ws = ap->ws; (void)ws;
            phase_m2(ws, tid, vcu, G);
            phase_s2(ap, tid, vcu, G, l);
            __syncthreads();
            phase_r2_build(ap, lds, tid, lane, wave, vcu, G, l, 0, R2_SPLIT);
        }
        SEAM(pb + 3);
        REP(pb + 4) if (IN(pb + 4)) { REPBAR KArgsP ap = fresh_args(); PHASE_IDS unsigned char* ws = ap->ws; (void)ws;
            if (bx < R2_WGS) {
#if DBL_SUB == 4
                if (l == 0) { for (int q_ = 0; q_ < REPN - 1; ++q_) { phase_r2_scan<SCANVAR>(ap, lds, tid, lane, wave, bx, l, R2_SPLIT, (unsigned)(G - R2_WGS)); __syncthreads(); } }
#endif
                phase_r2_scan(ap, lds, tid, lane, wave, bx, l, R2_SPLIT, (unsigned)(G - R2_WGS)); __syncthreads(); }
            else {
                phase_r2_build(ap, lds, tid, lane, wave, bx - R2_WGS, G - R2_WGS, l, R2_SPLIT, SEQ / 32 - R2_SPLIT);
                asm volatile("s_waitcnt vmcnt(0)" ::: "memory"); __syncthreads();
                if (tid == 0) { __builtin_amdgcn_fence(__ATOMIC_RELEASE, "agent"); asm volatile("s_waitcnt vmcnt(0)" ::: "memory"); (void)xb_add((unsigned*)(ws + WS_CTL) + CW_Q + 64 * l + 48, 1u); }
                phase_s3(ap, lds, tid, lane, wave, 0, 1, l, (unsigned*)(ws + WS_CTL) + CW_Q + 64 * l + 32); __syncthreads();
            }
            {
                unsigned* qctr = (unsigned*)(ws + WS_CTL) + CW_Q + 64 * l; volatile LAS unsigned* qw = (volatile LAS unsigned*)(lds + MISC_OFF) + 16;
                unsigned nxt = 0u; if (tid == 0) nxt = __hip_atomic_fetch_add(qctr, 1u, __ATOMIC_RELAXED, __HIP_MEMORY_SCOPE_AGENT);
                for (;;) {
                    if (tid == 0) *qw = nxt;
                    __syncthreads();
                    const int u = (int)*qw;
                    __syncthreads();
                    if (u >= NUNIT_M) break;
                    if (tid == 0) nxt = __hip_atomic_fetch_add(qctr, 1u, __ATOMIC_RELAXED, __HIP_MEMORY_SCOPE_AGENT);
                    phase_m3(ap, lds, tid, lane, wave, u, NUNIT_M, l);
                }
            }
        }
        SEAM(pb + 4);
        REP(pb + 6) if (IN(pb + 6)) { REPBAR KArgsP ap = fresh_args(); PHASE_IDS unsigned char* ws = ap->ws; (void)ws;
            pg8::Gemm g{(const pg8::bf16_t*)(ws + WS_YC), (const pg8::bf16_t*)(ws + WS_WOUT) + (size_t)l * DM * DM, NTOK, DM, DM};
            pg8::StaticOrder S; S.init(NTOK, DM, G, bx);
            pg8::EpiResid E{l == 0 ? ap->in[I_X] : (const float*)ap->out, ap->out, (const float*)(ws + WS_MODF) + (size_t)l * 4 * 6144, 2048};
SUBREP(8) { pg8::gemm_phase<pg8::EpiResid, pg8::StaticOrder, GEMM_ALIGN, GEMM_SP2>(lds, g, S, E); __syncthreads(); }
        }
        SEAM(pb + 6);
#if EN_MOE
        REP(pb + 7) if (IN(pb + 7)) { REPBAR KArgsP ap = fresh_args(); PHASE_IDS phase_router(ap, lds, tid, lane, wave, G, l); __syncthreads();
            SUBREP(11) {
            moe_convert13(ap->in[I_MW1], ap->in[I_MW3], l, (bf16*)(ap->ws + WS_W13), vcu * NWAVES + wave, G * NWAVES, (LAS float*)(lds + wave * 16640), lane);
            moe_convert2(ap->in[I_MW2], l, (bf16*)(ap->ws + WS_W2), vcu * NWAVES + wave, G * NWAVES, (LAS float*)(lds + wave * 16640), lane); __syncthreads(); } }
        SEAM(pb + 7);
        REP(pb + 8) if (IN(pb + 8)) { REPBAR KArgsP ap = fresh_args(); PHASE_IDS unsigned char* ws = ap->ws; (void)ws;
            LAS int* ptab = (LAS int*)(lds + PTAB_OFF); LAS int* pst = ptab + 512; LAS int* cnt = pst + 32;
            build_ptab((const unsigned*)(ws + WS_CTL) + CW_CNT + l * 32, ptab, pst, cnt, tid);
            pg8::Gemm g{(const pg8::bf16_t*)(ws + WS_HN), (const pg8::bf16_t*)(ws + WS_W13), 0, 0, DM, (const int*)(ws + WS_LIST), ptab};
            pg8::MoeOrder S{ptab, G, vcu};
            pg8::EpiSwiglu E{(pg8::bf16_t*)(ws + WS_HMID)};
SUBREP(9) { pg8::gemm_phase<pg8::EpiSwiglu, pg8::MoeOrder, false, true, true>(lds, g, S, E); __syncthreads(); }
        }
        SEAM(pb + 8);
        REP(pb + 9) if (IN(pb + 9)) { REPBAR KArgsP ap = fresh_args(); PHASE_IDS unsigned char* ws = ap->ws; (void)ws;
            LAS int* ptab = (LAS int*)(lds + PTAB_OFF); LAS int* pst = ptab + 512; LAS int* cnt = pst + 32;
            build_ptab((const unsigned*)(ws + WS_CTL) + CW_CNT + l * 32, ptab, pst, cnt, tid);
            pg8::Gemm g{(const pg8::bf16_t*)(ws + WS_HMID), (const pg8::bf16_t*)(ws + WS_W2), 0, 0, DEXP};
            pg8::MoeOrder S{ptab, G, vcu};
            pg8::EpiMoeOut E{(pg8::bf16_t*)(ws + WS_YMOE), (const int*)(ws + WS_LIST), ptab};
SUBREP(10) { pg8::gemm_phase<pg8::EpiMoeOut, pg8::MoeOrder, true, true>(lds, g, S, E); __syncthreads(); }
        }
        SEAM(pb + 9);
#else
        SEAM(pb + 6); SEAM(pb + 7); SEAM(pb + 8); SEAM(pb + 9);
#endif
    }
#undef LCONST
#endif
    if (IN(PH_FINAL)) { KArgsP ap = fresh_args(); PHASE_IDS
#if EN_MOE
        if (N_LAYERS > 0) phase_rownorm<1, true>(ap, lds, tid, lane, wave, G, ap->out, ap->out, ap->in[I_NORM_FINAL], false, 0, 0, N_LAYERS - 1);
        else phase_rownorm<1, false>(ap, lds, tid, lane, wave, G, ap->in[I_X], ap->out, ap->in[I_NORM_FINAL], false, 0, 0, 0);
#else
        phase_rownorm<1, false>(ap, lds, tid, lane, wave, G, N_LAYERS > 0 ? (const float*)ap->out : ap->in[I_X], ap->out, ap->in[I_NORM_FINAL], false, 0, 0, 0);
#endif
    }
#undef IN
#undef SEAM
}

extern "C" void kernel_launch(void* const* d_in, const int* in_sizes, int n_in, void* d_out, int out_size, void* d_ws, size_t ws_size, hipStream_t stream) {
    static int grid = 0;
    if (grid == 0) {
        if (n_in != 47 || out_size != NTOK * DM || ws_size < WS_END) { fprintf(stderr, "kernel_launch: unexpected problem (n_in %d, out %d, ws %zu < %zu)\n", n_in, out_size, ws_size, (size_t)WS_END); grid = -1; return; }
        int dev = 0, cus = 0, per_cu = 0;
        if (hipGetDevice(&dev) != hipSuccess || hipDeviceGetAttribute(&cus, hipDeviceAttributeMultiprocessorCount, dev) != hipSuccess) { grid = -1; return; }
        if (hipFuncSetAttribute((const void*)fwd, hipFuncAttributeMaxDynamicSharedMemorySize, LDS_BYTES) != hipSuccess) { fprintf(stderr, "kernel_launch: hipFuncSetAttribute failed\n"); grid = -1; return; }
        if (hipOccupancyMaxActiveBlocksPerMultiprocessor(&per_cu, (const void*)fwd, NTHR, LDS_BYTES) != hipSuccess || per_cu < 1) fprintf(stderr, "kernel_launch: occupancy query says %d\n", per_cu);
        (void)hipGetLastError();
        grid = cus;
        if (grid != 256) fprintf(stderr, "kernel_launch: %d CUs (built for 256)\n", grid);
    }
    if (grid < 0) return;
    (void)hipMemsetAsync((char*)d_ws + WS_CTL, 0, CTL_ZERO_BYTES, stream);
    Args a{};
    for (int i = 0; i < 47; ++i) a.in[i] = (const float*)d_in[i];
    a.out = (float*)d_out; a.ws = (unsigned char*)d_ws;
#if MK_PER_PHASE
    for (int p = 0; p < N_PHASES; ++p) { a.ph_lo = p; a.ph_hi = p + 1; hipLaunchKernelGGL(fwd, dim3(grid), dim3(NTHR), LDS_BYTES, stream, a); }
#else
    a.ph_lo = 0; a.ph_hi = N_PHASES; hipLaunchKernelGGL(fwd, dim3(grid), dim3(NTHR), LDS_BYTES, stream, a);
#endif
}
#ifdef DIAG_KERNELS
#define DK(name, ...) __global__ void __launch_bounds__(NTHR, 2) name(Args args) { extern __shared__ __attribute__((aligned(16))) unsigned char lds_raw[]; LAS unsigned char* lds = (LAS unsigned char*)lds_raw; \
    const int tid = threadIdx.x, lane = tid & 63, wave = __builtin_amdgcn_readfirstlane(tid >> 6); const int G = gridDim.x; const int bx = blockIdx.x; const int vcu = bx; KArgsP ap = fresh_args(); int l = ap->ph_lo; (void)lane; (void)wave; (void)vcu; (void)G; (void)l; __VA_ARGS__ }
DK(k_prologue, phase_prologue(ap, lds, tid, lane, wave, vcu, G);)
DK(k_norm0, phase_rownorm<0, false>(ap, lds, tid, lane, wave, G, ap->in[I_X], ap->out, ap->in[I_NORM_MIX], true, 0, 0, 0);)
DK(k_norm1, phase_rownorm<0, true>(ap, lds, tid, lane, wave, G, ap->out, ap->out, ap->in[I_NORM_MIX], false, l, 0, 0);)
DK(k_normf, phase_rownorm<1, true>(ap, lds, tid, lane, wave, G, ap->out, ap->out, ap->in[I_NORM_MIX], false, l, 0, 0);)
DK(k_m1, phase_m1(ap, lds, tid, lane, wave, vcu, G, l);)
DK(k_m2, phase_m2(ap->ws, tid, vcu, G);)
DK(k_m3, phase_m3(ap, lds, tid, lane, wave, vcu, G, l);)
DK(k_s1, phase_s1(ap, lds, tid, lane, wave, vcu, G, l);)
DK(k_s2, phase_s2(ap, tid, vcu, G, l);)
DK(k_s3, phase_s3(ap, lds, tid, lane, wave, vcu, G, l);)
DK(k_r1, phase_r1(ap, lds, tid, lane, wave, vcu, G, l);)
DK(k_r2b, phase_r2_build(ap, lds, tid, lane, wave, vcu, G, l);)
DK(k_r2s, phase_r2_scan(ap, lds, tid, lane, wave, vcu, l);)
DK(k_r3, phase_r3(ap, lane, vcu * NWAVES + wave, G * NWAVES, l);)
DK(k_router, phase_router(ap, lds, tid, lane, wave, G, l);)
DK(k_gather, phase_gather(ap, lds, tid, lane, wave, vcu, G, l);)
DK(k_moecv, moe_convert13(ap->in[I_MW1], ap->in[I_MW3], 1, (bf16*)(ap->ws + WS_W13), vcu * NWAVES + wave, G * NWAVES, (LAS float*)(lds + wave * 16640), lane);)
#endif
```

```cpp
#include <hip/hip_runtime.h>
#include <cstdio>
#include <cstdint>
#define MK_PER_PHASE 0

#ifndef MK_PER_PHASE
#define MK_PER_PHASE 0
#endif
#ifndef EN_MLSTM
#define EN_MLSTM 1
#endif
#ifndef EN_S5
#define EN_S5 1
#endif
#ifndef EN_RWKV
#define EN_RWKV 1
#endif
#ifndef EN_MOE
#define EN_MOE 1
#endif
#ifndef N_LAYERS
#define N_LAYERS 2
#endif
constexpr int NWAVES = 8, NTHR = 512;
constexpr int DM = 1024, NB = 4, SEQ = 8192, NTOK = NB * SEQ;
constexpr int DA = 384, DBR = 384, DC = 256, NH = 6, HD = 64, NCH = SEQ / 64;
constexpr int IN_COLS = 2828, NPROJ = 2816, NPROJ_PAD = 3072;
constexpr int PC_QK = 0, PC_V = 384, PC_O = 768, PC_RW = 1152, PC_S5 = 2560;
constexpr int RWC_R = 0, RWC_K = 384, RWC_V = 768, RWC_WD = 1152, RWC_AD = 1216, RWC_GD = 1280, RW_COLS = 1408;
constexpr int NEXP = 32, DEXP = 512, MOE_ROWS_MAX = 73728;
constexpr int NUNIT_M = NB * NCH * NH;
constexpr int CL_STRIDE = 4160;
constexpr float NORM_EPS = 1e-6f, HEAD_NORM_EPS = 1e-5f, RWKV_GN_EPS = 64e-5f;

constexpr size_t MiB = 1u << 20;
constexpr size_t WS_CTL = 0, CTL_ZERO_BYTES = 1 * MiB;
constexpr size_t WS_MODP = 1 * MiB;
constexpr size_t WS_MODF = 2 * MiB + 512 * 1024;
constexpr size_t WS_S5BB = 2 * MiB + 896 * 1024;
constexpr size_t WS_RTW = 3 * MiB;
constexpr size_t WS_S5AP = 3 * MiB + 384 * 1024;
constexpr size_t WS_MLW = 3 * MiB + 512 * 1024;
constexpr size_t WS_S5CM = 2 * MiB + 768 * 1024;
constexpr size_t WS_GLUT = 3 * MiB + 768 * 1024;
constexpr size_t WS_WIN = 4 * MiB;
constexpr size_t WS_WOUT = 16 * MiB;
constexpr size_t WS_GATES = 20 * MiB;
constexpr size_t WS_W13 = 22 * MiB;
constexpr size_t WS_W2 = 86 * MiB;
constexpr size_t WS_HN = 118 * MiB;
constexpr size_t WS_CLOC = 118 * MiB;
constexpr size_t WS_MSC = 168 * MiB;
constexpr size_t WS_S5ST = 170 * MiB;
constexpr size_t WS_VF = 182 * MiB;
constexpr size_t WS_YC = 206 * MiB;
constexpr size_t WS_LIST = 206 * MiB;
constexpr size_t WS_ROWMAP = 214 * MiB;
constexpr size_t WS_TOKE = 215 * MiB;
constexpr size_t WS_TOKW = 215 * MiB + 512 * 1024;
constexpr size_t WS_PROJ = 270 * MiB;
constexpr size_t WS_RE = 446 * MiB, WS_RA = 470 * MiB, WS_RG = 494 * MiB, WS_RVG = 518 * MiB;
constexpr size_t WS_XG = 270 * MiB;
constexpr size_t WS_HMID = 414 * MiB;
constexpr size_t WS_YMOE = 270 * MiB;
constexpr size_t WS_R1W = 542 * MiB;
constexpr size_t WS_OPA = 22 * MiB;
constexpr size_t WS_OPB = 543 * MiB;
constexpr size_t WS_END = 591 * MiB;
constexpr int CW_TMO = 0, CW_BAR = 4096, CW_CNT = 8192, CW_Q = 8320;

constexpr int RING_BYTES = 131072, MISC_OFF = 135168, PTAB_OFF = MISC_OFF + 1024, LDS_BYTES = 147456;

#define GAS __attribute__((address_space(1)))
#define LAS __attribute__((address_space(3)))
typedef unsigned short bf16;
typedef unsigned v4u __attribute__((ext_vector_type(4)));
typedef unsigned v2u __attribute__((ext_vector_type(2)));
typedef float f32x4 __attribute__((ext_vector_type(4)));
typedef float f32x2 __attribute__((ext_vector_type(2)));
typedef GAS unsigned gu32;
#define RLX_AGENT __ATOMIC_RELAXED, __HIP_MEMORY_SCOPE_AGENT
#define LDS_WAIT() asm volatile("s_waitcnt lgkmcnt(0)" ::: "memory")
#define VM_WAIT() asm volatile("s_waitcnt vmcnt(0)" ::: "memory")
typedef float f32x2v __attribute__((ext_vector_type(2)));
typedef __bf16 bf16x2v __attribute__((ext_vector_type(2)));
__device__ __forceinline__ unsigned pk2(float lo, float hi) { const f32x2v v = {lo, hi}; const bf16x2v b = __builtin_convertvector(v, bf16x2v); return __builtin_bit_cast(unsigned, b); }
__device__ __forceinline__ unsigned f2bf(float f) { return pk2(f, 0.f) & 0xffffu; }
__device__ __forceinline__ float bf2f(unsigned v) { return __builtin_bit_cast(float, v << 16); }
__device__ __forceinline__ float bflo(unsigned w) { return __builtin_bit_cast(float, w << 16); }
__device__ __forceinline__ float bfhi(unsigned w) { return __builtin_bit_cast(float, w & 0xffff0000u); }
__device__ __forceinline__ float sigmoidf_(float x) { return 1.f / (1.f + __expf(-x)); }
__device__ __forceinline__ float wave_sum(float v) {
#pragma unroll
    for (int o = 1; o < 64; o <<= 1) v += __shfl_xor(v, o);
    return v;
}
__device__ __forceinline__ float wave_max(float v) {
#pragma unroll
    for (int o = 1; o < 64; o <<= 1) v = fmaxf(v, __shfl_xor(v, o));
    return v;
}
namespace pg8 {
#define PG8_LAS __attribute__((address_space(3)))
typedef unsigned short bf16_t;
typedef short bf16x8 __attribute__((ext_vector_type(8)));
typedef float f32x4 __attribute__((ext_vector_type(4)));
typedef unsigned u32x4 __attribute__((ext_vector_type(4)));
constexpr int BM = 256, BK = 64, HALF = 128, HTB = HALF * BK * 2  , STAGE_BYTES = 8 * HTB, NXCD = 8, WGM = 8;

__host__ __device__ __forceinline__ int lds_byte(int r, int c) { const int st = (r >> 4) * 2 + (c >> 5), rr = r & 15, cc = c & 31, ob = rr * 64 + cc * 2; return st * 1024 + (ob ^ (((ob >> 9) & 1) << 5)); }
__host__ __device__ __forceinline__ void stage_rc(int b, int& R, int& C) { const int st = b / 1024, sb = b % 1024, swz = sb ^ (((sb >> 9) & 1) << 5); R = (st >> 1) * 16 + swz / 64; C = (st & 1) * 32 + (swz % 64) / 2; }
__host__ __device__ __forceinline__ int perm32(int rho) { const int n = rho >> 4, i = rho & 15; return 8 * (i >> 2) + 4 * n + (i & 3); }

struct Unit { int pm, pn; };
__device__ __forceinline__ int moe_tok2(const int* list, PG8_LAS const int* ptab, int row) { const int e = ptab[1 + (row >> 8)], pos = row - ptab[512 + e]; return pos < ptab[544 + e] ? list[(size_t)e * 65536 + pos] : -1; }
struct Gemm { const bf16_t* A; const bf16_t* Bt; int M, N, K; const int* list = nullptr; PG8_LAS const int* ptab = nullptr; };

struct StaticOrder {
    int nM, nN, nwg, G, c;
    __host__ __device__ void init(int M, int N, int G_, int c_) { nM = M / BM; nN = N / BM; nwg = nM * nN; G = G_; c = c_; }
    __host__ __device__ bool next(int i, Unit& u) const {
        const long L = (long)i * G + c; if (L >= nwg) return false;
        int wgid = (int)L; { const int q = nwg / NXCD, r = nwg % NXCD, xcd = wgid % NXCD, off = wgid / NXCD; wgid = (xcd < r ? xcd * (q + 1) : r * (q + 1) + (xcd - r) * q) + off; }
        const int nig = WGM * nN, gid = wgid / nig, fm = gid * WGM, gsz = (nM - fm) < WGM ? (nM - fm) : WGM;
        u.pm = fm + ((wgid % nig) % gsz); u.pn = (wgid % nig) / gsz; return true;
    }
    __device__ __forceinline__ void a_ready(const Unit&) const {}
    __device__ __forceinline__ void done(const Unit&) const {}
};

__device__ __forceinline__ unsigned cvt_pk_bf16(float lo, float hi) { unsigned r; asm volatile("v_cvt_pk_bf16_f32 %0, %1, %2" : "=v"(r) : "v"(lo), "v"(hi)); return r; }

struct EpiProj {
    static constexpr bool PERM = true, AFTER_DRAIN = false;
    bf16_t* O; float* G;
    __device__ __forceinline__ void operator()(const f32x4 (&acc)[2][2][4][2], const Unit& u, int wr, int wc, int fr, int fq) const {
        const int row0 = u.pm * BM + wr * 64 + fr;
        if (u.pn < 11) {
            const int col0 = u.pn * BM + wc * 32 + 8 * fq;
#pragma unroll
            for (int ai = 0; ai < 2; ++ai)
#pragma unroll
                for (int m = 0; m < 4; ++m) { bf16_t* rowp = O + (size_t)(row0 + ai * HALF + m * 16) * 2816 + col0;
#pragma unroll
                    for (int bj = 0; bj < 2; ++bj) { const f32x4 v0 = acc[ai][bj][m][0], v1 = acc[ai][bj][m][1];
                        u32x4 w; w.x = cvt_pk_bf16(v0[0], v0[1]); w.y = cvt_pk_bf16(v0[2], v0[3]); w.z = cvt_pk_bf16(v1[0], v1[1]); w.w = cvt_pk_bf16(v1[2], v1[3]);
                        *(u32x4*)(rowp + bj * HALF) = w; } }
        } else if (wc == 0 && fq < 2) {
#pragma unroll
            for (int ai = 0; ai < 2; ++ai)
#pragma unroll
                for (int m = 0; m < 4; ++m) { float* rowp = G + (size_t)(row0 + ai * HALF + m * 16) * 16 + 8 * fq;
                    *(f32x4*)(rowp) = acc[ai][0][m][0]; *(f32x4*)(rowp + 4) = acc[ai][0][m][1]; }
        }
    }
};
struct EpiResid {
    static constexpr bool PERM = true, AFTER_DRAIN = false;
    const float* xin; float* out; const float* gate;
    int goff;
    __device__ __forceinline__ void operator()(const f32x4 (&acc)[2][2][4][2], const Unit& u, int wr, int wc, int fr, int fq) const {
        const int row0 = u.pm * BM + wr * 64 + fr, col0 = u.pn * BM + wc * 32 + 8 * fq;
        const float* gp = gate + (size_t)(row0 >> 13) * 6144 + goff + col0;
        f32x4 g[2][2];
#pragma unroll
        for (int bj = 0; bj < 2; ++bj)
#pragma unroll
            for (int n = 0; n < 2; ++n) g[bj][n] = *(const f32x4*)(gp + bj * HALF + 4 * n) + 1.0f;
#pragma unroll
        for (int ai = 0; ai < 2; ++ai) { f32x4 xv[4][2][2];
#pragma unroll
            for (int m = 0; m < 4; ++m) { const size_t off = (size_t)(row0 + ai * HALF + m * 16) * 1024 + col0;
#pragma unroll
                for (int bj = 0; bj < 2; ++bj)
#pragma unroll
                    for (int n = 0; n < 2; ++n) xv[m][bj][n] = *(const f32x4*)(xin + off + bj * HALF + 4 * n); }
#pragma unroll
            for (int m = 0; m < 4; ++m) { const size_t off = (size_t)(row0 + ai * HALF + m * 16) * 1024 + col0;
#pragma unroll
                for (int bj = 0; bj < 2; ++bj)
#pragma unroll
                    for (int n = 0; n < 2; ++n) *(f32x4*)(out + off + bj * HALF + 4 * n) = xv[m][bj][n] + g[bj][n] * acc[ai][bj][m][n]; } }
    }
};
struct EpiSwiglu {
    static constexpr bool PERM = true, AFTER_DRAIN = false;
    bf16_t* H;
    __device__ __forceinline__ void operator()(const f32x4 (&acc)[2][2][4][2], const Unit& u, int wr, int wc, int fr, int fq) const {
        const int row0 = u.pm * BM + wr * 64 + fr, hid0 = 128 * (u.pn & 3) + 16 * wc + 4 * fq;
#pragma unroll
        for (int ai = 0; ai < 2; ++ai)
#pragma unroll
            for (int m = 0; m < 4; ++m) { bf16_t* rowp = H + (size_t)(row0 + ai * HALF + m * 16) * 512 + hid0;
#pragma unroll
                for (int bj = 0; bj < 2; ++bj) { const f32x4 g = acc[ai][bj][m][0], uu = acc[ai][bj][m][1]; float h[4];
#pragma unroll
                    for (int i = 0; i < 4; ++i) h[i] = g[i] / (1.f + __expf(-g[i])) * uu[i];
                    unsigned w0 = cvt_pk_bf16(h[0], h[1]), w1 = cvt_pk_bf16(h[2], h[3]);
                    *(unsigned long long*)(rowp + 64 * bj) = (unsigned long long)w0 | ((unsigned long long)w1 << 32); } }
    }
};
struct EpiMoeOut {
    static constexpr bool PERM = true, AFTER_DRAIN = false;
    bf16_t* Y; const int* list; PG8_LAS const int* ptab;
    __device__ __forceinline__ void operator()(const f32x4 (&acc)[2][2][4][2], const Unit& u, int wr, int wc, int fr, int fq) const {
        const int row0 = u.pm * BM + wr * 64 + fr, col0 = (u.pn & 3) * BM + wc * 32 + 8 * fq;
        int dsts[2][4];
#pragma unroll
        for (int ai = 0; ai < 2; ++ai)
#pragma unroll
            for (int m = 0; m < 4; ++m) dsts[ai][m] = moe_tok2(list, ptab, row0 + ai * HALF + m * 16);
#pragma unroll
        for (int ai = 0; ai < 2; ++ai)
#pragma unroll
            for (int m = 0; m < 4; ++m) { const int dst = dsts[ai][m];
                if (dst >= 0) { bf16_t* rowp = Y + (size_t)dst * 1024 + col0;
#pragma unroll
                    for (int bj = 0; bj < 2; ++bj) { const f32x4 v0 = acc[ai][bj][m][0], v1 = acc[ai][bj][m][1];
                        u32x4 w; w.x = cvt_pk_bf16(v0[0], v0[1]); w.y = cvt_pk_bf16(v0[2], v0[3]); w.z = cvt_pk_bf16(v1[0], v1[1]); w.w = cvt_pk_bf16(v1[2], v1[3]);
                        *(u32x4*)(rowp + bj * HALF) = w; } } }
    }
};
struct MoeOrder {
    PG8_LAS const int* ptab; int G, c;
    __device__ __forceinline__ bool next(int i, Unit& u) const {
        const int L = i * G + c, np = __builtin_amdgcn_readfirstlane(ptab[0]);
        if (L >= np * 4) return false;
        const int p = L >> 2; u.pm = p; u.pn = __builtin_amdgcn_readfirstlane(ptab[1 + p]) * 4 + (L & 3); return true;
    }
    __device__ __forceinline__ void a_ready(const Unit&) const {}
    __device__ __forceinline__ void done(const Unit&) const {}
};
template <class Epi, class Sched, bool ALIGN_EPI = false, bool SP2 = false, bool GATHER = false>
__device__ __forceinline__ void gemm_phase(PG8_LAS unsigned char* lds, const Gemm g, const Sched& S, const Epi& E) {
    int tid_ = threadIdx.x; asm volatile("" : "+v"(tid_));
    const int tid = tid_, wid = __builtin_amdgcn_readfirstlane(tid >> 6), lane = tid & 63, wr = wid >> 2, wc = wid & 3, fr = lane & 15, fq = lane >> 4;
    const int K = g.K, nt = K / BK;
    static_assert(!GATHER || SP2, "the gathered-A variant exists for the SP2 loop only");
    unsigned voffA[2], voffB[2];
    unsigned vAc[2] = {0u, 0u}, vAn[2] = {0u, 0u};
#pragma unroll
    for (int i = 0; i < 2; ++i) { int R, C; stage_rc(tid * 16 + i * 8192, R, C); const int Rb = Epi::PERM ? ((R & ~31) + perm32(R & 31)) : R;
        voffA[i] = (unsigned)(R * K + C) * 2u; voffB[i] = (unsigned)(Rb * K + C) * 2u; }
    const size_t kstep = (size_t)(BK * 2);
    const size_t hstep = (size_t)HALF * K * 2;
    const size_t tstep = 2 * hstep;
    const unsigned ldsw = (unsigned)wid * 1024u;
    const int aoff = lds_byte(wr * 64 + fr, fq * 8), boff = lds_byte(wc * 32 + fr, fq * 8);
#define PG8_SA(b, h) (((b) * 2 + (h)) * HTB)
#define PG8_SB(b, h) ((4 + (b) * 2 + (h)) * HTB)
#define PG8_STAGE(bufoff, gbase, voff) do { _Pragma("unroll") for (int _i = 0; _i < 2; ++_i) \
        __builtin_amdgcn_global_load_lds((const unsigned*)((const char*)(gbase) + (voff)[_i]), (PG8_LAS unsigned*)(lds + (bufoff) + ldsw + _i * 8192), 16, 0, 0); } while (0)
#define PG8_STAGEG(bufoff, base, pk) do { unsigned vg_[2]; _Pragma("unroll") for (int i_ = 0; i_ < 2; ++i_) { int R_, C_; stage_rc(tid * 16 + i_ * 8192, R_, C_); vg_[i_] = (((pk) >> (16 * i_)) & 0xffffu) * (unsigned)(2 * K) + (unsigned)(2 * C_); } PG8_STAGE(bufoff, base, vg_); } while (0)
#define PG8_STAGEA(bufoff, base, hh, nx) do { if constexpr (GATHER) { const unsigned pk_ = (nx) ? vAn[hh] : vAc[hh]; PG8_STAGEG(bufoff, base, pk_); } else PG8_STAGE(bufoff, (base) + (hh) * hstep, voffA); } while (0)
#define PG8_GOFF(dst, unit) do { _Pragma("unroll") for (int hh_ = 0; hh_ < 2; ++hh_) { unsigned pk_ = 0u; _Pragma("unroll") for (int i_ = 0; i_ < 2; ++i_) { int R_, C_; stage_rc(tid * 16 + i_ * 8192, R_, C_); \
        const int t2_ = moe_tok2(g.list, g.ptab, (unit).pm * BM + hh_ * HALF + R_); pk_ |= (unsigned)(t2_ < 0 ? 0 : (t2_ >> 1)) << (16 * i_); } dst[hh_] = pk_; } } while (0)
#define PG8_LDA(dst, b, h) do { _Pragma("unroll") for (int m = 0; m < 4; ++m) _Pragma("unroll") for (int k = 0; k < 2; ++k) dst[m][k] = *(const PG8_LAS bf16x8*)(lds + PG8_SA(b, h) + aoff + m * 2048 + k * 1024); } while (0)
#define PG8_LDB(dst, b, h) do { _Pragma("unroll") for (int n = 0; n < 2; ++n) _Pragma("unroll") for (int k = 0; k < 2; ++k) dst[n][k] = *(const PG8_LAS bf16x8*)(lds + PG8_SB(b, h) + boff + n * 2048 + k * 1024); } while (0)
#define PG8_MMA(ai, bj, At, Bt) do { __builtin_amdgcn_s_setprio(1); _Pragma("unroll") for (int m = 0; m < 4; ++m) _Pragma("unroll") for (int n = 0; n < 2; ++n) _Pragma("unroll") for (int k = 0; k < 2; ++k) \
        acc[ai][bj][m][n] = __builtin_amdgcn_mfma_f32_16x16x32_bf16(Bt[n][k], At[m][k], acc[ai][bj][m][n], 0, 0, 0); __builtin_amdgcn_s_setprio(0); } while (0)
#define PG8_WAIT_V(n) asm volatile("s_waitcnt vmcnt(" #n ")" ::: "memory")
#define PG8_WAIT_L(n) asm volatile("s_waitcnt lgkmcnt(" #n ")" ::: "memory")
#define PG8_BAR __builtin_amdgcn_s_barrier()
#define PG8_SCHED __builtin_amdgcn_sched_barrier(0)
    Unit cur, nxt; int ui = 0;
    if (!S.next(0, cur)) return;
    f32x4 acc[2][2][4][2];
#pragma unroll
    for (int a = 0; a < 2; ++a)
#pragma unroll
        for (int b = 0; b < 2; ++b)
#pragma unroll
            for (int m = 0; m < 4; ++m)
#pragma unroll
                for (int n = 0; n < 2; ++n) acc[a][b][m][n] = (f32x4){0.f, 0.f, 0.f, 0.f};
    bf16x8 At[4][2], B0[2][2], B1[2][2];
    const char* cA = (const char*)g.A + (GATHER ? (size_t)0 : (size_t)cur.pm * tstep); const char* cB = (const char*)g.Bt + (size_t)cur.pn * tstep;
    if constexpr (GATHER) { PG8_GOFF(vAc, cur); }
    S.a_ready(cur);
    if constexpr (SP2) {
        PG8_STAGE(PG8_SB(0, 0), cB, voffB); PG8_STAGE(PG8_SB(0, 1), cB + hstep, voffB); PG8_STAGEA(PG8_SA(0, 0), cA, 0, false); PG8_STAGEA(PG8_SA(0, 1), cA, 1, false);
        if (wr == 1) PG8_BAR;
        PG8_WAIT_V(2); PG8_BAR;
        PG8_STAGE(PG8_SB(1, 0), cB + kstep, voffB); PG8_STAGEA(PG8_SA(1, 0), cA + kstep, 0, false); PG8_STAGE(PG8_SB(1, 1), cB + hstep + kstep, voffB);
        PG8_WAIT_V(6); PG8_BAR;
    } else {
        PG8_STAGE(PG8_SB(0, 0), cB, voffB); PG8_STAGE(PG8_SA(0, 0), cA, voffA); PG8_STAGE(PG8_SB(0, 1), cB + hstep, voffB); PG8_STAGE(PG8_SA(0, 1), cA + hstep, voffA);
        if (wr == 1) PG8_BAR;
        PG8_WAIT_V(4); PG8_BAR;
        PG8_STAGE(PG8_SB(1, 0), cB + kstep, voffB); PG8_STAGE(PG8_SA(1, 0), cA + kstep, voffA); PG8_STAGE(PG8_SB(1, 1), cB + hstep + kstep, voffB);
        PG8_WAIT_V(6); PG8_BAR;
    }
    for (;;) {
        const bool has_next = S.next(ui + 1, nxt);
        const char* nA = (has_next && !GATHER) ? (const char*)g.A + (size_t)nxt.pm * tstep : cA;
        if constexpr (GATHER) { if (has_next) { PG8_GOFF(vAn, nxt); } else { vAn[0] = vAc[0]; vAn[1] = vAc[1]; } } const char* nB = has_next ? (const char*)g.Bt + (size_t)nxt.pn * tstep : cB;
        for (int t = 0; t < nt; t += 2) {
            const bool last = (t == nt - 2);
            const char* a1 = cA + (size_t)(t + 1) * kstep;
            const char* a2 = last ? nA : cA + (size_t)(t + 2) * kstep; const char* b2 = last ? nB : cB + (size_t)(t + 2) * kstep;
            const char* a3 = a2 + kstep; const char* b3 = b2 + kstep;
            if (last && has_next) S.a_ready(nxt);
            if constexpr (SP2) {
            PG8_LDB(B0, 0, 0); PG8_LDB(B1, 0, 1); PG8_SCHED; PG8_LDA(At, 0, 0); PG8_STAGEA(PG8_SA(1, 1), a1, 1, false);
            PG8_WAIT_V(8); PG8_WAIT_L(0); PG8_BAR; PG8_MMA(0, 0, At, B0); PG8_MMA(0, 1, At, B1); PG8_BAR; PG8_SCHED;
            PG8_LDA(At, 0, 1); PG8_STAGE(PG8_SB(0, 0), b2, voffB); PG8_STAGE(PG8_SB(0, 1), b2 + hstep, voffB); PG8_STAGEA(PG8_SA(0, 0), a2, 0, last);
            PG8_WAIT_V(8); PG8_WAIT_L(0); PG8_BAR; PG8_MMA(1, 0, At, B0); PG8_MMA(1, 1, At, B1); PG8_BAR; PG8_SCHED;
            PG8_LDB(B0, 1, 0); PG8_LDB(B1, 1, 1); PG8_SCHED; PG8_LDA(At, 1, 0); PG8_STAGEA(PG8_SA(0, 1), a2, 1, last);
            PG8_WAIT_V(8); PG8_WAIT_L(0); PG8_BAR; PG8_MMA(0, 0, At, B0); PG8_MMA(0, 1, At, B1); PG8_BAR; PG8_SCHED;
            PG8_LDA(At, 1, 1); PG8_STAGE(PG8_SB(1, 0), b3, voffB); PG8_STAGE(PG8_SB(1, 1), b3 + hstep, voffB); PG8_STAGEA(PG8_SA(1, 0), a3, 0, last);
            PG8_WAIT_V(8); PG8_WAIT_L(0); PG8_BAR; PG8_MMA(1, 0, At, B0); PG8_MMA(1, 1, At, B1); PG8_BAR; PG8_SCHED;
            } else {
            PG8_LDB(B0, 0, 0); PG8_SCHED; PG8_LDA(At, 0, 0); PG8_STAGE(PG8_SA(1, 1), a1 + hstep, voffA);
            PG8_WAIT_L(8); PG8_BAR; PG8_WAIT_L(0); PG8_MMA(0, 0, At, B0); PG8_BAR; PG8_SCHED;
            PG8_LDB(B1, 0, 1); PG8_STAGE(PG8_SB(0, 0), b2, voffB);
            PG8_BAR; PG8_WAIT_L(0); PG8_MMA(0, 1, At, B1); PG8_BAR;
            PG8_LDA(At, 0, 1); PG8_STAGE(PG8_SA(0, 0), a2, voffA);
            PG8_BAR; PG8_WAIT_L(0); PG8_MMA(1, 0, At, B0); PG8_BAR; PG8_SCHED;
            PG8_STAGE(PG8_SB(0, 1), b2 + hstep, voffB);
            PG8_WAIT_V(6); PG8_BAR; PG8_MMA(1, 1, At, B1); PG8_BAR;
            PG8_LDB(B0, 1, 0); PG8_SCHED; PG8_LDA(At, 1, 0); PG8_STAGE(PG8_SA(0, 1), a2 + hstep, voffA);
            PG8_WAIT_L(8); PG8_BAR; PG8_WAIT_L(0); PG8_MMA(0, 0, At, B0); PG8_BAR; PG8_SCHED;
            PG8_LDB(B1, 1, 1); PG8_STAGE(PG8_SB(1, 0), b3, voffB);
            PG8_BAR; PG8_WAIT_L(0); PG8_MMA(0, 1, At, B1); PG8_BAR;
            PG8_LDA(At, 1, 1); PG8_STAGE(PG8_SA(1, 0), a3, voffA);
            PG8_BAR; PG8_WAIT_L(0); PG8_MMA(1, 0, At, B0); PG8_BAR; PG8_SCHED;
            PG8_STAGE(PG8_SB(1, 1), b3 + hstep, voffB);
            PG8_WAIT_V(6); PG8_BAR; PG8_MMA(1, 1, At, B1); PG8_BAR;
            }
        }
        if constexpr (ALIGN_EPI) { if (wr == 0) PG8_BAR; }
        if constexpr (!Epi::AFTER_DRAIN) { E(acc, cur, wr, wc, fr, fq); S.done(cur); }
        if (!has_next) break;
#pragma unroll
        for (int a = 0; a < 2; ++a)
#pragma unroll
            for (int b = 0; b < 2; ++b)
#pragma unroll
                for (int m = 0; m < 4; ++m)
#pragma unroll
                    for (int n = 0; n < 2; ++n) acc[a][b][m][n] = (f32x4){0.f, 0.f, 0.f, 0.f};
        cur = nxt; cA = nA; cB = nB; ++ui;
        if constexpr (GATHER) { vAc[0] = vAn[0]; vAc[1] = vAn[1]; }
        if constexpr (ALIGN_EPI) { if (wr == 1) PG8_BAR; }
    }
    PG8_WAIT_V(0);
    if constexpr (!ALIGN_EPI) { if (wr == 0) PG8_BAR; }
    PG8_BAR;
    if constexpr (Epi::AFTER_DRAIN) { E.fused(acc, cur, wr, wc, fr, fq, lds, wid, lane); S.done(cur); }
#undef PG8_SA
#undef PG8_SB
#undef PG8_STAGE
#undef PG8_STAGEA
#undef PG8_STAGEG
#undef PG8_GOFF
#undef PG8_LDA
#undef PG8_LDB
#undef PG8_MMA
#undef PG8_WAIT_V
#undef PG8_WAIT_L
#undef PG8_BAR
#undef PG8_SCHED
}
}
#define XB_TMO      128
#define XB_XCNT(j)  (256  + 64 * (j))
#define XB_XSUB(j)  (1280 + 64 * (j))
#define XB_XGEN(j)  (2304 + 64 * (j))
#define XB_TOP      3328
#define XB_TOPGEN   3392
#define XCD_BAR_WORDS 3456
#define XB_SPIN_CAP (1u << 18)
#define LAS __attribute__((address_space(3)))

__device__ __forceinline__ unsigned xb_ld(unsigned* p)              { return __hip_atomic_load(p, __ATOMIC_RELAXED, __HIP_MEMORY_SCOPE_AGENT); }
__device__ __forceinline__ unsigned xb_add(unsigned* p, unsigned v) { return __hip_atomic_fetch_add(p, v, __ATOMIC_RELAXED, __HIP_MEMORY_SCOPE_AGENT); }
__device__ __forceinline__ unsigned xb_xcc_id() { return (unsigned)__builtin_amdgcn_s_getreg((3 << 11) | 20) & 0xFu; }
#define XB_SPIN(cond, bar) do { unsigned _sp = 0; while (cond) { __builtin_amdgcn_s_sleep(1); \
    if ((++_sp & 255u) == 0u) { if (xb_ld(&(bar)[XB_TMO])) break; if (_sp > XB_SPIN_CAP) { atomicAdd(&(bar)[XB_TMO], 1u); break; } } } } while (0)

struct XcdBarrier {
    unsigned* bar; unsigned x;
    volatile LAS unsigned* st;
};

__device__ __forceinline__ XcdBarrier xcd_barrier_post(unsigned* bar, volatile LAS unsigned* st) {
    XcdBarrier b; b.bar = bar; b.x = xb_xcc_id(); b.st = st;
    if (threadIdx.x == 0) (void)xb_add(&bar[XB_XCNT(b.x)], 1u);
    return b;
}
__device__ __forceinline__ void xcd_barrier_complete(unsigned* bar, unsigned x, unsigned& nloc, unsigned& nx) {
    const unsigned G = gridDim.x * gridDim.y * gridDim.z;
    unsigned sum, cnt, mine, sp = 0u;
    for (;;) {
        sum = 0u; cnt = 0u; mine = 0u;
#pragma unroll
        for (unsigned j = 0; j < 16; ++j) { const unsigned c = xb_ld(&bar[XB_XCNT(j)]); sum += c; cnt += (c > 0u) ? 1u : 0u; mine = (j == x) ? c : mine; }
        if (sum == G) break;
        __builtin_amdgcn_s_sleep(1);
        if ((++sp & 255u) == 0u) { if (xb_ld(&bar[XB_TMO])) break; if (sp > XB_SPIN_CAP) { atomicAdd(&bar[XB_TMO], 1u); break; } }
    }
    nloc = mine > 0u ? mine : 1u; nx = cnt > 0u ? cnt : 1u;
}

__device__ __forceinline__ void xcd_barrier(const XcdBarrier& b) {
    asm volatile("s_waitcnt vmcnt(0)" ::: "memory");
    __syncthreads();
    if (threadIdx.x == 0) {
        unsigned* bar = b.bar;
        __builtin_amdgcn_s_waitcnt(0);
        unsigned nloc = b.st[0], nx = b.st[1];
        if (nloc == 0u) { xcd_barrier_complete(bar, b.x, nloc, nx); b.st[0] = nloc; b.st[1] = nx; }
        const unsigned old = xb_add(&bar[XB_XSUB(b.x)], 1u);
        const unsigned gen = old / nloc;
        if (old + 1u == (gen + 1u) * nloc) {
            __builtin_amdgcn_fence(__ATOMIC_RELEASE, "agent");
            asm volatile("s_waitcnt vmcnt(0)" ::: "memory");
            const unsigned og = xb_add(&bar[XB_TOP], 1u);
            const unsigned tg = og / nx;
            if (og + 1u == (tg + 1u) * nx) xb_add(&bar[XB_TOPGEN], 1u);
            else XB_SPIN(xb_ld(&bar[XB_TOPGEN]) == tg, bar);
            __builtin_amdgcn_fence(__ATOMIC_ACQUIRE, "agent");
            xb_add(&bar[XB_XGEN(b.x)], 1u);
            asm volatile("s_waitcnt vmcnt(0)" ::: "memory");
        } else {
            XB_SPIN(xb_ld(&bar[XB_XGEN(b.x)]) == gen, bar);
            __builtin_amdgcn_fence(__ATOMIC_ACQUIRE, "agent");
            asm volatile("s_waitcnt vmcnt(0)" ::: "memory");
        }
    }
    __syncthreads();
}

struct Args { const float* in[47]; float* out; unsigned char* ws; int ph_lo, ph_hi; };
typedef const __attribute__((address_space(4))) Args* KArgsP;
__device__ __forceinline__ KArgsP fresh_args() { KArgsP p = (KArgsP)__builtin_amdgcn_kernarg_segment_ptr(); asm volatile("" : "+s"(p)); return p; }
enum { I_X = 0, I_C, I_ADA_W, I_ADA_B, I_NORM_MIX, I_NORM_FFN, I_NORM_FINAL, I_W_IN, I_W_OUT, I_CONV_W, I_CONV_B, I_WQ, I_WK, I_BI, I_BF, I_MNORM_W,
       I_RMU, I_RW0, I_RWUP, I_RA0, I_RAUP, I_RGUP, I_RKK, I_RKA, I_RRK, I_RLNW, I_RLNB, I_RV0, I_RVDN, I_RVUP,
       I_S5ARE, I_S5AIM, I_S5LDT, I_S5BRE, I_S5BIM, I_S5CRE, I_S5CIM, I_S5D, I_S5GLUW, I_S5GLUB,
       I_MWRG, I_MBRG, I_MWRE, I_MBRE, I_MW1, I_MW3, I_MW2 };

struct RmWin { __device__ __forceinline__ int operator()(int n) const { return n < 1152 ? n : (n < 1164 ? 2816 + (n - 1152) : (n < 2572 ? 1152 + (n - 1164) : 2560 + (n - 2572))); } };
struct RmId  { __device__ __forceinline__ int operator()(int n) const { return n; } };
struct RmGU  { int add; __device__ __forceinline__ int operator()(int n) const { return 8 * (n >> 2) + (n & 3) + add; } };
template <class RM>
__device__ __forceinline__ void transpose_item(const float* W, int ldw, int ncols, int k0, int n0, bf16* WT, int ldt, LAS float* scr, int lane, const RM rm) {
    if (n0 + 64 <= ncols && (ldw & 3) == 0) {
        const float* src = W + (size_t)(k0 + (lane >> 4)) * ldw + n0 + 4 * (lane & 15);
        f32x4 v[16];
#pragma unroll
        for (int i = 0; i < 16; ++i) v[i] = *(const GAS f32x4*)(src + (size_t)(4 * i) * ldw);
#pragma unroll
        for (int i = 0; i < 16; ++i) { LAS float* d = scr + (4 * i + (lane >> 4)) * 65 + 4 * (lane & 15); d[0] = v[i][0]; d[1] = v[i][1]; d[2] = v[i][2]; d[3] = v[i][3]; }
    } else {
    const int nn = n0 + lane; const bool ok = nn < ncols; const float* src = W + (size_t)k0 * ldw + (ok ? nn : n0);
    float v[64];
#pragma unroll
    for (int kk = 0; kk < 64; ++kk) v[kk] = src[(size_t)kk * ldw];
#pragma unroll
    for (int kk = 0; kk < 64; ++kk) scr[kk * 65 + lane] = v[kk];
    }
    LDS_WAIT(); asm volatile("" ::: "memory");
    const int c = lane & 7;
#pragma unroll
    for (int j = 0; j < 8; ++j) { const int nl = (lane >> 3) + 8 * j; const LAS float* s = scr + (8 * c) * 65 + nl;
        v4u o; o.x = pk2(s[0 * 65], s[1 * 65]); o.y = pk2(s[2 * 65], s[3 * 65]); o.z = pk2(s[4 * 65], s[5 * 65]); o.w = pk2(s[6 * 65], s[7 * 65]);
        if (n0 + nl < ncols) *(GAS v4u*)(WT + (size_t)rm(n0 + nl) * ldt + k0 + 8 * c) = o; }
    LDS_WAIT(); asm volatile("" ::: "memory");
}
__device__ __forceinline__ void moe_convert13(const float* w1, const float* w3, int l, bf16* W13, int worker, int nworkers, LAS float* scr, int lane) {
    for (int it = worker; it < NEXP * 256; it += nworkers) {
        const int e = it >> 8, r = it & 255; const size_t eo = (size_t)(l * NEXP + e) * DM * DEXP;
        if (r < 128) transpose_item(w1 + eo, DEXP, DEXP, 64 * (r >> 3), 64 * (r & 7), W13 + (size_t)e * 1024 * 1024, 1024, scr, lane, RmGU{0});
        else         transpose_item(w3 + eo, DEXP, DEXP, 64 * ((r - 128) >> 3), 64 * ((r - 128) & 7), W13 + (size_t)e * 1024 * 1024, 1024, scr, lane, RmGU{4});
    }
}
__device__ __forceinline__ void moe_convert2(const float* w2, int l, bf16* W2T, int worker, int nworkers, LAS float* scr, int lane) {
    for (int it = worker; it < NEXP * 128; it += nworkers) {
        const int e = it >> 7, r = it & 127; const size_t eo = (size_t)(l * NEXP + e) * DM * DEXP;
        transpose_item(w2 + eo, DM, DM, 64 * (r >> 4), 64 * (r & 15), W2T + (size_t)e * 1024 * 512, 512, scr, lane, RmId{});
    }
}
__device__ __forceinline__ void phase_prologue(KArgsP a, LAS unsigned char* lds, int tid, int lane, int wave, int vcu, int G) {
    unsigned char* ws = a->ws;
    LAS float* scr = (LAS float*)(lds + wave * 16640);
    const int gw = vcu * NWAVES + wave, NGW = G * NWAVES;
    bf16* WIN = (bf16*)(ws + WS_WIN); bf16* WOUT = (bf16*)(ws + WS_WOUT);
    for (int it = gw; it < 2 * 16 * 45; it += NGW) { const int l = it / (16 * 45), r = it % (16 * 45);
        transpose_item(a->in[I_W_IN] + (size_t)l * DM * IN_COLS, IN_COLS, IN_COLS, 64 * (r / 45), 64 * (r % 45), WIN + (size_t)l * NPROJ_PAD * DM, DM, scr, lane, RmWin{}); }
    for (int it = gw; it < 2 * 16 * 16; it += NGW) { const int l = it / 256, r = it % 256;
        transpose_item(a->in[I_W_OUT] + (size_t)l * DM * DM, DM, DM, 64 * (r >> 4), 64 * (r & 15), WOUT + (size_t)l * DM * DM, DM, scr, lane, RmId{}); }
    for (int it = gw; it < 2 * 244; it += NGW) { const int l = it / 244, r = 2828 + it % 244; GAS v4u* p = (GAS v4u*)(WIN + ((size_t)l * NPROJ_PAD + r) * DM);
        p[lane] = (v4u){0u, 0u, 0u, 0u}; p[lane + 64] = (v4u){0u, 0u, 0u, 0u}; }
    { float* RTW = (float*)(ws + WS_RTW);
      for (int idx = (vcu * NTHR + tid); idx < 2 * 1024 * 48; idx += G * NTHR) { const int j = idx % 48, k = (idx / 48) % 1024, l = idx / (48 * 1024);
          RTW[(size_t)l * 49152 + ((k >> 2) * 16 + (j & 15)) * 12 + (k & 3) * 3 + (j >> 4)] = j < 4 ? a->in[I_MWRG][(size_t)(l * 1024 + k) * 4 + j] : (j < 36 ? a->in[I_MWRE][(size_t)(l * 1024 + k) * 32 + (j - 4)] : 0.f); } }
    { bf16* RW = (bf16*)(ws + WS_R1W);
      for (int idx = (vcu * NTHR + tid); idx < 2 * 98304 + 24576; idx += G * NTHR) { float v;
          if (idx < 2 * 98304) { const int l = idx / 98304, r = idx % 98304;
              if (r < 24576)      v = a->in[I_RWUP][(size_t)l * 64 * DBR + (r & 63) * DBR + (r >> 6)];
              else if (r < 49152) v = a->in[I_RAUP][(size_t)l * 64 * DBR + ((r - 24576) & 63) * DBR + ((r - 24576) >> 6)];
              else                v = a->in[I_RGUP][(size_t)l * 128 * DBR + ((r - 49152) & 127) * DBR + ((r - 49152) >> 7)];
          } else { const int r = idx - 2 * 98304;
              if (r < 12288) v = a->in[I_RVDN][(size_t)(r % 384) * 32 + (r / 384)];
              else           v = a->in[I_RVUP][(size_t)((r - 12288) & 31) * DBR + ((r - 12288) >> 5)]; }
          RW[idx] = (bf16)f2bf(v); } }
    for (int idx = (vcu * NTHR + tid); idx < 2 * 16 * 64; idx += G * NTHR) { const int p = idx & 63, lg = idx >> 6;
        const float lam_re = a->in[I_S5ARE][idx], lam_im = a->in[I_S5AIM][idx]; const float dt = expf(a->in[I_S5LDT][lg]); const float mag = expf(lam_re * dt), ang = lam_im * dt;
        const float are = mag * cosf(ang), aim = mag * sinf(ang); const float inv = 1.f / (lam_re * lam_re + lam_im * lam_im);
        const float cre = ((are - 1.f) * lam_re + aim * lam_im) * inv, cim = (aim * lam_re - (are - 1.f) * lam_im) * inv;
        ((float*)(ws + WS_S5AP))[idx * 2] = are; ((float*)(ws + WS_S5AP))[idx * 2 + 1] = aim;
        const float* br = a->in[I_S5BRE] + (size_t)idx * 16; const float* bi = a->in[I_S5BIM] + (size_t)idx * 16; bf16* o = (bf16*)(ws + WS_S5BB) + ((size_t)lg * 128 + 2 * p) * 16;
        for (int c = 0; c < 16; ++c) { o[c] = (bf16)f2bf(cre * br[c] - cim * bi[c]); o[16 + c] = (bf16)f2bf(cre * bi[c] + cim * br[c]); } }
    { bf16* CM = (bf16*)(ws + WS_S5CM);
      for (int idx = (vcu * NTHR + tid); idx < 2 * 16 * 16 * 128; idx += G * NTHR) { const int k = idx & 127, lgc = idx >> 7;
          CM[idx] = (bf16)f2bf((k & 1) ? -a->in[I_S5CIM][(size_t)lgc * 64 + (k >> 1)] : a->in[I_S5CRE][(size_t)lgc * 64 + (k >> 1)]); } }
    for (int it = gw; it < 2 * 16; it += NGW) { const int l = it >> 4, r = it & 15;
        transpose_item(a->in[I_S5GLUW] + (size_t)l * DC * DC, DC, DC, 64 * (r >> 2), 64 * (r & 3), (bf16*)(ws + WS_GLUT) + (size_t)l * DC * DC, DC, scr, lane, RmId{}); }
    { bf16* MLW = (bf16*)(ws + WS_MLW);
      for (int idx = (vcu * NTHR + tid); idx < 2 * NH * 2 * 4096; idx += G * NTHR) { const int d = idx & 63, e = (idx >> 6) & 63, which = (idx >> 12) & 1, lh = idx >> 13;
          MLW[idx] = (bf16)f2bf(a->in[which ? I_WK : I_WQ][(size_t)lh * 4096 + d * 64 + e]); } }
    __syncthreads();
    if (vcu < 192) {
        const int q = vcu, l = q / 96, cb = (q >> 3) % 12, kc = q & 7;
        LAS float* cond = (LAS float*)lds;
        { const int b = tid >> 7, kk = tid & 127; const float cv = a->in[I_C][b * DM + kc * 128 + kk]; cond[tid] = cv / (1.f + __expf(-cv)); }
        __syncthreads();
        const int col = cb * 512 + tid; const float* wp = a->in[I_ADA_W] + ((size_t)l * DM + kc * 128) * 6144 + col;
        float acc0 = 0.f, acc1 = 0.f, acc2 = 0.f, acc3 = 0.f;
#pragma unroll 8
        for (int kk = 0; kk < 128; ++kk) { const float w = wp[(size_t)kk * 6144]; acc0 += cond[kk] * w; acc1 += cond[128 + kk] * w; acc2 += cond[256 + kk] * w; acc3 += cond[384 + kk] * w; }
        const float bias = (kc == 0) ? a->in[I_ADA_B][l * 6144 + col] : 0.f;
        float* MP = (float*)(ws + WS_MODP) + ((size_t)(kc * 2 + l) * 4) * 6144 + col;
        MP[0] = acc0 + bias; MP[6144] = acc1 + bias; MP[2 * 6144] = acc2 + bias; MP[3 * 6144] = acc3 + bias;
    }
}

__device__ __forceinline__ float modval(const unsigned char* ws, bool part, int l, int b, int idx) {
    if (!part) return ((const float*)(ws + WS_MODF))[(size_t)(l * 4 + b) * 6144 + idx];
    const float* mp = (const float*)(ws + WS_MODP) + (size_t)(l * 4 + b) * 6144 + idx; float s = 0.f;
#pragma unroll
    for (int kc = 0; kc < 8; ++kc) s += mp[(size_t)kc * 2 * 4 * 6144];
    return s;
}
template <int MODE, bool COMBINE>
__device__ __forceinline__ void phase_rownorm(KArgsP a, LAS unsigned char* lds, int tid, int lane, int wave, int G,
                                              const float* xsrc, float* xdst, const float* gvec, bool part, int l, int isc  , int lprev) {
    unsigned char* ws = a->ws;
    LAS float* sc = (LAS float*)lds; LAS float* sh = sc + 1024; LAS float* gt = sh + 1024;
    bf16* HN = (bf16*)(ws + WS_HN); const bf16* YM = (const bf16*)(ws + WS_YMOE); const float* TW = (const float*)(ws + WS_TOKW);
    for (int c = blockIdx.x; c < NTOK / 128; c += G) {
        const int b = c >> 6;
        __syncthreads();
        for (int j = tid; j < 1024; j += NTHR) {
            if (MODE == 0) { sc[j] = gvec[j] * (1.f + modval(ws, part, l, b, (isc + 1) * 1024 + j)); sh[j] = modval(ws, part, l, b, isc * 1024 + j); }
            else { sc[j] = gvec[j]; sh[j] = 0.f; }
            if (COMBINE) gt[j] = 1.f + modval(ws, false, lprev, b, 5 * 1024 + j);
        }
        __syncthreads();
        f32x4 vn[4]; v2u yn0[4], yn1[4]; float wn0 = 0.f, wn1 = 0.f;
        { const int row = c * 128 + wave * 16; const GAS f32x4* xr = (const GAS f32x4*)(xsrc + (size_t)row * DM) + lane;
#pragma unroll
          for (int j = 0; j < 4; ++j) vn[j] = xr[64 * j];
          if (COMBINE) { wn0 = TW[2 * row]; wn1 = TW[2 * row + 1]; const GAS v2u* y0 = (const GAS v2u*)(YM + (size_t)(2 * row) * DM) + lane; const GAS v2u* y1 = (const GAS v2u*)(YM + (size_t)(2 * row + 1) * DM) + lane;
#pragma unroll
              for (int j = 0; j < 4; ++j) { yn0[j] = y0[64 * j]; yn1[j] = y1[64 * j]; } } }
        for (int i = 0; i < 16; ++i) {
            const int row = c * 128 + wave * 16 + i;
            f32x4 v[4]; v2u q0[4], q1[4]; const float w0 = wn0, w1 = wn1;
#pragma unroll
            for (int j = 0; j < 4; ++j) { v[j] = vn[j]; q0[j] = yn0[j]; q1[j] = yn1[j]; }
            if (i + 1 < 16) { const int rn = row + 1; const GAS f32x4* xr = (const GAS f32x4*)(xsrc + (size_t)rn * DM) + lane;
#pragma unroll
                for (int j = 0; j < 4; ++j) vn[j] = xr[64 * j];
                if (COMBINE) { wn0 = TW[2 * rn]; wn1 = TW[2 * rn + 1]; const GAS v2u* y0 = (const GAS v2u*)(YM + (size_t)(2 * rn) * DM) + lane; const GAS v2u* y1 = (const GAS v2u*)(YM + (size_t)(2 * rn + 1) * DM) + lane;
#pragma unroll
                    for (int j = 0; j < 4; ++j) { yn0[j] = y0[64 * j]; yn1[j] = y1[64 * j]; } } }
            if (COMBINE) {
#pragma unroll
                for (int j = 0; j < 4; ++j) { const v2u p0 = q0[j], p1 = q1[j]; const f32x4 g4 = *(const LAS f32x4*)(gt + lane * 4 + 256 * j);
                    f32x4 m; m.x = w0 * bflo(p0.x) + w1 * bflo(p1.x); m.y = w0 * bfhi(p0.x) + w1 * bfhi(p1.x); m.z = w0 * bflo(p0.y) + w1 * bflo(p1.y); m.w = w0 * bfhi(p0.y) + w1 * bfhi(p1.y);
                    v[j] = v[j] + g4 * m; }
                if (MODE == 0) { GAS f32x4* xo = (GAS f32x4*)(xdst + (size_t)row * DM) + lane;
#pragma unroll
                    for (int j = 0; j < 4; ++j) xo[64 * j] = v[j]; }
            }
            float ss = 0.f;
#pragma unroll
            for (int j = 0; j < 4; ++j) ss += (v[j].x * v[j].x + v[j].y * v[j].y) + (v[j].z * v[j].z + v[j].w * v[j].w);
            const float rstd = rsqrtf(wave_sum(ss) * (1.f / DM) + NORM_EPS);
            if (MODE == 0) {
                GAS v2u* o = (GAS v2u*)(HN + (size_t)row * DM) + lane;
#pragma unroll
                for (int j = 0; j < 4; ++j) { const f32x4 s4 = *(const LAS f32x4*)(sc + lane * 4 + 256 * j), h4 = *(const LAS f32x4*)(sh + lane * 4 + 256 * j); const f32x4 h = v[j] * rstd * s4 + h4;
                    v2u w; w.x = pk2(h.x, h.y); w.y = pk2(h.z, h.w); o[64 * j] = w; }
            } else {
                GAS f32x4* o = (GAS f32x4*)(xdst + (size_t)row * DM) + lane;
#pragma unroll
                for (int j = 0; j < 4; ++j) { const f32x4 s4 = *(const LAS f32x4*)(sc + lane * 4 + 256 * j); o[64 * j] = v[j] * rstd * s4; }
            }
        }
    }
}
__device__ __forceinline__ void mod_finalize(unsigned char* ws, int tid, int G) {
    float* MF = (float*)(ws + WS_MODF);
    for (int idx = blockIdx.x * NTHR + tid; idx < 2 * 4 * 6144; idx += G * NTHR) { const float* mp = (const float*)(ws + WS_MODP) + idx; float s = 0.f;
#pragma unroll
        for (int kc = 0; kc < 8; ++kc) s += mp[(size_t)kc * 2 * 4 * 6144];
        MF[idx] = s; }
}

typedef float f32x4m __attribute__((ext_vector_type(4)));
__device__ __forceinline__ void phase_router(KArgsP a, LAS unsigned char* lds, int tid, int lane, int wave, int G, int l) {
    unsigned char* ws = a->ws;
    LAS float* sc = (LAS float*)lds; LAS float* sh = sc + 1024; LAS float* rstd_s = sh + 1024  ; LAS float* cvec = rstd_s + 128  ; LAS float* cpart = cvec + 64  ;
    LAS float* lg = cpart + 8 * 48  ; LAS int* hist = (LAS int*)(lg + 8 * 16 * 48)  ; LAS int* basev = hist + 32; LAS int* asg_e = basev + 32  ; LAS int* asg_lp = asg_e + 256;
    bf16* HN = (bf16*)(ws + WS_HN); const float* x = a->out; const float* RTW = (const float*)(ws + WS_RTW) + (size_t)l * 1024 * 48;
    int* TOKE = (int*)(ws + WS_TOKE); float* TOKW = (float*)(ws + WS_TOKW); int* LIST = (int*)(ws + WS_LIST); unsigned* CNT = (unsigned*)(ws + WS_CTL) + CW_CNT + l * 32;
    const float* gvec = a->in[I_NORM_FFN] + l * DM;
    for (int c = blockIdx.x; c < NTOK / 128; c += G) {
        const int b = c >> 6;
        __syncthreads();
        for (int j = tid; j < 1024; j += NTHR) { sc[j] = gvec[j] * (1.f + modval(ws, false, l, b, 4 * 1024 + j)); sh[j] = modval(ws, false, l, b, 3 * 1024 + j); }
        if (tid < 32) hist[tid] = 0;
        __syncthreads();
        if (tid < 128) { const int i16 = tid & 15, part = tid >> 4; float s0 = 0.f, s1 = 0.f, s2 = 0.f;
#pragma unroll 1
            for (int kg = part * 32; kg < part * 32 + 32; kg += 4) { f32x4 w[4][3];
#pragma unroll
                for (int q = 0; q < 4; ++q) { const GAS f32x4* wp = (const GAS f32x4*)(RTW + (size_t)((kg + q) * 16 + i16) * 12); w[q][0] = wp[0]; w[q][1] = wp[1]; w[q][2] = wp[2]; }
#pragma unroll
                for (int q = 0; q < 4; ++q) { const f32x4 h = *(const LAS f32x4*)(sh + 4 * (kg + q));
                    const float wf[12] = {w[q][0][0], w[q][0][1], w[q][0][2], w[q][0][3], w[q][1][0], w[q][1][1], w[q][1][2], w[q][1][3], w[q][2][0], w[q][2][1], w[q][2][2], w[q][2][3]};
#pragma unroll
                    for (int jj = 0; jj < 4; ++jj) { s0 = fmaf(h[jj], wf[3 * jj], s0); s1 = fmaf(h[jj], wf[3 * jj + 1], s1); s2 = fmaf(h[jj], wf[3 * jj + 2], s2); } } }
            cpart[part * 48 + i16] = s0; cpart[part * 48 + 16 + i16] = s1; cpart[part * 48 + 32 + i16] = s2; }
        { f32x4 vn[4];
          { const GAS f32x4* xr = (const GAS f32x4*)(x + (size_t)(c * 128 + wave * 16) * DM) + lane;
#pragma unroll
            for (int j = 0; j < 4; ++j) vn[j] = xr[64 * j]; }
          for (int i = 0; i < 16; ++i) {
            const int row = c * 128 + wave * 16 + i;
            f32x4 v[4]; float ss = 0.f;
#pragma unroll
            for (int j = 0; j < 4; ++j) { v[j] = vn[j]; ss += (v[j].x * v[j].x + v[j].y * v[j].y) + (v[j].z * v[j].z + v[j].w * v[j].w); }
            if (i + 1 < 16) { const GAS f32x4* xr = (const GAS f32x4*)(x + (size_t)(row + 1) * DM) + lane;
#pragma unroll
                for (int j = 0; j < 4; ++j) vn[j] = xr[64 * j]; }
            const float rstd = rsqrtf(wave_sum(ss) * (1.f / DM) + NORM_EPS);
            if (lane == 0) rstd_s[wave * 16 + i] = rstd;
            GAS v2u* o = (GAS v2u*)(HN + (size_t)row * DM) + lane;
#pragma unroll
            for (int j = 0; j < 4; ++j) { const f32x4 s4 = *(const LAS f32x4*)(sc + lane * 4 + 256 * j), h4 = *(const LAS f32x4*)(sh + lane * 4 + 256 * j); const f32x4 h = v[j] * rstd * s4 + h4;
                v2u w; w.x = pk2(h.x, h.y); w.y = pk2(h.z, h.w); o[64 * j] = w; }
          } }
        __syncthreads();
        if (tid < 48) { float s = 0.f;
#pragma unroll
            for (int p = 0; p < 8; ++p) s += cpart[p * 48 + tid];
            s += tid < 4 ? a->in[I_MBRG][l * 4 + tid] : (tid < 36 ? a->in[I_MBRE][l * 32 + tid - 4] : 0.f); cvec[tid] = s; }
        {
            const int i16 = lane & 15, kq = lane >> 4, r0 = c * 128 + wave * 16;
            f32x4m acc0 = {0.f, 0.f, 0.f, 0.f}, acc1 = acc0, acc2 = acc0;
            const float* xrow = x + (size_t)(r0 + i16) * DM + 4 * kq;
            constexpr int PD = 4;
            const float* wbase = RTW + (size_t)(kq * 16 + i16) * 12;
            f32x4 xq[PD], wq[PD][3];
#pragma unroll
            for (int s = 0; s < PD; ++s) { xq[s] = *(const GAS f32x4*)(xrow + 16 * s); const GAS f32x4* wp = (const GAS f32x4*)(wbase + (size_t)(4 * s) * 16 * 12); wq[s][0] = wp[0]; wq[s][1] = wp[1]; wq[s][2] = wp[2]; }
#pragma unroll 1
            for (int k0 = 0; k0 < DM; k0 += 16 * PD) {
#pragma unroll
                for (int s = 0; s < PD; ++s) {
                    const f32x4 xv = xq[s], w0 = wq[s][0], w1 = wq[s][1], w2 = wq[s][2];
                    { const int kn = min(k0 + 16 * (s + PD), DM - 16); xq[s] = *(const GAS f32x4*)(xrow + kn); const GAS f32x4* wp = (const GAS f32x4*)(wbase + (size_t)(kn >> 2) * 16 * 12); wq[s][0] = wp[0]; wq[s][1] = wp[1]; wq[s][2] = wp[2]; }
                    __builtin_amdgcn_sched_barrier(0);
                    const f32x4 sv = *(const LAS f32x4*)(sc + k0 + 16 * s + 4 * kq);
                    const float wf[12] = {w0[0], w0[1], w0[2], w0[3], w1[0], w1[1], w1[2], w1[3], w2[0], w2[1], w2[2], w2[3]};
#pragma unroll
                    for (int j = 0; j < 4; ++j) { const float av = xv[j] * sv[j];
                        acc0 = __builtin_amdgcn_mfma_f32_16x16x4f32(av, wf[j * 3], acc0, 0, 0, 0);
                        acc1 = __builtin_amdgcn_mfma_f32_16x16x4f32(av, wf[j * 3 + 1], acc1, 0, 0, 0);
                        acc2 = __builtin_amdgcn_mfma_f32_16x16x4f32(av, wf[j * 3 + 2], acc2, 0, 0, 0); }
                }
            }
            __syncthreads();
            LAS float* lw = lg + wave * 16 * 48;
#pragma unroll
            for (int r = 0; r < 4; ++r) { const int rr = 4 * kq + r; const float rs = rstd_s[wave * 16 + rr];
                lw[rr * 48 + i16] = acc0[r] * rs + cvec[i16]; lw[rr * 48 + 16 + i16] = acc1[r] * rs + cvec[16 + i16]; lw[rr * 48 + 32 + i16] = acc2[r] * rs + cvec[32 + i16]; }
            LDS_WAIT(); asm volatile("" ::: "memory");
            if (lane < 16) {
                const LAS float* lr = lw + lane * 48; const int row = r0 + lane;
                float g0 = lr[0], g1 = lr[1], g2 = lr[2], g3 = lr[3]; const float gm = fmaxf(fmaxf(g0, g1), fmaxf(g2, g3));
                float p0 = __expf(g0 - gm), p1 = __expf(g1 - gm), p2 = __expf(g2 - gm), p3 = __expf(g3 - gm); const float inv = 1.f / (p0 + p1 + p2 + p3);
                p0 *= inv; p1 *= inv; p2 *= inv; p3 *= inv;
                int gi = 0; float gp = p0; if (p1 > gp) { gp = p1; gi = 1; } if (p2 > gp) { gp = p2; gi = 2; } if (p3 > gp) { gp = p3; gi = 3; }
                float ev0 = -3.4e38f, ev1 = -3.4e38f; int e0 = 0, e1 = 0;
#pragma unroll
                for (int j = 0; j < 8; ++j) { const float s = lr[4 + gi * 8 + j]; if (s > ev0) { ev1 = ev0; e1 = e0; ev0 = s; e0 = j; } else if (s > ev1) { ev1 = s; e1 = j; } }
                const float q = __expf(ev1 - ev0), w0 = gp / (1.f + q), w1 = gp * q / (1.f + q);
                e0 += gi * 8; e1 += gi * 8;
                TOKE[2 * row] = e0; TOKE[2 * row + 1] = e1; TOKW[2 * row] = w0; TOKW[2 * row + 1] = w1;
                const int a0 = 2 * (wave * 16 + lane);
                asg_e[a0] = e0; asg_e[a0 + 1] = e1; asg_lp[a0] = atomicAdd((int*)&hist[e0], 1); asg_lp[a0 + 1] = atomicAdd((int*)&hist[e1], 1);
            }
        }
        __syncthreads();
        if (tid < 32) { const int h = hist[tid]; basev[tid] = h ? (int)atomicAdd(CNT + tid, (unsigned)h) : 0; }
        __syncthreads();
        if (tid < 256) { const int e = asg_e[tid]; LIST[(size_t)e * 65536 + basev[e] + asg_lp[tid]] = (c * 128) * 2 + tid; }
    }
}
__device__ __forceinline__ void build_ptab(const unsigned* CNT, LAS int* ptab, LAS int* pst, LAS int* cnt, int tid) {
    __syncthreads();
    if (tid < NEXP) {
        const int ce = (int)__hip_atomic_load(CNT + tid, RLX_AGENT); cnt[tid] = ce; const int pe = (ce + 255) >> 8;
        int incl = pe;
#pragma unroll
        for (int d = 1; d < NEXP; d <<= 1) { const int t = __shfl_up(incl, d, 64); if (tid >= d) incl += t; }
        const int start = incl - pe; pst[tid] = start * 256;
        for (int p = 0; p < pe; ++p) ptab[1 + start + p] = tid;
        if (tid == NEXP - 1) ptab[0] = incl; }
    __syncthreads();
}
__device__ __forceinline__ void phase_gather(KArgsP a, LAS unsigned char* lds, int tid, int lane, int wave, int vcu, int G, int l) {
    unsigned char* ws = a->ws;
    LAS int* ptab = (LAS int*)lds; LAS int* pst = ptab + 512; LAS int* cnt = pst + 32;
    build_ptab((const unsigned*)(ws + WS_CTL) + CW_CNT + l * 32, ptab, pst, cnt, tid);
    const bf16* HN = (const bf16*)(ws + WS_HN); bf16* XG = (bf16*)(ws + WS_XG); int* ROWMAP = (int*)(ws + WS_ROWMAP); const int* LIST = (const int*)(ws + WS_LIST);
    const int nrows = ptab[0] * 256;
    for (int row0 = (vcu * NWAVES + wave) * 8; row0 < nrows; row0 += G * NWAVES * 8) {
        int tok2[8]; v4u p0[8], p1[8];
#pragma unroll
        for (int j = 0; j < 8; ++j) { const int row = row0 + j, e = ptab[1 + (row >> 8)], pos = row - pst[e]; tok2[j] = (pos < cnt[e]) ? LIST[(size_t)e * 65536 + pos] : -1; }
#pragma unroll
        for (int j = 0; j < 8; ++j) { if (tok2[j] >= 0) { const GAS v4u* s = (const GAS v4u*)(HN + (size_t)(tok2[j] >> 1) * DM) + lane; p0[j] = s[0]; p1[j] = s[64]; } else { p0[j] = (v4u){0u, 0u, 0u, 0u}; p1[j] = p0[j]; } }
#pragma unroll
        for (int j = 0; j < 8; ++j) { GAS v4u* d = (GAS v4u*)(XG + (size_t)(row0 + j) * DM) + lane; d[0] = p0[j]; d[64] = p1[j]; if (lane == 0) ROWMAP[row0 + j] = tok2[j]; }
    }
}

__device__ __forceinline__ void phase_rowmap(KArgsP a, LAS unsigned char* lds, int tid, int vcu, int G, int l) {
    unsigned char* ws = a->ws;
    LAS int* ptab = (LAS int*)lds; LAS int* pst = ptab + 512; LAS int* cnt = pst + 32;
    build_ptab((const unsigned*)(ws + WS_CTL) + CW_CNT + l * 32, ptab, pst, cnt, tid);
    int* ROWMAP = (int*)(ws + WS_ROWMAP); const int* LIST = (const int*)(ws + WS_LIST);
    const int nrows = ptab[0] * 256;
    for (int row = vcu * NTHR + tid; row < nrows; row += G * NTHR) { const int e = ptab[1 + (row >> 8)], pos = row - pst[e]; ROWMAP[row] = (pos < cnt[e]) ? LIST[(size_t)e * 65536 + pos] : -1; }
}

typedef short bf16x8 __attribute__((ext_vector_type(8)));
constexpr int MT = 72;
constexpr int ML_XP = 0;
constexpr int ML_CX = 17152;
constexpr int ML_WQ = ML_CX + 9216, ML_WK = ML_WQ + 9216;
constexpr int ML_Q = ML_WK + 9216, ML_K = ML_Q + 9216;
constexpr int ML_S = ML_K + 9216;
constexpr int ML_VT = ML_S + 9216;
constexpr int ML_CT = ML_VT + 11520;
constexpr int ML_H = ML_CT + 11520;
constexpr int ML_SM = ML_H + 16640;
static_assert(ML_SM + 2048 <= RING_BYTES, "mLSTM LDS map");
__device__ __forceinline__ float logsigmoidf_(float x) { return fminf(x, 0.f) - log1pf(__expf(-fabsf(x))); }
__device__ __forceinline__ void mma64(const LAS bf16* A, int arow0, const LAS bf16* Bt, int brow0, int lane, f32x4& acc) {
    const LAS bf16* ap = A + (arow0 + (lane & 15)) * MT + 8 * (lane >> 4); const LAS bf16* bp = Bt + (brow0 + (lane & 15)) * MT + 8 * (lane >> 4);
    const bf16x8 a0 = *(const LAS bf16x8*)ap, a1 = *(const LAS bf16x8*)(ap + 32), b0 = *(const LAS bf16x8*)bp, b1 = *(const LAS bf16x8*)(bp + 32);
    acc = __builtin_amdgcn_mfma_f32_16x16x32_bf16(a0, b0, acc, 0, 0, 0); acc = __builtin_amdgcn_mfma_f32_16x16x32_bf16(a1, b1, acc, 0, 0, 0);
}
__device__ __forceinline__ void ml_front(KArgsP a, LAS unsigned char* lds, int tid, int l, int b, int c, int h, bool want_q) {
    const bf16* PROJ = (const bf16*)(a->ws + WS_PROJ); const size_t row0 = (size_t)b * SEQ + c * 64;
    LAS float* xp = (LAS float*)(lds + ML_XP);
    for (int idx = tid; idx < 67 * 8; idx += NTHR) { const int r = idx >> 3, c8 = idx & 7, tr = c * 64 + r - 3; LAS float* d = xp + r * 64 + c8 * 8;
        if (tr >= 0) { const v4u p = *(const GAS v4u*)(PROJ + ((size_t)b * SEQ + tr) * NPROJ + PC_QK + h * 64 + c8 * 8);
            *(LAS f32x4*)d = (f32x4){bflo(p.x), bfhi(p.x), bflo(p.y), bfhi(p.y)}; *(LAS f32x4*)(d + 4) = (f32x4){bflo(p.z), bfhi(p.z), bflo(p.w), bfhi(p.w)}; }
        else { *(LAS f32x4*)d = (f32x4){0.f, 0.f, 0.f, 0.f}; *(LAS f32x4*)(d + 4) = (f32x4){0.f, 0.f, 0.f, 0.f}; } }
    {
        const int t = tid >> 3, vg = tid & 7; LAS bf16* VT = (LAS bf16*)(lds + ML_VT);
        const v4u p = *(const GAS v4u*)(PROJ + (row0 + t) * NPROJ + PC_V + h * 64 + vg * 8);
        const unsigned w[4] = {p.x, p.y, p.z, p.w};
#pragma unroll
        for (int j = 0; j < 4; ++j) { VT[(vg * 8 + 2 * j) * MT + t] = (bf16)(w[j] & 0xffffu); VT[(vg * 8 + 2 * j + 1) * MT + t] = (bf16)(w[j] >> 16); }
        for (int idx = tid; idx < 16 * 64; idx += NTHR) VT[(64 + (idx >> 6)) * MT + (idx & 63)] = (idx < 64) ? (bf16)0x3F80 : (bf16)0;
        const bf16* WT = (const bf16*)(a->ws + WS_MLW) + (size_t)((l * NH + h) * 2) * 4096;
        const int e = tid >> 3, d8 = tid & 7;
        if (want_q) *(LAS v4u*)(lds + ML_WQ + (e * MT + d8 * 8) * 2) = *(const GAS v4u*)(WT + e * 64 + d8 * 8);
        *(LAS v4u*)(lds + ML_WK + (e * MT + d8 * 8) * 2) = *(const GAS v4u*)(WT + 4096 + e * 64 + d8 * 8);
    }
    __syncthreads();
    const float* cw = a->in[I_CONV_W] + (size_t)l * 4 * DA + h * 64; const float* cb = a->in[I_CONV_B] + (size_t)l * DA + h * 64;
    {
        const int t = tid >> 3, c8 = (tid & 7) * 8; float s[8];
#pragma unroll
        for (int j = 0; j < 8; ++j) s[j] = cb[c8 + j];
#pragma unroll
        for (int q = 0; q < 4; ++q) { const f32x4 x0 = *(const LAS f32x4*)(xp + (t + q) * 64 + c8), x1 = *(const LAS f32x4*)(xp + (t + q) * 64 + c8 + 4); const float* w = cw + q * DA + c8;
            s[0] += x0.x * w[0]; s[1] += x0.y * w[1]; s[2] += x0.z * w[2]; s[3] += x0.w * w[3]; s[4] += x1.x * w[4]; s[5] += x1.y * w[5]; s[6] += x1.z * w[6]; s[7] += x1.w * w[7]; }
#pragma unroll
        for (int j = 0; j < 8; ++j) s[j] = s[j] / (1.f + __expf(-s[j]));
        v4u o; o.x = pk2(s[0], s[1]); o.y = pk2(s[2], s[3]); o.z = pk2(s[4], s[5]); o.w = pk2(s[6], s[7]);
        *(LAS v4u*)(lds + ML_CX + (t * MT + c8) * 2) = o;
    }
}
__device__ __forceinline__ void phase_m1(KArgsP a, LAS unsigned char* lds, int tid, int lane, int wave, int vcu, int G, int l) {
    unsigned char* ws = a->ws; const float* GT = (const float*)(ws + WS_GATES);
    float* CLOC = (float*)(ws + WS_CLOC); float* MLG = (float*)(ws + WS_MSC); float* MLM = MLG + 4096;
    LAS float* sm = (LAS float*)(lds + ML_SM);
    for (int u = vcu; u < NUNIT_M; u += G) {
        const int h = u % NH, c = (u / NH) % NCH, b = u / (NH * NCH); const size_t row0 = (size_t)b * SEQ + c * 64;
        __syncthreads();
        ml_front(a, lds, tid, l, b, c, h, false);
        if (wave == 0) {
            const float ig = GT[(row0 + lane) * 16 + h] + a->in[I_BI][l * NH + h];
            const float fl = logsigmoidf_(GT[(row0 + lane) * 16 + 6 + h] + a->in[I_BF][l * NH + h]);
            float bc = fl;
#pragma unroll
            for (int o = 1; o < 64; o <<= 1) { const float t = __shfl_up(bc, o); if (lane >= o) bc += t; }
            const float gtot = __shfl(bc, 63); const float lw = gtot - bc + ig; const float ml = wave_max(lw);
            sm[lane] = __expf(lw - ml);
            if (lane == 0) { MLG[u] = gtot; MLM[u] = ml; }
        }
        __syncthreads();
        {
            const int rt = wave >> 1; LAS bf16* KT = (LAS bf16*)(lds + ML_K);
#pragma unroll
            for (int q = 0; q < 2; ++q) { const int ct = 2 * (wave & 1) + q; f32x4 acc = {0.f, 0.f, 0.f, 0.f};
                mma64((const LAS bf16*)(lds + ML_CX), 16 * rt, (const LAS bf16*)(lds + ML_WK), 16 * ct, lane, acc);
                const int t0 = 16 * rt + 4 * (lane >> 4), e = 16 * ct + (lane & 15);
                const float w0 = sm[t0] * 0.125f, w1 = sm[t0 + 1] * 0.125f, w2 = sm[t0 + 2] * 0.125f, w3 = sm[t0 + 3] * 0.125f;
                v2u o; o.x = pk2(acc[0] * w0, acc[1] * w1); o.y = pk2(acc[2] * w2, acc[3] * w3);
                *(LAS v2u*)(KT + e * MT + t0) = o; }
        }
        __syncthreads();
        {
            const int ct = wave & 3, r_lo = wave < 4 ? 0 : 3, r_hi = wave < 4 ? 3 : 5; float* cl = CLOC + (size_t)u * CL_STRIDE;
            for (int rt = r_lo; rt < r_hi; ++rt) { f32x4 acc = {0.f, 0.f, 0.f, 0.f};
                mma64((const LAS bf16*)(lds + ML_VT), 16 * rt, (const LAS bf16*)(lds + ML_K), 16 * ct, lane, acc);
                const int v0 = 16 * rt + 4 * (lane >> 4), e = 16 * ct + (lane & 15);
                if (rt < 4) {
#pragma unroll
                    for (int r = 0; r < 4; ++r) cl[(v0 + r) * 64 + e] = acc[r];
                } else if ((lane >> 4) == 0) cl[4096 + e] = acc[0]; }
        }
    }
}
__device__ __forceinline__ void phase_m2(unsigned char* ws, int tid, int wg, int nwg) {
    float* CLOC = (float*)(ws + WS_CLOC); const float* MLG = (const float*)(ws + WS_MSC); const float* MLM = MLG + 4096; float* MST = (float*)(ws + WS_MSC) + 8192;
    for (int idx = wg * NTHR + tid; idx < NB * NH * CL_STRIDE; idx += nwg * NTHR) {
        const int e = idx % CL_STRIDE, bh = idx / CL_STRIDE, b = bh / NH, h = bh % NH;
        float m = 0.f, cs = 0.f;
        float cn[8], gn[8], mn8[8];
#pragma unroll
        for (int j = 0; j < 8; ++j) { const int u = (b * NCH + j) * NH + h; cn[j] = CLOC[(size_t)u * CL_STRIDE + e]; gn[j] = MLG[u]; mn8[j] = MLM[u]; }
        for (int c0 = 0; c0 < NCH; c0 += 8) {
            float cl[8], g[8], ml[8];
#pragma unroll
            for (int j = 0; j < 8; ++j) { cl[j] = cn[j]; g[j] = gn[j]; ml[j] = mn8[j]; }
            { const int cq = min(c0 + 8, NCH - 8);
#pragma unroll
              for (int j = 0; j < 8; ++j) { const int u = (b * NCH + cq + j) * NH + h; cn[j] = CLOC[(size_t)u * CL_STRIDE + e]; gn[j] = MLG[u]; mn8[j] = MLM[u]; } }
#pragma unroll
            for (int j = 0; j < 8; ++j) { const int u = (b * NCH + c0 + j) * NH + h;
                CLOC[(size_t)u * CL_STRIDE + e] = cs; if (e == 0) MST[u] = m;
                const float mn = fmaxf(g[j] + m, ml[j]); const float ao = __expf(g[j] + m - mn), al = __expf(ml[j] - mn);
                cs = ao * cs + al * cl[j]; m = mn; }
        }
    }
}
__device__ __forceinline__ void phase_m3(KArgsP a, LAS unsigned char* lds, int tid, int lane, int wave, int vcu, int G, int l) {
    unsigned char* ws = a->ws; const bf16* PROJ = (const bf16*)(ws + WS_PROJ); const float* GT = (const float*)(ws + WS_GATES);
    const float* CLOC = (const float*)(ws + WS_CLOC); const float* MST = (const float*)(ws + WS_MSC) + 8192; bf16* YC = (bf16*)(ws + WS_YC);
    LAS float* sm = (LAS float*)(lds + ML_SM); LAS float* hb = (LAS float*)(lds + ML_H);
    for (int u = vcu; u < NUNIT_M; u += G) {
        const int h = u % NH, c = (u / NH) % NCH, b = u / (NH * NCH); const size_t row0 = (size_t)b * SEQ + c * 64;
        __syncthreads();
        ml_front(a, lds, tid, l, b, c, h, true);
        {
            const float* cl = CLOC + (size_t)u * CL_STRIDE; LAS bf16* CT = (LAS bf16*)(lds + ML_CT);
            for (int idx = tid; idx < 65 * 16; idx += NTHR) { const int r = idx >> 4, c4 = idx & 15; const f32x4 v = *(const GAS f32x4*)(cl + r * 64 + c4 * 4);
                v2u o; o.x = pk2(v.x, v.y); o.y = pk2(v.z, v.w); *(LAS v2u*)(CT + r * MT + c4 * 4) = o; }
            for (int idx = tid; idx < 15 * 64; idx += NTHR) CT[(65 + (idx >> 6)) * MT + (idx & 63)] = 0;
        }
        if (wave == 0) {
            const float ig = GT[(row0 + lane) * 16 + h] + a->in[I_BI][l * NH + h];
            const float fl = logsigmoidf_(GT[(row0 + lane) * 16 + 6 + h] + a->in[I_BF][l * NH + h]);
            float bc = fl;
#pragma unroll
            for (int o = 1; o < 64; o <<= 1) { const float t = __shfl_up(bc, o); if (lane >= o) bc += t; }
            float pm = ig - bc;
#pragma unroll
            for (int o = 1; o < 64; o <<= 1) { const float t = __shfl_up(pm, o); if (lane >= o) pm = fmaxf(pm, t); }
            const float mst = MST[u]; const float inter = bc + mst, mt = fmaxf(inter, bc + pm);
            sm[lane] = ig - bc; sm[64 + lane] = bc - mt; sm[128 + lane] = __expf(inter - mt); sm[192 + lane] = __expf(-mt);
        }
        __syncthreads();
        {
            const int rt = wave >> 1; LAS bf16* Qs = (LAS bf16*)(lds + ML_Q); LAS bf16* Ks = (LAS bf16*)(lds + ML_K);
#pragma unroll
            for (int q = 0; q < 2; ++q) { const int ct = 2 * (wave & 1) + q; f32x4 aq = {0.f, 0.f, 0.f, 0.f}, ak = {0.f, 0.f, 0.f, 0.f};
                mma64((const LAS bf16*)(lds + ML_CX), 16 * rt, (const LAS bf16*)(lds + ML_WQ), 16 * ct, lane, aq);
                mma64((const LAS bf16*)(lds + ML_CX), 16 * rt, (const LAS bf16*)(lds + ML_WK), 16 * ct, lane, ak);
                const int t0 = 16 * rt + 4 * (lane >> 4), e = 16 * ct + (lane & 15);
#pragma unroll
                for (int r = 0; r < 4; ++r) { Qs[(t0 + r) * MT + e] = (bf16)f2bf(aq[r]); Ks[(t0 + r) * MT + e] = (bf16)f2bf(ak[r] * 0.125f); } }
        }
        __syncthreads();
        {
            const int rt = wave >> 1; LAS bf16* Ss = (LAS bf16*)(lds + ML_S);
#pragma unroll
            for (int q = 0; q < 2; ++q) { const int ct = 2 * (wave & 1) + q; f32x4 acc = {0.f, 0.f, 0.f, 0.f};
                if (ct <= rt) mma64((const LAS bf16*)(lds + ML_Q), 16 * rt, (const LAS bf16*)(lds + ML_K), 16 * ct, lane, acc);
                const int t0 = 16 * rt + 4 * (lane >> 4), s = 16 * ct + (lane & 15); const float qs = sm[s];
#pragma unroll
                for (int r = 0; r < 4; ++r) { const int t = t0 + r; Ss[t * MT + s] = (bf16)f2bf((s <= t) ? acc[r] * __expf(sm[64 + t] + qs) : 0.f); } }
        }
        __syncthreads();
        {
            const int rt = wave >> 1, nt = (wave & 1) ? 2 : 3;
            for (int q = 0; q < nt; ++q) { const int ct = (wave & 1) ? 2 + q : (q < 2 ? q : 4); f32x4 aA = {0.f, 0.f, 0.f, 0.f}, aB = {0.f, 0.f, 0.f, 0.f};
                mma64((const LAS bf16*)(lds + ML_Q), 16 * rt, (const LAS bf16*)(lds + ML_CT), 16 * ct, lane, aA);
                mma64((const LAS bf16*)(lds + ML_S), 16 * rt, (const LAS bf16*)(lds + ML_VT), 16 * ct, lane, aB);
                const int t0 = 16 * rt + 4 * (lane >> 4), v = 16 * ct + (lane & 15);
#pragma unroll
                for (int r = 0; r < 4; ++r) { const int t = t0 + r; const float x = sm[128 + t] * aA[r] + aB[r];
                    if (ct < 4) hb[t * 65 + v] = x; else if ((lane & 15) == 0) sm[256 + t] = x; } }
        }
        __syncthreads();
        {
            const int t = tid >> 3, vg = tid & 7; float acc[8];
            const float dn = 1.f / fmaxf(fabsf(sm[256 + t]), sm[192 + t]);
            float s1 = 0.f;
#pragma unroll
            for (int j = 0; j < 8; ++j) { acc[j] = hb[t * 65 + vg * 8 + j] * dn; s1 += acc[j]; }
            s1 += __shfl_xor(s1, 1); s1 += __shfl_xor(s1, 2); s1 += __shfl_xor(s1, 4);
            const float mu = s1 * (1.f / 64.f); float s2 = 0.f;
#pragma unroll
            for (int j = 0; j < 8; ++j) { acc[j] -= mu; s2 += acc[j] * acc[j]; }
            s2 += __shfl_xor(s2, 1); s2 += __shfl_xor(s2, 2); s2 += __shfl_xor(s2, 4);
            const float rs = rsqrtf(s2 * (1.f / 64.f) + HEAD_NORM_EPS);
            const float* nw = a->in[I_MNORM_W] + (size_t)l * DA + h * 64 + vg * 8;
            const v4u ov = *(const GAS v4u*)(PROJ + (row0 + t) * NPROJ + PC_O + h * 64 + vg * 8);
            const float o[8] = {bflo(ov.x), bfhi(ov.x), bflo(ov.y), bfhi(ov.y), bflo(ov.z), bfhi(ov.z), bflo(ov.w), bfhi(ov.w)};
            float r[8];
#pragma unroll
            for (int j = 0; j < 8; ++j) r[j] = acc[j] * rs * nw[j] * sigmoidf_(o[j]);
            v4u w; w.x = pk2(r[0], r[1]); w.y = pk2(r[2], r[3]); w.z = pk2(r[4], r[5]); w.w = pk2(r[6], r[7]);
            *(GAS v4u*)(YC + (row0 + t) * DM + h * 64 + vg * 8) = w;
        }
    }
}

constexpr int S5_UT = 264, S5_XT = 2056;
constexpr int S5_U = 0, S5_Z = 33792, S5_X = 67584;
static_assert(S5_X + 16 * S5_XT * 2 <= MISC_OFF, "S5 LDS map");
struct S5A { float are, aim, cre, cim; };
__device__ __forceinline__ S5A s5_a(KArgsP a, int l, int g, int p) {
    const float lam_re = a->in[I_S5ARE][(size_t)(l * 16 + g) * 64 + p], lam_im = a->in[I_S5AIM][(size_t)(l * 16 + g) * 64 + p];
    const float dt = expf(a->in[I_S5LDT][l * 16 + g]); const float mag = expf(lam_re * dt), ang = lam_im * dt;
    S5A r; r.are = mag * cosf(ang); r.aim = mag * sinf(ang);
    const float inv = 1.f / (lam_re * lam_re + lam_im * lam_im);
    r.cre = ((r.are - 1.f) * lam_re + r.aim * lam_im) * inv; r.cim = (r.aim * lam_re - (r.are - 1.f) * lam_im) * inv; return r;
}
__device__ __forceinline__ bf16x8 pack8(const float* v) { v4u o; o.x = pk2(v[0], v[1]); o.y = pk2(v[2], v[3]); o.z = pk2(v[4], v[5]); o.w = pk2(v[6], v[7]); return __builtin_bit_cast(bf16x8, o); }
__device__ __forceinline__ void s5_bfrag(const unsigned char* ws, int l, int g, int lane, bf16x8 (&bf)[8]) {
    const bf16* BB = (const bf16*)(ws + WS_S5BB) + (size_t)(l * 16 + g) * 128 * 16;
#pragma unroll
    for (int j = 0; j < 8; ++j) { v4u o = {0u, 0u, 0u, 0u}; if ((lane >> 4) < 2) o = *(const GAS v4u*)(BB + (16 * j + (lane & 15)) * 16 + 8 * (lane >> 4)); bf[j] = __builtin_bit_cast(bf16x8, o); }
}
__device__ __forceinline__ f32x2 s5_ap(const unsigned char* ws, int l, int g, int p) { return *(const GAS f32x2*)((const float*)(ws + WS_S5AP) + ((size_t)(l * 16 + g) * 64 + p) * 2); }
__device__ __forceinline__ void s5_load_u(const unsigned char* ws, LAS unsigned char* lds, int tid, size_t row0) {
    const bf16* PROJ = (const bf16*)(ws + WS_PROJ);
    for (int idx = tid; idx < 64 * 32; idx += NTHR) { const int t = idx >> 5, c8 = idx & 31;
        *(LAS v4u*)(lds + S5_U + (t * S5_UT + c8 * 8) * 2) = *(const GAS v4u*)(PROJ + (row0 + t) * NPROJ + PC_S5 + c8 * 8); }
}
__device__ __forceinline__ void s5_block(LAS unsigned char* lds, int lane, int tb, int g, const bf16x8 (&bf)[8], float are, float aim, float& xr, float& xi) {
    const int kq = lane >> 4; bf16x8 uf = {0, 0, 0, 0, 0, 0, 0, 0};
    if (kq < 2) uf = *(const LAS bf16x8*)(lds + S5_U + ((16 * tb + (lane & 15)) * S5_UT + g * 16 + 8 * kq) * 2);
    LAS bf16* X = (LAS bf16*)(lds + S5_X);
#pragma unroll
    for (int j = 0; j < 8; ++j) { f32x4 acc = {0.f, 0.f, 0.f, 0.f}; acc = __builtin_amdgcn_mfma_f32_16x16x32_bf16(bf[j], uf, acc, 0, 0, 0);
        v2u o; o.x = pk2(acc[0], acc[1]); o.y = pk2(acc[2], acc[3]); *(LAS v2u*)(X + (lane & 15) * S5_XT + g * 128 + 16 * j + 4 * kq) = o; }
    LDS_WAIT(); asm volatile("" ::: "memory");
    LAS unsigned* xw = (LAS unsigned*)(lds + S5_X) + (g * 128 + 2 * lane) / 2;
    unsigned wv[16];
#pragma unroll
    for (int t = 0; t < 16; ++t) wv[t] = xw[t * (S5_XT / 2)];
#pragma unroll
    for (int t = 0; t < 16; ++t) { const float br = bflo(wv[t]), bi = bfhi(wv[t]);
        const float nr = are * xr - aim * xi + br, ni = are * xi + aim * xr + bi; xr = nr; xi = ni;
        wv[t] = pk2(xr, xi); }
#pragma unroll
    for (int t = 0; t < 16; ++t) xw[t * (S5_XT / 2)] = wv[t];
    LDS_WAIT(); asm volatile("" ::: "memory");
}
__device__ __forceinline__ void phase_s1(KArgsP a, LAS unsigned char* lds, int tid, int lane, int wave, int vcu, int G, int l) {
    unsigned char* ws = a->ws; float* ST = (float*)(ws + WS_S5ST);
    bf16x8 bf0[8], bf1[8]; s5_bfrag(ws, l, wave, lane, bf0); s5_bfrag(ws, l, wave + 8, lane, bf1);
    struct { float are, aim; } A0, A1; { const f32x2 q0 = s5_ap(ws, l, wave, lane), q1 = s5_ap(ws, l, wave + 8, lane); A0.are = q0.x; A0.aim = q0.y; A1.are = q1.x; A1.aim = q1.y; }
    for (int u = vcu; u < NB * NCH; u += G) {
        const size_t row0 = (size_t)u * 64;
        __syncthreads();
        s5_load_u(ws, lds, tid, row0);
        __syncthreads();
        float x0r = 0.f, x0i = 0.f, x1r = 0.f, x1i = 0.f;
        for (int tb = 0; tb < 4; ++tb) { s5_block(lds, lane, tb, wave, bf0, A0.are, A0.aim, x0r, x0i); s5_block(lds, lane, tb, wave + 8, bf1, A1.are, A1.aim, x1r, x1i); }
        *(f32x2*)(ST + (((size_t)u * 16 + wave) * 64 + lane) * 2) = (f32x2){x0r, x0i};
        *(f32x2*)(ST + (((size_t)u * 16 + wave + 8) * 64 + lane) * 2) = (f32x2){x1r, x1i};
    }
}
__device__ __forceinline__ void phase_s2(KArgsP a, int tid, int wg, int nwg, int l) {
    float* ST = (float*)(a->ws + WS_S5ST);
    for (int idx = wg * NTHR + tid; idx < NB * 1024; idx += nwg * NTHR) {
        const int b = idx >> 10, gp = idx & 1023, g = gp >> 6, p = gp & 63;
        const f32x2 A = s5_ap(a->ws, l, g, p); float ar = A.x, ai = A.y;
#pragma unroll
        for (int s = 0; s < 6; ++s) { const float nr = ar * ar - ai * ai, ni = 2.f * ar * ai; ar = nr; ai = ni; }
        float cr = 0.f, ci = 0.f;
        f32x2 en[8];
#pragma unroll
        for (int j = 0; j < 8; ++j) en[j] = *(const f32x2*)(ST + (((size_t)(b * NCH + j) * 16 + g) * 64 + p) * 2);
        for (int c0 = 0; c0 < NCH; c0 += 8) {
            f32x2 e[8];
#pragma unroll
            for (int j = 0; j < 8; ++j) e[j] = en[j];
            { const int cq = min(c0 + 8, NCH - 8);
#pragma unroll
              for (int j = 0; j < 8; ++j) en[j] = *(const f32x2*)(ST + (((size_t)(b * NCH + cq + j) * 16 + g) * 64 + p) * 2); }
#pragma unroll
            for (int j = 0; j < 8; ++j) { *(f32x2*)(ST + (((size_t)(b * NCH + c0 + j) * 16 + g) * 64 + p) * 2) = (f32x2){cr, ci};
                const float nr = ar * cr - ai * ci + e[j].x, ni = ar * ci + ai * cr + e[j].y; cr = nr; ci = ni; }
        }
    }
}
__device__ __forceinline__ float tanh_fast(float x) { return 1.f - 2.f / (1.f + __expf(2.f * x)); }
__device__ __forceinline__ float gelu_tanh_(float x) { const float t = tanh_fast(0.7978845608f * (x + 0.044715f * x * x * x)); return 0.5f * x * (1.f + t); }
__device__ __forceinline__ void s5_cload(const bf16* cmt  , int lane, bf16x8 (&cf)[4]) {
#pragma unroll
    for (int s = 0; s < 4; ++s) cf[s] = __builtin_bit_cast(bf16x8, *(const GAS v4u*)(cmt + (lane & 15) * 128 + 32 * s + 8 * (lane >> 4)));
}
__device__ __forceinline__ void s5_cproj(LAS unsigned char* lds, int lane, int tb, int g, const bf16x8 (&cf)[4], const float (&dv)[4]) {
    const int kq = lane >> 4; f32x4 acc = {0.f, 0.f, 0.f, 0.f};
    const LAS bf16* xp = (const LAS bf16*)(lds + S5_X) + (lane & 15) * S5_XT + g * 128 + 8 * kq;
#pragma unroll
    for (int s = 0; s < 4; ++s) acc = __builtin_amdgcn_mfma_f32_16x16x32_bf16(cf[s], *(const LAS bf16x8*)(xp + 32 * s), acc, 0, 0, 0);
    const int t = 16 * tb + (lane & 15), c0 = g * 16 + 4 * kq;
    const v2u uw = *(const LAS v2u*)(lds + S5_U + (t * S5_UT + c0) * 2);
    const float u4[4] = {bflo(uw.x), bfhi(uw.x), bflo(uw.y), bfhi(uw.y)}; float z[4];
#pragma unroll
    for (int r = 0; r < 4; ++r) z[r] = gelu_tanh_(acc[r] + dv[r] * u4[r]);
    v2u o; o.x = pk2(z[0], z[1]); o.y = pk2(z[2], z[3]); *(LAS v2u*)(lds + S5_Z + (t * S5_UT + c0) * 2) = o;
}
__device__ __forceinline__ void phase_s3(KArgsP a, LAS unsigned char* lds, int tid, int lane, int wave, int vcu, int G, int l, unsigned* qctr = nullptr) {
    unsigned char* ws = a->ws; const float* ST = (const float*)(ws + WS_S5ST); bf16* YC = (bf16*)(ws + WS_YC);
    const bf16* GLUT = (const bf16*)(ws + WS_GLUT) + (size_t)l * DC * DC;
    bf16x8 bf0[8], bf1[8]; s5_bfrag(ws, l, wave, lane, bf0); s5_bfrag(ws, l, wave + 8, lane, bf1);
    const bf16* cm0 = (const bf16*)(ws + WS_S5CM) + (size_t)(l * 16 + wave) * 2048; const bf16* cm1 = cm0 + 8 * 2048;
    struct { float are, aim; } A0, A1; { const f32x2 q0 = s5_ap(ws, l, wave, lane), q1 = s5_ap(ws, l, wave + 8, lane); A0.are = q0.x; A0.aim = q0.y; A1.are = q1.x; A1.aim = q1.y; }
    float d0[4], d1[4];
#pragma unroll
    for (int r = 0; r < 4; ++r) { d0[r] = a->in[I_S5D][l * DC + wave * 16 + 4 * (lane >> 4) + r]; d1[r] = a->in[I_S5D][l * DC + (wave + 8) * 16 + 4 * (lane >> 4) + r]; }
    volatile LAS unsigned* qw = (volatile LAS unsigned*)(lds + MISC_OFF) + 20;
    unsigned qn = 0u; if (qctr && tid == 0) qn = __hip_atomic_fetch_add(qctr, 1u, __ATOMIC_RELAXED, __HIP_MEMORY_SCOPE_AGENT);
    for (int u = vcu; ; u += G) {
        if (qctr) { __syncthreads(); if (tid == 0) *qw = qn; __syncthreads(); u = (int)*qw; }
        if (u >= NB * NCH) break;
        if (qctr && tid == 0) qn = __hip_atomic_fetch_add(qctr, 1u, __ATOMIC_RELAXED, __HIP_MEMORY_SCOPE_AGENT);
        const size_t row0 = (size_t)u * 64;
        __syncthreads();
        s5_load_u(ws, lds, tid, row0);
        const f32x2 s0 = *(const f32x2*)(ST + (((size_t)u * 16 + wave) * 64 + lane) * 2), s1 = *(const f32x2*)(ST + (((size_t)u * 16 + wave + 8) * 64 + lane) * 2);
        float x0r = s0.x, x0i = s0.y, x1r = s1.x, x1i = s1.y;
        __syncthreads();
        for (int tb = 0; tb < 4; ++tb) {
            { bf16x8 cf[4]; s5_cload(cm0, lane, cf); s5_block(lds, lane, tb, wave, bf0, A0.are, A0.aim, x0r, x0i); s5_cproj(lds, lane, tb, wave, cf, d0); }
            { bf16x8 cf[4]; s5_cload(cm1, lane, cf); s5_block(lds, lane, tb, wave + 8, bf1, A1.are, A1.aim, x1r, x1i); s5_cproj(lds, lane, tb, wave + 8, cf, d1); }
        }
        __syncthreads();
        {
            const int kq = lane >> 4;
#pragma unroll
            for (int q = 0; q < 2; ++q) { const int ct = 2 * wave + q; f32x4 acc[4];
#pragma unroll
                for (int rt = 0; rt < 4; ++rt) acc[rt] = (f32x4){0.f, 0.f, 0.f, 0.f};
                const bf16* gp = GLUT + (size_t)(16 * ct + (lane & 15)) * DC + 8 * kq;
#pragma unroll 2
                for (int s = 0; s < 8; ++s) { const bf16x8 gf = __builtin_bit_cast(bf16x8, *(const GAS v4u*)(gp + 32 * s));
#pragma unroll
                    for (int rt = 0; rt < 4; ++rt) acc[rt] = __builtin_amdgcn_mfma_f32_16x16x32_bf16(gf, *(const LAS bf16x8*)(lds + S5_Z + ((16 * rt + (lane & 15)) * S5_UT + 32 * s + 8 * kq) * 2), acc[rt], 0, 0, 0); }
                const int j0 = 16 * ct + 4 * kq; const f32x4 gb = *(const GAS f32x4*)(a->in[I_S5GLUB] + l * DC + j0);
#pragma unroll
                for (int rt = 0; rt < 4; ++rt) { const int t = 16 * rt + (lane & 15); const v2u zw = *(const LAS v2u*)(lds + S5_Z + (t * S5_UT + j0) * 2);
                    const float z0 = bflo(zw.x), z1 = bfhi(zw.x), z2 = bflo(zw.y), z3 = bfhi(zw.y);
                    v2u o; o.x = pk2(z0 * sigmoidf_(acc[rt][0] + gb.x), z1 * sigmoidf_(acc[rt][1] + gb.y)); o.y = pk2(z2 * sigmoidf_(acc[rt][2] + gb.z), z3 * sigmoidf_(acc[rt][3] + gb.w));
                    *(GAS v2u*)(YC + (row0 + t) * DM + 768 + j0) = o; } }
        }
    }
}

__device__ __forceinline__ float rw_shift(const bf16* PROJ, const float* mu, size_t row, int col) {
    const float cur = bf2f(PROJ[row * NPROJ + PC_RW + col]); const float prv = (row % SEQ) ? bf2f(PROJ[(row - 1) * NPROJ + PC_RW + col]) : 0.f;
    return cur + mu[col] * (prv - cur);
}
constexpr int R1_TH = 0, R1_AD = 9216, R1_SG = 18432, R1_VS = 35840, R1_TMP = 86016;
template <int KS, int MODE>
__device__ __forceinline__ void r1_prod(const bf16* WT, const LAS bf16* act, int astride, const float* bias, bf16* OUT, size_t row0, int lane, int wave) {
    const int kq = lane >> 4, n0 = 48 * wave; constexpr int K = 32 * KS;
    f32x4 acc[3][4];
#pragma unroll
    for (int nt = 0; nt < 3; ++nt)
#pragma unroll
        for (int ti = 0; ti < 4; ++ti) acc[nt][ti] = (f32x4){0.f, 0.f, 0.f, 0.f};
#pragma unroll
    for (int s = 0; s < KS; ++s) { bf16x8 wf[3], af[4];
#pragma unroll
        for (int nt = 0; nt < 3; ++nt) wf[nt] = __builtin_bit_cast(bf16x8, *(const GAS v4u*)(WT + (size_t)(n0 + 16 * nt + (lane & 15)) * K + 32 * s + 8 * kq));
#pragma unroll
        for (int ti = 0; ti < 4; ++ti) af[ti] = *(const LAS bf16x8*)(act + (16 * ti + (lane & 15)) * astride + 32 * s + 8 * kq);
#pragma unroll
        for (int nt = 0; nt < 3; ++nt)
#pragma unroll
            for (int ti = 0; ti < 4; ++ti) acc[nt][ti] = __builtin_amdgcn_mfma_f32_16x16x32_bf16(wf[nt], af[ti], acc[nt][ti], 0, 0, 0); }
#pragma unroll
    for (int nt = 0; nt < 3; ++nt) { const int n = n0 + 16 * nt + 4 * kq; f32x4 bv = {0.f, 0.f, 0.f, 0.f}; if (MODE != 2) bv = *(const GAS f32x4*)(bias + n);
#pragma unroll
        for (int ti = 0; ti < 4; ++ti) { float o[4];
#pragma unroll
            for (int r = 0; r < 4; ++r) { const float x = acc[nt][ti][r] + bv[r]; o[r] = MODE == 0 ? 0.60653066f * sigmoidf_(x) : (MODE == 1 ? sigmoidf_(x) : x); }
            v2u w; w.x = pk2(o[0], o[1]); w.y = pk2(o[2], o[3]);
            *(GAS v2u*)(OUT + (row0 + 16 * ti + (lane & 15)) * DBR + n) = w; } }
}
__device__ __forceinline__ void phase_r1(KArgsP a, LAS unsigned char* lds, int tid, int lane, int wave, int vcu, int G, int l) {
    unsigned char* ws = a->ws; const bf16* PROJ = (const bf16*)(ws + WS_PROJ); const float* mu = a->in[I_RMU] + (size_t)l * RW_COLS;
    const bf16* W1 = (const bf16*)(ws + WS_R1W) + (size_t)l * 98304;
    const bf16* WV = (const bf16*)(ws + WS_R1W) + 2 * 98304;
    for (int u = vcu; u < NTOK / 64; u += G) {
        const size_t row0 = (size_t)u * 64;
        __syncthreads();
        for (int idx = tid; idx < 64 * 32; idx += NTHR) { const int tt = idx >> 5, col = 8 * (idx & 31); const size_t r = row0 + tt;
            const v4u cw = *(const GAS v4u*)(PROJ + r * NPROJ + PC_RW + RWC_WD + col); v4u pw = {0u, 0u, 0u, 0u}; if (r % SEQ) pw = *(const GAS v4u*)(PROJ + (r - 1) * NPROJ + PC_RW + RWC_WD + col);
            const f32x4 m0 = *(const GAS f32x4*)(mu + RWC_WD + col), m1 = *(const GAS f32x4*)(mu + RWC_WD + col + 4);
            const unsigned cu[4] = {cw.x, cw.y, cw.z, cw.w}, pu[4] = {pw.x, pw.y, pw.z, pw.w}; const float mm[8] = {m0[0], m0[1], m0[2], m0[3], m1[0], m1[1], m1[2], m1[3]}; unsigned o[4];
#pragma unroll
            for (int j = 0; j < 4; ++j) { const float c0 = bflo(cu[j]), c1 = bfhi(cu[j]); const float x0 = c0 + mm[2 * j] * (bflo(pu[j]) - c0), x1 = c1 + mm[2 * j + 1] * (bfhi(pu[j]) - c1);
                o[j] = col < 64 ? pk2(tanh_fast(x0), tanh_fast(x1)) : (col < 128 ? pk2(x0, x1) : pk2(sigmoidf_(x0), sigmoidf_(x1))); }
            v4u w; w.x = o[0]; w.y = o[1]; w.z = o[2]; w.w = o[3];
            if (col < 64) *(LAS v4u*)(lds + R1_TH + (tt * 72 + col) * 2) = w;
            else if (col < 128) *(LAS v4u*)(lds + R1_AD + (tt * 72 + col - 64) * 2) = w;
            else *(LAS v4u*)(lds + R1_SG + (tt * 136 + col - 128) * 2) = w; }
        if (l > 0) for (int idx = tid; idx < 64 * 48; idx += NTHR) { const int tt = idx / 48, col = 8 * (idx % 48); const size_t r = row0 + tt;
            const v4u cw = *(const GAS v4u*)(PROJ + r * NPROJ + PC_RW + RWC_V + col); v4u pw = {0u, 0u, 0u, 0u}; if (r % SEQ) pw = *(const GAS v4u*)(PROJ + (r - 1) * NPROJ + PC_RW + RWC_V + col);
            const f32x4 m0 = *(const GAS f32x4*)(mu + RWC_V + col), m1 = *(const GAS f32x4*)(mu + RWC_V + col + 4);
            const unsigned cu[4] = {cw.x, cw.y, cw.z, cw.w}, pu[4] = {pw.x, pw.y, pw.z, pw.w}; const float mm[8] = {m0[0], m0[1], m0[2], m0[3], m1[0], m1[1], m1[2], m1[3]}; unsigned o[4];
#pragma unroll
            for (int j = 0; j < 4; ++j) { const float c0 = bflo(cu[j]), c1 = bfhi(cu[j]); o[j] = pk2(c0 + mm[2 * j] * (bflo(pu[j]) - c0), c1 + mm[2 * j + 1] * (bfhi(pu[j]) - c1)); }
            v4u w; w.x = o[0]; w.y = o[1]; w.z = o[2]; w.w = o[3];
            *(LAS v4u*)(lds + R1_VS + (tt * 392 + col) * 2) = w; }
        __syncthreads();
        r1_prod<2, 0>(W1, (const LAS bf16*)(lds + R1_TH), 72, a->in[I_RW0] + l * DBR, (bf16*)(ws + WS_RE), row0, lane, wave);
        r1_prod<2, 1>(W1 + 24576, (const LAS bf16*)(lds + R1_AD), 72, a->in[I_RA0] + l * DBR, (bf16*)(ws + WS_RA), row0, lane, wave);
        r1_prod<4, 2>(W1 + 49152, (const LAS bf16*)(lds + R1_SG), 136, nullptr, (bf16*)(ws + WS_RG), row0, lane, wave);
        if (l > 0) {
            { const int kq = lane >> 4, mt = wave & 1, ti = wave >> 1; f32x4 acc = {0.f, 0.f, 0.f, 0.f};
#pragma unroll
              for (int s = 0; s < 12; ++s) acc = __builtin_amdgcn_mfma_f32_16x16x32_bf16(__builtin_bit_cast(bf16x8, *(const GAS v4u*)(WV + (size_t)(16 * mt + (lane & 15)) * 384 + 32 * s + 8 * kq)),
                                                                                          *(const LAS bf16x8*)(lds + R1_VS + ((16 * ti + (lane & 15)) * 392 + 32 * s + 8 * kq) * 2), acc, 0, 0, 0);
              v2u w; w.x = pk2(acc[0], acc[1]); w.y = pk2(acc[2], acc[3]); *(LAS v2u*)(lds + R1_TMP + ((16 * ti + (lane & 15)) * 40 + 16 * mt + 4 * kq) * 2) = w; }
            __syncthreads();
            r1_prod<1, 1>(WV + 12288, (const LAS bf16*)(lds + R1_TMP), 40, a->in[I_RV0], (bf16*)(ws + WS_RVG), row0, lane, wave);
        }
    }
}
__device__ __forceinline__ float dpp_allsum(float x) {
    x += __builtin_bit_cast(float, __builtin_amdgcn_update_dpp(0, __builtin_bit_cast(int, x), 0x128, 0xf, 0xf, false));
    x += __builtin_bit_cast(float, __builtin_amdgcn_update_dpp(0, __builtin_bit_cast(int, x), 0x124, 0xf, 0xf, false));
    x += __builtin_bit_cast(float, __builtin_amdgcn_update_dpp(0, __builtin_bit_cast(int, x), 0x122, 0xf, 0xf, false));
    x += __builtin_bit_cast(float, __builtin_amdgcn_update_dpp(0, __builtin_bit_cast(int, x), 0x121, 0xf, 0xf, false));
    { const unsigned xi = __builtin_bit_cast(unsigned, x); auto r = __builtin_amdgcn_permlane16_swap(xi, xi, false, false); const unsigned r0 = r[0], r1 = r[1]; x = __uint_as_float(r0) + __uint_as_float(r1); }
    { const unsigned xi = __builtin_bit_cast(unsigned, x); auto r = __builtin_amdgcn_permlane32_swap(xi, xi, false, false); const unsigned r0 = r[0], r1 = r[1]; x = __uint_as_float(r0) + __uint_as_float(r1); }
    return x;
}

constexpr int RC_EF = 0, RC_ATF = 4096, RC_QF = 8448, RC_PFT = 9472, RC_AT = 10496, RC_RT = 12800, RC_BH = 15104, RC_KH = 17408, RC_AH = 19712, RC_BTT = 22016, RC_KTT = 25088, RC_VS = 28160,
              RC_PRL = 31232, RC_QRL = 32000, RC_TQL = 32768, RC_G15 = 33536, RC_CH = 33792;
struct RCRegs { v2u r0, r1, k0, k1, aa, ee, v0, v1, vg, vf, gg; };
__device__ __forceinline__ void rc_issue(const unsigned char* ws, int l, size_t row, int h, int tid, RCRegs& R) {
    const bf16* PROJ = (const bf16*)(ws + WS_PROJ); const int tt = tid >> 4, c0 = h * 64 + 4 * (tid & 15); const size_t r = row + tt; const bool first = (r % SEQ) == 0; const size_t rp = first ? r : r - 1;
    R.r0 = *(const GAS v2u*)(PROJ + r * NPROJ + PC_RW + RWC_R + c0); R.r1 = *(const GAS v2u*)(PROJ + rp * NPROJ + PC_RW + RWC_R + c0);
    R.k0 = *(const GAS v2u*)(PROJ + r * NPROJ + PC_RW + RWC_K + c0); R.k1 = *(const GAS v2u*)(PROJ + rp * NPROJ + PC_RW + RWC_K + c0);
    R.v0 = *(const GAS v2u*)(PROJ + r * NPROJ + PC_RW + RWC_V + c0); R.v1 = *(const GAS v2u*)(PROJ + rp * NPROJ + PC_RW + RWC_V + c0);
    R.aa = *(const GAS v2u*)((const bf16*)(ws + WS_RA) + r * DBR + c0); R.ee = *(const GAS v2u*)((const bf16*)(ws + WS_RE) + r * DBR + c0);
    R.gg = *(const GAS v2u*)((const bf16*)(ws + WS_RG) + r * DBR + c0);
    if (l > 0) { R.vg = *(const GAS v2u*)((const bf16*)(ws + WS_RVG) + r * DBR + c0); R.vf = *(const GAS v2u*)((const bf16*)(ws + WS_VF) + r * DBR + c0); }
    if (first) { R.r1 = (v2u){0u, 0u}; R.k1 = (v2u){0u, 0u}; R.v1 = (v2u){0u, 0u}; }
}
__device__ __forceinline__ void unpack4(const v2u p, float (&o)[4]) { o[0] = bflo(p.x); o[1] = bfhi(p.x); o[2] = bflo(p.y); o[3] = bfhi(p.y); }
__device__ __forceinline__ v2u pack4(const float (&v)[4]) { v2u o; o.x = pk2(v[0], v[1]); o.y = pk2(v[2], v[3]); return o; }
__device__ __forceinline__ v2u pack4v(const f32x4 v) { v2u o; o.x = pk2(v[0], v[1]); o.y = pk2(v[2], v[3]); return o; }
__device__ __forceinline__ bf16x8 cat8(const v2u a, const v2u b) { v4u o; o.x = a.x; o.y = a.y; o.z = b.x; o.w = b.y; return __builtin_bit_cast(bf16x8, o); }
#define RC_BAR() asm volatile("s_waitcnt lgkmcnt(0)\n\ts_barrier" ::: "memory")

constexpr int REC_BYTES = 12288, REC_UNITS = 752;
__device__ __forceinline__ unsigned char* rc_rec(unsigned char* ws, size_t cu) { return cu < 8192 ? ws + WS_OPA + cu * REC_BYTES : ws + WS_OPB + (cu - 8192) * REC_BYTES; }
__device__ __forceinline__ v4u rc_gather_unit(const LAS unsigned char* wb, int u) {
    v2u lo, hi;
    if (u < 256) { const int base = u < 128 ? RC_AH : RC_RT, uu = u & 127, row = uu >> 3, s = (uu >> 2) & 1, lq = uu & 3; const LAS unsigned char* p = wb + base + (row * 72 + 32 * s + 4 * lq) * 2;
        lo = *(const LAS v2u*)p; hi = *(const LAS v2u*)(p + 32); }
    else if (u < 512) { const int k = (u - 256) >> 2, lq = (u - 256) & 3; lo = *(const LAS v2u*)(wb + RC_BTT + (k * 24 + 4 * lq) * 2); hi = *(const LAS v2u*)(wb + RC_KTT + (k * 24 + 4 * lq) * 2); }
    else if (u < 576) { const int t = (u - 512) >> 2, lq = (u - 512) & 3; lo = *(const LAS v2u*)(wb + RC_PRL + (t * 24 + 4 * lq) * 2); hi = *(const LAS v2u*)(wb + RC_QRL + (t * 24 + 4 * lq) * 2); }
    else if (u < 608) { const LAS unsigned char* p = wb + RC_TQL + (((u - 576) >> 1) * 24 + 8 * ((u - 576) & 1)) * 2; lo = *(const LAS v2u*)p; hi = *(const LAS v2u*)(p + 8); }
    else if (u < 736) { const LAS unsigned char* p = wb + RC_VS + (((u - 608) >> 1) * 24 + 8 * ((u - 608) & 1)) * 2; lo = *(const LAS v2u*)p; hi = *(const LAS v2u*)(p + 8); }
    else { const LAS unsigned char* p = wb + RC_G15 + (u - 736) * 16; lo = *(const LAS v2u*)p; hi = *(const LAS v2u*)(p + 8); }
    v4u o; o.x = lo.x; o.y = lo.y; o.z = hi.x; o.w = hi.y; return o;
}
__device__ __forceinline__ void rc_copy_out(unsigned char* rec, const LAS unsigned char* wb, int u) {
#pragma unroll
    for (int q = 0; q < 3; ++q) { const int uu = u + 256 * q; if (uu < REC_UNITS) *(GAS v4u*)(rec + uu * 16) = rc_gather_unit(wb, uu); }
}
constexpr int RS_AH = 0, RS_RT = 2304, RS_BK = 4608, RS_PQ = 9728, RS_TQL = 11008, RS_VS = 11776, RS_G15 = 14848, RS_CH = 15360;
__device__ __forceinline__ int rs_unit_off(int u) {
    if (u < 128) return RS_AH + (u >> 3) * 144 + (u & 7) * 16;
    if (u < 256) return RS_RT + ((u - 128) >> 3) * 144 + (u & 7) * 16;
    if (u < 512) return RS_BK + ((u - 256) >> 2) * 80 + (u & 3) * 16;
    if (u < 576) return RS_PQ + ((u - 512) >> 2) * 80 + (u & 3) * 16;
    if (u < 608) return RS_TQL + ((u - 576) >> 1) * 48 + (u & 1) * 16;
    if (u < 736) return RS_VS + ((u - 608) >> 1) * 48 + (u & 1) * 16;
    return RS_G15 + (u - 736) * 16;
}
#define RC_BUILD(RUSE, q) do { const int bh_ = (q) % (NB * NH), b = bh_ / NH, h = bh_ % NH, blk_ = blk0 + (q) / (NB * NH), c0 = h * 64 + 4 * kq; const size_t row0 = (size_t)b * SEQ + (size_t)blk_ * 32; \
        float kkw[4], kaw[4], mur[4], muk[4], muv[4], rrkw[4], lnww[4], lnbw[4];     \
_Pragma("unroll") \
        for (int j = 0; j < 4; ++j) { kkw[j] = cst[c0 + j]; kaw[j] = cst[384 + c0 + j]; rrkw[j] = cst[768 + c0 + j]; lnww[j] = cst[1152 + c0 + j]; lnbw[j] = cst[1536 + c0 + j]; mur[j] = cst[1920 + c0 + j]; muk[j] = cst[2304 + c0 + j]; muv[j] = cst[2688 + c0 + j]; } \
        float an[4], bk[4], km[4], rs[4], ev[4]; \
        {   const RCRegs& R = RUSE; \
            float rc[4], rp[4], kc[4], kp[4], av[4], vc[4], vp[4], ks[4], kk[4], vs[4]; unpack4(R.r0, rc); unpack4(R.r1, rp); unpack4(R.k0, kc); unpack4(R.k1, kp); unpack4(R.aa, av); unpack4(R.ee, ev); unpack4(R.v0, vc); unpack4(R.v1, vp); \
            float ss = 0.f; \
_Pragma("unroll") \
            for (int j = 0; j < 4; ++j) { rs[j] = rc[j] + mur[j] * (rp[j] - rc[j]); ks[j] = kc[j] + muk[j] * (kp[j] - kc[j]); kk[j] = ks[j] * kkw[j]; ss += kk[j] * kk[j]; vs[j] = vc[j] + muv[j] * (vp[j] - vc[j]); } \
            ss += __shfl_xor(ss, 1); ss += __shfl_xor(ss, 2); ss += __shfl_xor(ss, 4); ss += __shfl_xor(ss, 8); \
            const float inv = 1.f / fmaxf(sqrtf(ss), 1e-12f); \
_Pragma("unroll") \
            for (int j = 0; j < 4; ++j) { const float kn = kk[j] * inv; an[j] = -kn; bk[j] = kn * av[j]; km[j] = ks[j] * (1.f + (av[j] - 1.f) * kaw[j]); } \
            if (l == 0) *(GAS v2u*)((bf16*)(ws + WS_VF) + (row0 + tt) * DBR + c0) = pack4(vs); \
            else { float g[4], f[4]; unpack4(R.vg, g); unpack4(R.vf, f); \
_Pragma("unroll") \
                for (int j = 0; j < 4; ++j) vs[j] = vs[j] + (f[j] - vs[j]) * g[j]; } \
            {     \
                float gq[4], o1[4], o2[4]; unpack4(R.gg, gq); float rkp = 0.f; \
_Pragma("unroll") \
                for (int j = 0; j < 4; ++j) rkp += rs[j] * km[j] * rrkw[j]; \
                rkp += __shfl_xor(rkp, 1); rkp += __shfl_xor(rkp, 2); rkp += __shfl_xor(rkp, 4); rkp += __shfl_xor(rkp, 8); \
_Pragma("unroll") \
                for (int j = 0; j < 4; ++j) { o1[j] = lnww[j] * gq[j]; o2[j] = (lnbw[j] + rkp * vs[j]) * gq[j]; } \
                if (ST12) { *(GAS v2u*)((bf16*)(ws + WS_RG) + (row0 + tt) * DBR + c0) = pack4(o1); *(GAS v2u*)((bf16*)(ws + WS_RA) + (row0 + tt) * DBR + c0) = pack4(o2); } } \
            *(LAS f32x4*)(cb + RC_EF + (t * 64 + 4 * kq) * 4) = (f32x4){ev[0], ev[1], ev[2], ev[3]}; \
_Pragma("unroll") \
            for (int j = 0; j < 4; ++j) *(LAS bf16*)(cb + RC_VS + ((4 * kq + j) * 24 + t) * 2) = (bf16)f2bf(vs[j]); \
        } \
        if ((q) + 2 * G < NQ) rc_issue_q(ws, l, (q) + 2 * G, blk0, tid, RUSE); \
        RC_BAR(); \
        {   f32x4 inc = {0.f, 0.f, 0.f, 0.f}, tot = inc; \
_Pragma("unroll") \
            for (int i = 0; i < 16; ++i) { const f32x4 ei = *(const LAS f32x4*)(cb + RC_EF + (i * 64 + 4 * kq) * 4); tot = tot + ei; if (i <= t) inc = inc + ei; } \
            float At[4], Rt[4], Bh[4], Kh[4], Bt[4], Kt[4], Gt[4]; \
_Pragma("unroll") \
            for (int j = 0; j < 4; ++j) { const float Gi = __expf(-inc[j]), Ge = __expf(ev[j] - inc[j]), Gn = __expf(inc[j]); Gt[j] = __expf(-tot[j]); \
                At[j] = an[j] * Ge; Rt[j] = rs[j] * Gi; Bh[j] = bk[j] * Gn; Kh[j] = km[j] * Gn; Bt[j] = Bh[j] * Gt[j]; Kt[j] = Kh[j] * Gt[j]; } \
            *(LAS f32x4*)(cb + RC_ATF + (t * 68 + 4 * kq) * 4) = (f32x4){At[0], At[1], At[2], At[3]}; \
            *(LAS v2u*)(cb + RC_AT + (t * 72 + 4 * kq) * 2) = pack4(At); *(LAS v2u*)(cb + RC_RT + (t * 72 + 4 * kq) * 2) = pack4(Rt); \
            *(LAS v2u*)(cb + RC_BH + (t * 72 + 4 * kq) * 2) = pack4(Bh); *(LAS v2u*)(cb + RC_KH + (t * 72 + 4 * kq) * 2) = pack4(Kh); \
_Pragma("unroll") \
            for (int j = 0; j < 4; ++j) { *(LAS bf16*)(cb + RC_BTT + ((4 * kq + j) * 24 + t) * 2) = (bf16)f2bf(Bt[j]); *(LAS bf16*)(cb + RC_KTT + ((4 * kq + j) * 24 + t) * 2) = (bf16)f2bf(Kt[j]); } \
            if (t == 0) *(LAS f32x4*)(cb + RC_G15 + 4 * kq * 4) = (f32x4){Gt[0], Gt[1], Gt[2], Gt[3]}; \
        } \
        RC_BAR(); \
        {   LAS unsigned char* wb = lds + (wave >> 2) * RC_CH; const int pi = wave & 3; \
            const LAS bf16* Ap = (const LAS bf16*)(wb + (pi < 2 ? RC_AT : RC_RT)) + li * 72 + 8 * lq; const LAS bf16* Bp = (const LAS bf16*)(wb + ((pi & 1) ? RC_KH : RC_BH)) + li * 72 + 8 * lq; \
            f32x4 acc = {0.f, 0.f, 0.f, 0.f}; \
            acc = __builtin_amdgcn_mfma_f32_16x16x32_bf16(*(const LAS bf16x8*)Ap, *(const LAS bf16x8*)Bp, acc, 0, 0, 0); \
            acc = __builtin_amdgcn_mfma_f32_16x16x32_bf16(*(const LAS bf16x8*)(Ap + 32), *(const LAS bf16x8*)(Bp + 32), acc, 0, 0, 0); \
_Pragma("unroll") \
            for (int r = 0; r < 4; ++r) { const int tr = 4 * lq + r; if (pi < 2 ? !(li < tr) : !(li <= tr)) acc[r] = 0.f; } \
            if (pi == 0) *(LAS f32x4*)(wb + RC_PFT + (li * 16 + 4 * lq) * 4) = acc; \
            else if (pi == 1) { \
_Pragma("unroll") \
                for (int r = 0; r < 4; ++r) *(LAS float*)(wb + RC_QF + ((4 * lq + r) * 16 + li) * 4) = acc[r]; } \
            else { LAS bf16* o = (LAS bf16*)(wb + (pi == 2 ? RC_PRL : RC_QRL)); \
_Pragma("unroll") \
                for (int r = 0; r < 4; ++r) o[(4 * lq + r) * 24 + li] = (bf16)f2bf(acc[r]); } \
        } \
        RC_BAR(); \
        if (wave < 4) { \
            LAS unsigned char* wb = lds + (wave >> 1) * RC_CH; const bool isq = wave & 1; \
            float X[16]; \
_Pragma("unroll") \
            for (int r = 0; r < 16; ++r) X[r] = isq ? *(const LAS float*)(wb + RC_QF + (r * 16 + li) * 4) : *(const LAS float*)(wb + RC_ATF + (r * 68 + lane) * 4); \
_Pragma("unroll") \
            for (int j = 0; j < 15; ++j) { const LAS f32x4* pc = (const LAS f32x4*)(wb + RC_PFT + j * 64); const f32x4 c0v = pc[0], c1v = pc[1], c2v = pc[2], c3v = pc[3]; \
                const float c[16] = {c0v[0], c0v[1], c0v[2], c0v[3], c1v[0], c1v[1], c1v[2], c1v[3], c2v[0], c2v[1], c2v[2], c2v[3], c3v[0], c3v[1], c3v[2], c3v[3]}; \
_Pragma("unroll") \
                for (int r = j + 1; r < 16; ++r) X[r] = fmaf(c[r], X[j], X[r]); } \
            if (!isq) { LAS bf16* o = (LAS bf16*)(wb + RC_AH); \
_Pragma("unroll") \
                for (int r = 0; r < 16; ++r) o[r * 72 + lane] = (bf16)f2bf(X[r]); } \
            else if (lane < 16) { LAS bf16* o = (LAS bf16*)(wb + RC_TQL); \
_Pragma("unroll") \
                for (int r = 0; r < 16; ++r) o[r * 24 + lane] = (bf16)f2bf(X[r]); } \
        } \
        RC_BAR(); \
        { const int cc = tid >> 8, u = tid & 255; unsigned char* rec = rc_rec(ws, (size_t)bh_ * 512 + 2 * blk_ + cc); const LAS unsigned char* wb = lds + cc * RC_CH; \
          rc_copy_out(rec, wb, u); } \
        RC_BAR(); \
    } while (0)
#ifndef RS_NT
#define RS_NT 1
#endif
constexpr int RS_TILES = RS_NT;
struct RSOps { bf16x8 a01, a23, r01, r23, tq, pq, bk[4]; v2u vb[RS_TILES]; f32x4 g[4]; };
__device__ __forceinline__ void rs_load(const LAS unsigned char* wb, int wave, int li, int lq, RSOps& O) {
    O.a01 = *(const LAS bf16x8*)(wb + RS_AH + li * 144 + lq * 16); O.a23 = *(const LAS bf16x8*)(wb + RS_AH + li * 144 + 64 + lq * 16);
    O.r01 = *(const LAS bf16x8*)(wb + RS_RT + li * 144 + lq * 16); O.r23 = *(const LAS bf16x8*)(wb + RS_RT + li * 144 + 64 + lq * 16);
    O.pq = *(const LAS bf16x8*)(wb + RS_PQ + li * 80 + lq * 16);
    { const v2u t = *(const LAS v2u*)(wb + RS_TQL + li * 48 + lq * 8); v4u o; o.x = t.x; o.y = t.y; o.z = 0u; o.w = 0u; O.tq = __builtin_bit_cast(bf16x8, o); }
#pragma unroll
    for (int vt = 0; vt < RS_TILES; ++vt) O.vb[vt] = *(const LAS v2u*)(wb + RS_VS + (16 * (RS_TILES * wave + vt) + li) * 48 + lq * 8);
#pragma unroll
    for (int kt = 0; kt < 4; ++kt) { O.bk[kt] = *(const LAS bf16x8*)(wb + RS_BK + (16 * kt + li) * 80 + lq * 16); O.g[kt] = *(const LAS f32x4*)(wb + RS_G15 + (16 * kt + 4 * lq) * 4); }
}
#define RC_CHUNK(O, cc, yb) do { const v2u z2_ = {0u, 0u}; \
_Pragma("unroll") \
        for (int vt = 0; vt < RS_TILES; ++vt) {     \
            f32x4 aD = {0.f, 0.f, 0.f, 0.f}, aY = {0.f, 0.f, 0.f, 0.f}; \
            aD = __builtin_amdgcn_mfma_f32_16x16x32_bf16(O.tq, cat8(O.vb[vt], z2_), aD, 0, 0, 0); \
            aD = __builtin_amdgcn_mfma_f32_16x16x32_bf16(O.a01, Sb01[vt], aD, 0, 0, 0); \
            aD = __builtin_amdgcn_mfma_f32_16x16x32_bf16(O.a23, Sb23[vt], aD, 0, 0, 0); \
            aY = __builtin_amdgcn_mfma_f32_16x16x32_bf16(Sb01[vt], O.r01, aY, 0, 0, 0); \
            aY = __builtin_amdgcn_mfma_f32_16x16x32_bf16(Sb23[vt], O.r23, aY, 0, 0, 0); \
            const bf16x8 DV = cat8(pack4v(aD), O.vb[vt]); \
_Pragma("unroll") \
            for (int kt = 0; kt < 4; ++kt) Sacc[vt][kt] = __builtin_amdgcn_mfma_f32_16x16x32_bf16(O.bk[kt], DV, Sacc[vt][kt] * O.g[kt], 0, 0, 0); \
            aY = __builtin_amdgcn_mfma_f32_16x16x32_bf16(DV, O.pq, aY, 0, 0, 0); \
            Sb01[vt] = cat8(pack4v(Sacc[vt][0]), pack4v(Sacc[vt][1])); Sb23[vt] = cat8(pack4v(Sacc[vt][2]), pack4v(Sacc[vt][3])); \
            *(LAS v2u*)((yb) + (((cc) * 16 + li) * 72 + 16 * (RS_TILES * wave + vt) + 4 * lq) * 2) = pack4v(aY);     \
        } \
    } while (0)
#define RC_SCAN(slot, yb) do { { RSOps O0; rs_load(slot, wave, li, lq, O0); __builtin_amdgcn_sched_barrier(0); RC_CHUNK(O0, 0, yb); } \
        { RSOps O1; rs_load(slot + RS_CH, wave, li, lq, O1); __builtin_amdgcn_sched_barrier(0); RC_CHUNK(O1, 1, yb); } } while (0)

__device__ __forceinline__ void rc_issue_q(const unsigned char* ws, int l, int q, int blk0, int tid, RCRegs& R) {
    const int bh = q % (NB * NH), blk = blk0 + q / (NB * NH);
    rc_issue(ws, l, (size_t)(bh / NH) * SEQ + (size_t)blk * 32, bh % NH, tid, R);
}
template <bool ST12 = true>
__device__ __forceinline__ void phase_r2_build(KArgsP a, LAS unsigned char* lds, int tid, int lane, int wave, int vcu, int G, int l, int blk0 = 0, int nblk = SEQ / 32) {
    unsigned char* ws = a->ws;
    const int tt = tid >> 4, kq = tid & 15, ch = tt >> 4, t = tt & 15;
    const int lq = lane >> 4, li = lane & 15;
    LAS unsigned char* cb = lds + ch * RC_CH;
    const float* mu = a->in[I_RMU] + (size_t)l * RW_COLS;
    const float* pRKK = a->in[I_RKK] + (size_t)l * DBR; const float* pRKA = a->in[I_RKA] + (size_t)l * DBR; const float* pRRK = a->in[I_RRK] + (size_t)l * DBR;
    const float* pLNW = a->in[I_RLNW] + (size_t)l * DBR; const float* pLNB = a->in[I_RLNB] + (size_t)l * DBR;
    const int NQ = NB * NH * nblk;
    LAS float* cst = (LAS float*)(lds + 2 * RC_CH);
    __syncthreads();
    for (int i = tid; i < 8 * DBR; i += NTHR) { const int arr = i / DBR, c = i % DBR;
        cst[i] = arr == 0 ? pRKK[c] : arr == 1 ? pRKA[c] : arr == 2 ? pRRK[c] : arr == 3 ? pLNW[c] : arr == 4 ? pLNB[c] : mu[RWC_R + (arr - 5) * DBR + c]; }
    __syncthreads();
    RCRegs RA, RB;
    if (vcu < NQ) rc_issue_q(ws, l, vcu, blk0, tid, RA);
    if (vcu + G < NQ) rc_issue_q(ws, l, vcu + G, blk0, tid, RB);
    for (int q0 = vcu; q0 < NQ; q0 += 2 * G) { { const int q = q0; RC_BUILD(RA, q); } if (q0 + G < NQ) { const int q = q0 + G; RC_BUILD(RB, q); } }
}
#ifndef RS_DEPTH
#define RS_DEPTH 4
#endif
struct RSRegs { v4u p[6]; };
__device__ __forceinline__ unsigned char* ubase(const unsigned char* p) {
    const unsigned lo = __builtin_amdgcn_readfirstlane((unsigned)(uintptr_t)p), hi = __builtin_amdgcn_readfirstlane((unsigned)((uintptr_t)p >> 32));
    return (unsigned char*)(((uintptr_t)hi << 32) | lo);
}
struct RSOff { unsigned g[6], s[6]; };
__device__ __forceinline__ void rs_offsets(int lt, RSOff& F) {
#pragma unroll
    for (int j = 0; j < 6; ++j) { const int uu = min(lt + 256 * j, 2 * REC_UNITS - 1); const int cc = uu >= REC_UNITS, u = uu - cc * REC_UNITS;
        F.g[j] = uu * 16 + cc * (REC_BYTES - REC_UNITS * 16); F.s[j] = cc * RS_CH + rs_unit_off(u); }
}
__device__ __forceinline__ void rs_issue(unsigned char* ws, size_t cu0, const RSOff& F, RSRegs& R) {
    const unsigned char* base = ubase(rc_rec(ws, cu0));
#pragma unroll
    for (int j = 0; j < 6; ++j) R.p[j] = *(const GAS v4u*)(base + F.g[j]);
}
__device__ __forceinline__ void rs_store(LAS unsigned char* slot, const RSOff& F, const RSRegs& R) {
#pragma unroll
    for (int j = 0; j < 6; ++j) *(LAS v4u*)(slot + F.s[j]) = R.p[j];
}
struct R3Q { v4u a1, a2; };
__device__ __forceinline__ void r3q_issue(const unsigned char* ws, size_t row0, int h, int lt, R3Q& Q) {
    const unsigned off = (unsigned)(((lt >> 3) * DBR + 8 * (lt & 7)) * 2); const size_t ub = (row0 * DBR + h * 64) * 2;
    Q.a1 = *(const GAS v4u*)(ubase(ws + WS_RG + ub) + off); Q.a2 = *(const GAS v4u*)(ubase(ws + WS_RA + ub) + off);
}
__device__ __forceinline__ float dpp8sum(float x) {
    x += __builtin_bit_cast(float, __builtin_amdgcn_update_dpp(0, __builtin_bit_cast(int, x), 0xB1, 0xf, 0xf, false));
    x += __builtin_bit_cast(float, __builtin_amdgcn_update_dpp(0, __builtin_bit_cast(int, x), 0x4E, 0xf, 0xf, false));
    x += __builtin_bit_cast(float, __builtin_amdgcn_update_dpp(0, __builtin_bit_cast(int, x), 0x141, 0xf, 0xf, false));
    return x;
}
__device__ __forceinline__ void r3_block(const LAS unsigned char* yb, bf16* YC, size_t row0, int h, int lt, const R3Q& Q) {
    const int tk = lt >> 3, c8 = 8 * (lt & 7);
    const v4u yy = *(const LAS v4u*)(yb + (tk * 72 + c8) * 2);
    float d[8] = {bflo(yy.x), bfhi(yy.x), bflo(yy.y), bfhi(yy.y), bflo(yy.z), bfhi(yy.z), bflo(yy.w), bfhi(yy.w)};
    const float m = dpp8sum(((d[0] + d[1]) + (d[2] + d[3])) + ((d[4] + d[5]) + (d[6] + d[7]))) * (1.f / 64.f);
    float q = 0.f;
#pragma unroll
    for (int j = 0; j < 8; ++j) { d[j] -= m; q = fmaf(d[j], d[j], q); }
    const float rstd = rsqrtf(dpp8sum(q) * (1.f / 64.f) + RWKV_GN_EPS);
    const unsigned a1[4] = {Q.a1.x, Q.a1.y, Q.a1.z, Q.a1.w}, a2[4] = {Q.a2.x, Q.a2.y, Q.a2.z, Q.a2.w}; unsigned o[4];
#pragma unroll
    for (int j = 0; j < 4; ++j) o[j] = pk2(fmaf(d[2 * j] * rstd, bflo(a1[j]), bflo(a2[j])), fmaf(d[2 * j + 1] * rstd, bfhi(a1[j]), bfhi(a2[j])));
    v4u w; w.x = o[0]; w.y = o[1]; w.z = o[2]; w.w = o[3];
    *(GAS v4u*)(ubase((const unsigned char*)(YC + row0 * DM + 384 + h * 64)) + (unsigned)((tk * DM + c8) * 2)) = w;
}
template <int VAR = 0>
__device__ __forceinline__ void phase_r2_scan(KArgsP a, LAS unsigned char* lds, int tid, int lane, int wave, int wg, int l, int bsplit = SEQ / 32, unsigned nbuilders = 0u) {
    unsigned char* ws = a->ws; bf16* YC = (bf16*)(ws + WS_YC);
    const int b = wg / NH, h = wg % NH; const size_t rowb = (size_t)b * SEQ, cub = (size_t)wg * 512;
    const int lq = lane >> 4, li = lane & 15, lt = tid - 256; const bool loader = wave >= 4;
    f32x4 Sacc[RS_TILES][4]; bf16x8 Sb01[RS_TILES], Sb23[RS_TILES];
#pragma unroll
    for (int vt = 0; vt < RS_TILES; ++vt) {
#pragma unroll
        for (int kt = 0; kt < 4; ++kt) Sacc[vt][kt] = (f32x4){0.f, 0.f, 0.f, 0.f};
        Sb01[vt] = (bf16x8){0, 0, 0, 0, 0, 0, 0, 0}; Sb23[vt] = Sb01[vt]; }
    constexpr int NBLK = SEQ / 32;
    LAS unsigned char* yb0 = lds + 8 * RS_CH; LAS unsigned char* yb1 = yb0 + 32 * 72 * 2;
    static_assert(8 * RS_CH + 2 * 32 * 72 * 2 <= MISC_OFF, "scan LDS layout");
    if (wave < 4 / RS_TILES) {
        RSOps OA, OB;
        RC_BAR();
        rs_load(lds, wave, li, lq, OA);
#pragma unroll 1
        for (int X = 0; X < NBLK; ++X) {
            LAS unsigned char* sl = lds + (X & 3) * 2 * RS_CH; LAS unsigned char* sn = lds + ((X + 1) & 3) * 2 * RS_CH; LAS unsigned char* yb = yb0 + (X & 1) * (32 * 72 * 2);
            if (X == bsplit - 7 && wave == 0) {
                if (lane == 0) { unsigned* bar_ = (unsigned*)(ws + WS_CTL) + CW_BAR; unsigned* cnt_ = (unsigned*)(ws + WS_CTL) + CW_Q + 64 * l + 48; XB_SPIN(xb_ld(cnt_) < nbuilders, bar_); }
                __builtin_amdgcn_fence(__ATOMIC_ACQUIRE, "agent"); asm volatile("s_waitcnt vmcnt(0)" ::: "memory");
            }
            rs_load(sl + RS_CH, wave, li, lq, OB); __builtin_amdgcn_sched_barrier(0); if (VAR != 2) { RC_CHUNK(OA, 0, yb); } else { asm volatile("" :: "v"(OA.a01), "v"(OA.bk[3]), "v"(OA.g[3])); }
            rs_load(sn, wave, li, lq, OA); __builtin_amdgcn_sched_barrier(0); if (VAR != 2) { RC_CHUNK(OB, 1, yb); } else { asm volatile("" :: "v"(OB.a01), "v"(OB.bk[3]), "v"(OB.g[3])); }
            RC_BAR();
        }
    } else if (!loader) {
        RC_BAR();
        for (int X = 0; X < NBLK; ++X) RC_BAR();
    } else {
        constexpr int ND = 4;
        RSRegs R[ND]; R3Q Q[ND]; RSOff F; rs_offsets(lt, F);
#pragma unroll
        for (int j = 0; j < ND; ++j) { rs_issue(ws, cub + 2 * j, F, R[j]); r3q_issue(ws, rowb + 32 * j, h, lt, Q[j]); }
        rs_store(lds, F, R[0]); rs_issue(ws, cub + 2 * ND, F, R[0]); rs_store(lds + 2 * RS_CH, F, R[1]); rs_issue(ws, cub + 2 * (ND + 1), F, R[1]);
        RC_BAR();
        for (int bb = 0; bb < NBLK; bb += ND) {
#pragma unroll
            for (int j = 0; j < ND; ++j) { const int X = bb + j;
                if (VAR != 1) { r3_block((j & 1) ? yb0 : yb1, YC, rowb + (size_t)max(X - 1, 0) * 32, h, lt, Q[(j + ND - 1) % ND]);
                r3q_issue(ws, rowb + (size_t)min(X - 1 + ND, NBLK - 1) * 32, h, lt, Q[(j + ND - 1) % ND]); }
                rs_store(lds + ((j + 2) & 3) * 2 * RS_CH, F, R[(j + 2) % ND]);
                rs_issue(ws, cub + 2 * (size_t)min(X + 2 + ND, NBLK - 1), F, R[(j + 2) % ND]);
                RC_BAR();
            }
        }
        r3_block(yb1, YC, rowb + (size_t)(NBLK - 1) * 32, h, lt, Q[(NBLK - 1) % ND]);
    }
}
__device__ __forceinline__ void phase_r3(KArgsP a, int lane, int gw, int ngw, int l) {
    unsigned char* ws = a->ws; const bf16* PROJ = (const bf16*)(ws + WS_PROJ); bf16* YC = (bf16*)(ws + WS_YC);
    const bf16* RA = (const bf16*)(ws + WS_RA); const bf16* RG = (const bf16*)(ws + WS_RG); const bf16* RVG = (const bf16*)(ws + WS_RVG); const bf16* VF = (const bf16*)(ws + WS_VF);
    const float* mu = a->in[I_RMU] + (size_t)l * RW_COLS;
    for (size_t row = gw; row < NTOK; row += ngw) {
#pragma unroll
        for (int h = 0; h < NH; ++h) {
            const int c = h * 64 + lane;
            const float y = bf2f(YC[row * DM + 384 + c]);
            const float m = dpp_allsum(y) * (1.f / 64.f); const float d = y - m; const float var = dpp_allsum(d * d) * (1.f / 64.f);
            const float yn = d * rsqrtf(var + RWKV_GN_EPS) * a->in[I_RLNW][l * DBR + c] + a->in[I_RLNB][l * DBR + c];
            const float rs = rw_shift(PROJ, mu, row, RWC_R + c), ks = rw_shift(PROJ, mu, row, RWC_K + c); float v = rw_shift(PROJ, mu, row, RWC_V + c);
            if (l > 0) v = v + (bf2f(VF[row * DBR + c]) - v) * bf2f(RVG[row * DBR + c]);
            const float av = bf2f(RA[row * DBR + c]);
            const float km = ks * (1.f + (av - 1.f) * a->in[I_RKA][l * DBR + c]);
            const float rk = dpp_allsum(rs * km * a->in[I_RRK][l * DBR + c]);
            YC[row * DM + 384 + c] = (bf16)f2bf((yn + rk * v) * bf2f(RG[row * DBR + c]));
        }
    }
}

constexpr int PH_PER_LAYER = 10, PH_FINAL = 1 + 2 * PH_PER_LAYER, N_PHASES = PH_FINAL + 1;
constexpr int R2_WGS = 24;
__global__ void __launch_bounds__(NTHR, 2) fwd(Args args) {
    extern __shared__ __attribute__((aligned(16))) unsigned char lds_raw[];
    LAS unsigned char* lds = (LAS unsigned char*)lds_raw;
    volatile LAS unsigned* MISC = (volatile LAS unsigned*)(lds + MISC_OFF);
    const int tid0 = threadIdx.x;
    const int G = gridDim.x;
#define PHASE_IDS int tid_ = threadIdx.x; asm volatile("" : "+v"(tid_)); const int tid = tid_, lane = tid & 63, wave = __builtin_amdgcn_readfirstlane(tid >> 6); \
    int bx_ = blockIdx.x; asm volatile("" : "+s"(bx_)); const int bx = bx_; const int vcu = (G % 8 == 0) ? (bx % 8) * (G / 8) + bx / 8 : bx; (void)lane; (void)wave; (void)vcu; (void)bx;
    unsigned char* ws0 = fresh_args()->ws;
    for (int u = tid0; u < (LDS_BYTES - RING_BYTES) / 4; u += NTHR) ((LAS unsigned*)(lds + RING_BYTES))[u] = 0u;
    __syncthreads();
    XcdBarrier bar; bar.bar = (unsigned*)(ws0 + WS_CTL) + CW_BAR; bar.x = 0; bar.st = nullptr;
    if (!MK_PER_PHASE) bar = xcd_barrier_post((unsigned*)(ws0 + WS_CTL) + CW_BAR, MISC + 8);
#if MK_PER_PHASE
    const int lo = args.ph_lo, hi = args.ph_hi;
#define IN(k) (lo <= (k) && (k) < hi)
#else
#define IN(k) true
#endif
#define SEAM(k) do { if (IN(k) && IN((k) + 1)) { XcdBarrier b2 = bar; asm volatile("" : "+s"(b2.bar)); xcd_barrier(b2); } } while (0)

#ifndef GEMM_SP2
#define GEMM_SP2 true
#endif
#ifndef GEMM_ALIGN
#define GEMM_ALIGN true
#endif
#ifndef RS_DEPTH
#define RS_DEPTH 4
#endif
#ifndef R2_SPLIT
#define R2_SPLIT 160
#endif
#ifndef SCANVAR
#define SCANVAR 0
#endif
#ifndef DBL_SUB
#define DBL_SUB 0
#endif
#ifndef DBL_PHASE
#define DBL_PHASE (-1)
#endif
#ifndef REPN
#define REPN 2
#endif
#define SUBREP(k) _Pragma("nounroll") for (int q_ = 0; q_ < 1 + (REPN - 1) * (((k) == DBL_SUB) && l == 0); ++q_)
#define REP(k) for (int rep_ = 0; rep_ < ((k) == DBL_PHASE ? REPN : 1); ++rep_)
#define REPBAR if (rep_ > 0) { XcdBarrier b2 = bar; asm volatile("" : "+s"(b2.bar)); xcd_barrier(b2); }
    REP(0) if (IN(0)) { REPBAR KArgsP ap = fresh_args(); PHASE_IDS
_Pragma("nounroll")
 for (int q_ = 0; q_ < 1 + (REPN - 1) * (DBL_SUB == 12); ++q_) { phase_prologue(ap, lds, tid, lane, wave, vcu, G); __syncthreads(); } }
    SEAM(0);
#ifdef EXTRA_BAR
    for (int eb_ = 0; eb_ < EXTRA_BAR; ++eb_) { XcdBarrier b2 = bar; asm volatile("" : "+s"(b2.bar)); xcd_barrier(b2); }
#endif
#define LCONST 0
    {
        constexpr int l = LCONST; constexpr int pb = 1 + l * PH_PER_LAYER;
        REP(pb + 0) if (IN(pb + 0)) { REPBAR KArgsP ap = fresh_args(); PHASE_IDS unsigned char* ws = ap->ws; (void)ws;
            if (l == 0) { mod_finalize(ws, tid, G); SUBREP(6) { phase_rownorm<0, false>(ap, lds, tid, lane, wave, G, ap->in[I_X], ap->out, ap->in[I_NORM_MIX], true, 0, 0, 0); __syncthreads(); } }
            else {
#if EN_MOE
                phase_rownorm<0, true>(ap, lds, tid, lane, wave, G, ap->out, ap->out, ap->in[I_NORM_MIX] + l * DM, false, l, 0, l - 1);
#else
                phase_rownorm<0, false>(ap, lds, tid, lane, wave, G, ap->out, ap->out, ap->in[I_NORM_MIX] + l * DM, false, l, 0, l - 1);
#endif
            }
        }
        SEAM(pb + 0);
        REP(pb + 1) if (IN(pb + 1)) { REPBAR KArgsP ap = fresh_args(); PHASE_IDS unsigned char* ws = ap->ws; (void)ws;
            pg8::Gemm g{(const pg8::bf16_t*)(ws + WS_HN), (const pg8::bf16_t*)(ws + WS_WIN) + (size_t)l * NPROJ_PAD * DM, NTOK, NPROJ_PAD, DM};
            pg8::StaticOrder S; S.init(NTOK, NPROJ_PAD, G, bx);
            pg8::EpiProj E{(pg8::bf16_t*)(ws + WS_PROJ), (float*)(ws + WS_GATES)};
SUBREP(7) { pg8::gemm_phase<pg8::EpiProj, pg8::StaticOrder, GEMM_ALIGN, GEMM_SP2>(lds, g, S, E); __syncthreads(); }
        }
        SEAM(pb + 1);
        REP(pb + 2) if (IN(pb + 2)) { REPBAR KArgsP ap = fresh_args(); PHASE_IDS unsigned char* ws = ap->ws; (void)ws;
#if EN_MLSTM
            for (int q_ = 0; q_ < 1 + (REPN - 1) * ((DBL_SUB == 1) && l == 0); ++q_) { phase_m1(ap, lds, tid, lane, wave, vcu, G, l); __syncthreads(); }
            __syncthreads();
#endif
#if EN_S5
            phase_s1(ap, lds, tid, lane, wave, vcu, G, l); __syncthreads();
#if DBL_SUB == 2
            if (l == 0) { phase_s1(ap, lds, tid, lane, wave, vcu, G, l); __syncthreads(); phase_s1(ap, lds, tid, lane, wave, vcu, G, l); __syncthreads(); phase_s1(ap, lds, tid, lane, wave, vcu, G, l); __syncthreads(); phase_s1(ap, lds, tid, lane, wave, vcu, G, l); __syncthreads(); }
#endif
            __syncthreads();
#endif
#if EN_RWKV
            for (int q_ = 0; q_ < 1 + (REPN - 1) * ((DBL_SUB == 3) && l == 0); ++q_) { phase_r1(ap, lds, tid, lane, wave, vcu, G, l); __syncthreads(); }
#endif
        }
        SEAM(pb + 2);
        REP(pb + 3) if (IN(pb + 3)) { REPBAR KArgsP ap = fresh_args(); PHASE_IDS unsigned char* ws = ap->ws; (void)ws;
            phase_m2(ws, tid, vcu, G);
            phase_s2(ap, tid, vcu, G, l);
            __syncthreads();
            phase_r2_build(ap, lds, tid, lane, wave, vcu, G, l, 0, R2_SPLIT);
        }
        SEAM(pb + 3);
        REP(pb + 4) if (IN(pb + 4)) { REPBAR KArgsP ap = fresh_args(); PHASE_IDS unsigned char* ws = ap->ws; (void)ws;
            if (bx < R2_WGS) {
#if DBL_SUB == 4
                if (l == 0) { for (int q_ = 0; q_ < REPN - 1; ++q_) { phase_r2_scan<SCANVAR>(ap, lds, tid, lane, wave, bx, l, R2_SPLIT, (unsigned)(G - R2_WGS)); __syncthreads(); } }
#endif
                phase_r2_scan(ap, lds, tid, lane, wave, bx, l, R2_SPLIT, (unsigned)(G - R2_WGS)); __syncthreads(); }
            else {
                phase_r2_build(ap, lds, tid, lane, wave, bx - R2_WGS, G - R2_WGS, l, R2_SPLIT, SEQ / 32 - R2_SPLIT);
                asm volatile("s_waitcnt vmcnt(0)" ::: "memory"); __syncthreads();
                if (tid == 0) { __builtin_amdgcn_fence(__ATOMIC_RELEASE, "agent"); asm volatile("s_waitcnt vmcnt(0)" ::: "memory"); (void)xb_add((unsigned*)(ws + WS_CTL) + CW_Q + 64 * l + 48, 1u); }
                phase_s3(ap, lds, tid, lane, wave, 0, 1, l, (unsigned*)(ws + WS_CTL) + CW_Q + 64 * l + 32); __syncthreads();
            }
            {
                unsigned* qctr = (unsigned*)(ws + WS_CTL) + CW_Q + 64 * l; volatile LAS unsigned* qw = (volatile LAS unsigned*)(lds + MISC_OFF) + 16;
                unsigned nxt = 0u; if (tid == 0) nxt = __hip_atomic_fetch_add(qctr, 1u, __ATOMIC_RELAXED, __HIP_MEMORY_SCOPE_AGENT);
                for (;;) {
                    if (tid == 0) *qw = nxt;
                    __syncthreads();
                    const int u = (int)*qw;
                    __syncthreads();
                    if (u >= NUNIT_M) break;
                    if (tid == 0) nxt = __hip_atomic_fetch_add(qctr, 1u, __ATOMIC_RELAXED, __HIP_MEMORY_SCOPE_AGENT);
                    phase_m3(ap, lds, tid, lane, wave, u, NUNIT_M, l);
                }
            }
        }
        SEAM(pb + 4);
        REP(pb + 6) if (IN(pb + 6)) { REPBAR KArgsP ap = fresh_args(); PHASE_IDS unsigned char* ws = ap->ws; (void)ws;
            pg8::Gemm g{(const pg8::bf16_t*)(ws + WS_YC), (const pg8::bf16_t*)(ws + WS_WOUT) + (size_t)l * DM * DM, NTOK, DM, DM};
            pg8::StaticOrder S; S.init(NTOK, DM, G, bx);
            pg8::EpiResid E{l == 0 ? ap->in[I_X] : (const float*)ap->out, ap->out, (const float*)(ws + WS_MODF) + (size_t)l * 4 * 6144, 2048};
SUBREP(8) { pg8::gemm_phase<pg8::EpiResid, pg8::StaticOrder, GEMM_ALIGN, GEMM_SP2>(lds, g, S, E); __syncthreads(); }
        }
        SEAM(pb + 6);
#if EN_MOE
        REP(pb + 7) if (IN(pb + 7)) { REPBAR KArgsP ap = fresh_args(); PHASE_IDS phase_router(ap, lds, tid, lane, wave, G, l); __syncthreads();
            SUBREP(11) {
            moe_convert13(ap->in[I_MW1], ap->in[I_MW3], l, (bf16*)(ap->ws + WS_W13), vcu * NWAVES + wave, G * NWAVES, (LAS float*)(lds + wave * 16640), lane);
            moe_convert2(ap->in[I_MW2], l, (bf16*)(ap->ws + WS_W2), vcu * NWAVES + wave, G * NWAVES, (LAS float*)(lds + wave * 16640), lane); __syncthreads(); } }
        SEAM(pb + 7);
        REP(pb + 8) if (IN(pb + 8)) { REPBAR KArgsP ap = fresh_args(); PHASE_IDS unsigned char* ws = ap->ws; (void)ws;
            LAS int* ptab = (LAS int*)(lds + PTAB_OFF); LAS int* pst = ptab + 512; LAS int* cnt = pst + 32;
            build_ptab((const unsigned*)(ws + WS_CTL) + CW_CNT + l * 32, ptab, pst, cnt, tid);
            pg8::Gemm g{(const pg8::bf16_t*)(ws + WS_HN), (const pg8::bf16_t*)(ws + WS_W13), 0, 0, DM, (const int*)(ws + WS_LIST), ptab};
            pg8::MoeOrder S{ptab, G, vcu};
            pg8::EpiSwiglu E{(pg8::bf16_t*)(ws + WS_HMID)};
SUBREP(9) { pg8::gemm_phase<pg8::EpiSwiglu, pg8::MoeOrder, false, true, true>(lds, g, S, E); __syncthreads(); }
        }
        SEAM(pb + 8);
        REP(pb + 9) if (IN(pb + 9)) { REPBAR KArgsP ap = fresh_args(); PHASE_IDS unsigned char* ws = ap->ws; (void)ws;
            LAS int* ptab = (LAS int*)(lds + PTAB_OFF); LAS int* pst = ptab + 512; LAS int* cnt = pst + 32;
            build_ptab((const unsigned*)(ws + WS_CTL) + CW_CNT + l * 32, ptab, pst, cnt, tid);
            pg8::Gemm g{(const pg8::bf16_t*)(ws + WS_HMID), (const pg8::bf16_t*)(ws + WS_W2), 0, 0, DEXP};
            pg8::MoeOrder S{ptab, G, vcu};
            pg8::EpiMoeOut E{(pg8::bf16_t*)(ws + WS_YMOE), (const int*)(ws + WS_LIST), ptab};
SUBREP(10) { pg8::gemm_phase<pg8::EpiMoeOut, pg8::MoeOrder, true, true>(lds, g, S, E); __syncthreads(); }
        }
        SEAM(pb + 9);
#else
        SEAM(pb + 6); SEAM(pb + 7); SEAM(pb + 8); SEAM(pb + 9);
#endif
    }
#undef LCONST
#if N_LAYERS > 1
#define LCONST 1
    {
        constexpr int l = LCONST; constexpr int pb = 1 + l * PH_PER_LAYER;
        REP(pb + 0) if (IN(pb + 0)) { REPBAR KArgsP ap = fresh_args(); PHASE_IDS unsigned char* ws = ap->ws; (void)ws;
            if (l == 0) { mod_finalize(ws, tid, G); SUBREP(6) { phase_rownorm<0, false>(ap, lds, tid, lane, wave, G, ap->in[I_X], ap->out, ap->in[I_NORM_MIX], true, 0, 0, 0); __syncthreads(); } }
            else {
#if EN_MOE
                phase_rownorm<0, true>(ap, lds, tid, lane, wave, G, ap->out, ap->out, ap->in[I_NORM_MIX] + l * DM, false, l, 0, l - 1);
#else
                phase_rownorm<0, false>(ap, lds, tid, lane, wave, G, ap->out, ap->out, ap->in[I_NORM_MIX] + l * DM, false, l, 0, l - 1);
#endif
            }
        }
        SEAM(pb + 0);
        REP(pb + 1) if (IN(pb + 1)) { REPBAR KArgsP ap = fresh_args(); PHASE_IDS unsigned char* ws = ap->ws; (void)ws;
            pg8::Gemm g{(const pg8::bf16_t*)(ws + WS_HN), (const pg8::bf16_t*)(ws + WS_WIN) + (size_t)l * NPROJ_PAD * DM, NTOK, NPROJ_PAD, DM};
            pg8::StaticOrder S; S.init(NTOK, NPROJ_PAD, G, bx);
            pg8::EpiProj E{(pg8::bf16_t*)(ws + WS_PROJ), (float*)(ws + WS_GATES)};
SUBREP(7) { pg8::gemm_phase<pg8::EpiProj, pg8::StaticOrder, GEMM_ALIGN, GEMM_SP2>(lds, g, S, E); __syncthreads(); }
        }
        SEAM(pb + 1);
        REP(pb + 2) if (IN(pb + 2)) { REPBAR KArgsP ap = fresh_args(); PHASE_IDS unsigned char* ws = ap->ws; (void)ws;
#if EN_MLSTM
            for (int q_ = 0; q_ < 1 + (REPN - 1) * ((DBL_SUB == 1) && l == 0); ++q_) { phase_m1(ap, lds, tid, lane, wave, vcu, G, l); __syncthreads(); }
            __syncthreads();
#endif
#if EN_S5
            phase_s1(ap, lds, tid, lane, wave, vcu, G, l); __syncthreads();
#if DBL_SUB == 2
            if (l == 0) { phase_s1(ap, lds, tid, lane, wave, vcu, G, l); __syncthreads(); phase_s1(ap, lds, tid, lane, wave, vcu, G, l); __syncthreads(); phase_s1(ap, lds, tid, lane, wave, vcu, G, l); __syncthreads(); phase_s1(ap, lds, tid, lane, wave, vcu, G, l); __syncthreads(); }
#endif
            __syncthreads();
#endif
#if EN_RWKV
            for (int q_ = 0; q_ < 1 + (REPN - 1) * ((DBL_SUB == 3) && l == 0); ++q_) { phase_r1(ap, lds, tid, lane, wave, vcu, G, l); __syncthreads(); }
#endif
        }
        SEAM(pb + 2);
        REP(pb + 3) if (IN(pb + 3)) { REPBAR KArgsP ap = fresh_args(); PHASE_IDS unsigned char* ws = ap->ws; (void)ws;
            phase_m2(ws, tid, vcu, G);
            phase_s2(ap, tid, vcu, G, l);
            __syncthreads();
            phase_r2_build(ap, lds, tid, lane, wave, vcu, G, l, 0, R2_SPLIT);
        }
        SEAM(pb + 3);
        REP(pb + 4) if (IN(pb + 4)) { REPBAR KArgsP ap = fresh_args(); PHASE_IDS unsigned char* ws = ap->ws; (void)ws;
            if (bx < R2_WGS) {
#if DBL_SUB == 4
                if (l == 0) { for (int q_ = 0; q_ < REPN - 1; ++q_) { phase_r2_scan<SCANVAR>(ap, lds, tid, lane, wave, bx, l, R2_SPLIT, (unsigned)(G - R2_WGS)); __syncthreads(); } }
#endif
                phase_r2_scan(ap, lds, tid, lane, wave, bx, l, R2_SPLIT, (unsigned)(G - R2_WGS)); __syncthreads(); }
            else {
                phase_r2_build(ap, lds, tid, lane, wave, bx - R2_WGS, G - R2_WGS, l, R2_SPLIT, SEQ / 32 - R2_SPLIT);
                asm volatile("s_waitcnt vmcnt(0)" ::: "memory"); __syncthreads();
                if (tid == 0) { __builtin_amdgcn_fence(__ATOMIC_RELEASE, "agent"); asm volatile("s_waitcnt vmcnt(0)" ::: "memory"); (void)xb_add((unsigned*)(ws + WS_CTL) + CW_Q + 64 * l + 48, 1u); }
                phase_s3(ap, lds, tid, lane, wave, 0, 1, l, (unsigned*)(ws + WS_CTL) + CW_Q + 64 * l + 32); __syncthreads();
            }
            {
                unsigned* qctr = (unsigned*)(ws + WS_CTL) + CW_Q + 64 * l; volatile LAS unsigned* qw = (volatile LAS unsigned*)(lds + MISC_OFF) + 16;
                unsigned nxt = 0u; if (tid == 0) nxt = __hip_atomic_fetch_add(qctr, 1u, __ATOMIC_RELAXED, __HIP_MEMORY_SCOPE_AGENT);
                for (;;) {
                    if (tid == 0) *qw = nxt;
                    __syncthreads();
                    const int u = (int)*qw;
                    __syncthreads();
                    if (u >= NUNIT_M) break;
                    if (tid == 0) nxt = __hip_atomic_fetch_add(qctr, 1u, __ATOMIC_RELAXED, __HIP_MEMORY_SCOPE_AGENT);
                    phase_m3(ap, lds, tid, lane, wave, u, NUNIT_M, l);
                }
            }
        }
        SEAM(pb + 4);
        REP(pb + 6) if (IN(pb + 6)) { REPBAR KArgsP ap = fresh_args(); PHASE_IDS unsigned char* ws = ap->ws; (void)ws;
            pg8::Gemm g{(const pg8::bf16_t*)(ws + WS_YC), (const pg8::bf16_t*)(ws + WS_WOUT) + (size_t)l * DM * DM, NTOK, DM, DM};
            pg8::StaticOrder S; S.init(NTOK, DM, G, bx);
            pg8::EpiResid E{l == 0 ? ap->in[I_X] : (const float*)ap->out, ap->out, (const float*)(ws + WS_MODF) + (size_t)l * 4 * 6144, 2048};
SUBREP(8) { pg8::gemm_phase<pg8::EpiResid, pg8::StaticOrder, GEMM_ALIGN, GEMM_SP2>(lds, g, S, E); __syncthreads(); }
        }
        SEAM(pb + 6);
#if EN_MOE
        REP(pb + 7) if (IN(pb + 7)) { REPBAR KArgsP ap = fresh_args(); PHASE_IDS phase_router(ap, lds, tid, lane, wave, G, l); __syncthreads();
            SUBREP(11) {
            moe_convert13(ap->in[I_MW1], ap->in[I_MW3], l, (bf16*)(ap->ws + WS_W13), vcu * NWAVES + wave, G * NWAVES, (LAS float*)(lds + wave * 16640), lane);
            moe_convert2(ap->in[I_MW2], l, (bf16*)(ap->ws + WS_W2), vcu * NWAVES + wave, G * NWAVES, (LAS float*)(lds + wave * 16640), lane); __syncthreads(); } }
        SEAM(pb + 7);
        REP(pb + 8) if (IN(pb + 8)) { REPBAR KArgsP ap = fresh_args(); PHASE_IDS unsigned char* ws = ap->ws; (void)ws;
            LAS int* ptab = (LAS int*)(lds + PTAB_OFF); LAS int* pst = ptab + 512; LAS int* cnt = pst + 32;
            build_ptab((const unsigned*)(ws + WS_CTL) + CW_CNT + l * 32, ptab, pst, cnt, tid);
            pg8::Gemm g{(const pg8::bf16_t*)(ws + WS_HN), (const pg8::bf16_t*)(ws + WS_W13), 0, 0, DM, (const int*)(ws + WS_LIST), ptab};
            pg8::MoeOrder S{ptab, G, vcu};
            pg8::EpiSwiglu E{(pg8::bf16_t*)(ws + WS_HMID)};
SUBREP(9) { pg8::gemm_phase<pg8::EpiSwiglu, pg8::MoeOrder, false, true, true>(lds, g, S, E); __syncthreads(); }
        }
        SEAM(pb + 8);
        REP(pb + 9) if (IN(pb + 9)) { REPBAR KArgsP ap = fresh_args(); PHASE_IDS unsigned char* ws = ap->ws; (void)ws;
            LAS int* ptab = (LAS int*)(lds + PTAB_OFF); LAS int* pst = ptab + 512; LAS int* cnt = pst + 32;
            build_ptab((const unsigned*)(ws + WS_CTL) + CW_CNT + l * 32, ptab, pst, cnt, tid);
            pg8::Gemm g{(const pg8::bf16_t*)(ws + WS_HMID), (const pg8::bf16_t*)(ws + WS_W2), 0, 0, DEXP};
            pg8::MoeOrder S{ptab, G, vcu};
            pg8::EpiMoeOut E{(pg8::bf16_t*)(ws + WS_YMOE), (const int*)(ws + WS_LIST), ptab};
SUBREP(10) { pg8::gemm_phase<pg8::EpiMoeOut, pg8::MoeOrder, true, true>(lds, g, S, E); __syncthreads(); }
        }
        SEAM(pb + 9);
#else
        SEAM(pb + 6); SEAM(pb + 7); SEAM(pb + 8); SEAM(pb + 9);
#endif
    }
#undef LCONST
#endif
    if (IN(PH_FINAL)) { KArgsP ap = fresh_args(); PHASE_IDS
#if EN_MOE
        if (N_LAYERS > 0) phase_rownorm<1, true>(ap, lds, tid, lane, wave, G, ap->out, ap->out, ap->in[I_NORM_FINAL], false, 0, 0, N_LAYERS - 1);
        else phase_rownorm<1, false>(ap, lds, tid, lane, wave, G, ap->in[I_X], ap->out, ap->in[I_NORM_FINAL], false, 0, 0, 0);
#else
        phase_rownorm<1, false>(ap, lds, tid, lane, wave, G, N_LAYERS > 0 ? (const float*)ap->out : ap->in[I_X], ap->out, ap->in[I_NORM_FINAL], false, 0, 0, 0);
#endif
    }
#undef IN
#undef SEAM
}

extern "C" void kernel_launch(void* const* d_in, const int* in_sizes, int n_in, void* d_out, int out_size, void* d_ws, size_t ws_size, hipStream_t stream) {
    static int grid = 0;
    if (grid == 0) {
        if (n_in != 47 || out_size != NTOK * DM || ws_size < WS_END) { fprintf(stderr, "kernel_launch: unexpected problem (n_in %d, out %d, ws %zu < %zu)\n", n_in, out_size, ws_size, (size_t)WS_END); grid = -1; return; }
        int dev = 0, cus = 0, per_cu = 0;
        if (hipGetDevice(&dev) != hipSuccess || hipDeviceGetAttribute(&cus, hipDeviceAttributeMultiprocessorCount, dev) != hipSuccess) { grid = -1; return; }
        if (hipFuncSetAttribute((const void*)fwd, hipFuncAttributeMaxDynamicSharedMemorySize, LDS_BYTES) != hipSuccess) { fprintf(stderr, "kernel_launch: hipFuncSetAttribute failed\n"); grid = -1; return; }
        if (hipOccupancyMaxActiveBlocksPerMultiprocessor(&per_cu, (const void*)fwd, NTHR, LDS_BYTES) != hipSuccess || per_cu < 1) fprintf(stderr, "kernel_launch: occupancy query says %d\n", per_cu);
        (void)hipGetLastError();
        grid = cus;
        if (grid != 256) fprintf(stderr, "kernel_launch: %d CUs (built for 256)\n", grid);
    }
    if (grid < 0) return;
    (void)hipMemsetAsync((char*)d_ws + WS_CTL, 0, CTL_ZERO_BYTES, stream);
    Args a{};
    for (int i = 0; i < 47; ++i) a.in[i] = (const float*)d_in[i];
    a.out = (float*)d_out; a.ws = (unsigned char*)d_ws;
#if MK_PER_PHASE
    for (int p = 0; p < N_PHASES; ++p) { a.ph_lo = p; a.ph_hi = p + 1; hipLaunchKernelGGL(fwd, dim3(grid), dim3(NTHR), LDS_BYTES, stream, a); }
#else
    a.ph_lo = 0; a.ph_hi = N_PHASES; hipLaunchKernelGGL(fwd, dim3(grid), dim3(NTHR), LDS_BYTES, stream, a);
#endif
}
#ifdef DIAG_KERNELS
#define DK(name, ...) __global__ void __launch_bounds__(NTHR, 2) name(Args args) { extern __shared__ __attribute__((aligned(16))) unsigned char lds_raw[]; LAS unsigned char* lds = (LAS unsigned char*)lds_raw; \
    const int tid = threadIdx.x, lane = tid & 63, wave = __builtin_amdgcn_readfirstlane(tid >> 6); const int G = gridDim.x; const int bx = blockIdx.x; const int vcu = bx; KArgsP ap = fresh_args(); int l = ap->ph_lo; (void)lane; (void)wave; (void)vcu; (void)G; (void)l; __VA_ARGS__ }
DK(k_prologue, phase_prologue(ap, lds, tid, lane, wave, vcu, G);)
DK(k_norm0, phase_rownorm<0, false>(ap, lds, tid, lane, wave, G, ap->in[I_X], ap->out, ap->in[I_NORM_MIX], true, 0, 0, 0);)
DK(k_norm1, phase_rownorm<0, true>(ap, lds, tid, lane, wave, G, ap->out, ap->out, ap->in[I_NORM_MIX], false, l, 0, 0);)
DK(k_normf, phase_rownorm<1, true>(ap, lds, tid, lane, wave, G, ap->out, ap->out, ap->in[I_NORM_MIX], false, l, 0, 0);)
DK(k_m1, phase_m1(ap, lds, tid, lane, wave, vcu, G, l);)
DK(k_m2, phase_m2(ap->ws, tid, vcu, G);)
DK(k_m3, phase_m3(ap, lds, tid, lane, wave, vcu, G, l);)
DK(k_s1, phase_s1(ap, lds, tid, lane, wave, vcu, G, l);)
DK(k_s2, phase_s2(ap, tid, vcu, G, l);)
DK(k_s3, phase_s3(ap, lds, tid, lane, wave, vcu, G, l);)
DK(k_r1, phase_r1(ap, lds, tid, lane, wave, vcu, G, l);)
DK(k_r2b, phase_r2_build(ap, lds, tid, lane, wave, vcu, G, l);)
DK(k_r2s, phase_r2_scan(ap, lds, tid, lane, wave, vcu, l);)
DK(k_r3, phase_r3(ap, lane, vcu * NWAVES + wave, G * NWAVES, l);)
DK(k_router, phase_router(ap, lds, tid, lane, wave, G, l);)
DK(k_gather, phase_gather(ap, lds, tid, lane, wave, vcu, G, l);)
DK(k_moecv, moe_convert13(ap->in[I_MW1], ap->in[I_MW3], 1, (bf16*)(ap->ws + WS_W13), vcu * NWAVES + wave, G * NWAVES, (LAS float*)(lds + wave * 16640), lane);)
#endif
```

```cpp
#include <hip/hip_runtime.h>
#include <cstdio>
#include <cstdint>
#define MK_PER_PHASE 0

#ifndef MK_PER_PHASE
#define MK_PER_PHASE 0
#endif
#ifndef EN_MLSTM
#define EN_MLSTM 1
#endif
#ifndef EN_S5
#define EN_S5 1
#endif
#ifndef EN_RWKV
#define EN_RWKV 1
#endif
#ifndef EN_MOE
#define EN_MOE 1
#endif
#ifndef N_LAYERS
#define N_LAYERS 2
#endif
constexpr int NWAVES = 8, NTHR = 512;
constexpr int DM = 1024, NB = 4, SEQ = 8192, NTOK = NB * SEQ;
constexpr int DA = 384, DBR = 384, DC = 256, NH = 6, HD = 64, NCH = SEQ / 64;
constexpr int IN_COLS = 2828, NPROJ = 2816, NPROJ_PAD = 3072;
constexpr int PC_QK = 0, PC_V = 384, PC_O = 768, PC_RW = 1152, PC_S5 = 2560;
constexpr int RWC_R = 0, RWC_K = 384, RWC_V = 768, RWC_WD = 1152, RWC_AD = 1216, RWC_GD = 1280, RW_COLS = 1408;
constexpr int NEXP = 32, DEXP = 512, MOE_ROWS_MAX = 73728;
constexpr int NUNIT_M = NB * NCH * NH;
constexpr int CL_STRIDE = 4160;
constexpr float NORM_EPS = 1e-6f, HEAD_NORM_EPS = 1e-5f, RWKV_GN_EPS = 64e-5f;

constexpr size_t MiB = 1u << 20;
constexpr size_t WS_CTL = 0, CTL_ZERO_BYTES = 1 * MiB;
constexpr size_t WS_MODP = 1 * MiB;
constexpr size_t WS_MODF = 2 * MiB + 512 * 1024;
constexpr size_t WS_S5BB = 2 * MiB + 896 * 1024;
constexpr size_t WS_RTW = 3 * MiB;
constexpr size_t WS_S5AP = 3 * MiB + 384 * 1024;
constexpr size_t WS_MLW = 3 * MiB + 512 * 1024;
constexpr size_t WS_S5CM = 2 * MiB + 768 * 1024;
constexpr size_t WS_GLUT = 3 * MiB + 768 * 1024;
constexpr size_t WS_WIN = 4 * MiB;
constexpr size_t WS_WOUT = 16 * MiB;
constexpr size_t WS_GATES = 20 * MiB;
constexpr size_t WS_W13 = 22 * MiB;
constexpr size_t WS_W2 = 86 * MiB;
constexpr size_t WS_HN = 118 * MiB;
constexpr size_t WS_CLOC = 118 * MiB;
constexpr size_t WS_MSC = 168 * MiB;
constexpr size_t WS_S5ST = 170 * MiB;
constexpr size_t WS_VF = 182 * MiB;
constexpr size_t WS_YC = 206 * MiB;
constexpr size_t WS_LIST = 206 * MiB;
constexpr size_t WS_ROWMAP = 214 * MiB;
constexpr size_t WS_TOKE = 215 * MiB;
constexpr size_t WS_TOKW = 215 * MiB + 512 * 1024;
constexpr size_t WS_PROJ = 270 * MiB;
constexpr size_t WS_RE = 446 * MiB, WS_RA = 470 * MiB, WS_RG = 494 * MiB, WS_RVG = 518 * MiB;
constexpr size_t WS_XG = 270 * MiB;
constexpr size_t WS_HMID = 414 * MiB;
constexpr size_t WS_YMOE = 270 * MiB;
constexpr size_t WS_R1W = 542 * MiB;
constexpr size_t WS_OPA = 22 * MiB;
constexpr size_t WS_OPB = 543 * MiB;
constexpr size_t WS_END = 591 * MiB;
constexpr int CW_TMO = 0, CW_BAR = 4096, CW_CNT = 8192, CW_Q = 8320;

constexpr int RING_BYTES = 131072, MISC_OFF = 135168, PTAB_OFF = MISC_OFF + 1024, LDS_BYTES = 147456;

#define GAS __attribute__((address_space(1)))
#define LAS __attribute__((address_space(3)))
typedef unsigned short bf16;
typedef unsigned v4u __attribute__((ext_vector_type(4)));
typedef unsigned v2u __attribute__((ext_vector_type(2)));
typedef float f32x4 __attribute__((ext_vector_type(4)));
typedef float f32x2 __attribute__((ext_vector_type(2)));
typedef GAS unsigned gu32;
#define RLX_AGENT __ATOMIC_RELAXED, __HIP_MEMORY_SCOPE_AGENT
#define LDS_WAIT() asm volatile("s_waitcnt lgkmcnt(0)" ::: "memory")
#define VM_WAIT() asm volatile("s_waitcnt vmcnt(0)" ::: "memory")
typedef float f32x2v __attribute__((ext_vector_type(2)));
typedef __bf16 bf16x2v __attribute__((ext_vector_type(2)));
__device__ __forceinline__ unsigned pk2(float lo, float hi) { const f32x2v v = {lo, hi}; const bf16x2v b = __builtin_convertvector(v, bf16x2v); return __builtin_bit_cast(unsigned, b); }
__device__ __forceinline__ unsigned f2bf(float f) { return pk2(f, 0.f) & 0xffffu; }
__device__ __forceinline__ float bf2f(unsigned v) { return __builtin_bit_cast(float, v << 16); }
__device__ __forceinline__ float bflo(unsigned w) { return __builtin_bit_cast(float, w << 16); }
__device__ __forceinline__ float bfhi(unsigned w) { return __builtin_bit_cast(float, w & 0xffff0000u); }
__device__ __forceinline__ float sigmoidf_(float x) { return 1.f / (1.f + __expf(-x)); }
__device__ __forceinline__ float wave_sum(float v) {
#pragma unroll
    for (int o = 1; o < 64; o <<= 1) v += __shfl_xor(v, o);
    return v;
}
__device__ __forceinline__ float wave_max(float v) {
#pragma unroll
    for (int o = 1; o < 64; o <<= 1) v = fmaxf(v, __shfl_xor(v, o));
    return v;
}
namespace pg8 {
#define PG8_LAS __attribute__((address_space(3)))
typedef unsigned short bf16_t;
typedef short bf16x8 __attribute__((ext_vector_type(8)));
typedef float f32x4 __attribute__((ext_vector_type(4)));
typedef unsigned u32x4 __attribute__((ext_vector_type(4)));
constexpr int BM = 256, BK = 64, HALF = 128, HTB = HALF * BK * 2  , STAGE_BYTES = 8 * HTB, NXCD = 8, WGM = 8;

__host__ __device__ __forceinline__ int lds_byte(int r, int c) { const int st = (r >> 4) * 2 + (c >> 5), rr = r & 15, cc = c & 31, ob = rr * 64 + cc * 2; return st * 1024 + (ob ^ (((ob >> 9) & 1) << 5)); }
__host__ __device__ __forceinline__ void stage_rc(int b, int& R, int& C) { const int st = b / 1024, sb = b % 1024, swz = sb ^ (((sb >> 9) & 1) << 5); R = (st >> 1) * 16 + swz / 64; C = (st & 1) * 32 + (swz % 64) / 2; }
__host__ __device__ __forceinline__ int perm32(int rho) { const int n = rho >> 4, i = rho & 15; return 8 * (i >> 2) + 4 * n + (i & 3); }

struct Unit { int pm, pn; };
__device__ __forceinline__ int moe_tok2(const int* list, PG8_LAS const int* ptab, int row) { const int e = ptab[1 + (row >> 8)], pos = row - ptab[512 + e]; return pos < ptab[544 + e] ? list[(size_t)e * 65536 + pos] : -1; }
struct Gemm { const bf16_t* A; const bf16_t* Bt; int M, N, K; const int* list = nullptr; PG8_LAS const int* ptab = nullptr; };

struct StaticOrder {
    int nM, nN, nwg, G, c;
    __host__ __device__ void init(int M, int N, int G_, int c_) { nM = M / BM; nN = N / BM; nwg = nM * nN; G = G_; c = c_; }
    __host__ __device__ bool next(int i, Unit& u) const {
        const long L = (long)i * G + c; if (L >= nwg) return false;
        int wgid = (int)L; { const int q = nwg / NXCD, r = nwg % NXCD, xcd = wgid % NXCD, off = wgid / NXCD; wgid = (xcd < r ? xcd * (q + 1) : r * (q + 1) + (xcd - r) * q) + off; }
        const int nig = WGM * nN, gid = wgid / nig, fm = gid * WGM, gsz = (nM - fm) < WGM ? (nM - fm) : WGM;
        u.pm = fm + ((wgid % nig) % gsz); u.pn = (wgid % nig) / gsz; return true;
    }
    __device__ __forceinline__ void a_ready(const Unit&) const {}
    __device__ __forceinline__ void done(const Unit&) const {}
};

__device__ __forceinline__ unsigned cvt_pk_bf16(float lo, float hi) { unsigned r; asm volatile("v_cvt_pk_bf16_f32 %0, %1, %2" : "=v"(r) : "v"(lo), "v"(hi)); return r; }

struct EpiProj {
    static constexpr bool PERM = true, AFTER_DRAIN = false;
    bf16_t* O; float* G;
    __device__ __forceinline__ void operator()(const f32x4 (&acc)[2][2][4][2], const Unit& u, int wr, int wc, int fr, int fq) const {
        const int row0 = u.pm * BM + wr * 64 + fr;
        if (u.pn < 11) {
            const int col0 = u.pn * BM + wc * 32 + 8 * fq;
#pragma unroll
            for (int ai = 0; ai < 2; ++ai)
#pragma unroll
                for (int m = 0; m < 4; ++m) { bf16_t* rowp = O + (size_t)(row0 + ai * HALF + m * 16) * 2816 + col0;
#pragma unroll
                    for (int bj = 0; bj < 2; ++bj) { const f32x4 v0 = acc[ai][bj][m][0], v1 = acc[ai][bj][m][1];
                        u32x4 w; w.x = cvt_pk_bf16(v0[0], v0[1]); w.y = cvt_pk_bf16(v0[2], v0[3]); w.z = cvt_pk_bf16(v1[0], v1[1]); w.w = cvt_pk_bf16(v1[2], v1[3]);
                        *(u32x4*)(rowp + bj * HALF) = w; } }
        } else if (wc == 0 && fq < 2) {
#pragma unroll
            for (int ai = 0; ai < 2; ++ai)
#pragma unroll
                for (int m = 0; m < 4; ++m) { float* rowp = G + (size_t)(row0 + ai * HALF + m * 16) * 16 + 8 * fq;
                    *(f32x4*)(rowp) = acc[ai][0][m][0]; *(f32x4*)(rowp + 4) = acc[ai][0][m][1]; }
        }
    }
};
struct EpiResid {
    static constexpr bool PERM = true, AFTER_DRAIN = false;
    const float* xin; float* out; const float* gate;
    int goff;
    __device__ __forceinline__ void operator()(const f32x4 (&acc)[2][2][4][2], const Unit& u, int wr, int wc, int fr, int fq) const {
        const int row0 = u.pm * BM + wr * 64 + fr, col0 = u.pn * BM + wc * 32 + 8 * fq;
        const float* gp = gate + (size_t)(row0 >> 13) * 6144 + goff + col0;
        f32x4 g[2][2];
#pragma unroll
        for (int bj = 0; bj < 2; ++bj)
#pragma unroll
            for (int n = 0; n < 2; ++n) g[bj][n] = *(const f32x4*)(gp + bj * HALF + 4 * n) + 1.0f;
#pragma unroll
        for (int ai = 0; ai < 2; ++ai) { f32x4 xv[4][2][2];
#pragma unroll
            for (int m = 0; m < 4; ++m) { const size_t off = (size_t)(row0 + ai * HALF + m * 16) * 1024 + col0;
#pragma unroll
                for (int bj = 0; bj < 2; ++bj)
#pragma unroll
                    for (int n = 0; n < 2; ++n) xv[m][bj][n] = *(const f32x4*)(xin + off + bj * HALF + 4 * n); }
#pragma unroll
            for (int m = 0; m < 4; ++m) { const size_t off = (size_t)(row0 + ai * HALF + m * 16) * 1024 + col0;
#pragma unroll
                for (int bj = 0; bj < 2; ++bj)
#pragma unroll
                    for (int n = 0; n < 2; ++n) *(f32x4*)(out + off + bj * HALF + 4 * n) = xv[m][bj][n] + g[bj][n] * acc[ai][bj][m][n]; } }
    }
};
struct EpiSwiglu {
    static constexpr bool PERM = true, AFTER_DRAIN = false;
    bf16_t* H;
    __device__ __forceinline__ void operator()(const f32x4 (&acc)[2][2][4][2], const Unit& u, int wr, int wc, int fr, int fq) const {
        const int row0 = u.pm * BM + wr * 64 + fr, hid0 = 128 * (u.pn & 3) + 16 * wc + 4 * fq;
#pragma unroll
        for (int ai = 0; ai < 2; ++ai)
#pragma unroll
            for (int m = 0; m < 4; ++m) { bf16_t* rowp = H + (size_t)(row0 + ai * HALF + m * 16) * 512 + hid0;
#pragma unroll
                for (int bj = 0; bj < 2; ++bj) { const f32x4 g = acc[ai][bj][m][0], uu = acc[ai][bj][m][1]; float h[4];
#pragma unroll
                    for (int i = 0; i < 4; ++i) h[i] = g[i] / (1.f + __expf(-g[i])) * uu[i];
                    unsigned w0 = cvt_pk_bf16(h[0], h[1]), w1 = cvt_pk_bf16(h[2], h[3]);
                    *(unsigned long long*)(rowp + 64 * bj) = (unsigned long long)w0 | ((unsigned long long)w1 << 32); } }
    }
};
struct EpiMoeOut {
    static constexpr bool PERM = true, AFTER_DRAIN = false;
    bf16_t* Y; const int* list; PG8_LAS const int* ptab;
    __device__ __forceinline__ void operator()(const f32x4 (&acc)[2][2][4][2], const Unit& u, int wr, int wc, int fr, int fq) const {
        const int row0 = u.pm * BM + wr * 64 + fr, col0 = (u.pn & 3) * BM + wc * 32 + 8 * fq;
        int dsts[2][4];
#pragma unroll
        for (int ai = 0; ai < 2; ++ai)
#pragma unroll
            for (int m = 0; m < 4; ++m) dsts[ai][m] = moe_tok2(list, ptab, row0 + ai * HALF + m * 16);
#pragma unroll
        for (int ai = 0; ai < 2; ++ai)
#pragma unroll
            for (int m = 0; m < 4; ++m) { const int dst = dsts[ai][m];
                if (dst >= 0) { bf16_t* rowp = Y + (size_t)dst * 1024 + col0;
#pragma unroll
                    for (int bj = 0; bj < 2; ++bj) { const f32x4 v0 = acc[ai][bj][m][0], v1 = acc[ai][bj][m][1];
                        u32x4 w; w.x = cvt_pk_bf16(v0[0], v0[1]); w.y = cvt_pk_bf16(v0[2], v0[3]); w.z = cvt_pk_bf16(v1[0], v1[1]); w.w = cvt_pk_bf16(v1[2], v1[3]);
                        *(u32x4*)(rowp + bj * HALF) = w; } } }
    }
};
struct MoeOrder {
    PG8_LAS const int* ptab; int G, c;
    __device__ __forceinline__ bool next(int i, Unit& u) const {
        const int L = i * G + c, np = __builtin_amdgcn_readfirstlane(ptab[0]);
        if (L >= np * 4) return false;
        const int p = L >> 2; u.pm = p; u.pn = __builtin_amdgcn_readfirstlane(ptab[1 + p]) * 4 + (L & 3); return true;
    }
    __device__ __forceinline__ void a_ready(const Unit&) const {}
    __device__ __forceinline__ void done(const Unit&) const {}
};
template <class Epi, class Sched, bool ALIGN_EPI = false, bool SP2 = false, bool GATHER = false>
__device__ __forceinline__ void gemm_phase(PG8_LAS unsigned char* lds, const Gemm g, const Sched& S, const Epi& E) {
    int tid_ = threadIdx.x; asm volatile("" : "+v"(tid_));
    const int tid = tid_, wid = __builtin_amdgcn_readfirstlane(tid >> 6), lane = tid & 63, wr = wid >> 2, wc = wid & 3, fr = lane & 15, fq = lane >> 4;
    const int K = g.K, nt = K / BK;
    static_assert(!GATHER || SP2, "the gathered-A variant exists for the SP2 loop only");
    unsigned voffA[2], voffB[2];
    unsigned vAc[2] = {0u, 0u}, vAn[2] = {0u, 0u};
#pragma unroll
    for (int i = 0; i < 2; ++i) { int R, C; stage_rc(tid * 16 + i * 8192, R, C); const int Rb = Epi::PERM ? ((R & ~31) + perm32(R & 31)) : R;
        voffA[i] = (unsigned)(R * K + C) * 2u; voffB[i] = (unsigned)(Rb * K + C) * 2u; }
    const size_t kstep = (size_t)(BK * 2);
    const size_t hstep = (size_t)HALF * K * 2;
    const size_t tstep = 2 * hstep;
    const unsigned ldsw = (unsigned)wid * 1024u;
    const int aoff = lds_byte(wr * 64 + fr, fq * 8), boff = lds_byte(wc * 32 + fr, fq * 8);
#define PG8_SA(b, h) (((b) * 2 + (h)) * HTB)
#define PG8_SB(b, h) ((4 + (b) * 2 + (h)) * HTB)
#define PG8_STAGE(bufoff, gbase, voff) do { _Pragma("unroll") for (int _i = 0; _i < 2; ++_i) \
        __builtin_amdgcn_global_load_lds((const unsigned*)((const char*)(gbase) + (voff)[_i]), (PG8_LAS unsigned*)(lds + (bufoff) + ldsw + _i * 8192), 16, 0, 0); } while (0)
#define PG8_STAGEG(bufoff, base, pk) do { unsigned vg_[2]; _Pragma("unroll") for (int i_ = 0; i_ < 2; ++i_) { int R_, C_; stage_rc(tid * 16 + i_ * 8192, R_, C_); vg_[i_] = (((pk) >> (16 * i_)) & 0xffffu) * (unsigned)(2 * K) + (unsigned)(2 * C_); } PG8_STAGE(bufoff, base, vg_); } while (0)
#define PG8_STAGEA(bufoff, base, hh, nx) do { if constexpr (GATHER) { const unsigned pk_ = (nx) ? vAn[hh] : vAc[hh]; PG8_STAGEG(bufoff, base, pk_); } else PG8_STAGE(bufoff, (base) + (hh) * hstep, voffA); } while (0)
#define PG8_GOFF(dst, unit) do { _Pragma("unroll") for (int hh_ = 0; hh_ < 2; ++hh_) { unsigned pk_ = 0u; _Pragma("unroll") for (int i_ = 0; i_ < 2; ++i_) { int R_, C_; stage_rc(tid * 16 + i_ * 8192, R_, C_); \
        const int t2_ = moe_tok2(g.list, g.ptab, (unit).pm * BM + hh_ * HALF + R_); pk_ |= (unsigned)(t2_ < 0 ? 0 : (t2_ >> 1)) << (16 * i_); } dst[hh_] = pk_; } } while (0)
#define PG8_LDA(dst, b, h) do { _Pragma("unroll") for (int m = 0; m < 4; ++m) _Pragma("unroll") for (int k = 0; k < 2; ++k) dst[m][k] = *(const PG8_LAS bf16x8*)(lds + PG8_SA(b, h) + aoff + m * 2048 + k * 1024); } while (0)
#define PG8_LDB(dst, b, h) do { _Pragma("unroll") for (int n = 0; n < 2; ++n) _Pragma("unroll") for (int k = 0; k < 2; ++k) dst[n][k] = *(const PG8_LAS bf16x8*)(lds + PG8_SB(b, h) + boff + n * 2048 + k * 1024); } while (0)
#define PG8_MMA(ai, bj, At, Bt) do { __builtin_amdgcn_s_setprio(1); _Pragma("unroll") for (int m = 0; m < 4; ++m) _Pragma("unroll") for (int n = 0; n < 2; ++n) _Pragma("unroll") for (int k = 0; k < 2; ++k) \
        acc[ai][bj][m][n] = __builtin_amdgcn_mfma_f32_16x16x32_bf16(Bt[n][k], At[m][k], acc[ai][bj][m][n], 0, 0, 0); __builtin_amdgcn_s_setprio(0); } while (0)
#define PG8_WAIT_V(n) asm volatile("s_waitcnt vmcnt(" #n ")" ::: "memory")
#define PG8_WAIT_L(n) asm volatile("s_waitcnt lgkmcnt(" #n ")" ::: "memory")
#define PG8_BAR __builtin_amdgcn_s_barrier()
#define PG8_SCHED __builtin_amdgcn_sched_barrier(0)
    Unit cur, nxt; int ui = 0;
    if (!S.next(0, cur)) return;
    f32x4 acc[2][2][4][2];
#pragma unroll
    for (int a = 0; a < 2; ++a)
#pragma unroll
        for (int b = 0; b < 2; ++b)
#pragma unroll
            for (int m = 0; m < 4; ++m)
#pragma unroll
                for (int n = 0; n < 2; ++n) acc[a][b][m][n] = (f32x4){0.f, 0.f, 0.f, 0.f};
    bf16x8 At[4][2], B0[2][2], B1[2][2];
    const char* cA = (const char*)g.A + (GATHER ? (size_t)0 : (size_t)cur.pm * tstep); const char* cB = (const char*)g.Bt + (size_t)cur.pn * tstep;
    if constexpr (GATHER) { PG8_GOFF(vAc, cur); }
    S.a_ready(cur);
    if constexpr (SP2) {
        PG8_STAGE(PG8_SB(0, 0), cB, voffB); PG8_STAGE(PG8_SB(0, 1), cB + hstep, voffB); PG8_STAGEA(PG8_SA(0, 0), cA, 0, false); PG8_STAGEA(PG8_SA(0, 1), cA, 1, false);
        if (wr == 1) PG8_BAR;
        PG8_WAIT_V(2); PG8_BAR;
        PG8_STAGE(PG8_SB(1, 0), cB + kstep, voffB); PG8_STAGEA(PG8_SA(1, 0), cA + kstep, 0, false); PG8_STAGE(PG8_SB(1, 1), cB + hstep + kstep, voffB);
        PG8_WAIT_V(6); PG8_BAR;
    } else {
        PG8_STAGE(PG8_SB(0, 0), cB, voffB); PG8_STAGE(PG8_SA(0, 0), cA, voffA); PG8_STAGE(PG8_SB(0, 1), cB + hstep, voffB); PG8_STAGE(PG8_SA(0, 1), cA + hstep, voffA);
        if (wr == 1) PG8_BAR;
        PG8_WAIT_V(4); PG8_BAR;
        PG8_STAGE(PG8_SB(1, 0), cB + kstep, voffB); PG8_STAGE(PG8_SA(1, 0), cA + kstep, voffA); PG8_STAGE(PG8_SB(1, 1), cB + hstep + kstep, voffB);
        PG8_WAIT_V(6); PG8_BAR;
    }
    for (;;) {
        const bool has_next = S.next(ui + 1, nxt);
        const char* nA = (has_next && !GATHER) ? (const char*)g.A + (size_t)nxt.pm * tstep : cA;
        if constexpr (GATHER) { if (has_next) { PG8_GOFF(vAn, nxt); } else { vAn[0] = vAc[0]; vAn[1] = vAc[1]; } } const char* nB = has_next ? (const char*)g.Bt + (size_t)nxt.pn * tstep : cB;
        for (int t = 0; t < nt; t += 2) {
            const bool last = (t == nt - 2);
            const char* a1 = cA + (size_t)(t + 1) * kstep;
            const char* a2 = last ? nA : cA + (size_t)(t + 2) * kstep; const char* b2 = last ? nB : cB + (size_t)(t + 2) * kstep;
            const char* a3 = a2 + kstep; const char* b3 = b2 + kstep;
            if (last && has_next) S.a_ready(nxt);
            if constexpr (SP2) {
            PG8_LDB(B0, 0, 0); PG8_LDB(B1, 0, 1); PG8_SCHED; PG8_LDA(At, 0, 0); PG8_STAGEA(PG8_SA(1, 1), a1, 1, false);
            PG8_WAIT_V(8); PG8_WAIT_L(0); PG8_BAR; PG8_MMA(0, 0, At, B0); PG8_MMA(0, 1, At, B1); PG8_BAR; PG8_SCHED;
            PG8_LDA(At, 0, 1); PG8_STAGE(PG8_SB(0, 0), b2, voffB); PG8_STAGE(PG8_SB(0, 1), b2 + hstep, voffB); PG8_STAGEA(PG8_SA(0, 0), a2, 0, last);
            PG8_WAIT_V(8); PG8_WAIT_L(0); PG8_BAR; PG8_MMA(1, 0, At, B0); PG8_MMA(1, 1, At, B1); PG8_BAR; PG8_SCHED;
            PG8_LDB(B0, 1, 0); PG8_LDB(B1, 1, 1); PG8_SCHED; PG8_LDA(At, 1, 0); PG8_STAGEA(PG8_SA(0, 1), a2, 1, last);
            PG8_WAIT_V(8); PG8_WAIT_L(0); PG8_BAR; PG8_MMA(0, 0, At, B0); PG8_MMA(0, 1, At, B1); PG8_BAR; PG8_SCHED;
            PG8_LDA(At, 1, 1); PG8_STAGE(PG8_SB(1, 0), b3, voffB); PG8_STAGE(PG8_SB(1, 1), b3 + hstep, voffB); PG8_STAGEA(PG8_SA(1, 0), a3, 0, last);
            PG8_WAIT_V(8); PG8_WAIT_L(0); PG8_BAR; PG8_MMA(1, 0, At, B0); PG8_MMA(1, 1, At, B1); PG8_BAR; PG8_SCHED;
            } else {
            PG8_LDB(B0, 0, 0); PG8_SCHED; PG8_LDA(At, 0, 0); PG8_STAGE(PG8_SA(1, 1), a1 + hstep, voffA);
            PG8_WAIT_L(8); PG8_BAR; PG8_WAIT_L(0); PG8_MMA(0, 0, At, B0); PG8_BAR; PG8_SCHED;
            PG8_LDB(B1, 0, 1); PG8_STAGE(PG8_SB(0, 0), b2, voffB);
            PG8_BAR; PG8_WAIT_L(0); PG8_MMA(0, 1, At, B1); PG8_BAR;
            PG8_LDA(At, 0, 1); PG8_STAGE(PG8_SA(0, 0), a2, voffA);
            PG8_BAR; PG8_WAIT_L(0); PG8_MMA(1, 0, At, B0); PG8_BAR; PG8_SCHED;
            PG8_STAGE(PG8_SB(0, 1), b2 + hstep, voffB);
            PG8_WAIT_V(6); PG8_BAR; PG8_MMA(1, 1, At, B1); PG8_BAR;
            PG8_LDB(B0, 1, 0); PG8_SCHED; PG8_LDA(At, 1, 0); PG8_STAGE(PG8_SA(0, 1), a2 + hstep, voffA);
            PG8_WAIT_L(8); PG8_BAR; PG8_WAIT_L(0); PG8_MMA(0, 0, At, B0); PG8_BAR; PG8_SCHED;
            PG8_LDB(B1, 1, 1); PG8_STAGE(PG8_SB(1, 0), b3, voffB);
            PG8_BAR; PG8_WAIT_L(0); PG8_MMA(0, 1, At, B1); PG8_BAR;
            PG8_LDA(At, 1, 1); PG8_STAGE(PG8_SA(1, 0), a3, voffA);
            PG8_BAR; PG8_WAIT_L(0); PG8_MMA(1, 0, At, B0); PG8_BAR; PG8_SCHED;
            PG8_STAGE(PG8_SB(1, 1), b3 + hstep, voffB);
            PG8_WAIT_V(6); PG8_BAR; PG8_MMA(1, 1, At, B1); PG8_BAR;
            }
        }
        if constexpr (ALIGN_EPI) { if (wr == 0) PG8_BAR; }
        if constexpr (!Epi::AFTER_DRAIN) { E(acc, cur, wr, wc, fr, fq); S.done(cur); }
        if (!has_next) break;
#pragma unroll
        for (int a = 0; a < 2; ++a)
#pragma unroll
            for (int b = 0; b < 2; ++b)
#pragma unroll
                for (int m = 0; m < 4; ++m)
#pragma unroll
                    for (int n = 0; n < 2; ++n) acc[a][b][m][n] = (f32x4){0.f, 0.f, 0.f, 0.f};
        cur = nxt; cA = nA; cB = nB; ++ui;
        if constexpr (GATHER) { vAc[0] = vAn[0]; vAc[1] = vAn[1]; }
        if constexpr (ALIGN_EPI) { if (wr == 1) PG8_BAR; }
    }
    PG8_WAIT_V(0);
    if constexpr (!ALIGN_EPI) { if (wr == 0) PG8_BAR; }
    PG8_BAR;
    if constexpr (Epi::AFTER_DRAIN) { E.fused(acc, cur, wr, wc, fr, fq, lds, wid, lane); S.done(cur); }
#undef PG8_SA
#undef PG8_SB
#undef PG8_STAGE
#undef PG8_STAGEA
#undef PG8_STAGEG
#undef PG8_GOFF
#undef PG8_LDA
#undef PG8_LDB
#undef PG8_MMA
#undef PG8_WAIT_V
#undef PG8_WAIT_L
#undef PG8_BAR
#undef PG8_SCHED
}
}
#define XB_TMO      128
#define XB_XCNT(j)  (256  + 64 * (j))
#define XB_XSUB(j)  (1280 + 64 * (j))
#define XB_XGEN(j)  (2304 + 64 * (j))
#define XB_TOP      3328
#define XB_TOPGEN   3392
#define XCD_BAR_WORDS 3456
#define XB_SPIN_CAP (1u << 18)
#define LAS __attribute__((address_space(3)))

__device__ __forceinline__ unsigned xb_ld(unsigned* p)              { return __hip_atomic_load(p, __ATOMIC_RELAXED, __HIP_MEMORY_SCOPE_AGENT); }
__device__ __forceinline__ unsigned xb_add(unsigned* p, unsigned v) { return __hip_atomic_fetch_add(p, v, __ATOMIC_RELAXED, __HIP_MEMORY_SCOPE_AGENT); }
__device__ __forceinline__ unsigned xb_xcc_id() { return (unsigned)__builtin_amdgcn_s_getreg((3 << 11) | 20) & 0xFu; }
#define XB_SPIN(cond, bar) do { unsigned _sp = 0; while (cond) { __builtin_amdgcn_s_sleep(1); \
    if ((++_sp & 255u) == 0u) { if (xb_ld(&(bar)[XB_TMO])) break; if (_sp > XB_SPIN_CAP) { atomicAdd(&(bar)[XB_TMO], 1u); break; } } } } while (0)

struct XcdBarrier {
    unsigned* bar; unsigned x;
    volatile LAS unsigned* st;
};

__device__ __forceinline__ XcdBarrier xcd_barrier_post(unsigned* bar, volatile LAS unsigned* st) {
    XcdBarrier b; b.bar = bar; b.x = xb_xcc_id(); b.st = st;
    if (threadIdx.x == 0) (void)xb_add(&bar[XB_XCNT(b.x)], 1u);
    return b;
}
__device__ __forceinline__ void xcd_barrier_complete(unsigned* bar, unsigned x, unsigned& nloc, unsigned& nx) {
    const unsigned G = gridDim.x * gridDim.y * gridDim.z;
    unsigned sum, cnt, mine, sp = 0u;
    for (;;) {
        sum = 0u; cnt = 0u; mine = 0u;
#pragma unroll
        for (unsigned j = 0; j < 16; ++j) { const unsigned c = xb_ld(&bar[XB_XCNT(j)]); sum += c; cnt += (c > 0u) ? 1u : 0u; mine = (j == x) ? c : mine; }
        if (sum == G) break;
        __builtin_amdgcn_s_sleep(1);
        if ((++sp & 255u) == 0u) { if (xb_ld(&bar[XB_TMO])) break; if (sp > XB_SPIN_CAP) { atomicAdd(&bar[XB_TMO], 1u); break; } }
    }
    nloc = mine > 0u ? mine : 1u; nx = cnt > 0u ? cnt : 1u;
}

__device__ __forceinline__ void xcd_barrier(const XcdBarrier& b) {
    asm volatile("s_waitcnt vmcnt(0)" ::: "memory");
    __syncthreads();
    if (threadIdx.x == 0) {
        unsigned* bar = b.bar;
        __builtin_amdgcn_s_waitcnt(0);
        unsigned nloc = b.st[0], nx = b.st[1];
        if (nloc == 0u) { xcd_barrier_complete(bar, b.x, nloc, nx); b.st[0] = nloc; b.st[1] = nx; }
        const unsigned old = xb_add(&bar[XB_XSUB(b.x)], 1u);
        const unsigned gen = old / nloc;
        if (old + 1u == (gen + 1u) * nloc) {
            __builtin_amdgcn_fence(__ATOMIC_RELEASE, "agent");
            asm volatile("s_waitcnt vmcnt(0)" ::: "memory");
            const unsigned og = xb_add(&bar[XB_TOP], 1u);
            const unsigned tg = og / nx;
            if (og + 1u == (tg + 1u) * nx) xb_add(&bar[XB_TOPGEN], 1u);
            else XB_SPIN(xb_ld(&bar[XB_TOPGEN]) == tg, bar);
            __builtin_amdgcn_fence(__ATOMIC_ACQUIRE, "agent");
            xb_add(&bar[XB_XGEN(b.x)], 1u);
            asm volatile("s_waitcnt vmcnt(0)" ::: "memory");
        } else {
            XB_SPIN(xb_ld(&bar[XB_XGEN(b.x)]) == gen, bar);
            __builtin_amdgcn_fence(__ATOMIC_ACQUIRE, "agent");
            asm volatile("s_waitcnt vmcnt(0)" ::: "memory");
        }
    }
    __syncthreads();
}

struct Args { const float* in[47]; float* out; unsigned char* ws; int ph_lo, ph_hi; };
typedef const __attribute__((address_space(4))) Args* KArgsP;
__device__ __forceinline__ KArgsP fresh_args() { KArgsP p = (KArgsP)__builtin_amdgcn_kernarg_segment_ptr(); asm volatile("" : "+s"(p)); return p; }
enum { I_X = 0, I_C, I_ADA_W, I_ADA_B, I_NORM_MIX, I_NORM_FFN, I_NORM_FINAL, I_W_IN, I_W_OUT, I_CONV_W, I_CONV_B, I_WQ, I_WK, I_BI, I_BF, I_MNORM_W,
       I_RMU, I_RW0, I_RWUP, I_RA0, I_RAUP, I_RGUP, I_RKK, I_RKA, I_RRK, I_RLNW, I_RLNB, I_RV0, I_RVDN, I_RVUP,
       I_S5ARE, I_S5AIM, I_S5LDT, I_S5BRE, I_S5BIM, I_S5CRE, I_S5CIM, I_S5D, I_S5GLUW, I_S5GLUB,
       I_MWRG, I_MBRG, I_MWRE, I_MBRE, I_MW1, I_MW3, I_MW2 };

struct RmWin { __device__ __forceinline__ int operator()(int n) const { return n < 1152 ? n : (n < 1164 ? 2816 + (n - 1152) : (n < 2572 ? 1152 + (n - 1164) : 2560 + (n - 2572))); } };
struct RmId  { __device__ __forceinline__ int operator()(int n) const { return n; } };
struct RmGU  { int add; __device__ __forceinline__ int operator()(int n) const { return 8 * (n >> 2) + (n & 3) + add; } };
template <class RM>
__device__ __forceinline__ void transpose_item(const float* W, int ldw, int ncols, int k0, int n0, bf16* WT, int ldt, LAS float* scr, int lane, const RM rm) {
    if (n0 + 64 <= ncols && (ldw & 3) == 0) {
        const float* src = W + (size_t)(k0 + (lane >> 4)) * ldw + n0 + 4 * (lane & 15);
        f32x4 v[16];
#pragma unroll
        for (int i = 0; i < 16; ++i) v[i] = *(const GAS f32x4*)(src + (size_t)(4 * i) * ldw);
#pragma unroll
        for (int i = 0; i < 16; ++i) { LAS float* d = scr + (4 * i + (lane >> 4)) * 65 + 4 * (lane & 15); d[0] = v[i][0]; d[1] = v[i][1]; d[2] = v[i][2]; d[3] = v[i][3]; }
    } else {
    const int nn = n0 + lane; const bool ok = nn < ncols; const float* src = W + (size_t)k0 * ldw + (ok ? nn : n0);
    float v[64];
#pragma unroll
    for (int kk = 0; kk < 64; ++kk) v[kk] = src[(size_t)kk * ldw];
#pragma unroll
    for (int kk = 0; kk < 64; ++kk) scr[kk * 65 + lane] = v[kk];
    }
    LDS_WAIT(); asm volatile("" ::: "memory");
    const int c = lane & 7;
#pragma unroll
    for (int j = 0; j < 8; ++j) { const int nl = (lane >> 3) + 8 * j; const LAS float* s = scr + (8 * c) * 65 + nl;
        v4u o; o.x = pk2(s[0 * 65], s[1 * 65]); o.y = pk2(s[2 * 65], s[3 * 65]); o.z = pk2(s[4 * 65], s[5 * 65]); o.w = pk2(s[6 * 65], s[7 * 65]);
        if (n0 + nl < ncols) *(GAS v4u*)(WT + (size_t)rm(n0 + nl) * ldt + k0 + 8 * c) = o; }
    LDS_WAIT(); asm volatile("" ::: "memory");
}
__device__ __forceinline__ void moe_convert13(const float* w1, const float* w3, int l, bf16* W13, int worker, int nworkers, LAS float* scr, int lane) {
    for (int it = worker; it < NEXP * 256; it += nworkers) {
        const int e = it >> 8, r = it & 255; const size_t eo = (size_t)(l * NEXP + e) * DM * DEXP;
        if (r < 128) transpose_item(w1 + eo, DEXP, DEXP, 64 * (r >> 3), 64 * (r & 7), W13 + (size_t)e * 1024 * 1024, 1024, scr, lane, RmGU{0});
        else         transpose_item(w3 + eo, DEXP, DEXP, 64 * ((r - 128) >> 3), 64 * ((r - 128) & 7), W13 + (size_t)e * 1024 * 1024, 1024, scr, lane, RmGU{4});
    }
}
__device__ __forceinline__ void moe_convert2(const float* w2, int l, bf16* W2T, int worker, int nworkers, LAS float* scr, int lane) {
    for (int it = worker; it < NEXP * 128; it += nworkers) {
        const int e = it >> 7, r = it & 127; const size_t eo = (size_t)(l * NEXP + e) * DM * DEXP;
        transpose_item(w2 + eo, DM, DM, 64 * (r >> 4), 64 * (r & 15), W2T + (size_t)e * 1024 * 512, 512, scr, lane, RmId{});
    }
}
__device__ __forceinline__ void phase_prologue(KArgsP a, LAS unsigned char* lds, int tid, int lane, int wave, int vcu, int G) {
    unsigned char* ws = a->ws;
    LAS float* scr = (LAS float*)(lds + wave * 16640);
    const int gw = vcu * NWAVES + wave, NGW = G * NWAVES;
    bf16* WIN = (bf16*)(ws + WS_WIN); bf16* WOUT = (bf16*)(ws + WS_WOUT);
    for (int it = gw; it < 2 * 16 * 45; it += NGW) { const int l = it / (16 * 45), r = it % (16 * 45);
        transpose_item(a->in[I_W_IN] + (size_t)l * DM * IN_COLS, IN_COLS, IN_COLS, 64 * (r / 45), 64 * (r % 45), WIN + (size_t)l * NPROJ_PAD * DM, DM, scr, lane, RmWin{}); }
    for (int it = gw; it < 2 * 16 * 16; it += NGW) { const int l = it / 256, r = it % 256;
        transpose_item(a->in[I_W_OUT] + (size_t)l * DM * DM, DM, DM, 64 * (r >> 4), 64 * (r & 15), WOUT + (size_t)l * DM * DM, DM, scr, lane, RmId{}); }
    for (int it = gw; it < 2 * 244; it += NGW) { const int l = it / 244, r = 2828 + it % 244; GAS v4u* p = (GAS v4u*)(WIN + ((size_t)l * NPROJ_PAD + r) * DM);
        p[lane] = (v4u){0u, 0u, 0u, 0u}; p[lane + 64] = (v4u){0u, 0u, 0u, 0u}; }
    { float* RTW = (float*)(ws + WS_RTW);
      for (int idx = (vcu * NTHR + tid); idx < 2 * 1024 * 48; idx += G * NTHR) { const int j = idx % 48, k = (idx / 48) % 1024, l = idx / (48 * 1024);
          RTW[(size_t)l * 49152 + ((k >> 2) * 16 + (j & 15)) * 12 + (k & 3) * 3 + (j >> 4)] = j < 4 ? a->in[I_MWRG][(size_t)(l * 1024 + k) * 4 + j] : (j < 36 ? a->in[I_MWRE][(size_t)(l * 1024 + k) * 32 + (j - 4)] : 0.f); } }
    { bf16* RW = (bf16*)(ws + WS_R1W);
      for (int idx = (vcu * NTHR + tid); idx < 2 * 98304 + 24576; idx += G * NTHR) { float v;
          if (idx < 2 * 98304) { const int l = idx / 98304, r = idx % 98304;
              if (r < 24576)      v = a->in[I_RWUP][(size_t)l * 64 * DBR + (r & 63) * DBR + (r >> 6)];
              else if (r < 49152) v = a->in[I_RAUP][(size_t)l * 64 * DBR + ((r - 24576) & 63) * DBR + ((r - 24576) >> 6)];
              else                v = a->in[I_RGUP][(size_t)l * 128 * DBR + ((r - 49152) & 127) * DBR + ((r - 49152) >> 7)];
          } else { const int r = idx - 2 * 98304;
              if (r < 12288) v = a->in[I_RVDN][(size_t)(r % 384) * 32 + (r / 384)];
              else           v = a->in[I_RVUP][(size_t)((r - 12288) & 31) * DBR + ((r - 12288) >> 5)]; }
          RW[idx] = (bf16)f2bf(v); } }
    for (int idx = (vcu * NTHR + tid); idx < 2 * 16 * 64; idx += G * NTHR) { const int p = idx & 63, lg = idx >> 6;
        const float lam_re = a->in[I_S5ARE][idx], lam_im = a->in[I_S5AIM][idx]; const float dt = expf(a->in[I_S5LDT][lg]); const float mag = expf(lam_re * dt), ang = lam_im * dt;
        const float are = mag * cosf(ang), aim = mag * sinf(ang); const float inv = 1.f / (lam_re * lam_re + lam_im * lam_im);
        const float cre = ((are - 1.f) * lam_re + aim * lam_im) * inv, cim = (aim * lam_re - (are - 1.f) * lam_im) * inv;
        ((float*)(ws + WS_S5AP))[idx * 2] = are; ((float*)(ws + WS_S5AP))[idx * 2 + 1] = aim;
        const float* br = a->in[I_S5BRE] + (size_t)idx * 16; const float* bi = a->in[I_S5BIM] + (size_t)idx * 16; bf16* o = (bf16*)(ws + WS_S5BB) + ((size_t)lg * 128 + 2 * p) * 16;
        for (int c = 0; c < 16; ++c) { o[c] = (bf16)f2bf(cre * br[c] - cim * bi[c]); o[16 + c] = (bf16)f2bf(cre * bi[c] + cim * br[c]); } }
    { bf16* CM = (bf16*)(ws + WS_S5CM);
      for (int idx = (vcu * NTHR + tid); idx < 2 * 16 * 16 * 128; idx += G * NTHR) { const int k = idx & 127, lgc = idx >> 7;
          CM[idx] = (bf16)f2bf((k & 1) ? -a->in[I_S5CIM][(size_t)lgc * 64 + (k >> 1)] : a->in[I_S5CRE][(size_t)lgc * 64 + (k >> 1)]); } }
    for (int it = gw; it < 2 * 16; it += NGW) { const int l = it >> 4, r = it & 15;
        transpose_item(a->in[I_S5GLUW] + (size_t)l * DC * DC, DC, DC, 64 * (r >> 2), 64 * (r & 3), (bf16*)(ws + WS_GLUT) + (size_t)l * DC * DC, DC, scr, lane, RmId{}); }
    { bf16* MLW = (bf16*)(ws + WS_MLW);
      for (int idx = (vcu * NTHR + tid); idx < 2 * NH * 2 * 4096; idx += G * NTHR) { const int d = idx & 63, e = (idx >> 6) & 63, which = (idx >> 12) & 1, lh = idx >> 13;
          MLW[idx] = (bf16)f2bf(a->in[which ? I_WK : I_WQ][(size_t)lh * 4096 + d * 64 + e]); } }
    __syncthreads();
    if (vcu < 192) {
        const int q = vcu, l = q / 96, cb = (q >> 3) % 12, kc = q & 7;
        LAS float* cond = (LAS float*)lds;
        { const int b = tid >> 7, kk = tid & 127; const float cv = a->in[I_C][b * DM + kc * 128 + kk]; cond[tid] = cv / (1.f + __expf(-cv)); }
        __syncthreads();
        const int col = cb * 512 + tid; const float* wp = a->in[I_ADA_W] + ((size_t)l * DM + kc * 128) * 6144 + col;
        float acc0 = 0.f, acc1 = 0.f, acc2 = 0.f, acc3 = 0.f;
#pragma unroll 8
        for (int kk = 0; kk < 128; ++kk) { const float w = wp[(size_t)kk * 6144]; acc0 += cond[kk] * w; acc1 += cond[128 + kk] * w; acc2 += cond[256 + kk] * w; acc3 += cond[384 + kk] * w; }
        const float bias = (kc == 0) ? a->in[I_ADA_B][l * 6144 + col] : 0.f;
        float* MP = (float*)(ws + WS_MODP) + ((size_t)(kc * 2 + l) * 4) * 6144 + col;
        MP[0] = acc0 + bias; MP[6144] = acc1 + bias; MP[2 * 6144] = acc2 + bias; MP[3 * 6144] = acc3 + bias;
    }
}

__device__ __forceinline__ float modval(const unsigned char* ws, bool part, int l, int b, int idx) {
    if (!part) return ((const float*)(ws + WS_MODF))[(size_t)(l * 4 + b) * 6144 + idx];
    const float* mp = (const float*)(ws + WS_MODP) + (size_t)(l * 4 + b) * 6144 + idx; float s = 0.f;
#pragma unroll
    for (int kc = 0; kc < 8; ++kc) s += mp[(size_t)kc * 2 * 4 * 6144];
    return s;
}
template <int MODE, bool COMBINE>
__device__ __forceinline__ void phase_rownorm(KArgsP a, LAS unsigned char* lds, int tid, int lane, int wave, int G,
                                              const float* xsrc, float* xdst, const float* gvec, bool part, int l, int isc  , int lprev) {
    unsigned char* ws = a->ws;
    LAS float* sc = (LAS float*)lds; LAS float* sh = sc + 1024; LAS float* gt = sh + 1024;
    bf16* HN = (bf16*)(ws + WS_HN); const bf16* YM = (const bf16*)(ws + WS_YMOE); const float* TW = (const float*)(ws + WS_TOKW);
    for (int c = blockIdx.x; c < NTOK / 128; c += G) {
        const int b = c >> 6;
        __syncthreads();
        for (int j = tid; j < 1024; j += NTHR) {
            if (MODE == 0) { sc[j] = gvec[j] * (1.f + modval(ws, part, l, b, (isc + 1) * 1024 + j)); sh[j] = modval(ws, part, l, b, isc * 1024 + j); }
            else { sc[j] = gvec[j]; sh[j] = 0.f; }
            if (COMBINE) gt[j] = 1.f + modval(ws, false, lprev, b, 5 * 1024 + j);
        }
        __syncthreads();
        f32x4 vn[4]; v2u yn0[4], yn1[4]; float wn0 = 0.f, wn1 = 0.f;
        { const int row = c * 128 + wave * 16; const GAS f32x4* xr = (const GAS f32x4*)(xsrc + (size_t)row * DM) + lane;
#pragma unroll
          for (int j = 0; j < 4; ++j) vn[j] = xr[64 * j];
          if (COMBINE) { wn0 = TW[2 * row]; wn1 = TW[2 * row + 1]; const GAS v2u* y0 = (const GAS v2u*)(YM + (size_t)(2 * row) * DM) + lane; const GAS v2u* y1 = (const GAS v2u*)(YM + (size_t)(2 * row + 1) * DM) + lane;
#pragma unroll
              for (int j = 0; j < 4; ++j) { yn0[j] = y0[64 * j]; yn1[j] = y1[64 * j]; } } }
        for (int i = 0; i < 16; ++i) {
            const int row = c * 128 + wave * 16 + i;
            f32x4 v[4]; v2u q0[4], q1[4]; const float w0 = wn0, w1 = wn1;
#pragma unroll
            for (int j = 0; j < 4; ++j) { v[j] = vn[j]; q0[j] = yn0[j]; q1[j] = yn1[j]; }
            if (i + 1 < 16) { const int rn = row + 1; const GAS f32x4* xr = (const GAS f32x4*)(xsrc + (size_t)rn * DM) + lane;
#pragma unroll
                for (int j = 0; j < 4; ++j) vn[j] = xr[64 * j];
                if (COMBINE) { wn0 = TW[2 * rn]; wn1 = TW[2 * rn + 1]; const GAS v2u* y0 = (const GAS v2u*)(YM + (size_t)(2 * rn) * DM) + lane; const GAS v2u* y1 = (const GAS v2u*)(YM + (size_t)(2 * rn + 1) * DM) + lane;
#pragma unroll
                    for (int j = 0; j < 4; ++j) { yn0[j] = y0[64 * j]; yn1[j] = y1[64 * j]; } } }
            if (COMBINE) {
#pragma unroll
                for (int j = 0; j < 4; ++j) { const v2u p0 = q0[j], p1 = q1[j]; const f32x4 g4 = *(const LAS f32x4*)(gt + lane * 4 + 256 * j);
                    f32x4 m; m.x = w0 * bflo(p0.x) + w1 * bflo(p1.x); m.y = w0 * bfhi(p0.x) + w1 * bfhi(p1.x); m.z = w0 * bflo(p0.y) + w1 * bflo(p1.y); m.w = w0 * bfhi(p0.y) + w1 * bfhi(p1.y);
                    v[j] = v[j] + g4 * m; }
                if (MODE == 0) { GAS f32x4* xo = (GAS f32x4*)(xdst + (size_t)row * DM) + lane;
#pragma unroll
                    for (int j = 0; j < 4; ++j) xo[64 * j] = v[j]; }
            }
            float ss = 0.f;
#pragma unroll
            for (int j = 0; j < 4; ++j) ss += (v[j].x * v[j].x + v[j].y * v[j].y) + (v[j].z * v[j].z + v[j].w * v[j].w);
            const float rstd = rsqrtf(wave_sum(ss) * (1.f / DM) + NORM_EPS);
            if (MODE == 0) {
                GAS v2u* o = (GAS v2u*)(HN + (size_t)row * DM) + lane;
#pragma unroll
                for (int j = 0; j < 4; ++j) { const f32x4 s4 = *(const LAS f32x4*)(sc + lane * 4 + 256 * j), h4 = *(const LAS f32x4*)(sh + lane * 4 + 256 * j); const f32x4 h = v[j] * rstd * s4 + h4;
                    v2u w; w.x = pk2(h.x, h.y); w.y = pk2(h.z, h.w); o[64 * j] = w; }
            } else {
                GAS f32x4* o = (GAS f32x4*)(xdst + (size_t)row * DM) + lane;
#pragma unroll
                for (int j = 0; j < 4; ++j) { const f32x4 s4 = *(const LAS f32x4*)(sc + lane * 4 + 256 * j); o[64 * j] = v[j] * rstd * s4; }
            }
        }
    }
}
__device__ __forceinline__ void mod_finalize(unsigned char* ws, int tid, int G) {
    float* MF = (float*)(ws + WS_MODF);
    for (int idx = blockIdx.x * NTHR + tid; idx < 2 * 4 * 6144; idx += G * NTHR) { const float* mp = (const float*)(ws + WS_MODP) + idx; float s = 0.f;
#pragma unroll
        for (int kc = 0; kc < 8; ++kc) s += mp[(size_t)kc * 2 * 4 * 6144];
        MF[idx] = s; }
}

typedef float f32x4m __attribute__((ext_vector_type(4)));
__device__ __forceinline__ void phase_router(KArgsP a, LAS unsigned char* lds, int tid, int lane, int wave, int G, int l) {
    unsigned char* ws = a->ws;
    LAS float* sc = (LAS float*)lds; LAS float* sh = sc + 1024; LAS float* rstd_s = sh + 1024  ; LAS float* cvec = rstd_s + 128  ; LAS float* cpart = cvec + 64  ;
    LAS float* lg = cpart + 8 * 48  ; LAS int* hist = (LAS int*)(lg + 8 * 16 * 48)  ; LAS int* basev = hist + 32; LAS int* asg_e = basev + 32  ; LAS int* asg_lp = asg_e + 256;
    bf16* HN = (bf16*)(ws + WS_HN); const float* x = a->out; const float* RTW = (const float*)(ws + WS_RTW) + (size_t)l * 1024 * 48;
    int* TOKE = (int*)(ws + WS_TOKE); float* TOKW = (float*)(ws + WS_TOKW); int* LIST = (int*)(ws + WS_LIST); unsigned* CNT = (unsigned*)(ws + WS_CTL) + CW_CNT + l * 32;
    const float* gvec = a->in[I_NORM_FFN] + l * DM;
    for (int c = blockIdx.x; c < NTOK / 128; c += G) {
        const int b = c >> 6;
        __syncthreads();
        for (int j = tid; j < 1024; j += NTHR) { sc[j] = gvec[j] * (1.f + modval(ws, false, l, b, 4 * 1024 + j)); sh[j] = modval(ws, false, l, b, 3 * 1024 + j); }
        if (tid < 32) hist[tid] = 0;
        __syncthreads();
        if (tid < 128) { const int i16 = tid & 15, part = tid >> 4; float s0 = 0.f, s1 = 0.f, s2 = 0.f;
#pragma unroll 1
            for (int kg = part * 32; kg < part * 32 + 32; kg += 4) { f32x4 w[4][3];
#pragma unroll
                for (int q = 0; q < 4; ++q) { const GAS f32x4* wp = (const GAS f32x4*)(RTW + (size_t)((kg + q) * 16 + i16) * 12); w[q][0] = wp[0]; w[q][1] = wp[1]; w[q][2] = wp[2]; }
#pragma unroll
                for (int q = 0; q < 4; ++q) { const f32x4 h = *(const LAS f32x4*)(sh + 4 * (kg + q));
                    const float wf[12] = {w[q][0][0], w[q][0][1], w[q][0][2], w[q][0][3], w[q][1][0], w[q][1][1], w[q][1][2], w[q][1][3], w[q][2][0], w[q][2][1], w[q][2][2], w[q][2][3]};
#pragma unroll
                    for (int jj = 0; jj < 4; ++jj) { s0 = fmaf(h[jj], wf[3 * jj], s0); s1 = fmaf(h[jj], wf[3 * jj + 1], s1); s2 = fmaf(h[jj], wf[3 * jj + 2], s2); } } }
            cpart[part * 48 + i16] = s0; cpart[part * 48 + 16 + i16] = s1; cpart[part * 48 + 32 + i16] = s2; }
        { f32x4 vn[4];
          { const GAS f32x4* xr = (const GAS f32x4*)(x + (size_t)(c * 128 + wave * 16) * DM) + lane;
#pragma unroll
            for (int j = 0; j < 4; ++j) vn[j] = xr[64 * j]; }
          for (int i = 0; i < 16; ++i) {
            const int row = c * 128 + wave * 16 + i;
            f32x4 v[4]; float ss = 0.f;
#pragma unroll
            for (int j = 0; j < 4; ++j) { v[j] = vn[j]; ss += (v[j].x * v[j].x + v[j].y * v[j].y) + (v[j].z * v[j].z + v[j].w * v[j].w); }
            if (i + 1 < 16) { const GAS f32x4* xr = (const GAS f32x4*)(x + (size_t)(row + 1) * DM) + lane;
#pragma unroll
                for (int j = 0; j < 4; ++j) vn[j] = xr[64 * j]; }
            const float rstd = rsqrtf(wave_sum(ss) * (1.f / DM) + NORM_EPS);
            if (lane == 0) rstd_s[wave * 16 + i] = rstd;
            GAS v2u* o = (GAS v2u*)(HN + (size_t)row * DM) + lane;
#pragma unroll
            for (int j = 0; j < 4; ++j) { const f32x4 s4 = *(const LAS f32x4*)(sc + lane * 4 + 256 * j), h4 = *(const LAS f32x4*)(sh + lane * 4 + 256 * j); const f32x4 h = v[j] * rstd * s4 + h4;
                v2u w; w.x = pk2(h.x, h.y); w.y = pk2(h.z, h.w); o[64 * j] = w; }
          } }
        __syncthreads();
        if (tid < 48) { float s = 0.f;
#pragma unroll
            for (int p = 0; p < 8; ++p) s += cpart[p * 48 + tid];
            s += tid < 4 ? a->in[I_MBRG][l * 4 + tid] : (tid < 36 ? a->in[I_MBRE][l * 32 + tid - 4] : 0.f); cvec[tid] = s; }
        {
            const int i16 = lane & 15, kq = lane >> 4, r0 = c * 128 + wave * 16;
            f32x4m acc0 = {0.f, 0.f, 0.f, 0.f}, acc1 = acc0, acc2 = acc0;
            const float* xrow = x + (size_t)(r0 + i16) * DM + 4 * kq;
            constexpr int PD = 4;
            const float* wbase = RTW + (size_t)(kq * 16 + i16) * 12;
            f32x4 xq[PD], wq[PD][3];
#pragma unroll
            for (int s = 0; s < PD; ++s) { xq[s] = *(const GAS f32x4*)(xrow + 16 * s); const GAS f32x4* wp = (const GAS f32x4*)(wbase + (size_t)(4 * s) * 16 * 12); wq[s][0] = wp[0]; wq[s][1] = wp[1]; wq[s][2] = wp[2]; }
#pragma unroll 1
            for (int k0 = 0; k0 < DM; k0 += 16 * PD) {
#pragma unroll
                for (int s = 0; s < PD; ++s) {
                    const f32x4 xv = xq[s], w0 = wq[s][0], w1 = wq[s][1], w2 = wq[s][2];
                    { const int kn = min(k0 + 16 * (s + PD), DM - 16); xq[s] = *(const GAS f32x4*)(xrow + kn); const GAS f32x4* wp = (const GAS f32x4*)(wbase + (size_t)(kn >> 2) * 16 * 12); wq[s][0] = wp[0]; wq[s][1] = wp[1]; wq[s][2] = wp[2]; }
                    __builtin_amdgcn_sched_barrier(0);
                    const f32x4 sv = *(const LAS f32x4*)(sc + k0 + 16 * s + 4 * kq);
                    const float wf[12] = {w0[0], w0[1], w0[2], w0[3], w1[0], w1[1], w1[2], w1[3], w2[0], w2[1], w2[2], w2[3]};
#pragma unroll
                    for (int j = 0; j < 4; ++j) { const float av = xv[j] * sv[j];
                        acc0 = __builtin_amdgcn_mfma_f32_16x16x4f32(av, wf[j * 3], acc0, 0, 0, 0);
                        acc1 = __builtin_amdgcn_mfma_f32_16x16x4f32(av, wf[j * 3 + 1], acc1, 0, 0, 0);
                        acc2 = __builtin_amdgcn_mfma_f32_16x16x4f32(av, wf[j * 3 + 2], acc2, 0, 0, 0); }
                }
            }
            __syncthreads();
            LAS float* lw = lg + wave * 16 * 48;
#pragma unroll
            for (int r = 0; r < 4; ++r) { const int rr = 4 * kq + r; const float rs = rstd_s[wave * 16 + rr];
                lw[rr * 48 + i16] = acc0[r] * rs + cvec[i16]; lw[rr * 48 + 16 + i16] = acc1[r] * rs + cvec[16 + i16]; lw[rr * 48 + 32 + i16] = acc2[r] * rs + cvec[32 + i16]; }
            LDS_WAIT(); asm volatile("" ::: "memory");
            if (lane < 16) {
                const LAS float* lr = lw + lane * 48; const int row = r0 + lane;
                float g0 = lr[0], g1 = lr[1], g2 = lr[2], g3 = lr[3]; const float gm = fmaxf(fmaxf(g0, g1), fmaxf(g2, g3));
                float p0 = __expf(g0 - gm), p1 = __expf(g1 - gm), p2 = __expf(g2 - gm), p3 = __expf(g3 - gm); const float inv = 1.f / (p0 + p1 + p2 + p3);
                p0 *= inv; p1 *= inv; p2 *= inv; p3 *= inv;
                int gi = 0; float gp = p0; if (p1 > gp) { gp = p1; gi = 1; } if (p2 > gp) { gp = p2; gi = 2; } if (p3 > gp) { gp = p3; gi = 3; }
                float ev0 = -3.4e38f, ev1 = -3.4e38f; int e0 = 0, e1 = 0;
#pragma unroll
                for (int j = 0; j < 8; ++j) { const float s = lr[4 + gi * 8 + j]; if (s > ev0) { ev1 = ev0; e1 = e0; ev0 = s; e0 = j; } else if (s > ev1) { ev1 = s; e1 = j; } }
                const float q = __expf(ev1 - ev0), w0 = gp / (1.f + q), w1 = gp * q / (1.f + q);
                e0 += gi * 8; e1 += gi * 8;
                TOKE[2 * row] = e0; TOKE[2 * row + 1] = e1; TOKW[2 * row] = w0; TOKW[2 * row + 1] = w1;
                const int a0 = 2 * (wave * 16 + lane);
                asg_e[a0] = e0; asg_e[a0 + 1] = e1; asg_lp[a0] = atomicAdd((int*)&hist[e0], 1); asg_lp[a0 + 1] = atomicAdd((int*)&hist[e1], 1);
            }
        }
        __syncthreads();
        if (tid < 32) { const int h = hist[tid]; basev[tid] = h ? (int)atomicAdd(CNT + tid, (unsigned)h) : 0; }
        __syncthreads();
        if (tid < 256) { const int e = asg_e[tid]; LIST[(size_t)e * 65536 + basev[e] + asg_lp[tid]] = (c * 128) * 2 + tid; }
    }
}
__device__ __forceinline__ void build_ptab(const unsigned* CNT, LAS int* ptab, LAS int* pst, LAS int* cnt, int tid) {
    __syncthreads();
    if (tid < NEXP) {
        const int ce = (int)__hip_atomic_load(CNT + tid, RLX_AGENT); cnt[tid] = ce; const int pe = (ce + 255) >> 8;
        int incl = pe;
#pragma unroll
        for (int d = 1; d < NEXP; d <<= 1) { const int t = __shfl_up(incl, d, 64); if (tid >= d) incl += t; }
        const int start = incl - pe; pst[tid] = start * 256;
        for (int p = 0; p < pe; ++p) ptab[1 + start + p] = tid;
        if (tid == NEXP - 1) ptab[0] = incl; }
    __syncthreads();
}
__device__ __forceinline__ void phase_gather(KArgsP a, LAS unsigned char* lds, int tid, int lane, int wave, int vcu, int G, int l) {
    unsigned char* ws = a->ws;
    LAS int* ptab = (LAS int*)lds; LAS int* pst = ptab + 512; LAS int* cnt = pst + 32;
    build_ptab((const unsigned*)(ws + WS_CTL) + CW_CNT + l * 32, ptab, pst, cnt, tid);
    const bf16* HN = (const bf16*)(ws + WS_HN); bf16* XG = (bf16*)(ws + WS_XG); int* ROWMAP = (int*)(ws + WS_ROWMAP); const int* LIST = (const int*)(ws + WS_LIST);
    const int nrows = ptab[0] * 256;
    for (int row0 = (vcu * NWAVES + wave) * 8; row0 < nrows; row0 += G * NWAVES * 8) {
        int tok2[8]; v4u p0[8], p1[8];
#pragma unroll
        for (int j = 0; j < 8; ++j) { const int row = row0 + j, e = ptab[1 + (row >> 8)], pos = row - pst[e]; tok2[j] = (pos < cnt[e]) ? LIST[(size_t)e * 65536 + pos] : -1; }
#pragma unroll
        for (int j = 0; j < 8; ++j) { if (tok2[j] >= 0) { const GAS v4u* s = (const GAS v4u*)(HN + (size_t)(tok2[j] >> 1) * DM) + lane; p0[j] = s[0]; p1[j] = s[64]; } else { p0[j] = (v4u){0u, 0u, 0u, 0u}; p1[j] = p0[j]; } }
#pragma unroll
        for (int j = 0; j < 8; ++j) { GAS v4u* d = (GAS v4u*)(XG + (size_t)(row0 + j) * DM) + lane; d[0] = p0[j]; d[64] = p1[j]; if (lane == 0) ROWMAP[row0 + j] = tok2[j]; }
    }
}

__device__ __forceinline__ void phase_rowmap(KArgsP a, LAS unsigned char* lds, int tid, int vcu, int G, int l) {
    unsigned char* ws = a->ws;
    LAS int* ptab = (LAS int*)lds; LAS int* pst = ptab + 512; LAS int* cnt = pst + 32;
    build_ptab((const unsigned*)(ws + WS_CTL) + CW_CNT + l * 32, ptab, pst, cnt, tid);
    int* ROWMAP = (int*)(ws + WS_ROWMAP); const int* LIST = (const int*)(ws + WS_LIST);
    const int nrows = ptab[0] * 256;
    for (int row = vcu * NTHR + tid; row < nrows; row += G * NTHR) { const int e = ptab[1 + (row >> 8)], pos = row - pst[e]; ROWMAP[row] = (pos < cnt[e]) ? LIST[(size_t)e * 65536 + pos] : -1; }
}

typedef short bf16x8 __attribute__((ext_vector_type(8)));
constexpr int MT = 72;
constexpr int ML_XP = 0;
constexpr int ML_CX = 17152;
constexpr int ML_WQ = ML_CX + 9216, ML_WK = ML_WQ + 9216;
constexpr int ML_Q = ML_WK + 9216, ML_K = ML_Q + 9216;
constexpr int ML_S = ML_K + 9216;
constexpr int ML_VT = ML_S + 9216;
constexpr int ML_CT = ML_VT + 11520;
constexpr int ML_H = ML_CT + 11520;
constexpr int ML_SM = ML_H + 16640;
static_assert(ML_SM + 2048 <= RING_BYTES, "mLSTM LDS map");
__device__ __forceinline__ float logsigmoidf_(float x) { return fminf(x, 0.f) - log1pf(__expf(-fabsf(x))); }
__device__ __forceinline__ void mma64(const LAS bf16* A, int arow0, const LAS bf16* Bt, int brow0, int lane, f32x4& acc) {
    const LAS bf16* ap = A + (arow0 + (lane & 15)) * MT + 8 * (lane >> 4); const LAS bf16* bp = Bt + (brow0 + (lane & 15)) * MT + 8 * (lane >> 4);
    const bf16x8 a0 = *(const LAS bf16x8*)ap, a1 = *(const LAS bf16x8*)(ap + 32), b0 = *(const LAS bf16x8*)bp, b1 = *(const LAS bf16x8*)(bp + 32);
    acc = __builtin_amdgcn_mfma_f32_16x16x32_bf16(a0, b0, acc, 0, 0, 0); acc = __builtin_amdgcn_mfma_f32_16x16x32_bf16(a1, b1, acc, 0, 0, 0);
}
__device__ __forceinline__ void ml_front(KArgsP a, LAS unsigned char* lds, int tid, int l, int b, int c, int h, bool want_q) {
    const bf16* PROJ = (const bf16*)(a->ws + WS_PROJ); const size_t row0 = (size_t)b * SEQ + c * 64;
    LAS float* xp = (LAS float*)(lds + ML_XP);
    for (int idx = tid; idx < 67 * 8; idx += NTHR) { const int r = idx >> 3, c8 = idx & 7, tr = c * 64 + r - 3; LAS float* d = xp + r * 64 + c8 * 8;
        if (tr >= 0) { const v4u p = *(const GAS v4u*)(PROJ + ((size_t)b * SEQ + tr) * NPROJ + PC_QK + h * 64 + c8 * 8);
            *(LAS f32x4*)d = (f32x4){bflo(p.x), bfhi(p.x), bflo(p.y), bfhi(p.y)}; *(LAS f32x4*)(d + 4) = (f32x4){bflo(p.z), bfhi(p.z), bflo(p.w), bfhi(p.w)}; }
        else { *(LAS f32x4*)d = (f32x4){0.f, 0.f, 0.f, 0.f}; *(LAS f32x4*)(d + 4) = (f32x4){0.f, 0.f, 0.f, 0.f}; } }
    {
        const int t = tid >> 3, vg = tid & 7; LAS bf16* VT = (LAS bf16*)(lds + ML_VT);
        const v4u p = *(const GAS v4u*)(PROJ + (row0 + t) * NPROJ + PC_V + h * 64 + vg * 8);
        const unsigned w[4] = {p.x, p.y, p.z, p.w};
#pragma unroll
        for (int j = 0; j < 4; ++j) { VT[(vg * 8 + 2 * j) * MT + t] = (bf16)(w[j] & 0xffffu); VT[(vg * 8 + 2 * j + 1) * MT + t] = (bf16)(w[j] >> 16); }
        for (int idx = tid; idx < 16 * 64; idx += NTHR) VT[(64 + (idx >> 6)) * MT + (idx & 63)] = (idx < 64) ? (bf16)0x3F80 : (bf16)0;
        const bf16* WT = (const bf16*)(a->ws + WS_MLW) + (size_t)((l * NH + h) * 2) * 4096;
        const int e = tid >> 3, d8 = tid & 7;
        if (want_q) *(LAS v4u*)(lds + ML_WQ + (e * MT + d8 * 8) * 2) = *(const GAS v4u*)(WT + e * 64 + d8 * 8);
        *(LAS v4u*)(lds + ML_WK + (e * MT + d8 * 8) * 2) = *(const GAS v4u*)(WT + 4096 + e * 64 + d8 * 8);
    }
    __syncthreads();
    const float* cw = a->in[I_CONV_W] + (size_t)l * 4 * DA + h * 64; const float* cb = a->in[I_CONV_B] + (size_t)l * DA + h * 64;
    {
        const int t = tid >> 3, c8 = (tid & 7) * 8; float s[8];
#pragma unroll
        for (int j = 0; j < 8; ++j) s[j] = cb[c8 + j];
#pragma unroll
        for (int q = 0; q < 4; ++q) { const f32x4 x0 = *(const LAS f32x4*)(xp + (t + q) * 64 + c8), x1 = *(const LAS f32x4*)(xp + (t + q) * 64 + c8 + 4); const float* w = cw + q * DA + c8;
            s[0] += x0.x * w[0]; s[1] += x0.y * w[1]; s[2] += x0.z * w[2]; s[3] += x0.w * w[3]; s[4] += x1.x * w[4]; s[5] += x1.y * w[5]; s[6] += x1.z * w[6]; s[7] += x1.w * w[7]; }
#pragma unroll
        for (int j = 0; j < 8; ++j) s[j] = s[j] / (1.f + __expf(-s[j]));
        v4u o; o.x = pk2(s[0], s[1]); o.y = pk2(s[2], s[3]); o.z = pk2(s[4], s[5]); o.w = pk2(s[6], s[7]);
        *(LAS v4u*)(lds + ML_CX + (t * MT + c8) * 2) = o;
    }
}
__device__ __forceinline__ void phase_m1(KArgsP a, LAS unsigned char* lds, int tid, int lane, int wave, int vcu, int G, int l) {
    unsigned char* ws = a->ws; const float* GT = (const float*)(ws + WS_GATES);
    float* CLOC = (float*)(ws + WS_CLOC); float* MLG = (float*)(ws + WS_MSC); float* MLM = MLG + 4096;
    LAS float* sm = (LAS float*)(lds + ML_SM);
    for (int u = vcu; u < NUNIT_M; u += G) {
        const int h = u % NH, c = (u / NH) % NCH, b = u / (NH * NCH); const size_t row0 = (size_t)b * SEQ + c * 64;
        __syncthreads();
        ml_front(a, lds, tid, l, b, c, h, false);
        if (wave == 0) {
            const float ig = GT[(row0 + lane) * 16 + h] + a->in[I_BI][l * NH + h];
            const float fl = logsigmoidf_(GT[(row0 + lane) * 16 + 6 + h] + a->in[I_BF][l * NH + h]);
            float bc = fl;
#pragma unroll
            for (int o = 1; o < 64; o <<= 1) { const float t = __shfl_up(bc, o); if (lane >= o) bc += t; }
            const float gtot = __shfl(bc, 63); const float lw = gtot - bc + ig; const float ml = wave_max(lw);
            sm[lane] = __expf(lw - ml);
            if (lane == 0) { MLG[u] = gtot; MLM[u] = ml; }
        }
        __syncthreads();
        {
            const int rt = wave >> 1; LAS bf16* KT = (LAS bf16*)(lds + ML_K);
#pragma unroll
            for (int q = 0; q < 2; ++q) { const int ct = 2 * (wave & 1) + q; f32x4 acc = {0.f, 0.f, 0.f, 0.f};
                mma64((const LAS bf16*)(lds + ML_CX), 16 * rt, (const LAS bf16*)(lds + ML_WK), 16 * ct, lane, acc);
                const int t0 = 16 * rt + 4 * (lane >> 4), e = 16 * ct + (lane & 15);
                const float w0 = sm[t0] * 0.125f, w1 = sm[t0 + 1] * 0.125f, w2 = sm[t0 + 2] * 0.125f, w3 = sm[t0 + 3] * 0.125f;
                v2u o; o.x = pk2(acc[0] * w0, acc[1] * w1); o.y = pk2(acc[2] * w2, acc[3] * w3);
                *(LAS v2u*)(KT + e * MT + t0) = o; }
        }
        __syncthreads();
        {
            const int ct = wave & 3, r_lo = wave < 4 ? 0 : 3, r_hi = wave < 4 ? 3 : 5; float* cl = CLOC + (size_t)u * CL_STRIDE;
            for (int rt = r_lo; rt < r_hi; ++rt) { f32x4 acc = {0.f, 0.f, 0.f, 0.f};
                mma64((const LAS bf16*)(lds + ML_VT), 16 * rt, (const LAS bf16*)(lds + ML_K), 16 * ct, lane, acc);
                const int v0 = 16 * rt + 4 * (lane >> 4), e = 16 * ct + (lane & 15);
                if (rt < 4) {
#pragma unroll
                    for (int r = 0; r < 4; ++r) cl[(v0 + r) * 64 + e] = acc[r];
                } else if ((lane >> 4) == 0) cl[4096 + e] = acc[0]; }
        }
    }
}
__device__ __forceinline__ void phase_m2(unsigned char* ws, int tid, int wg, int nwg) {
    float* CLOC = (float*)(ws + WS_CLOC); const float* MLG = (const float*)(ws + WS_MSC); const float* MLM = MLG + 4096; float* MST = (float*)(ws + WS_MSC) + 8192;
    for (int idx = wg * NTHR + tid; idx < NB * NH * CL_STRIDE; idx += nwg * NTHR) {
        const int e = idx % CL_STRIDE, bh = idx / CL_STRIDE, b = bh / NH, h = bh % NH;
        float m = 0.f, cs = 0.f;
        float cn[8], gn[8], mn8[8];
#pragma unroll
        for (int j = 0; j < 8; ++j) { const int u = (b * NCH + j) * NH + h; cn[j] = CLOC[(size_t)u * CL_STRIDE + e]; gn[j] = MLG[u]; mn8[j] = MLM[u]; }
        for (int c0 = 0; c0 < NCH; c0 += 8) {
            float cl[8], g[8], ml[8];
#pragma unroll
            for (int j = 0; j < 8; ++j) { cl[j] = cn[j]; g[j] = gn[j]; ml[j] = mn8[j]; }
            { const int cq = min(c0 + 8, NCH - 8);
#pragma unroll
              for (int j = 0; j < 8; ++j) { const int u = (b * NCH + cq + j) * NH + h; cn[j] = CLOC[(size_t)u * CL_STRIDE + e]; gn[j] = MLG[u]; mn8[j] = MLM[u]; } }
#pragma unroll
            for (int j = 0; j < 8; ++j) { const int u = (b * NCH + c0 + j) * NH + h;
                CLOC[(size_t)u * CL_STRIDE + e] = cs; if (e == 0) MST[u] = m;
                const float mn = fmaxf(g[j] + m, ml[j]); const float ao = __expf(g[j] + m - mn), al = __expf(ml[j] - mn);
                cs = ao * cs + al * cl[j]; m = mn; }
        }
    }
}
__device__ __forceinline__ void phase_m3(KArgsP a, LAS unsigned char* lds, int tid, int lane, int wave, int vcu, int G, int l) {
    unsigned char* ws = a->ws; const bf16* PROJ = (const bf16*)(ws + WS_PROJ); const float* GT = (const float*)(ws + WS_GATES);
    const float* CLOC = (const float*)(ws + WS_CLOC); const float* MST = (const float*)(ws + WS_MSC) + 8192; bf16* YC = (bf16*)(ws + WS_YC);
    LAS float* sm = (LAS float*)(lds + ML_SM); LAS float* hb = (LAS float*)(lds + ML_H);
    for (int u = vcu; u < NUNIT_M; u += G) {
        const int h = u % NH, c = (u / NH) % NCH, b = u / (NH * NCH); const size_t row0 = (size_t)b * SEQ + c * 64;
        __syncthreads();
        ml_front(a, lds, tid, l, b, c, h, true);
        {
            const float* cl = CLOC + (size_t)u * CL_STRIDE; LAS bf16* CT = (LAS bf16*)(lds + ML_CT);
            for (int idx = tid; idx < 65 * 16; idx += NTHR) { const int r = idx >> 4, c4 = idx & 15; const f32x4 v = *(const GAS f32x4*)(cl + r * 64 + c4 * 4);
                v2u o; o.x = pk2(v.x, v.y); o.y = pk2(v.z, v.w); *(LAS v2u*)(CT + r * MT + c4 * 4) = o; }
            for (int idx = tid; idx < 15 * 64; idx += NTHR) CT[(65 + (idx >> 6)) * MT + (idx & 63)] = 0;
        }
        if (wave == 0) {
            const float ig = GT[(row0 + lane) * 16 + h] + a->in[I_BI][l * NH + h];
            const float fl = logsigmoidf_(GT[(row0 + lane) * 16 + 6 + h] + a->in[I_BF][l * NH + h]);
            float bc = fl;
#pragma unroll
            for (int o = 1; o < 64; o <<= 1) { const float t = __shfl_up(bc, o); if (lane >= o) bc += t; }
            float pm = ig - bc;
#pragma unroll
            for (int o = 1; o < 64; o <<= 1) { const float t = __shfl_up(pm, o); if (lane >= o) pm = fmaxf(pm, t); }
            const float mst = MST[u]; const float inter = bc + mst, mt = fmaxf(inter, bc + pm);
            sm[lane] = ig - bc; sm[64 + lane] = bc - mt; sm[128 + lane] = __expf(inter - mt); sm[192 + lane] = __expf(-mt);
        }
        __syncthreads();
        {
            const int rt = wave >> 1; LAS bf16* Qs = (LAS bf16*)(lds + ML_Q); LAS bf16* Ks = (LAS bf16*)(lds + ML_K);
#pragma unroll
            for (int q = 0; q < 2; ++q) { const int ct = 2 * (wave & 1) + q; f32x4 aq = {0.f, 0.f, 0.f, 0.f}, ak = {0.f, 0.f, 0.f, 0.f};
                mma64((const LAS bf16*)(lds + ML_CX), 16 * rt, (const LAS bf16*)(lds + ML_WQ), 16 * ct, lane, aq);
                mma64((const LAS bf16*)(lds + ML_CX), 16 * rt, (const LAS bf16*)(lds + ML_WK), 16 * ct, lane, ak);
                const int t0 = 16 * rt + 4 * (lane >> 4), e = 16 * ct + (lane & 15);
#pragma unroll
                for (int r = 0; r < 4; ++r) { Qs[(t0 + r) * MT + e] = (bf16)f2bf(aq[r]); Ks[(t0 + r) * MT + e] = (bf16)f2bf(ak[r] * 0.125f); } }
        }
        __syncthreads();
        {
            const int rt = wave >> 1; LAS bf16* Ss = (LAS bf16*)(lds + ML_S);
#pragma unroll
            for (int q = 0; q < 2; ++q) { const int ct = 2 * (wave & 1) + q; f32x4 acc = {0.f, 0.f, 0.f, 0.f};
                if (ct <= rt) mma64((const LAS bf16*)(lds + ML_Q), 16 * rt, (const LAS bf16*)(lds + ML_K), 16 * ct, lane, acc);
                const int t0 = 16 * rt + 4 * (lane >> 4), s = 16 * ct + (lane & 15); const float qs = sm[s];
#pragma unroll
                for (int r = 0; r < 4; ++r) { const int t = t0 + r; Ss[t * MT + s] = (bf16)f2bf((s <= t) ? acc[r] * __expf(sm[64 + t] + qs) : 0.f); } }
        }
        __syncthreads();
        {
            const int rt = wave >> 1, nt = (wave & 1) ? 2 : 3;
            for (int q = 0; q < nt; ++q) { const int ct = (wave & 1) ? 2 + q : (q < 2 ? q : 4); f32x4 aA = {0.f, 0.f, 0.f, 0.f}, aB = {0.f, 0.f, 0.f, 0.f};
                mma64((const LAS bf16*)(lds + ML_Q), 16 * rt, (const LAS bf16*)(lds + ML_CT), 16 * ct, lane, aA);
                mma64((const LAS bf16*)(lds + ML_S), 16 * rt, (const LAS bf16*)(lds + ML_VT), 16 * ct, lane, aB);
                const int t0 = 16 * rt + 4 * (lane >> 4), v = 16 * ct + (lane & 15);
#pragma unroll
                for (int r = 0; r < 4; ++r) { const int t = t0 + r; const float x = sm[128 + t] * aA[r] + aB[r];
                    if (ct < 4) hb[t * 65 + v] = x; else if ((lane & 15) == 0) sm[256 + t] = x; } }
        }
        __syncthreads();
        {
            const int t = tid >> 3, vg = tid & 7; float acc[8];
            const float dn = 1.f / fmaxf(fabsf(sm[256 + t]), sm[192 + t]);
            float s1 = 0.f;
#pragma unroll
            for (int j = 0; j < 8; ++j) { acc[j] = hb[t * 65 + vg * 8 + j] * dn; s1 += acc[j]; }
            s1 += __shfl_xor(s1, 1); s1 += __shfl_xor(s1, 2); s1 += __shfl_xor(s1, 4);
            const float mu = s1 * (1.f / 64.f); float s2 = 0.f;
#pragma unroll
            for (int j = 0; j < 8; ++j) { acc[j] -= mu; s2 += acc[j] * acc[j]; }
            s2 += __shfl_xor(s2, 1); s2 += __shfl_xor(s2, 2); s2 += __shfl_xor(s2, 4);
            const float rs = rsqrtf(s2 * (1.f / 64.f) + HEAD_NORM_EPS);
            const float* nw = a->in[I_MNORM_W] + (size_t)l * DA + h * 64 + vg * 8;
            const v4u ov = *(const GAS v4u*)(PROJ + (row0 + t) * NPROJ + PC_O + h * 64 + vg * 8);
            const float o[8] = {bflo(ov.x), bfhi(ov.x), bflo(ov.y), bfhi(ov.y), bflo(ov.z), bfhi(ov.z), bflo(ov.w), bfhi(ov.w)};
            float r[8];
#pragma unroll
            for (int j = 0; j < 8; ++j) r[j] = acc[j] * rs * nw[j] * sigmoidf_(o[j]);
            v4u w; w.x = pk2(r[0], r[1]); w.y = pk2(r[2], r[3]); w.z = pk2(r[4], r[5]); w.w = pk2(r[6], r[7]);
            *(GAS v4u*)(YC + (row0 + t) * DM + h * 64 + vg * 8) = w;
        }
    }
}

constexpr int S5_UT = 264, S5_XT = 2056;
constexpr int S5_U = 0, S5_Z = 33792, S5_X = 67584;
static_assert(S5_X + 16 * S5_XT * 2 <= MISC_OFF, "S5 LDS map");
struct S5A { float are, aim, cre, cim; };
__device__ __forceinline__ S5A s5_a(KArgsP a, int l, int g, int p) {
    const float lam_re = a->in[I_S5ARE][(size_t)(l * 16 + g) * 64 + p], lam_im = a->in[I_S5AIM][(size_t)(l * 16 + g) * 64 + p];
    const float dt = expf(a->in[I_S5LDT][l * 16 + g]); const float mag = expf(lam_re * dt), ang = lam_im * dt;
    S5A r; r.are = mag * cosf(ang); r.aim = mag * sinf(ang);
    const float inv = 1.f / (lam_re * lam_re + lam_im * lam_im);
    r.cre = ((r.are - 1.f) * lam_re + r.aim * lam_im) * inv; r.cim = (r.aim * lam_re - (r.are - 1.f) * lam_im) * inv; return r;
}
__device__ __forceinline__ bf16x8 pack8(const float* v) { v4u o; o.x = pk2(v[0], v[1]); o.y = pk2(v[2], v[3]); o.z = pk2(v[4], v[5]); o.w = pk2(v[6], v[7]); return __builtin_bit_cast(bf16x8, o); }
__device__ __forceinline__ void s5_bfrag(const unsigned char* ws, int l, int g, int lane, bf16x8 (&bf)[8]) {
    const bf16* BB = (const bf16*)(ws + WS_S5BB) + (size_t)(l * 16 + g) * 128 * 16;
#pragma unroll
    for (int j = 0; j < 8; ++j) { v4u o = {0u, 0u, 0u, 0u}; if ((lane >> 4) < 2) o = *(const GAS v4u*)(BB + (16 * j + (lane & 15)) * 16 + 8 * (lane >> 4)); bf[j] = __builtin_bit_cast(bf16x8, o); }
}
__device__ __forceinline__ f32x2 s5_ap(const unsigned char* ws, int l, int g, int p) { return *(const GAS f32x2*)((const float*)(ws + WS_S5AP) + ((size_t)(l * 16 + g) * 64 + p) * 2); }
__device__ __forceinline__ void s5_load_u(const unsigned char* ws, LAS unsigned char* lds, int tid, size_t row0) {
    const bf16* PROJ = (const bf16*)(ws + WS_PROJ);
    for (int idx = tid; idx < 64 * 32; idx += NTHR) { const int t = idx >> 5, c8 = idx & 31;
        *(LAS v4u*)(lds + S5_U + (t * S5_UT + c8 * 8) * 2) = *(const GAS v4u*)(PROJ + (row0 + t) * NPROJ + PC_S5 + c8 * 8); }
}
__device__ __forceinline__ void s5_block(LAS unsigned char* lds, int lane, int tb, int g, const bf16x8 (&bf)[8], float are, float aim, float& xr, float& xi) {
    const int kq = lane >> 4; bf16x8 uf = {0, 0, 0, 0, 0, 0, 0, 0};
    if (kq < 2) uf = *(const LAS bf16x8*)(lds + S5_U + ((16 * tb + (lane & 15)) * S5_UT + g * 16 + 8 * kq) * 2);
    LAS bf16* X = (LAS bf16*)(lds + S5_X);
#pragma unroll
    for (int j = 0; j < 8; ++j) { f32x4 acc = {0.f, 0.f, 0.f, 0.f}; acc = __builtin_amdgcn_mfma_f32_16x16x32_bf16(bf[j], uf, acc, 0, 0, 0);
        v2u o; o.x = pk2(acc[0], acc[1]); o.y = pk2(acc[2], acc[3]); *(LAS v2u*)(X + (lane & 15) * S5_XT + g * 128 + 16 * j + 4 * kq) = o; }
    LDS_WAIT(); asm volatile("" ::: "memory");
    LAS unsigned* xw = (LAS unsigned*)(lds + S5_X) + (g * 128 + 2 * lane) / 2;
    unsigned wv[16];
#pragma unroll
    for (int t = 0; t < 16; ++t) wv[t] = xw[t * (S5_XT / 2)];
#pragma unroll
    for (int t = 0; t < 16; ++t) { const float br = bflo(wv[t]), bi = bfhi(wv[t]);
        const float nr = are * xr - aim * xi + br, ni = are * xi + aim * xr + bi; xr = nr; xi = ni;
        wv[t] = pk2(xr, xi); }
#pragma unroll
    for (int t = 0; t < 16; ++t) xw[t * (S5_XT / 2)] = wv[t];
    LDS_WAIT(); asm volatile("" ::: "memory");
}
__device__ __forceinline__ void phase_s1(KArgsP a, LAS unsigned char* lds, int tid, int lane, int wave, int vcu, int G, int l) {
    unsigned char* ws = a->ws; float* ST = (float*)(ws + WS_S5ST);
    bf16x8 bf0[8], bf1[8]; s5_bfrag(ws, l, wave, lane, bf0); s5_bfrag(ws, l, wave + 8, lane, bf1);
    struct { float are, aim; } A0, A1; { const f32x2 q0 = s5_ap(ws, l, wave, lane), q1 = s5_ap(ws, l, wave + 8, lane); A0.are = q0.x; A0.aim = q0.y; A1.are = q1.x; A1.aim = q1.y; }
    for (int u = vcu; u < NB * NCH; u += G) {
        const size_t row0 = (size_t)u * 64;
        __syncthreads();
        s5_load_u(ws, lds, tid, row0);
        __syncthreads();
        float x0r = 0.f, x0i = 0.f, x1r = 0.f, x1i = 0.f;
        for (int tb = 0; tb < 4; ++tb) { s5_block(lds, lane, tb, wave, bf0, A0.are, A0.aim, x0r, x0i); s5_block(lds, lane, tb, wave + 8, bf1, A1.are, A1.aim, x1r, x1i); }
        *(f32x2*)(ST + (((size_t)u * 16 + wave) * 64 + lane) * 2) = (f32x2){x0r, x0i};
        *(f32x2*)(ST + (((size_t)u * 16 + wave + 8) * 64 + lane) * 2) = (f32x2){x1r, x1i};
    }
}
__device__ __forceinline__ void phase_s2(KArgsP a, int tid, int wg, int nwg, int l) {
    float* ST = (float*)(a->ws + WS_S5ST);
    for (int idx = wg * NTHR + tid; idx < NB * 1024; idx += nwg * NTHR) {
        const int b = idx >> 10, gp = idx & 1023, g = gp >> 6, p = gp & 63;
        const f32x2 A = s5_ap(a->ws, l, g, p); float ar = A.x, ai = A.y;
#pragma unroll
        for (int s = 0; s < 6; ++s) { const float nr = ar * ar - ai * ai, ni = 2.f * ar * ai; ar = nr; ai = ni; }
        float cr = 0.f, ci = 0.f;
        f32x2 en[8];
#pragma unroll
        for (int j = 0; j < 8; ++j) en[j] = *(const f32x2*)(ST + (((size_t)(b * NCH + j) * 16 + g) * 64 + p) * 2);
        for (int c0 = 0; c0 < NCH; c0 += 8) {
            f32x2 e[8];
#pragma unroll
            for (int j = 0; j < 8; ++j) e[j] = en[j];
            { const int cq = min(c0 + 8, NCH - 8);
#pragma unroll
              for (int j = 0; j < 8; ++j) en[j] = *(const f32x2*)(ST + (((size_t)(b * NCH + cq + j) * 16 + g) * 64 + p) * 2); }
#pragma unroll
            for (int j = 0; j < 8; ++j) { *(f32x2*)(ST + (((size_t)(b * NCH + c0 + j) * 16 + g) * 64 + p) * 2) = (f32x2){cr, ci};
                const float nr = ar * cr - ai * ci + e[j].x, ni = ar * ci + ai * cr + e[j].y; cr = nr; ci = ni; }
        }
    }
}
__device__ __forceinline__ float tanh_fast(float x) { return 1.f - 2.f / (1.f + __expf(2.f * x)); }
__device__ __forceinline__ float gelu_tanh_(float x) { const float t = tanh_fast(0.7978845608f * (x + 0.044715f * x * x * x)); return 0.5f * x * (1.f + t); }
__device__ __forceinline__ void s5_cload(const bf16* cmt  , int lane, bf16x8 (&cf)[4]) {
#pragma unroll
    for (int s = 0; s < 4; ++s) cf[s] = __builtin_bit_cast(bf16x8, *(const GAS v4u*)(cmt + (lane & 15) * 128 + 32 * s + 8 * (lane >> 4)));
}
__device__ __forceinline__ void s5_cproj(LAS unsigned char* lds, int lane, int tb, int g, const bf16x8 (&cf)[4], const float (&dv)[4]) {
    const int kq = lane >> 4; f32x4 acc = {0.f, 0.f, 0.f, 0.f};
    const LAS bf16* xp = (const LAS bf16*)(lds + S5_X) + (lane & 15) * S5_XT + g * 128 + 8 * kq;
#pragma unroll
    for (int s = 0; s < 4; ++s) acc = __builtin_amdgcn_mfma_f32_16x16x32_bf16(cf[s], *(const LAS bf16x8*)(xp + 32 * s), acc, 0, 0, 0);
    const int t = 16 * tb + (lane & 15), c0 = g * 16 + 4 * kq;
    const v2u uw = *(const LAS v2u*)(lds + S5_U + (t * S5_UT + c0) * 2);
    const float u4[4] = {bflo(uw.x), bfhi(uw.x), bflo(uw.y), bfhi(uw.y)}; float z[4];
#pragma unroll
    for (int r = 0; r < 4; ++r) z[r] = gelu_tanh_(acc[r] + dv[r] * u4[r]);
    v2u o; o.x = pk2(z[0], z[1]); o.y = pk2(z[2], z[3]); *(LAS v2u*)(lds + S5_Z + (t * S5_UT + c0) * 2) = o;
}
__device__ __forceinline__ void phase_s3(KArgsP a, LAS unsigned char* lds, int tid, int lane, int wave, int vcu, int G, int l, unsigned* qctr = nullptr) {
    unsigned char* ws = a->ws; const float* ST = (const float*)(ws + WS_S5ST); bf16* YC = (bf16*)(ws + WS_YC);
    const bf16* GLUT = (const bf16*)(ws + WS_GLUT) + (size_t)l * DC * DC;
    bf16x8 bf0[8], bf1[8]; s5_bfrag(ws, l, wave, lane, bf0); s5_bfrag(ws, l, wave + 8, lane, bf1);
    const bf16* cm0 = (const bf16*)(ws + WS_S5CM) + (size_t)(l * 16 + wave) * 2048; const bf16* cm1 = cm0 + 8 * 2048;
    struct { float are, aim; } A0, A1; { const f32x2 q0 = s5_ap(ws, l, wave, lane), q1 = s5_ap(ws, l, wave + 8, lane); A0.are = q0.x; A0.aim = q0.y; A1.are = q1.x; A1.aim = q1.y; }
    float d0[4], d1[4];
#pragma unroll
    for (int r = 0; r < 4; ++r) { d0[r] = a->in[I_S5D][l * DC + wave * 16 + 4 * (lane >> 4) + r]; d1[r] = a->in[I_S5D][l * DC + (wave + 8) * 16 + 4 * (lane >> 4) + r]; }
    volatile LAS unsigned* qw = (volatile LAS unsigned*)(lds + MISC_OFF) + 20;
    unsigned qn = 0u; if (qctr && tid == 0) qn = __hip_atomic_fetch_add(qctr, 1u, __ATOMIC_RELAXED, __HIP_MEMORY_SCOPE_AGENT);
    for (int u = vcu; ; u += G) {
        if (qctr) { __syncthreads(); if (tid == 0) *qw = qn; __syncthreads(); u = (int)*qw; }
        if (u >= NB * NCH) break;
        if (qctr && tid == 0) qn = __hip_atomic_fetch_add(qctr, 1u, __ATOMIC_RELAXED, __HIP_MEMORY_SCOPE_AGENT);
        const size_t row0 = (size_t)u * 64;
        __syncthreads();
        s5_load_u(ws, lds, tid, row0);
        const f32x2 s0 = *(const f32x2*)(ST + (((size_t)u * 16 + wave) * 64 + lane) * 2), s1 = *(const f32x2*)(ST + (((size_t)u * 16 + wave + 8) * 64 + lane) * 2);
        float x0r = s0.x, x0i = s0.y, x1r = s1.x, x1i = s1.y;
        __syncthreads();
        for (int tb = 0; tb < 4; ++tb) {
            { bf16x8 cf[4]; s5_cload(cm0, lane, cf); s5_block(lds, lane, tb, wave, bf0, A0.are, A0.aim, x0r, x0i); s5_cproj(lds, lane, tb, wave, cf, d0); }
            { bf16x8 cf[4]; s5_cload(cm1, lane, cf); s5_block(lds, lane, tb, wave + 8, bf1, A1.are, A1.aim, x1r, x1i); s5_cproj(lds, lane, tb, wave + 8, cf, d1); }
        }
        __syncthreads();
        {
            const int kq = lane >> 4;
#pragma unroll
            for (int q = 0; q < 2; ++q) { const int ct = 2 * wave + q; f32x4 acc[4];
#pragma unroll
                for (int rt = 0; rt < 4; ++rt) acc[rt] = (f32x4){0.f, 0.f, 0.f, 0.f};
                const bf16* gp = GLUT + (size_t)(16 * ct + (lane & 15)) * DC + 8 * kq;
#pragma unroll 2
                for (int s = 0; s < 8; ++s) { const bf16x8 gf = __builtin_bit_cast(bf16x8, *(const GAS v4u*)(gp + 32 * s));
#pragma unroll
                    for (int rt = 0; rt < 4; ++rt) acc[rt] = __builtin_amdgcn_mfma_f32_16x16x32_bf16(gf, *(const LAS bf16x8*)(lds + S5_Z + ((16 * rt + (lane & 15)) * S5_UT + 32 * s + 8 * kq) * 2), acc[rt], 0, 0, 0); }
                const int j0 = 16 * ct + 4 * kq; const f32x4 gb = *(const GAS f32x4*)(a->in[I_S5GLUB] + l * DC + j0);
#pragma unroll
                for (int rt = 0; rt < 4; ++rt) { const int t = 16 * rt + (lane & 15); const v2u zw = *(const LAS v2u*)(lds + S5_Z + (t * S5_UT + j0) * 2);
                    const float z0 = bflo(zw.x), z1 = bfhi(zw.x), z2 = bflo(zw.y), z3 = bfhi(zw.y);
                    v2u o; o.x = pk2(z0 * sigmoidf_(acc[rt][0] + gb.x), z1 * sigmoidf_(acc[rt][1] + gb.y)); o.y = pk2(z2 * sigmoidf_(acc[rt][2] + gb.z), z3 * sigmoidf_(acc[rt][3] + gb.w));
                    *(GAS v2u*)(YC + (row0 + t) * DM + 768 + j0) = o; } }
        }
    }
}

__device__ __forceinline__ float rw_shift(const bf16* PROJ, const float* mu, size_t row, int col) {
    const float cur = bf2f(PROJ[row * NPROJ + PC_RW + col]); const float prv = (row % SEQ) ? bf2f(PROJ[(row - 1) * NPROJ + PC_RW + col]) : 0.f;
    return cur + mu[col] * (prv - cur);
}
constexpr int R1_TH = 0, R1_AD = 9216, R1_SG = 18432, R1_VS = 35840, R1_TMP = 86016;
template <int KS, int MODE>
__device__ __forceinline__ void r1_prod(const bf16* WT, const LAS bf16* act, int astride, const float* bias, bf16* OUT, size_t row0, int lane, int wave) {
    const int kq = lane >> 4, n0 = 48 * wave; constexpr int K = 32 * KS;
    f32x4 acc[3][4];
#pragma unroll
    for (int nt = 0; nt < 3; ++nt)
#pragma unroll
        for (int ti = 0; ti < 4; ++ti) acc[nt][ti] = (f32x4){0.f, 0.f, 0.f, 0.f};
#pragma unroll
    for (int s = 0; s < KS; ++s) { bf16x8 wf[3], af[4];
#pragma unroll
        for (int nt = 0; nt < 3; ++nt) wf[nt] = __builtin_bit_cast(bf16x8, *(const GAS v4u*)(WT + (size_t)(n0 + 16 * nt + (lane & 15)) * K + 32 * s + 8 * kq));
#pragma unroll
        for (int ti = 0; ti < 4; ++ti) af[ti] = *(const LAS bf16x8*)(act + (16 * ti + (lane & 15)) * astride + 32 * s + 8 * kq);
#pragma unroll
        for (int nt = 0; nt < 3; ++nt)
#pragma unroll
            for (int ti = 0; ti < 4; ++ti) acc[nt][ti] = __builtin_amdgcn_mfma_f32_16x16x32_bf16(wf[nt], af[ti], acc[nt][ti], 0, 0, 0); }
#pragma unroll
    for (int nt = 0; nt < 3; ++nt) { const int n = n0 + 16 * nt + 4 * kq; f32x4 bv = {0.f, 0.f, 0.f, 0.f}; if (MODE != 2) bv = *(const GAS f32x4*)(bias + n);
#pragma unroll
        for (int ti = 0; ti < 4; ++ti) { float o[4];
#pragma unroll
            for (int r = 0; r < 4; ++r) { const float x = acc[nt][ti][r] + bv[r]; o[r] = MODE == 0 ? 0.60653066f * sigmoidf_(x) : (MODE == 1 ? sigmoidf_(x) : x); }
            v2u w; w.x = pk2(o[0], o[1]); w.y = pk2(o[2], o[3]);
            *(GAS v2u*)(OUT + (row0 + 16 * ti + (lane & 15)) * DBR + n) = w; } }
}
__device__ __forceinline__ void phase_r1(KArgsP a, LAS unsigned char* lds, int tid, int lane, int wave, int vcu, int G, int l) {
    unsigned char* ws = a->ws; const bf16* PROJ = (const bf16*)(ws + WS_PROJ); const float* mu = a->in[I_RMU] + (size_t)l * RW_COLS;
    const bf16* W1 = (const bf16*)(ws + WS_R1W) + (size_t)l * 98304;
    const bf16* WV = (const bf16*)(ws + WS_R1W) + 2 * 98304;
    for (int u = vcu; u < NTOK / 64; u += G) {
        const size_t row0 = (size_t)u * 64;
        __syncthreads();
        for (int idx = tid; idx < 64 * 32; idx += NTHR) { const int tt = idx >> 5, col = 8 * (idx & 31); const size_t r = row0 + tt;
            const v4u cw = *(const GAS v4u*)(PROJ + r * NPROJ + PC_RW + RWC_WD + col); v4u pw = {0u, 0u, 0u, 0u}; if (r % SEQ) pw = *(const GAS v4u*)(PROJ + (r - 1) * NPROJ + PC_RW + RWC_WD + col);
            const f32x4 m0 = *(const GAS f32x4*)(mu + RWC_WD + col), m1 = *(const GAS f32x4*)(mu + RWC_WD + col + 4);
            const unsigned cu[4] = {cw.x, cw.y, cw.z, cw.w}, pu[4] = {pw.x, pw.y, pw.z, pw.w}; const float mm[8] = {m0[0], m0[1], m0[2], m0[3], m1[0], m1[1], m1[2], m1[3]}; unsigned o[4];
#pragma unroll
            for (int j = 0; j < 4; ++j) { const float c0 = bflo(cu[j]), c1 = bfhi(cu[j]); const float x0 = c0 + mm[2 * j] * (bflo(pu[j]) - c0), x1 = c1 + mm[2 * j + 1] * (bfhi(pu[j]) - c1);
                o[j] = col < 64 ? pk2(tanh_fast(x0), tanh_fast(x1)) : (col < 128 ? pk2(x0, x1) : pk2(sigmoidf_(x0), sigmoidf_(x1))); }
            v4u w; w.x = o[0]; w.y = o[1]; w.z = o[2]; w.w = o[3];
            if (col < 64) *(LAS v4u*)(lds + R1_TH + (tt * 72 + col) * 2) = w;
            else if (col < 128) *(LAS v4u*)(lds + R1_AD + (tt * 72 + col - 64) * 2) = w;
            else *(LAS v4u*)(lds + R1_SG + (tt * 136 + col - 128) * 2) = w; }
        if (l > 0) for (int idx = tid; idx < 64 * 48; idx += NTHR) { const int tt = idx / 48, col = 8 * (idx % 48); const size_t r = row0 + tt;
            const v4u cw = *(const GAS v4u*)(PROJ + r * NPROJ + PC_RW + RWC_V + col); v4u pw = {0u, 0u, 0u, 0u}; if (r % SEQ) pw = *(const GAS v4u*)(PROJ + (r - 1) * NPROJ + PC_RW + RWC_V + col);
            const f32x4 m0 = *(const GAS f32x4*)(mu + RWC_V + col), m1 = *(const GAS f32x4*)(mu + RWC_V + col + 4);
            const unsigned cu[4] = {cw.x, cw.y, cw.z, cw.w}, pu[4] = {pw.x, pw.y, pw.z, pw.w}; const float mm[8] = {m0[0], m0[1], m0[2], m0[3], m1[0], m1[1], m1[2], m1[3]}; unsigned o[4];
#pragma unroll
            for (int j = 0; j < 4; ++j) { const float c0 = bflo(cu[j]), c1 = bfhi(cu[j]); o[j] = pk2(c0 + mm[2 * j] * (bflo(pu[j]) - c0), c1 + mm[2 * j + 1] * (bfhi(pu[j]) - c1)); }
            v4u w; w.x = o[0]; w.y = o[1]; w.z = o[2]; w.w = o[3];
            *(LAS v4u*)(lds + R1_VS + (tt * 392 + col) * 2) = w; }
        __syncthreads();
        r1_prod<2, 0>(W1, (const LAS bf16*)(lds + R1_TH), 72, a->in[I_RW0] + l * DBR, (bf16*)(ws + WS_RE), row0, lane, wave);
        r1_prod<2, 1>(W1 + 24576, (const LAS bf16*)(lds + R1_AD), 72, a->in[I_RA0] + l * DBR, (bf16*)(ws + WS_RA), row0, lane, wave);
        r1_prod<4, 2>(W1 + 49152, (const LAS bf16*)(lds + R1_SG), 136, nullptr, (bf16*)(ws + WS_RG), row0, lane, wave);
        if (l > 0) {
            { const int kq = lane >> 4, mt = wave & 1, ti = wave >> 1; f32x4 acc = {0.f, 0.f, 0.f, 0.f};
#pragma unroll
              for (int s = 0; s < 12; ++s) acc = __builtin_amdgcn_mfma_f32_16x16x32_bf16(__builtin_bit_cast(bf16x8, *(const GAS v4u*)(WV + (size_t)(16 * mt + (lane & 15)) * 384 + 32 * s + 8 * kq)),
                                                                                          *(const LAS bf16x8*)(lds + R1_VS + ((16 * ti + (lane & 15)) * 392 + 32 * s + 8 * kq) * 2), acc, 0, 0, 0);
              v2u w; w.x = pk2(acc[0], acc[1]); w.y = pk2(acc[2], acc[3]); *(LAS v2u*)(lds + R1_TMP + ((16 * ti + (lane & 15)) * 40 + 16 * mt + 4 * kq) * 2) = w; }
            __syncthreads();
            r1_prod<1, 1>(WV + 12288, (const LAS bf16*)(lds + R1_TMP), 40, a->in[I_RV0], (bf16*)(ws + WS_RVG), row0, lane, wave);
        }
    }
}
__device__ __forceinline__ float dpp_allsum(float x) {
    x += __builtin_bit_cast(float, __builtin_amdgcn_update_dpp(0, __builtin_bit_cast(int, x), 0x128, 0xf, 0xf, false));
    x += __builtin_bit_cast(float, __builtin_amdgcn_update_dpp(0, __builtin_bit_cast(int, x), 0x124, 0xf, 0xf, false));
    x += __builtin_bit_cast(float, __builtin_amdgcn_update_dpp(0, __builtin_bit_cast(int, x), 0x122, 0xf, 0xf, false));
    x += __builtin_bit_cast(float, __builtin_amdgcn_update_dpp(0, __builtin_bit_cast(int, x), 0x121, 0xf, 0xf, false));
    { const unsigned xi = __builtin_bit_cast(unsigned, x); auto r = __builtin_amdgcn_permlane16_swap(xi, xi, false, false); const unsigned r0 = r[0], r1 = r[1]; x = __uint_as_float(r0) + __uint_as_float(r1); }
    { const unsigned xi = __builtin_bit_cast(unsigned, x); auto r = __builtin_amdgcn_permlane32_swap(xi, xi, false, false); const unsigned r0 = r[0], r1 = r[1]; x = __uint_as_float(r0) + __uint_as_float(r1); }
    return x;
}

constexpr int RC_EF = 0, RC_ATF = 4096, RC_QF = 8448, RC_PFT = 9472, RC_AT = 10496, RC_RT = 12800, RC_BH = 15104, RC_KH = 17408, RC_AH = 19712, RC_BTT = 22016, RC_KTT = 25088, RC_VS = 28160,
              RC_PRL = 31232, RC_QRL = 32000, RC_TQL = 32768, RC_G15 = 33536, RC_CH = 33792;
struct RCRegs { v2u r0, r1, k0, k1, aa, ee, v0, v1, vg, vf, gg; };
__device__ __forceinline__ void rc_issue(const unsigned char* ws, int l, size_t row, int h, int tid, RCRegs& R) {
    const bf16* PROJ = (const bf16*)(ws + WS_PROJ); const int tt = tid >> 4, c0 = h * 64 + 4 * (tid & 15); const size_t r = row + tt; const bool first = (r % SEQ) == 0; const size_t rp = first ? r : r - 1;
    R.r0 = *(const GAS v2u*)(PROJ + r * NPROJ + PC_RW + RWC_R + c0); R.r1 = *(const GAS v2u*)(PROJ + rp * NPROJ + PC_RW + RWC_R + c0);
    R.k0 = *(const GAS v2u*)(PROJ + r * NPROJ + PC_RW + RWC_K + c0); R.k1 = *(const GAS v2u*)(PROJ + rp * NPROJ + PC_RW + RWC_K + c0);
    R.v0 = *(const GAS v2u*)(PROJ + r * NPROJ + PC_RW + RWC_V + c0); R.v1 = *(const GAS v2u*)(PROJ + rp * NPROJ + PC_RW + RWC_V + c0);
    R.aa = *(const GAS v2u*)((const bf16*)(ws + WS_RA) + r * DBR + c0); R.ee = *(const GAS v2u*)((const bf16*)(ws + WS_RE) + r * DBR + c0);
    R.gg = *(const GAS v2u*)((const bf16*)(ws + WS_RG) + r * DBR + c0);
    if (l > 0) { R.vg = *(const GAS v2u*)((const bf16*)(ws + WS_RVG) + r * DBR + c0); R.vf = *(const GAS v2u*)((const bf16*)(ws + WS_VF) + r * DBR + c0); }
    if (first) { R.r1 = (v2u){0u, 0u}; R.k1 = (v2u){0u, 0u}; R.v1 = (v2u){0u, 0u}; }
}
__device__ __forceinline__ void unpack4(const v2u p, float (&o)[4]) { o[0] = bflo(p.x); o[1] = bfhi(p.x); o[2] = bflo(p.y); o[3] = bfhi(p.y); }
__device__ __forceinline__ v2u pack4(const float (&v)[4]) { v2u o; o.x = pk2(v[0], v[1]); o.y = pk2(v[2], v[3]); return o; }
__device__ __forceinline__ v2u pack4v(const f32x4 v) { v2u o; o.x = pk2(v[0], v[1]); o.y = pk2(v[2], v[3]); return o; }
__device__ __forceinline__ bf16x8 cat8(const v2u a, const v2u b) { v4u o; o.x = a.x; o.y = a.y; o.z = b.x; o.w = b.y; return __builtin_bit_cast(bf16x8, o); }
#define RC_BAR() asm volatile("s_waitcnt lgkmcnt(0)\n\ts_barrier" ::: "memory")

constexpr int REC_BYTES = 12288, REC_UNITS = 752;
__device__ __forceinline__ unsigned char* rc_rec(unsigned char* ws, size_t cu) { return cu < 8192 ? ws + WS_OPA + cu * REC_BYTES : ws + WS_OPB + (cu - 8192) * REC_BYTES; }
__device__ __forceinline__ v4u rc_gather_unit(const LAS unsigned char* wb, int u) {
    v2u lo, hi;
    if (u < 256) { const int base = u < 128 ? RC_AH : RC_RT, uu = u & 127, row = uu >> 3, s = (uu >> 2) & 1, lq = uu & 3; const LAS unsigned char* p = wb + base + (row * 72 + 32 * s + 4 * lq) * 2;
        lo = *(const LAS v2u*)p; hi = *(const LAS v2u*)(p + 32); }
    else if (u < 512) { const int k = (u - 256) >> 2, lq = (u - 256) & 3; lo = *(const LAS v2u*)(wb + RC_BTT + (k * 24 + 4 * lq) * 2); hi = *(const LAS v2u*)(wb + RC_KTT + (k * 24 + 4 * lq) * 2); }
    else if (u < 576) { const int t = (u - 512) >> 2, lq = (u - 512) & 3; lo = *(const LAS v2u*)(wb + RC_PRL + (t * 24 + 4 * lq) * 2); hi = *(const LAS v2u*)(wb + RC_QRL + (t * 24 + 4 * lq) * 2); }
    else if (u < 608) { const LAS unsigned char* p = wb + RC_TQL + (((u - 576) >> 1) * 24 + 8 * ((u - 576) & 1)) * 2; lo = *(const LAS v2u*)p; hi = *(const LAS v2u*)(p + 8); }
    else if (u < 736) { const LAS unsigned char* p = wb + RC_VS + (((u - 608) >> 1) * 24 + 8 * ((u - 608) & 1)) * 2; lo = *(const LAS v2u*)p; hi = *(const LAS v2u*)(p + 8); }
    else { const LAS unsigned char* p = wb + RC_G15 + (u - 736) * 16; lo = *(const LAS v2u*)p; hi = *(const LAS v2u*)(p + 8); }
    v4u o; o.x = lo.x; o.y = lo.y; o.z = hi.x; o.w = hi.y; return o;
}
__device__ __forceinline__ void rc_copy_out(unsigned char* rec, const LAS unsigned char* wb, int u) {
#pragma unroll
    for (int q = 0; q < 3; ++q) { const int uu = u + 256 * q; if (uu < REC_UNITS) *(GAS v4u*)(rec + uu * 16) = rc_gather_unit(wb, uu); }
}
constexpr int RS_AH = 0, RS_RT = 2304, RS_BK = 4608, RS_PQ = 9728, RS_TQL = 11008, RS_VS = 11776, RS_G15 = 14848, RS_CH = 15360;
__device__ __forceinline__ int rs_unit_off(int u) {
    if (u < 128) return RS_AH + (u >> 3) * 144 + (u & 7) * 16;
    if (u < 256) return RS_RT + ((u - 128) >> 3) * 144 + (u & 7) * 16;
    if (u < 512) return RS_BK + ((u - 256) >> 2) * 80 + (u & 3) * 16;
    if (u < 576) return RS_PQ + ((u - 512) >> 2) * 80 + (u & 3) * 16;
    if (u < 608) return RS_TQL + ((u - 576) >> 1) * 48 + (u & 1) * 16;
    if (u < 736) return RS_VS + ((u - 608) >> 1) * 48 + (u & 1) * 16;
    return RS_G15 + (u - 736) * 16;
}
#define RC_BUILD(RUSE, q) do { const int bh_ = (q) % (NB * NH), b = bh_ / NH, h = bh_ % NH, blk_ = blk0 + (q) / (NB * NH), c0 = h * 64 + 4 * kq; const size_t row0 = (size_t)b * SEQ + (size_t)blk_ * 32; \
        float kkw[4], kaw[4], mur[4], muk[4], muv[4], rrkw[4], lnww[4], lnbw[4];     \
_Pragma("unroll") \
        for (int j = 0; j < 4; ++j) { kkw[j] = cst[c0 + j]; kaw[j] = cst[384 + c0 + j]; rrkw[j] = cst[768 + c0 + j]; lnww[j] = cst[1152 + c0 + j]; lnbw[j] = cst[1536 + c0 + j]; mur[j] = cst[1920 + c0 + j]; muk[j] = cst[2304 + c0 + j]; muv[j] = cst[2688 + c0 + j]; } \
        float an[4], bk[4], km[4], rs[4], ev[4]; \
        {   const RCRegs& R = RUSE; \
            float rc[4], rp[4], kc[4], kp[4], av[4], vc[4], vp[4], ks[4], kk[4], vs[4]; unpack4(R.r0, rc); unpack4(R.r1, rp); unpack4(R.k0, kc); unpack4(R.k1, kp); unpack4(R.aa, av); unpack4(R.ee, ev); unpack4(R.v0, vc); unpack4(R.v1, vp); \
            float ss = 0.f; \
_Pragma("unroll") \
            for (int j = 0; j < 4; ++j) { rs[j] = rc[j] + mur[j] * (rp[j] - rc[j]); ks[j] = kc[j] + muk[j] * (kp[j] - kc[j]); kk[j] = ks[j] * kkw[j]; ss += kk[j] * kk[j]; vs[j] = vc[j] + muv[j] * (vp[j] - vc[j]); } \
            ss += __shfl_xor(ss, 1); ss += __shfl_xor(ss, 2); ss += __shfl_xor(ss, 4); ss += __shfl_xor(ss, 8); \
            const float inv = 1.f / fmaxf(sqrtf(ss), 1e-12f); \
_Pragma("unroll") \
            for (int j = 0; j < 4; ++j) { const float kn = kk[j] * inv; an[j] = -kn; bk[j] = kn * av[j]; km[j] = ks[j] * (1.f + (av[j] - 1.f) * kaw[j]); } \
            if (l == 0) *(GAS v2u*)((bf16*)(ws + WS_VF) + (row0 + tt) * DBR + c0) = pack4(vs); \
            else { float g[4], f[4]; unpack4(R.vg, g); unpack4(R.vf, f); \
_Pragma("unroll") \
                for (int j = 0; j < 4; ++j) vs[j] = vs[j] + (f[j] - vs[j]) * g[j]; } \
            {     \
                float gq[4], o1[4], o2[4]; unpack4(R.gg, gq); float rkp = 0.f; \
_Pragma("unroll") \
                for (int j = 0; j < 4; ++j) rkp += rs[j] * km[j] * rrkw[j]; \
                rkp += __shfl_xor(rkp, 1); rkp += __shfl_xor(rkp, 2); rkp += __shfl_xor(rkp, 4); rkp += __shfl_xor(rkp, 8); \
_Pragma("unroll") \
                for (int j = 0; j < 4; ++j) { o1[j] = lnww[j] * gq[j]; o2[j] = (lnbw[j] + rkp * vs[j]) * gq[j]; } \
                if (ST12) { *(GAS v2u*)((bf16*)(ws + WS_RG) + (row0 + tt) * DBR + c0) = pack4(o1); *(GAS v2u*)((bf16*)(ws + WS_RA) + (row0 + tt) * DBR + c0) = pack4(o2); } } \
            *(LAS f32x4*)(cb + RC_EF + (t * 64 + 4 * kq) * 4) = (f32x4){ev[0], ev[1], ev[2], ev[3]}; \
_Pragma("unroll") \
            for (int j = 0; j < 4; ++j) *(LAS bf16*)(cb + RC_VS + ((4 * kq + j) * 24 + t) * 2) = (bf16)f2bf(vs[j]); \
        } \
        if ((q) + 2 * G < NQ) rc_issue_q(ws, l, (q) + 2 * G, blk0, tid, RUSE); \
        RC_BAR(); \
        {   f32x4 inc = {0.f, 0.f, 0.f, 0.f}, tot = inc; \
_Pragma("unroll") \
            for (int i = 0; i < 16; ++i) { const f32x4 ei = *(const LAS f32x4*)(cb + RC_EF + (i * 64 + 4 * kq) * 4); tot = tot + ei; if (i <= t) inc = inc + ei; } \
            float At[4], Rt[4], Bh[4], Kh[4], Bt[4], Kt[4], Gt[4]; \
_Pragma("unroll") \
            for (int j = 0; j < 4; ++j) { const float Gi = __expf(-inc[j]), Ge = __expf(ev[j] - inc[j]), Gn = __expf(inc[j]); Gt[j] = __expf(-tot[j]); \
                At[j] = an[j] * Ge; Rt[j] = rs[j] * Gi; Bh[j] = bk[j] * Gn; Kh[j] = km[j] * Gn; Bt[j] = Bh[j] * Gt[j]; Kt[j] = Kh[j] * Gt[j]; } \
            *(LAS f32x4*)(cb + RC_ATF + (t * 68 + 4 * kq) * 4) = (f32x4){At[0], At[1], At[2], At[3]}; \
            *(LAS v2u*)(cb + RC_AT + (t * 72 + 4 * kq) * 2) = pack4(At); *(LAS v2u*)(cb + RC_RT + (t * 72 + 4 * kq) * 2) = pack4(Rt); \
            *(LAS v2u*)(cb + RC_BH + (t * 72 + 4 * kq) * 2) = pack4(Bh); *(LAS v2u*)(cb + RC_KH + (t * 72 + 4 * kq) * 2) = pack4(Kh); \
_Pragma("unroll") \
            for (int j = 0; j < 4; ++j) { *(LAS bf16*)(cb + RC_BTT + ((4 * kq + j) * 24 + t) * 2) = (bf16)f2bf(Bt[j]); *(LAS bf16*)(cb + RC_KTT + ((4 * kq + j) * 24 + t) * 2) = (bf16)f2bf(Kt[j]); } \
            if (t == 0) *(LAS f32x4*)(cb + RC_G15 + 4 * kq * 4) = (f32x4){Gt[0], Gt[1], Gt[2], Gt[3]}; \
        } \
        RC_BAR(); \
        {   LAS unsigned char* wb = lds + (wave >> 2) * RC_CH; const int pi = wave & 3; \
            const LAS bf16* Ap = (const LAS bf16*)(wb + (pi < 2 ? RC_AT : RC_RT)) + li * 72 + 8 * lq; const LAS bf16* Bp = (const LAS bf16*)(wb + ((pi & 1) ? RC_KH : RC_BH)) + li * 72 + 8 * lq; \
            f32x4 acc = {0.f, 0.f, 0.f, 0.f}; \
            acc = __builtin_amdgcn_mfma_f32_16x16x32_bf16(*(const LAS bf16x8*)Ap, *(const LAS bf16x8*)Bp, acc, 0, 0, 0); \
            acc = __builtin_amdgcn_mfma_f32_16x16x32_bf16(*(const LAS bf16x8*)(Ap + 32), *(const LAS bf16x8*)(Bp + 32), acc, 0, 0, 0); \
_Pragma("unroll") \
            for (int r = 0; r < 4; ++r) { const int tr = 4 * lq + r; if (pi < 2 ? !(li < tr) : !(li <= tr)) acc[r] = 0.f; } \
            if (pi == 0) *(LAS f32x4*)(wb + RC_PFT + (li * 16 + 4 * lq) * 4) = acc; \
            else if (pi == 1) { \
_Pragma("unroll") \
                for (int r = 0; r < 4; ++r) *(LAS float*)(wb + RC_QF + ((4 * lq + r) * 16 + li) * 4) = acc[r]; } \
            else { LAS bf16* o = (LAS bf16*)(wb + (pi == 2 ? RC_PRL : RC_QRL)); \
_Pragma("unroll") \
                for (int r = 0; r < 4; ++r) o[(4 * lq + r) * 24 + li] = (bf16)f2bf(acc[r]); } \
        } \
        RC_BAR(); \
        if (wave < 4) { \
            LAS unsigned char* wb = lds + (wave >> 1) * RC_CH; const bool isq = wave & 1; \
            float X[16]; \
_Pragma("unroll") \
            for (int r = 0; r < 16; ++r) X[r] = isq ? *(const LAS float*)(wb + RC_QF + (r * 16 + li) * 4) : *(const LAS float*)(wb + RC_ATF + (r * 68 + lane) * 4); \
_Pragma("unroll") \
            for (int j = 0; j < 15; ++j) { const LAS f32x4* pc = (const LAS f32x4*)(wb + RC_PFT + j * 64); const f32x4 c0v = pc[0], c1v = pc[1], c2v = pc[2], c3v = pc[3]; \
                const float c[16] = {c0v[0], c0v[1], c0v[2], c0v[3], c1v[0], c1v[1], c1v[2], c1v[3], c2v[0], c2v[1], c2v[2], c2v[3], c3v[0], c3v[1], c3v[2], c3v[3]}; \
_Pragma("unroll") \
                for (int r = j + 1; r < 16; ++r) X[r] = fmaf(c[r], X[j], X[r]); } \
            if (!isq) { LAS bf16* o = (LAS bf16*)(wb + RC_AH); \
_Pragma("unroll") \
                for (int r = 0; r < 16; ++r) o[r * 72 + lane] = (bf16)f2bf(X[r]); } \
            else if (lane < 16) { LAS bf16* o = (LAS bf16*)(wb + RC_TQL); \
_Pragma("unroll") \
                for (int r = 0; r < 16; ++r) o[r * 24 + lane] = (bf16)f2bf(X[r]); } \
        } \
        RC_BAR(); \
        { const int cc = tid >> 8, u = tid & 255; unsigned char* rec = rc_rec(ws, (size_t)bh_ * 512 + 2 * blk_ + cc); const LAS unsigned char* wb = lds + cc * RC_CH; \
          rc_copy_out(rec, wb, u); } \
        RC_BAR(); \
    } while (0)
#ifndef RS_NT
#define RS_NT 1
#endif
constexpr int RS_TILES = RS_NT;
struct RSOps { bf16x8 a01, a23, r01, r23, tq, pq, bk[4]; v2u vb[RS_TILES]; f32x4 g[4]; };
__device__ __forceinline__ void rs_load(const LAS unsigned char* wb, int wave, int li, int lq, RSOps& O) {
    O.a01 = *(const LAS bf16x8*)(wb + RS_AH + li * 144 + lq * 16); O.a23 = *(const LAS bf16x8*)(wb + RS_AH + li * 144 + 64 + lq * 16);
    O.r01 = *(const LAS bf16x8*)(wb + RS_RT + li * 144 + lq * 16); O.r23 = *(const LAS bf16x8*)(wb + RS_RT + li * 144 + 64 + lq * 16);
    O.pq = *(const LAS bf16x8*)(wb + RS_PQ + li * 80 + lq * 16);
    { const v2u t = *(const LAS v2u*)(wb + RS_TQL + li * 48 + lq * 8); v4u o; o.x = t.x; o.y = t.y; o.z = 0u; o.w = 0u; O.tq = __builtin_bit_cast(bf16x8, o); }
#pragma unroll
    for (int vt = 0; vt < RS_TILES; ++vt) O.vb[vt] = *(const LAS v2u*)(wb + RS_VS + (16 * (RS_TILES * wave + vt) + li) * 48 + lq * 8);
#pragma unroll
    for (int kt = 0; kt < 4; ++kt) { O.bk[kt] = *(const LAS bf16x8*)(wb + RS_BK + (16 * kt + li) * 80 + lq * 16); O.g[kt] = *(const LAS f32x4*)(wb + RS_G15 + (16 * kt + 4 * lq) * 4); }
}
#define RC_CHUNK(O, cc, yb) do { const v2u z2_ = {0u, 0u}; \
_Pragma("unroll") \
        for (int vt = 0; vt < RS_TILES; ++vt) {     \
            f32x4 aD = {0.f, 0.f, 0.f, 0.f}, aY = {0.f, 0.f, 0.f, 0.f}; \
            aD = __builtin_amdgcn_mfma_f32_16x16x32_bf16(O.tq, cat8(O.vb[vt], z2_), aD, 0, 0, 0); \
            aD = __builtin_amdgcn_mfma_f32_16x16x32_bf16(O.a01, Sb01[vt], aD, 0, 0, 0); \
            aD = __builtin_amdgcn_mfma_f32_16x16x32_bf16(O.a23, Sb23[vt], aD, 0, 0, 0); \
            aY = __builtin_amdgcn_mfma_f32_16x16x32_bf16(Sb01[vt], O.r01, aY, 0, 0, 0); \
            aY = __builtin_amdgcn_mfma_f32_16x16x32_bf16(Sb23[vt], O.r23, aY, 0, 0, 0); \
            const bf16x8 DV = cat8(pack4v(aD), O.vb[vt]); \
_Pragma("unroll") \
            for (int kt = 0; kt < 4; ++kt) Sacc[vt][kt] = __builtin_amdgcn_mfma_f32_16x16x32_bf16(O.bk[kt], DV, Sacc[vt][kt] * O.g[kt], 0, 0, 0); \
            aY = __builtin_amdgcn_mfma_f32_16x16x32_bf16(DV, O.pq, aY, 0, 0, 0); \
            Sb01[vt] = cat8(pack4v(Sacc[vt][0]), pack4v(Sacc[vt][1])); Sb23[vt] = cat8(pack4v(Sacc[vt][2]), pack4v(Sacc[vt][3])); \
            *(LAS v2u*)((yb) + (((cc) * 16 + li) * 72 + 16 * (RS_TILES * wave + vt) + 4 * lq) * 2) = pack4v(aY);     \
        } \
    } while (0)
#define RC_SCAN(slot, yb) do { { RSOps O0; rs_load(slot, wave, li, lq, O0); __builtin_amdgcn_sched_barrier(0); RC_CHUNK(O0, 0, yb); } \
        { RSOps O1; rs_load(slot + RS_CH, wave, li, lq, O1); __builtin_amdgcn_sched_barrier(0); RC_CHUNK(O1, 1, yb); } } while (0)

__device__ __forceinline__ void rc_issue_q(const unsigned char* ws, int l, int q, int blk0, int tid, RCRegs& R) {
    const int bh = q % (NB * NH), blk = blk0 + q / (NB * NH);
    rc_issue(ws, l, (size_t)(bh / NH) * SEQ + (size_t)blk * 32, bh % NH, tid, R);
}
template <bool ST12 = true>
__device__ __forceinline__ void phase_r2_build(KArgsP a, LAS unsigned char* lds, int tid, int lane, int wave, int vcu, int G, int l, int blk0 = 0, int nblk = SEQ / 32) {
    unsigned char* ws = a->ws;
    const int tt = tid >> 4, kq = tid & 15, ch = tt >> 4, t = tt & 15;
    const int lq = lane >> 4, li = lane & 15;
    LAS unsigned char* cb = lds + ch * RC_CH;
    const float* mu = a->in[I_RMU] + (size_t)l * RW_COLS;
    const float* pRKK = a->in[I_RKK] + (size_t)l * DBR; const float* pRKA = a->in[I_RKA] + (size_t)l * DBR; const float* pRRK = a->in[I_RRK] + (size_t)l * DBR;
    const float* pLNW = a->in[I_RLNW] + (size_t)l * DBR; const float* pLNB = a->in[I_RLNB] + (size_t)l * DBR;
    const int NQ = NB * NH * nblk;
    LAS float* cst = (LAS float*)(lds + 2 * RC_CH);
    __syncthreads();
    for (int i = tid; i < 8 * DBR; i += NTHR) { const int arr = i / DBR, c = i % DBR;
        cst[i] = arr == 0 ? pRKK[c] : arr == 1 ? pRKA[c] : arr == 2 ? pRRK[c] : arr == 3 ? pLNW[c] : arr == 4 ? pLNB[c] : mu[RWC_R + (arr - 5) * DBR + c]; }
    __syncthreads();
    RCRegs RA, RB;
    if (vcu < NQ) rc_issue_q(ws, l, vcu, blk0, tid, RA);
    if (vcu + G < NQ) rc_issue_q(ws, l, vcu + G, blk0, tid, RB);
    for (int q0 = vcu; q0 < NQ; q0 += 2 * G) { { const int q = q0; RC_BUILD(RA, q); } if (q0 + G < NQ) { const int q = q0 + G; RC_BUILD(RB, q); } }
}
#ifndef RS_DEPTH
#define RS_DEPTH 4
#endif
struct RSRegs { v4u p[6]; };
__device__ __forceinline__ unsigned char* ubase(const unsigned char* p) {
    const unsigned lo = __builtin_amdgcn_readfirstlane((unsigned)(uintptr_t)p), hi = __builtin_amdgcn_readfirstlane((unsigned)((uintptr_t)p >> 32));
    return (unsigned char*)(((uintptr_t)hi << 32) | lo);
}
struct RSOff { unsigned g[6], s[6]; };
__device__ __forceinline__ void rs_offsets(int lt, RSOff& F) {
#pragma unroll
    for (int j = 0; j < 6; ++j) { const int uu = min(lt + 256 * j, 2 * REC_UNITS - 1); const int cc = uu >= REC_UNITS, u = uu - cc * REC_UNITS;
        F.g[j] = uu * 16 + cc * (REC_BYTES - REC_UNITS * 16); F.s[j] = cc * RS_CH + rs_unit_off(u); }
}
__device__ __forceinline__ void rs_issue(unsigned char* ws, size_t cu0, const RSOff& F, RSRegs& R) {
    const unsigned char* base = ubase(rc_rec(ws, cu0));
#pragma unroll
    for (int j = 0; j < 6; ++j) R.p[j] = *(const GAS v4u*)(base + F.g[j]);
}
__device__ __forceinline__ void rs_store(LAS unsigned char* slot, const RSOff& F, const RSRegs& R) {
#pragma unroll
    for (int j = 0; j < 6; ++j) *(LAS v4u*)(slot + F.s[j]) = R.p[j];
}
struct R3Q { v4u a1, a2; };
__device__ __forceinline__ void r3q_issue(const unsigned char* ws, size_t row0, int h, int lt, R3Q& Q) {
    const unsigned off = (unsigned)(((lt >> 3) * DBR + 8 * (lt & 7)) * 2); const size_t ub = (row0 * DBR + h * 64) * 2;
    Q.a1 = *(const GAS v4u*)(ubase(ws + WS_RG + ub) + off); Q.a2 = *(const GAS v4u*)(ubase(ws + WS_RA + ub) + off);
}
__device__ __forceinline__ float dpp8sum(float x) {
    x += __builtin_bit_cast(float, __builtin_amdgcn_update_dpp(0, __builtin_bit_cast(int, x), 0xB1, 0xf, 0xf, false));
    x += __builtin_bit_cast(float, __builtin_amdgcn_update_dpp(0, __builtin_bit_cast(int, x), 0x4E, 0xf, 0xf, false));
    x += __builtin_bit_cast(float, __builtin_amdgcn_update_dpp(0, __builtin_bit_cast(int, x), 0x141, 0xf, 0xf, false));
    return x;
}
__device__ __forceinline__ void r3_block(const LAS unsigned char* yb, bf16* YC, size_t row0, int h, int lt, const R3Q& Q) {
    const int tk = lt >> 3, c8 = 8 * (lt & 7);
    const v4u yy = *(const LAS v4u*)(yb + (tk * 72 + c8) * 2);
    float d[8] = {bflo(yy.x), bfhi(yy.x), bflo(yy.y), bfhi(yy.y), bflo(yy.z), bfhi(yy.z), bflo(yy.w), bfhi(yy.w)};
    const float m = dpp8sum(((d[0] + d[1]) + (d[2] + d[3])) + ((d[4] + d[5]) + (d[6] + d[7]))) * (1.f / 64.f);
    float q = 0.f;
#pragma unroll
    for (int j = 0; j < 8; ++j) { d[j] -= m; q = fmaf(d[j], d[j], q); }
    const float rstd = rsqrtf(dpp8sum(q) * (1.f / 64.f) + RWKV_GN_EPS);
    const unsigned a1[4] = {Q.a1.x, Q.a1.y, Q.a1.z, Q.a1.w}, a2[4] = {Q.a2.x, Q.a2.y, Q.a2.z, Q.a2.w}; unsigned o[4];
#pragma unroll
    for (int j = 0; j < 4; ++j) o[j] = pk2(fmaf(d[2 * j] * rstd, bflo(a1[j]), bflo(a2[j])), fmaf(d[2 * j + 1] * rstd, bfhi(a1[j]), bfhi(a2[j])));
    v4u w; w.x = o[0]; w.y = o[1]; w.z = o[2]; w.w = o[3];
    *(GAS v4u*)(ubase((const unsigned char*)(YC + row0 * DM + 384 + h * 64)) + (unsigned)((tk * DM + c8) * 2)) = w;
}
template <int VAR = 0>
__device__ __forceinline__ void phase_r2_scan(KArgsP a, LAS unsigned char* lds, int tid, int lane, int wave, int wg, int l, int bsplit = SEQ / 32, unsigned nbuilders = 0u) {
    unsigned char* ws = a->ws; bf16* YC = (bf16*)(ws + WS_YC);
    const int b = wg / NH, h = wg % NH; const size_t rowb = (size_t)b * SEQ, cub = (size_t)wg * 512;
    const int lq = lane >> 4, li = lane & 15, lt = tid - 256; const bool loader = wave >= 4;
    f32x4 Sacc[RS_TILES][4]; bf16x8 Sb01[RS_TILES], Sb23[RS_TILES];
#pragma unroll
    for (int vt = 0; vt < RS_TILES; ++vt) {
#pragma unroll
        for (int kt = 0; kt < 4; ++kt) Sacc[vt][kt] = (f32x4){0.f, 0.f, 0.f, 0.f};
        Sb01[vt] = (bf16x8){0, 0, 0, 0, 0, 0, 0, 0}; Sb23[vt] = Sb01[vt]; }
    constexpr int NBLK = SEQ / 32;
    LAS unsigned char* yb0 = lds + 8 * RS_CH; LAS unsigned char* yb1 = yb0 + 32 * 72 * 2;
    static_assert(8 * RS_CH + 2 * 32 * 72 * 2 <= MISC_OFF, "scan LDS layout");
    if (wave < 4 / RS_TILES) {
        RSOps OA, OB;
        __builtin_amdgcn_s_setprio(3);
        RC_BAR();
        rs_load(lds, wave, li, lq, OA);
#pragma unroll 1
        for (int X = 0; X < NBLK; ++X) {
            LAS unsigned char* sl = lds + (X & 3) * 2 * RS_CH; LAS unsigned char* sn = lds + ((X + 1) & 3) * 2 * RS_CH; LAS unsigned char* yb = yb0 + (X & 1) * (32 * 72 * 2);
            if (X == bsplit - 7 && wave == 0) {
                if (lane == 0) { unsigned* bar_ = (unsigned*)(ws + WS_CTL) + CW_BAR; unsigned* cnt_ = (unsigned*)(ws + WS_CTL) + CW_Q + 64 * l + 48; XB_SPIN(xb_ld(cnt_) < nbuilders, bar_); }
                __builtin_amdgcn_fence(__ATOMIC_ACQUIRE, "agent"); asm volatile("s_waitcnt vmcnt(0)" ::: "memory");
            }
            rs_load(sl + RS_CH, wave, li, lq, OB); __builtin_amdgcn_sched_barrier(0); if (VAR != 2) { RC_CHUNK(OA, 0, yb); } else { asm volatile("" :: "v"(OA.a01), "v"(OA.bk[3]), "v"(OA.g[3])); }
            rs_load(sn, wave, li, lq, OA); __builtin_amdgcn_sched_barrier(0); if (VAR != 2) { RC_CHUNK(OB, 1, yb); } else { asm volatile("" :: "v"(OB.a01), "v"(OB.bk[3]), "v"(OB.g[3])); }
            RC_BAR();
        }
        __builtin_amdgcn_s_setprio(0);
    } else if (!loader) {
        RC_BAR();
        for (int X = 0; X < NBLK; ++X) RC_BAR();
    } else {
        constexpr int ND = 4;
        RSRegs R[ND]; R3Q Q[ND]; RSOff F; rs_offsets(lt, F);
#pragma unroll
        for (int j = 0; j < ND; ++j) { rs_issue(ws, cub + 2 * j, F, R[j]); r3q_issue(ws, rowb + 32 * j, h, lt, Q[j]); }
        rs_store(lds, F, R[0]); rs_issue(ws, cub + 2 * ND, F, R[0]); rs_store(lds + 2 * RS_CH, F, R[1]); rs_issue(ws, cub + 2 * (ND + 1), F, R[1]);
        RC_BAR();
        for (int bb = 0; bb < NBLK; bb += ND) {
#pragma unroll
            for (int j = 0; j < ND; ++j) { const int X = bb + j;
                if (VAR != 1) { r3_block((j & 1) ? yb0 : yb1, YC, rowb + (size_t)max(X - 1, 0) * 32, h, lt, Q[(j + ND - 1) % ND]);
                r3q_issue(ws, rowb + (size_t)min(X - 1 + ND, NBLK - 1) * 32, h, lt, Q[(j + ND - 1) % ND]); }
                rs_store(lds + ((j + 2) & 3) * 2 * RS_CH, F, R[(j + 2) % ND]);
                rs_issue(ws, cub + 2 * (size_t)min(X + 2 + ND, NBLK - 1), F, R[(j + 2) % ND]);
                RC_BAR();
            }
        }
        r3_block(yb1, YC, rowb + (size_t)(NBLK - 1) * 32, h, lt, Q[(NBLK - 1) % ND]);
    }
}
__device__ __forceinline__ void phase_r3(KArgsP a, int lane, int gw, int ngw, int l) {
    unsigned char* ws = a->ws; const bf16* PROJ = (const bf16*)(ws + WS_PROJ); bf16* YC = (bf16*)(ws + WS_YC);
    const bf16* RA = (const bf16*)(ws + WS_RA); const bf16* RG = (const bf16*)(ws + WS_RG); const bf16* RVG = (const bf16*)(ws + WS_RVG); const bf16* VF = (const bf16*)(ws + WS_VF);
    const float* mu = a->in[I_RMU] + (size_t)l * RW_COLS;
    for (size_t row = gw; row < NTOK; row += ngw) {
#pragma unroll
        for (int h = 0; h < NH; ++h) {
            const int c = h * 64 + lane;
            const float y = bf2f(YC[row * DM + 384 + c]);
            const float m = dpp_allsum(y) * (1.f / 64.f); const float d = y - m; const float var = dpp_allsum(d * d) * (1.f / 64.f);
            const float yn = d * rsqrtf(var + RWKV_GN_EPS) * a->in[I_RLNW][l * DBR + c] + a->in[I_RLNB][l * DBR + c];
            const float rs = rw_shift(PROJ, mu, row, RWC_R + c), ks = rw_shift(PROJ, mu, row, RWC_K + c); float v = rw_shift(PROJ, mu, row, RWC_V + c);
            if (l > 0) v = v + (bf2f(VF[row * DBR + c]) - v) * bf2f(RVG[row * DBR + c]);
            const float av = bf2f(RA[row * DBR + c]);
            const float km = ks * (1.f + (av - 1.f) * a->in[I_RKA][l * DBR + c]);
            const float rk = dpp_allsum(rs * km * a->in[I_RRK][l * DBR + c]);
            YC[row * DM + 384 + c] = (bf16)f2bf((yn + rk * v) * bf2f(RG[row * DBR + c]));
        }
    }
}

constexpr int PH_PER_LAYER = 10, PH_FINAL = 1 + 2 * PH_PER_LAYER, N_PHASES = PH_FINAL + 1;
constexpr int R2_WGS = 24;
__global__ void __launch_bounds__(NTHR, 2) fwd(Args args) {
    extern __shared__ __attribute__((aligned(16))) unsigned char lds_raw[];
    LAS unsigned char* lds = (LAS unsigned char*)lds_raw;
    volatile LAS unsigned* MISC = (volatile LAS unsigned*)(lds + MISC_OFF);
    const int tid0 = threadIdx.x;
    const int G = gridDim.x;
#define PHASE_IDS int tid_ = threadIdx.x; asm volatile("" : "+v"(tid_)); const int tid = tid_, lane = tid & 63, wave = __builtin_amdgcn_readfirstlane(tid >> 6); \
    int bx_ = blockIdx.x; asm volatile("" : "+s"(bx_)); const int bx = bx_; const int vcu = (G % 8 == 0) ? (bx % 8) * (G / 8) + bx / 8 : bx; (void)lane; (void)wave; (void)vcu; (void)bx;
    unsigned char* ws0 = fresh_args()->ws;
    for (int u = tid0; u < (LDS_BYTES - RING_BYTES) / 4; u += NTHR) ((LAS unsigned*)(lds + RING_BYTES))[u] = 0u;
    __syncthreads();
    XcdBarrier bar; bar.bar = (unsigned*)(ws0 + WS_CTL) + CW_BAR; bar.x = 0; bar.st = nullptr;
    if (!MK_PER_PHASE) bar = xcd_barrier_post((unsigned*)(ws0 + WS_CTL) + CW_BAR, MISC + 8);
#if MK_PER_PHASE
    const int lo = args.ph_lo, hi = args.ph_hi;
#define IN(k) (lo <= (k) && (k) < hi)
#else
#define IN(k) true
#endif
#define SEAM(k) do { if (IN(k) && IN((k) + 1)) { XcdBarrier b2 = bar; asm volatile("" : "+s"(b2.bar)); xcd_barrier(b2); } } while (0)

#ifndef GEMM_SP2
#define GEMM_SP2 true
#endif
#ifndef GEMM_ALIGN
#define GEMM_ALIGN true
#endif
#ifndef RS_DEPTH
#define RS_DEPTH 4
#endif
#ifndef R2_SPLIT
#define R2_SPLIT 160
#endif
#ifndef SCANVAR
#define SCANVAR 0
#endif
#ifndef DBL_SUB
#define DBL_SUB 0
#endif
#ifndef DBL_PHASE
#define DBL_PHASE (-1)
#endif
#ifndef REPN
#define REPN 2
#endif
#define SUBREP(k) _Pragma("nounroll") for (int q_ = 0; q_ < 1 + (REPN - 1) * (((k) == DBL_SUB) && l == 0); ++q_)
#define REP(k) for (int rep_ = 0; rep_ < ((k) == DBL_PHASE ? REPN : 1); ++rep_)
#define REPBAR if (rep_ > 0) { XcdBarrier b2 = bar; asm volatile("" : "+s"(b2.bar)); xcd_barrier(b2); }
    REP(0) if (IN(0)) { REPBAR KArgsP ap = fresh_args(); PHASE_IDS
_Pragma("nounroll")
 for (int q_ = 0; q_ < 1 + (REPN - 1) * (DBL_SUB == 12); ++q_) { phase_prologue(ap, lds, tid, lane, wave, vcu, G); __syncthreads(); } }
    SEAM(0);
#ifdef EXTRA_BAR
    for (int eb_ = 0; eb_ < EXTRA_BAR; ++eb_) { XcdBarrier b2 = bar; asm volatile("" : "+s"(b2.bar)); xcd_barrier(b2); }
#endif
#define LCONST 0
    {
        constexpr int l = LCONST; constexpr int pb = 1 + l * PH_PER_LAYER;
        REP(pb + 0) if (IN(pb + 0)) { REPBAR KArgsP ap = fresh_args(); PHASE_IDS unsigned char* ws = ap->ws; (void)ws;
            if (l == 0) { mod_finalize(ws, tid, G); SUBREP(6) { phase_rownorm<0, false>(ap, lds, tid, lane, wave, G, ap->in[I_X], ap->out, ap->in[I_NORM_MIX], true, 0, 0, 0); __syncthreads(); } }
            else {
#if EN_MOE
                phase_rownorm<0, true>(ap, lds, tid, lane, wave, G, ap->out, ap->out, ap->in[I_NORM_MIX] + l * DM, false, l, 0, l - 1);
#else
                phase_rownorm<0, false>(ap, lds, tid, lane, wave, G, ap->out, ap->out, ap->in[I_NORM_MIX] + l * DM, false, l, 0, l - 1);
#endif
            }
        }
        SEAM(pb + 0);
        REP(pb + 1) if (IN(pb + 1)) { REPBAR KArgsP ap = fresh_args(); PHASE_IDS unsigned char* ws = ap->ws; (void)ws;
            pg8::Gemm g{(const pg8::bf16_t*)(ws + WS_HN), (const pg8::bf16_t*)(ws + WS_WIN) + (size_t)l * NPROJ_PAD * DM, NTOK, NPROJ_PAD, DM};
            pg8::StaticOrder S; S.init(NTOK, NPROJ_PAD, G, bx);
            pg8::EpiProj E{(pg8::bf16_t*)(ws + WS_PROJ), (float*)(ws + WS_GATES)};
SUBREP(7) { pg8::gemm_phase<pg8::EpiProj, pg8::StaticOrder, GEMM_ALIGN, GEMM_SP2>(lds, g, S, E); __syncthreads(); }
        }
        SEAM(pb + 1);
        REP(pb + 2) if (IN(pb + 2)) { REPBAR KArgsP ap = fresh_args(); PHASE_IDS unsigned char* ws = ap->ws; (void)ws;
#if EN_MLSTM
            for (int q_ = 0; q_ < 1 + (REPN - 1) * ((DBL_SUB == 1) && l == 0); ++q_) { phase_m1(ap, lds, tid, lane, wave, vcu, G, l); __syncthreads(); }
            __syncthreads();
#endif
#if EN_S5
            phase_s1(ap, lds, tid, lane, wave, vcu, G, l); __syncthreads();
#if DBL_SUB == 2
            if (l == 0) { phase_s1(ap, lds, tid, lane, wave, vcu, G, l); __syncthreads(); phase_s1(ap, lds, tid, lane, wave, vcu, G, l); __syncthreads(); phase_s1(ap, lds, tid, lane, wave, vcu, G, l); __syncthreads(); phase_s1(ap, lds, tid, lane, wave, vcu, G, l); __syncthreads(); }
#endif
            __syncthreads();
#endif
#if EN_RWKV
            for (int q_ = 0; q_ < 1 + (REPN - 1) * ((DBL_SUB == 3) && l == 0); ++q_) { phase_r1(ap, lds, tid, lane, wave, vcu, G, l); __syncthreads(); }
#endif
        }
        SEAM(pb + 2);
        REP(pb + 3) if (IN(pb + 3)) { REPBAR KArgsP ap = fresh_args(); PHASE_IDS unsigned char* ws = ap->ws; (void)ws;
            phase_m2(ws, tid, vcu, G);
            phase_s2(ap, tid, vcu, G, l);
            __syncthreads();
            phase_r2_build(ap, lds, tid, lane, wave, vcu, G, l, 0, R2_SPLIT);
        }
        SEAM(pb + 3);
        REP(pb + 4) if (IN(pb + 4)) { REPBAR KArgsP ap = fresh_args(); PHASE_IDS unsigned char* ws = ap->ws; (void)ws;
            if (bx < R2_WGS) {
#if DBL_SUB == 4
                if (l == 0) { for (int q_ = 0; q_ < REPN - 1; ++q_) { phase_r2_scan<SCANVAR>(ap, lds, tid, lane, wave, bx, l, R2_SPLIT, (unsigned)(G - R2_WGS)); __syncthreads(); } }
#endif
                phase_r2_scan(ap, lds, tid, lane, wave, bx, l, R2_SPLIT, (unsigned)(G - R2_WGS)); __syncthreads(); }
            else {
                phase_r2_build(ap, lds, tid, lane, wave, bx - R2_WGS, G - R2_WGS, l, R2_SPLIT, SEQ / 32 - R2_SPLIT);
                asm volatile("s_waitcnt vmcnt(0)" ::: "memory"); __syncthreads();
                if (tid == 0) { __builtin_amdgcn_fence(__ATOMIC_RELEASE, "agent"); asm volatile("s_waitcnt vmcnt(0)" ::: "memory"); (void)xb_add((unsigned*)(ws + WS_CTL) + CW_Q + 64 * l + 48, 1u); }
                phase_s3(ap, lds, tid, lane, wave, 0, 1, l, (unsigned*)(ws + WS_CTL) + CW_Q + 64 * l + 32); __syncthreads();
            }
            {
                unsigned* qctr = (unsigned*)(ws + WS_CTL) + CW_Q + 64 * l; volatile LAS unsigned* qw = (volatile LAS unsigned*)(lds + MISC_OFF) + 16;
                unsigned nxt = 0u; if (tid == 0) nxt = __hip_atomic_fetch_add(qctr, 1u, __ATOMIC_RELAXED, __HIP_MEMORY_SCOPE_AGENT);
                for (;;) {
                    if (tid == 0) *qw = nxt;
                    __syncthreads();
                    const int u = (int)*qw;
                    __syncthreads();
                    if (u >= NUNIT_M) break;
                    if (tid == 0) nxt = __hip_atomic_fetch_add(qctr, 1u, __ATOMIC_RELAXED, __HIP_MEMORY_SCOPE_AGENT);
                    phase_m3(ap, lds, tid, lane, wave, u, NUNIT_M, l);
                }
            }
        }
        SEAM(pb + 4);
        REP(pb + 6) if (IN(pb + 6)) { REPBAR KArgsP ap = fresh_args(); PHASE_IDS unsigned char* ws = ap->ws; (void)ws;
            pg8::Gemm g{(const pg8::bf16_t*)(ws + WS_YC), (const pg8::bf16_t*)(ws + WS_WOUT) + (size_t)l * DM * DM, NTOK, DM, DM};
            pg8::StaticOrder S; S.init(NTOK, DM, G, bx);
            pg8::EpiResid E{l == 0 ? ap->in[I_X] : (const float*)ap->out, ap->out, (const float*)(ws + WS_MODF) + (size_t)l * 4 * 6144, 2048};
SUBREP(8) { pg8::gemm_phase<pg8::EpiResid, pg8::StaticOrder, GEMM_ALIGN, GEMM_SP2>(lds, g, S, E); __syncthreads(); }
        }
        SEAM(pb + 6);
#if EN_MOE
        REP(pb + 7) if (IN(pb + 7)) { REPBAR KArgsP ap = fresh_args(); PHASE_IDS phase_router(ap, lds, tid, lane, wave, G, l); __syncthreads();
            SUBREP(11) {
            moe_convert13(ap->in[I_MW1], ap->in[I_MW3], l, (bf16*)(ap->ws + WS_W13), vcu * NWAVES + wave, G * NWAVES, (LAS float*)(lds + wave * 16640), lane);
            moe_convert2(ap->in[I_MW2], l, (bf16*)(ap->ws + WS_W2), vcu * NWAVES + wave, G * NWAVES, (LAS float*)(lds + wave * 16640), lane); __syncthreads(); } }
        SEAM(pb + 7);
        REP(pb + 8) if (IN(pb + 8)) { REPBAR KArgsP ap = fresh_args(); PHASE_IDS unsigned char* ws = ap->ws; (void)ws;
            LAS int* ptab = (LAS int*)(lds + PTAB_OFF); LAS int* pst = ptab + 512; LAS int* cnt = pst + 32;
            build_ptab((const unsigned*)(ws + WS_CTL) + CW_CNT + l * 32, ptab, pst, cnt, tid);
            pg8::Gemm g{(const pg8::bf16_t*)(ws + WS_HN), (const pg8::bf16_t*)(ws + WS_W13), 0, 0, DM, (const int*)(ws + WS_LIST), ptab};
            pg8::MoeOrder S{ptab, G, vcu};
            pg8::EpiSwiglu E{(pg8::bf16_t*)(ws + WS_HMID)};
SUBREP(9) { pg8::gemm_phase<pg8::EpiSwiglu, pg8::MoeOrder, false, true, true>(lds, g, S, E); __syncthreads(); }
        }
        SEAM(pb + 8);
        REP(pb + 9) if (IN(pb + 9)) { REPBAR KArgsP ap = fresh_args(); PHASE_IDS unsigned char* ws = ap->ws; (void)ws;
            LAS int* ptab = (LAS int*)(lds + PTAB_OFF); LAS int* pst = ptab + 512; LAS int* cnt = pst + 32;
            build_ptab((const unsigned*)(ws + WS_CTL) + CW_CNT + l * 32, ptab, pst, cnt, tid);
            pg8::Gemm g{(const pg8::bf16_t*)(ws + WS_HMID), (const pg8::bf16_t*)(ws + WS_W2), 0, 0, DEXP};
            pg8::MoeOrder S{ptab, G, vcu};
            pg8::EpiMoeOut E{(pg8::bf16_t*)(ws + WS_YMOE), (const int*)(ws + WS_LIST), ptab};
SUBREP(10) { pg8::gemm_phase<pg8::EpiMoeOut, pg8::MoeOrder, true, true>(lds, g, S, E); __syncthreads(); }
        }
        SEAM(pb + 9);
#else
        SEAM(pb + 6); SEAM(pb + 7); SEAM(pb + 8); SEAM(pb + 9);
#endif
    }
#undef LCONST
#if N_LAYERS > 1
#define LCONST 1
    {
        constexpr int l = LCONST; constexpr int pb = 1 + l * PH_PER_LAYER;
        REP(pb + 0) if (IN(pb + 0)) { REPBAR KArgsP ap = fresh_args(); PHASE_IDS unsigned char* ws = ap->ws; (void)ws;
            if (l == 0) { mod_finalize(ws, tid, G); SUBREP(6) { phase_rownorm<0, false>(ap, lds, tid, lane, wave, G, ap->in[I_X], ap->out, ap->in[I_NORM_MIX], true, 0, 0, 0); __syncthreads(); } }
            else {
#if EN_MOE
                phase_rownorm<0, true>(ap, lds, tid, lane, wave, G, ap->out, ap->out, ap->in[I_NORM_MIX] + l * DM, false, l, 0, l - 1);
#else
                phase_rownorm<0, false>(ap, lds, tid, lane, wave, G, ap->out, ap->out, ap->in[I_NORM_MIX] + l * DM, false, l, 0, l - 1);
#endif
            }
        }
        SEAM(pb + 0);
        REP(pb + 1) if (IN(pb + 1)) { REPBAR KArgsP ap = fresh_args(); PHASE_IDS unsigned char* ws = ap->ws; (void)ws;
            pg8::Gemm g{(const pg8::bf16_t*)(ws + WS_HN), (const pg8::bf16_t*)(ws + WS_WIN) + (size_t)l * NPROJ_PAD * DM, NTOK, NPROJ_PAD, DM};
            pg8::StaticOrder S; S.init(NTOK, NPROJ_PAD, G, bx);
            pg8::EpiProj E{(pg8::bf16_t*)(ws + WS_PROJ), (float*)(ws + WS_GATES)};
SUBREP(7) { pg8::gemm_phase<pg8::EpiProj, pg8::StaticOrder, GEMM_ALIGN, GEMM_SP2>(lds, g, S, E); __syncthreads(); }
        }
        SEAM(pb + 1);
        REP(pb + 2) if (IN(pb + 2)) { REPBAR KArgsP ap = fresh_args(); PHASE_IDS unsigned char* ws = ap->ws; (void)ws;
#if EN_MLSTM
            for (int q_ = 0; q_ < 1 + (REPN - 1) * ((DBL_SUB == 1) && l == 0); ++q_) { phase_m1(ap, lds, tid, lane, wave, vcu, G, l); __syncthreads(); }
            __syncthreads();
#endif
#if EN_S5
            phase_s1(ap, lds, tid, lane, wave, vcu, G, l); __syncthreads();
#if DBL_SUB == 2
            if (l == 0) { phase_s1(ap, lds, tid, lane, wave, vcu, G, l); __syncthreads(); phase_s1(ap, lds, tid, lane, wave, vcu, G, l); __syncthreads(); phase_s1(ap, lds, tid, lane, wave, vcu, G, l); __syncthreads(); phase_s1(ap, lds, tid, lane, wave, vcu, G, l); __syncthreads(); }
#endif
            __syncthreads();
#endif
#if EN_RWKV
            for (int q_ = 0; q_ < 1 + (REPN - 1) * ((DBL_SUB == 3) && l == 0); ++q_) { phase_r1(ap, lds, tid, lane, wave, vcu, G, l); __syncthreads(); }
#endif
        }
        SEAM(pb + 2);
        REP(pb + 3) if (IN(pb + 3)) { REPBAR KArgsP ap = fresh_args(); PHASE_IDS unsigned char* ws = ap->ws; (void)ws;
            phase_m2(ws, tid, vcu, G);
            phase_s2(ap, tid, vcu, G, l);
            __syncthreads();
            phase_r2_build(ap, lds, tid, lane, wave, vcu, G, l, 0, R2_SPLIT);
        }
        SEAM(pb + 3);
        REP(pb + 4) if (IN(pb + 4)) { REPBAR KArgsP ap = fresh_args(); PHASE_IDS unsigned char* ws = ap->ws; (void)ws;
            if (bx < R2_WGS) {
#if DBL_SUB == 4
                if (l == 0) { for (int q_ = 0; q_ < REPN - 1; ++q_) { phase_r2_scan<SCANVAR>(ap, lds, tid, lane, wave, bx, l, R2_SPLIT, (unsigned)(G - R2_WGS)); __syncthreads(); } }
#endif
                phase_r2_scan(ap, lds, tid, lane, wave, bx, l, R2_SPLIT, (unsigned)(G - R2_WGS)); __syncthreads(); }
            else {
                phase_r2_build(ap, lds, tid, lane, wave, bx - R2_WGS, G - R2_WGS, l, R2_SPLIT, SEQ / 32 - R2_SPLIT);
                asm volatile("s_waitcnt vmcnt(0)" ::: "memory"); __syncthreads();
                if (tid == 0) { __builtin_amdgcn_fence(__ATOMIC_RELEASE, "agent"); asm volatile("s_waitcnt vmcnt(0)" ::: "memory"); (void)xb_add((unsigned*)(ws + WS_CTL) + CW_Q + 64 * l + 48, 1u); }
                phase_s3(ap, lds, tid, lane, wave, 0, 1, l, (unsigned*)(ws + WS_CTL) + CW_Q + 64 * l + 32); __syncthreads();
            }
            {
                unsigned* qctr = (unsigned*)(ws + WS_CTL) + CW_Q + 64 * l; volatile LAS unsigned* qw = (volatile LAS unsigned*)(lds + MISC_OFF) + 16;
                unsigned nxt = 0u; if (tid == 0) nxt = __hip_atomic_fetch_add(qctr, 1u, __ATOMIC_RELAXED, __HIP_MEMORY_SCOPE_AGENT);
                for (;;) {
                    if (tid == 0) *qw = nxt;
                    __syncthreads();
                    const int u = (int)*qw;
                    __syncthreads();
                    if (u >= NUNIT_M) break;
                    if (tid == 0) nxt = __hip_atomic_fetch_add(qctr, 1u, __ATOMIC_RELAXED, __HIP_MEMORY_SCOPE_AGENT);
                    phase_m3(ap, lds, tid, lane, wave, u, NUNIT_M, l);
                }
            }
        }
        SEAM(pb + 4);
        REP(pb + 6) if (IN(pb + 6)) { REPBAR KArgsP ap = fresh_args(); PHASE_IDS unsigned char* ws = ap->ws; (void)ws;
            pg8::Gemm g{(const pg8::bf16_t*)(ws + WS_YC), (const pg8::bf16_t*)(ws + WS_WOUT) + (size_t)l * DM * DM, NTOK, DM, DM};
            pg8::StaticOrder S; S.init(NTOK, DM, G, bx);
            pg8::EpiResid E{l == 0 ? ap->in[I_X] : (const float*)ap->out, ap->out, (const float*)(ws + WS_MODF) + (size_t)l * 4 * 6144, 2048};
SUBREP(8) { pg8::gemm_phase<pg8::EpiResid, pg8::StaticOrder, GEMM_ALIGN, GEMM_SP2>(lds, g, S, E); __syncthreads(); }
        }
        SEAM(pb + 6);
#if EN_MOE
        REP(pb + 7) if (IN(pb + 7)) { REPBAR KArgsP ap = fresh_args(); PHASE_IDS phase_router(ap, lds, tid, lane, wave, G, l); __syncthreads();
            SUBREP(11) {
            moe_convert13(ap->in[I_MW1], ap->in[I_MW3], l, (bf16*)(ap->ws + WS_W13), vcu * NWAVES + wave, G * NWAVES, (LAS float*)(lds + wave * 16640), lane);
            moe_convert2(ap->in[I_MW2], l, (bf16*)(ap->ws + WS_W2), vcu * NWAVES + wave, G * NWAVES, (LAS float*)(lds + wave * 16640), lane); __syncthreads(); } }
        SEAM(pb + 7);
        REP(pb + 8) if (IN(pb + 8)) { REPBAR KArgsP ap = fresh_args(); PHASE_IDS unsigned char* ws = ap->ws; (void)ws;
            LAS int* ptab = (LAS int*)(lds + PTAB_OFF); LAS int* pst = ptab + 512; LAS int* cnt = pst + 32;
            build_ptab((const unsigned*)(ws + WS_CTL) + CW_CNT + l * 32, ptab, pst, cnt, tid);
            pg8::Gemm g{(const pg8::bf16_t*)(ws + WS_HN), (const pg8::bf16_t*)(ws + WS_W13), 0, 0, DM, (const int*)(ws + WS_LIST), ptab};
            pg8::MoeOrder S{ptab, G, vcu};
            pg8::EpiSwiglu E{(pg8::bf16_t*)(ws + WS_HMID)};
SUBREP(9) { pg8::gemm_phase<pg8::EpiSwiglu, pg8::MoeOrder, false, true, true>(lds, g, S, E); __syncthreads(); }
        }
        SEAM(pb + 8);
        REP(pb + 9) if (IN(pb + 9)) { REPBAR KArgsP ap = fresh_args(); PHASE_IDS unsigned char* ws = ap->ws; (void)ws;
            LAS int* ptab = (LAS int*)(lds + PTAB_OFF); LAS int* pst = ptab + 512; LAS int* cnt = pst + 32;
            build_ptab((const unsigned*)(ws + WS_CTL) + CW_CNT + l * 32, ptab, pst, cnt, tid);
            pg8::Gemm g{(const pg8::bf16_t*)(ws + WS_HMID), (const pg8::bf16_t*)(ws + WS_W2), 0, 0, DEXP};
            pg8::MoeOrder S{ptab, G, vcu};
            pg8::EpiMoeOut E{(pg8::bf16_t*)(ws + WS_YMOE), (const int*)(ws + WS_LIST), ptab};
SUBREP(10) { pg8::gemm_phase<pg8::EpiMoeOut, pg8::MoeOrder, true, true>(lds, g, S, E); __syncthreads(); }
        }
        SEAM(pb + 9);
#else
        SEAM(pb + 6); SEAM(pb + 7); SEAM(pb + 8); SEAM(pb + 9);
#endif
    }
#undef LCONST
#endif
    if (IN(PH_FINAL)) { KArgsP ap = fresh_args(); PHASE_IDS
#if EN_MOE
        if (N_LAYERS > 0) phase_rownorm<1, true>(ap, lds, tid, lane, wave, G, ap->out, ap->out, ap->in[I_NORM_FINAL], false, 0, 0, N_LAYERS - 1);
        else phase_rownorm<1, false>(ap, lds, tid, lane, wave, G, ap->in[I_X], ap->out, ap->in[I_NORM_FINAL], false, 0, 0, 0);
#else
        phase_rownorm<1, false>(ap, lds, tid, lane, wave, G, N_LAYERS > 0 ? (const float*)ap->out : ap->in[I_X], ap->out, ap->in[I_NORM_FINAL], false, 0, 0, 0);
#endif
    }
#undef IN
#undef SEAM
}

extern "C" void kernel_launch(void* const* d_in, const int* in_sizes, int n_in, void* d_out, int out_size, void* d_ws, size_t ws_size, hipStream_t stream) {
    static int grid = 0;
    if (grid == 0) {
        if (n_in != 47 || out_size != NTOK * DM || ws_size < WS_END) { fprintf(stderr, "kernel_launch: unexpected problem (n_in %d, out %d, ws %zu < %zu)\n", n_in, out_size, ws_size, (size_t)WS_END); grid = -1; return; }
        int dev = 0, cus = 0, per_cu = 0;
        if (hipGetDevice(&dev) != hipSuccess || hipDeviceGetAttribute(&cus, hipDeviceAttributeMultiprocessorCount, dev) != hipSuccess) { grid = -1; return; }
        if (hipFuncSetAttribute((const void*)fwd, hipFuncAttributeMaxDynamicSharedMemorySize, LDS_BYTES) != hipSuccess) { fprintf(stderr, "kernel_launch: hipFuncSetAttribute failed\n"); grid = -1; return; }
        if (hipOccupancyMaxActiveBlocksPerMultiprocessor(&per_cu, (const void*)fwd, NTHR, LDS_BYTES) != hipSuccess || per_cu < 1) fprintf(stderr, "kernel_launch: occupancy query says %d\n", per_cu);
        (void)hipGetLastError();
        grid = cus;
        if (grid != 256) fprintf(stderr, "kernel_launch: %d CUs (built for 256)\n", grid);
    }
    if (grid < 0) return;
    (void)hipMemsetAsync((char*)d_ws + WS_CTL, 0, CTL_ZERO_BYTES, stream);
    Args a{};
    for (int i = 0; i < 47; ++i) a.in[i] = (const float*)d_in[i];
    a.out = (float*)d_out; a.ws = (unsigned char*)d_ws;
#if MK_PER_PHASE
    for (int p = 0; p < N_PHASES; ++p) { a.ph_lo = p; a.ph_hi = p + 1; hipLaunchKernelGGL(fwd, dim3(grid), dim3(NTHR), LDS_BYTES, stream, a); }
#else
    a.ph_lo = 0; a.ph_hi = N_PHASES; hipLaunchKernelGGL(fwd, dim3(grid), dim3(NTHR), LDS_BYTES, stream, a);
#endif
}
#ifdef DIAG_KERNELS
#define DK(name, ...) __global__ void __launch_bounds__(NTHR, 2) name(Args args) { extern __shared__ __attribute__((aligned(16))) unsigned char lds_raw[]; LAS unsigned char* lds = (LAS unsigned char*)lds_raw; \
    const int tid = threadIdx.x, lane = tid & 63, wave = __builtin_amdgcn_readfirstlane(tid >> 6); const int G = gridDim.x; const int bx = blockIdx.x; const int vcu = bx; KArgsP ap = fresh_args(); int l = ap->ph_lo; (void)lane; (void)wave; (void)vcu; (void)G; (void)l; __VA_ARGS__ }
DK(k_prologue, phase_prologue(ap, lds, tid, lane, wave, vcu, G);)
DK(k_norm0, phase_rownorm<0, false>(ap, lds, tid, lane, wave, G, ap->in[I_X], ap->out, ap->in[I_NORM_MIX], true, 0, 0, 0);)
DK(k_norm1, phase_rownorm<0, true>(ap, lds, tid, lane, wave, G, ap->out, ap->out, ap->in[I_NORM_MIX], false, l, 0, 0);)
DK(k_normf, phase_rownorm<1, true>(ap, lds, tid, lane, wave, G, ap->out, ap->out, ap->in[I_NORM_MIX], false, l, 0, 0);)
DK(k_m1, phase_m1(ap, lds, tid, lane, wave, vcu, G, l);)
DK(k_m2, phase_m2(ap->ws, tid, vcu, G);)
DK(k_m3, phase_m3(ap, lds, tid, lane, wave, vcu, G, l);)
DK(k_s1, phase_s1(ap, lds, tid, lane, wave, vcu, G, l);)
DK(k_s2, phase_s2(ap, tid, vcu, G, l);)
DK(k_s3, phase_s3(ap, lds, tid, lane, wave, vcu, G, l);)
DK(k_r1, phase_r1(ap, lds, tid, lane, wave, vcu, G, l);)
DK(k_r2b, phase_r2_build(ap, lds, tid, lane, wave, vcu, G, l);)
DK(k_r2s, phase_r2_scan(ap, lds, tid, lane, wave, vcu, l);)
DK(k_r3, phase_r3(ap, lane, vcu * NWAVES + wave, G * NWAVES, l);)
DK(k_router, phase_router(ap, lds, tid, lane, wave, G, l);)
DK(k_gather, phase_gather(ap, lds, tid, lane, wave, vcu, G, l);)
DK(k_moecv, moe_convert13(ap->in[I_MW1], ap->in[I_MW3], 1, (bf16*)(ap->ws + WS_W13), vcu * NWAVES + wave, G * NWAVES, (LAS float*)(lds + wave * 16640), lane);)
#endif
```

```cpp
#include <hip/hip_runtime.h>
#include <cstdio>
#include <cstdint>
#define MK_PER_PHASE 0

#ifndef MK_PER_PHASE
#define MK_PER_PHASE 0
#endif
#ifndef EN_MLSTM
#define EN_MLSTM 1
#endif
#ifndef EN_S5
#define EN_S5 1
#endif
#ifndef EN_RWKV
#define EN_RWKV 1
#endif
#ifndef EN_MOE
#define EN_MOE 1
#endif
#ifndef N_LAYERS
#define N_LAYERS 2
#endif
constexpr int NWAVES = 8, NTHR = 512;
constexpr int DM = 1024, NB = 4, SEQ = 8192, NTOK = NB * SEQ;
constexpr int DA = 384, DBR = 384, DC = 256, NH = 6, HD = 64, NCH = SEQ / 64;
constexpr int IN_COLS = 2828, NPROJ = 2816, NPROJ_PAD = 3072;
constexpr int PC_QK = 0, PC_V = 384, PC_O = 768, PC_RW = 1152, PC_S5 = 2560;
constexpr int RWC_R = 0, RWC_K = 384, RWC_V = 768, RWC_WD = 1152, RWC_AD = 1216, RWC_GD = 1280, RW_COLS = 1408;
constexpr int NEXP = 32, DEXP = 512, MOE_ROWS_MAX = 73728;
constexpr int NUNIT_M = NB * NCH * NH;
constexpr int CL_STRIDE = 4160;
constexpr float NORM_EPS = 1e-6f, HEAD_NORM_EPS = 1e-5f, RWKV_GN_EPS = 64e-5f;

constexpr size_t MiB = 1u << 20;
constexpr size_t WS_CTL = 0, CTL_ZERO_BYTES = 64 * 1024;
constexpr size_t WS_MODP = 1 * MiB;
constexpr size_t WS_MODF = 2 * MiB + 512 * 1024;
constexpr size_t WS_S5BB = 2 * MiB + 896 * 1024;
constexpr size_t WS_RTW = 3 * MiB;
constexpr size_t WS_S5AP = 3 * MiB + 384 * 1024;
constexpr size_t WS_MLW = 3 * MiB + 512 * 1024;
constexpr size_t WS_S5CM = 2 * MiB + 768 * 1024;
constexpr size_t WS_GLUT = 3 * MiB + 768 * 1024;
constexpr size_t WS_WIN = 4 * MiB;
constexpr size_t WS_WOUT = 16 * MiB;
constexpr size_t WS_GATES = 20 * MiB;
constexpr size_t WS_W13 = 22 * MiB;
constexpr size_t WS_W2 = 86 * MiB;
constexpr size_t WS_HN = 118 * MiB;
constexpr size_t WS_CLOC = 118 * MiB;
constexpr size_t WS_MSC = 168 * MiB;
constexpr size_t WS_S5ST = 170 * MiB;
constexpr size_t WS_VF = 182 * MiB;
constexpr size_t WS_YC = 206 * MiB;
constexpr size_t WS_LIST = 206 * MiB;
constexpr size_t WS_ROWMAP = 214 * MiB;
constexpr size_t WS_TOKE = 215 * MiB;
constexpr size_t WS_TOKW = 215 * MiB + 512 * 1024;
constexpr size_t WS_PROJ = 270 * MiB;
constexpr size_t WS_RE = 446 * MiB, WS_RA = 470 * MiB, WS_RG = 494 * MiB, WS_RVG = 518 * MiB;
constexpr size_t WS_XG = 270 * MiB;
constexpr size_t WS_HMID = 414 * MiB;
constexpr size_t WS_YMOE = 270 * MiB;
constexpr size_t WS_R1W = 542 * MiB;
constexpr size_t WS_OPA = 22 * MiB;
constexpr size_t WS_OPB = 543 * MiB;
constexpr size_t WS_END = 591 * MiB;
constexpr int CW_TMO = 0, CW_BAR = 4096, CW_CNT = 8192, CW_Q = 8320;

constexpr int RING_BYTES = 131072, MISC_OFF = 135168, PTAB_OFF = MISC_OFF + 1024, LDS_BYTES = 147456;

#define GAS __attribute__((address_space(1)))
#define LAS __attribute__((address_space(3)))
typedef unsigned short bf16;
typedef unsigned v4u __attribute__((ext_vector_type(4)));
typedef unsigned v2u __attribute__((ext_vector_type(2)));
typedef float f32x4 __attribute__((ext_vector_type(4)));
typedef float f32x2 __attribute__((ext_vector_type(2)));
typedef GAS unsigned gu32;
#define RLX_AGENT __ATOMIC_RELAXED, __HIP_MEMORY_SCOPE_AGENT
#define LDS_WAIT() asm volatile("s_waitcnt lgkmcnt(0)" ::: "memory")
#define VM_WAIT() asm volatile("s_waitcnt vmcnt(0)" ::: "memory")
typedef float f32x2v __attribute__((ext_vector_type(2)));
typedef __bf16 bf16x2v __attribute__((ext_vector_type(2)));
__device__ __forceinline__ unsigned pk2(float lo, float hi) { const f32x2v v = {lo, hi}; const bf16x2v b = __builtin_convertvector(v, bf16x2v); return __builtin_bit_cast(unsigned, b); }
__device__ __forceinline__ unsigned f2bf(float f) { return pk2(f, 0.f) & 0xffffu; }
__device__ __forceinline__ float bf2f(unsigned v) { return __builtin_bit_cast(float, v << 16); }
__device__ __forceinline__ float bflo(unsigned w) { return __builtin_bit_cast(float, w << 16); }
__device__ __forceinline__ float bfhi(unsigned w) { return __builtin_bit_cast(float, w & 0xffff0000u); }
__device__ __forceinline__ float sigmoidf_(float x) { return 1.f / (1.f + __expf(-x)); }
__device__ __forceinline__ float wave_sum(float v) {
#pragma unroll
    for (int o = 1; o < 64; o <<= 1) v += __shfl_xor(v, o);
    return v;
}
__device__ __forceinline__ float wave_max(float v) {
#pragma unroll
    for (int o = 1; o < 64; o <<= 1) v = fmaxf(v, __shfl_xor(v, o));
    return v;
}
namespace pg8 {
#define PG8_LAS __attribute__((address_space(3)))
typedef unsigned short bf16_t;
typedef short bf16x8 __attribute__((ext_vector_type(8)));
typedef float f32x4 __attribute__((ext_vector_type(4)));
typedef unsigned u32x4 __attribute__((ext_vector_type(4)));
constexpr int BM = 256, BK = 64, HALF = 128, HTB = HALF * BK * 2  , STAGE_BYTES = 8 * HTB, NXCD = 8, WGM = 8;

__host__ __device__ __forceinline__ int lds_byte(int r, int c) { const int st = (r >> 4) * 2 + (c >> 5), rr = r & 15, cc = c & 31, ob = rr * 64 + cc * 2; return st * 1024 + (ob ^ (((ob >> 9) & 1) << 5)); }
__host__ __device__ __forceinline__ void stage_rc(int b, int& R, int& C) { const int st = b / 1024, sb = b % 1024, swz = sb ^ (((sb >> 9) & 1) << 5); R = (st >> 1) * 16 + swz / 64; C = (st & 1) * 32 + (swz % 64) / 2; }
__host__ __device__ __forceinline__ int perm32(int rho) { const int n = rho >> 4, i = rho & 15; return 8 * (i >> 2) + 4 * n + (i & 3); }

struct Unit { int pm, pn; };
__device__ __forceinline__ int moe_tok2(const int* list, PG8_LAS const int* ptab, int row) { const int e = ptab[1 + (row >> 8)], pos = row - ptab[512 + e]; return pos < ptab[544 + e] ? list[(size_t)e * 65536 + pos] : -1; }
struct Gemm { const bf16_t* A; const bf16_t* Bt; int M, N, K; const int* list = nullptr; PG8_LAS const int* ptab = nullptr; };

struct StaticOrder {
    int nM, nN, nwg, G, c;
    __host__ __device__ void init(int M, int N, int G_, int c_) { nM = M / BM; nN = N / BM; nwg = nM * nN; G = G_; c = c_; }
    __host__ __device__ bool next(int i, Unit& u) const {
        const long L = (long)i * G + c; if (L >= nwg) return false;
        int wgid = (int)L; { const int q = nwg / NXCD, r = nwg % NXCD, xcd = wgid % NXCD, off = wgid / NXCD; wgid = (xcd < r ? xcd * (q + 1) : r * (q + 1) + (xcd - r) * q) + off; }
        const int nig = WGM * nN, gid = wgid / nig, fm = gid * WGM, gsz = (nM - fm) < WGM ? (nM - fm) : WGM;
        u.pm = fm + ((wgid % nig) % gsz); u.pn = (wgid % nig) / gsz; return true;
    }
    __device__ __forceinline__ void a_ready(const Unit&) const {}
    __device__ __forceinline__ void done(const Unit&) const {}
};

__device__ __forceinline__ unsigned cvt_pk_bf16(float lo, float hi) { unsigned r; asm volatile("v_cvt_pk_bf16_f32 %0, %1, %2" : "=v"(r) : "v"(lo), "v"(hi)); return r; }

struct EpiProj {
    static constexpr bool PERM = true, AFTER_DRAIN = false;
    bf16_t* O; float* G;
    __device__ __forceinline__ void operator()(const f32x4 (&acc)[2][2][4][2], const Unit& u, int wr, int wc, int fr, int fq) const {
        const int row0 = u.pm * BM + wr * 64 + fr;
        if (u.pn < 11) {
            const int col0 = u.pn * BM + wc * 32 + 8 * fq;
#pragma unroll
            for (int ai = 0; ai < 2; ++ai)
#pragma unroll
                for (int m = 0; m < 4; ++m) { bf16_t* rowp = O + (size_t)(row0 + ai * HALF + m * 16) * 2816 + col0;
#pragma unroll
                    for (int bj = 0; bj < 2; ++bj) { const f32x4 v0 = acc[ai][bj][m][0], v1 = acc[ai][bj][m][1];
                        u32x4 w; w.x = cvt_pk_bf16(v0[0], v0[1]); w.y = cvt_pk_bf16(v0[2], v0[3]); w.z = cvt_pk_bf16(v1[0], v1[1]); w.w = cvt_pk_bf16(v1[2], v1[3]);
                        *(u32x4*)(rowp + bj * HALF) = w; } }
        } else if (wc == 0 && fq < 2) {
#pragma unroll
            for (int ai = 0; ai < 2; ++ai)
#pragma unroll
                for (int m = 0; m < 4; ++m) { float* rowp = G + (size_t)(row0 + ai * HALF + m * 16) * 16 + 8 * fq;
                    *(f32x4*)(rowp) = acc[ai][0][m][0]; *(f32x4*)(rowp + 4) = acc[ai][0][m][1]; }
        }
    }
};
struct EpiResid {
    static constexpr bool PERM = true, AFTER_DRAIN = false;
    const float* xin; float* out; const float* gate;
    int goff;
    __device__ __forceinline__ void operator()(const f32x4 (&acc)[2][2][4][2], const Unit& u, int wr, int wc, int fr, int fq) const {
        const int row0 = u.pm * BM + wr * 64 + fr, col0 = u.pn * BM + wc * 32 + 8 * fq;
        const float* gp = gate + (size_t)(row0 >> 13) * 6144 + goff + col0;
        f32x4 g[2][2];
#pragma unroll
        for (int bj = 0; bj < 2; ++bj)
#pragma unroll
            for (int n = 0; n < 2; ++n) g[bj][n] = *(const f32x4*)(gp + bj * HALF + 4 * n) + 1.0f;
#pragma unroll
        for (int ai = 0; ai < 2; ++ai) { f32x4 xv[4][2][2];
#pragma unroll
            for (int m = 0; m < 4; ++m) { const size_t off = (size_t)(row0 + ai * HALF + m * 16) * 1024 + col0;
#pragma unroll
                for (int bj = 0; bj < 2; ++bj)
#pragma unroll
                    for (int n = 0; n < 2; ++n) xv[m][bj][n] = *(const f32x4*)(xin + off + bj * HALF + 4 * n); }
#pragma unroll
            for (int m = 0; m < 4; ++m) { const size_t off = (size_t)(row0 + ai * HALF + m * 16) * 1024 + col0;
#pragma unroll
                for (int bj = 0; bj < 2; ++bj)
#pragma unroll
                    for (int n = 0; n < 2; ++n) *(f32x4*)(out + off + bj * HALF + 4 * n) = xv[m][bj][n] + g[bj][n] * acc[ai][bj][m][n]; } }
    }
};
struct EpiSwiglu {
    static constexpr bool PERM = true, AFTER_DRAIN = false;
    bf16_t* H;
    __device__ __forceinline__ void operator()(const f32x4 (&acc)[2][2][4][2], const Unit& u, int wr, int wc, int fr, int fq) const {
        const int row0 = u.pm * BM + wr * 64 + fr, hid0 = 128 * (u.pn & 3) + 16 * wc + 4 * fq;
#pragma unroll
        for (int ai = 0; ai < 2; ++ai)
#pragma unroll
            for (int m = 0; m < 4; ++m) { bf16_t* rowp = H + (size_t)(row0 + ai * HALF + m * 16) * 512 + hid0;
#pragma unroll
                for (int bj = 0; bj < 2; ++bj) { const f32x4 g = acc[ai][bj][m][0], uu = acc[ai][bj][m][1]; float h[4];
#pragma unroll
                    for (int i = 0; i < 4; ++i) h[i] = g[i] / (1.f + __expf(-g[i])) * uu[i];
                    unsigned w0 = cvt_pk_bf16(h[0], h[1]), w1 = cvt_pk_bf16(h[2], h[3]);
                    *(unsigned long long*)(rowp + 64 * bj) = (unsigned long long)w0 | ((unsigned long long)w1 << 32); } }
    }
};
struct EpiMoeOut {
    static constexpr bool PERM = true, AFTER_DRAIN = false;
    bf16_t* Y; const int* list; PG8_LAS const int* ptab;
    __device__ __forceinline__ void operator()(const f32x4 (&acc)[2][2][4][2], const Unit& u, int wr, int wc, int fr, int fq) const {
        const int row0 = u.pm * BM + wr * 64 + fr, col0 = (u.pn & 3) * BM + wc * 32 + 8 * fq;
        int dsts[2][4];
#pragma unroll
        for (int ai = 0; ai < 2; ++ai)
#pragma unroll
            for (int m = 0; m < 4; ++m) dsts[ai][m] = moe_tok2(list, ptab, row0 + ai * HALF + m * 16);
#pragma unroll
        for (int ai = 0; ai < 2; ++ai)
#pragma unroll
            for (int m = 0; m < 4; ++m) { const int dst = dsts[ai][m];
                if (dst >= 0) { bf16_t* rowp = Y + (size_t)dst * 1024 + col0;
#pragma unroll
                    for (int bj = 0; bj < 2; ++bj) { const f32x4 v0 = acc[ai][bj][m][0], v1 = acc[ai][bj][m][1];
                        u32x4 w; w.x = cvt_pk_bf16(v0[0], v0[1]); w.y = cvt_pk_bf16(v0[2], v0[3]); w.z = cvt_pk_bf16(v1[0], v1[1]); w.w = cvt_pk_bf16(v1[2], v1[3]);
                        *(u32x4*)(rowp + bj * HALF) = w; } } }
    }
};
struct MoeOrder {
    PG8_LAS const int* ptab; int G, c;
    __device__ __forceinline__ bool next(int i, Unit& u) const {
        const int L = i * G + c, np = __builtin_amdgcn_readfirstlane(ptab[0]);
        if (L >= np * 4) return false;
        const int p = L >> 2; u.pm = p; u.pn = __builtin_amdgcn_readfirstlane(ptab[1 + p]) * 4 + (L & 3); return true;
    }
    __device__ __forceinline__ void a_ready(const Unit&) const {}
    __device__ __forceinline__ void done(const Unit&) const {}
};
template <class Epi, class Sched, bool ALIGN_EPI = false, bool SP2 = false, bool GATHER = false>
__device__ __forceinline__ void gemm_phase(PG8_LAS unsigned char* lds, const Gemm g, const Sched& S, const Epi& E) {
    int tid_ = threadIdx.x; asm volatile("" : "+v"(tid_));
    const int tid = tid_, wid = __builtin_amdgcn_readfirstlane(tid >> 6), lane = tid & 63, wr = wid >> 2, wc = wid & 3, fr = lane & 15, fq = lane >> 4;
    const int K = g.K, nt = K / BK;
    static_assert(!GATHER || SP2, "the gathered-A variant exists for the SP2 loop only");
    unsigned voffA[2], voffB[2];
    unsigned vAc[2] = {0u, 0u}, vAn[2] = {0u, 0u};
#pragma unroll
    for (int i = 0; i < 2; ++i) { int R, C; stage_rc(tid * 16 + i * 8192, R, C); const int Rb = Epi::PERM ? ((R & ~31) + perm32(R & 31)) : R;
        voffA[i] = (unsigned)(R * K + C) * 2u; voffB[i] = (unsigned)(Rb * K + C) * 2u; }
    const size_t kstep = (size_t)(BK * 2);
    const size_t hstep = (size_t)HALF * K * 2;
    const size_t tstep = 2 * hstep;
    const unsigned ldsw = (unsigned)wid * 1024u;
    const int aoff = lds_byte(wr * 64 + fr, fq * 8), boff = lds_byte(wc * 32 + fr, fq * 8);
#define PG8_SA(b, h) (((b) * 2 + (h)) * HTB)
#define PG8_SB(b, h) ((4 + (b) * 2 + (h)) * HTB)
#define PG8_STAGE(bufoff, gbase, voff) do { _Pragma("unroll") for (int _i = 0; _i < 2; ++_i) \
        __builtin_amdgcn_global_load_lds((const unsigned*)((const char*)(gbase) + (voff)[_i]), (PG8_LAS unsigned*)(lds + (bufoff) + ldsw + _i * 8192), 16, 0, 0); } while (0)
#define PG8_STAGEG(bufoff, base, pk) do { unsigned vg_[2]; _Pragma("unroll") for (int i_ = 0; i_ < 2; ++i_) { int R_, C_; stage_rc(tid * 16 + i_ * 8192, R_, C_); vg_[i_] = (((pk) >> (16 * i_)) & 0xffffu) * (unsigned)(2 * K) + (unsigned)(2 * C_); } PG8_STAGE(bufoff, base, vg_); } while (0)
#define PG8_STAGEA(bufoff, base, hh, nx) do { if constexpr (GATHER) { const unsigned pk_ = (nx) ? vAn[hh] : vAc[hh]; PG8_STAGEG(bufoff, base, pk_); } else PG8_STAGE(bufoff, (base) + (hh) * hstep, voffA); } while (0)
#define PG8_GOFF(dst, unit) do { _Pragma("unroll") for (int hh_ = 0; hh_ < 2; ++hh_) { unsigned pk_ = 0u; _Pragma("unroll") for (int i_ = 0; i_ < 2; ++i_) { int R_, C_; stage_rc(tid * 16 + i_ * 8192, R_, C_); \
        const int t2_ = moe_tok2(g.list, g.ptab, (unit).pm * BM + hh_ * HALF + R_); pk_ |= (unsigned)(t2_ < 0 ? 0 : (t2_ >> 1)) << (16 * i_); } dst[hh_] = pk_; } } while (0)
#define PG8_LDA(dst, b, h) do { _Pragma("unroll") for (int m = 0; m < 4; ++m) _Pragma("unroll") for (int k = 0; k < 2; ++k) dst[m][k] = *(const PG8_LAS bf16x8*)(lds + PG8_SA(b, h) + aoff + m * 2048 + k * 1024); } while (0)
#define PG8_LDB(dst, b, h) do { _Pragma("unroll") for (int n = 0; n < 2; ++n) _Pragma("unroll") for (int k = 0; k < 2; ++k) dst[n][k] = *(const PG8_LAS bf16x8*)(lds + PG8_SB(b, h) + boff + n * 2048 + k * 1024); } while (0)
#define PG8_MMA(ai, bj, At, Bt) do { __builtin_amdgcn_s_setprio(1); _Pragma("unroll") for (int m = 0; m < 4; ++m) _Pragma("unroll") for (int n = 0; n < 2; ++n) _Pragma("unroll") for (int k = 0; k < 2; ++k) \
        acc[ai][bj][m][n] = __builtin_amdgcn_mfma_f32_16x16x32_bf16(Bt[n][k], At[m][k], acc[ai][bj][m][n], 0, 0, 0); __builtin_amdgcn_s_setprio(0); } while (0)
#define PG8_WAIT_V(n) asm volatile("s_waitcnt vmcnt(" #n ")" ::: "memory")
#define PG8_WAIT_L(n) asm volatile("s_waitcnt lgkmcnt(" #n ")" ::: "memory")
#define PG8_BAR __builtin_amdgcn_s_barrier()
#define PG8_SCHED __builtin_amdgcn_sched_barrier(0)
    Unit cur, nxt; int ui = 0;
    if (!S.next(0, cur)) return;
    f32x4 acc[2][2][4][2];
#pragma unroll
    for (int a = 0; a < 2; ++a)
#pragma unroll
        for (int b = 0; b < 2; ++b)
#pragma unroll
            for (int m = 0; m < 4; ++m)
#pragma unroll
                for (int n = 0; n < 2; ++n) acc[a][b][m][n] = (f32x4){0.f, 0.f, 0.f, 0.f};
    bf16x8 At[4][2], B0[2][2], B1[2][2];
    const char* cA = (const char*)g.A + (GATHER ? (size_t)0 : (size_t)cur.pm * tstep); const char* cB = (const char*)g.Bt + (size_t)cur.pn * tstep;
    if constexpr (GATHER) { PG8_GOFF(vAc, cur); }
    S.a_ready(cur);
    if constexpr (SP2) {
        PG8_STAGE(PG8_SB(0, 0), cB, voffB); PG8_STAGE(PG8_SB(0, 1), cB + hstep, voffB); PG8_STAGEA(PG8_SA(0, 0), cA, 0, false); PG8_STAGEA(PG8_SA(0, 1), cA, 1, false);
        if (wr == 1) PG8_BAR;
        PG8_WAIT_V(2); PG8_BAR;
        PG8_STAGE(PG8_SB(1, 0), cB + kstep, voffB); PG8_STAGEA(PG8_SA(1, 0), cA + kstep, 0, false); PG8_STAGE(PG8_SB(1, 1), cB + hstep + kstep, voffB);
        PG8_WAIT_V(6); PG8_BAR;
    } else {
        PG8_STAGE(PG8_SB(0, 0), cB, voffB); PG8_STAGE(PG8_SA(0, 0), cA, voffA); PG8_STAGE(PG8_SB(0, 1), cB + hstep, voffB); PG8_STAGE(PG8_SA(0, 1), cA + hstep, voffA);
        if (wr == 1) PG8_BAR;
        PG8_WAIT_V(4); PG8_BAR;
        PG8_STAGE(PG8_SB(1, 0), cB + kstep, voffB); PG8_STAGE(PG8_SA(1, 0), cA + kstep, voffA); PG8_STAGE(PG8_SB(1, 1), cB + hstep + kstep, voffB);
        PG8_WAIT_V(6); PG8_BAR;
    }
    for (;;) {
        const bool has_next = S.next(ui + 1, nxt);
        const char* nA = (has_next && !GATHER) ? (const char*)g.A + (size_t)nxt.pm * tstep : cA;
        if constexpr (GATHER) { if (has_next) { PG8_GOFF(vAn, nxt); } else { vAn[0] = vAc[0]; vAn[1] = vAc[1]; } } const char* nB = has_next ? (const char*)g.Bt + (size_t)nxt.pn * tstep : cB;
        for (int t = 0; t < nt; t += 2) {
            const bool last = (t == nt - 2);
            const char* a1 = cA + (size_t)(t + 1) * kstep;
            const char* a2 = last ? nA : cA + (size_t)(t + 2) * kstep; const char* b2 = last ? nB : cB + (size_t)(t + 2) * kstep;
            const char* a3 = a2 + kstep; const char* b3 = b2 + kstep;
            if (last && has_next) S.a_ready(nxt);
            if constexpr (SP2) {
            PG8_LDB(B0, 0, 0); PG8_LDB(B1, 0, 1); PG8_SCHED; PG8_LDA(At, 0, 0); PG8_STAGEA(PG8_SA(1, 1), a1, 1, false);
            PG8_WAIT_V(8); PG8_WAIT_L(0); PG8_BAR; PG8_MMA(0, 0, At, B0); PG8_MMA(0, 1, At, B1); PG8_BAR; PG8_SCHED;
            PG8_LDA(At, 0, 1); PG8_STAGE(PG8_SB(0, 0), b2, voffB); PG8_STAGE(PG8_SB(0, 1), b2 + hstep, voffB); PG8_STAGEA(PG8_SA(0, 0), a2, 0, last);
            PG8_WAIT_V(8); PG8_WAIT_L(0); PG8_BAR; PG8_MMA(1, 0, At, B0); PG8_MMA(1, 1, At, B1); PG8_BAR; PG8_SCHED;
            PG8_LDB(B0, 1, 0); PG8_LDB(B1, 1, 1); PG8_SCHED; PG8_LDA(At, 1, 0); PG8_STAGEA(PG8_SA(0, 1), a2, 1, last);
            PG8_WAIT_V(8); PG8_WAIT_L(0); PG8_BAR; PG8_MMA(0, 0, At, B0); PG8_MMA(0, 1, At, B1); PG8_BAR; PG8_SCHED;
            PG8_LDA(At, 1, 1); PG8_STAGE(PG8_SB(1, 0), b3, voffB); PG8_STAGE(PG8_SB(1, 1), b3 + hstep, voffB); PG8_STAGEA(PG8_SA(1, 0), a3, 0, last);
            PG8_WAIT_V(8); PG8_WAIT_L(0); PG8_BAR; PG8_MMA(1, 0, At, B0); PG8_MMA(1, 1, At, B1); PG8_BAR; PG8_SCHED;
            } else {
            PG8_LDB(B0, 0, 0); PG8_SCHED; PG8_LDA(At, 0, 0); PG8_STAGE(PG8_SA(1, 1), a1 + hstep, voffA);
            PG8_WAIT_L(8); PG8_BAR; PG8_WAIT_L(0); PG8_MMA(0, 0, At, B0); PG8_BAR; PG8_SCHED;
            PG8_LDB(B1, 0, 1); PG8_STAGE(PG8_SB(0, 0), b2, voffB);
            PG8_BAR; PG8_WAIT_L(0); PG8_MMA(0, 1, At, B1); PG8_BAR;
            PG8_LDA(At, 0, 1); PG8_STAGE(PG8_SA(0, 0), a2, voffA);
            PG8_BAR; PG8_WAIT_L(0); PG8_MMA(1, 0, At, B0); PG8_BAR; PG8_SCHED;
            PG8_STAGE(PG8_SB(0, 1), b2 + hstep, voffB);
            PG8_WAIT_V(6); PG8_BAR; PG8_MMA(1, 1, At, B1); PG8_BAR;
            PG8_LDB(B0, 1, 0); PG8_SCHED; PG8_LDA(At, 1, 0); PG8_STAGE(PG8_SA(0, 1), a2 + hstep, voffA);
            PG8_WAIT_L(8); PG8_BAR; PG8_WAIT_L(0); PG8_MMA(0, 0, At, B0); PG8_BAR; PG8_SCHED;
            PG8_LDB(B1, 1, 1); PG8_STAGE(PG8_SB(1, 0), b3, voffB);
            PG8_BAR; PG8_WAIT_L(0); PG8_MMA(0, 1, At, B1); PG8_BAR;
            PG8_LDA(At, 1, 1); PG8_STAGE(PG8_SA(1, 0), a3, voffA);
            PG8_BAR; PG8_WAIT_L(0); PG8_MMA(1, 0, At, B0); PG8_BAR; PG8_SCHED;
            PG8_STAGE(PG8_SB(1, 1), b3 + hstep, voffB);
            PG8_WAIT_V(6); PG8_BAR; PG8_MMA(1, 1, At, B1); PG8_BAR;
            }
        }
        if constexpr (ALIGN_EPI) { if (wr == 0) PG8_BAR; }
        if constexpr (!Epi::AFTER_DRAIN) { E(acc, cur, wr, wc, fr, fq); S.done(cur); }
        if (!has_next) break;
#pragma unroll
        for (int a = 0; a < 2; ++a)
#pragma unroll
            for (int b = 0; b < 2; ++b)
#pragma unroll
                for (int m = 0; m < 4; ++m)
#pragma unroll
                    for (int n = 0; n < 2; ++n) acc[a][b][m][n] = (f32x4){0.f, 0.f, 0.f, 0.f};
        cur = nxt; cA = nA; cB = nB; ++ui;
        if constexpr (GATHER) { vAc[0] = vAn[0]; vAc[1] = vAn[1]; }
        if constexpr (ALIGN_EPI) { if (wr == 1) PG8_BAR; }
    }
    PG8_WAIT_V(0);
    if constexpr (!ALIGN_EPI) { if (wr == 0) PG8_BAR; }
    PG8_BAR;
    if constexpr (Epi::AFTER_DRAIN) { E.fused(acc, cur, wr, wc, fr, fq, lds, wid, lane); S.done(cur); }
#undef PG8_SA
#undef PG8_SB
#undef PG8_STAGE
#undef PG8_STAGEA
#undef PG8_STAGEG
#undef PG8_GOFF
#undef PG8_LDA
#undef PG8_LDB
#undef PG8_MMA
#undef PG8_WAIT_V
#undef PG8_WAIT_L
#undef PG8_BAR
#undef PG8_SCHED
}
}
#define XB_TMO      128
#define XB_XCNT(j)  (256  + 64 * (j))
#define XB_XSUB(j)  (1280 + 64 * (j))
#define XB_XGEN(j)  (2304 + 64 * (j))
#define XB_TOP      3328
#define XB_TOPGEN   3392
#define XCD_BAR_WORDS 3456
#define XB_SPIN_CAP (1u << 18)
#define LAS __attribute__((address_space(3)))

__device__ __forceinline__ unsigned xb_ld(unsigned* p)              { return __hip_atomic_load(p, __ATOMIC_RELAXED, __HIP_MEMORY_SCOPE_AGENT); }
__device__ __forceinline__ unsigned xb_add(unsigned* p, unsigned v) { return __hip_atomic_fetch_add(p, v, __ATOMIC_RELAXED, __HIP_MEMORY_SCOPE_AGENT); }
__device__ __forceinline__ unsigned xb_xcc_id() { return (unsigned)__builtin_amdgcn_s_getreg((3 << 11) | 20) & 0xFu; }
#define XB_SPIN(cond, bar) do { unsigned _sp = 0; while (cond) { __builtin_amdgcn_s_sleep(1); \
    if ((++_sp & 255u) == 0u) { if (xb_ld(&(bar)[XB_TMO])) break; if (_sp > XB_SPIN_CAP) { atomicAdd(&(bar)[XB_TMO], 1u); break; } } } } while (0)

struct XcdBarrier {
    unsigned* bar; unsigned x;
    volatile LAS unsigned* st;
};

__device__ __forceinline__ XcdBarrier xcd_barrier_post(unsigned* bar, volatile LAS unsigned* st) {
    XcdBarrier b; b.bar = bar; b.x = xb_xcc_id(); b.st = st;
    if (threadIdx.x == 0) (void)xb_add(&bar[XB_XCNT(b.x)], 1u);
    return b;
}
__device__ __forceinline__ void xcd_barrier_complete(unsigned* bar, unsigned x, unsigned& nloc, unsigned& nx) {
    const unsigned G = gridDim.x * gridDim.y * gridDim.z;
    unsigned sum, cnt, mine, sp = 0u;
    for (;;) {
        sum = 0u; cnt = 0u; mine = 0u;
#pragma unroll
        for (unsigned j = 0; j < 16; ++j) { const unsigned c = xb_ld(&bar[XB_XCNT(j)]); sum += c; cnt += (c > 0u) ? 1u : 0u; mine = (j == x) ? c : mine; }
        if (sum == G) break;
        __builtin_amdgcn_s_sleep(1);
        if ((++sp & 255u) == 0u) { if (xb_ld(&bar[XB_TMO])) break; if (sp > XB_SPIN_CAP) { atomicAdd(&bar[XB_TMO], 1u); break; } }
    }
    nloc = mine > 0u ? mine : 1u; nx = cnt > 0u ? cnt : 1u;
}

__device__ __forceinline__ void xcd_barrier(const XcdBarrier& b) {
    asm volatile("s_waitcnt vmcnt(0)" ::: "memory");
    __syncthreads();
    if (threadIdx.x == 0) {
        unsigned* bar = b.bar;
        __builtin_amdgcn_s_waitcnt(0);
        unsigned nloc = b.st[0], nx = b.st[1];
        if (nloc == 0u) { xcd_barrier_complete(bar, b.x, nloc, nx); b.st[0] = nloc; b.st[1] = nx; }
        const unsigned old = xb_add(&bar[XB_XSUB(b.x)], 1u);
        const unsigned gen = old / nloc;
        if (old + 1u == (gen + 1u) * nloc) {
            __builtin_amdgcn_fence(__ATOMIC_RELEASE, "agent");
            asm volatile("s_waitcnt vmcnt(0)" ::: "memory");
            const unsigned og = xb_add(&bar[XB_TOP], 1u);
            const unsigned tg = og / nx;
            if (og + 1u == (tg + 1u) * nx) xb_add(&bar[XB_TOPGEN], 1u);
            else XB_SPIN(xb_ld(&bar[XB_TOPGEN]) == tg, bar);
            __builtin_amdgcn_fence(__ATOMIC_ACQUIRE, "agent");
            xb_add(&bar[XB_XGEN(b.x)], 1u);
            asm volatile("s_waitcnt vmcnt(0)" ::: "memory");
        } else {
            XB_SPIN(xb_ld(&bar[XB_XGEN(b.x)]) == gen, bar);
            __builtin_amdgcn_fence(__ATOMIC_ACQUIRE, "agent");
            asm volatile("s_waitcnt vmcnt(0)" ::: "memory");
        }
    }
    __syncthreads();
}

struct Args { const float* in[47]; float* out; unsigned char* ws; int ph_lo, ph_hi; };
typedef const __attribute__((address_space(4))) Args* KArgsP;
__device__ __forceinline__ KArgsP fresh_args() { KArgsP p = (KArgsP)__builtin_amdgcn_kernarg_segment_ptr(); asm volatile("" : "+s"(p)); return p; }
enum { I_X = 0, I_C, I_ADA_W, I_ADA_B, I_NORM_MIX, I_NORM_FFN, I_NORM_FINAL, I_W_IN, I_W_OUT, I_CONV_W, I_CONV_B, I_WQ, I_WK, I_BI, I_BF, I_MNORM_W,
       I_RMU, I_RW0, I_RWUP, I_RA0, I_RAUP, I_RGUP, I_RKK, I_RKA, I_RRK, I_RLNW, I_RLNB, I_RV0, I_RVDN, I_RVUP,
       I_S5ARE, I_S5AIM, I_S5LDT, I_S5BRE, I_S5BIM, I_S5CRE, I_S5CIM, I_S5D, I_S5GLUW, I_S5GLUB,
       I_MWRG, I_MBRG, I_MWRE, I_MBRE, I_MW1, I_MW3, I_MW2 };

struct RmWin { __device__ __forceinline__ int operator()(int n) const { return n < 1152 ? n : (n < 1164 ? 2816 + (n - 1152) : (n < 2572 ? 1152 + (n - 1164) : 2560 + (n - 2572))); } };
struct RmId  { __device__ __forceinline__ int operator()(int n) const { return n; } };
struct RmGU  { int add; __device__ __forceinline__ int operator()(int n) const { return 8 * (n >> 2) + (n & 3) + add; } };
template <class RM>
__device__ __forceinline__ void transpose_item(const float* W, int ldw, int ncols, int k0, int n0, bf16* WT, int ldt, LAS float* scr, int lane, const RM rm) {
    if (n0 + 64 <= ncols && (ldw & 3) == 0) {
        const float* src = W + (size_t)(k0 + (lane >> 4)) * ldw + n0 + 4 * (lane & 15);
        f32x4 v[16];
#pragma unroll
        for (int i = 0; i < 16; ++i) v[i] = *(const GAS f32x4*)(src + (size_t)(4 * i) * ldw);
#pragma unroll
        for (int i = 0; i < 16; ++i) { LAS float* d = scr + (4 * i + (lane >> 4)) * 65 + 4 * (lane & 15); d[0] = v[i][0]; d[1] = v[i][1]; d[2] = v[i][2]; d[3] = v[i][3]; }
    } else {
    const int nn = n0 + lane; const bool ok = nn < ncols; const float* src = W + (size_t)k0 * ldw + (ok ? nn : n0);
    float v[64];
#pragma unroll
    for (int kk = 0; kk < 64; ++kk) v[kk] = src[(size_t)kk * ldw];
#pragma unroll
    for (int kk = 0; kk < 64; ++kk) scr[kk * 65 + lane] = v[kk];
    }
    LDS_WAIT(); asm volatile("" ::: "memory");
    const int c = lane & 7;
#pragma unroll
    for (int j = 0; j < 8; ++j) { const int nl = (lane >> 3) + 8 * j; const LAS float* s = scr + (8 * c) * 65 + nl;
        v4u o; o.x = pk2(s[0 * 65], s[1 * 65]); o.y = pk2(s[2 * 65], s[3 * 65]); o.z = pk2(s[4 * 65], s[5 * 65]); o.w = pk2(s[6 * 65], s[7 * 65]);
        if (n0 + nl < ncols) *(GAS v4u*)(WT + (size_t)rm(n0 + nl) * ldt + k0 + 8 * c) = o; }
    LDS_WAIT(); asm volatile("" ::: "memory");
}
__device__ __forceinline__ void moe_convert13(const float* w1, const float* w3, int l, bf16* W13, int worker, int nworkers, LAS float* scr, int lane) {
    for (int it = worker; it < NEXP * 256; it += nworkers) {
        const int e = it >> 8, r = it & 255; const size_t eo = (size_t)(l * NEXP + e) * DM * DEXP;
        if (r < 128) transpose_item(w1 + eo, DEXP, DEXP, 64 * (r >> 3), 64 * (r & 7), W13 + (size_t)e * 1024 * 1024, 1024, scr, lane, RmGU{0});
        else         transpose_item(w3 + eo, DEXP, DEXP, 64 * ((r - 128) >> 3), 64 * ((r - 128) & 7), W13 + (size_t)e * 1024 * 1024, 1024, scr, lane, RmGU{4});
    }
}
__device__ __forceinline__ void moe_convert2(const float* w2, int l, bf16* W2T, int worker, int nworkers, LAS float* scr, int lane) {
    for (int it = worker; it < NEXP * 128; it += nworkers) {
        const int e = it >> 7, r = it & 127; const size_t eo = (size_t)(l * NEXP + e) * DM * DEXP;
        transpose_item(w2 + eo, DM, DM, 64 * (r >> 4), 64 * (r & 15), W2T + (size_t)e * 1024 * 512, 512, scr, lane, RmId{});
    }
}
__device__ __forceinline__ void phase_prologue(KArgsP a, LAS unsigned char* lds, int tid, int lane, int wave, int vcu, int G) {
    unsigned char* ws = a->ws;
    LAS float* scr = (LAS float*)(lds + wave * 16640);
    const int gw = vcu * NWAVES + wave, NGW = G * NWAVES;
    bf16* WIN = (bf16*)(ws + WS_WIN); bf16* WOUT = (bf16*)(ws + WS_WOUT);
    for (int it = gw; it < 2 * 16 * 45; it += NGW) { const int l = it / (16 * 45), r = it % (16 * 45);
        transpose_item(a->in[I_W_IN] + (size_t)l * DM * IN_COLS, IN_COLS, IN_COLS, 64 * (r / 45), 64 * (r % 45), WIN + (size_t)l * NPROJ_PAD * DM, DM, scr, lane, RmWin{}); }
    for (int it = gw; it < 2 * 16 * 16; it += NGW) { const int l = it / 256, r = it % 256;
        transpose_item(a->in[I_W_OUT] + (size_t)l * DM * DM, DM, DM, 64 * (r >> 4), 64 * (r & 15), WOUT + (size_t)l * DM * DM, DM, scr, lane, RmId{}); }
    for (int it = gw; it < 2 * 244; it += NGW) { const int l = it / 244, r = 2828 + it % 244; GAS v4u* p = (GAS v4u*)(WIN + ((size_t)l * NPROJ_PAD + r) * DM);
        p[lane] = (v4u){0u, 0u, 0u, 0u}; p[lane + 64] = (v4u){0u, 0u, 0u, 0u}; }
    { float* RTW = (float*)(ws + WS_RTW);
      for (int idx = (vcu * NTHR + tid); idx < 2 * 1024 * 48; idx += G * NTHR) { const int j = idx % 48, k = (idx / 48) % 1024, l = idx / (48 * 1024);
          RTW[(size_t)l * 49152 + ((k >> 2) * 16 + (j & 15)) * 12 + (k & 3) * 3 + (j >> 4)] = j < 4 ? a->in[I_MWRG][(size_t)(l * 1024 + k) * 4 + j] : (j < 36 ? a->in[I_MWRE][(size_t)(l * 1024 + k) * 32 + (j - 4)] : 0.f); } }
    { bf16* RW = (bf16*)(ws + WS_R1W);
      for (int idx = (vcu * NTHR + tid); idx < 2 * 98304 + 24576; idx += G * NTHR) { float v;
          if (idx < 2 * 98304) { const int l = idx / 98304, r = idx % 98304;
              if (r < 24576)      v = a->in[I_RWUP][(size_t)l * 64 * DBR + (r & 63) * DBR + (r >> 6)];
              else if (r < 49152) v = a->in[I_RAUP][(size_t)l * 64 * DBR + ((r - 24576) & 63) * DBR + ((r - 24576) >> 6)];
              else                v = a->in[I_RGUP][(size_t)l * 128 * DBR + ((r - 49152) & 127) * DBR + ((r - 49152) >> 7)];
          } else { const int r = idx - 2 * 98304;
              if (r < 12288) v = a->in[I_RVDN][(size_t)(r % 384) * 32 + (r / 384)];
              else           v = a->in[I_RVUP][(size_t)((r - 12288) & 31) * DBR + ((r - 12288) >> 5)]; }
          RW[idx] = (bf16)f2bf(v); } }
    for (int idx = (vcu * NTHR + tid); idx < 2 * 16 * 64; idx += G * NTHR) { const int p = idx & 63, lg = idx >> 6;
        const float lam_re = a->in[I_S5ARE][idx], lam_im = a->in[I_S5AIM][idx]; const float dt = expf(a->in[I_S5LDT][lg]); const float mag = expf(lam_re * dt), ang = lam_im * dt;
        const float are = mag * cosf(ang), aim = mag * sinf(ang); const float inv = 1.f / (lam_re * lam_re + lam_im * lam_im);
        const float cre = ((are - 1.f) * lam_re + aim * lam_im) * inv, cim = (aim * lam_re - (are - 1.f) * lam_im) * inv;
        ((float*)(ws + WS_S5AP))[idx * 2] = are; ((float*)(ws + WS_S5AP))[idx * 2 + 1] = aim;
        const float* br = a->in[I_S5BRE] + (size_t)idx * 16; const float* bi = a->in[I_S5BIM] + (size_t)idx * 16; bf16* o = (bf16*)(ws + WS_S5BB) + ((size_t)lg * 128 + 2 * p) * 16;
        for (int c = 0; c < 16; ++c) { o[c] = (bf16)f2bf(cre * br[c] - cim * bi[c]); o[16 + c] = (bf16)f2bf(cre * bi[c] + cim * br[c]); } }
    { bf16* CM = (bf16*)(ws + WS_S5CM);
      for (int idx = (vcu * NTHR + tid); idx < 2 * 16 * 16 * 128; idx += G * NTHR) { const int k = idx & 127, lgc = idx >> 7;
          CM[idx] = (bf16)f2bf((k & 1) ? -a->in[I_S5CIM][(size_t)lgc * 64 + (k >> 1)] : a->in[I_S5CRE][(size_t)lgc * 64 + (k >> 1)]); } }
    for (int it = gw; it < 2 * 16; it += NGW) { const int l = it >> 4, r = it & 15;
        transpose_item(a->in[I_S5GLUW] + (size_t)l * DC * DC, DC, DC, 64 * (r >> 2), 64 * (r & 3), (bf16*)(ws + WS_GLUT) + (size_t)l * DC * DC, DC, scr, lane, RmId{}); }
    { bf16* MLW = (bf16*)(ws + WS_MLW);
      for (int idx = (vcu * NTHR + tid); idx < 2 * NH * 2 * 4096; idx += G * NTHR) { const int d = idx & 63, e = (idx >> 6) & 63, which = (idx >> 12) & 1, lh = idx >> 13;
          MLW[idx] = (bf16)f2bf(a->in[which ? I_WK : I_WQ][(size_t)lh * 4096 + d * 64 + e]); } }
    __syncthreads();
    if (vcu < 192) {
        const int q = vcu, l = q / 96, cb = (q >> 3) % 12, kc = q & 7;
        LAS float* cond = (LAS float*)lds;
        { const int b = tid >> 7, kk = tid & 127; const float cv = a->in[I_C][b * DM + kc * 128 + kk]; cond[tid] = cv / (1.f + __expf(-cv)); }
        __syncthreads();
        const int col = cb * 512 + tid; const float* wp = a->in[I_ADA_W] + ((size_t)l * DM + kc * 128) * 6144 + col;
        float acc0 = 0.f, acc1 = 0.f, acc2 = 0.f, acc3 = 0.f;
#pragma unroll 8
        for (int kk = 0; kk < 128; ++kk) { const float w = wp[(size_t)kk * 6144]; acc0 += cond[kk] * w; acc1 += cond[128 + kk] * w; acc2 += cond[256 + kk] * w; acc3 += cond[384 + kk] * w; }
        const float bias = (kc == 0) ? a->in[I_ADA_B][l * 6144 + col] : 0.f;
        float* MP = (float*)(ws + WS_MODP) + ((size_t)(kc * 2 + l) * 4) * 6144 + col;
        MP[0] = acc0 + bias; MP[6144] = acc1 + bias; MP[2 * 6144] = acc2 + bias; MP[3 * 6144] = acc3 + bias;
    }
}

__device__ __forceinline__ float modval(const unsigned char* ws, bool part, int l, int b, int idx) {
    if (!part) return ((const float*)(ws + WS_MODF))[(size_t)(l * 4 + b) * 6144 + idx];
    const float* mp = (const float*)(ws + WS_MODP) + (size_t)(l * 4 + b) * 6144 + idx; float s = 0.f;
#pragma unroll
    for (int kc = 0; kc < 8; ++kc) s += mp[(size_t)kc * 2 * 4 * 6144];
    return s;
}
template <int MODE, bool COMBINE>
__device__ __forceinline__ void phase_rownorm(KArgsP a, LAS unsigned char* lds, int tid, int lane, int wave, int G,
                                              const float* xsrc, float* xdst, const float* gvec, bool part, int l, int isc  , int lprev) {
    unsigned char* ws = a->ws;
    LAS float* sc = (LAS float*)lds; LAS float* sh = sc + 1024; LAS float* gt = sh + 1024;
    bf16* HN = (bf16*)(ws + WS_HN); const bf16* YM = (const bf16*)(ws + WS_YMOE); const float* TW = (const float*)(ws + WS_TOKW);
    for (int c = blockIdx.x; c < NTOK / 128; c += G) {
        const int b = c >> 6;
        __syncthreads();
        for (int j = tid; j < 1024; j += NTHR) {
            if (MODE == 0) { sc[j] = gvec[j] * (1.f + modval(ws, part, l, b, (isc + 1) * 1024 + j)); sh[j] = modval(ws, part, l, b, isc * 1024 + j); }
            else { sc[j] = gvec[j]; sh[j] = 0.f; }
            if (COMBINE) gt[j] = 1.f + modval(ws, false, lprev, b, 5 * 1024 + j);
        }
        __syncthreads();
        f32x4 vn[4]; v2u yn0[4], yn1[4]; float wn0 = 0.f, wn1 = 0.f;
        { const int row = c * 128 + wave * 16; const GAS f32x4* xr = (const GAS f32x4*)(xsrc + (size_t)row * DM) + lane;
#pragma unroll
          for (int j = 0; j < 4; ++j) vn[j] = xr[64 * j];
          if (COMBINE) { wn0 = TW[2 * row]; wn1 = TW[2 * row + 1]; const GAS v2u* y0 = (const GAS v2u*)(YM + (size_t)(2 * row) * DM) + lane; const GAS v2u* y1 = (const GAS v2u*)(YM + (size_t)(2 * row + 1) * DM) + lane;
#pragma unroll
              for (int j = 0; j < 4; ++j) { yn0[j] = y0[64 * j]; yn1[j] = y1[64 * j]; } } }
        for (int i = 0; i < 16; ++i) {
            const int row = c * 128 + wave * 16 + i;
            f32x4 v[4]; v2u q0[4], q1[4]; const float w0 = wn0, w1 = wn1;
#pragma unroll
            for (int j = 0; j < 4; ++j) { v[j] = vn[j]; q0[j] = yn0[j]; q1[j] = yn1[j]; }
            if (i + 1 < 16) { const int rn = row + 1; const GAS f32x4* xr = (const GAS f32x4*)(xsrc + (size_t)rn * DM) + lane;
#pragma unroll
                for (int j = 0; j < 4; ++j) vn[j] = xr[64 * j];
                if (COMBINE) { wn0 = TW[2 * rn]; wn1 = TW[2 * rn + 1]; const GAS v2u* y0 = (const GAS v2u*)(YM + (size_t)(2 * rn) * DM) + lane; const GAS v2u* y1 = (const GAS v2u*)(YM + (size_t)(2 * rn + 1) * DM) + lane;
#pragma unroll
                    for (int j = 0; j < 4; ++j) { yn0[j] = y0[64 * j]; yn1[j] = y1[64 * j]; } } }
            if (COMBINE) {
#pragma unroll
                for (int j = 0; j < 4; ++j) { const v2u p0 = q0[j], p1 = q1[j]; const f32x4 g4 = *(const LAS f32x4*)(gt + lane * 4 + 256 * j);
                    f32x4 m; m.x = w0 * bflo(p0.x) + w1 * bflo(p1.x); m.y = w0 * bfhi(p0.x) + w1 * bfhi(p1.x); m.z = w0 * bflo(p0.y) + w1 * bflo(p1.y); m.w = w0 * bfhi(p0.y) + w1 * bfhi(p1.y);
                    v[j] = v[j] + g4 * m; }
                if (MODE == 0) { GAS f32x4* xo = (GAS f32x4*)(xdst + (size_t)row * DM) + lane;
#pragma unroll
                    for (int j = 0; j < 4; ++j) xo[64 * j] = v[j]; }
            }
            float ss = 0.f;
#pragma unroll
            for (int j = 0; j < 4; ++j) ss += (v[j].x * v[j].x + v[j].y * v[j].y) + (v[j].z * v[j].z + v[j].w * v[j].w);
            const float rstd = rsqrtf(wave_sum(ss) * (1.f / DM) + NORM_EPS);
            if (MODE == 0) {
                GAS v2u* o = (GAS v2u*)(HN + (size_t)row * DM) + lane;
#pragma unroll
                for (int j = 0; j < 4; ++j) { const f32x4 s4 = *(const LAS f32x4*)(sc + lane * 4 + 256 * j), h4 = *(const LAS f32x4*)(sh + lane * 4 + 256 * j); const f32x4 h = v[j] * rstd * s4 + h4;
                    v2u w; w.x = pk2(h.x, h.y); w.y = pk2(h.z, h.w); o[64 * j] = w; }
            } else {
                GAS f32x4* o = (GAS f32x4*)(xdst + (size_t)row * DM) + lane;
#pragma unroll
                for (int j = 0; j < 4; ++j) { const f32x4 s4 = *(const LAS f32x4*)(sc + lane * 4 + 256 * j); o[64 * j] = v[j] * rstd * s4; }
            }
        }
    }
}
__device__ __forceinline__ void mod_finalize(unsigned char* ws, int tid, int G) {
    float* MF = (float*)(ws + WS_MODF);
    for (int idx = blockIdx.x * NTHR + tid; idx < 2 * 4 * 6144; idx += G * NTHR) { const float* mp = (const float*)(ws + WS_MODP) + idx; float s = 0.f;
#pragma unroll
        for (int kc = 0; kc < 8; ++kc) s += mp[(size_t)kc * 2 * 4 * 6144];
        MF[idx] = s; }
}

typedef float f32x4m __attribute__((ext_vector_type(4)));
__device__ __forceinline__ void phase_router(KArgsP a, LAS unsigned char* lds, int tid, int lane, int wave, int G, int l) {
    unsigned char* ws = a->ws;
    LAS float* sc = (LAS float*)lds; LAS float* sh = sc + 1024; LAS float* rstd_s = sh + 1024  ; LAS float* cvec = rstd_s + 128  ; LAS float* cpart = cvec + 64  ;
    LAS float* lg = cpart + 8 * 48  ; LAS int* hist = (LAS int*)(lg + 8 * 16 * 48)  ; LAS int* basev = hist + 32; LAS int* asg_e = basev + 32  ; LAS int* asg_lp = asg_e + 256;
    bf16* HN = (bf16*)(ws + WS_HN); const float* x = a->out; const float* RTW = (const float*)(ws + WS_RTW) + (size_t)l * 1024 * 48;
    int* TOKE = (int*)(ws + WS_TOKE); float* TOKW = (float*)(ws + WS_TOKW); int* LIST = (int*)(ws + WS_LIST); unsigned* CNT = (unsigned*)(ws + WS_CTL) + CW_CNT + l * 32;
    const float* gvec = a->in[I_NORM_FFN] + l * DM;
    for (int c = blockIdx.x; c < NTOK / 128; c += G) {
        const int b = c >> 6;
        __syncthreads();
        for (int j = tid; j < 1024; j += NTHR) { sc[j] = gvec[j] * (1.f + modval(ws, false, l, b, 4 * 1024 + j)); sh[j] = modval(ws, false, l, b, 3 * 1024 + j); }
        if (tid < 32) hist[tid] = 0;
        __syncthreads();
        if (tid < 128) { const int i16 = tid & 15, part = tid >> 4; float s0 = 0.f, s1 = 0.f, s2 = 0.f;
#pragma unroll 1
            for (int kg = part * 32; kg < part * 32 + 32; kg += 4) { f32x4 w[4][3];
#pragma unroll
                for (int q = 0; q < 4; ++q) { const GAS f32x4* wp = (const GAS f32x4*)(RTW + (size_t)((kg + q) * 16 + i16) * 12); w[q][0] = wp[0]; w[q][1] = wp[1]; w[q][2] = wp[2]; }
#pragma unroll
                for (int q = 0; q < 4; ++q) { const f32x4 h = *(const LAS f32x4*)(sh + 4 * (kg + q));
                    const float wf[12] = {w[q][0][0], w[q][0][1], w[q][0][2], w[q][0][3], w[q][1][0], w[q][1][1], w[q][1][2], w[q][1][3], w[q][2][0], w[q][2][1], w[q][2][2], w[q][2][3]};
#pragma unroll
                    for (int jj = 0; jj < 4; ++jj) { s0 = fmaf(h[jj], wf[3 * jj], s0); s1 = fmaf(h[jj], wf[3 * jj + 1], s1); s2 = fmaf(h[jj], wf[3 * jj + 2], s2); } } }
            cpart[part * 48 + i16] = s0; cpart[part * 48 + 16 + i16] = s1; cpart[part * 48 + 32 + i16] = s2; }
        { f32x4 vn[4];
          { const GAS f32x4* xr = (const GAS f32x4*)(x + (size_t)(c * 128 + wave * 16) * DM) + lane;
#pragma unroll
            for (int j = 0; j < 4; ++j) vn[j] = xr[64 * j]; }
          for (int i = 0; i < 16; ++i) {
            const int row = c * 128 + wave * 16 + i;
            f32x4 v[4]; float ss = 0.f;
#pragma unroll
            for (int j = 0; j < 4; ++j) { v[j] = vn[j]; ss += (v[j].x * v[j].x + v[j].y * v[j].y) + (v[j].z * v[j].z + v[j].w * v[j].w); }
            if (i + 1 < 16) { const GAS f32x4* xr = (const GAS f32x4*)(x + (size_t)(row + 1) * DM) + lane;
#pragma unroll
                for (int j = 0; j < 4; ++j) vn[j] = xr[64 * j]; }
            const float rstd = rsqrtf(wave_sum(ss) * (1.f / DM) + NORM_EPS);
            if (lane == 0) rstd_s[wave * 16 + i] = rstd;
            GAS v2u* o = (GAS v2u*)(HN + (size_t)row * DM) + lane;
#pragma unroll
            for (int j = 0; j < 4; ++j) { const f32x4 s4 = *(const LAS f32x4*)(sc + lane * 4 + 256 * j), h4 = *(const LAS f32x4*)(sh + lane * 4 + 256 * j); const f32x4 h = v[j] * rstd * s4 + h4;
                v2u w; w.x = pk2(h.x, h.y); w.y = pk2(h.z, h.w); o[64 * j] = w; }
          } }
        __syncthreads();
        if (tid < 48) { float s = 0.f;
#pragma unroll
            for (int p = 0; p < 8; ++p) s += cpart[p * 48 + tid];
            s += tid < 4 ? a->in[I_MBRG][l * 4 + tid] : (tid < 36 ? a->in[I_MBRE][l * 32 + tid - 4] : 0.f); cvec[tid] = s; }
        {
            const int i16 = lane & 15, kq = lane >> 4, r0 = c * 128 + wave * 16;
            f32x4m acc0 = {0.f, 0.f, 0.f, 0.f}, acc1 = acc0, acc2 = acc0;
            const float* xrow = x + (size_t)(r0 + i16) * DM + 4 * kq;
            constexpr int PD = 4;
            const float* wbase = RTW + (size_t)(kq * 16 + i16) * 12;
            f32x4 xq[PD], wq[PD][3];
#pragma unroll
            for (int s = 0; s < PD; ++s) { xq[s] = *(const GAS f32x4*)(xrow + 16 * s); const GAS f32x4* wp = (const GAS f32x4*)(wbase + (size_t)(4 * s) * 16 * 12); wq[s][0] = wp[0]; wq[s][1] = wp[1]; wq[s][2] = wp[2]; }
#pragma unroll 1
            for (int k0 = 0; k0 < DM; k0 += 16 * PD) {
#pragma unroll
                for (int s = 0; s < PD; ++s) {
                    const f32x4 xv = xq[s], w0 = wq[s][0], w1 = wq[s][1], w2 = wq[s][2];
                    { const int kn = min(k0 + 16 * (s + PD), DM - 16); xq[s] = *(const GAS f32x4*)(xrow + kn); const GAS f32x4* wp = (const GAS f32x4*)(wbase + (size_t)(kn >> 2) * 16 * 12); wq[s][0] = wp[0]; wq[s][1] = wp[1]; wq[s][2] = wp[2]; }
                    __builtin_amdgcn_sched_barrier(0);
                    const f32x4 sv = *(const LAS f32x4*)(sc + k0 + 16 * s + 4 * kq);
                    const float wf[12] = {w0[0], w0[1], w0[2], w0[3], w1[0], w1[1], w1[2], w1[3], w2[0], w2[1], w2[2], w2[3]};
#pragma unroll
                    for (int j = 0; j < 4; ++j) { const float av = xv[j] * sv[j];
                        acc0 = __builtin_amdgcn_mfma_f32_16x16x4f32(av, wf[j * 3], acc0, 0, 0, 0);
                        acc1 = __builtin_amdgcn_mfma_f32_16x16x4f32(av, wf[j * 3 + 1], acc1, 0, 0, 0);
                        acc2 = __builtin_amdgcn_mfma_f32_16x16x4f32(av, wf[j * 3 + 2], acc2, 0, 0, 0); }
                }
            }
            __syncthreads();
            LAS float* lw = lg + wave * 16 * 48;
#pragma unroll
            for (int r = 0; r < 4; ++r) { const int rr = 4 * kq + r; const float rs = rstd_s[wave * 16 + rr];
                lw[rr * 48 + i16] = acc0[r] * rs + cvec[i16]; lw[rr * 48 + 16 + i16] = acc1[r] * rs + cvec[16 + i16]; lw[rr * 48 + 32 + i16] = acc2[r] * rs + cvec[32 + i16]; }
            LDS_WAIT(); asm volatile("" ::: "memory");
            if (lane < 16) {
                const LAS float* lr = lw + lane * 48; const int row = r0 + lane;
                float g0 = lr[0], g1 = lr[1], g2 = lr[2], g3 = lr[3]; const float gm = fmaxf(fmaxf(g0, g1), fmaxf(g2, g3));
                float p0 = __expf(g0 - gm), p1 = __expf(g1 - gm), p2 = __expf(g2 - gm), p3 = __expf(g3 - gm); const float inv = 1.f / (p0 + p1 + p2 + p3);
                p0 *= inv; p1 *= inv; p2 *= inv; p3 *= inv;
                int gi = 0; float gp = p0; if (p1 > gp) { gp = p1; gi = 1; } if (p2 > gp) { gp = p2; gi = 2; } if (p3 > gp) { gp = p3; gi = 3; }
                float ev0 = -3.4e38f, ev1 = -3.4e38f; int e0 = 0, e1 = 0;
#pragma unroll
                for (int j = 0; j < 8; ++j) { const float s = lr[4 + gi * 8 + j]; if (s > ev0) { ev1 = ev0; e1 = e0; ev0 = s; e0 = j; } else if (s > ev1) { ev1 = s; e1 = j; } }
                const float q = __expf(ev1 - ev0), w0 = gp / (1.f + q), w1 = gp * q / (1.f + q);
                e0 += gi * 8; e1 += gi * 8;
                TOKE[2 * row] = e0; TOKE[2 * row + 1] = e1; TOKW[2 * row] = w0; TOKW[2 * row + 1] = w1;
                const int a0 = 2 * (wave * 16 + lane);
                asg_e[a0] = e0; asg_e[a0 + 1] = e1; asg_lp[a0] = atomicAdd((int*)&hist[e0], 1); asg_lp[a0 + 1] = atomicAdd((int*)&hist[e1], 1);
            }
        }
        __syncthreads();
        if (tid < 32) { const int h = hist[tid]; basev[tid] = h ? (int)atomicAdd(CNT + tid, (unsigned)h) : 0; }
        __syncthreads();
        if (tid < 256) { const int e = asg_e[tid]; LIST[(size_t)e * 65536 + basev[e] + asg_lp[tid]] = (c * 128) * 2 + tid; }
    }
}
__device__ __forceinline__ void build_ptab(const unsigned* CNT, LAS int* ptab, LAS int* pst, LAS int* cnt, int tid) {
    __syncthreads();
    if (tid < NEXP) {
        const int ce = (int)__hip_atomic_load(CNT + tid, RLX_AGENT); cnt[tid] = ce; const int pe = (ce + 255) >> 8;
        int incl = pe;
#pragma unroll
        for (int d = 1; d < NEXP; d <<= 1) { const int t = __shfl_up(incl, d, 64); if (tid >= d) incl += t; }
        const int start = incl - pe; pst[tid] = start * 256;
        for (int p = 0; p < pe; ++p) ptab[1 + start + p] = tid;
        if (tid == NEXP - 1) ptab[0] = incl; }
    __syncthreads();
}
__device__ __forceinline__ void phase_gather(KArgsP a, LAS unsigned char* lds, int tid, int lane, int wave, int vcu, int G, int l) {
    unsigned char* ws = a->ws;
    LAS int* ptab = (LAS int*)lds; LAS int* pst = ptab + 512; LAS int* cnt = pst + 32;
    build_ptab((const unsigned*)(ws + WS_CTL) + CW_CNT + l * 32, ptab, pst, cnt, tid);
    const bf16* HN = (const bf16*)(ws + WS_HN); bf16* XG = (bf16*)(ws + WS_XG); int* ROWMAP = (int*)(ws + WS_ROWMAP); const int* LIST = (const int*)(ws + WS_LIST);
    const int nrows = ptab[0] * 256;
    for (int row0 = (vcu * NWAVES + wave) * 8; row0 < nrows; row0 += G * NWAVES * 8) {
        int tok2[8]; v4u p0[8], p1[8];
#pragma unroll
        for (int j = 0; j < 8; ++j) { const int row = row0 + j, e = ptab[1 + (row >> 8)], pos = row - pst[e]; tok2[j] = (pos < cnt[e]) ? LIST[(size_t)e * 65536 + pos] : -1; }
#pragma unroll
        for (int j = 0; j < 8; ++j) { if (tok2[j] >= 0) { const GAS v4u* s = (const GAS v4u*)(HN + (size_t)(tok2[j] >> 1) * DM) + lane; p0[j] = s[0]; p1[j] = s[64]; } else { p0[j] = (v4u){0u, 0u, 0u, 0u}; p1[j] = p0[j]; } }
#pragma unroll
        for (int j = 0; j < 8; ++j) { GAS v4u* d = (GAS v4u*)(XG + (size_t)(row0 + j) * DM) + lane; d[0] = p0[j]; d[64] = p1[j]; if (lane == 0) ROWMAP[row0 + j] = tok2[j]; }
    }
}

__device__ __forceinline__ void phase_rowmap(KArgsP a, LAS unsigned char* lds, int tid, int vcu, int G, int l) {
    unsigned char* ws = a->ws;
    LAS int* ptab = (LAS int*)lds; LAS int* pst = ptab + 512; LAS int* cnt = pst + 32;
    build_ptab((const unsigned*)(ws + WS_CTL) + CW_CNT + l * 32, ptab, pst, cnt, tid);
    int* ROWMAP = (int*)(ws + WS_ROWMAP); const int* LIST = (const int*)(ws + WS_LIST);
    const int nrows = ptab[0] * 256;
    for (int row = vcu * NTHR + tid; row < nrows; row += G * NTHR) { const int e = ptab[1 + (row >> 8)], pos = row - pst[e]; ROWMAP[row] = (pos < cnt[e]) ? LIST[(size_t)e * 65536 + pos] : -1; }
}

typedef short bf16x8 __attribute__((ext_vector_type(8)));
constexpr int MT = 72;
constexpr int ML_XP = 0;
constexpr int ML_CX = 17152;
constexpr int ML_WQ = ML_CX + 9216, ML_WK = ML_WQ + 9216;
constexpr int ML_Q = ML_WK + 9216, ML_K = ML_Q + 9216;
constexpr int ML_S = ML_K + 9216;
constexpr int ML_VT = ML_S + 9216;
constexpr int ML_CT = ML_VT + 11520;
constexpr int ML_H = ML_CT + 11520;
constexpr int ML_SM = ML_H + 16640;
static_assert(ML_SM + 2048 <= RING_BYTES, "mLSTM LDS map");
__device__ __forceinline__ float logsigmoidf_(float x) { return fminf(x, 0.f) - log1pf(__expf(-fabsf(x))); }
__device__ __forceinline__ void mma64(const LAS bf16* A, int arow0, const LAS bf16* Bt, int brow0, int lane, f32x4& acc) {
    const LAS bf16* ap = A + (arow0 + (lane & 15)) * MT + 8 * (lane >> 4); const LAS bf16* bp = Bt + (brow0 + (lane & 15)) * MT + 8 * (lane >> 4);
    const bf16x8 a0 = *(const LAS bf16x8*)ap, a1 = *(const LAS bf16x8*)(ap + 32), b0 = *(const LAS bf16x8*)bp, b1 = *(const LAS bf16x8*)(bp + 32);
    acc = __builtin_amdgcn_mfma_f32_16x16x32_bf16(a0, b0, acc, 0, 0, 0); acc = __builtin_amdgcn_mfma_f32_16x16x32_bf16(a1, b1, acc, 0, 0, 0);
}
__device__ __forceinline__ void ml_front(KArgsP a, LAS unsigned char* lds, int tid, int l, int b, int c, int h, bool want_q) {
    const bf16* PROJ = (const bf16*)(a->ws + WS_PROJ); const size_t row0 = (size_t)b * SEQ + c * 64;
    LAS float* xp = (LAS float*)(lds + ML_XP);
    for (int idx = tid; idx < 67 * 8; idx += NTHR) { const int r = idx >> 3, c8 = idx & 7, tr = c * 64 + r - 3; LAS float* d = xp + r * 64 + c8 * 8;
        if (tr >= 0) { const v4u p = *(const GAS v4u*)(PROJ + ((size_t)b * SEQ + tr) * NPROJ + PC_QK + h * 64 + c8 * 8);
            *(LAS f32x4*)d = (f32x4){bflo(p.x), bfhi(p.x), bflo(p.y), bfhi(p.y)}; *(LAS f32x4*)(d + 4) = (f32x4){bflo(p.z), bfhi(p.z), bflo(p.w), bfhi(p.w)}; }
        else { *(LAS f32x4*)d = (f32x4){0.f, 0.f, 0.f, 0.f}; *(LAS f32x4*)(d + 4) = (f32x4){0.f, 0.f, 0.f, 0.f}; } }
    {
        const int t = tid >> 3, vg = tid & 7; LAS bf16* VT = (LAS bf16*)(lds + ML_VT);
        const v4u p = *(const GAS v4u*)(PROJ + (row0 + t) * NPROJ + PC_V + h * 64 + vg * 8);
        const unsigned w[4] = {p.x, p.y, p.z, p.w};
#pragma unroll
        for (int j = 0; j < 4; ++j) { VT[(vg * 8 + 2 * j) * MT + t] = (bf16)(w[j] & 0xffffu); VT[(vg * 8 + 2 * j + 1) * MT + t] = (bf16)(w[j] >> 16); }
        for (int idx = tid; idx < 16 * 64; idx += NTHR) VT[(64 + (idx >> 6)) * MT + (idx & 63)] = (idx < 64) ? (bf16)0x3F80 : (bf16)0;
        const bf16* WT = (const bf16*)(a->ws + WS_MLW) + (size_t)((l * NH + h) * 2) * 4096;
        const int e = tid >> 3, d8 = tid & 7;
        if (want_q) *(LAS v4u*)(lds + ML_WQ + (e * MT + d8 * 8) * 2) = *(const GAS v4u*)(WT + e * 64 + d8 * 8);
        *(LAS v4u*)(lds + ML_WK + (e * MT + d8 * 8) * 2) = *(const GAS v4u*)(WT + 4096 + e * 64 + d8 * 8);
    }
    __syncthreads();
    const float* cw = a->in[I_CONV_W] + (size_t)l * 4 * DA + h * 64; const float* cb = a->in[I_CONV_B] + (size_t)l * DA + h * 64;
    {
        const int t = tid >> 3, c8 = (tid & 7) * 8; float s[8];
#pragma unroll
        for (int j = 0; j < 8; ++j) s[j] = cb[c8 + j];
#pragma unroll
        for (int q = 0; q < 4; ++q) { const f32x4 x0 = *(const LAS f32x4*)(xp + (t + q) * 64 + c8), x1 = *(const LAS f32x4*)(xp + (t + q) * 64 + c8 + 4); const float* w = cw + q * DA + c8;
            s[0] += x0.x * w[0]; s[1] += x0.y * w[1]; s[2] += x0.z * w[2]; s[3] += x0.w * w[3]; s[4] += x1.x * w[4]; s[5] += x1.y * w[5]; s[6] += x1.z * w[6]; s[7] += x1.w * w[7]; }
#pragma unroll
        for (int j = 0; j < 8; ++j) s[j] = s[j] / (1.f + __expf(-s[j]));
        v4u o; o.x = pk2(s[0], s[1]); o.y = pk2(s[2], s[3]); o.z = pk2(s[4], s[5]); o.w = pk2(s[6], s[7]);
        *(LAS v4u*)(lds + ML_CX + (t * MT + c8) * 2) = o;
    }
}
__device__ __forceinline__ void phase_m1(KArgsP a, LAS unsigned char* lds, int tid, int lane, int wave, int vcu, int G, int l) {
    unsigned char* ws = a->ws; const float* GT = (const float*)(ws + WS_GATES);
    float* CLOC = (float*)(ws + WS_CLOC); float* MLG = (float*)(ws + WS_MSC); float* MLM = MLG + 4096;
    LAS float* sm = (LAS float*)(lds + ML_SM);
    for (int u = vcu; u < NUNIT_M; u += G) {
        const int h = u % NH, c = (u / NH) % NCH, b = u / (NH * NCH); const size_t row0 = (size_t)b * SEQ + c * 64;
        __syncthreads();
        ml_front(a, lds, tid, l, b, c, h, false);
        if (wave == 0) {
            const float ig = GT[(row0 + lane) * 16 + h] + a->in[I_BI][l * NH + h];
            const float fl = logsigmoidf_(GT[(row0 + lane) * 16 + 6 + h] + a->in[I_BF][l * NH + h]);
            float bc = fl;
#pragma unroll
            for (int o = 1; o < 64; o <<= 1) { const float t = __shfl_up(bc, o); if (lane >= o) bc += t; }
            const float gtot = __shfl(bc, 63); const float lw = gtot - bc + ig; const float ml = wave_max(lw);
            sm[lane] = __expf(lw - ml);
            if (lane == 0) { MLG[u] = gtot; MLM[u] = ml; }
        }
        __syncthreads();
        {
            const int rt = wave >> 1; LAS bf16* KT = (LAS bf16*)(lds + ML_K);
#pragma unroll
            for (int q = 0; q < 2; ++q) { const int ct = 2 * (wave & 1) + q; f32x4 acc = {0.f, 0.f, 0.f, 0.f};
                mma64((const LAS bf16*)(lds + ML_CX), 16 * rt, (const LAS bf16*)(lds + ML_WK), 16 * ct, lane, acc);
                const int t0 = 16 * rt + 4 * (lane >> 4), e = 16 * ct + (lane & 15);
                const float w0 = sm[t0] * 0.125f, w1 = sm[t0 + 1] * 0.125f, w2 = sm[t0 + 2] * 0.125f, w3 = sm[t0 + 3] * 0.125f;
                v2u o; o.x = pk2(acc[0] * w0, acc[1] * w1); o.y = pk2(acc[2] * w2, acc[3] * w3);
                *(LAS v2u*)(KT + e * MT + t0) = o; }
        }
        __syncthreads();
        {
            const int ct = wave & 3, r_lo = wave < 4 ? 0 : 3, r_hi = wave < 4 ? 3 : 5; float* cl = CLOC + (size_t)u * CL_STRIDE;
            for (int rt = r_lo; rt < r_hi; ++rt) { f32x4 acc = {0.f, 0.f, 0.f, 0.f};
                mma64((const LAS bf16*)(lds + ML_VT), 16 * rt, (const LAS bf16*)(lds + ML_K), 16 * ct, lane, acc);
                const int v0 = 16 * rt + 4 * (lane >> 4), e = 16 * ct + (lane & 15);
                if (rt < 4) {
#pragma unroll
                    for (int r = 0; r < 4; ++r) cl[(v0 + r) * 64 + e] = acc[r];
                } else if ((lane >> 4) == 0) cl[4096 + e] = acc[0]; }
        }
    }
}
__device__ __forceinline__ void phase_m2(unsigned char* ws, int tid, int wg, int nwg) {
    float* CLOC = (float*)(ws + WS_CLOC); const float* MLG = (const float*)(ws + WS_MSC); const float* MLM = MLG + 4096; float* MST = (float*)(ws + WS_MSC) + 8192;
    for (int idx = wg * NTHR + tid; idx < NB * NH * CL_STRIDE; idx += nwg * NTHR) {
        const int e = idx % CL_STRIDE, bh = idx / CL_STRIDE, b = bh / NH, h = bh % NH;
        float m = 0.f, cs = 0.f;
        float cn[8], gn[8], mn8[8];
#pragma unroll
        for (int j = 0; j < 8; ++j) { const int u = (b * NCH + j) * NH + h; cn[j] = CLOC[(size_t)u * CL_STRIDE + e]; gn[j] = MLG[u]; mn8[j] = MLM[u]; }
        for (int c0 = 0; c0 < NCH; c0 += 8) {
            float cl[8], g[8], ml[8];
#pragma unroll
            for (int j = 0; j < 8; ++j) { cl[j] = cn[j]; g[j] = gn[j]; ml[j] = mn8[j]; }
            { const int cq = min(c0 + 8, NCH - 8);
#pragma unroll
              for (int j = 0; j < 8; ++j) { const int u = (b * NCH + cq + j) * NH + h; cn[j] = CLOC[(size_t)u * CL_STRIDE + e]; gn[j] = MLG[u]; mn8[j] = MLM[u]; } }
#pragma unroll
            for (int j = 0; j < 8; ++j) { const int u = (b * NCH + c0 + j) * NH + h;
                CLOC[(size_t)u * CL_STRIDE + e] = cs; if (e == 0) MST[u] = m;
                const float mn = fmaxf(g[j] + m, ml[j]); const float ao = __expf(g[j] + m - mn), al = __expf(ml[j] - mn);
                cs = ao * cs + al * cl[j]; m = mn; }
        }
    }
}
__device__ __forceinline__ void phase_m3(KArgsP a, LAS unsigned char* lds, int tid, int lane, int wave, int vcu, int G, int l) {
    unsigned char* ws = a->ws; const bf16* PROJ = (const bf16*)(ws + WS_PROJ); const float* GT = (const float*)(ws + WS_GATES);
    const float* CLOC = (const float*)(ws + WS_CLOC); const float* MST = (const float*)(ws + WS_MSC) + 8192; bf16* YC = (bf16*)(ws + WS_YC);
    LAS float* sm = (LAS float*)(lds + ML_SM); LAS float* hb = (LAS float*)(lds + ML_H);
    for (int u = vcu; u < NUNIT_M; u += G) {
        const int h = u % NH, c = (u / NH) % NCH, b = u / (NH * NCH); const size_t row0 = (size_t)b * SEQ + c * 64;
        __syncthreads();
        ml_front(a, lds, tid, l, b, c, h, true);
        {
            const float* cl = CLOC + (size_t)u * CL_STRIDE; LAS bf16* CT = (LAS bf16*)(lds + ML_CT);
            for (int idx = tid; idx < 65 * 16; idx += NTHR) { const int r = idx >> 4, c4 = idx & 15; const f32x4 v = *(const GAS f32x4*)(cl + r * 64 + c4 * 4);
                v2u o; o.x = pk2(v.x, v.y); o.y = pk2(v.z, v.w); *(LAS v2u*)(CT + r * MT + c4 * 4) = o; }
            for (int idx = tid; idx < 15 * 64; idx += NTHR) CT[(65 + (idx >> 6)) * MT + (idx & 63)] = 0;
        }
        if (wave == 0) {
            const float ig = GT[(row0 + lane) * 16 + h] + a->in[I_BI][l * NH + h];
            const float fl = logsigmoidf_(GT[(row0 + lane) * 16 + 6 + h] + a->in[I_BF][l * NH + h]);
            float bc = fl;
#pragma unroll
            for (int o = 1; o < 64; o <<= 1) { const float t = __shfl_up(bc, o); if (lane >= o) bc += t; }
            float pm = ig - bc;
#pragma unroll
            for (int o = 1; o < 64; o <<= 1) { const float t = __shfl_up(pm, o); if (lane >= o) pm = fmaxf(pm, t); }
            const float mst = MST[u]; const float inter = bc + mst, mt = fmaxf(inter, bc + pm);
            sm[lane] = ig - bc; sm[64 + lane] = bc - mt; sm[128 + lane] = __expf(inter - mt); sm[192 + lane] = __expf(-mt);
        }
        __syncthreads();
        {
            const int rt = wave >> 1; LAS bf16* Qs = (LAS bf16*)(lds + ML_Q); LAS bf16* Ks = (LAS bf16*)(lds + ML_K);
#pragma unroll
            for (int q = 0; q < 2; ++q) { const int ct = 2 * (wave & 1) + q; f32x4 aq = {0.f, 0.f, 0.f, 0.f}, ak = {0.f, 0.f, 0.f, 0.f};
                mma64((const LAS bf16*)(lds + ML_CX), 16 * rt, (const LAS bf16*)(lds + ML_WQ), 16 * ct, lane, aq);
                mma64((const LAS bf16*)(lds + ML_CX), 16 * rt, (const LAS bf16*)(lds + ML_WK), 16 * ct, lane, ak);
                const int t0 = 16 * rt + 4 * (lane >> 4), e = 16 * ct + (lane & 15);
#pragma unroll
                for (int r = 0; r < 4; ++r) { Qs[(t0 + r) * MT + e] = (bf16)f2bf(aq[r]); Ks[(t0 + r) * MT + e] = (bf16)f2bf(ak[r] * 0.125f); } }
        }
        __syncthreads();
        {
            const int rt = wave >> 1; LAS bf16* Ss = (LAS bf16*)(lds + ML_S);
#pragma unroll
            for (int q = 0; q < 2; ++q) { const int ct = 2 * (wave & 1) + q; f32x4 acc = {0.f, 0.f, 0.f, 0.f};
                if (ct <= rt) mma64((const LAS bf16*)(lds + ML_Q), 16 * rt, (const LAS bf16*)(lds + ML_K), 16 * ct, lane, acc);
                const int t0 = 16 * rt + 4 * (lane >> 4), s = 16 * ct + (lane & 15); const float qs = sm[s];
#pragma unroll
                for (int r = 0; r < 4; ++r) { const int t = t0 + r; Ss[t * MT + s] = (bf16)f2bf((s <= t) ? acc[r] * __expf(sm[64 + t] + qs) : 0.f); } }
        }
        __syncthreads();
        {
            const int rt = wave >> 1, nt = (wave & 1) ? 2 : 3;
            for (int q = 0; q < nt; ++q) { const int ct = (wave & 1) ? 2 + q : (q < 2 ? q : 4); f32x4 aA = {0.f, 0.f, 0.f, 0.f}, aB = {0.f, 0.f, 0.f, 0.f};
                mma64((const LAS bf16*)(lds + ML_Q), 16 * rt, (const LAS bf16*)(lds + ML_CT), 16 * ct, lane, aA);
                mma64((const LAS bf16*)(lds + ML_S), 16 * rt, (const LAS bf16*)(lds + ML_VT), 16 * ct, lane, aB);
                const int t0 = 16 * rt + 4 * (lane >> 4), v = 16 * ct + (lane & 15);
#pragma unroll
                for (int r = 0; r < 4; ++r) { const int t = t0 + r; const float x = sm[128 + t] * aA[r] + aB[r];
                    if (ct < 4) hb[t * 65 + v] = x; else if ((lane & 15) == 0) sm[256 + t] = x; } }
        }
        __syncthreads();
        {
            const int t = tid >> 3, vg = tid & 7; float acc[8];
            const float dn = 1.f / fmaxf(fabsf(sm[256 + t]), sm[192 + t]);
            float s1 = 0.f;
#pragma unroll
            for (int j = 0; j < 8; ++j) { acc[j] = hb[t * 65 + vg * 8 + j] * dn; s1 += acc[j]; }
            s1 += __shfl_xor(s1, 1); s1 += __shfl_xor(s1, 2); s1 += __shfl_xor(s1, 4);
            const float mu = s1 * (1.f / 64.f); float s2 = 0.f;
#pragma unroll
            for (int j = 0; j < 8; ++j) { acc[j] -= mu; s2 += acc[j] * acc[j]; }
            s2 += __shfl_xor(s2, 1); s2 += __shfl_xor(s2, 2); s2 += __shfl_xor(s2, 4);
            const float rs = rsqrtf(s2 * (1.f / 64.f) + HEAD_NORM_EPS);
            const float* nw = a->in[I_MNORM_W] + (size_t)l * DA + h * 64 + vg * 8;
            const v4u ov = *(const GAS v4u*)(PROJ + (row0 + t) * NPROJ + PC_O + h * 64 + vg * 8);
            const float o[8] = {bflo(ov.x), bfhi(ov.x), bflo(ov.y), bfhi(ov.y), bflo(ov.z), bfhi(ov.z), bflo(ov.w), bfhi(ov.w)};
            float r[8];
#pragma unroll
            for (int j = 0; j < 8; ++j) r[j] = acc[j] * rs * nw[j] * sigmoidf_(o[j]);
            v4u w; w.x = pk2(r[0], r[1]); w.y = pk2(r[2], r[3]); w.z = pk2(r[4], r[5]); w.w = pk2(r[6], r[7]);
            *(GAS v4u*)(YC + (row0 + t) * DM + h * 64 + vg * 8) = w;
        }
    }
}

constexpr int S5_UT = 264, S5_XT = 2056;
constexpr int S5_U = 0, S5_Z = 33792, S5_X = 67584;
static_assert(S5_X + 16 * S5_XT * 2 <= MISC_OFF, "S5 LDS map");
struct S5A { float are, aim, cre, cim; };
__device__ __forceinline__ S5A s5_a(KArgsP a, int l, int g, int p) {
    const float lam_re = a->in[I_S5ARE][(size_t)(l * 16 + g) * 64 + p], lam_im = a->in[I_S5AIM][(size_t)(l * 16 + g) * 64 + p];
    const float dt = expf(a->in[I_S5LDT][l * 16 + g]); const float mag = expf(lam_re * dt), ang = lam_im * dt;
    S5A r; r.are = mag * cosf(ang); r.aim = mag * sinf(ang);
    const float inv = 1.f / (lam_re * lam_re + lam_im * lam_im);
    r.cre = ((r.are - 1.f) * lam_re + r.aim * lam_im) * inv; r.cim = (r.aim * lam_re - (r.are - 1.f) * lam_im) * inv; return r;
}
__device__ __forceinline__ bf16x8 pack8(const float* v) { v4u o; o.x = pk2(v[0], v[1]); o.y = pk2(v[2], v[3]); o.z = pk2(v[4], v[5]); o.w = pk2(v[6], v[7]); return __builtin_bit_cast(bf16x8, o); }
__device__ __forceinline__ void s5_bfrag(const unsigned char* ws, int l, int g, int lane, bf16x8 (&bf)[8]) {
    const bf16* BB = (const bf16*)(ws + WS_S5BB) + (size_t)(l * 16 + g) * 128 * 16;
#pragma unroll
    for (int j = 0; j < 8; ++j) { v4u o = {0u, 0u, 0u, 0u}; if ((lane >> 4) < 2) o = *(const GAS v4u*)(BB + (16 * j + (lane & 15)) * 16 + 8 * (lane >> 4)); bf[j] = __builtin_bit_cast(bf16x8, o); }
}
__device__ __forceinline__ f32x2 s5_ap(const unsigned char* ws, int l, int g, int p) { return *(const GAS f32x2*)((const float*)(ws + WS_S5AP) + ((size_t)(l * 16 + g) * 64 + p) * 2); }
__device__ __forceinline__ void s5_load_u(const unsigned char* ws, LAS unsigned char* lds, int tid, size_t row0) {
    const bf16* PROJ = (const bf16*)(ws + WS_PROJ);
    for (int idx = tid; idx < 64 * 32; idx += NTHR) { const int t = idx >> 5, c8 = idx & 31;
        *(LAS v4u*)(lds + S5_U + (t * S5_UT + c8 * 8) * 2) = *(const GAS v4u*)(PROJ + (row0 + t) * NPROJ + PC_S5 + c8 * 8); }
}
__device__ __forceinline__ void s5_block(LAS unsigned char* lds, int lane, int tb, int g, const bf16x8 (&bf)[8], float are, float aim, float& xr, float& xi) {
    const int kq = lane >> 4; bf16x8 uf = {0, 0, 0, 0, 0, 0, 0, 0};
    if (kq < 2) uf = *(const LAS bf16x8*)(lds + S5_U + ((16 * tb + (lane & 15)) * S5_UT + g * 16 + 8 * kq) * 2);
    LAS bf16* X = (LAS bf16*)(lds + S5_X);
#pragma unroll
    for (int j = 0; j < 8; ++j) { f32x4 acc = {0.f, 0.f, 0.f, 0.f}; acc = __builtin_amdgcn_mfma_f32_16x16x32_bf16(bf[j], uf, acc, 0, 0, 0);
        v2u o; o.x = pk2(acc[0], acc[1]); o.y = pk2(acc[2], acc[3]); *(LAS v2u*)(X + (lane & 15) * S5_XT + g * 128 + 16 * j + 4 * kq) = o; }
    LDS_WAIT(); asm volatile("" ::: "memory");
    LAS unsigned* xw = (LAS unsigned*)(lds + S5_X) + (g * 128 + 2 * lane) / 2;
    unsigned wv[16];
#pragma unroll
    for (int t = 0; t < 16; ++t) wv[t] = xw[t * (S5_XT / 2)];
#pragma unroll
    for (int t = 0; t < 16; ++t) { const float br = bflo(wv[t]), bi = bfhi(wv[t]);
        const float nr = are * xr - aim * xi + br, ni = are * xi + aim * xr + bi; xr = nr; xi = ni;
        wv[t] = pk2(xr, xi); }
#pragma unroll
    for (int t = 0; t < 16; ++t) xw[t * (S5_XT / 2)] = wv[t];
    LDS_WAIT(); asm volatile("" ::: "memory");
}
__device__ __forceinline__ void phase_s1(KArgsP a, LAS unsigned char* lds, int tid, int lane, int wave, int vcu, int G, int l) {
    unsigned char* ws = a->ws; float* ST = (float*)(ws + WS_S5ST);
    bf16x8 bf0[8], bf1[8]; s5_bfrag(ws, l, wave, lane, bf0); s5_bfrag(ws, l, wave + 8, lane, bf1);
    struct { float are, aim; } A0, A1; { const f32x2 q0 = s5_ap(ws, l, wave, lane), q1 = s5_ap(ws, l, wave + 8, lane); A0.are = q0.x; A0.aim = q0.y; A1.are = q1.x; A1.aim = q1.y; }
    for (int u = vcu; u < NB * NCH; u += G) {
        const size_t row0 = (size_t)u * 64;
        __syncthreads();
        s5_load_u(ws, lds, tid, row0);
        __syncthreads();
        float x0r = 0.f, x0i = 0.f, x1r = 0.f, x1i = 0.f;
        for (int tb = 0; tb < 4; ++tb) { s5_block(lds, lane, tb, wave, bf0, A0.are, A0.aim, x0r, x0i); s5_block(lds, lane, tb, wave + 8, bf1, A1.are, A1.aim, x1r, x1i); }
        *(f32x2*)(ST + (((size_t)u * 16 + wave) * 64 + lane) * 2) = (f32x2){x0r, x0i};
        *(f32x2*)(ST + (((size_t)u * 16 + wave + 8) * 64 + lane) * 2) = (f32x2){x1r, x1i};
    }
}
__device__ __forceinline__ void phase_s2(KArgsP a, int tid, int wg, int nwg, int l) {
    float* ST = (float*)(a->ws + WS_S5ST);
    for (int idx = wg * NTHR + tid; idx < NB * 1024; idx += nwg * NTHR) {
        const int b = idx >> 10, gp = idx & 1023, g = gp >> 6, p = gp & 63;
        const f32x2 A = s5_ap(a->ws, l, g, p); float ar = A.x, ai = A.y;
#pragma unroll
        for (int s = 0; s < 6; ++s) { const float nr = ar * ar - ai * ai, ni = 2.f * ar * ai; ar = nr; ai = ni; }
        float cr = 0.f, ci = 0.f;
        f32x2 en[8];
#pragma unroll
        for (int j = 0; j < 8; ++j) en[j] = *(const f32x2*)(ST + (((size_t)(b * NCH + j) * 16 + g) * 64 + p) * 2);
        for (int c0 = 0; c0 < NCH; c0 += 8) {
            f32x2 e[8];
#pragma unroll
            for (int j = 0; j < 8; ++j) e[j] = en[j];
            { const int cq = min(c0 + 8, NCH - 8);
#pragma unroll
              for (int j = 0; j < 8; ++j) en[j] = *(const f32x2*)(ST + (((size_t)(b * NCH + cq + j) * 16 + g) * 64 + p) * 2); }
#pragma unroll
            for (int j = 0; j < 8; ++j) { *(f32x2*)(ST + (((size_t)(b * NCH + c0 + j) * 16 + g) * 64 + p) * 2) = (f32x2){cr, ci};
                const float nr = ar * cr - ai * ci + e[j].x, ni = ar * ci + ai * cr + e[j].y; cr = nr; ci = ni; }
        }
    }
}
__device__ __forceinline__ float tanh_fast(float x) { return 1.f - 2.f / (1.f + __expf(2.f * x)); }
__device__ __forceinline__ float gelu_tanh_(float x) { const float t = tanh_fast(0.7978845608f * (x + 0.044715f * x * x * x)); return 0.5f * x * (1.f + t); }
__device__ __forceinline__ void s5_cload(const bf16* cmt  , int lane, bf16x8 (&cf)[4]) {
#pragma unroll
    for (int s = 0; s < 4; ++s) cf[s] = __builtin_bit_cast(bf16x8, *(const GAS v4u*)(cmt + (lane & 15) * 128 + 32 * s + 8 * (lane >> 4)));
}
__device__ __forceinline__ void s5_cproj(LAS unsigned char* lds, int lane, int tb, int g, const bf16x8 (&cf)[4], const float (&dv)[4]) {
    const int kq = lane >> 4; f32x4 acc = {0.f, 0.f, 0.f, 0.f};
    const LAS bf16* xp = (const LAS bf16*)(lds + S5_X) + (lane & 15) * S5_XT + g * 128 + 8 * kq;
#pragma unroll
    for (int s = 0; s < 4; ++s) acc = __builtin_amdgcn_mfma_f32_16x16x32_bf16(cf[s], *(const LAS bf16x8*)(xp + 32 * s), acc, 0, 0, 0);
    const int t = 16 * tb + (lane & 15), c0 = g * 16 + 4 * kq;
    const v2u uw = *(const LAS v2u*)(lds + S5_U + (t * S5_UT + c0) * 2);
    const float u4[4] = {bflo(uw.x), bfhi(uw.x), bflo(uw.y), bfhi(uw.y)}; float z[4];
#pragma unroll
    for (int r = 0; r < 4; ++r) z[r] = gelu_tanh_(acc[r] + dv[r] * u4[r]);
    v2u o; o.x = pk2(z[0], z[1]); o.y = pk2(z[2], z[3]); *(LAS v2u*)(lds + S5_Z + (t * S5_UT + c0) * 2) = o;
}
__device__ __forceinline__ void phase_s3(KArgsP a, LAS unsigned char* lds, int tid, int lane, int wave, int vcu, int G, int l, unsigned* qctr = nullptr) {
    unsigned char* ws = a->ws; const float* ST = (const float*)(ws + WS_S5ST); bf16* YC = (bf16*)(ws + WS_YC);
    const bf16* GLUT = (const bf16*)(ws + WS_GLUT) + (size_t)l * DC * DC;
    bf16x8 bf0[8], bf1[8]; s5_bfrag(ws, l, wave, lane, bf0); s5_bfrag(ws, l, wave + 8, lane, bf1);
    const bf16* cm0 = (const bf16*)(ws + WS_S5CM) + (size_t)(l * 16 + wave) * 2048; const bf16* cm1 = cm0 + 8 * 2048;
    struct { float are, aim; } A0, A1; { const f32x2 q0 = s5_ap(ws, l, wave, lane), q1 = s5_ap(ws, l, wave + 8, lane); A0.are = q0.x; A0.aim = q0.y; A1.are = q1.x; A1.aim = q1.y; }
    float d0[4], d1[4];
#pragma unroll
    for (int r = 0; r < 4; ++r) { d0[r] = a->in[I_S5D][l * DC + wave * 16 + 4 * (lane >> 4) + r]; d1[r] = a->in[I_S5D][l * DC + (wave + 8) * 16 + 4 * (lane >> 4) + r]; }
    volatile LAS unsigned* qw = (volatile LAS unsigned*)(lds + MISC_OFF) + 20;
    unsigned qn = 0u; if (qctr && tid == 0) qn = __hip_atomic_fetch_add(qctr, 1u, __ATOMIC_RELAXED, __HIP_MEMORY_SCOPE_AGENT);
    for (int u = vcu; ; u += G) {
        if (qctr) { __syncthreads(); if (tid == 0) *qw = qn; __syncthreads(); u = (int)*qw; }
        if (u >= NB * NCH) break;
        if (qctr && tid == 0) qn = __hip_atomic_fetch_add(qctr, 1u, __ATOMIC_RELAXED, __HIP_MEMORY_SCOPE_AGENT);
        const size_t row0 = (size_t)u * 64;
        __syncthreads();
        s5_load_u(ws, lds, tid, row0);
        const f32x2 s0 = *(const f32x2*)(ST + (((size_t)u * 16 + wave) * 64 + lane) * 2), s1 = *(const f32x2*)(ST + (((size_t)u * 16 + wave + 8) * 64 + lane) * 2);
        float x0r = s0.x, x0i = s0.y, x1r = s1.x, x1i = s1.y;
        __syncthreads();
        for (int tb = 0; tb < 4; ++tb) {
            { bf16x8 cf[4]; s5_cload(cm0, lane, cf); s5_block(lds, lane, tb, wave, bf0, A0.are, A0.aim, x0r, x0i); s5_cproj(lds, lane, tb, wave, cf, d0); }
            { bf16x8 cf[4]; s5_cload(cm1, lane, cf); s5_block(lds, lane, tb, wave + 8, bf1, A1.are, A1.aim, x1r, x1i); s5_cproj(lds, lane, tb, wave + 8, cf, d1); }
        }
        __syncthreads();
        {
            const int kq = lane >> 4;
#pragma unroll
            for (int q = 0; q < 2; ++q) { const int ct = 2 * wave + q; f32x4 acc[4];
#pragma unroll
                for (int rt = 0; rt < 4; ++rt) acc[rt] = (f32x4){0.f, 0.f, 0.f, 0.f};
                const bf16* gp = GLUT + (size_t)(16 * ct + (lane & 15)) * DC + 8 * kq;
#pragma unroll 2
                for (int s = 0; s < 8; ++s) { const bf16x8 gf = __builtin_bit_cast(bf16x8, *(const GAS v4u*)(gp + 32 * s));
#pragma unroll
                    for (int rt = 0; rt < 4; ++rt) acc[rt] = __builtin_amdgcn_mfma_f32_16x16x32_bf16(gf, *(const LAS bf16x8*)(lds + S5_Z + ((16 * rt + (lane & 15)) * S5_UT + 32 * s + 8 * kq) * 2), acc[rt], 0, 0, 0); }
                const int j0 = 16 * ct + 4 * kq; const f32x4 gb = *(const GAS f32x4*)(a->in[I_S5GLUB] + l * DC + j0);
#pragma unroll
                for (int rt = 0; rt < 4; ++rt) { const int t = 16 * rt + (lane & 15); const v2u zw = *(const LAS v2u*)(lds + S5_Z + (t * S5_UT + j0) * 2);
                    const float z0 = bflo(zw.x), z1 = bfhi(zw.x), z2 = bflo(zw.y), z3 = bfhi(zw.y);
                    v2u o; o.x = pk2(z0 * sigmoidf_(acc[rt][0] + gb.x), z1 * sigmoidf_(acc[rt][1] + gb.y)); o.y = pk2(z2 * sigmoidf_(acc[rt][2] + gb.z), z3 * sigmoidf_(acc[rt][3] + gb.w));
                    *(GAS v2u*)(YC + (row0 + t) * DM + 768 + j0) = o; } }
        }
    }
}

__device__ __forceinline__ float rw_shift(const bf16* PROJ, const float* mu, size_t row, int col) {
    const float cur = bf2f(PROJ[row * NPROJ + PC_RW + col]); const float prv = (row % SEQ) ? bf2f(PROJ[(row - 1) * NPROJ + PC_RW + col]) : 0.f;
    return cur + mu[col] * (prv - cur);
}
constexpr int R1_TH = 0, R1_AD = 9216, R1_SG = 18432, R1_VS = 35840, R1_TMP = 86016;
template <int KS, int MODE>
__device__ __forceinline__ void r1_prod(const bf16* WT, const LAS bf16* act, int astride, const float* bias, bf16* OUT, size_t row0, int lane, int wave) {
    const int kq = lane >> 4, n0 = 48 * wave; constexpr int K = 32 * KS;
    f32x4 acc[3][4];
#pragma unroll
    for (int nt = 0; nt < 3; ++nt)
#pragma unroll
        for (int ti = 0; ti < 4; ++ti) acc[nt][ti] = (f32x4){0.f, 0.f, 0.f, 0.f};
#pragma unroll
    for (int s = 0; s < KS; ++s) { bf16x8 wf[3], af[4];
#pragma unroll
        for (int nt = 0; nt < 3; ++nt) wf[nt] = __builtin_bit_cast(bf16x8, *(const GAS v4u*)(WT + (size_t)(n0 + 16 * nt + (lane & 15)) * K + 32 * s + 8 * kq));
#pragma unroll
        for (int ti = 0; ti < 4; ++ti) af[ti] = *(const LAS bf16x8*)(act + (16 * ti + (lane & 15)) * astride + 32 * s + 8 * kq);
#pragma unroll
        for (int nt = 0; nt < 3; ++nt)
#pragma unroll
            for (int ti = 0; ti < 4; ++ti) acc[nt][ti] = __builtin_amdgcn_mfma_f32_16x16x32_bf16(wf[nt], af[ti], acc[nt][ti], 0, 0, 0); }
#pragma unroll
    for (int nt = 0; nt < 3; ++nt) { const int n = n0 + 16 * nt + 4 * kq; f32x4 bv = {0.f, 0.f, 0.f, 0.f}; if (MODE != 2) bv = *(const GAS f32x4*)(bias + n);
#pragma unroll
        for (int ti = 0; ti < 4; ++ti) { float o[4];
#pragma unroll
            for (int r = 0; r < 4; ++r) { const float x = acc[nt][ti][r] + bv[r]; o[r] = MODE == 0 ? 0.60653066f * sigmoidf_(x) : (MODE == 1 ? sigmoidf_(x) : x); }
            v2u w; w.x = pk2(o[0], o[1]); w.y = pk2(o[2], o[3]);
            *(GAS v2u*)(OUT + (row0 + 16 * ti + (lane & 15)) * DBR + n) = w; } }
}
__device__ __forceinline__ void phase_r1(KArgsP a, LAS unsigned char* lds, int tid, int lane, int wave, int vcu, int G, int l) {
    unsigned char* ws = a->ws; const bf16* PROJ = (const bf16*)(ws + WS_PROJ); const float* mu = a->in[I_RMU] + (size_t)l * RW_COLS;
    const bf16* W1 = (const bf16*)(ws + WS_R1W) + (size_t)l * 98304;
    const bf16* WV = (const bf16*)(ws + WS_R1W) + 2 * 98304;
    for (int u = vcu; u < NTOK / 64; u += G) {
        const size_t row0 = (size_t)u * 64;
        __syncthreads();
        for (int idx = tid; idx < 64 * 32; idx += NTHR) { const int tt = idx >> 5, col = 8 * (idx & 31); const size_t r = row0 + tt;
            const v4u cw = *(const GAS v4u*)(PROJ + r * NPROJ + PC_RW + RWC_WD + col); v4u pw = {0u, 0u, 0u, 0u}; if (r % SEQ) pw = *(const GAS v4u*)(PROJ + (r - 1) * NPROJ + PC_RW + RWC_WD + col);
            const f32x4 m0 = *(const GAS f32x4*)(mu + RWC_WD + col), m1 = *(const GAS f32x4*)(mu + RWC_WD + col + 4);
            const unsigned cu[4] = {cw.x, cw.y, cw.z, cw.w}, pu[4] = {pw.x, pw.y, pw.z, pw.w}; const float mm[8] = {m0[0], m0[1], m0[2], m0[3], m1[0], m1[1], m1[2], m1[3]}; unsigned o[4];
#pragma unroll
            for (int j = 0; j < 4; ++j) { const float c0 = bflo(cu[j]), c1 = bfhi(cu[j]); const float x0 = c0 + mm[2 * j] * (bflo(pu[j]) - c0), x1 = c1 + mm[2 * j + 1] * (bfhi(pu[j]) - c1);
                o[j] = col < 64 ? pk2(tanh_fast(x0), tanh_fast(x1)) : (col < 128 ? pk2(x0, x1) : pk2(sigmoidf_(x0), sigmoidf_(x1))); }
            v4u w; w.x = o[0]; w.y = o[1]; w.z = o[2]; w.w = o[3];
            if (col < 64) *(LAS v4u*)(lds + R1_TH + (tt * 72 + col) * 2) = w;
            else if (col < 128) *(LAS v4u*)(lds + R1_AD + (tt * 72 + col - 64) * 2) = w;
            else *(LAS v4u*)(lds + R1_SG + (tt * 136 + col - 128) * 2) = w; }
        if (l > 0) for (int idx = tid; idx < 64 * 48; idx += NTHR) { const int tt = idx / 48, col = 8 * (idx % 48); const size_t r = row0 + tt;
            const v4u cw = *(const GAS v4u*)(PROJ + r * NPROJ + PC_RW + RWC_V + col); v4u pw = {0u, 0u, 0u, 0u}; if (r % SEQ) pw = *(const GAS v4u*)(PROJ + (r - 1) * NPROJ + PC_RW + RWC_V + col);
            const f32x4 m0 = *(const GAS f32x4*)(mu + RWC_V + col), m1 = *(const GAS f32x4*)(mu + RWC_V + col + 4);
            const unsigned cu[4] = {cw.x, cw.y, cw.z, cw.w}, pu[4] = {pw.x, pw.y, pw.z, pw.w}; const float mm[8] = {m0[0], m0[1], m0[2], m0[3], m1[0], m1[1], m1[2], m1[3]}; unsigned o[4];
#pragma unroll
            for (int j = 0; j < 4; ++j) { const float c0 = bflo(cu[j]), c1 = bfhi(cu[j]); o[j] = pk2(c0 + mm[2 * j] * (bflo(pu[j]) - c0), c1 + mm[2 * j + 1] * (bfhi(pu[j]) - c1)); }
            v4u w; w.x = o[0]; w.y = o[1]; w.z = o[2]; w.w = o[3];
            *(LAS v4u*)(lds + R1_VS + (tt * 392 + col) * 2) = w; }
        __syncthreads();
        r1_prod<2, 0>(W1, (const LAS bf16*)(lds + R1_TH), 72, a->in[I_RW0] + l * DBR, (bf16*)(ws + WS_RE), row0, lane, wave);
        r1_prod<2, 1>(W1 + 24576, (const LAS bf16*)(lds + R1_AD), 72, a->in[I_RA0] + l * DBR, (bf16*)(ws + WS_RA), row0, lane, wave);
        r1_prod<4, 2>(W1 + 49152, (const LAS bf16*)(lds + R1_SG), 136, nullptr, (bf16*)(ws + WS_RG), row0, lane, wave);
        if (l > 0) {
            { const int kq = lane >> 4, mt = wave & 1, ti = wave >> 1; f32x4 acc = {0.f, 0.f, 0.f, 0.f};
#pragma unroll
              for (int s = 0; s < 12; ++s) acc = __builtin_amdgcn_mfma_f32_16x16x32_bf16(__builtin_bit_cast(bf16x8, *(const GAS v4u*)(WV + (size_t)(16 * mt + (lane & 15)) * 384 + 32 * s + 8 * kq)),
                                                                                          *(const LAS bf16x8*)(lds + R1_VS + ((16 * ti + (lane & 15)) * 392 + 32 * s + 8 * kq) * 2), acc, 0, 0, 0);
              v2u w; w.x = pk2(acc[0], acc[1]); w.y = pk2(acc[2], acc[3]); *(LAS v2u*)(lds + R1_TMP + ((16 * ti + (lane & 15)) * 40 + 16 * mt + 4 * kq) * 2) = w; }
            __syncthreads();
            r1_prod<1, 1>(WV + 12288, (const LAS bf16*)(lds + R1_TMP), 40, a->in[I_RV0], (bf16*)(ws + WS_RVG), row0, lane, wave);
        }
    }
}
__device__ __forceinline__ float dpp_allsum(float x) {
    x += __builtin_bit_cast(float, __builtin_amdgcn_update_dpp(0, __builtin_bit_cast(int, x), 0x128, 0xf, 0xf, false));
    x += __builtin_bit_cast(float, __builtin_amdgcn_update_dpp(0, __builtin_bit_cast(int, x), 0x124, 0xf, 0xf, false));
    x += __builtin_bit_cast(float, __builtin_amdgcn_update_dpp(0, __builtin_bit_cast(int, x), 0x122, 0xf, 0xf, false));
    x += __builtin_bit_cast(float, __builtin_amdgcn_update_dpp(0, __builtin_bit_cast(int, x), 0x121, 0xf, 0xf, false));
    { const unsigned xi = __builtin_bit_cast(unsigned, x); auto r = __builtin_amdgcn_permlane16_swap(xi, xi, false, false); const unsigned r0 = r[0], r1 = r[1]; x = __uint_as_float(r0) + __uint_as_float(r1); }
    { const unsigned xi = __builtin_bit_cast(unsigned, x); auto r = __builtin_amdgcn_permlane32_swap(xi, xi, false, false); const unsigned r0 = r[0], r1 = r[1]; x = __uint_as_float(r0) + __uint_as_float(r1); }
    return x;
}

constexpr int RC_EF = 0, RC_ATF = 4096, RC_QF = 8448, RC_PFT = 9472, RC_AT = 10496, RC_RT = 12800, RC_BH = 15104, RC_KH = 17408, RC_AH = 19712, RC_BTT = 22016, RC_KTT = 25088, RC_VS = 28160,
              RC_PRL = 31232, RC_QRL = 32000, RC_TQL = 32768, RC_G15 = 33536, RC_CH = 33792;
struct RCRegs { v2u r0, r1, k0, k1, aa, ee, v0, v1, vg, vf, gg; };
__device__ __forceinline__ void rc_issue(const unsigned char* ws, int l, size_t row, int h, int tid, RCRegs& R) {
    const bf16* PROJ = (const bf16*)(ws + WS_PROJ); const int tt = tid >> 4, c0 = h * 64 + 4 * (tid & 15); const size_t r = row + tt; const bool first = (r % SEQ) == 0; const size_t rp = first ? r : r - 1;
    R.r0 = *(const GAS v2u*)(PROJ + r * NPROJ + PC_RW + RWC_R + c0); R.r1 = *(const GAS v2u*)(PROJ + rp * NPROJ + PC_RW + RWC_R + c0);
    R.k0 = *(const GAS v2u*)(PROJ + r * NPROJ + PC_RW + RWC_K + c0); R.k1 = *(const GAS v2u*)(PROJ + rp * NPROJ + PC_RW + RWC_K + c0);
    R.v0 = *(const GAS v2u*)(PROJ + r * NPROJ + PC_RW + RWC_V + c0); R.v1 = *(const GAS v2u*)(PROJ + rp * NPROJ + PC_RW + RWC_V + c0);
    R.aa = *(const GAS v2u*)((const bf16*)(ws + WS_RA) + r * DBR + c0); R.ee = *(const GAS v2u*)((const bf16*)(ws + WS_RE) + r * DBR + c0);
    R.gg = *(const GAS v2u*)((const bf16*)(ws + WS_RG) + r * DBR + c0);
    if (l > 0) { R.vg = *(const GAS v2u*)((const bf16*)(ws + WS_RVG) + r * DBR + c0); R.vf = *(const GAS v2u*)((const bf16*)(ws + WS_VF) + r * DBR + c0); }
    if (first) { R.r1 = (v2u){0u, 0u}; R.k1 = (v2u){0u, 0u}; R.v1 = (v2u){0u, 0u}; }
}
__device__ __forceinline__ void unpack4(const v2u p, float (&o)[4]) { o[0] = bflo(p.x); o[1] = bfhi(p.x); o[2] = bflo(p.y); o[3] = bfhi(p.y); }
__device__ __forceinline__ v2u pack4(const float (&v)[4]) { v2u o; o.x = pk2(v[0], v[1]); o.y = pk2(v[2], v[3]); return o; }
__device__ __forceinline__ v2u pack4v(const f32x4 v) { v2u o; o.x = pk2(v[0], v[1]); o.y = pk2(v[2], v[3]); return o; }
__device__ __forceinline__ bf16x8 cat8(const v2u a, const v2u b) { v4u o; o.x = a.x; o.y = a.y; o.z = b.x; o.w = b.y; return __builtin_bit_cast(bf16x8, o); }
#define RC_BAR() asm volatile("s_waitcnt lgkmcnt(0)\n\ts_barrier" ::: "memory")

constexpr int REC_BYTES = 12288, REC_UNITS = 752;
__device__ __forceinline__ unsigned char* rc_rec(unsigned char* ws, size_t cu) { return cu < 8192 ? ws + WS_OPA + cu * REC_BYTES : ws + WS_OPB + (cu - 8192) * REC_BYTES; }
__device__ __forceinline__ v4u rc_gather_unit(const LAS unsigned char* wb, int u) {
    v2u lo, hi;
    if (u < 256) { const int base = u < 128 ? RC_AH : RC_RT, uu = u & 127, row = uu >> 3, s = (uu >> 2) & 1, lq = uu & 3; const LAS unsigned char* p = wb + base + (row * 72 + 32 * s + 4 * lq) * 2;
        lo = *(const LAS v2u*)p; hi = *(const LAS v2u*)(p + 32); }
    else if (u < 512) { const int k = (u - 256) >> 2, lq = (u - 256) & 3; lo = *(const LAS v2u*)(wb + RC_BTT + (k * 24 + 4 * lq) * 2); hi = *(const LAS v2u*)(wb + RC_KTT + (k * 24 + 4 * lq) * 2); }
    else if (u < 576) { const int t = (u - 512) >> 2, lq = (u - 512) & 3; lo = *(const LAS v2u*)(wb + RC_PRL + (t * 24 + 4 * lq) * 2); hi = *(const LAS v2u*)(wb + RC_QRL + (t * 24 + 4 * lq) * 2); }
    else if (u < 608) { const LAS unsigned char* p = wb + RC_TQL + (((u - 576) >> 1) * 24 + 8 * ((u - 576) & 1)) * 2; lo = *(const LAS v2u*)p; hi = *(const LAS v2u*)(p + 8); }
    else if (u < 736) { const LAS unsigned char* p = wb + RC_VS + (((u - 608) >> 1) * 24 + 8 * ((u - 608) & 1)) * 2; lo = *(const LAS v2u*)p; hi = *(const LAS v2u*)(p + 8); }
    else { const LAS unsigned char* p = wb + RC_G15 + (u - 736) * 16; lo = *(const LAS v2u*)p; hi = *(const LAS v2u*)(p + 8); }
    v4u o; o.x = lo.x; o.y = lo.y; o.z = hi.x; o.w = hi.y; return o;
}
__device__ __forceinline__ void rc_copy_out(unsigned char* rec, const LAS unsigned char* wb, int u) {
#pragma unroll
    for (int q = 0; q < 3; ++q) { const int uu = u + 256 * q; if (uu < REC_UNITS) *(GAS v4u*)(rec + uu * 16) = rc_gather_unit(wb, uu); }
}
constexpr int RS_AH = 0, RS_RT = 2304, RS_BK = 4608, RS_PQ = 9728, RS_TQL = 11008, RS_VS = 11776, RS_G15 = 14848, RS_CH = 15360;
__device__ __forceinline__ int rs_unit_off(int u) {
    if (u < 128) return RS_AH + (u >> 3) * 144 + (u & 7) * 16;
    if (u < 256) return RS_RT + ((u - 128) >> 3) * 144 + (u & 7) * 16;
    if (u < 512) return RS_BK + ((u - 256) >> 2) * 80 + (u & 3) * 16;
    if (u < 576) return RS_PQ + ((u - 512) >> 2) * 80 + (u & 3) * 16;
    if (u < 608) return RS_TQL + ((u - 576) >> 1) * 48 + (u & 1) * 16;
    if (u < 736) return RS_VS + ((u - 608) >> 1) * 48 + (u & 1) * 16;
    return RS_G15 + (u - 736) * 16;
}
#define RC_BUILD(RUSE, q) do { const int bh_ = (q) % (NB * NH), b = bh_ / NH, h = bh_ % NH, blk_ = blk0 + (q) / (NB * NH), c0 = h * 64 + 4 * kq; const size_t row0 = (size_t)b * SEQ + (size_t)blk_ * 32; \
        float kkw[4], kaw[4], mur[4], muk[4], muv[4], rrkw[4], lnww[4], lnbw[4];     \
_Pragma("unroll") \
        for (int j = 0; j < 4; ++j) { kkw[j] = cst[c0 + j]; kaw[j] = cst[384 + c0 + j]; rrkw[j] = cst[768 + c0 + j]; lnww[j] = cst[1152 + c0 + j]; lnbw[j] = cst[1536 + c0 + j]; mur[j] = cst[1920 + c0 + j]; muk[j] = cst[2304 + c0 + j]; muv[j] = cst[2688 + c0 + j]; } \
        float an[4], bk[4], km[4], rs[4], ev[4]; \
        {   const RCRegs& R = RUSE; \
            float rc[4], rp[4], kc[4], kp[4], av[4], vc[4], vp[4], ks[4], kk[4], vs[4]; unpack4(R.r0, rc); unpack4(R.r1, rp); unpack4(R.k0, kc); unpack4(R.k1, kp); unpack4(R.aa, av); unpack4(R.ee, ev); unpack4(R.v0, vc); unpack4(R.v1, vp); \
            float ss = 0.f; \
_Pragma("unroll") \
            for (int j = 0; j < 4; ++j) { rs[j] = rc[j] + mur[j] * (rp[j] - rc[j]); ks[j] = kc[j] + muk[j] * (kp[j] - kc[j]); kk[j] = ks[j] * kkw[j]; ss += kk[j] * kk[j]; vs[j] = vc[j] + muv[j] * (vp[j] - vc[j]); } \
            ss += __shfl_xor(ss, 1); ss += __shfl_xor(ss, 2); ss += __shfl_xor(ss, 4); ss += __shfl_xor(ss, 8); \
            const float inv = 1.f / fmaxf(sqrtf(ss), 1e-12f); \
_Pragma("unroll") \
            for (int j = 0; j < 4; ++j) { const float kn = kk[j] * inv; an[j] = -kn; bk[j] = kn * av[j]; km[j] = ks[j] * (1.f + (av[j] - 1.f) * kaw[j]); } \
            if (l == 0) *(GAS v2u*)((bf16*)(ws + WS_VF) + (row0 + tt) * DBR + c0) = pack4(vs); \
            else { float g[4], f[4]; unpack4(R.vg, g); unpack4(R.vf, f); \
_Pragma("unroll") \
                for (int j = 0; j < 4; ++j) vs[j] = vs[j] + (f[j] - vs[j]) * g[j]; } \
            {     \
                float gq[4], o1[4], o2[4]; unpack4(R.gg, gq); float rkp = 0.f; \
_Pragma("unroll") \
                for (int j = 0; j < 4; ++j) rkp += rs[j] * km[j] * rrkw[j]; \
                rkp += __shfl_xor(rkp, 1); rkp += __shfl_xor(rkp, 2); rkp += __shfl_xor(rkp, 4); rkp += __shfl_xor(rkp, 8); \
_Pragma("unroll") \
                for (int j = 0; j < 4; ++j) { o1[j] = lnww[j] * gq[j]; o2[j] = (lnbw[j] + rkp * vs[j]) * gq[j]; } \
                if (ST12) { *(GAS v2u*)((bf16*)(ws + WS_RG) + (row0 + tt) * DBR + c0) = pack4(o1); *(GAS v2u*)((bf16*)(ws + WS_RA) + (row0 + tt) * DBR + c0) = pack4(o2); } } \
            *(LAS f32x4*)(cb + RC_EF + (t * 64 + 4 * kq) * 4) = (f32x4){ev[0], ev[1], ev[2], ev[3]}; \
_Pragma("unroll") \
            for (int j = 0; j < 4; ++j) *(LAS bf16*)(cb + RC_VS + ((4 * kq + j) * 24 + t) * 2) = (bf16)f2bf(vs[j]); \
        } \
        if ((q) + 2 * G < NQ) rc_issue_q(ws, l, (q) + 2 * G, blk0, tid, RUSE); \
        RC_BAR(); \
        {   f32x4 inc = {0.f, 0.f, 0.f, 0.f}, tot = inc; \
_Pragma("unroll") \
            for (int i = 0; i < 16; ++i) { const f32x4 ei = *(const LAS f32x4*)(cb + RC_EF + (i * 64 + 4 * kq) * 4); tot = tot + ei; if (i <= t) inc = inc + ei; } \
            float At[4], Rt[4], Bh[4], Kh[4], Bt[4], Kt[4], Gt[4]; \
_Pragma("unroll") \
            for (int j = 0; j < 4; ++j) { const float Gi = __expf(-inc[j]), Ge = __expf(ev[j] - inc[j]), Gn = __expf(inc[j]); Gt[j] = __expf(-tot[j]); \
                At[j] = an[j] * Ge; Rt[j] = rs[j] * Gi; Bh[j] = bk[j] * Gn; Kh[j] = km[j] * Gn; Bt[j] = Bh[j] * Gt[j]; Kt[j] = Kh[j] * Gt[j]; } \
            *(LAS f32x4*)(cb + RC_ATF + (t * 68 + 4 * kq) * 4) = (f32x4){At[0], At[1], At[2], At[3]}; \
            *(LAS v2u*)(cb + RC_AT + (t * 72 + 4 * kq) * 2) = pack4(At); *(LAS v2u*)(cb + RC_RT + (t * 72 + 4 * kq) * 2) = pack4(Rt); \
            *(LAS v2u*)(cb + RC_BH + (t * 72 + 4 * kq) * 2) = pack4(Bh); *(LAS v2u*)(cb + RC_KH + (t * 72 + 4 * kq) * 2) = pack4(Kh); \
_Pragma("unroll") \
            for (int j = 0; j < 4; ++j) { *(LAS bf16*)(cb + RC_BTT + ((4 * kq + j) * 24 + t) * 2) = (bf16)f2bf(Bt[j]); *(LAS bf16*)(cb + RC_KTT + ((4 * kq + j) * 24 + t) * 2) = (bf16)f2bf(Kt[j]); } \
            if (t == 0) *(LAS f32x4*)(cb + RC_G15 + 4 * kq * 4) = (f32x4){Gt[0], Gt[1], Gt[2], Gt[3]}; \
        } \
        RC_BAR(); \
        {   LAS unsigned char* wb = lds + (wave >> 2) * RC_CH; const int pi = wave & 3; \
            const LAS bf16* Ap = (const LAS bf16*)(wb + (pi < 2 ? RC_AT : RC_RT)) + li * 72 + 8 * lq; const LAS bf16* Bp = (const LAS bf16*)(wb + ((pi & 1) ? RC_KH : RC_BH)) + li * 72 + 8 * lq; \
            f32x4 acc = {0.f, 0.f, 0.f, 0.f}; \
            acc = __builtin_amdgcn_mfma_f32_16x16x32_bf16(*(const LAS bf16x8*)Ap, *(const LAS bf16x8*)Bp, acc, 0, 0, 0); \
            acc = __builtin_amdgcn_mfma_f32_16x16x32_bf16(*(const LAS bf16x8*)(Ap + 32), *(const LAS bf16x8*)(Bp + 32), acc, 0, 0, 0); \
_Pragma("unroll") \
            for (int r = 0; r < 4; ++r) { const int tr = 4 * lq + r; if (pi < 2 ? !(li < tr) : !(li <= tr)) acc[r] = 0.f; } \
            if (pi == 0) *(LAS f32x4*)(wb + RC_PFT + (li * 16 + 4 * lq) * 4) = acc; \
            else if (pi == 1) { \
_Pragma("unroll") \
                for (int r = 0; r < 4; ++r) *(LAS float*)(wb + RC_QF + ((4 * lq + r) * 16 + li) * 4) = acc[r]; } \
            else { LAS bf16* o = (LAS bf16*)(wb + (pi == 2 ? RC_PRL : RC_QRL)); \
_Pragma("unroll") \
                for (int r = 0; r < 4; ++r) o[(4 * lq + r) * 24 + li] = (bf16)f2bf(acc[r]); } \
        } \
        RC_BAR(); \
        if (wave < 4) { \
            LAS unsigned char* wb = lds + (wave >> 1) * RC_CH; const bool isq = wave & 1; \
            float X[16]; \
_Pragma("unroll") \
            for (int r = 0; r < 16; ++r) X[r] = isq ? *(const LAS float*)(wb + RC_QF + (r * 16 + li) * 4) : *(const LAS float*)(wb + RC_ATF + (r * 68 + lane) * 4); \
_Pragma("unroll") \
            for (int j = 0; j < 15; ++j) { const LAS f32x4* pc = (const LAS f32x4*)(wb + RC_PFT + j * 64); const f32x4 c0v = pc[0], c1v = pc[1], c2v = pc[2], c3v = pc[3]; \
                const float c[16] = {c0v[0], c0v[1], c0v[2], c0v[3], c1v[0], c1v[1], c1v[2], c1v[3], c2v[0], c2v[1], c2v[2], c2v[3], c3v[0], c3v[1], c3v[2], c3v[3]}; \
_Pragma("unroll") \
                for (int r = j + 1; r < 16; ++r) X[r] = fmaf(c[r], X[j], X[r]); } \
            if (!isq) { LAS bf16* o = (LAS bf16*)(wb + RC_AH); \
_Pragma("unroll") \
                for (int r = 0; r < 16; ++r) o[r * 72 + lane] = (bf16)f2bf(X[r]); } \
            else if (lane < 16) { LAS bf16* o = (LAS bf16*)(wb + RC_TQL); \
_Pragma("unroll") \
                for (int r = 0; r < 16; ++r) o[r * 24 + lane] = (bf16)f2bf(X[r]); } \
        } \
        RC_BAR(); \
        { const int cc = tid >> 8, u = tid & 255; unsigned char* rec = rc_rec(ws, (size_t)bh_ * 512 + 2 * blk_ + cc); const LAS unsigned char* wb = lds + cc * RC_CH; \
          rc_copy_out(rec, wb, u); } \
        RC_BAR(); \
    } while (0)
#ifndef RS_NT
#define RS_NT 1
#endif
constexpr int RS_TILES = RS_NT;
struct RSOps { bf16x8 a01, a23, r01, r23, tq, pq, bk[4]; v2u vb[RS_TILES]; f32x4 g[4]; };
__device__ __forceinline__ void rs_load(const LAS unsigned char* wb, int wave, int li, int lq, RSOps& O) {
    O.a01 = *(const LAS bf16x8*)(wb + RS_AH + li * 144 + lq * 16); O.a23 = *(const LAS bf16x8*)(wb + RS_AH + li * 144 + 64 + lq * 16);
    O.r01 = *(const LAS bf16x8*)(wb + RS_RT + li * 144 + lq * 16); O.r23 = *(const LAS bf16x8*)(wb + RS_RT + li * 144 + 64 + lq * 16);
    O.pq = *(const LAS bf16x8*)(wb + RS_PQ + li * 80 + lq * 16);
    { const v2u t = *(const LAS v2u*)(wb + RS_TQL + li * 48 + lq * 8); v4u o; o.x = t.x; o.y = t.y; o.z = 0u; o.w = 0u; O.tq = __builtin_bit_cast(bf16x8, o); }
#pragma unroll
    for (int vt = 0; vt < RS_TILES; ++vt) O.vb[vt] = *(const LAS v2u*)(wb + RS_VS + (16 * (RS_TILES * wave + vt) + li) * 48 + lq * 8);
#pragma unroll
    for (int kt = 0; kt < 4; ++kt) { O.bk[kt] = *(const LAS bf16x8*)(wb + RS_BK + (16 * kt + li) * 80 + lq * 16); O.g[kt] = *(const LAS f32x4*)(wb + RS_G15 + (16 * kt + 4 * lq) * 4); }
}
#define RC_CHUNK(O, cc, yb) do { const v2u z2_ = {0u, 0u}; \
_Pragma("unroll") \
        for (int vt = 0; vt < RS_TILES; ++vt) {     \
            f32x4 aD = {0.f, 0.f, 0.f, 0.f}, aY = {0.f, 0.f, 0.f, 0.f}; \
            aD = __builtin_amdgcn_mfma_f32_16x16x32_bf16(O.tq, cat8(O.vb[vt], z2_), aD, 0, 0, 0); \
            aD = __builtin_amdgcn_mfma_f32_16x16x32_bf16(O.a01, Sb01[vt], aD, 0, 0, 0); \
            aD = __builtin_amdgcn_mfma_f32_16x16x32_bf16(O.a23, Sb23[vt], aD, 0, 0, 0); \
            aY = __builtin_amdgcn_mfma_f32_16x16x32_bf16(Sb01[vt], O.r01, aY, 0, 0, 0); \
            aY = __builtin_amdgcn_mfma_f32_16x16x32_bf16(Sb23[vt], O.r23, aY, 0, 0, 0); \
            const bf16x8 DV = cat8(pack4v(aD), O.vb[vt]); \
_Pragma("unroll") \
            for (int kt = 0; kt < 4; ++kt) Sacc[vt][kt] = __builtin_amdgcn_mfma_f32_16x16x32_bf16(O.bk[kt], DV, Sacc[vt][kt] * O.g[kt], 0, 0, 0); \
            aY = __builtin_amdgcn_mfma_f32_16x16x32_bf16(DV, O.pq, aY, 0, 0, 0); \
            Sb01[vt] = cat8(pack4v(Sacc[vt][0]), pack4v(Sacc[vt][1])); Sb23[vt] = cat8(pack4v(Sacc[vt][2]), pack4v(Sacc[vt][3])); \
            *(LAS v2u*)((yb) + (((cc) * 16 + li) * 72 + 16 * (RS_TILES * wave + vt) + 4 * lq) * 2) = pack4v(aY);     \
        } \
    } while (0)
#define RC_SCAN(slot, yb) do { { RSOps O0; rs_load(slot, wave, li, lq, O0); __builtin_amdgcn_sched_barrier(0); RC_CHUNK(O0, 0, yb); } \
        { RSOps O1; rs_load(slot + RS_CH, wave, li, lq, O1); __builtin_amdgcn_sched_barrier(0); RC_CHUNK(O1, 1, yb); } } while (0)

__device__ __forceinline__ void rc_issue_q(const unsigned char* ws, int l, int q, int blk0, int tid, RCRegs& R) {
    const int bh = q % (NB * NH), blk = blk0 + q / (NB * NH);
    rc_issue(ws, l, (size_t)(bh / NH) * SEQ + (size_t)blk * 32, bh % NH, tid, R);
}
template <bool ST12 = true>
__device__ __forceinline__ void phase_r2_build(KArgsP a, LAS unsigned char* lds, int tid, int lane, int wave, int vcu, int G, int l, int blk0 = 0, int nblk = SEQ / 32) {
    unsigned char* ws = a->ws;
    const int tt = tid >> 4, kq = tid & 15, ch = tt >> 4, t = tt & 15;
    const int lq = lane >> 4, li = lane & 15;
    LAS unsigned char* cb = lds + ch * RC_CH;
    const float* mu = a->in[I_RMU] + (size_t)l * RW_COLS;
    const float* pRKK = a->in[I_RKK] + (size_t)l * DBR; const float* pRKA = a->in[I_RKA] + (size_t)l * DBR; const float* pRRK = a->in[I_RRK] + (size_t)l * DBR;
    const float* pLNW = a->in[I_RLNW] + (size_t)l * DBR; const float* pLNB = a->in[I_RLNB] + (size_t)l * DBR;
    const int NQ = NB * NH * nblk;
    LAS float* cst = (LAS float*)(lds + 2 * RC_CH);
    __syncthreads();
    for (int i = tid; i < 8 * DBR; i += NTHR) { const int arr = i / DBR, c = i % DBR;
        cst[i] = arr == 0 ? pRKK[c] : arr == 1 ? pRKA[c] : arr == 2 ? pRRK[c] : arr == 3 ? pLNW[c] : arr == 4 ? pLNB[c] : mu[RWC_R + (arr - 5) * DBR + c]; }
    __syncthreads();
    RCRegs RA, RB;
    if (vcu < NQ) rc_issue_q(ws, l, vcu, blk0, tid, RA);
    if (vcu + G < NQ) rc_issue_q(ws, l, vcu + G, blk0, tid, RB);
    for (int q0 = vcu; q0 < NQ; q0 += 2 * G) { { const int q = q0; RC_BUILD(RA, q); } if (q0 + G < NQ) { const int q = q0 + G; RC_BUILD(RB, q); } }
}
#ifndef RS_DEPTH
#define RS_DEPTH 4
#endif
struct RSRegs { v4u p[6]; };
__device__ __forceinline__ unsigned char* ubase(const unsigned char* p) {
    const unsigned lo = __builtin_amdgcn_readfirstlane((unsigned)(uintptr_t)p), hi = __builtin_amdgcn_readfirstlane((unsigned)((uintptr_t)p >> 32));
    return (unsigned char*)(((uintptr_t)hi << 32) | lo);
}
struct RSOff { unsigned g[6], s[6]; };
__device__ __forceinline__ void rs_offsets(int lt, RSOff& F) {
#pragma unroll
    for (int j = 0; j < 6; ++j) { const int uu = min(lt + 256 * j, 2 * REC_UNITS - 1); const int cc = uu >= REC_UNITS, u = uu - cc * REC_UNITS;
        F.g[j] = uu * 16 + cc * (REC_BYTES - REC_UNITS * 16); F.s[j] = cc * RS_CH + rs_unit_off(u); }
}
__device__ __forceinline__ void rs_issue(unsigned char* ws, size_t cu0, const RSOff& F, RSRegs& R) {
    const unsigned char* base = ubase(rc_rec(ws, cu0));
#pragma unroll
    for (int j = 0; j < 6; ++j) R.p[j] = *(const GAS v4u*)(base + F.g[j]);
}
__device__ __forceinline__ void rs_store(LAS unsigned char* slot, const RSOff& F, const RSRegs& R) {
#pragma unroll
    for (int j = 0; j < 6; ++j) *(LAS v4u*)(slot + F.s[j]) = R.p[j];
}
struct R3Q { v4u a1, a2; };
__device__ __forceinline__ void r3q_issue(const unsigned char* ws, size_t row0, int h, int lt, R3Q& Q) {
    const unsigned off = (unsigned)(((lt >> 3) * DBR + 8 * (lt & 7)) * 2); const size_t ub = (row0 * DBR + h * 64) * 2;
    Q.a1 = *(const GAS v4u*)(ubase(ws + WS_RG + ub) + off); Q.a2 = *(const GAS v4u*)(ubase(ws + WS_RA + ub) + off);
}
__device__ __forceinline__ float dpp8sum(float x) {
    x += __builtin_bit_cast(float, __builtin_amdgcn_update_dpp(0, __builtin_bit_cast(int, x), 0xB1, 0xf, 0xf, false));
    x += __builtin_bit_cast(float, __builtin_amdgcn_update_dpp(0, __builtin_bit_cast(int, x), 0x4E, 0xf, 0xf, false));
    x += __builtin_bit_cast(float, __builtin_amdgcn_update_dpp(0, __builtin_bit_cast(int, x), 0x141, 0xf, 0xf, false));
    return x;
}
__device__ __forceinline__ void r3_block(const LAS unsigned char* yb, bf16* YC, size_t row0, int h, int lt, const R3Q& Q) {
    const int tk = lt >> 3, c8 = 8 * (lt & 7);
    const v4u yy = *(const LAS v4u*)(yb + (tk * 72 + c8) * 2);
    float d[8] = {bflo(yy.x), bfhi(yy.x), bflo(yy.y), bfhi(yy.y), bflo(yy.z), bfhi(yy.z), bflo(yy.w), bfhi(yy.w)};
    const float m = dpp8sum(((d[0] + d[1]) + (d[2] + d[3])) + ((d[4] + d[5]) + (d[6] + d[7]))) * (1.f / 64.f);
    float q = 0.f;
#pragma unroll
    for (int j = 0; j < 8; ++j) { d[j] -= m; q = fmaf(d[j], d[j], q); }
    const float rstd = rsqrtf(dpp8sum(q) * (1.f / 64.f) + RWKV_GN_EPS);
    const unsigned a1[4] = {Q.a1.x, Q.a1.y, Q.a1.z, Q.a1.w}, a2[4] = {Q.a2.x, Q.a2.y, Q.a2.z, Q.a2.w}; unsigned o[4];
#pragma unroll
    for (int j = 0; j < 4; ++j) o[j] = pk2(fmaf(d[2 * j] * rstd, bflo(a1[j]), bflo(a2[j])), fmaf(d[2 * j + 1] * rstd, bfhi(a1[j]), bfhi(a2[j])));
    v4u w; w.x = o[0]; w.y = o[1]; w.z = o[2]; w.w = o[3];
    *(GAS v4u*)(ubase((const unsigned char*)(YC + row0 * DM + 384 + h * 64)) + (unsigned)((tk * DM + c8) * 2)) = w;
}
template <int VAR = 0>
__device__ __forceinline__ void phase_r2_scan(KArgsP a, LAS unsigned char* lds, int tid, int lane, int wave, int wg, int l, int bsplit = SEQ / 32, unsigned nbuilders = 0u) {
    unsigned char* ws = a->ws; bf16* YC = (bf16*)(ws + WS_YC);
    const int b = wg / NH, h = wg % NH; const size_t rowb = (size_t)b * SEQ, cub = (size_t)wg * 512;
    const int lq = lane >> 4, li = lane & 15, lt = tid - 256; const bool loader = wave >= 4;
    f32x4 Sacc[RS_TILES][4]; bf16x8 Sb01[RS_TILES], Sb23[RS_TILES];
#pragma unroll
    for (int vt = 0; vt < RS_TILES; ++vt) {
#pragma unroll
        for (int kt = 0; kt < 4; ++kt) Sacc[vt][kt] = (f32x4){0.f, 0.f, 0.f, 0.f};
        Sb01[vt] = (bf16x8){0, 0, 0, 0, 0, 0, 0, 0}; Sb23[vt] = Sb01[vt]; }
    constexpr int NBLK = SEQ / 32;
    LAS unsigned char* yb0 = lds + 8 * RS_CH; LAS unsigned char* yb1 = yb0 + 32 * 72 * 2;
    static_assert(8 * RS_CH + 2 * 32 * 72 * 2 <= MISC_OFF, "scan LDS layout");
    if (wave < 4 / RS_TILES) {
        RSOps OA, OB;
        RC_BAR();
        rs_load(lds, wave, li, lq, OA);
#pragma unroll 1
        for (int X = 0; X < NBLK; ++X) {
            LAS unsigned char* sl = lds + (X & 3) * 2 * RS_CH; LAS unsigned char* sn = lds + ((X + 1) & 3) * 2 * RS_CH; LAS unsigned char* yb = yb0 + (X & 1) * (32 * 72 * 2);
            if (X == bsplit - 7 && wave == 0) {
                if (lane == 0) { unsigned* bar_ = (unsigned*)(ws + WS_CTL) + CW_BAR; unsigned* cnt_ = (unsigned*)(ws + WS_CTL) + CW_Q + 64 * l + 48; XB_SPIN(xb_ld(cnt_) < nbuilders, bar_); }
                __builtin_amdgcn_fence(__ATOMIC_ACQUIRE, "agent"); asm volatile("s_waitcnt vmcnt(0)" ::: "memory");
            }
            rs_load(sl + RS_CH, wave, li, lq, OB); __builtin_amdgcn_sched_barrier(0); if (VAR != 2) { RC_CHUNK(OA, 0, yb); } else { asm volatile("" :: "v"(OA.a01), "v"(OA.bk[3]), "v"(OA.g[3])); }
            rs_load(sn, wave, li, lq, OA); __builtin_amdgcn_sched_barrier(0); if (VAR != 2) { RC_CHUNK(OB, 1, yb); } else { asm volatile("" :: "v"(OB.a01), "v"(OB.bk[3]), "v"(OB.g[3])); }
            RC_BAR();
        }
    } else if (!loader) {
        RC_BAR();
        for (int X = 0; X < NBLK; ++X) RC_BAR();
    } else {
        constexpr int ND = 4;
        RSRegs R[ND]; R3Q Q[ND]; RSOff F; rs_offsets(lt, F);
#pragma unroll
        for (int j = 0; j < ND; ++j) { rs_issue(ws, cub + 2 * j, F, R[j]); r3q_issue(ws, rowb + 32 * j, h, lt, Q[j]); }
        rs_store(lds, F, R[0]); rs_issue(ws, cub + 2 * ND, F, R[0]); rs_store(lds + 2 * RS_CH, F, R[1]); rs_issue(ws, cub + 2 * (ND + 1), F, R[1]);
        RC_BAR();
        for (int bb = 0; bb < NBLK; bb += ND) {
#pragma unroll
            for (int j = 0; j < ND; ++j) { const int X = bb + j;
                if (VAR != 1) { r3_block((j & 1) ? yb0 : yb1, YC, rowb + (size_t)max(X - 1, 0) * 32, h, lt, Q[(j + ND - 1) % ND]);
                r3q_issue(ws, rowb + (size_t)min(X - 1 + ND, NBLK - 1) * 32, h, lt, Q[(j + ND - 1) % ND]); }
                rs_store(lds + ((j + 2) & 3) * 2 * RS_CH, F, R[(j + 2) % ND]);
                rs_issue(ws, cub + 2 * (size_t)min(X + 2 + ND, NBLK - 1), F, R[(j + 2) % ND]);
                RC_BAR();
            }
        }
        r3_block(yb1, YC, rowb + (size_t)(NBLK - 1) * 32, h, lt, Q[(NBLK - 1) % ND]);
    }
}
__device__ __forceinline__ void phase_r3(KArgsP a, int lane, int gw, int ngw, int l) {
    unsigned char* ws = a->ws; const bf16* PROJ = (const bf16*)(ws + WS_PROJ); bf16* YC = (bf16*)(ws + WS_YC);
    const bf16* RA = (const bf16*)(ws + WS_RA); const bf16* RG = (const bf16*)(ws + WS_RG); const bf16* RVG = (const bf16*)(ws + WS_RVG); const bf16* VF = (const bf16*)(ws + WS_VF);
    const float* mu = a->in[I_RMU] + (size_t)l * RW_COLS;
    for (size_t row = gw; row < NTOK; row += ngw) {
#pragma unroll
        for (int h = 0; h < NH; ++h) {
            const int c = h * 64 + lane;
            const float y = bf2f(YC[row * DM + 384 + c]);
            const float m = dpp_allsum(y) * (1.f / 64.f); const float d = y - m; const float var = dpp_allsum(d * d) * (1.f / 64.f);
            const float yn = d * rsqrtf(var + RWKV_GN_EPS) * a->in[I_RLNW][l * DBR + c] + a->in[I_RLNB][l * DBR + c];
            const float rs = rw_shift(PROJ, mu, row, RWC_R + c), ks = rw_shift(PROJ, mu, row, RWC_K + c); float v = rw_shift(PROJ, mu, row, RWC_V + c);
            if (l > 0) v = v + (bf2f(VF[row * DBR + c]) - v) * bf2f(RVG[row * DBR + c]);
            const float av = bf2f(RA[row * DBR + c]);
            const float km = ks * (1.f + (av - 1.f) * a->in[I_RKA][l * DBR + c]);
            const float rk = dpp_allsum(rs * km * a->in[I_RRK][l * DBR + c]);
            YC[row * DM + 384 + c] = (bf16)f2bf((yn + rk * v) * bf2f(RG[row * DBR + c]));
        }
    }
}

constexpr int PH_PER_LAYER = 10, PH_FINAL = 1 + 2 * PH_PER_LAYER, N_PHASES = PH_FINAL + 1;
constexpr int R2_WGS = 24;
__global__ void __launch_bounds__(NTHR, 2) fwd(Args args) {
    extern __shared__ __attribute__((aligned(16))) unsigned char lds_raw[];
    LAS unsigned char* lds = (LAS unsigned char*)lds_raw;
    volatile LAS unsigned* MISC = (volatile LAS unsigned*)(lds + MISC_OFF);
    const int tid0 = threadIdx.x;
    const int G = gridDim.x;
#define PHASE_IDS int tid_ = threadIdx.x; asm volatile("" : "+v"(tid_)); const int tid = tid_, lane = tid & 63, wave = __builtin_amdgcn_readfirstlane(tid >> 6); \
    int bx_ = blockIdx.x; asm volatile("" : "+s"(bx_)); const int bx = bx_; const int vcu = (G % 8 == 0) ? (bx % 8) * (G / 8) + bx / 8 : bx; (void)lane; (void)wave; (void)vcu; (void)bx;
    unsigned char* ws0 = fresh_args()->ws;
    for (int u = tid0; u < (LDS_BYTES - RING_BYTES) / 4; u += NTHR) ((LAS unsigned*)(lds + RING_BYTES))[u] = 0u;
    __syncthreads();
    XcdBarrier bar; bar.bar = (unsigned*)(ws0 + WS_CTL) + CW_BAR; bar.x = 0; bar.st = nullptr;
    if (!MK_PER_PHASE) bar = xcd_barrier_post((unsigned*)(ws0 + WS_CTL) + CW_BAR, MISC + 8);
#if MK_PER_PHASE
    const int lo = args.ph_lo, hi = args.ph_hi;
#define IN(k) (lo <= (k) && (k) < hi)
#else
#define IN(k) true
#endif
#define SEAM(k) do { if (IN(k) && IN((k) + 1)) { XcdBarrier b2 = bar; asm volatile("" : "+s"(b2.bar)); xcd_barrier(b2); } } while (0)

#ifndef GEMM_SP2
#define GEMM_SP2 true
#endif
#ifndef GEMM_ALIGN
#define GEMM_ALIGN true
#endif
#ifndef RS_DEPTH
#define RS_DEPTH 4
#endif
#ifndef R2_SPLIT
#define R2_SPLIT 160
#endif
#ifndef SCANVAR
#define SCANVAR 0
#endif
#ifndef DBL_SUB
#define DBL_SUB 0
#endif
#ifndef DBL_PHASE
#define DBL_PHASE (-1)
#endif
#ifndef REPN
#define REPN 2
#endif
#define SUBREP(k) _Pragma("nounroll") for (int q_ = 0; q_ < 1 + (REPN - 1) * (((k) == DBL_SUB) && l == 0); ++q_)
#define REP(k) for (int rep_ = 0; rep_ < ((k) == DBL_PHASE ? REPN : 1); ++rep_)
#define REPBAR if (rep_ > 0) { XcdBarrier b2 = bar; asm volatile("" : "+s"(b2.bar)); xcd_barrier(b2); }
    REP(0) if (IN(0)) { REPBAR KArgsP ap = fresh_args(); PHASE_IDS
_Pragma("nounroll")
 for (int q_ = 0; q_ < 1 + (REPN - 1) * (DBL_SUB == 12); ++q_) { phase_prologue(ap, lds, tid, lane, wave, vcu, G); __syncthreads(); } }
    SEAM(0);
#ifdef EXTRA_BAR
    for (int eb_ = 0; eb_ < EXTRA_BAR; ++eb_) { XcdBarrier b2 = bar; asm volatile("" : "+s"(b2.bar)); xcd_barrier(b2); }
#endif
#define LCONST 0
    {
        constexpr int l = LCONST; constexpr int pb = 1 + l * PH_PER_LAYER;
        REP(pb + 0) if (IN(pb + 0)) { REPBAR KArgsP ap = fresh_args(); PHASE_IDS unsigned char* ws = ap->ws; (void)ws;
            if (l == 0) { mod_finalize(ws, tid, G); SUBREP(6) { phase_rownorm<0, false>(ap, lds, tid, lane, wave, G, ap->in[I_X], ap->out, ap->in[I_NORM_MIX], true, 0, 0, 0); __syncthreads(); } }
            else {
#if EN_MOE
                phase_rownorm<0, true>(ap, lds, tid, lane, wave, G, ap->out, ap->out, ap->in[I_NORM_MIX] + l * DM, false, l, 0, l - 1);
#else
                phase_rownorm<0, false>(ap, lds, tid, lane, wave, G, ap->out, ap->out, ap->in[I_NORM_MIX] + l * DM, false, l, 0, l - 1);
#endif
            }
        }
        SEAM(pb + 0);
        REP(pb + 1) if (IN(pb + 1)) { REPBAR KArgsP ap = fresh_args(); PHASE_IDS unsigned char* ws = ap->ws; (void)ws;
            pg8::Gemm g{(const pg8::bf16_t*)(ws + WS_HN), (const pg8::bf16_t*)(ws + WS_WIN) + (size_t)l * NPROJ_PAD * DM, NTOK, NPROJ_PAD, DM};
            pg8::StaticOrder S; S.init(NTOK, NPROJ_PAD, G, bx);
            pg8::EpiProj E{(pg8::bf16_t*)(ws + WS_PROJ), (float*)(ws + WS_GATES)};
SUBREP(7) { pg8::gemm_phase<pg8::EpiProj, pg8::StaticOrder, GEMM_ALIGN, GEMM_SP2>(lds, g, S, E); __syncthreads(); }
        }
        SEAM(pb + 1);
        REP(pb + 2) if (IN(pb + 2)) { REPBAR KArgsP ap = fresh_args(); PHASE_IDS unsigned char* ws = ap->ws; (void)ws;
#if EN_MLSTM
            for (int q_ = 0; q_ < 1 + (REPN - 1) * ((DBL_SUB == 1) && l == 0); ++q_) { phase_m1(ap, lds, tid, lane, wave, vcu, G, l); __syncthreads(); }
            __syncthreads();
#endif
#if EN_S5
            phase_s1(ap, lds, tid, lane, wave, vcu, G, l); __syncthreads();
#if DBL_SUB == 2
            if (l == 0) { phase_s1(ap, lds, tid, lane, wave, vcu, G, l); __syncthreads(); phase_s1(ap, lds, tid, lane, wave, vcu, G, l); __syncthreads(); phase_s1(ap, lds, tid, lane, wave, vcu, G, l); __syncthreads(); phase_s1(ap, lds, tid, lane, wave, vcu, G, l); __syncthreads(); }
#endif
            __syncthreads();
#endif
#if EN_RWKV
            for (int q_ = 0; q_ < 1 + (REPN - 1) * ((DBL_SUB == 3) && l == 0); ++q_) { phase_r1(ap, lds, tid, lane, wave, vcu, G, l); __syncthreads(); }
#endif
        }
        SEAM(pb + 2);
        REP(pb + 3) if (IN(pb + 3)) { REPBAR KArgsP ap = fresh_args(); PHASE_IDS unsigned char* ws = ap->ws; (void)ws;
            phase_m2(ws, tid, vcu, G);
            phase_s2(ap, tid, vcu, G, l);
            __syncthreads();
            phase_r2_build(ap, lds, tid, lane, wave, vcu, G, l, 0, R2_SPLIT);
        }
        SEAM(pb + 3);
        REP(pb + 4) if (IN(pb + 4)) { REPBAR KArgsP ap = fresh_args(); PHASE_IDS unsigned char* ws = ap->ws; (void)ws;
            if (bx < R2_WGS) {
#if DBL_SUB == 4
                if (l == 0) { for (int q_ = 0; q_ < REPN - 1; ++q_) { phase_r2_scan<SCANVAR>(ap, lds, tid, lane, wave, bx, l, R2_SPLIT, (unsigned)(G - R2_WGS)); __syncthreads(); } }
#endif
                phase_r2_scan(ap, lds, tid, lane, wave, bx, l, R2_SPLIT, (unsigned)(G - R2_WGS)); __syncthreads(); }
            else {
                phase_r2_build(ap, lds, tid, lane, wave, bx - R2_WGS, G - R2_WGS, l, R2_SPLIT, SEQ / 32 - R2_SPLIT);
                asm volatile("s_waitcnt vmcnt(0)" ::: "memory"); __syncthreads();
                if (tid == 0) { __builtin_amdgcn_fence(__ATOMIC_RELEASE, "agent"); asm volatile("s_waitcnt vmcnt(0)" ::: "memory"); (void)xb_add((unsigned*)(ws + WS_CTL) + CW_Q + 64 * l + 48, 1u); }
                phase_s3(ap, lds, tid, lane, wave, 0, 1, l, (unsigned*)(ws + WS_CTL) + CW_Q + 64 * l + 32); __syncthreads();
            }
            {
                unsigned* qctr = (unsigned*)(ws + WS_CTL) + CW_Q + 64 * l; volatile LAS unsigned* qw = (volatile LAS unsigned*)(lds + MISC_OFF) + 16;
                unsigned nxt = 0u; if (tid == 0) nxt = __hip_atomic_fetch_add(qctr, 1u, __ATOMIC_RELAXED, __HIP_MEMORY_SCOPE_AGENT);
                for (;;) {
                    if (tid == 0) *qw = nxt;
                    __syncthreads();
                    const int u = (int)*qw;
                    __syncthreads();
                    if (u >= NUNIT_M) break;
                    if (tid == 0) nxt = __hip_atomic_fetch_add(qctr, 1u, __ATOMIC_RELAXED, __HIP_MEMORY_SCOPE_AGENT);
                    phase_m3(ap, lds, tid, lane, wave, u, NUNIT_M, l);
                }
            }
        }
        SEAM(pb + 4);
        REP(pb + 6) if (IN(pb + 6)) { REPBAR KArgsP ap = fresh_args(); PHASE_IDS unsigned char* ws = ap->ws; (void)ws;
            pg8::Gemm g{(const pg8::bf16_t*)(ws + WS_YC), (const pg8::bf16_t*)(ws + WS_WOUT) + (size_t)l * DM * DM, NTOK, DM, DM};
            pg8::StaticOrder S; S.init(NTOK, DM, G, bx);
            pg8::EpiResid E{l == 0 ? ap->in[I_X] : (const float*)ap->out, ap->out, (const float*)(ws + WS_MODF) + (size_t)l * 4 * 6144, 2048};
SUBREP(8) { pg8::gemm_phase<pg8::EpiResid, pg8::StaticOrder, GEMM_ALIGN, GEMM_SP2>(lds, g, S, E); __syncthreads(); }
        }
        SEAM(pb + 6);
#if EN_MOE
        REP(pb + 7) if (IN(pb + 7)) { REPBAR KArgsP ap = fresh_args(); PHASE_IDS phase_router(ap, lds, tid, lane, wave, G, l); __syncthreads();
            SUBREP(11) {
            moe_convert13(ap->in[I_MW1], ap->in[I_MW3], l, (bf16*)(ap->ws + WS_W13), vcu * NWAVES + wave, G * NWAVES, (LAS float*)(lds + wave * 16640), lane);
            moe_convert2(ap->in[I_MW2], l, (bf16*)(ap->ws + WS_W2), vcu * NWAVES + wave, G * NWAVES, (LAS float*)(lds + wave * 16640), lane); __syncthreads(); } }
        SEAM(pb + 7);
        REP(pb + 8) if (IN(pb + 8)) { REPBAR KArgsP ap = fresh_args(); PHASE_IDS unsigned char* ws = ap->ws; (void)ws;
            LAS int* ptab = (LAS int*)(lds + PTAB_OFF); LAS int* pst = ptab + 512; LAS int* cnt = pst + 32;
            build_ptab((const unsigned*)(ws + WS_CTL) + CW_CNT + l * 32, ptab, pst, cnt, tid);
            pg8::Gemm g{(const pg8::bf16_t*)(ws + WS_HN), (const pg8::bf16_t*)(ws + WS_W13), 0, 0, DM, (const int*)(ws + WS_LIST), ptab};
            pg8::MoeOrder S{ptab, G, vcu};
            pg8::EpiSwiglu E{(pg8::bf16_t*)(ws + WS_HMID)};
SUBREP(9) { pg8::gemm_phase<pg8::EpiSwiglu, pg8::MoeOrder, false, true, true>(lds, g, S, E); __syncthreads(); }
        }
        SEAM(pb + 8);
        REP(pb + 9) if (IN(pb + 9)) { REPBAR KArgsP ap = fresh_args(); PHASE_IDS unsigned char* ws = ap->ws; (void)ws;
            LAS int* ptab = (LAS int*)(lds + PTAB_OFF); LAS int* pst = ptab + 512; LAS int* cnt = pst + 32;
            build_ptab((const unsigned*)(ws + WS_CTL) + CW_CNT + l * 32, ptab, pst, cnt, tid);
            pg8::Gemm g{(const pg8::bf16_t*)(ws + WS_HMID), (const pg8::bf16_t*)(ws + WS_W2), 0, 0, DEXP};
            pg8::MoeOrder S{ptab, G, vcu};
            pg8::EpiMoeOut E{(pg8::bf16_t*)(ws + WS_YMOE), (const int*)(ws + WS_LIST), ptab};
SUBREP(10) { pg8::gemm_phase<pg8::EpiMoeOut, pg8::MoeOrder, true, true>(lds, g, S, E); __syncthreads(); }
        }
        SEAM(pb + 9);
#else
        SEAM(pb + 6); SEAM(pb + 7); SEAM(pb + 8); SEAM(pb + 9);
#endif
    }
#undef LCONST
#if N_LAYERS > 1
#define LCONST 1
    {
        constexpr int l = LCONST; constexpr int pb = 1 + l * PH_PER_LAYER;
        REP(pb + 0) if (IN(pb + 0)) { REPBAR KArgsP ap = fresh_args(); PHASE_IDS unsigned char* ws = ap->ws; (void)ws;
            if (l == 0) { mod_finalize(ws, tid, G); SUBREP(6) { phase_rownorm<0, false>(ap, lds, tid, lane, wave, G, ap->in[I_X], ap->out, ap->in[I_NORM_MIX], true, 0, 0, 0); __syncthreads(); } }
            else {
#if EN_MOE
                phase_rownorm<0, true>(ap, lds, tid, lane, wave, G, ap->out, ap->out, ap->in[I_NORM_MIX] + l * DM, false, l, 0, l - 1);
#else
                phase_rownorm<0, false>(ap, lds, tid, lane, wave, G, ap->out, ap->out, ap->in[I_NORM_MIX] + l * DM, false, l, 0, l - 1);
#endif
            }
        }
        SEAM(pb + 0);
        REP(pb + 1) if (IN(pb + 1)) { REPBAR KArgsP ap = fresh_args(); PHASE_IDS unsigned char* ws = ap->ws; (void)ws;
            pg8::Gemm g{(const pg8::bf16_t*)(ws + WS_HN), (const pg8::bf16_t*)(ws + WS_WIN) + (size_t)l * NPROJ_PAD * DM, NTOK, NPROJ_PAD, DM};
            pg8::StaticOrder S; S.init(NTOK, NPROJ_PAD, G, bx);
            pg8::EpiProj E{(pg8::bf16_t*)(ws + WS_PROJ), (float*)(ws + WS_GATES)};
SUBREP(7) { pg8::gemm_phase<pg8::EpiProj, pg8::StaticOrder, GEMM_ALIGN, GEMM_SP2>(lds, g, S, E); __syncthreads(); }
        }
        SEAM(pb + 1);
        REP(pb + 2) if (IN(pb + 2)) { REPBAR KArgsP ap = fresh_args(); PHASE_IDS unsigned char* ws = ap->ws; (void)ws;
#if EN_MLSTM
            for (int q_ = 0; q_ < 1 + (REPN - 1) * ((DBL_SUB == 1) && l == 0); ++q_) { phase_m1(ap, lds, tid, lane, wave, vcu, G, l); __syncthreads(); }
            __syncthreads();
#endif
#if EN_S5
            phase_s1(ap, lds, tid, lane, wave, vcu, G, l); __syncthreads();
#if DBL_SUB == 2
            if (l == 0) { phase_s1(ap, lds, tid, lane, wave, vcu, G, l); __syncthreads(); phase_s1(ap, lds, tid, lane, wave, vcu, G, l); __syncthreads(); phase_s1(ap, lds, tid, lane, wave, vcu, G, l); __syncthreads(); phase_s1(ap, lds, tid, lane, wave, vcu, G, l); __syncthreads(); }
#endif
            __syncthreads();
#endif
#if EN_RWKV
            for (int q_ = 0; q_ < 1 + (REPN - 1) * ((DBL_SUB == 3) && l == 0); ++q_) { phase_r1(ap, lds, tid, lane, wave, vcu, G, l); __syncthreads(); }
#endif
        }
        SEAM(pb + 2);
        REP(pb + 3) if (IN(pb + 3)) { REPBAR KArgsP ap = fresh_args(); PHASE_IDS unsigned char* ws = ap->ws; (void)ws;
            phase_m2(ws, tid, vcu, G);
            phase_s2(ap, tid, vcu, G, l);
            __syncthreads();
            phase_r2_build(ap, lds, tid, lane, wave, vcu, G, l, 0, R2_SPLIT);
        }
        SEAM(pb + 3);
        REP(pb + 4) if (IN(pb + 4)) { REPBAR KArgsP ap = fresh_args(); PHASE_IDS unsigned char* ws = ap->ws; (void)ws;
            if (bx < R2_WGS) {
#if DBL_SUB == 4
                if (l == 0) { for (int q_ = 0; q_ < REPN - 1; ++q_) { phase_r2_scan<SCANVAR>(ap, lds, tid, lane, wave, bx, l, R2_SPLIT, (unsigned)(G - R2_WGS)); __syncthreads(); } }
#endif
                phase_r2_scan(ap, lds, tid, lane, wave, bx, l, R2_SPLIT, (unsigned)(G - R2_WGS)); __syncthreads(); }
            else {
                phase_r2_build(ap, lds, tid, lane, wave, bx - R2_WGS, G - R2_WGS, l, R2_SPLIT, SEQ / 32 - R2_SPLIT);
                asm volatile("s_waitcnt vmcnt(0)" ::: "memory"); __syncthreads();
                if (tid == 0) { __builtin_amdgcn_fence(__ATOMIC_RELEASE, "agent"); asm volatile("s_waitcnt vmcnt(0)" ::: "memory"); (void)xb_add((unsigned*)(ws + WS_CTL) + CW_Q + 64 * l + 48, 1u); }
                phase_s3(ap, lds, tid, lane, wave, 0, 1, l, (unsigned*)(ws + WS_CTL) + CW_Q + 64 * l + 32); __syncthreads();
            }
            {
                unsigned* qctr = (unsigned*)(ws + WS_CTL) + CW_Q + 64 * l; volatile LAS unsigned* qw = (volatile LAS unsigned*)(lds + MISC_OFF) + 16;
                unsigned nxt = 0u; if (tid == 0) nxt = __hip_atomic_fetch_add(qctr, 1u, __ATOMIC_RELAXED, __HIP_MEMORY_SCOPE_AGENT);
                for (;;) {
                    if (tid == 0) *qw = nxt;
                    __syncthreads();
                    const int u = (int)*qw;
                    __syncthreads();
                    if (u >= NUNIT_M) break;
                    if (tid == 0) nxt = __hip_atomic_fetch_add(qctr, 1u, __ATOMIC_RELAXED, __HIP_MEMORY_SCOPE_AGENT);
                    phase_m3(ap, lds, tid, lane, wave, u, NUNIT_M, l);
                }
            }
        }
        SEAM(pb + 4);
        REP(pb + 6) if (IN(pb + 6)) { REPBAR KArgsP ap = fresh_args(); PHASE_IDS unsigned char* ws = ap->ws; (void)ws;
            pg8::Gemm g{(const pg8::bf16_t*)(ws + WS_YC), (const pg8::bf16_t*)(ws + WS_WOUT) + (size_t)l * DM * DM, NTOK, DM, DM};
            pg8::StaticOrder S; S.init(NTOK, DM, G, bx);
            pg8::EpiResid E{l == 0 ? ap->in[I_X] : (const float*)ap->out, ap->out, (const float*)(ws + WS_MODF) + (size_t)l * 4 * 6144, 2048};
SUBREP(8) { pg8::gemm_phase<pg8::EpiResid, pg8::StaticOrder, GEMM_ALIGN, GEMM_SP2>(lds, g, S, E); __syncthreads(); }
        }
        SEAM(pb + 6);
#if EN_MOE
        REP(pb + 7) if (IN(pb + 7)) { REPBAR KArgsP ap = fresh_args(); PHASE_IDS phase_router(ap, lds, tid, lane, wave, G, l); __syncthreads();
            SUBREP(11) {
            moe_convert13(ap->in[I_MW1], ap->in[I_MW3], l, (bf16*)(ap->ws + WS_W13), vcu * NWAVES + wave, G * NWAVES, (LAS float*)(lds + wave * 16640), lane);
            moe_convert2(ap->in[I_MW2], l, (bf16*)(ap->ws + WS_W2), vcu * NWAVES + wave, G * NWAVES, (LAS float*)(lds + wave * 16640), lane); __syncthreads(); } }
        SEAM(pb + 7);
        REP(pb + 8) if (IN(pb + 8)) { REPBAR KArgsP ap = fresh_args(); PHASE_IDS unsigned char* ws = ap->ws; (void)ws;
            LAS int* ptab = (LAS int*)(lds + PTAB_OFF); LAS int* pst = ptab + 512; LAS int* cnt = pst + 32;
            build_ptab((const unsigned*)(ws + WS_CTL) + CW_CNT + l * 32, ptab, pst, cnt, tid);
            pg8::Gemm g{(const pg8::bf16_t*)(ws + WS_HN), (const pg8::bf16_t*)(ws + WS_W13), 0, 0, DM, (const int*)(ws + WS_LIST), ptab};
            pg8::MoeOrder S{ptab, G, vcu};
            pg8::EpiSwiglu E{(pg8::bf16_t*)(ws + WS_HMID)};
SUBREP(9) { pg8::gemm_phase<pg8::EpiSwiglu, pg8::MoeOrder, false, true, true>(lds, g, S, E); __syncthreads(); }
        }
        SEAM(pb + 8);
        REP(pb + 9) if (IN(pb + 9)) { REPBAR KArgsP ap = fresh_args(); PHASE_IDS unsigned char* ws = ap->ws; (void)ws;
            LAS int* ptab = (LAS int*)(lds + PTAB_OFF); LAS int* pst = ptab + 512; LAS int* cnt = pst + 32;
            build_ptab((const unsigned*)(ws + WS_CTL) + CW_CNT + l * 32, ptab, pst, cnt, tid);
            pg8::Gemm g{(const pg8::bf16_t*)(ws + WS_HMID), (const pg8::bf16_t*)(ws + WS_W2), 0, 0, DEXP};
            pg8::MoeOrder S{ptab, G, vcu};
            pg8::EpiMoeOut E{(pg8::bf16_t*)(ws + WS_YMOE), (const int*)(ws + WS_LIST), ptab};
SUBREP(10) { pg8::gemm_phase<pg8::EpiMoeOut, pg8::MoeOrder, true, true>(lds, g, S, E); __syncthreads(); }
        }
        SEAM(pb + 9);
#else
        SEAM(pb + 6); SEAM(pb + 7); SEAM(pb + 8); SEAM(pb + 9);
#endif
    }
#undef LCONST
#endif
    if (IN(PH_FINAL)) { KArgsP ap = fresh_args(); PHASE_IDS
#if EN_MOE
        if (N_LAYERS > 0) phase_rownorm<1, true>(ap, lds, tid, lane, wave, G, ap->out, ap->out, ap->in[I_NORM_FINAL], false, 0, 0, N_LAYERS - 1);
        else phase_rownorm<1, false>(ap, lds, tid, lane, wave, G, ap->in[I_X], ap->out, ap->in[I_NORM_FINAL], false, 0, 0, 0);
#else
        phase_rownorm<1, false>(ap, lds, tid, lane, wave, G, N_LAYERS > 0 ? (const float*)ap->out : ap->in[I_X], ap->out, ap->in[I_NORM_FINAL], false, 0, 0, 0);
#endif
    }
#undef IN
#undef SEAM
}

extern "C" void kernel_launch(void* const* d_in, const int* in_sizes, int n_in, void* d_out, int out_size, void* d_ws, size_t ws_size, hipStream_t stream) {
    static int grid = 0;
    if (grid == 0) {
        if (n_in != 47 || out_size != NTOK * DM || ws_size < WS_END) { fprintf(stderr, "kernel_launch: unexpected problem (n_in %d, out %d, ws %zu < %zu)\n", n_in, out_size, ws_size, (size_t)WS_END); grid = -1; return; }
        int dev = 0, cus = 0, per_cu = 0;
        if (hipGetDevice(&dev) != hipSuccess || hipDeviceGetAttribute(&cus, hipDeviceAttributeMultiprocessorCount, dev) != hipSuccess) { grid = -1; return; }
        if (hipFuncSetAttribute((const void*)fwd, hipFuncAttributeMaxDynamicSharedMemorySize, LDS_BYTES) != hipSuccess) { fprintf(stderr, "kernel_launch: hipFuncSetAttribute failed\n"); grid = -1; return; }
        if (hipOccupancyMaxActiveBlocksPerMultiprocessor(&per_cu, (const void*)fwd, NTHR, LDS_BYTES) != hipSuccess || per_cu < 1) fprintf(stderr, "kernel_launch: occupancy query says %d\n", per_cu);
        (void)hipGetLastError();
        grid = cus;
        if (grid != 256) fprintf(stderr, "kernel_launch: %d CUs (built for 256)\n", grid);
    }
    if (grid < 0) return;
    (void)hipMemsetAsync((char*)d_ws + WS_CTL, 0, CTL_ZERO_BYTES, stream);
    Args a{};
    for (int i = 0; i < 47; ++i) a.in[i] = (const float*)d_in[i];
    a.out = (float*)d_out; a.ws = (unsigned char*)d_ws;
#if MK_PER_PHASE
    for (int p = 0; p < N_PHASES; ++p) { a.ph_lo = p; a.ph_hi = p + 1; hipLaunchKernelGGL(fwd, dim3(grid), dim3(NTHR), LDS_BYTES, stream, a); }
#else
    a.ph_lo = 0; a.ph_hi = N_PHASES; hipLaunchKernelGGL(fwd, dim3(grid), dim3(NTHR), LDS_BYTES, stream, a);
#endif
}
#ifdef DIAG_KERNELS
#define DK(name, ...) __global__ void __launch_bounds__(NTHR, 2) name(Args args) { extern __shared__ __attribute__((aligned(16))) unsigned char lds_raw[]; LAS unsigned char* lds = (LAS unsigned char*)lds_raw; \
    const int tid = threadIdx.x, lane = tid & 63, wave = __builtin_amdgcn_readfirstlane(tid >> 6); const int G = gridDim.x; const int bx = blockIdx.x; const int vcu = bx; KArgsP ap = fresh_args(); int l = ap->ph_lo; (void)lane; (void)wave; (void)vcu; (void)G; (void)l; __VA_ARGS__ }
DK(k_prologue, phase_prologue(ap, lds, tid, lane, wave, vcu, G);)
DK(k_norm0, phase_rownorm<0, false>(ap, lds, tid, lane, wave, G, ap->in[I_X], ap->out, ap->in[I_NORM_MIX], true, 0, 0, 0);)
DK(k_norm1, phase_rownorm<0, true>(ap, lds, tid, lane, wave, G, ap->out, ap->out, ap->in[I_NORM_MIX], false, l, 0, 0);)
DK(k_normf, phase_rownorm<1, true>(ap, lds, tid, lane, wave, G, ap->out, ap->out, ap->in[I_NORM_MIX], false, l, 0, 0);)
DK(k_m1, phase_m1(ap, lds, tid, lane, wave, vcu, G, l);)
DK(k_m2, phase_m2(ap->ws, tid, vcu, G);)
DK(k_m3, phase_m3(ap, lds, tid, lane, wave, vcu, G, l);)
DK(k_s1, phase_s1(ap, lds, tid, lane, wave, vcu, G, l);)
DK(k_s2, phase_s2(ap, tid, vcu, G, l);)
DK(k_s3, phase_s3(ap, lds, tid, lane, wave, vcu, G, l);)
DK(k_r1, phase_r1(ap, lds, tid, lane, wave, vcu, G, l);)
DK(k_r2b, phase_r2_build(ap, lds, tid, lane, wave, vcu, G, l);)
DK(k_r2s, phase_r2_scan(ap, lds, tid, lane, wave, vcu, l);)
DK(k_r3, phase_r3(ap, lane, vcu * NWAVES + wave, G * NWAVES, l);)
DK(k_router, phase_router(ap, lds, tid, lane, wave, G, l);)
DK(k_gather, phase_gather(ap, lds, tid, lane, wave, vcu, G, l);)
DK(k_moecv, moe_convert13(ap->in[I_MW1], ap->in[I_MW3], 1, (bf16*)(ap->ws + WS_W13), vcu * NWAVES + wave, G * NWAVES, (LAS float*)(lds + wave * 16640), lane);)
#endif
```
